# Optimizing an MI355X kernel written in HIP

```python
import math
import jax, jax.numpy as jnp
from jax import lax
import numpy as np

D_MODEL = 2048
BATCH = 2
SEQ = 8192
DEPTH = 2

HY_CH = D_MODEL // 2
HY_ORDER = 2
HY_SHORT = 3
HF_BANDS = 16
HF_EMB = 2 * HF_BANDS + 1
HF_HIDDEN = 64
HF_TARGET = 1e-2
HF_FAST = 0.3
HF_SLOW = 1.5
DA_HEADS = 8
DA_HEAD_DIM = 64
DA_V_DIM = 2 * DA_HEAD_DIM
DA_QK = DA_HEADS * 2 * DA_HEAD_DIM
DA_WIDTH = DA_HEADS * DA_V_DIM
Q_BLOCK = 128
EV_IN = 3 * HY_CH + 2 * DA_QK + DA_WIDTH

RG_WIDTH = D_MODEL
RG_BLOCKS = 8
RG_BLOCK_W = RG_WIDTH // RG_BLOCKS
RG_CONV = 4
RG_C = 8.0

N_EXPERTS = 32
N_GROUPS = 4
EXPERTS_PER_GROUP = N_EXPERTS // N_GROUPS
TOP_K = 2
D_FF = 512
MOE_BLOCK = 128

N_EVEN = (DEPTH + 1) // 2
N_ODD = DEPTH // 2
DN_ALPHA = (2 * DEPTH) ** 0.25
DN_BETA = (8 * DEPTH) ** -0.25
LN_EPS = 1e-5

kernel_name = "hyena_diffattn_rglru_grouped_moe_deepnorm"

F32 = jnp.float32


def layer_norm(x, g, b):
    xf = x.astype(F32)
    mu = xf.mean(-1, keepdims=True)
    var = jnp.square(xf - mu).mean(-1, keepdims=True)
    return ((xf - mu) * lax.rsqrt(var + LN_EPS) * g.astype(F32) + b.astype(F32)).astype(x.dtype)


def depthwise_conv(x, w, b, left):
    k, s = w.shape[0], x.shape[1]
    xp = jnp.pad(x, ((0, 0), (left, k - 1 - left), (0, 0)))
    return sum(xp[:, j:j + s] * w[j] for j in range(k)) + b


def hyena_filters(L, w1, b1, w2, b2, w3, b3, freq, w4):
    t = jnp.linspace(0.0, 1.0, L, dtype=F32)[:, None]
    omega = 2.0 * math.pi * jnp.arange(L, dtype=F32)[:, None] / L
    bands = jnp.linspace(1e-4, HF_BANDS - 1, HF_BANDS, dtype=F32)[None, :]
    ang = omega * bands
    z = jnp.concatenate([t, jnp.cos(ang), -jnp.sin(ang)], -1)
    fr = freq.astype(F32)
    h = jnp.sin(fr * (z @ w1.astype(F32) + b1.astype(F32)))
    h = jnp.sin(fr * (h @ w2.astype(F32) + b2.astype(F32)))
    h = jnp.sin(fr * (h @ w3.astype(F32) + b3.astype(F32)))
    h = (h @ w4.astype(F32)).reshape(L, 2, HY_ORDER, HY_CH)
    max_decay = math.log(HF_TARGET) / HF_FAST
    min_decay = math.log(HF_TARGET) / HF_SLOW
    deltas = jnp.abs(jnp.linspace(min_decay, max_decay, HY_CH, dtype=F32))
    h = h * jnp.exp(-t[:, :, None, None] * deltas)
    k = jnp.concatenate([h[:, 0], jnp.zeros((1, HY_ORDER, HY_CH), F32), h[:0:-1, 1]], 0)
    k = k * lax.rsqrt(jnp.sum(k * k, 0, keepdims=True))
    return jnp.fft.rfft(k, axis=0)


def hyena_mixer(v, x1, x2, k_f, skip):
    L = v.shape[1]
    z = v.astype(F32)
    for o, g in enumerate((x1, x2)):
        zf = jnp.fft.rfft(z, n=2 * L, axis=1)
        y = jnp.fft.irfft(zf * k_f[None, :, o], n=2 * L, axis=1)[:, :L]
        z = g.astype(F32) * (y + skip[o].astype(F32) * z)
    return z.astype(v.dtype)


def diff_attention(q, k, v, lam, subln_g, lambda_init):
    B, S, _ = q.shape
    q = q.reshape(B, S, DA_HEADS, 2, DA_HEAD_DIM).transpose(0, 2, 3, 1, 4) * (DA_HEAD_DIM ** -0.5)
    k = k.reshape(B, S, DA_HEADS, 2, DA_HEAD_DIM).transpose(0, 2, 3, 1, 4)
    v = v.reshape(B, S, DA_HEADS, DA_V_DIM).transpose(0, 2, 1, 3)
    nqb = S // Q_BLOCK
    qb = q.reshape(B, DA_HEADS, 2, nqb, Q_BLOCK, DA_HEAD_DIM).transpose(3, 0, 1, 2, 4, 5)
    slopes = 2.0 ** (-(8.0 / DA_HEADS) * jnp.arange(1, DA_HEADS + 1, dtype=F32))
    kpos = jnp.arange(S)

    def block(args):
        qblk, start = args
        s = jnp.einsum('bhcqd,bhckd->bhcqk', qblk, k).astype(F32)
        qpos = start + jnp.arange(Q_BLOCK)
        dist = jnp.abs(qpos[:, None] - kpos[None, :]).astype(F32)
        s = s - slopes[:, None, None, None] * dist
        p = jax.nn.softmax(s, axis=-1)
        a = (p[:, :, 0] - lam * p[:, :, 1]).astype(v.dtype)
        return jnp.einsum('bhqk,bhkv->bhqv', a, v)

    o = lax.map(block, (qb, jnp.arange(nqb) * Q_BLOCK))
    o = o.transpose(1, 0, 3, 2, 4).reshape(B, S, DA_HEADS, DA_V_DIM).astype(F32)
    o = o * lax.rsqrt(jnp.mean(o * o, -1, keepdims=True) + LN_EPS) * subln_g.astype(F32)
    o = o * (1.0 - lambda_init)
    return o.reshape(B, S, DA_WIDTH).astype(q.dtype)


def _lin_rec(left, right):
    a1, b1 = left
    a2, b2 = right
    return a1 * a2, a2 * b1 + b2


def rg_lru_bidir(xr, wa, ba, wx, bx, lam):
    B, S, _ = xr.shape
    xf = xr.astype(F32)
    xb = xf.reshape(B, S, RG_BLOCKS, RG_BLOCK_W)
    y = 0
    for d in range(2):
        r = jax.nn.sigmoid(jnp.einsum('bsni,nij->bsnj', xb, wa[d].astype(F32)).reshape(B, S, RG_WIDTH) + ba[d].astype(F32))
        i = jax.nn.sigmoid(jnp.einsum('bsni,nij->bsnj', xb, wx[d].astype(F32)).reshape(B, S, RG_WIDTH) + bx[d].astype(F32))
        log_a = -RG_C * r * jax.nn.softplus(-lam[d].astype(F32))
        a = jnp.exp(log_a)
        b = jnp.sqrt(-jnp.expm1(2.0 * log_a)) * (i * xf)
        _, h = lax.associative_scan(_lin_rec, (a, b), axis=1, reverse=(d == 1))
        y = y + h
    return y


def route(xf, router_w, router_b):
    N = xf.shape[0]
    s = jax.nn.sigmoid((xf @ router_w).astype(F32))
    sel = (s + router_b.astype(F32)).reshape(N, N_GROUPS, EXPERTS_PER_GROUP)
    group_score = lax.top_k(sel, TOP_K)[0].sum(-1)
    g = jnp.argmax(group_score, -1).astype(jnp.int32)
    sel_g = jnp.take_along_axis(sel, g[:, None, None], 1)[:, 0]
    _, local = lax.top_k(sel_g, TOP_K)
    s_g = jnp.take_along_axis(s.reshape(N, N_GROUPS, EXPERTS_PER_GROUP), g[:, None, None], 1)[:, 0]
    w = jnp.take_along_axis(s_g, local, -1)
    w = w / w.sum(-1, keepdims=True)
    return g[:, None] * EXPERTS_PER_GROUP + local.astype(jnp.int32), w


def moe_ffn(x, router_w, router_b, w_gate, w_up, w_down):
    B, S, D = x.shape
    N = B * S
    A = N * TOP_K
    xf = x.reshape(N, D)
    e_idx, gate = route(xf, router_w, router_b)
    e_flat = e_idx.reshape(A)
    g_flat = gate.reshape(A)
    tok = jnp.arange(A, dtype=jnp.int32) // TOP_K
    order = jnp.argsort(e_flat)
    e_sorted = e_flat[order]
    counts = jax.ops.segment_sum(jnp.ones((A,), jnp.int32), e_flat, num_segments=N_EXPERTS)
    padded = (counts + MOE_BLOCK - 1) // MOE_BLOCK * MOE_BLOCK
    pad_end = jnp.cumsum(padded)
    pad_start = pad_end - padded
    start = jnp.cumsum(counts) - counts
    dest = pad_start[e_sorted] + jnp.arange(A, dtype=jnp.int32) - start[e_sorted]
    n_blocks = -(-A // MOE_BLOCK) + N_EXPERTS
    P = n_blocks * MOE_BLOCK
    row_tok = jnp.full((P,), N, jnp.int32).at[dest].set(tok[order])
    row_gate = jnp.zeros((P,), F32).at[dest].set(g_flat[order])
    blk_exp = jnp.minimum(jnp.searchsorted(pad_end, jnp.arange(n_blocks) * MOE_BLOCK, side='right'), N_EXPERTS - 1)
    x_pad = jnp.concatenate([xf, jnp.zeros((1, D), xf.dtype)], 0)
    xb = x_pad[row_tok].reshape(n_blocks, MOE_BLOCK, D)

    def expert_block(args):
        xblk, e = args
        h = jax.nn.silu(xblk @ w_gate[e]) * (xblk @ w_up[e])
        return h @ w_down[e]

    yb = lax.map(expert_block, (xb, blk_exp)).reshape(P, D)
    y = jax.ops.segment_sum(yb * row_gate[:, None].astype(yb.dtype), row_tok, num_segments=N + 1)[:N]
    return y.reshape(B, S, D)


def setup_inputs(seed: int = 0) -> dict:
    key = jax.random.key(seed)
    keys = iter(jax.random.split(key, 48))

    def nrm(shape, scale):
        return scale * jax.random.normal(next(keys), shape, F32)

    D = D_MODEL
    x = nrm((BATCH, SEQ, D), 1.0)
    ev_w_in = nrm((N_EVEN, D, EV_IN), D ** -0.5)
    ev_hy_conv_w = nrm((N_EVEN, HY_SHORT, 3 * HY_CH), HY_SHORT ** -0.5)
    ev_hy_conv_b = nrm((N_EVEN, 3 * HY_CH), 0.02)
    ev_hf_w1 = nrm((N_EVEN, HF_EMB, HF_HIDDEN), HF_EMB ** -0.5)
    ev_hf_b1 = nrm((N_EVEN, HF_HIDDEN), 0.1)
    ev_hf_w2 = nrm((N_EVEN, HF_HIDDEN, HF_HIDDEN), HF_HIDDEN ** -0.5)
    ev_hf_b2 = nrm((N_EVEN, HF_HIDDEN), 0.1)
    ev_hf_w3 = nrm((N_EVEN, HF_HIDDEN, HF_HIDDEN), HF_HIDDEN ** -0.5)
    ev_hf_b3 = nrm((N_EVEN, HF_HIDDEN), 0.1)
    ev_hf_freq = 1.0 + nrm((N_EVEN, HF_HIDDEN), 0.1)
    ev_hf_w4 = nrm((N_EVEN, HF_HIDDEN, 2 * HY_ORDER * HY_CH), HF_HIDDEN ** -0.5)
    ev_hy_skip = nrm((N_EVEN, HY_ORDER, HY_CH), 0.5)
    ev_lam_q1 = nrm((N_EVEN, DA_HEAD_DIM), 0.1)
    ev_lam_k1 = nrm((N_EVEN, DA_HEAD_DIM), 0.1)
    ev_lam_q2 = nrm((N_EVEN, DA_HEAD_DIM), 0.1)
    ev_lam_k2 = nrm((N_EVEN, DA_HEAD_DIM), 0.1)
    ev_subln_g = 1.0 + nrm((N_EVEN, DA_V_DIM), 0.01)
    ev_w_out = nrm((N_EVEN, HY_CH + DA_WIDTH, D), DN_BETA * (HY_CH + DA_WIDTH) ** -0.5)
    od_w_in = nrm((N_ODD, D, 2 * RG_WIDTH), D ** -0.5)
    od_conv_w = nrm((N_ODD, RG_CONV, RG_WIDTH), RG_CONV ** -0.5)
    od_conv_b = nrm((N_ODD, RG_WIDTH), 0.02)
    od_wa = nrm((N_ODD, 2, RG_BLOCKS, RG_BLOCK_W, RG_BLOCK_W), RG_BLOCK_W ** -0.5)
    od_ba = nrm((N_ODD, 2, RG_WIDTH), 0.02)
    od_wx = nrm((N_ODD, 2, RG_BLOCKS, RG_BLOCK_W, RG_BLOCK_W), RG_BLOCK_W ** -0.5)
    od_bx = nrm((N_ODD, 2, RG_WIDTH), 0.02)
    u = jax.random.uniform(next(keys), (N_ODD, 2, RG_WIDTH), F32, 0.9, 0.999)
    s = u ** (1.0 / RG_C)
    od_lam = jnp.log(s) - jnp.log1p(-s)
    od_w_out = nrm((N_ODD, RG_WIDTH, D), DN_BETA * RG_WIDTH ** -0.5)
    ln1_g = 1.0 + nrm((DEPTH, D), 0.01)
    ln1_b = nrm((DEPTH, D), 0.01)
    ln2_g = 1.0 + nrm((DEPTH, D), 0.01)
    ln2_b = nrm((DEPTH, D), 0.01)
    router_w = nrm((D, N_EXPERTS), D ** -0.5)
    router_b = nrm((N_EXPERTS,), 0.01)
    ex_w_gate = nrm((DEPTH, N_EXPERTS, D, D_FF), D ** -0.5)
    ex_w_up = nrm((DEPTH, N_EXPERTS, D, D_FF), D ** -0.5)
    ex_w_down = nrm((DEPTH, N_EXPERTS, D_FF, D), DN_BETA * D_FF ** -0.5)
    return {"x": x, "ev_w_in": ev_w_in, "ev_hy_conv_w": ev_hy_conv_w, "ev_hy_conv_b": ev_hy_conv_b,
            "ev_hf_w1": ev_hf_w1, "ev_hf_b1": ev_hf_b1, "ev_hf_w2": ev_hf_w2, "ev_hf_b2": ev_hf_b2,
            "ev_hf_w3": ev_hf_w3, "ev_hf_b3": ev_hf_b3, "ev_hf_freq": ev_hf_freq, "ev_hf_w4": ev_hf_w4,
            "ev_hy_skip": ev_hy_skip, "ev_lam_q1": ev_lam_q1, "ev_lam_k1": ev_lam_k1,
            "ev_lam_q2": ev_lam_q2, "ev_lam_k2": ev_lam_k2, "ev_subln_g": ev_subln_g, "ev_w_out": ev_w_out,
            "od_w_in": od_w_in, "od_conv_w": od_conv_w, "od_conv_b": od_conv_b, "od_wa": od_wa,
            "od_ba": od_ba, "od_wx": od_wx, "od_bx": od_bx, "od_lam": od_lam, "od_w_out": od_w_out,
            "ln1_g": ln1_g, "ln1_b": ln1_b, "ln2_g": ln2_g, "ln2_b": ln2_b,
            "router_w": router_w, "router_b": router_b,
            "ex_w_gate": ex_w_gate, "ex_w_up": ex_w_up, "ex_w_down": ex_w_down}


def reference(x, ev_w_in, ev_hy_conv_w, ev_hy_conv_b, ev_hf_w1, ev_hf_b1, ev_hf_w2, ev_hf_b2,
              ev_hf_w3, ev_hf_b3, ev_hf_freq, ev_hf_w4, ev_hy_skip, ev_lam_q1, ev_lam_k1,
              ev_lam_q2, ev_lam_k2, ev_subln_g, ev_w_out, od_w_in, od_conv_w, od_conv_b, od_wa,
              od_ba, od_wx, od_bx, od_lam, od_w_out, ln1_g, ln1_b, ln2_g, ln2_b,
              router_w, router_b, ex_w_gate, ex_w_up, ex_w_down):
    S = x.shape[1]
    h = x
    for layer in range(DEPTH):
        i = layer // 2
        if layer % 2 == 0:
            u = h @ ev_w_in[i]
            hy = depthwise_conv(u[..., :3 * HY_CH], ev_hy_conv_w[i], ev_hy_conv_b[i], 1)
            v_h, x1, x2 = jnp.split(hy, 3, axis=-1)
            q = u[..., 3 * HY_CH:3 * HY_CH + DA_QK]
            k = u[..., 3 * HY_CH + DA_QK:3 * HY_CH + 2 * DA_QK]
            v = u[..., 3 * HY_CH + 2 * DA_QK:]
            k_f = hyena_filters(S, ev_hf_w1[i], ev_hf_b1[i], ev_hf_w2[i], ev_hf_b2[i],
                                ev_hf_w3[i], ev_hf_b3[i], ev_hf_freq[i], ev_hf_w4[i])
            y_hy = hyena_mixer(v_h, x1, x2, k_f, ev_hy_skip[i])
            lambda_init = 0.8 - 0.6 * math.exp(-0.3 * layer)
            lam = (jnp.exp(jnp.sum(ev_lam_q1[i].astype(F32) * ev_lam_k1[i].astype(F32)))
                   - jnp.exp(jnp.sum(ev_lam_q2[i].astype(F32) * ev_lam_k2[i].astype(F32))) + lambda_init)
            y_da = diff_attention(q, k, v, lam, ev_subln_g[i], lambda_init)
            mix = jnp.concatenate([y_hy, y_da], axis=-1) @ ev_w_out[i]
        else:
            u = h @ od_w_in[i]
            gate_b, xr = jnp.split(u, 2, axis=-1)
            xr = depthwise_conv(xr, od_conv_w[i], od_conv_b[i], 2)
            y = rg_lru_bidir(xr, od_wa[i], od_ba[i], od_wx[i], od_bx[i], od_lam[i])
            mix = (jax.nn.gelu(gate_b.astype(F32)) * y).astype(h.dtype) @ od_w_out[i]
        h = layer_norm(DN_ALPHA * h + mix, ln1_g[layer], ln1_b[layer])
        ffn = moe_ffn(h, router_w, router_b, ex_w_gate[layer], ex_w_up[layer], ex_w_down[layer])
        h = layer_norm(DN_ALPHA * h + ffn, ln2_g[layer], ln2_b[layer])
    return h
```

```cpp
#define MK_PER_PHASE 1
#include <hip/hip_runtime.h>
#include <hip/hip_fp16.h>
#include <cstdio>
#include <cstdint>

#define GAS __attribute__((address_space(1)))
#define LAS __attribute__((address_space(3)))
typedef unsigned short bf16_t;
typedef short bf16x8 __attribute__((ext_vector_type(8)));
typedef short s16x4 __attribute__((ext_vector_type(4)));
typedef float f32x2 __attribute__((ext_vector_type(2)));
typedef float f32x4 __attribute__((ext_vector_type(4)));
typedef float f32x8 __attribute__((ext_vector_type(8)));
typedef float f32x16 __attribute__((ext_vector_type(16)));
typedef unsigned u32x2 __attribute__((ext_vector_type(2)));
typedef unsigned u32x4 __attribute__((ext_vector_type(4)));
typedef GAS unsigned gu32;

constexpr int DM = 2048, BATCH = 2, SEQ = 8192, NTOK = BATCH * SEQ;
constexpr int HY_CH = 1024, EV_IN = 6144;
constexpr int NEXP = 32, DFF = 512, NASSIGN = NTOK * 2, ECAP = NASSIGN;
constexpr float LN_EPS = 1e-5f;
constexpr float DN_ALPHA = 1.4142135623730951f;
constexpr float QSCALE = 0.125f * 1.4426950408889634f;
constexpr int FFT_N = 16384, FFT_RS = 528;

__device__ __forceinline__ unsigned f2bf(float f) { unsigned u = __builtin_bit_cast(unsigned, f); return (u + 0x7fffu + ((u >> 16) & 1u)) >> 16; }
__device__ __forceinline__ unsigned pk2(float lo, float hi) { return f2bf(lo) | (f2bf(hi) << 16); }
__device__ __forceinline__ float bf2f(unsigned short h) { return __builtin_bit_cast(float, (unsigned)h << 16); }
__device__ __forceinline__ float bflo(unsigned w) { return __builtin_bit_cast(float, w << 16); }
__device__ __forceinline__ float bfhi(unsigned w) { return __builtin_bit_cast(float, w & 0xffff0000u); }
__device__ __forceinline__ unsigned cvt_pk_bf16(float lo, float hi) { unsigned r; asm volatile("v_cvt_pk_bf16_f32 %0, %1, %2" : "=v"(r) : "v"(lo), "v"(hi)); return r; }
__device__ __forceinline__ float wave_sum(float v) {
#pragma unroll
    for (int o = 1; o < 64; o <<= 1) v += __shfl_xor(v, o);
    return v;
}
__device__ __forceinline__ float sigmoidf_(float x) { return 1.0f / (1.0f + __expf(-x)); }
__device__ __forceinline__ int opaque_tid() { int t = threadIdx.x; asm volatile("" : "+v"(t)); return t; }
#define LDS_WAIT() asm volatile("s_waitcnt lgkmcnt(0)" ::: "memory")
#define VM_WAIT() asm volatile("s_waitcnt vmcnt(0)" ::: "memory")

#define XB_TMO      128
#define XB_XCNT(j)  (256  + 64 * (j))
#define XB_XSUB(j)  (1280 + 64 * (j))
#define XB_XGEN(j)  (2304 + 64 * (j))
#define XB_TOP      3328
#define XB_TOPGEN   3392
#define XCD_BAR_WORDS 3456
#define XB_SPIN_CAP (1u << 18)
__device__ __forceinline__ unsigned xb_ld(unsigned* p)              { return __hip_atomic_load(p, __ATOMIC_RELAXED, __HIP_MEMORY_SCOPE_AGENT); }
__device__ __forceinline__ unsigned xb_add(unsigned* p, unsigned v) { return __hip_atomic_fetch_add(p, v, __ATOMIC_RELAXED, __HIP_MEMORY_SCOPE_AGENT); }
__device__ __forceinline__ unsigned xb_xcc_id() { return (unsigned)__builtin_amdgcn_s_getreg((3 << 11) | 20) & 0xFu; }
#define XB_SPIN(cond, bar) do { unsigned _sp = 0; while (cond) { __builtin_amdgcn_s_sleep(1); \
    if ((++_sp & 255u) == 0u) { if (xb_ld(&(bar)[XB_TMO])) break; if (_sp > XB_SPIN_CAP) { atomicAdd(&(bar)[XB_TMO], 1u); break; } } } } while (0)
struct XcdBarrier { unsigned* bar; unsigned x; volatile LAS unsigned* st; };
__device__ __forceinline__ XcdBarrier xcd_barrier_post(unsigned* bar, volatile LAS unsigned* st) {
    XcdBarrier b; b.bar = bar; b.x = xb_xcc_id(); b.st = st;
    if (threadIdx.x == 0) (void)xb_add(&bar[XB_XCNT(b.x)], 1u);
    return b;
}
__device__ __forceinline__ void xcd_barrier_complete(unsigned* bar, unsigned x, unsigned& nloc, unsigned& nx) {
    const unsigned G = gridDim.x * gridDim.y * gridDim.z;
    unsigned sum, cnt, mine, sp = 0u;
    for (;;) {
        sum = 0u; cnt = 0u; mine = 0u;
#pragma unroll
        for (unsigned j = 0; j < 16; ++j) { const unsigned c = xb_ld(&bar[XB_XCNT(j)]); sum += c; cnt += (c > 0u) ? 1u : 0u; mine = (j == x) ? c : mine; }
        if (sum == G) break;
        __builtin_amdgcn_s_sleep(1);
        if ((++sp & 255u) == 0u) { if (xb_ld(&bar[XB_TMO])) break; if (sp > XB_SPIN_CAP) { atomicAdd(&bar[XB_TMO], 1u); break; } }
    }
    nloc = mine > 0u ? mine : 1u; nx = cnt > 0u ? cnt : 1u;
}
__device__ __forceinline__ void xcd_barrier(const XcdBarrier& b) {
    asm volatile("s_waitcnt vmcnt(0)" ::: "memory");
    __syncthreads();
    if (threadIdx.x == 0) {
        unsigned* bar = b.bar;
        __builtin_amdgcn_s_waitcnt(0);
        unsigned nloc = b.st[0], nx = b.st[1];
        if (nloc == 0u) { xcd_barrier_complete(bar, b.x, nloc, nx); b.st[0] = nloc; b.st[1] = nx; }
        const unsigned old = xb_add(&bar[XB_XSUB(b.x)], 1u);
        const unsigned gen = old / nloc;
        if (old + 1u == (gen + 1u) * nloc) {
            __builtin_amdgcn_fence(__ATOMIC_RELEASE, "agent");
            asm volatile("s_waitcnt vmcnt(0)" ::: "memory");
            const unsigned og = xb_add(&bar[XB_TOP], 1u);
            const unsigned tg = og / nx;
            if (og + 1u == (tg + 1u) * nx) xb_add(&bar[XB_TOPGEN], 1u);
            else XB_SPIN(xb_ld(&bar[XB_TOPGEN]) == tg, bar);
            __builtin_amdgcn_fence(__ATOMIC_ACQUIRE, "agent");
            xb_add(&bar[XB_XGEN(b.x)], 1u);
            asm volatile("s_waitcnt vmcnt(0)" ::: "memory");
        } else {
            XB_SPIN(xb_ld(&bar[XB_XGEN(b.x)]) == gen, bar);
            __builtin_amdgcn_fence(__ATOMIC_ACQUIRE, "agent");
            asm volatile("s_waitcnt vmcnt(0)" ::: "memory");
        }
    }
    __syncthreads();
}

namespace pg8 {
constexpr int BM = 256, BK = 64, HALF = 128, HTB = HALF * BK * 2, STAGE_BYTES = 8 * HTB, NXCD = 8, WGM = 8;
__host__ __device__ __forceinline__ int lds_byte(int r, int c) { const int st = (r >> 4) * 2 + (c >> 5), rr = r & 15, cc = c & 31, ob = rr * 64 + cc * 2; return st * 1024 + (ob ^ (((ob >> 9) & 1) << 5)); }
__host__ __device__ __forceinline__ void stage_rc(int b, int& R, int& C) { const int st = b / 1024, sb = b % 1024, swz = sb ^ (((sb >> 9) & 1) << 5); R = (st >> 1) * 16 + swz / 64; C = (st & 1) * 32 + (swz % 64) / 2; }
__host__ __device__ __forceinline__ int perm32(int rho) { const int n = rho >> 4, i = rho & 15; return 8 * (i >> 2) + 4 * n + (i & 3); }

struct Unit { int pm, pn, e, t, cnt; };
struct Gemm { const bf16_t* A; const bf16_t* Bt; int lda, ldb, K; };

struct StaticOrder {
    static constexpr bool GATHER_A = false;
    int nM, nN, nwg, G, c;
    __device__ void init(int M, int N, int G_, int c_) { nM = M / BM; nN = N / BM; nwg = nM * nN; G = G_; c = c_; }
    __device__ __forceinline__ bool next(int i, Unit& u) const {
        const long L = (long)i * G + c; if (L >= nwg) return false;
        int wgid = (int)L; { const int q = nwg / NXCD, r = nwg % NXCD, xcd = wgid % NXCD, off = wgid / NXCD; wgid = (xcd < r ? xcd * (q + 1) : r * (q + 1) + (xcd - r) * q) + off; }
        const int nig = WGM * nN, gid = wgid / nig, fm = gid * WGM, gsz = (nM - fm) < WGM ? (nM - fm) : WGM;
        u.pm = fm + ((wgid % nig) % gsz); u.pn = (wgid % nig) / gsz; u.e = 0; u.t = 0; u.cnt = 0; return true;
    }
    __device__ __forceinline__ int rowA(const Unit& u, int r) const { return u.pm * BM + r; }
    __device__ __forceinline__ int colA(const Unit&) const { return 0; }
    __device__ __forceinline__ int rowB(const Unit& u, int r) const { return u.pn * BM + r; }
};

template <class Epi, class Sched>
__device__ __forceinline__ void gemm_phase(LAS unsigned char* lds, const Gemm g, const Sched& S, const Epi& E) {
    const int tid = opaque_tid(), wid = __builtin_amdgcn_readfirstlane(tid >> 6), lane = tid & 63, wr = wid >> 2, wc = wid & 3, fr = lane & 15, fq = lane >> 4;
    const int K = g.K, nt = K / BK;
    constexpr bool GA = Sched::GATHER_A;
    int sR[2], sC[2];
    unsigned laneA[2], laneB[2];
#pragma unroll
    for (int i = 0; i < 2; ++i) { int R, C; stage_rc(tid * 16 + i * 8192, R, C); sR[i] = R; sC[i] = C; const int Rb = Epi::PERM ? ((R & ~31) + perm32(R & 31)) : R;
        laneA[i] = (unsigned)(R * g.lda + C) * 2u; laneB[i] = (unsigned)(Rb * g.ldb + C) * 2u; }
    const size_t hstepA = (size_t)HALF * g.lda * 2, hstepB = (size_t)HALF * g.ldb * 2;
    const unsigned ldsw = (unsigned)wid * 1024u;
    const int aoff = lds_byte(wr * 64 + fr, fq * 8), boff = lds_byte(wc * 32 + fr, fq * 8);
    const char* gA = (const char*)g.A; const char* gB = (const char*)g.Bt;
#define PG8_SA(b, h) (((b) * 2 + (h)) * HTB)
#define PG8_SB(b, h) ((4 + (b) * 2 + (h)) * HTB)
#define PG8_STAGE(bufoff, gptr, voff) do { _Pragma("unroll") for (int _i = 0; _i < 2; ++_i) \
        __builtin_amdgcn_global_load_lds((const unsigned*)((gptr) + (size_t)(voff)[_i]), (LAS unsigned*)(lds + (bufoff) + ldsw + _i * 8192), 16, 0, 0); } while (0)
#define PG8_STAGE_B(bufoff, ub, h, kb) PG8_STAGE(bufoff, gB + (ub) + (size_t)(h) * hstepB + (size_t)(kb), laneB)
#define PG8_STAGE_A(bufoff, ub, va, h, kb) do { if constexpr (GA) { PG8_STAGE(bufoff, gA + (size_t)(kb), va[h]); } else { PG8_STAGE(bufoff, gA + (ub) + (size_t)(h) * hstepA + (size_t)(kb), laneA); } } while (0)
#define PG8_LDA(dst, b, h) do { _Pragma("unroll") for (int m = 0; m < 4; ++m) _Pragma("unroll") for (int k = 0; k < 2; ++k) dst[m][k] = *(const LAS bf16x8*)(lds + PG8_SA(b, h) + aoff + m * 2048 + k * 1024); } while (0)
#define PG8_LDB(dst, b, h) do { _Pragma("unroll") for (int n = 0; n < 2; ++n) _Pragma("unroll") for (int k = 0; k < 2; ++k) dst[n][k] = *(const LAS bf16x8*)(lds + PG8_SB(b, h) + boff + n * 2048 + k * 1024); } while (0)
#define PG8_MMA(ai, bj, At, Bt) do { __builtin_amdgcn_s_setprio(1); _Pragma("unroll") for (int m = 0; m < 4; ++m) _Pragma("unroll") for (int n = 0; n < 2; ++n) _Pragma("unroll") for (int k = 0; k < 2; ++k) \
        acc[ai][bj][m][n] = __builtin_amdgcn_mfma_f32_16x16x32_bf16(Bt[n][k], At[m][k], acc[ai][bj][m][n], 0, 0, 0); __builtin_amdgcn_s_setprio(0); } while (0)
#define PG8_WAIT_V(n) asm volatile("s_waitcnt vmcnt(" #n ")" ::: "memory")
#define PG8_WAIT_L(n) asm volatile("s_waitcnt lgkmcnt(" #n ")" ::: "memory")
#define PG8_BAR __builtin_amdgcn_s_barrier()
#define PG8_SCHED __builtin_amdgcn_sched_barrier(0)
#define PG8_OFFS(u, ubA, ubB, vA) do { ubB = ((size_t)S.rowB(u, 0) * (size_t)g.ldb) * 2; \
        if constexpr (GA) { ubA = 0; _Pragma("unroll") for (int _h = 0; _h < 2; ++_h) _Pragma("unroll") for (int _i = 0; _i < 2; ++_i) vA[_h][_i] = ((unsigned)S.rowA(u, _h * HALF + sR[_i]) * (unsigned)g.lda + (unsigned)sC[_i]) * 2u; } \
        else { ubA = ((size_t)S.rowA(u, 0) * (size_t)g.lda + (size_t)S.colA(u)) * 2; } } while (0)
    Unit cur, nxt; int ui = 0;
    if (!S.next(0, cur)) return;
    f32x4 acc[2][2][4][2];
#pragma unroll
    for (int a = 0; a < 2; ++a)
#pragma unroll
        for (int b = 0; b < 2; ++b)
#pragma unroll
            for (int m = 0; m < 4; ++m)
#pragma unroll
                for (int n = 0; n < 2; ++n) acc[a][b][m][n] = (f32x4){0.f, 0.f, 0.f, 0.f};
    bf16x8 At[4][2], B0[2][2], B1[2][2];
    size_t ubAc, ubBc, ubAn, ubBn; unsigned vAc[2][2] = {}, vAn[2][2] = {};
    PG8_OFFS(cur, ubAc, ubBc, vAc);
    PG8_STAGE_B(PG8_SB(0, 0), ubBc, 0, 0); PG8_STAGE_B(PG8_SB(0, 1), ubBc, 1, 0); PG8_STAGE_A(PG8_SA(0, 0), ubAc, vAc, 0, 0); PG8_STAGE_A(PG8_SA(0, 1), ubAc, vAc, 1, 0);
    if (wr == 1) PG8_BAR;
    PG8_WAIT_V(2); PG8_BAR;
    PG8_STAGE_B(PG8_SB(1, 0), ubBc, 0, 128); PG8_STAGE_A(PG8_SA(1, 0), ubAc, vAc, 0, 128); PG8_STAGE_B(PG8_SB(1, 1), ubBc, 1, 128);
    PG8_WAIT_V(6); PG8_BAR;
    for (;;) {
        const bool has_next = S.next(ui + 1, nxt);
        if (has_next) { PG8_OFFS(nxt, ubAn, ubBn, vAn); }
        else { ubAn = ubAc; ubBn = ubBc;
#pragma unroll
            for (int h = 0; h < 2; ++h)
#pragma unroll
                for (int i = 0; i < 2; ++i) vAn[h][i] = vAc[h][i]; }
        for (int t = 0; t < nt; t += 2) {
            const bool last = (t == nt - 2);
            const unsigned k1 = (unsigned)(t + 1) * 128u, k2 = last ? 0u : (unsigned)(t + 2) * 128u, k3 = k2 + 128u;
            const size_t xubA = last ? ubAn : ubAc, xubB = last ? ubBn : ubBc;
            unsigned xA[2][2];
#pragma unroll
            for (int h = 0; h < 2; ++h)
#pragma unroll
                for (int i = 0; i < 2; ++i) xA[h][i] = last ? vAn[h][i] : vAc[h][i];
            PG8_LDB(B0, 0, 0); PG8_LDB(B1, 0, 1); PG8_SCHED; PG8_LDA(At, 0, 0); PG8_STAGE_A(PG8_SA(1, 1), ubAc, vAc, 1, k1);
            PG8_WAIT_V(8); PG8_WAIT_L(0); PG8_BAR; PG8_MMA(0, 0, At, B0); PG8_MMA(0, 1, At, B1); PG8_BAR; PG8_SCHED;
            PG8_LDA(At, 0, 1); PG8_STAGE_B(PG8_SB(0, 0), xubB, 0, k2); PG8_STAGE_B(PG8_SB(0, 1), xubB, 1, k2); PG8_STAGE_A(PG8_SA(0, 0), xubA, xA, 0, k2);
            PG8_WAIT_V(8); PG8_WAIT_L(0); PG8_BAR; PG8_MMA(1, 0, At, B0); PG8_MMA(1, 1, At, B1); PG8_BAR; PG8_SCHED;
            PG8_LDB(B0, 1, 0); PG8_LDB(B1, 1, 1); PG8_SCHED; PG8_LDA(At, 1, 0); PG8_STAGE_A(PG8_SA(0, 1), xubA, xA, 1, k2);
            PG8_WAIT_V(8); PG8_WAIT_L(0); PG8_BAR; PG8_MMA(0, 0, At, B0); PG8_MMA(0, 1, At, B1); PG8_BAR; PG8_SCHED;
            PG8_LDA(At, 1, 1); PG8_STAGE_B(PG8_SB(1, 0), xubB, 0, k3); PG8_STAGE_B(PG8_SB(1, 1), xubB, 1, k3); PG8_STAGE_A(PG8_SA(1, 0), xubA, xA, 0, k3);
            PG8_WAIT_V(8); PG8_WAIT_L(0); PG8_BAR; PG8_MMA(1, 0, At, B0); PG8_MMA(1, 1, At, B1); PG8_BAR; PG8_SCHED;
        }
        if (wr == 0) PG8_BAR;
        E(acc, cur, wr, wc, fr, fq);
        if (!has_next) break;
#pragma unroll
        for (int a = 0; a < 2; ++a)
#pragma unroll
            for (int b = 0; b < 2; ++b)
#pragma unroll
                for (int m = 0; m < 4; ++m)
#pragma unroll
                    for (int n = 0; n < 2; ++n) acc[a][b][m][n] = (f32x4){0.f, 0.f, 0.f, 0.f};
        cur = nxt; ++ui; ubAc = ubAn; ubBc = ubBn;
#pragma unroll
        for (int h = 0; h < 2; ++h)
#pragma unroll
            for (int i = 0; i < 2; ++i) vAc[h][i] = vAn[h][i];
        if (wr == 1) PG8_BAR;
    }
    PG8_WAIT_V(0);
    PG8_BAR;
#undef PG8_SA
#undef PG8_SB
#undef PG8_STAGE
#undef PG8_STAGE_A
#undef PG8_STAGE_B
#undef PG8_LDA
#undef PG8_LDB
#undef PG8_MMA
#undef PG8_WAIT_V
#undef PG8_WAIT_L
#undef PG8_BAR
#undef PG8_SCHED
#undef PG8_OFFS
}
}
namespace pg8 {
struct EpiBf16 {
    static constexpr bool PERM = true;
    bf16_t* O; int ldc; int split_cols; size_t split_stride; float scale0;
    __device__ __forceinline__ void operator()(const f32x4 (&acc)[2][2][4][2], const Unit& u, int wr, int wc, int fr, int fq) const {
        const int row0 = u.pm * BM + wr * 64 + fr; int colt = u.pn * BM; bf16_t* base = O;
        float sc = 1.f; if (split_cols) { const int t = colt / split_cols; base += (size_t)t * split_stride; colt -= t * split_cols; if (t == 0) sc = scale0; }
        const int col0 = colt + wc * 32 + 8 * fq;
#pragma unroll
        for (int ai = 0; ai < 2; ++ai)
#pragma unroll
            for (int m = 0; m < 4; ++m) { bf16_t* rowp = base + (size_t)(row0 + ai * HALF + m * 16) * ldc + col0;
#pragma unroll
                for (int bj = 0; bj < 2; ++bj) { const f32x4 v0 = acc[ai][bj][m][0] * sc, v1 = acc[ai][bj][m][1] * sc;
                    u32x4 w; w.x = cvt_pk_bf16(v0[0], v0[1]); w.y = cvt_pk_bf16(v0[2], v0[3]); w.z = cvt_pk_bf16(v1[0], v1[1]); w.w = cvt_pk_bf16(v1[2], v1[3]);
                    *(u32x4*)(rowp + bj * HALF) = w; } }
    }
};
struct EpiFilt {
    static constexpr bool PERM = false;
    float* O;
    __device__ __forceinline__ void operator()(const f32x4 (&acc)[2][2][4][2], const Unit& u, int wr, int wc, int fr, int fq) const {
        const float dmin = -3.0701134573253945f, dmax = -15.350567286626973f;
#pragma unroll
        for (int ai = 0; ai < 2; ++ai)
#pragma unroll
            for (int m = 0; m < 4; ++m) { const int row = u.pm * BM + ai * HALF + wr * 64 + m * 16 + fr; const int c = row & 1023;
                const float delta = fabsf(dmin + (float)c * ((dmax - dmin) / 1023.0f));
#pragma unroll
                for (int bj = 0; bj < 2; ++bj)
#pragma unroll
                    for (int n = 0; n < 2; ++n) { const int col = u.pn * BM + bj * HALF + wc * 32 + n * 16 + 4 * fq; f32x4 v = acc[ai][bj][m][n];
#pragma unroll
                        for (int j = 0; j < 4; ++j) v[j] *= __expf(-(float)(col + j) * (1.0f / 8191.0f) * delta);
                        *(f32x4*)(O + (size_t)row * 8192 + col) = v; }
                asm volatile("" ::: "memory"); }
    }
};
struct EpiResF32 {
    static constexpr bool PERM = false;
    const float* res; float* O; int ldc; float alpha;
    __device__ __forceinline__ void operator()(const f32x4 (&acc)[2][2][4][2], const Unit& u, int wr, int wc, int fr, int fq) const {
#pragma unroll
        for (int ai = 0; ai < 2; ++ai)
#pragma unroll
            for (int m = 0; m < 4; ++m) { const size_t off = (size_t)(u.pm * BM + ai * HALF + wr * 64 + m * 16 + fr) * ldc + u.pn * BM + wc * 32 + 4 * fq;
#pragma unroll
                for (int bj = 0; bj < 2; ++bj)
#pragma unroll
                    for (int n = 0; n < 2; ++n) { const f32x4 r = *(const f32x4*)(res + off + bj * HALF + n * 16); *(f32x4*)(O + off + bj * HALF + n * 16) = r * alpha + acc[ai][bj][m][n]; }
                if (m & 1) asm volatile("" ::: "memory"); }
    }
};
struct EpiSwiglu {
    static constexpr bool PERM = true;
    bf16_t* O;
    __device__ __forceinline__ void operator()(const f32x4 (&acc)[2][2][4][2], const Unit& u, int wr, int wc, int fr, int fq) const {
#pragma unroll
        for (int ai = 0; ai < 2; ++ai)
#pragma unroll
            for (int m = 0; m < 4; ++m) { bf16_t* p = O + (size_t)(u.pm * BM + ai * HALF + wr * 64 + m * 16 + fr) * DFF + u.pn * HALF + wc * 32 + 8 * fq;
                float h[8];
#pragma unroll
                for (int n = 0; n < 2; ++n)
#pragma unroll
                    for (int j = 0; j < 4; ++j) { const float gt = acc[ai][0][m][n][j], up = acc[ai][1][m][n][j]; h[n * 4 + j] = gt * sigmoidf_(gt) * up; }
                u32x4 w; w.x = cvt_pk_bf16(h[0], h[1]); w.y = cvt_pk_bf16(h[2], h[3]); w.z = cvt_pk_bf16(h[4], h[5]); w.w = cvt_pk_bf16(h[6], h[7]);
                *(u32x4*)p = w; }
    }
};
struct EpiDown {
    static constexpr bool PERM = true;
    bf16_t* O; const int* rowlist; const float* gatew;
    __device__ __forceinline__ void operator()(const f32x4 (&acc)[2][2][4][2], const Unit& u, int wr, int wc, int fr, int fq) const {
#pragma unroll
        for (int ai = 0; ai < 2; ++ai)
#pragma unroll
            for (int m = 0; m < 4; ++m) { const int idx = u.t * BM + ai * HALF + wr * 64 + m * 16 + fr;
                if (idx < u.cnt) { const int a = rowlist[(size_t)u.e * ECAP + idx]; const float gw = gatew[a];
                    bf16_t* p = O + (size_t)a * DM + u.pn * BM + wc * 32 + 8 * fq;
#pragma unroll
                    for (int bj = 0; bj < 2; ++bj) { const f32x4 v0 = acc[ai][bj][m][0] * gw, v1 = acc[ai][bj][m][1] * gw;
                        u32x4 w; w.x = cvt_pk_bf16(v0[0], v0[1]); w.y = cvt_pk_bf16(v0[2], v0[3]); w.z = cvt_pk_bf16(v1[0], v1[1]); w.w = cvt_pk_bf16(v1[2], v1[3]);
                        *(u32x4*)(p + bj * HALF) = w; } } }
    }
};
struct EpiRG {
    static constexpr bool PERM = true;
    bf16_t* LA; bf16_t* BB; const bf16_t* XC; const float* ba; const float* bx; const float* lam;
    __device__ __forceinline__ void operator()(const f32x4 (&acc)[2][2][4][2], const Unit& u, int wr, int wc, int fr, int fq) const {
        const int nb = u.pn >> 2, q = u.pn & 3, dir = q >> 1, half = q & 1;
        const int ch0 = nb * 256 + half * HALF + wc * 32 + 8 * fq;
        float vba[8], vbx[8], vsp[8];
#pragma unroll
        for (int j = 0; j < 8; ++j) { vba[j] = ba[dir * DM + ch0 + j]; vbx[j] = bx[dir * DM + ch0 + j];
            const float x = __expf(-lam[dir * DM + ch0 + j]);
            vsp[j] = 8.0f * (x < 0.05f ? x * (1.0f - x * (0.5f - x * (0.33333334f - 0.25f * x))) : __logf(1.0f + x)); }
#pragma unroll
        for (int ai = 0; ai < 2; ++ai)
#pragma unroll
            for (int m = 0; m < 4; ++m) { const size_t tok = (size_t)(u.pm * BM + ai * HALF + wr * 64 + m * 16 + fr);
                asm volatile("" ::: "memory");
                const u32x4 xw = *(const u32x4*)(XC + tok * DM + ch0);
                float xf[8] = {bflo(xw.x), bfhi(xw.x), bflo(xw.y), bfhi(xw.y), bflo(xw.z), bfhi(xw.z), bflo(xw.w), bfhi(xw.w)};
                float la[8], bb[8];
#pragma unroll
                for (int n = 0; n < 2; ++n)
#pragma unroll
                    for (int j = 0; j < 4; ++j) { const int k = n * 4 + j;
                        const float r = sigmoidf_(acc[ai][0][m][n][j] + vba[k]), ig = sigmoidf_(acc[ai][1][m][n][j] + vbx[k]);
                        const float l = -r * vsp[k]; la[k] = l; bb[k] = sqrtf(fmaxf(1.0f - __expf(2.0f * l), 0.f)) * (ig * xf[k]); }
                u32x4 w; w.x = cvt_pk_bf16(la[0], la[1]); w.y = cvt_pk_bf16(la[2], la[3]); w.z = cvt_pk_bf16(la[4], la[5]); w.w = cvt_pk_bf16(la[6], la[7]);
                *(u32x4*)(LA + ((size_t)dir * NTOK + tok) * DM + ch0) = w;
                w.x = cvt_pk_bf16(bb[0], bb[1]); w.y = cvt_pk_bf16(bb[2], bb[3]); w.z = cvt_pk_bf16(bb[4], bb[5]); w.w = cvt_pk_bf16(bb[6], bb[7]);
                *(u32x4*)(BB + ((size_t)dir * NTOK + tok) * DM + ch0) = w; }
    }
};

struct RGOrder {
    static constexpr bool GATHER_A = false;
    int G, c;
    __device__ __forceinline__ bool next(int i, Unit& u) const { const int L = i * G + c; if (L >= 64 * 32) return false; u.pm = L >> 5; u.pn = L & 31; u.e = 0; u.t = 0; u.cnt = 0; return true; }
    __device__ __forceinline__ int rowA(const Unit& u, int r) const { return u.pm * BM + r; }
    __device__ __forceinline__ int colA(const Unit& u) const { return (u.pn >> 2) * 256; }
    __device__ __forceinline__ int rowB(const Unit& u, int r) const { return u.pn * BM + r; }
};
template <int NPN, bool GATHER>
struct MoeOrder {
    static constexpr bool GATHER_A = GATHER;
    int G, c; const LAS int* tab; const int* rowlist;
    __device__ __forceinline__ bool next(int i, Unit& u) const {
        const int L = i * G + c, ntile = tab[32]; if (L >= ntile * NPN) return false;
        const int tile = L / NPN; u.pm = tile; u.pn = L % NPN; int e = 0;
        while (e < 31 && tab[e + 1] <= tile) ++e;
        u.e = e; u.t = tile - tab[e]; u.cnt = tab[64 + e]; return true;
    }
    __device__ __forceinline__ int rowA(const Unit& u, int r) const {
        if (GATHER) { const int idx = u.t * BM + r; const int a = idx < u.cnt ? rowlist[(size_t)u.e * ECAP + idx] : 0; return a >> 1; }
        return u.pm * BM + r;
    }
    __device__ __forceinline__ int colA(const Unit&) const { return 0; }
    __device__ __forceinline__ int rowB(const Unit& u, int r) const { return (u.e * NPN + u.pn) * BM + r; }
};
}
namespace att {
constexpr int NW = 8, QBLK = 32, KVBLK = 64, LDQ = 1024, LDK = 1024, LDV = 1024, LDO = 1024;
constexpr int SHM_V = KVBLK * 128 * 2, SHM_K = KVBLK * 64 * 2, SHM_ATTN = 2 * SHM_V + 2 * SHM_K + NW * 64 * 4;
constexpr float THR2 = 8.0f * 1.4426950408889634f;
#define KSWZ64(row, colB) ((row) * 128 + ((colB) ^ ((((row) >> 1) & 7) << 4)))
#define SBAR() __builtin_amdgcn_sched_barrier(0)
__device__ __forceinline__ int crow(int r, int hi) { return (r & 3) + 8 * (r >> 2) + 4 * hi; }
__device__ __forceinline__ void partialSM(f32x16& p0, f32x16& p1, float& m_reg, float& mn, float& alpha, float fd, float sl2) {
#pragma unroll
    for (int r = 0; r < 16; ++r) { const float d0 = fd - (float)((r & 3) + 8 * (r >> 2)); p0[r] = fmaf(fabsf(d0), -sl2, p0[r]); p1[r] = fmaf(fabsf(d0 - 32.0f), -sl2, p1[r]); }
    float pmax = p0[0];
#pragma unroll
    for (int r = 1; r < 16; ++r) pmax = fmaxf(pmax, p0[r]);
#pragma unroll
    for (int r = 0; r < 16; ++r) pmax = fmaxf(pmax, p1[r]);
    { auto rr = __builtin_amdgcn_permlane32_swap(__float_as_uint(pmax), __float_as_uint(pmax), false, false); pmax = fmaxf(__uint_as_float(rr[0]), __uint_as_float(rr[1])); }
    if (__builtin_expect(__all(pmax - m_reg <= THR2), 1)) { mn = m_reg; alpha = 1.f; }
    else { mn = fmaxf(m_reg, pmax); alpha = __builtin_amdgcn_exp2f(m_reg - mn); m_reg = mn; }
#pragma unroll
    for (int r = 0; r < 16; ++r) { p0[r] -= mn; p1[r] -= mn; }
#pragma unroll
    for (int r = 0; r < 16; ++r) p0[r] = __builtin_amdgcn_exp2f(p0[r]);
}
__device__ __forceinline__ void finishSM(f32x16& p0, f32x16& p1, float alpha, float& l_reg, bf16x8& pa0, bf16x8& pa1, bf16x8& pa2, bf16x8& pa3) {
#pragma unroll
    for (int r = 0; r < 16; ++r) p1[r] = __builtin_amdgcn_exp2f(p1[r]);
    float ps = 0;
#pragma unroll
    for (int r = 0; r < 16; ++r) ps += p0[r];
#pragma unroll
    for (int r = 0; r < 16; ++r) ps += p1[r];
    { auto rr = __builtin_amdgcn_permlane32_swap(__float_as_uint(ps), __float_as_uint(ps), false, false); ps = __uint_as_float(rr[0]) + __uint_as_float(rr[1]); }
    l_reg = l_reg * alpha + ps;
#define PK4(P, BASE, OUT) do { unsigned a0 = cvt_pk_bf16(P[BASE + 0], P[BASE + 1]), a1 = cvt_pk_bf16(P[BASE + 2], P[BASE + 3]);   \
    unsigned b0 = cvt_pk_bf16(P[BASE + 4], P[BASE + 5]), b1 = cvt_pk_bf16(P[BASE + 6], P[BASE + 7]);                              \
    auto r0 = __builtin_amdgcn_permlane32_swap(a0, b0, false, false); auto r1 = __builtin_amdgcn_permlane32_swap(a1, b1, false, false); \
    u32x4 w = {r0[0], r1[0], r0[1], r1[1]}; OUT = __builtin_bit_cast(bf16x8, w); } while (0)
    PK4(p0, 0, pa0); PK4(p0, 8, pa1); PK4(p1, 0, pa2); PK4(p1, 8, pa3);
#undef PK4
}
__device__ __forceinline__ void qkt(f32x16& p0, f32x16& p1, const char* Ks, const bf16x8* qr, int r32, int hi) {
    p0 = f32x16{}; p1 = f32x16{};
#pragma unroll
    for (int d0 = 0; d0 < 4; ++d0) { const int cb = (d0 * 16 + hi * 8) * 2;
        const bf16x8 b0 = *reinterpret_cast<const bf16x8*>(Ks + KSWZ64(r32, cb));
        const bf16x8 b1 = *reinterpret_cast<const bf16x8*>(Ks + KSWZ64(32 + r32, cb));
        p0 = __builtin_amdgcn_mfma_f32_32x32x16_bf16(b0, qr[d0], p0, 0, 0, 0);
        p1 = __builtin_amdgcn_mfma_f32_32x32x16_bf16(b1, qr[d0], p1, 0, 0, 0); }
}
__device__ __forceinline__ int v_st(int k, int c) { const int kk = (k & ~0xC) | ((k & 4) << 1) | ((k & 8) >> 1); return ((kk >> 3) * 4 + (c >> 5)) * 512 + ((kk & 7) * 32 + (c & 31)) * 2; }
__device__ __forceinline__ int v_rd_base(int lane) { return ((lane & 3) << 3) | (((lane >> 2) & 3) << 6) | (((lane >> 4) & 1) << 5) | (((lane >> 5) & 1) << 8); }
constexpr int v_rd_off(int d0, int ks, int half) { return d0 * 512 + ks * 4096 + half * 2048; }
template <int OFF> __device__ __forceinline__ s16x4 tr_read(int vb) {
    s16x4 r; asm volatile("ds_read_b64_tr_b16 %0, %1 offset:%2" : "=&v"(r) : "v"(vb), "i"(OFF) : "memory"); return r;
}
template <int D0> __device__ __forceinline__ void pv_one(f32x16& od, int vb, bf16x8 pa0, bf16x8 pa1, bf16x8 pa2, bf16x8 pa3) {
    const s16x4 l0 = tr_read<v_rd_off(D0, 0, 0)>(vb), h0 = tr_read<v_rd_off(D0, 0, 1)>(vb), l1 = tr_read<v_rd_off(D0, 1, 0)>(vb), h1 = tr_read<v_rd_off(D0, 1, 1)>(vb);
    const s16x4 l2 = tr_read<v_rd_off(D0, 2, 0)>(vb), h2 = tr_read<v_rd_off(D0, 2, 1)>(vb), l3 = tr_read<v_rd_off(D0, 3, 0)>(vb), h3 = tr_read<v_rd_off(D0, 3, 1)>(vb);
    asm volatile("s_waitcnt lgkmcnt(0)" ::: "memory"); SBAR();
#define PK(L, H) (bf16x8){L[0], L[1], L[2], L[3], H[0], H[1], H[2], H[3]}
    od = __builtin_amdgcn_mfma_f32_32x32x16_bf16(pa0, PK(l0, h0), od, 0, 0, 0);
    od = __builtin_amdgcn_mfma_f32_32x32x16_bf16(pa1, PK(l1, h1), od, 0, 0, 0);
    od = __builtin_amdgcn_mfma_f32_32x32x16_bf16(pa2, PK(l2, h2), od, 0, 0, 0);
    od = __builtin_amdgcn_mfma_f32_32x32x16_bf16(pa3, PK(l3, h3), od, 0, 0, 0);
#undef PK
}
__device__ __forceinline__ void pv_d0(f32x16* o, int vb, bf16x8 pa0, bf16x8 pa1, bf16x8 pa2, bf16x8 pa3) {
    pv_one<0>(o[0], vb, pa0, pa1, pa2, pa3); pv_one<1>(o[1], vb, pa0, pa1, pa2, pa3); pv_one<2>(o[2], vb, pa0, pa1, pa2, pa3); pv_one<3>(o[3], vb, pa0, pa1, pa2, pa3);
}
__device__ __forceinline__ void attn_unit(const bf16_t* __restrict__ Qb, const bf16_t* __restrict__ Kh, const bf16_t* __restrict__ Vh, bf16_t* __restrict__ Ob, int q0, int seq, float sl2, char* lds) {
    const int tid = opaque_tid(), wid = tid >> 6, lane = tid & 63, r32 = lane & 31, hi = lane >> 5;
    char* V_lds = lds; char* K_lds = lds + 2 * SHM_V;
    float* ws = (float*)(lds + 2 * SHM_V + 2 * SHM_K) + wid * 64; float* li_l = ws; float* al_l = ws + 32;
    float m_reg = -1e30f, l_reg = 0; f32x16 o[4] = {}; bf16x8 qr[4];
    const bf16_t* Qw = Qb + (long)(wid * QBLK + r32) * LDQ + hi * 8;
#pragma unroll
    for (int d0 = 0; d0 < 4; ++d0) qr[d0] = *reinterpret_cast<const bf16x8*>(Qw + d0 * 16);
    const int sr = tid >> 4, sc = (tid & 15) * 8, vst0 = v_st(sr, sc), vst1 = v_st(32 + sr, sc);
    const int kr = tid >> 3, kc = (tid & 7) * 8, kst = KSWZ64(kr, kc * 2);
    const int vb0 = (int)(uintptr_t)V_lds + v_rd_base(lane);
    const float fq0 = (float)(q0 + wid * QBLK + r32 - 4 * hi);
    struct { bf16x8 vs0, vs1, ks; } sr_[2];
#define SLOAD(i, k0) do { sr_[i].vs0 = *reinterpret_cast<const bf16x8*>(&Vh[(long)((k0) + sr) * LDV + sc]); sr_[i].vs1 = *reinterpret_cast<const bf16x8*>(&Vh[(long)((k0) + 32 + sr) * LDV + sc]); \
    sr_[i].ks = *reinterpret_cast<const bf16x8*>(&Kh[(long)((k0) + kr) * LDK + kc]); } while (0)
#define SWRITE(b, i) do { *(bf16x8*)(V_lds + (b) * SHM_V + vst0) = sr_[i].vs0; *(bf16x8*)(V_lds + (b) * SHM_V + vst1) = sr_[i].vs1; \
    *(bf16x8*)(K_lds + (b) * SHM_K + kst) = sr_[i].ks; } while (0)
#define SWAIT() asm volatile("s_waitcnt vmcnt(3)" ::: "memory")
#define RESC(a) do { if (__any((a) < 1.f)) { if (hi == 0) al_l[r32] = (a); asm volatile("s_waitcnt lgkmcnt(0)" ::: "memory"); \
    _Pragma("unroll") for (int d = 0; d < 4; ++d) _Pragma("unroll") for (int r = 0; r < 16; ++r) o[d][r] *= al_l[crow(r, hi)]; } } while (0)
    f32x16 pA0, pA1, pB0, pB1; float mnA, mnB, alA, alB; bf16x8 pa0, pa1, pa2, pa3; const int NT = seq / KVBLK;
    constexpr int SE = 0, SO = 1;
    SLOAD(SE, 0); asm volatile("s_waitcnt vmcnt(0)" ::: "memory"); SWRITE(0, SE); __syncthreads();
    qkt(pA0, pA1, K_lds, qr, r32, hi); partialSM(pA0, pA1, m_reg, mnA, alA, fq0, sl2);
    SLOAD(SO, KVBLK); if (2 < NT) SLOAD(SE, 2 * KVBLK);
    SWAIT(); SWRITE(1, SO); __syncthreads();
    for (int j = 1; j + 1 < NT; j += 2) {
        SBAR(); qkt(pB0, pB1, K_lds + SHM_K, qr, r32, hi);
        finishSM(pA0, pA1, alA, l_reg, pa0, pa1, pa2, pa3); SBAR();
        SLOAD(SO, (j + 2) * KVBLK); SBAR();
        pv_d0(o, vb0, pa0, pa1, pa2, pa3); partialSM(pB0, pB1, m_reg, mnB, alB, fq0 - (float)(j * KVBLK), sl2);
        __syncthreads(); SWAIT(); SWRITE(0, SE);
        RESC(alB); __syncthreads();
        SBAR(); qkt(pA0, pA1, K_lds, qr, r32, hi);
        finishSM(pB0, pB1, alB, l_reg, pa0, pa1, pa2, pa3); SBAR();
        if (j + 3 < NT) SLOAD(SE, (j + 3) * KVBLK); SBAR();
        pv_d0(o, vb0 + SHM_V, pa0, pa1, pa2, pa3); partialSM(pA0, pA1, m_reg, mnA, alA, fq0 - (float)((j + 1) * KVBLK), sl2);
        __syncthreads(); SWAIT(); SWRITE(1, SO);
        RESC(alA); __syncthreads();
    }
    SBAR(); qkt(pB0, pB1, K_lds + SHM_K, qr, r32, hi);
    finishSM(pA0, pA1, alA, l_reg, pa0, pa1, pa2, pa3); SBAR();
    pv_d0(o, vb0, pa0, pa1, pa2, pa3); partialSM(pB0, pB1, m_reg, mnB, alB, fq0 - (float)((NT - 1) * KVBLK), sl2);
    __syncthreads(); RESC(alB);
    finishSM(pB0, pB1, alB, l_reg, pa0, pa1, pa2, pa3); SBAR();
    pv_d0(o, vb0 + SHM_V, pa0, pa1, pa2, pa3);
    if (hi == 0) li_l[r32] = l_reg; asm volatile("s_waitcnt lgkmcnt(0)" ::: "memory");
    float rli[16];
#pragma unroll
    for (int r = 0; r < 16; ++r) rli[r] = __builtin_amdgcn_rcpf(li_l[crow(r, hi)]);
    bf16_t* Ow = Ob + (long)(wid * QBLK) * LDO;
#pragma unroll
    for (int r = 0; r < 16; ++r) { const int orow = crow(r, hi);
#pragma unroll
        for (int d0 = 0; d0 < 4; ++d0) Ow[(long)orow * LDO + d0 * 32 + r32] = (bf16_t)f2bf(o[d0][r] * rli[r]); }
    __syncthreads();
#undef SLOAD
#undef SWRITE
#undef SWAIT
#undef RESC
}
#undef SBAR
}

namespace hy {
struct cf { float x, y; };
__device__ __forceinline__ cf lld(const LAS f32x2* L, int i) { const f32x2 t = L[i]; return cf{t[0], t[1]}; }
__device__ __forceinline__ void lst(LAS f32x2* L, int i, cf v) { L[i] = (f32x2){v.x, v.y}; }
__device__ __forceinline__ cf cmul(cf a, cf b) { return cf{a.x * b.x - a.y * b.y, a.x * b.y + a.y * b.x}; }
__device__ __forceinline__ cf cmulc(cf a, cf b) { return cf{a.x * b.x + a.y * b.y, a.y * b.x - a.x * b.y}; }
__device__ constexpr float C32[16] = {1.0f, 0.98078528040323043f, 0.92387953251128674f, 0.83146961230254524f, 0.70710678118654757f, 0.55557023301960229f, 0.38268343236508984f, 0.19509032201612833f,
                                      0.0f, -0.19509032201612819f, -0.38268343236508973f, -0.55557023301960196f, -0.70710678118654746f, -0.83146961230254535f, -0.92387953251128674f, -0.98078528040323043f};
__device__ constexpr float S32[16] = {0.0f, 0.19509032201612825f, 0.38268343236508978f, 0.55557023301960218f, 0.70710678118654746f, 0.83146961230254524f, 0.92387953251128674f, 0.98078528040323043f,
                                      1.0f, 0.98078528040323043f, 0.92387953251128674f, 0.83146961230254546f, 0.70710678118654757f, 0.55557023301960218f, 0.38268343236508989f, 0.19509032201612861f};
__host__ __device__ constexpr int brev(int k, int bits) { int r = 0; for (int i = 0; i < bits; ++i) r |= ((k >> i) & 1) << (bits - 1 - i); return r; }
template <int R, bool INV> __device__ __forceinline__ void dft_reg(cf (&v)[R]) {
#pragma unroll
    for (int s = R / 2; s >= 1; s >>= 1) {
#pragma unroll
        for (int g0 = 0; g0 < R; g0 += 2 * s) {
#pragma unroll
            for (int j = 0; j < s; ++j) {
                const cf a = v[g0 + j], b = v[g0 + j + s];
                v[g0 + j] = cf{a.x + b.x, a.y + b.y};
                const cf d = cf{a.x - b.x, a.y - b.y};
                const int tw = j * (16 / s);
                if (tw == 0) v[g0 + j + s] = d;
                else if (tw == 8) v[g0 + j + s] = INV ? cf{-d.y, d.x} : cf{d.y, -d.x};
                else { const float c = C32[tw], sn = S32[tw]; v[g0 + j + s] = INV ? cf{d.x * c - d.y * sn, d.y * c + d.x * sn} : cf{d.x * c + d.y * sn, d.y * c - d.x * sn}; }
            }
        }
    }
}
constexpr int RS = FFT_RS;
__device__ __forceinline__ void fft_fwd12(cf (&v)[32], LAS f32x2* L, int tid) {
    dft_reg<32, false>(v);
    { float s, c; sincospif((float)tid * (1.0f / 8192.0f), &s, &c); cf w1{c, -s}; asm volatile("" : "+v"(w1.x), "+v"(w1.y)); cf w = w1;
#pragma unroll
      for (int k1 = 0; k1 < 32; ++k1) { cf x = v[brev(k1, 5)]; if (k1) { x = cmul(x, w); w = cmul(w, w1); } lst(L, k1 * RS + tid, x); } }
    __syncthreads();
    const int k1 = tid >> 4, m2 = tid & 15;
#pragma unroll
    for (int m1 = 0; m1 < 32; ++m1) v[m1] = lld(L, k1 * RS + 16 * m1 + m2);
    __syncthreads();
    dft_reg<32, false>(v);
    { float s, c; sincospif((float)m2 * (1.0f / 256.0f), &s, &c); cf w1{c, -s}; asm volatile("" : "+v"(w1.x), "+v"(w1.y)); cf w = w1;
#pragma unroll
      for (int j1 = 0; j1 < 32; ++j1) { cf x = v[brev(j1, 5)]; if (j1) { x = cmul(x, w); w = cmul(w, w1); } lst(L, k1 * RS + 33 * m2 + j1, x); } }
    __syncthreads();
}
__device__ __forceinline__ void fft_inv21(cf (&v)[32], LAS f32x2* L, int tid) {
    const int k1 = tid >> 4, m2 = tid & 15;
    { float s, c; sincospif((float)m2 * (1.0f / 256.0f), &s, &c); cf w1{c, -s}; asm volatile("" : "+v"(w1.x), "+v"(w1.y)); cf w = w1;
#pragma unroll
      for (int j1 = 0; j1 < 32; ++j1) { cf x = lld(L, k1 * RS + 33 * m2 + j1); if (j1) { x = cmulc(x, w); w = cmul(w, w1); } v[j1] = x; } }
    __syncthreads();
    dft_reg<32, true>(v);
#pragma unroll
    for (int m1 = 0; m1 < 32; ++m1) lst(L, k1 * RS + 16 * m1 + m2, v[brev(m1, 5)]);
    __syncthreads();
    { float s, c; sincospif((float)tid * (1.0f / 8192.0f), &s, &c); cf w1{c, -s}; asm volatile("" : "+v"(w1.x), "+v"(w1.y)); cf w = w1;
#pragma unroll
      for (int kk = 0; kk < 32; ++kk) { cf x = lld(L, kk * RS + tid); if (kk) { x = cmulc(x, w); w = cmul(w, w1); } v[kk] = x; } }
    dft_reg<32, true>(v);
}
}
constexpr size_t MiB = 1u << 20;
constexpr size_t WS_CTL = 0, CTL_ZERO_BYTES = 1 * MiB;
constexpr size_t WS_W1T = 1 * MiB;
constexpr size_t WS_W2T = 257 * MiB;
constexpr size_t WS_WIN_EV = 385 * MiB, WS_WOUT_EV = 409 * MiB, WS_WIN_OD = 417 * MiB, WS_WOUT_OD = 433 * MiB, WS_WG_OD = 441 * MiB;
constexpr size_t AR = 445 * MiB;
constexpr size_t A_XB = AR + 0 * MiB, A_UHT = AR + 64 * MiB, A_QB = AR + 160 * MiB, A_KB = AR + 192 * MiB, A_VB = AR + 224 * MiB, A_KTD = AR + 256 * MiB, A_KF = AR + 384 * MiB,
                 A_H3B = AR + 512 * MiB, A_W4T = AR + 514 * MiB, A_YHT = AR + 256 * MiB, A_OA = AR + 288 * MiB, A_YCAT = AR + 0 * MiB, A_R0 = AR + 64 * MiB, A_H1_0 = AR + 192 * MiB,
                 A_HB_0 = AR + 320 * MiB, A_HID_0 = AR + 384 * MiB, A_ROWL = AR + 424 * MiB, A_GATEW = AR + 428 * MiB, A_Y2_0 = AR + 0 * MiB, A_H2 = AR + 448 * MiB, A_HB2 = AR + 128 * MiB;
constexpr size_t A_GB = AR + 0 * MiB, A_XR = AR + 64 * MiB, A_XC = AR + 192 * MiB, A_LA = AR + 256 * MiB, A_BB = AR + 64 * MiB, A_CAR = AR + 384 * MiB, A_YG = AR + 192 * MiB, A_R1 = AR + 256 * MiB,
                 A_H1_1 = AR + 0 * MiB, A_HB_1 = AR + 128 * MiB, A_HID_1 = AR + 192 * MiB, A_Y2_1 = AR + 256 * MiB;
constexpr size_t WS_END = AR + 576 * MiB;
constexpr int CW_BAR = 4096, CW_CNT = 16384;
constexpr int LDS_MISC = 139264, LDS_BYTES = 147456;
constexpr int NPHASE = 21;

struct Args { const float* in[37]; float* out; unsigned char* ws; int ph_lo, ph_hi; };
typedef const __attribute__((address_space(4))) Args& KArgs;

__device__ __forceinline__ void transpose_item(const float* W, int N, int k0, int n0, bf16_t* WT, int ldk, int drow0, LAS float* scr, int lane) {
#pragma unroll 8
    for (int i = 0; i < 32; ++i) { const int kk = 2 * i + (lane >> 5); scr[kk * 33 + (lane & 31)] = W[(size_t)(k0 + kk) * N + n0 + (lane & 31)]; }
    LDS_WAIT(); asm volatile("" ::: "memory");
    const int c = lane & 7;
#pragma unroll
    for (int j = 0; j < 4; ++j) { const int n = (lane >> 3) + 8 * j; const LAS float* s = scr + (8 * c) * 33 + n;
        u32x4 o; o.x = pk2(s[0 * 33], s[1 * 33]); o.y = pk2(s[2 * 33], s[3 * 33]); o.z = pk2(s[4 * 33], s[5 * 33]); o.w = pk2(s[6 * 33], s[7 * 33]);
        *(u32x4*)(WT + (size_t)(drow0 + n) * ldk + k0 + 8 * c) = o; }
    LDS_WAIT(); asm volatile("" ::: "memory");
}

__device__ __forceinline__ void phase_prologue(KArgs a, LAS unsigned char* lds) {
    const int tid = opaque_tid(), lane = tid & 63, wave = tid >> 6, G = gridDim.x;
    const int gw = blockIdx.x * 8 + wave, NGW = G * 8;
    unsigned char* ws = a.ws;
    LAS float* scr = (LAS float*)(lds + wave * 16384);
    constexpr int I_EVIN = 32 * 192, I_SQ = 32 * 64, I_ODIN = 32 * 128, I_MOE_GU = 64 * 512, I_MOE_D = 64 * 512, I_RG = 16 * 32, I_W4 = 128;
    constexpr int O1 = I_EVIN, O2 = O1 + I_SQ, O3 = O2 + I_ODIN, O4 = O3 + I_SQ, O5 = O4 + I_MOE_GU, O6 = O5 + I_MOE_GU, O7 = O6 + I_MOE_D, O8 = O7 + I_RG, O9 = O8 + I_RG, O10 = O9 + I_W4;
    for (int it = gw; it < O10; it += NGW) {
        if (it < O1) { const int kb = it / 192, nb = it % 192; transpose_item(a.in[1], EV_IN, kb * 64, nb * 32, (bf16_t*)(ws + WS_WIN_EV), DM, nb * 32, scr, lane); }
        else if (it < O2) { const int r = it - O1, kb = r / 64, nb = r % 64; transpose_item(a.in[18], DM, kb * 64, nb * 32, (bf16_t*)(ws + WS_WOUT_EV), DM, nb * 32, scr, lane); }
        else if (it < O3) { const int r = it - O2, kb = r / 128, nb = r % 128; transpose_item(a.in[19], 2 * DM, kb * 64, nb * 32, (bf16_t*)(ws + WS_WIN_OD), DM, nb * 32, scr, lane); }
        else if (it < O4) { const int r = it - O3, kb = r / 64, nb = r % 64; transpose_item(a.in[27], DM, kb * 64, nb * 32, (bf16_t*)(ws + WS_WOUT_OD), DM, nb * 32, scr, lane); }
        else if (it < O6) { const bool up = it >= O5; const int r = it - (up ? O5 : O4), le = r / 512, q = r % 512, kb = q / 16, nb = q % 16, n0 = nb * 32;
            transpose_item((up ? a.in[35] : a.in[34]) + (size_t)le * DM * DFF, DFF, kb * 64, n0, (bf16_t*)(ws + WS_W1T) + (size_t)le * 1024 * DM, DM, (n0 >> 7) * 256 + (n0 & 127) + (up ? 128 : 0), scr, lane); }
        else if (it < O7) { const int r = it - O6, le = r / 512, q = r % 512, kb = q / 64, nb = q % 64;
            transpose_item(a.in[36] + (size_t)le * DFF * DM, DM, kb * 64, nb * 32, (bf16_t*)(ws + WS_W2T) + (size_t)le * DM * DFF, DFF, nb * 32, scr, lane); }
        else if (it < O9) { const bool wx = it >= O8; const int r = it - (wx ? O8 : O7), dn = r / 32, q = r % 32, kb = q / 8, nb = q % 8, n0 = nb * 32, dir = dn / 8, n = dn % 8;
            transpose_item((wx ? a.in[24] : a.in[22]) + (size_t)dn * 65536, 256, kb * 64, n0, (bf16_t*)(ws + WS_WG_OD), 256, (n * 4 + dir * 2 + (n0 >> 7)) * 256 + (n0 & 127) + (wx ? 128 : 0), scr, lane); }
        else { const int nb = it - O9; transpose_item(a.in[11], 4096, 0, nb * 32, (bf16_t*)(ws + A_W4T), 128, nb * 32, scr, lane); }
    }
    { const int gt = blockIdx.x * 512 + tid, NT = G * 512;
      for (int i = gt; i < 4096 * 8; i += NT) { const int r = i >> 3, c = i & 7; *(u32x4*)((bf16_t*)(ws + A_W4T) + (size_t)r * 128 + 64 + c * 8) = (u32x4){0u, 0u, 0u, 0u}; }
      for (int i = gt; i < 8192 * 8; i += NT) { const int r = i >> 3, c = i & 7; *(u32x4*)((bf16_t*)(ws + A_H3B) + (size_t)r * 128 + 64 + c * 8) = (u32x4){0u, 0u, 0u, 0u}; }
      const f32x8* x8 = (const f32x8*)a.in[0]; u32x4* xb = (u32x4*)(ws + A_XB);
      for (int i = gt; i < NTOK * DM / 8; i += NT) { const f32x8 v = x8[i]; u32x4 o; o.x = pk2(v[0], v[1]); o.y = pk2(v[2], v[3]); o.z = pk2(v[4], v[5]); o.w = pk2(v[6], v[7]); xb[i] = o; } }
    { const float* w1 = a.in[4]; const float* b1 = a.in[5]; const float* w2 = a.in[6]; const float* b2 = a.in[7]; const float* w3 = a.in[8]; const float* b3 = a.in[9]; const float* fr = a.in[10];
      const float frq = fr[lane];
      for (int t = gw; t < SEQ; t += NGW) {
          float z;
          { const float tl = (float)t * (1.0f / 8191.0f);
            if (lane == 0) z = tl;
            else { const int j = (lane - 1) & 15; const float band = 1e-4f + (float)j * ((15.0f - 1e-4f) / 15.0f);
                   const float ang = (6.283185307179586f * (float)t * (1.0f / 8192.0f)) * band; float sn, cs; sincosf(ang, &sn, &cs); z = (lane <= 16) ? cs : -sn; } }
          float acc = b1[lane];
#pragma unroll
          for (int i = 0; i < 33; ++i) acc += __shfl(z, i) * w1[i * 64 + lane];
          float h = sinf(frq * acc);
          acc = b2[lane];
#pragma unroll 16
          for (int i = 0; i < 64; ++i) acc += __shfl(h, i) * w2[i * 64 + lane];
          h = sinf(frq * acc);
          acc = b3[lane];
#pragma unroll 16
          for (int i = 0; i < 64; ++i) acc += __shfl(h, i) * w3[i * 64 + lane];
          h = sinf(frq * acc);
          ((bf16_t*)(ws + A_H3B))[(size_t)t * 128 + lane] = (bf16_t)f2bf(h);
      } }
}

__device__ __forceinline__ void phase_filter_fft(KArgs a, LAS unsigned char* lds) {
    const int tid = opaque_tid(), lane = tid & 63, wave = tid >> 6, G = gridDim.x;
    LAS f32x2* L = (LAS f32x2*)lds; LAS float* red = (LAS float*)(lds + LDS_MISC + 1024);
    const float* KTD = (const float*)(a.ws + A_KTD); __half2* KF = (__half2*)(a.ws + A_KF);
    for (int u = blockIdx.x; u < 2048; u += G) {
        const int o = u >> 10, c = u & 1023;
        int tl = tid; asm volatile("" : "+v"(tl));
        const float* rowF = KTD + (size_t)(o * 1024 + c) * 8192; const float* rowB = KTD + (size_t)(2048 + o * 1024 + c) * 8192;
        hy::cf v[32]; float ss = 0.f;
#pragma unroll
        for (int n1 = 0; n1 < 32; ++n1) { const int p = tl + 512 * n1; float val;
            if (n1 < 16) val = rowF[p]; else if (p == 8192) val = 0.f; else val = rowB[16384 - p];
            v[n1] = hy::cf{val, 0.f}; ss += val * val; }
        ss = wave_sum(ss); if (lane == 0) red[wave] = ss; __syncthreads();
        float tot = 0.f;
#pragma unroll
        for (int w = 0; w < 8; ++w) tot += red[w];
        const float scale = rsqrtf(tot), skp = a.in[12][u];
        hy::fft_fwd12(v, L, tl);
#pragma unroll
        for (int bf = 0; bf < 2; ++bf) { const int idx = bf * 512 + tl, k1 = idx >> 5, j1 = idx & 31; hy::cf w[16];
#pragma unroll
            for (int m2 = 0; m2 < 16; ++m2) w[m2] = hy::lld(L, k1 * hy::RS + 33 * m2 + j1);
            hy::dft_reg<16, false>(w);
#pragma unroll
            for (int j2 = 0; j2 < 16; ++j2) { const hy::cf x = w[hy::brev(j2, 4)]; KF[((size_t)(u * 2 + bf) * 16 + j2) * 512 + tl] = __floats2half2_rn(x.x * scale + skp, x.y * scale); } }
        __syncthreads();
    }
}
__device__ __forceinline__ float hyconv(const bf16_t* row, int t, float w0, float w1, float w2, float bias) {
    const unsigned tm = (unsigned)(t > 0 ? t - 1 : 0), tp = (unsigned)(t < SEQ - 1 ? t + 1 : SEQ - 1);
    float xm = bf2f(row[tm]), x0 = bf2f(row[(unsigned)t]), xp = bf2f(row[tp]);
    xm = t > 0 ? xm : 0.f; xp = t < SEQ - 1 ? xp : 0.f;
    return w0 * xm + w1 * x0 + w2 * xp + bias;
}
__device__ __forceinline__ void phase_hyena_mixer(KArgs a, LAS unsigned char* lds) {
    const int tid = opaque_tid(), G = gridDim.x;
    LAS f32x2* L = (LAS f32x2*)lds;
    const bf16_t* UHT = (const bf16_t*)(a.ws + A_UHT); const __half2* KF = (const __half2*)(a.ws + A_KF); bf16_t* YHT = (bf16_t*)(a.ws + A_YHT);
    const float* cw = a.in[2]; const float* cb = a.in[3];
    for (int c = blockIdx.x; c < HY_CH; c += G) {
        int tl = tid; asm volatile("" : "+v"(tl));
        hy::cf v[32];
        { const bf16_t* r0 = UHT + (size_t)c * NTOK; const float w0 = cw[c], w1 = cw[3072 + c], w2 = cw[6144 + c], bb = cb[c];
#pragma unroll
          for (int n1 = 0; n1 < 16; ++n1) { const int t = tl + 512 * n1; v[n1] = hy::cf{hyconv(r0, t, w0, w1, w2, bb), hyconv(r0 + SEQ, t, w0, w1, w2, bb)}; if ((n1 & 3) == 3) asm volatile("" ::: "memory"); } }
#pragma unroll 1
        for (int o = 0; o < 2; ++o) {
#pragma unroll
            for (int n1 = 16; n1 < 32; ++n1) v[n1] = hy::cf{0.f, 0.f};
            hy::fft_fwd12(v, L, tl);
#pragma unroll
            for (int bf = 0; bf < 2; ++bf) { const int idx = bf * 512 + tl, k1 = idx >> 5, j1 = idx & 31; hy::cf w[16];
#pragma unroll
                for (int m2 = 0; m2 < 16; ++m2) w[m2] = hy::lld(L, k1 * hy::RS + 33 * m2 + j1);
                hy::dft_reg<16, false>(w);
                asm volatile("" ::: "memory");
                hy::cf y[16];
#pragma unroll
                for (int j2 = 0; j2 < 16; ++j2) { const float2 kf = __half22float2(KF[((size_t)((o * 1024 + c) * 2 + bf) * 16 + j2) * 512 + tl]);
                    y[j2] = hy::cmul(w[hy::brev(j2, 4)], hy::cf{kf.x, kf.y}); }
                hy::dft_reg<16, true>(y);
#pragma unroll
                for (int m2 = 0; m2 < 16; ++m2) hy::lst(L, k1 * hy::RS + 33 * m2 + j1, y[hy::brev(m2, 4)]); }
            __syncthreads();
            hy::fft_inv21(v, L, tl);
            const int gch = (o + 1) * 1024 + c; const bf16_t* rg = UHT + (size_t)gch * NTOK;
            const float w0 = cw[gch], w1 = cw[3072 + gch], w2 = cw[6144 + gch], bb = cb[gch];
            hy::cf zn[16]; int tg = tl; asm volatile("" : "+v"(tg));
#pragma unroll
            for (int n1 = 0; n1 < 16; ++n1) { const int t = tg + 512 * n1; const hy::cf y = v[hy::brev(n1, 5)];
                const float g0 = hyconv(rg, t, w0, w1, w2, bb), g1 = hyconv(rg + SEQ, t, w0, w1, w2, bb);
                zn[n1] = hy::cf{g0 * y.x * (1.0f / 16384.0f), g1 * y.y * (1.0f / 16384.0f)}; if ((n1 & 3) == 3) asm volatile("" ::: "memory"); }
#pragma unroll
            for (int n1 = 0; n1 < 16; ++n1) v[n1] = zn[n1];
        }
        bf16_t* yo = YHT + (size_t)c * NTOK;
#pragma unroll
        for (int n1 = 0; n1 < 16; ++n1) { const int t = tl + 512 * n1; yo[t] = (bf16_t)f2bf(v[n1].x); yo[SEQ + t] = (bf16_t)f2bf(v[n1].y); }
    }
    __syncthreads();
}
__device__ __forceinline__ void phase_attention(KArgs a, LAS unsigned char* lds) {
    const int G = gridDim.x, bx = blockIdx.x;
    const bf16_t* QB = (const bf16_t*)(a.ws + A_QB); const bf16_t* KB = (const bf16_t*)(a.ws + A_KB); const bf16_t* VB = (const bf16_t*)(a.ws + A_VB); bf16_t* OA = (bf16_t*)(a.ws + A_OA);
    for (int i = 0;; ++i) {
        int bhc, qb;
        if (G == 256) { if (i >= 4) break; bhc = i * 8 + (bx & 7); qb = bx >> 3; }
        else { const int Lu = i * G + bx; if (Lu >= 1024) break; bhc = Lu >> 5; qb = Lu & 31; }
        const int b = bhc >> 4, h = (bhc >> 1) & 7, cm = bhc & 1;
        const size_t rowq = (size_t)b * SEQ + (size_t)qb * 256;
        const float sl2 = exp2f(-(float)(h + 1)) * 1.4426950408889634f;
        att::attn_unit(QB + rowq * 1024 + h * 128 + cm * 64, KB + (size_t)b * SEQ * 1024 + h * 128 + cm * 64, VB + (size_t)b * SEQ * 1024 + h * 128,
                       OA + (size_t)cm * NTOK * 1024 + rowq * 1024 + h * 128, qb * 256, SEQ, sl2, (char*)lds);
    }
}
__device__ __forceinline__ void phase_concat(KArgs a, LAS unsigned char* lds) {
    const int tid = opaque_tid(), lane = tid & 63, wave = tid >> 6, G = gridDim.x;
    const bf16_t* YHT = (const bf16_t*)(a.ws + A_YHT); const bf16_t* OA0 = (const bf16_t*)(a.ws + A_OA); const bf16_t* OA1 = OA0 + (size_t)NTOK * 1024; bf16_t* YC = (bf16_t*)(a.ws + A_YCAT);
    LAS bf16_t* T = (LAS bf16_t*)lds;
    const float lambda_init = 0.2f;
    const float lam = __expf(wave_sum(a.in[13][lane] * a.in[14][lane])) - __expf(wave_sum(a.in[15][lane] * a.in[16][lane])) + lambda_init;
    float gl[16];
#pragma unroll
    for (int i = 0; i < 16; ++i) gl[i] = a.in[17][(lane & 7) * 16 + i] * (1.0f - lambda_init);
    for (int it = blockIdx.x; it < NTOK / 64; it += G) {
        const int tok0 = it * 64;
#pragma unroll 4
        for (int k = 0; k < 16; ++k) { const int idx = tid + 512 * k, c = idx >> 3, ch = idx & 7;
            const u32x4 w = *(const u32x4*)(YHT + (size_t)c * NTOK + tok0 + ch * 8);
            LAS bf16_t* d = T + (ch * 8) * 1026 + c;
            d[0 * 1026] = (bf16_t)(w.x & 0xffff); d[1 * 1026] = (bf16_t)(w.x >> 16); d[2 * 1026] = (bf16_t)(w.y & 0xffff); d[3 * 1026] = (bf16_t)(w.y >> 16);
            d[4 * 1026] = (bf16_t)(w.z & 0xffff); d[5 * 1026] = (bf16_t)(w.z >> 16); d[6 * 1026] = (bf16_t)(w.w & 0xffff); d[7 * 1026] = (bf16_t)(w.w >> 16); }
        __syncthreads();
#pragma unroll 4
        for (int k = 0; k < 16; ++k) { const int idx = tid + 512 * k, tl = idx >> 7, c8 = idx & 127;
            const LAS unsigned* s = (const LAS unsigned*)(T + tl * 1026 + c8 * 8);
            u32x4 w; w.x = s[0]; w.y = s[1]; w.z = s[2]; w.w = s[3];
            *(u32x4*)(YC + (size_t)(tok0 + tl) * DM + c8 * 8) = w; }
        for (int rr = 0; rr < 8; ++rr) { const size_t tok = (size_t)tok0 + wave * 8 + rr;
            const u32x4 p0 = *(const u32x4*)(OA0 + tok * 1024 + lane * 16), p1 = *(const u32x4*)(OA0 + tok * 1024 + lane * 16 + 8);
            const u32x4 q0 = *(const u32x4*)(OA1 + tok * 1024 + lane * 16), q1 = *(const u32x4*)(OA1 + tok * 1024 + lane * 16 + 8);
            const unsigned pw[8] = {p0.x, p0.y, p0.z, p0.w, p1.x, p1.y, p1.z, p1.w}, qw[8] = {q0.x, q0.y, q0.z, q0.w, q1.x, q1.y, q1.z, q1.w};
            float o[16]; float ss = 0.f;
#pragma unroll
            for (int i = 0; i < 8; ++i) { o[2 * i] = bflo(pw[i]) - lam * bflo(qw[i]); o[2 * i + 1] = bfhi(pw[i]) - lam * bfhi(qw[i]); ss += o[2 * i] * o[2 * i] + o[2 * i + 1] * o[2 * i + 1]; }
            ss += __shfl_xor(ss, 1); ss += __shfl_xor(ss, 2); ss += __shfl_xor(ss, 4);
            const float rs = rsqrtf(ss * (1.0f / 128.0f) + LN_EPS);
            u32x4 w0, w1;
            w0.x = pk2(o[0] * rs * gl[0], o[1] * rs * gl[1]); w0.y = pk2(o[2] * rs * gl[2], o[3] * rs * gl[3]); w0.z = pk2(o[4] * rs * gl[4], o[5] * rs * gl[5]); w0.w = pk2(o[6] * rs * gl[6], o[7] * rs * gl[7]);
            w1.x = pk2(o[8] * rs * gl[8], o[9] * rs * gl[9]); w1.y = pk2(o[10] * rs * gl[10], o[11] * rs * gl[11]); w1.z = pk2(o[12] * rs * gl[12], o[13] * rs * gl[13]); w1.w = pk2(o[14] * rs * gl[14], o[15] * rs * gl[15]);
            *(u32x4*)(YC + tok * DM + 1024 + lane * 16) = w0; *(u32x4*)(YC + tok * DM + 1024 + lane * 16 + 8) = w1; }
        __syncthreads();
    }
}
__device__ __forceinline__ void ln_row(f32x4 (&v)[8], const float* g, const float* b, int lane) {
    float s = 0.f;
#pragma unroll
    for (int j = 0; j < 8; ++j) s += (v[j][0] + v[j][1]) + (v[j][2] + v[j][3]);
    const float mean = wave_sum(s) * (1.0f / DM); float s2 = 0.f;
#pragma unroll
    for (int j = 0; j < 8; ++j) { v[j] = v[j] - mean; s2 += (v[j][0] * v[j][0] + v[j][1] * v[j][1]) + (v[j][2] * v[j][2] + v[j][3] * v[j][3]); }
    const float rstd = rsqrtf(wave_sum(s2) * (1.0f / DM) + LN_EPS);
#pragma unroll
    for (int j = 0; j < 8; ++j) { const f32x4 gg = *(const f32x4*)(g + 4 * (lane + 64 * j)), bb = *(const f32x4*)(b + 4 * (lane + 64 * j)); v[j] = v[j] * rstd * gg + bb; }
}
__device__ __forceinline__ void phase_ln_router(KArgs a, LAS unsigned char* lds, const float* R, const float* g, const float* b, float* H1, bf16_t* HB, unsigned* cnt, int* rowlist, float* gatew) {
    const int tid = opaque_tid(), lane = tid & 63, wave = tid >> 6, G = gridDim.x;
    const float* rw = a.in[32]; const float* rb = a.in[33];
    LAS float* part = (LAS float*)lds;
    LAS int* hist = (LAS int*)(lds + 40960); LAS int* base = hist + 32;
    for (int it = blockIdx.x; it < NTOK / 32; it += G) {
        const int tok0 = it * 32;
        for (int rr = 0; rr < 4; ++rr) { const size_t row = (size_t)tok0 + wave * 4 + rr; f32x4 v[8];
#pragma unroll
            for (int j = 0; j < 8; ++j) v[j] = *(const f32x4*)(R + row * DM + 4 * (lane + 64 * j));
            ln_row(v, g, b, lane);
#pragma unroll
            for (int j = 0; j < 8; ++j) { *(f32x4*)(H1 + row * DM + 4 * (lane + 64 * j)) = v[j]; u32x2 w; w.x = pk2(v[j][0], v[j][1]); w.y = pk2(v[j][2], v[j][3]); *(u32x2*)(HB + row * DM + 4 * (lane + 64 * j)) = w; } }
        if (tid < 32) hist[tid] = 0;
        VM_WAIT(); __syncthreads();
        { const int i = lane & 31, kk = lane >> 5; f32x16 acc = {};
          const float* hrow = H1 + (size_t)(tok0 + i) * DM + wave * 256 + 4 * kk; const float* rwp = rw + (size_t)(wave * 256 + 4 * kk) * NEXP + i;
#pragma unroll 4
          for (int s = 0; s < 32; ++s) { const f32x4 hv = __builtin_nontemporal_load((const f32x4*)(hrow + 8 * s));
#pragma unroll
              for (int j = 0; j < 4; ++j) acc = __builtin_amdgcn_mfma_f32_32x32x2f32(rwp[(size_t)(8 * s + j) * NEXP], hv[j], acc, 0, 0, 0); }
#pragma unroll
          for (int r = 0; r < 16; ++r) part[(wave * 32 + i) * 33 + (r & 3) + 8 * (r >> 2) + 4 * kk] = acc[r]; }
        __syncthreads();
        int e1 = 0, e2 = 0, r1 = 0, r2 = 0; float g1 = 0.f, g2 = 0.f;
        if (tid < 32) {
            float bestg = -1e30f;
#pragma unroll
            for (int gi = 0; gi < 4; ++gi) { float m1 = -1e30f, m2 = -1e30f, s1 = 0.f, s2 = 0.f; int i1 = 0, i2 = 0;
#pragma unroll
                for (int j = 0; j < 8; ++j) { const int e = gi * 8 + j; float lg = 0.f;
#pragma unroll
                    for (int w = 0; w < 8; ++w) lg += part[(w * 32 + tid) * 33 + e];
                    const float sg = 1.0f / (1.0f + expf(-lg)), sl = sg + rb[e];
                    if (sl > m1) { m2 = m1; i2 = i1; s2 = s1; m1 = sl; i1 = j; s1 = sg; } else if (sl > m2) { m2 = sl; i2 = j; s2 = sg; } }
                const float gs = m1 + m2;
                if (gs > bestg) { bestg = gs; e1 = gi * 8 + i1; e2 = gi * 8 + i2; g1 = s1; g2 = s2; } }
            const float inv = 1.0f / (g1 + g2); g1 *= inv; g2 *= inv;
            r1 = atomicAdd((int*)&hist[e1], 1); r2 = atomicAdd((int*)&hist[e2], 1);
        }
        __syncthreads();
        if (tid < 32) { const int hc = hist[tid]; base[tid] = hc ? (int)__hip_atomic_fetch_add(cnt + tid * 64, (unsigned)hc, __ATOMIC_RELAXED, __HIP_MEMORY_SCOPE_AGENT) : 0; }
        __syncthreads();
        if (tid < 32) { const int a0 = (tok0 + tid) * 2;
            rowlist[(size_t)e1 * ECAP + base[e1] + r1] = a0; gatew[a0] = g1;
            rowlist[(size_t)e2 * ECAP + base[e2] + r2] = a0 + 1; gatew[a0 + 1] = g2; }
        __syncthreads();
    }
}
__device__ __forceinline__ void phase_ln2(const float* H1, const bf16_t* Y2, const float* g, const float* b, float* OUT, bf16_t* OB) {
    const int tid = opaque_tid(), lane = tid & 63, wave = tid >> 6;
    for (int row = blockIdx.x * 8 + wave; row < NTOK; row += gridDim.x * 8) { f32x4 v[8];
#pragma unroll
        for (int j = 0; j < 8; ++j) { const int c = 4 * (lane + 64 * j); const f32x4 h = *(const f32x4*)(H1 + (size_t)row * DM + c);
            const u32x2 y0 = *(const u32x2*)(Y2 + (size_t)(2 * row) * DM + c), y1 = *(const u32x2*)(Y2 + (size_t)(2 * row + 1) * DM + c);
            v[j] = h * DN_ALPHA + (f32x4){bflo(y0.x) + bflo(y1.x), bfhi(y0.x) + bfhi(y1.x), bflo(y0.y) + bflo(y1.y), bfhi(y0.y) + bfhi(y1.y)}; }
        ln_row(v, g, b, lane);
#pragma unroll
        for (int j = 0; j < 8; ++j) { const int c = 4 * (lane + 64 * j); *(f32x4*)(OUT + (size_t)row * DM + c) = v[j];
            if (OB) { u32x2 w; w.x = pk2(v[j][0], v[j][1]); w.y = pk2(v[j][2], v[j][3]); *(u32x2*)(OB + (size_t)row * DM + c) = w; } }
    }
}
__device__ __forceinline__ void moe_table(LAS int* tab, const unsigned* cnt) {
    __syncthreads();
    if (threadIdx.x < 32) tab[64 + threadIdx.x] = (int)cnt[threadIdx.x * 64];
    __syncthreads();
    if (threadIdx.x == 0) { int acc = 0; for (int e = 0; e < 32; ++e) { tab[e] = acc; acc += (tab[64 + e] + 255) >> 8; } tab[32] = acc; }
    __syncthreads();
}
__device__ __forceinline__ void phase_conv4(KArgs a) {
    const bf16_t* XR = (const bf16_t*)(a.ws + A_XR); bf16_t* XC = (bf16_t*)(a.ws + A_XC); const float* cw = a.in[20]; const float* cb = a.in[21];
    const int NT = gridDim.x * 512;
    for (int it = blockIdx.x * 512 + opaque_tid(); it < NTOK * 256; it += NT) { const int tok = it >> 8, ch = (it & 255) * 8, t = tok & (SEQ - 1);
        float acc[8];
#pragma unroll
        for (int i = 0; i < 8; ++i) acc[i] = cb[ch + i];
#pragma unroll
        for (int j = 0; j < 4; ++j) { const int tt = t + j - 2;
            if (tt >= 0 && tt < SEQ) { const u32x4 w = *(const u32x4*)(XR + (size_t)(tok + j - 2) * DM + ch); const unsigned ww[4] = {w.x, w.y, w.z, w.w};
#pragma unroll
                for (int i = 0; i < 4; ++i) { acc[2 * i] += cw[j * DM + ch + 2 * i] * bflo(ww[i]); acc[2 * i + 1] += cw[j * DM + ch + 2 * i + 1] * bfhi(ww[i]); } } }
        u32x4 o; o.x = pk2(acc[0], acc[1]); o.y = pk2(acc[2], acc[3]); o.z = pk2(acc[4], acc[5]); o.w = pk2(acc[6], acc[7]);
        *(u32x4*)(XC + (size_t)tok * DM + ch) = o; }
}
constexpr size_t CAR_ELEMS = (size_t)2 * 2 * 256 * DM;
__device__ __forceinline__ void phase_scan1(KArgs a) {
    const bf16_t* LA = (const bf16_t*)(a.ws + A_LA); const bf16_t* BB = (const bf16_t*)(a.ws + A_BB); float* CARA = (float*)(a.ws + A_CAR); float* CARB = CARA + CAR_ELEMS;
    const int NT = gridDim.x * 512;
    for (int it = blockIdx.x * 512 + opaque_tid(); it < 2 * 2 * 256 * 512; it += NT) { const int ch = (it & 511) * 4, chunk = (it >> 9) & 255, dir = (it >> 17) & 1, b = it >> 18;
        float h[4] = {0.f, 0.f, 0.f, 0.f}, ls[4] = {0.f, 0.f, 0.f, 0.f};
#pragma unroll 8
        for (int s = 0; s < 32; ++s) { const int t = chunk * 32 + (dir ? 31 - s : s); const size_t off = ((size_t)dir * NTOK + (size_t)b * SEQ + t) * DM + ch;
            const u32x2 lw = *(const u32x2*)(LA + off), bw = *(const u32x2*)(BB + off);
            const float l4[4] = {bflo(lw.x), bfhi(lw.x), bflo(lw.y), bfhi(lw.y)}, b4[4] = {bflo(bw.x), bfhi(bw.x), bflo(bw.y), bfhi(bw.y)};
#pragma unroll
            for (int i = 0; i < 4; ++i) { h[i] = __expf(l4[i]) * h[i] + b4[i]; ls[i] += l4[i]; } }
        const size_t co = (((size_t)b * 2 + dir) * 256 + chunk) * DM + ch;
        *(f32x4*)(CARA + co) = (f32x4){ls[0], ls[1], ls[2], ls[3]}; *(f32x4*)(CARB + co) = (f32x4){h[0], h[1], h[2], h[3]}; }
}
__device__ __forceinline__ void phase_scan2(KArgs a) {
    float* CARA = (float*)(a.ws + A_CAR); float* CARB = CARA + CAR_ELEMS; float* CARIN = CARB + CAR_ELEMS;
    const int NT = gridDim.x * 512;
    for (int it = blockIdx.x * 512 + opaque_tid(); it < 2 * 2 * DM; it += NT) { const int ch = it & (DM - 1), dir = (it >> 11) & 1, b = it >> 12;
        float h = 0.f;
#pragma unroll 8
        for (int k = 0; k < 256; ++k) { const int chunk = dir ? 255 - k : k; const size_t co = (((size_t)b * 2 + dir) * 256 + chunk) * DM + ch;
            CARIN[co] = h; h = __expf(CARA[co]) * h + CARB[co]; } }
}
__device__ __forceinline__ float gelu_tanh(float x) { const float u = 0.7978845608028654f * (x + 0.044715f * x * x * x); const float th = 1.0f - 2.0f / (1.0f + __expf(2.0f * u)); return 0.5f * x * (1.0f + th); }
__device__ __forceinline__ void phase_scan3(KArgs a) {
    const bf16_t* LA = (const bf16_t*)(a.ws + A_LA); const bf16_t* BB = (const bf16_t*)(a.ws + A_BB); const bf16_t* GB = (const bf16_t*)(a.ws + A_GB); bf16_t* YG = (bf16_t*)(a.ws + A_YG);
    const float* CARIN = (const float*)(a.ws + A_CAR) + 2 * CAR_ELEMS;
    const int NT = gridDim.x * 512;
    for (int it = blockIdx.x * 512 + opaque_tid(); it < 2 * 256 * 512; it += NT) { const int ch = (it & 511) * 4, chunk = (it >> 9) & 255, b = it >> 17;
        float hf[32][4]; float h[4];
        { const f32x4 c = *(const f32x4*)(CARIN + (((size_t)b * 2 + 0) * 256 + chunk) * DM + ch); h[0] = c[0]; h[1] = c[1]; h[2] = c[2]; h[3] = c[3]; }
#pragma unroll
        for (int s = 0; s < 32; ++s) { const size_t off = ((size_t)b * SEQ + chunk * 32 + s) * DM + ch;
            const u32x2 lw = *(const u32x2*)(LA + off), bw = *(const u32x2*)(BB + off);
            const float l4[4] = {bflo(lw.x), bfhi(lw.x), bflo(lw.y), bfhi(lw.y)}, b4[4] = {bflo(bw.x), bfhi(bw.x), bflo(bw.y), bfhi(bw.y)};
#pragma unroll
            for (int i = 0; i < 4; ++i) { h[i] = __expf(l4[i]) * h[i] + b4[i]; hf[s][i] = h[i]; } }
        { const f32x4 c = *(const f32x4*)(CARIN + (((size_t)b * 2 + 1) * 256 + chunk) * DM + ch); h[0] = c[0]; h[1] = c[1]; h[2] = c[2]; h[3] = c[3]; }
#pragma unroll
        for (int s = 31; s >= 0; --s) { const size_t tokoff = ((size_t)b * SEQ + chunk * 32 + s) * DM + ch; const size_t off = (size_t)NTOK * DM + tokoff;
            const u32x2 lw = *(const u32x2*)(LA + off), bw = *(const u32x2*)(BB + off), gw = *(const u32x2*)(GB + tokoff);
            const float l4[4] = {bflo(lw.x), bfhi(lw.x), bflo(lw.y), bfhi(lw.y)}, b4[4] = {bflo(bw.x), bfhi(bw.x), bflo(bw.y), bfhi(bw.y)}, g4[4] = {bflo(gw.x), bfhi(gw.x), bflo(gw.y), bfhi(gw.y)};
            float y[4];
#pragma unroll
            for (int i = 0; i < 4; ++i) { h[i] = __expf(l4[i]) * h[i] + b4[i]; y[i] = gelu_tanh(g4[i]) * (hf[s][i] + h[i]); }
            u32x2 w; w.x = pk2(y[0], y[1]); w.y = pk2(y[2], y[3]); *(u32x2*)(YG + tokoff) = w; } }
}

extern __shared__ __attribute__((aligned(16))) unsigned char lds_raw[];
#define KARGS() (*(const __attribute__((address_space(4))) Args*)__builtin_amdgcn_kernarg_segment_ptr())
#define PHASE_FN __device__ __forceinline__ void
#define PH_PRE() KArgs a = KARGS(); LAS unsigned char* lds = (LAS unsigned char*)lds_raw; unsigned char* ws = a.ws; asm volatile("" : "+s"(ws)); const int G = gridDim.x, bx = blockIdx.x; (void)lds; (void)ws; (void)G; (void)bx; using namespace pg8
PHASE_FN ph0() { PH_PRE(); phase_prologue(a, lds); }
PHASE_FN ph1a() { PH_PRE(); Gemm g{(const bf16_t*)(ws + A_W4T), (const bf16_t*)(ws + A_H3B), 128, 128, 128}; StaticOrder S; S.init(4096, 8192, G, bx); EpiFilt E{(float*)(ws + A_KTD)}; gemm_phase(lds, g, S, E); }
PHASE_FN ph1b() { PH_PRE(); Gemm g{(const bf16_t*)(ws + A_XB), (const bf16_t*)(ws + WS_WIN_EV) + (size_t)3072 * DM, DM, DM, DM}; StaticOrder S; S.init(NTOK, 3072, G, bx);
                  EpiBf16 E{(bf16_t*)(ws + A_QB), 1024, 1024, (size_t)(A_KB - A_QB) / 2, QSCALE}; gemm_phase(lds, g, S, E); }
PHASE_FN ph1c() { PH_PRE(); Gemm g{(const bf16_t*)(ws + WS_WIN_EV), (const bf16_t*)(ws + A_XB), DM, DM, DM}; StaticOrder S; S.init(3072, NTOK, G, bx);
                  EpiBf16 E{(bf16_t*)(ws + A_UHT), NTOK, 0, 0, 1.f}; gemm_phase(lds, g, S, E); }
PHASE_FN ph2() { PH_PRE(); phase_filter_fft(a, lds); }
PHASE_FN ph3a() { PH_PRE(); phase_hyena_mixer(a, lds); }
PHASE_FN ph3b() { PH_PRE(); phase_attention(a, lds); }
PHASE_FN ph4() { PH_PRE(); phase_concat(a, lds); }
PHASE_FN ph5() { PH_PRE(); Gemm g{(const bf16_t*)(ws + A_YCAT), (const bf16_t*)(ws + WS_WOUT_EV), DM, DM, DM}; StaticOrder S; S.init(NTOK, DM, G, bx);
                 EpiResF32 E{a.in[0], (float*)(ws + A_R0), DM, DN_ALPHA}; gemm_phase(lds, g, S, E); }
template <int LAYER> PHASE_FN ph_lnr() { PH_PRE(); unsigned* ctl = (unsigned*)(ws + WS_CTL);
    phase_ln_router(a, lds, (const float*)(ws + (LAYER ? A_R1 : A_R0)), a.in[28] + LAYER * DM, a.in[29] + LAYER * DM, (float*)(ws + (LAYER ? A_H1_1 : A_H1_0)), (bf16_t*)(ws + (LAYER ? A_HB_1 : A_HB_0)),
                    ctl + CW_CNT + LAYER * 32 * 64, (int*)(ws + A_ROWL), (float*)(ws + A_GATEW)); }
template <int LAYER> PHASE_FN ph_moe1() { PH_PRE(); LAS int* tab = (LAS int*)(lds + LDS_MISC); moe_table(tab, (const unsigned*)(ws + WS_CTL) + CW_CNT + LAYER * 32 * 64);
    Gemm g{(const bf16_t*)(ws + (LAYER ? A_HB_1 : A_HB_0)), (const bf16_t*)(ws + WS_W1T) + (size_t)LAYER * 32 * 1024 * DM, DM, DM, DM}; MoeOrder<4, true> S{G, bx, tab, (const int*)(ws + A_ROWL)};
    EpiSwiglu E{(bf16_t*)(ws + (LAYER ? A_HID_1 : A_HID_0))}; gemm_phase(lds, g, S, E); }
template <int LAYER> PHASE_FN ph_moe2() { PH_PRE(); LAS int* tab = (LAS int*)(lds + LDS_MISC); moe_table(tab, (const unsigned*)(ws + WS_CTL) + CW_CNT + LAYER * 32 * 64);
    Gemm g{(const bf16_t*)(ws + (LAYER ? A_HID_1 : A_HID_0)), (const bf16_t*)(ws + WS_W2T) + (size_t)LAYER * 32 * DM * DFF, DFF, DFF, DFF}; MoeOrder<8, false> S{G, bx, tab, (const int*)(ws + A_ROWL)};
    EpiDown E{(bf16_t*)(ws + (LAYER ? A_Y2_1 : A_Y2_0)), (const int*)(ws + A_ROWL), (const float*)(ws + A_GATEW)}; gemm_phase(lds, g, S, E); }
template <int LAYER> PHASE_FN ph_ln2() { PH_PRE();
    phase_ln2((const float*)(ws + (LAYER ? A_H1_1 : A_H1_0)), (const bf16_t*)(ws + (LAYER ? A_Y2_1 : A_Y2_0)), a.in[30] + LAYER * DM, a.in[31] + LAYER * DM, LAYER ? a.out : (float*)(ws + A_H2), LAYER ? nullptr : (bf16_t*)(ws + A_HB2)); }
PHASE_FN ph10() { PH_PRE(); Gemm g{(const bf16_t*)(ws + A_HB2), (const bf16_t*)(ws + WS_WIN_OD), DM, DM, DM}; StaticOrder S; S.init(NTOK, 2 * DM, G, bx);
                  EpiBf16 E{(bf16_t*)(ws + A_GB), DM, DM, (size_t)(A_XR - A_GB) / 2, 1.f}; gemm_phase(lds, g, S, E); }
PHASE_FN ph11() { PH_PRE(); phase_conv4(a); }
PHASE_FN ph12() { PH_PRE(); Gemm g{(const bf16_t*)(ws + A_XC), (const bf16_t*)(ws + WS_WG_OD), DM, 256, 256}; RGOrder S{G, bx};
                  EpiRG E{(bf16_t*)(ws + A_LA), (bf16_t*)(ws + A_BB), (const bf16_t*)(ws + A_XC), a.in[23], a.in[25], a.in[26]}; gemm_phase(lds, g, S, E); }
PHASE_FN ph13() { PH_PRE(); phase_scan1(a); }
PHASE_FN ph14() { PH_PRE(); phase_scan2(a); }
PHASE_FN ph15() { PH_PRE(); phase_scan3(a); }
PHASE_FN ph16() { PH_PRE(); Gemm g{(const bf16_t*)(ws + A_YG), (const bf16_t*)(ws + WS_WOUT_OD), DM, DM, DM}; StaticOrder S; S.init(NTOK, DM, G, bx);
                  EpiResF32 E{(const float*)(ws + A_H2), (float*)(ws + A_R1), DM, DN_ALPHA}; gemm_phase(lds, g, S, E); }

__global__ void __launch_bounds__(512, 2) fwd(Args a) {
    LAS unsigned char* lds = (LAS unsigned char*)lds_raw;
    const int tid = threadIdx.x;
    unsigned* ctl = (unsigned*)(a.ws + WS_CTL);
    volatile LAS unsigned* bst = (volatile LAS unsigned*)(lds + LDS_MISC + 2048);
    if (tid < 4) bst[tid] = 0u;
    __syncthreads();
    const int lo = a.ph_lo, hi = a.ph_hi;
    XcdBarrier bar; bar.bar = ctl + CW_BAR; bar.x = 0; bar.st = bst;
    if (hi - lo > 1) bar = xcd_barrier_post(ctl + CW_BAR, bst);
#ifdef ONLY_PHASE
#define IN(k) ((k) == ONLY_PHASE && lo <= (k) && (k) < hi)
#else
#define IN(k) (lo <= (k) && (k) < hi)
#endif
#define SEAM(k) do { if (IN(k) && IN((k) + 1)) xcd_barrier(bar); } while (0)
    if (IN(0)) { asm volatile("; PHASE_MARK 0"); ph0(); } SEAM(0);
    if (IN(1)) { asm volatile("; PHASE_MARK 1a"); ph1a(); asm volatile("; PHASE_MARK 1b"); ph1b(); asm volatile("; PHASE_MARK 1c"); ph1c(); } SEAM(1);
    if (IN(2)) { asm volatile("; PHASE_MARK 2"); ph2(); } SEAM(2);
    if (IN(3)) { asm volatile("; PHASE_MARK 3a"); ph3a(); asm volatile("; PHASE_MARK 3b"); ph3b(); } SEAM(3);
    if (IN(4)) { asm volatile("; PHASE_MARK 4"); ph4(); } SEAM(4);
    if (IN(5)) { asm volatile("; PHASE_MARK 5"); ph5(); } SEAM(5);
    if (IN(6)) { asm volatile("; PHASE_MARK 6"); ph_lnr<0>(); } SEAM(6);
    if (IN(7)) { asm volatile("; PHASE_MARK 7"); ph_moe1<0>(); } SEAM(7);
    if (IN(8)) { asm volatile("; PHASE_MARK 8"); ph_moe2<0>(); } SEAM(8);
    if (IN(9)) { asm volatile("; PHASE_MARK 9"); ph_ln2<0>(); } SEAM(9);
    if (IN(10)) { asm volatile("; PHASE_MARK 10"); ph10(); } SEAM(10);
    if (IN(11)) { asm volatile("; PHASE_MARK 11"); ph11(); } SEAM(11);
    if (IN(12)) { asm volatile("; PHASE_MARK 12"); ph12(); } SEAM(12);
    if (IN(13)) { asm volatile("; PHASE_MARK 13"); ph13(); } SEAM(13);
    if (IN(14)) { asm volatile("; PHASE_MARK 14"); ph14(); } SEAM(14);
    if (IN(15)) { asm volatile("; PHASE_MARK 15"); ph15(); } SEAM(15);
    if (IN(16)) { asm volatile("; PHASE_MARK 16"); ph16(); } SEAM(16);
    if (IN(17)) { asm volatile("; PHASE_MARK 17"); ph_lnr<1>(); } SEAM(17);
    if (IN(18)) { asm volatile("; PHASE_MARK 18"); ph_moe1<1>(); } SEAM(18);
    if (IN(19)) { asm volatile("; PHASE_MARK 19"); ph_moe2<1>(); } SEAM(19);
    if (IN(20)) { asm volatile("; PHASE_MARK 20"); ph_ln2<1>(); }
#undef IN
#undef SEAM
}

#ifndef MK_PER_PHASE
#define MK_PER_PHASE 0
#endif
extern "C" void kernel_launch(void* const* d_in, const int* in_sizes, int n_in, void* d_out, int out_size, void* d_ws, size_t ws_size, hipStream_t stream) {
    static int grid = 0;
    if (grid == 0) {
        if (n_in != 37 || out_size != NTOK * DM || ws_size < WS_END) { fprintf(stderr, "kernel_launch: built for 37 inputs, %d outputs, >= %zu bytes of workspace; got n_in %d out %d ws %zu\n", NTOK * DM, (size_t)WS_END, n_in, out_size, ws_size); grid = -1; return; }
        int dev = 0, cus = 0, per_cu = 0;
        if (hipGetDevice(&dev) != hipSuccess || hipDeviceGetAttribute(&cus, hipDeviceAttributeMultiprocessorCount, dev) != hipSuccess) { grid = -1; return; }
        if (hipFuncSetAttribute((const void*)fwd, hipFuncAttributeMaxDynamicSharedMemorySize, LDS_BYTES) != hipSuccess) { fprintf(stderr, "kernel_launch: hipFuncSetAttribute failed\n"); grid = -1; return; }
        if (hipOccupancyMaxActiveBlocksPerMultiprocessor(&per_cu, (const void*)fwd, 512, LDS_BYTES) != hipSuccess || per_cu < 1) fprintf(stderr, "kernel_launch: occupancy query reports %d\n", per_cu);
        (void)hipGetLastError();
        grid = cus;
    }
    if (grid < 0) return;
    (void)hipMemsetAsync((char*)d_ws + WS_CTL, 0, CTL_ZERO_BYTES, stream);
    Args a{};
    for (int i = 0; i < 37; ++i) a.in[i] = (const float*)d_in[i];
    a.out = (float*)d_out; a.ws = (unsigned char*)d_ws;
#if MK_PER_PHASE
    for (int p = 0; p < NPHASE; ++p) { a.ph_lo = p; a.ph_hi = p + 1; hipLaunchKernelGGL(fwd, dim3(grid), dim3(512), LDS_BYTES, stream, a); }
#else
    a.ph_lo = 0; a.ph_hi = NPHASE; hipLaunchKernelGGL(fwd, dim3(grid), dim3(512), LDS_BYTES, stream, a);
#endif
}
```

```cpp
#include <hip/hip_runtime.h>
#include <hip/hip_fp16.h>
#include <cstdio>
#include <cstdint>

#define GAS __attribute__((address_space(1)))
#define LAS __attribute__((address_space(3)))
typedef unsigned short bf16_t;
typedef short bf16x8 __attribute__((ext_vector_type(8)));
typedef short s16x4 __attribute__((ext_vector_type(4)));
typedef float f32x2 __attribute__((ext_vector_type(2)));
typedef float f32x4 __attribute__((ext_vector_type(4)));
typedef float f32x8 __attribute__((ext_vector_type(8)));
typedef float f32x16 __attribute__((ext_vector_type(16)));
typedef unsigned u32x2 __attribute__((ext_vector_type(2)));
typedef unsigned u32x4 __attribute__((ext_vector_type(4)));
typedef GAS unsigned gu32;

constexpr int DM = 2048, BATCH = 2, SEQ = 8192, NTOK = BATCH * SEQ;
constexpr int HY_CH = 1024, EV_IN = 6144;
constexpr int NEXP = 32, DFF = 512, NASSIGN = NTOK * 2, ECAP = NASSIGN;
constexpr float LN_EPS = 1e-5f;
constexpr float DN_ALPHA = 1.4142135623730951f;
constexpr float QSCALE = 0.125f * 1.4426950408889634f;
constexpr int FFT_N = 16384, FFT_RS = 528;

__device__ __forceinline__ unsigned f2bf(float f) { unsigned u = __builtin_bit_cast(unsigned, f); return (u + 0x7fffu + ((u >> 16) & 1u)) >> 16; }
__device__ __forceinline__ unsigned pk2(float lo, float hi) { return f2bf(lo) | (f2bf(hi) << 16); }
__device__ __forceinline__ float bf2f(unsigned short h) { return __builtin_bit_cast(float, (unsigned)h << 16); }
__device__ __forceinline__ float bflo(unsigned w) { return __builtin_bit_cast(float, w << 16); }
__device__ __forceinline__ float bfhi(unsigned w) { return __builtin_bit_cast(float, w & 0xffff0000u); }
__device__ __forceinline__ unsigned cvt_pk_bf16(float lo, float hi) { unsigned r; asm volatile("v_cvt_pk_bf16_f32 %0, %1, %2" : "=v"(r) : "v"(lo), "v"(hi)); return r; }
__device__ __forceinline__ float wave_sum(float v) {
#pragma unroll
    for (int o = 1; o < 64; o <<= 1) v += __shfl_xor(v, o);
    return v;
}
__device__ __forceinline__ float sigmoidf_(float x) { return 1.0f / (1.0f + __expf(-x)); }
__device__ __forceinline__ int opaque_tid() { int t = threadIdx.x; asm volatile("" : "+v"(t)); return t; }
#define LDS_WAIT() asm volatile("s_waitcnt lgkmcnt(0)" ::: "memory")
#define VM_WAIT() asm volatile("s_waitcnt vmcnt(0)" ::: "memory")

#define XB_TMO      128
#define XB_XCNT(j)  (256  + 64 * (j))
#define XB_XSUB(j)  (1280 + 64 * (j))
#define XB_XGEN(j)  (2304 + 64 * (j))
#define XB_TOP      3328
#define XB_TOPGEN   3392
#define XCD_BAR_WORDS 3456
#define XB_SPIN_CAP (1u << 18)
__device__ __forceinline__ unsigned xb_ld(unsigned* p)              { return __hip_atomic_load(p, __ATOMIC_RELAXED, __HIP_MEMORY_SCOPE_AGENT); }
__device__ __forceinline__ unsigned xb_add(unsigned* p, unsigned v) { return __hip_atomic_fetch_add(p, v, __ATOMIC_RELAXED, __HIP_MEMORY_SCOPE_AGENT); }
__device__ __forceinline__ unsigned xb_xcc_id() { return (unsigned)__builtin_amdgcn_s_getreg((3 << 11) | 20) & 0xFu; }
#define XB_SPIN(cond, bar) do { unsigned _sp = 0; while (cond) { __builtin_amdgcn_s_sleep(1); \
    if ((++_sp & 255u) == 0u) { if (xb_ld(&(bar)[XB_TMO])) break; if (_sp > XB_SPIN_CAP) { atomicAdd(&(bar)[XB_TMO], 1u); break; } } } } while (0)
struct XcdBarrier { unsigned* bar; unsigned x; volatile LAS unsigned* st; };
__device__ __forceinline__ XcdBarrier xcd_barrier_post(unsigned* bar, volatile LAS unsigned* st) {
    XcdBarrier b; b.bar = bar; b.x = xb_xcc_id(); b.st = st;
    if (threadIdx.x == 0) (void)xb_add(&bar[XB_XCNT(b.x)], 1u);
    return b;
}
__device__ __forceinline__ void xcd_barrier_complete(unsigned* bar, unsigned x, unsigned& nloc, unsigned& nx) {
    const unsigned G = gridDim.x * gridDim.y * gridDim.z;
    unsigned sum, cnt, mine, sp = 0u;
    for (;;) {
        sum = 0u; cnt = 0u; mine = 0u;
#pragma unroll
        for (unsigned j = 0; j < 16; ++j) { const unsigned c = xb_ld(&bar[XB_XCNT(j)]); sum += c; cnt += (c > 0u) ? 1u : 0u; mine = (j == x) ? c : mine; }
        if (sum == G) break;
        __builtin_amdgcn_s_sleep(1);
        if ((++sp & 255u) == 0u) { if (xb_ld(&bar[XB_TMO])) break; if (sp > XB_SPIN_CAP) { atomicAdd(&bar[XB_TMO], 1u); break; } }
    }
    nloc = mine > 0u ? mine : 1u; nx = cnt > 0u ? cnt : 1u;
}
__device__ __forceinline__ void xcd_barrier(const XcdBarrier& b) {
    asm volatile("s_waitcnt vmcnt(0)" ::: "memory");
    __syncthreads();
    if (threadIdx.x == 0) {
        unsigned* bar = b.bar;
        __builtin_amdgcn_s_waitcnt(0);
        unsigned nloc = b.st[0], nx = b.st[1];
        if (nloc == 0u) { xcd_barrier_complete(bar, b.x, nloc, nx); b.st[0] = nloc; b.st[1] = nx; }
        const unsigned old = xb_add(&bar[XB_XSUB(b.x)], 1u);
        const unsigned gen = old / nloc;
        if (old + 1u == (gen + 1u) * nloc) {
            __builtin_amdgcn_fence(__ATOMIC_RELEASE, "agent");
            asm volatile("s_waitcnt vmcnt(0)" ::: "memory");
            const unsigned og = xb_add(&bar[XB_TOP], 1u);
            const unsigned tg = og / nx;
            if (og + 1u == (tg + 1u) * nx) xb_add(&bar[XB_TOPGEN], 1u);
            else XB_SPIN(xb_ld(&bar[XB_TOPGEN]) == tg, bar);
            __builtin_amdgcn_fence(__ATOMIC_ACQUIRE, "agent");
            xb_add(&bar[XB_XGEN(b.x)], 1u);
            asm volatile("s_waitcnt vmcnt(0)" ::: "memory");
        } else {
            XB_SPIN(xb_ld(&bar[XB_XGEN(b.x)]) == gen, bar);
            __builtin_amdgcn_fence(__ATOMIC_ACQUIRE, "agent");
            asm volatile("s_waitcnt vmcnt(0)" ::: "memory");
        }
    }
    __syncthreads();
}

namespace pg8 {
constexpr int BM = 256, BK = 64, HALF = 128, HTB = HALF * BK * 2, STAGE_BYTES = 8 * HTB, NXCD = 8, WGM = 8;
__host__ __device__ __forceinline__ int lds_byte(int r, int c) { const int st = (r >> 4) * 2 + (c >> 5), rr = r & 15, cc = c & 31, ob = rr * 64 + cc * 2; return st * 1024 + (ob ^ (((ob >> 9) & 1) << 5)); }
__host__ __device__ __forceinline__ void stage_rc(int b, int& R, int& C) { const int st = b / 1024, sb = b % 1024, swz = sb ^ (((sb >> 9) & 1) << 5); R = (st >> 1) * 16 + swz / 64; C = (st & 1) * 32 + (swz % 64) / 2; }
__host__ __device__ __forceinline__ int perm32(int rho) { const int n = rho >> 4, i = rho & 15; return 8 * (i >> 2) + 4 * n + (i & 3); }

struct Unit { int pm, pn, e, t, cnt; };
struct Gemm { const bf16_t* A; const bf16_t* Bt; int lda, ldb, K; };

struct StaticOrder {
    static constexpr bool GATHER_A = false;
    int nM, nN, nwg, G, c;
    __device__ void init(int M, int N, int G_, int c_) { nM = M / BM; nN = N / BM; nwg = nM * nN; G = G_; c = c_; }
    __device__ __forceinline__ bool next(int i, Unit& u) const {
        const long L = (long)i * G + c; if (L >= nwg) return false;
        int wgid = (int)L; { const int q = nwg / NXCD, r = nwg % NXCD, xcd = wgid % NXCD, off = wgid / NXCD; wgid = (xcd < r ? xcd * (q + 1) : r * (q + 1) + (xcd - r) * q) + off; }
        const int nig = WGM * nN, gid = wgid / nig, fm = gid * WGM, gsz = (nM - fm) < WGM ? (nM - fm) : WGM;
        u.pm = fm + ((wgid % nig) % gsz); u.pn = (wgid % nig) / gsz; u.e = 0; u.t = 0; u.cnt = 0; return true;
    }
    __device__ __forceinline__ int rowA(const Unit& u, int r) const { return u.pm * BM + r; }
    __device__ __forceinline__ int colA(const Unit&) const { return 0; }
    __device__ __forceinline__ int rowB(const Unit& u, int r) const { return u.pn * BM + r; }
};

template <class Epi, class Sched>
__device__ __forceinline__ void gemm_phase(LAS unsigned char* lds, const Gemm g, const Sched& S, const Epi& E) {
    const int tid = opaque_tid(), wid = __builtin_amdgcn_readfirstlane(tid >> 6), lane = tid & 63, wr = wid >> 2, wc = wid & 3, fr = lane & 15, fq = lane >> 4;
    const int K = g.K, nt = K / BK;
    constexpr bool GA = Sched::GATHER_A;
    int sR[2], sC[2];
    unsigned laneA[2], laneB[2];
#pragma unroll
    for (int i = 0; i < 2; ++i) { int R, C; stage_rc(tid * 16 + i * 8192, R, C); sR[i] = R; sC[i] = C; const int Rb = Epi::PERM ? ((R & ~31) + perm32(R & 31)) : R;
        laneA[i] = (unsigned)(R * g.lda + C) * 2u; laneB[i] = (unsigned)(Rb * g.ldb + C) * 2u; }
    const size_t hstepA = (size_t)HALF * g.lda * 2, hstepB = (size_t)HALF * g.ldb * 2;
    const unsigned ldsw = (unsigned)wid * 1024u;
    const int aoff = lds_byte(wr * 64 + fr, fq * 8), boff = lds_byte(wc * 32 + fr, fq * 8);
    const char* gA = (const char*)g.A; const char* gB = (const char*)g.Bt;
#define PG8_SA(b, h) (((b) * 2 + (h)) * HTB)
#define PG8_SB(b, h) ((4 + (b) * 2 + (h)) * HTB)
#define PG8_STAGE(bufoff, gptr, voff) do { _Pragma("unroll") for (int _i = 0; _i < 2; ++_i) \
        __builtin_amdgcn_global_load_lds((const unsigned*)((gptr) + (size_t)(voff)[_i]), (LAS unsigned*)(lds + (bufoff) + ldsw + _i * 8192), 16, 0, 0); } while (0)
#define PG8_STAGE_B(bufoff, ub, h, kb) PG8_STAGE(bufoff, gB + (ub) + (size_t)(h) * hstepB + (size_t)(kb), laneB)
#define PG8_STAGE_A(bufoff, ub, va, h, kb) do { if constexpr (GA) { PG8_STAGE(bufoff, gA + (size_t)(kb), va[h]); } else { PG8_STAGE(bufoff, gA + (ub) + (size_t)(h) * hstepA + (size_t)(kb), laneA); } } while (0)
#define PG8_LDA(dst, b, h) do { _Pragma("unroll") for (int m = 0; m < 4; ++m) _Pragma("unroll") for (int k = 0; k < 2; ++k) dst[m][k] = *(const LAS bf16x8*)(lds + PG8_SA(b, h) + aoff + m * 2048 + k * 1024); } while (0)
#define PG8_LDB(dst, b, h) do { _Pragma("unroll") for (int n = 0; n < 2; ++n) _Pragma("unroll") for (int k = 0; k < 2; ++k) dst[n][k] = *(const LAS bf16x8*)(lds + PG8_SB(b, h) + boff + n * 2048 + k * 1024); } while (0)
#define PG8_MMA(ai, bj, At, Bt) do { __builtin_amdgcn_s_setprio(1); _Pragma("unroll") for (int m = 0; m < 4; ++m) _Pragma("unroll") for (int n = 0; n < 2; ++n) _Pragma("unroll") for (int k = 0; k < 2; ++k) \
        acc[ai][bj][m][n] = __builtin_amdgcn_mfma_f32_16x16x32_bf16(Bt[n][k], At[m][k], acc[ai][bj][m][n], 0, 0, 0); __builtin_amdgcn_s_setprio(0); } while (0)
#define PG8_WAIT_V(n) asm volatile("s_waitcnt vmcnt(" #n ")" ::: "memory")
#define PG8_WAIT_L(n) asm volatile("s_waitcnt lgkmcnt(" #n ")" ::: "memory")
#define PG8_BAR __builtin_amdgcn_s_barrier()
#define PG8_SCHED __builtin_amdgcn_sched_barrier(0)
#define PG8_OFFS(u, ubA, ubB, vA) do { ubB = ((size_t)S.rowB(u, 0) * (size_t)g.ldb) * 2; \
        if constexpr (GA) { ubA = 0; _Pragma("unroll") for (int _h = 0; _h < 2; ++_h) _Pragma("unroll") for (int _i = 0; _i < 2; ++_i) vA[_h][_i] = ((unsigned)S.rowA(u, _h * HALF + sR[_i]) * (unsigned)g.lda + (unsigned)sC[_i]) * 2u; } \
        else { ubA = ((size_t)S.rowA(u, 0) * (size_t)g.lda + (size_t)S.colA(u)) * 2; } } while (0)
    Unit cur, nxt; int ui = 0;
    if (!S.next(0, cur)) return;
    f32x4 acc[2][2][4][2];
#pragma unroll
    for (int a = 0; a < 2; ++a)
#pragma unroll
        for (int b = 0; b < 2; ++b)
#pragma unroll
            for (int m = 0; m < 4; ++m)
#pragma unroll
                for (int n = 0; n < 2; ++n) acc[a][b][m][n] = (f32x4){0.f, 0.f, 0.f, 0.f};
    bf16x8 At[4][2], B0[2][2], B1[2][2];
    size_t ubAc, ubBc, ubAn, ubBn; unsigned vAc[2][2] = {}, vAn[2][2] = {};
    PG8_OFFS(cur, ubAc, ubBc, vAc);
    PG8_STAGE_B(PG8_SB(0, 0), ubBc, 0, 0); PG8_STAGE_B(PG8_SB(0, 1), ubBc, 1, 0); PG8_STAGE_A(PG8_SA(0, 0), ubAc, vAc, 0, 0); PG8_STAGE_A(PG8_SA(0, 1), ubAc, vAc, 1, 0);
    if (wr == 1) PG8_BAR;
    PG8_WAIT_V(2); PG8_BAR;
    PG8_STAGE_B(PG8_SB(1, 0), ubBc, 0, 128); PG8_STAGE_A(PG8_SA(1, 0), ubAc, vAc, 0, 128); PG8_STAGE_B(PG8_SB(1, 1), ubBc, 1, 128);
    PG8_WAIT_V(6); PG8_BAR;
    for (;;) {
        const bool has_next = S.next(ui + 1, nxt);
        if (has_next) { PG8_OFFS(nxt, ubAn, ubBn, vAn); }
        else { ubAn = ubAc; ubBn = ubBc;
#pragma unroll
            for (int h = 0; h < 2; ++h)
#pragma unroll
                for (int i = 0; i < 2; ++i) vAn[h][i] = vAc[h][i]; }
        for (int t = 0; t < nt; t += 2) {
            const bool last = (t == nt - 2);
            const unsigned k1 = (unsigned)(t + 1) * 128u, k2 = last ? 0u : (unsigned)(t + 2) * 128u, k3 = k2 + 128u;
            const size_t xubA = last ? ubAn : ubAc, xubB = last ? ubBn : ubBc;
            unsigned xA[2][2];
#pragma unroll
            for (int h = 0; h < 2; ++h)
#pragma unroll
                for (int i = 0; i < 2; ++i) xA[h][i] = last ? vAn[h][i] : vAc[h][i];
            PG8_LDB(B0, 0, 0); PG8_LDB(B1, 0, 1); PG8_SCHED; PG8_LDA(At, 0, 0); PG8_STAGE_A(PG8_SA(1, 1), ubAc, vAc, 1, k1);
            PG8_WAIT_V(8); PG8_WAIT_L(0); PG8_BAR; PG8_MMA(0, 0, At, B0); PG8_MMA(0, 1, At, B1); PG8_BAR; PG8_SCHED;
            PG8_LDA(At, 0, 1); PG8_STAGE_B(PG8_SB(0, 0), xubB, 0, k2); PG8_STAGE_B(PG8_SB(0, 1), xubB, 1, k2); PG8_STAGE_A(PG8_SA(0, 0), xubA, xA, 0, k2);
            PG8_WAIT_V(8); PG8_WAIT_L(0); PG8_BAR; PG8_MMA(1, 0, At, B0); PG8_MMA(1, 1, At, B1); PG8_BAR; PG8_SCHED;
            PG8_LDB(B0, 1, 0); PG8_LDB(B1, 1, 1); PG8_SCHED; PG8_LDA(At, 1, 0); PG8_STAGE_A(PG8_SA(0, 1), xubA, xA, 1, k2);
            PG8_WAIT_V(8); PG8_WAIT_L(0); PG8_BAR; PG8_MMA(0, 0, At, B0); PG8_MMA(0, 1, At, B1); PG8_BAR; PG8_SCHED;
            PG8_LDA(At, 1, 1); PG8_STAGE_B(PG8_SB(1, 0), xubB, 0, k3); PG8_STAGE_B(PG8_SB(1, 1), xubB, 1, k3); PG8_STAGE_A(PG8_SA(1, 0), xubA, xA, 0, k3);
            PG8_WAIT_V(8); PG8_WAIT_L(0); PG8_BAR; PG8_MMA(1, 0, At, B0); PG8_MMA(1, 1, At, B1); PG8_BAR; PG8_SCHED;
        }
        if (wr == 0) PG8_BAR;
        E(acc, cur, wr, wc, fr, fq);
        if (!has_next) break;
#pragma unroll
        for (int a = 0; a < 2; ++a)
#pragma unroll
            for (int b = 0; b < 2; ++b)
#pragma unroll
                for (int m = 0; m < 4; ++m)
#pragma unroll
                    for (int n = 0; n < 2; ++n) acc[a][b][m][n] = (f32x4){0.f, 0.f, 0.f, 0.f};
        cur = nxt; ++ui; ubAc = ubAn; ubBc = ubBn;
#pragma unroll
        for (int h = 0; h < 2; ++h)
#pragma unroll
            for (int i = 0; i < 2; ++i) vAc[h][i] = vAn[h][i];
        if (wr == 1) PG8_BAR;
    }
    PG8_WAIT_V(0);
    PG8_BAR;
#undef PG8_SA
#undef PG8_SB
#undef PG8_STAGE
#undef PG8_STAGE_A
#undef PG8_STAGE_B
#undef PG8_LDA
#undef PG8_LDB
#undef PG8_MMA
#undef PG8_WAIT_V
#undef PG8_WAIT_L
#undef PG8_BAR
#undef PG8_SCHED
#undef PG8_OFFS
}
}
namespace pg8 {
struct EpiBf16 {
    static constexpr bool PERM = true;
    bf16_t* O; int ldc; int split_cols; size_t split_stride; float scale0;
    __device__ __forceinline__ void operator()(const f32x4 (&acc)[2][2][4][2], const Unit& u, int wr, int wc, int fr, int fq) const {
        const int row0 = u.pm * BM + wr * 64 + fr; int colt = u.pn * BM; bf16_t* base = O;
        float sc = 1.f; if (split_cols) { const int t = colt / split_cols; base += (size_t)t * split_stride; colt -= t * split_cols; if (t == 0) sc = scale0; }
        const int col0 = colt + wc * 32 + 8 * fq;
#pragma unroll
        for (int ai = 0; ai < 2; ++ai)
#pragma unroll
            for (int m = 0; m < 4; ++m) { bf16_t* rowp = base + (size_t)(row0 + ai * HALF + m * 16) * ldc + col0;
#pragma unroll
                for (int bj = 0; bj < 2; ++bj) { const f32x4 v0 = acc[ai][bj][m][0] * sc, v1 = acc[ai][bj][m][1] * sc;
                    u32x4 w; w.x = cvt_pk_bf16(v0[0], v0[1]); w.y = cvt_pk_bf16(v0[2], v0[3]); w.z = cvt_pk_bf16(v1[0], v1[1]); w.w = cvt_pk_bf16(v1[2], v1[3]);
                    *(u32x4*)(rowp + bj * HALF) = w; } }
    }
};
struct EpiFilt {
    static constexpr bool PERM = false;
    float* O;
    __device__ __forceinline__ void operator()(const f32x4 (&acc)[2][2][4][2], const Unit& u, int wr, int wc, int fr, int fq) const {
        const float dmin = -3.0701134573253945f, dmax = -15.350567286626973f;
#pragma unroll
        for (int ai = 0; ai < 2; ++ai)
#pragma unroll
            for (int m = 0; m < 4; ++m) { const int row = u.pm * BM + ai * HALF + wr * 64 + m * 16 + fr; const int c = row & 1023;
                const float delta = fabsf(dmin + (float)c * ((dmax - dmin) / 1023.0f));
#pragma unroll
                for (int bj = 0; bj < 2; ++bj)
#pragma unroll
                    for (int n = 0; n < 2; ++n) { const int col = u.pn * BM + bj * HALF + wc * 32 + n * 16 + 4 * fq; f32x4 v = acc[ai][bj][m][n];
#pragma unroll
                        for (int j = 0; j < 4; ++j) v[j] *= __expf(-(float)(col + j) * (1.0f / 8191.0f) * delta);
                        *(f32x4*)(O + (size_t)row * 8192 + col) = v; }
                asm volatile("" ::: "memory"); }
    }
};
struct EpiResF32 {
    static constexpr bool PERM = false;
    const float* res; float* O; int ldc; float alpha;
    __device__ __forceinline__ void operator()(const f32x4 (&acc)[2][2][4][2], const Unit& u, int wr, int wc, int fr, int fq) const {
#pragma unroll
        for (int ai = 0; ai < 2; ++ai)
#pragma unroll
            for (int m = 0; m < 4; ++m) { const size_t off = (size_t)(u.pm * BM + ai * HALF + wr * 64 + m * 16 + fr) * ldc + u.pn * BM + wc * 32 + 4 * fq;
#pragma unroll
                for (int bj = 0; bj < 2; ++bj)
#pragma unroll
                    for (int n = 0; n < 2; ++n) { const f32x4 r = *(const f32x4*)(res + off + bj * HALF + n * 16); *(f32x4*)(O + off + bj * HALF + n * 16) = r * alpha + acc[ai][bj][m][n]; }
                if (m & 1) asm volatile("" ::: "memory"); }
    }
};
struct EpiSwiglu {
    static constexpr bool PERM = true;
    bf16_t* O;
    __device__ __forceinline__ void operator()(const f32x4 (&acc)[2][2][4][2], const Unit& u, int wr, int wc, int fr, int fq) const {
#pragma unroll
        for (int ai = 0; ai < 2; ++ai)
#pragma unroll
            for (int m = 0; m < 4; ++m) { bf16_t* p = O + (size_t)(u.pm * BM + ai * HALF + wr * 64 + m * 16 + fr) * DFF + u.pn * HALF + wc * 32 + 8 * fq;
                float h[8];
#pragma unroll
                for (int n = 0; n < 2; ++n)
#pragma unroll
                    for (int j = 0; j < 4; ++j) { const float gt = acc[ai][0][m][n][j], up = acc[ai][1][m][n][j]; h[n * 4 + j] = gt * sigmoidf_(gt) * up; }
                u32x4 w; w.x = cvt_pk_bf16(h[0], h[1]); w.y = cvt_pk_bf16(h[2], h[3]); w.z = cvt_pk_bf16(h[4], h[5]); w.w = cvt_pk_bf16(h[6], h[7]);
                *(u32x4*)p = w; }
    }
};
struct EpiDown {
    static constexpr bool PERM = true;
    bf16_t* O; const int* rowlist; const float* gatew;
    __device__ __forceinline__ void operator()(const f32x4 (&acc)[2][2][4][2], const Unit& u, int wr, int wc, int fr, int fq) const {
#pragma unroll
        for (int ai = 0; ai < 2; ++ai)
#pragma unroll
            for (int m = 0; m < 4; ++m) { const int idx = u.t * BM + ai * HALF + wr * 64 + m * 16 + fr;
                if (idx < u.cnt) { const int a = rowlist[(size_t)u.e * ECAP + idx]; const float gw = gatew[a];
                    bf16_t* p = O + (size_t)a * DM + u.pn * BM + wc * 32 + 8 * fq;
#pragma unroll
                    for (int bj = 0; bj < 2; ++bj) { const f32x4 v0 = acc[ai][bj][m][0] * gw, v1 = acc[ai][bj][m][1] * gw;
                        u32x4 w; w.x = cvt_pk_bf16(v0[0], v0[1]); w.y = cvt_pk_bf16(v0[2], v0[3]); w.z = cvt_pk_bf16(v1[0], v1[1]); w.w = cvt_pk_bf16(v1[2], v1[3]);
                        *(u32x4*)(p + bj * HALF) = w; } } }
    }
};
struct EpiRG {
    static constexpr bool PERM = true;
    bf16_t* LA; bf16_t* BB; const bf16_t* XC; const float* ba; const float* bx; const float* lam;
    __device__ __forceinline__ void operator()(const f32x4 (&acc)[2][2][4][2], const Unit& u, int wr, int wc, int fr, int fq) const {
        const int nb = u.pn >> 2, q = u.pn & 3, dir = q >> 1, half = q & 1;
        const int ch0 = nb * 256 + half * HALF + wc * 32 + 8 * fq;
        float vba[8], vbx[8], vsp[8];
#pragma unroll
        for (int j = 0; j < 8; ++j) { vba[j] = ba[dir * DM + ch0 + j]; vbx[j] = bx[dir * DM + ch0 + j];
            const float x = __expf(-lam[dir * DM + ch0 + j]);
            vsp[j] = 8.0f * (x < 0.05f ? x * (1.0f - x * (0.5f - x * (0.33333334f - 0.25f * x))) : __logf(1.0f + x)); }
#pragma unroll
        for (int ai = 0; ai < 2; ++ai)
#pragma unroll
            for (int m = 0; m < 4; ++m) { const size_t tok = (size_t)(u.pm * BM + ai * HALF + wr * 64 + m * 16 + fr);
                asm volatile("" ::: "memory");
                const u32x4 xw = *(const u32x4*)(XC + tok * DM + ch0);
                float xf[8] = {bflo(xw.x), bfhi(xw.x), bflo(xw.y), bfhi(xw.y), bflo(xw.z), bfhi(xw.z), bflo(xw.w), bfhi(xw.w)};
                float la[8], bb[8];
#pragma unroll
                for (int n = 0; n < 2; ++n)
#pragma unroll
                    for (int j = 0; j < 4; ++j) { const int k = n * 4 + j;
                        const float r = sigmoidf_(acc[ai][0][m][n][j] + vba[k]), ig = sigmoidf_(acc[ai][1][m][n][j] + vbx[k]);
                        const float l = -r * vsp[k]; la[k] = l; bb[k] = sqrtf(fmaxf(1.0f - __expf(2.0f * l), 0.f)) * (ig * xf[k]); }
                u32x4 w; w.x = cvt_pk_bf16(la[0], la[1]); w.y = cvt_pk_bf16(la[2], la[3]); w.z = cvt_pk_bf16(la[4], la[5]); w.w = cvt_pk_bf16(la[6], la[7]);
                *(u32x4*)(LA + ((size_t)dir * NTOK + tok) * DM + ch0) = w;
                w.x = cvt_pk_bf16(bb[0], bb[1]); w.y = cvt_pk_bf16(bb[2], bb[3]); w.z = cvt_pk_bf16(bb[4], bb[5]); w.w = cvt_pk_bf16(bb[6], bb[7]);
                *(u32x4*)(BB + ((size_t)dir * NTOK + tok) * DM + ch0) = w; }
    }
};

struct RGOrder {
    static constexpr bool GATHER_A = false;
    int G, c;
    __device__ __forceinline__ bool next(int i, Unit& u) const { const int L = i * G + c; if (L >= 64 * 32) return false; u.pm = L >> 5; u.pn = L & 31; u.e = 0; u.t = 0; u.cnt = 0; return true; }
    __device__ __forceinline__ int rowA(const Unit& u, int r) const { return u.pm * BM + r; }
    __device__ __forceinline__ int colA(const Unit& u) const { return (u.pn >> 2) * 256; }
    __device__ __forceinline__ int rowB(const Unit& u, int r) const { return u.pn * BM + r; }
};
template <int NPN, bool GATHER>
struct MoeOrder {
    static constexpr bool GATHER_A = GATHER;
    int G, c; const LAS int* tab; const int* rowlist;
    __device__ __forceinline__ bool next(int i, Unit& u) const {
        const int L = i * G + c, ntile = tab[32]; if (L >= ntile * NPN) return false;
        const int tile = L / NPN; u.pm = tile; u.pn = L % NPN; int e = 0;
        while (e < 31 && tab[e + 1] <= tile) ++e;
        u.e = e; u.t = tile - tab[e]; u.cnt = tab[64 + e]; return true;
    }
    __device__ __forceinline__ int rowA(const Unit& u, int r) const {
        if (GATHER) { const int idx = u.t * BM + r; const int a = idx < u.cnt ? rowlist[(size_t)u.e * ECAP + idx] : 0; return a >> 1; }
        return u.pm * BM + r;
    }
    __device__ __forceinline__ int colA(const Unit&) const { return 0; }
    __device__ __forceinline__ int rowB(const Unit& u, int r) const { return (u.e * NPN + u.pn) * BM + r; }
};
}
namespace att {
constexpr int NW = 8, QBLK = 32, KVBLK = 64, LDQ = 1024, LDK = 1024, LDV = 1024, LDO = 1024;
constexpr int SHM_V = KVBLK * 128 * 2, SHM_K = KVBLK * 64 * 2, SHM_ATTN = 2 * SHM_V + 2 * SHM_K + NW * 64 * 4;
constexpr float THR2 = 8.0f * 1.4426950408889634f;
#define KSWZ64(row, colB) ((row) * 128 + ((colB) ^ ((((row) >> 1) & 7) << 4)))
#define SBAR() __builtin_amdgcn_sched_barrier(0)
__device__ __forceinline__ int crow(int r, int hi) { return (r & 3) + 8 * (r >> 2) + 4 * hi; }
__device__ __forceinline__ void partialSM(f32x16& p0, f32x16& p1, float& m_reg, float& mn, float& alpha, float fd, float sl2) {
#pragma unroll
    for (int r = 0; r < 16; ++r) { const float d0 = fd - (float)((r & 3) + 8 * (r >> 2)); p0[r] = fmaf(fabsf(d0), -sl2, p0[r]); p1[r] = fmaf(fabsf(d0 - 32.0f), -sl2, p1[r]); }
    float pmax = p0[0];
#pragma unroll
    for (int r = 1; r < 16; ++r) pmax = fmaxf(pmax, p0[r]);
#pragma unroll
    for (int r = 0; r < 16; ++r) pmax = fmaxf(pmax, p1[r]);
    { auto rr = __builtin_amdgcn_permlane32_swap(__float_as_uint(pmax), __float_as_uint(pmax), false, false); pmax = fmaxf(__uint_as_float(rr[0]), __uint_as_float(rr[1])); }
    if (__builtin_expect(__all(pmax - m_reg <= THR2), 1)) { mn = m_reg; alpha = 1.f; }
    else { mn = fmaxf(m_reg, pmax); alpha = __builtin_amdgcn_exp2f(m_reg - mn); m_reg = mn; }
#pragma unroll
    for (int r = 0; r < 16; ++r) { p0[r] -= mn; p1[r] -= mn; }
#pragma unroll
    for (int r = 0; r < 16; ++r) p0[r] = __builtin_amdgcn_exp2f(p0[r]);
}
__device__ __forceinline__ void finishSM(f32x16& p0, f32x16& p1, float alpha, float& l_reg, bf16x8& pa0, bf16x8& pa1, bf16x8& pa2, bf16x8& pa3) {
#pragma unroll
    for (int r = 0; r < 16; ++r) p1[r] = __builtin_amdgcn_exp2f(p1[r]);
    float ps = 0;
#pragma unroll
    for (int r = 0; r < 16; ++r) ps += p0[r];
#pragma unroll
    for (int r = 0; r < 16; ++r) ps += p1[r];
    { auto rr = __builtin_amdgcn_permlane32_swap(__float_as_uint(ps), __float_as_uint(ps), false, false); ps = __uint_as_float(rr[0]) + __uint_as_float(rr[1]); }
    l_reg = l_reg * alpha + ps;
#define PK4(P, BASE, OUT) do { unsigned a0 = cvt_pk_bf16(P[BASE + 0], P[BASE + 1]), a1 = cvt_pk_bf16(P[BASE + 2], P[BASE + 3]);   \
    unsigned b0 = cvt_pk_bf16(P[BASE + 4], P[BASE + 5]), b1 = cvt_pk_bf16(P[BASE + 6], P[BASE + 7]);                              \
    auto r0 = __builtin_amdgcn_permlane32_swap(a0, b0, false, false); auto r1 = __builtin_amdgcn_permlane32_swap(a1, b1, false, false); \
    u32x4 w = {r0[0], r1[0], r0[1], r1[1]}; OUT = __builtin_bit_cast(bf16x8, w); } while (0)
    PK4(p0, 0, pa0); PK4(p0, 8, pa1); PK4(p1, 0, pa2); PK4(p1, 8, pa3);
#undef PK4
}
__device__ __forceinline__ void qkt(f32x16& p0, f32x16& p1, const char* Ks, const bf16x8* qr, int r32, int hi) {
    p0 = f32x16{}; p1 = f32x16{};
#pragma unroll
    for (int d0 = 0; d0 < 4; ++d0) { const int cb = (d0 * 16 + hi * 8) * 2;
        const bf16x8 b0 = *reinterpret_cast<const bf16x8*>(Ks + KSWZ64(r32, cb));
        const bf16x8 b1 = *reinterpret_cast<const bf16x8*>(Ks + KSWZ64(32 + r32, cb));
        p0 = __builtin_amdgcn_mfma_f32_32x32x16_bf16(b0, qr[d0], p0, 0, 0, 0);
        p1 = __builtin_amdgcn_mfma_f32_32x32x16_bf16(b1, qr[d0], p1, 0, 0, 0); }
}
__device__ __forceinline__ int v_st(int k, int c) { const int kk = (k & ~0xC) | ((k & 4) << 1) | ((k & 8) >> 1); return ((kk >> 3) * 4 + (c >> 5)) * 512 + ((kk & 7) * 32 + (c & 31)) * 2; }
__device__ __forceinline__ int v_rd_base(int lane) { return ((lane & 3) << 3) | (((lane >> 2) & 3) << 6) | (((lane >> 4) & 1) << 5) | (((lane >> 5) & 1) << 8); }
constexpr int v_rd_off(int d0, int ks, int half) { return d0 * 512 + ks * 4096 + half * 2048; }
template <int OFF> __device__ __forceinline__ s16x4 tr_read(int vb) {
    s16x4 r; asm volatile("ds_read_b64_tr_b16 %0, %1 offset:%2" : "=&v"(r) : "v"(vb), "i"(OFF) : "memory"); return r;
}
template <int D0> __device__ __forceinline__ void pv_one(f32x16& od, int vb, bf16x8 pa0, bf16x8 pa1, bf16x8 pa2, bf16x8 pa3) {
    const s16x4 l0 = tr_read<v_rd_off(D0, 0, 0)>(vb), h0 = tr_read<v_rd_off(D0, 0, 1)>(vb), l1 = tr_read<v_rd_off(D0, 1, 0)>(vb), h1 = tr_read<v_rd_off(D0, 1, 1)>(vb);
    const s16x4 l2 = tr_read<v_rd_off(D0, 2, 0)>(vb), h2 = tr_read<v_rd_off(D0, 2, 1)>(vb), l3 = tr_read<v_rd_off(D0, 3, 0)>(vb), h3 = tr_read<v_rd_off(D0, 3, 1)>(vb);
    asm volatile("s_waitcnt lgkmcnt(0)" ::: "memory"); SBAR();
#define PK(L, H) (bf16x8){L[0], L[1], L[2], L[3], H[0], H[1], H[2], H[3]}
    od = __builtin_amdgcn_mfma_f32_32x32x16_bf16(pa0, PK(l0, h0), od, 0, 0, 0);
    od = __builtin_amdgcn_mfma_f32_32x32x16_bf16(pa1, PK(l1, h1), od, 0, 0, 0);
    od = __builtin_amdgcn_mfma_f32_32x32x16_bf16(pa2, PK(l2, h2), od, 0, 0, 0);
    od = __builtin_amdgcn_mfma_f32_32x32x16_bf16(pa3, PK(l3, h3), od, 0, 0, 0);
#undef PK
}
__device__ __forceinline__ void pv_d0(f32x16* o, int vb, bf16x8 pa0, bf16x8 pa1, bf16x8 pa2, bf16x8 pa3) {
    pv_one<0>(o[0], vb, pa0, pa1, pa2, pa3); pv_one<1>(o[1], vb, pa0, pa1, pa2, pa3); pv_one<2>(o[2], vb, pa0, pa1, pa2, pa3); pv_one<3>(o[3], vb, pa0, pa1, pa2, pa3);
}
__device__ __forceinline__ void attn_unit(const bf16_t* __restrict__ Qb, const bf16_t* __restrict__ Kh, const bf16_t* __restrict__ Vh, bf16_t* __restrict__ Ob, int q0, int seq, float sl2, char* lds) {
    const int tid = opaque_tid(), wid = tid >> 6, lane = tid & 63, r32 = lane & 31, hi = lane >> 5;
    char* V_lds = lds; char* K_lds = lds + 2 * SHM_V;
    float* ws = (float*)(lds + 2 * SHM_V + 2 * SHM_K) + wid * 64; float* li_l = ws; float* al_l = ws + 32;
    float m_reg = -1e30f, l_reg = 0; f32x16 o[4] = {}; bf16x8 qr[4];
    const bf16_t* Qw = Qb + (long)(wid * QBLK + r32) * LDQ + hi * 8;
#pragma unroll
    for (int d0 = 0; d0 < 4; ++d0) qr[d0] = *reinterpret_cast<const bf16x8*>(Qw + d0 * 16);
    const int sr = tid >> 4, sc = (tid & 15) * 8, vst0 = v_st(sr, sc), vst1 = v_st(32 + sr, sc);
    const int kr = tid >> 3, kc = (tid & 7) * 8, kst = KSWZ64(kr, kc * 2);
    const int vb0 = (int)(uintptr_t)V_lds + v_rd_base(lane);
    const float fq0 = (float)(q0 + wid * QBLK + r32 - 4 * hi);
    struct { bf16x8 vs0, vs1, ks; } sr_[2];
#define SLOAD(i, k0) do { sr_[i].vs0 = *reinterpret_cast<const bf16x8*>(&Vh[(long)((k0) + sr) * LDV + sc]); sr_[i].vs1 = *reinterpret_cast<const bf16x8*>(&Vh[(long)((k0) + 32 + sr) * LDV + sc]); \
    sr_[i].ks = *reinterpret_cast<const bf16x8*>(&Kh[(long)((k0) + kr) * LDK + kc]); } while (0)
#define SWRITE(b, i) do { *(bf16x8*)(V_lds + (b) * SHM_V + vst0) = sr_[i].vs0; *(bf16x8*)(V_lds + (b) * SHM_V + vst1) = sr_[i].vs1; \
    *(bf16x8*)(K_lds + (b) * SHM_K + kst) = sr_[i].ks; } while (0)
#define SWAIT() asm volatile("s_waitcnt vmcnt(3)" ::: "memory")
#define RESC(a) do { if (__any((a) < 1.f)) { if (hi == 0) al_l[r32] = (a); asm volatile("s_waitcnt lgkmcnt(0)" ::: "memory"); \
    _Pragma("unroll") for (int d = 0; d < 4; ++d) _Pragma("unroll") for (int r = 0; r < 16; ++r) o[d][r] *= al_l[crow(r, hi)]; } } while (0)
    f32x16 pA0, pA1, pB0, pB1; float mnA, mnB, alA, alB; bf16x8 pa0, pa1, pa2, pa3; const int NT = seq / KVBLK;
    constexpr int SE = 0, SO = 1;
    SLOAD(SE, 0); asm volatile("s_waitcnt vmcnt(0)" ::: "memory"); SWRITE(0, SE); __syncthreads();
    qkt(pA0, pA1, K_lds, qr, r32, hi); partialSM(pA0, pA1, m_reg, mnA, alA, fq0, sl2);
    SLOAD(SO, KVBLK); if (2 < NT) SLOAD(SE, 2 * KVBLK);
    SWAIT(); SWRITE(1, SO); __syncthreads();
    for (int j = 1; j + 1 < NT; j += 2) {
        SBAR(); qkt(pB0, pB1, K_lds + SHM_K, qr, r32, hi);
        finishSM(pA0, pA1, alA, l_reg, pa0, pa1, pa2, pa3); SBAR();
        SLOAD(SO, (j + 2) * KVBLK); SBAR();
        pv_d0(o, vb0, pa0, pa1, pa2, pa3); partialSM(pB0, pB1, m_reg, mnB, alB, fq0 - (float)(j * KVBLK), sl2);
        __syncthreads(); SWAIT(); SWRITE(0, SE);
        RESC(alB); __syncthreads();
        SBAR(); qkt(pA0, pA1, K_lds, qr, r32, hi);
        finishSM(pB0, pB1, alB, l_reg, pa0, pa1, pa2, pa3); SBAR();
        if (j + 3 < NT) SLOAD(SE, (j + 3) * KVBLK); SBAR();
        pv_d0(o, vb0 + SHM_V, pa0, pa1, pa2, pa3); partialSM(pA0, pA1, m_reg, mnA, alA, fq0 - (float)((j + 1) * KVBLK), sl2);
        __syncthreads(); SWAIT(); SWRITE(1, SO);
        RESC(alA); __syncthreads();
    }
    SBAR(); qkt(pB0, pB1, K_lds + SHM_K, qr, r32, hi);
    finishSM(pA0, pA1, alA, l_reg, pa0, pa1, pa2, pa3); SBAR();
    pv_d0(o, vb0, pa0, pa1, pa2, pa3); partialSM(pB0, pB1, m_reg, mnB, alB, fq0 - (float)((NT - 1) * KVBLK), sl2);
    __syncthreads(); RESC(alB);
    finishSM(pB0, pB1, alB, l_reg, pa0, pa1, pa2, pa3); SBAR();
    pv_d0(o, vb0 + SHM_V, pa0, pa1, pa2, pa3);
    if (hi == 0) li_l[r32] = l_reg; asm volatile("s_waitcnt lgkmcnt(0)" ::: "memory");
    float rli[16];
#pragma unroll
    for (int r = 0; r < 16; ++r) rli[r] = __builtin_amdgcn_rcpf(li_l[crow(r, hi)]);
    bf16_t* Ow = Ob + (long)(wid * QBLK) * LDO;
#pragma unroll
    for (int r = 0; r < 16; ++r) { const int orow = crow(r, hi);
#pragma unroll
        for (int d0 = 0; d0 < 4; ++d0) Ow[(long)orow * LDO + d0 * 32 + r32] = (bf16_t)f2bf(o[d0][r] * rli[r]); }
    __syncthreads();
#undef SLOAD
#undef SWRITE
#undef SWAIT
#undef RESC
}
#undef SBAR
}

namespace hy {
struct cf { float x, y; };
__device__ __forceinline__ cf lld(const LAS f32x2* L, int i) { const f32x2 t = L[i]; return cf{t[0], t[1]}; }
__device__ __forceinline__ void lst(LAS f32x2* L, int i, cf v) { L[i] = (f32x2){v.x, v.y}; }
__device__ __forceinline__ cf cmul(cf a, cf b) { return cf{a.x * b.x - a.y * b.y, a.x * b.y + a.y * b.x}; }
__device__ __forceinline__ cf cmulc(cf a, cf b) { return cf{a.x * b.x + a.y * b.y, a.y * b.x - a.x * b.y}; }
__device__ constexpr float C32[16] = {1.0f, 0.98078528040323043f, 0.92387953251128674f, 0.83146961230254524f, 0.70710678118654757f, 0.55557023301960229f, 0.38268343236508984f, 0.19509032201612833f,
                                      0.0f, -0.19509032201612819f, -0.38268343236508973f, -0.55557023301960196f, -0.70710678118654746f, -0.83146961230254535f, -0.92387953251128674f, -0.98078528040323043f};
__device__ constexpr float S32[16] = {0.0f, 0.19509032201612825f, 0.38268343236508978f, 0.55557023301960218f, 0.70710678118654746f, 0.83146961230254524f, 0.92387953251128674f, 0.98078528040323043f,
                                      1.0f, 0.98078528040323043f, 0.92387953251128674f, 0.83146961230254546f, 0.70710678118654757f, 0.55557023301960218f, 0.38268343236508989f, 0.19509032201612861f};
__host__ __device__ constexpr int brev(int k, int bits) { int r = 0; for (int i = 0; i < bits; ++i) r |= ((k >> i) & 1) << (bits - 1 - i); return r; }
template <int R, bool INV> __device__ __forceinline__ void dft_reg(cf (&v)[R]) {
#pragma unroll
    for (int s = R / 2; s >= 1; s >>= 1) {
#pragma unroll
        for (int g0 = 0; g0 < R; g0 += 2 * s) {
#pragma unroll
            for (int j = 0; j < s; ++j) {
                const cf a = v[g0 + j], b = v[g0 + j + s];
                v[g0 + j] = cf{a.x + b.x, a.y + b.y};
                const cf d = cf{a.x - b.x, a.y - b.y};
                const int tw = j * (16 / s);
                if (tw == 0) v[g0 + j + s] = d;
                else if (tw == 8) v[g0 + j + s] = INV ? cf{-d.y, d.x} : cf{d.y, -d.x};
                else { const float c = C32[tw], sn = S32[tw]; v[g0 + j + s] = INV ? cf{d.x * c - d.y * sn, d.y * c + d.x * sn} : cf{d.x * c + d.y * sn, d.y * c - d.x * sn}; }
            }
        }
    }
}
constexpr int RS = FFT_RS;
__device__ __forceinline__ void fft_fwd12(cf (&v)[32], LAS f32x2* L, int tid) {
    dft_reg<32, false>(v);
    { float s, c; sincospif((float)tid * (1.0f / 8192.0f), &s, &c); cf w1{c, -s}; asm volatile("" : "+v"(w1.x), "+v"(w1.y)); cf w = w1;
#pragma unroll
      for (int k1 = 0; k1 < 32; ++k1) { cf x = v[brev(k1, 5)]; if (k1) { x = cmul(x, w); w = cmul(w, w1); } lst(L, k1 * RS + tid, x); } }
    __syncthreads();
    const int k1 = tid >> 4, m2 = tid & 15;
#pragma unroll
    for (int m1 = 0; m1 < 32; ++m1) v[m1] = lld(L, k1 * RS + 16 * m1 + m2);
    __syncthreads();
    dft_reg<32, false>(v);
    { float s, c; sincospif((float)m2 * (1.0f / 256.0f), &s, &c); cf w1{c, -s}; asm volatile("" : "+v"(w1.x), "+v"(w1.y)); cf w = w1;
#pragma unroll
      for (int j1 = 0; j1 < 32; ++j1) { cf x = v[brev(j1, 5)]; if (j1) { x = cmul(x, w); w = cmul(w, w1); } lst(L, k1 * RS + 33 * m2 + j1, x); } }
    __syncthreads();
}
__device__ __forceinline__ void fft_inv21(cf (&v)[32], LAS f32x2* L, int tid) {
    const int k1 = tid >> 4, m2 = tid & 15;
    { float s, c; sincospif((float)m2 * (1.0f / 256.0f), &s, &c); cf w1{c, -s}; asm volatile("" : "+v"(w1.x), "+v"(w1.y)); cf w = w1;
#pragma unroll
      for (int j1 = 0; j1 < 32; ++j1) { cf x = lld(L, k1 * RS + 33 * m2 + j1); if (j1) { x = cmulc(x, w); w = cmul(w, w1); } v[j1] = x; } }
    __syncthreads();
    dft_reg<32, true>(v);
#pragma unroll
    for (int m1 = 0; m1 < 32; ++m1) lst(L, k1 * RS + 16 * m1 + m2, v[brev(m1, 5)]);
    __syncthreads();
    { float s, c; sincospif((float)tid * (1.0f / 8192.0f), &s, &c); cf w1{c, -s}; asm volatile("" : "+v"(w1.x), "+v"(w1.y)); cf w = w1;
#pragma unroll
      for (int kk = 0; kk < 32; ++kk) { cf x = lld(L, kk * RS + tid); if (kk) { x = cmulc(x, w); w = cmul(w, w1); } v[kk] = x; } }
    dft_reg<32, true>(v);
}
}
constexpr size_t MiB = 1u << 20;
constexpr size_t WS_CTL = 0, CTL_ZERO_BYTES = 1 * MiB;
constexpr size_t WS_W1T = 1 * MiB;
constexpr size_t WS_W2T = 257 * MiB;
constexpr size_t WS_WIN_EV = 385 * MiB, WS_WOUT_EV = 409 * MiB, WS_WIN_OD = 417 * MiB, WS_WOUT_OD = 433 * MiB, WS_WG_OD = 441 * MiB;
constexpr size_t AR = 445 * MiB;
constexpr size_t A_XB = AR + 0 * MiB, A_UHT = AR + 64 * MiB, A_QB = AR + 160 * MiB, A_KB = AR + 192 * MiB, A_VB = AR + 224 * MiB, A_KTD = AR + 256 * MiB, A_KF = AR + 384 * MiB,
                 A_H3B = AR + 512 * MiB, A_W4T = AR + 514 * MiB, A_YHT = AR + 256 * MiB, A_OA = AR + 288 * MiB, A_YCAT = AR + 0 * MiB, A_R0 = AR + 64 * MiB, A_H1_0 = AR + 192 * MiB,
                 A_HB_0 = AR + 320 * MiB, A_HID_0 = AR + 384 * MiB, A_ROWL = AR + 424 * MiB, A_GATEW = AR + 428 * MiB, A_Y2_0 = AR + 0 * MiB, A_H2 = AR + 448 * MiB, A_HB2 = AR + 128 * MiB;
constexpr size_t A_GB = AR + 0 * MiB, A_XR = AR + 64 * MiB, A_XC = AR + 192 * MiB, A_LA = AR + 256 * MiB, A_BB = AR + 64 * MiB, A_CAR = AR + 384 * MiB, A_YG = AR + 192 * MiB, A_R1 = AR + 256 * MiB,
                 A_H1_1 = AR + 0 * MiB, A_HB_1 = AR + 128 * MiB, A_HID_1 = AR + 192 * MiB, A_Y2_1 = AR + 256 * MiB;
constexpr size_t WS_END = AR + 576 * MiB;
constexpr int CW_BAR = 4096, CW_CNT = 16384;
constexpr int LDS_MISC = 139264, LDS_BYTES = 147456;
constexpr int NPHASE = 21;

struct Args { const float* in[37]; float* out; unsigned char* ws; int ph_lo, ph_hi; };
typedef const __attribute__((address_space(4))) Args& KArgs;

__device__ __forceinline__ void transpose_item(const float* W, int N, int k0, int n0, bf16_t* WT, int ldk, int drow0, LAS float* scr, int lane) {
#pragma unroll 8
    for (int i = 0; i < 32; ++i) { const int kk = 2 * i + (lane >> 5); scr[kk * 33 + (lane & 31)] = W[(size_t)(k0 + kk) * N + n0 + (lane & 31)]; }
    LDS_WAIT(); asm volatile("" ::: "memory");
    const int c = lane & 7;
#pragma unroll
    for (int j = 0; j < 4; ++j) { const int n = (lane >> 3) + 8 * j; const LAS float* s = scr + (8 * c) * 33 + n;
        u32x4 o; o.x = pk2(s[0 * 33], s[1 * 33]); o.y = pk2(s[2 * 33], s[3 * 33]); o.z = pk2(s[4 * 33], s[5 * 33]); o.w = pk2(s[6 * 33], s[7 * 33]);
        *(u32x4*)(WT + (size_t)(drow0 + n) * ldk + k0 + 8 * c) = o; }
    LDS_WAIT(); asm volatile("" ::: "memory");
}

__device__ __forceinline__ void phase_prologue(KArgs a, LAS unsigned char* lds) {
    const int tid = opaque_tid(), lane = tid & 63, wave = tid >> 6, G = gridDim.x;
    const int gw = blockIdx.x * 8 + wave, NGW = G * 8;
    unsigned char* ws = a.ws;
    LAS float* scr = (LAS float*)(lds + wave * 16384);
    constexpr int I_EVIN = 32 * 192, I_SQ = 32 * 64, I_ODIN = 32 * 128, I_MOE_GU = 64 * 512, I_MOE_D = 64 * 512, I_RG = 16 * 32, I_W4 = 128;
    constexpr int O1 = I_EVIN, O2 = O1 + I_SQ, O3 = O2 + I_ODIN, O4 = O3 + I_SQ, O5 = O4 + I_MOE_GU, O6 = O5 + I_MOE_GU, O7 = O6 + I_MOE_D, O8 = O7 + I_RG, O9 = O8 + I_RG, O10 = O9 + I_W4;
    for (int it = gw; it < O10; it += NGW) {
        if (it < O1) { const int kb = it / 192, nb = it % 192; transpose_item(a.in[1], EV_IN, kb * 64, nb * 32, (bf16_t*)(ws + WS_WIN_EV), DM, nb * 32, scr, lane); }
        else if (it < O2) { const int r = it - O1, kb = r / 64, nb = r % 64; transpose_item(a.in[18], DM, kb * 64, nb * 32, (bf16_t*)(ws + WS_WOUT_EV), DM, nb * 32, scr, lane); }
        else if (it < O3) { const int r = it - O2, kb = r / 128, nb = r % 128; transpose_item(a.in[19], 2 * DM, kb * 64, nb * 32, (bf16_t*)(ws + WS_WIN_OD), DM, nb * 32, scr, lane); }
        else if (it < O4) { const int r = it - O3, kb = r / 64, nb = r % 64; transpose_item(a.in[27], DM, kb * 64, nb * 32, (bf16_t*)(ws + WS_WOUT_OD), DM, nb * 32, scr, lane); }
        else if (it < O6) { const bool up = it >= O5; const int r = it - (up ? O5 : O4), le = r / 512, q = r % 512, kb = q / 16, nb = q % 16, n0 = nb * 32;
            transpose_item((up ? a.in[35] : a.in[34]) + (size_t)le * DM * DFF, DFF, kb * 64, n0, (bf16_t*)(ws + WS_W1T) + (size_t)le * 1024 * DM, DM, (n0 >> 7) * 256 + (n0 & 127) + (up ? 128 : 0), scr, lane); }
        else if (it < O7) { const int r = it - O6, le = r / 512, q = r % 512, kb = q / 64, nb = q % 64;
            transpose_item(a.in[36] + (size_t)le * DFF * DM, DM, kb * 64, nb * 32, (bf16_t*)(ws + WS_W2T) + (size_t)le * DM * DFF, DFF, nb * 32, scr, lane); }
        else if (it < O9) { const bool wx = it >= O8; const int r = it - (wx ? O8 : O7), dn = r / 32, q = r % 32, kb = q / 8, nb = q % 8, n0 = nb * 32, dir = dn / 8, n = dn % 8;
            transpose_item((wx ? a.in[24] : a.in[22]) + (size_t)dn * 65536, 256, kb * 64, n0, (bf16_t*)(ws + WS_WG_OD), 256, (n * 4 + dir * 2 + (n0 >> 7)) * 256 + (n0 & 127) + (wx ? 128 : 0), scr, lane); }
        else { const int nb = it - O9; transpose_item(a.in[11], 4096, 0, nb * 32, (bf16_t*)(ws + A_W4T), 128, nb * 32, scr, lane); }
    }
    { const int gt = blockIdx.x * 512 + tid, NT = G * 512;
      for (int i = gt; i < 4096 * 8; i += NT) { const int r = i >> 3, c = i & 7; *(u32x4*)((bf16_t*)(ws + A_W4T) + (size_t)r * 128 + 64 + c * 8) = (u32x4){0u, 0u, 0u, 0u}; }
      for (int i = gt; i < 8192 * 8; i += NT) { const int r = i >> 3, c = i & 7; *(u32x4*)((bf16_t*)(ws + A_H3B) + (size_t)r * 128 + 64 + c * 8) = (u32x4){0u, 0u, 0u, 0u}; }
      const f32x8* x8 = (const f32x8*)a.in[0]; u32x4* xb = (u32x4*)(ws + A_XB);
      for (int i = gt; i < NTOK * DM / 8; i += NT) { const f32x8 v = x8[i]; u32x4 o; o.x = pk2(v[0], v[1]); o.y = pk2(v[2], v[3]); o.z = pk2(v[4], v[5]); o.w = pk2(v[6], v[7]); xb[i] = o; } }
    { const float* w1 = a.in[4]; const float* b1 = a.in[5]; const float* w2 = a.in[6]; const float* b2 = a.in[7]; const float* w3 = a.in[8]; const float* b3 = a.in[9]; const float* fr = a.in[10];
      const float frq = fr[lane];
      for (int t = gw; t < SEQ; t += NGW) {
          float z;
          { const float tl = (float)t * (1.0f / 8191.0f);
            if (lane == 0) z = tl;
            else { const int j = (lane - 1) & 15; const float band = 1e-4f + (float)j * ((15.0f - 1e-4f) / 15.0f);
                   const float ang = (6.283185307179586f * (float)t * (1.0f / 8192.0f)) * band; float sn, cs; sincosf(ang, &sn, &cs); z = (lane <= 16) ? cs : -sn; } }
          float acc = b1[lane];
#pragma unroll
          for (int i = 0; i < 33; ++i) acc += __shfl(z, i) * w1[i * 64 + lane];
          float h = sinf(frq * acc);
          acc = b2[lane];
#pragma unroll 16
          for (int i = 0; i < 64; ++i) acc += __shfl(h, i) * w2[i * 64 + lane];
          h = sinf(frq * acc);
          acc = b3[lane];
#pragma unroll 16
          for (int i = 0; i < 64; ++i) acc += __shfl(h, i) * w3[i * 64 + lane];
          h = sinf(frq * acc);
          ((bf16_t*)(ws + A_H3B))[(size_t)t * 128 + lane] = (bf16_t)f2bf(h);
      } }
}

__device__ __forceinline__ void phase_filter_fft(KArgs a, LAS unsigned char* lds) {
    const int tid = opaque_tid(), lane = tid & 63, wave = tid >> 6, G = gridDim.x;
    LAS f32x2* L = (LAS f32x2*)lds; LAS float* red = (LAS float*)(lds + LDS_MISC + 1024);
    const float* KTD = (const float*)(a.ws + A_KTD); __half2* KF = (__half2*)(a.ws + A_KF);
    for (int u = blockIdx.x; u < 2048; u += G) {
        const int o = u >> 10, c = u & 1023;
        int tl = tid; asm volatile("" : "+v"(tl));
        const float* rowF = KTD + (size_t)(o * 1024 + c) * 8192; const float* rowB = KTD + (size_t)(2048 + o * 1024 + c) * 8192;
        hy::cf v[32]; float ss = 0.f;
#pragma unroll
        for (int n1 = 0; n1 < 32; ++n1) { const int p = tl + 512 * n1; float val;
            if (n1 < 16) val = rowF[p]; else if (p == 8192) val = 0.f; else val = rowB[16384 - p];
            v[n1] = hy::cf{val, 0.f}; ss += val * val; }
        ss = wave_sum(ss); if (lane == 0) red[wave] = ss; __syncthreads();
        float tot = 0.f;
#pragma unroll
        for (int w = 0; w < 8; ++w) tot += red[w];
        const float scale = rsqrtf(tot), skp = a.in[12][u];
        hy::fft_fwd12(v, L, tl);
#pragma unroll
        for (int bf = 0; bf < 2; ++bf) { const int idx = bf * 512 + tl, k1 = idx >> 5, j1 = idx & 31; hy::cf w[16];
#pragma unroll
            for (int m2 = 0; m2 < 16; ++m2) w[m2] = hy::lld(L, k1 * hy::RS + 33 * m2 + j1);
            hy::dft_reg<16, false>(w);
#pragma unroll
            for (int j2 = 0; j2 < 16; ++j2) { const hy::cf x = w[hy::brev(j2, 4)]; KF[((size_t)(u * 2 + bf) * 16 + j2) * 512 + tl] = __floats2half2_rn(x.x * scale + skp, x.y * scale); } }
        __syncthreads();
    }
}
__device__ __forceinline__ float hyconv(const bf16_t* row, int t, float w0, float w1, float w2, float bias) {
    const unsigned tm = (unsigned)(t > 0 ? t - 1 : 0), tp = (unsigned)(t < SEQ - 1 ? t + 1 : SEQ - 1);
    float xm = bf2f(row[tm]), x0 = bf2f(row[(unsigned)t]), xp = bf2f(row[tp]);
    xm = t > 0 ? xm : 0.f; xp = t < SEQ - 1 ? xp : 0.f;
    return w0 * xm + w1 * x0 + w2 * xp + bias;
}
__device__ __forceinline__ void phase_hyena_mixer(KArgs a, LAS unsigned char* lds) {
    const int tid = opaque_tid(), G = gridDim.x;
    LAS f32x2* L = (LAS f32x2*)lds;
    const bf16_t* UHT = (const bf16_t*)(a.ws + A_UHT); const __half2* KF = (const __half2*)(a.ws + A_KF); bf16_t* YHT = (bf16_t*)(a.ws + A_YHT);
    const float* cw = a.in[2]; const float* cb = a.in[3];
    for (int c = blockIdx.x; c < HY_CH; c += G) {
        int tl = tid; asm volatile("" : "+v"(tl));
        hy::cf v[32];
        { const bf16_t* r0 = UHT + (size_t)c * NTOK; const float w0 = cw[c], w1 = cw[3072 + c], w2 = cw[6144 + c], bb = cb[c];
#pragma unroll
          for (int n1 = 0; n1 < 16; ++n1) { const int t = tl + 512 * n1; v[n1] = hy::cf{hyconv(r0, t, w0, w1, w2, bb), hyconv(r0 + SEQ, t, w0, w1, w2, bb)}; if ((n1 & 3) == 3) asm volatile("" ::: "memory"); } }
#pragma unroll 1
        for (int o = 0; o < 2; ++o) {
#pragma unroll
            for (int n1 = 16; n1 < 32; ++n1) v[n1] = hy::cf{0.f, 0.f};
            hy::fft_fwd12(v, L, tl);
#pragma unroll
            for (int bf = 0; bf < 2; ++bf) { const int idx = bf * 512 + tl, k1 = idx >> 5, j1 = idx & 31; hy::cf w[16];
#pragma unroll
                for (int m2 = 0; m2 < 16; ++m2) w[m2] = hy::lld(L, k1 * hy::RS + 33 * m2 + j1);
                hy::dft_reg<16, false>(w);
                asm volatile("" ::: "memory");
                hy::cf y[16];
#pragma unroll
                for (int j2 = 0; j2 < 16; ++j2) { const float2 kf = __half22float2(KF[((size_t)((o * 1024 + c) * 2 + bf) * 16 + j2) * 512 + tl]);
                    y[j2] = hy::cmul(w[hy::brev(j2, 4)], hy::cf{kf.x, kf.y}); }
                hy::dft_reg<16, true>(y);
#pragma unroll
                for (int m2 = 0; m2 < 16; ++m2) hy::lst(L, k1 * hy::RS + 33 * m2 + j1, y[hy::brev(m2, 4)]); }
            __syncthreads();
            hy::fft_inv21(v, L, tl);
            const int gch = (o + 1) * 1024 + c; const bf16_t* rg = UHT + (size_t)gch * NTOK;
            const float w0 = cw[gch], w1 = cw[3072 + gch], w2 = cw[6144 + gch], bb = cb[gch];
            hy::cf zn[16]; int tg = tl; asm volatile("" : "+v"(tg));
#pragma unroll
            for (int n1 = 0; n1 < 16; ++n1) { const int t = tg + 512 * n1; const hy::cf y = v[hy::brev(n1, 5)];
                const float g0 = hyconv(rg, t, w0, w1, w2, bb), g1 = hyconv(rg + SEQ, t, w0, w1, w2, bb);
                zn[n1] = hy::cf{g0 * y.x * (1.0f / 16384.0f), g1 * y.y * (1.0f / 16384.0f)}; if ((n1 & 3) == 3) asm volatile("" ::: "memory"); }
#pragma unroll
            for (int n1 = 0; n1 < 16; ++n1) v[n1] = zn[n1];
        }
        bf16_t* yo = YHT + (size_t)c * NTOK;
#pragma unroll
        for (int n1 = 0; n1 < 16; ++n1) { const int t = tl + 512 * n1; yo[t] = (bf16_t)f2bf(v[n1].x); yo[SEQ + t] = (bf16_t)f2bf(v[n1].y); }
    }
    __syncthreads();
}
__device__ __forceinline__ void phase_attention(KArgs a, LAS unsigned char* lds) {
    const int G = gridDim.x, bx = blockIdx.x;
    const bf16_t* QB = (const bf16_t*)(a.ws + A_QB); const bf16_t* KB = (const bf16_t*)(a.ws + A_KB); const bf16_t* VB = (const bf16_t*)(a.ws + A_VB); bf16_t* OA = (bf16_t*)(a.ws + A_OA);
    for (int i = 0;; ++i) {
        int bhc, qb;
        if (G == 256) { if (i >= 4) break; bhc = i * 8 + (bx & 7); qb = bx >> 3; }
        else { const int Lu = i * G + bx; if (Lu >= 1024) break; bhc = Lu >> 5; qb = Lu & 31; }
        const int b = bhc >> 4, h = (bhc >> 1) & 7, cm = bhc & 1;
        const size_t rowq = (size_t)b * SEQ + (size_t)qb * 256;
        const float sl2 = exp2f(-(float)(h + 1)) * 1.4426950408889634f;
        att::attn_unit(QB + rowq * 1024 + h * 128 + cm * 64, KB + (size_t)b * SEQ * 1024 + h * 128 + cm * 64, VB + (size_t)b * SEQ * 1024 + h * 128,
                       OA + (size_t)cm * NTOK * 1024 + rowq * 1024 + h * 128, qb * 256, SEQ, sl2, (char*)lds);
    }
}
__device__ __forceinline__ void phase_concat(KArgs a, LAS unsigned char* lds) {
    const int tid = opaque_tid(), lane = tid & 63, wave = tid >> 6, G = gridDim.x;
    const bf16_t* YHT = (const bf16_t*)(a.ws + A_YHT); const bf16_t* OA0 = (const bf16_t*)(a.ws + A_OA); const bf16_t* OA1 = OA0 + (size_t)NTOK * 1024; bf16_t* YC = (bf16_t*)(a.ws + A_YCAT);
    LAS bf16_t* T = (LAS bf16_t*)lds;
    const float lambda_init = 0.2f;
    const float lam = __expf(wave_sum(a.in[13][lane] * a.in[14][lane])) - __expf(wave_sum(a.in[15][lane] * a.in[16][lane])) + lambda_init;
    float gl[16];
#pragma unroll
    for (int i = 0; i < 16; ++i) gl[i] = a.in[17][(lane & 7) * 16 + i] * (1.0f - lambda_init);
    for (int it = blockIdx.x; it < NTOK / 64; it += G) {
        const int tok0 = it * 64;
#pragma unroll 4
        for (int k = 0; k < 16; ++k) { const int idx = tid + 512 * k, c = idx >> 3, ch = idx & 7;
            const u32x4 w = *(const u32x4*)(YHT + (size_t)c * NTOK + tok0 + ch * 8);
            LAS bf16_t* d = T + (ch * 8) * 1026 + c;
            d[0 * 1026] = (bf16_t)(w.x & 0xffff); d[1 * 1026] = (bf16_t)(w.x >> 16); d[2 * 1026] = (bf16_t)(w.y & 0xffff); d[3 * 1026] = (bf16_t)(w.y >> 16);
            d[4 * 1026] = (bf16_t)(w.z & 0xffff); d[5 * 1026] = (bf16_t)(w.z >> 16); d[6 * 1026] = (bf16_t)(w.w & 0xffff); d[7 * 1026] = (bf16_t)(w.w >> 16); }
        __syncthreads();
#pragma unroll 4
        for (int k = 0; k < 16; ++k) { const int idx = tid + 512 * k, tl = idx >> 7, c8 = idx & 127;
            const LAS unsigned* s = (const LAS unsigned*)(T + tl * 1026 + c8 * 8);
            u32x4 w; w.x = s[0]; w.y = s[1]; w.z = s[2]; w.w = s[3];
            *(u32x4*)(YC + (size_t)(tok0 + tl) * DM + c8 * 8) = w; }
        for (int rr = 0; rr < 8; ++rr) { const size_t tok = (size_t)tok0 + wave * 8 + rr;
            const u32x4 p0 = *(const u32x4*)(OA0 + tok * 1024 + lane * 16), p1 = *(const u32x4*)(OA0 + tok * 1024 + lane * 16 + 8);
            const u32x4 q0 = *(const u32x4*)(OA1 + tok * 1024 + lane * 16), q1 = *(const u32x4*)(OA1 + tok * 1024 + lane * 16 + 8);
            const unsigned pw[8] = {p0.x, p0.y, p0.z, p0.w, p1.x, p1.y, p1.z, p1.w}, qw[8] = {q0.x, q0.y, q0.z, q0.w, q1.x, q1.y, q1.z, q1.w};
            float o[16]; float ss = 0.f;
#pragma unroll
            for (int i = 0; i < 8; ++i) { o[2 * i] = bflo(pw[i]) - lam * bflo(qw[i]); o[2 * i + 1] = bfhi(pw[i]) - lam * bfhi(qw[i]); ss += o[2 * i] * o[2 * i] + o[2 * i + 1] * o[2 * i + 1]; }
            ss += __shfl_xor(ss, 1); ss += __shfl_xor(ss, 2); ss += __shfl_xor(ss, 4);
            const float rs = rsqrtf(ss * (1.0f / 128.0f) + LN_EPS);
            u32x4 w0, w1;
            w0.x = pk2(o[0] * rs * gl[0], o[1] * rs * gl[1]); w0.y = pk2(o[2] * rs * gl[2], o[3] * rs * gl[3]); w0.z = pk2(o[4] * rs * gl[4], o[5] * rs * gl[5]); w0.w = pk2(o[6] * rs * gl[6], o[7] * rs * gl[7]);
            w1.x = pk2(o[8] * rs * gl[8], o[9] * rs * gl[9]); w1.y = pk2(o[10] * rs * gl[10], o[11] * rs * gl[11]); w1.z = pk2(o[12] * rs * gl[12], o[13] * rs * gl[13]); w1.w = pk2(o[14] * rs * gl[14], o[15] * rs * gl[15]);
            *(u32x4*)(YC + tok * DM + 1024 + lane * 16) = w0; *(u32x4*)(YC + tok * DM + 1024 + lane * 16 + 8) = w1; }
        __syncthreads();
    }
}
__device__ __forceinline__ void ln_row(f32x4 (&v)[8], const float* g, const float* b, int lane) {
    float s = 0.f;
#pragma unroll
    for (int j = 0; j < 8; ++j) s += (v[j][0] + v[j][1]) + (v[j][2] + v[j][3]);
    const float mean = wave_sum(s) * (1.0f / DM); float s2 = 0.f;
#pragma unroll
    for (int j = 0; j < 8; ++j) { v[j] = v[j] - mean; s2 += (v[j][0] * v[j][0] + v[j][1] * v[j][1]) + (v[j][2] * v[j][2] + v[j][3] * v[j][3]); }
    const float rstd = rsqrtf(wave_sum(s2) * (1.0f / DM) + LN_EPS);
#pragma unroll
    for (int j = 0; j < 8; ++j) { const f32x4 gg = *(const f32x4*)(g + 4 * (lane + 64 * j)), bb = *(const f32x4*)(b + 4 * (lane + 64 * j)); v[j] = v[j] * rstd * gg + bb; }
}
__device__ __forceinline__ void phase_ln_router(KArgs a, LAS unsigned char* lds, const float* R, const float* g, const float* b, float* H1, bf16_t* HB, unsigned* cnt, int* rowlist, float* gatew) {
    const int tid = opaque_tid(), lane = tid & 63, wave = tid >> 6, G = gridDim.x;
    const float* rw = a.in[32]; const float* rb = a.in[33];
    LAS float* part = (LAS float*)lds;
    LAS int* hist = (LAS int*)(lds + 40960); LAS int* base = hist + 32;
    for (int it = blockIdx.x; it < NTOK / 32; it += G) {
        const int tok0 = it * 32;
        for (int rr = 0; rr < 4; ++rr) { const size_t row = (size_t)tok0 + wave * 4 + rr; f32x4 v[8];
#pragma unroll
            for (int j = 0; j < 8; ++j) v[j] = *(const f32x4*)(R + row * DM + 4 * (lane + 64 * j));
            ln_row(v, g, b, lane);
#pragma unroll
            for (int j = 0; j < 8; ++j) { *(f32x4*)(H1 + row * DM + 4 * (lane + 64 * j)) = v[j]; u32x2 w; w.x = pk2(v[j][0], v[j][1]); w.y = pk2(v[j][2], v[j][3]); *(u32x2*)(HB + row * DM + 4 * (lane + 64 * j)) = w; } }
        if (tid < 32) hist[tid] = 0;
        VM_WAIT(); __syncthreads();
        { const int i = lane & 31, kk = lane >> 5; f32x16 acc = {};
          const float* hrow = H1 + (size_t)(tok0 + i) * DM + wave * 256 + 4 * kk; const float* rwp = rw + (size_t)(wave * 256 + 4 * kk) * NEXP + i;
#pragma unroll 4
          for (int s = 0; s < 32; ++s) { const f32x4 hv = __builtin_nontemporal_load((const f32x4*)(hrow + 8 * s));
#pragma unroll
              for (int j = 0; j < 4; ++j) acc = __builtin_amdgcn_mfma_f32_32x32x2f32(rwp[(size_t)(8 * s + j) * NEXP], hv[j], acc, 0, 0, 0); }
#pragma unroll
          for (int r = 0; r < 16; ++r) part[(wave * 32 + i) * 33 + (r & 3) + 8 * (r >> 2) + 4 * kk] = acc[r]; }
        __syncthreads();
        int e1 = 0, e2 = 0, r1 = 0, r2 = 0; float g1 = 0.f, g2 = 0.f;
        if (tid < 32) {
            float bestg = -1e30f;
#pragma unroll
            for (int gi = 0; gi < 4; ++gi) { float m1 = -1e30f, m2 = -1e30f, s1 = 0.f, s2 = 0.f; int i1 = 0, i2 = 0;
#pragma unroll
                for (int j = 0; j < 8; ++j) { const int e = gi * 8 + j; float lg = 0.f;
#pragma unroll
                    for (int w = 0; w < 8; ++w) lg += part[(w * 32 + tid) * 33 + e];
                    const float sg = 1.0f / (1.0f + expf(-lg)), sl = sg + rb[e];
                    if (sl > m1) { m2 = m1; i2 = i1; s2 = s1; m1 = sl; i1 = j; s1 = sg; } else if (sl > m2) { m2 = sl; i2 = j; s2 = sg; } }
                const float gs = m1 + m2;
                if (gs > bestg) { bestg = gs; e1 = gi * 8 + i1; e2 = gi * 8 + i2; g1 = s1; g2 = s2; } }
            const float inv = 1.0f / (g1 + g2); g1 *= inv; g2 *= inv;
            r1 = atomicAdd((int*)&hist[e1], 1); r2 = atomicAdd((int*)&hist[e2], 1);
        }
        __syncthreads();
        if (tid < 32) { const int hc = hist[tid]; base[tid] = hc ? (int)__hip_atomic_fetch_add(cnt + tid * 64, (unsigned)hc, __ATOMIC_RELAXED, __HIP_MEMORY_SCOPE_AGENT) : 0; }
        __syncthreads();
        if (tid < 32) { const int a0 = (tok0 + tid) * 2;
            rowlist[(size_t)e1 * ECAP + base[e1] + r1] = a0; gatew[a0] = g1;
            rowlist[(size_t)e2 * ECAP + base[e2] + r2] = a0 + 1; gatew[a0 + 1] = g2; }
        __syncthreads();
    }
}
__device__ __forceinline__ void phase_ln2(const float* H1, const bf16_t* Y2, const float* g, const float* b, float* OUT, bf16_t* OB) {
    const int tid = opaque_tid(), lane = tid & 63, wave = tid >> 6;
    for (int row = blockIdx.x * 8 + wave; row < NTOK; row += gridDim.x * 8) { f32x4 v[8];
#pragma unroll
        for (int j = 0; j < 8; ++j) { const int c = 4 * (lane + 64 * j); const f32x4 h = *(const f32x4*)(H1 + (size_t)row * DM + c);
            const u32x2 y0 = *(const u32x2*)(Y2 + (size_t)(2 * row) * DM + c), y1 = *(const u32x2*)(Y2 + (size_t)(2 * row + 1) * DM + c);
            v[j] = h * DN_ALPHA + (f32x4){bflo(y0.x) + bflo(y1.x), bfhi(y0.x) + bfhi(y1.x), bflo(y0.y) + bflo(y1.y), bfhi(y0.y) + bfhi(y1.y)}; }
        ln_row(v, g, b, lane);
#pragma unroll
        for (int j = 0; j < 8; ++j) { const int c = 4 * (lane + 64 * j); *(f32x4*)(OUT + (size_t)row * DM + c) = v[j];
            if (OB) { u32x2 w; w.x = pk2(v[j][0], v[j][1]); w.y = pk2(v[j][2], v[j][3]); *(u32x2*)(OB + (size_t)row * DM + c) = w; } }
    }
}
__device__ __forceinline__ void moe_table(LAS int* tab, const unsigned* cnt) {
    __syncthreads();
    if (threadIdx.x < 32) tab[64 + threadIdx.x] = (int)cnt[threadIdx.x * 64];
    __syncthreads();
    if (threadIdx.x == 0) { int acc = 0; for (int e = 0; e < 32; ++e) { tab[e] = acc; acc += (tab[64 + e] + 255) >> 8; } tab[32] = acc; }
    __syncthreads();
}
__device__ __forceinline__ void phase_conv4(KArgs a) {
    const bf16_t* XR = (const bf16_t*)(a.ws + A_XR); bf16_t* XC = (bf16_t*)(a.ws + A_XC); const float* cw = a.in[20]; const float* cb = a.in[21];
    const int NT = gridDim.x * 512;
    for (int it = blockIdx.x * 512 + opaque_tid(); it < NTOK * 256; it += NT) { const int tok = it >> 8, ch = (it & 255) * 8, t = tok & (SEQ - 1);
        float acc[8];
#pragma unroll
        for (int i = 0; i < 8; ++i) acc[i] = cb[ch + i];
#pragma unroll
        for (int j = 0; j < 4; ++j) { const int tt = t + j - 2;
            if (tt >= 0 && tt < SEQ) { const u32x4 w = *(const u32x4*)(XR + (size_t)(tok + j - 2) * DM + ch); const unsigned ww[4] = {w.x, w.y, w.z, w.w};
#pragma unroll
                for (int i = 0; i < 4; ++i) { acc[2 * i] += cw[j * DM + ch + 2 * i] * bflo(ww[i]); acc[2 * i + 1] += cw[j * DM + ch + 2 * i + 1] * bfhi(ww[i]); } } }
        u32x4 o; o.x = pk2(acc[0], acc[1]); o.y = pk2(acc[2], acc[3]); o.z = pk2(acc[4], acc[5]); o.w = pk2(acc[6], acc[7]);
        *(u32x4*)(XC + (size_t)tok * DM + ch) = o; }
}
constexpr size_t CAR_ELEMS = (size_t)2 * 2 * 256 * DM;
__device__ __forceinline__ void phase_scan1(KArgs a) {
    const bf16_t* LA = (const bf16_t*)(a.ws + A_LA); const bf16_t* BB = (const bf16_t*)(a.ws + A_BB); float* CARA = (float*)(a.ws + A_CAR); float* CARB = CARA + CAR_ELEMS;
    const int NT = gridDim.x * 512;
    for (int it = blockIdx.x * 512 + opaque_tid(); it < 2 * 2 * 256 * 512; it += NT) { const int ch = (it & 511) * 4, chunk = (it >> 9) & 255, dir = (it >> 17) & 1, b = it >> 18;
        float h[4] = {0.f, 0.f, 0.f, 0.f}, ls[4] = {0.f, 0.f, 0.f, 0.f};
#pragma unroll 8
        for (int s = 0; s < 32; ++s) { const int t = chunk * 32 + (dir ? 31 - s : s); const size_t off = ((size_t)dir * NTOK + (size_t)b * SEQ + t) * DM + ch;
            const u32x2 lw = *(const u32x2*)(LA + off), bw = *(const u32x2*)(BB + off);
            const float l4[4] = {bflo(lw.x), bfhi(lw.x), bflo(lw.y), bfhi(lw.y)}, b4[4] = {bflo(bw.x), bfhi(bw.x), bflo(bw.y), bfhi(bw.y)};
#pragma unroll
            for (int i = 0; i < 4; ++i) { h[i] = __expf(l4[i]) * h[i] + b4[i]; ls[i] += l4[i]; } }
        const size_t co = (((size_t)b * 2 + dir) * 256 + chunk) * DM + ch;
        *(f32x4*)(CARA + co) = (f32x4){ls[0], ls[1], ls[2], ls[3]}; *(f32x4*)(CARB + co) = (f32x4){h[0], h[1], h[2], h[3]}; }
}
__device__ __forceinline__ void phase_scan2(KArgs a) {
    float* CARA = (float*)(a.ws + A_CAR); float* CARB = CARA + CAR_ELEMS; float* CARIN = CARB + CAR_ELEMS;
    const int NT = gridDim.x * 512;
    for (int it = blockIdx.x * 512 + opaque_tid(); it < 2 * 2 * DM; it += NT) { const int ch = it & (DM - 1), dir = (it >> 11) & 1, b = it >> 12;
        float h = 0.f;
#pragma unroll 8
        for (int k = 0; k < 256; ++k) { const int chunk = dir ? 255 - k : k; const size_t co = (((size_t)b * 2 + dir) * 256 + chunk) * DM + ch;
            CARIN[co] = h; h = __expf(CARA[co]) * h + CARB[co]; } }
}
__device__ __forceinline__ float gelu_tanh(float x) { const float u = 0.7978845608028654f * (x + 0.044715f * x * x * x); const float th = 1.0f - 2.0f / (1.0f + __expf(2.0f * u)); return 0.5f * x * (1.0f + th); }
__device__ __forceinline__ void phase_scan3(KArgs a) {
    const bf16_t* LA = (const bf16_t*)(a.ws + A_LA); const bf16_t* BB = (const bf16_t*)(a.ws + A_BB); const bf16_t* GB = (const bf16_t*)(a.ws + A_GB); bf16_t* YG = (bf16_t*)(a.ws + A_YG);
    const float* CARIN = (const float*)(a.ws + A_CAR) + 2 * CAR_ELEMS;
    const int NT = gridDim.x * 512;
    for (int it = blockIdx.x * 512 + opaque_tid(); it < 2 * 256 * 512; it += NT) { const int ch = (it & 511) * 4, chunk = (it >> 9) & 255, b = it >> 17;
        float hf[32][4]; float h[4];
        { const f32x4 c = *(const f32x4*)(CARIN + (((size_t)b * 2 + 0) * 256 + chunk) * DM + ch); h[0] = c[0]; h[1] = c[1]; h[2] = c[2]; h[3] = c[3]; }
#pragma unroll
        for (int s = 0; s < 32; ++s) { const size_t off = ((size_t)b * SEQ + chunk * 32 + s) * DM + ch;
            const u32x2 lw = *(const u32x2*)(LA + off), bw = *(const u32x2*)(BB + off);
            const float l4[4] = {bflo(lw.x), bfhi(lw.x), bflo(lw.y), bfhi(lw.y)}, b4[4] = {bflo(bw.x), bfhi(bw.x), bflo(bw.y), bfhi(bw.y)};
#pragma unroll
            for (int i = 0; i < 4; ++i) { h[i] = __expf(l4[i]) * h[i] + b4[i]; hf[s][i] = h[i]; } }
        { const f32x4 c = *(const f32x4*)(CARIN + (((size_t)b * 2 + 1) * 256 + chunk) * DM + ch); h[0] = c[0]; h[1] = c[1]; h[2] = c[2]; h[3] = c[3]; }
#pragma unroll
        for (int s = 31; s >= 0; --s) { const size_t tokoff = ((size_t)b * SEQ + chunk * 32 + s) * DM + ch; const size_t off = (size_t)NTOK * DM + tokoff;
            const u32x2 lw = *(const u32x2*)(LA + off), bw = *(const u32x2*)(BB + off), gw = *(const u32x2*)(GB + tokoff);
            const float l4[4] = {bflo(lw.x), bfhi(lw.x), bflo(lw.y), bfhi(lw.y)}, b4[4] = {bflo(bw.x), bfhi(bw.x), bflo(bw.y), bfhi(bw.y)}, g4[4] = {bflo(gw.x), bfhi(gw.x), bflo(gw.y), bfhi(gw.y)};
            float y[4];
#pragma unroll
            for (int i = 0; i < 4; ++i) { h[i] = __expf(l4[i]) * h[i] + b4[i]; y[i] = gelu_tanh(g4[i]) * (hf[s][i] + h[i]); }
            u32x2 w; w.x = pk2(y[0], y[1]); w.y = pk2(y[2], y[3]); *(u32x2*)(YG + tokoff) = w; } }
}

extern __shared__ __attribute__((aligned(16))) unsigned char lds_raw[];
#define KARGS() (*(const __attribute__((address_space(4))) Args*)__builtin_amdgcn_kernarg_segment_ptr())
#define PHASE_FN __device__ __forceinline__ void
#define PH_PRE() KArgs a = KARGS(); LAS unsigned char* lds = (LAS unsigned char*)lds_raw; unsigned char* ws = a.ws; asm volatile("" : "+s"(ws)); const int G = gridDim.x, bx = blockIdx.x; (void)lds; (void)ws; (void)G; (void)bx; using namespace pg8
PHASE_FN ph0() { PH_PRE(); phase_prologue(a, lds); }
PHASE_FN ph1a() { PH_PRE(); Gemm g{(const bf16_t*)(ws + A_W4T), (const bf16_t*)(ws + A_H3B), 128, 128, 128}; StaticOrder S; S.init(4096, 8192, G, bx); EpiFilt E{(float*)(ws + A_KTD)}; gemm_phase(lds, g, S, E); }
PHASE_FN ph1b() { PH_PRE(); Gemm g{(const bf16_t*)(ws + A_XB), (const bf16_t*)(ws + WS_WIN_EV) + (size_t)3072 * DM, DM, DM, DM}; StaticOrder S; S.init(NTOK, 3072, G, bx);
                  EpiBf16 E{(bf16_t*)(ws + A_QB), 1024, 1024, (size_t)(A_KB - A_QB) / 2, QSCALE}; gemm_phase(lds, g, S, E); }
PHASE_FN ph1c() { PH_PRE(); Gemm g{(const bf16_t*)(ws + WS_WIN_EV), (const bf16_t*)(ws + A_XB), DM, DM, DM}; StaticOrder S; S.init(3072, NTOK, G, bx);
                  EpiBf16 E{(bf16_t*)(ws + A_UHT), NTOK, 0, 0, 1.f}; gemm_phase(lds, g, S, E); }
PHASE_FN ph2() { PH_PRE(); phase_filter_fft(a, lds); }
PHASE_FN ph3a() { PH_PRE(); phase_hyena_mixer(a, lds); }
PHASE_FN ph3b() { PH_PRE(); phase_attention(a, lds); }
PHASE_FN ph4() { PH_PRE(); phase_concat(a, lds); }
PHASE_FN ph5() { PH_PRE(); Gemm g{(const bf16_t*)(ws + A_YCAT), (const bf16_t*)(ws + WS_WOUT_EV), DM, DM, DM}; StaticOrder S; S.init(NTOK, DM, G, bx);
                 EpiResF32 E{a.in[0], (float*)(ws + A_R0), DM, DN_ALPHA}; gemm_phase(lds, g, S, E); }
template <int LAYER> PHASE_FN ph_lnr() { PH_PRE(); unsigned* ctl = (unsigned*)(ws + WS_CTL);
    phase_ln_router(a, lds, (const float*)(ws + (LAYER ? A_R1 : A_R0)), a.in[28] + LAYER * DM, a.in[29] + LAYER * DM, (float*)(ws + (LAYER ? A_H1_1 : A_H1_0)), (bf16_t*)(ws + (LAYER ? A_HB_1 : A_HB_0)),
                    ctl + CW_CNT + LAYER * 32 * 64, (int*)(ws + A_ROWL), (float*)(ws + A_GATEW)); }
template <int LAYER> PHASE_FN ph_moe1() { PH_PRE(); LAS int* tab = (LAS int*)(lds + LDS_MISC); moe_table(tab, (const unsigned*)(ws + WS_CTL) + CW_CNT + LAYER * 32 * 64);
    Gemm g{(const bf16_t*)(ws + (LAYER ? A_HB_1 : A_HB_0)), (const bf16_t*)(ws + WS_W1T) + (size_t)LAYER * 32 * 1024 * DM, DM, DM, DM}; MoeOrder<4, true> S{G, bx, tab, (const int*)(ws + A_ROWL)};
    EpiSwiglu E{(bf16_t*)(ws + (LAYER ? A_HID_1 : A_HID_0))}; gemm_phase(lds, g, S, E); }
template <int LAYER> PHASE_FN ph_moe2() { PH_PRE(); LAS int* tab = (LAS int*)(lds + LDS_MISC); moe_table(tab, (const unsigned*)(ws + WS_CTL) + CW_CNT + LAYER * 32 * 64);
    Gemm g{(const bf16_t*)(ws + (LAYER ? A_HID_1 : A_HID_0)), (const bf16_t*)(ws + WS_W2T) + (size_t)LAYER * 32 * DM * DFF, DFF, DFF, DFF}; MoeOrder<8, false> S{G, bx, tab, (const int*)(ws + A_ROWL)};
    EpiDown E{(bf16_t*)(ws + (LAYER ? A_Y2_1 : A_Y2_0)), (const int*)(ws + A_ROWL), (const float*)(ws + A_GATEW)}; gemm_phase(lds, g, S, E); }
template <int LAYER> PHASE_FN ph_ln2() { PH_PRE();
    phase_ln2((const float*)(ws + (LAYER ? A_H1_1 : A_H1_0)), (const bf16_t*)(ws + (LAYER ? A_Y2_1 : A_Y2_0)), a.in[30] + LAYER * DM, a.in[31] + LAYER * DM, LAYER ? a.out : (float*)(ws + A_H2), LAYER ? nullptr : (bf16_t*)(ws + A_HB2)); }
PHASE_FN ph10() { PH_PRE(); Gemm g{(const bf16_t*)(ws + A_HB2), (const bf16_t*)(ws + WS_WIN_OD), DM, DM, DM}; StaticOrder S; S.init(NTOK, 2 * DM, G, bx);
                  EpiBf16 E{(bf16_t*)(ws + A_GB), DM, DM, (size_t)(A_XR - A_GB) / 2, 1.f}; gemm_phase(lds, g, S, E); }
PHASE_FN ph11() { PH_PRE(); phase_conv4(a); }
PHASE_FN ph12() { PH_PRE(); Gemm g{(const bf16_t*)(ws + A_XC), (const bf16_t*)(ws + WS_WG_OD), DM, 256, 256}; RGOrder S{G, bx};
                  EpiRG E{(bf16_t*)(ws + A_LA), (bf16_t*)(ws + A_BB), (const bf16_t*)(ws + A_XC), a.in[23], a.in[25], a.in[26]}; gemm_phase(lds, g, S, E); }
PHASE_FN ph13() { PH_PRE(); phase_scan1(a); }
PHASE_FN ph14() { PH_PRE(); phase_scan2(a); }
PHASE_FN ph15() { PH_PRE(); phase_scan3(a); }
PHASE_FN ph16() { PH_PRE(); Gemm g{(const bf16_t*)(ws + A_YG), (const bf16_t*)(ws + WS_WOUT_OD), DM, DM, DM}; StaticOrder S; S.init(NTOK, DM, G, bx);
                  EpiResF32 E{(const float*)(ws + A_H2), (float*)(ws + A_R1), DM, DN_ALPHA}; gemm_phase(lds, g, S, E); }

__global__ void __launch_bounds__(512, 2) fwd(Args a) {
    LAS unsigned char* lds = (LAS unsigned char*)lds_raw;
    const int tid = threadIdx.x;
    unsigned* ctl = (unsigned*)(a.ws + WS_CTL);
    volatile LAS unsigned* bst = (volatile LAS unsigned*)(lds + LDS_MISC + 2048);
    if (tid < 4) bst[tid] = 0u;
    __syncthreads();
    const int lo = a.ph_lo, hi = a.ph_hi;
    XcdBarrier bar; bar.bar = ctl + CW_BAR; bar.x = 0; bar.st = bst;
    if (hi - lo > 1) bar = xcd_barrier_post(ctl + CW_BAR, bst);
#ifdef ONLY_PHASE
#define IN(k) ((k) == ONLY_PHASE && lo <= (k) && (k) < hi)
#else
#define IN(k) (lo <= (k) && (k) < hi)
#endif
#define SEAM(k) do { if (IN(k) && IN((k) + 1)) xcd_barrier(bar); } while (0)
    if (IN(0)) { asm volatile("; PHASE_MARK 0"); ph0(); } SEAM(0);
    if (IN(1)) { asm volatile("; PHASE_MARK 1a"); ph1a(); asm volatile("; PHASE_MARK 1b"); ph1b(); asm volatile("; PHASE_MARK 1c"); ph1c(); } SEAM(1);
    if (IN(2)) { asm volatile("; PHASE_MARK 2"); ph2(); } SEAM(2);
    if (IN(3)) { asm volatile("; PHASE_MARK 3a"); ph3a(); asm volatile("; PHASE_MARK 3b"); ph3b(); } SEAM(3);
    if (IN(4)) { asm volatile("; PHASE_MARK 4"); ph4(); } SEAM(4);
    if (IN(5)) { asm volatile("; PHASE_MARK 5"); ph5(); } SEAM(5);
    if (IN(6)) { asm volatile("; PHASE_MARK 6"); ph_lnr<0>(); } SEAM(6);
    if (IN(7)) { asm volatile("; PHASE_MARK 7"); ph_moe1<0>(); } SEAM(7);
    if (IN(8)) { asm volatile("; PHASE_MARK 8"); ph_moe2<0>(); } SEAM(8);
    if (IN(9)) { asm volatile("; PHASE_MARK 9"); ph_ln2<0>(); } SEAM(9);
    if (IN(10)) { asm volatile("; PHASE_MARK 10"); ph10(); } SEAM(10);
    if (IN(11)) { asm volatile("; PHASE_MARK 11"); ph11(); } SEAM(11);
    if (IN(12)) { asm volatile("; PHASE_MARK 12"); ph12(); } SEAM(12);
    if (IN(13)) { asm volatile("; PHASE_MARK 13"); ph13(); } SEAM(13);
    if (IN(14)) { asm volatile("; PHASE_MARK 14"); ph14(); } SEAM(14);
    if (IN(15)) { asm volatile("; PHASE_MARK 15"); ph15(); } SEAM(15);
    if (IN(16)) { asm volatile("; PHASE_MARK 16"); ph16(); } SEAM(16);
    if (IN(17)) { asm volatile("; PHASE_MARK 17"); ph_lnr<1>(); } SEAM(17);
    if (IN(18)) { asm volatile("; PHASE_MARK 18"); ph_moe1<1>(); } SEAM(18);
    if (IN(19)) { asm volatile("; PHASE_MARK 19"); ph_moe2<1>(); } SEAM(19);
    if (IN(20)) { asm volatile("; PHASE_MARK 20"); ph_ln2<1>(); }
#undef IN
#undef SEAM
}

#ifndef MK_PER_PHASE
#define MK_PER_PHASE 0
#endif
extern "C" void kernel_launch(void* const* d_in, const int* in_sizes, int n_in, void* d_out, int out_size, void* d_ws, size_t ws_size, hipStream_t stream) {
    static int grid = 0;
    if (grid == 0) {
        if (n_in != 37 || out_size != NTOK * DM || ws_size < WS_END) { fprintf(stderr, "kernel_launch: built for 37 inputs, %d outputs, >= %zu bytes of workspace; got n_in %d out %d ws %zu\n", NTOK * DM, (size_t)WS_END, n_in, out_size, ws_size); grid = -1; return; }
        int dev = 0, cus = 0, per_cu = 0;
        if (hipGetDevice(&dev) != hipSuccess || hipDeviceGetAttribute(&cus, hipDeviceAttributeMultiprocessorCount, dev) != hipSuccess) { grid = -1; return; }
        if (hipFuncSetAttribute((const void*)fwd, hipFuncAttributeMaxDynamicSharedMemorySize, LDS_BYTES) != hipSuccess) { fprintf(stderr, "kernel_launch: hipFuncSetAttribute failed\n"); grid = -1; return; }
        if (hipOccupancyMaxActiveBlocksPerMultiprocessor(&per_cu, (const void*)fwd, 512, LDS_BYTES) != hipSuccess || per_cu < 1) fprintf(stderr, "kernel_launch: occupancy query reports %d\n", per_cu);
        (void)hipGetLastError();
        grid = cus;
    }
    if (grid < 0) return;
    (void)hipMemsetAsync((char*)d_ws + WS_CTL, 0, CTL_ZERO_BYTES, stream);
    Args a{};
    for (int i = 0; i < 37; ++i) a.in[i] = (const float*)d_in[i];
    a.out = (float*)d_out; a.ws = (unsigned char*)d_ws;
#if MK_PER_PHASE
    for (int p = 0; p < NPHASE; ++p) { a.ph_lo = p; a.ph_hi = p + 1; hipLaunchKernelGGL(fwd, dim3(grid), dim3(512), LDS_BYTES, stream, a); }
#else
    a.ph_lo = 0; a.ph_hi = NPHASE; hipLaunchKernelGGL(fwd, dim3(grid), dim3(512), LDS_BYTES, stream, a);
#endif
}
```

```cpp
#include <hip/hip_runtime.h>
#include <hip/hip_fp16.h>
#include <cstdio>
#include <cstdint>

#define GAS __attribute__((address_space(1)))
#define LAS __attribute__((address_space(3)))
typedef unsigned short bf16_t;
typedef short bf16x8 __attribute__((ext_vector_type(8)));
typedef short s16x4 __attribute__((ext_vector_type(4)));
typedef float f32x2 __attribute__((ext_vector_type(2)));
typedef float f32x4 __attribute__((ext_vector_type(4)));
typedef float f32x8 __attribute__((ext_vector_type(8)));
typedef float f32x16 __attribute__((ext_vector_type(16)));
typedef unsigned u32x2 __attribute__((ext_vector_type(2)));
typedef unsigned u32x4 __attribute__((ext_vector_type(4)));
typedef GAS unsigned gu32;

constexpr int DM = 2048, BATCH = 2, SEQ = 8192, NTOK = BATCH * SEQ;
constexpr int HY_CH = 1024, EV_IN = 6144;
constexpr int NEXP = 32, DFF = 512, NASSIGN = NTOK * 2, ECAP = NASSIGN;
constexpr float LN_EPS = 1e-5f;
constexpr float DN_ALPHA = 1.4142135623730951f;
constexpr float QSCALE = 0.125f * 1.4426950408889634f;
constexpr int FFT_N = 16384, FFT_RS = 528;

__device__ __forceinline__ unsigned f2bf(float f) { unsigned u = __builtin_bit_cast(unsigned, f); return (u + 0x7fffu + ((u >> 16) & 1u)) >> 16; }
__device__ __forceinline__ unsigned pk2(float lo, float hi) { return f2bf(lo) | (f2bf(hi) << 16); }
__device__ __forceinline__ float bf2f(unsigned short h) { return __builtin_bit_cast(float, (unsigned)h << 16); }
__device__ __forceinline__ float bflo(unsigned w) { return __builtin_bit_cast(float, w << 16); }
__device__ __forceinline__ float bfhi(unsigned w) { return __builtin_bit_cast(float, w & 0xffff0000u); }
__device__ __forceinline__ unsigned cvt_pk_bf16(float lo, float hi) { unsigned r; asm volatile("v_cvt_pk_bf16_f32 %0, %1, %2" : "=v"(r) : "v"(lo), "v"(hi)); return r; }
__device__ __forceinline__ float wave_sum(float v) {
#pragma unroll
    for (int o = 1; o < 64; o <<= 1) v += __shfl_xor(v, o);
    return v;
}
__device__ __forceinline__ float sigmoidf_(float x) { return 1.0f / (1.0f + __expf(-x)); }
constexpr int LDS_WIDTAB = 139264 + 3072;
__device__ __forceinline__ int hw_slot() { return (int)(__builtin_amdgcn_s_getreg((5 << 11) | 4) & 63u); }
__device__ __forceinline__ int lane_id() { return (int)__builtin_amdgcn_mbcnt_hi(~0u, __builtin_amdgcn_mbcnt_lo(~0u, 0u)); }
extern __shared__ __attribute__((aligned(16))) unsigned char lds_raw[];
__device__ __forceinline__ int wave_id() { return __builtin_amdgcn_readfirstlane(((const LAS int*)((LAS unsigned char*)lds_raw + LDS_WIDTAB))[hw_slot()]); }
__device__ __forceinline__ int opaque_tid() { int t = wave_id() * 64 + lane_id(); asm volatile("" : "+v"(t)); return t; }
#define LDS_WAIT() asm volatile("s_waitcnt lgkmcnt(0)" ::: "memory")
#define VM_WAIT() asm volatile("s_waitcnt vmcnt(0)" ::: "memory")

#define XB_TMO      128
#define XB_XCNT(j)  (256  + 64 * (j))
#define XB_XSUB(j)  (1280 + 64 * (j))
#define XB_XGEN(j)  (2304 + 64 * (j))
#define XB_TOP      3328
#define XB_TOPGEN   3392
#define XCD_BAR_WORDS 3456
#define XB_SPIN_CAP (1u << 18)
__device__ __forceinline__ unsigned xb_ld(unsigned* p)              { return __hip_atomic_load(p, __ATOMIC_RELAXED, __HIP_MEMORY_SCOPE_AGENT); }
__device__ __forceinline__ unsigned xb_add(unsigned* p, unsigned v) { return __hip_atomic_fetch_add(p, v, __ATOMIC_RELAXED, __HIP_MEMORY_SCOPE_AGENT); }
__device__ __forceinline__ unsigned xb_xcc_id() { return (unsigned)__builtin_amdgcn_s_getreg((3 << 11) | 20) & 0xFu; }
#define XB_SPIN(cond, bar) do { unsigned _sp = 0; while (cond) { __builtin_amdgcn_s_sleep(1); \
    if ((++_sp & 255u) == 0u) { if (xb_ld(&(bar)[XB_TMO])) break; if (_sp > XB_SPIN_CAP) { atomicAdd(&(bar)[XB_TMO], 1u); break; } } } } while (0)
struct XcdBarrier { unsigned* bar; unsigned x; volatile LAS unsigned* st; };
__device__ __forceinline__ XcdBarrier xcd_barrier_post(unsigned* bar, volatile LAS unsigned* st) {
    XcdBarrier b; b.bar = bar; b.x = xb_xcc_id(); b.st = st;
    if (opaque_tid() == 0) (void)xb_add(&bar[XB_XCNT(b.x)], 1u);
    return b;
}
__device__ __forceinline__ void xcd_barrier_complete(unsigned* bar, unsigned x, unsigned& nloc, unsigned& nx) {
    const unsigned G = gridDim.x * gridDim.y * gridDim.z;
    unsigned sum, cnt, mine, sp = 0u;
    for (;;) {
        sum = 0u; cnt = 0u; mine = 0u;
#pragma unroll
        for (unsigned j = 0; j < 16; ++j) { const unsigned c = xb_ld(&bar[XB_XCNT(j)]); sum += c; cnt += (c > 0u) ? 1u : 0u; mine = (j == x) ? c : mine; }
        if (sum == G) break;
        __builtin_amdgcn_s_sleep(1);
        if ((++sp & 255u) == 0u) { if (xb_ld(&bar[XB_TMO])) break; if (sp > XB_SPIN_CAP) { atomicAdd(&bar[XB_TMO], 1u); break; } }
    }
    nloc = mine > 0u ? mine : 1u; nx = cnt > 0u ? cnt : 1u;
}
__device__ __forceinline__ void xcd_barrier(const XcdBarrier& b) {
    asm volatile("s_waitcnt vmcnt(0)" ::: "memory");
    __syncthreads();
    if (opaque_tid() == 0) {
        unsigned* bar = b.bar;
        __builtin_amdgcn_s_waitcnt(0);
        unsigned nloc = b.st[0], nx = b.st[1];
        if (nloc == 0u) { xcd_barrier_complete(bar, b.x, nloc, nx); b.st[0] = nloc; b.st[1] = nx; }
        const unsigned old = xb_add(&bar[XB_XSUB(b.x)], 1u);
        const unsigned gen = old / nloc;
        if (old + 1u == (gen + 1u) * nloc) {
            __builtin_amdgcn_fence(__ATOMIC_RELEASE, "agent");
            asm volatile("s_waitcnt vmcnt(0)" ::: "memory");
            const unsigned og = xb_add(&bar[XB_TOP], 1u);
            const unsigned tg = og / nx;
            if (og + 1u == (tg + 1u) * nx) xb_add(&bar[XB_TOPGEN], 1u);
            else XB_SPIN(xb_ld(&bar[XB_TOPGEN]) == tg, bar);
            __builtin_amdgcn_fence(__ATOMIC_ACQUIRE, "agent");
            xb_add(&bar[XB_XGEN(b.x)], 1u);
            asm volatile("s_waitcnt vmcnt(0)" ::: "memory");
        } else {
            XB_SPIN(xb_ld(&bar[XB_XGEN(b.x)]) == gen, bar);
            __builtin_amdgcn_fence(__ATOMIC_ACQUIRE, "agent");
            asm volatile("s_waitcnt vmcnt(0)" ::: "memory");
        }
    }
    __syncthreads();
}

namespace pg8 {
constexpr int BM = 256, BK = 64, HALF = 128, HTB = HALF * BK * 2, STAGE_BYTES = 8 * HTB, NXCD = 8, WGM = 8;
__host__ __device__ __forceinline__ int lds_byte(int r, int c) { const int st = (r >> 4) * 2 + (c >> 5), rr = r & 15, cc = c & 31, ob = rr * 64 + cc * 2; return st * 1024 + (ob ^ (((ob >> 9) & 1) << 5)); }
__host__ __device__ __forceinline__ void stage_rc(int b, int& R, int& C) { const int st = b / 1024, sb = b % 1024, swz = sb ^ (((sb >> 9) & 1) << 5); R = (st >> 1) * 16 + swz / 64; C = (st & 1) * 32 + (swz % 64) / 2; }
__host__ __device__ __forceinline__ int perm32(int rho) { const int n = rho >> 4, i = rho & 15; return 8 * (i >> 2) + 4 * n + (i & 3); }

struct Unit { int pm, pn, e, t, cnt; };
struct Gemm { const bf16_t* A; const bf16_t* Bt; int lda, ldb, K; };

struct StaticOrder {
    static constexpr bool GATHER_A = false;
    int nM, nN, nwg, G, c;
    __device__ void init(int M, int N, int G_, int c_) { nM = M / BM; nN = N / BM; nwg = nM * nN; G = G_; c = c_; }
    __device__ __forceinline__ bool next(int i, Unit& u) const {
        const long L = (long)i * G + c; if (L >= nwg) return false;
        int wgid = (int)L; { const int q = nwg / NXCD, r = nwg % NXCD, xcd = wgid % NXCD, off = wgid / NXCD; wgid = (xcd < r ? xcd * (q + 1) : r * (q + 1) + (xcd - r) * q) + off; }
        const int nig = WGM * nN, gid = wgid / nig, fm = gid * WGM, gsz = (nM - fm) < WGM ? (nM - fm) : WGM;
        u.pm = fm + ((wgid % nig) % gsz); u.pn = (wgid % nig) / gsz; u.e = 0; u.t = 0; u.cnt = 0; return true;
    }
    __device__ __forceinline__ int rowA(const Unit& u, int r) const { return u.pm * BM + r; }
    __device__ __forceinline__ int colA(const Unit&) const { return 0; }
    __device__ __forceinline__ int rowB(const Unit& u, int r) const { return u.pn * BM + r; }
};

template <class Epi, class Sched>
__device__ __forceinline__ void gemm_phase(LAS unsigned char* lds, const Gemm g, const Sched& S, const Epi& E) {
    const int tid = opaque_tid(), wid = __builtin_amdgcn_readfirstlane(tid >> 6), lane = tid & 63, wr = wid >> 2, wc = wid & 3, fr = lane & 15, fq = lane >> 4;
    const int K = g.K, nt = K / BK;
    constexpr bool GA = Sched::GATHER_A;
    int sR[2], sC[2];
    unsigned laneA[2], laneB[2];
#pragma unroll
    for (int i = 0; i < 2; ++i) { int R, C; stage_rc(tid * 16 + i * 8192, R, C); sR[i] = R; sC[i] = C; const int Rb = Epi::PERM ? ((R & ~31) + perm32(R & 31)) : R;
        laneA[i] = (unsigned)(R * g.lda + C) * 2u; laneB[i] = (unsigned)(Rb * g.ldb + C) * 2u; }
    const size_t hstepA = (size_t)HALF * g.lda * 2, hstepB = (size_t)HALF * g.ldb * 2;
    const unsigned ldsw = (unsigned)wid * 1024u;
    const int aoff = lds_byte(wr * 64 + fr, fq * 8), boff = lds_byte(wc * 32 + fr, fq * 8);
    const char* gA = (const char*)g.A; const char* gB = (const char*)g.Bt;
#define PG8_SA(b, h) (((b) * 2 + (h)) * HTB)
#define PG8_SB(b, h) ((4 + (b) * 2 + (h)) * HTB)
#define PG8_STAGE(bufoff, gptr, voff) do { _Pragma("unroll") for (int _i = 0; _i < 2; ++_i) \
        __builtin_amdgcn_global_load_lds((const unsigned*)((gptr) + (size_t)(voff)[_i]), (LAS unsigned*)(lds + (bufoff) + ldsw + _i * 8192), 16, 0, 0); } while (0)
#define PG8_STAGE_B(bufoff, ub, h, kb) PG8_STAGE(bufoff, gB + (ub) + (size_t)(h) * hstepB + (size_t)(kb), laneB)
#define PG8_STAGE_A(bufoff, ub, va, h, kb) do { if constexpr (GA) { PG8_STAGE(bufoff, gA + (size_t)(kb), va[h]); } else { PG8_STAGE(bufoff, gA + (ub) + (size_t)(h) * hstepA + (size_t)(kb), laneA); } } while (0)
#define PG8_LDA(dst, b, h) do { _Pragma("unroll") for (int m = 0; m < 4; ++m) _Pragma("unroll") for (int k = 0; k < 2; ++k) dst[m][k] = *(const LAS bf16x8*)(lds + PG8_SA(b, h) + aoff + m * 2048 + k * 1024); } while (0)
#define PG8_LDB(dst, b, h) do { _Pragma("unroll") for (int n = 0; n < 2; ++n) _Pragma("unroll") for (int k = 0; k < 2; ++k) dst[n][k] = *(const LAS bf16x8*)(lds + PG8_SB(b, h) + boff + n * 2048 + k * 1024); } while (0)
#define PG8_MMA(ai, bj, At, Bt) do { __builtin_amdgcn_s_setprio(1); _Pragma("unroll") for (int m = 0; m < 4; ++m) _Pragma("unroll") for (int n = 0; n < 2; ++n) _Pragma("unroll") for (int k = 0; k < 2; ++k) \
        acc[ai][bj][m][n] = __builtin_amdgcn_mfma_f32_16x16x32_bf16(Bt[n][k], At[m][k], acc[ai][bj][m][n], 0, 0, 0); __builtin_amdgcn_s_setprio(0); } while (0)
#define PG8_WAIT_V(n) asm volatile("s_waitcnt vmcnt(" #n ")" ::: "memory")
#define PG8_WAIT_L(n) asm volatile("s_waitcnt lgkmcnt(" #n ")" ::: "memory")
#define PG8_BAR __builtin_amdgcn_s_barrier()
#define PG8_SCHED __builtin_amdgcn_sched_barrier(0)
#define PG8_OFFS(u, ubA, ubB, vA) do { ubB = ((size_t)S.rowB(u, 0) * (size_t)g.ldb) * 2; \
        if constexpr (GA) { ubA = 0; _Pragma("unroll") for (int _h = 0; _h < 2; ++_h) _Pragma("unroll") for (int _i = 0; _i < 2; ++_i) vA[_h][_i] = ((unsigned)S.rowA(u, _h * HALF + sR[_i]) * (unsigned)g.lda + (unsigned)sC[_i]) * 2u; } \
        else { ubA = ((size_t)S.rowA(u, 0) * (size_t)g.lda + (size_t)S.colA(u)) * 2; } } while (0)
    Unit cur, nxt; int ui = 0;
    if (!S.next(0, cur)) return;
    f32x4 acc[2][2][4][2];
#pragma unroll
    for (int a = 0; a < 2; ++a)
#pragma unroll
        for (int b = 0; b < 2; ++b)
#pragma unroll
            for (int m = 0; m < 4; ++m)
#pragma unroll
                for (int n = 0; n < 2; ++n) acc[a][b][m][n] = (f32x4){0.f, 0.f, 0.f, 0.f};
    bf16x8 At[4][2], B0[2][2], B1[2][2];
    size_t ubAc, ubBc, ubAn, ubBn; unsigned vAc[2][2] = {}, vAn[2][2] = {};
    PG8_OFFS(cur, ubAc, ubBc, vAc);
    PG8_STAGE_B(PG8_SB(0, 0), ubBc, 0, 0); PG8_STAGE_B(PG8_SB(0, 1), ubBc, 1, 0); PG8_STAGE_A(PG8_SA(0, 0), ubAc, vAc, 0, 0); PG8_STAGE_A(PG8_SA(0, 1), ubAc, vAc, 1, 0);
    if (wr == 1) PG8_BAR;
    PG8_WAIT_V(2); PG8_BAR;
    PG8_STAGE_B(PG8_SB(1, 0), ubBc, 0, 128); PG8_STAGE_A(PG8_SA(1, 0), ubAc, vAc, 0, 128); PG8_STAGE_B(PG8_SB(1, 1), ubBc, 1, 128);
    PG8_WAIT_V(6); PG8_BAR;
    for (;;) {
        const bool has_next = S.next(ui + 1, nxt);
        if (has_next) { PG8_OFFS(nxt, ubAn, ubBn, vAn); }
        else { ubAn = ubAc; ubBn = ubBc;
#pragma unroll
            for (int h = 0; h < 2; ++h)
#pragma unroll
                for (int i = 0; i < 2; ++i) vAn[h][i] = vAc[h][i]; }
        for (int t = 0; t < nt; t += 2) {
            const bool last = (t == nt - 2);
            const unsigned k1 = (unsigned)(t + 1) * 128u, k2 = last ? 0u : (unsigned)(t + 2) * 128u, k3 = k2 + 128u;
            const size_t xubA = last ? ubAn : ubAc, xubB = last ? ubBn : ubBc;
            unsigned xA[2][2];
#pragma unroll
            for (int h = 0; h < 2; ++h)
#pragma unroll
                for (int i = 0; i < 2; ++i) xA[h][i] = last ? vAn[h][i] : vAc[h][i];
            PG8_LDB(B0, 0, 0); PG8_LDB(B1, 0, 1); PG8_SCHED; PG8_LDA(At, 0, 0); PG8_STAGE_A(PG8_SA(1, 1), ubAc, vAc, 1, k1);
            PG8_WAIT_V(8); PG8_WAIT_L(0); PG8_BAR; PG8_MMA(0, 0, At, B0); PG8_MMA(0, 1, At, B1); PG8_BAR; PG8_SCHED;
            PG8_LDA(At, 0, 1); PG8_STAGE_B(PG8_SB(0, 0), xubB, 0, k2); PG8_STAGE_B(PG8_SB(0, 1), xubB, 1, k2); PG8_STAGE_A(PG8_SA(0, 0), xubA, xA, 0, k2);
            PG8_WAIT_V(8); PG8_WAIT_L(0); PG8_BAR; PG8_MMA(1, 0, At, B0); PG8_MMA(1, 1, At, B1); PG8_BAR; PG8_SCHED;
            PG8_LDB(B0, 1, 0); PG8_LDB(B1, 1, 1); PG8_SCHED; PG8_LDA(At, 1, 0); PG8_STAGE_A(PG8_SA(0, 1), xubA, xA, 1, k2);
            PG8_WAIT_V(8); PG8_WAIT_L(0); PG8_BAR; PG8_MMA(0, 0, At, B0); PG8_MMA(0, 1, At, B1); PG8_BAR; PG8_SCHED;
            PG8_LDA(At, 1, 1); PG8_STAGE_B(PG8_SB(1, 0), xubB, 0, k3); PG8_STAGE_B(PG8_SB(1, 1), xubB, 1, k3); PG8_STAGE_A(PG8_SA(1, 0), xubA, xA, 0, k3);
            PG8_WAIT_V(8); PG8_WAIT_L(0); PG8_BAR; PG8_MMA(1, 0, At, B0); PG8_MMA(1, 1, At, B1); PG8_BAR; PG8_SCHED;
        }
        if (wr == 0) PG8_BAR;
        E(acc, cur, wr, wc, fr, fq);
        if (!has_next) break;
#pragma unroll
        for (int a = 0; a < 2; ++a)
#pragma unroll
            for (int b = 0; b < 2; ++b)
#pragma unroll
                for (int m = 0; m < 4; ++m)
#pragma unroll
                    for (int n = 0; n < 2; ++n) acc[a][b][m][n] = (f32x4){0.f, 0.f, 0.f, 0.f};
        cur = nxt; ++ui; ubAc = ubAn; ubBc = ubBn;
#pragma unroll
        for (int h = 0; h < 2; ++h)
#pragma unroll
            for (int i = 0; i < 2; ++i) vAc[h][i] = vAn[h][i];
        if (wr == 1) PG8_BAR;
    }
    PG8_WAIT_V(0);
    PG8_BAR;
#undef PG8_SA
#undef PG8_SB
#undef PG8_STAGE
#undef PG8_STAGE_A
#undef PG8_STAGE_B
#undef PG8_LDA
#undef PG8_LDB
#undef PG8_MMA
#undef PG8_WAIT_V
#undef PG8_WAIT_L
#undef PG8_BAR
#undef PG8_SCHED
#undef PG8_OFFS
}
}
namespace pg8 {
struct EpiBf16 {
    static constexpr bool PERM = true;
    bf16_t* O; int ldc; int split_cols; size_t split_stride; float scale0;
    __device__ __forceinline__ void operator()(const f32x4 (&acc)[2][2][4][2], const Unit& u, int wr, int wc, int fr, int fq) const {
        const int row0 = u.pm * BM + wr * 64 + fr; int colt = u.pn * BM; bf16_t* base = O;
        float sc = 1.f; if (split_cols) { const int t = colt / split_cols; base += (size_t)t * split_stride; colt -= t * split_cols; if (t == 0) sc = scale0; }
        const int col0 = colt + wc * 32 + 8 * fq;
#pragma unroll
        for (int ai = 0; ai < 2; ++ai)
#pragma unroll
            for (int m = 0; m < 4; ++m) { bf16_t* rowp = base + (size_t)(row0 + ai * HALF + m * 16) * ldc + col0;
#pragma unroll
                for (int bj = 0; bj < 2; ++bj) { const f32x4 v0 = acc[ai][bj][m][0] * sc, v1 = acc[ai][bj][m][1] * sc;
                    u32x4 w; w.x = cvt_pk_bf16(v0[0], v0[1]); w.y = cvt_pk_bf16(v0[2], v0[3]); w.z = cvt_pk_bf16(v1[0], v1[1]); w.w = cvt_pk_bf16(v1[2], v1[3]);
                    *(u32x4*)(rowp + bj * HALF) = w; } }
    }
};
struct EpiFilt {
    static constexpr bool PERM = false;
    float* O;
    __device__ __forceinline__ void operator()(const f32x4 (&acc)[2][2][4][2], const Unit& u, int wr, int wc, int fr, int fq) const {
        const float dmin = -3.0701134573253945f, dmax = -15.350567286626973f;
#pragma unroll
        for (int ai = 0; ai < 2; ++ai)
#pragma unroll
            for (int m = 0; m < 4; ++m) { const int row = u.pm * BM + ai * HALF + wr * 64 + m * 16 + fr; const int c = row & 1023;
                const float delta = fabsf(dmin + (float)c * ((dmax - dmin) / 1023.0f));
#pragma unroll
                for (int bj = 0; bj < 2; ++bj)
#pragma unroll
                    for (int n = 0; n < 2; ++n) { const int col = u.pn * BM + bj * HALF + wc * 32 + n * 16 + 4 * fq; f32x4 v = acc[ai][bj][m][n];
#pragma unroll
                        for (int j = 0; j < 4; ++j) v[j] *= __expf(-(float)(col + j) * (1.0f / 8191.0f) * delta);
                        *(f32x4*)(O + (size_t)row * 8192 + col) = v; }
                asm volatile("" ::: "memory"); }
    }
};
struct EpiResF32 {
    static constexpr bool PERM = false;
    const float* res; float* O; int ldc; float alpha;
    __device__ __forceinline__ void operator()(const f32x4 (&acc)[2][2][4][2], const Unit& u, int wr, int wc, int fr, int fq) const {
#pragma unroll
        for (int ai = 0; ai < 2; ++ai)
#pragma unroll
            for (int m = 0; m < 4; ++m) { const size_t off = (size_t)(u.pm * BM + ai * HALF + wr * 64 + m * 16 + fr) * ldc + u.pn * BM + wc * 32 + 4 * fq;
#pragma unroll
                for (int bj = 0; bj < 2; ++bj)
#pragma unroll
                    for (int n = 0; n < 2; ++n) { const f32x4 r = *(const f32x4*)(res + off + bj * HALF + n * 16); *(f32x4*)(O + off + bj * HALF + n * 16) = r * alpha + acc[ai][bj][m][n]; }
                if (m & 1) asm volatile("" ::: "memory"); }
    }
};
struct EpiSwiglu {
    static constexpr bool PERM = true;
    bf16_t* O;
    __device__ __forceinline__ void operator()(const f32x4 (&acc)[2][2][4][2], const Unit& u, int wr, int wc, int fr, int fq) const {
#pragma unroll
        for (int ai = 0; ai < 2; ++ai)
#pragma unroll
            for (int m = 0; m < 4; ++m) { bf16_t* p = O + (size_t)(u.pm * BM + ai * HALF + wr * 64 + m * 16 + fr) * DFF + u.pn * HALF + wc * 32 + 8 * fq;
                float h[8];
#pragma unroll
                for (int n = 0; n < 2; ++n)
#pragma unroll
                    for (int j = 0; j < 4; ++j) { const float gt = acc[ai][0][m][n][j], up = acc[ai][1][m][n][j]; h[n * 4 + j] = gt * sigmoidf_(gt) * up; }
                u32x4 w; w.x = cvt_pk_bf16(h[0], h[1]); w.y = cvt_pk_bf16(h[2], h[3]); w.z = cvt_pk_bf16(h[4], h[5]); w.w = cvt_pk_bf16(h[6], h[7]);
                *(u32x4*)p = w; }
    }
};
struct EpiDown {
    static constexpr bool PERM = true;
    bf16_t* O; const int* rowlist; const float* gatew;
    __device__ __forceinline__ void operator()(const f32x4 (&acc)[2][2][4][2], const Unit& u, int wr, int wc, int fr, int fq) const {
#pragma unroll
        for (int ai = 0; ai < 2; ++ai)
#pragma unroll
            for (int m = 0; m < 4; ++m) { const int idx = u.t * BM + ai * HALF + wr * 64 + m * 16 + fr;
                if (idx < u.cnt) { const int a = rowlist[(size_t)u.e * ECAP + idx]; const float gw = gatew[a];
                    bf16_t* p = O + (size_t)a * DM + u.pn * BM + wc * 32 + 8 * fq;
#pragma unroll
                    for (int bj = 0; bj < 2; ++bj) { const f32x4 v0 = acc[ai][bj][m][0] * gw, v1 = acc[ai][bj][m][1] * gw;
                        u32x4 w; w.x = cvt_pk_bf16(v0[0], v0[1]); w.y = cvt_pk_bf16(v0[2], v0[3]); w.z = cvt_pk_bf16(v1[0], v1[1]); w.w = cvt_pk_bf16(v1[2], v1[3]);
                        *(u32x4*)(p + bj * HALF) = w; } } }
    }
};
struct EpiRG {
    static constexpr bool PERM = true;
    bf16_t* LA; bf16_t* BB; const bf16_t* XC; const float* ba; const float* bx; const float* lam;
    __device__ __forceinline__ void operator()(const f32x4 (&acc)[2][2][4][2], const Unit& u, int wr, int wc, int fr, int fq) const {
        const int nb = u.pn >> 2, q = u.pn & 3, dir = q >> 1, half = q & 1;
        const int ch0 = nb * 256 + half * HALF + wc * 32 + 8 * fq;
        float vba[8], vbx[8], vsp[8];
#pragma unroll
        for (int j = 0; j < 8; ++j) { vba[j] = ba[dir * DM + ch0 + j]; vbx[j] = bx[dir * DM + ch0 + j];
            const float x = __expf(-lam[dir * DM + ch0 + j]);
            vsp[j] = 8.0f * (x < 0.05f ? x * (1.0f - x * (0.5f - x * (0.33333334f - 0.25f * x))) : __logf(1.0f + x)); }
#pragma unroll
        for (int ai = 0; ai < 2; ++ai)
#pragma unroll
            for (int m = 0; m < 4; ++m) { const size_t tok = (size_t)(u.pm * BM + ai * HALF + wr * 64 + m * 16 + fr);
                asm volatile("" ::: "memory");
                const u32x4 xw = *(const u32x4*)(XC + tok * DM + ch0);
                float xf[8] = {bflo(xw.x), bfhi(xw.x), bflo(xw.y), bfhi(xw.y), bflo(xw.z), bfhi(xw.z), bflo(xw.w), bfhi(xw.w)};
                float la[8], bb[8];
#pragma unroll
                for (int n = 0; n < 2; ++n)
#pragma unroll
                    for (int j = 0; j < 4; ++j) { const int k = n * 4 + j;
                        const float r = sigmoidf_(acc[ai][0][m][n][j] + vba[k]), ig = sigmoidf_(acc[ai][1][m][n][j] + vbx[k]);
                        const float l = -r * vsp[k]; la[k] = l; bb[k] = sqrtf(fmaxf(1.0f - __expf(2.0f * l), 0.f)) * (ig * xf[k]); }
                u32x4 w; w.x = cvt_pk_bf16(la[0], la[1]); w.y = cvt_pk_bf16(la[2], la[3]); w.z = cvt_pk_bf16(la[4], la[5]); w.w = cvt_pk_bf16(la[6], la[7]);
                *(u32x4*)(LA + ((size_t)dir * NTOK + tok) * DM + ch0) = w;
                w.x = cvt_pk_bf16(bb[0], bb[1]); w.y = cvt_pk_bf16(bb[2], bb[3]); w.z = cvt_pk_bf16(bb[4], bb[5]); w.w = cvt_pk_bf16(bb[6], bb[7]);
                *(u32x4*)(BB + ((size_t)dir * NTOK + tok) * DM + ch0) = w; }
    }
};

struct RGOrder {
    static constexpr bool GATHER_A = false;
    int G, c;
    __device__ __forceinline__ bool next(int i, Unit& u) const { const int L = i * G + c; if (L >= 64 * 32) return false; u.pm = L >> 5; u.pn = L & 31; u.e = 0; u.t = 0; u.cnt = 0; return true; }
    __device__ __forceinline__ int rowA(const Unit& u, int r) const { return u.pm * BM + r; }
    __device__ __forceinline__ int colA(const Unit& u) const { return (u.pn >> 2) * 256; }
    __device__ __forceinline__ int rowB(const Unit& u, int r) const { return u.pn * BM + r; }
};
template <int NPN, bool GATHER>
struct MoeOrder {
    static constexpr bool GATHER_A = GATHER;
    int G, c; const LAS int* tab; const int* rowlist;
    __device__ __forceinline__ bool next(int i, Unit& u) const {
        const int L = i * G + c, ntile = tab[32]; if (L >= ntile * NPN) return false;
        const int tile = L / NPN; u.pm = tile; u.pn = L % NPN; int e = 0;
        while (e < 31 && tab[e + 1] <= tile) ++e;
        u.e = e; u.t = tile - tab[e]; u.cnt = tab[64 + e]; return true;
    }
    __device__ __forceinline__ int rowA(const Unit& u, int r) const {
        if (GATHER) { const int idx = u.t * BM + r; const int a = idx < u.cnt ? rowlist[(size_t)u.e * ECAP + idx] : 0; return a >> 1; }
        return u.pm * BM + r;
    }
    __device__ __forceinline__ int colA(const Unit&) const { return 0; }
    __device__ __forceinline__ int rowB(const Unit& u, int r) const { return (u.e * NPN + u.pn) * BM + r; }
};
}
namespace att {
constexpr int NW = 8, QBLK = 32, KVBLK = 64, LDQ = 1024, LDK = 1024, LDV = 1024, LDO = 1024;
constexpr int SHM_V = KVBLK * 128 * 2, SHM_K = KVBLK * 64 * 2, SHM_ATTN = 2 * SHM_V + 2 * SHM_K + NW * 64 * 4;
constexpr float THR2 = 8.0f * 1.4426950408889634f;
#define KSWZ64(row, colB) ((row) * 128 + ((colB) ^ ((((row) >> 1) & 7) << 4)))
#define SBAR() __builtin_amdgcn_sched_barrier(0)
__device__ __forceinline__ int crow(int r, int hi) { return (r & 3) + 8 * (r >> 2) + 4 * hi; }
__device__ __forceinline__ void qkt(f32x16& p0, f32x16& p1, const char* Ks, const bf16x8* qr, int r32, int hi, float A, float st) {
    { float b4[4];
#pragma unroll
      for (int j = 0; j < 4; ++j) b4[j] = fmaf(st, (float)j, A);
      const float s8 = 8.0f * st, s32 = 32.0f * st;
#pragma unroll
      for (int r = 0; r < 16; ++r) { p0[r] = (r < 4) ? b4[r] : p0[r - 4] + s8; }
#pragma unroll
      for (int r = 0; r < 16; ++r) p1[r] = p0[r] + s32; }
#pragma unroll
    for (int d0 = 0; d0 < 4; ++d0) { const int cb = (d0 * 16 + hi * 8) * 2;
        const bf16x8 b0 = *reinterpret_cast<const bf16x8*>(Ks + KSWZ64(r32, cb));
        const bf16x8 b1 = *reinterpret_cast<const bf16x8*>(Ks + KSWZ64(32 + r32, cb));
        p0 = __builtin_amdgcn_mfma_f32_32x32x16_bf16(b0, qr[d0], p0, 0, 0, 0);
        p1 = __builtin_amdgcn_mfma_f32_32x32x16_bf16(b1, qr[d0], p1, 0, 0, 0); }
}
__device__ __forceinline__ void partialSM(f32x16& p0, f32x16& p1, bool mixed, float fd, float sl2) {
    if (mixed) {
#pragma unroll
        for (int r = 0; r < 16; ++r) { const float d0 = fd - (float)((r & 3) + 8 * (r >> 2)); p0[r] = fmaf(fabsf(d0), -sl2, p0[r]); p1[r] = fmaf(fabsf(d0 - 32.0f), -sl2, p1[r]); }
    }
#pragma unroll
    for (int r = 0; r < 16; ++r) p0[r] = __builtin_amdgcn_exp2f(p0[r]);
}
__device__ __forceinline__ void finishSM(f32x16& p0, f32x16& p1, float& l_reg, bf16x8& pa0, bf16x8& pa1, bf16x8& pa2, bf16x8& pa3) {
#pragma unroll
    for (int r = 0; r < 16; ++r) p1[r] = __builtin_amdgcn_exp2f(p1[r]);
    float ps = 0;
#pragma unroll
    for (int r = 0; r < 16; ++r) ps += p0[r];
#pragma unroll
    for (int r = 0; r < 16; ++r) ps += p1[r];
    l_reg += ps;
#define PK4(P, BASE, OUT) do { unsigned a0 = cvt_pk_bf16(P[BASE + 0], P[BASE + 1]), a1 = cvt_pk_bf16(P[BASE + 2], P[BASE + 3]);   \
    unsigned b0 = cvt_pk_bf16(P[BASE + 4], P[BASE + 5]), b1 = cvt_pk_bf16(P[BASE + 6], P[BASE + 7]);                              \
    auto r0 = __builtin_amdgcn_permlane32_swap(a0, b0, false, false); auto r1 = __builtin_amdgcn_permlane32_swap(a1, b1, false, false); \
    u32x4 w = {r0[0], r1[0], r0[1], r1[1]}; OUT = __builtin_bit_cast(bf16x8, w); } while (0)
    PK4(p0, 0, pa0); PK4(p0, 8, pa1); PK4(p1, 0, pa2); PK4(p1, 8, pa3);
#undef PK4
}
__device__ __forceinline__ int v_st(int k, int c) { const int kk = (k & ~0xC) | ((k & 4) << 1) | ((k & 8) >> 1); return ((kk >> 3) * 4 + (c >> 5)) * 512 + ((kk & 7) * 32 + (c & 31)) * 2; }
__device__ __forceinline__ int v_rd_base(int lane) { return ((lane & 3) << 3) | (((lane >> 2) & 3) << 6) | (((lane >> 4) & 1) << 5) | (((lane >> 5) & 1) << 8); }
constexpr int v_rd_off(int d0, int ks, int half) { return d0 * 512 + ks * 4096 + half * 2048; }
template <int OFF> __device__ __forceinline__ s16x4 tr_read(int vb) {
    s16x4 r; asm volatile("ds_read_b64_tr_b16 %0, %1 offset:%2" : "=&v"(r) : "v"(vb), "i"(OFF) : "memory"); return r;
}
template <int D0> __device__ __forceinline__ void pv_one(f32x16& od, int vb, bf16x8 pa0, bf16x8 pa1, bf16x8 pa2, bf16x8 pa3) {
    const s16x4 l0 = tr_read<v_rd_off(D0, 0, 0)>(vb), h0 = tr_read<v_rd_off(D0, 0, 1)>(vb), l1 = tr_read<v_rd_off(D0, 1, 0)>(vb), h1 = tr_read<v_rd_off(D0, 1, 1)>(vb);
    const s16x4 l2 = tr_read<v_rd_off(D0, 2, 0)>(vb), h2 = tr_read<v_rd_off(D0, 2, 1)>(vb), l3 = tr_read<v_rd_off(D0, 3, 0)>(vb), h3 = tr_read<v_rd_off(D0, 3, 1)>(vb);
    asm volatile("s_waitcnt lgkmcnt(0)" ::: "memory"); SBAR();
#define PK(L, H) (bf16x8){L[0], L[1], L[2], L[3], H[0], H[1], H[2], H[3]}
    od = __builtin_amdgcn_mfma_f32_32x32x16_bf16(pa0, PK(l0, h0), od, 0, 0, 0);
    od = __builtin_amdgcn_mfma_f32_32x32x16_bf16(pa1, PK(l1, h1), od, 0, 0, 0);
    od = __builtin_amdgcn_mfma_f32_32x32x16_bf16(pa2, PK(l2, h2), od, 0, 0, 0);
    od = __builtin_amdgcn_mfma_f32_32x32x16_bf16(pa3, PK(l3, h3), od, 0, 0, 0);
#undef PK
}
__device__ __forceinline__ void pv_d0(f32x16* o, int vb, bf16x8 pa0, bf16x8 pa1, bf16x8 pa2, bf16x8 pa3) {
    pv_one<0>(o[0], vb, pa0, pa1, pa2, pa3); pv_one<1>(o[1], vb, pa0, pa1, pa2, pa3); pv_one<2>(o[2], vb, pa0, pa1, pa2, pa3); pv_one<3>(o[3], vb, pa0, pa1, pa2, pa3);
}
__device__ __forceinline__ void attn_unit(const bf16_t* __restrict__ Qb, const bf16_t* __restrict__ Kh, const bf16_t* __restrict__ Vh, bf16_t* __restrict__ Ob, int q0, int t_lo, int n, float sl2, char* lds) {
    const int tid = opaque_tid(), wid = __builtin_amdgcn_readfirstlane(tid >> 6), lane = tid & 63, r32 = lane & 31, hi = lane >> 5;
    char* V_lds = lds; char* K_lds = lds + 2 * SHM_V;
    float* ws = (float*)(lds + 2 * SHM_V + 2 * SHM_K) + wid * 64; float* li_l = ws;
    float l_reg = 0; f32x16 o[4] = {}; bf16x8 qr[4];
    const bf16_t* Qw = Qb + (long)(wid * QBLK + r32) * LDQ + hi * 8;
#pragma unroll
    for (int d0 = 0; d0 < 4; ++d0) qr[d0] = *reinterpret_cast<const bf16x8*>(Qw + d0 * 16);
    float negM;
    { const bf16_t* Kw = Kh + (long)(q0 + wid * QBLK + r32) * LDK + hi * 8; float s = 0.f;
#pragma unroll
      for (int d0 = 0; d0 < 4; ++d0) { const u32x4 kw = *reinterpret_cast<const u32x4*>(Kw + d0 * 16); const u32x4 qw = __builtin_bit_cast(u32x4, qr[d0]);
          s += bflo(kw.x) * bflo(qw.x) + bfhi(kw.x) * bfhi(qw.x) + bflo(kw.y) * bflo(qw.y) + bfhi(kw.y) * bfhi(qw.y) + bflo(kw.z) * bflo(qw.z) + bfhi(kw.z) * bfhi(qw.z) + bflo(kw.w) * bflo(qw.w) + bfhi(kw.w) * bfhi(qw.w); }
      auto rr = __builtin_amdgcn_permlane32_swap(__float_as_uint(s), __float_as_uint(s), false, false); negM = -(__uint_as_float(rr[0]) + __uint_as_float(rr[1])); }
    const int sr = tid >> 4, sc = (tid & 15) * 8, vst0 = v_st(2 * sr, sc), vst1 = v_st(2 * sr + 1, sc);
    const int kr = tid >> 3, kc = (tid & 7) * 8, kst = KSWZ64(kr, kc * 2);
    const unsigned voff = (unsigned)((2 * sr) * LDV + sc) * 2u, koff = (unsigned)(kr * LDK + kc) * 2u;
    const int vb0 = (int)(uintptr_t)V_lds + v_rd_base(lane);
    const int qw0 = q0 + wid * QBLK;
    const float fq0 = (float)(qw0 + r32 - 4 * hi);
    const bf16_t* Kt = Kh + (long)t_lo * KVBLK * LDK; const bf16_t* Vt = Vh + (long)t_lo * KVBLK * LDV;
    struct { bf16x8 vs0, vs1, ks; } sr_[1];
#define SLOAD(i, k0) do { const char* vb_ = (const char*)Vt + (size_t)(k0) * (LDV * 2); const char* kb_ = (const char*)Kt + (size_t)(k0) * (LDK * 2); \
    sr_[i].vs0 = *reinterpret_cast<const bf16x8*>(vb_ + voff); sr_[i].vs1 = *reinterpret_cast<const bf16x8*>(vb_ + voff + LDV * 2); \
    sr_[i].ks = *reinterpret_cast<const bf16x8*>(kb_ + koff); } while (0)
#define SWRITE(b, i) do { *(bf16x8*)(V_lds + (b) * SHM_V + vst0) = sr_[i].vs0; *(bf16x8*)(V_lds + (b) * SHM_V + vst1) = sr_[i].vs1; \
    *(bf16x8*)(K_lds + (b) * SHM_K + kst) = sr_[i].ks; } while (0)
#define SWAIT() asm volatile("s_waitcnt vmcnt(0)" ::: "memory")
#define TILE(jj) const int k0_ = (t_lo + (jj)) * KVBLK; const bool left_ = k0_ + 63 < qw0, right_ = k0_ > qw0 + 31, mixed_ = !(left_ || right_); \
    const float fd_ = fq0 - (float)k0_, st_ = left_ ? sl2 : (right_ ? -sl2 : 0.f), A_ = negM - st_ * fd_
    f32x16 pA0, pA1, pB0, pB1; bf16x8 pa0, pa1, pa2, pa3;
    constexpr int SE = 0, SO = 0;
    SLOAD(SE, 0); asm volatile("s_waitcnt vmcnt(0)" ::: "memory"); SWRITE(0, SE); __syncthreads();
    { TILE(0); qkt(pA0, pA1, K_lds, qr, r32, hi, A_, st_); partialSM(pA0, pA1, mixed_, fd_, sl2); }
    SLOAD(SO, KVBLK);
    SWAIT(); SWRITE(1, SO); __syncthreads();
    for (int j = 1; j + 1 < n; j += 2) {
        { TILE(j); SBAR(); qkt(pB0, pB1, K_lds + SHM_K, qr, r32, hi, A_, st_);
          finishSM(pA0, pA1, l_reg, pa0, pa1, pa2, pa3); SBAR();
          SLOAD(SO, (j + 1) * KVBLK); SBAR();
          pv_d0(o, vb0, pa0, pa1, pa2, pa3); partialSM(pB0, pB1, mixed_, fd_, sl2); }
        __syncthreads(); SWAIT(); SWRITE(0, SE);
        __syncthreads();
        { TILE(j + 1); SBAR(); qkt(pA0, pA1, K_lds, qr, r32, hi, A_, st_);
          finishSM(pB0, pB1, l_reg, pa0, pa1, pa2, pa3); SBAR();
          SLOAD(SE, (j + 2) * KVBLK); SBAR();
          pv_d0(o, vb0 + SHM_V, pa0, pa1, pa2, pa3); partialSM(pA0, pA1, mixed_, fd_, sl2); }
        __syncthreads(); SWAIT(); SWRITE(1, SO);
        __syncthreads();
    }
    { TILE(n - 1); SBAR(); qkt(pB0, pB1, K_lds + SHM_K, qr, r32, hi, A_, st_);
      finishSM(pA0, pA1, l_reg, pa0, pa1, pa2, pa3); SBAR();
      pv_d0(o, vb0, pa0, pa1, pa2, pa3); partialSM(pB0, pB1, mixed_, fd_, sl2); }
    finishSM(pB0, pB1, l_reg, pa0, pa1, pa2, pa3); SBAR();
    pv_d0(o, vb0 + SHM_V, pa0, pa1, pa2, pa3);
    { auto rr = __builtin_amdgcn_permlane32_swap(__float_as_uint(l_reg), __float_as_uint(l_reg), false, false); l_reg = __uint_as_float(rr[0]) + __uint_as_float(rr[1]); }
    if (hi == 0) li_l[r32] = l_reg; asm volatile("s_waitcnt lgkmcnt(0)" ::: "memory");
    float rli[16];
#pragma unroll
    for (int r = 0; r < 16; ++r) rli[r] = __builtin_amdgcn_rcpf(li_l[crow(r, hi)]);
    bf16_t* Ow = Ob + (long)(wid * QBLK) * LDO;
#pragma unroll
    for (int r = 0; r < 16; ++r) { const int orow = crow(r, hi);
#pragma unroll
        for (int d0 = 0; d0 < 4; ++d0) Ow[(long)orow * LDO + d0 * 32 + r32] = (bf16_t)f2bf(o[d0][r] * rli[r]); }
    __syncthreads();
#undef SLOAD
#undef SWRITE
#undef SWAIT
#undef TILE
}
#undef SBAR
}

namespace hy {
struct cf { float x, y; };
__device__ __forceinline__ cf lld(const LAS f32x2* L, int i) { const f32x2 t = L[i]; return cf{t[0], t[1]}; }
__device__ __forceinline__ void lst(LAS f32x2* L, int i, cf v) { L[i] = (f32x2){v.x, v.y}; }
__device__ __forceinline__ cf cmul(cf a, cf b) { return cf{a.x * b.x - a.y * b.y, a.x * b.y + a.y * b.x}; }
__device__ __forceinline__ cf cmulc(cf a, cf b) { return cf{a.x * b.x + a.y * b.y, a.y * b.x - a.x * b.y}; }
__device__ constexpr float C32[16] = {1.0f, 0.98078528040323043f, 0.92387953251128674f, 0.83146961230254524f, 0.70710678118654757f, 0.55557023301960229f, 0.38268343236508984f, 0.19509032201612833f,
                                      0.0f, -0.19509032201612819f, -0.38268343236508973f, -0.55557023301960196f, -0.70710678118654746f, -0.83146961230254535f, -0.92387953251128674f, -0.98078528040323043f};
__device__ constexpr float S32[16] = {0.0f, 0.19509032201612825f, 0.38268343236508978f, 0.55557023301960218f, 0.70710678118654746f, 0.83146961230254524f, 0.92387953251128674f, 0.98078528040323043f,
                                      1.0f, 0.98078528040323043f, 0.92387953251128674f, 0.83146961230254546f, 0.70710678118654757f, 0.55557023301960218f, 0.38268343236508989f, 0.19509032201612861f};
__host__ __device__ constexpr int brev(int k, int bits) { int r = 0; for (int i = 0; i < bits; ++i) r |= ((k >> i) & 1) << (bits - 1 - i); return r; }
template <int R, bool INV> __device__ __forceinline__ void dft_reg(cf (&v)[R]) {
#pragma unroll
    for (int s = R / 2; s >= 1; s >>= 1) {
#pragma unroll
        for (int g0 = 0; g0 < R; g0 += 2 * s) {
#pragma unroll
            for (int j = 0; j < s; ++j) {
                const cf a = v[g0 + j], b = v[g0 + j + s];
                v[g0 + j] = cf{a.x + b.x, a.y + b.y};
                const cf d = cf{a.x - b.x, a.y - b.y};
                const int tw = j * (16 / s);
                if (tw == 0) v[g0 + j + s] = d;
                else if (tw == 8) v[g0 + j + s] = INV ? cf{-d.y, d.x} : cf{d.y, -d.x};
                else { const float c = C32[tw], sn = S32[tw]; v[g0 + j + s] = INV ? cf{d.x * c - d.y * sn, d.y * c + d.x * sn} : cf{d.x * c + d.y * sn, d.y * c - d.x * sn}; }
            }
        }
    }
}
constexpr int RS = FFT_RS;
__device__ __forceinline__ void fft_fwd12(cf (&v)[32], LAS f32x2* L, int tid) {
    dft_reg<32, false>(v);
    { float s, c; sincospif((float)tid * (1.0f / 8192.0f), &s, &c); cf w1{c, -s}; asm volatile("" : "+v"(w1.x), "+v"(w1.y)); cf w = w1;
#pragma unroll
      for (int k1 = 0; k1 < 32; ++k1) { cf x = v[brev(k1, 5)]; if (k1) { x = cmul(x, w); w = cmul(w, w1); } lst(L, k1 * RS + tid, x); } }
    __syncthreads();
    const int k1 = tid >> 4, m2 = tid & 15;
#pragma unroll
    for (int m1 = 0; m1 < 32; ++m1) v[m1] = lld(L, k1 * RS + 16 * m1 + m2);
    __syncthreads();
    dft_reg<32, false>(v);
    { float s, c; sincospif((float)m2 * (1.0f / 256.0f), &s, &c); cf w1{c, -s}; asm volatile("" : "+v"(w1.x), "+v"(w1.y)); cf w = w1;
#pragma unroll
      for (int j1 = 0; j1 < 32; ++j1) { cf x = v[brev(j1, 5)]; if (j1) { x = cmul(x, w); w = cmul(w, w1); } lst(L, k1 * RS + 33 * m2 + j1, x); } }
    __syncthreads();
}
__device__ __forceinline__ void fft_inv21(cf (&v)[32], LAS f32x2* L, int tid) {
    const int k1 = tid >> 4, m2 = tid & 15;
    { float s, c; sincospif((float)m2 * (1.0f / 256.0f), &s, &c); cf w1{c, -s}; asm volatile("" : "+v"(w1.x), "+v"(w1.y)); cf w = w1;
#pragma unroll
      for (int j1 = 0; j1 < 32; ++j1) { cf x = lld(L, k1 * RS + 33 * m2 + j1); if (j1) { x = cmulc(x, w); w = cmul(w, w1); } v[j1] = x; } }
    __syncthreads();
    dft_reg<32, true>(v);
#pragma unroll
    for (int m1 = 0; m1 < 32; ++m1) lst(L, k1 * RS + 16 * m1 + m2, v[brev(m1, 5)]);
    __syncthreads();
    { float s, c; sincospif((float)tid * (1.0f / 8192.0f), &s, &c); cf w1{c, -s}; asm volatile("" : "+v"(w1.x), "+v"(w1.y)); cf w = w1;
#pragma unroll
      for (int kk = 0; kk < 32; ++kk) { cf x = lld(L, kk * RS + tid); if (kk) { x = cmulc(x, w); w = cmul(w, w1); } v[kk] = x; } }
    dft_reg<32, true>(v);
}
}
constexpr size_t MiB = 1u << 20;
constexpr size_t WS_CTL = 0, CTL_ZERO_BYTES = 1 * MiB;
constexpr size_t WS_W1T = 1 * MiB;
constexpr size_t WS_W2T = 257 * MiB;
constexpr size_t WS_WIN_EV = 385 * MiB, WS_WOUT_EV = 409 * MiB, WS_WIN_OD = 417 * MiB, WS_WOUT_OD = 433 * MiB, WS_WG_OD = 441 * MiB;
constexpr size_t AR = 445 * MiB;
constexpr size_t A_XB = AR + 0 * MiB, A_UHT = AR + 64 * MiB, A_QB = AR + 160 * MiB, A_KB = AR + 192 * MiB, A_VB = AR + 224 * MiB, A_KTD = AR + 256 * MiB, A_KF = AR + 384 * MiB,
                 A_H3B = AR + 512 * MiB, A_W4T = AR + 514 * MiB, A_YHT = AR + 256 * MiB, A_OA = AR + 288 * MiB, A_YCAT = AR + 0 * MiB, A_R0 = AR + 64 * MiB, A_H1_0 = AR + 192 * MiB,
                 A_HB_0 = AR + 320 * MiB, A_HID_0 = AR + 384 * MiB, A_ROWL = AR + 424 * MiB, A_GATEW = AR + 428 * MiB, A_Y2_0 = AR + 0 * MiB, A_H2 = AR + 448 * MiB, A_HB2 = AR + 128 * MiB;
constexpr size_t A_GB = AR + 0 * MiB, A_XR = AR + 64 * MiB, A_XC = AR + 192 * MiB, A_LA = AR + 256 * MiB, A_BB = AR + 64 * MiB, A_CAR = AR + 384 * MiB, A_YG = AR + 192 * MiB, A_R1 = AR + 256 * MiB,
                 A_H1_1 = AR + 0 * MiB, A_HB_1 = AR + 128 * MiB, A_HID_1 = AR + 192 * MiB, A_Y2_1 = AR + 256 * MiB;
constexpr size_t WS_END = AR + 576 * MiB;
constexpr int CW_BAR = 4096, CW_CNT = 16384, CW_NORM = 24576;
constexpr int LDS_MISC = 139264, LDS_BYTES = 147456;
constexpr int NPHASE = 21;

struct Args { const float* in[37]; float* out; unsigned char* ws; int ph_lo, ph_hi; };
typedef const __attribute__((address_space(4))) Args& KArgs;

__device__ __forceinline__ void transpose_item(const float* W, int N, int k0, int n0, bf16_t* WT, int ldk, int drow0, LAS float* scr, int lane) {
#pragma unroll 8
    for (int i = 0; i < 32; ++i) { const int kk = 2 * i + (lane >> 5); scr[kk * 33 + (lane & 31)] = W[(size_t)(k0 + kk) * N + n0 + (lane & 31)]; }
    LDS_WAIT(); asm volatile("" ::: "memory");
    const int c = lane & 7;
#pragma unroll
    for (int j = 0; j < 4; ++j) { const int n = (lane >> 3) + 8 * j; const LAS float* s = scr + (8 * c) * 33 + n;
        u32x4 o; o.x = pk2(s[0 * 33], s[1 * 33]); o.y = pk2(s[2 * 33], s[3 * 33]); o.z = pk2(s[4 * 33], s[5 * 33]); o.w = pk2(s[6 * 33], s[7 * 33]);
        *(u32x4*)(WT + (size_t)(drow0 + n) * ldk + k0 + 8 * c) = o; }
    LDS_WAIT(); asm volatile("" ::: "memory");
}

__device__ __forceinline__ void phase_prologue(KArgs a, LAS unsigned char* lds) {
    const int tid = opaque_tid(), lane = tid & 63, wave = tid >> 6, G = gridDim.x;
    const int gw = blockIdx.x * 8 + wave, NGW = G * 8;
    unsigned char* ws = a.ws;
    LAS float* scr = (LAS float*)(lds + wave * 16384);
    constexpr int I_EVIN = 32 * 192, I_SQ = 32 * 64, I_ODIN = 32 * 128, I_MOE_GU = 64 * 512, I_MOE_D = 64 * 512, I_RG = 16 * 32, I_W4 = 128;
    constexpr int O1 = I_EVIN, O2 = O1 + I_SQ, O3 = O2 + I_ODIN, O4 = O3 + I_SQ, O5 = O4 + I_MOE_GU, O6 = O5 + I_MOE_GU, O7 = O6 + I_MOE_D, O8 = O7 + I_RG, O9 = O8 + I_RG, O10 = O9 + I_W4;
    for (int it = gw; it < O10; it += NGW) {
        if (it < O1) { const int kb = it / 192, nb = it % 192; transpose_item(a.in[1], EV_IN, kb * 64, nb * 32, (bf16_t*)(ws + WS_WIN_EV), DM, nb * 32, scr, lane); }
        else if (it < O2) { const int r = it - O1, kb = r / 64, nb = r % 64; transpose_item(a.in[18], DM, kb * 64, nb * 32, (bf16_t*)(ws + WS_WOUT_EV), DM, nb * 32, scr, lane); }
        else if (it < O3) { const int r = it - O2, kb = r / 128, nb = r % 128; transpose_item(a.in[19], 2 * DM, kb * 64, nb * 32, (bf16_t*)(ws + WS_WIN_OD), DM, nb * 32, scr, lane); }
        else if (it < O4) { const int r = it - O3, kb = r / 64, nb = r % 64; transpose_item(a.in[27], DM, kb * 64, nb * 32, (bf16_t*)(ws + WS_WOUT_OD), DM, nb * 32, scr, lane); }
        else if (it < O6) { const bool up = it >= O5; const int r = it - (up ? O5 : O4), le = r / 512, q = r % 512, kb = q / 16, nb = q % 16, n0 = nb * 32;
            transpose_item((up ? a.in[35] : a.in[34]) + (size_t)le * DM * DFF, DFF, kb * 64, n0, (bf16_t*)(ws + WS_W1T) + (size_t)le * 1024 * DM, DM, (n0 >> 7) * 256 + (n0 & 127) + (up ? 128 : 0), scr, lane); }
        else if (it < O7) { const int r = it - O6, le = r / 512, q = r % 512, kb = q / 64, nb = q % 64;
            transpose_item(a.in[36] + (size_t)le * DFF * DM, DM, kb * 64, nb * 32, (bf16_t*)(ws + WS_W2T) + (size_t)le * DM * DFF, DFF, nb * 32, scr, lane); }
        else if (it < O9) { const bool wx = it >= O8; const int r = it - (wx ? O8 : O7), dn = r / 32, q = r % 32, kb = q / 8, nb = q % 8, n0 = nb * 32, dir = dn / 8, n = dn % 8;
            transpose_item((wx ? a.in[24] : a.in[22]) + (size_t)dn * 65536, 256, kb * 64, n0, (bf16_t*)(ws + WS_WG_OD), 256, (n * 4 + dir * 2 + (n0 >> 7)) * 256 + (n0 & 127) + (wx ? 128 : 0), scr, lane); }
        else { const int nb = it - O9; transpose_item(a.in[11], 4096, 0, nb * 32, (bf16_t*)(ws + A_W4T), 128, nb * 32, scr, lane); }
    }
    { const int gt = blockIdx.x * 512 + tid, NT = G * 512;
      for (int i = gt; i < 4096 * 8; i += NT) { const int r = i >> 3, c = i & 7; *(u32x4*)((bf16_t*)(ws + A_W4T) + (size_t)r * 128 + 64 + c * 8) = (u32x4){0u, 0u, 0u, 0u}; }
      for (int i = gt; i < 8192 * 8; i += NT) { const int r = i >> 3, c = i & 7; *(u32x4*)((bf16_t*)(ws + A_H3B) + (size_t)r * 128 + 64 + c * 8) = (u32x4){0u, 0u, 0u, 0u}; }
      const f32x8* x8 = (const f32x8*)a.in[0]; u32x4* xb = (u32x4*)(ws + A_XB);
      for (int i = gt; i < NTOK * DM / 8; i += NT) { const f32x8 v = x8[i]; u32x4 o; o.x = pk2(v[0], v[1]); o.y = pk2(v[2], v[3]); o.z = pk2(v[4], v[5]); o.w = pk2(v[6], v[7]); xb[i] = o; } }
    { const float* w1 = a.in[4]; const float* b1 = a.in[5]; const float* w2 = a.in[6]; const float* b2 = a.in[7]; const float* w3 = a.in[8]; const float* b3 = a.in[9]; const float* fr = a.in[10];
      const float frq = fr[lane];
      for (int t = gw; t < SEQ; t += NGW) {
          float z;
          { const float tl = (float)t * (1.0f / 8191.0f);
            if (lane == 0) z = tl;
            else { const int j = (lane - 1) & 15; const float band = 1e-4f + (float)j * ((15.0f - 1e-4f) / 15.0f);
                   const float ang = (6.283185307179586f * (float)t * (1.0f / 8192.0f)) * band; float sn, cs; sincosf(ang, &sn, &cs); z = (lane <= 16) ? cs : -sn; } }
          float acc = b1[lane];
#pragma unroll
          for (int i = 0; i < 33; ++i) acc += __shfl(z, i) * w1[i * 64 + lane];
          float h = sinf(frq * acc);
          acc = b2[lane];
#pragma unroll 16
          for (int i = 0; i < 64; ++i) acc += __shfl(h, i) * w2[i * 64 + lane];
          h = sinf(frq * acc);
          acc = b3[lane];
#pragma unroll 16
          for (int i = 0; i < 64; ++i) acc += __shfl(h, i) * w3[i * 64 + lane];
          h = sinf(frq * acc);
          ((bf16_t*)(ws + A_H3B))[(size_t)t * 128 + lane] = (bf16_t)f2bf(h);
      } }
}

__device__ __forceinline__ void phase_filter_fft(KArgs a, LAS unsigned char* lds) {
    const int tid = opaque_tid(), lane = tid & 63, wave = tid >> 6, G = gridDim.x;
    LAS f32x2* L = (LAS f32x2*)lds; LAS float* red = (LAS float*)(lds + LDS_MISC + 1024);
    const float* KTD = (const float*)(a.ws + A_KTD); __half2* KF = (__half2*)(a.ws + A_KF);
    for (int u = blockIdx.x; u < 2048; u += G) {
        const int o = u >> 10, c = u & 1023;
        int tl = tid; asm volatile("" : "+v"(tl));
        const float* rowF = KTD + (size_t)(o * 1024 + c) * 8192; const float* rowB = KTD + (size_t)(2048 + o * 1024 + c) * 8192;
        hy::cf v[32]; float ss = 0.f;
#pragma unroll
        for (int n1 = 0; n1 < 32; ++n1) { const int p = tl + 512 * n1; float val;
            if (n1 < 16) val = rowF[p]; else if (p == 8192) val = 0.f; else val = rowB[16384 - p];
            v[n1] = hy::cf{val, 0.f}; ss += val * val; }
        ss = wave_sum(ss); if (lane == 0) red[wave] = ss; __syncthreads();
        float tot = 0.f;
#pragma unroll
        for (int w = 0; w < 8; ++w) tot += red[w];
        const float scale = rsqrtf(tot), skp = a.in[12][u];
        hy::fft_fwd12(v, L, tl);
#pragma unroll
        for (int bf = 0; bf < 2; ++bf) { const int idx = bf * 512 + tl, k1 = idx >> 5, j1 = idx & 31; hy::cf w[16];
#pragma unroll
            for (int m2 = 0; m2 < 16; ++m2) w[m2] = hy::lld(L, k1 * hy::RS + 33 * m2 + j1);
            hy::dft_reg<16, false>(w);
#pragma unroll
            for (int j2 = 0; j2 < 16; ++j2) { const hy::cf x = w[hy::brev(j2, 4)]; KF[((size_t)(u * 2 + bf) * 16 + j2) * 512 + tl] = __floats2half2_rn(x.x * scale + skp, x.y * scale); } }
        __syncthreads();
    }
}
__device__ __forceinline__ float hyconv(const bf16_t* row, int t, float w0, float w1, float w2, float bias) {
    const unsigned tm = (unsigned)(t > 0 ? t - 1 : 0), tp = (unsigned)(t < SEQ - 1 ? t + 1 : SEQ - 1);
    float xm = bf2f(row[tm]), x0 = bf2f(row[(unsigned)t]), xp = bf2f(row[tp]);
    xm = t > 0 ? xm : 0.f; xp = t < SEQ - 1 ? xp : 0.f;
    return w0 * xm + w1 * x0 + w2 * xp + bias;
}
__device__ __forceinline__ void phase_hyena_mixer(KArgs a, LAS unsigned char* lds) {
    const int tid = opaque_tid(), G = gridDim.x;
    LAS f32x2* L = (LAS f32x2*)lds;
    const bf16_t* UHT = (const bf16_t*)(a.ws + A_UHT); const __half2* KF = (const __half2*)(a.ws + A_KF); bf16_t* YHT = (bf16_t*)(a.ws + A_YHT);
    const float* cw = a.in[2]; const float* cb = a.in[3];
    for (int c = blockIdx.x; c < HY_CH; c += G) {
        int tl = tid; asm volatile("" : "+v"(tl));
        hy::cf v[32];
        { const bf16_t* r0 = UHT + (size_t)c * NTOK; const float w0 = cw[c], w1 = cw[3072 + c], w2 = cw[6144 + c], bb = cb[c];
#pragma unroll
          for (int n1 = 0; n1 < 16; ++n1) { const int t = tl + 512 * n1; v[n1] = hy::cf{hyconv(r0, t, w0, w1, w2, bb), hyconv(r0 + SEQ, t, w0, w1, w2, bb)}; if ((n1 & 3) == 3) asm volatile("" ::: "memory"); } }
#pragma unroll 1
        for (int o = 0; o < 2; ++o) {
#pragma unroll
            for (int n1 = 16; n1 < 32; ++n1) v[n1] = hy::cf{0.f, 0.f};
            hy::fft_fwd12(v, L, tl);
#pragma unroll
            for (int bf = 0; bf < 2; ++bf) { const int idx = bf * 512 + tl, k1 = idx >> 5, j1 = idx & 31; hy::cf w[16];
#pragma unroll
                for (int m2 = 0; m2 < 16; ++m2) w[m2] = hy::lld(L, k1 * hy::RS + 33 * m2 + j1);
                hy::dft_reg<16, false>(w);
                asm volatile("" ::: "memory");
                hy::cf y[16];
#pragma unroll
                for (int j2 = 0; j2 < 16; ++j2) { const float2 kf = __half22float2(KF[((size_t)((o * 1024 + c) * 2 + bf) * 16 + j2) * 512 + tl]);
                    y[j2] = hy::cmul(w[hy::brev(j2, 4)], hy::cf{kf.x, kf.y}); }
                hy::dft_reg<16, true>(y);
#pragma unroll
                for (int m2 = 0; m2 < 16; ++m2) hy::lst(L, k1 * hy::RS + 33 * m2 + j1, y[hy::brev(m2, 4)]); }
            __syncthreads();
            hy::fft_inv21(v, L, tl);
            const int gch = (o + 1) * 1024 + c; const bf16_t* rg = UHT + (size_t)gch * NTOK;
            const float w0 = cw[gch], w1 = cw[3072 + gch], w2 = cw[6144 + gch], bb = cb[gch];
            hy::cf zn[16]; int tg = tl; asm volatile("" : "+v"(tg));
#pragma unroll
            for (int n1 = 0; n1 < 16; ++n1) { const int t = tg + 512 * n1; const hy::cf y = v[hy::brev(n1, 5)];
                const float g0 = hyconv(rg, t, w0, w1, w2, bb), g1 = hyconv(rg + SEQ, t, w0, w1, w2, bb);
                zn[n1] = hy::cf{g0 * y.x * (1.0f / 16384.0f), g1 * y.y * (1.0f / 16384.0f)}; if ((n1 & 3) == 3) asm volatile("" ::: "memory"); }
#pragma unroll
            for (int n1 = 0; n1 < 16; ++n1) v[n1] = zn[n1];
        }
        bf16_t* yo = YHT + (size_t)c * NTOK;
#pragma unroll
        for (int n1 = 0; n1 < 16; ++n1) { const int t = tl + 512 * n1; yo[t] = (bf16_t)f2bf(v[n1].x); yo[SEQ + t] = (bf16_t)f2bf(v[n1].y); }
    }
    __syncthreads();
}
__device__ __forceinline__ void phase_qknorm(KArgs a, LAS unsigned char* lds) {
    const int tid = opaque_tid(), lane = tid & 63, wave = tid >> 6, gw = blockIdx.x * 8 + wave, NGW = gridDim.x * 8;
    LAS unsigned* red = (LAS unsigned*)(lds + LDS_MISC + 1536);
    unsigned* ctl = (unsigned*)(a.ws + WS_CTL);
    if (tid < 64) red[tid] = 0u;
    __syncthreads();
    for (int which = 0; which < 2; ++which) { const bf16_t* P = (const bf16_t*)(a.ws + (which ? A_KB : A_QB));
        for (int b = 0; b < 2; ++b) { float mx = 0.f;
            for (int row = gw; row < SEQ; row += NGW) { const bf16_t* p = P + ((size_t)b * SEQ + row) * 1024 + lane * 16;
                const u32x4 w0 = *(const u32x4*)p, w1 = *(const u32x4*)(p + 8); const unsigned ww[8] = {w0.x, w0.y, w0.z, w0.w, w1.x, w1.y, w1.z, w1.w};
                float ss = 0.f;
#pragma unroll
                for (int i = 0; i < 8; ++i) { const float x = bflo(ww[i]), y = bfhi(ww[i]); ss += x * x + y * y; }
                ss += __shfl_xor(ss, 1); ss += __shfl_xor(ss, 2); mx = fmaxf(mx, ss); }
            if ((lane & 3) == 0) atomicMax((unsigned*)&red[which * 32 + b * 16 + (lane >> 2)], __float_as_uint(mx)); } }
    __syncthreads();
    if (tid < 64) atomicMax(ctl + CW_NORM + tid, red[tid]);
}
__device__ __forceinline__ void phase_attention(KArgs a, LAS unsigned char* lds) {
    const int G = gridDim.x, bx = blockIdx.x;
    const bf16_t* QB = (const bf16_t*)(a.ws + A_QB); const bf16_t* KB = (const bf16_t*)(a.ws + A_KB); const bf16_t* VB = (const bf16_t*)(a.ws + A_VB); bf16_t* OA = (bf16_t*)(a.ws + A_OA);
    const unsigned* nrm = (const unsigned*)(a.ws + WS_CTL) + CW_NORM;
    for (int i = 0;; ++i) {
        int bhc, qb;
        if (G == 256) { if (i >= 4) break;
            const int x = bx & 7, pr = x >> 1, b = x & 1, h = (i < 2) ? 7 - pr : pr, cm = i & 1; bhc = b * 16 + h * 2 + cm; qb = bx >> 3; }
        else { const int Lu = i * G + bx; if (Lu >= 1024) break; bhc = Lu >> 5; qb = Lu & 31; }
        const int b = bhc >> 4, h = (bhc >> 1) & 7, cm = bhc & 1;
        const size_t rowq = (size_t)b * SEQ + (size_t)qb * 256;
        const float sl2 = exp2f(-(float)(h + 1)) * 1.4426950408889634f;
        const float qk = sqrtf(__uint_as_float(nrm[bhc]) * __uint_as_float(nrm[32 + bhc]));
        const float Wk = (2.0f * qk + 46.0f) / sl2, q0f = (float)(qb * 256);
        int t_lo = (int)fmaxf(floorf((q0f - Wk - 63.0f) * (1.0f / 64.0f)), 0.0f), t_hi = (int)fminf(ceilf((q0f + 255.0f + Wk) * (1.0f / 64.0f)), 127.0f);
        if (((t_hi - t_lo + 1) & 1) != 0) { if (t_hi < 127) ++t_hi; else --t_lo; }
        att::attn_unit(QB + rowq * 1024 + h * 128 + cm * 64, KB + (size_t)b * SEQ * 1024 + h * 128 + cm * 64, VB + (size_t)b * SEQ * 1024 + h * 128,
                       OA + (size_t)cm * NTOK * 1024 + rowq * 1024 + h * 128, qb * 256, t_lo, t_hi - t_lo + 1, sl2, (char*)lds);
    }
}
__device__ __forceinline__ void phase_concat(KArgs a, LAS unsigned char* lds) {
    const int tid = opaque_tid(), lane = tid & 63, wave = tid >> 6, G = gridDim.x;
    const bf16_t* YHT = (const bf16_t*)(a.ws + A_YHT); const bf16_t* OA0 = (const bf16_t*)(a.ws + A_OA); const bf16_t* OA1 = OA0 + (size_t)NTOK * 1024; bf16_t* YC = (bf16_t*)(a.ws + A_YCAT);
    LAS bf16_t* T = (LAS bf16_t*)lds;
    const float lambda_init = 0.2f;
    const float lam = __expf(wave_sum(a.in[13][lane] * a.in[14][lane])) - __expf(wave_sum(a.in[15][lane] * a.in[16][lane])) + lambda_init;
    float gl[16];
#pragma unroll
    for (int i = 0; i < 16; ++i) gl[i] = a.in[17][(lane & 7) * 16 + i] * (1.0f - lambda_init);
    for (int it = blockIdx.x; it < NTOK / 64; it += G) {
        const int tok0 = it * 64;
#pragma unroll 4
        for (int k = 0; k < 16; ++k) { const int idx = tid + 512 * k, c = idx >> 3, ch = idx & 7;
            const u32x4 w = *(const u32x4*)(YHT + (size_t)c * NTOK + tok0 + ch * 8);
            LAS bf16_t* d = T + (ch * 8) * 1026 + c;
            d[0 * 1026] = (bf16_t)(w.x & 0xffff); d[1 * 1026] = (bf16_t)(w.x >> 16); d[2 * 1026] = (bf16_t)(w.y & 0xffff); d[3 * 1026] = (bf16_t)(w.y >> 16);
            d[4 * 1026] = (bf16_t)(w.z & 0xffff); d[5 * 1026] = (bf16_t)(w.z >> 16); d[6 * 1026] = (bf16_t)(w.w & 0xffff); d[7 * 1026] = (bf16_t)(w.w >> 16); }
        __syncthreads();
#pragma unroll 4
        for (int k = 0; k < 16; ++k) { const int idx = tid + 512 * k, tl = idx >> 7, c8 = idx & 127;
            const LAS unsigned* s = (const LAS unsigned*)(T + tl * 1026 + c8 * 8);
            u32x4 w; w.x = s[0]; w.y = s[1]; w.z = s[2]; w.w = s[3];
            *(u32x4*)(YC + (size_t)(tok0 + tl) * DM + c8 * 8) = w; }
        for (int rr = 0; rr < 8; ++rr) { const size_t tok = (size_t)tok0 + wave * 8 + rr;
            const u32x4 p0 = *(const u32x4*)(OA0 + tok * 1024 + lane * 16), p1 = *(const u32x4*)(OA0 + tok * 1024 + lane * 16 + 8);
            const u32x4 q0 = *(const u32x4*)(OA1 + tok * 1024 + lane * 16), q1 = *(const u32x4*)(OA1 + tok * 1024 + lane * 16 + 8);
            const unsigned pw[8] = {p0.x, p0.y, p0.z, p0.w, p1.x, p1.y, p1.z, p1.w}, qw[8] = {q0.x, q0.y, q0.z, q0.w, q1.x, q1.y, q1.z, q1.w};
            float o[16]; float ss = 0.f;
#pragma unroll
            for (int i = 0; i < 8; ++i) { o[2 * i] = bflo(pw[i]) - lam * bflo(qw[i]); o[2 * i + 1] = bfhi(pw[i]) - lam * bfhi(qw[i]); ss += o[2 * i] * o[2 * i] + o[2 * i + 1] * o[2 * i + 1]; }
            ss += __shfl_xor(ss, 1); ss += __shfl_xor(ss, 2); ss += __shfl_xor(ss, 4);
            const float rs = rsqrtf(ss * (1.0f / 128.0f) + LN_EPS);
            u32x4 w0, w1;
            w0.x = pk2(o[0] * rs * gl[0], o[1] * rs * gl[1]); w0.y = pk2(o[2] * rs * gl[2], o[3] * rs * gl[3]); w0.z = pk2(o[4] * rs * gl[4], o[5] * rs * gl[5]); w0.w = pk2(o[6] * rs * gl[6], o[7] * rs * gl[7]);
            w1.x = pk2(o[8] * rs * gl[8], o[9] * rs * gl[9]); w1.y = pk2(o[10] * rs * gl[10], o[11] * rs * gl[11]); w1.z = pk2(o[12] * rs * gl[12], o[13] * rs * gl[13]); w1.w = pk2(o[14] * rs * gl[14], o[15] * rs * gl[15]);
            *(u32x4*)(YC + tok * DM + 1024 + lane * 16) = w0; *(u32x4*)(YC + tok * DM + 1024 + lane * 16 + 8) = w1; }
        __syncthreads();
    }
}
__device__ __forceinline__ void ln_row(f32x4 (&v)[8], const float* g, const float* b, int lane) {
    float s = 0.f;
#pragma unroll
    for (int j = 0; j < 8; ++j) s += (v[j][0] + v[j][1]) + (v[j][2] + v[j][3]);
    const float mean = wave_sum(s) * (1.0f / DM); float s2 = 0.f;
#pragma unroll
    for (int j = 0; j < 8; ++j) { v[j] = v[j] - mean; s2 += (v[j][0] * v[j][0] + v[j][1] * v[j][1]) + (v[j][2] * v[j][2] + v[j][3] * v[j][3]); }
    const float rstd = rsqrtf(wave_sum(s2) * (1.0f / DM) + LN_EPS);
#pragma unroll
    for (int j = 0; j < 8; ++j) { const f32x4 gg = *(const f32x4*)(g + 4 * (lane + 64 * j)), bb = *(const f32x4*)(b + 4 * (lane + 64 * j)); v[j] = v[j] * rstd * gg + bb; }
}
__device__ __forceinline__ void phase_ln_router(KArgs a, LAS unsigned char* lds, const float* R, const float* g, const float* b, float* H1, bf16_t* HB, unsigned* cnt, int* rowlist, float* gatew) {
    const int tid = opaque_tid(), lane = tid & 63, wave = tid >> 6, G = gridDim.x;
    const float* rw = a.in[32]; const float* rb = a.in[33];
    LAS float* part = (LAS float*)lds;
    LAS int* hist = (LAS int*)(lds + 40960); LAS int* base = hist + 32;
    for (int it = blockIdx.x; it < NTOK / 32; it += G) {
        const int tok0 = it * 32;
        for (int rr = 0; rr < 4; ++rr) { const size_t row = (size_t)tok0 + wave * 4 + rr; f32x4 v[8];
#pragma unroll
            for (int j = 0; j < 8; ++j) v[j] = *(const f32x4*)(R + row * DM + 4 * (lane + 64 * j));
            ln_row(v, g, b, lane);
#pragma unroll
            for (int j = 0; j < 8; ++j) { *(f32x4*)(H1 + row * DM + 4 * (lane + 64 * j)) = v[j]; u32x2 w; w.x = pk2(v[j][0], v[j][1]); w.y = pk2(v[j][2], v[j][3]); *(u32x2*)(HB + row * DM + 4 * (lane + 64 * j)) = w; } }
        if (tid < 32) hist[tid] = 0;
        VM_WAIT(); __syncthreads();
        { const int i = lane & 31, kk = lane >> 5; f32x16 acc = {};
          const float* hrow = H1 + (size_t)(tok0 + i) * DM + wave * 256 + 4 * kk; const float* rwp = rw + (size_t)(wave * 256 + 4 * kk) * NEXP + i;
#pragma unroll 4
          for (int s = 0; s < 32; ++s) { const f32x4 hv = __builtin_nontemporal_load((const f32x4*)(hrow + 8 * s));
#pragma unroll
              for (int j = 0; j < 4; ++j) acc = __builtin_amdgcn_mfma_f32_32x32x2f32(rwp[(size_t)(8 * s + j) * NEXP], hv[j], acc, 0, 0, 0); }
#pragma unroll
          for (int r = 0; r < 16; ++r) part[(wave * 32 + i) * 33 + (r & 3) + 8 * (r >> 2) + 4 * kk] = acc[r]; }
        __syncthreads();
        int e1 = 0, e2 = 0, r1 = 0, r2 = 0; float g1 = 0.f, g2 = 0.f;
        if (tid < 32) {
            float bestg = -1e30f;
#pragma unroll
            for (int gi = 0; gi < 4; ++gi) { float m1 = -1e30f, m2 = -1e30f, s1 = 0.f, s2 = 0.f; int i1 = 0, i2 = 0;
#pragma unroll
                for (int j = 0; j < 8; ++j) { const int e = gi * 8 + j; float lg = 0.f;
#pragma unroll
                    for (int w = 0; w < 8; ++w) lg += part[(w * 32 + tid) * 33 + e];
                    const float sg = 1.0f / (1.0f + expf(-lg)), sl = sg + rb[e];
                    if (sl > m1) { m2 = m1; i2 = i1; s2 = s1; m1 = sl; i1 = j; s1 = sg; } else if (sl > m2) { m2 = sl; i2 = j; s2 = sg; } }
                const float gs = m1 + m2;
                if (gs > bestg) { bestg = gs; e1 = gi * 8 + i1; e2 = gi * 8 + i2; g1 = s1; g2 = s2; } }
            const float inv = 1.0f / (g1 + g2); g1 *= inv; g2 *= inv;
            r1 = atomicAdd((int*)&hist[e1], 1); r2 = atomicAdd((int*)&hist[e2], 1);
        }
        __syncthreads();
        if (tid < 32) { const int hc = hist[tid]; base[tid] = hc ? (int)__hip_atomic_fetch_add(cnt + tid * 64, (unsigned)hc, __ATOMIC_RELAXED, __HIP_MEMORY_SCOPE_AGENT) : 0; }
        __syncthreads();
        if (tid < 32) { const int a0 = (tok0 + tid) * 2;
            rowlist[(size_t)e1 * ECAP + base[e1] + r1] = a0; gatew[a0] = g1;
            rowlist[(size_t)e2 * ECAP + base[e2] + r2] = a0 + 1; gatew[a0 + 1] = g2; }
        __syncthreads();
    }
}
__device__ __forceinline__ void phase_ln2(const float* H1, const bf16_t* Y2, const float* g, const float* b, float* OUT, bf16_t* OB) {
    const int tid = opaque_tid(), lane = tid & 63, wave = tid >> 6;
    for (int row = blockIdx.x * 8 + wave; row < NTOK; row += gridDim.x * 8) { f32x4 v[8];
#pragma unroll
        for (int j = 0; j < 8; ++j) { const int c = 4 * (lane + 64 * j); const f32x4 h = *(const f32x4*)(H1 + (size_t)row * DM + c);
            const u32x2 y0 = *(const u32x2*)(Y2 + (size_t)(2 * row) * DM + c), y1 = *(const u32x2*)(Y2 + (size_t)(2 * row + 1) * DM + c);
            v[j] = h * DN_ALPHA + (f32x4){bflo(y0.x) + bflo(y1.x), bfhi(y0.x) + bfhi(y1.x), bflo(y0.y) + bflo(y1.y), bfhi(y0.y) + bfhi(y1.y)}; }
        ln_row(v, g, b, lane);
#pragma unroll
        for (int j = 0; j < 8; ++j) { const int c = 4 * (lane + 64 * j); *(f32x4*)(OUT + (size_t)row * DM + c) = v[j];
            if (OB) { u32x2 w; w.x = pk2(v[j][0], v[j][1]); w.y = pk2(v[j][2], v[j][3]); *(u32x2*)(OB + (size_t)row * DM + c) = w; } }
    }
}
__device__ __forceinline__ void moe_table(LAS int* tab, const unsigned* cnt) {
    __syncthreads();
    const int tid = opaque_tid();
    if (tid < 32) tab[64 + tid] = (int)cnt[tid * 64];
    __syncthreads();
    if (tid == 0) { int acc = 0; for (int e = 0; e < 32; ++e) { tab[e] = acc; acc += (tab[64 + e] + 255) >> 8; } tab[32] = acc; }
    __syncthreads();
}
__device__ __forceinline__ void phase_conv4(KArgs a) {
    const bf16_t* XR = (const bf16_t*)(a.ws + A_XR); bf16_t* XC = (bf16_t*)(a.ws + A_XC); const float* cw = a.in[20]; const float* cb = a.in[21];
    const int NT = gridDim.x * 512;
    for (int it = blockIdx.x * 512 + opaque_tid(); it < NTOK * 256; it += NT) { const int tok = it >> 8, ch = (it & 255) * 8, t = tok & (SEQ - 1);
        float acc[8];
#pragma unroll
        for (int i = 0; i < 8; ++i) acc[i] = cb[ch + i];
#pragma unroll
        for (int j = 0; j < 4; ++j) { const int tt = t + j - 2;
            if (tt >= 0 && tt < SEQ) { const u32x4 w = *(const u32x4*)(XR + (size_t)(tok + j - 2) * DM + ch); const unsigned ww[4] = {w.x, w.y, w.z, w.w};
#pragma unroll
                for (int i = 0; i < 4; ++i) { acc[2 * i] += cw[j * DM + ch + 2 * i] * bflo(ww[i]); acc[2 * i + 1] += cw[j * DM + ch + 2 * i + 1] * bfhi(ww[i]); } } }
        u32x4 o; o.x = pk2(acc[0], acc[1]); o.y = pk2(acc[2], acc[3]); o.z = pk2(acc[4], acc[5]); o.w = pk2(acc[6], acc[7]);
        *(u32x4*)(XC + (size_t)tok * DM + ch) = o; }
}
constexpr size_t CAR_ELEMS = (size_t)2 * 2 * 256 * DM;
__device__ __forceinline__ void phase_scan1(KArgs a) {
    const bf16_t* LA = (const bf16_t*)(a.ws + A_LA); const bf16_t* BB = (const bf16_t*)(a.ws + A_BB); float* CARA = (float*)(a.ws + A_CAR); float* CARB = CARA + CAR_ELEMS;
    const int NT = gridDim.x * 512;
    for (int it = blockIdx.x * 512 + opaque_tid(); it < 2 * 2 * 256 * 512; it += NT) { const int ch = (it & 511) * 4, chunk = (it >> 9) & 255, dir = (it >> 17) & 1, b = it >> 18;
        float h[4] = {0.f, 0.f, 0.f, 0.f}, ls[4] = {0.f, 0.f, 0.f, 0.f};
#pragma unroll 8
        for (int s = 0; s < 32; ++s) { const int t = chunk * 32 + (dir ? 31 - s : s); const size_t off = ((size_t)dir * NTOK + (size_t)b * SEQ + t) * DM + ch;
            const u32x2 lw = *(const u32x2*)(LA + off), bw = *(const u32x2*)(BB + off);
            const float l4[4] = {bflo(lw.x), bfhi(lw.x), bflo(lw.y), bfhi(lw.y)}, b4[4] = {bflo(bw.x), bfhi(bw.x), bflo(bw.y), bfhi(bw.y)};
#pragma unroll
            for (int i = 0; i < 4; ++i) { h[i] = __expf(l4[i]) * h[i] + b4[i]; ls[i] += l4[i]; } }
        const size_t co = (((size_t)b * 2 + dir) * 256 + chunk) * DM + ch;
        *(f32x4*)(CARA + co) = (f32x4){ls[0], ls[1], ls[2], ls[3]}; *(f32x4*)(CARB + co) = (f32x4){h[0], h[1], h[2], h[3]}; }
}
__device__ __forceinline__ void phase_scan2(KArgs a) {
    float* CARA = (float*)(a.ws + A_CAR); float* CARB = CARA + CAR_ELEMS; float* CARIN = CARB + CAR_ELEMS;
    const int NT = gridDim.x * 512;
    for (int it = blockIdx.x * 512 + opaque_tid(); it < 2 * 2 * DM; it += NT) { const int ch = it & (DM - 1), dir = (it >> 11) & 1, b = it >> 12;
        float h = 0.f;
#pragma unroll 8
        for (int k = 0; k < 256; ++k) { const int chunk = dir ? 255 - k : k; const size_t co = (((size_t)b * 2 + dir) * 256 + chunk) * DM + ch;
            CARIN[co] = h; h = __expf(CARA[co]) * h + CARB[co]; } }
}
__device__ __forceinline__ float gelu_tanh(float x) { const float u = 0.7978845608028654f * (x + 0.044715f * x * x * x); const float th = 1.0f - 2.0f / (1.0f + __expf(2.0f * u)); return 0.5f * x * (1.0f + th); }
__device__ __forceinline__ void phase_scan3(KArgs a) {
    const bf16_t* LA = (const bf16_t*)(a.ws + A_LA); const bf16_t* BB = (const bf16_t*)(a.ws + A_BB); const bf16_t* GB = (const bf16_t*)(a.ws + A_GB); bf16_t* YG = (bf16_t*)(a.ws + A_YG);
    const float* CARIN = (const float*)(a.ws + A_CAR) + 2 * CAR_ELEMS;
    const int NT = gridDim.x * 512;
    for (int it = blockIdx.x * 512 + opaque_tid(); it < 2 * 256 * 512; it += NT) { const int ch = (it & 511) * 4, chunk = (it >> 9) & 255, b = it >> 17;
        float hf[32][4]; float h[4];
        { const f32x4 c = *(const f32x4*)(CARIN + (((size_t)b * 2 + 0) * 256 + chunk) * DM + ch); h[0] = c[0]; h[1] = c[1]; h[2] = c[2]; h[3] = c[3]; }
#pragma unroll
        for (int s = 0; s < 32; ++s) { const size_t off = ((size_t)b * SEQ + chunk * 32 + s) * DM + ch;
            const u32x2 lw = *(const u32x2*)(LA + off), bw = *(const u32x2*)(BB + off);
            const float l4[4] = {bflo(lw.x), bfhi(lw.x), bflo(lw.y), bfhi(lw.y)}, b4[4] = {bflo(bw.x), bfhi(bw.x), bflo(bw.y), bfhi(bw.y)};
#pragma unroll
            for (int i = 0; i < 4; ++i) { h[i] = __expf(l4[i]) * h[i] + b4[i]; hf[s][i] = h[i]; } }
        { const f32x4 c = *(const f32x4*)(CARIN + (((size_t)b * 2 + 1) * 256 + chunk) * DM + ch); h[0] = c[0]; h[1] = c[1]; h[2] = c[2]; h[3] = c[3]; }
#pragma unroll
        for (int s = 31; s >= 0; --s) { const size_t tokoff = ((size_t)b * SEQ + chunk * 32 + s) * DM + ch; const size_t off = (size_t)NTOK * DM + tokoff;
            const u32x2 lw = *(const u32x2*)(LA + off), bw = *(const u32x2*)(BB + off), gw = *(const u32x2*)(GB + tokoff);
            const float l4[4] = {bflo(lw.x), bfhi(lw.x), bflo(lw.y), bfhi(lw.y)}, b4[4] = {bflo(bw.x), bfhi(bw.x), bflo(bw.y), bfhi(bw.y)}, g4[4] = {bflo(gw.x), bfhi(gw.x), bflo(gw.y), bfhi(gw.y)};
            float y[4];
#pragma unroll
            for (int i = 0; i < 4; ++i) { h[i] = __expf(l4[i]) * h[i] + b4[i]; y[i] = gelu_tanh(g4[i]) * (hf[s][i] + h[i]); }
            u32x2 w; w.x = pk2(y[0], y[1]); w.y = pk2(y[2], y[3]); *(u32x2*)(YG + tokoff) = w; } }
}

#define KARGS() (*(const __attribute__((address_space(4))) Args*)__builtin_amdgcn_kernarg_segment_ptr())
#define PHASE_FN __device__ __forceinline__ void
#define PH_PRE() KArgs a = KARGS(); LAS unsigned char* lds = (LAS unsigned char*)lds_raw; unsigned char* ws = a.ws; asm volatile("" : "+s"(ws)); const int G = gridDim.x, bx = blockIdx.x; (void)lds; (void)ws; (void)G; (void)bx; using namespace pg8
PHASE_FN ph0() { PH_PRE(); phase_prologue(a, lds); }
PHASE_FN ph1a() { PH_PRE(); Gemm g{(const bf16_t*)(ws + A_W4T), (const bf16_t*)(ws + A_H3B), 128, 128, 128}; StaticOrder S; S.init(4096, 8192, G, bx); EpiFilt E{(float*)(ws + A_KTD)}; gemm_phase(lds, g, S, E); }
PHASE_FN ph1b() { PH_PRE(); Gemm g{(const bf16_t*)(ws + A_XB), (const bf16_t*)(ws + WS_WIN_EV) + (size_t)3072 * DM, DM, DM, DM}; StaticOrder S; S.init(NTOK, 3072, G, bx);
                  EpiBf16 E{(bf16_t*)(ws + A_QB), 1024, 1024, (size_t)(A_KB - A_QB) / 2, QSCALE}; gemm_phase(lds, g, S, E); }
PHASE_FN ph1c() { PH_PRE(); Gemm g{(const bf16_t*)(ws + WS_WIN_EV), (const bf16_t*)(ws + A_XB), DM, DM, DM}; StaticOrder S; S.init(3072, NTOK, G, bx);
                  EpiBf16 E{(bf16_t*)(ws + A_UHT), NTOK, 0, 0, 1.f}; gemm_phase(lds, g, S, E); }
PHASE_FN ph2() { PH_PRE(); phase_filter_fft(a, lds); phase_qknorm(a, lds); }
PHASE_FN ph3a() { PH_PRE(); phase_hyena_mixer(a, lds); }
PHASE_FN ph3b() { PH_PRE(); phase_attention(a, lds); }
PHASE_FN ph4() { PH_PRE(); phase_concat(a, lds); }
PHASE_FN ph5() { PH_PRE(); Gemm g{(const bf16_t*)(ws + A_YCAT), (const bf16_t*)(ws + WS_WOUT_EV), DM, DM, DM}; StaticOrder S; S.init(NTOK, DM, G, bx);
                 EpiResF32 E{a.in[0], (float*)(ws + A_R0), DM, DN_ALPHA}; gemm_phase(lds, g, S, E); }
template <int LAYER> PHASE_FN ph_lnr() { PH_PRE(); unsigned* ctl = (unsigned*)(ws + WS_CTL);
    phase_ln_router(a, lds, (const float*)(ws + (LAYER ? A_R1 : A_R0)), a.in[28] + LAYER * DM, a.in[29] + LAYER * DM, (float*)(ws + (LAYER ? A_H1_1 : A_H1_0)), (bf16_t*)(ws + (LAYER ? A_HB_1 : A_HB_0)),
                    ctl + CW_CNT + LAYER * 32 * 64, (int*)(ws + A_ROWL), (float*)(ws + A_GATEW)); }
template <int LAYER> PHASE_FN ph_moe1() { PH_PRE(); LAS int* tab = (LAS int*)(lds + LDS_MISC); moe_table(tab, (const unsigned*)(ws + WS_CTL) + CW_CNT + LAYER * 32 * 64);
    Gemm g{(const bf16_t*)(ws + (LAYER ? A_HB_1 : A_HB_0)), (const bf16_t*)(ws + WS_W1T) + (size_t)LAYER * 32 * 1024 * DM, DM, DM, DM}; MoeOrder<4, true> S{G, bx, tab, (const int*)(ws + A_ROWL)};
    EpiSwiglu E{(bf16_t*)(ws + (LAYER ? A_HID_1 : A_HID_0))}; gemm_phase(lds, g, S, E); }
template <int LAYER> PHASE_FN ph_moe2() { PH_PRE(); LAS int* tab = (LAS int*)(lds + LDS_MISC); moe_table(tab, (const unsigned*)(ws + WS_CTL) + CW_CNT + LAYER * 32 * 64);
    Gemm g{(const bf16_t*)(ws + (LAYER ? A_HID_1 : A_HID_0)), (const bf16_t*)(ws + WS_W2T) + (size_t)LAYER * 32 * DM * DFF, DFF, DFF, DFF}; MoeOrder<8, false> S{G, bx, tab, (const int*)(ws + A_ROWL)};
    EpiDown E{(bf16_t*)(ws + (LAYER ? A_Y2_1 : A_Y2_0)), (const int*)(ws + A_ROWL), (const float*)(ws + A_GATEW)}; gemm_phase(lds, g, S, E); }
template <int LAYER> PHASE_FN ph_ln2() { PH_PRE();
    phase_ln2((const float*)(ws + (LAYER ? A_H1_1 : A_H1_0)), (const bf16_t*)(ws + (LAYER ? A_Y2_1 : A_Y2_0)), a.in[30] + LAYER * DM, a.in[31] + LAYER * DM, LAYER ? a.out : (float*)(ws + A_H2), LAYER ? nullptr : (bf16_t*)(ws + A_HB2)); }
PHASE_FN ph10() { PH_PRE(); Gemm g{(const bf16_t*)(ws + A_HB2), (const bf16_t*)(ws + WS_WIN_OD), DM, DM, DM}; StaticOrder S; S.init(NTOK, 2 * DM, G, bx);
                  EpiBf16 E{(bf16_t*)(ws + A_GB), DM, DM, (size_t)(A_XR - A_GB) / 2, 1.f}; gemm_phase(lds, g, S, E); }
PHASE_FN ph11() { PH_PRE(); phase_conv4(a); }
PHASE_FN ph12() { PH_PRE(); Gemm g{(const bf16_t*)(ws + A_XC), (const bf16_t*)(ws + WS_WG_OD), DM, 256, 256}; RGOrder S{G, bx};
                  EpiRG E{(bf16_t*)(ws + A_LA), (bf16_t*)(ws + A_BB), (const bf16_t*)(ws + A_XC), a.in[23], a.in[25], a.in[26]}; gemm_phase(lds, g, S, E); }
PHASE_FN ph13() { PH_PRE(); phase_scan1(a); }
PHASE_FN ph14() { PH_PRE(); phase_scan2(a); }
PHASE_FN ph15() { PH_PRE(); phase_scan3(a); }
PHASE_FN ph16() { PH_PRE(); Gemm g{(const bf16_t*)(ws + A_YG), (const bf16_t*)(ws + WS_WOUT_OD), DM, DM, DM}; StaticOrder S; S.init(NTOK, DM, G, bx);
                  EpiResF32 E{(const float*)(ws + A_H2), (float*)(ws + A_R1), DM, DN_ALPHA}; gemm_phase(lds, g, S, E); }

__global__ void __launch_bounds__(512, 2) fwd(Args a) {
    LAS unsigned char* lds = (LAS unsigned char*)lds_raw;
    unsigned* ctl = (unsigned*)(a.ws + WS_CTL);
    volatile LAS unsigned* bst = (volatile LAS unsigned*)(lds + LDS_MISC + 2048);
    { const int tid = threadIdx.x;
      if ((tid & 63) == 0) ((LAS int*)(lds + LDS_WIDTAB))[hw_slot()] = tid >> 6;
      if (tid < 4) bst[tid] = 0u; }
    __syncthreads();
    const int lo = a.ph_lo, hi = a.ph_hi;
    XcdBarrier bar; bar.bar = ctl + CW_BAR; bar.x = 0; bar.st = bst;
    if (hi - lo > 1) bar = xcd_barrier_post(ctl + CW_BAR, bst);
#ifdef ONLY_PHASE
#define IN(k) ((k) == ONLY_PHASE && lo <= (k) && (k) < hi)
#else
#define IN(k) (lo <= (k) && (k) < hi)
#endif
#define SEAM(k) do { if (IN(k) && IN((k) + 1)) xcd_barrier(bar); } while (0)
    if (IN(0)) { asm volatile("; PHASE_MARK 0"); ph0(); } SEAM(0);
    if (IN(1)) { asm volatile("; PHASE_MARK 1a"); ph1a(); asm volatile("; PHASE_MARK 1b"); ph1b(); asm volatile("; PHASE_MARK 1c"); ph1c(); } SEAM(1);
    if (IN(2)) { asm volatile("; PHASE_MARK 2"); ph2(); } SEAM(2);
    if (IN(3)) { asm volatile("; PHASE_MARK 3a"); ph3a(); asm volatile("; PHASE_MARK 3b"); ph3b(); } SEAM(3);
    if (IN(4)) { asm volatile("; PHASE_MARK 4"); ph4(); } SEAM(4);
    if (IN(5)) { asm volatile("; PHASE_MARK 5"); ph5(); } SEAM(5);
    if (IN(6)) { asm volatile("; PHASE_MARK 6"); ph_lnr<0>(); } SEAM(6);
    if (IN(7)) { asm volatile("; PHASE_MARK 7"); ph_moe1<0>(); } SEAM(7);
    if (IN(8)) { asm volatile("; PHASE_MARK 8"); ph_moe2<0>(); } SEAM(8);
    if (IN(9)) { asm volatile("; PHASE_MARK 9"); ph_ln2<0>(); } SEAM(9);
    if (IN(10)) { asm volatile("; PHASE_MARK 10"); ph10(); } SEAM(10);
    if (IN(11)) { asm volatile("; PHASE_MARK 11"); ph11(); } SEAM(11);
    if (IN(12)) { asm volatile("; PHASE_MARK 12"); ph12(); } SEAM(12);
    if (IN(13)) { asm volatile("; PHASE_MARK 13"); ph13(); } SEAM(13);
    if (IN(14)) { asm volatile("; PHASE_MARK 14"); ph14(); } SEAM(14);
    if (IN(15)) { asm volatile("; PHASE_MARK 15"); ph15(); } SEAM(15);
    if (IN(16)) { asm volatile("; PHASE_MARK 16"); ph16(); } SEAM(16);
    if (IN(17)) { asm volatile("; PHASE_MARK 17"); ph_lnr<1>(); } SEAM(17);
    if (IN(18)) { asm volatile("; PHASE_MARK 18"); ph_moe1<1>(); } SEAM(18);
    if (IN(19)) { asm volatile("; PHASE_MARK 19"); ph_moe2<1>(); } SEAM(19);
    if (IN(20)) { asm volatile("; PHASE_MARK 20"); ph_ln2<1>(); }
#undef IN
#undef SEAM
}

#ifndef MK_PER_PHASE
#define MK_PER_PHASE 0
#endif
extern "C" void kernel_launch(void* const* d_in, const int* in_sizes, int n_in, void* d_out, int out_size, void* d_ws, size_t ws_size, hipStream_t stream) {
    static int grid = 0;
    if (grid == 0) {
        if (n_in != 37 || out_size != NTOK * DM || ws_size < WS_END) { fprintf(stderr, "kernel_launch: built for 37 inputs, %d outputs, >= %zu bytes of workspace; got n_in %d out %d ws %zu\n", NTOK * DM, (size_t)WS_END, n_in, out_size, ws_size); grid = -1; return; }
        int dev = 0, cus = 0, per_cu = 0;
        if (hipGetDevice(&dev) != hipSuccess || hipDeviceGetAttribute(&cus, hipDeviceAttributeMultiprocessorCount, dev) != hipSuccess) { grid = -1; return; }
        if (hipFuncSetAttribute((const void*)fwd, hipFuncAttributeMaxDynamicSharedMemorySize, LDS_BYTES) != hipSuccess) { fprintf(stderr, "kernel_launch: hipFuncSetAttribute failed\n"); grid = -1; return; }
        if (hipOccupancyMaxActiveBlocksPerMultiprocessor(&per_cu, (const void*)fwd, 512, LDS_BYTES) != hipSuccess || per_cu < 1) fprintf(stderr, "kernel_launch: occupancy query reports %d\n", per_cu);
        (void)hipGetLastError();
        grid = cus;
    }
    if (grid < 0) return;
    (void)hipMemsetAsync((char*)d_ws + WS_CTL, 0, CTL_ZERO_BYTES, stream);
    Args a{};
    for (int i = 0; i < 37; ++i) a.in[i] = (const float*)d_in[i];
    a.out = (float*)d_out; a.ws = (unsigned char*)d_ws;
#if MK_PER_PHASE
    for (int p = 0; p < NPHASE; ++p) { a.ph_lo = p; a.ph_hi = p + 1; hipLaunchKernelGGL(fwd, dim3(grid), dim3(512), LDS_BYTES, stream, a); }
#else
    a.ph_lo = 0; a.ph_hi = NPHASE; hipLaunchKernelGGL(fwd, dim3(grid), dim3(512), LDS_BYTES, stream, a);
#endif
}
```

```cpp
#include <hip/hip_runtime.h>
#include <hip/hip_fp16.h>
#include <cstdio>
#include <cstdint>

#define GAS __attribute__((address_space(1)))
#define LAS __attribute__((address_space(3)))
typedef unsigned short bf16_t;
typedef short bf16x8 __attribute__((ext_vector_type(8)));
typedef short s16x4 __attribute__((ext_vector_type(4)));
typedef float f32x2 __attribute__((ext_vector_type(2)));
typedef float f32x4 __attribute__((ext_vector_type(4)));
typedef float f32x8 __attribute__((ext_vector_type(8)));
typedef float f32x16 __attribute__((ext_vector_type(16)));
typedef unsigned u32x2 __attribute__((ext_vector_type(2)));
typedef unsigned u32x4 __attribute__((ext_vector_type(4)));
typedef GAS unsigned gu32;

constexpr int DM = 2048, BATCH = 2, SEQ = 8192, NTOK = BATCH * SEQ;
constexpr int HY_CH = 1024, EV_IN = 6144;
constexpr int NEXP = 32, DFF = 512, NASSIGN = NTOK * 2, ECAP = NASSIGN;
constexpr float LN_EPS = 1e-5f;
constexpr float DN_ALPHA = 1.4142135623730951f;
constexpr float QSCALE = 0.125f * 1.4426950408889634f;
constexpr int FFT_N = 16384, FFT_RS = 528;

__device__ __forceinline__ unsigned f2bf(float f) { unsigned u = __builtin_bit_cast(unsigned, f); return (u + 0x7fffu + ((u >> 16) & 1u)) >> 16; }
__device__ __forceinline__ unsigned pk2(float lo, float hi) { return f2bf(lo) | (f2bf(hi) << 16); }
__device__ __forceinline__ float bf2f(unsigned short h) { return __builtin_bit_cast(float, (unsigned)h << 16); }
__device__ __forceinline__ float bflo(unsigned w) { return __builtin_bit_cast(float, w << 16); }
__device__ __forceinline__ float bfhi(unsigned w) { return __builtin_bit_cast(float, w & 0xffff0000u); }
__device__ __forceinline__ unsigned cvt_pk_bf16(float lo, float hi) { unsigned r; asm volatile("v_cvt_pk_bf16_f32 %0, %1, %2" : "=v"(r) : "v"(lo), "v"(hi)); return r; }
__device__ __forceinline__ float wave_sum(float v) {
#pragma unroll
    for (int o = 1; o < 64; o <<= 1) v += __shfl_xor(v, o);
    return v;
}
__device__ __forceinline__ float sigmoidf_(float x) { return 1.0f / (1.0f + __expf(-x)); }
constexpr int LDS_WIDTAB = 139264 + 3072;
__device__ __forceinline__ int hw_slot() { return (int)(__builtin_amdgcn_s_getreg((5 << 11) | 4) & 63u); }
__device__ __forceinline__ int lane_id() { return (int)__builtin_amdgcn_mbcnt_hi(~0u, __builtin_amdgcn_mbcnt_lo(~0u, 0u)); }
extern __shared__ __attribute__((aligned(16))) unsigned char lds_raw[];
__device__ __forceinline__ int wave_id() { return __builtin_amdgcn_readfirstlane(((const LAS int*)((LAS unsigned char*)lds_raw + LDS_WIDTAB))[hw_slot()]); }
__device__ __forceinline__ int opaque_tid() { int t = wave_id() * 64 + lane_id(); asm volatile("" : "+v"(t)); return t; }
#define LDS_WAIT() asm volatile("s_waitcnt lgkmcnt(0)" ::: "memory")
#define VM_WAIT() asm volatile("s_waitcnt vmcnt(0)" ::: "memory")

#define XB_TMO      128
#define XB_XCNT(j)  (256  + 64 * (j))
#define XB_XSUB(j)  (1280 + 64 * (j))
#define XB_XGEN(j)  (2304 + 64 * (j))
#define XB_TOP      3328
#define XB_TOPGEN   3392
#define XCD_BAR_WORDS 3456
#define XB_SPIN_CAP (1u << 18)
__device__ __forceinline__ unsigned xb_ld(unsigned* p)              { return __hip_atomic_load(p, __ATOMIC_RELAXED, __HIP_MEMORY_SCOPE_AGENT); }
__device__ __forceinline__ unsigned xb_add(unsigned* p, unsigned v) { return __hip_atomic_fetch_add(p, v, __ATOMIC_RELAXED, __HIP_MEMORY_SCOPE_AGENT); }
__device__ __forceinline__ unsigned xb_xcc_id() { return (unsigned)__builtin_amdgcn_s_getreg((3 << 11) | 20) & 0xFu; }
#define XB_SPIN(cond, bar) do { unsigned _sp = 0; while (cond) { __builtin_amdgcn_s_sleep(1); \
    if ((++_sp & 255u) == 0u) { if (xb_ld(&(bar)[XB_TMO])) break; if (_sp > XB_SPIN_CAP) { atomicAdd(&(bar)[XB_TMO], 1u); break; } } } } while (0)
struct XcdBarrier { unsigned* bar; unsigned x; volatile LAS unsigned* st; };
__device__ __forceinline__ XcdBarrier xcd_barrier_post(unsigned* bar, volatile LAS unsigned* st) {
    XcdBarrier b; b.bar = bar; b.x = xb_xcc_id(); b.st = st;
    if (opaque_tid() == 0) (void)xb_add(&bar[XB_XCNT(b.x)], 1u);
    return b;
}
__device__ __forceinline__ void xcd_barrier_complete(unsigned* bar, unsigned x, unsigned& nloc, unsigned& nx) {
    const unsigned G = gridDim.x * gridDim.y * gridDim.z;
    unsigned sum, cnt, mine, sp = 0u;
    for (;;) {
        sum = 0u; cnt = 0u; mine = 0u;
#pragma unroll
        for (unsigned j = 0; j < 16; ++j) { const unsigned c = xb_ld(&bar[XB_XCNT(j)]); sum += c; cnt += (c > 0u) ? 1u : 0u; mine = (j == x) ? c : mine; }
        if (sum == G) break;
        __builtin_amdgcn_s_sleep(1);
        if ((++sp & 255u) == 0u) { if (xb_ld(&bar[XB_TMO])) break; if (sp > XB_SPIN_CAP) { atomicAdd(&bar[XB_TMO], 1u); break; } }
    }
    nloc = mine > 0u ? mine : 1u; nx = cnt > 0u ? cnt : 1u;
}
__device__ __forceinline__ void xcd_barrier(const XcdBarrier& b) {
    asm volatile("s_waitcnt vmcnt(0)" ::: "memory");
    __syncthreads();
    if (opaque_tid() == 0) {
        unsigned* bar = b.bar;
        __builtin_amdgcn_s_waitcnt(0);
        unsigned nloc = b.st[0], nx = b.st[1];
        if (nloc == 0u) { xcd_barrier_complete(bar, b.x, nloc, nx); b.st[0] = nloc; b.st[1] = nx; }
        const unsigned old = xb_add(&bar[XB_XSUB(b.x)], 1u);
        const unsigned gen = old / nloc;
        if (old + 1u == (gen + 1u) * nloc) {
            __builtin_amdgcn_fence(__ATOMIC_RELEASE, "agent");
            asm volatile("s_waitcnt vmcnt(0)" ::: "memory");
            const unsigned og = xb_add(&bar[XB_TOP], 1u);
            const unsigned tg = og / nx;
            if (og + 1u == (tg + 1u) * nx) xb_add(&bar[XB_TOPGEN], 1u);
            else XB_SPIN(xb_ld(&bar[XB_TOPGEN]) == tg, bar);
            __builtin_amdgcn_fence(__ATOMIC_ACQUIRE, "agent");
            xb_add(&bar[XB_XGEN(b.x)], 1u);
            asm volatile("s_waitcnt vmcnt(0)" ::: "memory");
        } else {
            XB_SPIN(xb_ld(&bar[XB_XGEN(b.x)]) == gen, bar);
            __builtin_amdgcn_fence(__ATOMIC_ACQUIRE, "agent");
            asm volatile("s_waitcnt vmcnt(0)" ::: "memory");
        }
    }
    __syncthreads();
}

namespace pg8 {
constexpr int BM = 256, BK = 64, HALF = 128, HTB = HALF * BK * 2, STAGE_BYTES = 8 * HTB, NXCD = 8, WGM = 8;
__host__ __device__ __forceinline__ int lds_byte(int r, int c) { const int st = (r >> 4) * 2 + (c >> 5), rr = r & 15, cc = c & 31, ob = rr * 64 + cc * 2; return st * 1024 + (ob ^ (((ob >> 9) & 1) << 5)); }
__host__ __device__ __forceinline__ void stage_rc(int b, int& R, int& C) { const int st = b / 1024, sb = b % 1024, swz = sb ^ (((sb >> 9) & 1) << 5); R = (st >> 1) * 16 + swz / 64; C = (st & 1) * 32 + (swz % 64) / 2; }
__host__ __device__ __forceinline__ int perm32(int rho) { const int n = rho >> 4, i = rho & 15; return 8 * (i >> 2) + 4 * n + (i & 3); }

struct Unit { int pm, pn, e, t, cnt; };
struct Gemm { const bf16_t* A; const bf16_t* Bt; int lda, ldb, K; };

struct StaticOrder {
    static constexpr bool GATHER_A = false;
    int nM, nN, nwg, G, c;
    __device__ void init(int M, int N, int G_, int c_) { nM = M / BM; nN = N / BM; nwg = nM * nN; G = G_; c = c_; }
    __device__ __forceinline__ bool next(int i, Unit& u) const {
        const long L = (long)i * G + c; if (L >= nwg) return false;
        int wgid = (int)L; { const int q = nwg / NXCD, r = nwg % NXCD, xcd = wgid % NXCD, off = wgid / NXCD; wgid = (xcd < r ? xcd * (q + 1) : r * (q + 1) + (xcd - r) * q) + off; }
        const int nig = WGM * nN, gid = wgid / nig, fm = gid * WGM, gsz = (nM - fm) < WGM ? (nM - fm) : WGM;
        u.pm = fm + ((wgid % nig) % gsz); u.pn = (wgid % nig) / gsz; u.e = 0; u.t = 0; u.cnt = 0; return true;
    }
    __device__ __forceinline__ int rowA(const Unit& u, int r) const { return u.pm * BM + r; }
    __device__ __forceinline__ int colA(const Unit&) const { return 0; }
    __device__ __forceinline__ int rowB(const Unit& u, int r) const { return u.pn * BM + r; }
};

template <class Epi, class Sched>
__device__ __forceinline__ void gemm_phase(LAS unsigned char* lds, const Gemm g, const Sched& S, const Epi& E) {
    const int tid = opaque_tid(), wid = __builtin_amdgcn_readfirstlane(tid >> 6), lane = tid & 63, wr = wid >> 2, wc = wid & 3, fr = lane & 15, fq = lane >> 4;
    const int K = g.K, nt = K / BK;
    constexpr bool GA = Sched::GATHER_A;
    int sR[2], sC[2];
    unsigned laneA[2], laneB[2];
#pragma unroll
    for (int i = 0; i < 2; ++i) { int R, C; stage_rc(tid * 16 + i * 8192, R, C); sR[i] = R; sC[i] = C; const int Rb = Epi::PERM ? ((R & ~31) + perm32(R & 31)) : R;
        laneA[i] = (unsigned)(R * g.lda + C) * 2u; laneB[i] = (unsigned)(Rb * g.ldb + C) * 2u; }
    const size_t hstepA = (size_t)HALF * g.lda * 2, hstepB = (size_t)HALF * g.ldb * 2;
    const unsigned ldsw = (unsigned)wid * 1024u;
    const int aoff = lds_byte(wr * 64 + fr, fq * 8), boff = lds_byte(wc * 32 + fr, fq * 8);
    const char* gA = (const char*)g.A; const char* gB = (const char*)g.Bt;
#define PG8_SA(b, h) (((b) * 2 + (h)) * HTB)
#define PG8_SB(b, h) ((4 + (b) * 2 + (h)) * HTB)
#define PG8_STAGE(bufoff, gptr, voff) do { _Pragma("unroll") for (int _i = 0; _i < 2; ++_i) \
        __builtin_amdgcn_global_load_lds((const unsigned*)((gptr) + (size_t)(voff)[_i]), (LAS unsigned*)(lds + (bufoff) + ldsw + _i * 8192), 16, 0, 0); } while (0)
#define PG8_STAGE_B(bufoff, ub, h, kb) PG8_STAGE(bufoff, gB + (ub) + (size_t)(h) * hstepB + (size_t)(kb), laneB)
#define PG8_STAGE_A(bufoff, ub, va, h, kb) do { if constexpr (GA) { PG8_STAGE(bufoff, gA + (size_t)(kb), va[h]); } else { PG8_STAGE(bufoff, gA + (ub) + (size_t)(h) * hstepA + (size_t)(kb), laneA); } } while (0)
#define PG8_LDA(dst, b, h) do { _Pragma("unroll") for (int m = 0; m < 4; ++m) _Pragma("unroll") for (int k = 0; k < 2; ++k) dst[m][k] = *(const LAS bf16x8*)(lds + PG8_SA(b, h) + aoff + m * 2048 + k * 1024); } while (0)
#define PG8_LDB(dst, b, h) do { _Pragma("unroll") for (int n = 0; n < 2; ++n) _Pragma("unroll") for (int k = 0; k < 2; ++k) dst[n][k] = *(const LAS bf16x8*)(lds + PG8_SB(b, h) + boff + n * 2048 + k * 1024); } while (0)
#define PG8_MMA(ai, bj, At, Bt) do { __builtin_amdgcn_s_setprio(1); _Pragma("unroll") for (int m = 0; m < 4; ++m) _Pragma("unroll") for (int n = 0; n < 2; ++n) _Pragma("unroll") for (int k = 0; k < 2; ++k) \
        acc[ai][bj][m][n] = __builtin_amdgcn_mfma_f32_16x16x32_bf16(Bt[n][k], At[m][k], acc[ai][bj][m][n], 0, 0, 0); __builtin_amdgcn_s_setprio(0); } while (0)
#define PG8_WAIT_V(n) asm volatile("s_waitcnt vmcnt(" #n ")" ::: "memory")
#define PG8_WAIT_L(n) asm volatile("s_waitcnt lgkmcnt(" #n ")" ::: "memory")
#define PG8_BAR __builtin_amdgcn_s_barrier()
#define PG8_SCHED __builtin_amdgcn_sched_barrier(0)
#define PG8_OFFS(u, ubA, ubB, vA) do { ubB = ((size_t)S.rowB(u, 0) * (size_t)g.ldb) * 2; \
        if constexpr (GA) { ubA = 0; _Pragma("unroll") for (int _h = 0; _h < 2; ++_h) _Pragma("unroll") for (int _i = 0; _i < 2; ++_i) vA[_h][_i] = ((unsigned)S.rowA(u, _h * HALF + sR[_i]) * (unsigned)g.lda + (unsigned)sC[_i]) * 2u; } \
        else { ubA = ((size_t)S.rowA(u, 0) * (size_t)g.lda + (size_t)S.colA(u)) * 2; } } while (0)
    Unit cur, nxt; int ui = 0;
    if (!S.next(0, cur)) return;
    f32x4 acc[2][2][4][2];
#pragma unroll
    for (int a = 0; a < 2; ++a)
#pragma unroll
        for (int b = 0; b < 2; ++b)
#pragma unroll
            for (int m = 0; m < 4; ++m)
#pragma unroll
                for (int n = 0; n < 2; ++n) acc[a][b][m][n] = (f32x4){0.f, 0.f, 0.f, 0.f};
    bf16x8 At[4][2], B0[2][2], B1[2][2];
    size_t ubAc, ubBc, ubAn, ubBn; unsigned vAc[2][2] = {}, vAn[2][2] = {};
    PG8_OFFS(cur, ubAc, ubBc, vAc);
    PG8_STAGE_B(PG8_SB(0, 0), ubBc, 0, 0); PG8_STAGE_B(PG8_SB(0, 1), ubBc, 1, 0); PG8_STAGE_A(PG8_SA(0, 0), ubAc, vAc, 0, 0); PG8_STAGE_A(PG8_SA(0, 1), ubAc, vAc, 1, 0);
    if (wr == 1) PG8_BAR;
    PG8_WAIT_V(2); PG8_BAR;
    PG8_STAGE_B(PG8_SB(1, 0), ubBc, 0, 128); PG8_STAGE_A(PG8_SA(1, 0), ubAc, vAc, 0, 128); PG8_STAGE_B(PG8_SB(1, 1), ubBc, 1, 128);
    PG8_WAIT_V(6); PG8_BAR;
    for (;;) {
        const bool has_next = S.next(ui + 1, nxt);
        if (has_next) { PG8_OFFS(nxt, ubAn, ubBn, vAn); }
        else { ubAn = ubAc; ubBn = ubBc;
#pragma unroll
            for (int h = 0; h < 2; ++h)
#pragma unroll
                for (int i = 0; i < 2; ++i) vAn[h][i] = vAc[h][i]; }
        for (int t = 0; t < nt; t += 2) {
            const bool last = (t == nt - 2);
            const unsigned k1 = (unsigned)(t + 1) * 128u, k2 = last ? 0u : (unsigned)(t + 2) * 128u, k3 = k2 + 128u;
            const size_t xubA = last ? ubAn : ubAc, xubB = last ? ubBn : ubBc;
            unsigned xA[2][2];
#pragma unroll
            for (int h = 0; h < 2; ++h)
#pragma unroll
                for (int i = 0; i < 2; ++i) xA[h][i] = last ? vAn[h][i] : vAc[h][i];
            PG8_LDB(B0, 0, 0); PG8_LDB(B1, 0, 1); PG8_SCHED; PG8_LDA(At, 0, 0); PG8_STAGE_A(PG8_SA(1, 1), ubAc, vAc, 1, k1);
            PG8_WAIT_V(8); PG8_WAIT_L(0); PG8_BAR; PG8_MMA(0, 0, At, B0); PG8_MMA(0, 1, At, B1); PG8_BAR; PG8_SCHED;
            PG8_LDA(At, 0, 1); PG8_STAGE_B(PG8_SB(0, 0), xubB, 0, k2); PG8_STAGE_B(PG8_SB(0, 1), xubB, 1, k2); PG8_STAGE_A(PG8_SA(0, 0), xubA, xA, 0, k2);
            PG8_WAIT_V(8); PG8_WAIT_L(0); PG8_BAR; PG8_MMA(1, 0, At, B0); PG8_MMA(1, 1, At, B1); PG8_BAR; PG8_SCHED;
            PG8_LDB(B0, 1, 0); PG8_LDB(B1, 1, 1); PG8_SCHED; PG8_LDA(At, 1, 0); PG8_STAGE_A(PG8_SA(0, 1), xubA, xA, 1, k2);
            PG8_WAIT_V(8); PG8_WAIT_L(0); PG8_BAR; PG8_MMA(0, 0, At, B0); PG8_MMA(0, 1, At, B1); PG8_BAR; PG8_SCHED;
            PG8_LDA(At, 1, 1); PG8_STAGE_B(PG8_SB(1, 0), xubB, 0, k3); PG8_STAGE_B(PG8_SB(1, 1), xubB, 1, k3); PG8_STAGE_A(PG8_SA(1, 0), xubA, xA, 0, k3);
            PG8_WAIT_V(8); PG8_WAIT_L(0); PG8_BAR; PG8_MMA(1, 0, At, B0); PG8_MMA(1, 1, At, B1); PG8_BAR; PG8_SCHED;
        }
        if (wr == 0) PG8_BAR;
        E(acc, cur, wr, wc, fr, fq);
        if (!has_next) break;
#pragma unroll
        for (int a = 0; a < 2; ++a)
#pragma unroll
            for (int b = 0; b < 2; ++b)
#pragma unroll
                for (int m = 0; m < 4; ++m)
#pragma unroll
                    for (int n = 0; n < 2; ++n) acc[a][b][m][n] = (f32x4){0.f, 0.f, 0.f, 0.f};
        cur = nxt; ++ui; ubAc = ubAn; ubBc = ubBn;
#pragma unroll
        for (int h = 0; h < 2; ++h)
#pragma unroll
            for (int i = 0; i < 2; ++i) vAc[h][i] = vAn[h][i];
        if (wr == 1) PG8_BAR;
    }
    PG8_WAIT_V(0);
    PG8_BAR;
#undef PG8_SA
#undef PG8_SB
#undef PG8_STAGE
#undef PG8_STAGE_A
#undef PG8_STAGE_B
#undef PG8_LDA
#undef PG8_LDB
#undef PG8_MMA
#undef PG8_WAIT_V
#undef PG8_WAIT_L
#undef PG8_BAR
#undef PG8_SCHED
#undef PG8_OFFS
}
}
namespace pg8 {
struct EpiBf16 {
    static constexpr bool PERM = true;
    bf16_t* O; int ldc; int split_cols; size_t split_stride; float scale0;
    __device__ __forceinline__ void operator()(const f32x4 (&acc)[2][2][4][2], const Unit& u, int wr, int wc, int fr, int fq) const {
        const int row0 = u.pm * BM + wr * 64 + fr; int colt = u.pn * BM; bf16_t* base = O;
        float sc = 1.f; if (split_cols) { const int t = colt / split_cols; base += (size_t)t * split_stride; colt -= t * split_cols; if (t == 0) sc = scale0; }
        const int col0 = colt + wc * 32 + 8 * fq;
#pragma unroll
        for (int ai = 0; ai < 2; ++ai)
#pragma unroll
            for (int m = 0; m < 4; ++m) { bf16_t* rowp = base + (size_t)(row0 + ai * HALF + m * 16) * ldc + col0;
#pragma unroll
                for (int bj = 0; bj < 2; ++bj) { const f32x4 v0 = acc[ai][bj][m][0] * sc, v1 = acc[ai][bj][m][1] * sc;
                    u32x4 w; w.x = cvt_pk_bf16(v0[0], v0[1]); w.y = cvt_pk_bf16(v0[2], v0[3]); w.z = cvt_pk_bf16(v1[0], v1[1]); w.w = cvt_pk_bf16(v1[2], v1[3]);
                    *(u32x4*)(rowp + bj * HALF) = w; } }
    }
};
struct EpiFilt {
    static constexpr bool PERM = false;
    float* O;
    __device__ __forceinline__ void operator()(const f32x4 (&acc)[2][2][4][2], const Unit& u, int wr, int wc, int fr, int fq) const {
        const float dmin = -3.0701134573253945f, dmax = -15.350567286626973f;
#pragma unroll
        for (int ai = 0; ai < 2; ++ai)
#pragma unroll
            for (int m = 0; m < 4; ++m) { const int row = u.pm * BM + ai * HALF + wr * 64 + m * 16 + fr; const int c = row & 1023;
                const float delta = fabsf(dmin + (float)c * ((dmax - dmin) / 1023.0f));
#pragma unroll
                for (int bj = 0; bj < 2; ++bj)
#pragma unroll
                    for (int n = 0; n < 2; ++n) { const int col = u.pn * BM + bj * HALF + wc * 32 + n * 16 + 4 * fq; f32x4 v = acc[ai][bj][m][n];
#pragma unroll
                        for (int j = 0; j < 4; ++j) v[j] *= __expf(-(float)(col + j) * (1.0f / 8191.0f) * delta);
                        *(f32x4*)(O + (size_t)row * 8192 + col) = v; }
                asm volatile("" ::: "memory"); }
    }
};
struct EpiResF32 {
    static constexpr bool PERM = false;
    const float* res; float* O; int ldc; float alpha;
    __device__ __forceinline__ void operator()(const f32x4 (&acc)[2][2][4][2], const Unit& u, int wr, int wc, int fr, int fq) const {
#pragma unroll
        for (int ai = 0; ai < 2; ++ai)
#pragma unroll
            for (int m = 0; m < 4; ++m) { const size_t off = (size_t)(u.pm * BM + ai * HALF + wr * 64 + m * 16 + fr) * ldc + u.pn * BM + wc * 32 + 4 * fq;
#pragma unroll
                for (int bj = 0; bj < 2; ++bj)
#pragma unroll
                    for (int n = 0; n < 2; ++n) { const f32x4 r = *(const f32x4*)(res + off + bj * HALF + n * 16); *(f32x4*)(O + off + bj * HALF + n * 16) = r * alpha + acc[ai][bj][m][n]; }
                if (m & 1) asm volatile("" ::: "memory"); }
    }
};
struct EpiSwiglu {
    static constexpr bool PERM = true;
    bf16_t* O;
    __device__ __forceinline__ void operator()(const f32x4 (&acc)[2][2][4][2], const Unit& u, int wr, int wc, int fr, int fq) const {
#pragma unroll
        for (int ai = 0; ai < 2; ++ai)
#pragma unroll
            for (int m = 0; m < 4; ++m) { bf16_t* p = O + (size_t)(u.pm * BM + ai * HALF + wr * 64 + m * 16 + fr) * DFF + u.pn * HALF + wc * 32 + 8 * fq;
                float h[8];
#pragma unroll
                for (int n = 0; n < 2; ++n)
#pragma unroll
                    for (int j = 0; j < 4; ++j) { const float gt = acc[ai][0][m][n][j], up = acc[ai][1][m][n][j]; h[n * 4 + j] = gt * sigmoidf_(gt) * up; }
                u32x4 w; w.x = cvt_pk_bf16(h[0], h[1]); w.y = cvt_pk_bf16(h[2], h[3]); w.z = cvt_pk_bf16(h[4], h[5]); w.w = cvt_pk_bf16(h[6], h[7]);
                *(u32x4*)p = w; }
    }
};
struct EpiDown {
    static constexpr bool PERM = true;
    bf16_t* O; const int* rowlist; const float* gatew;
    __device__ __forceinline__ void operator()(const f32x4 (&acc)[2][2][4][2], const Unit& u, int wr, int wc, int fr, int fq) const {
#pragma unroll
        for (int ai = 0; ai < 2; ++ai)
#pragma unroll
            for (int m = 0; m < 4; ++m) { const int idx = u.t * BM + ai * HALF + wr * 64 + m * 16 + fr;
                if (idx < u.cnt) { const int a = rowlist[(size_t)u.e * ECAP + idx]; const float gw = gatew[a];
                    bf16_t* p = O + (size_t)a * DM + u.pn * BM + wc * 32 + 8 * fq;
#pragma unroll
                    for (int bj = 0; bj < 2; ++bj) { const f32x4 v0 = acc[ai][bj][m][0] * gw, v1 = acc[ai][bj][m][1] * gw;
                        u32x4 w; w.x = cvt_pk_bf16(v0[0], v0[1]); w.y = cvt_pk_bf16(v0[2], v0[3]); w.z = cvt_pk_bf16(v1[0], v1[1]); w.w = cvt_pk_bf16(v1[2], v1[3]);
                        *(u32x4*)(p + bj * HALF) = w; } } }
    }
};
struct EpiRG {
    static constexpr bool PERM = true;
    bf16_t* LA; bf16_t* BB; const bf16_t* XC; const float* ba; const float* bx; const float* lam;
    __device__ __forceinline__ void operator()(const f32x4 (&acc)[2][2][4][2], const Unit& u, int wr, int wc, int fr, int fq) const {
        const int nb = u.pn >> 2, q = u.pn & 3, dir = q >> 1, half = q & 1;
        const int ch0 = nb * 256 + half * HALF + wc * 32 + 8 * fq;
        float vba[8], vbx[8], vsp[8];
#pragma unroll
        for (int j = 0; j < 8; ++j) { vba[j] = ba[dir * DM + ch0 + j]; vbx[j] = bx[dir * DM + ch0 + j];
            const float x = __expf(-lam[dir * DM + ch0 + j]);
            vsp[j] = 8.0f * (x < 0.05f ? x * (1.0f - x * (0.5f - x * (0.33333334f - 0.25f * x))) : __logf(1.0f + x)); }
#pragma unroll
        for (int ai = 0; ai < 2; ++ai)
#pragma unroll
            for (int m = 0; m < 4; ++m) { const size_t tok = (size_t)(u.pm * BM + ai * HALF + wr * 64 + m * 16 + fr);
                asm volatile("" ::: "memory");
                const u32x4 xw = *(const u32x4*)(XC + tok * DM + ch0);
                float xf[8] = {bflo(xw.x), bfhi(xw.x), bflo(xw.y), bfhi(xw.y), bflo(xw.z), bfhi(xw.z), bflo(xw.w), bfhi(xw.w)};
                float la[8], bb[8];
#pragma unroll
                for (int n = 0; n < 2; ++n)
#pragma unroll
                    for (int j = 0; j < 4; ++j) { const int k = n * 4 + j;
                        const float r = sigmoidf_(acc[ai][0][m][n][j] + vba[k]), ig = sigmoidf_(acc[ai][1][m][n][j] + vbx[k]);
                        const float l = -r * vsp[k]; la[k] = l; bb[k] = sqrtf(fmaxf(1.0f - __expf(2.0f * l), 0.f)) * (ig * xf[k]); }
                u32x4 w; w.x = cvt_pk_bf16(la[0], la[1]); w.y = cvt_pk_bf16(la[2], la[3]); w.z = cvt_pk_bf16(la[4], la[5]); w.w = cvt_pk_bf16(la[6], la[7]);
                *(u32x4*)(LA + ((size_t)dir * NTOK + tok) * DM + ch0) = w;
                w.x = cvt_pk_bf16(bb[0], bb[1]); w.y = cvt_pk_bf16(bb[2], bb[3]); w.z = cvt_pk_bf16(bb[4], bb[5]); w.w = cvt_pk_bf16(bb[6], bb[7]);
                *(u32x4*)(BB + ((size_t)dir * NTOK + tok) * DM + ch0) = w; }
    }
};

struct RGOrder {
    static constexpr bool GATHER_A = false;
    int G, c;
    __device__ __forceinline__ bool next(int i, Unit& u) const { const int L = i * G + c; if (L >= 64 * 32) return false; u.pm = L >> 5; u.pn = L & 31; u.e = 0; u.t = 0; u.cnt = 0; return true; }
    __device__ __forceinline__ int rowA(const Unit& u, int r) const { return u.pm * BM + r; }
    __device__ __forceinline__ int colA(const Unit& u) const { return (u.pn >> 2) * 256; }
    __device__ __forceinline__ int rowB(const Unit& u, int r) const { return u.pn * BM + r; }
};
template <int NPN, bool GATHER>
struct MoeOrder {
    static constexpr bool GATHER_A = GATHER;
    int G, c; const LAS int* tab; const int* rowlist;
    __device__ __forceinline__ bool next(int i, Unit& u) const {
        const int L = i * G + c, ntile = tab[32]; if (L >= ntile * NPN) return false;
        const int tile = L / NPN; u.pm = tile; u.pn = L % NPN; int e = 0;
        while (e < 31 && tab[e + 1] <= tile) ++e;
        u.e = e; u.t = tile - tab[e]; u.cnt = tab[64 + e]; return true;
    }
    __device__ __forceinline__ int rowA(const Unit& u, int r) const {
        if (GATHER) { const int idx = u.t * BM + r; const int a = idx < u.cnt ? rowlist[(size_t)u.e * ECAP + idx] : 0; return a >> 1; }
        return u.pm * BM + r;
    }
    __device__ __forceinline__ int colA(const Unit&) const { return 0; }
    __device__ __forceinline__ int rowB(const Unit& u, int r) const { return (u.e * NPN + u.pn) * BM + r; }
};
}
namespace att {
constexpr int NW = 8, QBLK = 32, KVBLK = 64, LDQ = 1024, LDK = 1024, LDV = 1024, LDO = 1024;
constexpr int SHM_V = KVBLK * 128 * 2, SHM_K = KVBLK * 64 * 2, NSLOT = 3, LDS_K = 0, LDS_V = NSLOT * SHM_K, LDS_WS = NSLOT * (SHM_K + SHM_V), SHM_ATTN = LDS_WS + NW * 64 * 4;
__device__ __forceinline__ void glds16s(const void* sbase, unsigned voff, unsigned lds_dst) { unsigned keep;
    asm volatile("s_mov_b32 %0, m0\n\ts_mov_b32 m0, %3\n\ts_nop 0\n\tglobal_load_lds_dwordx4 %1, %2\n\ts_mov_b32 m0, %0" : "=&s"(keep) : "v"(voff), "s"(sbase), "s"(lds_dst) : "memory"); }
#define WAITBAR(N) asm volatile("s_waitcnt vmcnt(" #N ") lgkmcnt(0)\n\ts_barrier" ::: "memory")
constexpr float THR2 = 8.0f * 1.4426950408889634f;
#define KSWZ64(row, colB) ((row) * 128 + ((colB) ^ ((((row) >> 1) & 7) << 4)))
#define SBAR() __builtin_amdgcn_sched_barrier(0)
__device__ __forceinline__ int crow(int r, int hi) { return (r & 3) + 8 * (r >> 2) + 4 * hi; }
__device__ __forceinline__ void qkt(f32x16& p0, f32x16& p1, const char* Ks, const bf16x8* qr, int r32, int hi, float A, float st) {
    { float b4[4];
#pragma unroll
      for (int j = 0; j < 4; ++j) b4[j] = fmaf(st, (float)j, A);
      const float s8 = 8.0f * st, s32 = 32.0f * st;
#pragma unroll
      for (int r = 0; r < 16; ++r) { p0[r] = (r < 4) ? b4[r] : p0[r - 4] + s8; }
#pragma unroll
      for (int r = 0; r < 16; ++r) p1[r] = p0[r] + s32; }
#pragma unroll
    for (int d0 = 0; d0 < 4; ++d0) { const int cb = (d0 * 16 + hi * 8) * 2;
        const bf16x8 b0 = *reinterpret_cast<const bf16x8*>(Ks + KSWZ64(r32, cb));
        const bf16x8 b1 = *reinterpret_cast<const bf16x8*>(Ks + KSWZ64(32 + r32, cb));
        p0 = __builtin_amdgcn_mfma_f32_32x32x16_bf16(b0, qr[d0], p0, 0, 0, 0);
        p1 = __builtin_amdgcn_mfma_f32_32x32x16_bf16(b1, qr[d0], p1, 0, 0, 0); }
}
__device__ __forceinline__ void partialSM(f32x16& p0, f32x16& p1, bool mixed, float fd, float sl2) {
    if (mixed) {
#pragma unroll
        for (int r = 0; r < 16; ++r) { const float d0 = fd - (float)((r & 3) + 8 * (r >> 2)); p0[r] = fmaf(fabsf(d0), -sl2, p0[r]); p1[r] = fmaf(fabsf(d0 - 32.0f), -sl2, p1[r]); }
    }
#pragma unroll
    for (int r = 0; r < 16; ++r) p0[r] = __builtin_amdgcn_exp2f(p0[r]);
}
__device__ __forceinline__ void finishSM(f32x16& p0, f32x16& p1, float& l_reg, bf16x8& pa0, bf16x8& pa1, bf16x8& pa2, bf16x8& pa3) {
#pragma unroll
    for (int r = 0; r < 16; ++r) p1[r] = __builtin_amdgcn_exp2f(p1[r]);
    float ps = 0;
#pragma unroll
    for (int r = 0; r < 16; ++r) ps += p0[r];
#pragma unroll
    for (int r = 0; r < 16; ++r) ps += p1[r];
    l_reg += ps;
#define PK4(P, BASE, OUT) do { unsigned a0 = cvt_pk_bf16(P[BASE + 0], P[BASE + 1]), a1 = cvt_pk_bf16(P[BASE + 2], P[BASE + 3]);   \
    unsigned b0 = cvt_pk_bf16(P[BASE + 4], P[BASE + 5]), b1 = cvt_pk_bf16(P[BASE + 6], P[BASE + 7]);                              \
    auto r0 = __builtin_amdgcn_permlane32_swap(a0, b0, false, false); auto r1 = __builtin_amdgcn_permlane32_swap(a1, b1, false, false); \
    u32x4 w = {r0[0], r1[0], r0[1], r1[1]}; OUT = __builtin_bit_cast(bf16x8, w); } while (0)
    PK4(p0, 0, pa0); PK4(p0, 8, pa1); PK4(p1, 0, pa2); PK4(p1, 8, pa3);
#undef PK4
}
__device__ __forceinline__ int v_st(int k, int c) { const int kk = (k & ~0xC) | ((k & 4) << 1) | ((k & 8) >> 1); return ((kk >> 3) * 4 + (c >> 5)) * 512 + ((kk & 7) * 32 + (c & 31)) * 2; }
__device__ __forceinline__ int v_rd_base(int lane) { return ((lane & 3) << 3) | (((lane >> 2) & 3) << 6) | (((lane >> 4) & 1) << 5) | (((lane >> 5) & 1) << 8); }
constexpr int v_rd_off(int d0, int ks, int half) { return d0 * 512 + ks * 4096 + half * 2048; }
template <int OFF> __device__ __forceinline__ s16x4 tr_read(int vb) {
    s16x4 r; asm volatile("ds_read_b64_tr_b16 %0, %1 offset:%2" : "=&v"(r) : "v"(vb), "i"(OFF) : "memory"); return r;
}
template <int D0> __device__ __forceinline__ void pv_one(f32x16& od, int vb, bf16x8 pa0, bf16x8 pa1, bf16x8 pa2, bf16x8 pa3) {
    const s16x4 l0 = tr_read<v_rd_off(D0, 0, 0)>(vb), h0 = tr_read<v_rd_off(D0, 0, 1)>(vb), l1 = tr_read<v_rd_off(D0, 1, 0)>(vb), h1 = tr_read<v_rd_off(D0, 1, 1)>(vb);
    const s16x4 l2 = tr_read<v_rd_off(D0, 2, 0)>(vb), h2 = tr_read<v_rd_off(D0, 2, 1)>(vb), l3 = tr_read<v_rd_off(D0, 3, 0)>(vb), h3 = tr_read<v_rd_off(D0, 3, 1)>(vb);
    asm volatile("s_waitcnt lgkmcnt(0)" ::: "memory"); SBAR();
#define PK(L, H) (bf16x8){L[0], L[1], L[2], L[3], H[0], H[1], H[2], H[3]}
    od = __builtin_amdgcn_mfma_f32_32x32x16_bf16(pa0, PK(l0, h0), od, 0, 0, 0);
    od = __builtin_amdgcn_mfma_f32_32x32x16_bf16(pa1, PK(l1, h1), od, 0, 0, 0);
    od = __builtin_amdgcn_mfma_f32_32x32x16_bf16(pa2, PK(l2, h2), od, 0, 0, 0);
    od = __builtin_amdgcn_mfma_f32_32x32x16_bf16(pa3, PK(l3, h3), od, 0, 0, 0);
#undef PK
}
__device__ __forceinline__ void pv_d0(f32x16* o, int vb, bf16x8 pa0, bf16x8 pa1, bf16x8 pa2, bf16x8 pa3) {
    pv_one<0>(o[0], vb, pa0, pa1, pa2, pa3); pv_one<1>(o[1], vb, pa0, pa1, pa2, pa3); pv_one<2>(o[2], vb, pa0, pa1, pa2, pa3); pv_one<3>(o[3], vb, pa0, pa1, pa2, pa3);
}
__device__ __forceinline__ void attn_unit(const bf16_t* __restrict__ Qb, const bf16_t* __restrict__ Kh, const bf16_t* __restrict__ Vh, bf16_t* __restrict__ Ob, int q0, int t_lo, int n, float sl2, char* lds) {
    const int tid = opaque_tid(), wid = __builtin_amdgcn_readfirstlane(tid >> 6), lane = tid & 63, r32 = lane & 31, hi = lane >> 5;
    float* ws = (float*)(lds + LDS_WS) + wid * 64; float* li_l = ws;
    float l_reg = 0; f32x16 o[4] = {}; bf16x8 qr[4];
    const bf16_t* Qw = Qb + (long)(wid * QBLK + r32) * LDQ + hi * 8;
#pragma unroll
    for (int d0 = 0; d0 < 4; ++d0) qr[d0] = *reinterpret_cast<const bf16x8*>(Qw + d0 * 16);
    float negM;
    { const bf16_t* Kw = Kh + (long)(q0 + wid * QBLK + r32) * LDK + hi * 8; float s = 0.f;
#pragma unroll
      for (int d0 = 0; d0 < 4; ++d0) { const u32x4 kw = *reinterpret_cast<const u32x4*>(Kw + d0 * 16); const u32x4 qw = __builtin_bit_cast(u32x4, qr[d0]);
          s += bflo(kw.x) * bflo(qw.x) + bfhi(kw.x) * bfhi(qw.x) + bflo(kw.y) * bflo(qw.y) + bfhi(kw.y) * bfhi(qw.y) + bflo(kw.z) * bflo(qw.z) + bfhi(kw.z) * bfhi(qw.z) + bflo(kw.w) * bflo(qw.w) + bfhi(kw.w) * bfhi(qw.w); }
      auto rr = __builtin_amdgcn_permlane32_swap(__float_as_uint(s), __float_as_uint(s), false, false); negM = -(__uint_as_float(rr[0]) + __uint_as_float(rr[1])); }
    const unsigned lds0 = (unsigned)(uintptr_t)lds;
    const int krow = wid * 8 + (lane >> 3), kch = (lane & 7) ^ ((krow >> 1) & 7);
    const unsigned koff = (unsigned)(krow * LDK * 2 + kch * 16);
    unsigned voff[2];
#pragma unroll
    for (int z = 0; z < 2; ++z) { const int P16 = (wid + 8 * z) * 64 + lane, sub = P16 >> 5, win = P16 & 31, kk = (sub >> 2) * 8 + (win >> 2), k = (kk & ~0xC) | ((kk & 4) << 1) | ((kk & 8) >> 1), c = (sub & 3) * 32 + (win & 3) * 8;
        voff[z] = (unsigned)(k * LDV * 2 + c * 2); }
    const unsigned kdst = lds0 + LDS_K + wid * 1024, vdst = lds0 + LDS_V + wid * 1024;
    const int vb0 = (int)(lds0 + LDS_V) + v_rd_base(lane);
    const char* K_lds = lds + LDS_K;
    const int qw0 = q0 + wid * QBLK;
    const float fq0 = (float)(qw0 + r32 - 4 * hi);
    const char* Kt = (const char*)(Kh + (long)t_lo * KVBLK * LDK); const char* Vt = (const char*)(Vh + (long)t_lo * KVBLK * LDV);
#define DMA(jj, slot) do { const char* kb_ = Kt + (size_t)(jj) * (KVBLK * LDK * 2); const char* vb_ = Vt + (size_t)(jj) * (KVBLK * LDV * 2); \
    glds16s(kb_, koff, (unsigned)__builtin_amdgcn_readfirstlane(kdst + (slot) * SHM_K)); \
    glds16s(vb_, voff[0], (unsigned)__builtin_amdgcn_readfirstlane(vdst + (slot) * SHM_V)); \
    glds16s(vb_, voff[1], (unsigned)__builtin_amdgcn_readfirstlane(vdst + (slot) * SHM_V + 8192)); } while (0)
#define TILE(jj) const int k0_ = (t_lo + (jj)) * KVBLK; const bool left_ = k0_ + 63 < qw0, right_ = k0_ > qw0 + 31, mixed_ = !(left_ || right_); \
    const float fd_ = fq0 - (float)k0_, st_ = left_ ? sl2 : (right_ ? -sl2 : 0.f), A_ = negM - st_ * fd_
    f32x16 pA0, pA1, pB0, pB1; bf16x8 pa0, pa1, pa2, pa3;
    asm volatile("s_waitcnt vmcnt(0)" ::: "memory");
    DMA(0, 0); DMA(1, 1);
    WAITBAR(3);
    { TILE(0); qkt(pA0, pA1, K_lds, qr, r32, hi, A_, st_); partialSM(pA0, pA1, mixed_, fd_, sl2); }
    WAITBAR(0);
    if (2 < n) DMA(2, 2);
    int s_prev = 0, s_cur = 1, s_next = 2;
#define ROT() do { const int t_ = s_prev; s_prev = s_cur; s_cur = s_next; s_next = t_; } while (0)
    for (int j = 1; j + 1 < n; j += 2) {
        { TILE(j); SBAR(); qkt(pB0, pB1, K_lds + s_cur * SHM_K, qr, r32, hi, A_, st_);
          finishSM(pA0, pA1, l_reg, pa0, pa1, pa2, pa3); SBAR();
          pv_d0(o, vb0 + s_prev * SHM_V, pa0, pa1, pa2, pa3); partialSM(pB0, pB1, mixed_, fd_, sl2); }
        WAITBAR(0);
        if (j + 2 < n) DMA(j + 2, s_prev);
        ROT();
        { TILE(j + 1); SBAR(); qkt(pA0, pA1, K_lds + s_cur * SHM_K, qr, r32, hi, A_, st_);
          finishSM(pB0, pB1, l_reg, pa0, pa1, pa2, pa3); SBAR();
          pv_d0(o, vb0 + s_prev * SHM_V, pa0, pa1, pa2, pa3); partialSM(pA0, pA1, mixed_, fd_, sl2); }
        WAITBAR(0);
        if (j + 3 < n) DMA(j + 3, s_prev);
        ROT();
    }
    { TILE(n - 1); SBAR(); qkt(pB0, pB1, K_lds + s_cur * SHM_K, qr, r32, hi, A_, st_);
      finishSM(pA0, pA1, l_reg, pa0, pa1, pa2, pa3); SBAR();
      pv_d0(o, vb0 + s_prev * SHM_V, pa0, pa1, pa2, pa3); partialSM(pB0, pB1, mixed_, fd_, sl2); }
    finishSM(pB0, pB1, l_reg, pa0, pa1, pa2, pa3); SBAR();
    pv_d0(o, vb0 + s_cur * SHM_V, pa0, pa1, pa2, pa3);
    { auto rr = __builtin_amdgcn_permlane32_swap(__float_as_uint(l_reg), __float_as_uint(l_reg), false, false); l_reg = __uint_as_float(rr[0]) + __uint_as_float(rr[1]); }
    if (hi == 0) li_l[r32] = l_reg; asm volatile("s_waitcnt lgkmcnt(0)" ::: "memory");
    float rli[16];
#pragma unroll
    for (int r = 0; r < 16; ++r) rli[r] = __builtin_amdgcn_rcpf(li_l[crow(r, hi)]);
    bf16_t* Ow = Ob + (long)(wid * QBLK) * LDO;
#pragma unroll
    for (int r = 0; r < 16; ++r) { const int orow = crow(r, hi);
#pragma unroll
        for (int d0 = 0; d0 < 4; ++d0) Ow[(long)orow * LDO + d0 * 32 + r32] = (bf16_t)f2bf(o[d0][r] * rli[r]); }
    WAITBAR(0);
#undef DMA
#undef ROT
#undef TILE
}
#undef SBAR
}

namespace hy {
struct cf { float x, y; };
__device__ __forceinline__ cf lld(const LAS f32x2* L, int i) { const f32x2 t = L[i]; return cf{t[0], t[1]}; }
__device__ __forceinline__ void lst(LAS f32x2* L, int i, cf v) { L[i] = (f32x2){v.x, v.y}; }
__device__ __forceinline__ cf cmul(cf a, cf b) { return cf{a.x * b.x - a.y * b.y, a.x * b.y + a.y * b.x}; }
__device__ __forceinline__ cf cmulc(cf a, cf b) { return cf{a.x * b.x + a.y * b.y, a.y * b.x - a.x * b.y}; }
__device__ constexpr float C32[16] = {1.0f, 0.98078528040323043f, 0.92387953251128674f, 0.83146961230254524f, 0.70710678118654757f, 0.55557023301960229f, 0.38268343236508984f, 0.19509032201612833f,
                                      0.0f, -0.19509032201612819f, -0.38268343236508973f, -0.55557023301960196f, -0.70710678118654746f, -0.83146961230254535f, -0.92387953251128674f, -0.98078528040323043f};
__device__ constexpr float S32[16] = {0.0f, 0.19509032201612825f, 0.38268343236508978f, 0.55557023301960218f, 0.70710678118654746f, 0.83146961230254524f, 0.92387953251128674f, 0.98078528040323043f,
                                      1.0f, 0.98078528040323043f, 0.92387953251128674f, 0.83146961230254546f, 0.70710678118654757f, 0.55557023301960218f, 0.38268343236508989f, 0.19509032201612861f};
__host__ __device__ constexpr int brev(int k, int bits) { int r = 0; for (int i = 0; i < bits; ++i) r |= ((k >> i) & 1) << (bits - 1 - i); return r; }
template <int R, bool INV> __device__ __forceinline__ void dft_reg(cf (&v)[R]) {
#pragma unroll
    for (int s = R / 2; s >= 1; s >>= 1) {
#pragma unroll
        for (int g0 = 0; g0 < R; g0 += 2 * s) {
#pragma unroll
            for (int j = 0; j < s; ++j) {
                const cf a = v[g0 + j], b = v[g0 + j + s];
                v[g0 + j] = cf{a.x + b.x, a.y + b.y};
                const cf d = cf{a.x - b.x, a.y - b.y};
                const int tw = j * (16 / s);
                if (tw == 0) v[g0 + j + s] = d;
                else if (tw == 8) v[g0 + j + s] = INV ? cf{-d.y, d.x} : cf{d.y, -d.x};
                else { const float c = C32[tw], sn = S32[tw]; v[g0 + j + s] = INV ? cf{d.x * c - d.y * sn, d.y * c + d.x * sn} : cf{d.x * c + d.y * sn, d.y * c - d.x * sn}; }
            }
        }
    }
}
constexpr int RS = FFT_RS;
__device__ __forceinline__ void fft_fwd12(cf (&v)[32], LAS f32x2* L, int tid) {
    dft_reg<32, false>(v);
    { float s, c; sincospif((float)tid * (1.0f / 8192.0f), &s, &c); cf w1{c, -s}; asm volatile("" : "+v"(w1.x), "+v"(w1.y)); cf w = w1;
#pragma unroll
      for (int k1 = 0; k1 < 32; ++k1) { cf x = v[brev(k1, 5)]; if (k1) { x = cmul(x, w); w = cmul(w, w1); } lst(L, k1 * RS + tid, x); } }
    __syncthreads();
    const int k1 = tid >> 4, m2 = tid & 15;
#pragma unroll
    for (int m1 = 0; m1 < 32; ++m1) v[m1] = lld(L, k1 * RS + 16 * m1 + m2);
    __syncthreads();
    dft_reg<32, false>(v);
    { float s, c; sincospif((float)m2 * (1.0f / 256.0f), &s, &c); cf w1{c, -s}; asm volatile("" : "+v"(w1.x), "+v"(w1.y)); cf w = w1;
#pragma unroll
      for (int j1 = 0; j1 < 32; ++j1) { cf x = v[brev(j1, 5)]; if (j1) { x = cmul(x, w); w = cmul(w, w1); } lst(L, k1 * RS + 33 * m2 + j1, x); } }
    __syncthreads();
}
__device__ __forceinline__ void fft_inv21(cf (&v)[32], LAS f32x2* L, int tid) {
    const int k1 = tid >> 4, m2 = tid & 15;
    { float s, c; sincospif((float)m2 * (1.0f / 256.0f), &s, &c); cf w1{c, -s}; asm volatile("" : "+v"(w1.x), "+v"(w1.y)); cf w = w1;
#pragma unroll
      for (int j1 = 0; j1 < 32; ++j1) { cf x = lld(L, k1 * RS + 33 * m2 + j1); if (j1) { x = cmulc(x, w); w = cmul(w, w1); } v[j1] = x; } }
    __syncthreads();
    dft_reg<32, true>(v);
#pragma unroll
    for (int m1 = 0; m1 < 32; ++m1) lst(L, k1 * RS + 16 * m1 + m2, v[brev(m1, 5)]);
    __syncthreads();
    { float s, c; sincospif((float)tid * (1.0f / 8192.0f), &s, &c); cf w1{c, -s}; asm volatile("" : "+v"(w1.x), "+v"(w1.y)); cf w = w1;
#pragma unroll
      for (int kk = 0; kk < 32; ++kk) { cf x = lld(L, kk * RS + tid); if (kk) { x = cmulc(x, w); w = cmul(w, w1); } v[kk] = x; } }
    dft_reg<32, true>(v);
}
}
constexpr size_t MiB = 1u << 20;
constexpr size_t WS_CTL = 0, CTL_ZERO_BYTES = 1 * MiB;
constexpr size_t WS_W1T = 1 * MiB;
constexpr size_t WS_W2T = 257 * MiB;
constexpr size_t WS_WIN_EV = 385 * MiB, WS_WOUT_EV = 409 * MiB, WS_WIN_OD = 417 * MiB, WS_WOUT_OD = 433 * MiB, WS_WG_OD = 441 * MiB;
constexpr size_t AR = 445 * MiB;
constexpr size_t A_XB = AR + 0 * MiB, A_UHT = AR + 64 * MiB, A_QB = AR + 160 * MiB, A_KB = AR + 192 * MiB, A_VB = AR + 224 * MiB, A_KTD = AR + 256 * MiB, A_KF = AR + 384 * MiB,
                 A_H3B = AR + 512 * MiB, A_W4T = AR + 514 * MiB, A_YHT = AR + 256 * MiB, A_OA = AR + 288 * MiB, A_YCAT = AR + 0 * MiB, A_R0 = AR + 64 * MiB, A_H1_0 = AR + 192 * MiB,
                 A_HB_0 = AR + 320 * MiB, A_HID_0 = AR + 384 * MiB, A_ROWL = AR + 424 * MiB, A_GATEW = AR + 428 * MiB, A_Y2_0 = AR + 0 * MiB, A_H2 = AR + 448 * MiB, A_HB2 = AR + 128 * MiB;
constexpr size_t A_GB = AR + 0 * MiB, A_XR = AR + 64 * MiB, A_XC = AR + 192 * MiB, A_LA = AR + 256 * MiB, A_BB = AR + 64 * MiB, A_CAR = AR + 384 * MiB, A_YG = AR + 192 * MiB, A_R1 = AR + 256 * MiB,
                 A_H1_1 = AR + 0 * MiB, A_HB_1 = AR + 128 * MiB, A_HID_1 = AR + 192 * MiB, A_Y2_1 = AR + 256 * MiB;
constexpr size_t WS_END = AR + 576 * MiB;
constexpr int CW_BAR = 4096, CW_CNT = 16384, CW_NORM = 24576;
constexpr int LDS_MISC = 139264, LDS_BYTES = 147456;
constexpr int NPHASE = 21;

struct Args { const float* in[37]; float* out; unsigned char* ws; int ph_lo, ph_hi; };
typedef const __attribute__((address_space(4))) Args& KArgs;

__device__ __forceinline__ void transpose_item(const float* W, int N, int k0, int n0, bf16_t* WT, int ldk, int drow0, LAS float* scr, int lane) {
#pragma unroll 8
    for (int i = 0; i < 32; ++i) { const int kk = 2 * i + (lane >> 5); scr[kk * 33 + (lane & 31)] = W[(size_t)(k0 + kk) * N + n0 + (lane & 31)]; }
    LDS_WAIT(); asm volatile("" ::: "memory");
    const int c = lane & 7;
#pragma unroll
    for (int j = 0; j < 4; ++j) { const int n = (lane >> 3) + 8 * j; const LAS float* s = scr + (8 * c) * 33 + n;
        u32x4 o; o.x = pk2(s[0 * 33], s[1 * 33]); o.y = pk2(s[2 * 33], s[3 * 33]); o.z = pk2(s[4 * 33], s[5 * 33]); o.w = pk2(s[6 * 33], s[7 * 33]);
        *(u32x4*)(WT + (size_t)(drow0 + n) * ldk + k0 + 8 * c) = o; }
    LDS_WAIT(); asm volatile("" ::: "memory");
}

__device__ __forceinline__ void phase_prologue(KArgs a, LAS unsigned char* lds) {
    const int tid = opaque_tid(), lane = tid & 63, wave = tid >> 6, G = gridDim.x;
    const int gw = blockIdx.x * 8 + wave, NGW = G * 8;
    unsigned char* ws = a.ws;
    LAS float* scr = (LAS float*)(lds + wave * 16384);
    constexpr int I_EVIN = 32 * 192, I_SQ = 32 * 64, I_ODIN = 32 * 128, I_MOE_GU = 64 * 512, I_MOE_D = 64 * 512, I_RG = 16 * 32, I_W4 = 128;
    constexpr int O1 = I_EVIN, O2 = O1 + I_SQ, O3 = O2 + I_ODIN, O4 = O3 + I_SQ, O5 = O4 + I_MOE_GU, O6 = O5 + I_MOE_GU, O7 = O6 + I_MOE_D, O8 = O7 + I_RG, O9 = O8 + I_RG, O10 = O9 + I_W4;
    for (int it = gw; it < O10; it += NGW) {
        if (it < O1) { const int kb = it / 192, nb = it % 192; transpose_item(a.in[1], EV_IN, kb * 64, nb * 32, (bf16_t*)(ws + WS_WIN_EV), DM, nb * 32, scr, lane); }
        else if (it < O2) { const int r = it - O1, kb = r / 64, nb = r % 64; transpose_item(a.in[18], DM, kb * 64, nb * 32, (bf16_t*)(ws + WS_WOUT_EV), DM, nb * 32, scr, lane); }
        else if (it < O3) { const int r = it - O2, kb = r / 128, nb = r % 128; transpose_item(a.in[19], 2 * DM, kb * 64, nb * 32, (bf16_t*)(ws + WS_WIN_OD), DM, nb * 32, scr, lane); }
        else if (it < O4) { const int r = it - O3, kb = r / 64, nb = r % 64; transpose_item(a.in[27], DM, kb * 64, nb * 32, (bf16_t*)(ws + WS_WOUT_OD), DM, nb * 32, scr, lane); }
        else if (it < O6) { const bool up = it >= O5; const int r = it - (up ? O5 : O4), le = r / 512, q = r % 512, kb = q / 16, nb = q % 16, n0 = nb * 32;
            transpose_item((up ? a.in[35] : a.in[34]) + (size_t)le * DM * DFF, DFF, kb * 64, n0, (bf16_t*)(ws + WS_W1T) + (size_t)le * 1024 * DM, DM, (n0 >> 7) * 256 + (n0 & 127) + (up ? 128 : 0), scr, lane); }
        else if (it < O7) { const int r = it - O6, le = r / 512, q = r % 512, kb = q / 64, nb = q % 64;
            transpose_item(a.in[36] + (size_t)le * DFF * DM, DM, kb * 64, nb * 32, (bf16_t*)(ws + WS_W2T) + (size_t)le * DM * DFF, DFF, nb * 32, scr, lane); }
        else if (it < O9) { const bool wx = it >= O8; const int r = it - (wx ? O8 : O7), dn = r / 32, q = r % 32, kb = q / 8, nb = q % 8, n0 = nb * 32, dir = dn / 8, n = dn % 8;
            transpose_item((wx ? a.in[24] : a.in[22]) + (size_t)dn * 65536, 256, kb * 64, n0, (bf16_t*)(ws + WS_WG_OD), 256, (n * 4 + dir * 2 + (n0 >> 7)) * 256 + (n0 & 127) + (wx ? 128 : 0), scr, lane); }
        else { const int nb = it - O9; transpose_item(a.in[11], 4096, 0, nb * 32, (bf16_t*)(ws + A_W4T), 128, nb * 32, scr, lane); }
    }
    { const int gt = blockIdx.x * 512 + tid, NT = G * 512;
      for (int i = gt; i < 4096 * 8; i += NT) { const int r = i >> 3, c = i & 7; *(u32x4*)((bf16_t*)(ws + A_W4T) + (size_t)r * 128 + 64 + c * 8) = (u32x4){0u, 0u, 0u, 0u}; }
      for (int i = gt; i < 8192 * 8; i += NT) { const int r = i >> 3, c = i & 7; *(u32x4*)((bf16_t*)(ws + A_H3B) + (size_t)r * 128 + 64 + c * 8) = (u32x4){0u, 0u, 0u, 0u}; }
      const f32x8* x8 = (const f32x8*)a.in[0]; u32x4* xb = (u32x4*)(ws + A_XB);
      for (int i = gt; i < NTOK * DM / 8; i += NT) { const f32x8 v = x8[i]; u32x4 o; o.x = pk2(v[0], v[1]); o.y = pk2(v[2], v[3]); o.z = pk2(v[4], v[5]); o.w = pk2(v[6], v[7]); xb[i] = o; } }
    { const float* w1 = a.in[4]; const float* b1 = a.in[5]; const float* w2 = a.in[6]; const float* b2 = a.in[7]; const float* w3 = a.in[8]; const float* b3 = a.in[9]; const float* fr = a.in[10];
      const float frq = fr[lane];
      for (int t = gw; t < SEQ; t += NGW) {
          float z;
          { const float tl = (float)t * (1.0f / 8191.0f);
            if (lane == 0) z = tl;
            else { const int j = (lane - 1) & 15; const float band = 1e-4f + (float)j * ((15.0f - 1e-4f) / 15.0f);
                   const float ang = (6.283185307179586f * (float)t * (1.0f / 8192.0f)) * band; float sn, cs; sincosf(ang, &sn, &cs); z = (lane <= 16) ? cs : -sn; } }
          float acc = b1[lane];
#pragma unroll
          for (int i = 0; i < 33; ++i) acc += __shfl(z, i) * w1[i * 64 + lane];
          float h = sinf(frq * acc);
          acc = b2[lane];
#pragma unroll 16
          for (int i = 0; i < 64; ++i) acc += __shfl(h, i) * w2[i * 64 + lane];
          h = sinf(frq * acc);
          acc = b3[lane];
#pragma unroll 16
          for (int i = 0; i < 64; ++i) acc += __shfl(h, i) * w3[i * 64 + lane];
          h = sinf(frq * acc);
          ((bf16_t*)(ws + A_H3B))[(size_t)t * 128 + lane] = (bf16_t)f2bf(h);
      } }
}

__device__ __forceinline__ void phase_filter_fft(KArgs a, LAS unsigned char* lds) {
    const int tid = opaque_tid(), lane = tid & 63, wave = tid >> 6, G = gridDim.x;
    LAS f32x2* L = (LAS f32x2*)lds; LAS float* red = (LAS float*)(lds + LDS_MISC + 1024);
    const float* KTD = (const float*)(a.ws + A_KTD); __half2* KF = (__half2*)(a.ws + A_KF);
    for (int u = blockIdx.x; u < 2048; u += G) {
        const int o = u >> 10, c = u & 1023;
        int tl = tid; asm volatile("" : "+v"(tl));
        const float* rowF = KTD + (size_t)(o * 1024 + c) * 8192; const float* rowB = KTD + (size_t)(2048 + o * 1024 + c) * 8192;
        hy::cf v[32]; float ss = 0.f;
#pragma unroll
        for (int n1 = 0; n1 < 32; ++n1) { const int p = tl + 512 * n1; float val;
            if (n1 < 16) val = rowF[p]; else if (p == 8192) val = 0.f; else val = rowB[16384 - p];
            v[n1] = hy::cf{val, 0.f}; ss += val * val; }
        ss = wave_sum(ss); if (lane == 0) red[wave] = ss; __syncthreads();
        float tot = 0.f;
#pragma unroll
        for (int w = 0; w < 8; ++w) tot += red[w];
        const float scale = rsqrtf(tot), skp = a.in[12][u];
        hy::fft_fwd12(v, L, tl);
#pragma unroll
        for (int bf = 0; bf < 2; ++bf) { const int idx = bf * 512 + tl, k1 = idx >> 5, j1 = idx & 31; hy::cf w[16];
#pragma unroll
            for (int m2 = 0; m2 < 16; ++m2) w[m2] = hy::lld(L, k1 * hy::RS + 33 * m2 + j1);
            hy::dft_reg<16, false>(w);
#pragma unroll
            for (int j2 = 0; j2 < 16; ++j2) { const hy::cf x = w[hy::brev(j2, 4)]; KF[((size_t)(u * 2 + bf) * 16 + j2) * 512 + tl] = __floats2half2_rn(x.x * scale + skp, x.y * scale); } }
        __syncthreads();
    }
}
__device__ __forceinline__ float hyconv(const bf16_t* row, int t, float w0, float w1, float w2, float bias) {
    const unsigned tm = (unsigned)(t > 0 ? t - 1 : 0), tp = (unsigned)(t < SEQ - 1 ? t + 1 : SEQ - 1);
    float xm = bf2f(row[tm]), x0 = bf2f(row[(unsigned)t]), xp = bf2f(row[tp]);
    xm = t > 0 ? xm : 0.f; xp = t < SEQ - 1 ? xp : 0.f;
    return w0 * xm + w1 * x0 + w2 * xp + bias;
}
__device__ __forceinline__ void phase_hyena_mixer(KArgs a, LAS unsigned char* lds) {
    const int tid = opaque_tid(), G = gridDim.x;
    LAS f32x2* L = (LAS f32x2*)lds;
    const bf16_t* UHT = (const bf16_t*)(a.ws + A_UHT); const __half2* KF = (const __half2*)(a.ws + A_KF); bf16_t* YHT = (bf16_t*)(a.ws + A_YHT);
    const float* cw = a.in[2]; const float* cb = a.in[3];
    for (int c = blockIdx.x; c < HY_CH; c += G) {
        int tl = tid; asm volatile("" : "+v"(tl));
        hy::cf v[32];
        { const bf16_t* r0 = UHT + (size_t)c * NTOK; const float w0 = cw[c], w1 = cw[3072 + c], w2 = cw[6144 + c], bb = cb[c];
#pragma unroll
          for (int n1 = 0; n1 < 16; ++n1) { const int t = tl + 512 * n1; v[n1] = hy::cf{hyconv(r0, t, w0, w1, w2, bb), hyconv(r0 + SEQ, t, w0, w1, w2, bb)}; if ((n1 & 3) == 3) asm volatile("" ::: "memory"); } }
#pragma unroll 1
        for (int o = 0; o < 2; ++o) {
#pragma unroll
            for (int n1 = 16; n1 < 32; ++n1) v[n1] = hy::cf{0.f, 0.f};
            hy::fft_fwd12(v, L, tl);
#pragma unroll
            for (int bf = 0; bf < 2; ++bf) { const int idx = bf * 512 + tl, k1 = idx >> 5, j1 = idx & 31; hy::cf w[16];
#pragma unroll
                for (int m2 = 0; m2 < 16; ++m2) w[m2] = hy::lld(L, k1 * hy::RS + 33 * m2 + j1);
                hy::dft_reg<16, false>(w);
                asm volatile("" ::: "memory");
                hy::cf y[16];
#pragma unroll
                for (int j2 = 0; j2 < 16; ++j2) { const float2 kf = __half22float2(KF[((size_t)((o * 1024 + c) * 2 + bf) * 16 + j2) * 512 + tl]);
                    y[j2] = hy::cmul(w[hy::brev(j2, 4)], hy::cf{kf.x, kf.y}); }
                hy::dft_reg<16, true>(y);
#pragma unroll
                for (int m2 = 0; m2 < 16; ++m2) hy::lst(L, k1 * hy::RS + 33 * m2 + j1, y[hy::brev(m2, 4)]); }
            __syncthreads();
            hy::fft_inv21(v, L, tl);
            const int gch = (o + 1) * 1024 + c; const bf16_t* rg = UHT + (size_t)gch * NTOK;
            const float w0 = cw[gch], w1 = cw[3072 + gch], w2 = cw[6144 + gch], bb = cb[gch];
            hy::cf zn[16]; int tg = tl; asm volatile("" : "+v"(tg));
#pragma unroll
            for (int n1 = 0; n1 < 16; ++n1) { const int t = tg + 512 * n1; const hy::cf y = v[hy::brev(n1, 5)];
                const float g0 = hyconv(rg, t, w0, w1, w2, bb), g1 = hyconv(rg + SEQ, t, w0, w1, w2, bb);
                zn[n1] = hy::cf{g0 * y.x * (1.0f / 16384.0f), g1 * y.y * (1.0f / 16384.0f)}; if ((n1 & 3) == 3) asm volatile("" ::: "memory"); }
#pragma unroll
            for (int n1 = 0; n1 < 16; ++n1) v[n1] = zn[n1];
        }
        bf16_t* yo = YHT + (size_t)c * NTOK;
#pragma unroll
        for (int n1 = 0; n1 < 16; ++n1) { const int t = tl + 512 * n1; yo[t] = (bf16_t)f2bf(v[n1].x); yo[SEQ + t] = (bf16_t)f2bf(v[n1].y); }
    }
    __syncthreads();
}
__device__ __forceinline__ void phase_qknorm(KArgs a, LAS unsigned char* lds) {
    const int tid = opaque_tid(), lane = tid & 63, wave = tid >> 6, gw = blockIdx.x * 8 + wave, NGW = gridDim.x * 8;
    LAS unsigned* red = (LAS unsigned*)(lds + LDS_MISC + 1536);
    unsigned* ctl = (unsigned*)(a.ws + WS_CTL);
    if (tid < 64) red[tid] = 0u;
    __syncthreads();
    for (int which = 0; which < 2; ++which) { const bf16_t* P = (const bf16_t*)(a.ws + (which ? A_KB : A_QB));
        for (int b = 0; b < 2; ++b) { float mx = 0.f;
            for (int row = gw; row < SEQ; row += NGW) { const bf16_t* p = P + ((size_t)b * SEQ + row) * 1024 + lane * 16;
                const u32x4 w0 = *(const u32x4*)p, w1 = *(const u32x4*)(p + 8); const unsigned ww[8] = {w0.x, w0.y, w0.z, w0.w, w1.x, w1.y, w1.z, w1.w};
                float ss = 0.f;
#pragma unroll
                for (int i = 0; i < 8; ++i) { const float x = bflo(ww[i]), y = bfhi(ww[i]); ss += x * x + y * y; }
                ss += __shfl_xor(ss, 1); ss += __shfl_xor(ss, 2); mx = fmaxf(mx, ss); }
            if ((lane & 3) == 0) atomicMax((unsigned*)&red[which * 32 + b * 16 + (lane >> 2)], __float_as_uint(mx)); } }
    __syncthreads();
    if (tid < 64) atomicMax(ctl + CW_NORM + tid, red[tid]);
}
__device__ __forceinline__ void phase_attention(KArgs a, LAS unsigned char* lds) {
    const int G = gridDim.x, bx = blockIdx.x;
    const bf16_t* QB = (const bf16_t*)(a.ws + A_QB); const bf16_t* KB = (const bf16_t*)(a.ws + A_KB); const bf16_t* VB = (const bf16_t*)(a.ws + A_VB); bf16_t* OA = (bf16_t*)(a.ws + A_OA);
    const unsigned* nrm = (const unsigned*)(a.ws + WS_CTL) + CW_NORM;
    for (int i = 0;; ++i) {
        int bhc, qb;
        if (G == 256) { if (i >= 4) break;
            const int x = bx & 7, pr = x >> 1, b = x & 1, h = (i < 2) ? 7 - pr : pr, cm = i & 1; bhc = b * 16 + h * 2 + cm; qb = bx >> 3; }
        else { const int Lu = i * G + bx; if (Lu >= 1024) break; bhc = Lu >> 5; qb = Lu & 31; }
        const int b = bhc >> 4, h = (bhc >> 1) & 7, cm = bhc & 1;
        const size_t rowq = (size_t)b * SEQ + (size_t)qb * 256;
        const float sl2 = exp2f(-(float)(h + 1)) * 1.4426950408889634f;
        const float qk = sqrtf(__uint_as_float(nrm[bhc]) * __uint_as_float(nrm[32 + bhc]));
        const float Wk = (2.0f * qk + 46.0f) / sl2, q0f = (float)(qb * 256);
        int t_lo = (int)fmaxf(floorf((q0f - Wk - 63.0f) * (1.0f / 64.0f)), 0.0f), t_hi = (int)fminf(ceilf((q0f + 255.0f + Wk) * (1.0f / 64.0f)), 127.0f);
        if (((t_hi - t_lo + 1) & 1) != 0) { if (t_hi < 127) ++t_hi; else --t_lo; }
        att::attn_unit(QB + rowq * 1024 + h * 128 + cm * 64, KB + (size_t)b * SEQ * 1024 + h * 128 + cm * 64, VB + (size_t)b * SEQ * 1024 + h * 128,
                       OA + (size_t)cm * NTOK * 1024 + rowq * 1024 + h * 128, qb * 256, t_lo, t_hi - t_lo + 1, sl2, (char*)lds);
    }
}
__device__ __forceinline__ void phase_concat(KArgs a, LAS unsigned char* lds) {
    const int tid = opaque_tid(), lane = tid & 63, wave = tid >> 6, G = gridDim.x;
    const bf16_t* YHT = (const bf16_t*)(a.ws + A_YHT); const bf16_t* OA0 = (const bf16_t*)(a.ws + A_OA); const bf16_t* OA1 = OA0 + (size_t)NTOK * 1024; bf16_t* YC = (bf16_t*)(a.ws + A_YCAT);
    LAS bf16_t* T = (LAS bf16_t*)lds;
    const float lambda_init = 0.2f;
    const float lam = __expf(wave_sum(a.in[13][lane] * a.in[14][lane])) - __expf(wave_sum(a.in[15][lane] * a.in[16][lane])) + lambda_init;
    float gl[16];
#pragma unroll
    for (int i = 0; i < 16; ++i) gl[i] = a.in[17][(lane & 7) * 16 + i] * (1.0f - lambda_init);
    for (int it = blockIdx.x; it < NTOK / 64; it += G) {
        const int tok0 = it * 64;
#pragma unroll 4
        for (int k = 0; k < 16; ++k) { const int idx = tid + 512 * k, c = idx >> 3, ch = idx & 7;
            const u32x4 w = *(const u32x4*)(YHT + (size_t)c * NTOK + tok0 + ch * 8);
            LAS bf16_t* d = T + (ch * 8) * 1026 + c;
            d[0 * 1026] = (bf16_t)(w.x & 0xffff); d[1 * 1026] = (bf16_t)(w.x >> 16); d[2 * 1026] = (bf16_t)(w.y & 0xffff); d[3 * 1026] = (bf16_t)(w.y >> 16);
            d[4 * 1026] = (bf16_t)(w.z & 0xffff); d[5 * 1026] = (bf16_t)(w.z >> 16); d[6 * 1026] = (bf16_t)(w.w & 0xffff); d[7 * 1026] = (bf16_t)(w.w >> 16); }
        __syncthreads();
#pragma unroll 4
        for (int k = 0; k < 16; ++k) { const int idx = tid + 512 * k, tl = idx >> 7, c8 = idx & 127;
            const LAS unsigned* s = (const LAS unsigned*)(T + tl * 1026 + c8 * 8);
            u32x4 w; w.x = s[0]; w.y = s[1]; w.z = s[2]; w.w = s[3];
            *(u32x4*)(YC + (size_t)(tok0 + tl) * DM + c8 * 8) = w; }
        for (int rr = 0; rr < 8; ++rr) { const size_t tok = (size_t)tok0 + wave * 8 + rr;
            const u32x4 p0 = *(const u32x4*)(OA0 + tok * 1024 + lane * 16), p1 = *(const u32x4*)(OA0 + tok * 1024 + lane * 16 + 8);
            const u32x4 q0 = *(const u32x4*)(OA1 + tok * 1024 + lane * 16), q1 = *(const u32x4*)(OA1 + tok * 1024 + lane * 16 + 8);
            const unsigned pw[8] = {p0.x, p0.y, p0.z, p0.w, p1.x, p1.y, p1.z, p1.w}, qw[8] = {q0.x, q0.y, q0.z, q0.w, q1.x, q1.y, q1.z, q1.w};
            float o[16]; float ss = 0.f;
#pragma unroll
            for (int i = 0; i < 8; ++i) { o[2 * i] = bflo(pw[i]) - lam * bflo(qw[i]); o[2 * i + 1] = bfhi(pw[i]) - lam * bfhi(qw[i]); ss += o[2 * i] * o[2 * i] + o[2 * i + 1] * o[2 * i + 1]; }
            ss += __shfl_xor(ss, 1); ss += __shfl_xor(ss, 2); ss += __shfl_xor(ss, 4);
            const float rs = rsqrtf(ss * (1.0f / 128.0f) + LN_EPS);
            u32x4 w0, w1;
            w0.x = pk2(o[0] * rs * gl[0], o[1] * rs * gl[1]); w0.y = pk2(o[2] * rs * gl[2], o[3] * rs * gl[3]); w0.z = pk2(o[4] * rs * gl[4], o[5] * rs * gl[5]); w0.w = pk2(o[6] * rs * gl[6], o[7] * rs * gl[7]);
            w1.x = pk2(o[8] * rs * gl[8], o[9] * rs * gl[9]); w1.y = pk2(o[10] * rs * gl[10], o[11] * rs * gl[11]); w1.z = pk2(o[12] * rs * gl[12], o[13] * rs * gl[13]); w1.w = pk2(o[14] * rs * gl[14], o[15] * rs * gl[15]);
            *(u32x4*)(YC + tok * DM + 1024 + lane * 16) = w0; *(u32x4*)(YC + tok * DM + 1024 + lane * 16 + 8) = w1; }
        __syncthreads();
    }
}
__device__ __forceinline__ void ln_row(f32x4 (&v)[8], const float* g, const float* b, int lane) {
    float s = 0.f;
#pragma unroll
    for (int j = 0; j < 8; ++j) s += (v[j][0] + v[j][1]) + (v[j][2] + v[j][3]);
    const float mean = wave_sum(s) * (1.0f / DM); float s2 = 0.f;
#pragma unroll
    for (int j = 0; j < 8; ++j) { v[j] = v[j] - mean; s2 += (v[j][0] * v[j][0] + v[j][1] * v[j][1]) + (v[j][2] * v[j][2] + v[j][3] * v[j][3]); }
    const float rstd = rsqrtf(wave_sum(s2) * (1.0f / DM) + LN_EPS);
#pragma unroll
    for (int j = 0; j < 8; ++j) { const f32x4 gg = *(const f32x4*)(g + 4 * (lane + 64 * j)), bb = *(const f32x4*)(b + 4 * (lane + 64 * j)); v[j] = v[j] * rstd * gg + bb; }
}
__device__ __forceinline__ void phase_ln_router(KArgs a, LAS unsigned char* lds, const float* R, const float* g, const float* b, float* H1, bf16_t* HB, unsigned* cnt, int* rowlist, float* gatew) {
    const int tid = opaque_tid(), lane = tid & 63, wave = tid >> 6, G = gridDim.x;
    const float* rw = a.in[32]; const float* rb = a.in[33];
    LAS float* part = (LAS float*)lds;
    LAS int* hist = (LAS int*)(lds + 40960); LAS int* base = hist + 32;
    for (int it = blockIdx.x; it < NTOK / 32; it += G) {
        const int tok0 = it * 32;
        for (int rr = 0; rr < 4; ++rr) { const size_t row = (size_t)tok0 + wave * 4 + rr; f32x4 v[8];
#pragma unroll
            for (int j = 0; j < 8; ++j) v[j] = *(const f32x4*)(R + row * DM + 4 * (lane + 64 * j));
            ln_row(v, g, b, lane);
#pragma unroll
            for (int j = 0; j < 8; ++j) { *(f32x4*)(H1 + row * DM + 4 * (lane + 64 * j)) = v[j]; u32x2 w; w.x = pk2(v[j][0], v[j][1]); w.y = pk2(v[j][2], v[j][3]); *(u32x2*)(HB + row * DM + 4 * (lane + 64 * j)) = w; } }
        if (tid < 32) hist[tid] = 0;
        VM_WAIT(); __syncthreads();
        { const int i = lane & 31, kk = lane >> 5; f32x16 acc = {};
          const float* hrow = H1 + (size_t)(tok0 + i) * DM + wave * 256 + 4 * kk; const float* rwp = rw + (size_t)(wave * 256 + 4 * kk) * NEXP + i;
#pragma unroll 4
          for (int s = 0; s < 32; ++s) { const f32x4 hv = __builtin_nontemporal_load((const f32x4*)(hrow + 8 * s));
#pragma unroll
              for (int j = 0; j < 4; ++j) acc = __builtin_amdgcn_mfma_f32_32x32x2f32(rwp[(size_t)(8 * s + j) * NEXP], hv[j], acc, 0, 0, 0); }
#pragma unroll
          for (int r = 0; r < 16; ++r) part[(wave * 32 + i) * 33 + (r & 3) + 8 * (r >> 2) + 4 * kk] = acc[r]; }
        __syncthreads();
        int e1 = 0, e2 = 0, r1 = 0, r2 = 0; float g1 = 0.f, g2 = 0.f;
        if (tid < 32) {
            float bestg = -1e30f;
#pragma unroll
            for (int gi = 0; gi < 4; ++gi) { float m1 = -1e30f, m2 = -1e30f, s1 = 0.f, s2 = 0.f; int i1 = 0, i2 = 0;
#pragma unroll
                for (int j = 0; j < 8; ++j) { const int e = gi * 8 + j; float lg = 0.f;
#pragma unroll
                    for (int w = 0; w < 8; ++w) lg += part[(w * 32 + tid) * 33 + e];
                    const float sg = 1.0f / (1.0f + expf(-lg)), sl = sg + rb[e];
                    if (sl > m1) { m2 = m1; i2 = i1; s2 = s1; m1 = sl; i1 = j; s1 = sg; } else if (sl > m2) { m2 = sl; i2 = j; s2 = sg; } }
                const float gs = m1 + m2;
                if (gs > bestg) { bestg = gs; e1 = gi * 8 + i1; e2 = gi * 8 + i2; g1 = s1; g2 = s2; } }
            const float inv = 1.0f / (g1 + g2); g1 *= inv; g2 *= inv;
            r1 = atomicAdd((int*)&hist[e1], 1); r2 = atomicAdd((int*)&hist[e2], 1);
        }
        __syncthreads();
        if (tid < 32) { const int hc = hist[tid]; base[tid] = hc ? (int)__hip_atomic_fetch_add(cnt + tid * 64, (unsigned)hc, __ATOMIC_RELAXED, __HIP_MEMORY_SCOPE_AGENT) : 0; }
        __syncthreads();
        if (tid < 32) { const int a0 = (tok0 + tid) * 2;
            rowlist[(size_t)e1 * ECAP + base[e1] + r1] = a0; gatew[a0] = g1;
            rowlist[(size_t)e2 * ECAP + base[e2] + r2] = a0 + 1; gatew[a0 + 1] = g2; }
        __syncthreads();
    }
}
__device__ __forceinline__ void phase_ln2(const float* H1, const bf16_t* Y2, const float* g, const float* b, float* OUT, bf16_t* OB) {
    const int tid = opaque_tid(), lane = tid & 63, wave = tid >> 6;
    for (int row = blockIdx.x * 8 + wave; row < NTOK; row += gridDim.x * 8) { f32x4 v[8];
#pragma unroll
        for (int j = 0; j < 8; ++j) { const int c = 4 * (lane + 64 * j); const f32x4 h = *(const f32x4*)(H1 + (size_t)row * DM + c);
            const u32x2 y0 = *(const u32x2*)(Y2 + (size_t)(2 * row) * DM + c), y1 = *(const u32x2*)(Y2 + (size_t)(2 * row + 1) * DM + c);
            v[j] = h * DN_ALPHA + (f32x4){bflo(y0.x) + bflo(y1.x), bfhi(y0.x) + bfhi(y1.x), bflo(y0.y) + bflo(y1.y), bfhi(y0.y) + bfhi(y1.y)}; }
        ln_row(v, g, b, lane);
#pragma unroll
        for (int j = 0; j < 8; ++j) { const int c = 4 * (lane + 64 * j); *(f32x4*)(OUT + (size_t)row * DM + c) = v[j];
            if (OB) { u32x2 w; w.x = pk2(v[j][0], v[j][1]); w.y = pk2(v[j][2], v[j][3]); *(u32x2*)(OB + (size_t)row * DM + c) = w; } }
    }
}
__device__ __forceinline__ void moe_table(LAS int* tab, const unsigned* cnt) {
    __syncthreads();
    const int tid = opaque_tid();
    if (tid < 32) tab[64 + tid] = (int)cnt[tid * 64];
    __syncthreads();
    if (tid == 0) { int acc = 0; for (int e = 0; e < 32; ++e) { tab[e] = acc; acc += (tab[64 + e] + 255) >> 8; } tab[32] = acc; }
    __syncthreads();
}
__device__ __forceinline__ void phase_conv4(KArgs a) {
    const bf16_t* XR = (const bf16_t*)(a.ws + A_XR); bf16_t* XC = (bf16_t*)(a.ws + A_XC); const float* cw = a.in[20]; const float* cb = a.in[21];
    const int NT = gridDim.x * 512;
    for (int it = blockIdx.x * 512 + opaque_tid(); it < NTOK * 256; it += NT) { const int tok = it >> 8, ch = (it & 255) * 8, t = tok & (SEQ - 1);
        float acc[8];
#pragma unroll
        for (int i = 0; i < 8; ++i) acc[i] = cb[ch + i];
#pragma unroll
        for (int j = 0; j < 4; ++j) { const int tt = t + j - 2;
            if (tt >= 0 && tt < SEQ) { const u32x4 w = *(const u32x4*)(XR + (size_t)(tok + j - 2) * DM + ch); const unsigned ww[4] = {w.x, w.y, w.z, w.w};
#pragma unroll
                for (int i = 0; i < 4; ++i) { acc[2 * i] += cw[j * DM + ch + 2 * i] * bflo(ww[i]); acc[2 * i + 1] += cw[j * DM + ch + 2 * i + 1] * bfhi(ww[i]); } } }
        u32x4 o; o.x = pk2(acc[0], acc[1]); o.y = pk2(acc[2], acc[3]); o.z = pk2(acc[4], acc[5]); o.w = pk2(acc[6], acc[7]);
        *(u32x4*)(XC + (size_t)tok * DM + ch) = o; }
}
constexpr size_t CAR_ELEMS = (size_t)2 * 2 * 256 * DM;
__device__ __forceinline__ void phase_scan1(KArgs a) {
    const bf16_t* LA = (const bf16_t*)(a.ws + A_LA); const bf16_t* BB = (const bf16_t*)(a.ws + A_BB); float* CARA = (float*)(a.ws + A_CAR); float* CARB = CARA + CAR_ELEMS;
    const int NT = gridDim.x * 512;
    for (int it = blockIdx.x * 512 + opaque_tid(); it < 2 * 2 * 256 * 512; it += NT) { const int ch = (it & 511) * 4, chunk = (it >> 9) & 255, dir = (it >> 17) & 1, b = it >> 18;
        float h[4] = {0.f, 0.f, 0.f, 0.f}, ls[4] = {0.f, 0.f, 0.f, 0.f};
#pragma unroll 8
        for (int s = 0; s < 32; ++s) { const int t = chunk * 32 + (dir ? 31 - s : s); const size_t off = ((size_t)dir * NTOK + (size_t)b * SEQ + t) * DM + ch;
            const u32x2 lw = *(const u32x2*)(LA + off), bw = *(const u32x2*)(BB + off);
            const float l4[4] = {bflo(lw.x), bfhi(lw.x), bflo(lw.y), bfhi(lw.y)}, b4[4] = {bflo(bw.x), bfhi(bw.x), bflo(bw.y), bfhi(bw.y)};
#pragma unroll
            for (int i = 0; i < 4; ++i) { h[i] = __expf(l4[i]) * h[i] + b4[i]; ls[i] += l4[i]; } }
        const size_t co = (((size_t)b * 2 + dir) * 256 + chunk) * DM + ch;
        *(f32x4*)(CARA + co) = (f32x4){ls[0], ls[1], ls[2], ls[3]}; *(f32x4*)(CARB + co) = (f32x4){h[0], h[1], h[2], h[3]}; }
}
__device__ __forceinline__ void phase_scan2(KArgs a) {
    float* CARA = (float*)(a.ws + A_CAR); float* CARB = CARA + CAR_ELEMS; float* CARIN = CARB + CAR_ELEMS;
    const int NT = gridDim.x * 512;
    for (int it = blockIdx.x * 512 + opaque_tid(); it < 2 * 2 * DM; it += NT) { const int ch = it & (DM - 1), dir = (it >> 11) & 1, b = it >> 12;
        float h = 0.f;
#pragma unroll 8
        for (int k = 0; k < 256; ++k) { const int chunk = dir ? 255 - k : k; const size_t co = (((size_t)b * 2 + dir) * 256 + chunk) * DM + ch;
            CARIN[co] = h; h = __expf(CARA[co]) * h + CARB[co]; } }
}
__device__ __forceinline__ float gelu_tanh(float x) { const float u = 0.7978845608028654f * (x + 0.044715f * x * x * x); const float th = 1.0f - 2.0f / (1.0f + __expf(2.0f * u)); return 0.5f * x * (1.0f + th); }
__device__ __forceinline__ void phase_scan3(KArgs a) {
    const bf16_t* LA = (const bf16_t*)(a.ws + A_LA); const bf16_t* BB = (const bf16_t*)(a.ws + A_BB); const bf16_t* GB = (const bf16_t*)(a.ws + A_GB); bf16_t* YG = (bf16_t*)(a.ws + A_YG);
    const float* CARIN = (const float*)(a.ws + A_CAR) + 2 * CAR_ELEMS;
    const int NT = gridDim.x * 512;
    for (int it = blockIdx.x * 512 + opaque_tid(); it < 2 * 256 * 512; it += NT) { const int ch = (it & 511) * 4, chunk = (it >> 9) & 255, b = it >> 17;
        float hf[32][4]; float h[4];
        { const f32x4 c = *(const f32x4*)(CARIN + (((size_t)b * 2 + 0) * 256 + chunk) * DM + ch); h[0] = c[0]; h[1] = c[1]; h[2] = c[2]; h[3] = c[3]; }
#pragma unroll
        for (int s = 0; s < 32; ++s) { const size_t off = ((size_t)b * SEQ + chunk * 32 + s) * DM + ch;
            const u32x2 lw = *(const u32x2*)(LA + off), bw = *(const u32x2*)(BB + off);
            const float l4[4] = {bflo(lw.x), bfhi(lw.x), bflo(lw.y), bfhi(lw.y)}, b4[4] = {bflo(bw.x), bfhi(bw.x), bflo(bw.y), bfhi(bw.y)};
#pragma unroll
            for (int i = 0; i < 4; ++i) { h[i] = __expf(l4[i]) * h[i] + b4[i]; hf[s][i] = h[i]; } }
        { const f32x4 c = *(const f32x4*)(CARIN + (((size_t)b * 2 + 1) * 256 + chunk) * DM + ch); h[0] = c[0]; h[1] = c[1]; h[2] = c[2]; h[3] = c[3]; }
#pragma unroll
        for (int s = 31; s >= 0; --s) { const size_t tokoff = ((size_t)b * SEQ + chunk * 32 + s) * DM + ch; const size_t off = (size_t)NTOK * DM + tokoff;
            const u32x2 lw = *(const u32x2*)(LA + off), bw = *(const u32x2*)(BB + off), gw = *(const u32x2*)(GB + tokoff);
            const float l4[4] = {bflo(lw.x), bfhi(lw.x), bflo(lw.y), bfhi(lw.y)}, b4[4] = {bflo(bw.x), bfhi(bw.x), bflo(bw.y), bfhi(bw.y)}, g4[4] = {bflo(gw.x), bfhi(gw.x), bflo(gw.y), bfhi(gw.y)};
            float y[4];
#pragma unroll
            for (int i = 0; i < 4; ++i) { h[i] = __expf(l4[i]) * h[i] + b4[i]; y[i] = gelu_tanh(g4[i]) * (hf[s][i] + h[i]); }
            u32x2 w; w.x = pk2(y[0], y[1]); w.y = pk2(y[2], y[3]); *(u32x2*)(YG + tokoff) = w; } }
}

#define KARGS() (*(const __attribute__((address_space(4))) Args*)__builtin_amdgcn_kernarg_segment_ptr())
#define PHASE_FN __device__ __forceinline__ void
#define PH_PRE() KArgs a = KARGS(); LAS unsigned char* lds = (LAS unsigned char*)lds_raw; unsigned char* ws = a.ws; asm volatile("" : "+s"(ws)); const int G = gridDim.x, bx = blockIdx.x; (void)lds; (void)ws; (void)G; (void)bx; using namespace pg8
PHASE_FN ph0() { PH_PRE(); phase_prologue(a, lds); }
PHASE_FN ph1a() { PH_PRE(); Gemm g{(const bf16_t*)(ws + A_W4T), (const bf16_t*)(ws + A_H3B), 128, 128, 128}; StaticOrder S; S.init(4096, 8192, G, bx); EpiFilt E{(float*)(ws + A_KTD)}; gemm_phase(lds, g, S, E); }
PHASE_FN ph1b() { PH_PRE(); Gemm g{(const bf16_t*)(ws + A_XB), (const bf16_t*)(ws + WS_WIN_EV) + (size_t)3072 * DM, DM, DM, DM}; StaticOrder S; S.init(NTOK, 3072, G, bx);
                  EpiBf16 E{(bf16_t*)(ws + A_QB), 1024, 1024, (size_t)(A_KB - A_QB) / 2, QSCALE}; gemm_phase(lds, g, S, E); }
PHASE_FN ph1c() { PH_PRE(); Gemm g{(const bf16_t*)(ws + WS_WIN_EV), (const bf16_t*)(ws + A_XB), DM, DM, DM}; StaticOrder S; S.init(3072, NTOK, G, bx);
                  EpiBf16 E{(bf16_t*)(ws + A_UHT), NTOK, 0, 0, 1.f}; gemm_phase(lds, g, S, E); }
PHASE_FN ph2() { PH_PRE(); phase_filter_fft(a, lds); phase_qknorm(a, lds); }
PHASE_FN ph3a() { PH_PRE(); phase_hyena_mixer(a, lds); }
PHASE_FN ph3b() { PH_PRE(); phase_attention(a, lds); }
PHASE_FN ph4() { PH_PRE(); phase_concat(a, lds); }
PHASE_FN ph5() { PH_PRE(); Gemm g{(const bf16_t*)(ws + A_YCAT), (const bf16_t*)(ws + WS_WOUT_EV), DM, DM, DM}; StaticOrder S; S.init(NTOK, DM, G, bx);
                 EpiResF32 E{a.in[0], (float*)(ws + A_R0), DM, DN_ALPHA}; gemm_phase(lds, g, S, E); }
template <int LAYER> PHASE_FN ph_lnr() { PH_PRE(); unsigned* ctl = (unsigned*)(ws + WS_CTL);
    phase_ln_router(a, lds, (const float*)(ws + (LAYER ? A_R1 : A_R0)), a.in[28] + LAYER * DM, a.in[29] + LAYER * DM, (float*)(ws + (LAYER ? A_H1_1 : A_H1_0)), (bf16_t*)(ws + (LAYER ? A_HB_1 : A_HB_0)),
                    ctl + CW_CNT + LAYER * 32 * 64, (int*)(ws + A_ROWL), (float*)(ws + A_GATEW)); }
template <int LAYER> PHASE_FN ph_moe1() { PH_PRE(); LAS int* tab = (LAS int*)(lds + LDS_MISC); moe_table(tab, (const unsigned*)(ws + WS_CTL) + CW_CNT + LAYER * 32 * 64);
    Gemm g{(const bf16_t*)(ws + (LAYER ? A_HB_1 : A_HB_0)), (const bf16_t*)(ws + WS_W1T) + (size_t)LAYER * 32 * 1024 * DM, DM, DM, DM}; MoeOrder<4, true> S{G, bx, tab, (const int*)(ws + A_ROWL)};
    EpiSwiglu E{(bf16_t*)(ws + (LAYER ? A_HID_1 : A_HID_0))}; gemm_phase(lds, g, S, E); }
template <int LAYER> PHASE_FN ph_moe2() { PH_PRE(); LAS int* tab = (LAS int*)(lds + LDS_MISC); moe_table(tab, (const unsigned*)(ws + WS_CTL) + CW_CNT + LAYER * 32 * 64);
    Gemm g{(const bf16_t*)(ws + (LAYER ? A_HID_1 : A_HID_0)), (const bf16_t*)(ws + WS_W2T) + (size_t)LAYER * 32 * DM * DFF, DFF, DFF, DFF}; MoeOrder<8, false> S{G, bx, tab, (const int*)(ws + A_ROWL)};
    EpiDown E{(bf16_t*)(ws + (LAYER ? A_Y2_1 : A_Y2_0)), (const int*)(ws + A_ROWL), (const float*)(ws + A_GATEW)}; gemm_phase(lds, g, S, E); }
template <int LAYER> PHASE_FN ph_ln2() { PH_PRE();
    phase_ln2((const float*)(ws + (LAYER ? A_H1_1 : A_H1_0)), (const bf16_t*)(ws + (LAYER ? A_Y2_1 : A_Y2_0)), a.in[30] + LAYER * DM, a.in[31] + LAYER * DM, LAYER ? a.out : (float*)(ws + A_H2), LAYER ? nullptr : (bf16_t*)(ws + A_HB2)); }
PHASE_FN ph10() { PH_PRE(); Gemm g{(const bf16_t*)(ws + A_HB2), (const bf16_t*)(ws + WS_WIN_OD), DM, DM, DM}; StaticOrder S; S.init(NTOK, 2 * DM, G, bx);
                  EpiBf16 E{(bf16_t*)(ws + A_GB), DM, DM, (size_t)(A_XR - A_GB) / 2, 1.f}; gemm_phase(lds, g, S, E); }
PHASE_FN ph11() { PH_PRE(); phase_conv4(a); }
PHASE_FN ph12() { PH_PRE(); Gemm g{(const bf16_t*)(ws + A_XC), (const bf16_t*)(ws + WS_WG_OD), DM, 256, 256}; RGOrder S{G, bx};
                  EpiRG E{(bf16_t*)(ws + A_LA), (bf16_t*)(ws + A_BB), (const bf16_t*)(ws + A_XC), a.in[23], a.in[25], a.in[26]}; gemm_phase(lds, g, S, E); }
PHASE_FN ph13() { PH_PRE(); phase_scan1(a); }
PHASE_FN ph14() { PH_PRE(); phase_scan2(a); }
PHASE_FN ph15() { PH_PRE(); phase_scan3(a); }
PHASE_FN ph16() { PH_PRE(); Gemm g{(const bf16_t*)(ws + A_YG), (const bf16_t*)(ws + WS_WOUT_OD), DM, DM, DM}; StaticOrder S; S.init(NTOK, DM, G, bx);
                  EpiResF32 E{(const float*)(ws + A_H2), (float*)(ws + A_R1), DM, DN_ALPHA}; gemm_phase(lds, g, S, E); }

__global__ void __launch_bounds__(512, 2) fwd(Args a) {
    LAS unsigned char* lds = (LAS unsigned char*)lds_raw;
    unsigned* ctl = (unsigned*)(a.ws + WS_CTL);
    volatile LAS unsigned* bst = (volatile LAS unsigned*)(lds + LDS_MISC + 2048);
    { const int tid = threadIdx.x;
      if ((tid & 63) == 0) ((LAS int*)(lds + LDS_WIDTAB))[hw_slot()] = tid >> 6;
      if (tid < 4) bst[tid] = 0u; }
    __syncthreads();
    const int lo = a.ph_lo, hi = a.ph_hi;
    XcdBarrier bar; bar.bar = ctl + CW_BAR; bar.x = 0; bar.st = bst;
    if (hi - lo > 1) bar = xcd_barrier_post(ctl + CW_BAR, bst);
#ifdef ONLY_PHASE
#define IN(k) ((k) == ONLY_PHASE && lo <= (k) && (k) < hi)
#else
#define IN(k) (lo <= (k) && (k) < hi)
#endif
#define SEAM(k) do { if (IN(k) && IN((k) + 1)) xcd_barrier(bar); } while (0)
    if (IN(0)) { asm volatile("; PHASE_MARK 0"); ph0(); } SEAM(0);
    if (IN(1)) { asm volatile("; PHASE_MARK 1a"); ph1a(); asm volatile("; PHASE_MARK 1b"); ph1b(); asm volatile("; PHASE_MARK 1c"); ph1c(); } SEAM(1);
    if (IN(2)) { asm volatile("; PHASE_MARK 2"); ph2(); } SEAM(2);
    if (IN(3)) { asm volatile("; PHASE_MARK 3a"); ph3a(); asm volatile("; PHASE_MARK 3b"); ph3b(); } SEAM(3);
    if (IN(4)) { asm volatile("; PHASE_MARK 4"); ph4(); } SEAM(4);
    if (IN(5)) { asm volatile("; PHASE_MARK 5"); ph5(); } SEAM(5);
    if (IN(6)) { asm volatile("; PHASE_MARK 6"); ph_lnr<0>(); } SEAM(6);
    if (IN(7)) { asm volatile("; PHASE_MARK 7"); ph_moe1<0>(); } SEAM(7);
    if (IN(8)) { asm volatile("; PHASE_MARK 8"); ph_moe2<0>(); } SEAM(8);
    if (IN(9)) { asm volatile("; PHASE_MARK 9"); ph_ln2<0>(); } SEAM(9);
    if (IN(10)) { asm volatile("; PHASE_MARK 10"); ph10(); } SEAM(10);
    if (IN(11)) { asm volatile("; PHASE_MARK 11"); ph11(); } SEAM(11);
    if (IN(12)) { asm volatile("; PHASE_MARK 12"); ph12(); } SEAM(12);
    if (IN(13)) { asm volatile("; PHASE_MARK 13"); ph13(); } SEAM(13);
    if (IN(14)) { asm volatile("; PHASE_MARK 14"); ph14(); } SEAM(14);
    if (IN(15)) { asm volatile("; PHASE_MARK 15"); ph15(); } SEAM(15);
    if (IN(16)) { asm volatile("; PHASE_MARK 16"); ph16(); } SEAM(16);
    if (IN(17)) { asm volatile("; PHASE_MARK 17"); ph_lnr<1>(); } SEAM(17);
    if (IN(18)) { asm volatile("; PHASE_MARK 18"); ph_moe1<1>(); } SEAM(18);
    if (IN(19)) { asm volatile("; PHASE_MARK 19"); ph_moe2<1>(); } SEAM(19);
    if (IN(20)) { asm volatile("; PHASE_MARK 20"); ph_ln2<1>(); }
#undef IN
#undef SEAM
}

#ifndef MK_PER_PHASE
#define MK_PER_PHASE 0
#endif
extern "C" void kernel_launch(void* const* d_in, const int* in_sizes, int n_in, void* d_out, int out_size, void* d_ws, size_t ws_size, hipStream_t stream) {
    static int grid = 0;
    if (grid == 0) {
        if (n_in != 37 || out_size != NTOK * DM || ws_size < WS_END) { fprintf(stderr, "kernel_launch: built for 37 inputs, %d outputs, >= %zu bytes of workspace; got n_in %d out %d ws %zu\n", NTOK * DM, (size_t)WS_END, n_in, out_size, ws_size); grid = -1; return; }
        int dev = 0, cus = 0, per_cu = 0;
        if (hipGetDevice(&dev) != hipSuccess || hipDeviceGetAttribute(&cus, hipDeviceAttributeMultiprocessorCount, dev) != hipSuccess) { grid = -1; return; }
        if (hipFuncSetAttribute((const void*)fwd, hipFuncAttributeMaxDynamicSharedMemorySize, LDS_BYTES) != hipSuccess) { fprintf(stderr, "kernel_launch: hipFuncSetAttribute failed\n"); grid = -1; return; }
        if (hipOccupancyMaxActiveBlocksPerMultiprocessor(&per_cu, (const void*)fwd, 512, LDS_BYTES) != hipSuccess || per_cu < 1) fprintf(stderr, "kernel_launch: occupancy query reports %d\n", per_cu);
        (void)hipGetLastError();
        grid = cus;
    }
    if (grid < 0) return;
    (void)hipMemsetAsync((char*)d_ws + WS_CTL, 0, CTL_ZERO_BYTES, stream);
    Args a{};
    for (int i = 0; i < 37; ++i) a.in[i] = (const float*)d_in[i];
    a.out = (float*)d_out; a.ws = (unsigned char*)d_ws;
#if MK_PER_PHASE
    for (int p = 0; p < NPHASE; ++p) { a.ph_lo = p; a.ph_hi = p + 1; hipLaunchKernelGGL(fwd, dim3(grid), dim3(512), LDS_BYTES, stream, a); }
#else
    a.ph_lo = 0; a.ph_hi = NPHASE; hipLaunchKernelGGL(fwd, dim3(grid), dim3(512), LDS_BYTES, stream, a);
#endif
}
```

```cpp
#include <hip/hip_runtime.h>
#include <hip/hip_fp16.h>
#include <cstdio>
#include <cstdint>

#define GAS __attribute__((address_space(1)))
#define LAS __attribute__((address_space(3)))
typedef unsigned short bf16_t;
typedef short bf16x8 __attribute__((ext_vector_type(8)));
typedef short s16x4 __attribute__((ext_vector_type(4)));
typedef float f32x2 __attribute__((ext_vector_type(2)));
typedef float f32x4 __attribute__((ext_vector_type(4)));
typedef float f32x8 __attribute__((ext_vector_type(8)));
typedef float f32x16 __attribute__((ext_vector_type(16)));
typedef unsigned u32x2 __attribute__((ext_vector_type(2)));
typedef unsigned u32x4 __attribute__((ext_vector_type(4)));
typedef GAS unsigned gu32;

constexpr int DM = 2048, BATCH = 2, SEQ = 8192, NTOK = BATCH * SEQ;
constexpr int HY_CH = 1024, EV_IN = 6144;
constexpr int NEXP = 32, DFF = 512, NASSIGN = NTOK * 2, ECAP = NASSIGN;
constexpr float LN_EPS = 1e-5f;
constexpr float DN_ALPHA = 1.4142135623730951f;
constexpr float QSCALE = 0.125f * 1.4426950408889634f;
constexpr int FFT_N = 16384, FFT_RS = 528;

__device__ __forceinline__ unsigned f2bf(float f) { unsigned u = __builtin_bit_cast(unsigned, f); return (u + 0x7fffu + ((u >> 16) & 1u)) >> 16; }
__device__ __forceinline__ unsigned pk2(float lo, float hi) { return f2bf(lo) | (f2bf(hi) << 16); }
__device__ __forceinline__ float bf2f(unsigned short h) { return __builtin_bit_cast(float, (unsigned)h << 16); }
__device__ __forceinline__ float bflo(unsigned w) { return __builtin_bit_cast(float, w << 16); }
__device__ __forceinline__ float bfhi(unsigned w) { return __builtin_bit_cast(float, w & 0xffff0000u); }
__device__ __forceinline__ unsigned cvt_pk_bf16(float lo, float hi) { unsigned r; asm volatile("v_cvt_pk_bf16_f32 %0, %1, %2" : "=v"(r) : "v"(lo), "v"(hi)); return r; }
__device__ __forceinline__ float wave_sum(float v) {
#pragma unroll
    for (int o = 1; o < 64; o <<= 1) v += __shfl_xor(v, o);
    return v;
}
__device__ __forceinline__ float sigmoidf_(float x) { return __builtin_amdgcn_rcpf(1.0f + __builtin_amdgcn_exp2f(-1.4426950408889634f * x)); }
constexpr int LDS_WIDTAB = 139264 + 3072;
__device__ __forceinline__ int hw_slot() { return (int)(__builtin_amdgcn_s_getreg((5 << 11) | 4) & 63u); }
__device__ __forceinline__ int lane_id() { return (int)__builtin_amdgcn_mbcnt_hi(~0u, __builtin_amdgcn_mbcnt_lo(~0u, 0u)); }
extern __shared__ __attribute__((aligned(16))) unsigned char lds_raw[];
__device__ __forceinline__ int wave_id() { return __builtin_amdgcn_readfirstlane(((const LAS int*)((LAS unsigned char*)lds_raw + LDS_WIDTAB))[hw_slot()]); }
__device__ __forceinline__ int opaque_tid() { int t = wave_id() * 64 + lane_id(); asm volatile("" : "+v"(t)); return t; }
#define LDS_WAIT() asm volatile("s_waitcnt lgkmcnt(0)" ::: "memory")
#define VM_WAIT() asm volatile("s_waitcnt vmcnt(0)" ::: "memory")

#define XB_TMO      128
#define XB_XCNT(j)  (256  + 64 * (j))
#define XB_XSUB(j)  (1280 + 64 * (j))
#define XB_XGEN(j)  (2304 + 64 * (j))
#define XB_TOP      3328
#define XB_TOPGEN   3392
#define XCD_BAR_WORDS 3456
#define XB_SPIN_CAP (1u << 18)
__device__ __forceinline__ unsigned xb_ld(unsigned* p)              { return __hip_atomic_load(p, __ATOMIC_RELAXED, __HIP_MEMORY_SCOPE_AGENT); }
__device__ __forceinline__ unsigned xb_add(unsigned* p, unsigned v) { return __hip_atomic_fetch_add(p, v, __ATOMIC_RELAXED, __HIP_MEMORY_SCOPE_AGENT); }
__device__ __forceinline__ unsigned xb_xcc_id() { return (unsigned)__builtin_amdgcn_s_getreg((3 << 11) | 20) & 0xFu; }
#define XB_SPIN(cond, bar) do { unsigned _sp = 0; while (cond) { __builtin_amdgcn_s_sleep(1); \
    if ((++_sp & 255u) == 0u) { if (xb_ld(&(bar)[XB_TMO])) break; if (_sp > XB_SPIN_CAP) { atomicAdd(&(bar)[XB_TMO], 1u); break; } } } } while (0)
struct XcdBarrier { unsigned* bar; unsigned x; volatile LAS unsigned* st; };
__device__ __forceinline__ XcdBarrier xcd_barrier_post(unsigned* bar, volatile LAS unsigned* st) {
    XcdBarrier b; b.bar = bar; b.x = xb_xcc_id(); b.st = st;
    if (opaque_tid() == 0) (void)xb_add(&bar[XB_XCNT(b.x)], 1u);
    return b;
}
__device__ __forceinline__ void xcd_barrier_complete(unsigned* bar, unsigned x, unsigned& nloc, unsigned& nx) {
    const unsigned G = gridDim.x * gridDim.y * gridDim.z;
    unsigned sum, cnt, mine, sp = 0u;
    for (;;) {
        sum = 0u; cnt = 0u; mine = 0u;
#pragma unroll
        for (unsigned j = 0; j < 16; ++j) { const unsigned c = xb_ld(&bar[XB_XCNT(j)]); sum += c; cnt += (c > 0u) ? 1u : 0u; mine = (j == x) ? c : mine; }
        if (sum == G) break;
        __builtin_amdgcn_s_sleep(1);
        if ((++sp & 255u) == 0u) { if (xb_ld(&bar[XB_TMO])) break; if (sp > XB_SPIN_CAP) { atomicAdd(&bar[XB_TMO], 1u); break; } }
    }
    nloc = mine > 0u ? mine : 1u; nx = cnt > 0u ? cnt : 1u;
}
__device__ __forceinline__ void xcd_barrier(const XcdBarrier& b) {
    asm volatile("s_waitcnt vmcnt(0)" ::: "memory");
    __syncthreads();
    if (opaque_tid() == 0) {
        unsigned* bar = b.bar;
        __builtin_amdgcn_s_waitcnt(0);
        unsigned nloc = b.st[0], nx = b.st[1];
        if (nloc == 0u) { xcd_barrier_complete(bar, b.x, nloc, nx); b.st[0] = nloc; b.st[1] = nx; }
        const unsigned old = xb_add(&bar[XB_XSUB(b.x)], 1u);
        const unsigned gen = old / nloc;
        if (old + 1u == (gen + 1u) * nloc) {
            __builtin_amdgcn_fence(__ATOMIC_RELEASE, "agent");
            asm volatile("s_waitcnt vmcnt(0)" ::: "memory");
            const unsigned og = xb_add(&bar[XB_TOP], 1u);
            const unsigned tg = og / nx;
            if (og + 1u == (tg + 1u) * nx) xb_add(&bar[XB_TOPGEN], 1u);
            else XB_SPIN(xb_ld(&bar[XB_TOPGEN]) == tg, bar);
            __builtin_amdgcn_fence(__ATOMIC_ACQUIRE, "agent");
            xb_add(&bar[XB_XGEN(b.x)], 1u);
            asm volatile("s_waitcnt vmcnt(0)" ::: "memory");
        } else {
            XB_SPIN(xb_ld(&bar[XB_XGEN(b.x)]) == gen, bar);
            __builtin_amdgcn_fence(__ATOMIC_ACQUIRE, "agent");
            asm volatile("s_waitcnt vmcnt(0)" ::: "memory");
        }
    }
    __syncthreads();
}

namespace pg8 {
constexpr int BM = 256, BK = 64, HALF = 128, HTB = HALF * BK * 2, STAGE_BYTES = 8 * HTB, NXCD = 8, WGM = 8;
__host__ __device__ __forceinline__ int lds_byte(int r, int c) { const int st = (r >> 4) * 2 + (c >> 5), rr = r & 15, cc = c & 31, ob = rr * 64 + cc * 2; return st * 1024 + (ob ^ (((ob >> 9) & 1) << 5)); }
__host__ __device__ __forceinline__ void stage_rc(int b, int& R, int& C) { const int st = b / 1024, sb = b % 1024, swz = sb ^ (((sb >> 9) & 1) << 5); R = (st >> 1) * 16 + swz / 64; C = (st & 1) * 32 + (swz % 64) / 2; }
__host__ __device__ __forceinline__ int perm32(int rho) { const int n = rho >> 4, i = rho & 15; return 8 * (i >> 2) + 4 * n + (i & 3); }

struct Unit { int pm, pn, e, t, cnt; };
struct Gemm { const bf16_t* A; const bf16_t* Bt; int lda, ldb, K; };

struct StaticOrder {
    static constexpr bool GATHER_A = false;
    int nM, nN, nwg, G, c;
    __device__ void init(int M, int N, int G_, int c_) { nM = M / BM; nN = N / BM; nwg = nM * nN; G = G_; c = c_; }
    __device__ __forceinline__ bool next(int i, Unit& u) const {
        const long L = (long)i * G + c; if (L >= nwg) return false;
        int wgid = (int)L; { const int q = nwg / NXCD, r = nwg % NXCD, xcd = wgid % NXCD, off = wgid / NXCD; wgid = (xcd < r ? xcd * (q + 1) : r * (q + 1) + (xcd - r) * q) + off; }
        const int nig = WGM * nN, gid = wgid / nig, fm = gid * WGM, gsz = (nM - fm) < WGM ? (nM - fm) : WGM;
        u.pm = fm + ((wgid % nig) % gsz); u.pn = (wgid % nig) / gsz; u.e = 0; u.t = 0; u.cnt = 0; return true;
    }
    __device__ __forceinline__ int rowA(const Unit& u, int r) const { return u.pm * BM + r; }
    __device__ __forceinline__ int colA(const Unit&) const { return 0; }
    __device__ __forceinline__ int rowB(const Unit& u, int r) const { return u.pn * BM + r; }
};

template <class Epi, class Sched>
__device__ __forceinline__ void gemm_phase(LAS unsigned char* lds, const Gemm g, const Sched& S, const Epi& E) {
    const int tid = opaque_tid(), wid = __builtin_amdgcn_readfirstlane(tid >> 6), lane = tid & 63, wr = wid >> 2, wc = wid & 3, fr = lane & 15, fq = lane >> 4;
    const int K = g.K, nt = K / BK;
    constexpr bool GA = Sched::GATHER_A;
    int sR[2], sC[2];
    unsigned laneA[2], laneB[2];
#pragma unroll
    for (int i = 0; i < 2; ++i) { int R, C; stage_rc(tid * 16 + i * 8192, R, C); sR[i] = R; sC[i] = C; const int Rb = Epi::PERM ? ((R & ~31) + perm32(R & 31)) : R;
        laneA[i] = (unsigned)(R * g.lda + C) * 2u; laneB[i] = (unsigned)(Rb * g.ldb + C) * 2u; }
    const size_t hstepA = (size_t)HALF * g.lda * 2, hstepB = (size_t)HALF * g.ldb * 2;
    const unsigned ldsw = (unsigned)wid * 1024u;
    const int aoff = lds_byte(wr * 64 + fr, fq * 8), boff = lds_byte(wc * 32 + fr, fq * 8);
    const char* gA = (const char*)g.A; const char* gB = (const char*)g.Bt;
#define PG8_SA(b, h) (((b) * 2 + (h)) * HTB)
#define PG8_SB(b, h) ((4 + (b) * 2 + (h)) * HTB)
#define PG8_STAGE(bufoff, gptr, voff) do { _Pragma("unroll") for (int _i = 0; _i < 2; ++_i) \
        __builtin_amdgcn_global_load_lds((const unsigned*)((gptr) + (size_t)(voff)[_i]), (LAS unsigned*)(lds + (bufoff) + ldsw + _i * 8192), 16, 0, 0); } while (0)
#define PG8_STAGE_B(bufoff, ub, h, kb) PG8_STAGE(bufoff, gB + (ub) + (size_t)(h) * hstepB + (size_t)(kb), laneB)
#define PG8_STAGE_A(bufoff, ub, va, h, kb) do { if constexpr (GA) { PG8_STAGE(bufoff, gA + (size_t)(kb), va[h]); } else { PG8_STAGE(bufoff, gA + (ub) + (size_t)(h) * hstepA + (size_t)(kb), laneA); } } while (0)
#define PG8_LDA(dst, b, h) do { _Pragma("unroll") for (int m = 0; m < 4; ++m) _Pragma("unroll") for (int k = 0; k < 2; ++k) dst[m][k] = *(const LAS bf16x8*)(lds + PG8_SA(b, h) + aoff + m * 2048 + k * 1024); } while (0)
#define PG8_LDB(dst, b, h) do { _Pragma("unroll") for (int n = 0; n < 2; ++n) _Pragma("unroll") for (int k = 0; k < 2; ++k) dst[n][k] = *(const LAS bf16x8*)(lds + PG8_SB(b, h) + boff + n * 2048 + k * 1024); } while (0)
#define PG8_MMA(ai, bj, At, Bt) do { __builtin_amdgcn_s_setprio(1); _Pragma("unroll") for (int m = 0; m < 4; ++m) _Pragma("unroll") for (int n = 0; n < 2; ++n) _Pragma("unroll") for (int k = 0; k < 2; ++k) \
        acc[ai][bj][m][n] = __builtin_amdgcn_mfma_f32_16x16x32_bf16(Bt[n][k], At[m][k], acc[ai][bj][m][n], 0, 0, 0); __builtin_amdgcn_s_setprio(0); } while (0)
#define PG8_WAIT_V(n) asm volatile("s_waitcnt vmcnt(" #n ")" ::: "memory")
#define PG8_WAIT_L(n) asm volatile("s_waitcnt lgkmcnt(" #n ")" ::: "memory")
#define PG8_BAR __builtin_amdgcn_s_barrier()
#define PG8_SCHED __builtin_amdgcn_sched_barrier(0)
#define PG8_OFFS(u, ubA, ubB, vA) do { ubB = ((size_t)S.rowB(u, 0) * (size_t)g.ldb) * 2; \
        if constexpr (GA) { ubA = 0; _Pragma("unroll") for (int _h = 0; _h < 2; ++_h) _Pragma("unroll") for (int _i = 0; _i < 2; ++_i) vA[_h][_i] = ((unsigned)S.rowA(u, _h * HALF + sR[_i]) * (unsigned)g.lda + (unsigned)sC[_i]) * 2u; } \
        else { ubA = ((size_t)S.rowA(u, 0) * (size_t)g.lda + (size_t)S.colA(u)) * 2; } } while (0)
    Unit cur, nxt; int ui = 0;
    if (!S.next(0, cur)) return;
    f32x4 acc[2][2][4][2];
#pragma unroll
    for (int a = 0; a < 2; ++a)
#pragma unroll
        for (int b = 0; b < 2; ++b)
#pragma unroll
            for (int m = 0; m < 4; ++m)
#pragma unroll
                for (int n = 0; n < 2; ++n) acc[a][b][m][n] = (f32x4){0.f, 0.f, 0.f, 0.f};
    bf16x8 At[4][2], B0[2][2], B1[2][2];
    size_t ubAc, ubBc, ubAn, ubBn; unsigned vAc[2][2] = {}, vAn[2][2] = {};
    PG8_OFFS(cur, ubAc, ubBc, vAc);
    PG8_STAGE_B(PG8_SB(0, 0), ubBc, 0, 0); PG8_STAGE_B(PG8_SB(0, 1), ubBc, 1, 0); PG8_STAGE_A(PG8_SA(0, 0), ubAc, vAc, 0, 0); PG8_STAGE_A(PG8_SA(0, 1), ubAc, vAc, 1, 0);
    if (wr == 1) PG8_BAR;
    PG8_WAIT_V(2); PG8_BAR;
    PG8_STAGE_B(PG8_SB(1, 0), ubBc, 0, 128); PG8_STAGE_A(PG8_SA(1, 0), ubAc, vAc, 0, 128); PG8_STAGE_B(PG8_SB(1, 1), ubBc, 1, 128);
    PG8_WAIT_V(6); PG8_BAR;
    for (;;) {
        const bool has_next = S.next(ui + 1, nxt);
        if (has_next) { PG8_OFFS(nxt, ubAn, ubBn, vAn); }
        else { ubAn = ubAc; ubBn = ubBc;
#pragma unroll
            for (int h = 0; h < 2; ++h)
#pragma unroll
                for (int i = 0; i < 2; ++i) vAn[h][i] = vAc[h][i]; }
        for (int t = 0; t < nt; t += 2) {
            const bool last = (t == nt - 2);
            const unsigned k1 = (unsigned)(t + 1) * 128u, k2 = last ? 0u : (unsigned)(t + 2) * 128u, k3 = k2 + 128u;
            const size_t xubA = last ? ubAn : ubAc, xubB = last ? ubBn : ubBc;
            unsigned xA[2][2];
#pragma unroll
            for (int h = 0; h < 2; ++h)
#pragma unroll
                for (int i = 0; i < 2; ++i) xA[h][i] = last ? vAn[h][i] : vAc[h][i];
            PG8_LDB(B0, 0, 0); PG8_LDB(B1, 0, 1); PG8_SCHED; PG8_LDA(At, 0, 0); PG8_STAGE_A(PG8_SA(1, 1), ubAc, vAc, 1, k1);
            PG8_WAIT_V(8); PG8_WAIT_L(0); PG8_BAR; PG8_MMA(0, 0, At, B0); PG8_MMA(0, 1, At, B1); PG8_BAR; PG8_SCHED;
            PG8_LDA(At, 0, 1); PG8_STAGE_B(PG8_SB(0, 0), xubB, 0, k2); PG8_STAGE_B(PG8_SB(0, 1), xubB, 1, k2); PG8_STAGE_A(PG8_SA(0, 0), xubA, xA, 0, k2);
            PG8_WAIT_V(8); PG8_WAIT_L(0); PG8_BAR; PG8_MMA(1, 0, At, B0); PG8_MMA(1, 1, At, B1); PG8_BAR; PG8_SCHED;
            PG8_LDB(B0, 1, 0); PG8_LDB(B1, 1, 1); PG8_SCHED; PG8_LDA(At, 1, 0); PG8_STAGE_A(PG8_SA(0, 1), xubA, xA, 1, k2);
            PG8_WAIT_V(8); PG8_WAIT_L(0); PG8_BAR; PG8_MMA(0, 0, At, B0); PG8_MMA(0, 1, At, B1); PG8_BAR; PG8_SCHED;
            PG8_LDA(At, 1, 1); PG8_STAGE_B(PG8_SB(1, 0), xubB, 0, k3); PG8_STAGE_B(PG8_SB(1, 1), xubB, 1, k3); PG8_STAGE_A(PG8_SA(1, 0), xubA, xA, 0, k3);
            PG8_WAIT_V(8); PG8_WAIT_L(0); PG8_BAR; PG8_MMA(1, 0, At, B0); PG8_MMA(1, 1, At, B1); PG8_BAR; PG8_SCHED;
        }
        if (wr == 0) PG8_BAR;
        E(acc, cur, wr, wc, fr, fq);
        if (!has_next) break;
#pragma unroll
        for (int a = 0; a < 2; ++a)
#pragma unroll
            for (int b = 0; b < 2; ++b)
#pragma unroll
                for (int m = 0; m < 4; ++m)
#pragma unroll
                    for (int n = 0; n < 2; ++n) acc[a][b][m][n] = (f32x4){0.f, 0.f, 0.f, 0.f};
        cur = nxt; ++ui; ubAc = ubAn; ubBc = ubBn;
#pragma unroll
        for (int h = 0; h < 2; ++h)
#pragma unroll
            for (int i = 0; i < 2; ++i) vAc[h][i] = vAn[h][i];
        if (wr == 1) PG8_BAR;
    }
    PG8_WAIT_V(0);
    PG8_BAR;
#undef PG8_SA
#undef PG8_SB
#undef PG8_STAGE
#undef PG8_STAGE_A
#undef PG8_STAGE_B
#undef PG8_LDA
#undef PG8_LDB
#undef PG8_MMA
#undef PG8_WAIT_V
#undef PG8_WAIT_L
#undef PG8_BAR
#undef PG8_SCHED
#undef PG8_OFFS
}
}
namespace pg8 {
struct EpiBf16 {
    static constexpr bool PERM = true;
    bf16_t* O; int ldc; int split_cols; size_t split_stride; float scale0;
    __device__ __forceinline__ void operator()(const f32x4 (&acc)[2][2][4][2], const Unit& u, int wr, int wc, int fr, int fq) const {
        const int row0 = u.pm * BM + wr * 64 + fr; int colt = u.pn * BM; bf16_t* base = O;
        float sc = 1.f; if (split_cols) { const int t = colt / split_cols; base += (size_t)t * split_stride; colt -= t * split_cols; if (t == 0) sc = scale0; }
        const int col0 = colt + wc * 32 + 8 * fq;
#pragma unroll
        for (int ai = 0; ai < 2; ++ai)
#pragma unroll
            for (int m = 0; m < 4; ++m) { bf16_t* rowp = base + (size_t)(row0 + ai * HALF + m * 16) * ldc + col0;
#pragma unroll
                for (int bj = 0; bj < 2; ++bj) { const f32x4 v0 = acc[ai][bj][m][0] * sc, v1 = acc[ai][bj][m][1] * sc;
                    u32x4 w; w.x = cvt_pk_bf16(v0[0], v0[1]); w.y = cvt_pk_bf16(v0[2], v0[3]); w.z = cvt_pk_bf16(v1[0], v1[1]); w.w = cvt_pk_bf16(v1[2], v1[3]);
                    *(u32x4*)(rowp + bj * HALF) = w; } }
    }
};
struct EpiFilt {
    static constexpr bool PERM = false;
    float* O;
    __device__ __forceinline__ void operator()(const f32x4 (&acc)[2][2][4][2], const Unit& u, int wr, int wc, int fr, int fq) const {
        const float dmin = -3.0701134573253945f, dmax = -15.350567286626973f;
#pragma unroll
        for (int ai = 0; ai < 2; ++ai)
#pragma unroll
            for (int m = 0; m < 4; ++m) { const int row = u.pm * BM + ai * HALF + wr * 64 + m * 16 + fr; const int c = row & 1023;
                const float delta = fabsf(dmin + (float)c * ((dmax - dmin) / 1023.0f));
#pragma unroll
                for (int bj = 0; bj < 2; ++bj)
#pragma unroll
                    for (int n = 0; n < 2; ++n) { const int col = u.pn * BM + bj * HALF + wc * 32 + n * 16 + 4 * fq; f32x4 v = acc[ai][bj][m][n];
#pragma unroll
                        for (int j = 0; j < 4; ++j) v[j] *= __expf(-(float)(col + j) * (1.0f / 8191.0f) * delta);
                        *(f32x4*)(O + (size_t)row * 8192 + col) = v; }
                asm volatile("" ::: "memory"); }
    }
};
struct EpiResF32 {
    static constexpr bool PERM = false;
    const float* res; float* O; int ldc; float alpha;
    __device__ __forceinline__ void operator()(const f32x4 (&acc)[2][2][4][2], const Unit& u, int wr, int wc, int fr, int fq) const {
#pragma unroll
        for (int ai = 0; ai < 2; ++ai)
#pragma unroll
            for (int m = 0; m < 4; ++m) { const size_t off = (size_t)(u.pm * BM + ai * HALF + wr * 64 + m * 16 + fr) * ldc + u.pn * BM + wc * 32 + 4 * fq;
#pragma unroll
                for (int bj = 0; bj < 2; ++bj)
#pragma unroll
                    for (int n = 0; n < 2; ++n) { const f32x4 r = *(const f32x4*)(res + off + bj * HALF + n * 16); *(f32x4*)(O + off + bj * HALF + n * 16) = r * alpha + acc[ai][bj][m][n]; }
                if (m & 1) asm volatile("" ::: "memory"); }
    }
};
struct EpiResBf {
    static constexpr bool PERM = false;
    const bf16_t* res; float* O; int ldc; float alpha;
    __device__ __forceinline__ void operator()(const f32x4 (&acc)[2][2][4][2], const Unit& u, int wr, int wc, int fr, int fq) const {
#pragma unroll
        for (int ai = 0; ai < 2; ++ai)
#pragma unroll
            for (int m = 0; m < 4; ++m) { const size_t off = (size_t)(u.pm * BM + ai * HALF + wr * 64 + m * 16 + fr) * ldc + u.pn * BM + wc * 32 + 4 * fq;
#pragma unroll
                for (int bj = 0; bj < 2; ++bj)
#pragma unroll
                    for (int n = 0; n < 2; ++n) { const u32x2 r = *(const u32x2*)(res + off + bj * HALF + n * 16);
                        *(f32x4*)(O + off + bj * HALF + n * 16) = (f32x4){bflo(r.x), bfhi(r.x), bflo(r.y), bfhi(r.y)} * alpha + acc[ai][bj][m][n]; }
                if (m & 1) asm volatile("" ::: "memory"); }
    }
};
struct EpiSwiglu {
    static constexpr bool PERM = true;
    bf16_t* O;
    __device__ __forceinline__ void operator()(const f32x4 (&acc)[2][2][4][2], const Unit& u, int wr, int wc, int fr, int fq) const {
#pragma unroll
        for (int ai = 0; ai < 2; ++ai)
#pragma unroll
            for (int m = 0; m < 4; ++m) { bf16_t* p = O + (size_t)(u.pm * BM + ai * HALF + wr * 64 + m * 16 + fr) * DFF + u.pn * HALF + wc * 32 + 8 * fq;
                float h[8];
#pragma unroll
                for (int n = 0; n < 2; ++n)
#pragma unroll
                    for (int j = 0; j < 4; ++j) { const float gt = acc[ai][0][m][n][j], up = acc[ai][1][m][n][j]; h[n * 4 + j] = gt * sigmoidf_(gt) * up; }
                u32x4 w; w.x = cvt_pk_bf16(h[0], h[1]); w.y = cvt_pk_bf16(h[2], h[3]); w.z = cvt_pk_bf16(h[4], h[5]); w.w = cvt_pk_bf16(h[6], h[7]);
                *(u32x4*)p = w; }
    }
};
struct EpiDown {
    static constexpr bool PERM = true;
    bf16_t* O; const int* rowlist; const float* gatew;
    __device__ __forceinline__ void operator()(const f32x4 (&acc)[2][2][4][2], const Unit& u, int wr, int wc, int fr, int fq) const {
#pragma unroll
        for (int ai = 0; ai < 2; ++ai)
#pragma unroll
            for (int m = 0; m < 4; ++m) { const int idx = u.t * BM + ai * HALF + wr * 64 + m * 16 + fr;
                if (idx < u.cnt) { const int a = rowlist[(size_t)u.e * ECAP + idx]; const float gw = gatew[a];
                    bf16_t* p = O + (size_t)a * DM + u.pn * BM + wc * 32 + 8 * fq;
#pragma unroll
                    for (int bj = 0; bj < 2; ++bj) { const f32x4 v0 = acc[ai][bj][m][0] * gw, v1 = acc[ai][bj][m][1] * gw;
                        u32x4 w; w.x = cvt_pk_bf16(v0[0], v0[1]); w.y = cvt_pk_bf16(v0[2], v0[3]); w.z = cvt_pk_bf16(v1[0], v1[1]); w.w = cvt_pk_bf16(v1[2], v1[3]);
                        *(u32x4*)(p + bj * HALF) = w; } } }
    }
};
struct EpiRG {
    static constexpr bool PERM = true;
    bf16_t* LA; bf16_t* BB; const bf16_t* XC; const float* ba; const float* bx; const float* lam;
    __device__ __forceinline__ void operator()(const f32x4 (&acc)[2][2][4][2], const Unit& u, int wr, int wc, int fr, int fq) const {
        const int nb = u.pn >> 2, q = u.pn & 3, dir = q >> 1, half = q & 1;
        const int ch0 = nb * 256 + half * HALF + wc * 32 + 8 * fq;
        float vba[8], vbx[8], vsp[8];
#pragma unroll
        for (int j = 0; j < 8; ++j) { vba[j] = ba[dir * DM + ch0 + j]; vbx[j] = bx[dir * DM + ch0 + j];
            const float x = __expf(-lam[dir * DM + ch0 + j]);
            vsp[j] = 8.0f * (x < 0.05f ? x * (1.0f - x * (0.5f - x * (0.33333334f - 0.25f * x))) : __logf(1.0f + x)); }
#pragma unroll
        for (int ai = 0; ai < 2; ++ai)
#pragma unroll
            for (int m = 0; m < 4; ++m) { const size_t tok = (size_t)(u.pm * BM + ai * HALF + wr * 64 + m * 16 + fr);
                asm volatile("" ::: "memory");
                const u32x4 xw = *(const u32x4*)(XC + tok * DM + ch0);
                float xf[8] = {bflo(xw.x), bfhi(xw.x), bflo(xw.y), bfhi(xw.y), bflo(xw.z), bfhi(xw.z), bflo(xw.w), bfhi(xw.w)};
                float la[8], bb[8];
#pragma unroll
                for (int n = 0; n < 2; ++n)
#pragma unroll
                    for (int j = 0; j < 4; ++j) { const int k = n * 4 + j;
                        const float r = sigmoidf_(acc[ai][0][m][n][j] + vba[k]), ig = sigmoidf_(acc[ai][1][m][n][j] + vbx[k]);
                        const float l = -r * vsp[k]; la[k] = l; bb[k] = __builtin_amdgcn_sqrtf(fmaxf(1.0f - __builtin_amdgcn_exp2f(2.8853900817779268f * l), 0.f)) * (ig * xf[k]); }
                u32x4 w; w.x = cvt_pk_bf16(la[0], la[1]); w.y = cvt_pk_bf16(la[2], la[3]); w.z = cvt_pk_bf16(la[4], la[5]); w.w = cvt_pk_bf16(la[6], la[7]);
                *(u32x4*)(LA + ((size_t)dir * NTOK + tok) * DM + ch0) = w;
                w.x = cvt_pk_bf16(bb[0], bb[1]); w.y = cvt_pk_bf16(bb[2], bb[3]); w.z = cvt_pk_bf16(bb[4], bb[5]); w.w = cvt_pk_bf16(bb[6], bb[7]);
                *(u32x4*)(BB + ((size_t)dir * NTOK + tok) * DM + ch0) = w; }
    }
};

struct RGOrder {
    static constexpr bool GATHER_A = false;
    int G, c;
    __device__ __forceinline__ bool next(int i, Unit& u) const {
        if (G == 256) { if (i >= 8) return false; const int x = c & 7, y = c >> 3; u.pm = i * 8 + (y >> 2); u.pn = x * 4 + (y & 3); }
        else { const int L = i * G + c; if (L >= 64 * 32) return false; u.pm = L >> 5; u.pn = L & 31; }
        u.e = 0; u.t = 0; u.cnt = 0; return true; }
    __device__ __forceinline__ int rowA(const Unit& u, int r) const { return u.pm * BM + r; }
    __device__ __forceinline__ int colA(const Unit& u) const { return (u.pn >> 2) * 256; }
    __device__ __forceinline__ int rowB(const Unit& u, int r) const { return u.pn * BM + r; }
};
template <int NPN, bool GATHER>
struct MoeOrder {
    static constexpr bool GATHER_A = GATHER;
    int G, c; const LAS int* tab; const int* rowlist;
    __device__ __forceinline__ bool next(int i, Unit& u) const {
        const int L = i * G + c, ntile = tab[32]; if (L >= ntile * NPN) return false;
        const int tile = L / NPN; u.pm = tile; u.pn = L % NPN; int e = 0;
        while (e < 31 && tab[e + 1] <= tile) ++e;
        u.e = e; u.t = tile - tab[e]; u.cnt = tab[64 + e]; return true;
    }
    __device__ __forceinline__ int rowA(const Unit& u, int r) const {
        if (GATHER) { const int idx = u.t * BM + r; const int a = idx < u.cnt ? rowlist[(size_t)u.e * ECAP + idx] : 0; return a >> 1; }
        return u.pm * BM + r;
    }
    __device__ __forceinline__ int colA(const Unit&) const { return 0; }
    __device__ __forceinline__ int rowB(const Unit& u, int r) const { return (u.e * NPN + u.pn) * BM + r; }
};
}
namespace att {
constexpr int NW = 8, QBLK = 32, KVBLK = 64, LDQ = 1024, LDK = 1024, LDV = 1024, LDO = 1024;
constexpr int SHM_V = KVBLK * 128 * 2, SHM_K = KVBLK * 64 * 2, NSLOT = 3, LDS_K = 0, LDS_V = NSLOT * SHM_K, LDS_WS = NSLOT * (SHM_K + SHM_V), SHM_ATTN = LDS_WS + NW * 64 * 4;
__device__ __forceinline__ void glds16s(const void* sbase, unsigned voff, unsigned lds_dst) { unsigned keep;
    asm volatile("s_mov_b32 %0, m0\n\ts_mov_b32 m0, %3\n\ts_nop 0\n\tglobal_load_lds_dwordx4 %1, %2\n\ts_mov_b32 m0, %0" : "=&s"(keep) : "v"(voff), "s"(sbase), "s"(lds_dst) : "memory"); }
#define WAITBAR(N) asm volatile("s_waitcnt vmcnt(" #N ") lgkmcnt(0)\n\ts_barrier" ::: "memory")
constexpr float THR2 = 8.0f * 1.4426950408889634f;
#define KSWZ64(row, colB) ((row) * 128 + ((colB) ^ ((((row) >> 1) & 7) << 4)))
#define SBAR() __builtin_amdgcn_sched_barrier(0)
__device__ __forceinline__ int crow(int r, int hi) { return (r & 3) + 8 * (r >> 2) + 4 * hi; }
__device__ __forceinline__ void qkt(f32x16& p0, f32x16& p1, const char* Ks, const bf16x8* qr, int r32, int hi, float A, float st) {
    { float b4[4];
#pragma unroll
      for (int j = 0; j < 4; ++j) b4[j] = fmaf(st, (float)j, A);
      const float s8 = 8.0f * st, s32 = 32.0f * st;
#pragma unroll
      for (int r = 0; r < 16; ++r) { p0[r] = (r < 4) ? b4[r] : p0[r - 4] + s8; }
#pragma unroll
      for (int r = 0; r < 16; ++r) p1[r] = p0[r] + s32; }
#pragma unroll
    for (int d0 = 0; d0 < 4; ++d0) { const int cb = (d0 * 16 + hi * 8) * 2;
        const bf16x8 b0 = *reinterpret_cast<const bf16x8*>(Ks + KSWZ64(r32, cb));
        const bf16x8 b1 = *reinterpret_cast<const bf16x8*>(Ks + KSWZ64(32 + r32, cb));
        p0 = __builtin_amdgcn_mfma_f32_32x32x16_bf16(b0, qr[d0], p0, 0, 0, 0);
        p1 = __builtin_amdgcn_mfma_f32_32x32x16_bf16(b1, qr[d0], p1, 0, 0, 0); }
}
__device__ __forceinline__ void partialSM(f32x16& p0, f32x16& p1, bool mixed, float fd, float sl2) {
    if (mixed) {
#pragma unroll
        for (int r = 0; r < 16; ++r) { const float d0 = fd - (float)((r & 3) + 8 * (r >> 2)); p0[r] = fmaf(fabsf(d0), -sl2, p0[r]); p1[r] = fmaf(fabsf(d0 - 32.0f), -sl2, p1[r]); }
    }
#pragma unroll
    for (int r = 0; r < 16; ++r) p0[r] = __builtin_amdgcn_exp2f(p0[r]);
}
__device__ __forceinline__ void finishSM(f32x16& p0, f32x16& p1, float& l_reg, bf16x8& pa0, bf16x8& pa1, bf16x8& pa2, bf16x8& pa3) {
#pragma unroll
    for (int r = 0; r < 16; ++r) p1[r] = __builtin_amdgcn_exp2f(p1[r]);
    float ps = 0;
#pragma unroll
    for (int r = 0; r < 16; ++r) ps += p0[r];
#pragma unroll
    for (int r = 0; r < 16; ++r) ps += p1[r];
    l_reg += ps;
#define PK4(P, BASE, OUT) do { unsigned a0 = cvt_pk_bf16(P[BASE + 0], P[BASE + 1]), a1 = cvt_pk_bf16(P[BASE + 2], P[BASE + 3]);   \
    unsigned b0 = cvt_pk_bf16(P[BASE + 4], P[BASE + 5]), b1 = cvt_pk_bf16(P[BASE + 6], P[BASE + 7]);                              \
    auto r0 = __builtin_amdgcn_permlane32_swap(a0, b0, false, false); auto r1 = __builtin_amdgcn_permlane32_swap(a1, b1, false, false); \
    u32x4 w = {r0[0], r1[0], r0[1], r1[1]}; OUT = __builtin_bit_cast(bf16x8, w); } while (0)
    PK4(p0, 0, pa0); PK4(p0, 8, pa1); PK4(p1, 0, pa2); PK4(p1, 8, pa3);
#undef PK4
}
__device__ __forceinline__ int v_st(int k, int c) { const int kk = (k & ~0xC) | ((k & 4) << 1) | ((k & 8) >> 1); return ((kk >> 3) * 4 + (c >> 5)) * 512 + ((kk & 7) * 32 + (c & 31)) * 2; }
__device__ __forceinline__ int v_rd_base(int lane) { return ((lane & 3) << 3) | (((lane >> 2) & 3) << 6) | (((lane >> 4) & 1) << 5) | (((lane >> 5) & 1) << 8); }
constexpr int v_rd_off(int d0, int ks, int half) { return d0 * 512 + ks * 4096 + half * 2048; }
template <int OFF> __device__ __forceinline__ s16x4 tr_read(int vb) {
    s16x4 r; asm volatile("ds_read_b64_tr_b16 %0, %1 offset:%2" : "=&v"(r) : "v"(vb), "i"(OFF) : "memory"); return r;
}
template <int D0> __device__ __forceinline__ void pv_one(f32x16& od, int vb, bf16x8 pa0, bf16x8 pa1, bf16x8 pa2, bf16x8 pa3) {
    const s16x4 l0 = tr_read<v_rd_off(D0, 0, 0)>(vb), h0 = tr_read<v_rd_off(D0, 0, 1)>(vb), l1 = tr_read<v_rd_off(D0, 1, 0)>(vb), h1 = tr_read<v_rd_off(D0, 1, 1)>(vb);
    const s16x4 l2 = tr_read<v_rd_off(D0, 2, 0)>(vb), h2 = tr_read<v_rd_off(D0, 2, 1)>(vb), l3 = tr_read<v_rd_off(D0, 3, 0)>(vb), h3 = tr_read<v_rd_off(D0, 3, 1)>(vb);
    asm volatile("s_waitcnt lgkmcnt(0)" ::: "memory"); SBAR();
#define PK(L, H) (bf16x8){L[0], L[1], L[2], L[3], H[0], H[1], H[2], H[3]}
    od = __builtin_amdgcn_mfma_f32_32x32x16_bf16(pa0, PK(l0, h0), od, 0, 0, 0);
    od = __builtin_amdgcn_mfma_f32_32x32x16_bf16(pa1, PK(l1, h1), od, 0, 0, 0);
    od = __builtin_amdgcn_mfma_f32_32x32x16_bf16(pa2, PK(l2, h2), od, 0, 0, 0);
    od = __builtin_amdgcn_mfma_f32_32x32x16_bf16(pa3, PK(l3, h3), od, 0, 0, 0);
#undef PK
}
__device__ __forceinline__ void pv_d0(f32x16* o, int vb, bf16x8 pa0, bf16x8 pa1, bf16x8 pa2, bf16x8 pa3) {
    pv_one<0>(o[0], vb, pa0, pa1, pa2, pa3); pv_one<1>(o[1], vb, pa0, pa1, pa2, pa3); pv_one<2>(o[2], vb, pa0, pa1, pa2, pa3); pv_one<3>(o[3], vb, pa0, pa1, pa2, pa3);
}
__device__ __forceinline__ void attn_unit(const bf16_t* __restrict__ Qb, const bf16_t* __restrict__ Kh, const bf16_t* __restrict__ Vh, bf16_t* __restrict__ Ob, int q0, int t_lo, int n, float sl2, char* lds) {
    const int tid = opaque_tid(), wid = __builtin_amdgcn_readfirstlane(tid >> 6), lane = tid & 63, r32 = lane & 31, hi = lane >> 5;
    float* ws = (float*)(lds + LDS_WS) + wid * 64; float* li_l = ws;
    float l_reg = 0; f32x16 o[4] = {}; bf16x8 qr[4];
    const bf16_t* Qw = Qb + (long)(wid * QBLK + r32) * LDQ + hi * 8;
#pragma unroll
    for (int d0 = 0; d0 < 4; ++d0) qr[d0] = *reinterpret_cast<const bf16x8*>(Qw + d0 * 16);
    float negM;
    { const bf16_t* Kw = Kh + (long)(q0 + wid * QBLK + r32) * LDK + hi * 8; float s = 0.f;
#pragma unroll
      for (int d0 = 0; d0 < 4; ++d0) { const u32x4 kw = *reinterpret_cast<const u32x4*>(Kw + d0 * 16); const u32x4 qw = __builtin_bit_cast(u32x4, qr[d0]);
          s += bflo(kw.x) * bflo(qw.x) + bfhi(kw.x) * bfhi(qw.x) + bflo(kw.y) * bflo(qw.y) + bfhi(kw.y) * bfhi(qw.y) + bflo(kw.z) * bflo(qw.z) + bfhi(kw.z) * bfhi(qw.z) + bflo(kw.w) * bflo(qw.w) + bfhi(kw.w) * bfhi(qw.w); }
      auto rr = __builtin_amdgcn_permlane32_swap(__float_as_uint(s), __float_as_uint(s), false, false); negM = -(__uint_as_float(rr[0]) + __uint_as_float(rr[1])); }
    const unsigned lds0 = (unsigned)(uintptr_t)lds;
    const int krow = wid * 8 + (lane >> 3), kch = (lane & 7) ^ ((krow >> 1) & 7);
    const unsigned koff = (unsigned)(krow * LDK * 2 + kch * 16);
    unsigned voff[2];
#pragma unroll
    for (int z = 0; z < 2; ++z) { const int P16 = (wid + 8 * z) * 64 + lane, sub = P16 >> 5, win = P16 & 31, kk = (sub >> 2) * 8 + (win >> 2), k = (kk & ~0xC) | ((kk & 4) << 1) | ((kk & 8) >> 1), c = (sub & 3) * 32 + (win & 3) * 8;
        voff[z] = (unsigned)(k * LDV * 2 + c * 2); }
    const unsigned kdst = lds0 + LDS_K + wid * 1024, vdst = lds0 + LDS_V + wid * 1024;
    const int vb0 = (int)(lds0 + LDS_V) + v_rd_base(lane);
    const char* K_lds = lds + LDS_K;
    const int qw0 = q0 + wid * QBLK;
    const float fq0 = (float)(qw0 + r32 - 4 * hi);
    const char* Kt = (const char*)(Kh + (long)t_lo * KVBLK * LDK); const char* Vt = (const char*)(Vh + (long)t_lo * KVBLK * LDV);
#define DMA(jj, slot) do { const char* kb_ = Kt + (size_t)(jj) * (KVBLK * LDK * 2); const char* vb_ = Vt + (size_t)(jj) * (KVBLK * LDV * 2); \
    glds16s(kb_, koff, (unsigned)__builtin_amdgcn_readfirstlane(kdst + (slot) * SHM_K)); \
    glds16s(vb_, voff[0], (unsigned)__builtin_amdgcn_readfirstlane(vdst + (slot) * SHM_V)); \
    glds16s(vb_, voff[1], (unsigned)__builtin_amdgcn_readfirstlane(vdst + (slot) * SHM_V + 8192)); } while (0)
#define TILE(jj) const int k0_ = (t_lo + (jj)) * KVBLK; const bool left_ = k0_ + 63 < qw0, right_ = k0_ > qw0 + 31, mixed_ = !(left_ || right_); \
    const float fd_ = fq0 - (float)k0_, st_ = left_ ? sl2 : (right_ ? -sl2 : 0.f), A_ = negM - st_ * fd_
    f32x16 pA0, pA1, pB0, pB1; bf16x8 pa0, pa1, pa2, pa3;
    asm volatile("s_waitcnt vmcnt(0)" ::: "memory");
    DMA(0, 0); DMA(1, 1);
    WAITBAR(3);
    { TILE(0); qkt(pA0, pA1, K_lds, qr, r32, hi, A_, st_); partialSM(pA0, pA1, mixed_, fd_, sl2); }
    WAITBAR(0);
    if (2 < n) DMA(2, 2);
    int s_prev = 0, s_cur = 1, s_next = 2;
#define ROT() do { const int t_ = s_prev; s_prev = s_cur; s_cur = s_next; s_next = t_; } while (0)
    for (int j = 1; j + 1 < n; j += 2) {
        { TILE(j); SBAR(); qkt(pB0, pB1, K_lds + s_cur * SHM_K, qr, r32, hi, A_, st_);
          finishSM(pA0, pA1, l_reg, pa0, pa1, pa2, pa3); SBAR();
          pv_d0(o, vb0 + s_prev * SHM_V, pa0, pa1, pa2, pa3); partialSM(pB0, pB1, mixed_, fd_, sl2); }
        WAITBAR(0);
        if (j + 2 < n) DMA(j + 2, s_prev);
        ROT();
        { TILE(j + 1); SBAR(); qkt(pA0, pA1, K_lds + s_cur * SHM_K, qr, r32, hi, A_, st_);
          finishSM(pB0, pB1, l_reg, pa0, pa1, pa2, pa3); SBAR();
          pv_d0(o, vb0 + s_prev * SHM_V, pa0, pa1, pa2, pa3); partialSM(pA0, pA1, mixed_, fd_, sl2); }
        WAITBAR(0);
        if (j + 3 < n) DMA(j + 3, s_prev);
        ROT();
    }
    { TILE(n - 1); SBAR(); qkt(pB0, pB1, K_lds + s_cur * SHM_K, qr, r32, hi, A_, st_);
      finishSM(pA0, pA1, l_reg, pa0, pa1, pa2, pa3); SBAR();
      pv_d0(o, vb0 + s_prev * SHM_V, pa0, pa1, pa2, pa3); partialSM(pB0, pB1, mixed_, fd_, sl2); }
    finishSM(pB0, pB1, l_reg, pa0, pa1, pa2, pa3); SBAR();
    pv_d0(o, vb0 + s_cur * SHM_V, pa0, pa1, pa2, pa3);
    { auto rr = __builtin_amdgcn_permlane32_swap(__float_as_uint(l_reg), __float_as_uint(l_reg), false, false); l_reg = __uint_as_float(rr[0]) + __uint_as_float(rr[1]); }
    if (hi == 0) li_l[r32] = l_reg; asm volatile("s_waitcnt lgkmcnt(0)" ::: "memory");
    float rli[16];
#pragma unroll
    for (int r = 0; r < 16; ++r) rli[r] = __builtin_amdgcn_rcpf(li_l[crow(r, hi)]);
    bf16_t* Ow = Ob + (long)(wid * QBLK) * LDO;
#pragma unroll
    for (int r = 0; r < 16; ++r) { const int orow = crow(r, hi);
#pragma unroll
        for (int d0 = 0; d0 < 4; ++d0) Ow[(long)orow * LDO + d0 * 32 + r32] = (bf16_t)f2bf(o[d0][r] * rli[r]); }
    WAITBAR(0);
#undef DMA
#undef ROT
#undef TILE
}
#undef SBAR
}

namespace hy {
struct cf { float x, y; };
__device__ __forceinline__ cf lld(const LAS f32x2* L, int i) { const f32x2 t = L[i]; return cf{t[0], t[1]}; }
__device__ __forceinline__ void lst(LAS f32x2* L, int i, cf v) { L[i] = (f32x2){v.x, v.y}; }
__device__ __forceinline__ cf cmul(cf a, cf b) { return cf{a.x * b.x - a.y * b.y, a.x * b.y + a.y * b.x}; }
__device__ __forceinline__ cf cmulc(cf a, cf b) { return cf{a.x * b.x + a.y * b.y, a.y * b.x - a.x * b.y}; }
__device__ constexpr float C32[16] = {1.0f, 0.98078528040323043f, 0.92387953251128674f, 0.83146961230254524f, 0.70710678118654757f, 0.55557023301960229f, 0.38268343236508984f, 0.19509032201612833f,
                                      0.0f, -0.19509032201612819f, -0.38268343236508973f, -0.55557023301960196f, -0.70710678118654746f, -0.83146961230254535f, -0.92387953251128674f, -0.98078528040323043f};
__device__ constexpr float S32[16] = {0.0f, 0.19509032201612825f, 0.38268343236508978f, 0.55557023301960218f, 0.70710678118654746f, 0.83146961230254524f, 0.92387953251128674f, 0.98078528040323043f,
                                      1.0f, 0.98078528040323043f, 0.92387953251128674f, 0.83146961230254546f, 0.70710678118654757f, 0.55557023301960218f, 0.38268343236508989f, 0.19509032201612861f};
__host__ __device__ constexpr int brev(int k, int bits) { int r = 0; for (int i = 0; i < bits; ++i) r |= ((k >> i) & 1) << (bits - 1 - i); return r; }
template <int R, bool INV> __device__ __forceinline__ void dft_reg(cf (&v)[R]) {
#pragma unroll
    for (int s = R / 2; s >= 1; s >>= 1) {
#pragma unroll
        for (int g0 = 0; g0 < R; g0 += 2 * s) {
#pragma unroll
            for (int j = 0; j < s; ++j) {
                const cf a = v[g0 + j], b = v[g0 + j + s];
                v[g0 + j] = cf{a.x + b.x, a.y + b.y};
                const cf d = cf{a.x - b.x, a.y - b.y};
                const int tw = j * (16 / s);
                if (tw == 0) v[g0 + j + s] = d;
                else if (tw == 8) v[g0 + j + s] = INV ? cf{-d.y, d.x} : cf{d.y, -d.x};
                else { const float c = C32[tw], sn = S32[tw]; v[g0 + j + s] = INV ? cf{d.x * c - d.y * sn, d.y * c + d.x * sn} : cf{d.x * c + d.y * sn, d.y * c - d.x * sn}; }
            }
        }
    }
}
constexpr int RS = FFT_RS;
__device__ __forceinline__ void fft_fwd12(cf (&v)[32], LAS f32x2* L, int tid) {
    dft_reg<32, false>(v);
    { float s, c; sincospif((float)tid * (1.0f / 8192.0f), &s, &c); cf w1{c, -s}; asm volatile("" : "+v"(w1.x), "+v"(w1.y)); cf w = w1;
#pragma unroll
      for (int k1 = 0; k1 < 32; ++k1) { cf x = v[brev(k1, 5)]; if (k1) { x = cmul(x, w); w = cmul(w, w1); } lst(L, k1 * RS + tid, x); } }
    __syncthreads();
    const int k1 = tid >> 4, m2 = tid & 15;
#pragma unroll
    for (int m1 = 0; m1 < 32; ++m1) v[m1] = lld(L, k1 * RS + 16 * m1 + m2);
    __syncthreads();
    dft_reg<32, false>(v);
    { float s, c; sincospif((float)m2 * (1.0f / 256.0f), &s, &c); cf w1{c, -s}; asm volatile("" : "+v"(w1.x), "+v"(w1.y)); cf w = w1;
#pragma unroll
      for (int j1 = 0; j1 < 32; ++j1) { cf x = v[brev(j1, 5)]; if (j1) { x = cmul(x, w); w = cmul(w, w1); } lst(L, k1 * RS + 33 * m2 + j1, x); } }
    __syncthreads();
}
__device__ __forceinline__ void fft_inv21(cf (&v)[32], LAS f32x2* L, int tid) {
    const int k1 = tid >> 4, m2 = tid & 15;
    { float s, c; sincospif((float)m2 * (1.0f / 256.0f), &s, &c); cf w1{c, -s}; asm volatile("" : "+v"(w1.x), "+v"(w1.y)); cf w = w1;
#pragma unroll
      for (int j1 = 0; j1 < 32; ++j1) { cf x = lld(L, k1 * RS + 33 * m2 + j1); if (j1) { x = cmulc(x, w); w = cmul(w, w1); } v[j1] = x; } }
    __syncthreads();
    dft_reg<32, true>(v);
#pragma unroll
    for (int m1 = 0; m1 < 32; ++m1) lst(L, k1 * RS + 16 * m1 + m2, v[brev(m1, 5)]);
    __syncthreads();
    { float s, c; sincospif((float)tid * (1.0f / 8192.0f), &s, &c); cf w1{c, -s}; asm volatile("" : "+v"(w1.x), "+v"(w1.y)); cf w = w1;
#pragma unroll
      for (int kk = 0; kk < 32; ++kk) { cf x = lld(L, kk * RS + tid); if (kk) { x = cmulc(x, w); w = cmul(w, w1); } v[kk] = x; } }
    dft_reg<32, true>(v);
}
}
constexpr size_t MiB = 1u << 20;
constexpr size_t WS_CTL = 0, CTL_ZERO_BYTES = 1 * MiB;
constexpr size_t WS_W1T = 1 * MiB;
constexpr size_t WS_W2T = 257 * MiB;
constexpr size_t WS_WIN_EV = 385 * MiB, WS_WOUT_EV = 409 * MiB, WS_WIN_OD = 417 * MiB, WS_WOUT_OD = 433 * MiB, WS_WG_OD = 441 * MiB;
constexpr size_t AR = 445 * MiB;
constexpr size_t A_XB = AR + 0 * MiB, A_UHT = AR + 64 * MiB, A_QB = AR + 160 * MiB, A_KB = AR + 192 * MiB, A_VB = AR + 224 * MiB, A_KTD = AR + 256 * MiB, A_KF = AR + 384 * MiB,
                 A_H3B = AR + 512 * MiB, A_W4T = AR + 514 * MiB, A_YHT = AR + 256 * MiB, A_OA = AR + 288 * MiB, A_YCAT = AR + 0 * MiB, A_R0 = AR + 64 * MiB, A_H1_0 = AR + 192 * MiB,
                 A_HB_0 = AR + 320 * MiB, A_HID_0 = AR + 384 * MiB, A_ROWL = AR + 424 * MiB, A_GATEW = AR + 428 * MiB, A_Y2_0 = AR + 0 * MiB, A_H2 = AR + 448 * MiB, A_HB2 = AR + 448 * MiB;
constexpr size_t A_GB = AR + 0 * MiB, A_XR = AR + 64 * MiB, A_XC = AR + 192 * MiB, A_LA = AR + 256 * MiB, A_BB = AR + 64 * MiB, A_CAR = AR + 384 * MiB, A_YG = AR + 192 * MiB, A_R1 = AR + 256 * MiB,
                 A_H1_1 = AR + 0 * MiB, A_HB_1 = AR + 128 * MiB, A_HID_1 = AR + 192 * MiB, A_Y2_1 = AR + 256 * MiB;
constexpr size_t WS_END = AR + 576 * MiB;
constexpr int CW_BAR = 4096, CW_CNT = 16384, CW_NORM = 24576;
constexpr int LDS_MISC = 139264, LDS_BYTES = 147456;
constexpr int NPHASE = 21;

struct Args { const float* in[37]; float* out; unsigned char* ws; int ph_lo, ph_hi; };
typedef const __attribute__((address_space(4))) Args& KArgs;

__device__ __forceinline__ void transpose_item(const float* W, int N, int k0, int n0, bf16_t* WT, int ldk, int drow0, LAS float* scr, int lane) {
#pragma unroll 8
    for (int i = 0; i < 32; ++i) { const int kk = 2 * i + (lane >> 5); scr[kk * 33 + (lane & 31)] = W[(size_t)(k0 + kk) * N + n0 + (lane & 31)]; }
    LDS_WAIT(); asm volatile("" ::: "memory");
    const int c = lane & 7;
#pragma unroll
    for (int j = 0; j < 4; ++j) { const int n = (lane >> 3) + 8 * j; const LAS float* s = scr + (8 * c) * 33 + n;
        u32x4 o; o.x = pk2(s[0 * 33], s[1 * 33]); o.y = pk2(s[2 * 33], s[3 * 33]); o.z = pk2(s[4 * 33], s[5 * 33]); o.w = pk2(s[6 * 33], s[7 * 33]);
        *(u32x4*)(WT + (size_t)(drow0 + n) * ldk + k0 + 8 * c) = o; }
    LDS_WAIT(); asm volatile("" ::: "memory");
}

__device__ __forceinline__ void phase_prologue(KArgs a, LAS unsigned char* lds) {
    const int tid = opaque_tid(), lane = tid & 63, wave = tid >> 6, G = gridDim.x;
    const int gw = blockIdx.x * 8 + wave, NGW = G * 8;
    unsigned char* ws = a.ws;
    LAS float* scr = (LAS float*)(lds + wave * 16384);
    constexpr int I_EVIN = 32 * 192, I_SQ = 32 * 64, I_ODIN = 32 * 128, I_MOE_GU = 64 * 512, I_MOE_D = 64 * 512, I_RG = 16 * 32, I_W4 = 128;
    constexpr int O1 = I_EVIN, O2 = O1 + I_SQ, O3 = O2 + I_ODIN, O4 = O3 + I_SQ, O5 = O4 + I_MOE_GU, O6 = O5 + I_MOE_GU, O7 = O6 + I_MOE_D, O8 = O7 + I_RG, O9 = O8 + I_RG, O10 = O9 + I_W4;
    for (int it = gw; it < O10; it += NGW) {
        if (it < O1) { const int kb = it / 192, nb = it % 192; transpose_item(a.in[1], EV_IN, kb * 64, nb * 32, (bf16_t*)(ws + WS_WIN_EV), DM, nb * 32, scr, lane); }
        else if (it < O2) { const int r = it - O1, kb = r / 64, nb = r % 64; transpose_item(a.in[18], DM, kb * 64, nb * 32, (bf16_t*)(ws + WS_WOUT_EV), DM, nb * 32, scr, lane); }
        else if (it < O3) { const int r = it - O2, kb = r / 128, nb = r % 128; transpose_item(a.in[19], 2 * DM, kb * 64, nb * 32, (bf16_t*)(ws + WS_WIN_OD), DM, nb * 32, scr, lane); }
        else if (it < O4) { const int r = it - O3, kb = r / 64, nb = r % 64; transpose_item(a.in[27], DM, kb * 64, nb * 32, (bf16_t*)(ws + WS_WOUT_OD), DM, nb * 32, scr, lane); }
        else if (it < O6) { const bool up = it >= O5; const int r = it - (up ? O5 : O4), le = r / 512, q = r % 512, kb = q / 16, nb = q % 16, n0 = nb * 32;
            transpose_item((up ? a.in[35] : a.in[34]) + (size_t)le * DM * DFF, DFF, kb * 64, n0, (bf16_t*)(ws + WS_W1T) + (size_t)le * 1024 * DM, DM, (n0 >> 7) * 256 + (n0 & 127) + (up ? 128 : 0), scr, lane); }
        else if (it < O7) { const int r = it - O6, le = r / 512, q = r % 512, kb = q / 64, nb = q % 64;
            transpose_item(a.in[36] + (size_t)le * DFF * DM, DM, kb * 64, nb * 32, (bf16_t*)(ws + WS_W2T) + (size_t)le * DM * DFF, DFF, nb * 32, scr, lane); }
        else if (it < O9) { const bool wx = it >= O8; const int r = it - (wx ? O8 : O7), dn = r / 32, q = r % 32, kb = q / 8, nb = q % 8, n0 = nb * 32, dir = dn / 8, n = dn % 8;
            transpose_item((wx ? a.in[24] : a.in[22]) + (size_t)dn * 65536, 256, kb * 64, n0, (bf16_t*)(ws + WS_WG_OD), 256, (n * 4 + dir * 2 + (n0 >> 7)) * 256 + (n0 & 127) + (wx ? 128 : 0), scr, lane); }
        else { const int nb = it - O9; transpose_item(a.in[11], 4096, 0, nb * 32, (bf16_t*)(ws + A_W4T), 128, nb * 32, scr, lane); }
    }
    { const int gt = blockIdx.x * 512 + tid, NT = G * 512;
      for (int i = gt; i < 4096 * 8; i += NT) { const int r = i >> 3, c = i & 7; *(u32x4*)((bf16_t*)(ws + A_W4T) + (size_t)r * 128 + 64 + c * 8) = (u32x4){0u, 0u, 0u, 0u}; }
      for (int i = gt; i < 8192 * 8; i += NT) { const int r = i >> 3, c = i & 7; *(u32x4*)((bf16_t*)(ws + A_H3B) + (size_t)r * 128 + 64 + c * 8) = (u32x4){0u, 0u, 0u, 0u}; }
      const f32x8* x8 = (const f32x8*)a.in[0]; u32x4* xb = (u32x4*)(ws + A_XB);
      for (int i = gt; i < NTOK * DM / 8; i += NT) { const f32x8 v = x8[i]; u32x4 o; o.x = pk2(v[0], v[1]); o.y = pk2(v[2], v[3]); o.z = pk2(v[4], v[5]); o.w = pk2(v[6], v[7]); xb[i] = o; } }
    { const float* w1 = a.in[4]; const float* b1 = a.in[5]; const float* w2 = a.in[6]; const float* b2 = a.in[7]; const float* w3 = a.in[8]; const float* b3 = a.in[9]; const float* fr = a.in[10];
      const float frq = fr[lane];
      for (int t = gw; t < SEQ; t += NGW) {
          float z;
          { const float tl = (float)t * (1.0f / 8191.0f);
            if (lane == 0) z = tl;
            else { const int j = (lane - 1) & 15; const float band = 1e-4f + (float)j * ((15.0f - 1e-4f) / 15.0f);
                   const float ang = (6.283185307179586f * (float)t * (1.0f / 8192.0f)) * band; float sn, cs; sincosf(ang, &sn, &cs); z = (lane <= 16) ? cs : -sn; } }
          float acc = b1[lane];
#pragma unroll
          for (int i = 0; i < 33; ++i) acc += __shfl(z, i) * w1[i * 64 + lane];
          float h = sinf(frq * acc);
          acc = b2[lane];
#pragma unroll 16
          for (int i = 0; i < 64; ++i) acc += __shfl(h, i) * w2[i * 64 + lane];
          h = sinf(frq * acc);
          acc = b3[lane];
#pragma unroll 16
          for (int i = 0; i < 64; ++i) acc += __shfl(h, i) * w3[i * 64 + lane];
          h = sinf(frq * acc);
          ((bf16_t*)(ws + A_H3B))[(size_t)t * 128 + lane] = (bf16_t)f2bf(h);
      } }
}

__device__ __forceinline__ void phase_filter_fft(KArgs a, LAS unsigned char* lds) {
    const int tid = opaque_tid(), lane = tid & 63, wave = tid >> 6, G = gridDim.x;
    LAS f32x2* L = (LAS f32x2*)lds; LAS float* red = (LAS float*)(lds + LDS_MISC + 1024);
    const float* KTD = (const float*)(a.ws + A_KTD); __half2* KF = (__half2*)(a.ws + A_KF);
    for (int u = blockIdx.x; u < 2048; u += G) {
        const int o = u >> 10, c = u & 1023;
        int tl = tid; asm volatile("" : "+v"(tl));
        const float* rowF = KTD + (size_t)(o * 1024 + c) * 8192; const float* rowB = KTD + (size_t)(2048 + o * 1024 + c) * 8192;
        hy::cf v[32]; float ss = 0.f;
#pragma unroll
        for (int n1 = 0; n1 < 32; ++n1) { const int p = tl + 512 * n1; float val;
            if (n1 < 16) val = rowF[p]; else if (p == 8192) val = 0.f; else val = rowB[16384 - p];
            v[n1] = hy::cf{val, 0.f}; ss += val * val; }
        ss = wave_sum(ss); if (lane == 0) red[wave] = ss; __syncthreads();
        float tot = 0.f;
#pragma unroll
        for (int w = 0; w < 8; ++w) tot += red[w];
        const float scale = rsqrtf(tot), skp = a.in[12][u];
        hy::fft_fwd12(v, L, tl);
#pragma unroll
        for (int bf = 0; bf < 2; ++bf) { const int idx = bf * 512 + tl, k1 = idx >> 5, j1 = idx & 31; hy::cf w[16];
#pragma unroll
            for (int m2 = 0; m2 < 16; ++m2) w[m2] = hy::lld(L, k1 * hy::RS + 33 * m2 + j1);
            hy::dft_reg<16, false>(w);
#pragma unroll
            for (int j2 = 0; j2 < 16; ++j2) { const hy::cf x = w[hy::brev(j2, 4)]; KF[((size_t)(u * 2 + bf) * 16 + j2) * 512 + tl] = __floats2half2_rn(x.x * scale + skp, x.y * scale); } }
        __syncthreads();
    }
}
__device__ __forceinline__ float hyconv(const bf16_t* row, int t, float w0, float w1, float w2, float bias) {
    const unsigned tm = (unsigned)(t > 0 ? t - 1 : 0), tp = (unsigned)(t < SEQ - 1 ? t + 1 : SEQ - 1);
    float xm = bf2f(row[tm]), x0 = bf2f(row[(unsigned)t]), xp = bf2f(row[tp]);
    xm = t > 0 ? xm : 0.f; xp = t < SEQ - 1 ? xp : 0.f;
    return w0 * xm + w1 * x0 + w2 * xp + bias;
}
__device__ __forceinline__ void phase_hyena_mixer(KArgs a, LAS unsigned char* lds) {
    const int tid = opaque_tid(), G = gridDim.x;
    LAS f32x2* L = (LAS f32x2*)lds;
    const bf16_t* UHT = (const bf16_t*)(a.ws + A_UHT); const __half2* KF = (const __half2*)(a.ws + A_KF); bf16_t* YHT = (bf16_t*)(a.ws + A_YHT);
    const float* cw = a.in[2]; const float* cb = a.in[3];
    for (int c = blockIdx.x; c < HY_CH; c += G) {
        int tl = tid; asm volatile("" : "+v"(tl));
        hy::cf v[32];
        { const bf16_t* r0 = UHT + (size_t)c * NTOK; const float w0 = cw[c], w1 = cw[3072 + c], w2 = cw[6144 + c], bb = cb[c];
#pragma unroll
          for (int n1 = 0; n1 < 16; ++n1) { const int t = tl + 512 * n1; v[n1] = hy::cf{hyconv(r0, t, w0, w1, w2, bb), hyconv(r0 + SEQ, t, w0, w1, w2, bb)}; if ((n1 & 3) == 3) asm volatile("" ::: "memory"); } }
#pragma unroll 1
        for (int o = 0; o < 2; ++o) {
#pragma unroll
            for (int n1 = 16; n1 < 32; ++n1) v[n1] = hy::cf{0.f, 0.f};
            hy::fft_fwd12(v, L, tl);
#pragma unroll
            for (int bf = 0; bf < 2; ++bf) { const int idx = bf * 512 + tl, k1 = idx >> 5, j1 = idx & 31; hy::cf w[16];
#pragma unroll
                for (int m2 = 0; m2 < 16; ++m2) w[m2] = hy::lld(L, k1 * hy::RS + 33 * m2 + j1);
                hy::dft_reg<16, false>(w);
                asm volatile("" ::: "memory");
                hy::cf y[16];
#pragma unroll
                for (int j2 = 0; j2 < 16; ++j2) { const float2 kf = __half22float2(KF[((size_t)((o * 1024 + c) * 2 + bf) * 16 + j2) * 512 + tl]);
                    y[j2] = hy::cmul(w[hy::brev(j2, 4)], hy::cf{kf.x, kf.y}); }
                hy::dft_reg<16, true>(y);
#pragma unroll
                for (int m2 = 0; m2 < 16; ++m2) hy::lst(L, k1 * hy::RS + 33 * m2 + j1, y[hy::brev(m2, 4)]); }
            __syncthreads();
            hy::fft_inv21(v, L, tl);
            const int gch = (o + 1) * 1024 + c; const bf16_t* rg = UHT + (size_t)gch * NTOK;
            const float w0 = cw[gch], w1 = cw[3072 + gch], w2 = cw[6144 + gch], bb = cb[gch];
            hy::cf zn[16]; int tg = tl; asm volatile("" : "+v"(tg));
#pragma unroll
            for (int n1 = 0; n1 < 16; ++n1) { const int t = tg + 512 * n1; const hy::cf y = v[hy::brev(n1, 5)];
                const float g0 = hyconv(rg, t, w0, w1, w2, bb), g1 = hyconv(rg + SEQ, t, w0, w1, w2, bb);
                zn[n1] = hy::cf{g0 * y.x * (1.0f / 16384.0f), g1 * y.y * (1.0f / 16384.0f)}; if ((n1 & 3) == 3) asm volatile("" ::: "memory"); }
#pragma unroll
            for (int n1 = 0; n1 < 16; ++n1) v[n1] = zn[n1];
        }
        bf16_t* yo = YHT + (size_t)c * NTOK;
#pragma unroll
        for (int n1 = 0; n1 < 16; ++n1) { const int t = tl + 512 * n1; yo[t] = (bf16_t)f2bf(v[n1].x); yo[SEQ + t] = (bf16_t)f2bf(v[n1].y); }
    }
    __syncthreads();
}
__device__ __forceinline__ void phase_qknorm(KArgs a, LAS unsigned char* lds) {
    const int tid = opaque_tid(), lane = tid & 63, wave = tid >> 6, gw = blockIdx.x * 8 + wave, NGW = gridDim.x * 8;
    LAS unsigned* red = (LAS unsigned*)(lds + LDS_MISC + 1536);
    unsigned* ctl = (unsigned*)(a.ws + WS_CTL);
    if (tid < 64) red[tid] = 0u;
    __syncthreads();
    for (int which = 0; which < 2; ++which) { const bf16_t* P = (const bf16_t*)(a.ws + (which ? A_KB : A_QB));
        for (int b = 0; b < 2; ++b) { float mx = 0.f;
            for (int row = gw; row < SEQ; row += NGW) { const bf16_t* p = P + ((size_t)b * SEQ + row) * 1024 + lane * 16;
                const u32x4 w0 = *(const u32x4*)p, w1 = *(const u32x4*)(p + 8); const unsigned ww[8] = {w0.x, w0.y, w0.z, w0.w, w1.x, w1.y, w1.z, w1.w};
                float ss = 0.f;
#pragma unroll
                for (int i = 0; i < 8; ++i) { const float x = bflo(ww[i]), y = bfhi(ww[i]); ss += x * x + y * y; }
                ss += __shfl_xor(ss, 1); ss += __shfl_xor(ss, 2); mx = fmaxf(mx, ss); }
            if ((lane & 3) == 0) atomicMax((unsigned*)&red[which * 32 + b * 16 + (lane >> 2)], __float_as_uint(mx)); } }
    __syncthreads();
    if (tid < 64) atomicMax(ctl + CW_NORM + tid, red[tid]);
}
__device__ __forceinline__ void phase_attention(KArgs a, LAS unsigned char* lds) {
    const int G = gridDim.x, bx = blockIdx.x;
    const bf16_t* QB = (const bf16_t*)(a.ws + A_QB); const bf16_t* KB = (const bf16_t*)(a.ws + A_KB); const bf16_t* VB = (const bf16_t*)(a.ws + A_VB); bf16_t* OA = (bf16_t*)(a.ws + A_OA);
    const unsigned* nrm = (const unsigned*)(a.ws + WS_CTL) + CW_NORM;
    for (int i = 0;; ++i) {
        int bhc, qb;
        if (G == 256) { if (i >= 4) break;
            const int x = bx & 7, combo = x & 3, hh = (x < 4) ? ((i == 0) ? 7 : (i == 1) ? 5 : (i == 2) ? 1 : 0) : ((i == 0) ? 6 : (i == 1) ? 4 : (i == 2) ? 3 : 2); bhc = (combo >> 1) * 16 + hh * 2 + (combo & 1); qb = bx >> 3; }
        else { const int Lu = i * G + bx; if (Lu >= 1024) break; bhc = Lu >> 5; qb = Lu & 31; }
        const int b = bhc >> 4, h = (bhc >> 1) & 7, cm = bhc & 1;
        const size_t rowq = (size_t)b * SEQ + (size_t)qb * 256;
        const float sl2 = exp2f(-(float)(h + 1)) * 1.4426950408889634f;
        const float qk = sqrtf(__uint_as_float(nrm[bhc]) * __uint_as_float(nrm[32 + bhc]));
        const float Wk = (2.0f * qk + 38.0f) / sl2, q0f = (float)(qb * 256);
        int t_lo = (int)fmaxf(floorf((q0f - Wk - 63.0f) * (1.0f / 64.0f)), 0.0f), t_hi = (int)fminf(ceilf((q0f + 255.0f + Wk) * (1.0f / 64.0f)), 127.0f);
        if (((t_hi - t_lo + 1) & 1) != 0) { if (t_hi < 127) ++t_hi; else --t_lo; }
        att::attn_unit(QB + rowq * 1024 + h * 128 + cm * 64, KB + (size_t)b * SEQ * 1024 + h * 128 + cm * 64, VB + (size_t)b * SEQ * 1024 + h * 128,
                       OA + (size_t)cm * NTOK * 1024 + rowq * 1024 + h * 128, qb * 256, t_lo, t_hi - t_lo + 1, sl2, (char*)lds);
    }
}
__device__ __forceinline__ void phase_concat(KArgs a, LAS unsigned char* lds) {
    const int tid = opaque_tid(), lane = tid & 63, wave = tid >> 6, G = gridDim.x;
    const bf16_t* YHT = (const bf16_t*)(a.ws + A_YHT); const bf16_t* OA0 = (const bf16_t*)(a.ws + A_OA); const bf16_t* OA1 = OA0 + (size_t)NTOK * 1024; bf16_t* YC = (bf16_t*)(a.ws + A_YCAT);
    LAS bf16_t* T = (LAS bf16_t*)lds;
    const float lambda_init = 0.2f;
    const float lam = __expf(wave_sum(a.in[13][lane] * a.in[14][lane])) - __expf(wave_sum(a.in[15][lane] * a.in[16][lane])) + lambda_init;
    float gl[16];
#pragma unroll
    for (int i = 0; i < 16; ++i) gl[i] = a.in[17][(lane & 7) * 16 + i] * (1.0f - lambda_init);
    for (int it = blockIdx.x; it < NTOK / 64; it += G) {
        const int tok0 = it * 64;
#pragma unroll 4
        for (int k = 0; k < 16; ++k) { const int idx = tid + 512 * k, c = idx >> 3, ch = idx & 7;
            const u32x4 w = *(const u32x4*)(YHT + (size_t)c * NTOK + tok0 + ch * 8);
            LAS bf16_t* d = T + (ch * 8) * 1026 + c;
            d[0 * 1026] = (bf16_t)(w.x & 0xffff); d[1 * 1026] = (bf16_t)(w.x >> 16); d[2 * 1026] = (bf16_t)(w.y & 0xffff); d[3 * 1026] = (bf16_t)(w.y >> 16);
            d[4 * 1026] = (bf16_t)(w.z & 0xffff); d[5 * 1026] = (bf16_t)(w.z >> 16); d[6 * 1026] = (bf16_t)(w.w & 0xffff); d[7 * 1026] = (bf16_t)(w.w >> 16); }
        __syncthreads();
#pragma unroll 4
        for (int k = 0; k < 16; ++k) { const int idx = tid + 512 * k, tl = idx >> 7, c8 = idx & 127;
            const LAS unsigned* s = (const LAS unsigned*)(T + tl * 1026 + c8 * 8);
            u32x4 w; w.x = s[0]; w.y = s[1]; w.z = s[2]; w.w = s[3];
            *(u32x4*)(YC + (size_t)(tok0 + tl) * DM + c8 * 8) = w; }
        for (int rr = 0; rr < 8; ++rr) { const size_t tok = (size_t)tok0 + wave * 8 + rr;
            const u32x4 p0 = *(const u32x4*)(OA0 + tok * 1024 + lane * 16), p1 = *(const u32x4*)(OA0 + tok * 1024 + lane * 16 + 8);
            const u32x4 q0 = *(const u32x4*)(OA1 + tok * 1024 + lane * 16), q1 = *(const u32x4*)(OA1 + tok * 1024 + lane * 16 + 8);
            const unsigned pw[8] = {p0.x, p0.y, p0.z, p0.w, p1.x, p1.y, p1.z, p1.w}, qw[8] = {q0.x, q0.y, q0.z, q0.w, q1.x, q1.y, q1.z, q1.w};
            float o[16]; float ss = 0.f;
#pragma unroll
            for (int i = 0; i < 8; ++i) { o[2 * i] = bflo(pw[i]) - lam * bflo(qw[i]); o[2 * i + 1] = bfhi(pw[i]) - lam * bfhi(qw[i]); ss += o[2 * i] * o[2 * i] + o[2 * i + 1] * o[2 * i + 1]; }
            ss += __shfl_xor(ss, 1); ss += __shfl_xor(ss, 2); ss += __shfl_xor(ss, 4);
            const float rs = rsqrtf(ss * (1.0f / 128.0f) + LN_EPS);
            u32x4 w0, w1;
            w0.x = pk2(o[0] * rs * gl[0], o[1] * rs * gl[1]); w0.y = pk2(o[2] * rs * gl[2], o[3] * rs * gl[3]); w0.z = pk2(o[4] * rs * gl[4], o[5] * rs * gl[5]); w0.w = pk2(o[6] * rs * gl[6], o[7] * rs * gl[7]);
            w1.x = pk2(o[8] * rs * gl[8], o[9] * rs * gl[9]); w1.y = pk2(o[10] * rs * gl[10], o[11] * rs * gl[11]); w1.z = pk2(o[12] * rs * gl[12], o[13] * rs * gl[13]); w1.w = pk2(o[14] * rs * gl[14], o[15] * rs * gl[15]);
            *(u32x4*)(YC + tok * DM + 1024 + lane * 16) = w0; *(u32x4*)(YC + tok * DM + 1024 + lane * 16 + 8) = w1; }
        __syncthreads();
    }
}
__device__ __forceinline__ void ln_row(f32x4 (&v)[8], const float* g, const float* b, int lane, float& mu, float& rs) {
    float s = 0.f;
#pragma unroll
    for (int j = 0; j < 8; ++j) s += (v[j][0] + v[j][1]) + (v[j][2] + v[j][3]);
    const float mean = wave_sum(s) * (1.0f / DM); float s2 = 0.f;
#pragma unroll
    for (int j = 0; j < 8; ++j) { v[j] = v[j] - mean; s2 += (v[j][0] * v[j][0] + v[j][1] * v[j][1]) + (v[j][2] * v[j][2] + v[j][3] * v[j][3]); }
    const float rstd = rsqrtf(wave_sum(s2) * (1.0f / DM) + LN_EPS); mu = mean; rs = rstd;
#pragma unroll
    for (int j = 0; j < 8; ++j) { const f32x4 gg = *(const f32x4*)(g + 4 * (lane + 64 * j)), bb = *(const f32x4*)(b + 4 * (lane + 64 * j)); v[j] = v[j] * rstd * gg + bb; }
}
__device__ __forceinline__ void phase_ln_router(KArgs a, LAS unsigned char* lds, const float* R, const float* g, const float* b, bf16_t* HB, unsigned* cnt, int* rowlist, float* gatew) {
    const int tid = opaque_tid(), lane = tid & 63, wave = tid >> 6, G = gridDim.x;
    const float* rw = a.in[32]; const float* rb = a.in[33];
    LAS float* part = (LAS float*)lds;
    LAS int* hist = (LAS int*)(lds + 40960); LAS int* base = hist + 32; LAS float* stats = (LAS float*)(lds + 40960 + 512);
    for (int it = blockIdx.x; it < NTOK / 32; it += G) {
        const int tok0 = it * 32;
        for (int rr = 0; rr < 4; ++rr) { const size_t row = (size_t)tok0 + wave * 4 + rr; f32x4 v[8]; float mu, rs;
#pragma unroll
            for (int j = 0; j < 8; ++j) v[j] = *(const f32x4*)(R + row * DM + 4 * (lane + 64 * j));
            ln_row(v, g, b, lane, mu, rs);
            if (lane == 0) { stats[(wave * 4 + rr) * 2] = mu; stats[(wave * 4 + rr) * 2 + 1] = rs; }
#pragma unroll
            for (int j = 0; j < 8; ++j) { u32x2 w; w.x = pk2(v[j][0], v[j][1]); w.y = pk2(v[j][2], v[j][3]); *(u32x2*)(HB + row * DM + 4 * (lane + 64 * j)) = w; } }
        if (tid < 32) hist[tid] = 0;
        __syncthreads();
        { const int i = lane & 31, kk = lane >> 5; f32x16 acc = {};
          const float mu = stats[i * 2], rs = stats[i * 2 + 1];
          const float* rrow = R + (size_t)(tok0 + i) * DM + wave * 256 + 4 * kk; const float* gp = g + wave * 256 + 4 * kk; const float* bp = b + wave * 256 + 4 * kk;
          const float* rwp = rw + (size_t)(wave * 256 + 4 * kk) * NEXP + i;
#pragma unroll 4
          for (int s = 0; s < 32; ++s) { const f32x4 hv = (*(const f32x4*)(rrow + 8 * s) - mu) * rs * *(const f32x4*)(gp + 8 * s) + *(const f32x4*)(bp + 8 * s);
#pragma unroll
              for (int j = 0; j < 4; ++j) acc = __builtin_amdgcn_mfma_f32_32x32x2f32(rwp[(size_t)(8 * s + j) * NEXP], hv[j], acc, 0, 0, 0); }
#pragma unroll
          for (int r = 0; r < 16; ++r) part[(wave * 32 + i) * 33 + (r & 3) + 8 * (r >> 2) + 4 * kk] = acc[r]; }
        __syncthreads();
        int e1 = 0, e2 = 0, r1 = 0, r2 = 0; float g1 = 0.f, g2 = 0.f;
        if (tid < 32) {
            float bestg = -1e30f;
#pragma unroll
            for (int gi = 0; gi < 4; ++gi) { float m1 = -1e30f, m2 = -1e30f, s1 = 0.f, s2 = 0.f; int i1 = 0, i2 = 0;
#pragma unroll
                for (int j = 0; j < 8; ++j) { const int e = gi * 8 + j; float lg = 0.f;
#pragma unroll
                    for (int w = 0; w < 8; ++w) lg += part[(w * 32 + tid) * 33 + e];
                    const float sg = 1.0f / (1.0f + expf(-lg)), sl = sg + rb[e];
                    if (sl > m1) { m2 = m1; i2 = i1; s2 = s1; m1 = sl; i1 = j; s1 = sg; } else if (sl > m2) { m2 = sl; i2 = j; s2 = sg; } }
                const float gs = m1 + m2;
                if (gs > bestg) { bestg = gs; e1 = gi * 8 + i1; e2 = gi * 8 + i2; g1 = s1; g2 = s2; } }
            const float inv = 1.0f / (g1 + g2); g1 *= inv; g2 *= inv;
            r1 = atomicAdd((int*)&hist[e1], 1); r2 = atomicAdd((int*)&hist[e2], 1);
        }
        __syncthreads();
        if (tid < 32) { const int hc = hist[tid]; base[tid] = hc ? (int)__hip_atomic_fetch_add(cnt + tid * 64, (unsigned)hc, __ATOMIC_RELAXED, __HIP_MEMORY_SCOPE_AGENT) : 0; }
        __syncthreads();
        if (tid < 32) { const int a0 = (tok0 + tid) * 2;
            rowlist[(size_t)e1 * ECAP + base[e1] + r1] = a0; gatew[a0] = g1;
            rowlist[(size_t)e2 * ECAP + base[e2] + r2] = a0 + 1; gatew[a0 + 1] = g2; }
        __syncthreads();
    }
}
__device__ __forceinline__ void phase_ln2(const bf16_t* HB, const bf16_t* Y2, const float* g, const float* b, float* OUT, bf16_t* OB) {
    const int tid = opaque_tid(), lane = tid & 63, wave = tid >> 6;
    for (int row = blockIdx.x * 8 + wave; row < NTOK; row += gridDim.x * 8) { f32x4 v[8]; float mu, rs;
#pragma unroll
        for (int j = 0; j < 8; ++j) { const int c = 4 * (lane + 64 * j); const u32x2 h = *(const u32x2*)(HB + (size_t)row * DM + c);
            const u32x2 y0 = *(const u32x2*)(Y2 + (size_t)(2 * row) * DM + c), y1 = *(const u32x2*)(Y2 + (size_t)(2 * row + 1) * DM + c);
            v[j] = (f32x4){bflo(h.x), bfhi(h.x), bflo(h.y), bfhi(h.y)} * DN_ALPHA + (f32x4){bflo(y0.x) + bflo(y1.x), bfhi(y0.x) + bfhi(y1.x), bflo(y0.y) + bflo(y1.y), bfhi(y0.y) + bfhi(y1.y)}; }
        ln_row(v, g, b, lane, mu, rs);
#pragma unroll
        for (int j = 0; j < 8; ++j) { const int c = 4 * (lane + 64 * j); if (OUT) *(f32x4*)(OUT + (size_t)row * DM + c) = v[j];
            if (OB) { u32x2 w; w.x = pk2(v[j][0], v[j][1]); w.y = pk2(v[j][2], v[j][3]); *(u32x2*)(OB + (size_t)row * DM + c) = w; } }
    }
}
__device__ __forceinline__ void moe_table(LAS int* tab, const unsigned* cnt) {
    __syncthreads();
    const int tid = opaque_tid();
    if (tid < 32) tab[64 + tid] = (int)cnt[tid * 64];
    __syncthreads();
    if (tid == 0) { int acc = 0; for (int e = 0; e < 32; ++e) { tab[e] = acc; acc += (tab[64 + e] + 255) >> 8; } tab[32] = acc; }
    __syncthreads();
}
__device__ __forceinline__ void phase_conv4(KArgs a) {
    const bf16_t* XR = (const bf16_t*)(a.ws + A_XR); bf16_t* XC = (bf16_t*)(a.ws + A_XC); const float* cw = a.in[20]; const float* cb = a.in[21];
    const int NT = gridDim.x * 512;
    for (int it = blockIdx.x * 512 + opaque_tid(); it < NTOK * 256; it += NT) { const int tok = it >> 8, ch = (it & 255) * 8, t = tok & (SEQ - 1);
        float acc[8];
#pragma unroll
        for (int i = 0; i < 8; ++i) acc[i] = cb[ch + i];
#pragma unroll
        for (int j = 0; j < 4; ++j) { const int tt = t + j - 2;
            if (tt >= 0 && tt < SEQ) { const u32x4 w = *(const u32x4*)(XR + (size_t)(tok + j - 2) * DM + ch); const unsigned ww[4] = {w.x, w.y, w.z, w.w};
#pragma unroll
                for (int i = 0; i < 4; ++i) { acc[2 * i] += cw[j * DM + ch + 2 * i] * bflo(ww[i]); acc[2 * i + 1] += cw[j * DM + ch + 2 * i + 1] * bfhi(ww[i]); } } }
        u32x4 o; o.x = pk2(acc[0], acc[1]); o.y = pk2(acc[2], acc[3]); o.z = pk2(acc[4], acc[5]); o.w = pk2(acc[6], acc[7]);
        *(u32x4*)(XC + (size_t)tok * DM + ch) = o; }
}
constexpr size_t CAR_ELEMS = (size_t)2 * 2 * 256 * DM;
__device__ __forceinline__ void phase_scan1(KArgs a) {
    const bf16_t* LA = (const bf16_t*)(a.ws + A_LA); const bf16_t* BB = (const bf16_t*)(a.ws + A_BB); float* CARA = (float*)(a.ws + A_CAR); float* CARB = CARA + CAR_ELEMS;
    const int NT = gridDim.x * 512;
    for (int it = blockIdx.x * 512 + opaque_tid(); it < 2 * 2 * 256 * 512; it += NT) { const int ch = (it & 511) * 4, chunk = (it >> 9) & 255, dir = (it >> 17) & 1, b = it >> 18;
        float h[4] = {0.f, 0.f, 0.f, 0.f}, ls[4] = {0.f, 0.f, 0.f, 0.f};
#pragma unroll 8
        for (int s = 0; s < 32; ++s) { const int t = chunk * 32 + (dir ? 31 - s : s); const size_t off = ((size_t)dir * NTOK + (size_t)b * SEQ + t) * DM + ch;
            const u32x2 lw = *(const u32x2*)(LA + off), bw = *(const u32x2*)(BB + off);
            const float l4[4] = {bflo(lw.x), bfhi(lw.x), bflo(lw.y), bfhi(lw.y)}, b4[4] = {bflo(bw.x), bfhi(bw.x), bflo(bw.y), bfhi(bw.y)};
#pragma unroll
            for (int i = 0; i < 4; ++i) { h[i] = __expf(l4[i]) * h[i] + b4[i]; ls[i] += l4[i]; } }
        const size_t co = (((size_t)b * 2 + dir) * 256 + chunk) * DM + ch;
        *(f32x4*)(CARA + co) = (f32x4){ls[0], ls[1], ls[2], ls[3]}; *(f32x4*)(CARB + co) = (f32x4){h[0], h[1], h[2], h[3]}; }
}
__device__ __forceinline__ void phase_scan2(KArgs a) {
    float* CARA = (float*)(a.ws + A_CAR); float* CARB = CARA + CAR_ELEMS; float* CARIN = CARB + CAR_ELEMS;
    const int NT = gridDim.x * 512;
    for (int it = blockIdx.x * 512 + opaque_tid(); it < 2 * 2 * DM; it += NT) { const int ch = it & (DM - 1), dir = (it >> 11) & 1, b = it >> 12;
        float h = 0.f;
#pragma unroll 8
        for (int k = 0; k < 256; ++k) { const int chunk = dir ? 255 - k : k; const size_t co = (((size_t)b * 2 + dir) * 256 + chunk) * DM + ch;
            CARIN[co] = h; h = __expf(CARA[co]) * h + CARB[co]; } }
}
__device__ __forceinline__ float gelu_tanh(float x) { const float u = 0.7978845608028654f * (x + 0.044715f * x * x * x); const float th = 1.0f - 2.0f * __builtin_amdgcn_rcpf(1.0f + __builtin_amdgcn_exp2f(2.8853900817779268f * u)); return 0.5f * x * (1.0f + th); }
__device__ __forceinline__ void phase_scan3(KArgs a) {
    const bf16_t* LA = (const bf16_t*)(a.ws + A_LA); const bf16_t* BB = (const bf16_t*)(a.ws + A_BB); const bf16_t* GB = (const bf16_t*)(a.ws + A_GB); bf16_t* YG = (bf16_t*)(a.ws + A_YG);
    const float* CARIN = (const float*)(a.ws + A_CAR) + 2 * CAR_ELEMS;
    const int NT = gridDim.x * 512;
    for (int it = blockIdx.x * 512 + opaque_tid(); it < 2 * 256 * 512; it += NT) { const int ch = (it & 511) * 4, chunk = (it >> 9) & 255, b = it >> 17;
        float hf[32][4]; float h[4];
        { const f32x4 c = *(const f32x4*)(CARIN + (((size_t)b * 2 + 0) * 256 + chunk) * DM + ch); h[0] = c[0]; h[1] = c[1]; h[2] = c[2]; h[3] = c[3]; }
#pragma unroll
        for (int s = 0; s < 32; ++s) { const size_t off = ((size_t)b * SEQ + chunk * 32 + s) * DM + ch;
            const u32x2 lw = *(const u32x2*)(LA + off), bw = *(const u32x2*)(BB + off);
            const float l4[4] = {bflo(lw.x), bfhi(lw.x), bflo(lw.y), bfhi(lw.y)}, b4[4] = {bflo(bw.x), bfhi(bw.x), bflo(bw.y), bfhi(bw.y)};
#pragma unroll
            for (int i = 0; i < 4; ++i) { h[i] = __expf(l4[i]) * h[i] + b4[i]; hf[s][i] = h[i]; } }
        { const f32x4 c = *(const f32x4*)(CARIN + (((size_t)b * 2 + 1) * 256 + chunk) * DM + ch); h[0] = c[0]; h[1] = c[1]; h[2] = c[2]; h[3] = c[3]; }
#pragma unroll
        for (int s = 31; s >= 0; --s) { const size_t tokoff = ((size_t)b * SEQ + chunk * 32 + s) * DM + ch; const size_t off = (size_t)NTOK * DM + tokoff;
            const u32x2 lw = *(const u32x2*)(LA + off), bw = *(const u32x2*)(BB + off), gw = *(const u32x2*)(GB + tokoff);
            const float l4[4] = {bflo(lw.x), bfhi(lw.x), bflo(lw.y), bfhi(lw.y)}, b4[4] = {bflo(bw.x), bfhi(bw.x), bflo(bw.y), bfhi(bw.y)}, g4[4] = {bflo(gw.x), bfhi(gw.x), bflo(gw.y), bfhi(gw.y)};
            float y[4];
#pragma unroll
            for (int i = 0; i < 4; ++i) { h[i] = __expf(l4[i]) * h[i] + b4[i]; y[i] = gelu_tanh(g4[i]) * (hf[s][i] + h[i]); }
            u32x2 w; w.x = pk2(y[0], y[1]); w.y = pk2(y[2], y[3]); *(u32x2*)(YG + tokoff) = w; } }
}

#define KARGS() (*(const __attribute__((address_space(4))) Args*)__builtin_amdgcn_kernarg_segment_ptr())
#define PHASE_FN __device__ __forceinline__ void
#define PH_PRE() KArgs a = KARGS(); LAS unsigned char* lds = (LAS unsigned char*)lds_raw; unsigned char* ws = a.ws; asm volatile("" : "+s"(ws)); const int G = gridDim.x, bx = blockIdx.x; (void)lds; (void)ws; (void)G; (void)bx; using namespace pg8
PHASE_FN ph0() { PH_PRE(); phase_prologue(a, lds); }
PHASE_FN ph1a() { PH_PRE(); Gemm g{(const bf16_t*)(ws + A_W4T), (const bf16_t*)(ws + A_H3B), 128, 128, 128}; StaticOrder S; S.init(4096, 8192, G, bx); EpiFilt E{(float*)(ws + A_KTD)}; gemm_phase(lds, g, S, E); }
PHASE_FN ph1b() { PH_PRE(); Gemm g{(const bf16_t*)(ws + A_XB), (const bf16_t*)(ws + WS_WIN_EV) + (size_t)3072 * DM, DM, DM, DM}; StaticOrder S; S.init(NTOK, 3072, G, bx);
                  EpiBf16 E{(bf16_t*)(ws + A_QB), 1024, 1024, (size_t)(A_KB - A_QB) / 2, QSCALE}; gemm_phase(lds, g, S, E); }
PHASE_FN ph1c() { PH_PRE(); Gemm g{(const bf16_t*)(ws + WS_WIN_EV), (const bf16_t*)(ws + A_XB), DM, DM, DM}; StaticOrder S; S.init(3072, NTOK, G, bx);
                  EpiBf16 E{(bf16_t*)(ws + A_UHT), NTOK, 0, 0, 1.f}; gemm_phase(lds, g, S, E); }
PHASE_FN ph2() { PH_PRE(); phase_filter_fft(a, lds); phase_qknorm(a, lds); }
PHASE_FN ph3a() { PH_PRE(); phase_hyena_mixer(a, lds); }
PHASE_FN ph3b() { PH_PRE(); phase_attention(a, lds); }
PHASE_FN ph4() { PH_PRE(); phase_concat(a, lds); }
PHASE_FN ph5() { PH_PRE(); Gemm g{(const bf16_t*)(ws + A_YCAT), (const bf16_t*)(ws + WS_WOUT_EV), DM, DM, DM}; StaticOrder S; S.init(NTOK, DM, G, bx);
                 EpiResF32 E{a.in[0], (float*)(ws + A_R0), DM, DN_ALPHA}; gemm_phase(lds, g, S, E); }
template <int LAYER> PHASE_FN ph_lnr() { PH_PRE(); unsigned* ctl = (unsigned*)(ws + WS_CTL);
    phase_ln_router(a, lds, (const float*)(ws + (LAYER ? A_R1 : A_R0)), a.in[28] + LAYER * DM, a.in[29] + LAYER * DM, (bf16_t*)(ws + (LAYER ? A_HB_1 : A_HB_0)),
                    ctl + CW_CNT + LAYER * 32 * 64, (int*)(ws + A_ROWL), (float*)(ws + A_GATEW)); }
template <int LAYER> PHASE_FN ph_moe1() { PH_PRE(); LAS int* tab = (LAS int*)(lds + LDS_MISC); moe_table(tab, (const unsigned*)(ws + WS_CTL) + CW_CNT + LAYER * 32 * 64);
    Gemm g{(const bf16_t*)(ws + (LAYER ? A_HB_1 : A_HB_0)), (const bf16_t*)(ws + WS_W1T) + (size_t)LAYER * 32 * 1024 * DM, DM, DM, DM}; MoeOrder<4, true> S{G, bx, tab, (const int*)(ws + A_ROWL)};
    EpiSwiglu E{(bf16_t*)(ws + (LAYER ? A_HID_1 : A_HID_0))}; gemm_phase(lds, g, S, E); }
template <int LAYER> PHASE_FN ph_moe2() { PH_PRE(); LAS int* tab = (LAS int*)(lds + LDS_MISC); moe_table(tab, (const unsigned*)(ws + WS_CTL) + CW_CNT + LAYER * 32 * 64);
    Gemm g{(const bf16_t*)(ws + (LAYER ? A_HID_1 : A_HID_0)), (const bf16_t*)(ws + WS_W2T) + (size_t)LAYER * 32 * DM * DFF, DFF, DFF, DFF}; MoeOrder<8, false> S{G, bx, tab, (const int*)(ws + A_ROWL)};
    EpiDown E{(bf16_t*)(ws + (LAYER ? A_Y2_1 : A_Y2_0)), (const int*)(ws + A_ROWL), (const float*)(ws + A_GATEW)}; gemm_phase(lds, g, S, E); }
template <int LAYER> PHASE_FN ph_ln2() { PH_PRE();
    phase_ln2((const bf16_t*)(ws + (LAYER ? A_HB_1 : A_HB_0)), (const bf16_t*)(ws + (LAYER ? A_Y2_1 : A_Y2_0)), a.in[30] + LAYER * DM, a.in[31] + LAYER * DM, LAYER ? a.out : nullptr, LAYER ? nullptr : (bf16_t*)(ws + A_HB2)); }
PHASE_FN ph10() { PH_PRE(); Gemm g{(const bf16_t*)(ws + A_HB2), (const bf16_t*)(ws + WS_WIN_OD), DM, DM, DM}; StaticOrder S; S.init(NTOK, 2 * DM, G, bx);
                  EpiBf16 E{(bf16_t*)(ws + A_GB), DM, DM, (size_t)(A_XR - A_GB) / 2, 1.f}; gemm_phase(lds, g, S, E); }
PHASE_FN ph11() { PH_PRE(); phase_conv4(a); }
PHASE_FN ph12() { PH_PRE(); Gemm g{(const bf16_t*)(ws + A_XC), (const bf16_t*)(ws + WS_WG_OD), DM, 256, 256}; RGOrder S{G, bx};
                  EpiRG E{(bf16_t*)(ws + A_LA), (bf16_t*)(ws + A_BB), (const bf16_t*)(ws + A_XC), a.in[23], a.in[25], a.in[26]}; gemm_phase(lds, g, S, E); }
PHASE_FN ph13() { PH_PRE(); phase_scan1(a); }
PHASE_FN ph14() { PH_PRE(); phase_scan2(a); }
PHASE_FN ph15() { PH_PRE(); phase_scan3(a); }
PHASE_FN ph16() { PH_PRE(); Gemm g{(const bf16_t*)(ws + A_YG), (const bf16_t*)(ws + WS_WOUT_OD), DM, DM, DM}; StaticOrder S; S.init(NTOK, DM, G, bx);
                  EpiResBf E{(const bf16_t*)(ws + A_HB2), (float*)(ws + A_R1), DM, DN_ALPHA}; gemm_phase(lds, g, S, E); }

__global__ void __launch_bounds__(512, 2) fwd(Args a) {
    LAS unsigned char* lds = (LAS unsigned char*)lds_raw;
    unsigned* ctl = (unsigned*)(a.ws + WS_CTL);
    volatile LAS unsigned* bst = (volatile LAS unsigned*)(lds + LDS_MISC + 2048);
    { const int tid = threadIdx.x;
      if ((tid & 63) == 0) ((LAS int*)(lds + LDS_WIDTAB))[hw_slot()] = tid >> 6;
      if (tid < 4) bst[tid] = 0u; }
    __syncthreads();
    const int lo = a.ph_lo, hi = a.ph_hi;
    XcdBarrier bar; bar.bar = ctl + CW_BAR; bar.x = 0; bar.st = bst;
    if (hi - lo > 1) bar = xcd_barrier_post(ctl + CW_BAR, bst);
#ifdef ONLY_PHASE
#define IN(k) ((k) == ONLY_PHASE && lo <= (k) && (k) < hi)
#else
#define IN(k) (lo <= (k) && (k) < hi)
#endif
#define SEAM(k) do { if (IN(k) && IN((k) + 1)) xcd_barrier(bar); } while (0)
    if (IN(0)) { asm volatile("; PHASE_MARK 0"); ph0(); } SEAM(0);
    if (IN(1)) { asm volatile("; PHASE_MARK 1a"); ph1a(); asm volatile("; PHASE_MARK 1b"); ph1b(); asm volatile("; PHASE_MARK 1c"); ph1c(); } SEAM(1);
    if (IN(2)) { asm volatile("; PHASE_MARK 2"); ph2(); } SEAM(2);
    if (IN(3)) { asm volatile("; PHASE_MARK 3a"); ph3a(); asm volatile("; PHASE_MARK 3b"); ph3b(); } SEAM(3);
    if (IN(4)) { asm volatile("; PHASE_MARK 4"); ph4(); } SEAM(4);
    if (IN(5)) { asm volatile("; PHASE_MARK 5"); ph5(); } SEAM(5);
    if (IN(6)) { asm volatile("; PHASE_MARK 6"); ph_lnr<0>(); } SEAM(6);
    if (IN(7)) { asm volatile("; PHASE_MARK 7"); ph_moe1<0>(); } SEAM(7);
    if (IN(8)) { asm volatile("; PHASE_MARK 8"); ph_moe2<0>(); } SEAM(8);
    if (IN(9)) { asm volatile("; PHASE_MARK 9"); ph_ln2<0>(); } SEAM(9);
    if (IN(10)) { asm volatile("; PHASE_MARK 10"); ph10(); } SEAM(10);
    if (IN(11)) { asm volatile("; PHASE_MARK 11"); ph11(); } SEAM(11);
    if (IN(12)) { asm volatile("; PHASE_MARK 12"); ph12(); } SEAM(12);
    if (IN(13)) { asm volatile("; PHASE_MARK 13"); ph13(); } SEAM(13);
    if (IN(14)) { asm volatile("; PHASE_MARK 14"); ph14(); } SEAM(14);
    if (IN(15)) { asm volatile("; PHASE_MARK 15"); ph15(); } SEAM(15);
    if (IN(16)) { asm volatile("; PHASE_MARK 16"); ph16(); } SEAM(16);
    if (IN(17)) { asm volatile("; PHASE_MARK 17"); ph_lnr<1>(); } SEAM(17);
    if (IN(18)) { asm volatile("; PHASE_MARK 18"); ph_moe1<1>(); } SEAM(18);
    if (IN(19)) { asm volatile("; PHASE_MARK 19"); ph_moe2<1>(); } SEAM(19);
    if (IN(20)) { asm volatile("; PHASE_MARK 20"); ph_ln2<1>(); }
#undef IN
#undef SEAM
}

#ifndef MK_PER_PHASE
#define MK_PER_PHASE 0
#endif
extern "C" void kernel_launch(void* const* d_in, const int* in_sizes, int n_in, void* d_out, int out_size, void* d_ws, size_t ws_size, hipStream_t stream) {
    static int grid = 0;
    if (grid == 0) {
        if (n_in != 37 || out_size != NTOK * DM || ws_size < WS_END) { fprintf(stderr, "kernel_launch: built for 37 inputs, %d outputs, >= %zu bytes of workspace; got n_in %d out %d ws %zu\n", NTOK * DM, (size_t)WS_END, n_in, out_size, ws_size); grid = -1; return; }
        int dev = 0, cus = 0, per_cu = 0;
        if (hipGetDevice(&dev) != hipSuccess || hipDeviceGetAttribute(&cus, hipDeviceAttributeMultiprocessorCount, dev) != hipSuccess) { grid = -1; return; }
        if (hipFuncSetAttribute((const void*)fwd, hipFuncAttributeMaxDynamicSharedMemorySize, LDS_BYTES) != hipSuccess) { fprintf(stderr, "kernel_launch: hipFuncSetAttribute failed\n"); grid = -1; return; }
        if (hipOccupancyMaxActiveBlocksPerMultiprocessor(&per_cu, (const void*)fwd, 512, LDS_BYTES) != hipSuccess || per_cu < 1) fprintf(stderr, "kernel_launch: occupancy query reports %d\n", per_cu);
        (void)hipGetLastError();
        grid = cus;
    }
    if (grid < 0) return;
    (void)hipMemsetAsync((char*)d_ws + WS_CTL, 0, CTL_ZERO_BYTES, stream);
    Args a{};
    for (int i = 0; i < 37; ++i) a.in[i] = (const float*)d_in[i];
    a.out = (float*)d_out; a.ws = (unsigned char*)d_ws;
#if MK_PER_PHASE
    for (int p = 0; p < NPHASE; ++p) { a.ph_lo = p; a.ph_hi = p + 1; hipLaunchKernelGGL(fwd, dim3(grid), dim3(512), LDS_BYTES, stream, a); }
#else
    a.ph_lo = 0; a.ph_hi = NPHASE; hipLaunchKernelGGL(fwd, dim3(grid), dim3(512), LDS_BYTES, stream, a);
#endif
}
```

```cpp
#include <hip/hip_runtime.h>
#include <hip/hip_fp16.h>
#include <cstdio>
#include <cstdint>

#define GAS __attribute__((address_space(1)))
#define LAS __attribute__((address_space(3)))
typedef unsigned short bf16_t;
typedef short bf16x8 __attribute__((ext_vector_type(8)));
typedef short s16x4 __attribute__((ext_vector_type(4)));
typedef float f32x2 __attribute__((ext_vector_type(2)));
typedef float f32x4 __attribute__((ext_vector_type(4)));
typedef float f32x8 __attribute__((ext_vector_type(8)));
typedef float f32x16 __attribute__((ext_vector_type(16)));
typedef unsigned u32x2 __attribute__((ext_vector_type(2)));
typedef unsigned u32x4 __attribute__((ext_vector_type(4)));
typedef GAS unsigned gu32;

constexpr int DM = 2048, BATCH = 2, SEQ = 8192, NTOK = BATCH * SEQ;
constexpr int HY_CH = 1024, EV_IN = 6144;
constexpr int NEXP = 32, DFF = 512, NASSIGN = NTOK * 2, ECAP = NASSIGN;
constexpr float LN_EPS = 1e-5f;
constexpr float DN_ALPHA = 1.4142135623730951f;
constexpr float QSCALE = 0.125f * 1.4426950408889634f;
constexpr int FFT_N = 16384, FFT_RS = 528;

__device__ __forceinline__ unsigned f2bf(float f) { unsigned u = __builtin_bit_cast(unsigned, f); return (u + 0x7fffu + ((u >> 16) & 1u)) >> 16; }
__device__ __forceinline__ unsigned pk2(float lo, float hi) { return f2bf(lo) | (f2bf(hi) << 16); }
__device__ __forceinline__ float bf2f(unsigned short h) { return __builtin_bit_cast(float, (unsigned)h << 16); }
__device__ __forceinline__ float bflo(unsigned w) { return __builtin_bit_cast(float, w << 16); }
__device__ __forceinline__ float bfhi(unsigned w) { return __builtin_bit_cast(float, w & 0xffff0000u); }
__device__ __forceinline__ unsigned cvt_pk_bf16(float lo, float hi) { unsigned r; asm volatile("v_cvt_pk_bf16_f32 %0, %1, %2" : "=v"(r) : "v"(lo), "v"(hi)); return r; }
__device__ __forceinline__ float wave_sum(float v) {
#pragma unroll
    for (int o = 1; o < 64; o <<= 1) v += __shfl_xor(v, o);
    return v;
}
__device__ __forceinline__ float sigmoidf_(float x) { return __builtin_amdgcn_rcpf(1.0f + __builtin_amdgcn_exp2f(-1.4426950408889634f * x)); }
constexpr int LDS_WIDTAB = 139264 + 3072;
__device__ __forceinline__ int hw_slot() { return (int)(__builtin_amdgcn_s_getreg((5 << 11) | 4) & 63u); }
__device__ __forceinline__ int lane_id() { return (int)__builtin_amdgcn_mbcnt_hi(~0u, __builtin_amdgcn_mbcnt_lo(~0u, 0u)); }
extern __shared__ __attribute__((aligned(16))) unsigned char lds_raw[];
__device__ __forceinline__ int wave_id() { return __builtin_amdgcn_readfirstlane(((const LAS int*)((LAS unsigned char*)lds_raw + LDS_WIDTAB))[hw_slot()]); }
__device__ __forceinline__ int opaque_tid() { int t = wave_id() * 64 + lane_id(); asm volatile("" : "+v"(t)); return t; }
#define LDS_WAIT() asm volatile("s_waitcnt lgkmcnt(0)" ::: "memory")
#define VM_WAIT() asm volatile("s_waitcnt vmcnt(0)" ::: "memory")

#define XB_TMO      128
#define XB_XCNT(j)  (256  + 64 * (j))
#define XB_XSUB(j)  (1280 + 64 * (j))
#define XB_XGEN(j)  (2304 + 64 * (j))
#define XB_TOP      3328
#define XB_TOPGEN   3392
#define XCD_BAR_WORDS 3456
#define XB_SPIN_CAP (1u << 18)
__device__ __forceinline__ unsigned xb_ld(unsigned* p)              { return __hip_atomic_load(p, __ATOMIC_RELAXED, __HIP_MEMORY_SCOPE_AGENT); }
__device__ __forceinline__ unsigned xb_add(unsigned* p, unsigned v) { return __hip_atomic_fetch_add(p, v, __ATOMIC_RELAXED, __HIP_MEMORY_SCOPE_AGENT); }
__device__ __forceinline__ unsigned xb_xcc_id() { return (unsigned)__builtin_amdgcn_s_getreg((3 << 11) | 20) & 0xFu; }
#define XB_SPIN(cond, bar) do { unsigned _sp = 0; while (cond) { __builtin_amdgcn_s_sleep(1); \
    if ((++_sp & 255u) == 0u) { if (xb_ld(&(bar)[XB_TMO])) break; if (_sp > XB_SPIN_CAP) { atomicAdd(&(bar)[XB_TMO], 1u); break; } } } } while (0)
struct XcdBarrier { unsigned* bar; unsigned x; volatile LAS unsigned* st; };
__device__ __forceinline__ XcdBarrier xcd_barrier_post(unsigned* bar, volatile LAS unsigned* st) {
    XcdBarrier b; b.bar = bar; b.x = xb_xcc_id(); b.st = st;
    if (opaque_tid() == 0) (void)xb_add(&bar[XB_XCNT(b.x)], 1u);
    return b;
}
__device__ __forceinline__ void xcd_barrier_complete(unsigned* bar, unsigned x, unsigned& nloc, unsigned& nx) {
    const unsigned G = gridDim.x * gridDim.y * gridDim.z;
    unsigned sum, cnt, mine, sp = 0u;
    for (;;) {
        sum = 0u; cnt = 0u; mine = 0u;
#pragma unroll
        for (unsigned j = 0; j < 16; ++j) { const unsigned c = xb_ld(&bar[XB_XCNT(j)]); sum += c; cnt += (c > 0u) ? 1u : 0u; mine = (j == x) ? c : mine; }
        if (sum == G) break;
        __builtin_amdgcn_s_sleep(1);
        if ((++sp & 255u) == 0u) { if (xb_ld(&bar[XB_TMO])) break; if (sp > XB_SPIN_CAP) { atomicAdd(&bar[XB_TMO], 1u); break; } }
    }
    nloc = mine > 0u ? mine : 1u; nx = cnt > 0u ? cnt : 1u;
}
__device__ __forceinline__ void xcd_barrier(const XcdBarrier& b) {
    asm volatile("s_waitcnt vmcnt(0)" ::: "memory");
    __syncthreads();
    if (opaque_tid() == 0) {
        unsigned* bar = b.bar;
        __builtin_amdgcn_s_waitcnt(0);
        unsigned nloc = b.st[0], nx = b.st[1];
        if (nloc == 0u) { xcd_barrier_complete(bar, b.x, nloc, nx); b.st[0] = nloc; b.st[1] = nx; }
        const unsigned old = xb_add(&bar[XB_XSUB(b.x)], 1u);
        const unsigned gen = old / nloc;
        if (old + 1u == (gen + 1u) * nloc) {
            __builtin_amdgcn_fence(__ATOMIC_RELEASE, "agent");
            asm volatile("s_waitcnt vmcnt(0)" ::: "memory");
            const unsigned og = xb_add(&bar[XB_TOP], 1u);
            const unsigned tg = og / nx;
            if (og + 1u == (tg + 1u) * nx) xb_add(&bar[XB_TOPGEN], 1u);
            else XB_SPIN(xb_ld(&bar[XB_TOPGEN]) == tg, bar);
            __builtin_amdgcn_fence(__ATOMIC_ACQUIRE, "agent");
            xb_add(&bar[XB_XGEN(b.x)], 1u);
            asm volatile("s_waitcnt vmcnt(0)" ::: "memory");
        } else {
            XB_SPIN(xb_ld(&bar[XB_XGEN(b.x)]) == gen, bar);
            __builtin_amdgcn_fence(__ATOMIC_ACQUIRE, "agent");
            asm volatile("s_waitcnt vmcnt(0)" ::: "memory");
        }
    }
    __syncthreads();
}

namespace pg8 {
constexpr int BM = 256, BK = 64, HALF = 128, HTB = HALF * BK * 2, STAGE_BYTES = 8 * HTB, NXCD = 8, WGM = 8;
__host__ __device__ __forceinline__ int lds_byte(int r, int c) { const int st = (r >> 4) * 2 + (c >> 5), rr = r & 15, cc = c & 31, ob = rr * 64 + cc * 2; return st * 1024 + (ob ^ (((ob >> 9) & 1) << 5)); }
__host__ __device__ __forceinline__ void stage_rc(int b, int& R, int& C) { const int st = b / 1024, sb = b % 1024, swz = sb ^ (((sb >> 9) & 1) << 5); R = (st >> 1) * 16 + swz / 64; C = (st & 1) * 32 + (swz % 64) / 2; }
__host__ __device__ __forceinline__ int perm32(int rho) { const int n = rho >> 4, i = rho & 15; return 8 * (i >> 2) + 4 * n + (i & 3); }

struct Unit { int pm, pn, e, t, cnt; };
struct Gemm { const bf16_t* A; const bf16_t* Bt; int lda, ldb, K; };

struct StaticOrder {
    static constexpr bool GATHER_A = false;
    int nM, nN, nwg, G, c;
    __device__ void init(int M, int N, int G_, int c_) { nM = M / BM; nN = N / BM; nwg = nM * nN; G = G_; c = c_; }
    __device__ __forceinline__ bool next(int i, Unit& u) const {
        const long L = (long)i * G + c; if (L >= nwg) return false;
        int wgid = (int)L; { const int q = nwg / NXCD, r = nwg % NXCD, xcd = wgid % NXCD, off = wgid / NXCD; wgid = (xcd < r ? xcd * (q + 1) : r * (q + 1) + (xcd - r) * q) + off; }
        const int nig = WGM * nN, gid = wgid / nig, fm = gid * WGM, gsz = (nM - fm) < WGM ? (nM - fm) : WGM;
        u.pm = fm + ((wgid % nig) % gsz); u.pn = (wgid % nig) / gsz; u.e = 0; u.t = 0; u.cnt = 0; return true;
    }
    __device__ __forceinline__ int rowA(const Unit& u, int r) const { return u.pm * BM + r; }
    __device__ __forceinline__ int colA(const Unit&) const { return 0; }
    __device__ __forceinline__ int rowB(const Unit& u, int r) const { return u.pn * BM + r; }
};

template <class Epi, class Sched>
__device__ __forceinline__ void gemm_phase(LAS unsigned char* lds, const Gemm g, const Sched& S, const Epi& E) {
    const int tid = opaque_tid(), wid = __builtin_amdgcn_readfirstlane(tid >> 6), lane = tid & 63, wr = wid >> 2, wc = wid & 3, fr = lane & 15, fq = lane >> 4;
    const int K = g.K, nt = K / BK;
    constexpr bool GA = Sched::GATHER_A;
    int sR[2], sC[2];
    unsigned laneA[2], laneB[2];
#pragma unroll
    for (int i = 0; i < 2; ++i) { int R, C; stage_rc(tid * 16 + i * 8192, R, C); sR[i] = R; sC[i] = C; const int Rb = Epi::PERM ? ((R & ~31) + perm32(R & 31)) : R;
        laneA[i] = (unsigned)(R * g.lda + C) * 2u; laneB[i] = (unsigned)(Rb * g.ldb + C) * 2u; }
    const size_t hstepA = (size_t)HALF * g.lda * 2, hstepB = (size_t)HALF * g.ldb * 2;
    const unsigned ldsw = (unsigned)wid * 1024u;
    const int aoff = lds_byte(wr * 64 + fr, fq * 8), boff = lds_byte(wc * 32 + fr, fq * 8);
    const char* gA = (const char*)g.A; const char* gB = (const char*)g.Bt;
#define PG8_SA(b, h) (((b) * 2 + (h)) * HTB)
#define PG8_SB(b, h) ((4 + (b) * 2 + (h)) * HTB)
#define PG8_STAGE(bufoff, gptr, voff) do { _Pragma("unroll") for (int _i = 0; _i < 2; ++_i) \
        __builtin_amdgcn_global_load_lds((const unsigned*)((gptr) + (size_t)(voff)[_i]), (LAS unsigned*)(lds + (bufoff) + ldsw + _i * 8192), 16, 0, 0); } while (0)
#define PG8_STAGE_B(bufoff, ub, h, kb) PG8_STAGE(bufoff, gB + (ub) + (size_t)(h) * hstepB + (size_t)(kb), laneB)
#define PG8_STAGE_A(bufoff, ub, va, h, kb) do { if constexpr (GA) { PG8_STAGE(bufoff, gA + (size_t)(kb), va[h]); } else { PG8_STAGE(bufoff, gA + (ub) + (size_t)(h) * hstepA + (size_t)(kb), laneA); } } while (0)
#define PG8_LDA(dst, b, h) do { _Pragma("unroll") for (int m = 0; m < 4; ++m) _Pragma("unroll") for (int k = 0; k < 2; ++k) dst[m][k] = *(const LAS bf16x8*)(lds + PG8_SA(b, h) + aoff + m * 2048 + k * 1024); } while (0)
#define PG8_LDB(dst, b, h) do { _Pragma("unroll") for (int n = 0; n < 2; ++n) _Pragma("unroll") for (int k = 0; k < 2; ++k) dst[n][k] = *(const LAS bf16x8*)(lds + PG8_SB(b, h) + boff + n * 2048 + k * 1024); } while (0)
#define PG8_MMA(ai, bj, At, Bt) do { __builtin_amdgcn_s_setprio(1); _Pragma("unroll") for (int m = 0; m < 4; ++m) _Pragma("unroll") for (int n = 0; n < 2; ++n) _Pragma("unroll") for (int k = 0; k < 2; ++k) \
        acc[ai][bj][m][n] = __builtin_amdgcn_mfma_f32_16x16x32_bf16(Bt[n][k], At[m][k], acc[ai][bj][m][n], 0, 0, 0); __builtin_amdgcn_s_setprio(0); } while (0)
#define PG8_WAIT_V(n) asm volatile("s_waitcnt vmcnt(" #n ")" ::: "memory")
#define PG8_WAIT_L(n) asm volatile("s_waitcnt lgkmcnt(" #n ")" ::: "memory")
#define PG8_BAR __builtin_amdgcn_s_barrier()
#define PG8_SCHED __builtin_amdgcn_sched_barrier(0)
#define PG8_OFFS(u, ubA, ubB, vA) do { ubB = ((size_t)S.rowB(u, 0) * (size_t)g.ldb) * 2; \
        if constexpr (GA) { ubA = 0; _Pragma("unroll") for (int _h = 0; _h < 2; ++_h) _Pragma("unroll") for (int _i = 0; _i < 2; ++_i) vA[_h][_i] = ((unsigned)S.rowA(u, _h * HALF + sR[_i]) * (unsigned)g.lda + (unsigned)sC[_i]) * 2u; } \
        else { ubA = ((size_t)S.rowA(u, 0) * (size_t)g.lda + (size_t)S.colA(u)) * 2; } } while (0)
    Unit cur, nxt; int ui = 0;
    if (!S.next(0, cur)) return;
    f32x4 acc[2][2][4][2];
#pragma unroll
    for (int a = 0; a < 2; ++a)
#pragma unroll
        for (int b = 0; b < 2; ++b)
#pragma unroll
            for (int m = 0; m < 4; ++m)
#pragma unroll
                for (int n = 0; n < 2; ++n) acc[a][b][m][n] = (f32x4){0.f, 0.f, 0.f, 0.f};
    bf16x8 At[4][2], B0[2][2], B1[2][2];
    size_t ubAc, ubBc, ubAn, ubBn; unsigned vAc[2][2] = {}, vAn[2][2] = {};
    PG8_OFFS(cur, ubAc, ubBc, vAc);
    PG8_STAGE_B(PG8_SB(0, 0), ubBc, 0, 0); PG8_STAGE_B(PG8_SB(0, 1), ubBc, 1, 0); PG8_STAGE_A(PG8_SA(0, 0), ubAc, vAc, 0, 0); PG8_STAGE_A(PG8_SA(0, 1), ubAc, vAc, 1, 0);
    if (wr == 1) PG8_BAR;
    PG8_WAIT_V(2); PG8_BAR;
    PG8_STAGE_B(PG8_SB(1, 0), ubBc, 0, 128); PG8_STAGE_A(PG8_SA(1, 0), ubAc, vAc, 0, 128); PG8_STAGE_B(PG8_SB(1, 1), ubBc, 1, 128);
    PG8_WAIT_V(6); PG8_BAR;
    for (;;) {
        const bool has_next = S.next(ui + 1, nxt);
        if (has_next) { PG8_OFFS(nxt, ubAn, ubBn, vAn); }
        else { ubAn = ubAc; ubBn = ubBc;
#pragma unroll
            for (int h = 0; h < 2; ++h)
#pragma unroll
                for (int i = 0; i < 2; ++i) vAn[h][i] = vAc[h][i]; }
        for (int t = 0; t < nt; t += 2) {
            const bool last = (t == nt - 2);
            const unsigned k1 = (unsigned)(t + 1) * 128u, k2 = last ? 0u : (unsigned)(t + 2) * 128u, k3 = k2 + 128u;
            const size_t xubA = last ? ubAn : ubAc, xubB = last ? ubBn : ubBc;
            unsigned xA[2][2];
#pragma unroll
            for (int h = 0; h < 2; ++h)
#pragma unroll
                for (int i = 0; i < 2; ++i) xA[h][i] = last ? vAn[h][i] : vAc[h][i];
            PG8_LDB(B0, 0, 0); PG8_LDB(B1, 0, 1); PG8_SCHED; PG8_LDA(At, 0, 0); PG8_STAGE_A(PG8_SA(1, 1), ubAc, vAc, 1, k1);
            PG8_WAIT_V(8); PG8_WAIT_L(0); PG8_BAR; PG8_MMA(0, 0, At, B0); PG8_MMA(0, 1, At, B1); PG8_BAR; PG8_SCHED;
            PG8_LDA(At, 0, 1); PG8_STAGE_B(PG8_SB(0, 0), xubB, 0, k2); PG8_STAGE_B(PG8_SB(0, 1), xubB, 1, k2); PG8_STAGE_A(PG8_SA(0, 0), xubA, xA, 0, k2);
            PG8_WAIT_V(8); PG8_WAIT_L(0); PG8_BAR; PG8_MMA(1, 0, At, B0); PG8_MMA(1, 1, At, B1); PG8_BAR; PG8_SCHED;
            PG8_LDB(B0, 1, 0); PG8_LDB(B1, 1, 1); PG8_SCHED; PG8_LDA(At, 1, 0); PG8_STAGE_A(PG8_SA(0, 1), xubA, xA, 1, k2);
            PG8_WAIT_V(8); PG8_WAIT_L(0); PG8_BAR; PG8_MMA(0, 0, At, B0); PG8_MMA(0, 1, At, B1); PG8_BAR; PG8_SCHED;
            PG8_LDA(At, 1, 1); PG8_STAGE_B(PG8_SB(1, 0), xubB, 0, k3); PG8_STAGE_B(PG8_SB(1, 1), xubB, 1, k3); PG8_STAGE_A(PG8_SA(1, 0), xubA, xA, 0, k3);
            PG8_WAIT_V(8); PG8_WAIT_L(0); PG8_BAR; PG8_MMA(1, 0, At, B0); PG8_MMA(1, 1, At, B1); PG8_BAR; PG8_SCHED;
        }
        if (wr == 0) PG8_BAR;
        E(acc, cur, wr, wc, fr, fq);
        if (!has_next) break;
#pragma unroll
        for (int a = 0; a < 2; ++a)
#pragma unroll
            for (int b = 0; b < 2; ++b)
#pragma unroll
                for (int m = 0; m < 4; ++m)
#pragma unroll
                    for (int n = 0; n < 2; ++n) acc[a][b][m][n] = (f32x4){0.f, 0.f, 0.f, 0.f};
        cur = nxt; ++ui; ubAc = ubAn; ubBc = ubBn;
#pragma unroll
        for (int h = 0; h < 2; ++h)
#pragma unroll
            for (int i = 0; i < 2; ++i) vAc[h][i] = vAn[h][i];
        if (wr == 1) PG8_BAR;
    }
    PG8_WAIT_V(0);
    PG8_BAR;
#undef PG8_SA
#undef PG8_SB
#undef PG8_STAGE
#undef PG8_STAGE_A
#undef PG8_STAGE_B
#undef PG8_LDA
#undef PG8_LDB
#undef PG8_MMA
#undef PG8_WAIT_V
#undef PG8_WAIT_L
#undef PG8_BAR
#undef PG8_SCHED
#undef PG8_OFFS
}
}
namespace pg8 {
struct EpiBf16 {
    static constexpr bool PERM = true;
    bf16_t* O; int ldc; int split_cols; size_t split_stride; float scale0;
    __device__ __forceinline__ void operator()(const f32x4 (&acc)[2][2][4][2], const Unit& u, int wr, int wc, int fr, int fq) const {
        const int row0 = u.pm * BM + wr * 64 + fr; int colt = u.pn * BM; bf16_t* base = O;
        float sc = 1.f; if (split_cols) { const int t = colt / split_cols; base += (size_t)t * split_stride; colt -= t * split_cols; if (t == 0) sc = scale0; }
        const int col0 = colt + wc * 32 + 8 * fq;
#pragma unroll
        for (int ai = 0; ai < 2; ++ai)
#pragma unroll
            for (int m = 0; m < 4; ++m) { bf16_t* rowp = base + (size_t)(row0 + ai * HALF + m * 16) * ldc + col0;
#pragma unroll
                for (int bj = 0; bj < 2; ++bj) { const f32x4 v0 = acc[ai][bj][m][0] * sc, v1 = acc[ai][bj][m][1] * sc;
                    u32x4 w; w.x = cvt_pk_bf16(v0[0], v0[1]); w.y = cvt_pk_bf16(v0[2], v0[3]); w.z = cvt_pk_bf16(v1[0], v1[1]); w.w = cvt_pk_bf16(v1[2], v1[3]);
                    *(u32x4*)(rowp + bj * HALF) = w; } }
    }
};
struct EpiFilt {
    static constexpr bool PERM = true;
    bf16_t* O;
    __device__ __forceinline__ void operator()(const f32x4 (&acc)[2][2][4][2], const Unit& u, int wr, int wc, int fr, int fq) const {
        const float dmin = -3.0701134573253945f, dmax = -15.350567286626973f;
#pragma unroll
        for (int ai = 0; ai < 2; ++ai)
#pragma unroll
            for (int m = 0; m < 4; ++m) { const int row = u.pm * BM + ai * HALF + wr * 64 + m * 16 + fr; const int c = row & 1023;
                const float dl2 = fabsf(dmin + (float)c * ((dmax - dmin) / 1023.0f)) * (1.4426950408889634f / 8191.0f);
#pragma unroll
                for (int bj = 0; bj < 2; ++bj) { const int col = u.pn * BM + bj * HALF + wc * 32 + 8 * fq; float v[8];
#pragma unroll
                    for (int n = 0; n < 2; ++n)
#pragma unroll
                        for (int j = 0; j < 4; ++j) v[n * 4 + j] = acc[ai][bj][m][n][j] * __builtin_amdgcn_exp2f(-(float)(col + n * 4 + j) * dl2);
                    u32x4 w; w.x = cvt_pk_bf16(v[0], v[1]); w.y = cvt_pk_bf16(v[2], v[3]); w.z = cvt_pk_bf16(v[4], v[5]); w.w = cvt_pk_bf16(v[6], v[7]);
                    *(u32x4*)(O + (size_t)row * 8192 + col) = w; }
                asm volatile("" ::: "memory"); }
    }
};
struct EpiResF32 {
    static constexpr bool PERM = false;
    const float* res; float* O; int ldc; float alpha;
    __device__ __forceinline__ void operator()(const f32x4 (&acc)[2][2][4][2], const Unit& u, int wr, int wc, int fr, int fq) const {
#pragma unroll
        for (int ai = 0; ai < 2; ++ai)
#pragma unroll
            for (int m = 0; m < 4; ++m) { const size_t off = (size_t)(u.pm * BM + ai * HALF + wr * 64 + m * 16 + fr) * ldc + u.pn * BM + wc * 32 + 4 * fq;
#pragma unroll
                for (int bj = 0; bj < 2; ++bj)
#pragma unroll
                    for (int n = 0; n < 2; ++n) { const f32x4 r = *(const f32x4*)(res + off + bj * HALF + n * 16); *(f32x4*)(O + off + bj * HALF + n * 16) = r * alpha + acc[ai][bj][m][n]; }
                if (m & 1) asm volatile("" ::: "memory"); }
    }
};
struct EpiResBf {
    static constexpr bool PERM = true;
    const bf16_t* res; bf16_t* O; int ldc; float alpha;
    __device__ __forceinline__ void operator()(const f32x4 (&acc)[2][2][4][2], const Unit& u, int wr, int wc, int fr, int fq) const {
#pragma unroll
        for (int ai = 0; ai < 2; ++ai)
#pragma unroll
            for (int m = 0; m < 4; ++m) { const size_t off = (size_t)(u.pm * BM + ai * HALF + wr * 64 + m * 16 + fr) * ldc + u.pn * BM + wc * 32 + 8 * fq;
#pragma unroll
                for (int bj = 0; bj < 2; ++bj) { const u32x4 r = *(const u32x4*)(res + off + bj * HALF); const f32x4 a0 = acc[ai][bj][m][0], a1 = acc[ai][bj][m][1];
                    u32x4 w; w.x = cvt_pk_bf16(bflo(r.x) * alpha + a0[0], bfhi(r.x) * alpha + a0[1]); w.y = cvt_pk_bf16(bflo(r.y) * alpha + a0[2], bfhi(r.y) * alpha + a0[3]);
                    w.z = cvt_pk_bf16(bflo(r.z) * alpha + a1[0], bfhi(r.z) * alpha + a1[1]); w.w = cvt_pk_bf16(bflo(r.w) * alpha + a1[2], bfhi(r.w) * alpha + a1[3]);
                    *(u32x4*)(O + off + bj * HALF) = w; }
                if (m & 1) asm volatile("" ::: "memory"); }
    }
};
struct EpiSwiglu {
    static constexpr bool PERM = true;
    bf16_t* O;
    __device__ __forceinline__ void operator()(const f32x4 (&acc)[2][2][4][2], const Unit& u, int wr, int wc, int fr, int fq) const {
#pragma unroll
        for (int ai = 0; ai < 2; ++ai)
#pragma unroll
            for (int m = 0; m < 4; ++m) { bf16_t* p = O + (size_t)(u.pm * BM + ai * HALF + wr * 64 + m * 16 + fr) * DFF + u.pn * HALF + wc * 32 + 8 * fq;
                float h[8];
#pragma unroll
                for (int n = 0; n < 2; ++n)
#pragma unroll
                    for (int j = 0; j < 4; ++j) { const float gt = acc[ai][0][m][n][j], up = acc[ai][1][m][n][j]; h[n * 4 + j] = gt * sigmoidf_(gt) * up; }
                u32x4 w; w.x = cvt_pk_bf16(h[0], h[1]); w.y = cvt_pk_bf16(h[2], h[3]); w.z = cvt_pk_bf16(h[4], h[5]); w.w = cvt_pk_bf16(h[6], h[7]);
                *(u32x4*)p = w; }
    }
};
struct EpiDown {
    static constexpr bool PERM = true;
    bf16_t* O; const int* rowlist; const float* gatew;
    __device__ __forceinline__ void operator()(const f32x4 (&acc)[2][2][4][2], const Unit& u, int wr, int wc, int fr, int fq) const {
#pragma unroll
        for (int ai = 0; ai < 2; ++ai)
#pragma unroll
            for (int m = 0; m < 4; ++m) { const int idx = u.t * BM + ai * HALF + wr * 64 + m * 16 + fr;
                if (idx < u.cnt) { const int a = rowlist[(size_t)u.e * ECAP + idx]; const float gw = gatew[a];
                    bf16_t* p = O + (size_t)a * DM + u.pn * BM + wc * 32 + 8 * fq;
#pragma unroll
                    for (int bj = 0; bj < 2; ++bj) { const f32x4 v0 = acc[ai][bj][m][0] * gw, v1 = acc[ai][bj][m][1] * gw;
                        u32x4 w; w.x = cvt_pk_bf16(v0[0], v0[1]); w.y = cvt_pk_bf16(v0[2], v0[3]); w.z = cvt_pk_bf16(v1[0], v1[1]); w.w = cvt_pk_bf16(v1[2], v1[3]);
                        *(u32x4*)(p + bj * HALF) = w; } } }
    }
};
struct EpiRG {
    static constexpr bool PERM = true;
    bf16_t* LA; bf16_t* BB; const bf16_t* XC; const float* ba; const float* bx; const float* lam;
    __device__ __forceinline__ void operator()(const f32x4 (&acc)[2][2][4][2], const Unit& u, int wr, int wc, int fr, int fq) const {
        const int nb = u.pn >> 2, q = u.pn & 3, dir = q >> 1, half = q & 1;
        const int ch0 = nb * 256 + half * HALF + wc * 32 + 8 * fq;
        float vba[8], vbx[8], vsp[8];
#pragma unroll
        for (int j = 0; j < 8; ++j) { vba[j] = ba[dir * DM + ch0 + j]; vbx[j] = bx[dir * DM + ch0 + j];
            const float x = __expf(-lam[dir * DM + ch0 + j]);
            vsp[j] = 8.0f * (x < 0.05f ? x * (1.0f - x * (0.5f - x * (0.33333334f - 0.25f * x))) : __logf(1.0f + x)); }
#pragma unroll
        for (int ai = 0; ai < 2; ++ai)
#pragma unroll
            for (int m = 0; m < 4; ++m) { const size_t tok = (size_t)(u.pm * BM + ai * HALF + wr * 64 + m * 16 + fr);
                asm volatile("" ::: "memory");
                const u32x4 xw = *(const u32x4*)(XC + tok * DM + ch0);
                float xf[8] = {bflo(xw.x), bfhi(xw.x), bflo(xw.y), bfhi(xw.y), bflo(xw.z), bfhi(xw.z), bflo(xw.w), bfhi(xw.w)};
                float la[8], bb[8];
#pragma unroll
                for (int n = 0; n < 2; ++n)
#pragma unroll
                    for (int j = 0; j < 4; ++j) { const int k = n * 4 + j;
                        const float r = sigmoidf_(acc[ai][0][m][n][j] + vba[k]), ig = sigmoidf_(acc[ai][1][m][n][j] + vbx[k]);
                        const float l = -r * vsp[k]; la[k] = l; bb[k] = __builtin_amdgcn_sqrtf(fmaxf(1.0f - __builtin_amdgcn_exp2f(2.8853900817779268f * l), 0.f)) * (ig * xf[k]); }
                u32x4 w; w.x = cvt_pk_bf16(la[0], la[1]); w.y = cvt_pk_bf16(la[2], la[3]); w.z = cvt_pk_bf16(la[4], la[5]); w.w = cvt_pk_bf16(la[6], la[7]);
                *(u32x4*)(LA + ((size_t)dir * NTOK + tok) * DM + ch0) = w;
                w.x = cvt_pk_bf16(bb[0], bb[1]); w.y = cvt_pk_bf16(bb[2], bb[3]); w.z = cvt_pk_bf16(bb[4], bb[5]); w.w = cvt_pk_bf16(bb[6], bb[7]);
                *(u32x4*)(BB + ((size_t)dir * NTOK + tok) * DM + ch0) = w; }
    }
};

struct RGOrder {
    static constexpr bool GATHER_A = false;
    int G, c;
    __device__ __forceinline__ bool next(int i, Unit& u) const {
        if (G == 256) { if (i >= 8) return false; const int x = c & 7, y = c >> 3; u.pm = i * 8 + (y >> 2); u.pn = x * 4 + (y & 3); }
        else { const int L = i * G + c; if (L >= 64 * 32) return false; u.pm = L >> 5; u.pn = L & 31; }
        u.e = 0; u.t = 0; u.cnt = 0; return true; }
    __device__ __forceinline__ int rowA(const Unit& u, int r) const { return u.pm * BM + r; }
    __device__ __forceinline__ int colA(const Unit& u) const { return (u.pn >> 2) * 256; }
    __device__ __forceinline__ int rowB(const Unit& u, int r) const { return u.pn * BM + r; }
};
template <int NPN, bool GATHER>
struct MoeOrder {
    static constexpr bool GATHER_A = GATHER;
    int G, c; const LAS int* tab; const int* rowlist;
    __device__ __forceinline__ bool next(int i, Unit& u) const {
        const int L = i * G + c, ntile = tab[32]; if (L >= ntile * NPN) return false;
        const int tile = L / NPN; u.pm = tile; u.pn = L % NPN; int e = 0;
        while (e < 31 && tab[e + 1] <= tile) ++e;
        u.e = e; u.t = tile - tab[e]; u.cnt = tab[64 + e]; return true;
    }
    __device__ __forceinline__ int rowA(const Unit& u, int r) const {
        if (GATHER) { const int idx = u.t * BM + r; const int a = idx < u.cnt ? rowlist[(size_t)u.e * ECAP + idx] : 0; return a >> 1; }
        return u.pm * BM + r;
    }
    __device__ __forceinline__ int colA(const Unit&) const { return 0; }
    __device__ __forceinline__ int rowB(const Unit& u, int r) const { return (u.e * NPN + u.pn) * BM + r; }
};
}
namespace att {
constexpr int NW = 8, QBLK = 32, KVBLK = 64, LDQ = 1024, LDK = 1024, LDV = 1024, LDO = 1024;
constexpr int SHM_V = KVBLK * 128 * 2, SHM_K = KVBLK * 64 * 2, NSLOT = 4, LDS_K = 0, LDS_V = NSLOT * SHM_K, LDS_WS = NSLOT * (SHM_K + SHM_V), SHM_ATTN = LDS_WS + NW * 64 * 4;
__device__ __forceinline__ void glds16s(const void* sbase, unsigned voff, unsigned lds_dst) { unsigned keep;
    asm volatile("s_mov_b32 %0, m0\n\ts_mov_b32 m0, %3\n\ts_nop 0\n\tglobal_load_lds_dwordx4 %1, %2\n\ts_mov_b32 m0, %0" : "=&s"(keep) : "v"(voff), "s"(sbase), "s"(lds_dst) : "memory"); }
#define WAITBAR(N) asm volatile("s_waitcnt vmcnt(" #N ") lgkmcnt(0)\n\ts_barrier" ::: "memory")
constexpr float THR2 = 8.0f * 1.4426950408889634f;
#define KSWZ64(row, colB) ((row) * 128 + ((colB) ^ ((((row) >> 1) & 7) << 4)))
#define SBAR() __builtin_amdgcn_sched_barrier(0)
__device__ __forceinline__ int crow(int r, int hi) { return (r & 3) + 8 * (r >> 2) + 4 * hi; }
__device__ __forceinline__ void qkt(f32x16& p0, f32x16& p1, const char* Ks, const bf16x8* qr, int r32, int hi, float A, float st) {
    { float b4[4];
#pragma unroll
      for (int j = 0; j < 4; ++j) b4[j] = fmaf(st, (float)j, A);
      const float s8 = 8.0f * st, s32 = 32.0f * st;
#pragma unroll
      for (int r = 0; r < 16; ++r) { p0[r] = (r < 4) ? b4[r] : p0[r - 4] + s8; }
#pragma unroll
      for (int r = 0; r < 16; ++r) p1[r] = p0[r] + s32; }
#pragma unroll
    for (int d0 = 0; d0 < 4; ++d0) { const int cb = (d0 * 16 + hi * 8) * 2;
        const bf16x8 b0 = *reinterpret_cast<const bf16x8*>(Ks + KSWZ64(r32, cb));
        const bf16x8 b1 = *reinterpret_cast<const bf16x8*>(Ks + KSWZ64(32 + r32, cb));
        p0 = __builtin_amdgcn_mfma_f32_32x32x16_bf16(b0, qr[d0], p0, 0, 0, 0);
        p1 = __builtin_amdgcn_mfma_f32_32x32x16_bf16(b1, qr[d0], p1, 0, 0, 0); }
}
__device__ __forceinline__ void partialSM(f32x16& p0, f32x16& p1, bool mixed, float fd, float sl2) {
    if (mixed) {
#pragma unroll
        for (int r = 0; r < 16; ++r) { const float d0 = fd - (float)((r & 3) + 8 * (r >> 2)); p0[r] = fmaf(fabsf(d0), -sl2, p0[r]); p1[r] = fmaf(fabsf(d0 - 32.0f), -sl2, p1[r]); }
    }
#pragma unroll
    for (int r = 0; r < 16; ++r) p0[r] = __builtin_amdgcn_exp2f(p0[r]);
}
__device__ __forceinline__ void finishSM(f32x16& p0, f32x16& p1, float& l_reg, bf16x8& pa0, bf16x8& pa1, bf16x8& pa2, bf16x8& pa3) {
#pragma unroll
    for (int r = 0; r < 16; ++r) p1[r] = __builtin_amdgcn_exp2f(p1[r]);
    float ps = 0;
#pragma unroll
    for (int r = 0; r < 16; ++r) ps += p0[r];
#pragma unroll
    for (int r = 0; r < 16; ++r) ps += p1[r];
    l_reg += ps;
#define PK4(P, BASE, OUT) do { unsigned a0 = cvt_pk_bf16(P[BASE + 0], P[BASE + 1]), a1 = cvt_pk_bf16(P[BASE + 2], P[BASE + 3]);   \
    unsigned b0 = cvt_pk_bf16(P[BASE + 4], P[BASE + 5]), b1 = cvt_pk_bf16(P[BASE + 6], P[BASE + 7]);                              \
    auto r0 = __builtin_amdgcn_permlane32_swap(a0, b0, false, false); auto r1 = __builtin_amdgcn_permlane32_swap(a1, b1, false, false); \
    u32x4 w = {r0[0], r1[0], r0[1], r1[1]}; OUT = __builtin_bit_cast(bf16x8, w); } while (0)
    PK4(p0, 0, pa0); PK4(p0, 8, pa1); PK4(p1, 0, pa2); PK4(p1, 8, pa3);
#undef PK4
}
__device__ __forceinline__ int v_st(int k, int c) { const int kk = (k & ~0xC) | ((k & 4) << 1) | ((k & 8) >> 1); return ((kk >> 3) * 4 + (c >> 5)) * 512 + ((kk & 7) * 32 + (c & 31)) * 2; }
__device__ __forceinline__ int v_rd_base(int lane) { return ((lane & 3) << 3) | (((lane >> 2) & 3) << 6) | (((lane >> 4) & 1) << 5) | (((lane >> 5) & 1) << 8); }
constexpr int v_rd_off(int d0, int ks, int half) { return d0 * 512 + ks * 4096 + half * 2048; }
template <int OFF> __device__ __forceinline__ s16x4 tr_read(int vb) {
    s16x4 r; asm volatile("ds_read_b64_tr_b16 %0, %1 offset:%2" : "=&v"(r) : "v"(vb), "i"(OFF) : "memory"); return r;
}
template <int D0> __device__ __forceinline__ void pv_one(f32x16& od, int vb, bf16x8 pa0, bf16x8 pa1, bf16x8 pa2, bf16x8 pa3) {
    const s16x4 l0 = tr_read<v_rd_off(D0, 0, 0)>(vb), h0 = tr_read<v_rd_off(D0, 0, 1)>(vb), l1 = tr_read<v_rd_off(D0, 1, 0)>(vb), h1 = tr_read<v_rd_off(D0, 1, 1)>(vb);
    const s16x4 l2 = tr_read<v_rd_off(D0, 2, 0)>(vb), h2 = tr_read<v_rd_off(D0, 2, 1)>(vb), l3 = tr_read<v_rd_off(D0, 3, 0)>(vb), h3 = tr_read<v_rd_off(D0, 3, 1)>(vb);
    asm volatile("s_waitcnt lgkmcnt(0)" ::: "memory"); SBAR();
#define PK(L, H) (bf16x8){L[0], L[1], L[2], L[3], H[0], H[1], H[2], H[3]}
    od = __builtin_amdgcn_mfma_f32_32x32x16_bf16(pa0, PK(l0, h0), od, 0, 0, 0);
    od = __builtin_amdgcn_mfma_f32_32x32x16_bf16(pa1, PK(l1, h1), od, 0, 0, 0);
    od = __builtin_amdgcn_mfma_f32_32x32x16_bf16(pa2, PK(l2, h2), od, 0, 0, 0);
    od = __builtin_amdgcn_mfma_f32_32x32x16_bf16(pa3, PK(l3, h3), od, 0, 0, 0);
#undef PK
}
__device__ __forceinline__ void pv_d0(f32x16* o, int vb, bf16x8 pa0, bf16x8 pa1, bf16x8 pa2, bf16x8 pa3) {
    pv_one<0>(o[0], vb, pa0, pa1, pa2, pa3); pv_one<1>(o[1], vb, pa0, pa1, pa2, pa3); pv_one<2>(o[2], vb, pa0, pa1, pa2, pa3); pv_one<3>(o[3], vb, pa0, pa1, pa2, pa3);
}
__device__ __forceinline__ void attn_unit(const bf16_t* __restrict__ Qb, const bf16_t* __restrict__ Kh, const bf16_t* __restrict__ Vh, bf16_t* __restrict__ Ob, int q0, int t_lo, int n, float sl2, char* lds) {
    const int tid = opaque_tid(), wid = __builtin_amdgcn_readfirstlane(tid >> 6), lane = tid & 63, r32 = lane & 31, hi = lane >> 5;
    float* ws = (float*)(lds + LDS_WS) + wid * 64; float* li_l = ws;
    float l_reg = 0; f32x16 o[4] = {}; bf16x8 qr[4];
    const bf16_t* Qw = Qb + (long)(wid * QBLK + r32) * LDQ + hi * 8;
#pragma unroll
    for (int d0 = 0; d0 < 4; ++d0) qr[d0] = *reinterpret_cast<const bf16x8*>(Qw + d0 * 16);
    float negM;
    { const bf16_t* Kw = Kh + (long)(q0 + wid * QBLK + r32) * LDK + hi * 8; float s = 0.f;
#pragma unroll
      for (int d0 = 0; d0 < 4; ++d0) { const u32x4 kw = *reinterpret_cast<const u32x4*>(Kw + d0 * 16); const u32x4 qw = __builtin_bit_cast(u32x4, qr[d0]);
          s += bflo(kw.x) * bflo(qw.x) + bfhi(kw.x) * bfhi(qw.x) + bflo(kw.y) * bflo(qw.y) + bfhi(kw.y) * bfhi(qw.y) + bflo(kw.z) * bflo(qw.z) + bfhi(kw.z) * bfhi(qw.z) + bflo(kw.w) * bflo(qw.w) + bfhi(kw.w) * bfhi(qw.w); }
      auto rr = __builtin_amdgcn_permlane32_swap(__float_as_uint(s), __float_as_uint(s), false, false); negM = -(__uint_as_float(rr[0]) + __uint_as_float(rr[1])); }
    const unsigned lds0 = (unsigned)(uintptr_t)lds;
    const int krow = wid * 8 + (lane >> 3), kch = (lane & 7) ^ ((krow >> 1) & 7);
    const unsigned koff = (unsigned)(krow * LDK * 2 + kch * 16);
    unsigned voff[2];
#pragma unroll
    for (int z = 0; z < 2; ++z) { const int P16 = (wid + 8 * z) * 64 + lane, sub = P16 >> 5, win = P16 & 31, kk = (sub >> 2) * 8 + (win >> 2), k = (kk & ~0xC) | ((kk & 4) << 1) | ((kk & 8) >> 1), c = (sub & 3) * 32 + (win & 3) * 8;
        voff[z] = (unsigned)(k * LDV * 2 + c * 2); }
    const unsigned kdst = lds0 + LDS_K + wid * 1024, vdst = lds0 + LDS_V + wid * 1024;
    const int vb0 = (int)(lds0 + LDS_V) + v_rd_base(lane);
    const char* K_lds = lds + LDS_K;
    const int qw0 = q0 + wid * QBLK;
    const float fq0 = (float)(qw0 + r32 - 4 * hi);
    const char* Kt = (const char*)(Kh + (long)t_lo * KVBLK * LDK); const char* Vt = (const char*)(Vh + (long)t_lo * KVBLK * LDV);
#define DMA(jj, slot) do { const char* kb_ = Kt + (size_t)(jj) * (KVBLK * LDK * 2); const char* vb_ = Vt + (size_t)(jj) * (KVBLK * LDV * 2); \
    glds16s(kb_, koff, (unsigned)__builtin_amdgcn_readfirstlane(kdst + (slot) * SHM_K)); \
    glds16s(vb_, voff[0], (unsigned)__builtin_amdgcn_readfirstlane(vdst + (slot) * SHM_V)); \
    glds16s(vb_, voff[1], (unsigned)__builtin_amdgcn_readfirstlane(vdst + (slot) * SHM_V + 8192)); } while (0)
#define TILE(jj) const int k0_ = (t_lo + (jj)) * KVBLK; const bool left_ = k0_ + 63 < qw0, right_ = k0_ > qw0 + 31, mixed_ = !(left_ || right_); \
    const float fd_ = fq0 - (float)k0_, st_ = left_ ? sl2 : (right_ ? -sl2 : 0.f), A_ = negM - st_ * fd_
    f32x16 pA0, pA1, pB0, pB1; bf16x8 pa0, pa1, pa2, pa3;
    asm volatile("s_waitcnt vmcnt(0)" ::: "memory");
#define SEG_A(PN0, PN1, PO0, PO1, jt, FIN) do { TILE(jt); SBAR(); qkt(PN0, PN1, K_lds + ((jt) & 3) * SHM_K, qr, r32, hi, A_, st_); if (FIN) finishSM(PO0, PO1, l_reg, pa0, pa1, pa2, pa3); SBAR(); } while (0)
#define SEG_B(P0, P1, jt, PV) do { if (PV) pv_d0(o, vb0 + (((jt) - 1) & 3) * SHM_V, pa0, pa1, pa2, pa3); { TILE(jt); partialSM(P0, P1, mixed_, fd_, sl2); } } while (0)
#define STEP_BAR(jt) do { WAITBAR(0); if ((jt) + 2 < n) DMA((jt) + 2, ((jt) + 2) & 3); } while (0)
    const bool lead = wid < 4;
    DMA(0, 0); DMA(1, 1);
    WAITBAR(3);
    SEG_A(pA0, pA1, pB0, pB1, 0, false); if (!lead) STEP_BAR(0); SEG_B(pA0, pA1, 0, false); if (lead) STEP_BAR(0);
    for (int j = 1; j + 1 < n; j += 2) {
        SEG_A(pB0, pB1, pA0, pA1, j, true); if (!lead) STEP_BAR(j); SEG_B(pB0, pB1, j, true); if (lead) STEP_BAR(j);
        SEG_A(pA0, pA1, pB0, pB1, j + 1, true); if (!lead) STEP_BAR(j + 1); SEG_B(pA0, pA1, j + 1, true); if (lead) STEP_BAR(j + 1);
    }
    SEG_A(pB0, pB1, pA0, pA1, n - 1, true); if (!lead) STEP_BAR(n - 1); SEG_B(pB0, pB1, n - 1, true); if (lead) STEP_BAR(n - 1);
    finishSM(pB0, pB1, l_reg, pa0, pa1, pa2, pa3); SBAR();
    pv_d0(o, vb0 + ((n - 1) & 3) * SHM_V, pa0, pa1, pa2, pa3);
    { auto rr = __builtin_amdgcn_permlane32_swap(__float_as_uint(l_reg), __float_as_uint(l_reg), false, false); l_reg = __uint_as_float(rr[0]) + __uint_as_float(rr[1]); }
    if (hi == 0) li_l[r32] = l_reg; asm volatile("s_waitcnt lgkmcnt(0)" ::: "memory");
    float rli[16];
#pragma unroll
    for (int r = 0; r < 16; ++r) rli[r] = __builtin_amdgcn_rcpf(li_l[crow(r, hi)]);
    bf16_t* Ow = Ob + (long)(wid * QBLK) * LDO;
#pragma unroll
    for (int r = 0; r < 16; ++r) { const int orow = crow(r, hi);
#pragma unroll
        for (int d0 = 0; d0 < 4; ++d0) Ow[(long)orow * LDO + d0 * 32 + r32] = (bf16_t)f2bf(o[d0][r] * rli[r]); }
    WAITBAR(0);
#undef DMA
#undef SEG_A
#undef SEG_B
#undef STEP_BAR
#undef TILE
}
#undef SBAR
}

namespace hy {
typedef f32x2 cf;
__device__ __forceinline__ cf lld(const LAS f32x2* L, int i) { return L[i]; }
__device__ __forceinline__ void lst(LAS f32x2* L, int i, cf v) { L[i] = v; }
__device__ __forceinline__ cf cmul(cf a, cf b) { return a * b.xx + a.yx * (b.yy * (cf){-1.f, 1.f}); }
__device__ __forceinline__ cf cmulc(cf a, cf b) { return a * b.xx + a.yx * (b.yy * (cf){1.f, -1.f}); }
__device__ constexpr float C32[16] = {1.0f, 0.98078528040323043f, 0.92387953251128674f, 0.83146961230254524f, 0.70710678118654757f, 0.55557023301960229f, 0.38268343236508984f, 0.19509032201612833f,
                                      0.0f, -0.19509032201612819f, -0.38268343236508973f, -0.55557023301960196f, -0.70710678118654746f, -0.83146961230254535f, -0.92387953251128674f, -0.98078528040323043f};
__device__ constexpr float S32[16] = {0.0f, 0.19509032201612825f, 0.38268343236508978f, 0.55557023301960218f, 0.70710678118654746f, 0.83146961230254524f, 0.92387953251128674f, 0.98078528040323043f,
                                      1.0f, 0.98078528040323043f, 0.92387953251128674f, 0.83146961230254546f, 0.70710678118654757f, 0.55557023301960218f, 0.38268343236508989f, 0.19509032201612861f};
__host__ __device__ constexpr int brev(int k, int bits) { int r = 0; for (int i = 0; i < bits; ++i) r |= ((k >> i) & 1) << (bits - 1 - i); return r; }
template <int R, bool INV> __device__ __forceinline__ void dft_reg(cf (&v)[R]) {
#pragma unroll
    for (int s = R / 2; s >= 1; s >>= 1) {
#pragma unroll
        for (int g0 = 0; g0 < R; g0 += 2 * s) {
#pragma unroll
            for (int j = 0; j < s; ++j) {
                const cf a = v[g0 + j], b = v[g0 + j + s];
                v[g0 + j] = a + b;
                const cf d = a - b;
                const int tw = j * (16 / s);
                if (tw == 0) v[g0 + j + s] = d;
                else if (tw == 8) v[g0 + j + s] = INV ? (cf){-d.y, d.x} : (cf){d.y, -d.x};
                else { const float c = C32[tw], sn = INV ? S32[tw] : -S32[tw]; v[g0 + j + s] = d * c + d.yx * (cf){-sn, sn}; }
            }
        }
    }
}
constexpr int RS = FFT_RS;
__device__ __forceinline__ void fft_fwd12(cf (&v)[32], LAS f32x2* L, int tid) {
    dft_reg<32, false>(v);
    { float s, c; sincospif((float)tid * (1.0f / 8192.0f), &s, &c); cf w1 = {c, -s}; asm volatile("" : "+v"(w1.x), "+v"(w1.y)); cf w = w1;
#pragma unroll
      for (int k1 = 0; k1 < 32; ++k1) { cf x = v[brev(k1, 5)]; if (k1) { x = cmul(x, w); w = cmul(w, w1); } lst(L, k1 * RS + tid, x); } }
    __syncthreads();
    const int k1 = tid >> 4, m2 = tid & 15;
#pragma unroll
    for (int m1 = 0; m1 < 32; ++m1) v[m1] = lld(L, k1 * RS + 16 * m1 + m2);
    __syncthreads();
    dft_reg<32, false>(v);
    { float s, c; sincospif((float)m2 * (1.0f / 256.0f), &s, &c); cf w1 = {c, -s}; asm volatile("" : "+v"(w1.x), "+v"(w1.y)); cf w = w1;
#pragma unroll
      for (int j1 = 0; j1 < 32; ++j1) { cf x = v[brev(j1, 5)]; if (j1) { x = cmul(x, w); w = cmul(w, w1); } lst(L, k1 * RS + 33 * m2 + j1, x); } }
    __syncthreads();
}
__device__ __forceinline__ void fft_inv21(cf (&v)[32], LAS f32x2* L, int tid) {
    const int k1 = tid >> 4, m2 = tid & 15;
    { float s, c; sincospif((float)m2 * (1.0f / 256.0f), &s, &c); cf w1 = {c, -s}; asm volatile("" : "+v"(w1.x), "+v"(w1.y)); cf w = w1;
#pragma unroll
      for (int j1 = 0; j1 < 32; ++j1) { cf x = lld(L, k1 * RS + 33 * m2 + j1); if (j1) { x = cmulc(x, w); w = cmul(w, w1); } v[j1] = x; } }
    __syncthreads();
    dft_reg<32, true>(v);
#pragma unroll
    for (int m1 = 0; m1 < 32; ++m1) lst(L, k1 * RS + 16 * m1 + m2, v[brev(m1, 5)]);
    __syncthreads();
    { float s, c; sincospif((float)tid * (1.0f / 8192.0f), &s, &c); cf w1 = {c, -s}; asm volatile("" : "+v"(w1.x), "+v"(w1.y)); cf w = w1;
#pragma unroll
      for (int kk = 0; kk < 32; ++kk) { cf x = lld(L, kk * RS + tid); if (kk) { x = cmulc(x, w); w = cmul(w, w1); } v[kk] = x; } }
    dft_reg<32, true>(v);
}
}
constexpr size_t MiB = 1u << 20;
constexpr size_t WS_CTL = 0, CTL_ZERO_BYTES = 1 * MiB;
constexpr size_t WS_W1T = 1 * MiB;
constexpr size_t WS_W2T = 257 * MiB;
constexpr size_t WS_WIN_EV = 385 * MiB, WS_WOUT_EV = 409 * MiB, WS_WIN_OD = 417 * MiB, WS_WOUT_OD = 433 * MiB, WS_WG_OD = 441 * MiB;
constexpr size_t AR = 445 * MiB;
constexpr size_t A_XB = AR + 0 * MiB, A_UHT = AR + 64 * MiB, A_QB = AR + 160 * MiB, A_KB = AR + 192 * MiB, A_VB = AR + 224 * MiB, A_KTD = AR + 256 * MiB, A_KF = AR + 384 * MiB,
                 A_H3B = AR + 512 * MiB, A_W4T = AR + 514 * MiB, A_YHT = AR + 256 * MiB, A_OA = AR + 288 * MiB, A_YCAT = AR + 512 * MiB, A_XB2 = AR + 0 * MiB, A_R0 = AR + 64 * MiB, A_H1_0 = AR + 192 * MiB,
                 A_HB_0 = AR + 320 * MiB, A_HID_0 = AR + 384 * MiB, A_ROWL = AR + 424 * MiB, A_GATEW = AR + 428 * MiB, A_Y2_0 = AR + 0 * MiB, A_H2 = AR + 448 * MiB, A_HB2 = AR + 448 * MiB;
constexpr size_t A_GB = AR + 0 * MiB, A_XR = AR + 64 * MiB, A_XC = AR + 192 * MiB, A_LA = AR + 256 * MiB, A_BB = AR + 64 * MiB, A_CAR = AR + 384 * MiB, A_YG = AR + 192 * MiB, A_R1 = AR + 256 * MiB,
                 A_H1_1 = AR + 0 * MiB, A_HB_1 = AR + 128 * MiB, A_HID_1 = AR + 192 * MiB, A_Y2_1 = AR + 256 * MiB;
constexpr size_t WS_END = AR + 576 * MiB;
constexpr int CW_BAR = 4096, CW_CNT = 16384, CW_NORM = 24576;
constexpr int LDS_MISC = 139264, LDS_BYTES = 147456;
constexpr int NPHASE = 21;

struct Args { const float* in[37]; float* out; unsigned char* ws; int ph_lo, ph_hi; };
typedef const __attribute__((address_space(4))) Args& KArgs;

__device__ __forceinline__ void transpose_item(const float* W, int N, int k0, int n0, bf16_t* WT, int ldk, int drow0, LAS float* scr, int lane) {
#pragma unroll 8
    for (int i = 0; i < 32; ++i) { const int kk = 2 * i + (lane >> 5); scr[kk * 33 + (lane & 31)] = W[(size_t)(k0 + kk) * N + n0 + (lane & 31)]; }
    LDS_WAIT(); asm volatile("" ::: "memory");
    const int c = lane & 7;
#pragma unroll
    for (int j = 0; j < 4; ++j) { const int n = (lane >> 3) + 8 * j; const LAS float* s = scr + (8 * c) * 33 + n;
        u32x4 o; o.x = pk2(s[0 * 33], s[1 * 33]); o.y = pk2(s[2 * 33], s[3 * 33]); o.z = pk2(s[4 * 33], s[5 * 33]); o.w = pk2(s[6 * 33], s[7 * 33]);
        *(u32x4*)(WT + (size_t)(drow0 + n) * ldk + k0 + 8 * c) = o; }
    LDS_WAIT(); asm volatile("" ::: "memory");
}

__device__ __forceinline__ void phase_prologue(KArgs a, LAS unsigned char* lds) {
    const int tid = opaque_tid(), lane = tid & 63, wave = tid >> 6, G = gridDim.x;
    const int gw = blockIdx.x * 8 + wave, NGW = G * 8;
    unsigned char* ws = a.ws;
    LAS float* scr = (LAS float*)(lds + wave * 16384);
    constexpr int I_EVIN = 32 * 192, I_SQ = 32 * 64, I_ODIN = 32 * 128, I_MOE_GU = 64 * 512, I_MOE_D = 64 * 512, I_RG = 16 * 32, I_W4 = 128;
    constexpr int O1 = I_EVIN, O2 = O1 + I_SQ, O3 = O2 + I_ODIN, O4 = O3 + I_SQ, O5 = O4 + I_MOE_GU, O6 = O5 + I_MOE_GU, O7 = O6 + I_MOE_D, O8 = O7 + I_RG, O9 = O8 + I_RG, O10 = O9 + I_W4;
    for (int it = gw; it < O10; it += NGW) {
        if (it < O1) { const int kb = it / 192, nb = it % 192; transpose_item(a.in[1], EV_IN, kb * 64, nb * 32, (bf16_t*)(ws + WS_WIN_EV), DM, nb * 32, scr, lane); }
        else if (it < O2) { const int r = it - O1, kb = r / 64, nb = r % 64; transpose_item(a.in[18], DM, kb * 64, nb * 32, (bf16_t*)(ws + WS_WOUT_EV), DM, nb * 32, scr, lane); }
        else if (it < O3) { const int r = it - O2, kb = r / 128, nb = r % 128; transpose_item(a.in[19], 2 * DM, kb * 64, nb * 32, (bf16_t*)(ws + WS_WIN_OD), DM, nb * 32, scr, lane); }
        else if (it < O4) { const int r = it - O3, kb = r / 64, nb = r % 64; transpose_item(a.in[27], DM, kb * 64, nb * 32, (bf16_t*)(ws + WS_WOUT_OD), DM, nb * 32, scr, lane); }
        else if (it < O6) { const bool up = it >= O5; const int r = it - (up ? O5 : O4), le = r / 512, q = r % 512, kb = q / 16, nb = q % 16, n0 = nb * 32;
            transpose_item((up ? a.in[35] : a.in[34]) + (size_t)le * DM * DFF, DFF, kb * 64, n0, (bf16_t*)(ws + WS_W1T) + (size_t)le * 1024 * DM, DM, (n0 >> 7) * 256 + (n0 & 127) + (up ? 128 : 0), scr, lane); }
        else if (it < O7) { const int r = it - O6, le = r / 512, q = r % 512, kb = q / 64, nb = q % 64;
            transpose_item(a.in[36] + (size_t)le * DFF * DM, DM, kb * 64, nb * 32, (bf16_t*)(ws + WS_W2T) + (size_t)le * DM * DFF, DFF, nb * 32, scr, lane); }
        else if (it < O9) { const bool wx = it >= O8; const int r = it - (wx ? O8 : O7), dn = r / 32, q = r % 32, kb = q / 8, nb = q % 8, n0 = nb * 32, dir = dn / 8, n = dn % 8;
            transpose_item((wx ? a.in[24] : a.in[22]) + (size_t)dn * 65536, 256, kb * 64, n0, (bf16_t*)(ws + WS_WG_OD), 256, (n * 4 + dir * 2 + (n0 >> 7)) * 256 + (n0 & 127) + (wx ? 128 : 0), scr, lane); }
        else { const int nb = it - O9; transpose_item(a.in[11], 4096, 0, nb * 32, (bf16_t*)(ws + A_W4T), 128, nb * 32, scr, lane); }
    }
    { const int gt = blockIdx.x * 512 + tid, NT = G * 512;
      for (int i = gt; i < 4096 * 8; i += NT) { const int r = i >> 3, c = i & 7; *(u32x4*)((bf16_t*)(ws + A_W4T) + (size_t)r * 128 + 64 + c * 8) = (u32x4){0u, 0u, 0u, 0u}; }
      for (int i = gt; i < 8192 * 8; i += NT) { const int r = i >> 3, c = i & 7; *(u32x4*)((bf16_t*)(ws + A_H3B) + (size_t)r * 128 + 64 + c * 8) = (u32x4){0u, 0u, 0u, 0u}; }
      const f32x8* x8 = (const f32x8*)a.in[0]; u32x4* xb = (u32x4*)(ws + A_XB);
      for (int i = gt; i < NTOK * DM / 8; i += NT) { const f32x8 v = x8[i]; u32x4 o; o.x = pk2(v[0], v[1]); o.y = pk2(v[2], v[3]); o.z = pk2(v[4], v[5]); o.w = pk2(v[6], v[7]); xb[i] = o; } }
    { const float* w1 = a.in[4]; const float* b1 = a.in[5]; const float* w2 = a.in[6]; const float* b2 = a.in[7]; const float* w3 = a.in[8]; const float* b3 = a.in[9]; const float* fr = a.in[10];
      const float frq = fr[lane];
      for (int t = gw; t < SEQ; t += NGW) {
          float z;
          { const float tl = (float)t * (1.0f / 8191.0f);
            if (lane == 0) z = tl;
            else { const int j = (lane - 1) & 15; const float band = 1e-4f + (float)j * ((15.0f - 1e-4f) / 15.0f);
                   const float ang = (6.283185307179586f * (float)t * (1.0f / 8192.0f)) * band; float sn, cs; sincosf(ang, &sn, &cs); z = (lane <= 16) ? cs : -sn; } }
          float acc = b1[lane];
#pragma unroll
          for (int i = 0; i < 33; ++i) acc += __shfl(z, i) * w1[i * 64 + lane];
          float h = sinf(frq * acc);
          acc = b2[lane];
#pragma unroll 16
          for (int i = 0; i < 64; ++i) acc += __shfl(h, i) * w2[i * 64 + lane];
          h = sinf(frq * acc);
          acc = b3[lane];
#pragma unroll 16
          for (int i = 0; i < 64; ++i) acc += __shfl(h, i) * w3[i * 64 + lane];
          h = sinf(frq * acc);
          ((bf16_t*)(ws + A_H3B))[(size_t)t * 128 + lane] = (bf16_t)f2bf(h);
      } }
}

__device__ __forceinline__ void phase_filter_fft(KArgs a, LAS unsigned char* lds) {
    const int tid = opaque_tid(), lane = tid & 63, wave = tid >> 6, G = gridDim.x;
    LAS f32x2* L = (LAS f32x2*)lds; LAS float* red = (LAS float*)(lds + LDS_MISC + 1024);
    const bf16_t* KTD = (const bf16_t*)(a.ws + A_KTD); __half2* KF = (__half2*)(a.ws + A_KF);
    for (int u = blockIdx.x; u < 2048; u += G) {
        const int o = u >> 10, c = u & 1023;
        int tl = tid; asm volatile("" : "+v"(tl));
        const bf16_t* rowF = KTD + (size_t)(o * 1024 + c) * 8192; const bf16_t* rowB = KTD + (size_t)(2048 + o * 1024 + c) * 8192;
        hy::cf v[32]; float ss = 0.f;
#pragma unroll
        for (int n1 = 0; n1 < 32; ++n1) { const int p = tl + 512 * n1; float val;
            if (n1 < 16) val = bf2f(rowF[p]); else if (p == 8192) val = 0.f; else val = bf2f(rowB[16384 - p]);
            v[n1] = (hy::cf){val, 0.f}; ss += val * val; }
        ss = wave_sum(ss); if (lane == 0) red[wave] = ss; __syncthreads();
        float tot = 0.f;
#pragma unroll
        for (int w = 0; w < 8; ++w) tot += red[w];
        const float scale = rsqrtf(tot), skp = a.in[12][u];
        hy::fft_fwd12(v, L, tl);
#pragma unroll
        for (int bf = 0; bf < 2; ++bf) { const int idx = bf * 512 + tl, k1 = idx >> 5, j1 = idx & 31; hy::cf w[16];
#pragma unroll
            for (int m2 = 0; m2 < 16; ++m2) w[m2] = hy::lld(L, k1 * hy::RS + 33 * m2 + j1);
            hy::dft_reg<16, false>(w);
#pragma unroll
            for (int j2 = 0; j2 < 16; ++j2) { const hy::cf x = w[hy::brev(j2, 4)]; KF[((size_t)(u * 2 + bf) * 16 + j2) * 512 + tl] = __floats2half2_rn(x.x * scale + skp, x.y * scale); } }
        __syncthreads();
    }
}
__device__ __forceinline__ float hyconv(const bf16_t* row, int t, float w0, float w1, float w2, float bias) {
    const unsigned tm = (unsigned)(t > 0 ? t - 1 : 0), tp = (unsigned)(t < SEQ - 1 ? t + 1 : SEQ - 1);
    float xm = bf2f(row[tm]), x0 = bf2f(row[(unsigned)t]), xp = bf2f(row[tp]);
    xm = t > 0 ? xm : 0.f; xp = t < SEQ - 1 ? xp : 0.f;
    return w0 * xm + w1 * x0 + w2 * xp + bias;
}
__device__ __forceinline__ void phase_hyena_mixer(KArgs a, LAS unsigned char* lds) {
    const int tid = opaque_tid(), G = gridDim.x;
    LAS f32x2* L = (LAS f32x2*)lds;
    const bf16_t* UHT = (const bf16_t*)(a.ws + A_UHT); const __half2* KF = (const __half2*)(a.ws + A_KF); bf16_t* YHT = (bf16_t*)(a.ws + A_YHT);
    const float* cw = a.in[2]; const float* cb = a.in[3];
    for (int c = blockIdx.x; c < HY_CH; c += G) {
        int tl = tid; asm volatile("" : "+v"(tl));
        hy::cf v[32];
        { const bf16_t* r0 = UHT + (size_t)c * NTOK; const float w0 = cw[c], w1 = cw[3072 + c], w2 = cw[6144 + c], bb = cb[c];
#pragma unroll
          for (int n1 = 0; n1 < 16; ++n1) { const int t = tl + 512 * n1; v[n1] = (hy::cf){hyconv(r0, t, w0, w1, w2, bb), hyconv(r0 + SEQ, t, w0, w1, w2, bb)}; if ((n1 & 3) == 3) asm volatile("" ::: "memory"); } }
#pragma unroll 1
        for (int o = 0; o < 2; ++o) {
#pragma unroll
            for (int n1 = 16; n1 < 32; ++n1) v[n1] = (hy::cf){0.f, 0.f};
            hy::fft_fwd12(v, L, tl);
#pragma unroll
            for (int bf = 0; bf < 2; ++bf) { const int idx = bf * 512 + tl, k1 = idx >> 5, j1 = idx & 31; hy::cf w[16];
#pragma unroll
                for (int m2 = 0; m2 < 16; ++m2) w[m2] = hy::lld(L, k1 * hy::RS + 33 * m2 + j1);
                hy::dft_reg<16, false>(w);
                asm volatile("" ::: "memory");
                hy::cf y[16];
#pragma unroll
                for (int j2 = 0; j2 < 16; ++j2) { const float2 kf = __half22float2(KF[((size_t)((o * 1024 + c) * 2 + bf) * 16 + j2) * 512 + tl]);
                    y[j2] = hy::cmul(w[hy::brev(j2, 4)], (hy::cf){kf.x, kf.y}); }
                hy::dft_reg<16, true>(y);
#pragma unroll
                for (int m2 = 0; m2 < 16; ++m2) hy::lst(L, k1 * hy::RS + 33 * m2 + j1, y[hy::brev(m2, 4)]); }
            __syncthreads();
            hy::fft_inv21(v, L, tl);
            const int gch = (o + 1) * 1024 + c; const bf16_t* rg = UHT + (size_t)gch * NTOK;
            const float w0 = cw[gch], w1 = cw[3072 + gch], w2 = cw[6144 + gch], bb = cb[gch];
            hy::cf zn[16]; int tg = tl; asm volatile("" : "+v"(tg));
#pragma unroll
            for (int n1 = 0; n1 < 16; ++n1) { const int t = tg + 512 * n1; const hy::cf y = v[hy::brev(n1, 5)];
                const float g0 = hyconv(rg, t, w0, w1, w2, bb), g1 = hyconv(rg + SEQ, t, w0, w1, w2, bb);
                zn[n1] = y * (hy::cf){g0 * (1.0f / 16384.0f), g1 * (1.0f / 16384.0f)}; if ((n1 & 3) == 3) asm volatile("" ::: "memory"); }
#pragma unroll
            for (int n1 = 0; n1 < 16; ++n1) v[n1] = zn[n1];
        }
        bf16_t* yo = YHT + (size_t)c * NTOK;
#pragma unroll
        for (int n1 = 0; n1 < 16; ++n1) { const int t = tl + 512 * n1; yo[t] = (bf16_t)f2bf(v[n1].x); yo[SEQ + t] = (bf16_t)f2bf(v[n1].y); }
    }
    __syncthreads();
}
__device__ __forceinline__ void phase_qknorm(KArgs a, LAS unsigned char* lds) {
    const int tid = opaque_tid(), lane = tid & 63, wave = tid >> 6, gw = blockIdx.x * 8 + wave, NGW = gridDim.x * 8;
    LAS unsigned* red = (LAS unsigned*)(lds + LDS_MISC + 1536);
    unsigned* ctl = (unsigned*)(a.ws + WS_CTL);
    if (tid < 64) red[tid] = 0u;
    __syncthreads();
    for (int which = 0; which < 2; ++which) { const bf16_t* P = (const bf16_t*)(a.ws + (which ? A_KB : A_QB));
        for (int b = 0; b < 2; ++b) { float mx = 0.f;
            for (int row = gw; row < SEQ; row += NGW) { const bf16_t* p = P + ((size_t)b * SEQ + row) * 1024 + lane * 16;
                const u32x4 w0 = *(const u32x4*)p, w1 = *(const u32x4*)(p + 8); const unsigned ww[8] = {w0.x, w0.y, w0.z, w0.w, w1.x, w1.y, w1.z, w1.w};
                float ss = 0.f;
#pragma unroll
                for (int i = 0; i < 8; ++i) { const float x = bflo(ww[i]), y = bfhi(ww[i]); ss += x * x + y * y; }
                ss += __shfl_xor(ss, 1); ss += __shfl_xor(ss, 2); mx = fmaxf(mx, ss); }
            if ((lane & 3) == 0) atomicMax((unsigned*)&red[which * 32 + b * 16 + (lane >> 2)], __float_as_uint(mx)); } }
    __syncthreads();
    if (tid < 64) atomicMax(ctl + CW_NORM + tid, red[tid]);
}
__device__ __forceinline__ void phase_attention(KArgs a, LAS unsigned char* lds) {
    const int G = gridDim.x, bx = blockIdx.x;
    const bf16_t* QB = (const bf16_t*)(a.ws + A_QB); const bf16_t* KB = (const bf16_t*)(a.ws + A_KB); const bf16_t* VB = (const bf16_t*)(a.ws + A_VB); bf16_t* OA = (bf16_t*)(a.ws + A_OA);
    const unsigned* nrm = (const unsigned*)(a.ws + WS_CTL) + CW_NORM;
    for (int i = 0;; ++i) {
        int bhc, qb;
        if (G == 256) { if (i >= 4) break;
            const int x = bx & 7, combo = x & 3, hh = (x < 4) ? ((i == 0) ? 7 : (i == 1) ? 5 : (i == 2) ? 1 : 0) : ((i == 0) ? 6 : (i == 1) ? 4 : (i == 2) ? 3 : 2); bhc = (combo >> 1) * 16 + hh * 2 + (combo & 1); qb = bx >> 3; }
        else { const int Lu = i * G + bx; if (Lu >= 1024) break; bhc = Lu >> 5; qb = Lu & 31; }
        const int b = bhc >> 4, h = (bhc >> 1) & 7, cm = bhc & 1;
        const size_t rowq = (size_t)b * SEQ + (size_t)qb * 256;
        const float sl2 = exp2f(-(float)(h + 1)) * 1.4426950408889634f;
        const float qk = sqrtf(__uint_as_float(nrm[bhc]) * __uint_as_float(nrm[32 + bhc]));
        const float Wk = (2.0f * qk + 38.0f) / sl2, q0f = (float)(qb * 256);
        int t_lo = (int)fmaxf(floorf((q0f - Wk - 63.0f) * (1.0f / 64.0f)), 0.0f), t_hi = (int)fminf(ceilf((q0f + 255.0f + Wk) * (1.0f / 64.0f)), 127.0f);
        if (((t_hi - t_lo + 1) & 1) != 0) { if (t_hi < 127) ++t_hi; else --t_lo; }
        att::attn_unit(QB + rowq * 1024 + h * 128 + cm * 64, KB + (size_t)b * SEQ * 1024 + h * 128 + cm * 64, VB + (size_t)b * SEQ * 1024 + h * 128,
                       OA + (size_t)cm * NTOK * 1024 + rowq * 1024 + h * 128, qb * 256, t_lo, t_hi - t_lo + 1, sl2, (char*)lds);
    }
}
__device__ __forceinline__ void phase_concat(KArgs a, LAS unsigned char* lds) {
    const int tid = opaque_tid(), lane = tid & 63, wave = tid >> 6, G = gridDim.x;
    const bf16_t* YHT = (const bf16_t*)(a.ws + A_YHT); const bf16_t* OA0 = (const bf16_t*)(a.ws + A_OA); const bf16_t* OA1 = OA0 + (size_t)NTOK * 1024; bf16_t* YC = (bf16_t*)(a.ws + A_YCAT);
    LAS bf16_t* T = (LAS bf16_t*)lds;
    const float lambda_init = 0.2f;
    const float lam = __expf(wave_sum(a.in[13][lane] * a.in[14][lane])) - __expf(wave_sum(a.in[15][lane] * a.in[16][lane])) + lambda_init;
    float gl[16];
#pragma unroll
    for (int i = 0; i < 16; ++i) gl[i] = a.in[17][(lane & 7) * 16 + i] * (1.0f - lambda_init);
    for (int it = blockIdx.x; it < NTOK / 64; it += G) {
        const int tok0 = it * 64;
#pragma unroll 4
        for (int k = 0; k < 16; ++k) { const int idx = tid + 512 * k, c = idx >> 3, ch = idx & 7;
            const u32x4 w = *(const u32x4*)(YHT + (size_t)c * NTOK + tok0 + ch * 8);
            LAS bf16_t* d = T + (ch * 8) * 1026 + c;
            d[0 * 1026] = (bf16_t)(w.x & 0xffff); d[1 * 1026] = (bf16_t)(w.x >> 16); d[2 * 1026] = (bf16_t)(w.y & 0xffff); d[3 * 1026] = (bf16_t)(w.y >> 16);
            d[4 * 1026] = (bf16_t)(w.z & 0xffff); d[5 * 1026] = (bf16_t)(w.z >> 16); d[6 * 1026] = (bf16_t)(w.w & 0xffff); d[7 * 1026] = (bf16_t)(w.w >> 16); }
        __syncthreads();
#pragma unroll 4
        for (int k = 0; k < 16; ++k) { const int idx = tid + 512 * k, tl = idx >> 7, c8 = idx & 127;
            const LAS unsigned* s = (const LAS unsigned*)(T + tl * 1026 + c8 * 8);
            u32x4 w; w.x = s[0]; w.y = s[1]; w.z = s[2]; w.w = s[3];
            *(u32x4*)(YC + (size_t)(tok0 + tl) * DM + c8 * 8) = w; }
        for (int rr = 0; rr < 8; ++rr) { const size_t tok = (size_t)tok0 + wave * 8 + rr;
            const u32x4 p0 = *(const u32x4*)(OA0 + tok * 1024 + lane * 16), p1 = *(const u32x4*)(OA0 + tok * 1024 + lane * 16 + 8);
            const u32x4 q0 = *(const u32x4*)(OA1 + tok * 1024 + lane * 16), q1 = *(const u32x4*)(OA1 + tok * 1024 + lane * 16 + 8);
            const unsigned pw[8] = {p0.x, p0.y, p0.z, p0.w, p1.x, p1.y, p1.z, p1.w}, qw[8] = {q0.x, q0.y, q0.z, q0.w, q1.x, q1.y, q1.z, q1.w};
            float o[16]; float ss = 0.f;
#pragma unroll
            for (int i = 0; i < 8; ++i) { o[2 * i] = bflo(pw[i]) - lam * bflo(qw[i]); o[2 * i + 1] = bfhi(pw[i]) - lam * bfhi(qw[i]); ss += o[2 * i] * o[2 * i] + o[2 * i + 1] * o[2 * i + 1]; }
            ss += __shfl_xor(ss, 1); ss += __shfl_xor(ss, 2); ss += __shfl_xor(ss, 4);
            const float rs = rsqrtf(ss * (1.0f / 128.0f) + LN_EPS);
            u32x4 w0, w1;
            w0.x = pk2(o[0] * rs * gl[0], o[1] * rs * gl[1]); w0.y = pk2(o[2] * rs * gl[2], o[3] * rs * gl[3]); w0.z = pk2(o[4] * rs * gl[4], o[5] * rs * gl[5]); w0.w = pk2(o[6] * rs * gl[6], o[7] * rs * gl[7]);
            w1.x = pk2(o[8] * rs * gl[8], o[9] * rs * gl[9]); w1.y = pk2(o[10] * rs * gl[10], o[11] * rs * gl[11]); w1.z = pk2(o[12] * rs * gl[12], o[13] * rs * gl[13]); w1.w = pk2(o[14] * rs * gl[14], o[15] * rs * gl[15]);
            *(u32x4*)(YC + tok * DM + 1024 + lane * 16) = w0; *(u32x4*)(YC + tok * DM + 1024 + lane * 16 + 8) = w1; }
        __syncthreads();
    }
}
__device__ __forceinline__ void ln_row(f32x4 (&v)[8], const float* g, const float* b, int lane, float& mu, float& rs) {
    float s = 0.f;
#pragma unroll
    for (int j = 0; j < 8; ++j) s += (v[j][0] + v[j][1]) + (v[j][2] + v[j][3]);
    const float mean = wave_sum(s) * (1.0f / DM); float s2 = 0.f;
#pragma unroll
    for (int j = 0; j < 8; ++j) { v[j] = v[j] - mean; s2 += (v[j][0] * v[j][0] + v[j][1] * v[j][1]) + (v[j][2] * v[j][2] + v[j][3] * v[j][3]); }
    const float rstd = rsqrtf(wave_sum(s2) * (1.0f / DM) + LN_EPS); mu = mean; rs = rstd;
#pragma unroll
    for (int j = 0; j < 8; ++j) { const f32x4 gg = *(const f32x4*)(g + 4 * (lane + 64 * j)), bb = *(const f32x4*)(b + 4 * (lane + 64 * j)); v[j] = v[j] * rstd * gg + bb; }
}
__device__ __forceinline__ void phase_ln_router(KArgs a, LAS unsigned char* lds, const bf16_t* R, const float* g, const float* b, bf16_t* HB, unsigned* cnt, int* rowlist, float* gatew) {
    const int tid = opaque_tid(), lane = tid & 63, wave = tid >> 6, G = gridDim.x;
    const float* rw = a.in[32]; const float* rb = a.in[33];
    LAS float* part = (LAS float*)lds;
    LAS int* hist = (LAS int*)(lds + 40960); LAS int* base = hist + 32; LAS float* stats = (LAS float*)(lds + 40960 + 512);
    for (int it = blockIdx.x; it < NTOK / 32; it += G) {
        const int tok0 = it * 32;
        for (int rr = 0; rr < 4; ++rr) { const size_t row = (size_t)tok0 + wave * 4 + rr; f32x4 v[8]; float mu, rs;
#pragma unroll
            for (int j = 0; j < 8; ++j) { const u32x2 w = *(const u32x2*)(R + row * DM + 4 * (lane + 64 * j)); v[j] = (f32x4){bflo(w.x), bfhi(w.x), bflo(w.y), bfhi(w.y)}; }
            ln_row(v, g, b, lane, mu, rs);
            if (lane == 0) { stats[(wave * 4 + rr) * 2] = mu; stats[(wave * 4 + rr) * 2 + 1] = rs; }
#pragma unroll
            for (int j = 0; j < 8; ++j) { u32x2 w; w.x = pk2(v[j][0], v[j][1]); w.y = pk2(v[j][2], v[j][3]); *(u32x2*)(HB + row * DM + 4 * (lane + 64 * j)) = w; } }
        if (tid < 32) hist[tid] = 0;
        __syncthreads();
        { const int i = lane & 31, kk = lane >> 5; f32x16 acc = {};
          const float mu = stats[i * 2], rs = stats[i * 2 + 1];
          const bf16_t* rrow = R + (size_t)(tok0 + i) * DM + wave * 256 + 4 * kk; const float* gp = g + wave * 256 + 4 * kk; const float* bp = b + wave * 256 + 4 * kk;
          const float* rwp = rw + (size_t)(wave * 256 + 4 * kk) * NEXP + i;
#pragma unroll 4
          for (int s = 0; s < 32; ++s) { const u32x2 rw2 = *(const u32x2*)(rrow + 8 * s); const f32x4 hv = ((f32x4){bflo(rw2.x), bfhi(rw2.x), bflo(rw2.y), bfhi(rw2.y)} - mu) * rs * *(const f32x4*)(gp + 8 * s) + *(const f32x4*)(bp + 8 * s);
#pragma unroll
              for (int j = 0; j < 4; ++j) acc = __builtin_amdgcn_mfma_f32_32x32x2f32(rwp[(size_t)(8 * s + j) * NEXP], hv[j], acc, 0, 0, 0); }
#pragma unroll
          for (int r = 0; r < 16; ++r) part[(wave * 32 + i) * 33 + (r & 3) + 8 * (r >> 2) + 4 * kk] = acc[r]; }
        __syncthreads();
        int e1 = 0, e2 = 0, r1 = 0, r2 = 0; float g1 = 0.f, g2 = 0.f;
        if (tid < 32) {
            float bestg = -1e30f;
#pragma unroll
            for (int gi = 0; gi < 4; ++gi) { float m1 = -1e30f, m2 = -1e30f, s1 = 0.f, s2 = 0.f; int i1 = 0, i2 = 0;
#pragma unroll
                for (int j = 0; j < 8; ++j) { const int e = gi * 8 + j; float lg = 0.f;
#pragma unroll
                    for (int w = 0; w < 8; ++w) lg += part[(w * 32 + tid) * 33 + e];
                    const float sg = 1.0f / (1.0f + expf(-lg)), sl = sg + rb[e];
                    if (sl > m1) { m2 = m1; i2 = i1; s2 = s1; m1 = sl; i1 = j; s1 = sg; } else if (sl > m2) { m2 = sl; i2 = j; s2 = sg; } }
                const float gs = m1 + m2;
                if (gs > bestg) { bestg = gs; e1 = gi * 8 + i1; e2 = gi * 8 + i2; g1 = s1; g2 = s2; } }
            const float inv = 1.0f / (g1 + g2); g1 *= inv; g2 *= inv;
            r1 = atomicAdd((int*)&hist[e1], 1); r2 = atomicAdd((int*)&hist[e2], 1);
        }
        __syncthreads();
        if (tid < 32) { const int hc = hist[tid]; base[tid] = hc ? (int)__hip_atomic_fetch_add(cnt + tid * 64, (unsigned)hc, __ATOMIC_RELAXED, __HIP_MEMORY_SCOPE_AGENT) : 0; }
        __syncthreads();
        if (tid < 32) { const int a0 = (tok0 + tid) * 2;
            rowlist[(size_t)e1 * ECAP + base[e1] + r1] = a0; gatew[a0] = g1;
            rowlist[(size_t)e2 * ECAP + base[e2] + r2] = a0 + 1; gatew[a0 + 1] = g2; }
        __syncthreads();
    }
}
__device__ __forceinline__ void phase_ln2(const bf16_t* HB, const bf16_t* Y2, const float* g, const float* b, float* OUT, bf16_t* OB) {
    const int tid = opaque_tid(), lane = tid & 63, wave = tid >> 6;
    for (int row = blockIdx.x * 8 + wave; row < NTOK; row += gridDim.x * 8) { f32x4 v[8]; float mu, rs;
#pragma unroll
        for (int j = 0; j < 8; ++j) { const int c = 4 * (lane + 64 * j); const u32x2 h = *(const u32x2*)(HB + (size_t)row * DM + c);
            const u32x2 y0 = *(const u32x2*)(Y2 + (size_t)(2 * row) * DM + c), y1 = *(const u32x2*)(Y2 + (size_t)(2 * row + 1) * DM + c);
            v[j] = (f32x4){bflo(h.x), bfhi(h.x), bflo(h.y), bfhi(h.y)} * DN_ALPHA + (f32x4){bflo(y0.x) + bflo(y1.x), bfhi(y0.x) + bfhi(y1.x), bflo(y0.y) + bflo(y1.y), bfhi(y0.y) + bfhi(y1.y)}; }
        ln_row(v, g, b, lane, mu, rs);
#pragma unroll
        for (int j = 0; j < 8; ++j) { const int c = 4 * (lane + 64 * j); if (OUT) *(f32x4*)(OUT + (size_t)row * DM + c) = v[j];
            if (OB) { u32x2 w; w.x = pk2(v[j][0], v[j][1]); w.y = pk2(v[j][2], v[j][3]); *(u32x2*)(OB + (size_t)row * DM + c) = w; } }
    }
}
__device__ __forceinline__ void moe_table(LAS int* tab, const unsigned* cnt) {
    __syncthreads();
    const int tid = opaque_tid();
    if (tid < 32) tab[64 + tid] = (int)cnt[tid * 64];
    __syncthreads();
    if (tid == 0) { int acc = 0; for (int e = 0; e < 32; ++e) { tab[e] = acc; acc += (tab[64 + e] + 255) >> 8; } tab[32] = acc; }
    __syncthreads();
}
__device__ __forceinline__ void phase_conv4(KArgs a) {
    const bf16_t* XR = (const bf16_t*)(a.ws + A_XR); bf16_t* XC = (bf16_t*)(a.ws + A_XC); const float* cw = a.in[20]; const float* cb = a.in[21];
    const int NT = gridDim.x * 512;
    for (int it = blockIdx.x * 512 + opaque_tid(); it < NTOK * 256; it += NT) { const int tok = it >> 8, ch = (it & 255) * 8, t = tok & (SEQ - 1);
        float acc[8];
#pragma unroll
        for (int i = 0; i < 8; ++i) acc[i] = cb[ch + i];
#pragma unroll
        for (int j = 0; j < 4; ++j) { const int tt = t + j - 2;
            if (tt >= 0 && tt < SEQ) { const u32x4 w = *(const u32x4*)(XR + (size_t)(tok + j - 2) * DM + ch); const unsigned ww[4] = {w.x, w.y, w.z, w.w};
#pragma unroll
                for (int i = 0; i < 4; ++i) { acc[2 * i] += cw[j * DM + ch + 2 * i] * bflo(ww[i]); acc[2 * i + 1] += cw[j * DM + ch + 2 * i + 1] * bfhi(ww[i]); } } }
        u32x4 o; o.x = pk2(acc[0], acc[1]); o.y = pk2(acc[2], acc[3]); o.z = pk2(acc[4], acc[5]); o.w = pk2(acc[6], acc[7]);
        *(u32x4*)(XC + (size_t)tok * DM + ch) = o; }
}
constexpr size_t CAR_ELEMS = (size_t)2 * 2 * 256 * DM;
__device__ __forceinline__ void phase_scan1(KArgs a) {
    const bf16_t* LA = (const bf16_t*)(a.ws + A_LA); const bf16_t* BB = (const bf16_t*)(a.ws + A_BB); float* CARA = (float*)(a.ws + A_CAR); float* CARB = CARA + CAR_ELEMS;
    const int NT = gridDim.x * 512;
    for (int it = blockIdx.x * 512 + opaque_tid(); it < 2 * 2 * 256 * 512; it += NT) { const int ch = (it & 511) * 4, chunk = (it >> 9) & 255, dir = (it >> 17) & 1, b = it >> 18;
        float h[4] = {0.f, 0.f, 0.f, 0.f}, ls[4] = {0.f, 0.f, 0.f, 0.f};
#pragma unroll 8
        for (int s = 0; s < 32; ++s) { const int t = chunk * 32 + (dir ? 31 - s : s); const size_t off = ((size_t)dir * NTOK + (size_t)b * SEQ + t) * DM + ch;
            const u32x2 lw = *(const u32x2*)(LA + off), bw = *(const u32x2*)(BB + off);
            const float l4[4] = {bflo(lw.x), bfhi(lw.x), bflo(lw.y), bfhi(lw.y)}, b4[4] = {bflo(bw.x), bfhi(bw.x), bflo(bw.y), bfhi(bw.y)};
#pragma unroll
            for (int i = 0; i < 4; ++i) { h[i] = __expf(l4[i]) * h[i] + b4[i]; ls[i] += l4[i]; } }
        const size_t co = (((size_t)b * 2 + dir) * 256 + chunk) * DM + ch;
        *(f32x4*)(CARA + co) = (f32x4){ls[0], ls[1], ls[2], ls[3]}; *(f32x4*)(CARB + co) = (f32x4){h[0], h[1], h[2], h[3]}; }
}
__device__ __forceinline__ void phase_scan2(KArgs a, LAS unsigned char* lds) {
    float* CARA = (float*)(a.ws + A_CAR); float* CARB = CARA + CAR_ELEMS; float* CARIN = CARB + CAR_ELEMS;
    const int tid = opaque_tid(), grp = tid >> 5, chl = tid & 31;
    LAS float* sh = (LAS float*)lds;
    for (int it = blockIdx.x; it < 2 * 2 * 64; it += gridDim.x) { const int ch = (it & 63) * 32 + chl, dir = (it >> 6) & 1, b = it >> 7;
        float la[16], lb[16]; float A = 0.f, B = 0.f;
#pragma unroll
        for (int k = 0; k < 16; ++k) { const int q = grp * 16 + k, chunk = dir ? 255 - q : q; const size_t co = (((size_t)b * 2 + dir) * 256 + chunk) * DM + ch; la[k] = CARA[co]; lb[k] = CARB[co]; }
#pragma unroll
        for (int k = 0; k < 16; ++k) { B = __expf(la[k]) * B + lb[k]; A += la[k]; }
        sh[(grp * 32 + chl) * 2] = A; sh[(grp * 32 + chl) * 2 + 1] = B;
        __syncthreads();
        float h = 0.f;
        for (int g2 = 0; g2 < grp; ++g2) h = __expf(sh[(g2 * 32 + chl) * 2]) * h + sh[(g2 * 32 + chl) * 2 + 1];
#pragma unroll
        for (int k = 0; k < 16; ++k) { const int q = grp * 16 + k, chunk = dir ? 255 - q : q; const size_t co = (((size_t)b * 2 + dir) * 256 + chunk) * DM + ch; CARIN[co] = h; h = __expf(la[k]) * h + lb[k]; }
        __syncthreads();
    }
}
__device__ __forceinline__ float gelu_tanh(float x) { const float u = 0.7978845608028654f * (x + 0.044715f * x * x * x); const float th = 1.0f - 2.0f * __builtin_amdgcn_rcpf(1.0f + __builtin_amdgcn_exp2f(2.8853900817779268f * u)); return 0.5f * x * (1.0f + th); }
__device__ __forceinline__ void phase_scan3(KArgs a) {
    const bf16_t* LA = (const bf16_t*)(a.ws + A_LA); const bf16_t* BB = (const bf16_t*)(a.ws + A_BB); const bf16_t* GB = (const bf16_t*)(a.ws + A_GB); bf16_t* YG = (bf16_t*)(a.ws + A_YG);
    const float* CARIN = (const float*)(a.ws + A_CAR) + 2 * CAR_ELEMS;
    const int NT = gridDim.x * 512;
    for (int it = blockIdx.x * 512 + opaque_tid(); it < 2 * 256 * 512; it += NT) { const int ch = (it & 511) * 4, chunk = (it >> 9) & 255, b = it >> 17;
        float hf[32][4]; float h[4];
        { const f32x4 c = *(const f32x4*)(CARIN + (((size_t)b * 2 + 0) * 256 + chunk) * DM + ch); h[0] = c[0]; h[1] = c[1]; h[2] = c[2]; h[3] = c[3]; }
#pragma unroll
        for (int s = 0; s < 32; ++s) { const size_t off = ((size_t)b * SEQ + chunk * 32 + s) * DM + ch;
            const u32x2 lw = *(const u32x2*)(LA + off), bw = *(const u32x2*)(BB + off);
            const float l4[4] = {bflo(lw.x), bfhi(lw.x), bflo(lw.y), bfhi(lw.y)}, b4[4] = {bflo(bw.x), bfhi(bw.x), bflo(bw.y), bfhi(bw.y)};
#pragma unroll
            for (int i = 0; i < 4; ++i) { h[i] = __expf(l4[i]) * h[i] + b4[i]; hf[s][i] = h[i]; } }
        { const f32x4 c = *(const f32x4*)(CARIN + (((size_t)b * 2 + 1) * 256 + chunk) * DM + ch); h[0] = c[0]; h[1] = c[1]; h[2] = c[2]; h[3] = c[3]; }
#pragma unroll
        for (int s = 31; s >= 0; --s) { const size_t tokoff = ((size_t)b * SEQ + chunk * 32 + s) * DM + ch; const size_t off = (size_t)NTOK * DM + tokoff;
            const u32x2 lw = *(const u32x2*)(LA + off), bw = *(const u32x2*)(BB + off), gw = *(const u32x2*)(GB + tokoff);
            const float l4[4] = {bflo(lw.x), bfhi(lw.x), bflo(lw.y), bfhi(lw.y)}, b4[4] = {bflo(bw.x), bfhi(bw.x), bflo(bw.y), bfhi(bw.y)}, g4[4] = {bflo(gw.x), bfhi(gw.x), bflo(gw.y), bfhi(gw.y)};
            float y[4];
#pragma unroll
            for (int i = 0; i < 4; ++i) { h[i] = __expf(l4[i]) * h[i] + b4[i]; y[i] = gelu_tanh(g4[i]) * (hf[s][i] + h[i]); }
            u32x2 w; w.x = pk2(y[0], y[1]); w.y = pk2(y[2], y[3]); *(u32x2*)(YG + tokoff) = w; } }
}

#define KARGS() (*(const __attribute__((address_space(4))) Args*)__builtin_amdgcn_kernarg_segment_ptr())
#define PHASE_FN __device__ __forceinline__ void
#define PH_PRE() KArgs a = KARGS(); LAS unsigned char* lds = (LAS unsigned char*)lds_raw; unsigned char* ws = a.ws; asm volatile("" : "+s"(ws)); const int G = gridDim.x, bx = blockIdx.x; (void)lds; (void)ws; (void)G; (void)bx; using namespace pg8
PHASE_FN ph0() { PH_PRE(); phase_prologue(a, lds); }
PHASE_FN ph1a() { PH_PRE(); Gemm g{(const bf16_t*)(ws + A_W4T), (const bf16_t*)(ws + A_H3B), 128, 128, 128}; StaticOrder S; S.init(4096, 8192, G, bx); EpiFilt E{(bf16_t*)(ws + A_KTD)}; gemm_phase(lds, g, S, E); }
PHASE_FN ph1b() { PH_PRE(); Gemm g{(const bf16_t*)(ws + A_XB), (const bf16_t*)(ws + WS_WIN_EV) + (size_t)3072 * DM, DM, DM, DM}; StaticOrder S; S.init(NTOK, 3072, G, bx);
                  EpiBf16 E{(bf16_t*)(ws + A_QB), 1024, 1024, (size_t)(A_KB - A_QB) / 2, QSCALE}; gemm_phase(lds, g, S, E); }
PHASE_FN ph1c() { PH_PRE(); Gemm g{(const bf16_t*)(ws + WS_WIN_EV), (const bf16_t*)(ws + A_XB), DM, DM, DM}; StaticOrder S; S.init(3072, NTOK, G, bx);
                  EpiBf16 E{(bf16_t*)(ws + A_UHT), NTOK, 0, 0, 1.f}; gemm_phase(lds, g, S, E); }
PHASE_FN ph2() { PH_PRE(); phase_filter_fft(a, lds); phase_qknorm(a, lds); }
PHASE_FN ph3a() { PH_PRE(); phase_hyena_mixer(a, lds); }
PHASE_FN ph3b() { PH_PRE(); phase_attention(a, lds); }
PHASE_FN ph4() { PH_PRE(); phase_concat(a, lds); }
PHASE_FN ph5() { PH_PRE(); Gemm g{(const bf16_t*)(ws + A_YCAT), (const bf16_t*)(ws + WS_WOUT_EV), DM, DM, DM}; StaticOrder S; S.init(NTOK, DM, G, bx);
                 EpiResBf E{(const bf16_t*)(ws + A_XB2), (bf16_t*)(ws + A_R0), DM, DN_ALPHA}; gemm_phase(lds, g, S, E); }
template <int LAYER> PHASE_FN ph_lnr() { PH_PRE(); unsigned* ctl = (unsigned*)(ws + WS_CTL);
    phase_ln_router(a, lds, (const bf16_t*)(ws + (LAYER ? A_R1 : A_R0)), a.in[28] + LAYER * DM, a.in[29] + LAYER * DM, (bf16_t*)(ws + (LAYER ? A_HB_1 : A_HB_0)),
                    ctl + CW_CNT + LAYER * 32 * 64, (int*)(ws + A_ROWL), (float*)(ws + A_GATEW)); }
template <int LAYER> PHASE_FN ph_moe1() { PH_PRE(); LAS int* tab = (LAS int*)(lds + LDS_MISC); moe_table(tab, (const unsigned*)(ws + WS_CTL) + CW_CNT + LAYER * 32 * 64);
    Gemm g{(const bf16_t*)(ws + (LAYER ? A_HB_1 : A_HB_0)), (const bf16_t*)(ws + WS_W1T) + (size_t)LAYER * 32 * 1024 * DM, DM, DM, DM}; MoeOrder<4, true> S{G, bx, tab, (const int*)(ws + A_ROWL)};
    EpiSwiglu E{(bf16_t*)(ws + (LAYER ? A_HID_1 : A_HID_0))}; gemm_phase(lds, g, S, E); }
template <int LAYER> PHASE_FN ph_moe2() { PH_PRE(); LAS int* tab = (LAS int*)(lds + LDS_MISC); moe_table(tab, (const unsigned*)(ws + WS_CTL) + CW_CNT + LAYER * 32 * 64);
    Gemm g{(const bf16_t*)(ws + (LAYER ? A_HID_1 : A_HID_0)), (const bf16_t*)(ws + WS_W2T) + (size_t)LAYER * 32 * DM * DFF, DFF, DFF, DFF}; MoeOrder<8, false> S{G, bx, tab, (const int*)(ws + A_ROWL)};
    EpiDown E{(bf16_t*)(ws + (LAYER ? A_Y2_1 : A_Y2_0)), (const int*)(ws + A_ROWL), (const float*)(ws + A_GATEW)}; gemm_phase(lds, g, S, E); }
template <int LAYER> PHASE_FN ph_ln2() { PH_PRE();
    phase_ln2((const bf16_t*)(ws + (LAYER ? A_HB_1 : A_HB_0)), (const bf16_t*)(ws + (LAYER ? A_Y2_1 : A_Y2_0)), a.in[30] + LAYER * DM, a.in[31] + LAYER * DM, LAYER ? a.out : nullptr, LAYER ? nullptr : (bf16_t*)(ws + A_HB2)); }
PHASE_FN ph10() { PH_PRE(); Gemm g{(const bf16_t*)(ws + A_HB2), (const bf16_t*)(ws + WS_WIN_OD), DM, DM, DM}; StaticOrder S; S.init(NTOK, 2 * DM, G, bx);
                  EpiBf16 E{(bf16_t*)(ws + A_GB), DM, DM, (size_t)(A_XR - A_GB) / 2, 1.f}; gemm_phase(lds, g, S, E); }
PHASE_FN ph11() { PH_PRE(); phase_conv4(a); }
PHASE_FN ph12() { PH_PRE(); Gemm g{(const bf16_t*)(ws + A_XC), (const bf16_t*)(ws + WS_WG_OD), DM, 256, 256}; RGOrder S{G, bx};
                  EpiRG E{(bf16_t*)(ws + A_LA), (bf16_t*)(ws + A_BB), (const bf16_t*)(ws + A_XC), a.in[23], a.in[25], a.in[26]}; gemm_phase(lds, g, S, E); }
PHASE_FN ph13() { PH_PRE(); phase_scan1(a); }
PHASE_FN ph14() { PH_PRE(); phase_scan2(a, lds); }
PHASE_FN ph15() { PH_PRE(); phase_scan3(a); }
PHASE_FN ph16() { PH_PRE(); Gemm g{(const bf16_t*)(ws + A_YG), (const bf16_t*)(ws + WS_WOUT_OD), DM, DM, DM}; StaticOrder S; S.init(NTOK, DM, G, bx);
                  EpiResBf E{(const bf16_t*)(ws + A_HB2), (bf16_t*)(ws + A_R1), DM, DN_ALPHA}; gemm_phase(lds, g, S, E); }

__global__ void __launch_bounds__(512, 2) fwd(Args a) {
    LAS unsigned char* lds = (LAS unsigned char*)lds_raw;
    unsigned* ctl = (unsigned*)(a.ws + WS_CTL);
    volatile LAS unsigned* bst = (volatile LAS unsigned*)(lds + LDS_MISC + 2048);
    { const int tid = threadIdx.x;
      if ((tid & 63) == 0) ((LAS int*)(lds + LDS_WIDTAB))[hw_slot()] = tid >> 6;
      if (tid < 4) bst[tid] = 0u; }
    __syncthreads();
    const int lo = a.ph_lo, hi = a.ph_hi;
    XcdBarrier bar; bar.bar = ctl + CW_BAR; bar.x = 0; bar.st = bst;
    if (hi - lo > 1) bar = xcd_barrier_post(ctl + CW_BAR, bst);
#ifdef ONLY_PHASE
#define IN(k) ((k) == ONLY_PHASE && lo <= (k) && (k) < hi)
#else
#define IN(k) (lo <= (k) && (k) < hi)
#endif
#define SEAM(k) do { if (IN(k) && IN((k) + 1)) xcd_barrier(bar); } while (0)
    if (IN(0)) { asm volatile("; PHASE_MARK 0"); ph0(); } SEAM(0);
    if (IN(1)) { asm volatile("; PHASE_MARK 1a"); ph1a(); asm volatile("; PHASE_MARK 1b"); ph1b(); asm volatile("; PHASE_MARK 1c"); ph1c(); } SEAM(1);
    if (IN(2)) { asm volatile("; PHASE_MARK 2"); ph2(); } SEAM(2);
    if (IN(3)) { asm volatile("; PHASE_MARK 3a"); ph3a(); asm volatile("; PHASE_MARK 3b"); ph3b(); } SEAM(3);
    if (IN(4)) { asm volatile("; PHASE_MARK 4"); ph4(); } SEAM(4);
    if (IN(5)) { asm volatile("; PHASE_MARK 5"); ph5(); } SEAM(5);
    if (IN(6)) { asm volatile("; PHASE_MARK 6"); ph_lnr<0>(); } SEAM(6);
    if (IN(7)) { asm volatile("; PHASE_MARK 7"); ph_moe1<0>(); } SEAM(7);
    if (IN(8)) { asm volatile("; PHASE_MARK 8"); ph_moe2<0>(); } SEAM(8);
    if (IN(9)) { asm volatile("; PHASE_MARK 9"); ph_ln2<0>(); } SEAM(9);
    if (IN(10)) { asm volatile("; PHASE_MARK 10"); ph10(); } SEAM(10);
    if (IN(11)) { asm volatile("; PHASE_MARK 11"); ph11(); } SEAM(11);
    if (IN(12)) { asm volatile("; PHASE_MARK 12"); ph12(); } SEAM(12);
    if (IN(13)) { asm volatile("; PHASE_MARK 13"); ph13(); } SEAM(13);
    if (IN(14)) { asm volatile("; PHASE_MARK 14"); ph14(); } SEAM(14);
    if (IN(15)) { asm volatile("; PHASE_MARK 15"); ph15(); } SEAM(15);
    if (IN(16)) { asm volatile("; PHASE_MARK 16"); ph16(); } SEAM(16);
    if (IN(17)) { asm volatile("; PHASE_MARK 17"); ph_lnr<1>(); } SEAM(17);
    if (IN(18)) { asm volatile("; PHASE_MARK 18"); ph_moe1<1>(); } SEAM(18);
    if (IN(19)) { asm volatile("; PHASE_MARK 19"); ph_moe2<1>(); } SEAM(19);
    if (IN(20)) { asm volatile("; PHASE_MARK 20"); ph_ln2<1>(); }
#undef IN
#undef SEAM
}

#ifndef MK_PER_PHASE
#define MK_PER_PHASE 0
#endif
extern "C" void kernel_launch(void* const* d_in, const int* in_sizes, int n_in, void* d_out, int out_size, void* d_ws, size_t ws_size, hipStream_t stream) {
    static int grid = 0;
    if (grid == 0) {
        if (n_in != 37 || out_size != NTOK * DM || ws_size < WS_END) { fprintf(stderr, "kernel_launch: built for 37 inputs, %d outputs, >= %zu bytes of workspace; got n_in %d out %d ws %zu\n", NTOK * DM, (size_t)WS_END, n_in, out_size, ws_size); grid = -1; return; }
        int dev = 0, cus = 0, per_cu = 0;
        if (hipGetDevice(&dev) != hipSuccess || hipDeviceGetAttribute(&cus, hipDeviceAttributeMultiprocessorCount, dev) != hipSuccess) { grid = -1; return; }
        if (hipFuncSetAttribute((const void*)fwd, hipFuncAttributeMaxDynamicSharedMemorySize, LDS_BYTES) != hipSuccess) { fprintf(stderr, "kernel_launch: hipFuncSetAttribute failed\n"); grid = -1; return; }
        if (hipOccupancyMaxActiveBlocksPerMultiprocessor(&per_cu, (const void*)fwd, 512, LDS_BYTES) != hipSuccess || per_cu < 1) fprintf(stderr, "kernel_launch: occupancy query reports %d\n", per_cu);
        (void)hipGetLastError();
        grid = cus;
    }
    if (grid < 0) return;
    (void)hipMemsetAsync((char*)d_ws + WS_CTL, 0, CTL_ZERO_BYTES, stream);
    Args a{};
    for (int i = 0; i < 37; ++i) a.in[i] = (const float*)d_in[i];
    a.out = (float*)d_out; a.ws = (unsigned char*)d_ws;
#if MK_PER_PHASE
    for (int p = 0; p < NPHASE; ++p) { a.ph_lo = p; a.ph_hi = p + 1; hipLaunchKernelGGL(fwd, dim3(grid), dim3(512), LDS_BYTES, stream, a); }
#else
    a.ph_lo = 0; a.ph_hi = NPHASE; hipLaunchKernelGGL(fwd, dim3(grid), dim3(512), LDS_BYTES, stream, a);
#endif
}
```

```cpp
#include <hip/hip_runtime.h>
#include <hip/hip_fp16.h>
#include <cstdio>
#include <cstdint>

#define GAS __attribute__((address_space(1)))
#define LAS __attribute__((address_space(3)))
typedef unsigned short bf16_t;
typedef short bf16x8 __attribute__((ext_vector_type(8)));
typedef short s16x4 __attribute__((ext_vector_type(4)));
typedef float f32x2 __attribute__((ext_vector_type(2)));
typedef float f32x4 __attribute__((ext_vector_type(4)));
typedef float f32x8 __attribute__((ext_vector_type(8)));
typedef float f32x16 __attribute__((ext_vector_type(16)));
typedef unsigned u32x2 __attribute__((ext_vector_type(2)));
typedef unsigned u32x4 __attribute__((ext_vector_type(4)));
typedef GAS unsigned gu32;

constexpr int DM = 2048, BATCH = 2, SEQ = 8192, NTOK = BATCH * SEQ;
constexpr int HY_CH = 1024, EV_IN = 6144;
constexpr int NEXP = 32, DFF = 512, NASSIGN = NTOK * 2, ECAP = NASSIGN;
constexpr float LN_EPS = 1e-5f;
constexpr float DN_ALPHA = 1.4142135623730951f;
constexpr float QSCALE = 0.125f * 1.4426950408889634f;
constexpr int FFT_N = 16384, FFT_RS = 528;

__device__ __forceinline__ unsigned f2bf(float f) { unsigned u = __builtin_bit_cast(unsigned, f); return (u + 0x7fffu + ((u >> 16) & 1u)) >> 16; }
__device__ __forceinline__ unsigned pk2(float lo, float hi) { return f2bf(lo) | (f2bf(hi) << 16); }
__device__ __forceinline__ float bf2f(unsigned short h) { return __builtin_bit_cast(float, (unsigned)h << 16); }
__device__ __forceinline__ float bflo(unsigned w) { return __builtin_bit_cast(float, w << 16); }
__device__ __forceinline__ float bfhi(unsigned w) { return __builtin_bit_cast(float, w & 0xffff0000u); }
__device__ __forceinline__ unsigned cvt_pk_bf16(float lo, float hi) { unsigned r; asm volatile("v_cvt_pk_bf16_f32 %0, %1, %2" : "=v"(r) : "v"(lo), "v"(hi)); return r; }
__device__ __forceinline__ float wave_sum(float v) {
#pragma unroll
    for (int o = 1; o < 64; o <<= 1) v += __shfl_xor(v, o);
    return v;
}
__device__ __forceinline__ float sigmoidf_(float x) { return __builtin_amdgcn_rcpf(1.0f + __builtin_amdgcn_exp2f(-1.4426950408889634f * x)); }
constexpr int LDS_WIDTAB = 139264 + 3072;
__device__ __forceinline__ int hw_slot() { return (int)(__builtin_amdgcn_s_getreg((5 << 11) | 4) & 63u); }
__device__ __forceinline__ int lane_id() { return (int)__builtin_amdgcn_mbcnt_hi(~0u, __builtin_amdgcn_mbcnt_lo(~0u, 0u)); }
extern __shared__ __attribute__((aligned(16))) unsigned char lds_raw[];
__device__ __forceinline__ int wave_id() { return __builtin_amdgcn_readfirstlane(((const LAS int*)((LAS unsigned char*)lds_raw + LDS_WIDTAB))[hw_slot()]); }
__device__ __forceinline__ int opaque_tid() { int t = wave_id() * 64 + lane_id(); asm volatile("" : "+v"(t)); return t; }
#define LDS_WAIT() asm volatile("s_waitcnt lgkmcnt(0)" ::: "memory")
#define VM_WAIT() asm volatile("s_waitcnt vmcnt(0)" ::: "memory")

#define XB_TMO      128
#define XB_XCNT(j)  (256  + 64 * (j))
#define XB_XSUB(j)  (1280 + 64 * (j))
#define XB_XGEN(j)  (2304 + 64 * (j))
#define XB_TOP      3328
#define XB_TOPGEN   3392
#define XCD_BAR_WORDS 3456
#define XB_SPIN_CAP (1u << 18)
__device__ __forceinline__ unsigned xb_ld(unsigned* p)              { return __hip_atomic_load(p, __ATOMIC_RELAXED, __HIP_MEMORY_SCOPE_AGENT); }
__device__ __forceinline__ unsigned xb_add(unsigned* p, unsigned v) { return __hip_atomic_fetch_add(p, v, __ATOMIC_RELAXED, __HIP_MEMORY_SCOPE_AGENT); }
__device__ __forceinline__ unsigned xb_xcc_id() { return (unsigned)__builtin_amdgcn_s_getreg((3 << 11) | 20) & 0xFu; }
#define XB_SPIN(cond, bar) do { unsigned _sp = 0; while (cond) { __builtin_amdgcn_s_sleep(1); \
    if ((++_sp & 255u) == 0u) { if (xb_ld(&(bar)[XB_TMO])) break; if (_sp > XB_SPIN_CAP) { atomicAdd(&(bar)[XB_TMO], 1u); break; } } } } while (0)
struct XcdBarrier { unsigned* bar; unsigned x; volatile LAS unsigned* st; };
__device__ __forceinline__ XcdBarrier xcd_barrier_post(unsigned* bar, volatile LAS unsigned* st) {
    XcdBarrier b; b.bar = bar; b.x = xb_xcc_id(); b.st = st;
    if (opaque_tid() == 0) (void)xb_add(&bar[XB_XCNT(b.x)], 1u);
    return b;
}
__device__ __forceinline__ void xcd_barrier_complete(unsigned* bar, unsigned x, unsigned& nloc, unsigned& nx) {
    const unsigned G = gridDim.x * gridDim.y * gridDim.z;
    unsigned sum, cnt, mine, sp = 0u;
    for (;;) {
        sum = 0u; cnt = 0u; mine = 0u;
#pragma unroll
        for (unsigned j = 0; j < 16; ++j) { const unsigned c = xb_ld(&bar[XB_XCNT(j)]); sum += c; cnt += (c > 0u) ? 1u : 0u; mine = (j == x) ? c : mine; }
        if (sum == G) break;
        __builtin_amdgcn_s_sleep(1);
        if ((++sp & 255u) == 0u) { if (xb_ld(&bar[XB_TMO])) break; if (sp > XB_SPIN_CAP) { atomicAdd(&bar[XB_TMO], 1u); break; } }
    }
    nloc = mine > 0u ? mine : 1u; nx = cnt > 0u ? cnt : 1u;
}
__device__ __forceinline__ void xcd_barrier(const XcdBarrier& b) {
    asm volatile("s_waitcnt vmcnt(0)" ::: "memory");
    __syncthreads();
    if (opaque_tid() == 0) {
        unsigned* bar = b.bar;
        __builtin_amdgcn_s_waitcnt(0);
        unsigned nloc = b.st[0], nx = b.st[1];
        if (nloc == 0u) { xcd_barrier_complete(bar, b.x, nloc, nx); b.st[0] = nloc; b.st[1] = nx; }
        const unsigned old = xb_add(&bar[XB_XSUB(b.x)], 1u);
        const unsigned gen = old / nloc;
        if (old + 1u == (gen + 1u) * nloc) {
            __builtin_amdgcn_fence(__ATOMIC_RELEASE, "agent");
            asm volatile("s_waitcnt vmcnt(0)" ::: "memory");
            const unsigned og = xb_add(&bar[XB_TOP], 1u);
            const unsigned tg = og / nx;
            if (og + 1u == (tg + 1u) * nx) xb_add(&bar[XB_TOPGEN], 1u);
            else XB_SPIN(xb_ld(&bar[XB_TOPGEN]) == tg, bar);
            __builtin_amdgcn_fence(__ATOMIC_ACQUIRE, "agent");
            xb_add(&bar[XB_XGEN(b.x)], 1u);
            asm volatile("s_waitcnt vmcnt(0)" ::: "memory");
        } else {
            XB_SPIN(xb_ld(&bar[XB_XGEN(b.x)]) == gen, bar);
            __builtin_amdgcn_fence(__ATOMIC_ACQUIRE, "agent");
            asm volatile("s_waitcnt vmcnt(0)" ::: "memory");
        }
    }
    __syncthreads();
}

namespace pg8 {
constexpr int BM = 256, BK = 64, HALF = 128, HTB = HALF * BK * 2, STAGE_BYTES = 8 * HTB, NXCD = 8, WGM = 8;
__host__ __device__ __forceinline__ int lds_byte(int r, int c) { const int st = (r >> 4) * 2 + (c >> 5), rr = r & 15, cc = c & 31, ob = rr * 64 + cc * 2; return st * 1024 + (ob ^ (((ob >> 9) & 1) << 5)); }
__host__ __device__ __forceinline__ void stage_rc(int b, int& R, int& C) { const int st = b / 1024, sb = b % 1024, swz = sb ^ (((sb >> 9) & 1) << 5); R = (st >> 1) * 16 + swz / 64; C = (st & 1) * 32 + (swz % 64) / 2; }
__host__ __device__ __forceinline__ int perm32(int rho) { const int n = rho >> 4, i = rho & 15; return 8 * (i >> 2) + 4 * n + (i & 3); }

struct Unit { int pm, pn, e, t, cnt; };
struct Gemm { const bf16_t* A; const bf16_t* Bt; int lda, ldb, K; };

struct StaticOrder {
    static constexpr bool GATHER_A = false;
    int nM, nN, nwg, G, c;
    __device__ void init(int M, int N, int G_, int c_) { nM = M / BM; nN = N / BM; nwg = nM * nN; G = G_; c = c_; }
    __device__ __forceinline__ bool next(int i, Unit& u) const {
        const long L = (long)i * G + c; if (L >= nwg) return false;
        int wgid = (int)L; { const int q = nwg / NXCD, r = nwg % NXCD, xcd = wgid % NXCD, off = wgid / NXCD; wgid = (xcd < r ? xcd * (q + 1) : r * (q + 1) + (xcd - r) * q) + off; }
        const int nig = WGM * nN, gid = wgid / nig, fm = gid * WGM, gsz = (nM - fm) < WGM ? (nM - fm) : WGM;
        u.pm = fm + ((wgid % nig) % gsz); u.pn = (wgid % nig) / gsz; u.e = 0; u.t = 0; u.cnt = 0; return true;
    }
    __device__ __forceinline__ int rowA(const Unit& u, int r) const { return u.pm * BM + r; }
    __device__ __forceinline__ int colA(const Unit&) const { return 0; }
    __device__ __forceinline__ int rowB(const Unit& u, int r) const { return u.pn * BM + r; }
};

typedef int v8i32 __attribute__((ext_vector_type(8)));
template <class Epi, class Sched, bool FP8 = false>
__device__ __forceinline__ void gemm_phase(LAS unsigned char* lds, const Gemm g, const Sched& S, const Epi& E) {
    const int tid = opaque_tid(), wid = __builtin_amdgcn_readfirstlane(tid >> 6), lane = tid & 63, wr = wid >> 2, wc = wid & 3, fr = lane & 15, fq = lane >> 4;
    const int K = g.K, nt = K / BK;
    constexpr bool GA = Sched::GATHER_A;
    int sR[2], sC[2];
    unsigned laneA[2], laneB[2];
#pragma unroll
    for (int i = 0; i < 2; ++i) { int R, C; stage_rc(tid * 16 + i * 8192, R, C); sR[i] = R; sC[i] = C; const int Rb = Epi::PERM ? ((R & ~31) + perm32(R & 31)) : R;
        laneA[i] = (unsigned)(R * g.lda + C) * 2u; laneB[i] = (unsigned)(Rb * g.ldb + C) * 2u; }
    const size_t hstepA = (size_t)HALF * g.lda * 2, hstepB = (size_t)HALF * g.ldb * 2;
    const unsigned ldsw = (unsigned)wid * 1024u;
    const int aoff = lds_byte(wr * 64 + fr, fq * 8), boff = lds_byte(wc * 32 + fr, fq * 8);
    const char* gA = (const char*)g.A; const char* gB = (const char*)g.Bt;
#define PG8_SA(b, h) (((b) * 2 + (h)) * HTB)
#define PG8_SB(b, h) ((4 + (b) * 2 + (h)) * HTB)
#define PG8_STAGE(bufoff, gptr, voff) do { _Pragma("unroll") for (int _i = 0; _i < 2; ++_i) \
        __builtin_amdgcn_global_load_lds((const unsigned*)((gptr) + (size_t)(voff)[_i]), (LAS unsigned*)(lds + (bufoff) + ldsw + _i * 8192), 16, 0, 0); } while (0)
#define PG8_STAGE_B(bufoff, ub, h, kb) PG8_STAGE(bufoff, gB + (ub) + (size_t)(h) * hstepB + (size_t)(kb), laneB)
#define PG8_STAGE_A(bufoff, ub, va, h, kb) do { if constexpr (GA) { PG8_STAGE(bufoff, gA + (size_t)(kb), va[h]); } else { PG8_STAGE(bufoff, gA + (ub) + (size_t)(h) * hstepA + (size_t)(kb), laneA); } } while (0)
#define PG8_RD(off) (*(const LAS u32x4*)(lds + (off)))
#define PG8_CAT2(x, y) __builtin_bit_cast(v8i32, __builtin_shufflevector((x), (y), 0, 1, 2, 3, 4, 5, 6, 7))
#define PG8_LDA(dst, b, h) do { if constexpr (FP8) { _Pragma("unroll") for (int m = 0; m < 4; ++m) dst##8[m] = PG8_CAT2(PG8_RD(PG8_SA(b, h) + aoff + m * 2048), PG8_RD(PG8_SA(b, h) + aoff + m * 2048 + 1024)); } \
        else { _Pragma("unroll") for (int m = 0; m < 4; ++m) _Pragma("unroll") for (int k = 0; k < 2; ++k) dst[m][k] = *(const LAS bf16x8*)(lds + PG8_SA(b, h) + aoff + m * 2048 + k * 1024); } } while (0)
#define PG8_LDB(dst, b, h) do { if constexpr (FP8) { _Pragma("unroll") for (int n = 0; n < 2; ++n) dst##8[n] = PG8_CAT2(PG8_RD(PG8_SB(b, h) + boff + n * 2048), PG8_RD(PG8_SB(b, h) + boff + n * 2048 + 1024)); } \
        else { _Pragma("unroll") for (int n = 0; n < 2; ++n) _Pragma("unroll") for (int k = 0; k < 2; ++k) dst[n][k] = *(const LAS bf16x8*)(lds + PG8_SB(b, h) + boff + n * 2048 + k * 1024); } } while (0)
#define PG8_MMA(ai, bj, At, Bt) do { __builtin_amdgcn_s_setprio(1); _Pragma("unroll") for (int m = 0; m < 4; ++m) _Pragma("unroll") for (int n = 0; n < 2; ++n) { \
        if constexpr (FP8) { asm volatile("v_mfma_scale_f32_16x16x128_f8f6f4 %0, %1, %2, %0, %3, %3 op_sel_hi:[0,0,0]" : "+v"(acc[ai][bj][m][n]) : "v"(Bt##8[n]), "v"(At##8[m]), "v"(fp8_one)); } \
        else { _Pragma("unroll") for (int k = 0; k < 2; ++k) acc[ai][bj][m][n] = __builtin_amdgcn_mfma_f32_16x16x32_bf16(Bt[n][k], At[m][k], acc[ai][bj][m][n], 0, 0, 0); } } \
        __builtin_amdgcn_s_setprio(0); } while (0)
#define PG8_WAIT_V(n) asm volatile("s_waitcnt vmcnt(" #n ")" ::: "memory")
#define PG8_WAIT_L(n) asm volatile("s_waitcnt lgkmcnt(" #n ")" ::: "memory")
#define PG8_BAR __builtin_amdgcn_s_barrier()
#define PG8_SCHED __builtin_amdgcn_sched_barrier(0)
#define PG8_SCHED8 do { if constexpr (FP8) __builtin_amdgcn_sched_barrier(0); } while (0)
#define PG8_OFFS(u, ubA, ubB, vA) do { ubB = ((size_t)S.rowB(u, 0) * (size_t)g.ldb) * 2; \
        if constexpr (GA) { ubA = 0; _Pragma("unroll") for (int _h = 0; _h < 2; ++_h) _Pragma("unroll") for (int _i = 0; _i < 2; ++_i) vA[_h][_i] = ((unsigned)S.rowA(u, _h * HALF + sR[_i]) * (unsigned)g.lda + (unsigned)sC[_i]) * 2u; } \
        else { ubA = ((size_t)S.rowA(u, 0) * (size_t)g.lda + (size_t)S.colA(u)) * 2; } } while (0)
    Unit cur, nxt; int ui = 0;
    if (!S.next(0, cur)) return;
    f32x4 acc[2][2][4][2];
#pragma unroll
    for (int a = 0; a < 2; ++a)
#pragma unroll
        for (int b = 0; b < 2; ++b)
#pragma unroll
            for (int m = 0; m < 4; ++m)
#pragma unroll
                for (int n = 0; n < 2; ++n) acc[a][b][m][n] = (f32x4){0.f, 0.f, 0.f, 0.f};
    const int fp8_one = 0x7f7f7f7f;
    bf16x8 At[4][2], B0[2][2], B1[2][2]; v8i32 At8[4], B08[2], B18[2];
    size_t ubAc, ubBc, ubAn, ubBn; unsigned vAc[2][2] = {}, vAn[2][2] = {};
    PG8_OFFS(cur, ubAc, ubBc, vAc);
    PG8_STAGE_B(PG8_SB(0, 0), ubBc, 0, 0); PG8_STAGE_B(PG8_SB(0, 1), ubBc, 1, 0); PG8_STAGE_A(PG8_SA(0, 0), ubAc, vAc, 0, 0); PG8_STAGE_A(PG8_SA(0, 1), ubAc, vAc, 1, 0);
    if (wr == 1) PG8_BAR;
    PG8_WAIT_V(2); PG8_BAR;
    PG8_STAGE_B(PG8_SB(1, 0), ubBc, 0, 128); PG8_STAGE_A(PG8_SA(1, 0), ubAc, vAc, 0, 128); PG8_STAGE_B(PG8_SB(1, 1), ubBc, 1, 128);
    PG8_WAIT_V(6); PG8_BAR;
    for (;;) {
        const bool has_next = S.next(ui + 1, nxt);
        if (has_next) { PG8_OFFS(nxt, ubAn, ubBn, vAn); }
        else { ubAn = ubAc; ubBn = ubBc;
#pragma unroll
            for (int h = 0; h < 2; ++h)
#pragma unroll
                for (int i = 0; i < 2; ++i) vAn[h][i] = vAc[h][i]; }
        for (int t = 0; t < nt; t += 2) {
            const bool last = (t == nt - 2);
            const unsigned k1 = (unsigned)(t + 1) * 128u, k2 = last ? 0u : (unsigned)(t + 2) * 128u, k3 = k2 + 128u;
            const size_t xubA = last ? ubAn : ubAc, xubB = last ? ubBn : ubBc;
            unsigned xA[2][2];
#pragma unroll
            for (int h = 0; h < 2; ++h)
#pragma unroll
                for (int i = 0; i < 2; ++i) xA[h][i] = last ? vAn[h][i] : vAc[h][i];
            PG8_LDB(B0, 0, 0); PG8_LDB(B1, 0, 1); PG8_SCHED; PG8_LDA(At, 0, 0); PG8_STAGE_A(PG8_SA(1, 1), ubAc, vAc, 1, k1);
            PG8_WAIT_V(8); PG8_WAIT_L(0); PG8_SCHED8; PG8_BAR; PG8_MMA(0, 0, At, B0); PG8_MMA(0, 1, At, B1); PG8_SCHED8; PG8_BAR; PG8_SCHED;
            PG8_LDA(At, 0, 1); PG8_STAGE_B(PG8_SB(0, 0), xubB, 0, k2); PG8_STAGE_B(PG8_SB(0, 1), xubB, 1, k2); PG8_STAGE_A(PG8_SA(0, 0), xubA, xA, 0, k2);
            PG8_WAIT_V(8); PG8_WAIT_L(0); PG8_SCHED8; PG8_BAR; PG8_MMA(1, 0, At, B0); PG8_MMA(1, 1, At, B1); PG8_SCHED8; PG8_BAR; PG8_SCHED;
            PG8_LDB(B0, 1, 0); PG8_LDB(B1, 1, 1); PG8_SCHED; PG8_LDA(At, 1, 0); PG8_STAGE_A(PG8_SA(0, 1), xubA, xA, 1, k2);
            PG8_WAIT_V(8); PG8_WAIT_L(0); PG8_SCHED8; PG8_BAR; PG8_MMA(0, 0, At, B0); PG8_MMA(0, 1, At, B1); PG8_SCHED8; PG8_BAR; PG8_SCHED;
            PG8_LDA(At, 1, 1); PG8_STAGE_B(PG8_SB(1, 0), xubB, 0, k3); PG8_STAGE_B(PG8_SB(1, 1), xubB, 1, k3); PG8_STAGE_A(PG8_SA(1, 0), xubA, xA, 0, k3);
            PG8_WAIT_V(8); PG8_WAIT_L(0); PG8_SCHED8; PG8_BAR; PG8_MMA(1, 0, At, B0); PG8_MMA(1, 1, At, B1); PG8_SCHED8; PG8_BAR; PG8_SCHED;
        }
        if (wr == 0) PG8_BAR;
        E(acc, cur, wr, wc, fr, fq);
        if (!has_next) break;
#pragma unroll
        for (int a = 0; a < 2; ++a)
#pragma unroll
            for (int b = 0; b < 2; ++b)
#pragma unroll
                for (int m = 0; m < 4; ++m)
#pragma unroll
                    for (int n = 0; n < 2; ++n) acc[a][b][m][n] = (f32x4){0.f, 0.f, 0.f, 0.f};
        cur = nxt; ++ui; ubAc = ubAn; ubBc = ubBn;
#pragma unroll
        for (int h = 0; h < 2; ++h)
#pragma unroll
            for (int i = 0; i < 2; ++i) vAc[h][i] = vAn[h][i];
        if (wr == 1) PG8_BAR;
    }
    PG8_WAIT_V(0);
    PG8_BAR;
#undef PG8_SA
#undef PG8_SB
#undef PG8_STAGE
#undef PG8_STAGE_A
#undef PG8_STAGE_B
#undef PG8_LDA
#undef PG8_LDB
#undef PG8_MMA
#undef PG8_RD
#undef PG8_CAT2
#undef PG8_WAIT_V
#undef PG8_WAIT_L
#undef PG8_BAR
#undef PG8_SCHED
#undef PG8_SCHED8
#undef PG8_OFFS
}
}
namespace pg8 {
struct EpiBf16 {
    static constexpr bool PERM = true;
    bf16_t* O; int ldc; int split_cols; size_t split_stride; float scale0;
    __device__ __forceinline__ void operator()(const f32x4 (&acc)[2][2][4][2], const Unit& u, int wr, int wc, int fr, int fq) const {
        const int row0 = u.pm * BM + wr * 64 + fr; int colt = u.pn * BM; bf16_t* base = O;
        float sc = 1.f; if (split_cols) { const int t = colt / split_cols; base += (size_t)t * split_stride; colt -= t * split_cols; if (t == 0) sc = scale0; }
        const int col0 = colt + wc * 32 + 8 * fq;
#pragma unroll
        for (int ai = 0; ai < 2; ++ai)
#pragma unroll
            for (int m = 0; m < 4; ++m) { bf16_t* rowp = base + (size_t)(row0 + ai * HALF + m * 16) * ldc + col0;
#pragma unroll
                for (int bj = 0; bj < 2; ++bj) { const f32x4 v0 = acc[ai][bj][m][0] * sc, v1 = acc[ai][bj][m][1] * sc;
                    u32x4 w; w.x = cvt_pk_bf16(v0[0], v0[1]); w.y = cvt_pk_bf16(v0[2], v0[3]); w.z = cvt_pk_bf16(v1[0], v1[1]); w.w = cvt_pk_bf16(v1[2], v1[3]);
                    *(u32x4*)(rowp + bj * HALF) = w; } }
    }
};
struct EpiFilt {
    static constexpr bool PERM = true;
    bf16_t* O;
    __device__ __forceinline__ void operator()(const f32x4 (&acc)[2][2][4][2], const Unit& u, int wr, int wc, int fr, int fq) const {
        const float dmin = -3.0701134573253945f, dmax = -15.350567286626973f;
#pragma unroll
        for (int ai = 0; ai < 2; ++ai)
#pragma unroll
            for (int m = 0; m < 4; ++m) { const int row = u.pm * BM + ai * HALF + wr * 64 + m * 16 + fr; const int c = row & 1023;
                const float dl2 = fabsf(dmin + (float)c * ((dmax - dmin) / 1023.0f)) * (1.4426950408889634f / 8191.0f);
#pragma unroll
                for (int bj = 0; bj < 2; ++bj) { const int col = u.pn * BM + bj * HALF + wc * 32 + 8 * fq; float v[8];
#pragma unroll
                    for (int n = 0; n < 2; ++n)
#pragma unroll
                        for (int j = 0; j < 4; ++j) v[n * 4 + j] = acc[ai][bj][m][n][j] * __builtin_amdgcn_exp2f(-(float)(col + n * 4 + j) * dl2);
                    u32x4 w; w.x = cvt_pk_bf16(v[0], v[1]); w.y = cvt_pk_bf16(v[2], v[3]); w.z = cvt_pk_bf16(v[4], v[5]); w.w = cvt_pk_bf16(v[6], v[7]);
                    *(u32x4*)(O + (size_t)row * 8192 + col) = w; }
                asm volatile("" ::: "memory"); }
    }
};
struct EpiResF32 {
    static constexpr bool PERM = false;
    const float* res; float* O; int ldc; float alpha;
    __device__ __forceinline__ void operator()(const f32x4 (&acc)[2][2][4][2], const Unit& u, int wr, int wc, int fr, int fq) const {
#pragma unroll
        for (int ai = 0; ai < 2; ++ai)
#pragma unroll
            for (int m = 0; m < 4; ++m) { const size_t off = (size_t)(u.pm * BM + ai * HALF + wr * 64 + m * 16 + fr) * ldc + u.pn * BM + wc * 32 + 4 * fq;
#pragma unroll
                for (int bj = 0; bj < 2; ++bj)
#pragma unroll
                    for (int n = 0; n < 2; ++n) { const f32x4 r = *(const f32x4*)(res + off + bj * HALF + n * 16); *(f32x4*)(O + off + bj * HALF + n * 16) = r * alpha + acc[ai][bj][m][n]; }
                if (m & 1) asm volatile("" ::: "memory"); }
    }
};
struct EpiResBf {
    static constexpr bool PERM = true;
    const bf16_t* res; bf16_t* O; int ldc; float alpha;
    __device__ __forceinline__ void operator()(const f32x4 (&acc)[2][2][4][2], const Unit& u, int wr, int wc, int fr, int fq) const {
#pragma unroll
        for (int ai = 0; ai < 2; ++ai)
#pragma unroll
            for (int m = 0; m < 4; ++m) { const size_t off = (size_t)(u.pm * BM + ai * HALF + wr * 64 + m * 16 + fr) * ldc + u.pn * BM + wc * 32 + 8 * fq;
#pragma unroll
                for (int bj = 0; bj < 2; ++bj) { const u32x4 r = *(const u32x4*)(res + off + bj * HALF); const f32x4 a0 = acc[ai][bj][m][0], a1 = acc[ai][bj][m][1];
                    u32x4 w; w.x = cvt_pk_bf16(bflo(r.x) * alpha + a0[0], bfhi(r.x) * alpha + a0[1]); w.y = cvt_pk_bf16(bflo(r.y) * alpha + a0[2], bfhi(r.y) * alpha + a0[3]);
                    w.z = cvt_pk_bf16(bflo(r.z) * alpha + a1[0], bfhi(r.z) * alpha + a1[1]); w.w = cvt_pk_bf16(bflo(r.w) * alpha + a1[2], bfhi(r.w) * alpha + a1[3]);
                    *(u32x4*)(O + off + bj * HALF) = w; }
                if (m & 1) asm volatile("" ::: "memory"); }
    }
};
struct EpiSwiglu {
    static constexpr bool PERM = true;
    bf16_t* O;
    __device__ __forceinline__ void operator()(const f32x4 (&acc)[2][2][4][2], const Unit& u, int wr, int wc, int fr, int fq) const {
#pragma unroll
        for (int ai = 0; ai < 2; ++ai)
#pragma unroll
            for (int m = 0; m < 4; ++m) { bf16_t* p = O + (size_t)(u.pm * BM + ai * HALF + wr * 64 + m * 16 + fr) * DFF + u.pn * HALF + wc * 32 + 8 * fq;
                float h[8];
#pragma unroll
                for (int n = 0; n < 2; ++n)
#pragma unroll
                    for (int j = 0; j < 4; ++j) { const float gt = acc[ai][0][m][n][j], up = acc[ai][1][m][n][j]; h[n * 4 + j] = gt * sigmoidf_(gt) * up; }
                u32x4 w; w.x = cvt_pk_bf16(h[0], h[1]); w.y = cvt_pk_bf16(h[2], h[3]); w.z = cvt_pk_bf16(h[4], h[5]); w.w = cvt_pk_bf16(h[6], h[7]);
                *(u32x4*)p = w; }
    }
};
__device__ __forceinline__ unsigned pk4_fp8(float a, float b, float c, float d) { int w = 0; w = __builtin_amdgcn_cvt_pk_fp8_f32(a, b, w, false); w = __builtin_amdgcn_cvt_pk_fp8_f32(c, d, w, true); return (unsigned)w; }
constexpr float FP8_SW = 64.0f, FP8_SH = 8.0f;
struct EpiSwiglu8 {
    static constexpr bool PERM = true;
    unsigned char* O;
    __device__ __forceinline__ void operator()(const f32x4 (&acc)[2][2][4][2], const Unit& u, int wr, int wc, int fr, int fq) const {
#pragma unroll
        for (int ai = 0; ai < 2; ++ai)
#pragma unroll
            for (int m = 0; m < 4; ++m) { unsigned char* p = O + (size_t)(u.pm * BM + ai * HALF + wr * 64 + m * 16 + fr) * DFF + u.pn * HALF + wc * 32 + 8 * fq;
                float h[8];
#pragma unroll
                for (int n = 0; n < 2; ++n)
#pragma unroll
                    for (int j = 0; j < 4; ++j) { const float gt = acc[ai][0][m][n][j] * (1.0f / FP8_SW), up = acc[ai][1][m][n][j] * (1.0f / FP8_SW); h[n * 4 + j] = gt * sigmoidf_(gt) * up * FP8_SH; }
                u32x2 w; w.x = pk4_fp8(h[0], h[1], h[2], h[3]); w.y = pk4_fp8(h[4], h[5], h[6], h[7]);
                *(u32x2*)p = w; }
    }
};
struct EpiDown {
    static constexpr bool PERM = true;
    bf16_t* O; const int* rowlist; const float* gatew; float oscale;
    __device__ __forceinline__ void operator()(const f32x4 (&acc)[2][2][4][2], const Unit& u, int wr, int wc, int fr, int fq) const {
#pragma unroll
        for (int ai = 0; ai < 2; ++ai)
#pragma unroll
            for (int m = 0; m < 4; ++m) { const int idx = u.t * BM + ai * HALF + wr * 64 + m * 16 + fr;
                if (idx < u.cnt) { const int a = rowlist[(size_t)u.e * ECAP + idx]; const float gw = gatew[a] * oscale;
                    bf16_t* p = O + (size_t)a * DM + u.pn * BM + wc * 32 + 8 * fq;
#pragma unroll
                    for (int bj = 0; bj < 2; ++bj) { const f32x4 v0 = acc[ai][bj][m][0] * gw, v1 = acc[ai][bj][m][1] * gw;
                        u32x4 w; w.x = cvt_pk_bf16(v0[0], v0[1]); w.y = cvt_pk_bf16(v0[2], v0[3]); w.z = cvt_pk_bf16(v1[0], v1[1]); w.w = cvt_pk_bf16(v1[2], v1[3]);
                        *(u32x4*)(p + bj * HALF) = w; } } }
    }
};
struct EpiRG {
    static constexpr bool PERM = true;
    bf16_t* LA; bf16_t* BB; const bf16_t* XC; const float* ba; const float* bx; const float* lam;
    __device__ __forceinline__ void operator()(const f32x4 (&acc)[2][2][4][2], const Unit& u, int wr, int wc, int fr, int fq) const {
        const int nb = u.pn >> 2, q = u.pn & 3, dir = q >> 1, half = q & 1;
        const int ch0 = nb * 256 + half * HALF + wc * 32 + 8 * fq;
        float vba[8], vbx[8], vsp[8];
#pragma unroll
        for (int j = 0; j < 8; ++j) { vba[j] = ba[dir * DM + ch0 + j]; vbx[j] = bx[dir * DM + ch0 + j];
            const float x = __expf(-lam[dir * DM + ch0 + j]);
            vsp[j] = 8.0f * (x < 0.05f ? x * (1.0f - x * (0.5f - x * (0.33333334f - 0.25f * x))) : __logf(1.0f + x)); }
#pragma unroll
        for (int ai = 0; ai < 2; ++ai)
#pragma unroll
            for (int m = 0; m < 4; ++m) { const size_t tok = (size_t)(u.pm * BM + ai * HALF + wr * 64 + m * 16 + fr);
                asm volatile("" ::: "memory");
                const u32x4 xw = *(const u32x4*)(XC + tok * DM + ch0);
                float xf[8] = {bflo(xw.x), bfhi(xw.x), bflo(xw.y), bfhi(xw.y), bflo(xw.z), bfhi(xw.z), bflo(xw.w), bfhi(xw.w)};
                float la[8], bb[8];
#pragma unroll
                for (int n = 0; n < 2; ++n)
#pragma unroll
                    for (int j = 0; j < 4; ++j) { const int k = n * 4 + j;
                        const float r = sigmoidf_(acc[ai][0][m][n][j] + vba[k]), ig = sigmoidf_(acc[ai][1][m][n][j] + vbx[k]);
                        const float l = -r * vsp[k]; la[k] = l; bb[k] = __builtin_amdgcn_sqrtf(fmaxf(1.0f - __builtin_amdgcn_exp2f(2.8853900817779268f * l), 0.f)) * (ig * xf[k]); }
                u32x4 w; w.x = cvt_pk_bf16(la[0], la[1]); w.y = cvt_pk_bf16(la[2], la[3]); w.z = cvt_pk_bf16(la[4], la[5]); w.w = cvt_pk_bf16(la[6], la[7]);
                *(u32x4*)(LA + ((size_t)dir * NTOK + tok) * DM + ch0) = w;
                w.x = cvt_pk_bf16(bb[0], bb[1]); w.y = cvt_pk_bf16(bb[2], bb[3]); w.z = cvt_pk_bf16(bb[4], bb[5]); w.w = cvt_pk_bf16(bb[6], bb[7]);
                *(u32x4*)(BB + ((size_t)dir * NTOK + tok) * DM + ch0) = w; }
    }
};

struct RGOrder {
    static constexpr bool GATHER_A = false;
    int G, c;
    __device__ __forceinline__ bool next(int i, Unit& u) const {
        if (G == 256) { if (i >= 8) return false; const int x = c & 7, y = c >> 3; u.pm = i * 8 + (y >> 2); u.pn = x * 4 + (y & 3); }
        else { const int L = i * G + c; if (L >= 64 * 32) return false; u.pm = L >> 5; u.pn = L & 31; }
        u.e = 0; u.t = 0; u.cnt = 0; return true; }
    __device__ __forceinline__ int rowA(const Unit& u, int r) const { return u.pm * BM + r; }
    __device__ __forceinline__ int colA(const Unit& u) const { return (u.pn >> 2) * 256; }
    __device__ __forceinline__ int rowB(const Unit& u, int r) const { return u.pn * BM + r; }
};
template <int NPN, bool GATHER>
struct MoeOrder {
    static constexpr bool GATHER_A = GATHER;
    int G, c; const LAS int* tab; const int* rowlist;
    __device__ __forceinline__ bool next(int i, Unit& u) const {
        const int L = i * G + c, ntile = tab[32]; if (L >= ntile * NPN) return false;
        const int tile = L / NPN; u.pm = tile; u.pn = L % NPN; int e = 0;
        while (e < 31 && tab[e + 1] <= tile) ++e;
        u.e = e; u.t = tile - tab[e]; u.cnt = tab[64 + e]; return true;
    }
    __device__ __forceinline__ int rowA(const Unit& u, int r) const {
        if (GATHER) { const int idx = u.t * BM + r; const int a = idx < u.cnt ? rowlist[(size_t)u.e * ECAP + idx] : 0; return a >> 1; }
        return u.pm * BM + r;
    }
    __device__ __forceinline__ int colA(const Unit&) const { return 0; }
    __device__ __forceinline__ int rowB(const Unit& u, int r) const { return (u.e * NPN + u.pn) * BM + r; }
};
}
namespace att {
constexpr int NW = 8, QBLK = 32, KVBLK = 64, LDQ = 1024, LDK = 1024, LDV = 1024, LDO = 1024;
constexpr int SHM_V = KVBLK * 128 * 2, SHM_K = KVBLK * 64 * 2, NSLOT = 4, LDS_K = 0, LDS_V = NSLOT * SHM_K, LDS_WS = NSLOT * (SHM_K + SHM_V), SHM_ATTN = LDS_WS + NW * 64 * 4;
__device__ __forceinline__ void glds16s(const void* sbase, unsigned voff, unsigned lds_dst) { unsigned keep;
    asm volatile("s_mov_b32 %0, m0\n\ts_mov_b32 m0, %3\n\ts_nop 0\n\tglobal_load_lds_dwordx4 %1, %2\n\ts_mov_b32 m0, %0" : "=&s"(keep) : "v"(voff), "s"(sbase), "s"(lds_dst) : "memory"); }
#define WAITBAR(N) asm volatile("s_waitcnt vmcnt(" #N ") lgkmcnt(0)\n\ts_barrier" ::: "memory")
constexpr float THR2 = 8.0f * 1.4426950408889634f;
#define KSWZ64(row, colB) ((row) * 128 + ((colB) ^ ((((row) >> 1) & 7) << 4)))
#define SBAR() __builtin_amdgcn_sched_barrier(0)
__device__ __forceinline__ int crow(int r, int hi) { return (r & 3) + 8 * (r >> 2) + 4 * hi; }
__device__ __forceinline__ void qkt(f32x16& p0, f32x16& p1, const char* Ks, const bf16x8* qr, int r32, int hi, float A, float st) {
    { float b4[4];
#pragma unroll
      for (int j = 0; j < 4; ++j) b4[j] = fmaf(st, (float)j, A);
      const float s8 = 8.0f * st, s32 = 32.0f * st;
#pragma unroll
      for (int r = 0; r < 16; ++r) { p0[r] = (r < 4) ? b4[r] : p0[r - 4] + s8; }
#pragma unroll
      for (int r = 0; r < 16; ++r) p1[r] = p0[r] + s32; }
#pragma unroll
    for (int d0 = 0; d0 < 4; ++d0) { const int cb = (d0 * 16 + hi * 8) * 2;
        const bf16x8 b0 = *reinterpret_cast<const bf16x8*>(Ks + KSWZ64(r32, cb));
        const bf16x8 b1 = *reinterpret_cast<const bf16x8*>(Ks + KSWZ64(32 + r32, cb));
        p0 = __builtin_amdgcn_mfma_f32_32x32x16_bf16(b0, qr[d0], p0, 0, 0, 0);
        p1 = __builtin_amdgcn_mfma_f32_32x32x16_bf16(b1, qr[d0], p1, 0, 0, 0); }
}
__device__ __forceinline__ void partialSM(f32x16& p0, f32x16& p1, bool mixed, float fd, float sl2) {
    if (mixed) {
#pragma unroll
        for (int r = 0; r < 16; ++r) { const float d0 = fd - (float)((r & 3) + 8 * (r >> 2)); p0[r] = fmaf(fabsf(d0), -sl2, p0[r]); p1[r] = fmaf(fabsf(d0 - 32.0f), -sl2, p1[r]); }
    }
#pragma unroll
    for (int r = 0; r < 16; ++r) p0[r] = __builtin_amdgcn_exp2f(p0[r]);
}
__device__ __forceinline__ void finishSM(f32x16& p0, f32x16& p1, float& l_reg, bf16x8& pa0, bf16x8& pa1, bf16x8& pa2, bf16x8& pa3) {
#pragma unroll
    for (int r = 0; r < 16; ++r) p1[r] = __builtin_amdgcn_exp2f(p1[r]);
    float ps = 0;
#pragma unroll
    for (int r = 0; r < 16; ++r) ps += p0[r];
#pragma unroll
    for (int r = 0; r < 16; ++r) ps += p1[r];
    l_reg += ps;
#define PK4(P, BASE, OUT) do { unsigned a0 = cvt_pk_bf16(P[BASE + 0], P[BASE + 1]), a1 = cvt_pk_bf16(P[BASE + 2], P[BASE + 3]);   \
    unsigned b0 = cvt_pk_bf16(P[BASE + 4], P[BASE + 5]), b1 = cvt_pk_bf16(P[BASE + 6], P[BASE + 7]);                              \
    auto r0 = __builtin_amdgcn_permlane32_swap(a0, b0, false, false); auto r1 = __builtin_amdgcn_permlane32_swap(a1, b1, false, false); \
    u32x4 w = {r0[0], r1[0], r0[1], r1[1]}; OUT = __builtin_bit_cast(bf16x8, w); } while (0)
    PK4(p0, 0, pa0); PK4(p0, 8, pa1); PK4(p1, 0, pa2); PK4(p1, 8, pa3);
#undef PK4
}
__device__ __forceinline__ int v_st(int k, int c) { const int kk = (k & ~0xC) | ((k & 4) << 1) | ((k & 8) >> 1); return ((kk >> 3) * 4 + (c >> 5)) * 512 + ((kk & 7) * 32 + (c & 31)) * 2; }
__device__ __forceinline__ int v_rd_base(int lane) { return ((lane & 3) << 3) | (((lane >> 2) & 3) << 6) | (((lane >> 4) & 1) << 5) | (((lane >> 5) & 1) << 8); }
constexpr int v_rd_off(int d0, int ks, int half) { return d0 * 512 + ks * 4096 + half * 2048; }
template <int OFF> __device__ __forceinline__ s16x4 tr_read(int vb) {
    s16x4 r; asm volatile("ds_read_b64_tr_b16 %0, %1 offset:%2" : "=&v"(r) : "v"(vb), "i"(OFF) : "memory"); return r;
}
template <int D0> __device__ __forceinline__ void pv_one(f32x16& od, int vb, bf16x8 pa0, bf16x8 pa1, bf16x8 pa2, bf16x8 pa3) {
    const s16x4 l0 = tr_read<v_rd_off(D0, 0, 0)>(vb), h0 = tr_read<v_rd_off(D0, 0, 1)>(vb), l1 = tr_read<v_rd_off(D0, 1, 0)>(vb), h1 = tr_read<v_rd_off(D0, 1, 1)>(vb);
    const s16x4 l2 = tr_read<v_rd_off(D0, 2, 0)>(vb), h2 = tr_read<v_rd_off(D0, 2, 1)>(vb), l3 = tr_read<v_rd_off(D0, 3, 0)>(vb), h3 = tr_read<v_rd_off(D0, 3, 1)>(vb);
    asm volatile("s_waitcnt lgkmcnt(0)" ::: "memory"); SBAR();
#define PK(L, H) (bf16x8){L[0], L[1], L[2], L[3], H[0], H[1], H[2], H[3]}
    od = __builtin_amdgcn_mfma_f32_32x32x16_bf16(pa0, PK(l0, h0), od, 0, 0, 0);
    od = __builtin_amdgcn_mfma_f32_32x32x16_bf16(pa1, PK(l1, h1), od, 0, 0, 0);
    od = __builtin_amdgcn_mfma_f32_32x32x16_bf16(pa2, PK(l2, h2), od, 0, 0, 0);
    od = __builtin_amdgcn_mfma_f32_32x32x16_bf16(pa3, PK(l3, h3), od, 0, 0, 0);
#undef PK
}
__device__ __forceinline__ void pv_d0(f32x16* o, int vb, bf16x8 pa0, bf16x8 pa1, bf16x8 pa2, bf16x8 pa3) {
    pv_one<0>(o[0], vb, pa0, pa1, pa2, pa3); pv_one<1>(o[1], vb, pa0, pa1, pa2, pa3); pv_one<2>(o[2], vb, pa0, pa1, pa2, pa3); pv_one<3>(o[3], vb, pa0, pa1, pa2, pa3);
}
__device__ __forceinline__ void attn_unit(const bf16_t* __restrict__ Qb, const bf16_t* __restrict__ Kh, const bf16_t* __restrict__ Vh, bf16_t* __restrict__ Ob, int q0, int t_lo, int n, float sl2, char* lds) {
    const int tid = opaque_tid(), wid = __builtin_amdgcn_readfirstlane(tid >> 6), lane = tid & 63, r32 = lane & 31, hi = lane >> 5;
    float* ws = (float*)(lds + LDS_WS) + wid * 64; float* li_l = ws;
    float l_reg = 0; f32x16 o[4] = {}; bf16x8 qr[4];
    const bf16_t* Qw = Qb + (long)(wid * QBLK + r32) * LDQ + hi * 8;
#pragma unroll
    for (int d0 = 0; d0 < 4; ++d0) qr[d0] = *reinterpret_cast<const bf16x8*>(Qw + d0 * 16);
    float negM;
    { const bf16_t* Kw = Kh + (long)(q0 + wid * QBLK + r32) * LDK + hi * 8; float s = 0.f;
#pragma unroll
      for (int d0 = 0; d0 < 4; ++d0) { const u32x4 kw = *reinterpret_cast<const u32x4*>(Kw + d0 * 16); const u32x4 qw = __builtin_bit_cast(u32x4, qr[d0]);
          s += bflo(kw.x) * bflo(qw.x) + bfhi(kw.x) * bfhi(qw.x) + bflo(kw.y) * bflo(qw.y) + bfhi(kw.y) * bfhi(qw.y) + bflo(kw.z) * bflo(qw.z) + bfhi(kw.z) * bfhi(qw.z) + bflo(kw.w) * bflo(qw.w) + bfhi(kw.w) * bfhi(qw.w); }
      auto rr = __builtin_amdgcn_permlane32_swap(__float_as_uint(s), __float_as_uint(s), false, false); negM = -(__uint_as_float(rr[0]) + __uint_as_float(rr[1])); }
    const unsigned lds0 = (unsigned)(uintptr_t)lds;
    const int krow = wid * 8 + (lane >> 3), kch = (lane & 7) ^ ((krow >> 1) & 7);
    const unsigned koff = (unsigned)(krow * LDK * 2 + kch * 16);
    unsigned voff[2];
#pragma unroll
    for (int z = 0; z < 2; ++z) { const int P16 = (wid + 8 * z) * 64 + lane, sub = P16 >> 5, win = P16 & 31, kk = (sub >> 2) * 8 + (win >> 2), k = (kk & ~0xC) | ((kk & 4) << 1) | ((kk & 8) >> 1), c = (sub & 3) * 32 + (win & 3) * 8;
        voff[z] = (unsigned)(k * LDV * 2 + c * 2); }
    const unsigned kdst = lds0 + LDS_K + wid * 1024, vdst = lds0 + LDS_V + wid * 1024;
    const int vb0 = (int)(lds0 + LDS_V) + v_rd_base(lane);
    const char* K_lds = lds + LDS_K;
    const int qw0 = q0 + wid * QBLK;
    const float fq0 = (float)(qw0 + r32 - 4 * hi);
    const char* Kt = (const char*)(Kh + (long)t_lo * KVBLK * LDK); const char* Vt = (const char*)(Vh + (long)t_lo * KVBLK * LDV);
#define DMA(jj, slot) do { const char* kb_ = Kt + (size_t)(jj) * (KVBLK * LDK * 2); const char* vb_ = Vt + (size_t)(jj) * (KVBLK * LDV * 2); \
    glds16s(kb_, koff, (unsigned)__builtin_amdgcn_readfirstlane(kdst + (slot) * SHM_K)); \
    glds16s(vb_, voff[0], (unsigned)__builtin_amdgcn_readfirstlane(vdst + (slot) * SHM_V)); \
    glds16s(vb_, voff[1], (unsigned)__builtin_amdgcn_readfirstlane(vdst + (slot) * SHM_V + 8192)); } while (0)
#define TILE(jj) const int k0_ = (t_lo + (jj)) * KVBLK; const bool left_ = k0_ + 63 < qw0, right_ = k0_ > qw0 + 31, mixed_ = !(left_ || right_); \
    const float fd_ = fq0 - (float)k0_, st_ = left_ ? sl2 : (right_ ? -sl2 : 0.f), A_ = negM - st_ * fd_
    f32x16 pA0, pA1, pB0, pB1; bf16x8 pa0, pa1, pa2, pa3;
    asm volatile("s_waitcnt vmcnt(0)" ::: "memory");
#define SEG_A(PN0, PN1, PO0, PO1, jt, FIN) do { TILE(jt); SBAR(); qkt(PN0, PN1, K_lds + ((jt) & 3) * SHM_K, qr, r32, hi, A_, st_); if (FIN) finishSM(PO0, PO1, l_reg, pa0, pa1, pa2, pa3); SBAR(); } while (0)
#define SEG_B(P0, P1, jt, PV) do { if (PV) pv_d0(o, vb0 + (((jt) - 1) & 3) * SHM_V, pa0, pa1, pa2, pa3); { TILE(jt); partialSM(P0, P1, mixed_, fd_, sl2); } } while (0)
#define STEP_BAR(jt) do { WAITBAR(0); if ((jt) + 2 < n) DMA((jt) + 2, ((jt) + 2) & 3); } while (0)
    const bool lead = wid < 4;
    DMA(0, 0); DMA(1, 1);
    WAITBAR(3);
    SEG_A(pA0, pA1, pB0, pB1, 0, false); if (!lead) STEP_BAR(0); SEG_B(pA0, pA1, 0, false); if (lead) STEP_BAR(0);
    for (int j = 1; j + 1 < n; j += 2) {
        SEG_A(pB0, pB1, pA0, pA1, j, true); if (!lead) STEP_BAR(j); SEG_B(pB0, pB1, j, true); if (lead) STEP_BAR(j);
        SEG_A(pA0, pA1, pB0, pB1, j + 1, true); if (!lead) STEP_BAR(j + 1); SEG_B(pA0, pA1, j + 1, true); if (lead) STEP_BAR(j + 1);
    }
    SEG_A(pB0, pB1, pA0, pA1, n - 1, true); if (!lead) STEP_BAR(n - 1); SEG_B(pB0, pB1, n - 1, true); if (lead) STEP_BAR(n - 1);
    finishSM(pB0, pB1, l_reg, pa0, pa1, pa2, pa3); SBAR();
    pv_d0(o, vb0 + ((n - 1) & 3) * SHM_V, pa0, pa1, pa2, pa3);
    { auto rr = __builtin_amdgcn_permlane32_swap(__float_as_uint(l_reg), __float_as_uint(l_reg), false, false); l_reg = __uint_as_float(rr[0]) + __uint_as_float(rr[1]); }
    if (hi == 0) li_l[r32] = l_reg; asm volatile("s_waitcnt lgkmcnt(0)" ::: "memory");
    float rli[16];
#pragma unroll
    for (int r = 0; r < 16; ++r) rli[r] = __builtin_amdgcn_rcpf(li_l[crow(r, hi)]);
    bf16_t* Ow = Ob + (long)(wid * QBLK) * LDO;
#pragma unroll
    for (int r = 0; r < 16; ++r) { const int orow = crow(r, hi);
#pragma unroll
        for (int d0 = 0; d0 < 4; ++d0) Ow[(long)orow * LDO + d0 * 32 + r32] = (bf16_t)f2bf(o[d0][r] * rli[r]); }
    WAITBAR(0);
#undef DMA
#undef SEG_A
#undef SEG_B
#undef STEP_BAR
#undef TILE
}
#undef SBAR
}

namespace hy {
typedef f32x2 cf;
__device__ __forceinline__ cf lld(const LAS f32x2* L, int i) { return L[i]; }
__device__ __forceinline__ void lst(LAS f32x2* L, int i, cf v) { L[i] = v; }
__device__ __forceinline__ cf cmul(cf a, cf b) { return a * b.xx + a.yx * (b.yy * (cf){-1.f, 1.f}); }
__device__ __forceinline__ cf cmulc(cf a, cf b) { return a * b.xx + a.yx * (b.yy * (cf){1.f, -1.f}); }
__device__ constexpr float C32[16] = {1.0f, 0.98078528040323043f, 0.92387953251128674f, 0.83146961230254524f, 0.70710678118654757f, 0.55557023301960229f, 0.38268343236508984f, 0.19509032201612833f,
                                      0.0f, -0.19509032201612819f, -0.38268343236508973f, -0.55557023301960196f, -0.70710678118654746f, -0.83146961230254535f, -0.92387953251128674f, -0.98078528040323043f};
__device__ constexpr float S32[16] = {0.0f, 0.19509032201612825f, 0.38268343236508978f, 0.55557023301960218f, 0.70710678118654746f, 0.83146961230254524f, 0.92387953251128674f, 0.98078528040323043f,
                                      1.0f, 0.98078528040323043f, 0.92387953251128674f, 0.83146961230254546f, 0.70710678118654757f, 0.55557023301960218f, 0.38268343236508989f, 0.19509032201612861f};
__host__ __device__ constexpr int brev(int k, int bits) { int r = 0; for (int i = 0; i < bits; ++i) r |= ((k >> i) & 1) << (bits - 1 - i); return r; }
template <int R, bool INV> __device__ __forceinline__ void dft_reg(cf (&v)[R]) {
#pragma unroll
    for (int s = R / 2; s >= 1; s >>= 1) {
#pragma unroll
        for (int g0 = 0; g0 < R; g0 += 2 * s) {
#pragma unroll
            for (int j = 0; j < s; ++j) {
                const cf a = v[g0 + j], b = v[g0 + j + s];
                v[g0 + j] = a + b;
                const cf d = a - b;
                const int tw = j * (16 / s);
                if (tw == 0) v[g0 + j + s] = d;
                else if (tw == 8) v[g0 + j + s] = INV ? (cf){-d.y, d.x} : (cf){d.y, -d.x};
                else { const float c = C32[tw], sn = INV ? S32[tw] : -S32[tw]; v[g0 + j + s] = d * c + d.yx * (cf){-sn, sn}; }
            }
        }
    }
}
constexpr int RS = FFT_RS;
__device__ __forceinline__ void fft_fwd12(cf (&v)[32], LAS f32x2* L, int tid) {
    dft_reg<32, false>(v);
    { float s, c; sincospif((float)tid * (1.0f / 8192.0f), &s, &c); cf w1 = {c, -s}; asm volatile("" : "+v"(w1.x), "+v"(w1.y)); cf w = w1;
#pragma unroll
      for (int k1 = 0; k1 < 32; ++k1) { cf x = v[brev(k1, 5)]; if (k1) { x = cmul(x, w); w = cmul(w, w1); } lst(L, k1 * RS + tid, x); } }
    __syncthreads();
    const int k1 = tid >> 4, m2 = tid & 15;
#pragma unroll
    for (int m1 = 0; m1 < 32; ++m1) v[m1] = lld(L, k1 * RS + 16 * m1 + m2);
    __syncthreads();
    dft_reg<32, false>(v);
    { float s, c; sincospif((float)m2 * (1.0f / 256.0f), &s, &c); cf w1 = {c, -s}; asm volatile("" : "+v"(w1.x), "+v"(w1.y)); cf w = w1;
#pragma unroll
      for (int j1 = 0; j1 < 32; ++j1) { cf x = v[brev(j1, 5)]; if (j1) { x = cmul(x, w); w = cmul(w, w1); } lst(L, k1 * RS + 33 * m2 + j1, x); } }
    __syncthreads();
}
__device__ __forceinline__ void fft_inv21(cf (&v)[32], LAS f32x2* L, int tid) {
    const int k1 = tid >> 4, m2 = tid & 15;
    { float s, c; sincospif((float)m2 * (1.0f / 256.0f), &s, &c); cf w1 = {c, -s}; asm volatile("" : "+v"(w1.x), "+v"(w1.y)); cf w = w1;
#pragma unroll
      for (int j1 = 0; j1 < 32; ++j1) { cf x = lld(L, k1 * RS + 33 * m2 + j1); if (j1) { x = cmulc(x, w); w = cmul(w, w1); } v[j1] = x; } }
    __syncthreads();
    dft_reg<32, true>(v);
#pragma unroll
    for (int m1 = 0; m1 < 32; ++m1) lst(L, k1 * RS + 16 * m1 + m2, v[brev(m1, 5)]);
    __syncthreads();
    { float s, c; sincospif((float)tid * (1.0f / 8192.0f), &s, &c); cf w1 = {c, -s}; asm volatile("" : "+v"(w1.x), "+v"(w1.y)); cf w = w1;
#pragma unroll
      for (int kk = 0; kk < 32; ++kk) { cf x = lld(L, kk * RS + tid); if (kk) { x = cmulc(x, w); w = cmul(w, w1); } v[kk] = x; } }
    dft_reg<32, true>(v);
}
}
constexpr size_t MiB = 1u << 20;
constexpr size_t WS_CTL = 0, CTL_ZERO_BYTES = 1 * MiB;
constexpr size_t WS_W1T = 1 * MiB;
constexpr size_t WS_W2T = 257 * MiB;
constexpr size_t WS_WIN_EV = 385 * MiB, WS_WOUT_EV = 409 * MiB, WS_WIN_OD = 417 * MiB, WS_WOUT_OD = 433 * MiB, WS_WG_OD = 441 * MiB;
constexpr size_t AR = 445 * MiB;
constexpr size_t A_XB = AR + 0 * MiB, A_UHT = AR + 64 * MiB, A_QB = AR + 160 * MiB, A_KB = AR + 192 * MiB, A_VB = AR + 224 * MiB, A_KTD = AR + 256 * MiB, A_KF = AR + 384 * MiB,
                 A_H3B = AR + 512 * MiB, A_W4T = AR + 514 * MiB, A_YHT = AR + 416 * MiB, A_OA = AR + 448 * MiB, A_YCAT = AR + 512 * MiB, A_XB2 = AR + 0 * MiB, A_R0 = AR + 64 * MiB, A_H1_0 = AR + 192 * MiB,
                 A_HB_0 = AR + 320 * MiB, A_HID_0 = AR + 384 * MiB, A_ROWL = AR + 424 * MiB, A_GATEW = AR + 428 * MiB, A_Y2_0 = AR + 0 * MiB, A_H2 = AR + 448 * MiB, A_HB2 = AR + 448 * MiB;
constexpr size_t A_GB = AR + 0 * MiB, A_XR = AR + 64 * MiB, A_XC = AR + 192 * MiB, A_LA = AR + 256 * MiB, A_BB = AR + 64 * MiB, A_CAR = AR + 384 * MiB, A_YG = AR + 192 * MiB, A_R1 = AR + 256 * MiB,
                 A_H1_1 = AR + 0 * MiB, A_HB8_1 = AR + 0 * MiB, A_HB8_0 = AR + 192 * MiB, A_HB_1 = AR + 128 * MiB, A_HID_1 = AR + 192 * MiB, A_Y2_1 = AR + 256 * MiB;
constexpr size_t WS_END = AR + 576 * MiB;
constexpr int CW_BAR = 4096, CW_CNT = 16384, CW_NORM = 24576;
constexpr int LDS_MISC = 139264, LDS_BYTES = 147456;
constexpr int NPHASE = 21;
#ifndef MOE_FP8_LAYERS
#define MOE_FP8_LAYERS 2
#endif

struct Args { const float* in[37]; float* out; unsigned char* ws; int ph_lo, ph_hi; };
typedef const __attribute__((address_space(4))) Args& KArgs;

__device__ __forceinline__ void transpose_item(const float* W, int N, int k0, int n0, bf16_t* WT, int ldk, int drow0, LAS float* scr, int lane) {
#pragma unroll 8
    for (int i = 0; i < 32; ++i) { const int kk = 2 * i + (lane >> 5); scr[kk * 33 + (lane & 31)] = W[(size_t)(k0 + kk) * N + n0 + (lane & 31)]; }
    LDS_WAIT(); asm volatile("" ::: "memory");
    const int c = lane & 7;
#pragma unroll
    for (int j = 0; j < 4; ++j) { const int n = (lane >> 3) + 8 * j; const LAS float* s = scr + (8 * c) * 33 + n;
        u32x4 o; o.x = pk2(s[0 * 33], s[1 * 33]); o.y = pk2(s[2 * 33], s[3 * 33]); o.z = pk2(s[4 * 33], s[5 * 33]); o.w = pk2(s[6 * 33], s[7 * 33]);
        *(u32x4*)(WT + (size_t)(drow0 + n) * ldk + k0 + 8 * c) = o; }
    LDS_WAIT(); asm volatile("" ::: "memory");
}

__device__ __forceinline__ void transpose_item8(const float* W, int N, int k0, int n0, unsigned char* WT8, int ldk, int drow0, float scale, LAS float* scr, int lane) {
#pragma unroll 8
    for (int i = 0; i < 32; ++i) { const int kk = 2 * i + (lane >> 5); scr[kk * 33 + (lane & 31)] = W[(size_t)(k0 + kk) * N + n0 + (lane & 31)]; }
    LDS_WAIT(); asm volatile("" ::: "memory");
    const int c = lane & 7;
#pragma unroll
    for (int j = 0; j < 4; ++j) { const int n = (lane >> 3) + 8 * j; const LAS float* s = scr + (8 * c) * 33 + n;
        u32x2 o; o.x = pg8::pk4_fp8(s[0 * 33] * scale, s[1 * 33] * scale, s[2 * 33] * scale, s[3 * 33] * scale); o.y = pg8::pk4_fp8(s[4 * 33] * scale, s[5 * 33] * scale, s[6 * 33] * scale, s[7 * 33] * scale);
        *(u32x2*)(WT8 + (size_t)(drow0 + n) * ldk + k0 + 8 * c) = o; }
    LDS_WAIT(); asm volatile("" ::: "memory");
}
__device__ __forceinline__ void phase_prologue(KArgs a, LAS unsigned char* lds) {
    const int tid = opaque_tid(), lane = tid & 63, wave = tid >> 6, G = gridDim.x;
    const int gw = blockIdx.x * 8 + wave, NGW = G * 8;
    unsigned char* ws = a.ws;
    LAS float* scr = (LAS float*)(lds + wave * 16384);
    constexpr int I_EVIN = 32 * 192, I_SQ = 32 * 64, I_ODIN = 32 * 128, I_MOE_GU = 64 * 512, I_MOE_D = 64 * 512, I_RG = 16 * 32, I_W4 = 128;
    constexpr int O1 = I_EVIN, O2 = O1 + I_SQ, O3 = O2 + I_ODIN, O4 = O3 + I_SQ, O5 = O4 + I_MOE_GU, O6 = O5 + I_MOE_GU, O7 = O6 + I_MOE_D, O8 = O7 + I_RG, O9 = O8 + I_RG, O10 = O9 + I_W4;
    for (int it = gw; it < O10; it += NGW) {
        if (it < O1) { const int kb = it / 192, nb = it % 192; transpose_item(a.in[1], EV_IN, kb * 64, nb * 32, (bf16_t*)(ws + WS_WIN_EV), DM, nb * 32, scr, lane); }
        else if (it < O2) { const int r = it - O1, kb = r / 64, nb = r % 64; transpose_item(a.in[18], DM, kb * 64, nb * 32, (bf16_t*)(ws + WS_WOUT_EV), DM, nb * 32, scr, lane); }
        else if (it < O3) { const int r = it - O2, kb = r / 128, nb = r % 128; transpose_item(a.in[19], 2 * DM, kb * 64, nb * 32, (bf16_t*)(ws + WS_WIN_OD), DM, nb * 32, scr, lane); }
        else if (it < O4) { const int r = it - O3, kb = r / 64, nb = r % 64; transpose_item(a.in[27], DM, kb * 64, nb * 32, (bf16_t*)(ws + WS_WOUT_OD), DM, nb * 32, scr, lane); }
        else if (it < O6) { const bool up = it >= O5; const int r = it - (up ? O5 : O4), le = r / 512, q = r % 512, kb = q / 16, nb = q % 16, n0 = nb * 32;
            const int drow = (n0 >> 7) * 256 + (n0 & 127) + (up ? 128 : 0); const float* src = (up ? a.in[35] : a.in[34]) + (size_t)le * DM * DFF;
            if (le < 32 * (2 - MOE_FP8_LAYERS)) transpose_item(src, DFF, kb * 64, n0, (bf16_t*)(ws + WS_W1T) + (size_t)le * 1024 * DM, DM, drow, scr, lane);
            else transpose_item8(src, DFF, kb * 64, n0, ws + WS_W1T + (size_t)(le >> 5) * 32 * 1024 * DM * 2 + (size_t)(le & 31) * 1024 * DM, DM, drow, pg8::FP8_SW, scr, lane); }
        else if (it < O7) { const int r = it - O6, le = r / 512, q = r % 512, kb = q / 64, nb = q % 64; const float* src = a.in[36] + (size_t)le * DFF * DM;
            if (le < 32 * (2 - MOE_FP8_LAYERS)) transpose_item(src, DM, kb * 64, nb * 32, (bf16_t*)(ws + WS_W2T) + (size_t)le * DM * DFF, DFF, nb * 32, scr, lane);
            else transpose_item8(src, DM, kb * 64, nb * 32, ws + WS_W2T + (size_t)(le >> 5) * 32 * DM * DFF * 2 + (size_t)(le & 31) * DM * DFF, DFF, nb * 32, pg8::FP8_SW, scr, lane); }
        else if (it < O9) { const bool wx = it >= O8; const int r = it - (wx ? O8 : O7), dn = r / 32, q = r % 32, kb = q / 8, nb = q % 8, n0 = nb * 32, dir = dn / 8, n = dn % 8;
            transpose_item((wx ? a.in[24] : a.in[22]) + (size_t)dn * 65536, 256, kb * 64, n0, (bf16_t*)(ws + WS_WG_OD), 256, (n * 4 + dir * 2 + (n0 >> 7)) * 256 + (n0 & 127) + (wx ? 128 : 0), scr, lane); }
        else { const int nb = it - O9; transpose_item(a.in[11], 4096, 0, nb * 32, (bf16_t*)(ws + A_W4T), 128, nb * 32, scr, lane); }
    }
    { const int gt = blockIdx.x * 512 + tid, NT = G * 512;
      for (int i = gt; i < 4096 * 8; i += NT) { const int r = i >> 3, c = i & 7; *(u32x4*)((bf16_t*)(ws + A_W4T) + (size_t)r * 128 + 64 + c * 8) = (u32x4){0u, 0u, 0u, 0u}; }
      for (int i = gt; i < 8192 * 8; i += NT) { const int r = i >> 3, c = i & 7; *(u32x4*)((bf16_t*)(ws + A_H3B) + (size_t)r * 128 + 64 + c * 8) = (u32x4){0u, 0u, 0u, 0u}; }
      const f32x8* x8 = (const f32x8*)a.in[0]; u32x4* xb = (u32x4*)(ws + A_XB);
      for (int i = gt; i < NTOK * DM / 8; i += NT) { const f32x8 v = x8[i]; u32x4 o; o.x = pk2(v[0], v[1]); o.y = pk2(v[2], v[3]); o.z = pk2(v[4], v[5]); o.w = pk2(v[6], v[7]); xb[i] = o; } }
    { const float* w1 = a.in[4]; const float* b1 = a.in[5]; const float* w2 = a.in[6]; const float* b2 = a.in[7]; const float* w3 = a.in[8]; const float* b3 = a.in[9]; const float* fr = a.in[10];
      const float frq = fr[lane];
      for (int t = gw; t < SEQ; t += NGW) {
          float z;
          { const float tl = (float)t * (1.0f / 8191.0f);
            if (lane == 0) z = tl;
            else { const int j = (lane - 1) & 15; const float band = 1e-4f + (float)j * ((15.0f - 1e-4f) / 15.0f);
                   const float ang = (6.283185307179586f * (float)t * (1.0f / 8192.0f)) * band; float sn, cs; sincosf(ang, &sn, &cs); z = (lane <= 16) ? cs : -sn; } }
          float acc = b1[lane];
#pragma unroll
          for (int i = 0; i < 33; ++i) acc += __shfl(z, i) * w1[i * 64 + lane];
          float h = sinf(frq * acc);
          acc = b2[lane];
#pragma unroll 16
          for (int i = 0; i < 64; ++i) acc += __shfl(h, i) * w2[i * 64 + lane];
          h = sinf(frq * acc);
          acc = b3[lane];
#pragma unroll 16
          for (int i = 0; i < 64; ++i) acc += __shfl(h, i) * w3[i * 64 + lane];
          h = sinf(frq * acc);
          ((bf16_t*)(ws + A_H3B))[(size_t)t * 128 + lane] = (bf16_t)f2bf(h);
      } }
}

__device__ __forceinline__ void filter_unit(KArgs a, LAS unsigned char* lds, int u, int tid) {
    const int lane = tid & 63, wave = tid >> 6;
    LAS f32x2* L = (LAS f32x2*)lds; LAS float* red = (LAS float*)(lds + LDS_MISC + 1024);
    const bf16_t* KTD = (const bf16_t*)(a.ws + A_KTD); __half2* KF = (__half2*)(a.ws + A_KF);
    {
        int tl = tid; asm volatile("" : "+v"(tl));
        const bf16_t* rowF = KTD + (size_t)u * 8192; const bf16_t* rowB = KTD + (size_t)(2048 + u) * 8192;
        hy::cf v[32]; float ss = 0.f;
#pragma unroll
        for (int n1 = 0; n1 < 32; ++n1) { const int p = tl + 512 * n1; float val;
            if (n1 < 16) val = bf2f(rowF[p]); else if (p == 8192) val = 0.f; else val = bf2f(rowB[16384 - p]);
            v[n1] = (hy::cf){val, 0.f}; ss += val * val; }
        ss = wave_sum(ss); if (lane == 0) red[wave] = ss; __syncthreads();
        float tot = 0.f;
#pragma unroll
        for (int w = 0; w < 8; ++w) tot += red[w];
        const float scale = rsqrtf(tot), skp = a.in[12][u];
        hy::fft_fwd12(v, L, tl);
#pragma unroll
        for (int bf = 0; bf < 2; ++bf) { const int idx = bf * 512 + tl, k1 = idx >> 5, j1 = idx & 31; hy::cf w[16];
#pragma unroll
            for (int m2 = 0; m2 < 16; ++m2) w[m2] = hy::lld(L, k1 * hy::RS + 33 * m2 + j1);
            hy::dft_reg<16, false>(w);
#pragma unroll
            for (int j2 = 0; j2 < 16; ++j2) { const hy::cf x = w[hy::brev(j2, 4)]; KF[((size_t)((blockIdx.x * 2 + (u >> 10)) * 2 + bf) * 16 + j2) * 512 + tl] = __floats2half2_rn(x.x * scale + skp, x.y * scale); } }
        __syncthreads();
    }
}
__device__ __forceinline__ float hyconv(const bf16_t* row, int t, float w0, float w1, float w2, float bias) {
    const unsigned tm = (unsigned)(t > 0 ? t - 1 : 0), tp = (unsigned)(t < SEQ - 1 ? t + 1 : SEQ - 1);
    float xm = bf2f(row[tm]), x0 = bf2f(row[(unsigned)t]), xp = bf2f(row[tp]);
    xm = t > 0 ? xm : 0.f; xp = t < SEQ - 1 ? xp : 0.f;
    return w0 * xm + w1 * x0 + w2 * xp + bias;
}
__device__ __forceinline__ void phase_hyena_mixer(KArgs a, LAS unsigned char* lds) {
    const int tid = opaque_tid(), G = gridDim.x;
    LAS f32x2* L = (LAS f32x2*)lds;
    const bf16_t* UHT = (const bf16_t*)(a.ws + A_UHT); const __half2* KF = (const __half2*)(a.ws + A_KF); bf16_t* YHT = (bf16_t*)(a.ws + A_YHT);
    const float* cw = a.in[2]; const float* cb = a.in[3];
    for (int c = blockIdx.x; c < HY_CH; c += G) {
        filter_unit(a, lds, c, tid); filter_unit(a, lds, 1024 + c, tid);
        VM_WAIT();
        int tl = tid; asm volatile("" : "+v"(tl));
        hy::cf v[32];
        { const bf16_t* r0 = UHT + (size_t)c * NTOK; const float w0 = cw[c], w1 = cw[3072 + c], w2 = cw[6144 + c], bb = cb[c];
#pragma unroll
          for (int n1 = 0; n1 < 16; ++n1) { const int t = tl + 512 * n1; v[n1] = (hy::cf){hyconv(r0, t, w0, w1, w2, bb), hyconv(r0 + SEQ, t, w0, w1, w2, bb)}; if ((n1 & 3) == 3) asm volatile("" ::: "memory"); } }
#pragma unroll 1
        for (int o = 0; o < 2; ++o) {
#pragma unroll
            for (int n1 = 16; n1 < 32; ++n1) v[n1] = (hy::cf){0.f, 0.f};
            hy::fft_fwd12(v, L, tl);
#pragma unroll
            for (int bf = 0; bf < 2; ++bf) { const int idx = bf * 512 + tl, k1 = idx >> 5, j1 = idx & 31; hy::cf w[16];
#pragma unroll
                for (int m2 = 0; m2 < 16; ++m2) w[m2] = hy::lld(L, k1 * hy::RS + 33 * m2 + j1);
                hy::dft_reg<16, false>(w);
                asm volatile("" ::: "memory");
                hy::cf y[16];
#pragma unroll
                for (int j2 = 0; j2 < 16; ++j2) { const float2 kf = __half22float2(KF[((size_t)((blockIdx.x * 2 + o) * 2 + bf) * 16 + j2) * 512 + tl]);
                    y[j2] = hy::cmul(w[hy::brev(j2, 4)], (hy::cf){kf.x, kf.y}); }
                hy::dft_reg<16, true>(y);
#pragma unroll
                for (int m2 = 0; m2 < 16; ++m2) hy::lst(L, k1 * hy::RS + 33 * m2 + j1, y[hy::brev(m2, 4)]); }
            __syncthreads();
            hy::fft_inv21(v, L, tl);
            const int gch = (o + 1) * 1024 + c; const bf16_t* rg = UHT + (size_t)gch * NTOK;
            const float w0 = cw[gch], w1 = cw[3072 + gch], w2 = cw[6144 + gch], bb = cb[gch];
            hy::cf zn[16]; int tg = tl; asm volatile("" : "+v"(tg));
#pragma unroll
            for (int n1 = 0; n1 < 16; ++n1) { const int t = tg + 512 * n1; const hy::cf y = v[hy::brev(n1, 5)];
                const float g0 = hyconv(rg, t, w0, w1, w2, bb), g1 = hyconv(rg + SEQ, t, w0, w1, w2, bb);
                zn[n1] = y * (hy::cf){g0 * (1.0f / 16384.0f), g1 * (1.0f / 16384.0f)}; if ((n1 & 3) == 3) asm volatile("" ::: "memory"); }
#pragma unroll
            for (int n1 = 0; n1 < 16; ++n1) v[n1] = zn[n1];
        }
        bf16_t* yo = YHT + (size_t)c * NTOK;
#pragma unroll
        for (int n1 = 0; n1 < 16; ++n1) { const int t = tl + 512 * n1; yo[t] = (bf16_t)f2bf(v[n1].x); yo[SEQ + t] = (bf16_t)f2bf(v[n1].y); }
    }
    __syncthreads();
}
__device__ __forceinline__ void phase_qknorm(KArgs a, LAS unsigned char* lds) {
    const int tid = opaque_tid(), lane = tid & 63, wave = tid >> 6, gw = blockIdx.x * 8 + wave, NGW = gridDim.x * 8;
    LAS unsigned* red = (LAS unsigned*)(lds + LDS_MISC + 1536);
    unsigned* ctl = (unsigned*)(a.ws + WS_CTL);
    if (tid < 64) red[tid] = 0u;
    __syncthreads();
    for (int which = 0; which < 2; ++which) { const bf16_t* P = (const bf16_t*)(a.ws + (which ? A_KB : A_QB));
        for (int b = 0; b < 2; ++b) { float mx = 0.f;
            for (int row = gw; row < SEQ; row += NGW) { const bf16_t* p = P + ((size_t)b * SEQ + row) * 1024 + lane * 16;
                const u32x4 w0 = *(const u32x4*)p, w1 = *(const u32x4*)(p + 8); const unsigned ww[8] = {w0.x, w0.y, w0.z, w0.w, w1.x, w1.y, w1.z, w1.w};
                float ss = 0.f;
#pragma unroll
                for (int i = 0; i < 8; ++i) { const float x = bflo(ww[i]), y = bfhi(ww[i]); ss += x * x + y * y; }
                ss += __shfl_xor(ss, 1); ss += __shfl_xor(ss, 2); mx = fmaxf(mx, ss); }
            if ((lane & 3) == 0) atomicMax((unsigned*)&red[which * 32 + b * 16 + (lane >> 2)], __float_as_uint(mx)); } }
    __syncthreads();
    if (tid < 64) atomicMax(ctl + CW_NORM + tid, red[tid]);
}
__device__ __forceinline__ void phase_attention(KArgs a, LAS unsigned char* lds) {
    const int G = gridDim.x, bx = blockIdx.x;
    const bf16_t* QB = (const bf16_t*)(a.ws + A_QB); const bf16_t* KB = (const bf16_t*)(a.ws + A_KB); const bf16_t* VB = (const bf16_t*)(a.ws + A_VB); bf16_t* OA = (bf16_t*)(a.ws + A_OA);
    const unsigned* nrm = (const unsigned*)(a.ws + WS_CTL) + CW_NORM;
    for (int i = 0;; ++i) {
        int bhc, qb;
        if (G == 256) { if (i >= 4) break;
            const int x = bx & 7, combo = x & 3, hh = (x < 4) ? ((i == 0) ? 7 : (i == 1) ? 5 : (i == 2) ? 1 : 0) : ((i == 0) ? 6 : (i == 1) ? 4 : (i == 2) ? 3 : 2); bhc = (combo >> 1) * 16 + hh * 2 + (combo & 1); qb = bx >> 3; }
        else { const int Lu = i * G + bx; if (Lu >= 1024) break; bhc = Lu >> 5; qb = Lu & 31; }
        const int b = bhc >> 4, h = (bhc >> 1) & 7, cm = bhc & 1;
        const size_t rowq = (size_t)b * SEQ + (size_t)qb * 256;
        const float sl2 = exp2f(-(float)(h + 1)) * 1.4426950408889634f;
        const float qk = sqrtf(__uint_as_float(nrm[bhc]) * __uint_as_float(nrm[32 + bhc]));
        const float Wk = (2.0f * qk + 38.0f) / sl2, q0f = (float)(qb * 256);
        int t_lo = (int)fmaxf(floorf((q0f - Wk - 63.0f) * (1.0f / 64.0f)), 0.0f), t_hi = (int)fminf(ceilf((q0f + 255.0f + Wk) * (1.0f / 64.0f)), 127.0f);
        if (((t_hi - t_lo + 1) & 1) != 0) { if (t_hi < 127) ++t_hi; else --t_lo; }
        att::attn_unit(QB + rowq * 1024 + h * 128 + cm * 64, KB + (size_t)b * SEQ * 1024 + h * 128 + cm * 64, VB + (size_t)b * SEQ * 1024 + h * 128,
                       OA + (size_t)cm * NTOK * 1024 + rowq * 1024 + h * 128, qb * 256, t_lo, t_hi - t_lo + 1, sl2, (char*)lds);
    }
}
__device__ __forceinline__ void phase_concat(KArgs a, LAS unsigned char* lds) {
    const int tid = opaque_tid(), lane = tid & 63, wave = tid >> 6, G = gridDim.x;
    const bf16_t* YHT = (const bf16_t*)(a.ws + A_YHT); const bf16_t* OA0 = (const bf16_t*)(a.ws + A_OA); const bf16_t* OA1 = OA0 + (size_t)NTOK * 1024; bf16_t* YC = (bf16_t*)(a.ws + A_YCAT);
    LAS bf16_t* T = (LAS bf16_t*)lds;
    const float lambda_init = 0.2f;
    const float lam = __expf(wave_sum(a.in[13][lane] * a.in[14][lane])) - __expf(wave_sum(a.in[15][lane] * a.in[16][lane])) + lambda_init;
    float gl[16];
#pragma unroll
    for (int i = 0; i < 16; ++i) gl[i] = a.in[17][(lane & 7) * 16 + i] * (1.0f - lambda_init);
    for (int it = blockIdx.x; it < NTOK / 64; it += G) {
        const int tok0 = it * 64;
#pragma unroll 4
        for (int k = 0; k < 16; ++k) { const int idx = tid + 512 * k, c = idx >> 3, ch = idx & 7;
            const u32x4 w = *(const u32x4*)(YHT + (size_t)c * NTOK + tok0 + ch * 8);
            LAS bf16_t* d = T + (ch * 8) * 1026 + c;
            d[0 * 1026] = (bf16_t)(w.x & 0xffff); d[1 * 1026] = (bf16_t)(w.x >> 16); d[2 * 1026] = (bf16_t)(w.y & 0xffff); d[3 * 1026] = (bf16_t)(w.y >> 16);
            d[4 * 1026] = (bf16_t)(w.z & 0xffff); d[5 * 1026] = (bf16_t)(w.z >> 16); d[6 * 1026] = (bf16_t)(w.w & 0xffff); d[7 * 1026] = (bf16_t)(w.w >> 16); }
        __syncthreads();
#pragma unroll 4
        for (int k = 0; k < 16; ++k) { const int idx = tid + 512 * k, tl = idx >> 7, c8 = idx & 127;
            const LAS unsigned* s = (const LAS unsigned*)(T + tl * 1026 + c8 * 8);
            u32x4 w; w.x = s[0]; w.y = s[1]; w.z = s[2]; w.w = s[3];
            *(u32x4*)(YC + (size_t)(tok0 + tl) * DM + c8 * 8) = w; }
        for (int rr = 0; rr < 8; ++rr) { const size_t tok = (size_t)tok0 + wave * 8 + rr;
            const u32x4 p0 = *(const u32x4*)(OA0 + tok * 1024 + lane * 16), p1 = *(const u32x4*)(OA0 + tok * 1024 + lane * 16 + 8);
            const u32x4 q0 = *(const u32x4*)(OA1 + tok * 1024 + lane * 16), q1 = *(const u32x4*)(OA1 + tok * 1024 + lane * 16 + 8);
            const unsigned pw[8] = {p0.x, p0.y, p0.z, p0.w, p1.x, p1.y, p1.z, p1.w}, qw[8] = {q0.x, q0.y, q0.z, q0.w, q1.x, q1.y, q1.z, q1.w};
            float o[16]; float ss = 0.f;
#pragma unroll
            for (int i = 0; i < 8; ++i) { o[2 * i] = bflo(pw[i]) - lam * bflo(qw[i]); o[2 * i + 1] = bfhi(pw[i]) - lam * bfhi(qw[i]); ss += o[2 * i] * o[2 * i] + o[2 * i + 1] * o[2 * i + 1]; }
            ss += __shfl_xor(ss, 1); ss += __shfl_xor(ss, 2); ss += __shfl_xor(ss, 4);
            const float rs = rsqrtf(ss * (1.0f / 128.0f) + LN_EPS);
            u32x4 w0, w1;
            w0.x = pk2(o[0] * rs * gl[0], o[1] * rs * gl[1]); w0.y = pk2(o[2] * rs * gl[2], o[3] * rs * gl[3]); w0.z = pk2(o[4] * rs * gl[4], o[5] * rs * gl[5]); w0.w = pk2(o[6] * rs * gl[6], o[7] * rs * gl[7]);
            w1.x = pk2(o[8] * rs * gl[8], o[9] * rs * gl[9]); w1.y = pk2(o[10] * rs * gl[10], o[11] * rs * gl[11]); w1.z = pk2(o[12] * rs * gl[12], o[13] * rs * gl[13]); w1.w = pk2(o[14] * rs * gl[14], o[15] * rs * gl[15]);
            *(u32x4*)(YC + tok * DM + 1024 + lane * 16) = w0; *(u32x4*)(YC + tok * DM + 1024 + lane * 16 + 8) = w1; }
        __syncthreads();
    }
}
__device__ __forceinline__ void ln_row(f32x4 (&v)[8], const float* g, const float* b, int lane, float& mu, float& rs) {
    float s = 0.f;
#pragma unroll
    for (int j = 0; j < 8; ++j) s += (v[j][0] + v[j][1]) + (v[j][2] + v[j][3]);
    const float mean = wave_sum(s) * (1.0f / DM); float s2 = 0.f;
#pragma unroll
    for (int j = 0; j < 8; ++j) { v[j] = v[j] - mean; s2 += (v[j][0] * v[j][0] + v[j][1] * v[j][1]) + (v[j][2] * v[j][2] + v[j][3] * v[j][3]); }
    const float rstd = rsqrtf(wave_sum(s2) * (1.0f / DM) + LN_EPS); mu = mean; rs = rstd;
#pragma unroll
    for (int j = 0; j < 8; ++j) { const f32x4 gg = *(const f32x4*)(g + 4 * (lane + 64 * j)), bb = *(const f32x4*)(b + 4 * (lane + 64 * j)); v[j] = v[j] * rstd * gg + bb; }
}
__device__ __forceinline__ void phase_ln_router(KArgs a, LAS unsigned char* lds, const bf16_t* R, const float* g, const float* b, bf16_t* HB, unsigned char* HB8, unsigned* cnt, int* rowlist, float* gatew) {
    const int tid = opaque_tid(), lane = tid & 63, wave = tid >> 6, G = gridDim.x;
    const float* rw = a.in[32]; const float* rb = a.in[33];
    LAS float* part = (LAS float*)lds;
    LAS int* hist = (LAS int*)(lds + 40960); LAS int* base = hist + 32; LAS float* stats = (LAS float*)(lds + 40960 + 512);
    for (int it = blockIdx.x; it < NTOK / 32; it += G) {
        const int tok0 = it * 32;
        for (int rr = 0; rr < 4; ++rr) { const size_t row = (size_t)tok0 + wave * 4 + rr; f32x4 v[8]; float mu, rs;
#pragma unroll
            for (int j = 0; j < 8; ++j) { const u32x2 w = *(const u32x2*)(R + row * DM + 4 * (lane + 64 * j)); v[j] = (f32x4){bflo(w.x), bfhi(w.x), bflo(w.y), bfhi(w.y)}; }
            ln_row(v, g, b, lane, mu, rs);
            if (lane == 0) { stats[(wave * 4 + rr) * 2] = mu; stats[(wave * 4 + rr) * 2 + 1] = rs; }
#pragma unroll
            for (int j = 0; j < 8; ++j) { u32x2 w; w.x = pk2(v[j][0], v[j][1]); w.y = pk2(v[j][2], v[j][3]); *(u32x2*)(HB + row * DM + 4 * (lane + 64 * j)) = w;
                if (HB8) *(unsigned*)(HB8 + row * DM + 4 * (lane + 64 * j)) = pg8::pk4_fp8(v[j][0], v[j][1], v[j][2], v[j][3]); } }
        if (tid < 32) hist[tid] = 0;
        __syncthreads();
        { const int i = lane & 31, kk = lane >> 5; f32x16 acc = {};
          const float mu = stats[i * 2], rs = stats[i * 2 + 1];
          const bf16_t* rrow = R + (size_t)(tok0 + i) * DM + wave * 256 + 4 * kk; const float* gp = g + wave * 256 + 4 * kk; const float* bp = b + wave * 256 + 4 * kk;
          const float* rwp = rw + (size_t)(wave * 256 + 4 * kk) * NEXP + i;
#pragma unroll 4
          for (int s = 0; s < 32; ++s) { const u32x2 rw2 = *(const u32x2*)(rrow + 8 * s); const f32x4 hv = ((f32x4){bflo(rw2.x), bfhi(rw2.x), bflo(rw2.y), bfhi(rw2.y)} - mu) * rs * *(const f32x4*)(gp + 8 * s) + *(const f32x4*)(bp + 8 * s);
#pragma unroll
              for (int j = 0; j < 4; ++j) acc = __builtin_amdgcn_mfma_f32_32x32x2f32(rwp[(size_t)(8 * s + j) * NEXP], hv[j], acc, 0, 0, 0); }
#pragma unroll
          for (int r = 0; r < 16; ++r) part[(wave * 32 + i) * 33 + (r & 3) + 8 * (r >> 2) + 4 * kk] = acc[r]; }
        __syncthreads();
        int e1 = 0, e2 = 0, r1 = 0, r2 = 0; float g1 = 0.f, g2 = 0.f;
        if (tid < 32) {
            float bestg = -1e30f;
#pragma unroll
            for (int gi = 0; gi < 4; ++gi) { float m1 = -1e30f, m2 = -1e30f, s1 = 0.f, s2 = 0.f; int i1 = 0, i2 = 0;
#pragma unroll
                for (int j = 0; j < 8; ++j) { const int e = gi * 8 + j; float lg = 0.f;
#pragma unroll
                    for (int w = 0; w < 8; ++w) lg += part[(w * 32 + tid) * 33 + e];
                    const float sg = 1.0f / (1.0f + expf(-lg)), sl = sg + rb[e];
                    if (sl > m1) { m2 = m1; i2 = i1; s2 = s1; m1 = sl; i1 = j; s1 = sg; } else if (sl > m2) { m2 = sl; i2 = j; s2 = sg; } }
                const float gs = m1 + m2;
                if (gs > bestg) { bestg = gs; e1 = gi * 8 + i1; e2 = gi * 8 + i2; g1 = s1; g2 = s2; } }
            const float inv = 1.0f / (g1 + g2); g1 *= inv; g2 *= inv;
            r1 = atomicAdd((int*)&hist[e1], 1); r2 = atomicAdd((int*)&hist[e2], 1);
        }
        __syncthreads();
        if (tid < 32) { const int hc = hist[tid]; base[tid] = hc ? (int)__hip_atomic_fetch_add(cnt + tid * 64, (unsigned)hc, __ATOMIC_RELAXED, __HIP_MEMORY_SCOPE_AGENT) : 0; }
        __syncthreads();
        if (tid < 32) { const int a0 = (tok0 + tid) * 2;
            rowlist[(size_t)e1 * ECAP + base[e1] + r1] = a0; gatew[a0] = g1;
            rowlist[(size_t)e2 * ECAP + base[e2] + r2] = a0 + 1; gatew[a0 + 1] = g2; }
        __syncthreads();
    }
}
__device__ __forceinline__ void phase_ln2(const bf16_t* HB, const bf16_t* Y2, const float* g, const float* b, float* OUT, bf16_t* OB) {
    const int tid = opaque_tid(), lane = tid & 63, wave = tid >> 6;
    for (int row = blockIdx.x * 8 + wave; row < NTOK; row += gridDim.x * 8) { f32x4 v[8]; float mu, rs;
#pragma unroll
        for (int j = 0; j < 8; ++j) { const int c = 4 * (lane + 64 * j); const u32x2 h = *(const u32x2*)(HB + (size_t)row * DM + c);
            const u32x2 y0 = *(const u32x2*)(Y2 + (size_t)(2 * row) * DM + c), y1 = *(const u32x2*)(Y2 + (size_t)(2 * row + 1) * DM + c);
            v[j] = (f32x4){bflo(h.x), bfhi(h.x), bflo(h.y), bfhi(h.y)} * DN_ALPHA + (f32x4){bflo(y0.x) + bflo(y1.x), bfhi(y0.x) + bfhi(y1.x), bflo(y0.y) + bflo(y1.y), bfhi(y0.y) + bfhi(y1.y)}; }
        ln_row(v, g, b, lane, mu, rs);
#pragma unroll
        for (int j = 0; j < 8; ++j) { const int c = 4 * (lane + 64 * j); if (OUT) *(f32x4*)(OUT + (size_t)row * DM + c) = v[j];
            if (OB) { u32x2 w; w.x = pk2(v[j][0], v[j][1]); w.y = pk2(v[j][2], v[j][3]); *(u32x2*)(OB + (size_t)row * DM + c) = w; } }
    }
}
__device__ __forceinline__ void moe_table(LAS int* tab, const unsigned* cnt) {
    __syncthreads();
    const int tid = opaque_tid();
    if (tid < 32) tab[64 + tid] = (int)cnt[tid * 64];
    __syncthreads();
    if (tid == 0) { int acc = 0; for (int e = 0; e < 32; ++e) { tab[e] = acc; acc += (tab[64 + e] + 255) >> 8; } tab[32] = acc; }
    __syncthreads();
}
__device__ __forceinline__ void phase_conv4(KArgs a) {
    const bf16_t* XR = (const bf16_t*)(a.ws + A_XR); bf16_t* XC = (bf16_t*)(a.ws + A_XC); const float* cw = a.in[20]; const float* cb = a.in[21];
    const int NT = gridDim.x * 512;
    for (int it = blockIdx.x * 512 + opaque_tid(); it < NTOK * 256; it += NT) { const int tok = it >> 8, ch = (it & 255) * 8, t = tok & (SEQ - 1);
        float acc[8];
#pragma unroll
        for (int i = 0; i < 8; ++i) acc[i] = cb[ch + i];
#pragma unroll
        for (int j = 0; j < 4; ++j) { const int tt = t + j - 2;
            if (tt >= 0 && tt < SEQ) { const u32x4 w = *(const u32x4*)(XR + (size_t)(tok + j - 2) * DM + ch); const unsigned ww[4] = {w.x, w.y, w.z, w.w};
#pragma unroll
                for (int i = 0; i < 4; ++i) { acc[2 * i] += cw[j * DM + ch + 2 * i] * bflo(ww[i]); acc[2 * i + 1] += cw[j * DM + ch + 2 * i + 1] * bfhi(ww[i]); } } }
        u32x4 o; o.x = pk2(acc[0], acc[1]); o.y = pk2(acc[2], acc[3]); o.z = pk2(acc[4], acc[5]); o.w = pk2(acc[6], acc[7]);
        *(u32x4*)(XC + (size_t)tok * DM + ch) = o; }
}
constexpr size_t CAR_ELEMS = (size_t)2 * 2 * 256 * DM;
__device__ __forceinline__ void phase_scan1(KArgs a) {
    const bf16_t* LA = (const bf16_t*)(a.ws + A_LA); const bf16_t* BB = (const bf16_t*)(a.ws + A_BB); float* CARA = (float*)(a.ws + A_CAR); float* CARB = CARA + CAR_ELEMS;
    const int NT = gridDim.x * 512;
    for (int it = blockIdx.x * 512 + opaque_tid(); it < 2 * 2 * 256 * 512; it += NT) { const int ch = (it & 511) * 4, chunk = (it >> 9) & 255, dir = (it >> 17) & 1, b = it >> 18;
        float h[4] = {0.f, 0.f, 0.f, 0.f}, ls[4] = {0.f, 0.f, 0.f, 0.f};
#pragma unroll 8
        for (int s = 0; s < 32; ++s) { const int t = chunk * 32 + (dir ? 31 - s : s); const size_t off = ((size_t)dir * NTOK + (size_t)b * SEQ + t) * DM + ch;
            const u32x2 lw = *(const u32x2*)(LA + off), bw = *(const u32x2*)(BB + off);
            const float l4[4] = {bflo(lw.x), bfhi(lw.x), bflo(lw.y), bfhi(lw.y)}, b4[4] = {bflo(bw.x), bfhi(bw.x), bflo(bw.y), bfhi(bw.y)};
#pragma unroll
            for (int i = 0; i < 4; ++i) { h[i] = __expf(l4[i]) * h[i] + b4[i]; ls[i] += l4[i]; } }
        const size_t co = (((size_t)b * 2 + dir) * 256 + chunk) * DM + ch;
        *(f32x4*)(CARA + co) = (f32x4){ls[0], ls[1], ls[2], ls[3]}; *(f32x4*)(CARB + co) = (f32x4){h[0], h[1], h[2], h[3]}; }
}
__device__ __forceinline__ void phase_scan2(KArgs a, LAS unsigned char* lds) {
    float* CARA = (float*)(a.ws + A_CAR); float* CARB = CARA + CAR_ELEMS; float* CARIN = CARB + CAR_ELEMS;
    const int tid = opaque_tid(), grp = tid >> 5, chl = tid & 31;
    LAS float* sh = (LAS float*)lds;
    for (int it = blockIdx.x; it < 2 * 2 * 64; it += gridDim.x) { const int ch = (it & 63) * 32 + chl, dir = (it >> 6) & 1, b = it >> 7;
        float la[16], lb[16]; float A = 0.f, B = 0.f;
#pragma unroll
        for (int k = 0; k < 16; ++k) { const int q = grp * 16 + k, chunk = dir ? 255 - q : q; const size_t co = (((size_t)b * 2 + dir) * 256 + chunk) * DM + ch; la[k] = CARA[co]; lb[k] = CARB[co]; }
#pragma unroll
        for (int k = 0; k < 16; ++k) { B = __expf(la[k]) * B + lb[k]; A += la[k]; }
        sh[(grp * 32 + chl) * 2] = A; sh[(grp * 32 + chl) * 2 + 1] = B;
        __syncthreads();
        float h = 0.f;
        for (int g2 = 0; g2 < grp; ++g2) h = __expf(sh[(g2 * 32 + chl) * 2]) * h + sh[(g2 * 32 + chl) * 2 + 1];
#pragma unroll
        for (int k = 0; k < 16; ++k) { const int q = grp * 16 + k, chunk = dir ? 255 - q : q; const size_t co = (((size_t)b * 2 + dir) * 256 + chunk) * DM + ch; CARIN[co] = h; h = __expf(la[k]) * h + lb[k]; }
        __syncthreads();
    }
}
__device__ __forceinline__ float gelu_tanh(float x) { const float u = 0.7978845608028654f * (x + 0.044715f * x * x * x); const float th = 1.0f - 2.0f * __builtin_amdgcn_rcpf(1.0f + __builtin_amdgcn_exp2f(2.8853900817779268f * u)); return 0.5f * x * (1.0f + th); }
__device__ __forceinline__ void phase_scan3(KArgs a) {
    const bf16_t* LA = (const bf16_t*)(a.ws + A_LA); const bf16_t* BB = (const bf16_t*)(a.ws + A_BB); const bf16_t* GB = (const bf16_t*)(a.ws + A_GB); bf16_t* YG = (bf16_t*)(a.ws + A_YG);
    const float* CARIN = (const float*)(a.ws + A_CAR) + 2 * CAR_ELEMS;
    const int NT = gridDim.x * 512;
    for (int it = blockIdx.x * 512 + opaque_tid(); it < 2 * 256 * 512; it += NT) { const int ch = (it & 511) * 4, chunk = (it >> 9) & 255, b = it >> 17;
        float hf[32][4]; float h[4];
        { const f32x4 c = *(const f32x4*)(CARIN + (((size_t)b * 2 + 0) * 256 + chunk) * DM + ch); h[0] = c[0]; h[1] = c[1]; h[2] = c[2]; h[3] = c[3]; }
#pragma unroll
        for (int s = 0; s < 32; ++s) { const size_t off = ((size_t)b * SEQ + chunk * 32 + s) * DM + ch;
            const u32x2 lw = *(const u32x2*)(LA + off), bw = *(const u32x2*)(BB + off);
            const float l4[4] = {bflo(lw.x), bfhi(lw.x), bflo(lw.y), bfhi(lw.y)}, b4[4] = {bflo(bw.x), bfhi(bw.x), bflo(bw.y), bfhi(bw.y)};
#pragma unroll
            for (int i = 0; i < 4; ++i) { h[i] = __expf(l4[i]) * h[i] + b4[i]; hf[s][i] = h[i]; } }
        { const f32x4 c = *(const f32x4*)(CARIN + (((size_t)b * 2 + 1) * 256 + chunk) * DM + ch); h[0] = c[0]; h[1] = c[1]; h[2] = c[2]; h[3] = c[3]; }
#pragma unroll
        for (int s = 31; s >= 0; --s) { const size_t tokoff = ((size_t)b * SEQ + chunk * 32 + s) * DM + ch; const size_t off = (size_t)NTOK * DM + tokoff;
            const u32x2 lw = *(const u32x2*)(LA + off), bw = *(const u32x2*)(BB + off), gw = *(const u32x2*)(GB + tokoff);
            const float l4[4] = {bflo(lw.x), bfhi(lw.x), bflo(lw.y), bfhi(lw.y)}, b4[4] = {bflo(bw.x), bfhi(bw.x), bflo(bw.y), bfhi(bw.y)}, g4[4] = {bflo(gw.x), bfhi(gw.x), bflo(gw.y), bfhi(gw.y)};
            float y[4];
#pragma unroll
            for (int i = 0; i < 4; ++i) { h[i] = __expf(l4[i]) * h[i] + b4[i]; y[i] = gelu_tanh(g4[i]) * (hf[s][i] + h[i]); }
            u32x2 w; w.x = pk2(y[0], y[1]); w.y = pk2(y[2], y[3]); *(u32x2*)(YG + tokoff) = w; } }
}

#define KARGS() (*(const __attribute__((address_space(4))) Args*)__builtin_amdgcn_kernarg_segment_ptr())
#define PHASE_FN __device__ __forceinline__ void
#define PH_PRE() KArgs a = KARGS(); LAS unsigned char* lds = (LAS unsigned char*)lds_raw; unsigned char* ws = a.ws; asm volatile("" : "+s"(ws)); const int G = gridDim.x, bx = blockIdx.x; (void)lds; (void)ws; (void)G; (void)bx; using namespace pg8
PHASE_FN ph0() { PH_PRE(); phase_prologue(a, lds); }
PHASE_FN ph1a() { PH_PRE(); Gemm g{(const bf16_t*)(ws + A_W4T), (const bf16_t*)(ws + A_H3B), 128, 128, 128}; StaticOrder S; S.init(4096, 8192, G, bx); EpiFilt E{(bf16_t*)(ws + A_KTD)}; gemm_phase(lds, g, S, E); }
PHASE_FN ph1b() { PH_PRE(); Gemm g{(const bf16_t*)(ws + A_XB), (const bf16_t*)(ws + WS_WIN_EV) + (size_t)3072 * DM, DM, DM, DM}; StaticOrder S; S.init(NTOK, 3072, G, bx);
                  EpiBf16 E{(bf16_t*)(ws + A_QB), 1024, 1024, (size_t)(A_KB - A_QB) / 2, QSCALE}; gemm_phase(lds, g, S, E); }
PHASE_FN ph1c() { PH_PRE(); Gemm g{(const bf16_t*)(ws + WS_WIN_EV), (const bf16_t*)(ws + A_XB), DM, DM, DM}; StaticOrder S; S.init(3072, NTOK, G, bx);
                  EpiBf16 E{(bf16_t*)(ws + A_UHT), NTOK, 0, 0, 1.f}; gemm_phase(lds, g, S, E); }
PHASE_FN ph2() { PH_PRE(); phase_qknorm(a, lds); }
PHASE_FN ph3a() { PH_PRE(); phase_hyena_mixer(a, lds); }
PHASE_FN ph3b() { PH_PRE(); phase_attention(a, lds); }
PHASE_FN ph4() { PH_PRE(); phase_concat(a, lds); }
PHASE_FN ph5() { PH_PRE(); Gemm g{(const bf16_t*)(ws + A_YCAT), (const bf16_t*)(ws + WS_WOUT_EV), DM, DM, DM}; StaticOrder S; S.init(NTOK, DM, G, bx);
                 EpiResBf E{(const bf16_t*)(ws + A_XB2), (bf16_t*)(ws + A_R0), DM, DN_ALPHA}; gemm_phase(lds, g, S, E); }
template <int LAYER> PHASE_FN ph_lnr() { PH_PRE(); unsigned* ctl = (unsigned*)(ws + WS_CTL);
    phase_ln_router(a, lds, (const bf16_t*)(ws + (LAYER ? A_R1 : A_R0)), a.in[28] + LAYER * DM, a.in[29] + LAYER * DM, (bf16_t*)(ws + (LAYER ? A_HB_1 : A_HB_0)), (LAYER >= 2 - MOE_FP8_LAYERS) ? ws + (LAYER ? A_HB8_1 : A_HB8_0) : nullptr,
                    ctl + CW_CNT + LAYER * 32 * 64, (int*)(ws + A_ROWL), (float*)(ws + A_GATEW)); }
template <int LAYER> PHASE_FN ph_moe1() { PH_PRE(); LAS int* tab = (LAS int*)(lds + LDS_MISC); moe_table(tab, (const unsigned*)(ws + WS_CTL) + CW_CNT + LAYER * 32 * 64);
    MoeOrder<4, true> S{G, bx, tab, (const int*)(ws + A_ROWL)};
    if constexpr (LAYER >= 2 - MOE_FP8_LAYERS) {
        Gemm g{(const bf16_t*)(ws + (LAYER ? A_HB8_1 : A_HB8_0)), (const bf16_t*)(ws + WS_W1T + (size_t)LAYER * 32 * 1024 * DM * 2), DM / 2, DM / 2, DM / 2};
        EpiSwiglu8 E{ws + (LAYER ? A_HID_1 : A_HID_0)}; gemm_phase<EpiSwiglu8, MoeOrder<4, true>, true>(lds, g, S, E);
    } else {
        Gemm g{(const bf16_t*)(ws + (LAYER ? A_HB_1 : A_HB_0)), (const bf16_t*)(ws + WS_W1T) + (size_t)LAYER * 32 * 1024 * DM, DM, DM, DM};
        EpiSwiglu E{(bf16_t*)(ws + (LAYER ? A_HID_1 : A_HID_0))}; gemm_phase(lds, g, S, E); } }
template <int LAYER> PHASE_FN ph_moe2() { PH_PRE(); LAS int* tab = (LAS int*)(lds + LDS_MISC); moe_table(tab, (const unsigned*)(ws + WS_CTL) + CW_CNT + LAYER * 32 * 64);
    MoeOrder<8, false> S{G, bx, tab, (const int*)(ws + A_ROWL)};
    if constexpr (LAYER >= 2 - MOE_FP8_LAYERS) {
        Gemm g{(const bf16_t*)(ws + (LAYER ? A_HID_1 : A_HID_0)), (const bf16_t*)(ws + WS_W2T + (size_t)LAYER * 32 * DM * DFF * 2), DFF / 2, DFF / 2, DFF / 2};
        EpiDown E{(bf16_t*)(ws + (LAYER ? A_Y2_1 : A_Y2_0)), (const int*)(ws + A_ROWL), (const float*)(ws + A_GATEW), 1.0f / (FP8_SW * FP8_SH)};
        gemm_phase<EpiDown, MoeOrder<8, false>, true>(lds, g, S, E);
    } else {
        Gemm g{(const bf16_t*)(ws + (LAYER ? A_HID_1 : A_HID_0)), (const bf16_t*)(ws + WS_W2T) + (size_t)LAYER * 32 * DM * DFF, DFF, DFF, DFF};
        EpiDown E{(bf16_t*)(ws + (LAYER ? A_Y2_1 : A_Y2_0)), (const int*)(ws + A_ROWL), (const float*)(ws + A_GATEW), 1.0f}; gemm_phase(lds, g, S, E); } }
template <int LAYER> PHASE_FN ph_ln2() { PH_PRE();
    phase_ln2((const bf16_t*)(ws + (LAYER ? A_HB_1 : A_HB_0)), (const bf16_t*)(ws + (LAYER ? A_Y2_1 : A_Y2_0)), a.in[30] + LAYER * DM, a.in[31] + LAYER * DM, LAYER ? a.out : nullptr, LAYER ? nullptr : (bf16_t*)(ws + A_HB2)); }
PHASE_FN ph10() { PH_PRE(); Gemm g{(const bf16_t*)(ws + A_HB2), (const bf16_t*)(ws + WS_WIN_OD), DM, DM, DM}; StaticOrder S; S.init(NTOK, 2 * DM, G, bx);
                  EpiBf16 E{(bf16_t*)(ws + A_GB), DM, DM, (size_t)(A_XR - A_GB) / 2, 1.f}; gemm_phase(lds, g, S, E); }
PHASE_FN ph11() { PH_PRE(); phase_conv4(a); }
PHASE_FN ph12() { PH_PRE(); Gemm g{(const bf16_t*)(ws + A_XC), (const bf16_t*)(ws + WS_WG_OD), DM, 256, 256}; RGOrder S{G, bx};
                  EpiRG E{(bf16_t*)(ws + A_LA), (bf16_t*)(ws + A_BB), (const bf16_t*)(ws + A_XC), a.in[23], a.in[25], a.in[26]}; gemm_phase(lds, g, S, E); }
PHASE_FN ph13() { PH_PRE(); phase_scan1(a); }
PHASE_FN ph14() { PH_PRE(); phase_scan2(a, lds); }
PHASE_FN ph15() { PH_PRE(); phase_scan3(a); }
PHASE_FN ph16() { PH_PRE(); Gemm g{(const bf16_t*)(ws + A_YG), (const bf16_t*)(ws + WS_WOUT_OD), DM, DM, DM}; StaticOrder S; S.init(NTOK, DM, G, bx);
                  EpiResBf E{(const bf16_t*)(ws + A_HB2), (bf16_t*)(ws + A_R1), DM, DN_ALPHA}; gemm_phase(lds, g, S, E); }

__global__ void __launch_bounds__(512, 2) fwd(Args a) {
    LAS unsigned char* lds = (LAS unsigned char*)lds_raw;
    unsigned* ctl = (unsigned*)(a.ws + WS_CTL);
    volatile LAS unsigned* bst = (volatile LAS unsigned*)(lds + LDS_MISC + 2048);
    { const int tid = threadIdx.x;
      if ((tid & 63) == 0) ((LAS int*)(lds + LDS_WIDTAB))[hw_slot()] = tid >> 6;
      if (tid < 4) bst[tid] = 0u; }
    __syncthreads();
    const int lo = a.ph_lo, hi = a.ph_hi;
    XcdBarrier bar; bar.bar = ctl + CW_BAR; bar.x = 0; bar.st = bst;
    if (hi - lo > 1) bar = xcd_barrier_post(ctl + CW_BAR, bst);
#ifdef ONLY_PHASE
#define IN(k) ((k) == ONLY_PHASE && lo <= (k) && (k) < hi)
#else
#define IN(k) (lo <= (k) && (k) < hi)
#endif
#define SEAM(k) do { if (IN(k) && IN((k) + 1)) xcd_barrier(bar); } while (0)
    if (IN(0)) { asm volatile("; PHASE_MARK 0"); ph0(); } SEAM(0);
    if (IN(1)) { asm volatile("; PHASE_MARK 1a"); ph1a(); asm volatile("; PHASE_MARK 1b"); ph1b(); asm volatile("; PHASE_MARK 1c"); ph1c(); } SEAM(1);
    if (IN(2)) { asm volatile("; PHASE_MARK 2"); ph2(); } SEAM(2);
    if (IN(3)) { asm volatile("; PHASE_MARK 3a"); ph3a(); asm volatile("; PHASE_MARK 3b"); ph3b(); } SEAM(3);
    if (IN(4)) { asm volatile("; PHASE_MARK 4"); ph4(); } SEAM(4);
    if (IN(5)) { asm volatile("; PHASE_MARK 5"); ph5(); } SEAM(5);
    if (IN(6)) { asm volatile("; PHASE_MARK 6"); ph_lnr<0>(); } SEAM(6);
    if (IN(7)) { asm volatile("; PHASE_MARK 7"); ph_moe1<0>(); } SEAM(7);
    if (IN(8)) { asm volatile("; PHASE_MARK 8"); ph_moe2<0>(); } SEAM(8);
    if (IN(9)) { asm volatile("; PHASE_MARK 9"); ph_ln2<0>(); } SEAM(9);
    if (IN(10)) { asm volatile("; PHASE_MARK 10"); ph10(); } SEAM(10);
    if (IN(11)) { asm volatile("; PHASE_MARK 11"); ph11(); } SEAM(11);
    if (IN(12)) { asm volatile("; PHASE_MARK 12"); ph12(); } SEAM(12);
    if (IN(13)) { asm volatile("; PHASE_MARK 13"); ph13(); } SEAM(13);
    if (IN(14)) { asm volatile("; PHASE_MARK 14"); ph14(); } SEAM(14);
    if (IN(15)) { asm volatile("; PHASE_MARK 15"); ph15(); } SEAM(15);
    if (IN(16)) { asm volatile("; PHASE_MARK 16"); ph16(); } SEAM(16);
    if (IN(17)) { asm volatile("; PHASE_MARK 17"); ph_lnr<1>(); } SEAM(17);
    if (IN(18)) { asm volatile("; PHASE_MARK 18"); ph_moe1<1>(); } SEAM(18);
    if (IN(19)) { asm volatile("; PHASE_MARK 19"); ph_moe2<1>(); } SEAM(19);
    if (IN(20)) { asm volatile("; PHASE_MARK 20"); ph_ln2<1>(); }
#undef IN
#undef SEAM
}

#ifndef MK_PER_PHASE
#define MK_PER_PHASE 0
#endif
extern "C" void kernel_launch(void* const* d_in, const int* in_sizes, int n_in, void* d_out, int out_size, void* d_ws, size_t ws_size, hipStream_t stream) {
    static int grid = 0;
    if (grid == 0) {
        if (n_in != 37 || out_size != NTOK * DM || ws_size < WS_END) { fprintf(stderr, "kernel_launch: built for 37 inputs, %d outputs, >= %zu bytes of workspace; got n_in %d out %d ws %zu\n", NTOK * DM, (size_t)WS_END, n_in, out_size, ws_size); grid = -1; return; }
        int dev = 0, cus = 0, per_cu = 0;
        if (hipGetDevice(&dev) != hipSuccess || hipDeviceGetAttribute(&cus, hipDeviceAttributeMultiprocessorCount, dev) != hipSuccess) { grid = -1; return; }
        if (hipFuncSetAttribute((const void*)fwd, hipFuncAttributeMaxDynamicSharedMemorySize, LDS_BYTES) != hipSuccess) { fprintf(stderr, "kernel_launch: hipFuncSetAttribute failed\n"); grid = -1; return; }
        if (hipOccupancyMaxActiveBlocksPerMultiprocessor(&per_cu, (const void*)fwd, 512, LDS_BYTES) != hipSuccess || per_cu < 1) fprintf(stderr, "kernel_launch: occupancy query reports %d\n", per_cu);
        (void)hipGetLastError();
        grid = cus;
    }
    if (grid < 0) return;
    (void)hipMemsetAsync((char*)d_ws + WS_CTL, 0, CTL_ZERO_BYTES, stream);
    Args a{};
    for (int i = 0; i < 37; ++i) a.in[i] = (const float*)d_in[i];
    a.out = (float*)d_out; a.ws = (unsigned char*)d_ws;
#if MK_PER_PHASE
    for (int p = 0; p < NPHASE; ++p) { a.ph_lo = p; a.ph_hi = p + 1; hipLaunchKernelGGL(fwd, dim3(grid), dim3(512), LDS_BYTES, stream, a); }
#else
    a.ph_lo = 0; a.ph_hi = NPHASE; hipLaunchKernelGGL(fwd, dim3(grid), dim3(512), LDS_BYTES, stream, a);
#endif
}
```

```cpp
#include <hip/hip_runtime.h>
#include <hip/hip_fp16.h>
#include <cstdio>
#include <cstdint>

#define GAS __attribute__((address_space(1)))
#define LAS __attribute__((address_space(3)))
typedef unsigned short bf16_t;
typedef short bf16x8 __attribute__((ext_vector_type(8)));
typedef short s16x4 __attribute__((ext_vector_type(4)));
typedef float f32x2 __attribute__((ext_vector_type(2)));
typedef float f32x4 __attribute__((ext_vector_type(4)));
typedef float f32x8 __attribute__((ext_vector_type(8)));
typedef float f32x16 __attribute__((ext_vector_type(16)));
typedef unsigned u32x2 __attribute__((ext_vector_type(2)));
typedef unsigned u32x4 __attribute__((ext_vector_type(4)));
typedef GAS unsigned gu32;

constexpr int DM = 2048, BATCH = 2, SEQ = 8192, NTOK = BATCH * SEQ;
constexpr int HY_CH = 1024, EV_IN = 6144;
constexpr int NEXP = 32, DFF = 512, NASSIGN = NTOK * 2, ECAP = NASSIGN;
constexpr float LN_EPS = 1e-5f;
constexpr float DN_ALPHA = 1.4142135623730951f;
constexpr float QSCALE = 0.125f * 1.4426950408889634f;
constexpr int FFT_N = 16384, FFT_RS = 528;

__device__ __forceinline__ unsigned f2bf(float f) { unsigned u = __builtin_bit_cast(unsigned, f); return (u + 0x7fffu + ((u >> 16) & 1u)) >> 16; }
__device__ __forceinline__ unsigned pk2(float lo, float hi) { return f2bf(lo) | (f2bf(hi) << 16); }
__device__ __forceinline__ float bf2f(unsigned short h) { return __builtin_bit_cast(float, (unsigned)h << 16); }
__device__ __forceinline__ float bflo(unsigned w) { return __builtin_bit_cast(float, w << 16); }
__device__ __forceinline__ float bfhi(unsigned w) { return __builtin_bit_cast(float, w & 0xffff0000u); }
__device__ __forceinline__ unsigned cvt_pk_bf16(float lo, float hi) { unsigned r; asm volatile("v_cvt_pk_bf16_f32 %0, %1, %2" : "=v"(r) : "v"(lo), "v"(hi)); return r; }
__device__ __forceinline__ float wave_sum(float v) {
#pragma unroll
    for (int o = 1; o < 64; o <<= 1) v += __shfl_xor(v, o);
    return v;
}
__device__ __forceinline__ float sigmoidf_(float x) { return __builtin_amdgcn_rcpf(1.0f + __builtin_amdgcn_exp2f(-1.4426950408889634f * x)); }
constexpr int LDS_WIDTAB = 139264 + 3072;
__device__ __forceinline__ int hw_slot() { return (int)(__builtin_amdgcn_s_getreg((5 << 11) | 4) & 63u); }
__device__ __forceinline__ int lane_id() { return (int)__builtin_amdgcn_mbcnt_hi(~0u, __builtin_amdgcn_mbcnt_lo(~0u, 0u)); }
extern __shared__ __attribute__((aligned(16))) unsigned char lds_raw[];
__device__ __forceinline__ int wave_id() { return __builtin_amdgcn_readfirstlane(((const LAS int*)((LAS unsigned char*)lds_raw + LDS_WIDTAB))[hw_slot()]); }
__device__ __forceinline__ int opaque_tid() { int t = wave_id() * 64 + lane_id(); asm volatile("" : "+v"(t)); return t; }
#define LDS_WAIT() asm volatile("s_waitcnt lgkmcnt(0)" ::: "memory")
#define VM_WAIT() asm volatile("s_waitcnt vmcnt(0)" ::: "memory")

#define XB_TMO      128
#define XB_XCNT(j)  (256  + 64 * (j))
#define XB_XSUB(j)  (1280 + 64 * (j))
#define XB_XGEN(j)  (2304 + 64 * (j))
#define XB_TOP      3328
#define XB_TOPGEN   3392
#define XCD_BAR_WORDS 3456
#define XB_SPIN_CAP (1u << 18)
__device__ __forceinline__ unsigned xb_ld(unsigned* p)              { return __hip_atomic_load(p, __ATOMIC_RELAXED, __HIP_MEMORY_SCOPE_AGENT); }
__device__ __forceinline__ unsigned xb_add(unsigned* p, unsigned v) { return __hip_atomic_fetch_add(p, v, __ATOMIC_RELAXED, __HIP_MEMORY_SCOPE_AGENT); }
__device__ __forceinline__ unsigned xb_xcc_id() { return (unsigned)__builtin_amdgcn_s_getreg((3 << 11) | 20) & 0xFu; }
#define XB_SPIN(cond, bar) do { unsigned _sp = 0; while (cond) { __builtin_amdgcn_s_sleep(1); \
    if ((++_sp & 255u) == 0u) { if (xb_ld(&(bar)[XB_TMO])) break; if (_sp > XB_SPIN_CAP) { atomicAdd(&(bar)[XB_TMO], 1u); break; } } } } while (0)
struct XcdBarrier { unsigned* bar; unsigned x; volatile LAS unsigned* st; };
__device__ __forceinline__ XcdBarrier xcd_barrier_post(unsigned* bar, volatile LAS unsigned* st) {
    XcdBarrier b; b.bar = bar; b.x = xb_xcc_id(); b.st = st;
    if (opaque_tid() == 0) (void)xb_add(&bar[XB_XCNT(b.x)], 1u);
    return b;
}
__device__ __forceinline__ void xcd_barrier_complete(unsigned* bar, unsigned x, unsigned& nloc, unsigned& nx) {
    const unsigned G = gridDim.x * gridDim.y * gridDim.z;
    unsigned sum, cnt, mine, sp = 0u;
    for (;;) {
        sum = 0u; cnt = 0u; mine = 0u;
#pragma unroll
        for (unsigned j = 0; j < 16; ++j) { const unsigned c = xb_ld(&bar[XB_XCNT(j)]); sum += c; cnt += (c > 0u) ? 1u : 0u; mine = (j == x) ? c : mine; }
        if (sum == G) break;
        __builtin_amdgcn_s_sleep(1);
        if ((++sp & 255u) == 0u) { if (xb_ld(&bar[XB_TMO])) break; if (sp > XB_SPIN_CAP) { atomicAdd(&bar[XB_TMO], 1u); break; } }
    }
    nloc = mine > 0u ? mine : 1u; nx = cnt > 0u ? cnt : 1u;
}
__device__ __forceinline__ void xcd_barrier(const XcdBarrier& b) {
    asm volatile("s_waitcnt vmcnt(0)" ::: "memory");
    __syncthreads();
    if (opaque_tid() == 0) {
        unsigned* bar = b.bar;
        __builtin_amdgcn_s_waitcnt(0);
        unsigned nloc = b.st[0], nx = b.st[1];
        if (nloc == 0u) { xcd_barrier_complete(bar, b.x, nloc, nx); b.st[0] = nloc; b.st[1] = nx; }
        const unsigned old = xb_add(&bar[XB_XSUB(b.x)], 1u);
        const unsigned gen = old / nloc;
        if (old + 1u == (gen + 1u) * nloc) {
            __builtin_amdgcn_fence(__ATOMIC_RELEASE, "agent");
            asm volatile("s_waitcnt vmcnt(0)" ::: "memory");
            const unsigned og = xb_add(&bar[XB_TOP], 1u);
            const unsigned tg = og / nx;
            if (og + 1u == (tg + 1u) * nx) xb_add(&bar[XB_TOPGEN], 1u);
            else XB_SPIN(xb_ld(&bar[XB_TOPGEN]) == tg, bar);
            __builtin_amdgcn_fence(__ATOMIC_ACQUIRE, "agent");
            xb_add(&bar[XB_XGEN(b.x)], 1u);
            asm volatile("s_waitcnt vmcnt(0)" ::: "memory");
        } else {
            XB_SPIN(xb_ld(&bar[XB_XGEN(b.x)]) == gen, bar);
            __builtin_amdgcn_fence(__ATOMIC_ACQUIRE, "agent");
            asm volatile("s_waitcnt vmcnt(0)" ::: "memory");
        }
    }
    __syncthreads();
}

namespace pg8 {
constexpr int BM = 256, BK = 64, HALF = 128, HTB = HALF * BK * 2, STAGE_BYTES = 8 * HTB, NXCD = 8, WGM = 8;
__host__ __device__ __forceinline__ int lds_byte(int r, int c) { const int st = (r >> 4) * 2 + (c >> 5), rr = r & 15, cc = c & 31, ob = rr * 64 + cc * 2; return st * 1024 + (ob ^ (((ob >> 9) & 1) << 5)); }
__host__ __device__ __forceinline__ void stage_rc(int b, int& R, int& C) { const int st = b / 1024, sb = b % 1024, swz = sb ^ (((sb >> 9) & 1) << 5); R = (st >> 1) * 16 + swz / 64; C = (st & 1) * 32 + (swz % 64) / 2; }
__host__ __device__ __forceinline__ int perm32(int rho) { const int n = rho >> 4, i = rho & 15; return 8 * (i >> 2) + 4 * n + (i & 3); }

struct Unit { int pm, pn, e, t, cnt; };
struct Gemm { const bf16_t* A; const bf16_t* Bt; int lda, ldb, K; };

struct StaticOrder {
    static constexpr bool GATHER_A = false;
    int nM, nN, nwg, G, c;
    __device__ void init(int M, int N, int G_, int c_) { nM = M / BM; nN = N / BM; nwg = nM * nN; G = G_; c = c_; }
    __device__ __forceinline__ bool next(int i, Unit& u) const {
        const long L = (long)i * G + c; if (L >= nwg) return false;
        int wgid = (int)L; { const int q = nwg / NXCD, r = nwg % NXCD, xcd = wgid % NXCD, off = wgid / NXCD; wgid = (xcd < r ? xcd * (q + 1) : r * (q + 1) + (xcd - r) * q) + off; }
        const int nig = WGM * nN, gid = wgid / nig, fm = gid * WGM, gsz = (nM - fm) < WGM ? (nM - fm) : WGM;
        u.pm = fm + ((wgid % nig) % gsz); u.pn = (wgid % nig) / gsz; u.e = 0; u.t = 0; u.cnt = 0; return true;
    }
    __device__ __forceinline__ int rowA(const Unit& u, int r) const { return u.pm * BM + r; }
    __device__ __forceinline__ int colA(const Unit&) const { return 0; }
    __device__ __forceinline__ int rowB(const Unit& u, int r) const { return u.pn * BM + r; }
};

typedef int v8i32 __attribute__((ext_vector_type(8)));
template <class Epi, class Sched, bool FP8 = false>
__device__ __forceinline__ void gemm_phase(LAS unsigned char* lds, const Gemm g, const Sched& S, const Epi& E) {
    const int tid = opaque_tid(), wid = __builtin_amdgcn_readfirstlane(tid >> 6), lane = tid & 63, wr = wid >> 2, wc = wid & 3, fr = lane & 15, fq = lane >> 4;
    const int K = g.K, nt = K / BK;
    constexpr bool GA = Sched::GATHER_A;
    int sR[2], sC[2];
    unsigned laneA[2], laneB[2];
#pragma unroll
    for (int i = 0; i < 2; ++i) { int R, C; stage_rc(tid * 16 + i * 8192, R, C); sR[i] = R; sC[i] = C; const int Rb = Epi::PERM ? ((R & ~31) + perm32(R & 31)) : R;
        laneA[i] = (unsigned)(R * g.lda + C) * 2u; laneB[i] = (unsigned)(Rb * g.ldb + C) * 2u; }
    const size_t hstepA = (size_t)HALF * g.lda * 2, hstepB = (size_t)HALF * g.ldb * 2;
    const unsigned ldsw = (unsigned)wid * 1024u;
    const int aoff = lds_byte(wr * 64 + fr, fq * 8), boff = lds_byte(wc * 32 + fr, fq * 8);
    const char* gA = (const char*)g.A; const char* gB = (const char*)g.Bt;
#define PG8_SA(b, h) (((b) * 2 + (h)) * HTB)
#define PG8_SB(b, h) ((4 + (b) * 2 + (h)) * HTB)
#define PG8_STAGE(bufoff, gptr, voff) do { _Pragma("unroll") for (int _i = 0; _i < 2; ++_i) \
        __builtin_amdgcn_global_load_lds((const unsigned*)((gptr) + (size_t)(voff)[_i]), (LAS unsigned*)(lds + (bufoff) + ldsw + _i * 8192), 16, 0, 0); } while (0)
#define PG8_STAGE_B(bufoff, ub, h, kb) PG8_STAGE(bufoff, gB + (ub) + (size_t)(h) * hstepB + (size_t)(kb), laneB)
#define PG8_STAGE_A(bufoff, ub, va, h, kb) do { if constexpr (GA) { PG8_STAGE(bufoff, gA + (size_t)(kb), va[h]); } else { PG8_STAGE(bufoff, gA + (ub) + (size_t)(h) * hstepA + (size_t)(kb), laneA); } } while (0)
#define PG8_RD(off) (*(const LAS u32x4*)(lds + (off)))
#define PG8_CAT2(x, y) __builtin_bit_cast(v8i32, __builtin_shufflevector((x), (y), 0, 1, 2, 3, 4, 5, 6, 7))
#define PG8_LDA(dst, b, h) do { if constexpr (FP8) { _Pragma("unroll") for (int m = 0; m < 4; ++m) dst##8[m] = PG8_CAT2(PG8_RD(PG8_SA(b, h) + aoff + m * 2048), PG8_RD(PG8_SA(b, h) + aoff + m * 2048 + 1024)); } \
        else { _Pragma("unroll") for (int m = 0; m < 4; ++m) _Pragma("unroll") for (int k = 0; k < 2; ++k) dst[m][k] = *(const LAS bf16x8*)(lds + PG8_SA(b, h) + aoff + m * 2048 + k * 1024); } } while (0)
#define PG8_LDB(dst, b, h) do { if constexpr (FP8) { _Pragma("unroll") for (int n = 0; n < 2; ++n) dst##8[n] = PG8_CAT2(PG8_RD(PG8_SB(b, h) + boff + n * 2048), PG8_RD(PG8_SB(b, h) + boff + n * 2048 + 1024)); } \
        else { _Pragma("unroll") for (int n = 0; n < 2; ++n) _Pragma("unroll") for (int k = 0; k < 2; ++k) dst[n][k] = *(const LAS bf16x8*)(lds + PG8_SB(b, h) + boff + n * 2048 + k * 1024); } } while (0)
#define PG8_MMA(ai, bj, At, Bt) do { __builtin_amdgcn_s_setprio(1); _Pragma("unroll") for (int m = 0; m < 4; ++m) _Pragma("unroll") for (int n = 0; n < 2; ++n) { \
        if constexpr (FP8) { asm volatile("v_mfma_scale_f32_16x16x128_f8f6f4 %0, %1, %2, %0, %3, %3 op_sel_hi:[0,0,0]" : "+v"(acc[ai][bj][m][n]) : "v"(Bt##8[n]), "v"(At##8[m]), "v"(fp8_one)); } \
        else { _Pragma("unroll") for (int k = 0; k < 2; ++k) acc[ai][bj][m][n] = __builtin_amdgcn_mfma_f32_16x16x32_bf16(Bt[n][k], At[m][k], acc[ai][bj][m][n], 0, 0, 0); } } \
        __builtin_amdgcn_s_setprio(0); } while (0)
#define PG8_WAIT_V(n) asm volatile("s_waitcnt vmcnt(" #n ")" ::: "memory")
#define PG8_WAIT_L(n) asm volatile("s_waitcnt lgkmcnt(" #n ")" ::: "memory")
#define PG8_BAR __builtin_amdgcn_s_barrier()
#define PG8_SCHED __builtin_amdgcn_sched_barrier(0)
#define PG8_SCHED8 do { if constexpr (FP8) __builtin_amdgcn_sched_barrier(0); } while (0)
#define PG8_OFFS(u, ubA, ubB, vA) do { ubB = ((size_t)S.rowB(u, 0) * (size_t)g.ldb) * 2; \
        if constexpr (GA) { ubA = 0; _Pragma("unroll") for (int _h = 0; _h < 2; ++_h) _Pragma("unroll") for (int _i = 0; _i < 2; ++_i) vA[_h][_i] = ((unsigned)S.rowA(u, _h * HALF + sR[_i]) * (unsigned)g.lda + (unsigned)sC[_i]) * 2u; } \
        else { ubA = ((size_t)S.rowA(u, 0) * (size_t)g.lda + (size_t)S.colA(u)) * 2; } } while (0)
    Unit cur, nxt; int ui = 0;
    if (!S.next(0, cur)) return;
    f32x4 acc[2][2][4][2];
#pragma unroll
    for (int a = 0; a < 2; ++a)
#pragma unroll
        for (int b = 0; b < 2; ++b)
#pragma unroll
            for (int m = 0; m < 4; ++m)
#pragma unroll
                for (int n = 0; n < 2; ++n) acc[a][b][m][n] = (f32x4){0.f, 0.f, 0.f, 0.f};
    const int fp8_one = 0x7f7f7f7f;
    bf16x8 At[4][2], B0[2][2], B1[2][2]; v8i32 At8[4], B08[2], B18[2];
    size_t ubAc, ubBc, ubAn, ubBn; unsigned vAc[2][2] = {}, vAn[2][2] = {};
    PG8_OFFS(cur, ubAc, ubBc, vAc);
    PG8_STAGE_B(PG8_SB(0, 0), ubBc, 0, 0); PG8_STAGE_B(PG8_SB(0, 1), ubBc, 1, 0); PG8_STAGE_A(PG8_SA(0, 0), ubAc, vAc, 0, 0); PG8_STAGE_A(PG8_SA(0, 1), ubAc, vAc, 1, 0);
    if (wr == 1) PG8_BAR;
    PG8_WAIT_V(2); PG8_BAR;
    PG8_STAGE_B(PG8_SB(1, 0), ubBc, 0, 128); PG8_STAGE_A(PG8_SA(1, 0), ubAc, vAc, 0, 128); PG8_STAGE_B(PG8_SB(1, 1), ubBc, 1, 128);
    PG8_WAIT_V(6); PG8_BAR;
    for (;;) {
        const bool has_next = S.next(ui + 1, nxt);
        if (has_next) { PG8_OFFS(nxt, ubAn, ubBn, vAn); }
        else { ubAn = ubAc; ubBn = ubBc;
#pragma unroll
            for (int h = 0; h < 2; ++h)
#pragma unroll
                for (int i = 0; i < 2; ++i) vAn[h][i] = vAc[h][i]; }
        for (int t = 0; t < nt; t += 2) {
            const bool last = (t == nt - 2);
            const unsigned k1 = (unsigned)(t + 1) * 128u, k2 = last ? 0u : (unsigned)(t + 2) * 128u, k3 = k2 + 128u;
            const size_t xubA = last ? ubAn : ubAc, xubB = last ? ubBn : ubBc;
            unsigned xA[2][2];
#pragma unroll
            for (int h = 0; h < 2; ++h)
#pragma unroll
                for (int i = 0; i < 2; ++i) xA[h][i] = last ? vAn[h][i] : vAc[h][i];
            PG8_LDB(B0, 0, 0); PG8_LDB(B1, 0, 1); PG8_SCHED; PG8_LDA(At, 0, 0); PG8_STAGE_A(PG8_SA(1, 1), ubAc, vAc, 1, k1);
            PG8_WAIT_V(8); PG8_WAIT_L(0); PG8_SCHED8; PG8_BAR; PG8_MMA(0, 0, At, B0); PG8_MMA(0, 1, At, B1); PG8_SCHED8; PG8_BAR; PG8_SCHED;
            PG8_LDA(At, 0, 1); PG8_STAGE_B(PG8_SB(0, 0), xubB, 0, k2); PG8_STAGE_B(PG8_SB(0, 1), xubB, 1, k2); PG8_STAGE_A(PG8_SA(0, 0), xubA, xA, 0, k2);
            PG8_WAIT_V(8); PG8_WAIT_L(0); PG8_SCHED8; PG8_BAR; PG8_MMA(1, 0, At, B0); PG8_MMA(1, 1, At, B1); PG8_SCHED8; PG8_BAR; PG8_SCHED;
            PG8_LDB(B0, 1, 0); PG8_LDB(B1, 1, 1); PG8_SCHED; PG8_LDA(At, 1, 0); PG8_STAGE_A(PG8_SA(0, 1), xubA, xA, 1, k2);
            PG8_WAIT_V(8); PG8_WAIT_L(0); PG8_SCHED8; PG8_BAR; PG8_MMA(0, 0, At, B0); PG8_MMA(0, 1, At, B1); PG8_SCHED8; PG8_BAR; PG8_SCHED;
            PG8_LDA(At, 1, 1); PG8_STAGE_B(PG8_SB(1, 0), xubB, 0, k3); PG8_STAGE_B(PG8_SB(1, 1), xubB, 1, k3); PG8_STAGE_A(PG8_SA(1, 0), xubA, xA, 0, k3);
            PG8_WAIT_V(8); PG8_WAIT_L(0); PG8_SCHED8; PG8_BAR; PG8_MMA(1, 0, At, B0); PG8_MMA(1, 1, At, B1); PG8_SCHED8; PG8_BAR; PG8_SCHED;
        }
        if (wr == 0) PG8_BAR;
        E(acc, cur, wr, wc, fr, fq);
        if (!has_next) break;
#pragma unroll
        for (int a = 0; a < 2; ++a)
#pragma unroll
            for (int b = 0; b < 2; ++b)
#pragma unroll
                for (int m = 0; m < 4; ++m)
#pragma unroll
                    for (int n = 0; n < 2; ++n) acc[a][b][m][n] = (f32x4){0.f, 0.f, 0.f, 0.f};
        cur = nxt; ++ui; ubAc = ubAn; ubBc = ubBn;
#pragma unroll
        for (int h = 0; h < 2; ++h)
#pragma unroll
            for (int i = 0; i < 2; ++i) vAc[h][i] = vAn[h][i];
        if (wr == 1) PG8_BAR;
    }
    PG8_WAIT_V(0);
    PG8_BAR;
#undef PG8_SA
#undef PG8_SB
#undef PG8_STAGE
#undef PG8_STAGE_A
#undef PG8_STAGE_B
#undef PG8_LDA
#undef PG8_LDB
#undef PG8_MMA
#undef PG8_RD
#undef PG8_CAT2
#undef PG8_WAIT_V
#undef PG8_WAIT_L
#undef PG8_BAR
#undef PG8_SCHED
#undef PG8_SCHED8
#undef PG8_OFFS
}
}
namespace pg8 {
struct EpiBf16 {
    static constexpr bool PERM = true;
    bf16_t* O; int ldc; int split_cols; size_t split_stride; float scale0; float scale_all = 1.0f;
    __device__ __forceinline__ void operator()(const f32x4 (&acc)[2][2][4][2], const Unit& u, int wr, int wc, int fr, int fq) const {
        const int row0 = u.pm * BM + wr * 64 + fr; int colt = u.pn * BM; bf16_t* base = O;
        float sc = scale_all; if (split_cols) { const int t = colt / split_cols; base += (size_t)t * split_stride; colt -= t * split_cols; if (t == 0) sc *= scale0; }
        const int col0 = colt + wc * 32 + 8 * fq;
#pragma unroll
        for (int ai = 0; ai < 2; ++ai)
#pragma unroll
            for (int m = 0; m < 4; ++m) { bf16_t* rowp = base + (size_t)(row0 + ai * HALF + m * 16) * ldc + col0;
#pragma unroll
                for (int bj = 0; bj < 2; ++bj) { const f32x4 v0 = acc[ai][bj][m][0] * sc, v1 = acc[ai][bj][m][1] * sc;
                    u32x4 w; w.x = cvt_pk_bf16(v0[0], v0[1]); w.y = cvt_pk_bf16(v0[2], v0[3]); w.z = cvt_pk_bf16(v1[0], v1[1]); w.w = cvt_pk_bf16(v1[2], v1[3]);
                    *(u32x4*)(rowp + bj * HALF) = w; } }
    }
};
struct EpiFilt {
    static constexpr bool PERM = true;
    bf16_t* O;
    __device__ __forceinline__ void operator()(const f32x4 (&acc)[2][2][4][2], const Unit& u, int wr, int wc, int fr, int fq) const {
        const float dmin = -3.0701134573253945f, dmax = -15.350567286626973f;
#pragma unroll
        for (int ai = 0; ai < 2; ++ai)
#pragma unroll
            for (int m = 0; m < 4; ++m) { const int row = u.pm * BM + ai * HALF + wr * 64 + m * 16 + fr; const int c = row & 1023;
                const float dl2 = fabsf(dmin + (float)c * ((dmax - dmin) / 1023.0f)) * (1.4426950408889634f / 8191.0f);
#pragma unroll
                for (int bj = 0; bj < 2; ++bj) { const int col = u.pn * BM + bj * HALF + wc * 32 + 8 * fq; float v[8];
#pragma unroll
                    for (int n = 0; n < 2; ++n)
#pragma unroll
                        for (int j = 0; j < 4; ++j) v[n * 4 + j] = acc[ai][bj][m][n][j] * __builtin_amdgcn_exp2f(-(float)(col + n * 4 + j) * dl2);
                    u32x4 w; w.x = cvt_pk_bf16(v[0], v[1]); w.y = cvt_pk_bf16(v[2], v[3]); w.z = cvt_pk_bf16(v[4], v[5]); w.w = cvt_pk_bf16(v[6], v[7]);
                    *(u32x4*)(O + (size_t)row * 8192 + col) = w; }
                asm volatile("" ::: "memory"); }
    }
};
struct EpiResF32 {
    static constexpr bool PERM = false;
    const float* res; float* O; int ldc; float alpha;
    __device__ __forceinline__ void operator()(const f32x4 (&acc)[2][2][4][2], const Unit& u, int wr, int wc, int fr, int fq) const {
#pragma unroll
        for (int ai = 0; ai < 2; ++ai)
#pragma unroll
            for (int m = 0; m < 4; ++m) { const size_t off = (size_t)(u.pm * BM + ai * HALF + wr * 64 + m * 16 + fr) * ldc + u.pn * BM + wc * 32 + 4 * fq;
#pragma unroll
                for (int bj = 0; bj < 2; ++bj)
#pragma unroll
                    for (int n = 0; n < 2; ++n) { const f32x4 r = *(const f32x4*)(res + off + bj * HALF + n * 16); *(f32x4*)(O + off + bj * HALF + n * 16) = r * alpha + acc[ai][bj][m][n]; }
                if (m & 1) asm volatile("" ::: "memory"); }
    }
};
struct EpiResBf {
    static constexpr bool PERM = true;
    const bf16_t* res; bf16_t* O; int ldc; float alpha; float ascale = 1.0f;
    __device__ __forceinline__ void operator()(const f32x4 (&acc)[2][2][4][2], const Unit& u, int wr, int wc, int fr, int fq) const {
#pragma unroll
        for (int ai = 0; ai < 2; ++ai)
#pragma unroll
            for (int m = 0; m < 4; ++m) { const size_t off = (size_t)(u.pm * BM + ai * HALF + wr * 64 + m * 16 + fr) * ldc + u.pn * BM + wc * 32 + 8 * fq;
#pragma unroll
                for (int bj = 0; bj < 2; ++bj) { const u32x4 r = *(const u32x4*)(res + off + bj * HALF); const f32x4 a0 = acc[ai][bj][m][0] * ascale, a1 = acc[ai][bj][m][1] * ascale;
                    u32x4 w; w.x = cvt_pk_bf16(bflo(r.x) * alpha + a0[0], bfhi(r.x) * alpha + a0[1]); w.y = cvt_pk_bf16(bflo(r.y) * alpha + a0[2], bfhi(r.y) * alpha + a0[3]);
                    w.z = cvt_pk_bf16(bflo(r.z) * alpha + a1[0], bfhi(r.z) * alpha + a1[1]); w.w = cvt_pk_bf16(bflo(r.w) * alpha + a1[2], bfhi(r.w) * alpha + a1[3]);
                    *(u32x4*)(O + off + bj * HALF) = w; }
                if (m & 1) asm volatile("" ::: "memory"); }
    }
};
struct EpiSwiglu {
    static constexpr bool PERM = true;
    bf16_t* O;
    __device__ __forceinline__ void operator()(const f32x4 (&acc)[2][2][4][2], const Unit& u, int wr, int wc, int fr, int fq) const {
#pragma unroll
        for (int ai = 0; ai < 2; ++ai)
#pragma unroll
            for (int m = 0; m < 4; ++m) { bf16_t* p = O + (size_t)(u.pm * BM + ai * HALF + wr * 64 + m * 16 + fr) * DFF + u.pn * HALF + wc * 32 + 8 * fq;
                float h[8];
#pragma unroll
                for (int n = 0; n < 2; ++n)
#pragma unroll
                    for (int j = 0; j < 4; ++j) { const float gt = acc[ai][0][m][n][j], up = acc[ai][1][m][n][j]; h[n * 4 + j] = gt * sigmoidf_(gt) * up; }
                u32x4 w; w.x = cvt_pk_bf16(h[0], h[1]); w.y = cvt_pk_bf16(h[2], h[3]); w.z = cvt_pk_bf16(h[4], h[5]); w.w = cvt_pk_bf16(h[6], h[7]);
                *(u32x4*)p = w; }
    }
};
__device__ __forceinline__ unsigned pk4_fp8(float a, float b, float c, float d) { int w = 0; w = __builtin_amdgcn_cvt_pk_fp8_f32(a, b, w, false); w = __builtin_amdgcn_cvt_pk_fp8_f32(c, d, w, true); return (unsigned)w; }
constexpr float FP8_SW = 64.0f, FP8_SH = 8.0f;
struct EpiSwiglu8 {
    static constexpr bool PERM = true;
    unsigned char* O;
    __device__ __forceinline__ void operator()(const f32x4 (&acc)[2][2][4][2], const Unit& u, int wr, int wc, int fr, int fq) const {
#pragma unroll
        for (int ai = 0; ai < 2; ++ai)
#pragma unroll
            for (int m = 0; m < 4; ++m) { unsigned char* p = O + (size_t)(u.pm * BM + ai * HALF + wr * 64 + m * 16 + fr) * DFF + u.pn * HALF + wc * 32 + 8 * fq;
                float h[8];
#pragma unroll
                for (int n = 0; n < 2; ++n)
#pragma unroll
                    for (int j = 0; j < 4; ++j) { const float gt = acc[ai][0][m][n][j] * (1.0f / FP8_SW), up = acc[ai][1][m][n][j] * (1.0f / FP8_SW); h[n * 4 + j] = gt * sigmoidf_(gt) * up * FP8_SH; }
                u32x2 w; w.x = pk4_fp8(h[0], h[1], h[2], h[3]); w.y = pk4_fp8(h[4], h[5], h[6], h[7]);
                *(u32x2*)p = w; }
    }
};
struct EpiDown {
    static constexpr bool PERM = true;
    bf16_t* O; const int* rowlist; const float* gatew; float oscale;
    __device__ __forceinline__ void operator()(const f32x4 (&acc)[2][2][4][2], const Unit& u, int wr, int wc, int fr, int fq) const {
#pragma unroll
        for (int ai = 0; ai < 2; ++ai)
#pragma unroll
            for (int m = 0; m < 4; ++m) { const int idx = u.t * BM + ai * HALF + wr * 64 + m * 16 + fr;
                if (idx < u.cnt) { const int a = rowlist[(size_t)u.e * ECAP + idx]; const float gw = gatew[a] * oscale;
                    bf16_t* p = O + (size_t)a * DM + u.pn * BM + wc * 32 + 8 * fq;
#pragma unroll
                    for (int bj = 0; bj < 2; ++bj) { const f32x4 v0 = acc[ai][bj][m][0] * gw, v1 = acc[ai][bj][m][1] * gw;
                        u32x4 w; w.x = cvt_pk_bf16(v0[0], v0[1]); w.y = cvt_pk_bf16(v0[2], v0[3]); w.z = cvt_pk_bf16(v1[0], v1[1]); w.w = cvt_pk_bf16(v1[2], v1[3]);
                        *(u32x4*)(p + bj * HALF) = w; } } }
    }
};
struct EpiRG {
    static constexpr bool PERM = true;
    bf16_t* LA; bf16_t* BB; const bf16_t* XC; const float* ba; const float* bx; const float* lam;
    __device__ __forceinline__ void operator()(const f32x4 (&acc)[2][2][4][2], const Unit& u, int wr, int wc, int fr, int fq) const {
        const int nb = u.pn >> 2, q = u.pn & 3, dir = q >> 1, half = q & 1;
        const int ch0 = nb * 256 + half * HALF + wc * 32 + 8 * fq;
        float vba[8], vbx[8], vsp[8];
#pragma unroll
        for (int j = 0; j < 8; ++j) { vba[j] = ba[dir * DM + ch0 + j]; vbx[j] = bx[dir * DM + ch0 + j];
            const float x = __expf(-lam[dir * DM + ch0 + j]);
            vsp[j] = 8.0f * (x < 0.05f ? x * (1.0f - x * (0.5f - x * (0.33333334f - 0.25f * x))) : __logf(1.0f + x)); }
#pragma unroll
        for (int ai = 0; ai < 2; ++ai)
#pragma unroll
            for (int m = 0; m < 4; ++m) { const size_t tok = (size_t)(u.pm * BM + ai * HALF + wr * 64 + m * 16 + fr);
                asm volatile("" ::: "memory");
                const u32x4 xw = *(const u32x4*)(XC + tok * DM + ch0);
                float xf[8] = {bflo(xw.x), bfhi(xw.x), bflo(xw.y), bfhi(xw.y), bflo(xw.z), bfhi(xw.z), bflo(xw.w), bfhi(xw.w)};
                float la[8], bb[8];
#pragma unroll
                for (int n = 0; n < 2; ++n)
#pragma unroll
                    for (int j = 0; j < 4; ++j) { const int k = n * 4 + j;
                        const float r = sigmoidf_(acc[ai][0][m][n][j] + vba[k]), ig = sigmoidf_(acc[ai][1][m][n][j] + vbx[k]);
                        const float l = -r * vsp[k]; la[k] = l; bb[k] = __builtin_amdgcn_sqrtf(fmaxf(1.0f - __builtin_amdgcn_exp2f(2.8853900817779268f * l), 0.f)) * (ig * xf[k]); }
                u32x4 w; w.x = cvt_pk_bf16(la[0], la[1]); w.y = cvt_pk_bf16(la[2], la[3]); w.z = cvt_pk_bf16(la[4], la[5]); w.w = cvt_pk_bf16(la[6], la[7]);
                *(u32x4*)(LA + ((size_t)dir * NTOK + tok) * DM + ch0) = w;
                w.x = cvt_pk_bf16(bb[0], bb[1]); w.y = cvt_pk_bf16(bb[2], bb[3]); w.z = cvt_pk_bf16(bb[4], bb[5]); w.w = cvt_pk_bf16(bb[6], bb[7]);
                *(u32x4*)(BB + ((size_t)dir * NTOK + tok) * DM + ch0) = w; }
    }
};

struct RGOrder {
    static constexpr bool GATHER_A = false;
    int G, c;
    __device__ __forceinline__ bool next(int i, Unit& u) const {
        if (G == 256) { if (i >= 8) return false; const int x = c & 7, y = c >> 3; u.pm = i * 8 + (y >> 2); u.pn = x * 4 + (y & 3); }
        else { const int L = i * G + c; if (L >= 64 * 32) return false; u.pm = L >> 5; u.pn = L & 31; }
        u.e = 0; u.t = 0; u.cnt = 0; return true; }
    __device__ __forceinline__ int rowA(const Unit& u, int r) const { return u.pm * BM + r; }
    __device__ __forceinline__ int colA(const Unit& u) const { return (u.pn >> 2) * 256; }
    __device__ __forceinline__ int rowB(const Unit& u, int r) const { return u.pn * BM + r; }
};
template <int NPN, bool GATHER>
struct MoeOrder {
    static constexpr bool GATHER_A = GATHER;
    int G, c; const LAS int* tab; const int* rowlist;
    __device__ __forceinline__ bool next(int i, Unit& u) const {
        const int L = i * G + c, ntile = tab[32]; if (L >= ntile * NPN) return false;
        const int tile = L / NPN; u.pm = tile; u.pn = L % NPN; int e = 0;
        while (e < 31 && tab[e + 1] <= tile) ++e;
        u.e = e; u.t = tile - tab[e]; u.cnt = tab[64 + e]; return true;
    }
    __device__ __forceinline__ int rowA(const Unit& u, int r) const {
        if (GATHER) { const int idx = u.t * BM + r; const int a = idx < u.cnt ? rowlist[(size_t)u.e * ECAP + idx] : 0; return a >> 1; }
        return u.pm * BM + r;
    }
    __device__ __forceinline__ int colA(const Unit&) const { return 0; }
    __device__ __forceinline__ int rowB(const Unit& u, int r) const { return (u.e * NPN + u.pn) * BM + r; }
};
}
namespace att {
constexpr int NW = 8, QBLK = 32, KVBLK = 64, LDQ = 1024, LDK = 1024, LDV = 1024, LDO = 1024;
constexpr int SHM_V = KVBLK * 128 * 2, SHM_K = KVBLK * 64 * 2, NSLOT = 4, LDS_K = 0, LDS_V = NSLOT * SHM_K, LDS_WS = NSLOT * (SHM_K + SHM_V), SHM_ATTN = LDS_WS + NW * 64 * 4;
__device__ __forceinline__ void glds16s(const void* sbase, unsigned voff, unsigned lds_dst) { unsigned keep;
    asm volatile("s_mov_b32 %0, m0\n\ts_mov_b32 m0, %3\n\ts_nop 0\n\tglobal_load_lds_dwordx4 %1, %2\n\ts_mov_b32 m0, %0" : "=&s"(keep) : "v"(voff), "s"(sbase), "s"(lds_dst) : "memory"); }
#define WAITBAR(N) asm volatile("s_waitcnt vmcnt(" #N ") lgkmcnt(0)\n\ts_barrier" ::: "memory")
constexpr float THR2 = 8.0f * 1.4426950408889634f;
#define KSWZ64(row, colB) ((row) * 128 + ((colB) ^ ((((row) >> 1) & 7) << 4)))
#define SBAR() __builtin_amdgcn_sched_barrier(0)
__device__ __forceinline__ int crow(int r, int hi) { return (r & 3) + 8 * (r >> 2) + 4 * hi; }
__device__ __forceinline__ void qkt(f32x16& p0, f32x16& p1, const char* Ks, const bf16x8* qr, int r32, int hi, float A, float st) {
    { float b4[4];
#pragma unroll
      for (int j = 0; j < 4; ++j) b4[j] = fmaf(st, (float)j, A);
      const float s8 = 8.0f * st, s32 = 32.0f * st;
#pragma unroll
      for (int r = 0; r < 16; ++r) { p0[r] = (r < 4) ? b4[r] : p0[r - 4] + s8; }
#pragma unroll
      for (int r = 0; r < 16; ++r) p1[r] = p0[r] + s32; }
#pragma unroll
    for (int d0 = 0; d0 < 4; ++d0) { const int cb = (d0 * 16 + hi * 8) * 2;
        const bf16x8 b0 = *reinterpret_cast<const bf16x8*>(Ks + KSWZ64(r32, cb));
        const bf16x8 b1 = *reinterpret_cast<const bf16x8*>(Ks + KSWZ64(32 + r32, cb));
        p0 = __builtin_amdgcn_mfma_f32_32x32x16_bf16(b0, qr[d0], p0, 0, 0, 0);
        p1 = __builtin_amdgcn_mfma_f32_32x32x16_bf16(b1, qr[d0], p1, 0, 0, 0); }
}
__device__ __forceinline__ void partialSM(f32x16& p0, f32x16& p1, bool mixed, float fd, float sl2) {
    if (mixed) {
#pragma unroll
        for (int r = 0; r < 16; ++r) { const float d0 = fd - (float)((r & 3) + 8 * (r >> 2)); p0[r] = fmaf(fabsf(d0), -sl2, p0[r]); p1[r] = fmaf(fabsf(d0 - 32.0f), -sl2, p1[r]); }
    }
#pragma unroll
    for (int r = 0; r < 16; ++r) p0[r] = __builtin_amdgcn_exp2f(p0[r]);
}
__device__ __forceinline__ void finishSM(f32x16& p0, f32x16& p1, float& l_reg, bf16x8& pa0, bf16x8& pa1, bf16x8& pa2, bf16x8& pa3) {
#pragma unroll
    for (int r = 0; r < 16; ++r) p1[r] = __builtin_amdgcn_exp2f(p1[r]);
    float ps = 0;
#pragma unroll
    for (int r = 0; r < 16; ++r) ps += p0[r];
#pragma unroll
    for (int r = 0; r < 16; ++r) ps += p1[r];
    l_reg += ps;
#define PK4(P, BASE, OUT) do { unsigned a0 = cvt_pk_bf16(P[BASE + 0], P[BASE + 1]), a1 = cvt_pk_bf16(P[BASE + 2], P[BASE + 3]);   \
    unsigned b0 = cvt_pk_bf16(P[BASE + 4], P[BASE + 5]), b1 = cvt_pk_bf16(P[BASE + 6], P[BASE + 7]);                              \
    auto r0 = __builtin_amdgcn_permlane32_swap(a0, b0, false, false); auto r1 = __builtin_amdgcn_permlane32_swap(a1, b1, false, false); \
    u32x4 w = {r0[0], r1[0], r0[1], r1[1]}; OUT = __builtin_bit_cast(bf16x8, w); } while (0)
    PK4(p0, 0, pa0); PK4(p0, 8, pa1); PK4(p1, 0, pa2); PK4(p1, 8, pa3);
#undef PK4
}
__device__ __forceinline__ int v_st(int k, int c) { const int kk = (k & ~0xC) | ((k & 4) << 1) | ((k & 8) >> 1); return ((kk >> 3) * 4 + (c >> 5)) * 512 + ((kk & 7) * 32 + (c & 31)) * 2; }
__device__ __forceinline__ int v_rd_base(int lane) { return ((lane & 3) << 3) | (((lane >> 2) & 3) << 6) | (((lane >> 4) & 1) << 5) | (((lane >> 5) & 1) << 8); }
constexpr int v_rd_off(int d0, int ks, int half) { return d0 * 512 + ks * 4096 + half * 2048; }
template <int OFF> __device__ __forceinline__ s16x4 tr_read(int vb) {
    s16x4 r; asm volatile("ds_read_b64_tr_b16 %0, %1 offset:%2" : "=&v"(r) : "v"(vb), "i"(OFF) : "memory"); return r;
}
template <int D0> __device__ __forceinline__ void pv_one(f32x16& od, int vb, bf16x8 pa0, bf16x8 pa1, bf16x8 pa2, bf16x8 pa3) {
    const s16x4 l0 = tr_read<v_rd_off(D0, 0, 0)>(vb), h0 = tr_read<v_rd_off(D0, 0, 1)>(vb), l1 = tr_read<v_rd_off(D0, 1, 0)>(vb), h1 = tr_read<v_rd_off(D0, 1, 1)>(vb);
    const s16x4 l2 = tr_read<v_rd_off(D0, 2, 0)>(vb), h2 = tr_read<v_rd_off(D0, 2, 1)>(vb), l3 = tr_read<v_rd_off(D0, 3, 0)>(vb), h3 = tr_read<v_rd_off(D0, 3, 1)>(vb);
    asm volatile("s_waitcnt lgkmcnt(0)" ::: "memory"); SBAR();
#define PK(L, H) (bf16x8){L[0], L[1], L[2], L[3], H[0], H[1], H[2], H[3]}
    od = __builtin_amdgcn_mfma_f32_32x32x16_bf16(pa0, PK(l0, h0), od, 0, 0, 0);
    od = __builtin_amdgcn_mfma_f32_32x32x16_bf16(pa1, PK(l1, h1), od, 0, 0, 0);
    od = __builtin_amdgcn_mfma_f32_32x32x16_bf16(pa2, PK(l2, h2), od, 0, 0, 0);
    od = __builtin_amdgcn_mfma_f32_32x32x16_bf16(pa3, PK(l3, h3), od, 0, 0, 0);
#undef PK
}
__device__ __forceinline__ void pv_d0(f32x16* o, int vb, bf16x8 pa0, bf16x8 pa1, bf16x8 pa2, bf16x8 pa3) {
    pv_one<0>(o[0], vb, pa0, pa1, pa2, pa3); pv_one<1>(o[1], vb, pa0, pa1, pa2, pa3); pv_one<2>(o[2], vb, pa0, pa1, pa2, pa3); pv_one<3>(o[3], vb, pa0, pa1, pa2, pa3);
}
__device__ __forceinline__ void attn_unit(const bf16_t* __restrict__ Qb, const bf16_t* __restrict__ Kh, const bf16_t* __restrict__ Vh, bf16_t* __restrict__ Ob, int q0, int t_lo, int n, float sl2, char* lds) {
    const int tid = opaque_tid(), wid = __builtin_amdgcn_readfirstlane(tid >> 6), lane = tid & 63, r32 = lane & 31, hi = lane >> 5;
    float* ws = (float*)(lds + LDS_WS) + wid * 64; float* li_l = ws;
    float l_reg = 0; f32x16 o[4] = {}; bf16x8 qr[4];
    const bf16_t* Qw = Qb + (long)(wid * QBLK + r32) * LDQ + hi * 8;
#pragma unroll
    for (int d0 = 0; d0 < 4; ++d0) qr[d0] = *reinterpret_cast<const bf16x8*>(Qw + d0 * 16);
    float negM;
    { const bf16_t* Kw = Kh + (long)(q0 + wid * QBLK + r32) * LDK + hi * 8; float s = 0.f;
#pragma unroll
      for (int d0 = 0; d0 < 4; ++d0) { const u32x4 kw = *reinterpret_cast<const u32x4*>(Kw + d0 * 16); const u32x4 qw = __builtin_bit_cast(u32x4, qr[d0]);
          s += bflo(kw.x) * bflo(qw.x) + bfhi(kw.x) * bfhi(qw.x) + bflo(kw.y) * bflo(qw.y) + bfhi(kw.y) * bfhi(qw.y) + bflo(kw.z) * bflo(qw.z) + bfhi(kw.z) * bfhi(qw.z) + bflo(kw.w) * bflo(qw.w) + bfhi(kw.w) * bfhi(qw.w); }
      auto rr = __builtin_amdgcn_permlane32_swap(__float_as_uint(s), __float_as_uint(s), false, false); negM = -(__uint_as_float(rr[0]) + __uint_as_float(rr[1])); }
    const unsigned lds0 = (unsigned)(uintptr_t)lds;
    const int krow = wid * 8 + (lane >> 3), kch = (lane & 7) ^ ((krow >> 1) & 7);
    const unsigned koff = (unsigned)(krow * LDK * 2 + kch * 16);
    unsigned voff[2];
#pragma unroll
    for (int z = 0; z < 2; ++z) { const int P16 = (wid + 8 * z) * 64 + lane, sub = P16 >> 5, win = P16 & 31, kk = (sub >> 2) * 8 + (win >> 2), k = (kk & ~0xC) | ((kk & 4) << 1) | ((kk & 8) >> 1), c = (sub & 3) * 32 + (win & 3) * 8;
        voff[z] = (unsigned)(k * LDV * 2 + c * 2); }
    const unsigned kdst = lds0 + LDS_K + wid * 1024, vdst = lds0 + LDS_V + wid * 1024;
    const int vb0 = (int)(lds0 + LDS_V) + v_rd_base(lane);
    const char* K_lds = lds + LDS_K;
    const int qw0 = q0 + wid * QBLK;
    const float fq0 = (float)(qw0 + r32 - 4 * hi);
    const char* Kt = (const char*)(Kh + (long)t_lo * KVBLK * LDK); const char* Vt = (const char*)(Vh + (long)t_lo * KVBLK * LDV);
#define DMA(jj, slot) do { const char* kb_ = Kt + (size_t)(jj) * (KVBLK * LDK * 2); const char* vb_ = Vt + (size_t)(jj) * (KVBLK * LDV * 2); \
    glds16s(kb_, koff, (unsigned)__builtin_amdgcn_readfirstlane(kdst + (slot) * SHM_K)); \
    glds16s(vb_, voff[0], (unsigned)__builtin_amdgcn_readfirstlane(vdst + (slot) * SHM_V)); \
    glds16s(vb_, voff[1], (unsigned)__builtin_amdgcn_readfirstlane(vdst + (slot) * SHM_V + 8192)); } while (0)
#define TILE(jj) const int k0_ = (t_lo + (jj)) * KVBLK; const bool left_ = k0_ + 63 < qw0, right_ = k0_ > qw0 + 31, mixed_ = !(left_ || right_); \
    const float fd_ = fq0 - (float)k0_, st_ = left_ ? sl2 : (right_ ? -sl2 : 0.f), A_ = negM - st_ * fd_
    f32x16 pA0, pA1, pB0, pB1; bf16x8 pa0, pa1, pa2, pa3;
    asm volatile("s_waitcnt vmcnt(0)" ::: "memory");
#define SEG_A(PN0, PN1, PO0, PO1, jt, FIN) do { TILE(jt); SBAR(); qkt(PN0, PN1, K_lds + ((jt) & 3) * SHM_K, qr, r32, hi, A_, st_); if (FIN) finishSM(PO0, PO1, l_reg, pa0, pa1, pa2, pa3); SBAR(); } while (0)
#define SEG_B(P0, P1, jt, PV) do { if (PV) pv_d0(o, vb0 + (((jt) - 1) & 3) * SHM_V, pa0, pa1, pa2, pa3); { TILE(jt); partialSM(P0, P1, mixed_, fd_, sl2); } } while (0)
#define STEP_BAR(jt) do { WAITBAR(0); if ((jt) + 2 < n) DMA((jt) + 2, ((jt) + 2) & 3); } while (0)
    const bool lead = wid < 4;
    DMA(0, 0); DMA(1, 1);
    WAITBAR(3);
    SEG_A(pA0, pA1, pB0, pB1, 0, false); if (!lead) STEP_BAR(0); SEG_B(pA0, pA1, 0, false); if (lead) STEP_BAR(0);
    for (int j = 1; j + 1 < n; j += 2) {
        SEG_A(pB0, pB1, pA0, pA1, j, true); if (!lead) STEP_BAR(j); SEG_B(pB0, pB1, j, true); if (lead) STEP_BAR(j);
        SEG_A(pA0, pA1, pB0, pB1, j + 1, true); if (!lead) STEP_BAR(j + 1); SEG_B(pA0, pA1, j + 1, true); if (lead) STEP_BAR(j + 1);
    }
    SEG_A(pB0, pB1, pA0, pA1, n - 1, true); if (!lead) STEP_BAR(n - 1); SEG_B(pB0, pB1, n - 1, true); if (lead) STEP_BAR(n - 1);
    finishSM(pB0, pB1, l_reg, pa0, pa1, pa2, pa3); SBAR();
    pv_d0(o, vb0 + ((n - 1) & 3) * SHM_V, pa0, pa1, pa2, pa3);
    { auto rr = __builtin_amdgcn_permlane32_swap(__float_as_uint(l_reg), __float_as_uint(l_reg), false, false); l_reg = __uint_as_float(rr[0]) + __uint_as_float(rr[1]); }
    if (hi == 0) li_l[r32] = l_reg; asm volatile("s_waitcnt lgkmcnt(0)" ::: "memory");
    float rli[16];
#pragma unroll
    for (int r = 0; r < 16; ++r) rli[r] = __builtin_amdgcn_rcpf(li_l[crow(r, hi)]);
    bf16_t* Ow = Ob + (long)(wid * QBLK) * LDO;
#pragma unroll
    for (int r = 0; r < 16; ++r) { const int orow = crow(r, hi);
#pragma unroll
        for (int d0 = 0; d0 < 4; ++d0) Ow[(long)orow * LDO + d0 * 32 + r32] = (bf16_t)f2bf(o[d0][r] * rli[r]); }
    WAITBAR(0);
#undef DMA
#undef SEG_A
#undef SEG_B
#undef STEP_BAR
#undef TILE
}
#undef SBAR
}

namespace hy {
typedef f32x2 cf;
__device__ __forceinline__ cf lld(const LAS f32x2* L, int i) { return L[i]; }
__device__ __forceinline__ void lst(LAS f32x2* L, int i, cf v) { L[i] = v; }
__device__ __forceinline__ cf cmul(cf a, cf b) { return a * b.xx + a.yx * (b.yy * (cf){-1.f, 1.f}); }
__device__ __forceinline__ cf cmulc(cf a, cf b) { return a * b.xx + a.yx * (b.yy * (cf){1.f, -1.f}); }
__device__ constexpr float C32[16] = {1.0f, 0.98078528040323043f, 0.92387953251128674f, 0.83146961230254524f, 0.70710678118654757f, 0.55557023301960229f, 0.38268343236508984f, 0.19509032201612833f,
                                      0.0f, -0.19509032201612819f, -0.38268343236508973f, -0.55557023301960196f, -0.70710678118654746f, -0.83146961230254535f, -0.92387953251128674f, -0.98078528040323043f};
__device__ constexpr float S32[16] = {0.0f, 0.19509032201612825f, 0.38268343236508978f, 0.55557023301960218f, 0.70710678118654746f, 0.83146961230254524f, 0.92387953251128674f, 0.98078528040323043f,
                                      1.0f, 0.98078528040323043f, 0.92387953251128674f, 0.83146961230254546f, 0.70710678118654757f, 0.55557023301960218f, 0.38268343236508989f, 0.19509032201612861f};
__host__ __device__ constexpr int brev(int k, int bits) { int r = 0; for (int i = 0; i < bits; ++i) r |= ((k >> i) & 1) << (bits - 1 - i); return r; }
template <int R, bool INV> __device__ __forceinline__ void dft_reg(cf (&v)[R]) {
#pragma unroll
    for (int s = R / 2; s >= 1; s >>= 1) {
#pragma unroll
        for (int g0 = 0; g0 < R; g0 += 2 * s) {
#pragma unroll
            for (int j = 0; j < s; ++j) {
                const cf a = v[g0 + j], b = v[g0 + j + s];
                v[g0 + j] = a + b;
                const cf d = a - b;
                const int tw = j * (16 / s);
                if (tw == 0) v[g0 + j + s] = d;
                else if (tw == 8) v[g0 + j + s] = INV ? (cf){-d.y, d.x} : (cf){d.y, -d.x};
                else { const float c = C32[tw], sn = INV ? S32[tw] : -S32[tw]; v[g0 + j + s] = d * c + d.yx * (cf){-sn, sn}; }
            }
        }
    }
}
constexpr int RS = FFT_RS;
__device__ __forceinline__ void fft_fwd12(cf (&v)[32], LAS f32x2* L, int tid) {
    dft_reg<32, false>(v);
    { float s, c; sincospif((float)tid * (1.0f / 8192.0f), &s, &c); cf w1 = {c, -s}; asm volatile("" : "+v"(w1.x), "+v"(w1.y)); cf w = w1;
#pragma unroll
      for (int k1 = 0; k1 < 32; ++k1) { cf x = v[brev(k1, 5)]; if (k1) { x = cmul(x, w); w = cmul(w, w1); } lst(L, k1 * RS + tid, x); } }
    __syncthreads();
    const int k1 = tid >> 4, m2 = tid & 15;
#pragma unroll
    for (int m1 = 0; m1 < 32; ++m1) v[m1] = lld(L, k1 * RS + 16 * m1 + m2);
    __syncthreads();
    dft_reg<32, false>(v);
    { float s, c; sincospif((float)m2 * (1.0f / 256.0f), &s, &c); cf w1 = {c, -s}; asm volatile("" : "+v"(w1.x), "+v"(w1.y)); cf w = w1;
#pragma unroll
      for (int j1 = 0; j1 < 32; ++j1) { cf x = v[brev(j1, 5)]; if (j1) { x = cmul(x, w); w = cmul(w, w1); } lst(L, k1 * RS + 33 * m2 + j1, x); } }
    __syncthreads();
}
__device__ __forceinline__ void fft_inv21(cf (&v)[32], LAS f32x2* L, int tid) {
    const int k1 = tid >> 4, m2 = tid & 15;
    { float s, c; sincospif((float)m2 * (1.0f / 256.0f), &s, &c); cf w1 = {c, -s}; asm volatile("" : "+v"(w1.x), "+v"(w1.y)); cf w = w1;
#pragma unroll
      for (int j1 = 0; j1 < 32; ++j1) { cf x = lld(L, k1 * RS + 33 * m2 + j1); if (j1) { x = cmulc(x, w); w = cmul(w, w1); } v[j1] = x; } }
    __syncthreads();
    dft_reg<32, true>(v);
#pragma unroll
    for (int m1 = 0; m1 < 32; ++m1) lst(L, k1 * RS + 16 * m1 + m2, v[brev(m1, 5)]);
    __syncthreads();
    { float s, c; sincospif((float)tid * (1.0f / 8192.0f), &s, &c); cf w1 = {c, -s}; asm volatile("" : "+v"(w1.x), "+v"(w1.y)); cf w = w1;
#pragma unroll
      for (int kk = 0; kk < 32; ++kk) { cf x = lld(L, kk * RS + tid); if (kk) { x = cmulc(x, w); w = cmul(w, w1); } v[kk] = x; } }
    dft_reg<32, true>(v);
}
}
constexpr size_t MiB = 1u << 20;
constexpr size_t WS_CTL = 0, CTL_ZERO_BYTES = 1 * MiB;
constexpr size_t WS_W1T = 1 * MiB;
constexpr size_t WS_W2T = 257 * MiB;
constexpr size_t WS_WIN_EV = 385 * MiB, WS_WOUT_EV = 409 * MiB, WS_WIN_OD = 417 * MiB, WS_WOUT_OD = 433 * MiB, WS_WG_OD = 441 * MiB;
constexpr size_t AR = 445 * MiB;
constexpr size_t A_XB = AR + 0 * MiB, A_UHT = AR + 64 * MiB, A_QB = AR + 160 * MiB, A_KB = AR + 192 * MiB, A_VB = AR + 224 * MiB, A_KTD = AR + 256 * MiB, A_KF = AR + 384 * MiB,
                 A_H3B = AR + 512 * MiB, A_W4T = AR + 514 * MiB, A_YHT = AR + 416 * MiB, A_OA = AR + 448 * MiB, A_YCAT = AR + 512 * MiB, A_XB2 = AR + 0 * MiB, A_R0 = AR + 64 * MiB, A_H1_0 = AR + 192 * MiB,
                 A_HB_0 = AR + 320 * MiB, A_HID_0 = AR + 384 * MiB, A_ROWL = AR + 424 * MiB, A_GATEW = AR + 428 * MiB, A_Y2_0 = AR + 0 * MiB, A_H2 = AR + 448 * MiB, A_HB2 = AR + 448 * MiB;
constexpr size_t A_GB = AR + 0 * MiB, A_XR = AR + 64 * MiB, A_XC = AR + 192 * MiB, A_LA = AR + 256 * MiB, A_BB = AR + 64 * MiB, A_CAR = AR + 384 * MiB, A_YG = AR + 192 * MiB, A_R1 = AR + 256 * MiB,
                 A_H1_1 = AR + 0 * MiB, A_HB8_1 = AR + 0 * MiB, A_XB8 = AR + 320 * MiB, WS_WIN_EV8 = AR + 544 * MiB, A_HB2_8 = AR + 512 * MiB, A_HB8_0 = AR + 192 * MiB, A_HB_1 = AR + 128 * MiB, A_HID_1 = AR + 192 * MiB, A_Y2_1 = AR + 256 * MiB;
constexpr size_t WS_END = AR + 576 * MiB;
constexpr int CW_BAR = 4096, CW_CNT = 16384, CW_NORM = 24576;
constexpr int LDS_MISC = 139264, LDS_BYTES = 147456;
constexpr int NPHASE = 21;
#ifndef FP8_P1
#define FP8_P1 1
#endif
#ifndef FP8_P1B
#define FP8_P1B 1
#endif
#ifndef FP8_P1C
#define FP8_P1C 0
#endif
#ifndef FP8_P16
#define FP8_P16 1
#endif
#ifndef FP8_P5
#define FP8_P5 1
#endif
#ifndef FP8_P10
#define FP8_P10 1
#endif
#ifndef MOE_FP8_LAYERS
#define MOE_FP8_LAYERS 2
#endif

struct Args { const float* in[37]; float* out; unsigned char* ws; int ph_lo, ph_hi; };
typedef const __attribute__((address_space(4))) Args& KArgs;

__device__ __forceinline__ void transpose_item(const float* W, int N, int k0, int n0, bf16_t* WT, int ldk, int drow0, LAS float* scr, int lane) {
#pragma unroll 8
    for (int i = 0; i < 32; ++i) { const int kk = 2 * i + (lane >> 5); scr[kk * 33 + (lane & 31)] = W[(size_t)(k0 + kk) * N + n0 + (lane & 31)]; }
    LDS_WAIT(); asm volatile("" ::: "memory");
    const int c = lane & 7;
#pragma unroll
    for (int j = 0; j < 4; ++j) { const int n = (lane >> 3) + 8 * j; const LAS float* s = scr + (8 * c) * 33 + n;
        u32x4 o; o.x = pk2(s[0 * 33], s[1 * 33]); o.y = pk2(s[2 * 33], s[3 * 33]); o.z = pk2(s[4 * 33], s[5 * 33]); o.w = pk2(s[6 * 33], s[7 * 33]);
        *(u32x4*)(WT + (size_t)(drow0 + n) * ldk + k0 + 8 * c) = o; }
    LDS_WAIT(); asm volatile("" ::: "memory");
}

__device__ __forceinline__ void transpose_item8(const float* W, int N, int k0, int n0, unsigned char* WT8, int ldk, int drow0, float scale, LAS float* scr, int lane) {
#pragma unroll 8
    for (int i = 0; i < 32; ++i) { const int kk = 2 * i + (lane >> 5); scr[kk * 33 + (lane & 31)] = W[(size_t)(k0 + kk) * N + n0 + (lane & 31)]; }
    LDS_WAIT(); asm volatile("" ::: "memory");
    const int c = lane & 7;
#pragma unroll
    for (int j = 0; j < 4; ++j) { const int n = (lane >> 3) + 8 * j; const LAS float* s = scr + (8 * c) * 33 + n;
        u32x2 o; o.x = pg8::pk4_fp8(s[0 * 33] * scale, s[1 * 33] * scale, s[2 * 33] * scale, s[3 * 33] * scale); o.y = pg8::pk4_fp8(s[4 * 33] * scale, s[5 * 33] * scale, s[6 * 33] * scale, s[7 * 33] * scale);
        *(u32x2*)(WT8 + (size_t)(drow0 + n) * ldk + k0 + 8 * c) = o; }
    LDS_WAIT(); asm volatile("" ::: "memory");
}
__device__ __forceinline__ void phase_prologue(KArgs a, LAS unsigned char* lds) {
    const int tid = opaque_tid(), lane = tid & 63, wave = tid >> 6, G = gridDim.x;
    const int gw = blockIdx.x * 8 + wave, NGW = G * 8;
    unsigned char* ws = a.ws;
    LAS float* scr = (LAS float*)(lds + wave * 16384);
    constexpr int I_EVIN = 32 * 192, I_SQ = 32 * 64, I_ODIN = 32 * 128, I_MOE_GU = 64 * 512, I_MOE_D = 64 * 512, I_RG = 16 * 32, I_W4 = 128;
    constexpr int O1 = I_EVIN, O2 = O1 + I_SQ, O3 = O2 + I_ODIN, O4 = O3 + I_SQ, O5 = O4 + I_MOE_GU, O6 = O5 + I_MOE_GU, O7 = O6 + I_MOE_D, O8 = O7 + I_RG, O9 = O8 + I_RG, O10 = O9 + I_W4;
    for (int it = gw; it < O10; it += NGW) {
        if (it < O1) { const int kb = it / 192, nb = it % 192;
            const bool f8 = (nb * 32 < 3072) ? (FP8_P1C != 0) : (FP8_P1B != 0);
            if (f8) transpose_item8(a.in[1], EV_IN, kb * 64, nb * 32, ws + WS_WIN_EV8, DM, nb * 32, pg8::FP8_SW, scr, lane);
            else transpose_item(a.in[1], EV_IN, kb * 64, nb * 32, (bf16_t*)(ws + WS_WIN_EV), DM, nb * 32, scr, lane); }
        else if (it < O2) { const int r = it - O1, kb = r / 64, nb = r % 64;
            if (FP8_P5) transpose_item8(a.in[18], DM, kb * 64, nb * 32, ws + WS_WOUT_EV, DM, nb * 32, pg8::FP8_SW, scr, lane);
            else transpose_item(a.in[18], DM, kb * 64, nb * 32, (bf16_t*)(ws + WS_WOUT_EV), DM, nb * 32, scr, lane); }
        else if (it < O3) { const int r = it - O2, kb = r / 128, nb = r % 128;
            if (FP8_P10) transpose_item8(a.in[19], 2 * DM, kb * 64, nb * 32, ws + WS_WIN_OD, DM, nb * 32, pg8::FP8_SW, scr, lane);
            else transpose_item(a.in[19], 2 * DM, kb * 64, nb * 32, (bf16_t*)(ws + WS_WIN_OD), DM, nb * 32, scr, lane); }
        else if (it < O4) { const int r = it - O3, kb = r / 64, nb = r % 64;
            if (FP8_P16) transpose_item8(a.in[27], DM, kb * 64, nb * 32, ws + WS_WOUT_OD, DM, nb * 32, pg8::FP8_SW, scr, lane);
            else transpose_item(a.in[27], DM, kb * 64, nb * 32, (bf16_t*)(ws + WS_WOUT_OD), DM, nb * 32, scr, lane); }
        else if (it < O6) { const bool up = it >= O5; const int r = it - (up ? O5 : O4), le = r / 512, q = r % 512, kb = q / 16, nb = q % 16, n0 = nb * 32;
            const int drow = (n0 >> 7) * 256 + (n0 & 127) + (up ? 128 : 0); const float* src = (up ? a.in[35] : a.in[34]) + (size_t)le * DM * DFF;
            if (le < 32 * (2 - MOE_FP8_LAYERS)) transpose_item(src, DFF, kb * 64, n0, (bf16_t*)(ws + WS_W1T) + (size_t)le * 1024 * DM, DM, drow, scr, lane);
            else transpose_item8(src, DFF, kb * 64, n0, ws + WS_W1T + (size_t)(le >> 5) * 32 * 1024 * DM * 2 + (size_t)(le & 31) * 1024 * DM, DM, drow, pg8::FP8_SW, scr, lane); }
        else if (it < O7) { const int r = it - O6, le = r / 512, q = r % 512, kb = q / 64, nb = q % 64; const float* src = a.in[36] + (size_t)le * DFF * DM;
            if (le < 32 * (2 - MOE_FP8_LAYERS)) transpose_item(src, DM, kb * 64, nb * 32, (bf16_t*)(ws + WS_W2T) + (size_t)le * DM * DFF, DFF, nb * 32, scr, lane);
            else transpose_item8(src, DM, kb * 64, nb * 32, ws + WS_W2T + (size_t)(le >> 5) * 32 * DM * DFF * 2 + (size_t)(le & 31) * DM * DFF, DFF, nb * 32, pg8::FP8_SW, scr, lane); }
        else if (it < O9) { const bool wx = it >= O8; const int r = it - (wx ? O8 : O7), dn = r / 32, q = r % 32, kb = q / 8, nb = q % 8, n0 = nb * 32, dir = dn / 8, n = dn % 8;
            transpose_item((wx ? a.in[24] : a.in[22]) + (size_t)dn * 65536, 256, kb * 64, n0, (bf16_t*)(ws + WS_WG_OD), 256, (n * 4 + dir * 2 + (n0 >> 7)) * 256 + (n0 & 127) + (wx ? 128 : 0), scr, lane); }
        else { const int nb = it - O9; transpose_item(a.in[11], 4096, 0, nb * 32, (bf16_t*)(ws + A_W4T), 128, nb * 32, scr, lane); }
    }
    { const int gt = blockIdx.x * 512 + tid, NT = G * 512;
      for (int i = gt; i < 4096 * 8; i += NT) { const int r = i >> 3, c = i & 7; *(u32x4*)((bf16_t*)(ws + A_W4T) + (size_t)r * 128 + 64 + c * 8) = (u32x4){0u, 0u, 0u, 0u}; }
      for (int i = gt; i < 8192 * 8; i += NT) { const int r = i >> 3, c = i & 7; *(u32x4*)((bf16_t*)(ws + A_H3B) + (size_t)r * 128 + 64 + c * 8) = (u32x4){0u, 0u, 0u, 0u}; }
      const f32x8* x8 = (const f32x8*)a.in[0]; u32x4* xb = (u32x4*)(ws + A_XB);
      u32x2* xb8 = (u32x2*)(ws + A_XB8);
      for (int i = gt; i < NTOK * DM / 8; i += NT) { const f32x8 v = x8[i]; u32x4 o; o.x = pk2(v[0], v[1]); o.y = pk2(v[2], v[3]); o.z = pk2(v[4], v[5]); o.w = pk2(v[6], v[7]); xb[i] = o;
          if (FP8_P1) { u32x2 q; q.x = pg8::pk4_fp8(v[0], v[1], v[2], v[3]); q.y = pg8::pk4_fp8(v[4], v[5], v[6], v[7]); xb8[i] = q; } } }
    { const float* w1 = a.in[4]; const float* b1 = a.in[5]; const float* w2 = a.in[6]; const float* b2 = a.in[7]; const float* w3 = a.in[8]; const float* b3 = a.in[9]; const float* fr = a.in[10];
      const float frq = fr[lane];
      for (int t = gw; t < SEQ; t += NGW) {
          float z;
          { const float tl = (float)t * (1.0f / 8191.0f);
            if (lane == 0) z = tl;
            else { const int j = (lane - 1) & 15; const float band = 1e-4f + (float)j * ((15.0f - 1e-4f) / 15.0f);
                   const float ang = (6.283185307179586f * (float)t * (1.0f / 8192.0f)) * band; float sn, cs; sincosf(ang, &sn, &cs); z = (lane <= 16) ? cs : -sn; } }
          float acc = b1[lane];
#pragma unroll
          for (int i = 0; i < 33; ++i) acc += __shfl(z, i) * w1[i * 64 + lane];
          float h = sinf(frq * acc);
          acc = b2[lane];
#pragma unroll 16
          for (int i = 0; i < 64; ++i) acc += __shfl(h, i) * w2[i * 64 + lane];
          h = sinf(frq * acc);
          acc = b3[lane];
#pragma unroll 16
          for (int i = 0; i < 64; ++i) acc += __shfl(h, i) * w3[i * 64 + lane];
          h = sinf(frq * acc);
          ((bf16_t*)(ws + A_H3B))[(size_t)t * 128 + lane] = (bf16_t)f2bf(h);
      } }
}

__device__ __forceinline__ void filter_unit(KArgs a, LAS unsigned char* lds, int u, int tid) {
    const int lane = tid & 63, wave = tid >> 6;
    LAS f32x2* L = (LAS f32x2*)lds; LAS float* red = (LAS float*)(lds + LDS_MISC + 1024);
    const bf16_t* KTD = (const bf16_t*)(a.ws + A_KTD); __half2* KF = (__half2*)(a.ws + A_KF);
    {
        int tl = tid; asm volatile("" : "+v"(tl));
        const bf16_t* rowF = KTD + (size_t)u * 8192; const bf16_t* rowB = KTD + (size_t)(2048 + u) * 8192;
        hy::cf v[32]; float ss = 0.f;
#pragma unroll
        for (int n1 = 0; n1 < 32; ++n1) { const int p = tl + 512 * n1; float val;
            if (n1 < 16) val = bf2f(rowF[p]); else if (p == 8192) val = 0.f; else val = bf2f(rowB[16384 - p]);
            v[n1] = (hy::cf){val, 0.f}; ss += val * val; }
        ss = wave_sum(ss); if (lane == 0) red[wave] = ss; __syncthreads();
        float tot = 0.f;
#pragma unroll
        for (int w = 0; w < 8; ++w) tot += red[w];
        const float scale = rsqrtf(tot), skp = a.in[12][u];
        hy::fft_fwd12(v, L, tl);
#pragma unroll
        for (int bf = 0; bf < 2; ++bf) { const int idx = bf * 512 + tl, k1 = idx >> 5, j1 = idx & 31; hy::cf w[16];
#pragma unroll
            for (int m2 = 0; m2 < 16; ++m2) w[m2] = hy::lld(L, k1 * hy::RS + 33 * m2 + j1);
            hy::dft_reg<16, false>(w);
#pragma unroll
            for (int j2 = 0; j2 < 16; ++j2) { const hy::cf x = w[hy::brev(j2, 4)]; KF[((size_t)((blockIdx.x * 2 + (u >> 10)) * 2 + bf) * 16 + j2) * 512 + tl] = __floats2half2_rn(x.x * scale + skp, x.y * scale); } }
        __syncthreads();
    }
}
__device__ __forceinline__ float hyconv(const bf16_t* row, int t, float w0, float w1, float w2, float bias) {
    const unsigned tm = (unsigned)(t > 0 ? t - 1 : 0), tp = (unsigned)(t < SEQ - 1 ? t + 1 : SEQ - 1);
    float xm = bf2f(row[tm]), x0 = bf2f(row[(unsigned)t]), xp = bf2f(row[tp]);
    xm = t > 0 ? xm : 0.f; xp = t < SEQ - 1 ? xp : 0.f;
    return w0 * xm + w1 * x0 + w2 * xp + bias;
}
__device__ __forceinline__ void phase_hyena_mixer(KArgs a, LAS unsigned char* lds) {
    const int tid = opaque_tid(), G = gridDim.x;
    LAS f32x2* L = (LAS f32x2*)lds;
    const bf16_t* UHT = (const bf16_t*)(a.ws + A_UHT); const __half2* KF = (const __half2*)(a.ws + A_KF); bf16_t* YHT = (bf16_t*)(a.ws + A_YHT);
    const float* cw = a.in[2]; const float* cb = a.in[3];
    for (int c = blockIdx.x; c < HY_CH; c += G) {
        filter_unit(a, lds, c, tid); filter_unit(a, lds, 1024 + c, tid);
        VM_WAIT();
        int tl = tid; asm volatile("" : "+v"(tl));
        hy::cf v[32];
        { const bf16_t* r0 = UHT + (size_t)c * NTOK; const float w0 = cw[c], w1 = cw[3072 + c], w2 = cw[6144 + c], bb = cb[c];
#pragma unroll
          for (int n1 = 0; n1 < 16; ++n1) { const int t = tl + 512 * n1; v[n1] = (hy::cf){hyconv(r0, t, w0, w1, w2, bb), hyconv(r0 + SEQ, t, w0, w1, w2, bb)}; if ((n1 & 3) == 3) asm volatile("" ::: "memory"); } }
#pragma unroll 1
        for (int o = 0; o < 2; ++o) {
#pragma unroll
            for (int n1 = 16; n1 < 32; ++n1) v[n1] = (hy::cf){0.f, 0.f};
            hy::fft_fwd12(v, L, tl);
#pragma unroll
            for (int bf = 0; bf < 2; ++bf) { const int idx = bf * 512 + tl, k1 = idx >> 5, j1 = idx & 31; hy::cf w[16];
#pragma unroll
                for (int m2 = 0; m2 < 16; ++m2) w[m2] = hy::lld(L, k1 * hy::RS + 33 * m2 + j1);
                hy::dft_reg<16, false>(w);
                asm volatile("" ::: "memory");
                hy::cf y[16];
#pragma unroll
                for (int j2 = 0; j2 < 16; ++j2) { const float2 kf = __half22float2(KF[((size_t)((blockIdx.x * 2 + o) * 2 + bf) * 16 + j2) * 512 + tl]);
                    y[j2] = hy::cmul(w[hy::brev(j2, 4)], (hy::cf){kf.x, kf.y}); }
                hy::dft_reg<16, true>(y);
#pragma unroll
                for (int m2 = 0; m2 < 16; ++m2) hy::lst(L, k1 * hy::RS + 33 * m2 + j1, y[hy::brev(m2, 4)]); }
            __syncthreads();
            hy::fft_inv21(v, L, tl);
            const int gch = (o + 1) * 1024 + c; const bf16_t* rg = UHT + (size_t)gch * NTOK;
            const float w0 = cw[gch], w1 = cw[3072 + gch], w2 = cw[6144 + gch], bb = cb[gch];
            hy::cf zn[16]; int tg = tl; asm volatile("" : "+v"(tg));
#pragma unroll
            for (int n1 = 0; n1 < 16; ++n1) { const int t = tg + 512 * n1; const hy::cf y = v[hy::brev(n1, 5)];
                const float g0 = hyconv(rg, t, w0, w1, w2, bb), g1 = hyconv(rg + SEQ, t, w0, w1, w2, bb);
                zn[n1] = y * (hy::cf){g0 * (1.0f / 16384.0f), g1 * (1.0f / 16384.0f)}; if ((n1 & 3) == 3) asm volatile("" ::: "memory"); }
#pragma unroll
            for (int n1 = 0; n1 < 16; ++n1) v[n1] = zn[n1];
        }
        bf16_t* yo = YHT + (size_t)c * NTOK;
#pragma unroll
        for (int n1 = 0; n1 < 16; ++n1) { const int t = tl + 512 * n1; yo[t] = (bf16_t)f2bf(v[n1].x); yo[SEQ + t] = (bf16_t)f2bf(v[n1].y); }
    }
    __syncthreads();
}
__device__ __forceinline__ void phase_qknorm(KArgs a, LAS unsigned char* lds) {
    const int tid = opaque_tid(), lane = tid & 63, wave = tid >> 6, gw = blockIdx.x * 8 + wave, NGW = gridDim.x * 8;
    LAS unsigned* red = (LAS unsigned*)(lds + LDS_MISC + 1536);
    unsigned* ctl = (unsigned*)(a.ws + WS_CTL);
    if (tid < 64) red[tid] = 0u;
    __syncthreads();
    for (int which = 0; which < 2; ++which) { const bf16_t* P = (const bf16_t*)(a.ws + (which ? A_KB : A_QB));
        for (int b = 0; b < 2; ++b) { float mx = 0.f;
            for (int row = gw; row < SEQ; row += NGW) { const bf16_t* p = P + ((size_t)b * SEQ + row) * 1024 + lane * 16;
                const u32x4 w0 = *(const u32x4*)p, w1 = *(const u32x4*)(p + 8); const unsigned ww[8] = {w0.x, w0.y, w0.z, w0.w, w1.x, w1.y, w1.z, w1.w};
                float ss = 0.f;
#pragma unroll
                for (int i = 0; i < 8; ++i) { const float x = bflo(ww[i]), y = bfhi(ww[i]); ss += x * x + y * y; }
                ss += __shfl_xor(ss, 1); ss += __shfl_xor(ss, 2); mx = fmaxf(mx, ss); }
            if ((lane & 3) == 0) atomicMax((unsigned*)&red[which * 32 + b * 16 + (lane >> 2)], __float_as_uint(mx)); } }
    __syncthreads();
    if (tid < 64) atomicMax(ctl + CW_NORM + tid, red[tid]);
}
__device__ __forceinline__ void phase_attention(KArgs a, LAS unsigned char* lds) {
    const int G = gridDim.x, bx = blockIdx.x;
    const bf16_t* QB = (const bf16_t*)(a.ws + A_QB); const bf16_t* KB = (const bf16_t*)(a.ws + A_KB); const bf16_t* VB = (const bf16_t*)(a.ws + A_VB); bf16_t* OA = (bf16_t*)(a.ws + A_OA);
    const unsigned* nrm = (const unsigned*)(a.ws + WS_CTL) + CW_NORM;
    for (int i = 0;; ++i) {
        int bhc, qb;
        if (G == 256) { if (i >= 4) break;
            const int x = bx & 7, combo = x & 3, hh = (x < 4) ? ((i == 0) ? 7 : (i == 1) ? 5 : (i == 2) ? 1 : 0) : ((i == 0) ? 6 : (i == 1) ? 4 : (i == 2) ? 3 : 2); bhc = (combo >> 1) * 16 + hh * 2 + (combo & 1); qb = bx >> 3; }
        else { const int Lu = i * G + bx; if (Lu >= 1024) break; bhc = Lu >> 5; qb = Lu & 31; }
        const int b = bhc >> 4, h = (bhc >> 1) & 7, cm = bhc & 1;
        const size_t rowq = (size_t)b * SEQ + (size_t)qb * 256;
        const float sl2 = exp2f(-(float)(h + 1)) * 1.4426950408889634f;
        const float qk = sqrtf(__uint_as_float(nrm[bhc]) * __uint_as_float(nrm[32 + bhc]));
        const float Wk = (2.0f * qk + 38.0f) / sl2, q0f = (float)(qb * 256);
        int t_lo = (int)fmaxf(floorf((q0f - Wk - 63.0f) * (1.0f / 64.0f)), 0.0f), t_hi = (int)fminf(ceilf((q0f + 255.0f + Wk) * (1.0f / 64.0f)), 127.0f);
        if (((t_hi - t_lo + 1) & 1) != 0) { if (t_hi < 127) ++t_hi; else --t_lo; }
        att::attn_unit(QB + rowq * 1024 + h * 128 + cm * 64, KB + (size_t)b * SEQ * 1024 + h * 128 + cm * 64, VB + (size_t)b * SEQ * 1024 + h * 128,
                       OA + (size_t)cm * NTOK * 1024 + rowq * 1024 + h * 128, qb * 256, t_lo, t_hi - t_lo + 1, sl2, (char*)lds);
    }
}
__device__ __forceinline__ void phase_concat(KArgs a, LAS unsigned char* lds) {
    const int tid = opaque_tid(), lane = tid & 63, wave = tid >> 6, G = gridDim.x;
    const bf16_t* YHT = (const bf16_t*)(a.ws + A_YHT); const bf16_t* OA0 = (const bf16_t*)(a.ws + A_OA); const bf16_t* OA1 = OA0 + (size_t)NTOK * 1024; bf16_t* YC = (bf16_t*)(a.ws + A_YCAT);
    LAS bf16_t* T = (LAS bf16_t*)lds;
    const float lambda_init = 0.2f;
    const float lam = __expf(wave_sum(a.in[13][lane] * a.in[14][lane])) - __expf(wave_sum(a.in[15][lane] * a.in[16][lane])) + lambda_init;
    float gl[16];
#pragma unroll
    for (int i = 0; i < 16; ++i) gl[i] = a.in[17][(lane & 7) * 16 + i] * (1.0f - lambda_init);
    for (int it = blockIdx.x; it < NTOK / 64; it += G) {
        const int tok0 = it * 64;
#pragma unroll 4
        for (int k = 0; k < 16; ++k) { const int idx = tid + 512 * k, c = idx >> 3, ch = idx & 7;
            const u32x4 w = *(const u32x4*)(YHT + (size_t)c * NTOK + tok0 + ch * 8);
            LAS bf16_t* d = T + (ch * 8) * 1026 + c;
            d[0 * 1026] = (bf16_t)(w.x & 0xffff); d[1 * 1026] = (bf16_t)(w.x >> 16); d[2 * 1026] = (bf16_t)(w.y & 0xffff); d[3 * 1026] = (bf16_t)(w.y >> 16);
            d[4 * 1026] = (bf16_t)(w.z & 0xffff); d[5 * 1026] = (bf16_t)(w.z >> 16); d[6 * 1026] = (bf16_t)(w.w & 0xffff); d[7 * 1026] = (bf16_t)(w.w >> 16); }
        __syncthreads();
#pragma unroll 4
        for (int k = 0; k < 16; ++k) { const int idx = tid + 512 * k, tl = idx >> 7, c8 = idx & 127;
            const LAS unsigned* s = (const LAS unsigned*)(T + tl * 1026 + c8 * 8);
            u32x4 w; w.x = s[0]; w.y = s[1]; w.z = s[2]; w.w = s[3];
            if (FP8_P5) { u32x2 q; q.x = pg8::pk4_fp8(bflo(w.x), bfhi(w.x), bflo(w.y), bfhi(w.y)); q.y = pg8::pk4_fp8(bflo(w.z), bfhi(w.z), bflo(w.w), bfhi(w.w)); *(u32x2*)((unsigned char*)YC + (size_t)(tok0 + tl) * DM + c8 * 8) = q; }
            else *(u32x4*)(YC + (size_t)(tok0 + tl) * DM + c8 * 8) = w; }
        for (int rr = 0; rr < 8; ++rr) { const size_t tok = (size_t)tok0 + wave * 8 + rr;
            const u32x4 p0 = *(const u32x4*)(OA0 + tok * 1024 + lane * 16), p1 = *(const u32x4*)(OA0 + tok * 1024 + lane * 16 + 8);
            const u32x4 q0 = *(const u32x4*)(OA1 + tok * 1024 + lane * 16), q1 = *(const u32x4*)(OA1 + tok * 1024 + lane * 16 + 8);
            const unsigned pw[8] = {p0.x, p0.y, p0.z, p0.w, p1.x, p1.y, p1.z, p1.w}, qw[8] = {q0.x, q0.y, q0.z, q0.w, q1.x, q1.y, q1.z, q1.w};
            float o[16]; float ss = 0.f;
#pragma unroll
            for (int i = 0; i < 8; ++i) { o[2 * i] = bflo(pw[i]) - lam * bflo(qw[i]); o[2 * i + 1] = bfhi(pw[i]) - lam * bfhi(qw[i]); ss += o[2 * i] * o[2 * i] + o[2 * i + 1] * o[2 * i + 1]; }
            ss += __shfl_xor(ss, 1); ss += __shfl_xor(ss, 2); ss += __shfl_xor(ss, 4);
            const float rs = rsqrtf(ss * (1.0f / 128.0f) + LN_EPS);
            u32x4 w0, w1;
            w0.x = pk2(o[0] * rs * gl[0], o[1] * rs * gl[1]); w0.y = pk2(o[2] * rs * gl[2], o[3] * rs * gl[3]); w0.z = pk2(o[4] * rs * gl[4], o[5] * rs * gl[5]); w0.w = pk2(o[6] * rs * gl[6], o[7] * rs * gl[7]);
            w1.x = pk2(o[8] * rs * gl[8], o[9] * rs * gl[9]); w1.y = pk2(o[10] * rs * gl[10], o[11] * rs * gl[11]); w1.z = pk2(o[12] * rs * gl[12], o[13] * rs * gl[13]); w1.w = pk2(o[14] * rs * gl[14], o[15] * rs * gl[15]);
            if (FP8_P5) { u32x4 q; q.x = pg8::pk4_fp8(o[0] * rs * gl[0], o[1] * rs * gl[1], o[2] * rs * gl[2], o[3] * rs * gl[3]); q.y = pg8::pk4_fp8(o[4] * rs * gl[4], o[5] * rs * gl[5], o[6] * rs * gl[6], o[7] * rs * gl[7]);
                q.z = pg8::pk4_fp8(o[8] * rs * gl[8], o[9] * rs * gl[9], o[10] * rs * gl[10], o[11] * rs * gl[11]); q.w = pg8::pk4_fp8(o[12] * rs * gl[12], o[13] * rs * gl[13], o[14] * rs * gl[14], o[15] * rs * gl[15]);
                *(u32x4*)((unsigned char*)YC + tok * DM + 1024 + lane * 16) = q; }
            else { *(u32x4*)(YC + tok * DM + 1024 + lane * 16) = w0; *(u32x4*)(YC + tok * DM + 1024 + lane * 16 + 8) = w1; } }
        __syncthreads();
    }
}
__device__ __forceinline__ void ln_row(f32x4 (&v)[8], const float* g, const float* b, int lane, float& mu, float& rs) {
    float s = 0.f;
#pragma unroll
    for (int j = 0; j < 8; ++j) s += (v[j][0] + v[j][1]) + (v[j][2] + v[j][3]);
    const float mean = wave_sum(s) * (1.0f / DM); float s2 = 0.f;
#pragma unroll
    for (int j = 0; j < 8; ++j) { v[j] = v[j] - mean; s2 += (v[j][0] * v[j][0] + v[j][1] * v[j][1]) + (v[j][2] * v[j][2] + v[j][3] * v[j][3]); }
    const float rstd = rsqrtf(wave_sum(s2) * (1.0f / DM) + LN_EPS); mu = mean; rs = rstd;
#pragma unroll
    for (int j = 0; j < 8; ++j) { const f32x4 gg = *(const f32x4*)(g + 4 * (lane + 64 * j)), bb = *(const f32x4*)(b + 4 * (lane + 64 * j)); v[j] = v[j] * rstd * gg + bb; }
}
__device__ __forceinline__ void phase_ln_router(KArgs a, LAS unsigned char* lds, const bf16_t* R, const float* g, const float* b, bf16_t* HB, unsigned char* HB8, unsigned* cnt, int* rowlist, float* gatew) {
    const int tid = opaque_tid(), lane = tid & 63, wave = tid >> 6, G = gridDim.x;
    const float* rw = a.in[32]; const float* rb = a.in[33];
    LAS float* part = (LAS float*)lds;
    LAS int* hist = (LAS int*)(lds + 40960); LAS int* base = hist + 32; LAS float* stats = (LAS float*)(lds + 40960 + 512);
    for (int it = blockIdx.x; it < NTOK / 32; it += G) {
        const int tok0 = it * 32;
        for (int rr = 0; rr < 4; ++rr) { const size_t row = (size_t)tok0 + wave * 4 + rr; f32x4 v[8]; float mu, rs;
#pragma unroll
            for (int j = 0; j < 8; ++j) { const u32x2 w = *(const u32x2*)(R + row * DM + 4 * (lane + 64 * j)); v[j] = (f32x4){bflo(w.x), bfhi(w.x), bflo(w.y), bfhi(w.y)}; }
            ln_row(v, g, b, lane, mu, rs);
            if (lane == 0) { stats[(wave * 4 + rr) * 2] = mu; stats[(wave * 4 + rr) * 2 + 1] = rs; }
#pragma unroll
            for (int j = 0; j < 8; ++j) { u32x2 w; w.x = pk2(v[j][0], v[j][1]); w.y = pk2(v[j][2], v[j][3]); *(u32x2*)(HB + row * DM + 4 * (lane + 64 * j)) = w;
                if (HB8) *(unsigned*)(HB8 + row * DM + 4 * (lane + 64 * j)) = pg8::pk4_fp8(v[j][0], v[j][1], v[j][2], v[j][3]); } }
        if (tid < 32) hist[tid] = 0;
        __syncthreads();
        { const int i = lane & 31, kk = lane >> 5; f32x16 acc = {};
          const float mu = stats[i * 2], rs = stats[i * 2 + 1];
          const bf16_t* rrow = R + (size_t)(tok0 + i) * DM + wave * 256 + 4 * kk; const float* gp = g + wave * 256 + 4 * kk; const float* bp = b + wave * 256 + 4 * kk;
          const float* rwp = rw + (size_t)(wave * 256 + 4 * kk) * NEXP + i;
#pragma unroll 4
          for (int s = 0; s < 32; ++s) { const u32x2 rw2 = *(const u32x2*)(rrow + 8 * s); const f32x4 hv = ((f32x4){bflo(rw2.x), bfhi(rw2.x), bflo(rw2.y), bfhi(rw2.y)} - mu) * rs * *(const f32x4*)(gp + 8 * s) + *(const f32x4*)(bp + 8 * s);
#pragma unroll
              for (int j = 0; j < 4; ++j) acc = __builtin_amdgcn_mfma_f32_32x32x2f32(rwp[(size_t)(8 * s + j) * NEXP], hv[j], acc, 0, 0, 0); }
#pragma unroll
          for (int r = 0; r < 16; ++r) part[(wave * 32 + i) * 33 + (r & 3) + 8 * (r >> 2) + 4 * kk] = acc[r]; }
        __syncthreads();
        int e1 = 0, e2 = 0, r1 = 0, r2 = 0; float g1 = 0.f, g2 = 0.f;
        if (tid < 32) {
            float bestg = -1e30f;
#pragma unroll
            for (int gi = 0; gi < 4; ++gi) { float m1 = -1e30f, m2 = -1e30f, s1 = 0.f, s2 = 0.f; int i1 = 0, i2 = 0;
#pragma unroll
                for (int j = 0; j < 8; ++j) { const int e = gi * 8 + j; float lg = 0.f;
#pragma unroll
                    for (int w = 0; w < 8; ++w) lg += part[(w * 32 + tid) * 33 + e];
                    const float sg = 1.0f / (1.0f + expf(-lg)), sl = sg + rb[e];
                    if (sl > m1) { m2 = m1; i2 = i1; s2 = s1; m1 = sl; i1 = j; s1 = sg; } else if (sl > m2) { m2 = sl; i2 = j; s2 = sg; } }
                const float gs = m1 + m2;
                if (gs > bestg) { bestg = gs; e1 = gi * 8 + i1; e2 = gi * 8 + i2; g1 = s1; g2 = s2; } }
            const float inv = 1.0f / (g1 + g2); g1 *= inv; g2 *= inv;
            r1 = atomicAdd((int*)&hist[e1], 1); r2 = atomicAdd((int*)&hist[e2], 1);
        }
        __syncthreads();
        if (tid < 32) { const int hc = hist[tid]; base[tid] = hc ? (int)__hip_atomic_fetch_add(cnt + tid * 64, (unsigned)hc, __ATOMIC_RELAXED, __HIP_MEMORY_SCOPE_AGENT) : 0; }
        __syncthreads();
        if (tid < 32) { const int a0 = (tok0 + tid) * 2;
            rowlist[(size_t)e1 * ECAP + base[e1] + r1] = a0; gatew[a0] = g1;
            rowlist[(size_t)e2 * ECAP + base[e2] + r2] = a0 + 1; gatew[a0 + 1] = g2; }
        __syncthreads();
    }
}
__device__ __forceinline__ void phase_ln2(const bf16_t* HB, const bf16_t* Y2, const float* g, const float* b, float* OUT, bf16_t* OB, unsigned char* OB8) {
    const int tid = opaque_tid(), lane = tid & 63, wave = tid >> 6;
    for (int row = blockIdx.x * 8 + wave; row < NTOK; row += gridDim.x * 8) { f32x4 v[8]; float mu, rs;
#pragma unroll
        for (int j = 0; j < 8; ++j) { const int c = 4 * (lane + 64 * j); const u32x2 h = *(const u32x2*)(HB + (size_t)row * DM + c);
            const u32x2 y0 = *(const u32x2*)(Y2 + (size_t)(2 * row) * DM + c), y1 = *(const u32x2*)(Y2 + (size_t)(2 * row + 1) * DM + c);
            v[j] = (f32x4){bflo(h.x), bfhi(h.x), bflo(h.y), bfhi(h.y)} * DN_ALPHA + (f32x4){bflo(y0.x) + bflo(y1.x), bfhi(y0.x) + bfhi(y1.x), bflo(y0.y) + bflo(y1.y), bfhi(y0.y) + bfhi(y1.y)}; }
        ln_row(v, g, b, lane, mu, rs);
#pragma unroll
        for (int j = 0; j < 8; ++j) { const int c = 4 * (lane + 64 * j); if (OUT) *(f32x4*)(OUT + (size_t)row * DM + c) = v[j];
            if (OB) { u32x2 w; w.x = pk2(v[j][0], v[j][1]); w.y = pk2(v[j][2], v[j][3]); *(u32x2*)(OB + (size_t)row * DM + c) = w; }
            if (OB8) *(unsigned*)(OB8 + (size_t)row * DM + c) = pg8::pk4_fp8(v[j][0], v[j][1], v[j][2], v[j][3]); }
    }
}
__device__ __forceinline__ void moe_table(LAS int* tab, const unsigned* cnt) {
    __syncthreads();
    const int tid = opaque_tid();
    if (tid < 32) tab[64 + tid] = (int)cnt[tid * 64];
    __syncthreads();
    if (tid == 0) { int acc = 0; for (int e = 0; e < 32; ++e) { tab[e] = acc; acc += (tab[64 + e] + 255) >> 8; } tab[32] = acc; }
    __syncthreads();
}
__device__ __forceinline__ void phase_conv4(KArgs a) {
    const bf16_t* XR = (const bf16_t*)(a.ws + A_XR); bf16_t* XC = (bf16_t*)(a.ws + A_XC); const float* cw = a.in[20]; const float* cb = a.in[21];
    const int NT = gridDim.x * 512;
    for (int it = blockIdx.x * 512 + opaque_tid(); it < NTOK * 256; it += NT) { const int tok = it >> 8, ch = (it & 255) * 8, t = tok & (SEQ - 1);
        float acc[8];
#pragma unroll
        for (int i = 0; i < 8; ++i) acc[i] = cb[ch + i];
#pragma unroll
        for (int j = 0; j < 4; ++j) { const int tt = t + j - 2;
            if (tt >= 0 && tt < SEQ) { const u32x4 w = *(const u32x4*)(XR + (size_t)(tok + j - 2) * DM + ch); const unsigned ww[4] = {w.x, w.y, w.z, w.w};
#pragma unroll
                for (int i = 0; i < 4; ++i) { acc[2 * i] += cw[j * DM + ch + 2 * i] * bflo(ww[i]); acc[2 * i + 1] += cw[j * DM + ch + 2 * i + 1] * bfhi(ww[i]); } } }
        u32x4 o; o.x = pk2(acc[0], acc[1]); o.y = pk2(acc[2], acc[3]); o.z = pk2(acc[4], acc[5]); o.w = pk2(acc[6], acc[7]);
        *(u32x4*)(XC + (size_t)tok * DM + ch) = o; }
}
constexpr size_t CAR_ELEMS = (size_t)2 * 2 * 256 * DM;
__device__ __forceinline__ void phase_scan1(KArgs a) {
    const bf16_t* LA = (const bf16_t*)(a.ws + A_LA); const bf16_t* BB = (const bf16_t*)(a.ws + A_BB); float* CARA = (float*)(a.ws + A_CAR); float* CARB = CARA + CAR_ELEMS;
    const int NT = gridDim.x * 512;
    for (int it = blockIdx.x * 512 + opaque_tid(); it < 2 * 2 * 256 * 512; it += NT) { const int ch = (it & 511) * 4, chunk = (it >> 9) & 255, dir = (it >> 17) & 1, b = it >> 18;
        float h[4] = {0.f, 0.f, 0.f, 0.f}, ls[4] = {0.f, 0.f, 0.f, 0.f};
#pragma unroll 8
        for (int s = 0; s < 32; ++s) { const int t = chunk * 32 + (dir ? 31 - s : s); const size_t off = ((size_t)dir * NTOK + (size_t)b * SEQ + t) * DM + ch;
            const u32x2 lw = *(const u32x2*)(LA + off), bw = *(const u32x2*)(BB + off);
            const float l4[4] = {bflo(lw.x), bfhi(lw.x), bflo(lw.y), bfhi(lw.y)}, b4[4] = {bflo(bw.x), bfhi(bw.x), bflo(bw.y), bfhi(bw.y)};
#pragma unroll
            for (int i = 0; i < 4; ++i) { h[i] = __expf(l4[i]) * h[i] + b4[i]; ls[i] += l4[i]; } }
        const size_t co = (((size_t)b * 2 + dir) * 256 + chunk) * DM + ch;
        *(f32x4*)(CARA + co) = (f32x4){ls[0], ls[1], ls[2], ls[3]}; *(f32x4*)(CARB + co) = (f32x4){h[0], h[1], h[2], h[3]}; }
}
__device__ __forceinline__ void phase_scan2(KArgs a, LAS unsigned char* lds) {
    float* CARA = (float*)(a.ws + A_CAR); float* CARB = CARA + CAR_ELEMS; float* CARIN = CARB + CAR_ELEMS;
    const int tid = opaque_tid(), grp = tid >> 5, chl = tid & 31;
    LAS float* sh = (LAS float*)lds;
    for (int it = blockIdx.x; it < 2 * 2 * 64; it += gridDim.x) { const int ch = (it & 63) * 32 + chl, dir = (it >> 6) & 1, b = it >> 7;
        float la[16], lb[16]; float A = 0.f, B = 0.f;
#pragma unroll
        for (int k = 0; k < 16; ++k) { const int q = grp * 16 + k, chunk = dir ? 255 - q : q; const size_t co = (((size_t)b * 2 + dir) * 256 + chunk) * DM + ch; la[k] = CARA[co]; lb[k] = CARB[co]; }
#pragma unroll
        for (int k = 0; k < 16; ++k) { B = __expf(la[k]) * B + lb[k]; A += la[k]; }
        sh[(grp * 32 + chl) * 2] = A; sh[(grp * 32 + chl) * 2 + 1] = B;
        __syncthreads();
        float h = 0.f;
        for (int g2 = 0; g2 < grp; ++g2) h = __expf(sh[(g2 * 32 + chl) * 2]) * h + sh[(g2 * 32 + chl) * 2 + 1];
#pragma unroll
        for (int k = 0; k < 16; ++k) { const int q = grp * 16 + k, chunk = dir ? 255 - q : q; const size_t co = (((size_t)b * 2 + dir) * 256 + chunk) * DM + ch; CARIN[co] = h; h = __expf(la[k]) * h + lb[k]; }
        __syncthreads();
    }
}
__device__ __forceinline__ float gelu_tanh(float x) { const float u = 0.7978845608028654f * (x + 0.044715f * x * x * x); const float th = 1.0f - 2.0f * __builtin_amdgcn_rcpf(1.0f + __builtin_amdgcn_exp2f(2.8853900817779268f * u)); return 0.5f * x * (1.0f + th); }
__device__ __forceinline__ void phase_scan3(KArgs a) {
    const bf16_t* LA = (const bf16_t*)(a.ws + A_LA); const bf16_t* BB = (const bf16_t*)(a.ws + A_BB); const bf16_t* GB = (const bf16_t*)(a.ws + A_GB); bf16_t* YG = (bf16_t*)(a.ws + A_YG);
    const float* CARIN = (const float*)(a.ws + A_CAR) + 2 * CAR_ELEMS;
    const int NT = gridDim.x * 512;
    for (int it = blockIdx.x * 512 + opaque_tid(); it < 2 * 256 * 512; it += NT) { const int ch = (it & 511) * 4, chunk = (it >> 9) & 255, b = it >> 17;
        float hf[32][4]; float h[4];
        { const f32x4 c = *(const f32x4*)(CARIN + (((size_t)b * 2 + 0) * 256 + chunk) * DM + ch); h[0] = c[0]; h[1] = c[1]; h[2] = c[2]; h[3] = c[3]; }
#pragma unroll
        for (int s = 0; s < 32; ++s) { const size_t off = ((size_t)b * SEQ + chunk * 32 + s) * DM + ch;
            const u32x2 lw = *(const u32x2*)(LA + off), bw = *(const u32x2*)(BB + off);
            const float l4[4] = {bflo(lw.x), bfhi(lw.x), bflo(lw.y), bfhi(lw.y)}, b4[4] = {bflo(bw.x), bfhi(bw.x), bflo(bw.y), bfhi(bw.y)};
#pragma unroll
            for (int i = 0; i < 4; ++i) { h[i] = __expf(l4[i]) * h[i] + b4[i]; hf[s][i] = h[i]; } }
        { const f32x4 c = *(const f32x4*)(CARIN + (((size_t)b * 2 + 1) * 256 + chunk) * DM + ch); h[0] = c[0]; h[1] = c[1]; h[2] = c[2]; h[3] = c[3]; }
#pragma unroll
        for (int s = 31; s >= 0; --s) { const size_t tokoff = ((size_t)b * SEQ + chunk * 32 + s) * DM + ch; const size_t off = (size_t)NTOK * DM + tokoff;
            const u32x2 lw = *(const u32x2*)(LA + off), bw = *(const u32x2*)(BB + off), gw = *(const u32x2*)(GB + tokoff);
            const float l4[4] = {bflo(lw.x), bfhi(lw.x), bflo(lw.y), bfhi(lw.y)}, b4[4] = {bflo(bw.x), bfhi(bw.x), bflo(bw.y), bfhi(bw.y)}, g4[4] = {bflo(gw.x), bfhi(gw.x), bflo(gw.y), bfhi(gw.y)};
            float y[4];
#pragma unroll
            for (int i = 0; i < 4; ++i) { h[i] = __expf(l4[i]) * h[i] + b4[i]; y[i] = gelu_tanh(g4[i]) * (hf[s][i] + h[i]); }
            if (FP8_P16) { *(unsigned*)((unsigned char*)YG + tokoff) = pg8::pk4_fp8(4.0f * y[0], 4.0f * y[1], 4.0f * y[2], 4.0f * y[3]); }
            else { u32x2 w; w.x = pk2(y[0], y[1]); w.y = pk2(y[2], y[3]); *(u32x2*)(YG + tokoff) = w; } } }
}

#define KARGS() (*(const __attribute__((address_space(4))) Args*)__builtin_amdgcn_kernarg_segment_ptr())
#define PHASE_FN __device__ __forceinline__ void
#define PH_PRE() KArgs a = KARGS(); LAS unsigned char* lds = (LAS unsigned char*)lds_raw; unsigned char* ws = a.ws; asm volatile("" : "+s"(ws)); const int G = gridDim.x, bx = blockIdx.x; (void)lds; (void)ws; (void)G; (void)bx; using namespace pg8
PHASE_FN ph0() { PH_PRE(); phase_prologue(a, lds); }
PHASE_FN ph1a() { PH_PRE(); Gemm g{(const bf16_t*)(ws + A_W4T), (const bf16_t*)(ws + A_H3B), 128, 128, 128}; StaticOrder S; S.init(4096, 8192, G, bx); EpiFilt E{(bf16_t*)(ws + A_KTD)}; gemm_phase(lds, g, S, E); }
PHASE_FN ph1b() { PH_PRE(); StaticOrder S; S.init(NTOK, 3072, G, bx);
    if constexpr (FP8_P1B) { Gemm g{(const bf16_t*)(ws + A_XB8), (const bf16_t*)(ws + WS_WIN_EV8 + (size_t)3072 * DM), DM / 2, DM / 2, DM / 2};
        EpiBf16 E{(bf16_t*)(ws + A_QB), 1024, 1024, (size_t)(A_KB - A_QB) / 2, QSCALE, 1.0f / FP8_SW}; gemm_phase<EpiBf16, StaticOrder, true>(lds, g, S, E); }
    else { Gemm g{(const bf16_t*)(ws + A_XB), (const bf16_t*)(ws + WS_WIN_EV) + (size_t)3072 * DM, DM, DM, DM};
        EpiBf16 E{(bf16_t*)(ws + A_QB), 1024, 1024, (size_t)(A_KB - A_QB) / 2, QSCALE}; gemm_phase(lds, g, S, E); } }
PHASE_FN ph1c() { PH_PRE(); StaticOrder S; S.init(3072, NTOK, G, bx);
    if constexpr (FP8_P1C) { Gemm g{(const bf16_t*)(ws + WS_WIN_EV8), (const bf16_t*)(ws + A_XB8), DM / 2, DM / 2, DM / 2};
        EpiBf16 E{(bf16_t*)(ws + A_UHT), NTOK, 0, 0, 1.f, 1.0f / FP8_SW}; gemm_phase<EpiBf16, StaticOrder, true>(lds, g, S, E); }
    else { Gemm g{(const bf16_t*)(ws + WS_WIN_EV), (const bf16_t*)(ws + A_XB), DM, DM, DM};
        EpiBf16 E{(bf16_t*)(ws + A_UHT), NTOK, 0, 0, 1.f}; gemm_phase(lds, g, S, E); } }
PHASE_FN ph2() { PH_PRE(); phase_qknorm(a, lds); }
PHASE_FN ph3a() { PH_PRE(); phase_hyena_mixer(a, lds); }
PHASE_FN ph3b() { PH_PRE(); phase_attention(a, lds); }
PHASE_FN ph4() { PH_PRE(); phase_concat(a, lds); }
PHASE_FN ph5() { PH_PRE(); StaticOrder S; S.init(NTOK, DM, G, bx);
    if constexpr (FP8_P5) { Gemm g{(const bf16_t*)(ws + A_YCAT), (const bf16_t*)(ws + WS_WOUT_EV), DM / 2, DM / 2, DM / 2};
        EpiResBf E{(const bf16_t*)(ws + A_XB2), (bf16_t*)(ws + A_R0), DM, DN_ALPHA, 1.0f / FP8_SW}; gemm_phase<EpiResBf, StaticOrder, true>(lds, g, S, E); }
    else { Gemm g{(const bf16_t*)(ws + A_YCAT), (const bf16_t*)(ws + WS_WOUT_EV), DM, DM, DM};
        EpiResBf E{(const bf16_t*)(ws + A_XB2), (bf16_t*)(ws + A_R0), DM, DN_ALPHA}; gemm_phase(lds, g, S, E); } }
template <int LAYER> PHASE_FN ph_lnr() { PH_PRE(); unsigned* ctl = (unsigned*)(ws + WS_CTL);
    phase_ln_router(a, lds, (const bf16_t*)(ws + (LAYER ? A_R1 : A_R0)), a.in[28] + LAYER * DM, a.in[29] + LAYER * DM, (bf16_t*)(ws + (LAYER ? A_HB_1 : A_HB_0)), (LAYER >= 2 - MOE_FP8_LAYERS) ? ws + (LAYER ? A_HB8_1 : A_HB8_0) : nullptr,
                    ctl + CW_CNT + LAYER * 32 * 64, (int*)(ws + A_ROWL), (float*)(ws + A_GATEW)); }
template <int LAYER> PHASE_FN ph_moe1() { PH_PRE(); LAS int* tab = (LAS int*)(lds + LDS_MISC); moe_table(tab, (const unsigned*)(ws + WS_CTL) + CW_CNT + LAYER * 32 * 64);
    MoeOrder<4, true> S{G, bx, tab, (const int*)(ws + A_ROWL)};
    if constexpr (LAYER >= 2 - MOE_FP8_LAYERS) {
        Gemm g{(const bf16_t*)(ws + (LAYER ? A_HB8_1 : A_HB8_0)), (const bf16_t*)(ws + WS_W1T + (size_t)LAYER * 32 * 1024 * DM * 2), DM / 2, DM / 2, DM / 2};
        EpiSwiglu8 E{ws + (LAYER ? A_HID_1 : A_HID_0)}; gemm_phase<EpiSwiglu8, MoeOrder<4, true>, true>(lds, g, S, E);
    } else {
        Gemm g{(const bf16_t*)(ws + (LAYER ? A_HB_1 : A_HB_0)), (const bf16_t*)(ws + WS_W1T) + (size_t)LAYER * 32 * 1024 * DM, DM, DM, DM};
        EpiSwiglu E{(bf16_t*)(ws + (LAYER ? A_HID_1 : A_HID_0))}; gemm_phase(lds, g, S, E); } }
template <int LAYER> PHASE_FN ph_moe2() { PH_PRE(); LAS int* tab = (LAS int*)(lds + LDS_MISC); moe_table(tab, (const unsigned*)(ws + WS_CTL) + CW_CNT + LAYER * 32 * 64);
    MoeOrder<8, false> S{G, bx, tab, (const int*)(ws + A_ROWL)};
    if constexpr (LAYER >= 2 - MOE_FP8_LAYERS) {
        Gemm g{(const bf16_t*)(ws + (LAYER ? A_HID_1 : A_HID_0)), (const bf16_t*)(ws + WS_W2T + (size_t)LAYER * 32 * DM * DFF * 2), DFF / 2, DFF / 2, DFF / 2};
        EpiDown E{(bf16_t*)(ws + (LAYER ? A_Y2_1 : A_Y2_0)), (const int*)(ws + A_ROWL), (const float*)(ws + A_GATEW), 1.0f / (FP8_SW * FP8_SH)};
        gemm_phase<EpiDown, MoeOrder<8, false>, true>(lds, g, S, E);
    } else {
        Gemm g{(const bf16_t*)(ws + (LAYER ? A_HID_1 : A_HID_0)), (const bf16_t*)(ws + WS_W2T) + (size_t)LAYER * 32 * DM * DFF, DFF, DFF, DFF};
        EpiDown E{(bf16_t*)(ws + (LAYER ? A_Y2_1 : A_Y2_0)), (const int*)(ws + A_ROWL), (const float*)(ws + A_GATEW), 1.0f}; gemm_phase(lds, g, S, E); } }
template <int LAYER> PHASE_FN ph_ln2() { PH_PRE();
    phase_ln2((const bf16_t*)(ws + (LAYER ? A_HB_1 : A_HB_0)), (const bf16_t*)(ws + (LAYER ? A_Y2_1 : A_Y2_0)), a.in[30] + LAYER * DM, a.in[31] + LAYER * DM, LAYER ? a.out : nullptr, LAYER ? nullptr : (bf16_t*)(ws + A_HB2), (!LAYER && FP8_P10) ? ws + A_HB2_8 : nullptr); }
PHASE_FN ph10() { PH_PRE(); StaticOrder S; S.init(NTOK, 2 * DM, G, bx);
    if constexpr (FP8_P10) { Gemm g{(const bf16_t*)(ws + A_HB2_8), (const bf16_t*)(ws + WS_WIN_OD), DM / 2, DM / 2, DM / 2};
        EpiBf16 E{(bf16_t*)(ws + A_GB), DM, DM, (size_t)(A_XR - A_GB) / 2, 1.f, 1.0f / FP8_SW}; gemm_phase<EpiBf16, StaticOrder, true>(lds, g, S, E); }
    else { Gemm g{(const bf16_t*)(ws + A_HB2), (const bf16_t*)(ws + WS_WIN_OD), DM, DM, DM};
        EpiBf16 E{(bf16_t*)(ws + A_GB), DM, DM, (size_t)(A_XR - A_GB) / 2, 1.f}; gemm_phase(lds, g, S, E); } }
PHASE_FN ph11() { PH_PRE(); phase_conv4(a); }
PHASE_FN ph12() { PH_PRE(); Gemm g{(const bf16_t*)(ws + A_XC), (const bf16_t*)(ws + WS_WG_OD), DM, 256, 256}; RGOrder S{G, bx};
                  EpiRG E{(bf16_t*)(ws + A_LA), (bf16_t*)(ws + A_BB), (const bf16_t*)(ws + A_XC), a.in[23], a.in[25], a.in[26]}; gemm_phase(lds, g, S, E); }
PHASE_FN ph13() { PH_PRE(); phase_scan1(a); }
PHASE_FN ph14() { PH_PRE(); phase_scan2(a, lds); }
PHASE_FN ph15() { PH_PRE(); phase_scan3(a); }
PHASE_FN ph16() { PH_PRE(); StaticOrder S; S.init(NTOK, DM, G, bx);
    if constexpr (FP8_P16) { Gemm g{(const bf16_t*)(ws + A_YG), (const bf16_t*)(ws + WS_WOUT_OD), DM / 2, DM / 2, DM / 2};
        EpiResBf E{(const bf16_t*)(ws + A_HB2), (bf16_t*)(ws + A_R1), DM, DN_ALPHA, 1.0f / (FP8_SW * 4.0f)}; gemm_phase<EpiResBf, StaticOrder, true>(lds, g, S, E); }
    else { Gemm g{(const bf16_t*)(ws + A_YG), (const bf16_t*)(ws + WS_WOUT_OD), DM, DM, DM};
        EpiResBf E{(const bf16_t*)(ws + A_HB2), (bf16_t*)(ws + A_R1), DM, DN_ALPHA}; gemm_phase(lds, g, S, E); } }

__global__ void __launch_bounds__(512, 2) fwd(Args a) {
    LAS unsigned char* lds = (LAS unsigned char*)lds_raw;
    unsigned* ctl = (unsigned*)(a.ws + WS_CTL);
    volatile LAS unsigned* bst = (volatile LAS unsigned*)(lds + LDS_MISC + 2048);
    { const int tid = threadIdx.x;
      if ((tid & 63) == 0) ((LAS int*)(lds + LDS_WIDTAB))[hw_slot()] = tid >> 6;
      if (tid < 4) bst[tid] = 0u; }
    __syncthreads();
    const int lo = a.ph_lo, hi = a.ph_hi;
    XcdBarrier bar; bar.bar = ctl + CW_BAR; bar.x = 0; bar.st = bst;
    if (hi - lo > 1) bar = xcd_barrier_post(ctl + CW_BAR, bst);
#ifdef ONLY_PHASE
#define IN(k) ((k) == ONLY_PHASE && lo <= (k) && (k) < hi)
#else
#define IN(k) (lo <= (k) && (k) < hi)
#endif
#define SEAM(k) do { if (IN(k) && IN((k) + 1)) xcd_barrier(bar); } while (0)
    if (IN(0)) { asm volatile("; PHASE_MARK 0"); ph0(); } SEAM(0);
    if (IN(1)) { asm volatile("; PHASE_MARK 1a"); ph1a(); asm volatile("; PHASE_MARK 1b"); ph1b(); asm volatile("; PHASE_MARK 1c"); ph1c(); } SEAM(1);
    if (IN(2)) { asm volatile("; PHASE_MARK 2"); ph2(); } SEAM(2);
    if (IN(3)) { asm volatile("; PHASE_MARK 3a"); ph3a(); asm volatile("; PHASE_MARK 3b"); ph3b(); } SEAM(3);
    if (IN(4)) { asm volatile("; PHASE_MARK 4"); ph4(); } SEAM(4);
    if (IN(5)) { asm volatile("; PHASE_MARK 5"); ph5(); } SEAM(5);
    if (IN(6)) { asm volatile("; PHASE_MARK 6"); ph_lnr<0>(); } SEAM(6);
    if (IN(7)) { asm volatile("; PHASE_MARK 7"); ph_moe1<0>(); } SEAM(7);
    if (IN(8)) { asm volatile("; PHASE_MARK 8"); ph_moe2<0>(); } SEAM(8);
    if (IN(9)) { asm volatile("; PHASE_MARK 9"); ph_ln2<0>(); } SEAM(9);
    if (IN(10)) { asm volatile("; PHASE_MARK 10"); ph10(); } SEAM(10);
    if (IN(11)) { asm volatile("; PHASE_MARK 11"); ph11(); } SEAM(11);
    if (IN(12)) { asm volatile("; PHASE_MARK 12"); ph12(); } SEAM(12);
    if (IN(13)) { asm volatile("; PHASE_MARK 13"); ph13(); } SEAM(13);
    if (IN(14)) { asm volatile("; PHASE_MARK 14"); ph14(); } SEAM(14);
    if (IN(15)) { asm volatile("; PHASE_MARK 15"); ph15(); } SEAM(15);
    if (IN(16)) { asm volatile("; PHASE_MARK 16"); ph16(); } SEAM(16);
    if (IN(17)) { asm volatile("; PHASE_MARK 17"); ph_lnr<1>(); } SEAM(17);
    if (IN(18)) { asm volatile("; PHASE_MARK 18"); ph_moe1<1>(); } SEAM(18);
    if (IN(19)) { asm volatile("; PHASE_MARK 19"); ph_moe2<1>(); } SEAM(19);
    if (IN(20)) { asm volatile("; PHASE_MARK 20"); ph_ln2<1>(); }
#undef IN
#undef SEAM
}

#ifndef MK_PER_PHASE
#define MK_PER_PHASE 0
#endif
extern "C" void kernel_launch(void* const* d_in, const int* in_sizes, int n_in, void* d_out, int out_size, void* d_ws, size_t ws_size, hipStream_t stream) {
    static int grid = 0;
    if (grid == 0) {
        if (n_in != 37 || out_size != NTOK * DM || ws_size < WS_END) { fprintf(stderr, "kernel_launch: built for 37 inputs, %d outputs, >= %zu bytes of workspace; got n_in %d out %d ws %zu\n", NTOK * DM, (size_t)WS_END, n_in, out_size, ws_size); grid = -1; return; }
        int dev = 0, cus = 0, per_cu = 0;
        if (hipGetDevice(&dev) != hipSuccess || hipDeviceGetAttribute(&cus, hipDeviceAttributeMultiprocessorCount, dev) != hipSuccess) { grid = -1; return; }
        if (hipFuncSetAttribute((const void*)fwd, hipFuncAttributeMaxDynamicSharedMemorySize, LDS_BYTES) != hipSuccess) { fprintf(stderr, "kernel_launch: hipFuncSetAttribute failed\n"); grid = -1; return; }
        if (hipOccupancyMaxActiveBlocksPerMultiprocessor(&per_cu, (const void*)fwd, 512, LDS_BYTES) != hipSuccess || per_cu < 1) fprintf(stderr, "kernel_launch: occupancy query reports %d\n", per_cu);
        (void)hipGetLastError();
        grid = cus;
    }
    if (grid < 0) return;
    (void)hipMemsetAsync((char*)d_ws + WS_CTL, 0, CTL_ZERO_BYTES, stream);
    Args a{};
    for (int i = 0; i < 37; ++i) a.in[i] = (const float*)d_in[i];
    a.out = (float*)d_out; a.ws = (unsigned char*)d_ws;
#if MK_PER_PHASE
    for (int p = 0; p < NPHASE; ++p) { a.ph_lo = p; a.ph_hi = p + 1; hipLaunchKernelGGL(fwd, dim3(grid), dim3(512), LDS_BYTES, stream, a); }
#else
    a.ph_lo = 0; a.ph_hi = NPHASE; hipLaunchKernelGGL(fwd, dim3(grid), dim3(512), LDS_BYTES, stream, a);
#endif
}
```

```cpp
#include <hip/hip_runtime.h>
#include <hip/hip_fp16.h>
#include <cstdio>
#include <cstdint>

#define GAS __attribute__((address_space(1)))
#define LAS __attribute__((address_space(3)))
typedef unsigned short bf16_t;
typedef short bf16x8 __attribute__((ext_vector_type(8)));
typedef short s16x4 __attribute__((ext_vector_type(4)));
typedef float f32x2 __attribute__((ext_vector_type(2)));
typedef float f32x4 __attribute__((ext_vector_type(4)));
typedef float f32x8 __attribute__((ext_vector_type(8)));
typedef float f32x16 __attribute__((ext_vector_type(16)));
typedef unsigned u32x2 __attribute__((ext_vector_type(2)));
typedef unsigned u32x4 __attribute__((ext_vector_type(4)));
typedef GAS unsigned gu32;

constexpr int DM = 2048, BATCH = 2, SEQ = 8192, NTOK = BATCH * SEQ;
constexpr int HY_CH = 1024, EV_IN = 6144;
constexpr int NEXP = 32, DFF = 512, NASSIGN = NTOK * 2, ECAP = NASSIGN;
constexpr float LN_EPS = 1e-5f;
constexpr float DN_ALPHA = 1.4142135623730951f;
constexpr float QSCALE = 0.125f * 1.4426950408889634f;
constexpr int FFT_N = 16384, FFT_RS = 528;

__device__ __forceinline__ unsigned f2bf(float f) { unsigned u = __builtin_bit_cast(unsigned, f); return (u + 0x7fffu + ((u >> 16) & 1u)) >> 16; }
__device__ __forceinline__ unsigned pk2(float lo, float hi) { return f2bf(lo) | (f2bf(hi) << 16); }
__device__ __forceinline__ float bf2f(unsigned short h) { return __builtin_bit_cast(float, (unsigned)h << 16); }
__device__ __forceinline__ float bflo(unsigned w) { return __builtin_bit_cast(float, w << 16); }
__device__ __forceinline__ float bfhi(unsigned w) { return __builtin_bit_cast(float, w & 0xffff0000u); }
__device__ __forceinline__ unsigned cvt_pk_bf16(float lo, float hi) { unsigned r; asm volatile("v_cvt_pk_bf16_f32 %0, %1, %2" : "=v"(r) : "v"(lo), "v"(hi)); return r; }
__device__ __forceinline__ float wave_sum(float v) {
#pragma unroll
    for (int o = 1; o < 64; o <<= 1) v += __shfl_xor(v, o);
    return v;
}
__device__ __forceinline__ float sigmoidf_(float x) { return __builtin_amdgcn_rcpf(1.0f + __builtin_amdgcn_exp2f(-1.4426950408889634f * x)); }
constexpr int LDS_WIDTAB = 139264 + 3072;
__device__ __forceinline__ int hw_slot() { return (int)(__builtin_amdgcn_s_getreg((5 << 11) | 4) & 63u); }
__device__ __forceinline__ int lane_id() { return (int)__builtin_amdgcn_mbcnt_hi(~0u, __builtin_amdgcn_mbcnt_lo(~0u, 0u)); }
extern __shared__ __attribute__((aligned(16))) unsigned char lds_raw[];
__device__ __forceinline__ int wave_id() { return __builtin_amdgcn_readfirstlane(((const LAS int*)((LAS unsigned char*)lds_raw + LDS_WIDTAB))[hw_slot()]); }
__device__ __forceinline__ int opaque_tid() { int t = wave_id() * 64 + lane_id(); asm volatile("" : "+v"(t)); return t; }
#define LDS_WAIT() asm volatile("s_waitcnt lgkmcnt(0)" ::: "memory")
#define VM_WAIT() asm volatile("s_waitcnt vmcnt(0)" ::: "memory")

#define XB_TMO      128
#define XB_XCNT(j)  (256  + 64 * (j))
#define XB_XSUB(j)  (1280 + 64 * (j))
#define XB_XGEN(j)  (2304 + 64 * (j))
#define XB_TOP      3328
#define XB_TOPGEN   3392
#define XCD_BAR_WORDS 3456
#define XB_SPIN_CAP (1u << 18)
__device__ __forceinline__ unsigned xb_ld(unsigned* p)              { return __hip_atomic_load(p, __ATOMIC_RELAXED, __HIP_MEMORY_SCOPE_AGENT); }
__device__ __forceinline__ unsigned xb_add(unsigned* p, unsigned v) { return __hip_atomic_fetch_add(p, v, __ATOMIC_RELAXED, __HIP_MEMORY_SCOPE_AGENT); }
__device__ __forceinline__ unsigned xb_xcc_id() { return (unsigned)__builtin_amdgcn_s_getreg((3 << 11) | 20) & 0xFu; }
#define XB_SPIN(cond, bar) do { unsigned _sp = 0; while (cond) { __builtin_amdgcn_s_sleep(1); \
    if ((++_sp & 255u) == 0u) { if (xb_ld(&(bar)[XB_TMO])) break; if (_sp > XB_SPIN_CAP) { atomicAdd(&(bar)[XB_TMO], 1u); break; } } } } while (0)
struct XcdBarrier { unsigned* bar; unsigned x; volatile LAS unsigned* st; };
__device__ __forceinline__ XcdBarrier xcd_barrier_post(unsigned* bar, volatile LAS unsigned* st) {
    XcdBarrier b; b.bar = bar; b.x = xb_xcc_id(); b.st = st;
    if (opaque_tid() == 0) (void)xb_add(&bar[XB_XCNT(b.x)], 1u);
    return b;
}
__device__ __forceinline__ void xcd_barrier_complete(unsigned* bar, unsigned x, unsigned& nloc, unsigned& nx) {
    const unsigned G = gridDim.x * gridDim.y * gridDim.z;
    unsigned sum, cnt, mine, sp = 0u;
    for (;;) {
        sum = 0u; cnt = 0u; mine = 0u;
#pragma unroll
        for (unsigned j = 0; j < 16; ++j) { const unsigned c = xb_ld(&bar[XB_XCNT(j)]); sum += c; cnt += (c > 0u) ? 1u : 0u; mine = (j == x) ? c : mine; }
        if (sum == G) break;
        __builtin_amdgcn_s_sleep(1);
        if ((++sp & 255u) == 0u) { if (xb_ld(&bar[XB_TMO])) break; if (sp > XB_SPIN_CAP) { atomicAdd(&bar[XB_TMO], 1u); break; } }
    }
    nloc = mine > 0u ? mine : 1u; nx = cnt > 0u ? cnt : 1u;
}
__device__ __forceinline__ void xcd_barrier(const XcdBarrier& b) {
    asm volatile("s_waitcnt vmcnt(0)" ::: "memory");
    __syncthreads();
    if (opaque_tid() == 0) {
        unsigned* bar = b.bar;
        __builtin_amdgcn_s_waitcnt(0);
        unsigned nloc = b.st[0], nx = b.st[1];
        if (nloc == 0u) { xcd_barrier_complete(bar, b.x, nloc, nx); b.st[0] = nloc; b.st[1] = nx; }
        const unsigned old = xb_add(&bar[XB_XSUB(b.x)], 1u);
        const unsigned gen = old / nloc;
        if (old + 1u == (gen + 1u) * nloc) {
            __builtin_amdgcn_fence(__ATOMIC_RELEASE, "agent");
            asm volatile("s_waitcnt vmcnt(0)" ::: "memory");
            const unsigned og = xb_add(&bar[XB_TOP], 1u);
            const unsigned tg = og / nx;
            if (og + 1u == (tg + 1u) * nx) xb_add(&bar[XB_TOPGEN], 1u);
            else XB_SPIN(xb_ld(&bar[XB_TOPGEN]) == tg, bar);
            __builtin_amdgcn_fence(__ATOMIC_ACQUIRE, "agent");
            xb_add(&bar[XB_XGEN(b.x)], 1u);
            asm volatile("s_waitcnt vmcnt(0)" ::: "memory");
        } else {
            XB_SPIN(xb_ld(&bar[XB_XGEN(b.x)]) == gen, bar);
            __builtin_amdgcn_fence(__ATOMIC_ACQUIRE, "agent");
            asm volatile("s_waitcnt vmcnt(0)" ::: "memory");
        }
    }
    __syncthreads();
}

namespace pg8 {
constexpr int BM = 256, BK = 64, HALF = 128, HTB = HALF * BK * 2, STAGE_BYTES = 8 * HTB, NXCD = 8, WGM = 8;
__host__ __device__ __forceinline__ int lds_byte(int r, int c) { const int st = (r >> 4) * 2 + (c >> 5), rr = r & 15, cc = c & 31, ob = rr * 64 + cc * 2; return st * 1024 + (ob ^ (((ob >> 9) & 1) << 5)); }
__host__ __device__ __forceinline__ void stage_rc(int b, int& R, int& C) { const int st = b / 1024, sb = b % 1024, swz = sb ^ (((sb >> 9) & 1) << 5); R = (st >> 1) * 16 + swz / 64; C = (st & 1) * 32 + (swz % 64) / 2; }
__host__ __device__ __forceinline__ int perm32(int rho) { const int n = rho >> 4, i = rho & 15; return 8 * (i >> 2) + 4 * n + (i & 3); }

struct Unit { int pm, pn, e, t, cnt; };
struct Gemm { const bf16_t* A; const bf16_t* Bt; int lda, ldb, K; };

struct StaticOrder {
    static constexpr bool GATHER_A = false;
    int nM, nN, nwg, G, c;
    __device__ void init(int M, int N, int G_, int c_) { nM = M / BM; nN = N / BM; nwg = nM * nN; G = G_; c = c_; }
    __device__ __forceinline__ bool next(int i, Unit& u) const {
        const long L = (long)i * G + c; if (L >= nwg) return false;
        int wgid = (int)L; { const int q = nwg / NXCD, r = nwg % NXCD, xcd = wgid % NXCD, off = wgid / NXCD; wgid = (xcd < r ? xcd * (q + 1) : r * (q + 1) + (xcd - r) * q) + off; }
        const int nig = WGM * nN, gid = wgid / nig, fm = gid * WGM, gsz = (nM - fm) < WGM ? (nM - fm) : WGM;
        u.pm = fm + ((wgid % nig) % gsz); u.pn = (wgid % nig) / gsz; u.e = 0; u.t = 0; u.cnt = 0; return true;
    }
    __device__ __forceinline__ int rowA(const Unit& u, int r) const { return u.pm * BM + r; }
    __device__ __forceinline__ int colA(const Unit&) const { return 0; }
    __device__ __forceinline__ int rowB(const Unit& u, int r) const { return u.pn * BM + r; }
};

typedef int v8i32 __attribute__((ext_vector_type(8)));
template <class Epi, class Sched, bool FP8 = false>
__device__ __forceinline__ void gemm_phase(LAS unsigned char* lds, const Gemm g, const Sched& S, const Epi& E) {
    const int tid = opaque_tid(), wid = __builtin_amdgcn_readfirstlane(tid >> 6), lane = tid & 63, wr = wid >> 2, wc = wid & 3, fr = lane & 15, fq = lane >> 4;
    const int K = g.K, nt = K / BK;
    constexpr bool GA = Sched::GATHER_A;
    int sR[2], sC[2];
    unsigned laneA[2], laneB[2];
#pragma unroll
    for (int i = 0; i < 2; ++i) { int R, C; stage_rc(tid * 16 + i * 8192, R, C); sR[i] = R; sC[i] = C; const int Rb = Epi::PERM ? ((R & ~31) + perm32(R & 31)) : R;
        laneA[i] = (unsigned)(R * g.lda + C) * 2u; laneB[i] = (unsigned)(Rb * g.ldb + C) * 2u; }
    const size_t hstepA = (size_t)HALF * g.lda * 2, hstepB = (size_t)HALF * g.ldb * 2;
    const unsigned ldsw = (unsigned)wid * 1024u;
    const int aoff = lds_byte(wr * 64 + fr, fq * 8), boff = lds_byte(wc * 32 + fr, fq * 8);
    const char* gA = (const char*)g.A; const char* gB = (const char*)g.Bt;
#define PG8_SA(b, h) (((b) * 2 + (h)) * HTB)
#define PG8_SB(b, h) ((4 + (b) * 2 + (h)) * HTB)
#define PG8_STAGE(bufoff, gptr, voff) do { _Pragma("unroll") for (int _i = 0; _i < 2; ++_i) \
        __builtin_amdgcn_global_load_lds((const unsigned*)((gptr) + (size_t)(voff)[_i]), (LAS unsigned*)(lds + (bufoff) + ldsw + _i * 8192), 16, 0, 0); } while (0)
#define PG8_STAGE_B(bufoff, ub, h, kb) PG8_STAGE(bufoff, gB + (ub) + (size_t)(h) * hstepB + (size_t)(kb), laneB)
#define PG8_STAGE_A(bufoff, ub, va, h, kb) do { if constexpr (GA) { PG8_STAGE(bufoff, gA + (size_t)(kb), va[h]); } else { PG8_STAGE(bufoff, gA + (ub) + (size_t)(h) * hstepA + (size_t)(kb), laneA); } } while (0)
#define PG8_RD(off) (*(const LAS u32x4*)(lds + (off)))
#define PG8_CAT2(x, y) __builtin_bit_cast(v8i32, __builtin_shufflevector((x), (y), 0, 1, 2, 3, 4, 5, 6, 7))
#define PG8_LDA(dst, b, h) do { if constexpr (FP8) { _Pragma("unroll") for (int m = 0; m < 4; ++m) dst##8[m] = PG8_CAT2(PG8_RD(PG8_SA(b, h) + aoff + m * 2048), PG8_RD(PG8_SA(b, h) + aoff + m * 2048 + 1024)); } \
        else { _Pragma("unroll") for (int m = 0; m < 4; ++m) _Pragma("unroll") for (int k = 0; k < 2; ++k) dst[m][k] = *(const LAS bf16x8*)(lds + PG8_SA(b, h) + aoff + m * 2048 + k * 1024); } } while (0)
#define PG8_LDB(dst, b, h) do { if constexpr (FP8) { _Pragma("unroll") for (int n = 0; n < 2; ++n) dst##8[n] = PG8_CAT2(PG8_RD(PG8_SB(b, h) + boff + n * 2048), PG8_RD(PG8_SB(b, h) + boff + n * 2048 + 1024)); } \
        else { _Pragma("unroll") for (int n = 0; n < 2; ++n) _Pragma("unroll") for (int k = 0; k < 2; ++k) dst[n][k] = *(const LAS bf16x8*)(lds + PG8_SB(b, h) + boff + n * 2048 + k * 1024); } } while (0)
#define PG8_MMA(ai, bj, At, Bt) do { __builtin_amdgcn_s_setprio(1); _Pragma("unroll") for (int m = 0; m < 4; ++m) _Pragma("unroll") for (int n = 0; n < 2; ++n) { \
        if constexpr (FP8) { asm volatile("v_mfma_scale_f32_16x16x128_f8f6f4 %0, %1, %2, %0, %3, %3 op_sel_hi:[0,0,0]" : "+v"(acc[ai][bj][m][n]) : "v"(Bt##8[n]), "v"(At##8[m]), "v"(fp8_one)); } \
        else { _Pragma("unroll") for (int k = 0; k < 2; ++k) acc[ai][bj][m][n] = __builtin_amdgcn_mfma_f32_16x16x32_bf16(Bt[n][k], At[m][k], acc[ai][bj][m][n], 0, 0, 0); } } \
        __builtin_amdgcn_s_setprio(0); } while (0)
#define PG8_WAIT_V(n) asm volatile("s_waitcnt vmcnt(" #n ")" ::: "memory")
#define PG8_WAIT_L(n) asm volatile("s_waitcnt lgkmcnt(" #n ")" ::: "memory")
#define PG8_BAR __builtin_amdgcn_s_barrier()
#define PG8_SCHED __builtin_amdgcn_sched_barrier(0)
#define PG8_SCHED8 do { if constexpr (FP8) __builtin_amdgcn_sched_barrier(0); } while (0)
#define PG8_OFFS(u, ubA, ubB, vA) do { ubB = ((size_t)S.rowB(u, 0) * (size_t)g.ldb) * 2; \
        if constexpr (GA) { ubA = 0; _Pragma("unroll") for (int _h = 0; _h < 2; ++_h) _Pragma("unroll") for (int _i = 0; _i < 2; ++_i) vA[_h][_i] = ((unsigned)S.rowA(u, _h * HALF + sR[_i]) * (unsigned)g.lda + (unsigned)sC[_i]) * 2u; } \
        else { ubA = ((size_t)S.rowA(u, 0) * (size_t)g.lda + (size_t)S.colA(u)) * 2; } } while (0)
    Unit cur, nxt; int ui = 0;
    if (!S.next(0, cur)) return;
    f32x4 acc[2][2][4][2];
#pragma unroll
    for (int a = 0; a < 2; ++a)
#pragma unroll
        for (int b = 0; b < 2; ++b)
#pragma unroll
            for (int m = 0; m < 4; ++m)
#pragma unroll
                for (int n = 0; n < 2; ++n) acc[a][b][m][n] = (f32x4){0.f, 0.f, 0.f, 0.f};
    const int fp8_one = 0x7f7f7f7f;
    bf16x8 At[4][2], B0[2][2], B1[2][2]; v8i32 At8[4], B08[2], B18[2];
    size_t ubAc, ubBc, ubAn, ubBn; unsigned vAc[2][2] = {}, vAn[2][2] = {};
    PG8_OFFS(cur, ubAc, ubBc, vAc);
    PG8_STAGE_B(PG8_SB(0, 0), ubBc, 0, 0); PG8_STAGE_B(PG8_SB(0, 1), ubBc, 1, 0); PG8_STAGE_A(PG8_SA(0, 0), ubAc, vAc, 0, 0); PG8_STAGE_A(PG8_SA(0, 1), ubAc, vAc, 1, 0);
    if (wr == 1) PG8_BAR;
    PG8_WAIT_V(2); PG8_BAR;
    PG8_STAGE_B(PG8_SB(1, 0), ubBc, 0, 128); PG8_STAGE_A(PG8_SA(1, 0), ubAc, vAc, 0, 128); PG8_STAGE_B(PG8_SB(1, 1), ubBc, 1, 128);
    PG8_WAIT_V(6); PG8_BAR;
    for (;;) {
        const bool has_next = S.next(ui + 1, nxt);
        if (has_next) { PG8_OFFS(nxt, ubAn, ubBn, vAn); }
        else { ubAn = ubAc; ubBn = ubBc;
#pragma unroll
            for (int h = 0; h < 2; ++h)
#pragma unroll
                for (int i = 0; i < 2; ++i) vAn[h][i] = vAc[h][i]; }
        for (int t = 0; t < nt; t += 2) {
            const bool last = (t == nt - 2);
            const unsigned k1 = (unsigned)(t + 1) * 128u, k2 = last ? 0u : (unsigned)(t + 2) * 128u, k3 = k2 + 128u;
            const size_t xubA = last ? ubAn : ubAc, xubB = last ? ubBn : ubBc;
            unsigned xA[2][2];
#pragma unroll
            for (int h = 0; h < 2; ++h)
#pragma unroll
                for (int i = 0; i < 2; ++i) xA[h][i] = last ? vAn[h][i] : vAc[h][i];
            PG8_LDB(B0, 0, 0); PG8_LDB(B1, 0, 1); PG8_SCHED; PG8_LDA(At, 0, 0); PG8_STAGE_A(PG8_SA(1, 1), ubAc, vAc, 1, k1);
            PG8_WAIT_V(8); PG8_WAIT_L(0); PG8_SCHED8; PG8_BAR; PG8_MMA(0, 0, At, B0); PG8_MMA(0, 1, At, B1); PG8_SCHED8; PG8_BAR; PG8_SCHED;
            PG8_LDA(At, 0, 1); PG8_STAGE_B(PG8_SB(0, 0), xubB, 0, k2); PG8_STAGE_B(PG8_SB(0, 1), xubB, 1, k2); PG8_STAGE_A(PG8_SA(0, 0), xubA, xA, 0, k2);
            PG8_WAIT_V(8); PG8_WAIT_L(0); PG8_SCHED8; PG8_BAR; PG8_MMA(1, 0, At, B0); PG8_MMA(1, 1, At, B1); PG8_SCHED8; PG8_BAR; PG8_SCHED;
            PG8_LDB(B0, 1, 0); PG8_LDB(B1, 1, 1); PG8_SCHED; PG8_LDA(At, 1, 0); PG8_STAGE_A(PG8_SA(0, 1), xubA, xA, 1, k2);
            PG8_WAIT_V(8); PG8_WAIT_L(0); PG8_SCHED8; PG8_BAR; PG8_MMA(0, 0, At, B0); PG8_MMA(0, 1, At, B1); PG8_SCHED8; PG8_BAR; PG8_SCHED;
            PG8_LDA(At, 1, 1); PG8_STAGE_B(PG8_SB(1, 0), xubB, 0, k3); PG8_STAGE_B(PG8_SB(1, 1), xubB, 1, k3); PG8_STAGE_A(PG8_SA(1, 0), xubA, xA, 0, k3);
            PG8_WAIT_V(8); PG8_WAIT_L(0); PG8_SCHED8; PG8_BAR; PG8_MMA(1, 0, At, B0); PG8_MMA(1, 1, At, B1); PG8_SCHED8; PG8_BAR; PG8_SCHED;
        }
        if (wr == 0) PG8_BAR;
        E(acc, cur, wr, wc, fr, fq);
        if (!has_next) break;
#pragma unroll
        for (int a = 0; a < 2; ++a)
#pragma unroll
            for (int b = 0; b < 2; ++b)
#pragma unroll
                for (int m = 0; m < 4; ++m)
#pragma unroll
                    for (int n = 0; n < 2; ++n) acc[a][b][m][n] = (f32x4){0.f, 0.f, 0.f, 0.f};
        cur = nxt; ++ui; ubAc = ubAn; ubBc = ubBn;
#pragma unroll
        for (int h = 0; h < 2; ++h)
#pragma unroll
            for (int i = 0; i < 2; ++i) vAc[h][i] = vAn[h][i];
        if (wr == 1) PG8_BAR;
    }
    PG8_WAIT_V(0);
    PG8_BAR;
#undef PG8_SA
#undef PG8_SB
#undef PG8_STAGE
#undef PG8_STAGE_A
#undef PG8_STAGE_B
#undef PG8_LDA
#undef PG8_LDB
#undef PG8_MMA
#undef PG8_RD
#undef PG8_CAT2
#undef PG8_WAIT_V
#undef PG8_WAIT_L
#undef PG8_BAR
#undef PG8_SCHED
#undef PG8_SCHED8
#undef PG8_OFFS
}
}
namespace pg8 {
struct EpiBf16 {
    static constexpr bool PERM = true;
    bf16_t* O; int ldc; int split_cols; size_t split_stride; float scale0; float scale_all = 1.0f;
    __device__ __forceinline__ void operator()(const f32x4 (&acc)[2][2][4][2], const Unit& u, int wr, int wc, int fr, int fq) const {
        const int row0 = u.pm * BM + wr * 64 + fr; int colt = u.pn * BM; bf16_t* base = O;
        float sc = scale_all; if (split_cols) { const int t = colt / split_cols; base += (size_t)t * split_stride; colt -= t * split_cols; if (t == 0) sc *= scale0; }
        const int col0 = colt + wc * 32 + 8 * fq;
#pragma unroll
        for (int ai = 0; ai < 2; ++ai)
#pragma unroll
            for (int m = 0; m < 4; ++m) { bf16_t* rowp = base + (size_t)(row0 + ai * HALF + m * 16) * ldc + col0;
#pragma unroll
                for (int bj = 0; bj < 2; ++bj) { const f32x4 v0 = acc[ai][bj][m][0] * sc, v1 = acc[ai][bj][m][1] * sc;
                    u32x4 w; w.x = cvt_pk_bf16(v0[0], v0[1]); w.y = cvt_pk_bf16(v0[2], v0[3]); w.z = cvt_pk_bf16(v1[0], v1[1]); w.w = cvt_pk_bf16(v1[2], v1[3]);
                    *(u32x4*)(rowp + bj * HALF) = w; } }
    }
};
struct EpiFilt {
    static constexpr bool PERM = true;
    bf16_t* O;
    __device__ __forceinline__ void operator()(const f32x4 (&acc)[2][2][4][2], const Unit& u, int wr, int wc, int fr, int fq) const {
        const float dmin = -3.0701134573253945f, dmax = -15.350567286626973f;
#pragma unroll
        for (int ai = 0; ai < 2; ++ai)
#pragma unroll
            for (int m = 0; m < 4; ++m) { const int row = u.pm * BM + ai * HALF + wr * 64 + m * 16 + fr; const int c = row & 1023;
                const float dl2 = fabsf(dmin + (float)c * ((dmax - dmin) / 1023.0f)) * (1.4426950408889634f / 8191.0f);
#pragma unroll
                for (int bj = 0; bj < 2; ++bj) { const int col = u.pn * BM + bj * HALF + wc * 32 + 8 * fq; float v[8];
#pragma unroll
                    for (int n = 0; n < 2; ++n)
#pragma unroll
                        for (int j = 0; j < 4; ++j) v[n * 4 + j] = acc[ai][bj][m][n][j] * __builtin_amdgcn_exp2f(-(float)(col + n * 4 + j) * dl2);
                    u32x4 w; w.x = cvt_pk_bf16(v[0], v[1]); w.y = cvt_pk_bf16(v[2], v[3]); w.z = cvt_pk_bf16(v[4], v[5]); w.w = cvt_pk_bf16(v[6], v[7]);
                    *(u32x4*)(O + (size_t)row * 8192 + col) = w; }
                asm volatile("" ::: "memory"); }
    }
};
struct EpiResF32 {
    static constexpr bool PERM = false;
    const float* res; float* O; int ldc; float alpha;
    __device__ __forceinline__ void operator()(const f32x4 (&acc)[2][2][4][2], const Unit& u, int wr, int wc, int fr, int fq) const {
#pragma unroll
        for (int ai = 0; ai < 2; ++ai)
#pragma unroll
            for (int m = 0; m < 4; ++m) { const size_t off = (size_t)(u.pm * BM + ai * HALF + wr * 64 + m * 16 + fr) * ldc + u.pn * BM + wc * 32 + 4 * fq;
#pragma unroll
                for (int bj = 0; bj < 2; ++bj)
#pragma unroll
                    for (int n = 0; n < 2; ++n) { const f32x4 r = *(const f32x4*)(res + off + bj * HALF + n * 16); *(f32x4*)(O + off + bj * HALF + n * 16) = r * alpha + acc[ai][bj][m][n]; }
                if (m & 1) asm volatile("" ::: "memory"); }
    }
};
struct EpiResBf {
    static constexpr bool PERM = true;
    const bf16_t* res; bf16_t* O; int ldc; float alpha; float ascale = 1.0f;
    __device__ __forceinline__ void operator()(const f32x4 (&acc)[2][2][4][2], const Unit& u, int wr, int wc, int fr, int fq) const {
#pragma unroll
        for (int ai = 0; ai < 2; ++ai)
#pragma unroll
            for (int m = 0; m < 4; ++m) { const size_t off = (size_t)(u.pm * BM + ai * HALF + wr * 64 + m * 16 + fr) * ldc + u.pn * BM + wc * 32 + 8 * fq;
#pragma unroll
                for (int bj = 0; bj < 2; ++bj) { const u32x4 r = *(const u32x4*)(res + off + bj * HALF); const f32x4 a0 = acc[ai][bj][m][0] * ascale, a1 = acc[ai][bj][m][1] * ascale;
                    u32x4 w; w.x = cvt_pk_bf16(bflo(r.x) * alpha + a0[0], bfhi(r.x) * alpha + a0[1]); w.y = cvt_pk_bf16(bflo(r.y) * alpha + a0[2], bfhi(r.y) * alpha + a0[3]);
                    w.z = cvt_pk_bf16(bflo(r.z) * alpha + a1[0], bfhi(r.z) * alpha + a1[1]); w.w = cvt_pk_bf16(bflo(r.w) * alpha + a1[2], bfhi(r.w) * alpha + a1[3]);
                    *(u32x4*)(O + off + bj * HALF) = w; }
                if (m & 1) asm volatile("" ::: "memory"); }
    }
};
struct EpiSwiglu {
    static constexpr bool PERM = true;
    bf16_t* O;
    __device__ __forceinline__ void operator()(const f32x4 (&acc)[2][2][4][2], const Unit& u, int wr, int wc, int fr, int fq) const {
#pragma unroll
        for (int ai = 0; ai < 2; ++ai)
#pragma unroll
            for (int m = 0; m < 4; ++m) { bf16_t* p = O + (size_t)(u.pm * BM + ai * HALF + wr * 64 + m * 16 + fr) * DFF + u.pn * HALF + wc * 32 + 8 * fq;
                float h[8];
#pragma unroll
                for (int n = 0; n < 2; ++n)
#pragma unroll
                    for (int j = 0; j < 4; ++j) { const float gt = acc[ai][0][m][n][j], up = acc[ai][1][m][n][j]; h[n * 4 + j] = gt * sigmoidf_(gt) * up; }
                u32x4 w; w.x = cvt_pk_bf16(h[0], h[1]); w.y = cvt_pk_bf16(h[2], h[3]); w.z = cvt_pk_bf16(h[4], h[5]); w.w = cvt_pk_bf16(h[6], h[7]);
                *(u32x4*)p = w; }
    }
};
__device__ __forceinline__ unsigned pk4_fp8(float a, float b, float c, float d) { int w = 0; w = __builtin_amdgcn_cvt_pk_fp8_f32(a, b, w, false); w = __builtin_amdgcn_cvt_pk_fp8_f32(c, d, w, true); return (unsigned)w; }
constexpr float FP8_SW = 64.0f, FP8_SH = 8.0f;
struct EpiSwiglu8 {
    static constexpr bool PERM = true;
    unsigned char* O;
    __device__ __forceinline__ void operator()(const f32x4 (&acc)[2][2][4][2], const Unit& u, int wr, int wc, int fr, int fq) const {
#pragma unroll
        for (int ai = 0; ai < 2; ++ai)
#pragma unroll
            for (int m = 0; m < 4; ++m) { unsigned char* p = O + (size_t)(u.pm * BM + ai * HALF + wr * 64 + m * 16 + fr) * DFF + u.pn * HALF + wc * 32 + 8 * fq;
                float h[8];
#pragma unroll
                for (int n = 0; n < 2; ++n)
#pragma unroll
                    for (int j = 0; j < 4; ++j) { const float gt = acc[ai][0][m][n][j] * (1.0f / FP8_SW), up = acc[ai][1][m][n][j] * (1.0f / FP8_SW); h[n * 4 + j] = gt * sigmoidf_(gt) * up * FP8_SH; }
                u32x2 w; w.x = pk4_fp8(h[0], h[1], h[2], h[3]); w.y = pk4_fp8(h[4], h[5], h[6], h[7]);
                *(u32x2*)p = w; }
    }
};
struct EpiDown {
    static constexpr bool PERM = true;
    bf16_t* O; const int* rowlist; const float* gatew; float oscale;
    __device__ __forceinline__ void operator()(const f32x4 (&acc)[2][2][4][2], const Unit& u, int wr, int wc, int fr, int fq) const {
#pragma unroll
        for (int ai = 0; ai < 2; ++ai)
#pragma unroll
            for (int m = 0; m < 4; ++m) { const int idx = u.t * BM + ai * HALF + wr * 64 + m * 16 + fr;
                if (idx < u.cnt) { const int a = rowlist[(size_t)u.e * ECAP + idx]; const float gw = gatew[a] * oscale;
                    bf16_t* p = O + (size_t)a * DM + u.pn * BM + wc * 32 + 8 * fq;
#pragma unroll
                    for (int bj = 0; bj < 2; ++bj) { const f32x4 v0 = acc[ai][bj][m][0] * gw, v1 = acc[ai][bj][m][1] * gw;
                        u32x4 w; w.x = cvt_pk_bf16(v0[0], v0[1]); w.y = cvt_pk_bf16(v0[2], v0[3]); w.z = cvt_pk_bf16(v1[0], v1[1]); w.w = cvt_pk_bf16(v1[2], v1[3]);
                        *(u32x4*)(p + bj * HALF) = w; } } }
    }
};
struct EpiRG {
    static constexpr bool PERM = true;
    bf16_t* LA; bf16_t* BB; const bf16_t* XC; const float* ba; const float* bx; const float* lam;
    __device__ __forceinline__ void operator()(const f32x4 (&acc)[2][2][4][2], const Unit& u, int wr, int wc, int fr, int fq) const {
        const int nb = u.pn >> 2, q = u.pn & 3, dir = q >> 1, half = q & 1;
        const int ch0 = nb * 256 + half * HALF + wc * 32 + 8 * fq;
        float vba[8], vbx[8], vsp[8];
#pragma unroll
        for (int j = 0; j < 8; ++j) { vba[j] = ba[dir * DM + ch0 + j]; vbx[j] = bx[dir * DM + ch0 + j];
            const float x = __expf(-lam[dir * DM + ch0 + j]);
            vsp[j] = 8.0f * (x < 0.05f ? x * (1.0f - x * (0.5f - x * (0.33333334f - 0.25f * x))) : __logf(1.0f + x)); }
#pragma unroll
        for (int ai = 0; ai < 2; ++ai)
#pragma unroll
            for (int m = 0; m < 4; ++m) { const size_t tok = (size_t)(u.pm * BM + ai * HALF + wr * 64 + m * 16 + fr);
                asm volatile("" ::: "memory");
                const u32x4 xw = *(const u32x4*)(XC + tok * DM + ch0);
                float xf[8] = {bflo(xw.x), bfhi(xw.x), bflo(xw.y), bfhi(xw.y), bflo(xw.z), bfhi(xw.z), bflo(xw.w), bfhi(xw.w)};
                float la[8], bb[8];
#pragma unroll
                for (int n = 0; n < 2; ++n)
#pragma unroll
                    for (int j = 0; j < 4; ++j) { const int k = n * 4 + j;
                        const float r = sigmoidf_(acc[ai][0][m][n][j] + vba[k]), ig = sigmoidf_(acc[ai][1][m][n][j] + vbx[k]);
                        const float l = -r * vsp[k]; la[k] = l; bb[k] = __builtin_amdgcn_sqrtf(fmaxf(1.0f - __builtin_amdgcn_exp2f(2.8853900817779268f * l), 0.f)) * (ig * xf[k]); }
                u32x4 w; w.x = cvt_pk_bf16(la[0], la[1]); w.y = cvt_pk_bf16(la[2], la[3]); w.z = cvt_pk_bf16(la[4], la[5]); w.w = cvt_pk_bf16(la[6], la[7]);
                *(u32x4*)(LA + ((size_t)dir * NTOK + tok) * DM + ch0) = w;
                w.x = cvt_pk_bf16(bb[0], bb[1]); w.y = cvt_pk_bf16(bb[2], bb[3]); w.z = cvt_pk_bf16(bb[4], bb[5]); w.w = cvt_pk_bf16(bb[6], bb[7]);
                *(u32x4*)(BB + ((size_t)dir * NTOK + tok) * DM + ch0) = w; }
    }
};

struct RGOrder {
    static constexpr bool GATHER_A = false;
    int G, c;
    __device__ __forceinline__ bool next(int i, Unit& u) const {
        if (G == 256) { if (i >= 8) return false; const int x = c & 7, y = c >> 3; u.pm = i * 8 + (y >> 2); u.pn = x * 4 + (y & 3); }
        else { const int L = i * G + c; if (L >= 64 * 32) return false; u.pm = L >> 5; u.pn = L & 31; }
        u.e = 0; u.t = 0; u.cnt = 0; return true; }
    __device__ __forceinline__ int rowA(const Unit& u, int r) const { return u.pm * BM + r; }
    __device__ __forceinline__ int colA(const Unit& u) const { return (u.pn >> 2) * 256; }
    __device__ __forceinline__ int rowB(const Unit& u, int r) const { return u.pn * BM + r; }
};
template <int NPN, bool GATHER>
struct MoeOrder {
    static constexpr bool GATHER_A = GATHER;
    int G, c; const LAS int* tab; const int* rowlist;
    __device__ __forceinline__ bool next(int i, Unit& u) const {
        const int L = i * G + c, ntile = tab[32]; if (L >= ntile * NPN) return false;
        const int tile = L / NPN; u.pm = tile; u.pn = L % NPN; int e = 0;
        while (e < 31 && tab[e + 1] <= tile) ++e;
        u.e = e; u.t = tile - tab[e]; u.cnt = tab[64 + e]; return true;
    }
    __device__ __forceinline__ int rowA(const Unit& u, int r) const {
        if (GATHER) { const int idx = u.t * BM + r; const int a = idx < u.cnt ? rowlist[(size_t)u.e * ECAP + idx] : 0; return a >> 1; }
        return u.pm * BM + r;
    }
    __device__ __forceinline__ int colA(const Unit&) const { return 0; }
    __device__ __forceinline__ int rowB(const Unit& u, int r) const { return (u.e * NPN + u.pn) * BM + r; }
};
}
namespace att {
constexpr int NW = 8, QBLK = 32, KVBLK = 64, LDQ = 1024, LDK = 1024, LDV = 1024, LDO = 1024;
constexpr int SHM_V = KVBLK * 128 * 2, SHM_K = KVBLK * 64 * 2, NSLOT = 4, LDS_K = 0, LDS_V = NSLOT * SHM_K, LDS_WS = NSLOT * (SHM_K + SHM_V), SHM_ATTN = LDS_WS + NW * 64 * 4;
__device__ __forceinline__ void glds16s(const void* sbase, unsigned voff, unsigned lds_dst) { unsigned keep;
    asm volatile("s_mov_b32 %0, m0\n\ts_mov_b32 m0, %3\n\ts_nop 0\n\tglobal_load_lds_dwordx4 %1, %2\n\ts_mov_b32 m0, %0" : "=&s"(keep) : "v"(voff), "s"(sbase), "s"(lds_dst) : "memory"); }
#define WAITBAR(N) asm volatile("s_waitcnt vmcnt(" #N ") lgkmcnt(0)\n\ts_barrier" ::: "memory")
constexpr float THR2 = 8.0f * 1.4426950408889634f;
#define KSWZ64(row, colB) ((row) * 128 + ((colB) ^ ((((row) >> 1) & 7) << 4)))
#define SBAR() __builtin_amdgcn_sched_barrier(0)
__device__ __forceinline__ int crow(int r, int hi) { return (r & 3) + 8 * (r >> 2) + 4 * hi; }
__device__ __forceinline__ void qkt(f32x16& p0, f32x16& p1, const char* Ks, const bf16x8* qr, int r32, int hi, float A, float st) {
    { float b4[4];
#pragma unroll
      for (int j = 0; j < 4; ++j) b4[j] = fmaf(st, (float)j, A);
      const float s8 = 8.0f * st, s32 = 32.0f * st;
#pragma unroll
      for (int r = 0; r < 16; ++r) { p0[r] = (r < 4) ? b4[r] : p0[r - 4] + s8; }
#pragma unroll
      for (int r = 0; r < 16; ++r) p1[r] = p0[r] + s32; }
#pragma unroll
    for (int d0 = 0; d0 < 4; ++d0) { const int cb = (d0 * 16 + hi * 8) * 2;
        const bf16x8 b0 = *reinterpret_cast<const bf16x8*>(Ks + KSWZ64(r32, cb));
        const bf16x8 b1 = *reinterpret_cast<const bf16x8*>(Ks + KSWZ64(32 + r32, cb));
        p0 = __builtin_amdgcn_mfma_f32_32x32x16_bf16(b0, qr[d0], p0, 0, 0, 0);
        p1 = __builtin_amdgcn_mfma_f32_32x32x16_bf16(b1, qr[d0], p1, 0, 0, 0); }
}
__device__ __forceinline__ void partialSM(f32x16& p0, f32x16& p1, bool mixed, float fd, float sl2) {
    if (mixed) {
#pragma unroll
        for (int r = 0; r < 16; ++r) { const float d0 = fd - (float)((r & 3) + 8 * (r >> 2)); p0[r] = fmaf(fabsf(d0), -sl2, p0[r]); p1[r] = fmaf(fabsf(d0 - 32.0f), -sl2, p1[r]); }
    }
#pragma unroll
    for (int r = 0; r < 16; ++r) p0[r] = __builtin_amdgcn_exp2f(p0[r]);
}
__device__ __forceinline__ void finishSM(f32x16& p0, f32x16& p1, float& l_reg, bf16x8& pa0, bf16x8& pa1, bf16x8& pa2, bf16x8& pa3) {
#pragma unroll
    for (int r = 0; r < 16; ++r) p1[r] = __builtin_amdgcn_exp2f(p1[r]);
    float ps = 0;
#pragma unroll
    for (int r = 0; r < 16; ++r) ps += p0[r];
#pragma unroll
    for (int r = 0; r < 16; ++r) ps += p1[r];
    l_reg += ps;
#define PK4(P, BASE, OUT) do { unsigned a0 = cvt_pk_bf16(P[BASE + 0], P[BASE + 1]), a1 = cvt_pk_bf16(P[BASE + 2], P[BASE + 3]);   \
    unsigned b0 = cvt_pk_bf16(P[BASE + 4], P[BASE + 5]), b1 = cvt_pk_bf16(P[BASE + 6], P[BASE + 7]);                              \
    auto r0 = __builtin_amdgcn_permlane32_swap(a0, b0, false, false); auto r1 = __builtin_amdgcn_permlane32_swap(a1, b1, false, false); \
    u32x4 w = {r0[0], r1[0], r0[1], r1[1]}; OUT = __builtin_bit_cast(bf16x8, w); } while (0)
    PK4(p0, 0, pa0); PK4(p0, 8, pa1); PK4(p1, 0, pa2); PK4(p1, 8, pa3);
#undef PK4
}
__device__ __forceinline__ int v_st(int k, int c) { const int kk = (k & ~0xC) | ((k & 4) << 1) | ((k & 8) >> 1); return ((kk >> 3) * 4 + (c >> 5)) * 512 + ((kk & 7) * 32 + (c & 31)) * 2; }
__device__ __forceinline__ int v_rd_base(int lane) { return ((lane & 3) << 3) | (((lane >> 2) & 3) << 6) | (((lane >> 4) & 1) << 5) | (((lane >> 5) & 1) << 8); }
constexpr int v_rd_off(int d0, int ks, int half) { return d0 * 512 + ks * 4096 + half * 2048; }
template <int OFF> __device__ __forceinline__ s16x4 tr_read(int vb) {
    s16x4 r; asm volatile("ds_read_b64_tr_b16 %0, %1 offset:%2" : "=&v"(r) : "v"(vb), "i"(OFF) : "memory"); return r;
}
template <int D0> __device__ __forceinline__ void pv_one(f32x16& od, int vb, bf16x8 pa0, bf16x8 pa1, bf16x8 pa2, bf16x8 pa3) {
    const s16x4 l0 = tr_read<v_rd_off(D0, 0, 0)>(vb), h0 = tr_read<v_rd_off(D0, 0, 1)>(vb), l1 = tr_read<v_rd_off(D0, 1, 0)>(vb), h1 = tr_read<v_rd_off(D0, 1, 1)>(vb);
    const s16x4 l2 = tr_read<v_rd_off(D0, 2, 0)>(vb), h2 = tr_read<v_rd_off(D0, 2, 1)>(vb), l3 = tr_read<v_rd_off(D0, 3, 0)>(vb), h3 = tr_read<v_rd_off(D0, 3, 1)>(vb);
    asm volatile("s_waitcnt lgkmcnt(0)" ::: "memory"); SBAR();
#define PK(L, H) (bf16x8){L[0], L[1], L[2], L[3], H[0], H[1], H[2], H[3]}
    od = __builtin_amdgcn_mfma_f32_32x32x16_bf16(pa0, PK(l0, h0), od, 0, 0, 0);
    od = __builtin_amdgcn_mfma_f32_32x32x16_bf16(pa1, PK(l1, h1), od, 0, 0, 0);
    od = __builtin_amdgcn_mfma_f32_32x32x16_bf16(pa2, PK(l2, h2), od, 0, 0, 0);
    od = __builtin_amdgcn_mfma_f32_32x32x16_bf16(pa3, PK(l3, h3), od, 0, 0, 0);
#undef PK
}
__device__ __forceinline__ void pv_d0(f32x16* o, int vb, bf16x8 pa0, bf16x8 pa1, bf16x8 pa2, bf16x8 pa3) {
    pv_one<0>(o[0], vb, pa0, pa1, pa2, pa3); pv_one<1>(o[1], vb, pa0, pa1, pa2, pa3); pv_one<2>(o[2], vb, pa0, pa1, pa2, pa3); pv_one<3>(o[3], vb, pa0, pa1, pa2, pa3);
}
__device__ __forceinline__ void attn_unit(const bf16_t* __restrict__ Qb, const bf16_t* __restrict__ Kh, const bf16_t* __restrict__ Vh, bf16_t* __restrict__ Ob, int q0, int t_lo, int n, float sl2, char* lds) {
    const int tid = opaque_tid(), wid = __builtin_amdgcn_readfirstlane(tid >> 6), lane = tid & 63, r32 = lane & 31, hi = lane >> 5;
    float* ws = (float*)(lds + LDS_WS) + wid * 64; float* li_l = ws;
    float l_reg = 0; f32x16 o[4] = {}; bf16x8 qr[4];
    const bf16_t* Qw = Qb + (long)(wid * QBLK + r32) * LDQ + hi * 8;
#pragma unroll
    for (int d0 = 0; d0 < 4; ++d0) qr[d0] = *reinterpret_cast<const bf16x8*>(Qw + d0 * 16);
    float negM;
    { const bf16_t* Kw = Kh + (long)(q0 + wid * QBLK + r32) * LDK + hi * 8; float s = 0.f;
#pragma unroll
      for (int d0 = 0; d0 < 4; ++d0) { const u32x4 kw = *reinterpret_cast<const u32x4*>(Kw + d0 * 16); const u32x4 qw = __builtin_bit_cast(u32x4, qr[d0]);
          s += bflo(kw.x) * bflo(qw.x) + bfhi(kw.x) * bfhi(qw.x) + bflo(kw.y) * bflo(qw.y) + bfhi(kw.y) * bfhi(qw.y) + bflo(kw.z) * bflo(qw.z) + bfhi(kw.z) * bfhi(qw.z) + bflo(kw.w) * bflo(qw.w) + bfhi(kw.w) * bfhi(qw.w); }
      auto rr = __builtin_amdgcn_permlane32_swap(__float_as_uint(s), __float_as_uint(s), false, false); negM = -(__uint_as_float(rr[0]) + __uint_as_float(rr[1])); }
    const unsigned lds0 = (unsigned)(uintptr_t)lds;
    const int krow = wid * 8 + (lane >> 3), kch = (lane & 7) ^ ((krow >> 1) & 7);
    const unsigned koff = (unsigned)(krow * LDK * 2 + kch * 16);
    unsigned voff[2];
#pragma unroll
    for (int z = 0; z < 2; ++z) { const int P16 = (wid + 8 * z) * 64 + lane, sub = P16 >> 5, win = P16 & 31, kk = (sub >> 2) * 8 + (win >> 2), k = (kk & ~0xC) | ((kk & 4) << 1) | ((kk & 8) >> 1), c = (sub & 3) * 32 + (win & 3) * 8;
        voff[z] = (unsigned)(k * LDV * 2 + c * 2); }
    const unsigned kdst = lds0 + LDS_K + wid * 1024, vdst = lds0 + LDS_V + wid * 1024;
    const int vb0 = (int)(lds0 + LDS_V) + v_rd_base(lane);
    const char* K_lds = lds + LDS_K;
    const int qw0 = q0 + wid * QBLK;
    const float fq0 = (float)(qw0 + r32 - 4 * hi);
    const char* Kt = (const char*)(Kh + (long)t_lo * KVBLK * LDK); const char* Vt = (const char*)(Vh + (long)t_lo * KVBLK * LDV);
#define DMA(jj, slot) do { const char* kb_ = Kt + (size_t)(jj) * (KVBLK * LDK * 2); const char* vb_ = Vt + (size_t)(jj) * (KVBLK * LDV * 2); \
    glds16s(kb_, koff, (unsigned)__builtin_amdgcn_readfirstlane(kdst + (slot) * SHM_K)); \
    glds16s(vb_, voff[0], (unsigned)__builtin_amdgcn_readfirstlane(vdst + (slot) * SHM_V)); \
    glds16s(vb_, voff[1], (unsigned)__builtin_amdgcn_readfirstlane(vdst + (slot) * SHM_V + 8192)); } while (0)
#define TILE(jj) const int k0_ = (t_lo + (jj)) * KVBLK; const bool left_ = k0_ + 63 < qw0, right_ = k0_ > qw0 + 31, mixed_ = !(left_ || right_); \
    const float fd_ = fq0 - (float)k0_, st_ = left_ ? sl2 : (right_ ? -sl2 : 0.f), A_ = negM - st_ * fd_
    f32x16 pA0, pA1, pB0, pB1; bf16x8 pa0, pa1, pa2, pa3;
    asm volatile("s_waitcnt vmcnt(0)" ::: "memory");
#define SEG_A(PN0, PN1, PO0, PO1, jt, FIN) do { TILE(jt); SBAR(); qkt(PN0, PN1, K_lds + ((jt) & 3) * SHM_K, qr, r32, hi, A_, st_); if (FIN) finishSM(PO0, PO1, l_reg, pa0, pa1, pa2, pa3); SBAR(); } while (0)
#define SEG_B(P0, P1, jt, PV) do { if (PV) pv_d0(o, vb0 + (((jt) - 1) & 3) * SHM_V, pa0, pa1, pa2, pa3); { TILE(jt); partialSM(P0, P1, mixed_, fd_, sl2); } } while (0)
#define STEP_BAR(jt) do { WAITBAR(0); if ((jt) + 2 < n) DMA((jt) + 2, ((jt) + 2) & 3); } while (0)
    const bool lead = wid < 4;
    DMA(0, 0); DMA(1, 1);
    WAITBAR(3);
    SEG_A(pA0, pA1, pB0, pB1, 0, false); if (!lead) STEP_BAR(0); SEG_B(pA0, pA1, 0, false); if (lead) STEP_BAR(0);
    for (int j = 1; j + 1 < n; j += 2) {
        SEG_A(pB0, pB1, pA0, pA1, j, true); if (!lead) STEP_BAR(j); SEG_B(pB0, pB1, j, true); if (lead) STEP_BAR(j);
        SEG_A(pA0, pA1, pB0, pB1, j + 1, true); if (!lead) STEP_BAR(j + 1); SEG_B(pA0, pA1, j + 1, true); if (lead) STEP_BAR(j + 1);
    }
    SEG_A(pB0, pB1, pA0, pA1, n - 1, true); if (!lead) STEP_BAR(n - 1); SEG_B(pB0, pB1, n - 1, true); if (lead) STEP_BAR(n - 1);
    finishSM(pB0, pB1, l_reg, pa0, pa1, pa2, pa3); SBAR();
    pv_d0(o, vb0 + ((n - 1) & 3) * SHM_V, pa0, pa1, pa2, pa3);
    { auto rr = __builtin_amdgcn_permlane32_swap(__float_as_uint(l_reg), __float_as_uint(l_reg), false, false); l_reg = __uint_as_float(rr[0]) + __uint_as_float(rr[1]); }
    if (hi == 0) li_l[r32] = l_reg; asm volatile("s_waitcnt lgkmcnt(0)" ::: "memory");
    float rli[16];
#pragma unroll
    for (int r = 0; r < 16; ++r) rli[r] = __builtin_amdgcn_rcpf(li_l[crow(r, hi)]);
    bf16_t* Ow = Ob + (long)(wid * QBLK) * LDO;
#pragma unroll
    for (int r = 0; r < 16; ++r) { const int orow = crow(r, hi);
#pragma unroll
        for (int d0 = 0; d0 < 4; ++d0) Ow[(long)orow * LDO + d0 * 32 + r32] = (bf16_t)f2bf(o[d0][r] * rli[r]); }
    WAITBAR(0);
#undef DMA
#undef SEG_A
#undef SEG_B
#undef STEP_BAR
#undef TILE
}
#undef SBAR
}

namespace hy {
typedef f32x2 cf;
__device__ __forceinline__ cf lld(const LAS f32x2* L, int i) { return L[i]; }
__device__ __forceinline__ void lst(LAS f32x2* L, int i, cf v) { L[i] = v; }
__device__ __forceinline__ cf cmul(cf a, cf b) { return a * b.xx + a.yx * (b.yy * (cf){-1.f, 1.f}); }
__device__ __forceinline__ cf cmulc(cf a, cf b) { return a * b.xx + a.yx * (b.yy * (cf){1.f, -1.f}); }
__device__ constexpr float C32[16] = {1.0f, 0.98078528040323043f, 0.92387953251128674f, 0.83146961230254524f, 0.70710678118654757f, 0.55557023301960229f, 0.38268343236508984f, 0.19509032201612833f,
                                      0.0f, -0.19509032201612819f, -0.38268343236508973f, -0.55557023301960196f, -0.70710678118654746f, -0.83146961230254535f, -0.92387953251128674f, -0.98078528040323043f};
__device__ constexpr float S32[16] = {0.0f, 0.19509032201612825f, 0.38268343236508978f, 0.55557023301960218f, 0.70710678118654746f, 0.83146961230254524f, 0.92387953251128674f, 0.98078528040323043f,
                                      1.0f, 0.98078528040323043f, 0.92387953251128674f, 0.83146961230254546f, 0.70710678118654757f, 0.55557023301960218f, 0.38268343236508989f, 0.19509032201612861f};
__host__ __device__ constexpr int brev(int k, int bits) { int r = 0; for (int i = 0; i < bits; ++i) r |= ((k >> i) & 1) << (bits - 1 - i); return r; }
template <int R, bool INV> __device__ __forceinline__ void dft_reg(cf (&v)[R]) {
#pragma unroll
    for (int s = R / 2; s >= 1; s >>= 1) {
#pragma unroll
        for (int g0 = 0; g0 < R; g0 += 2 * s) {
#pragma unroll
            for (int j = 0; j < s; ++j) {
                const cf a = v[g0 + j], b = v[g0 + j + s];
                v[g0 + j] = a + b;
                const cf d = a - b;
                const int tw = j * (16 / s);
                if (tw == 0) v[g0 + j + s] = d;
                else if (tw == 8) v[g0 + j + s] = INV ? (cf){-d.y, d.x} : (cf){d.y, -d.x};
                else { const float c = C32[tw], sn = INV ? S32[tw] : -S32[tw]; v[g0 + j + s] = d * c + d.yx * (cf){-sn, sn}; }
            }
        }
    }
}
constexpr int RS = FFT_RS;
__device__ __forceinline__ void fft_fwd12(cf (&v)[32], LAS f32x2* L, int tid) {
    dft_reg<32, false>(v);
    { float s, c; sincospif((float)tid * (1.0f / 8192.0f), &s, &c); cf w1 = {c, -s}; asm volatile("" : "+v"(w1.x), "+v"(w1.y)); cf w = w1;
#pragma unroll
      for (int k1 = 0; k1 < 32; ++k1) { cf x = v[brev(k1, 5)]; if (k1) { x = cmul(x, w); w = cmul(w, w1); } lst(L, k1 * RS + tid, x); } }
    __syncthreads();
    const int k1 = tid >> 4, m2 = tid & 15;
#pragma unroll
    for (int m1 = 0; m1 < 32; ++m1) v[m1] = lld(L, k1 * RS + 16 * m1 + m2);
    __syncthreads();
    dft_reg<32, false>(v);
    { float s, c; sincospif((float)m2 * (1.0f / 256.0f), &s, &c); cf w1 = {c, -s}; asm volatile("" : "+v"(w1.x), "+v"(w1.y)); cf w = w1;
#pragma unroll
      for (int j1 = 0; j1 < 32; ++j1) { cf x = v[brev(j1, 5)]; if (j1) { x = cmul(x, w); w = cmul(w, w1); } lst(L, k1 * RS + 33 * m2 + j1, x); } }
    __syncthreads();
}
__device__ __forceinline__ void fft_inv21(cf (&v)[32], LAS f32x2* L, int tid) {
    const int k1 = tid >> 4, m2 = tid & 15;
    { float s, c; sincospif((float)m2 * (1.0f / 256.0f), &s, &c); cf w1 = {c, -s}; asm volatile("" : "+v"(w1.x), "+v"(w1.y)); cf w = w1;
#pragma unroll
      for (int j1 = 0; j1 < 32; ++j1) { cf x = lld(L, k1 * RS + 33 * m2 + j1); if (j1) { x = cmulc(x, w); w = cmul(w, w1); } v[j1] = x; } }
    __syncthreads();
    dft_reg<32, true>(v);
#pragma unroll
    for (int m1 = 0; m1 < 32; ++m1) lst(L, k1 * RS + 16 * m1 + m2, v[brev(m1, 5)]);
    __syncthreads();
    { float s, c; sincospif((float)tid * (1.0f / 8192.0f), &s, &c); cf w1 = {c, -s}; asm volatile("" : "+v"(w1.x), "+v"(w1.y)); cf w = w1;
#pragma unroll
      for (int kk = 0; kk < 32; ++kk) { cf x = lld(L, kk * RS + tid); if (kk) { x = cmulc(x, w); w = cmul(w, w1); } v[kk] = x; } }
    dft_reg<32, true>(v);
}
}

namespace hm {
typedef f32x2 cf;
constexpr int ROWA = 40, ROWB = 24;
constexpr int PL_A = 512 * ROWA * 2, PL_B = 1024 * ROWB * 2;
__device__ __forceinline__ int crow(int r, int hi) { return (r & 3) + 8 * (r >> 2) + 4 * hi; }
struct CFrag { bf16x8 re, im, nim; };
__device__ __forceinline__ CFrag dft_frag(int n, int row, int k0, bool valid) {
    unsigned wr[4], wi[4], wn[4];
#pragma unroll
    for (int t = 0; t < 4; ++t) { float s0, c0, s1, c1; sincospif(-2.0f * (float)((row * (k0 + 2 * t)) % n) / (float)n, &s0, &c0); sincospif(-2.0f * (float)((row * (k0 + 2 * t + 1)) % n) / (float)n, &s1, &c1);
        if (!valid) { s0 = c0 = s1 = c1 = 0.f; }
        wr[t] = pk2(c0, c1); wi[t] = pk2(s0, s1); wn[t] = pk2(-s0, -s1); }
    CFrag f; f.re = __builtin_bit_cast(bf16x8, (u32x4){wr[0], wr[1], wr[2], wr[3]}); f.im = __builtin_bit_cast(bf16x8, (u32x4){wi[0], wi[1], wi[2], wi[3]}); f.nim = __builtin_bit_cast(bf16x8, (u32x4){wn[0], wn[1], wn[2], wn[3]});
    return f;
}
template <bool CONJ> __device__ __forceinline__ void cmfma(f32x16& dr, f32x16& di, const CFrag& a, bf16x8 br, bf16x8 bi) {
    dr = __builtin_amdgcn_mfma_f32_32x32x16_bf16(a.re, br, dr, 0, 0, 0); dr = __builtin_amdgcn_mfma_f32_32x32x16_bf16(CONJ ? a.im : a.nim, bi, dr, 0, 0, 0);
    di = __builtin_amdgcn_mfma_f32_32x32x16_bf16(a.re, bi, di, 0, 0, 0); di = __builtin_amdgcn_mfma_f32_32x32x16_bf16(CONJ ? a.nim : a.im, br, di, 0, 0, 0);
}
__device__ __forceinline__ cf cmul(cf a, cf b) { return a * b.xx + a.yx * (b.yy * (cf){-1.f, 1.f}); }
__device__ __forceinline__ cf cmulc(cf a, cf b) { return a * b.xx + a.yx * (b.yy * (cf){1.f, -1.f}); }
__device__ __forceinline__ bf16x8 pk4(const float (&P)[8]) {
    const unsigned a0 = cvt_pk_bf16(P[0], P[1]), a1 = cvt_pk_bf16(P[2], P[3]), b0 = cvt_pk_bf16(P[4], P[5]), b1 = cvt_pk_bf16(P[6], P[7]);
    auto r0 = __builtin_amdgcn_permlane32_swap(a0, b0, false, false); auto r1 = __builtin_amdgcn_permlane32_swap(a1, b1, false, false);
    return __builtin_bit_cast(bf16x8, (u32x4){r0[0], r1[0], r0[1], r1[1]});
}
constexpr int LDS_FTAB = 100 * 1024;
struct Consts { const LAS unsigned char* T; int lane;
    __device__ __forceinline__ CFrag get(int which) const { const LAS unsigned char* p = T + (which * 64 + lane) * 48; CFrag f; f.re = *(const LAS bf16x8*)p; f.im = *(const LAS bf16x8*)(p + 16); f.nim = *(const LAS bf16x8*)(p + 32); return f; } };
__device__ __forceinline__ void build_ftab(LAS unsigned char* T, int tid) {
    if (tid < 64) { const int j = tid & 31, hi = tid >> 5;
        const CFrag f0 = dft_frag(32, j, 8 * hi, true), f1 = dft_frag(32, j, 16 + 8 * hi, true), g = dft_frag(16, j & 15, 8 * hi, j < 16);
        LAS bf16x8* p = (LAS bf16x8*)(T + tid * 48); p[0] = f0.re; p[1] = f0.im; p[2] = f0.nim;
        p = (LAS bf16x8*)(T + (64 + tid) * 48); p[0] = f1.re; p[1] = f1.im; p[2] = f1.nim;
        p = (LAS bf16x8*)(T + (128 + tid) * 48); p[0] = g.re; p[1] = g.im; p[2] = g.nim; }
    __syncthreads();
}
__device__ __forceinline__ void st2(LAS unsigned char* L, int plane_bytes, int idx, cf v) { const unsigned w = cvt_pk_bf16(v.x, v.y); ((LAS bf16_t*)L)[idx] = (bf16_t)(w & 0xffffu); ((LAS bf16_t*)(L + plane_bytes))[idx] = (bf16_t)(w >> 16); }
template <int NK> __device__ __forceinline__ void fwd12(const Consts& C, const bf16x8 (&Bre)[2][NK], const bf16x8 (&Bim)[2][NK], LAS unsigned char* L, const float2* TW1, const float2* TW2, int wave, int j, int hi) {
    asm volatile("" : "+v"(j), "+v"(hi));
#pragma unroll
    for (int tl = 0; tl < 2; ++tl) { const int n2 = 64 * wave + 32 * tl + j; f32x16 dr = {}, di = {};
        cmfma<false>(dr, di, C.get(0), Bre[tl][0], Bim[tl][0]); if constexpr (NK == 2) cmfma<false>(dr, di, C.get(1), Bre[tl][1], Bim[tl][1]);
#pragma unroll
        for (int r = 0; r < 16; ++r) { const int k1 = crow(r, hi); const float2 t = TW1[k1 * 512 + n2]; st2(L, PL_A, (k1 * 16 + (n2 & 15)) * ROWA + (n2 >> 4), cmul((cf){dr[r], di[r]}, (cf){t.x, t.y})); } }
    __syncthreads();
    asm volatile("" : "+v"(j), "+v"(hi));
    bf16x8 yre[2][2], yim[2][2];
#pragma unroll
    for (int tl = 0; tl < 2; ++tl) { const int col = (4 * wave + 2 * tl + (j >> 4)) * 16 + (j & 15);
#pragma unroll
        for (int ks = 0; ks < 2; ++ks) { yre[tl][ks] = *(const LAS bf16x8*)(L + (col * ROWA + 16 * ks + 8 * hi) * 2); yim[tl][ks] = *(const LAS bf16x8*)(L + PL_A + (col * ROWA + 16 * ks + 8 * hi) * 2); } }
    __syncthreads();
    asm volatile("" : "+v"(j), "+v"(hi));
#pragma unroll
    for (int tl = 0; tl < 2; ++tl) { const int k1 = 4 * wave + 2 * tl + (j >> 4), m2 = j & 15; f32x16 dr = {}, di = {};
        cmfma<false>(dr, di, C.get(0), yre[tl][0], yim[tl][0]); cmfma<false>(dr, di, C.get(1), yre[tl][1], yim[tl][1]);
#pragma unroll
        for (int r = 0; r < 16; ++r) { const int j1 = crow(r, hi); const float2 t = TW2[j1 * 16 + m2]; st2(L, PL_B, (k1 * 32 + j1) * ROWB + m2, cmul((cf){dr[r], di[r]}, (cf){t.x, t.y})); } }
    __syncthreads();
}
__device__ __forceinline__ void inv21(const Consts& C, cf (&y)[2][8], LAS unsigned char* L, const float2* TW1, int wave, int j, int hi) {
    asm volatile("" : "+v"(j), "+v"(hi));
    bf16x8 yre[2][2], yim[2][2];
#pragma unroll
    for (int tl = 0; tl < 2; ++tl) { const int col = (4 * wave + 2 * tl + (j >> 4)) * 16 + (j & 15);
#pragma unroll
        for (int ks = 0; ks < 2; ++ks) { yre[tl][ks] = *(const LAS bf16x8*)(L + (col * ROWA + 16 * ks + 8 * hi) * 2); yim[tl][ks] = *(const LAS bf16x8*)(L + PL_A + (col * ROWA + 16 * ks + 8 * hi) * 2); } }
    __syncthreads();
    asm volatile("" : "+v"(j), "+v"(hi));
#pragma unroll
    for (int tl = 0; tl < 2; ++tl) { const int k1 = 4 * wave + 2 * tl + (j >> 4), m2 = j & 15; f32x16 dr = {}, di = {};
        cmfma<true>(dr, di, C.get(0), yre[tl][0], yim[tl][0]); cmfma<true>(dr, di, C.get(1), yre[tl][1], yim[tl][1]);
#pragma unroll
        for (int r = 0; r < 16; ++r) { const int n2 = 16 * crow(r, hi) + m2; const float2 t = TW1[k1 * 512 + n2]; st2(L, PL_A, n2 * ROWA + k1, cmulc((cf){dr[r], di[r]}, (cf){t.x, t.y})); } }
    __syncthreads();
    asm volatile("" : "+v"(j), "+v"(hi));
#pragma unroll
    for (int tl = 0; tl < 2; ++tl) { const int n2 = 64 * wave + 32 * tl + j; f32x16 dr = {}, di = {};
#pragma unroll
        for (int ks = 0; ks < 2; ++ks) { const bf16x8 br = *(const LAS bf16x8*)(L + (n2 * ROWA + 16 * ks + 8 * hi) * 2), bi = *(const LAS bf16x8*)(L + PL_A + (n2 * ROWA + 16 * ks + 8 * hi) * 2);
            cmfma<true>(dr, di, C.get(ks), br, bi); }
#pragma unroll
        for (int r = 0; r < 8; ++r) y[tl][r] = (cf){dr[r], di[r]}; }
    __syncthreads();
}
}
constexpr size_t MiB = 1u << 20;
constexpr size_t WS_CTL = 0, CTL_ZERO_BYTES = 1 * MiB;
constexpr size_t WS_W1T = 1 * MiB;
constexpr size_t WS_W2T = 257 * MiB;
constexpr size_t WS_WIN_EV = 385 * MiB, WS_WOUT_EV = 409 * MiB, WS_WIN_OD = 417 * MiB, WS_WOUT_OD = 433 * MiB, WS_WG_OD = 441 * MiB;
constexpr size_t AR = 445 * MiB;
constexpr size_t A_XB = AR + 0 * MiB, A_UHT = AR + 64 * MiB, A_QB = AR + 160 * MiB, A_KB = AR + 192 * MiB, A_VB = AR + 224 * MiB, A_KTD = AR + 256 * MiB, A_KF = AR + 384 * MiB,
                 A_H3B = AR + 512 * MiB, A_W4T = AR + 514 * MiB, A_YHT = AR + 416 * MiB, A_OA = AR + 448 * MiB, A_YCAT = AR + 512 * MiB, A_XB2 = AR + 0 * MiB, A_R0 = AR + 64 * MiB, A_H1_0 = AR + 192 * MiB,
                 A_HB_0 = AR + 320 * MiB, A_HID_0 = AR + 384 * MiB, A_ROWL = AR + 424 * MiB, A_GATEW = AR + 428 * MiB, A_Y2_0 = AR + 0 * MiB, A_H2 = AR + 448 * MiB, A_HB2 = AR + 448 * MiB;
constexpr size_t A_GB = AR + 0 * MiB, A_XR = AR + 64 * MiB, A_XC = AR + 192 * MiB, A_LA = AR + 256 * MiB, A_BB = AR + 64 * MiB, A_CAR = AR + 384 * MiB, A_YG = AR + 192 * MiB, A_R1 = AR + 256 * MiB,
                 A_H1_1 = AR + 0 * MiB, A_HB8_1 = AR + 0 * MiB, A_XB8 = AR + 320 * MiB, WS_WIN_EV8 = AR + 544 * MiB, A_HB2_8 = AR + 512 * MiB, A_HB8_0 = AR + 192 * MiB, A_HB_1 = AR + 128 * MiB, A_HID_1 = AR + 192 * MiB, A_Y2_1 = AR + 256 * MiB;
constexpr size_t WS_END = AR + 576 * MiB;
constexpr size_t WS_TW1 = WS_CTL + 512 * 1024, WS_TW2 = WS_TW1 + 128 * 1024;
constexpr int CW_BAR = 4096, CW_CNT = 16384, CW_NORM = 24576;
constexpr int LDS_MISC = 139264, LDS_BYTES = 147456;
constexpr int NPHASE = 21;
#ifndef FP8_P1
#define FP8_P1 0
#endif
#ifndef FP8_P1B
#define FP8_P1B 0
#endif
#ifndef FP8_P1C
#define FP8_P1C 0
#endif
#ifndef FP8_P16
#define FP8_P16 1
#endif
#ifndef FP8_P5
#define FP8_P5 1
#endif
#ifndef FP8_P10
#define FP8_P10 1
#endif
#ifndef MOE_FP8_LAYERS
#define MOE_FP8_LAYERS 2
#endif

struct Args { const float* in[37]; float* out; unsigned char* ws; int ph_lo, ph_hi; };
typedef const __attribute__((address_space(4))) Args& KArgs;

__device__ __forceinline__ void transpose_item(const float* W, int N, int k0, int n0, bf16_t* WT, int ldk, int drow0, LAS float* scr, int lane) {
#pragma unroll 8
    for (int i = 0; i < 32; ++i) { const int kk = 2 * i + (lane >> 5); scr[kk * 33 + (lane & 31)] = W[(size_t)(k0 + kk) * N + n0 + (lane & 31)]; }
    LDS_WAIT(); asm volatile("" ::: "memory");
    const int c = lane & 7;
#pragma unroll
    for (int j = 0; j < 4; ++j) { const int n = (lane >> 3) + 8 * j; const LAS float* s = scr + (8 * c) * 33 + n;
        u32x4 o; o.x = pk2(s[0 * 33], s[1 * 33]); o.y = pk2(s[2 * 33], s[3 * 33]); o.z = pk2(s[4 * 33], s[5 * 33]); o.w = pk2(s[6 * 33], s[7 * 33]);
        *(u32x4*)(WT + (size_t)(drow0 + n) * ldk + k0 + 8 * c) = o; }
    LDS_WAIT(); asm volatile("" ::: "memory");
}

__device__ __forceinline__ void transpose_item8(const float* W, int N, int k0, int n0, unsigned char* WT8, int ldk, int drow0, float scale, LAS float* scr, int lane) {
#pragma unroll 8
    for (int i = 0; i < 32; ++i) { const int kk = 2 * i + (lane >> 5); scr[kk * 33 + (lane & 31)] = W[(size_t)(k0 + kk) * N + n0 + (lane & 31)]; }
    LDS_WAIT(); asm volatile("" ::: "memory");
    const int c = lane & 7;
#pragma unroll
    for (int j = 0; j < 4; ++j) { const int n = (lane >> 3) + 8 * j; const LAS float* s = scr + (8 * c) * 33 + n;
        u32x2 o; o.x = pg8::pk4_fp8(s[0 * 33] * scale, s[1 * 33] * scale, s[2 * 33] * scale, s[3 * 33] * scale); o.y = pg8::pk4_fp8(s[4 * 33] * scale, s[5 * 33] * scale, s[6 * 33] * scale, s[7 * 33] * scale);
        *(u32x2*)(WT8 + (size_t)(drow0 + n) * ldk + k0 + 8 * c) = o; }
    LDS_WAIT(); asm volatile("" ::: "memory");
}
__device__ __forceinline__ void phase_prologue(KArgs a, LAS unsigned char* lds) {
    const int tid = opaque_tid(), lane = tid & 63, wave = tid >> 6, G = gridDim.x;
    const int gw = blockIdx.x * 8 + wave, NGW = G * 8;
    unsigned char* ws = a.ws;
    LAS float* scr = (LAS float*)(lds + wave * 16384);
    constexpr int I_EVIN = 32 * 192, I_SQ = 32 * 64, I_ODIN = 32 * 128, I_MOE_GU = 64 * 512, I_MOE_D = 64 * 512, I_RG = 16 * 32, I_W4 = 128;
    constexpr int O1 = I_EVIN, O2 = O1 + I_SQ, O3 = O2 + I_ODIN, O4 = O3 + I_SQ, O5 = O4 + I_MOE_GU, O6 = O5 + I_MOE_GU, O7 = O6 + I_MOE_D, O8 = O7 + I_RG, O9 = O8 + I_RG, O10 = O9 + I_W4;
    for (int it = gw; it < O10; it += NGW) {
        if (it < O1) { const int kb = it / 192, nb = it % 192;
            const bool f8 = (nb * 32 < 3072) ? (FP8_P1C != 0) : (FP8_P1B != 0);
            if (f8) transpose_item8(a.in[1], EV_IN, kb * 64, nb * 32, ws + WS_WIN_EV8, DM, nb * 32, pg8::FP8_SW, scr, lane);
            else transpose_item(a.in[1], EV_IN, kb * 64, nb * 32, (bf16_t*)(ws + WS_WIN_EV), DM, nb * 32, scr, lane); }
        else if (it < O2) { const int r = it - O1, kb = r / 64, nb = r % 64;
            if (FP8_P5) transpose_item8(a.in[18], DM, kb * 64, nb * 32, ws + WS_WOUT_EV, DM, nb * 32, pg8::FP8_SW, scr, lane);
            else transpose_item(a.in[18], DM, kb * 64, nb * 32, (bf16_t*)(ws + WS_WOUT_EV), DM, nb * 32, scr, lane); }
        else if (it < O3) { const int r = it - O2, kb = r / 128, nb = r % 128;
            if (FP8_P10) transpose_item8(a.in[19], 2 * DM, kb * 64, nb * 32, ws + WS_WIN_OD, DM, nb * 32, pg8::FP8_SW, scr, lane);
            else transpose_item(a.in[19], 2 * DM, kb * 64, nb * 32, (bf16_t*)(ws + WS_WIN_OD), DM, nb * 32, scr, lane); }
        else if (it < O4) { const int r = it - O3, kb = r / 64, nb = r % 64;
            if (FP8_P16) transpose_item8(a.in[27], DM, kb * 64, nb * 32, ws + WS_WOUT_OD, DM, nb * 32, pg8::FP8_SW, scr, lane);
            else transpose_item(a.in[27], DM, kb * 64, nb * 32, (bf16_t*)(ws + WS_WOUT_OD), DM, nb * 32, scr, lane); }
        else if (it < O6) { const bool up = it >= O5; const int r = it - (up ? O5 : O4), le = r / 512, q = r % 512, kb = q / 16, nb = q % 16, n0 = nb * 32;
            const int drow = (n0 >> 7) * 256 + (n0 & 127) + (up ? 128 : 0); const float* src = (up ? a.in[35] : a.in[34]) + (size_t)le * DM * DFF;
            if (le < 32 * (2 - MOE_FP8_LAYERS)) transpose_item(src, DFF, kb * 64, n0, (bf16_t*)(ws + WS_W1T) + (size_t)le * 1024 * DM, DM, drow, scr, lane);
            else transpose_item8(src, DFF, kb * 64, n0, ws + WS_W1T + (size_t)(le >> 5) * 32 * 1024 * DM * 2 + (size_t)(le & 31) * 1024 * DM, DM, drow, pg8::FP8_SW, scr, lane); }
        else if (it < O7) { const int r = it - O6, le = r / 512, q = r % 512, kb = q / 64, nb = q % 64; const float* src = a.in[36] + (size_t)le * DFF * DM;
            if (le < 32 * (2 - MOE_FP8_LAYERS)) transpose_item(src, DM, kb * 64, nb * 32, (bf16_t*)(ws + WS_W2T) + (size_t)le * DM * DFF, DFF, nb * 32, scr, lane);
            else transpose_item8(src, DM, kb * 64, nb * 32, ws + WS_W2T + (size_t)(le >> 5) * 32 * DM * DFF * 2 + (size_t)(le & 31) * DM * DFF, DFF, nb * 32, pg8::FP8_SW, scr, lane); }
        else if (it < O9) { const bool wx = it >= O8; const int r = it - (wx ? O8 : O7), dn = r / 32, q = r % 32, kb = q / 8, nb = q % 8, n0 = nb * 32, dir = dn / 8, n = dn % 8;
            transpose_item((wx ? a.in[24] : a.in[22]) + (size_t)dn * 65536, 256, kb * 64, n0, (bf16_t*)(ws + WS_WG_OD), 256, (n * 4 + dir * 2 + (n0 >> 7)) * 256 + (n0 & 127) + (wx ? 128 : 0), scr, lane); }
        else { const int nb = it - O9; transpose_item(a.in[11], 4096, 0, nb * 32, (bf16_t*)(ws + A_W4T), 128, nb * 32, scr, lane); }
    }
    { const int gt = blockIdx.x * 512 + tid, NT = G * 512;
      for (int i = gt; i < 16384 + 512; i += NT) { float sn, cs;
          if (i < 16384) { const int k1 = i >> 9, n2 = i & 511; sincospif(-2.0f * (float)((k1 * n2) & 16383) * (1.0f / 16384.0f), &sn, &cs); ((float2*)(ws + WS_TW1))[i] = make_float2(cs, sn); }
          else { const int q = i - 16384, j1 = q >> 4, m2 = q & 15; sincospif(-2.0f * (float)((j1 * m2) & 511) * (1.0f / 512.0f), &sn, &cs); ((float2*)(ws + WS_TW2))[q] = make_float2(cs, sn); } }
      for (int i = gt; i < 4096 * 8; i += NT) { const int r = i >> 3, c = i & 7; *(u32x4*)((bf16_t*)(ws + A_W4T) + (size_t)r * 128 + 64 + c * 8) = (u32x4){0u, 0u, 0u, 0u}; }
      for (int i = gt; i < 8192 * 8; i += NT) { const int r = i >> 3, c = i & 7; *(u32x4*)((bf16_t*)(ws + A_H3B) + (size_t)r * 128 + 64 + c * 8) = (u32x4){0u, 0u, 0u, 0u}; }
      const f32x8* x8 = (const f32x8*)a.in[0]; u32x4* xb = (u32x4*)(ws + A_XB);
      u32x2* xb8 = (u32x2*)(ws + A_XB8);
      for (int i = gt; i < NTOK * DM / 8; i += NT) { const f32x8 v = x8[i]; u32x4 o; o.x = pk2(v[0], v[1]); o.y = pk2(v[2], v[3]); o.z = pk2(v[4], v[5]); o.w = pk2(v[6], v[7]); xb[i] = o;
          if (FP8_P1) { u32x2 q; q.x = pg8::pk4_fp8(v[0], v[1], v[2], v[3]); q.y = pg8::pk4_fp8(v[4], v[5], v[6], v[7]); xb8[i] = q; } } }
    { const float* w1 = a.in[4]; const float* b1 = a.in[5]; const float* w2 = a.in[6]; const float* b2 = a.in[7]; const float* w3 = a.in[8]; const float* b3 = a.in[9]; const float* fr = a.in[10];
      const float frq = fr[lane];
      for (int t = gw; t < SEQ; t += NGW) {
          float z;
          { const float tl = (float)t * (1.0f / 8191.0f);
            if (lane == 0) z = tl;
            else { const int j = (lane - 1) & 15; const float band = 1e-4f + (float)j * ((15.0f - 1e-4f) / 15.0f);
                   const float ang = (6.283185307179586f * (float)t * (1.0f / 8192.0f)) * band; float sn, cs; sincosf(ang, &sn, &cs); z = (lane <= 16) ? cs : -sn; } }
          float acc = b1[lane];
#pragma unroll
          for (int i = 0; i < 33; ++i) acc += __shfl(z, i) * w1[i * 64 + lane];
          float h = sinf(frq * acc);
          acc = b2[lane];
#pragma unroll 16
          for (int i = 0; i < 64; ++i) acc += __shfl(h, i) * w2[i * 64 + lane];
          h = sinf(frq * acc);
          acc = b3[lane];
#pragma unroll 16
          for (int i = 0; i < 64; ++i) acc += __shfl(h, i) * w3[i * 64 + lane];
          h = sinf(frq * acc);
          ((bf16_t*)(ws + A_H3B))[(size_t)t * 128 + lane] = (bf16_t)f2bf(h);
      } }
}

__device__ __forceinline__ void filter_unit(KArgs a, LAS unsigned char* lds, int u, int tid) {
    const int lane = tid & 63, wave = tid >> 6;
    LAS f32x2* L = (LAS f32x2*)lds; LAS float* red = (LAS float*)(lds + LDS_MISC + 1024);
    const bf16_t* KTD = (const bf16_t*)(a.ws + A_KTD); __half2* KF = (__half2*)(a.ws + A_KF);
    {
        int tl = tid; asm volatile("" : "+v"(tl));
        const bf16_t* rowF = KTD + (size_t)u * 8192; const bf16_t* rowB = KTD + (size_t)(2048 + u) * 8192;
        hy::cf v[32]; float ss = 0.f;
#pragma unroll
        for (int n1 = 0; n1 < 32; ++n1) { const int p = tl + 512 * n1; float val;
            if (n1 < 16) val = bf2f(rowF[p]); else if (p == 8192) val = 0.f; else val = bf2f(rowB[16384 - p]);
            v[n1] = (hy::cf){val, 0.f}; ss += val * val; }
        ss = wave_sum(ss); if (lane == 0) red[wave] = ss; __syncthreads();
        float tot = 0.f;
#pragma unroll
        for (int w = 0; w < 8; ++w) tot += red[w];
        const float scale = rsqrtf(tot), skp = a.in[12][u];
        hy::fft_fwd12(v, L, tl);
#pragma unroll
        for (int bf = 0; bf < 2; ++bf) { const int idx = bf * 512 + tl, k1 = idx >> 5, j1 = idx & 31; hy::cf w[16];
#pragma unroll
            for (int m2 = 0; m2 < 16; ++m2) w[m2] = hy::lld(L, k1 * hy::RS + 33 * m2 + j1);
            hy::dft_reg<16, false>(w);
#pragma unroll
            for (int j2 = 0; j2 < 16; ++j2) { const hy::cf x = w[hy::brev(j2, 4)]; KF[((size_t)((blockIdx.x * 2 + (u >> 10)) * 2 + bf) * 16 + j2) * 512 + tl] = __floats2half2_rn(x.x * scale + skp, x.y * scale); } }
        __syncthreads();
    }
}
__device__ __forceinline__ float hyconv(const bf16_t* row, int t, float w0, float w1, float w2, float bias) {
    const bf16_t* p = row + t;
    float xm = bf2f(p[-1]), x0 = bf2f(p[0]), xp = bf2f(p[1]);
    xm = t > 0 ? xm : 0.f; xp = t < SEQ - 1 ? xp : 0.f;
    return w0 * xm + w1 * x0 + w2 * xp + bias;
}
__device__ __forceinline__ bf16x8 pack8(const float (&v)[8]) { return __builtin_bit_cast(bf16x8, (u32x4){cvt_pk_bf16(v[0], v[1]), cvt_pk_bf16(v[2], v[3]), cvt_pk_bf16(v[4], v[5]), cvt_pk_bf16(v[6], v[7])}); }
__device__ __forceinline__ void phase_hyena_mixer(KArgs a, LAS unsigned char* lds) {
    const int tid = opaque_tid(), lane = tid & 63, wave = __builtin_amdgcn_readfirstlane(tid >> 6), j = lane & 31, hi = lane >> 5, G = gridDim.x;
    LAS unsigned char* L = lds; LAS float* red = (LAS float*)(lds + LDS_MISC + 1024);
    const bf16_t* UHT = (const bf16_t*)(a.ws + A_UHT); const bf16_t* KTD = (const bf16_t*)(a.ws + A_KTD); bf16_t* YHT = (bf16_t*)(a.ws + A_YHT);
    __half2* KF = (__half2*)(a.ws + A_KF) + (size_t)blockIdx.x * (2 * 32 * 8 * 64);
    const float2* TW1 = (const float2*)(a.ws + WS_TW1); const float2* TW2 = (const float2*)(a.ws + WS_TW2);
    const float* cw = a.in[2]; const float* cb = a.in[3];
    hm::build_ftab(lds + hm::LDS_FTAB, tid); const hm::Consts C{lds + hm::LDS_FTAB, lane};
    for (int c = blockIdx.x; c < HY_CH; c += G) {
        int jl = j, hil = hi, wl = wave; asm volatile("" : "+v"(jl), "+v"(hil), "+s"(wl));
#ifndef HM_NOFILTER
#pragma unroll 1
        for (int o = 0; o < 2; ++o) { const int u = o * 1024 + c;
            const bf16_t* rowF = KTD + (size_t)u * 8192; const bf16_t* rowB = KTD + (size_t)(2048 + u) * 8192;
            bf16x8 Bre[2][2], Bim[2][2]; float ss = 0.f;
#pragma unroll
            for (int tl = 0; tl < 2; ++tl)
#pragma unroll
                for (int ks = 0; ks < 2; ++ks) { float v[8];
#pragma unroll
                    for (int t = 0; t < 8; ++t) { const int p = 64 * wl + 32 * tl + jl + 512 * (16 * ks + 8 * hil + t);
                        if (ks == 0) v[t] = bf2f(rowF[p]); else { const float x = bf2f(rowB[16384 - p]); v[t] = (p == 8192) ? 0.f : x; }
                        ss += v[t] * v[t]; }
                    Bre[tl][ks] = pack8(v); Bim[tl][ks] = (bf16x8){0, 0, 0, 0, 0, 0, 0, 0}; asm volatile("" ::: "memory"); }
            ss = wave_sum(ss); if (lane == 0) red[wave] = ss; __syncthreads();
            float tot = 0.f;
#pragma unroll
            for (int w = 0; w < 8; ++w) tot += red[w];
            const float scale = rsqrtf(tot), skp = a.in[12][u];
            hm::fwd12<2>(C, Bre, Bim, L, TW1, TW2, wl, jl, hil);
#pragma unroll
            for (int q = 0; q < 4; ++q) { const int t3 = 4 * wl + q, colp = 32 * t3 + jl; f32x16 dr = {}, di = {};
                hm::cmfma<false>(dr, di, C.get(2), *(const LAS bf16x8*)(L + (colp * hm::ROWB + 8 * hil) * 2), *(const LAS bf16x8*)(L + hm::PL_B + (colp * hm::ROWB + 8 * hil) * 2));
#pragma unroll
                for (int r = 0; r < 8; ++r) KF[((o * 32 + t3) * 8 + r) * 64 + lane] = __floats2half2_rn(dr[r] * scale + skp, di[r] * scale); asm volatile("" ::: "memory"); }
            __syncthreads();
        }
#endif
        VM_WAIT();
#ifndef HM_NOMIXER
        bf16x8 Zre[2][1], Zim[2][1];
        { const bf16_t* r0 = UHT + (size_t)c * NTOK; const float w0 = cw[c], w1 = cw[3072 + c], w2 = cw[6144 + c], bb = cb[c];
#pragma unroll
          for (int tl = 0; tl < 2; ++tl) { float v0[8], v1[8];
#pragma unroll
              for (int t = 0; t < 8; ++t) { const int tt = 64 * wl + 32 * tl + jl + 512 * (8 * hil + t); v0[t] = hyconv(r0, tt, w0, w1, w2, bb); v1[t] = hyconv(r0 + SEQ, tt, w0, w1, w2, bb); }
              Zre[tl][0] = pack8(v0); Zim[tl][0] = pack8(v1); asm volatile("" ::: "memory"); } }
#pragma unroll 1
        for (int o = 0; o < 2; ++o) {
            hm::fwd12<1>(C, Zre, Zim, L, TW1, TW2, wl, jl, hil);
            int j3 = jl, h3 = hil; asm volatile("" : "+v"(j3), "+v"(h3));
            bf16x8 zre[4], zim[4];
#pragma unroll
            for (int q = 0; q < 4; ++q) { const int colp = 32 * (4 * wl + q) + j3; zre[q] = *(const LAS bf16x8*)(L + (colp * hm::ROWB + 8 * h3) * 2); zim[q] = *(const LAS bf16x8*)(L + hm::PL_B + (colp * hm::ROWB + 8 * h3) * 2); }
            __syncthreads();
            asm volatile("" : "+v"(j3), "+v"(h3));
#pragma unroll
            for (int q = 0; q < 4; ++q) { const int t3 = 4 * wl + q; f32x16 dr = {}, di = {};
                hm::cmfma<false>(dr, di, C.get(2), zre[q], zim[q]);
                float xr[8], xi[8];
#pragma unroll
                for (int r = 0; r < 8; ++r) { const float2 kf = __half22float2(KF[((o * 32 + t3) * 8 + r) * 64 + lane]); const hm::cf x = hm::cmul((hm::cf){dr[r], di[r]}, (hm::cf){kf.x, kf.y}); xr[r] = x.x; xi[r] = x.y; }
                const bf16x8 br = hm::pk4(xr), bi = hm::pk4(xi);
                f32x16 er = {}, ei = {};
                hm::cmfma<true>(er, ei, C.get(2), br, bi);
#pragma unroll
                for (int r = 0; r < 8; ++r) { const int m2 = hm::crow(r, h3); const float2 t = TW2[j3 * 16 + m2]; hm::st2(L, hm::PL_A, (t3 * 16 + m2) * hm::ROWA + j3, hm::cmulc((hm::cf){er[r], ei[r]}, (hm::cf){t.x, t.y})); } asm volatile("" ::: "memory"); }
            __syncthreads();
            hm::cf y[2][8];
            hm::inv21(C, y, L, TW1, wl, jl, hil);
            const int gch = (o + 1) * 1024 + c; const bf16_t* rg = UHT + (size_t)gch * NTOK;
            const float w0 = cw[gch], w1 = cw[3072 + gch], w2 = cw[6144 + gch], bb = cb[gch];
            int jg = jl, hg = hil; asm volatile("" : "+v"(jg), "+v"(hg));
#pragma unroll
            for (int tl = 0; tl < 2; ++tl) { float z0[8], z1[8];
#pragma unroll
                for (int r = 0; r < 8; ++r) { const int tt = 64 * wl + 32 * tl + jg + 512 * hm::crow(r, hg);
                    z0[r] = hyconv(rg, tt, w0, w1, w2, bb) * y[tl][r].x * (1.0f / 16384.0f); z1[r] = hyconv(rg + SEQ, tt, w0, w1, w2, bb) * y[tl][r].y * (1.0f / 16384.0f); }
                asm volatile("" ::: "memory");
                if (o == 0) { Zre[tl][0] = hm::pk4(z0); Zim[tl][0] = hm::pk4(z1); }
                else { bf16_t* yo = YHT + (size_t)c * NTOK;
#pragma unroll
                    for (int r = 0; r < 8; ++r) { const int tt = 64 * wl + 32 * tl + jg + 512 * hm::crow(r, hg); yo[tt] = (bf16_t)f2bf(z0[r]); yo[SEQ + tt] = (bf16_t)f2bf(z1[r]); } } }
        }
#endif
    }
    __syncthreads();
}
__device__ __forceinline__ void phase_qknorm(KArgs a, LAS unsigned char* lds) {
    const int tid = opaque_tid(), lane = tid & 63, wave = tid >> 6, gw = blockIdx.x * 8 + wave, NGW = gridDim.x * 8;
    LAS unsigned* red = (LAS unsigned*)(lds + LDS_MISC + 1536);
    unsigned* ctl = (unsigned*)(a.ws + WS_CTL);
    if (tid < 64) red[tid] = 0u;
    __syncthreads();
    for (int which = 0; which < 2; ++which) { const bf16_t* P = (const bf16_t*)(a.ws + (which ? A_KB : A_QB));
        for (int b = 0; b < 2; ++b) { float mx = 0.f;
            for (int row = gw; row < SEQ; row += NGW) { const bf16_t* p = P + ((size_t)b * SEQ + row) * 1024 + lane * 16;
                const u32x4 w0 = *(const u32x4*)p, w1 = *(const u32x4*)(p + 8); const unsigned ww[8] = {w0.x, w0.y, w0.z, w0.w, w1.x, w1.y, w1.z, w1.w};
                float ss = 0.f;
#pragma unroll
                for (int i = 0; i < 8; ++i) { const float x = bflo(ww[i]), y = bfhi(ww[i]); ss += x * x + y * y; }
                ss += __shfl_xor(ss, 1); ss += __shfl_xor(ss, 2); mx = fmaxf(mx, ss); }
            if ((lane & 3) == 0) atomicMax((unsigned*)&red[which * 32 + b * 16 + (lane >> 2)], __float_as_uint(mx)); } }
    __syncthreads();
    if (tid < 64) atomicMax(ctl + CW_NORM + tid, red[tid]);
}
__device__ __forceinline__ void phase_attention(KArgs a, LAS unsigned char* lds) {
    const int G = gridDim.x, bx = blockIdx.x;
    const bf16_t* QB = (const bf16_t*)(a.ws + A_QB); const bf16_t* KB = (const bf16_t*)(a.ws + A_KB); const bf16_t* VB = (const bf16_t*)(a.ws + A_VB); bf16_t* OA = (bf16_t*)(a.ws + A_OA);
    const unsigned* nrm = (const unsigned*)(a.ws + WS_CTL) + CW_NORM;
    for (int i = 0;; ++i) {
        int bhc, qb;
        if (G == 256) { if (i >= 4) break;
            const int x = bx & 7, combo = x & 3, hh = (x < 4) ? ((i == 0) ? 7 : (i == 1) ? 5 : (i == 2) ? 1 : 0) : ((i == 0) ? 6 : (i == 1) ? 4 : (i == 2) ? 3 : 2); bhc = (combo >> 1) * 16 + hh * 2 + (combo & 1); qb = bx >> 3; }
        else { const int Lu = i * G + bx; if (Lu >= 1024) break; bhc = Lu >> 5; qb = Lu & 31; }
        const int b = bhc >> 4, h = (bhc >> 1) & 7, cm = bhc & 1;
        const size_t rowq = (size_t)b * SEQ + (size_t)qb * 256;
        const float sl2 = exp2f(-(float)(h + 1)) * 1.4426950408889634f;
        const float qk = sqrtf(__uint_as_float(nrm[bhc]) * __uint_as_float(nrm[32 + bhc]));
        const float Wk = (2.0f * qk + 38.0f) / sl2, q0f = (float)(qb * 256);
        int t_lo = (int)fmaxf(floorf((q0f - Wk - 63.0f) * (1.0f / 64.0f)), 0.0f), t_hi = (int)fminf(ceilf((q0f + 255.0f + Wk) * (1.0f / 64.0f)), 127.0f);
        if (((t_hi - t_lo + 1) & 1) != 0) { if (t_hi < 127) ++t_hi; else --t_lo; }
        att::attn_unit(QB + rowq * 1024 + h * 128 + cm * 64, KB + (size_t)b * SEQ * 1024 + h * 128 + cm * 64, VB + (size_t)b * SEQ * 1024 + h * 128,
                       OA + (size_t)cm * NTOK * 1024 + rowq * 1024 + h * 128, qb * 256, t_lo, t_hi - t_lo + 1, sl2, (char*)lds);
    }
}
__device__ __forceinline__ void phase_concat(KArgs a, LAS unsigned char* lds) {
    const int tid = opaque_tid(), lane = tid & 63, wave = tid >> 6, G = gridDim.x;
    const bf16_t* YHT = (const bf16_t*)(a.ws + A_YHT); const bf16_t* OA0 = (const bf16_t*)(a.ws + A_OA); const bf16_t* OA1 = OA0 + (size_t)NTOK * 1024; bf16_t* YC = (bf16_t*)(a.ws + A_YCAT);
    LAS bf16_t* T = (LAS bf16_t*)lds;
    const float lambda_init = 0.2f;
    const float lam = __expf(wave_sum(a.in[13][lane] * a.in[14][lane])) - __expf(wave_sum(a.in[15][lane] * a.in[16][lane])) + lambda_init;
    float gl[16];
#pragma unroll
    for (int i = 0; i < 16; ++i) gl[i] = a.in[17][(lane & 7) * 16 + i] * (1.0f - lambda_init);
    for (int it = blockIdx.x; it < NTOK / 64; it += G) {
        const int tok0 = it * 64;
#pragma unroll 4
        for (int k = 0; k < 16; ++k) { const int idx = tid + 512 * k, c = idx >> 3, ch = idx & 7;
            const u32x4 w = *(const u32x4*)(YHT + (size_t)c * NTOK + tok0 + ch * 8);
            LAS bf16_t* d = T + (ch * 8) * 1026 + c;
            d[0 * 1026] = (bf16_t)(w.x & 0xffff); d[1 * 1026] = (bf16_t)(w.x >> 16); d[2 * 1026] = (bf16_t)(w.y & 0xffff); d[3 * 1026] = (bf16_t)(w.y >> 16);
            d[4 * 1026] = (bf16_t)(w.z & 0xffff); d[5 * 1026] = (bf16_t)(w.z >> 16); d[6 * 1026] = (bf16_t)(w.w & 0xffff); d[7 * 1026] = (bf16_t)(w.w >> 16); }
        __syncthreads();
#pragma unroll 4
        for (int k = 0; k < 16; ++k) { const int idx = tid + 512 * k, tl = idx >> 7, c8 = idx & 127;
            const LAS unsigned* s = (const LAS unsigned*)(T + tl * 1026 + c8 * 8);
            u32x4 w; w.x = s[0]; w.y = s[1]; w.z = s[2]; w.w = s[3];
            if (FP8_P5) { u32x2 q; q.x = pg8::pk4_fp8(bflo(w.x), bfhi(w.x), bflo(w.y), bfhi(w.y)); q.y = pg8::pk4_fp8(bflo(w.z), bfhi(w.z), bflo(w.w), bfhi(w.w)); *(u32x2*)((unsigned char*)YC + (size_t)(tok0 + tl) * DM + c8 * 8) = q; }
            else *(u32x4*)(YC + (size_t)(tok0 + tl) * DM + c8 * 8) = w; }
        for (int rr = 0; rr < 8; ++rr) { const size_t tok = (size_t)tok0 + wave * 8 + rr;
            const u32x4 p0 = *(const u32x4*)(OA0 + tok * 1024 + lane * 16), p1 = *(const u32x4*)(OA0 + tok * 1024 + lane * 16 + 8);
            const u32x4 q0 = *(const u32x4*)(OA1 + tok * 1024 + lane * 16), q1 = *(const u32x4*)(OA1 + tok * 1024 + lane * 16 + 8);
            const unsigned pw[8] = {p0.x, p0.y, p0.z, p0.w, p1.x, p1.y, p1.z, p1.w}, qw[8] = {q0.x, q0.y, q0.z, q0.w, q1.x, q1.y, q1.z, q1.w};
            float o[16]; float ss = 0.f;
#pragma unroll
            for (int i = 0; i < 8; ++i) { o[2 * i] = bflo(pw[i]) - lam * bflo(qw[i]); o[2 * i + 1] = bfhi(pw[i]) - lam * bfhi(qw[i]); ss += o[2 * i] * o[2 * i] + o[2 * i + 1] * o[2 * i + 1]; }
            ss += __shfl_xor(ss, 1); ss += __shfl_xor(ss, 2); ss += __shfl_xor(ss, 4);
            const float rs = rsqrtf(ss * (1.0f / 128.0f) + LN_EPS);
            u32x4 w0, w1;
            w0.x = pk2(o[0] * rs * gl[0], o[1] * rs * gl[1]); w0.y = pk2(o[2] * rs * gl[2], o[3] * rs * gl[3]); w0.z = pk2(o[4] * rs * gl[4], o[5] * rs * gl[5]); w0.w = pk2(o[6] * rs * gl[6], o[7] * rs * gl[7]);
            w1.x = pk2(o[8] * rs * gl[8], o[9] * rs * gl[9]); w1.y = pk2(o[10] * rs * gl[10], o[11] * rs * gl[11]); w1.z = pk2(o[12] * rs * gl[12], o[13] * rs * gl[13]); w1.w = pk2(o[14] * rs * gl[14], o[15] * rs * gl[15]);
            if (FP8_P5) { u32x4 q; q.x = pg8::pk4_fp8(o[0] * rs * gl[0], o[1] * rs * gl[1], o[2] * rs * gl[2], o[3] * rs * gl[3]); q.y = pg8::pk4_fp8(o[4] * rs * gl[4], o[5] * rs * gl[5], o[6] * rs * gl[6], o[7] * rs * gl[7]);
                q.z = pg8::pk4_fp8(o[8] * rs * gl[8], o[9] * rs * gl[9], o[10] * rs * gl[10], o[11] * rs * gl[11]); q.w = pg8::pk4_fp8(o[12] * rs * gl[12], o[13] * rs * gl[13], o[14] * rs * gl[14], o[15] * rs * gl[15]);
                *(u32x4*)((unsigned char*)YC + tok * DM + 1024 + lane * 16) = q; }
            else { *(u32x4*)(YC + tok * DM + 1024 + lane * 16) = w0; *(u32x4*)(YC + tok * DM + 1024 + lane * 16 + 8) = w1; } }
        __syncthreads();
    }
}
__device__ __forceinline__ void ln_row(f32x4 (&v)[8], const float* g, const float* b, int lane, float& mu, float& rs) {
    float s = 0.f;
#pragma unroll
    for (int j = 0; j < 8; ++j) s += (v[j][0] + v[j][1]) + (v[j][2] + v[j][3]);
    const float mean = wave_sum(s) * (1.0f / DM); float s2 = 0.f;
#pragma unroll
    for (int j = 0; j < 8; ++j) { v[j] = v[j] - mean; s2 += (v[j][0] * v[j][0] + v[j][1] * v[j][1]) + (v[j][2] * v[j][2] + v[j][3] * v[j][3]); }
    const float rstd = rsqrtf(wave_sum(s2) * (1.0f / DM) + LN_EPS); mu = mean; rs = rstd;
#pragma unroll
    for (int j = 0; j < 8; ++j) { const f32x4 gg = *(const f32x4*)(g + 4 * (lane + 64 * j)), bb = *(const f32x4*)(b + 4 * (lane + 64 * j)); v[j] = v[j] * rstd * gg + bb; }
}
__device__ __forceinline__ void phase_ln_router(KArgs a, LAS unsigned char* lds, const bf16_t* R, const float* g, const float* b, bf16_t* HB, unsigned char* HB8, unsigned* cnt, int* rowlist, float* gatew) {
    const int tid = opaque_tid(), lane = tid & 63, wave = tid >> 6, G = gridDim.x;
    const float* rw = a.in[32]; const float* rb = a.in[33];
    LAS float* part = (LAS float*)lds;
    LAS int* hist = (LAS int*)(lds + 40960); LAS int* base = hist + 32; LAS float* stats = (LAS float*)(lds + 40960 + 512);
    for (int it = blockIdx.x; it < NTOK / 32; it += G) {
        const int tok0 = it * 32;
        for (int rr = 0; rr < 4; ++rr) { const size_t row = (size_t)tok0 + wave * 4 + rr; f32x4 v[8]; float mu, rs;
#pragma unroll
            for (int j = 0; j < 8; ++j) { const u32x2 w = *(const u32x2*)(R + row * DM + 4 * (lane + 64 * j)); v[j] = (f32x4){bflo(w.x), bfhi(w.x), bflo(w.y), bfhi(w.y)}; }
            ln_row(v, g, b, lane, mu, rs);
            if (lane == 0) { stats[(wave * 4 + rr) * 2] = mu; stats[(wave * 4 + rr) * 2 + 1] = rs; }
#pragma unroll
            for (int j = 0; j < 8; ++j) { u32x2 w; w.x = pk2(v[j][0], v[j][1]); w.y = pk2(v[j][2], v[j][3]); *(u32x2*)(HB + row * DM + 4 * (lane + 64 * j)) = w;
                if (HB8) *(unsigned*)(HB8 + row * DM + 4 * (lane + 64 * j)) = pg8::pk4_fp8(v[j][0], v[j][1], v[j][2], v[j][3]); } }
        if (tid < 32) hist[tid] = 0;
        __syncthreads();
        { const int i = lane & 31, kk = lane >> 5; f32x16 acc = {};
          const float mu = stats[i * 2], rs = stats[i * 2 + 1];
          const bf16_t* rrow = R + (size_t)(tok0 + i) * DM + wave * 256 + 4 * kk; const float* gp = g + wave * 256 + 4 * kk; const float* bp = b + wave * 256 + 4 * kk;
          const float* rwp = rw + (size_t)(wave * 256 + 4 * kk) * NEXP + i;
#pragma unroll 4
          for (int s = 0; s < 32; ++s) { const u32x2 rw2 = *(const u32x2*)(rrow + 8 * s); const f32x4 hv = ((f32x4){bflo(rw2.x), bfhi(rw2.x), bflo(rw2.y), bfhi(rw2.y)} - mu) * rs * *(const f32x4*)(gp + 8 * s) + *(const f32x4*)(bp + 8 * s);
#pragma unroll
              for (int j = 0; j < 4; ++j) acc = __builtin_amdgcn_mfma_f32_32x32x2f32(rwp[(size_t)(8 * s + j) * NEXP], hv[j], acc, 0, 0, 0); }
#pragma unroll
          for (int r = 0; r < 16; ++r) part[(wave * 32 + i) * 33 + (r & 3) + 8 * (r >> 2) + 4 * kk] = acc[r]; }
        __syncthreads();
        int e1 = 0, e2 = 0, r1 = 0, r2 = 0; float g1 = 0.f, g2 = 0.f;
        if (tid < 32) {
            float bestg = -1e30f;
#pragma unroll
            for (int gi = 0; gi < 4; ++gi) { float m1 = -1e30f, m2 = -1e30f, s1 = 0.f, s2 = 0.f; int i1 = 0, i2 = 0;
#pragma unroll
                for (int j = 0; j < 8; ++j) { const int e = gi * 8 + j; float lg = 0.f;
#pragma unroll
                    for (int w = 0; w < 8; ++w) lg += part[(w * 32 + tid) * 33 + e];
                    const float sg = 1.0f / (1.0f + expf(-lg)), sl = sg + rb[e];
                    if (sl > m1) { m2 = m1; i2 = i1; s2 = s1; m1 = sl; i1 = j; s1 = sg; } else if (sl > m2) { m2 = sl; i2 = j; s2 = sg; } }
                const float gs = m1 + m2;
                if (gs > bestg) { bestg = gs; e1 = gi * 8 + i1; e2 = gi * 8 + i2; g1 = s1; g2 = s2; } }
            const float inv = 1.0f / (g1 + g2); g1 *= inv; g2 *= inv;
            r1 = atomicAdd((int*)&hist[e1], 1); r2 = atomicAdd((int*)&hist[e2], 1);
        }
        __syncthreads();
        if (tid < 32) { const int hc = hist[tid]; base[tid] = hc ? (int)__hip_atomic_fetch_add(cnt + tid * 64, (unsigned)hc, __ATOMIC_RELAXED, __HIP_MEMORY_SCOPE_AGENT) : 0; }
        __syncthreads();
        if (tid < 32) { const int a0 = (tok0 + tid) * 2;
            rowlist[(size_t)e1 * ECAP + base[e1] + r1] = a0; gatew[a0] = g1;
            rowlist[(size_t)e2 * ECAP + base[e2] + r2] = a0 + 1; gatew[a0 + 1] = g2; }
        __syncthreads();
    }
}
__device__ __forceinline__ void phase_ln2(const bf16_t* HB, const bf16_t* Y2, const float* g, const float* b, float* OUT, bf16_t* OB, unsigned char* OB8) {
    const int tid = opaque_tid(), lane = tid & 63, wave = tid >> 6;
    for (int row = blockIdx.x * 8 + wave; row < NTOK; row += gridDim.x * 8) { f32x4 v[8]; float mu, rs;
#pragma unroll
        for (int j = 0; j < 8; ++j) { const int c = 4 * (lane + 64 * j); const u32x2 h = *(const u32x2*)(HB + (size_t)row * DM + c);
            const u32x2 y0 = *(const u32x2*)(Y2 + (size_t)(2 * row) * DM + c), y1 = *(const u32x2*)(Y2 + (size_t)(2 * row + 1) * DM + c);
            v[j] = (f32x4){bflo(h.x), bfhi(h.x), bflo(h.y), bfhi(h.y)} * DN_ALPHA + (f32x4){bflo(y0.x) + bflo(y1.x), bfhi(y0.x) + bfhi(y1.x), bflo(y0.y) + bflo(y1.y), bfhi(y0.y) + bfhi(y1.y)}; }
        ln_row(v, g, b, lane, mu, rs);
#pragma unroll
        for (int j = 0; j < 8; ++j) { const int c = 4 * (lane + 64 * j); if (OUT) *(f32x4*)(OUT + (size_t)row * DM + c) = v[j];
            if (OB) { u32x2 w; w.x = pk2(v[j][0], v[j][1]); w.y = pk2(v[j][2], v[j][3]); *(u32x2*)(OB + (size_t)row * DM + c) = w; }
            if (OB8) *(unsigned*)(OB8 + (size_t)row * DM + c) = pg8::pk4_fp8(v[j][0], v[j][1], v[j][2], v[j][3]); }
    }
}
__device__ __forceinline__ void moe_table(LAS int* tab, const unsigned* cnt) {
    __syncthreads();
    const int tid = opaque_tid();
    if (tid < 32) tab[64 + tid] = (int)cnt[tid * 64];
    __syncthreads();
    if (tid == 0) { int acc = 0; for (int e = 0; e < 32; ++e) { tab[e] = acc; acc += (tab[64 + e] + 255) >> 8; } tab[32] = acc; }
    __syncthreads();
}
__device__ __forceinline__ void phase_conv4(KArgs a) {
    const bf16_t* XR = (const bf16_t*)(a.ws + A_XR); bf16_t* XC = (bf16_t*)(a.ws + A_XC); const float* cw = a.in[20]; const float* cb = a.in[21];
    const int NT = gridDim.x * 512;
    for (int it = blockIdx.x * 512 + opaque_tid(); it < NTOK * 256; it += NT) { const int tok = it >> 8, ch = (it & 255) * 8, t = tok & (SEQ - 1);
        float acc[8];
#pragma unroll
        for (int i = 0; i < 8; ++i) acc[i] = cb[ch + i];
#pragma unroll
        for (int j = 0; j < 4; ++j) { const int tt = t + j - 2;
            if (tt >= 0 && tt < SEQ) { const u32x4 w = *(const u32x4*)(XR + (size_t)(tok + j - 2) * DM + ch); const unsigned ww[4] = {w.x, w.y, w.z, w.w};
#pragma unroll
                for (int i = 0; i < 4; ++i) { acc[2 * i] += cw[j * DM + ch + 2 * i] * bflo(ww[i]); acc[2 * i + 1] += cw[j * DM + ch + 2 * i + 1] * bfhi(ww[i]); } } }
        u32x4 o; o.x = pk2(acc[0], acc[1]); o.y = pk2(acc[2], acc[3]); o.z = pk2(acc[4], acc[5]); o.w = pk2(acc[6], acc[7]);
        *(u32x4*)(XC + (size_t)tok * DM + ch) = o; }
}
constexpr size_t CAR_ELEMS = (size_t)2 * 2 * 256 * DM;
__device__ __forceinline__ void phase_scan1(KArgs a) {
    const bf16_t* LA = (const bf16_t*)(a.ws + A_LA); const bf16_t* BB = (const bf16_t*)(a.ws + A_BB); float* CARA = (float*)(a.ws + A_CAR); float* CARB = CARA + CAR_ELEMS;
    const int NT = gridDim.x * 512;
    for (int it = blockIdx.x * 512 + opaque_tid(); it < 2 * 2 * 256 * 512; it += NT) { const int ch = (it & 511) * 4, chunk = (it >> 9) & 255, dir = (it >> 17) & 1, b = it >> 18;
        float h[4] = {0.f, 0.f, 0.f, 0.f}, ls[4] = {0.f, 0.f, 0.f, 0.f};
#pragma unroll 8
        for (int s = 0; s < 32; ++s) { const int t = chunk * 32 + (dir ? 31 - s : s); const size_t off = ((size_t)dir * NTOK + (size_t)b * SEQ + t) * DM + ch;
            const u32x2 lw = *(const u32x2*)(LA + off), bw = *(const u32x2*)(BB + off);
            const float l4[4] = {bflo(lw.x), bfhi(lw.x), bflo(lw.y), bfhi(lw.y)}, b4[4] = {bflo(bw.x), bfhi(bw.x), bflo(bw.y), bfhi(bw.y)};
#pragma unroll
            for (int i = 0; i < 4; ++i) { h[i] = __expf(l4[i]) * h[i] + b4[i]; ls[i] += l4[i]; } }
        const size_t co = (((size_t)b * 2 + dir) * 256 + chunk) * DM + ch;
        *(f32x4*)(CARA + co) = (f32x4){ls[0], ls[1], ls[2], ls[3]}; *(f32x4*)(CARB + co) = (f32x4){h[0], h[1], h[2], h[3]}; }
}
__device__ __forceinline__ void phase_scan2(KArgs a, LAS unsigned char* lds) {
    float* CARA = (float*)(a.ws + A_CAR); float* CARB = CARA + CAR_ELEMS; float* CARIN = CARB + CAR_ELEMS;
    const int tid = opaque_tid(), grp = tid >> 5, chl = tid & 31;
    LAS float* sh = (LAS float*)lds;
    for (int it = blockIdx.x; it < 2 * 2 * 64; it += gridDim.x) { const int ch = (it & 63) * 32 + chl, dir = (it >> 6) & 1, b = it >> 7;
        float la[16], lb[16]; float A = 0.f, B = 0.f;
#pragma unroll
        for (int k = 0; k < 16; ++k) { const int q = grp * 16 + k, chunk = dir ? 255 - q : q; const size_t co = (((size_t)b * 2 + dir) * 256 + chunk) * DM + ch; la[k] = CARA[co]; lb[k] = CARB[co]; }
#pragma unroll
        for (int k = 0; k < 16; ++k) { B = __expf(la[k]) * B + lb[k]; A += la[k]; }
        sh[(grp * 32 + chl) * 2] = A; sh[(grp * 32 + chl) * 2 + 1] = B;
        __syncthreads();
        float h = 0.f;
        for (int g2 = 0; g2 < grp; ++g2) h = __expf(sh[(g2 * 32 + chl) * 2]) * h + sh[(g2 * 32 + chl) * 2 + 1];
#pragma unroll
        for (int k = 0; k < 16; ++k) { const int q = grp * 16 + k, chunk = dir ? 255 - q : q; const size_t co = (((size_t)b * 2 + dir) * 256 + chunk) * DM + ch; CARIN[co] = h; h = __expf(la[k]) * h + lb[k]; }
        __syncthreads();
    }
}
__device__ __forceinline__ float gelu_tanh(float x) { const float u = 0.7978845608028654f * (x + 0.044715f * x * x * x); const float th = 1.0f - 2.0f * __builtin_amdgcn_rcpf(1.0f + __builtin_amdgcn_exp2f(2.8853900817779268f * u)); return 0.5f * x * (1.0f + th); }
__device__ __forceinline__ void phase_scan3(KArgs a) {
    const bf16_t* LA = (const bf16_t*)(a.ws + A_LA); const bf16_t* BB = (const bf16_t*)(a.ws + A_BB); const bf16_t* GB = (const bf16_t*)(a.ws + A_GB); bf16_t* YG = (bf16_t*)(a.ws + A_YG);
    const float* CARIN = (const float*)(a.ws + A_CAR) + 2 * CAR_ELEMS;
    const int NT = gridDim.x * 512;
    for (int it = blockIdx.x * 512 + opaque_tid(); it < 2 * 256 * 512; it += NT) { const int ch = (it & 511) * 4, chunk = (it >> 9) & 255, b = it >> 17;
        float hf[32][4]; float h[4];
        { const f32x4 c = *(const f32x4*)(CARIN + (((size_t)b * 2 + 0) * 256 + chunk) * DM + ch); h[0] = c[0]; h[1] = c[1]; h[2] = c[2]; h[3] = c[3]; }
#pragma unroll
        for (int s = 0; s < 32; ++s) { const size_t off = ((size_t)b * SEQ + chunk * 32 + s) * DM + ch;
            const u32x2 lw = *(const u32x2*)(LA + off), bw = *(const u32x2*)(BB + off);
            const float l4[4] = {bflo(lw.x), bfhi(lw.x), bflo(lw.y), bfhi(lw.y)}, b4[4] = {bflo(bw.x), bfhi(bw.x), bflo(bw.y), bfhi(bw.y)};
#pragma unroll
            for (int i = 0; i < 4; ++i) { h[i] = __expf(l4[i]) * h[i] + b4[i]; hf[s][i] = h[i]; } }
        { const f32x4 c = *(const f32x4*)(CARIN + (((size_t)b * 2 + 1) * 256 + chunk) * DM + ch); h[0] = c[0]; h[1] = c[1]; h[2] = c[2]; h[3] = c[3]; }
#pragma unroll
        for (int s = 31; s >= 0; --s) { const size_t tokoff = ((size_t)b * SEQ + chunk * 32 + s) * DM + ch; const size_t off = (size_t)NTOK * DM + tokoff;
            const u32x2 lw = *(const u32x2*)(LA + off), bw = *(const u32x2*)(BB + off), gw = *(const u32x2*)(GB + tokoff);
            const float l4[4] = {bflo(lw.x), bfhi(lw.x), bflo(lw.y), bfhi(lw.y)}, b4[4] = {bflo(bw.x), bfhi(bw.x), bflo(bw.y), bfhi(bw.y)}, g4[4] = {bflo(gw.x), bfhi(gw.x), bflo(gw.y), bfhi(gw.y)};
            float y[4];
#pragma unroll
            for (int i = 0; i < 4; ++i) { h[i] = __expf(l4[i]) * h[i] + b4[i]; y[i] = gelu_tanh(g4[i]) * (hf[s][i] + h[i]); }
            if (FP8_P16) { *(unsigned*)((unsigned char*)YG + tokoff) = pg8::pk4_fp8(4.0f * y[0], 4.0f * y[1], 4.0f * y[2], 4.0f * y[3]); }
            else { u32x2 w; w.x = pk2(y[0], y[1]); w.y = pk2(y[2], y[3]); *(u32x2*)(YG + tokoff) = w; } } }
}

#define KARGS() (*(const __attribute__((address_space(4))) Args*)__builtin_amdgcn_kernarg_segment_ptr())
#define PHASE_FN __device__ __forceinline__ void
#define PH_PRE() KArgs a = KARGS(); LAS unsigned char* lds = (LAS unsigned char*)lds_raw; unsigned char* ws = a.ws; asm volatile("" : "+s"(ws)); const int G = gridDim.x, bx = blockIdx.x; (void)lds; (void)ws; (void)G; (void)bx; using namespace pg8
PHASE_FN ph0() { PH_PRE(); phase_prologue(a, lds); }
PHASE_FN ph1a() { PH_PRE(); Gemm g{(const bf16_t*)(ws + A_W4T), (const bf16_t*)(ws + A_H3B), 128, 128, 128}; StaticOrder S; S.init(4096, 8192, G, bx); EpiFilt E{(bf16_t*)(ws + A_KTD)}; gemm_phase(lds, g, S, E); }
PHASE_FN ph1b() { PH_PRE(); StaticOrder S; S.init(NTOK, 3072, G, bx);
    if constexpr (FP8_P1B) { Gemm g{(const bf16_t*)(ws + A_XB8), (const bf16_t*)(ws + WS_WIN_EV8 + (size_t)3072 * DM), DM / 2, DM / 2, DM / 2};
        EpiBf16 E{(bf16_t*)(ws + A_QB), 1024, 1024, (size_t)(A_KB - A_QB) / 2, QSCALE, 1.0f / FP8_SW}; gemm_phase<EpiBf16, StaticOrder, true>(lds, g, S, E); }
    else { Gemm g{(const bf16_t*)(ws + A_XB), (const bf16_t*)(ws + WS_WIN_EV) + (size_t)3072 * DM, DM, DM, DM};
        EpiBf16 E{(bf16_t*)(ws + A_QB), 1024, 1024, (size_t)(A_KB - A_QB) / 2, QSCALE}; gemm_phase(lds, g, S, E); } }
PHASE_FN ph1c() { PH_PRE(); StaticOrder S; S.init(3072, NTOK, G, bx);
    if constexpr (FP8_P1C) { Gemm g{(const bf16_t*)(ws + WS_WIN_EV8), (const bf16_t*)(ws + A_XB8), DM / 2, DM / 2, DM / 2};
        EpiBf16 E{(bf16_t*)(ws + A_UHT), NTOK, 0, 0, 1.f, 1.0f / FP8_SW}; gemm_phase<EpiBf16, StaticOrder, true>(lds, g, S, E); }
    else { Gemm g{(const bf16_t*)(ws + WS_WIN_EV), (const bf16_t*)(ws + A_XB), DM, DM, DM};
        EpiBf16 E{(bf16_t*)(ws + A_UHT), NTOK, 0, 0, 1.f}; gemm_phase(lds, g, S, E); } }
PHASE_FN ph2() { PH_PRE(); phase_qknorm(a, lds); }
PHASE_FN ph3a() { PH_PRE(); phase_hyena_mixer(a, lds); }
PHASE_FN ph3b() { PH_PRE(); phase_attention(a, lds); }
PHASE_FN ph4() { PH_PRE(); phase_concat(a, lds); }
PHASE_FN ph5() { PH_PRE(); StaticOrder S; S.init(NTOK, DM, G, bx);
    if constexpr (FP8_P5) { Gemm g{(const bf16_t*)(ws + A_YCAT), (const bf16_t*)(ws + WS_WOUT_EV), DM / 2, DM / 2, DM / 2};
        EpiResBf E{(const bf16_t*)(ws + A_XB2), (bf16_t*)(ws + A_R0), DM, DN_ALPHA, 1.0f / FP8_SW}; gemm_phase<EpiResBf, StaticOrder, true>(lds, g, S, E); }
    else { Gemm g{(const bf16_t*)(ws + A_YCAT), (const bf16_t*)(ws + WS_WOUT_EV), DM, DM, DM};
        EpiResBf E{(const bf16_t*)(ws + A_XB2), (bf16_t*)(ws + A_R0), DM, DN_ALPHA}; gemm_phase(lds, g, S, E); } }
template <int LAYER> PHASE_FN ph_lnr() { PH_PRE(); unsigned* ctl = (unsigned*)(ws + WS_CTL);
    phase_ln_router(a, lds, (const bf16_t*)(ws + (LAYER ? A_R1 : A_R0)), a.in[28] + LAYER * DM, a.in[29] + LAYER * DM, (bf16_t*)(ws + (LAYER ? A_HB_1 : A_HB_0)), (LAYER >= 2 - MOE_FP8_LAYERS) ? ws + (LAYER ? A_HB8_1 : A_HB8_0) : nullptr,
                    ctl + CW_CNT + LAYER * 32 * 64, (int*)(ws + A_ROWL), (float*)(ws + A_GATEW)); }
template <int LAYER> PHASE_FN ph_moe1() { PH_PRE(); LAS int* tab = (LAS int*)(lds + LDS_MISC); moe_table(tab, (const unsigned*)(ws + WS_CTL) + CW_CNT + LAYER * 32 * 64);
    MoeOrder<4, true> S{G, bx, tab, (const int*)(ws + A_ROWL)};
    if constexpr (LAYER >= 2 - MOE_FP8_LAYERS) {
        Gemm g{(const bf16_t*)(ws + (LAYER ? A_HB8_1 : A_HB8_0)), (const bf16_t*)(ws + WS_W1T + (size_t)LAYER * 32 * 1024 * DM * 2), DM / 2, DM / 2, DM / 2};
        EpiSwiglu8 E{ws + (LAYER ? A_HID_1 : A_HID_0)}; gemm_phase<EpiSwiglu8, MoeOrder<4, true>, true>(lds, g, S, E);
    } else {
        Gemm g{(const bf16_t*)(ws + (LAYER ? A_HB_1 : A_HB_0)), (const bf16_t*)(ws + WS_W1T) + (size_t)LAYER * 32 * 1024 * DM, DM, DM, DM};
        EpiSwiglu E{(bf16_t*)(ws + (LAYER ? A_HID_1 : A_HID_0))}; gemm_phase(lds, g, S, E); } }
template <int LAYER> PHASE_FN ph_moe2() { PH_PRE(); LAS int* tab = (LAS int*)(lds + LDS_MISC); moe_table(tab, (const unsigned*)(ws + WS_CTL) + CW_CNT + LAYER * 32 * 64);
    MoeOrder<8, false> S{G, bx, tab, (const int*)(ws + A_ROWL)};
    if constexpr (LAYER >= 2 - MOE_FP8_LAYERS) {
        Gemm g{(const bf16_t*)(ws + (LAYER ? A_HID_1 : A_HID_0)), (const bf16_t*)(ws + WS_W2T + (size_t)LAYER * 32 * DM * DFF * 2), DFF / 2, DFF / 2, DFF / 2};
        EpiDown E{(bf16_t*)(ws + (LAYER ? A_Y2_1 : A_Y2_0)), (const int*)(ws + A_ROWL), (const float*)(ws + A_GATEW), 1.0f / (FP8_SW * FP8_SH)};
        gemm_phase<EpiDown, MoeOrder<8, false>, true>(lds, g, S, E);
    } else {
        Gemm g{(const bf16_t*)(ws + (LAYER ? A_HID_1 : A_HID_0)), (const bf16_t*)(ws + WS_W2T) + (size_t)LAYER * 32 * DM * DFF, DFF, DFF, DFF};
        EpiDown E{(bf16_t*)(ws + (LAYER ? A_Y2_1 : A_Y2_0)), (const int*)(ws + A_ROWL), (const float*)(ws + A_GATEW), 1.0f}; gemm_phase(lds, g, S, E); } }
template <int LAYER> PHASE_FN ph_ln2() { PH_PRE();
    phase_ln2((const bf16_t*)(ws + (LAYER ? A_HB_1 : A_HB_0)), (const bf16_t*)(ws + (LAYER ? A_Y2_1 : A_Y2_0)), a.in[30] + LAYER * DM, a.in[31] + LAYER * DM, LAYER ? a.out : nullptr, LAYER ? nullptr : (bf16_t*)(ws + A_HB2), (!LAYER && FP8_P10) ? ws + A_HB2_8 : nullptr); }
PHASE_FN ph10() { PH_PRE(); StaticOrder S; S.init(NTOK, 2 * DM, G, bx);
    if constexpr (FP8_P10) { Gemm g{(const bf16_t*)(ws + A_HB2_8), (const bf16_t*)(ws + WS_WIN_OD), DM / 2, DM / 2, DM / 2};
        EpiBf16 E{(bf16_t*)(ws + A_GB), DM, DM, (size_t)(A_XR - A_GB) / 2, 1.f, 1.0f / FP8_SW}; gemm_phase<EpiBf16, StaticOrder, true>(lds, g, S, E); }
    else { Gemm g{(const bf16_t*)(ws + A_HB2), (const bf16_t*)(ws + WS_WIN_OD), DM, DM, DM};
        EpiBf16 E{(bf16_t*)(ws + A_GB), DM, DM, (size_t)(A_XR - A_GB) / 2, 1.f}; gemm_phase(lds, g, S, E); } }
PHASE_FN ph11() { PH_PRE(); phase_conv4(a); }
PHASE_FN ph12() { PH_PRE(); Gemm g{(const bf16_t*)(ws + A_XC), (const bf16_t*)(ws + WS_WG_OD), DM, 256, 256}; RGOrder S{G, bx};
                  EpiRG E{(bf16_t*)(ws + A_LA), (bf16_t*)(ws + A_BB), (const bf16_t*)(ws + A_XC), a.in[23], a.in[25], a.in[26]}; gemm_phase(lds, g, S, E); }
PHASE_FN ph13() { PH_PRE(); phase_scan1(a); }
PHASE_FN ph14() { PH_PRE(); phase_scan2(a, lds); }
PHASE_FN ph15() { PH_PRE(); phase_scan3(a); }
PHASE_FN ph16() { PH_PRE(); StaticOrder S; S.init(NTOK, DM, G, bx);
    if constexpr (FP8_P16) { Gemm g{(const bf16_t*)(ws + A_YG), (const bf16_t*)(ws + WS_WOUT_OD), DM / 2, DM / 2, DM / 2};
        EpiResBf E{(const bf16_t*)(ws + A_HB2), (bf16_t*)(ws + A_R1), DM, DN_ALPHA, 1.0f / (FP8_SW * 4.0f)}; gemm_phase<EpiResBf, StaticOrder, true>(lds, g, S, E); }
    else { Gemm g{(const bf16_t*)(ws + A_YG), (const bf16_t*)(ws + WS_WOUT_OD), DM, DM, DM};
        EpiResBf E{(const bf16_t*)(ws + A_HB2), (bf16_t*)(ws + A_R1), DM, DN_ALPHA}; gemm_phase(lds, g, S, E); } }

__global__ void __launch_bounds__(512, 2) fwd(Args a) {
    LAS unsigned char* lds = (LAS unsigned char*)lds_raw;
    unsigned* ctl = (unsigned*)(a.ws + WS_CTL);
    volatile LAS unsigned* bst = (volatile LAS unsigned*)(lds + LDS_MISC + 2048);
    { const int tid = threadIdx.x;
      if ((tid & 63) == 0) ((LAS int*)(lds + LDS_WIDTAB))[hw_slot()] = tid >> 6;
      if (tid < 4) bst[tid] = 0u; }
    __syncthreads();
    const int lo = a.ph_lo, hi = a.ph_hi;
    XcdBarrier bar; bar.bar = ctl + CW_BAR; bar.x = 0; bar.st = bst;
    if (hi - lo > 1) bar = xcd_barrier_post(ctl + CW_BAR, bst);
#ifdef ONLY_PHASE
#define IN(k) ((k) == ONLY_PHASE && lo <= (k) && (k) < hi)
#else
#define IN(k) (lo <= (k) && (k) < hi)
#endif
#define SEAM(k) do { if (IN(k) && IN((k) + 1)) xcd_barrier(bar); } while (0)
    if (IN(0)) { asm volatile("; PHASE_MARK 0"); ph0(); } SEAM(0);
    if (IN(1)) { asm volatile("; PHASE_MARK 1a"); ph1a(); asm volatile("; PHASE_MARK 1b"); ph1b(); asm volatile("; PHASE_MARK 1c"); ph1c(); } SEAM(1);
    if (IN(2)) { asm volatile("; PHASE_MARK 2"); ph2(); } SEAM(2);
    if (IN(3)) { asm volatile("; PHASE_MARK 3a"); ph3a(); asm volatile("; PHASE_MARK 3b"); ph3b(); } SEAM(3);
    if (IN(4)) { asm volatile("; PHASE_MARK 4"); ph4(); } SEAM(4);
    if (IN(5)) { asm volatile("; PHASE_MARK 5"); ph5(); } SEAM(5);
    if (IN(6)) { asm volatile("; PHASE_MARK 6"); ph_lnr<0>(); } SEAM(6);
    if (IN(7)) { asm volatile("; PHASE_MARK 7"); ph_moe1<0>(); } SEAM(7);
    if (IN(8)) { asm volatile("; PHASE_MARK 8"); ph_moe2<0>(); } SEAM(8);
    if (IN(9)) { asm volatile("; PHASE_MARK 9"); ph_ln2<0>(); } SEAM(9);
    if (IN(10)) { asm volatile("; PHASE_MARK 10"); ph10(); } SEAM(10);
    if (IN(11)) { asm volatile("; PHASE_MARK 11"); ph11(); } SEAM(11);
    if (IN(12)) { asm volatile("; PHASE_MARK 12"); ph12(); } SEAM(12);
    if (IN(13)) { asm volatile("; PHASE_MARK 13"); ph13(); } SEAM(13);
    if (IN(14)) { asm volatile("; PHASE_MARK 14"); ph14(); } SEAM(14);
    if (IN(15)) { asm volatile("; PHASE_MARK 15"); ph15(); } SEAM(15);
    if (IN(16)) { asm volatile("; PHASE_MARK 16"); ph16(); } SEAM(16);
    if (IN(17)) { asm volatile("; PHASE_MARK 17"); ph_lnr<1>(); } SEAM(17);
    if (IN(18)) { asm volatile("; PHASE_MARK 18"); ph_moe1<1>(); } SEAM(18);
    if (IN(19)) { asm volatile("; PHASE_MARK 19"); ph_moe2<1>(); } SEAM(19);
    if (IN(20)) { asm volatile("; PHASE_MARK 20"); ph_ln2<1>(); }
#undef IN
#undef SEAM
}

#ifndef MK_PER_PHASE
#define MK_PER_PHASE 0
#endif
extern "C" void kernel_launch(void* const* d_in, const int* in_sizes, int n_in, void* d_out, int out_size, void* d_ws, size_t ws_size, hipStream_t stream) {
    static int grid = 0;
    if (grid == 0) {
        if (n_in != 37 || out_size != NTOK * DM || ws_size < WS_END) { fprintf(stderr, "kernel_launch: built for 37 inputs, %d outputs, >= %zu bytes of workspace; got n_in %d out %d ws %zu\n", NTOK * DM, (size_t)WS_END, n_in, out_size, ws_size); grid = -1; return; }
        int dev = 0, cus = 0, per_cu = 0;
        if (hipGetDevice(&dev) != hipSuccess || hipDeviceGetAttribute(&cus, hipDeviceAttributeMultiprocessorCount, dev) != hipSuccess) { grid = -1; return; }
        if (hipFuncSetAttribute((const void*)fwd, hipFuncAttributeMaxDynamicSharedMemorySize, LDS_BYTES) != hipSuccess) { fprintf(stderr, "kernel_launch: hipFuncSetAttribute failed\n"); grid = -1; return; }
        if (hipOccupancyMaxActiveBlocksPerMultiprocessor(&per_cu, (const void*)fwd, 512, LDS_BYTES) != hipSuccess || per_cu < 1) fprintf(stderr, "kernel_launch: occupancy query reports %d\n", per_cu);
        (void)hipGetLastError();
        grid = cus;
    }
    if (grid < 0) return;
    (void)hipMemsetAsync((char*)d_ws + WS_CTL, 0, CTL_ZERO_BYTES, stream);
    Args a{};
    for (int i = 0; i < 37; ++i) a.in[i] = (const float*)d_in[i];
    a.out = (float*)d_out; a.ws = (unsigned char*)d_ws;
#if MK_PER_PHASE
    for (int p = 0; p < NPHASE; ++p) { a.ph_lo = p; a.ph_hi = p + 1; hipLaunchKernelGGL(fwd, dim3(grid), dim3(512), LDS_BYTES, stream, a); }
#else
    a.ph_lo = 0; a.ph_hi = NPHASE; hipLaunchKernelGGL(fwd, dim3(grid), dim3(512), LDS_BYTES, stream, a);
#endif
}
```

```cpp
#include <hip/hip_runtime.h>
#include <hip/hip_fp16.h>
#include <cstdio>
#include <cstdint>

#define GAS __attribute__((address_space(1)))
#define LAS __attribute__((address_space(3)))
typedef unsigned short bf16_t;
typedef short bf16x8 __attribute__((ext_vector_type(8)));
typedef short s16x4 __attribute__((ext_vector_type(4)));
typedef float f32x2 __attribute__((ext_vector_type(2)));
typedef float f32x4 __attribute__((ext_vector_type(4)));
typedef float f32x8 __attribute__((ext_vector_type(8)));
typedef float f32x16 __attribute__((ext_vector_type(16)));
typedef unsigned u32x2 __attribute__((ext_vector_type(2)));
typedef unsigned u32x4 __attribute__((ext_vector_type(4)));
typedef GAS unsigned gu32;

constexpr int DM = 2048, BATCH = 2, SEQ = 8192, NTOK = BATCH * SEQ;
constexpr int HY_CH = 1024, EV_IN = 6144;
constexpr int NEXP = 32, DFF = 512, NASSIGN = NTOK * 2, ECAP = NASSIGN;
constexpr float LN_EPS = 1e-5f;
constexpr float DN_ALPHA = 1.4142135623730951f;
constexpr float QSCALE = 0.125f * 1.4426950408889634f;
constexpr int FFT_N = 16384, FFT_RS = 528;

__device__ __forceinline__ unsigned f2bf(float f) { unsigned u = __builtin_bit_cast(unsigned, f); return (u + 0x7fffu + ((u >> 16) & 1u)) >> 16; }
__device__ __forceinline__ unsigned pk2(float lo, float hi) { return f2bf(lo) | (f2bf(hi) << 16); }
__device__ __forceinline__ float bf2f(unsigned short h) { return __builtin_bit_cast(float, (unsigned)h << 16); }
__device__ __forceinline__ float bflo(unsigned w) { return __builtin_bit_cast(float, w << 16); }
__device__ __forceinline__ float bfhi(unsigned w) { return __builtin_bit_cast(float, w & 0xffff0000u); }
__device__ __forceinline__ unsigned cvt_pk_bf16(float lo, float hi) { unsigned r; asm volatile("v_cvt_pk_bf16_f32 %0, %1, %2" : "=v"(r) : "v"(lo), "v"(hi)); return r; }
__device__ __forceinline__ float wave_sum(float v) {
#pragma unroll
    for (int o = 1; o < 64; o <<= 1) v += __shfl_xor(v, o);
    return v;
}
__device__ __forceinline__ float sigmoidf_(float x) { return __builtin_amdgcn_rcpf(1.0f + __builtin_amdgcn_exp2f(-1.4426950408889634f * x)); }
constexpr int LDS_WIDTAB = 139264 + 3072;
__device__ __forceinline__ int hw_slot() { return (int)(__builtin_amdgcn_s_getreg((5 << 11) | 4) & 63u); }
__device__ __forceinline__ int lane_id() { return (int)__builtin_amdgcn_mbcnt_hi(~0u, __builtin_amdgcn_mbcnt_lo(~0u, 0u)); }
extern __shared__ __attribute__((aligned(16))) unsigned char lds_raw[];
__device__ __forceinline__ int wave_id() { return __builtin_amdgcn_readfirstlane(((const LAS int*)((LAS unsigned char*)lds_raw + LDS_WIDTAB))[hw_slot()]); }
__device__ __forceinline__ int opaque_tid() { int t = wave_id() * 64 + lane_id(); asm volatile("" : "+v"(t)); return t; }
#define LDS_WAIT() asm volatile("s_waitcnt lgkmcnt(0)" ::: "memory")
#define VM_WAIT() asm volatile("s_waitcnt vmcnt(0)" ::: "memory")

#define XB_TMO      128
#define XB_XCNT(j)  (256  + 64 * (j))
#define XB_XSUB(j)  (1280 + 64 * (j))
#define XB_XGEN(j)  (2304 + 64 * (j))
#define XB_TOP      3328
#define XB_TOPGEN   3392
#define XCD_BAR_WORDS 3456
#define XB_SPIN_CAP (1u << 18)
__device__ __forceinline__ unsigned xb_ld(unsigned* p)              { return __hip_atomic_load(p, __ATOMIC_RELAXED, __HIP_MEMORY_SCOPE_AGENT); }
__device__ __forceinline__ unsigned xb_add(unsigned* p, unsigned v) { return __hip_atomic_fetch_add(p, v, __ATOMIC_RELAXED, __HIP_MEMORY_SCOPE_AGENT); }
__device__ __forceinline__ unsigned xb_xcc_id() { return (unsigned)__builtin_amdgcn_s_getreg((3 << 11) | 20) & 0xFu; }
#define XB_SPIN(cond, bar) do { unsigned _sp = 0; while (cond) { __builtin_amdgcn_s_sleep(1); \
    if ((++_sp & 255u) == 0u) { if (xb_ld(&(bar)[XB_TMO])) break; if (_sp > XB_SPIN_CAP) { atomicAdd(&(bar)[XB_TMO], 1u); break; } } } } while (0)
struct XcdBarrier { unsigned* bar; unsigned x; volatile LAS unsigned* st; };
__device__ __forceinline__ XcdBarrier xcd_barrier_post(unsigned* bar, volatile LAS unsigned* st) {
    XcdBarrier b; b.bar = bar; b.x = xb_xcc_id(); b.st = st;
    if (opaque_tid() == 0) (void)xb_add(&bar[XB_XCNT(b.x)], 1u);
    return b;
}
__device__ __forceinline__ void xcd_barrier_complete(unsigned* bar, unsigned x, unsigned& nloc, unsigned& nx) {
    const unsigned G = gridDim.x * gridDim.y * gridDim.z;
    unsigned sum, cnt, mine, sp = 0u;
    for (;;) {
        sum = 0u; cnt = 0u; mine = 0u;
#pragma unroll
        for (unsigned j = 0; j < 16; ++j) { const unsigned c = xb_ld(&bar[XB_XCNT(j)]); sum += c; cnt += (c > 0u) ? 1u : 0u; mine = (j == x) ? c : mine; }
        if (sum == G) break;
        __builtin_amdgcn_s_sleep(1);
        if ((++sp & 255u) == 0u) { if (xb_ld(&bar[XB_TMO])) break; if (sp > XB_SPIN_CAP) { atomicAdd(&bar[XB_TMO], 1u); break; } }
    }
    nloc = mine > 0u ? mine : 1u; nx = cnt > 0u ? cnt : 1u;
}
__device__ __forceinline__ void xcd_barrier(const XcdBarrier& b) {
    asm volatile("s_waitcnt vmcnt(0)" ::: "memory");
    __syncthreads();
    if (opaque_tid() == 0) {
        unsigned* bar = b.bar;
        __builtin_amdgcn_s_waitcnt(0);
        unsigned nloc = b.st[0], nx = b.st[1];
        if (nloc == 0u) { xcd_barrier_complete(bar, b.x, nloc, nx); b.st[0] = nloc; b.st[1] = nx; }
        const unsigned old = xb_add(&bar[XB_XSUB(b.x)], 1u);
        const unsigned gen = old / nloc;
        if (old + 1u == (gen + 1u) * nloc) {
            __builtin_amdgcn_fence(__ATOMIC_RELEASE, "agent");
            asm volatile("s_waitcnt vmcnt(0)" ::: "memory");
            const unsigned og = xb_add(&bar[XB_TOP], 1u);
            const unsigned tg = og / nx;
            if (og + 1u == (tg + 1u) * nx) xb_add(&bar[XB_TOPGEN], 1u);
            else XB_SPIN(xb_ld(&bar[XB_TOPGEN]) == tg, bar);
            __builtin_amdgcn_fence(__ATOMIC_ACQUIRE, "agent");
            xb_add(&bar[XB_XGEN(b.x)], 1u);
            asm volatile("s_waitcnt vmcnt(0)" ::: "memory");
        } else {
            XB_SPIN(xb_ld(&bar[XB_XGEN(b.x)]) == gen, bar);
            __builtin_amdgcn_fence(__ATOMIC_ACQUIRE, "agent");
            asm volatile("s_waitcnt vmcnt(0)" ::: "memory");
        }
    }
    __syncthreads();
}

namespace pg8 {
constexpr int BM = 256, BK = 64, HALF = 128, HTB = HALF * BK * 2, STAGE_BYTES = 8 * HTB, NXCD = 8, WGM = 8;
__host__ __device__ __forceinline__ int lds_byte(int r, int c) { const int st = (r >> 4) * 2 + (c >> 5), rr = r & 15, cc = c & 31, ob = rr * 64 + cc * 2; return st * 1024 + (ob ^ (((ob >> 9) & 1) << 5)); }
__host__ __device__ __forceinline__ void stage_rc(int b, int& R, int& C) { const int st = b / 1024, sb = b % 1024, swz = sb ^ (((sb >> 9) & 1) << 5); R = (st >> 1) * 16 + swz / 64; C = (st & 1) * 32 + (swz % 64) / 2; }
__host__ __device__ __forceinline__ int perm32(int rho) { const int n = rho >> 4, i = rho & 15; return 8 * (i >> 2) + 4 * n + (i & 3); }

struct Unit { int pm, pn, e, t, cnt; };
struct Gemm { const bf16_t* A; const bf16_t* Bt; int lda, ldb, K; };

struct StaticOrder {
    static constexpr bool GATHER_A = false;
    int nM, nN, nwg, G, c;
    __device__ void init(int M, int N, int G_, int c_) { nM = M / BM; nN = N / BM; nwg = nM * nN; G = G_; c = c_; }
    __device__ __forceinline__ bool next(int i, Unit& u) const {
        const long L = (long)i * G + c; if (L >= nwg) return false;
        int wgid = (int)L; { const int q = nwg / NXCD, r = nwg % NXCD, xcd = wgid % NXCD, off = wgid / NXCD; wgid = (xcd < r ? xcd * (q + 1) : r * (q + 1) + (xcd - r) * q) + off; }
        const int nig = WGM * nN, gid = wgid / nig, fm = gid * WGM, gsz = (nM - fm) < WGM ? (nM - fm) : WGM;
        u.pm = fm + ((wgid % nig) % gsz); u.pn = (wgid % nig) / gsz; u.e = 0; u.t = 0; u.cnt = 0; return true;
    }
    __device__ __forceinline__ int rowA(const Unit& u, int r) const { return u.pm * BM + r; }
    __device__ __forceinline__ int colA(const Unit&) const { return 0; }
    __device__ __forceinline__ int rowB(const Unit& u, int r) const { return u.pn * BM + r; }
};

typedef int v8i32 __attribute__((ext_vector_type(8)));
template <class Epi, class Sched, bool FP8 = false>
__device__ __forceinline__ void gemm_phase(LAS unsigned char* lds, const Gemm g, const Sched& S, const Epi& E) {
    const int tid = opaque_tid(), wid = __builtin_amdgcn_readfirstlane(tid >> 6), lane = tid & 63, wr = wid >> 2, wc = wid & 3, fr = lane & 15, fq = lane >> 4;
    const int K = g.K, nt = K / BK;
    constexpr bool GA = Sched::GATHER_A;
    int sR[2], sC[2];
    unsigned laneA[2], laneB[2];
#pragma unroll
    for (int i = 0; i < 2; ++i) { int R, C; stage_rc(tid * 16 + i * 8192, R, C); sR[i] = R; sC[i] = C; const int Rb = Epi::PERM ? ((R & ~31) + perm32(R & 31)) : R;
        laneA[i] = (unsigned)(R * g.lda + C) * 2u; laneB[i] = (unsigned)(Rb * g.ldb + C) * 2u; }
    const size_t hstepA = (size_t)HALF * g.lda * 2, hstepB = (size_t)HALF * g.ldb * 2;
    const unsigned ldsw = (unsigned)wid * 1024u;
    const int aoff = lds_byte(wr * 64 + fr, fq * 8), boff = lds_byte(wc * 32 + fr, fq * 8);
    const char* gA = (const char*)g.A; const char* gB = (const char*)g.Bt;
#define PG8_SA(b, h) (((b) * 2 + (h)) * HTB)
#define PG8_SB(b, h) ((4 + (b) * 2 + (h)) * HTB)
#define PG8_STAGE(bufoff, gptr, voff) do { _Pragma("unroll") for (int _i = 0; _i < 2; ++_i) \
        __builtin_amdgcn_global_load_lds((const unsigned*)((gptr) + (size_t)(voff)[_i]), (LAS unsigned*)(lds + (bufoff) + ldsw + _i * 8192), 16, 0, 0); } while (0)
#define PG8_STAGE_B(bufoff, ub, h, kb) PG8_STAGE(bufoff, gB + (ub) + (size_t)(h) * hstepB + (size_t)(kb), laneB)
#define PG8_STAGE_A(bufoff, ub, va, h, kb) do { if constexpr (GA) { PG8_STAGE(bufoff, gA + (size_t)(kb), va[h]); } else { PG8_STAGE(bufoff, gA + (ub) + (size_t)(h) * hstepA + (size_t)(kb), laneA); } } while (0)
#define PG8_RD(off) (*(const LAS u32x4*)(lds + (off)))
#define PG8_CAT2(x, y) __builtin_bit_cast(v8i32, __builtin_shufflevector((x), (y), 0, 1, 2, 3, 4, 5, 6, 7))
#define PG8_LDA(dst, b, h) do { if constexpr (FP8) { _Pragma("unroll") for (int m = 0; m < 4; ++m) dst##8[m] = PG8_CAT2(PG8_RD(PG8_SA(b, h) + aoff + m * 2048), PG8_RD(PG8_SA(b, h) + aoff + m * 2048 + 1024)); } \
        else { _Pragma("unroll") for (int m = 0; m < 4; ++m) _Pragma("unroll") for (int k = 0; k < 2; ++k) dst[m][k] = *(const LAS bf16x8*)(lds + PG8_SA(b, h) + aoff + m * 2048 + k * 1024); } } while (0)
#define PG8_LDB(dst, b, h) do { if constexpr (FP8) { _Pragma("unroll") for (int n = 0; n < 2; ++n) dst##8[n] = PG8_CAT2(PG8_RD(PG8_SB(b, h) + boff + n * 2048), PG8_RD(PG8_SB(b, h) + boff + n * 2048 + 1024)); } \
        else { _Pragma("unroll") for (int n = 0; n < 2; ++n) _Pragma("unroll") for (int k = 0; k < 2; ++k) dst[n][k] = *(const LAS bf16x8*)(lds + PG8_SB(b, h) + boff + n * 2048 + k * 1024); } } while (0)
#define PG8_MMA(ai, bj, At, Bt) do { __builtin_amdgcn_s_setprio(1); _Pragma("unroll") for (int m = 0; m < 4; ++m) _Pragma("unroll") for (int n = 0; n < 2; ++n) { \
        if constexpr (FP8) { asm volatile("v_mfma_scale_f32_16x16x128_f8f6f4 %0, %1, %2, %0, %3, %3 op_sel_hi:[0,0,0]" : "+v"(acc[ai][bj][m][n]) : "v"(Bt##8[n]), "v"(At##8[m]), "v"(fp8_one)); } \
        else { _Pragma("unroll") for (int k = 0; k < 2; ++k) acc[ai][bj][m][n] = __builtin_amdgcn_mfma_f32_16x16x32_bf16(Bt[n][k], At[m][k], acc[ai][bj][m][n], 0, 0, 0); } } \
        __builtin_amdgcn_s_setprio(0); } while (0)
#define PG8_WAIT_V(n) asm volatile("s_waitcnt vmcnt(" #n ")" ::: "memory")
#define PG8_WAIT_L(n) asm volatile("s_waitcnt lgkmcnt(" #n ")" ::: "memory")
#define PG8_BAR __builtin_amdgcn_s_barrier()
#define PG8_SCHED __builtin_amdgcn_sched_barrier(0)
#define PG8_SCHED8 do { if constexpr (FP8) __builtin_amdgcn_sched_barrier(0); } while (0)
#define PG8_OFFS(u, ubA, ubB, vA) do { ubB = ((size_t)S.rowB(u, 0) * (size_t)g.ldb) * 2; \
        if constexpr (GA) { ubA = 0; _Pragma("unroll") for (int _h = 0; _h < 2; ++_h) _Pragma("unroll") for (int _i = 0; _i < 2; ++_i) vA[_h][_i] = ((unsigned)S.rowA(u, _h * HALF + sR[_i]) * (unsigned)g.lda + (unsigned)sC[_i]) * 2u; } \
        else { ubA = ((size_t)S.rowA(u, 0) * (size_t)g.lda + (size_t)S.colA(u)) * 2; } } while (0)
    Unit cur, nxt; int ui = 0;
    if (!S.next(0, cur)) return;
    f32x4 acc[2][2][4][2];
#pragma unroll
    for (int a = 0; a < 2; ++a)
#pragma unroll
        for (int b = 0; b < 2; ++b)
#pragma unroll
            for (int m = 0; m < 4; ++m)
#pragma unroll
                for (int n = 0; n < 2; ++n) acc[a][b][m][n] = (f32x4){0.f, 0.f, 0.f, 0.f};
    const int fp8_one = 0x7f7f7f7f;
    bf16x8 At[4][2], B0[2][2], B1[2][2]; v8i32 At8[4], B08[2], B18[2];
    size_t ubAc, ubBc, ubAn, ubBn; unsigned vAc[2][2] = {}, vAn[2][2] = {};
    PG8_OFFS(cur, ubAc, ubBc, vAc);
    PG8_STAGE_B(PG8_SB(0, 0), ubBc, 0, 0); PG8_STAGE_B(PG8_SB(0, 1), ubBc, 1, 0); PG8_STAGE_A(PG8_SA(0, 0), ubAc, vAc, 0, 0); PG8_STAGE_A(PG8_SA(0, 1), ubAc, vAc, 1, 0);
    if (wr == 1) PG8_BAR;
    PG8_WAIT_V(2); PG8_BAR;
    PG8_STAGE_B(PG8_SB(1, 0), ubBc, 0, 128); PG8_STAGE_A(PG8_SA(1, 0), ubAc, vAc, 0, 128); PG8_STAGE_B(PG8_SB(1, 1), ubBc, 1, 128);
    PG8_WAIT_V(6); PG8_BAR;
    for (;;) {
        const bool has_next = S.next(ui + 1, nxt);
        if (has_next) { PG8_OFFS(nxt, ubAn, ubBn, vAn); }
        else { ubAn = ubAc; ubBn = ubBc;
#pragma unroll
            for (int h = 0; h < 2; ++h)
#pragma unroll
                for (int i = 0; i < 2; ++i) vAn[h][i] = vAc[h][i]; }
        for (int t = 0; t < nt; t += 2) {
            const bool last = (t == nt - 2);
            const unsigned k1 = (unsigned)(t + 1) * 128u, k2 = last ? 0u : (unsigned)(t + 2) * 128u, k3 = k2 + 128u;
            const size_t xubA = last ? ubAn : ubAc, xubB = last ? ubBn : ubBc;
            unsigned xA[2][2];
#pragma unroll
            for (int h = 0; h < 2; ++h)
#pragma unroll
                for (int i = 0; i < 2; ++i) xA[h][i] = last ? vAn[h][i] : vAc[h][i];
            PG8_LDB(B0, 0, 0); PG8_LDB(B1, 0, 1); PG8_SCHED; PG8_LDA(At, 0, 0); PG8_STAGE_A(PG8_SA(1, 1), ubAc, vAc, 1, k1);
            PG8_WAIT_V(8); PG8_WAIT_L(0); PG8_SCHED8; PG8_BAR; PG8_MMA(0, 0, At, B0); PG8_MMA(0, 1, At, B1); PG8_SCHED8; PG8_BAR; PG8_SCHED;
            PG8_LDA(At, 0, 1); PG8_STAGE_B(PG8_SB(0, 0), xubB, 0, k2); PG8_STAGE_B(PG8_SB(0, 1), xubB, 1, k2); PG8_STAGE_A(PG8_SA(0, 0), xubA, xA, 0, k2);
            PG8_WAIT_V(8); PG8_WAIT_L(0); PG8_SCHED8; PG8_BAR; PG8_MMA(1, 0, At, B0); PG8_MMA(1, 1, At, B1); PG8_SCHED8; PG8_BAR; PG8_SCHED;
            PG8_LDB(B0, 1, 0); PG8_LDB(B1, 1, 1); PG8_SCHED; PG8_LDA(At, 1, 0); PG8_STAGE_A(PG8_SA(0, 1), xubA, xA, 1, k2);
            PG8_WAIT_V(8); PG8_WAIT_L(0); PG8_SCHED8; PG8_BAR; PG8_MMA(0, 0, At, B0); PG8_MMA(0, 1, At, B1); PG8_SCHED8; PG8_BAR; PG8_SCHED;
            PG8_LDA(At, 1, 1); PG8_STAGE_B(PG8_SB(1, 0), xubB, 0, k3); PG8_STAGE_B(PG8_SB(1, 1), xubB, 1, k3); PG8_STAGE_A(PG8_SA(1, 0), xubA, xA, 0, k3);
            PG8_WAIT_V(8); PG8_WAIT_L(0); PG8_SCHED8; PG8_BAR; PG8_MMA(1, 0, At, B0); PG8_MMA(1, 1, At, B1); PG8_SCHED8; PG8_BAR; PG8_SCHED;
        }
        if (wr == 0) PG8_BAR;
        E(acc, cur, wr, wc, fr, fq);
        if (!has_next) break;
#pragma unroll
        for (int a = 0; a < 2; ++a)
#pragma unroll
            for (int b = 0; b < 2; ++b)
#pragma unroll
                for (int m = 0; m < 4; ++m)
#pragma unroll
                    for (int n = 0; n < 2; ++n) acc[a][b][m][n] = (f32x4){0.f, 0.f, 0.f, 0.f};
        cur = nxt; ++ui; ubAc = ubAn; ubBc = ubBn;
#pragma unroll
        for (int h = 0; h < 2; ++h)
#pragma unroll
            for (int i = 0; i < 2; ++i) vAc[h][i] = vAn[h][i];
        if (wr == 1) PG8_BAR;
    }
    PG8_WAIT_V(0);
    PG8_BAR;
#undef PG8_SA
#undef PG8_SB
#undef PG8_STAGE
#undef PG8_STAGE_A
#undef PG8_STAGE_B
#undef PG8_LDA
#undef PG8_LDB
#undef PG8_MMA
#undef PG8_RD
#undef PG8_CAT2
#undef PG8_WAIT_V
#undef PG8_WAIT_L
#undef PG8_BAR
#undef PG8_SCHED
#undef PG8_SCHED8
#undef PG8_OFFS
}
}
namespace pg8 {
struct EpiBf16 {
    static constexpr bool PERM = true;
    bf16_t* O; int ldc; int split_cols; size_t split_stride; float scale0; float scale_all = 1.0f;
    __device__ __forceinline__ void operator()(const f32x4 (&acc)[2][2][4][2], const Unit& u, int wr, int wc, int fr, int fq) const {
        const int row0 = u.pm * BM + wr * 64 + fr; int colt = u.pn * BM; bf16_t* base = O;
        float sc = scale_all; if (split_cols) { const int t = colt / split_cols; base += (size_t)t * split_stride; colt -= t * split_cols; if (t == 0) sc *= scale0; }
        const int col0 = colt + wc * 32 + 8 * fq;
#pragma unroll
        for (int ai = 0; ai < 2; ++ai)
#pragma unroll
            for (int m = 0; m < 4; ++m) { bf16_t* rowp = base + (size_t)(row0 + ai * HALF + m * 16) * ldc + col0;
#pragma unroll
                for (int bj = 0; bj < 2; ++bj) { const f32x4 v0 = acc[ai][bj][m][0] * sc, v1 = acc[ai][bj][m][1] * sc;
                    u32x4 w; w.x = cvt_pk_bf16(v0[0], v0[1]); w.y = cvt_pk_bf16(v0[2], v0[3]); w.z = cvt_pk_bf16(v1[0], v1[1]); w.w = cvt_pk_bf16(v1[2], v1[3]);
                    *(u32x4*)(rowp + bj * HALF) = w; } }
    }
};
struct EpiFilt {
    static constexpr bool PERM = true;
    bf16_t* O;
    __device__ __forceinline__ void operator()(const f32x4 (&acc)[2][2][4][2], const Unit& u, int wr, int wc, int fr, int fq) const {
        const float dmin = -3.0701134573253945f, dmax = -15.350567286626973f;
#pragma unroll
        for (int ai = 0; ai < 2; ++ai)
#pragma unroll
            for (int m = 0; m < 4; ++m) { const int row = u.pm * BM + ai * HALF + wr * 64 + m * 16 + fr; const int c = row & 1023;
                const float dl2 = fabsf(dmin + (float)c * ((dmax - dmin) / 1023.0f)) * (1.4426950408889634f / 8191.0f);
#pragma unroll
                for (int bj = 0; bj < 2; ++bj) { const int col = u.pn * BM + bj * HALF + wc * 32 + 8 * fq; float v[8];
#pragma unroll
                    for (int n = 0; n < 2; ++n)
#pragma unroll
                        for (int j = 0; j < 4; ++j) v[n * 4 + j] = acc[ai][bj][m][n][j] * __builtin_amdgcn_exp2f(-(float)(col + n * 4 + j) * dl2);
                    u32x4 w; w.x = cvt_pk_bf16(v[0], v[1]); w.y = cvt_pk_bf16(v[2], v[3]); w.z = cvt_pk_bf16(v[4], v[5]); w.w = cvt_pk_bf16(v[6], v[7]);
                    *(u32x4*)(O + (size_t)row * 8192 + col) = w; }
                asm volatile("" ::: "memory"); }
    }
};
struct EpiResF32 {
    static constexpr bool PERM = false;
    const float* res; float* O; int ldc; float alpha;
    __device__ __forceinline__ void operator()(const f32x4 (&acc)[2][2][4][2], const Unit& u, int wr, int wc, int fr, int fq) const {
#pragma unroll
        for (int ai = 0; ai < 2; ++ai)
#pragma unroll
            for (int m = 0; m < 4; ++m) { const size_t off = (size_t)(u.pm * BM + ai * HALF + wr * 64 + m * 16 + fr) * ldc + u.pn * BM + wc * 32 + 4 * fq;
#pragma unroll
                for (int bj = 0; bj < 2; ++bj)
#pragma unroll
                    for (int n = 0; n < 2; ++n) { const f32x4 r = *(const f32x4*)(res + off + bj * HALF + n * 16); *(f32x4*)(O + off + bj * HALF + n * 16) = r * alpha + acc[ai][bj][m][n]; }
                if (m & 1) asm volatile("" ::: "memory"); }
    }
};
struct EpiResBf {
    static constexpr bool PERM = true;
    const bf16_t* res; bf16_t* O; int ldc; float alpha; float ascale = 1.0f;
    __device__ __forceinline__ void operator()(const f32x4 (&acc)[2][2][4][2], const Unit& u, int wr, int wc, int fr, int fq) const {
#pragma unroll
        for (int ai = 0; ai < 2; ++ai)
#pragma unroll
            for (int m = 0; m < 4; ++m) { const size_t off = (size_t)(u.pm * BM + ai * HALF + wr * 64 + m * 16 + fr) * ldc + u.pn * BM + wc * 32 + 8 * fq;
#pragma unroll
                for (int bj = 0; bj < 2; ++bj) { const u32x4 r = *(const u32x4*)(res + off + bj * HALF); const f32x4 a0 = acc[ai][bj][m][0] * ascale, a1 = acc[ai][bj][m][1] * ascale;
                    u32x4 w; w.x = cvt_pk_bf16(bflo(r.x) * alpha + a0[0], bfhi(r.x) * alpha + a0[1]); w.y = cvt_pk_bf16(bflo(r.y) * alpha + a0[2], bfhi(r.y) * alpha + a0[3]);
                    w.z = cvt_pk_bf16(bflo(r.z) * alpha + a1[0], bfhi(r.z) * alpha + a1[1]); w.w = cvt_pk_bf16(bflo(r.w) * alpha + a1[2], bfhi(r.w) * alpha + a1[3]);
                    *(u32x4*)(O + off + bj * HALF) = w; }
                if (m & 1) asm volatile("" ::: "memory"); }
    }
};
struct EpiSwiglu {
    static constexpr bool PERM = true;
    bf16_t* O;
    __device__ __forceinline__ void operator()(const f32x4 (&acc)[2][2][4][2], const Unit& u, int wr, int wc, int fr, int fq) const {
#pragma unroll
        for (int ai = 0; ai < 2; ++ai)
#pragma unroll
            for (int m = 0; m < 4; ++m) { bf16_t* p = O + (size_t)(u.pm * BM + ai * HALF + wr * 64 + m * 16 + fr) * DFF + u.pn * HALF + wc * 32 + 8 * fq;
                float h[8];
#pragma unroll
                for (int n = 0; n < 2; ++n)
#pragma unroll
                    for (int j = 0; j < 4; ++j) { const float gt = acc[ai][0][m][n][j], up = acc[ai][1][m][n][j]; h[n * 4 + j] = gt * sigmoidf_(gt) * up; }
                u32x4 w; w.x = cvt_pk_bf16(h[0], h[1]); w.y = cvt_pk_bf16(h[2], h[3]); w.z = cvt_pk_bf16(h[4], h[5]); w.w = cvt_pk_bf16(h[6], h[7]);
                *(u32x4*)p = w; }
    }
};
__device__ __forceinline__ float clamp_fp8(float x) { return __builtin_amdgcn_fmed3f(x, -448.0f, 448.0f); }
__device__ __forceinline__ unsigned pk4_fp8(float a, float b, float c, float d) { int w = 0; w = __builtin_amdgcn_cvt_pk_fp8_f32(clamp_fp8(a), clamp_fp8(b), w, false); w = __builtin_amdgcn_cvt_pk_fp8_f32(clamp_fp8(c), clamp_fp8(d), w, true); return (unsigned)w; }
constexpr float FP8_SW = 64.0f, FP8_SH = 8.0f;
struct EpiSwiglu8 {
    static constexpr bool PERM = true;
    unsigned char* O;
    __device__ __forceinline__ void operator()(const f32x4 (&acc)[2][2][4][2], const Unit& u, int wr, int wc, int fr, int fq) const {
#pragma unroll
        for (int ai = 0; ai < 2; ++ai)
#pragma unroll
            for (int m = 0; m < 4; ++m) { unsigned char* p = O + (size_t)(u.pm * BM + ai * HALF + wr * 64 + m * 16 + fr) * DFF + u.pn * HALF + wc * 32 + 8 * fq;
                float h[8];
#pragma unroll
                for (int n = 0; n < 2; ++n)
#pragma unroll
                    for (int j = 0; j < 4; ++j) { const float gt = acc[ai][0][m][n][j] * (1.0f / FP8_SW), up = acc[ai][1][m][n][j] * (1.0f / FP8_SW); h[n * 4 + j] = gt * sigmoidf_(gt) * up * FP8_SH; }
                u32x2 w; w.x = pk4_fp8(h[0], h[1], h[2], h[3]); w.y = pk4_fp8(h[4], h[5], h[6], h[7]);
                *(u32x2*)p = w; }
    }
};
struct EpiDown {
    static constexpr bool PERM = true;
    bf16_t* O; const int* rowlist; const float* gatew; float oscale;
    __device__ __forceinline__ void operator()(const f32x4 (&acc)[2][2][4][2], const Unit& u, int wr, int wc, int fr, int fq) const {
#pragma unroll
        for (int ai = 0; ai < 2; ++ai)
#pragma unroll
            for (int m = 0; m < 4; ++m) { const int idx = u.t * BM + ai * HALF + wr * 64 + m * 16 + fr;
                if (idx < u.cnt) { const int a = rowlist[(size_t)u.e * ECAP + idx]; const float gw = gatew[a] * oscale;
                    bf16_t* p = O + (size_t)a * DM + u.pn * BM + wc * 32 + 8 * fq;
#pragma unroll
                    for (int bj = 0; bj < 2; ++bj) { const f32x4 v0 = acc[ai][bj][m][0] * gw, v1 = acc[ai][bj][m][1] * gw;
                        u32x4 w; w.x = cvt_pk_bf16(v0[0], v0[1]); w.y = cvt_pk_bf16(v0[2], v0[3]); w.z = cvt_pk_bf16(v1[0], v1[1]); w.w = cvt_pk_bf16(v1[2], v1[3]);
                        *(u32x4*)(p + bj * HALF) = w; } } }
    }
};
struct EpiRG {
    static constexpr bool PERM = true;
    bf16_t* LA; bf16_t* BB; const bf16_t* XC; const float* ba; const float* bx; const float* lam;
    __device__ __forceinline__ void operator()(const f32x4 (&acc)[2][2][4][2], const Unit& u, int wr, int wc, int fr, int fq) const {
        const int nb = u.pn >> 2, q = u.pn & 3, dir = q >> 1, half = q & 1;
        const int ch0 = nb * 256 + half * HALF + wc * 32 + 8 * fq;
        float vba[8], vbx[8], vsp[8];
#pragma unroll
        for (int j = 0; j < 8; ++j) { vba[j] = ba[dir * DM + ch0 + j]; vbx[j] = bx[dir * DM + ch0 + j];
            const float x = __expf(-lam[dir * DM + ch0 + j]);
            vsp[j] = 8.0f * (x < 0.05f ? x * (1.0f - x * (0.5f - x * (0.33333334f - 0.25f * x))) : __logf(1.0f + x)); }
#pragma unroll
        for (int ai = 0; ai < 2; ++ai)
#pragma unroll
            for (int m = 0; m < 4; ++m) { const size_t tok = (size_t)(u.pm * BM + ai * HALF + wr * 64 + m * 16 + fr);
                asm volatile("" ::: "memory");
                const u32x4 xw = *(const u32x4*)(XC + tok * DM + ch0);
                float xf[8] = {bflo(xw.x), bfhi(xw.x), bflo(xw.y), bfhi(xw.y), bflo(xw.z), bfhi(xw.z), bflo(xw.w), bfhi(xw.w)};
                float la[8], bb[8];
#pragma unroll
                for (int n = 0; n < 2; ++n)
#pragma unroll
                    for (int j = 0; j < 4; ++j) { const int k = n * 4 + j;
                        const float r = sigmoidf_(acc[ai][0][m][n][j] + vba[k]), ig = sigmoidf_(acc[ai][1][m][n][j] + vbx[k]);
                        const float l = -r * vsp[k]; la[k] = l; bb[k] = __builtin_amdgcn_sqrtf(fmaxf(1.0f - __builtin_amdgcn_exp2f(2.8853900817779268f * l), 0.f)) * (ig * xf[k]); }
                u32x4 w; w.x = cvt_pk_bf16(la[0], la[1]); w.y = cvt_pk_bf16(la[2], la[3]); w.z = cvt_pk_bf16(la[4], la[5]); w.w = cvt_pk_bf16(la[6], la[7]);
                *(u32x4*)(LA + ((size_t)dir * NTOK + tok) * DM + ch0) = w;
                w.x = cvt_pk_bf16(bb[0], bb[1]); w.y = cvt_pk_bf16(bb[2], bb[3]); w.z = cvt_pk_bf16(bb[4], bb[5]); w.w = cvt_pk_bf16(bb[6], bb[7]);
                *(u32x4*)(BB + ((size_t)dir * NTOK + tok) * DM + ch0) = w; }
    }
};

struct RGOrder {
    static constexpr bool GATHER_A = false;
    int G, c;
    __device__ __forceinline__ bool next(int i, Unit& u) const {
        if (G == 256) { if (i >= 8) return false; const int x = c & 7, y = c >> 3; u.pm = i * 8 + (y >> 2); u.pn = x * 4 + (y & 3); }
        else { const int L = i * G + c; if (L >= 64 * 32) return false; u.pm = L >> 5; u.pn = L & 31; }
        u.e = 0; u.t = 0; u.cnt = 0; return true; }
    __device__ __forceinline__ int rowA(const Unit& u, int r) const { return u.pm * BM + r; }
    __device__ __forceinline__ int colA(const Unit& u) const { return (u.pn >> 2) * 256; }
    __device__ __forceinline__ int rowB(const Unit& u, int r) const { return u.pn * BM + r; }
};
template <int NPN, bool GATHER>
struct MoeOrder {
    static constexpr bool GATHER_A = GATHER;
    int G, c; const LAS int* tab; const int* rowlist;
    __device__ __forceinline__ bool next(int i, Unit& u) const {
        const int L = i * G + c, ntile = tab[32]; if (L >= ntile * NPN) return false;
        const int tile = L / NPN; u.pm = tile; u.pn = L % NPN; int e = 0;
        while (e < 31 && tab[e + 1] <= tile) ++e;
        u.e = e; u.t = tile - tab[e]; u.cnt = tab[64 + e]; return true;
    }
    __device__ __forceinline__ int rowA(const Unit& u, int r) const {
        if (GATHER) { const int idx = u.t * BM + r; const int a = idx < u.cnt ? rowlist[(size_t)u.e * ECAP + idx] : 0; return a >> 1; }
        return u.pm * BM + r;
    }
    __device__ __forceinline__ int colA(const Unit&) const { return 0; }
    __device__ __forceinline__ int rowB(const Unit& u, int r) const { return (u.e * NPN + u.pn) * BM + r; }
};
}
namespace att {
constexpr int NW = 8, QBLK = 32, KVBLK = 64, LDQ = 1024, LDK = 1024, LDV = 1024, LDO = 1024;
constexpr int SHM_V = KVBLK * 128 * 2, SHM_K = KVBLK * 64 * 2, NSLOT = 4, LDS_K = 0, LDS_V = NSLOT * SHM_K, LDS_WS = NSLOT * (SHM_K + SHM_V), SHM_ATTN = LDS_WS + NW * 64 * 4;
__device__ __forceinline__ void glds16s(const void* sbase, unsigned voff, unsigned lds_dst) { unsigned keep;
    asm volatile("s_mov_b32 %0, m0\n\ts_mov_b32 m0, %3\n\ts_nop 0\n\tglobal_load_lds_dwordx4 %1, %2\n\ts_mov_b32 m0, %0" : "=&s"(keep) : "v"(voff), "s"(sbase), "s"(lds_dst) : "memory"); }
#define WAITBAR(N) asm volatile("s_waitcnt vmcnt(" #N ") lgkmcnt(0)\n\ts_barrier" ::: "memory")
constexpr float THR2 = 8.0f * 1.4426950408889634f;
#define KSWZ64(row, colB) ((row) * 128 + ((colB) ^ ((((row) >> 1) & 7) << 4)))
#define SBAR() __builtin_amdgcn_sched_barrier(0)
__device__ __forceinline__ int crow(int r, int hi) { return (r & 3) + 8 * (r >> 2) + 4 * hi; }
__device__ __forceinline__ void qkt(f32x16& p0, f32x16& p1, const char* Ks, const bf16x8* qr, int r32, int hi, float A, float st) {
    { float b4[4];
#pragma unroll
      for (int j = 0; j < 4; ++j) b4[j] = fmaf(st, (float)j, A);
      const float s8 = 8.0f * st, s32 = 32.0f * st;
#pragma unroll
      for (int r = 0; r < 16; ++r) { p0[r] = (r < 4) ? b4[r] : p0[r - 4] + s8; }
#pragma unroll
      for (int r = 0; r < 16; ++r) p1[r] = p0[r] + s32; }
#pragma unroll
    for (int d0 = 0; d0 < 4; ++d0) { const int cb = (d0 * 16 + hi * 8) * 2;
        const bf16x8 b0 = *reinterpret_cast<const bf16x8*>(Ks + KSWZ64(r32, cb));
        const bf16x8 b1 = *reinterpret_cast<const bf16x8*>(Ks + KSWZ64(32 + r32, cb));
        p0 = __builtin_amdgcn_mfma_f32_32x32x16_bf16(b0, qr[d0], p0, 0, 0, 0);
        p1 = __builtin_amdgcn_mfma_f32_32x32x16_bf16(b1, qr[d0], p1, 0, 0, 0); }
}
__device__ __forceinline__ void partialSM(f32x16& p0, f32x16& p1, bool mixed, float fd, float sl2) {
    if (mixed) {
#pragma unroll
        for (int r = 0; r < 16; ++r) { const float d0 = fd - (float)((r & 3) + 8 * (r >> 2)); p0[r] = fmaf(fabsf(d0), -sl2, p0[r]); p1[r] = fmaf(fabsf(d0 - 32.0f), -sl2, p1[r]); }
    }
#pragma unroll
    for (int r = 0; r < 16; ++r) p0[r] = __builtin_amdgcn_exp2f(p0[r]);
}
__device__ __forceinline__ void finishSM(f32x16& p0, f32x16& p1, float& l_reg, bf16x8& pa0, bf16x8& pa1, bf16x8& pa2, bf16x8& pa3) {
#pragma unroll
    for (int r = 0; r < 16; ++r) p1[r] = __builtin_amdgcn_exp2f(p1[r]);
    float ps = 0;
#pragma unroll
    for (int r = 0; r < 16; ++r) ps += p0[r];
#pragma unroll
    for (int r = 0; r < 16; ++r) ps += p1[r];
    l_reg += ps;
#define PK4(P, BASE, OUT) do { unsigned a0 = cvt_pk_bf16(P[BASE + 0], P[BASE + 1]), a1 = cvt_pk_bf16(P[BASE + 2], P[BASE + 3]);   \
    unsigned b0 = cvt_pk_bf16(P[BASE + 4], P[BASE + 5]), b1 = cvt_pk_bf16(P[BASE + 6], P[BASE + 7]);                              \
    auto r0 = __builtin_amdgcn_permlane32_swap(a0, b0, false, false); auto r1 = __builtin_amdgcn_permlane32_swap(a1, b1, false, false); \
    u32x4 w = {r0[0], r1[0], r0[1], r1[1]}; OUT = __builtin_bit_cast(bf16x8, w); } while (0)
    PK4(p0, 0, pa0); PK4(p0, 8, pa1); PK4(p1, 0, pa2); PK4(p1, 8, pa3);
#undef PK4
}
__device__ __forceinline__ int v_st(int k, int c) { const int kk = (k & ~0xC) | ((k & 4) << 1) | ((k & 8) >> 1); return ((kk >> 3) * 4 + (c >> 5)) * 512 + ((kk & 7) * 32 + (c & 31)) * 2; }
__device__ __forceinline__ int v_rd_base(int lane) { return ((lane & 3) << 3) | (((lane >> 2) & 3) << 6) | (((lane >> 4) & 1) << 5) | (((lane >> 5) & 1) << 8); }
constexpr int v_rd_off(int d0, int ks, int half) { return d0 * 512 + ks * 4096 + half * 2048; }
template <int OFF> __device__ __forceinline__ s16x4 tr_read(int vb) {
    s16x4 r; asm volatile("ds_read_b64_tr_b16 %0, %1 offset:%2" : "=&v"(r) : "v"(vb), "i"(OFF) : "memory"); return r;
}
template <int D0> __device__ __forceinline__ void pv_one(f32x16& od, int vb, bf16x8 pa0, bf16x8 pa1, bf16x8 pa2, bf16x8 pa3) {
    const s16x4 l0 = tr_read<v_rd_off(D0, 0, 0)>(vb), h0 = tr_read<v_rd_off(D0, 0, 1)>(vb), l1 = tr_read<v_rd_off(D0, 1, 0)>(vb), h1 = tr_read<v_rd_off(D0, 1, 1)>(vb);
    const s16x4 l2 = tr_read<v_rd_off(D0, 2, 0)>(vb), h2 = tr_read<v_rd_off(D0, 2, 1)>(vb), l3 = tr_read<v_rd_off(D0, 3, 0)>(vb), h3 = tr_read<v_rd_off(D0, 3, 1)>(vb);
    asm volatile("s_waitcnt lgkmcnt(0)" ::: "memory"); SBAR();
#define PK(L, H) (bf16x8){L[0], L[1], L[2], L[3], H[0], H[1], H[2], H[3]}
    od = __builtin_amdgcn_mfma_f32_32x32x16_bf16(pa0, PK(l0, h0), od, 0, 0, 0);
    od = __builtin_amdgcn_mfma_f32_32x32x16_bf16(pa1, PK(l1, h1), od, 0, 0, 0);
    od = __builtin_amdgcn_mfma_f32_32x32x16_bf16(pa2, PK(l2, h2), od, 0, 0, 0);
    od = __builtin_amdgcn_mfma_f32_32x32x16_bf16(pa3, PK(l3, h3), od, 0, 0, 0);
#undef PK
}
__device__ __forceinline__ void pv_d0(f32x16* o, int vb, bf16x8 pa0, bf16x8 pa1, bf16x8 pa2, bf16x8 pa3) {
    pv_one<0>(o[0], vb, pa0, pa1, pa2, pa3); pv_one<1>(o[1], vb, pa0, pa1, pa2, pa3); pv_one<2>(o[2], vb, pa0, pa1, pa2, pa3); pv_one<3>(o[3], vb, pa0, pa1, pa2, pa3);
}
__device__ __forceinline__ void attn_unit(const bf16_t* __restrict__ Qb, const bf16_t* __restrict__ Kh, const bf16_t* __restrict__ Vh, bf16_t* __restrict__ Ob, int q0, int t_lo, int n, float sl2, char* lds) {
    const int tid = opaque_tid(), wid = __builtin_amdgcn_readfirstlane(tid >> 6), lane = tid & 63, r32 = lane & 31, hi = lane >> 5;
    float* ws = (float*)(lds + LDS_WS) + wid * 64; float* li_l = ws;
    float l_reg = 0; f32x16 o[4] = {}; bf16x8 qr[4];
    const bf16_t* Qw = Qb + (long)(wid * QBLK + r32) * LDQ + hi * 8;
#pragma unroll
    for (int d0 = 0; d0 < 4; ++d0) qr[d0] = *reinterpret_cast<const bf16x8*>(Qw + d0 * 16);
    float negM;
    { const bf16_t* Kw = Kh + (long)(q0 + wid * QBLK + r32) * LDK + hi * 8; float s = 0.f;
#pragma unroll
      for (int d0 = 0; d0 < 4; ++d0) { const u32x4 kw = *reinterpret_cast<const u32x4*>(Kw + d0 * 16); const u32x4 qw = __builtin_bit_cast(u32x4, qr[d0]);
          s += bflo(kw.x) * bflo(qw.x) + bfhi(kw.x) * bfhi(qw.x) + bflo(kw.y) * bflo(qw.y) + bfhi(kw.y) * bfhi(qw.y) + bflo(kw.z) * bflo(qw.z) + bfhi(kw.z) * bfhi(qw.z) + bflo(kw.w) * bflo(qw.w) + bfhi(kw.w) * bfhi(qw.w); }
      auto rr = __builtin_amdgcn_permlane32_swap(__float_as_uint(s), __float_as_uint(s), false, false); negM = -(__uint_as_float(rr[0]) + __uint_as_float(rr[1])); }
    const unsigned lds0 = (unsigned)(uintptr_t)lds;
    const int krow = wid * 8 + (lane >> 3), kch = (lane & 7) ^ ((krow >> 1) & 7);
    const unsigned koff = (unsigned)(krow * LDK * 2 + kch * 16);
    unsigned voff[2];
#pragma unroll
    for (int z = 0; z < 2; ++z) { const int P16 = (wid + 8 * z) * 64 + lane, sub = P16 >> 5, win = P16 & 31, kk = (sub >> 2) * 8 + (win >> 2), k = (kk & ~0xC) | ((kk & 4) << 1) | ((kk & 8) >> 1), c = (sub & 3) * 32 + (win & 3) * 8;
        voff[z] = (unsigned)(k * LDV * 2 + c * 2); }
    const unsigned kdst = lds0 + LDS_K + wid * 1024, vdst = lds0 + LDS_V + wid * 1024;
    const int vb0 = (int)(lds0 + LDS_V) + v_rd_base(lane);
    const char* K_lds = lds + LDS_K;
    const int qw0 = q0 + wid * QBLK;
    const float fq0 = (float)(qw0 + r32 - 4 * hi);
    const char* Kt = (const char*)(Kh + (long)t_lo * KVBLK * LDK); const char* Vt = (const char*)(Vh + (long)t_lo * KVBLK * LDV);
#define DMA(jj, slot) do { const char* kb_ = Kt + (size_t)(jj) * (KVBLK * LDK * 2); const char* vb_ = Vt + (size_t)(jj) * (KVBLK * LDV * 2); \
    glds16s(kb_, koff, (unsigned)__builtin_amdgcn_readfirstlane(kdst + (slot) * SHM_K)); \
    glds16s(vb_, voff[0], (unsigned)__builtin_amdgcn_readfirstlane(vdst + (slot) * SHM_V)); \
    glds16s(vb_, voff[1], (unsigned)__builtin_amdgcn_readfirstlane(vdst + (slot) * SHM_V + 8192)); } while (0)
#define TILE(jj) const int k0_ = (t_lo + (jj)) * KVBLK; const bool left_ = k0_ + 63 < qw0, right_ = k0_ > qw0 + 31, mixed_ = !(left_ || right_); \
    const float fd_ = fq0 - (float)k0_, st_ = left_ ? sl2 : (right_ ? -sl2 : 0.f), A_ = negM - st_ * fd_
    f32x16 pA0, pA1, pB0, pB1; bf16x8 pa0, pa1, pa2, pa3;
    asm volatile("s_waitcnt vmcnt(0)" ::: "memory");
#define SEG_A(PN0, PN1, PO0, PO1, jt, FIN) do { TILE(jt); SBAR(); qkt(PN0, PN1, K_lds + ((jt) & 3) * SHM_K, qr, r32, hi, A_, st_); if (FIN) finishSM(PO0, PO1, l_reg, pa0, pa1, pa2, pa3); SBAR(); } while (0)
#define SEG_B(P0, P1, jt, PV) do { if (PV) pv_d0(o, vb0 + (((jt) - 1) & 3) * SHM_V, pa0, pa1, pa2, pa3); { TILE(jt); partialSM(P0, P1, mixed_, fd_, sl2); } } while (0)
#define STEP_BAR(jt) do { WAITBAR(0); if ((jt) + 2 < n) DMA((jt) + 2, ((jt) + 2) & 3); } while (0)
    const bool lead = wid < 4;
    DMA(0, 0); DMA(1, 1);
    WAITBAR(3);
    SEG_A(pA0, pA1, pB0, pB1, 0, false); if (!lead) STEP_BAR(0); SEG_B(pA0, pA1, 0, false); if (lead) STEP_BAR(0);
    for (int j = 1; j + 1 < n; j += 2) {
        SEG_A(pB0, pB1, pA0, pA1, j, true); if (!lead) STEP_BAR(j); SEG_B(pB0, pB1, j, true); if (lead) STEP_BAR(j);
        SEG_A(pA0, pA1, pB0, pB1, j + 1, true); if (!lead) STEP_BAR(j + 1); SEG_B(pA0, pA1, j + 1, true); if (lead) STEP_BAR(j + 1);
    }
    SEG_A(pB0, pB1, pA0, pA1, n - 1, true); if (!lead) STEP_BAR(n - 1); SEG_B(pB0, pB1, n - 1, true); if (lead) STEP_BAR(n - 1);
    finishSM(pB0, pB1, l_reg, pa0, pa1, pa2, pa3); SBAR();
    pv_d0(o, vb0 + ((n - 1) & 3) * SHM_V, pa0, pa1, pa2, pa3);
    { auto rr = __builtin_amdgcn_permlane32_swap(__float_as_uint(l_reg), __float_as_uint(l_reg), false, false); l_reg = __uint_as_float(rr[0]) + __uint_as_float(rr[1]); }
    if (hi == 0) li_l[r32] = l_reg; asm volatile("s_waitcnt lgkmcnt(0)" ::: "memory");
    float rli[16];
#pragma unroll
    for (int r = 0; r < 16; ++r) rli[r] = __builtin_amdgcn_rcpf(li_l[crow(r, hi)]);
    bf16_t* Ow = Ob + (long)(wid * QBLK) * LDO;
#pragma unroll
    for (int r = 0; r < 16; ++r) { const int orow = crow(r, hi);
#pragma unroll
        for (int d0 = 0; d0 < 4; ++d0) Ow[(long)orow * LDO + d0 * 32 + r32] = (bf16_t)f2bf(o[d0][r] * rli[r]); }
    WAITBAR(0);
#undef DMA
#undef SEG_A
#undef SEG_B
#undef STEP_BAR
#undef TILE
}
#undef SBAR
}

namespace hy {
typedef f32x2 cf;
__device__ __forceinline__ cf lld(const LAS f32x2* L, int i) { return L[i]; }
__device__ __forceinline__ void lst(LAS f32x2* L, int i, cf v) { L[i] = v; }
__device__ __forceinline__ cf cmul(cf a, cf b) { return a * b.xx + a.yx * (b.yy * (cf){-1.f, 1.f}); }
__device__ __forceinline__ cf cmulc(cf a, cf b) { return a * b.xx + a.yx * (b.yy * (cf){1.f, -1.f}); }
__device__ constexpr float C32[16] = {1.0f, 0.98078528040323043f, 0.92387953251128674f, 0.83146961230254524f, 0.70710678118654757f, 0.55557023301960229f, 0.38268343236508984f, 0.19509032201612833f,
                                      0.0f, -0.19509032201612819f, -0.38268343236508973f, -0.55557023301960196f, -0.70710678118654746f, -0.83146961230254535f, -0.92387953251128674f, -0.98078528040323043f};
__device__ constexpr float S32[16] = {0.0f, 0.19509032201612825f, 0.38268343236508978f, 0.55557023301960218f, 0.70710678118654746f, 0.83146961230254524f, 0.92387953251128674f, 0.98078528040323043f,
                                      1.0f, 0.98078528040323043f, 0.92387953251128674f, 0.83146961230254546f, 0.70710678118654757f, 0.55557023301960218f, 0.38268343236508989f, 0.19509032201612861f};
__host__ __device__ constexpr int brev(int k, int bits) { int r = 0; for (int i = 0; i < bits; ++i) r |= ((k >> i) & 1) << (bits - 1 - i); return r; }
template <int R, bool INV> __device__ __forceinline__ void dft_reg(cf (&v)[R]) {
#pragma unroll
    for (int s = R / 2; s >= 1; s >>= 1) {
#pragma unroll
        for (int g0 = 0; g0 < R; g0 += 2 * s) {
#pragma unroll
            for (int j = 0; j < s; ++j) {
                const cf a = v[g0 + j], b = v[g0 + j + s];
                v[g0 + j] = a + b;
                const cf d = a - b;
                const int tw = j * (16 / s);
                if (tw == 0) v[g0 + j + s] = d;
                else if (tw == 8) v[g0 + j + s] = INV ? (cf){-d.y, d.x} : (cf){d.y, -d.x};
                else { const float c = C32[tw], sn = INV ? S32[tw] : -S32[tw]; v[g0 + j + s] = d * c + d.yx * (cf){-sn, sn}; }
            }
        }
    }
}
constexpr int RS = FFT_RS;
__device__ __forceinline__ void fft_fwd12(cf (&v)[32], LAS f32x2* L, int tid) {
    dft_reg<32, false>(v);
    { float s, c; sincospif((float)tid * (1.0f / 8192.0f), &s, &c); cf w1 = {c, -s}; asm volatile("" : "+v"(w1.x), "+v"(w1.y)); cf w = w1;
#pragma unroll
      for (int k1 = 0; k1 < 32; ++k1) { cf x = v[brev(k1, 5)]; if (k1) { x = cmul(x, w); w = cmul(w, w1); } lst(L, k1 * RS + tid, x); } }
    __syncthreads();
    const int k1 = tid >> 4, m2 = tid & 15;
#pragma unroll
    for (int m1 = 0; m1 < 32; ++m1) v[m1] = lld(L, k1 * RS + 16 * m1 + m2);
    __syncthreads();
    dft_reg<32, false>(v);
    { float s, c; sincospif((float)m2 * (1.0f / 256.0f), &s, &c); cf w1 = {c, -s}; asm volatile("" : "+v"(w1.x), "+v"(w1.y)); cf w = w1;
#pragma unroll
      for (int j1 = 0; j1 < 32; ++j1) { cf x = v[brev(j1, 5)]; if (j1) { x = cmul(x, w); w = cmul(w, w1); } lst(L, k1 * RS + 33 * m2 + j1, x); } }
    __syncthreads();
}
__device__ __forceinline__ void fft_inv21(cf (&v)[32], LAS f32x2* L, int tid) {
    const int k1 = tid >> 4, m2 = tid & 15;
    { float s, c; sincospif((float)m2 * (1.0f / 256.0f), &s, &c); cf w1 = {c, -s}; asm volatile("" : "+v"(w1.x), "+v"(w1.y)); cf w = w1;
#pragma unroll
      for (int j1 = 0; j1 < 32; ++j1) { cf x = lld(L, k1 * RS + 33 * m2 + j1); if (j1) { x = cmulc(x, w); w = cmul(w, w1); } v[j1] = x; } }
    __syncthreads();
    dft_reg<32, true>(v);
#pragma unroll
    for (int m1 = 0; m1 < 32; ++m1) lst(L, k1 * RS + 16 * m1 + m2, v[brev(m1, 5)]);
    __syncthreads();
    { float s, c; sincospif((float)tid * (1.0f / 8192.0f), &s, &c); cf w1 = {c, -s}; asm volatile("" : "+v"(w1.x), "+v"(w1.y)); cf w = w1;
#pragma unroll
      for (int kk = 0; kk < 32; ++kk) { cf x = lld(L, kk * RS + tid); if (kk) { x = cmulc(x, w); w = cmul(w, w1); } v[kk] = x; } }
    dft_reg<32, true>(v);
}
}

namespace hm {
typedef f32x2 cf;
constexpr int ROWA = 40, ROWB = 24;
constexpr int PL_A = 512 * ROWA * 2, PL_B = 1024 * ROWB * 2;
__device__ __forceinline__ int crow(int r, int hi) { return (r & 3) + 8 * (r >> 2) + 4 * hi; }
struct CFrag { bf16x8 re, im, nim; };
__device__ __forceinline__ CFrag dft_frag(int n, int row, int k0, bool valid) {
    unsigned wr[4], wi[4], wn[4];
#pragma unroll
    for (int t = 0; t < 4; ++t) { float s0, c0, s1, c1; sincospif(-2.0f * (float)((row * (k0 + 2 * t)) % n) / (float)n, &s0, &c0); sincospif(-2.0f * (float)((row * (k0 + 2 * t + 1)) % n) / (float)n, &s1, &c1);
        if (!valid) { s0 = c0 = s1 = c1 = 0.f; }
        wr[t] = pk2(c0, c1); wi[t] = pk2(s0, s1); wn[t] = pk2(-s0, -s1); }
    CFrag f; f.re = __builtin_bit_cast(bf16x8, (u32x4){wr[0], wr[1], wr[2], wr[3]}); f.im = __builtin_bit_cast(bf16x8, (u32x4){wi[0], wi[1], wi[2], wi[3]}); f.nim = __builtin_bit_cast(bf16x8, (u32x4){wn[0], wn[1], wn[2], wn[3]});
    return f;
}
template <bool CONJ> __device__ __forceinline__ void cmfma(f32x16& dr, f32x16& di, const CFrag& a, bf16x8 br, bf16x8 bi) {
    dr = __builtin_amdgcn_mfma_f32_32x32x16_bf16(a.re, br, dr, 0, 0, 0); dr = __builtin_amdgcn_mfma_f32_32x32x16_bf16(CONJ ? a.im : a.nim, bi, dr, 0, 0, 0);
    di = __builtin_amdgcn_mfma_f32_32x32x16_bf16(a.re, bi, di, 0, 0, 0); di = __builtin_amdgcn_mfma_f32_32x32x16_bf16(CONJ ? a.nim : a.im, br, di, 0, 0, 0);
}
__device__ __forceinline__ cf cmul(cf a, cf b) { return a * b.xx + a.yx * (b.yy * (cf){-1.f, 1.f}); }
__device__ __forceinline__ cf cmulc(cf a, cf b) { return a * b.xx + a.yx * (b.yy * (cf){1.f, -1.f}); }
__device__ __forceinline__ bf16x8 pk4(const float (&P)[8]) {
    const unsigned a0 = cvt_pk_bf16(P[0], P[1]), a1 = cvt_pk_bf16(P[2], P[3]), b0 = cvt_pk_bf16(P[4], P[5]), b1 = cvt_pk_bf16(P[6], P[7]);
    auto r0 = __builtin_amdgcn_permlane32_swap(a0, b0, false, false); auto r1 = __builtin_amdgcn_permlane32_swap(a1, b1, false, false);
    return __builtin_bit_cast(bf16x8, (u32x4){r0[0], r1[0], r0[1], r1[1]});
}
constexpr int LDS_FTAB = 100 * 1024;
struct Consts { const LAS unsigned char* T; int lane;
    __device__ __forceinline__ CFrag get(int which) const { const LAS unsigned char* p = T + (which * 64 + lane) * 48; CFrag f; f.re = *(const LAS bf16x8*)p; f.im = *(const LAS bf16x8*)(p + 16); f.nim = *(const LAS bf16x8*)(p + 32); return f; } };
__device__ __forceinline__ void build_ftab(LAS unsigned char* T, int tid) {
    if (tid < 64) { const int j = tid & 31, hi = tid >> 5;
        const CFrag f0 = dft_frag(32, j, 8 * hi, true), f1 = dft_frag(32, j, 16 + 8 * hi, true), g = dft_frag(16, j & 15, 8 * hi, j < 16);
        LAS bf16x8* p = (LAS bf16x8*)(T + tid * 48); p[0] = f0.re; p[1] = f0.im; p[2] = f0.nim;
        p = (LAS bf16x8*)(T + (64 + tid) * 48); p[0] = f1.re; p[1] = f1.im; p[2] = f1.nim;
        p = (LAS bf16x8*)(T + (128 + tid) * 48); p[0] = g.re; p[1] = g.im; p[2] = g.nim; }
    __syncthreads();
}
__device__ __forceinline__ void st2(LAS unsigned char* L, int plane_bytes, int idx, cf v) { const unsigned w = cvt_pk_bf16(v.x, v.y); ((LAS bf16_t*)L)[idx] = (bf16_t)(w & 0xffffu); ((LAS bf16_t*)(L + plane_bytes))[idx] = (bf16_t)(w >> 16); }
template <int NK> __device__ __forceinline__ void fwd12(const Consts& C, const bf16x8 (&Bre)[2][NK], const bf16x8 (&Bim)[2][NK], LAS unsigned char* L, const float2* TW1, const float2* TW2, int wave, int j, int hi) {
    asm volatile("" : "+v"(j), "+v"(hi));
#pragma unroll
    for (int tl = 0; tl < 2; ++tl) { const int n2 = 64 * wave + 32 * tl + j; f32x16 dr = {}, di = {};
        cmfma<false>(dr, di, C.get(0), Bre[tl][0], Bim[tl][0]); if constexpr (NK == 2) cmfma<false>(dr, di, C.get(1), Bre[tl][1], Bim[tl][1]);
#pragma unroll
        for (int r = 0; r < 16; ++r) { const int k1 = crow(r, hi); const float2 t = TW1[k1 * 512 + n2]; st2(L, PL_A, (k1 * 16 + (n2 & 15)) * ROWA + (n2 >> 4), cmul((cf){dr[r], di[r]}, (cf){t.x, t.y})); } }
    __syncthreads();
    asm volatile("" : "+v"(j), "+v"(hi));
    bf16x8 yre[2][2], yim[2][2];
#pragma unroll
    for (int tl = 0; tl < 2; ++tl) { const int col = (4 * wave + 2 * tl + (j >> 4)) * 16 + (j & 15);
#pragma unroll
        for (int ks = 0; ks < 2; ++ks) { yre[tl][ks] = *(const LAS bf16x8*)(L + (col * ROWA + 16 * ks + 8 * hi) * 2); yim[tl][ks] = *(const LAS bf16x8*)(L + PL_A + (col * ROWA + 16 * ks + 8 * hi) * 2); } }
    __syncthreads();
    asm volatile("" : "+v"(j), "+v"(hi));
#pragma unroll
    for (int tl = 0; tl < 2; ++tl) { const int k1 = 4 * wave + 2 * tl + (j >> 4), m2 = j & 15; f32x16 dr = {}, di = {};
        cmfma<false>(dr, di, C.get(0), yre[tl][0], yim[tl][0]); cmfma<false>(dr, di, C.get(1), yre[tl][1], yim[tl][1]);
#pragma unroll
        for (int r = 0; r < 16; ++r) { const int j1 = crow(r, hi); const float2 t = TW2[j1 * 16 + m2]; st2(L, PL_B, (k1 * 32 + j1) * ROWB + m2, cmul((cf){dr[r], di[r]}, (cf){t.x, t.y})); } }
    __syncthreads();
}
__device__ __forceinline__ void inv21(const Consts& C, cf (&y)[2][8], LAS unsigned char* L, const float2* TW1, int wave, int j, int hi) {
    asm volatile("" : "+v"(j), "+v"(hi));
    bf16x8 yre[2][2], yim[2][2];
#pragma unroll
    for (int tl = 0; tl < 2; ++tl) { const int col = (4 * wave + 2 * tl + (j >> 4)) * 16 + (j & 15);
#pragma unroll
        for (int ks = 0; ks < 2; ++ks) { yre[tl][ks] = *(const LAS bf16x8*)(L + (col * ROWA + 16 * ks + 8 * hi) * 2); yim[tl][ks] = *(const LAS bf16x8*)(L + PL_A + (col * ROWA + 16 * ks + 8 * hi) * 2); } }
    __syncthreads();
    asm volatile("" : "+v"(j), "+v"(hi));
#pragma unroll
    for (int tl = 0; tl < 2; ++tl) { const int k1 = 4 * wave + 2 * tl + (j >> 4), m2 = j & 15; f32x16 dr = {}, di = {};
        cmfma<true>(dr, di, C.get(0), yre[tl][0], yim[tl][0]); cmfma<true>(dr, di, C.get(1), yre[tl][1], yim[tl][1]);
#pragma unroll
        for (int r = 0; r < 16; ++r) { const int n2 = 16 * crow(r, hi) + m2; const float2 t = TW1[k1 * 512 + n2]; st2(L, PL_A, n2 * ROWA + k1, cmulc((cf){dr[r], di[r]}, (cf){t.x, t.y})); } }
    __syncthreads();
    asm volatile("" : "+v"(j), "+v"(hi));
#pragma unroll
    for (int tl = 0; tl < 2; ++tl) { const int n2 = 64 * wave + 32 * tl + j; f32x16 dr = {}, di = {};
#pragma unroll
        for (int ks = 0; ks < 2; ++ks) { const bf16x8 br = *(const LAS bf16x8*)(L + (n2 * ROWA + 16 * ks + 8 * hi) * 2), bi = *(const LAS bf16x8*)(L + PL_A + (n2 * ROWA + 16 * ks + 8 * hi) * 2);
            cmfma<true>(dr, di, C.get(ks), br, bi); }
#pragma unroll
        for (int r = 0; r < 8; ++r) y[tl][r] = (cf){dr[r], di[r]}; }
    __syncthreads();
}
}
constexpr size_t MiB = 1u << 20;
constexpr size_t WS_CTL = 0, CTL_ZERO_BYTES = 1 * MiB;
constexpr size_t WS_W1T = 1 * MiB;
constexpr size_t WS_W2T = 257 * MiB;
constexpr size_t WS_WIN_EV = 385 * MiB, WS_WOUT_EV = 409 * MiB, WS_WIN_OD = 417 * MiB, WS_WOUT_OD = 433 * MiB, WS_WG_OD = 441 * MiB;
constexpr size_t AR = 445 * MiB;
constexpr size_t A_XB = AR + 0 * MiB, A_UHT = AR + 64 * MiB, A_QB = AR + 160 * MiB, A_KB = AR + 192 * MiB, A_VB = AR + 224 * MiB, A_KTD = AR + 256 * MiB, A_KF = AR + 384 * MiB,
                 A_H3B = AR + 512 * MiB, A_W4T = AR + 514 * MiB, A_YHT = AR + 416 * MiB, A_OA = AR + 448 * MiB, A_YCAT = AR + 512 * MiB, A_XB2 = AR + 0 * MiB, A_R0 = AR + 64 * MiB, A_H1_0 = AR + 192 * MiB,
                 A_HB_0 = AR + 320 * MiB, A_HID_0 = AR + 384 * MiB, A_ROWL = AR + 424 * MiB, A_GATEW = AR + 428 * MiB, A_Y2_0 = AR + 0 * MiB, A_H2 = AR + 448 * MiB, A_HB2 = AR + 448 * MiB;
constexpr size_t A_GB = AR + 0 * MiB, A_XR = AR + 64 * MiB, A_XC = AR + 192 * MiB, A_LA = AR + 256 * MiB, A_BB = AR + 64 * MiB, A_CAR = AR + 384 * MiB, A_YG = AR + 192 * MiB, A_R1 = AR + 256 * MiB,
                 A_H1_1 = AR + 0 * MiB, A_HB8_1 = AR + 0 * MiB, A_XB8 = AR + 320 * MiB, WS_WIN_EV8 = AR + 544 * MiB, A_HB2_8 = AR + 512 * MiB, A_HB8_0 = AR + 192 * MiB, A_HB_1 = AR + 128 * MiB, A_HID_1 = AR + 192 * MiB, A_Y2_1 = AR + 256 * MiB;
constexpr size_t WS_END = AR + 576 * MiB;
constexpr size_t WS_TW1 = WS_CTL + 512 * 1024, WS_TW2 = WS_TW1 + 128 * 1024;
constexpr int CW_BAR = 4096, CW_CNT = 16384, CW_NORM = 24576;
constexpr int LDS_MISC = 139264, LDS_BYTES = 147456;
constexpr int NPHASE = 21;
#ifndef FP8_P1
#define FP8_P1 0
#endif
#ifndef FP8_P1B
#define FP8_P1B 0
#endif
#ifndef FP8_P1C
#define FP8_P1C 0
#endif
#ifndef FP8_P16
#define FP8_P16 1
#endif
#ifndef FP8_P5
#define FP8_P5 1
#endif
#ifndef FP8_P10
#define FP8_P10 1
#endif
#ifndef MOE_FP8_LAYERS
#define MOE_FP8_LAYERS 2
#endif

struct Args { const float* in[37]; float* out; unsigned char* ws; int ph_lo, ph_hi; };
typedef const __attribute__((address_space(4))) Args& KArgs;

template <bool F8> __device__ __forceinline__ void transpose_item(const float* W, int N, int k0, int n0, void* WTv, int ldk, int drow0, float scale, LAS float* scr, int lane) {
#pragma unroll 4
    for (int kk = 0; kk < 64; ++kk) scr[kk * 65 + lane] = W[(size_t)(k0 + kk) * N + n0 + lane];
    LDS_WAIT(); asm volatile("" ::: "memory");
    const int c = lane & 7;
#pragma unroll
    for (int jj = 0; jj < 8; ++jj) { const int n = (lane >> 3) + 8 * jj; const LAS float* s = scr + (8 * c) * 65 + n;
        if constexpr (F8) { u32x2 o; o.x = pg8::pk4_fp8(s[0 * 65] * scale, s[1 * 65] * scale, s[2 * 65] * scale, s[3 * 65] * scale); o.y = pg8::pk4_fp8(s[4 * 65] * scale, s[5 * 65] * scale, s[6 * 65] * scale, s[7 * 65] * scale);
            *(u32x2*)((unsigned char*)WTv + (size_t)(drow0 + n) * ldk + k0 + 8 * c) = o; }
        else { u32x4 o; o.x = pk2(s[0 * 65], s[1 * 65]); o.y = pk2(s[2 * 65], s[3 * 65]); o.z = pk2(s[4 * 65], s[5 * 65]); o.w = pk2(s[6 * 65], s[7 * 65]);
            *(u32x4*)((bf16_t*)WTv + (size_t)(drow0 + n) * ldk + k0 + 8 * c) = o; } }
    LDS_WAIT(); asm volatile("" ::: "memory");
}
__device__ __forceinline__ void phase_prologue(KArgs a, LAS unsigned char* lds) {
    const int tid = opaque_tid(), lane = tid & 63, wave = tid >> 6, G = gridDim.x;
    const int gw = blockIdx.x * 8 + wave, NGW = G * 8;
    unsigned char* ws = a.ws;
    LAS float* scr = (LAS float*)(lds + wave * 16640);
    constexpr int I_EVIN = 32 * 96, I_SQ = 32 * 32, I_ODIN = 32 * 64, I_MOE_GU = 64 * 256, I_MOE_D = 64 * 256, I_RG = 16 * 16, I_W4 = 64;
    constexpr int O1 = I_EVIN, O2 = O1 + I_SQ, O3 = O2 + I_ODIN, O4 = O3 + I_SQ, O5 = O4 + I_MOE_GU, O6 = O5 + I_MOE_GU, O7 = O6 + I_MOE_D, O8 = O7 + I_RG, O9 = O8 + I_RG, O10 = O9 + I_W4;
    for (int it = gw; it < O10; it += NGW) {
        if (it < O1) { const int kb = it / 96, nb = it % 96;
            const bool f8 = (nb * 64 < 3072) ? (FP8_P1C != 0) : (FP8_P1B != 0);
            if (f8) transpose_item<true>(a.in[1], EV_IN, kb * 64, nb * 64, ws + WS_WIN_EV8, DM, nb * 64, pg8::FP8_SW, scr, lane);
            else transpose_item<false>(a.in[1], EV_IN, kb * 64, nb * 64, ws + WS_WIN_EV, DM, nb * 64, 1.f, scr, lane); }
        else if (it < O2) { const int r = it - O1, kb = r / 32, nb = r % 32;
            if (FP8_P5) transpose_item<true>(a.in[18], DM, kb * 64, nb * 64, ws + WS_WOUT_EV, DM, nb * 64, pg8::FP8_SW, scr, lane);
            else transpose_item<false>(a.in[18], DM, kb * 64, nb * 64, ws + WS_WOUT_EV, DM, nb * 64, 1.f, scr, lane); }
        else if (it < O3) { const int r = it - O2, kb = r / 64, nb = r % 64;
            if (FP8_P10) transpose_item<true>(a.in[19], 2 * DM, kb * 64, nb * 64, ws + WS_WIN_OD, DM, nb * 64, pg8::FP8_SW, scr, lane);
            else transpose_item<false>(a.in[19], 2 * DM, kb * 64, nb * 64, ws + WS_WIN_OD, DM, nb * 64, 1.f, scr, lane); }
        else if (it < O4) { const int r = it - O3, kb = r / 32, nb = r % 32;
            if (FP8_P16) transpose_item<true>(a.in[27], DM, kb * 64, nb * 64, ws + WS_WOUT_OD, DM, nb * 64, pg8::FP8_SW, scr, lane);
            else transpose_item<false>(a.in[27], DM, kb * 64, nb * 64, ws + WS_WOUT_OD, DM, nb * 64, 1.f, scr, lane); }
        else if (it < O6) { const bool up = it >= O5; const int r = it - (up ? O5 : O4), le = r / 256, q = r % 256, kb = q / 8, nb = q % 8, n0 = nb * 64;
            const int drow = (n0 >> 7) * 256 + (n0 & 127) + (up ? 128 : 0); const float* src = (up ? a.in[35] : a.in[34]) + (size_t)le * DM * DFF;
            if (le < 32 * (2 - MOE_FP8_LAYERS)) transpose_item<false>(src, DFF, kb * 64, n0, (bf16_t*)(ws + WS_W1T) + (size_t)le * 1024 * DM, DM, drow, 1.f, scr, lane);
            else transpose_item<true>(src, DFF, kb * 64, n0, ws + WS_W1T + (size_t)(le >> 5) * 32 * 1024 * DM * 2 + (size_t)(le & 31) * 1024 * DM, DM, drow, pg8::FP8_SW, scr, lane); }
        else if (it < O7) { const int r = it - O6, le = r / 256, q = r % 256, kb = q / 32, nb = q % 32; const float* src = a.in[36] + (size_t)le * DFF * DM;
            if (le < 32 * (2 - MOE_FP8_LAYERS)) transpose_item<false>(src, DM, kb * 64, nb * 64, (bf16_t*)(ws + WS_W2T) + (size_t)le * DM * DFF, DFF, nb * 64, 1.f, scr, lane);
            else transpose_item<true>(src, DM, kb * 64, nb * 64, ws + WS_W2T + (size_t)(le >> 5) * 32 * DM * DFF * 2 + (size_t)(le & 31) * DM * DFF, DFF, nb * 64, pg8::FP8_SW, scr, lane); }
        else if (it < O9) { const bool wx = it >= O8; const int r = it - (wx ? O8 : O7), dn = r / 16, q = r % 16, kb = q / 4, nb = q % 4, n0 = nb * 64, dir = dn / 8, n = dn % 8;
            transpose_item<false>((wx ? a.in[24] : a.in[22]) + (size_t)dn * 65536, 256, kb * 64, n0, ws + WS_WG_OD, 256, (n * 4 + dir * 2 + (n0 >> 7)) * 256 + (n0 & 127) + (wx ? 128 : 0), 1.f, scr, lane); }
        else { const int nb = it - O9; transpose_item<false>(a.in[11], 4096, 0, nb * 64, ws + A_W4T, 128, nb * 64, 1.f, scr, lane); }
    }
    { const int gt = blockIdx.x * 512 + tid, NT = G * 512;
      for (int i = gt; i < 16384 + 512; i += NT) { float sn, cs;
          if (i < 16384) { const int k1 = i >> 9, n2 = i & 511; sincospif(-2.0f * (float)((k1 * n2) & 16383) * (1.0f / 16384.0f), &sn, &cs); ((float2*)(ws + WS_TW1))[i] = make_float2(cs, sn); }
          else { const int q = i - 16384, j1 = q >> 4, m2 = q & 15; sincospif(-2.0f * (float)((j1 * m2) & 511) * (1.0f / 512.0f), &sn, &cs); ((float2*)(ws + WS_TW2))[q] = make_float2(cs, sn); } }
      for (int i = gt; i < 4096 * 8; i += NT) { const int r = i >> 3, c = i & 7; *(u32x4*)((bf16_t*)(ws + A_W4T) + (size_t)r * 128 + 64 + c * 8) = (u32x4){0u, 0u, 0u, 0u}; }
      for (int i = gt; i < 8192 * 8; i += NT) { const int r = i >> 3, c = i & 7; *(u32x4*)((bf16_t*)(ws + A_H3B) + (size_t)r * 128 + 64 + c * 8) = (u32x4){0u, 0u, 0u, 0u}; }
      const f32x8* x8 = (const f32x8*)a.in[0]; u32x4* xb = (u32x4*)(ws + A_XB);
      u32x2* xb8 = (u32x2*)(ws + A_XB8);
      for (int i = gt; i < NTOK * DM / 8; i += NT) { const f32x8 v = x8[i]; u32x4 o; o.x = pk2(v[0], v[1]); o.y = pk2(v[2], v[3]); o.z = pk2(v[4], v[5]); o.w = pk2(v[6], v[7]); xb[i] = o;
          if (FP8_P1) { u32x2 q; q.x = pg8::pk4_fp8(v[0], v[1], v[2], v[3]); q.y = pg8::pk4_fp8(v[4], v[5], v[6], v[7]); xb8[i] = q; } } }
    { const float* w1 = a.in[4]; const float* b1 = a.in[5]; const float* w2 = a.in[6]; const float* b2 = a.in[7]; const float* w3 = a.in[8]; const float* b3 = a.in[9]; const float* fr = a.in[10];
      const float frq = fr[lane];
      for (int t = gw; t < SEQ; t += NGW) {
          float z;
          { const float tl = (float)t * (1.0f / 8191.0f);
            if (lane == 0) z = tl;
            else { const int j = (lane - 1) & 15; const float band = 1e-4f + (float)j * ((15.0f - 1e-4f) / 15.0f);
                   const float ang = (6.283185307179586f * (float)t * (1.0f / 8192.0f)) * band; float sn, cs; sincosf(ang, &sn, &cs); z = (lane <= 16) ? cs : -sn; } }
          float acc = b1[lane];
#pragma unroll
          for (int i = 0; i < 33; ++i) acc += __shfl(z, i) * w1[i * 64 + lane];
          float h = sinf(frq * acc);
          acc = b2[lane];
#pragma unroll 16
          for (int i = 0; i < 64; ++i) acc += __shfl(h, i) * w2[i * 64 + lane];
          h = sinf(frq * acc);
          acc = b3[lane];
#pragma unroll 16
          for (int i = 0; i < 64; ++i) acc += __shfl(h, i) * w3[i * 64 + lane];
          h = sinf(frq * acc);
          ((bf16_t*)(ws + A_H3B))[(size_t)t * 128 + lane] = (bf16_t)f2bf(h);
      } }
}

__device__ __forceinline__ void filter_unit(KArgs a, LAS unsigned char* lds, int u, int tid) {
    const int lane = tid & 63, wave = tid >> 6;
    LAS f32x2* L = (LAS f32x2*)lds; LAS float* red = (LAS float*)(lds + LDS_MISC + 1024);
    const bf16_t* KTD = (const bf16_t*)(a.ws + A_KTD); __half2* KF = (__half2*)(a.ws + A_KF);
    {
        int tl = tid; asm volatile("" : "+v"(tl));
        const bf16_t* rowF = KTD + (size_t)u * 8192; const bf16_t* rowB = KTD + (size_t)(2048 + u) * 8192;
        hy::cf v[32]; float ss = 0.f;
#pragma unroll
        for (int n1 = 0; n1 < 32; ++n1) { const int p = tl + 512 * n1; float val;
            if (n1 < 16) val = bf2f(rowF[p]); else if (p == 8192) val = 0.f; else val = bf2f(rowB[16384 - p]);
            v[n1] = (hy::cf){val, 0.f}; ss += val * val; }
        ss = wave_sum(ss); if (lane == 0) red[wave] = ss; __syncthreads();
        float tot = 0.f;
#pragma unroll
        for (int w = 0; w < 8; ++w) tot += red[w];
        const float scale = rsqrtf(tot), skp = a.in[12][u];
        hy::fft_fwd12(v, L, tl);
#pragma unroll
        for (int bf = 0; bf < 2; ++bf) { const int idx = bf * 512 + tl, k1 = idx >> 5, j1 = idx & 31; hy::cf w[16];
#pragma unroll
            for (int m2 = 0; m2 < 16; ++m2) w[m2] = hy::lld(L, k1 * hy::RS + 33 * m2 + j1);
            hy::dft_reg<16, false>(w);
#pragma unroll
            for (int j2 = 0; j2 < 16; ++j2) { const hy::cf x = w[hy::brev(j2, 4)]; KF[((size_t)((blockIdx.x * 2 + (u >> 10)) * 2 + bf) * 16 + j2) * 512 + tl] = __floats2half2_rn(x.x * scale + skp, x.y * scale); } }
        __syncthreads();
    }
}
__device__ __forceinline__ float hyconv(const bf16_t* row, int t, float w0, float w1, float w2, float bias) {
    const bf16_t* p = row + t;
    float xm = bf2f(p[-1]), x0 = bf2f(p[0]), xp = bf2f(p[1]);
    xm = t > 0 ? xm : 0.f; xp = t < SEQ - 1 ? xp : 0.f;
    return w0 * xm + w1 * x0 + w2 * xp + bias;
}
__device__ __forceinline__ bf16x8 pack8(const float (&v)[8]) { return __builtin_bit_cast(bf16x8, (u32x4){cvt_pk_bf16(v[0], v[1]), cvt_pk_bf16(v[2], v[3]), cvt_pk_bf16(v[4], v[5]), cvt_pk_bf16(v[6], v[7])}); }
__device__ __forceinline__ void phase_hyena_mixer(KArgs a, LAS unsigned char* lds) {
    const int tid = opaque_tid(), lane = tid & 63, wave = __builtin_amdgcn_readfirstlane(tid >> 6), j = lane & 31, hi = lane >> 5, G = gridDim.x;
    LAS unsigned char* L = lds; LAS float* red = (LAS float*)(lds + LDS_MISC + 1024);
    const bf16_t* UHT = (const bf16_t*)(a.ws + A_UHT); const bf16_t* KTD = (const bf16_t*)(a.ws + A_KTD); bf16_t* YHT = (bf16_t*)(a.ws + A_YHT);
    __half2* KF = (__half2*)(a.ws + A_KF) + (size_t)blockIdx.x * (2 * 32 * 8 * 64);
    const float2* TW1 = (const float2*)(a.ws + WS_TW1); const float2* TW2 = (const float2*)(a.ws + WS_TW2);
    const float* cw = a.in[2]; const float* cb = a.in[3];
    hm::build_ftab(lds + hm::LDS_FTAB, tid); const hm::Consts C{lds + hm::LDS_FTAB, lane};
    for (int c = blockIdx.x; c < HY_CH; c += G) {
        int jl = j, hil = hi, wl = wave; asm volatile("" : "+v"(jl), "+v"(hil), "+s"(wl));
#ifndef HM_NOFILTER
#pragma unroll 1
        for (int o = 0; o < 2; ++o) { const int u = o * 1024 + c;
            const bf16_t* rowF = KTD + (size_t)u * 8192; const bf16_t* rowB = KTD + (size_t)(2048 + u) * 8192;
            bf16x8 Bre[2][2], Bim[2][2]; float ss = 0.f;
#pragma unroll
            for (int tl = 0; tl < 2; ++tl)
#pragma unroll
                for (int ks = 0; ks < 2; ++ks) { float v[8];
#pragma unroll
                    for (int t = 0; t < 8; ++t) { const int p = 64 * wl + 32 * tl + jl + 512 * (16 * ks + 8 * hil + t);
                        if (ks == 0) v[t] = bf2f(rowF[p]); else { const float x = bf2f(rowB[16384 - p]); v[t] = (p == 8192) ? 0.f : x; }
                        ss += v[t] * v[t]; }
                    Bre[tl][ks] = pack8(v); Bim[tl][ks] = (bf16x8){0, 0, 0, 0, 0, 0, 0, 0}; asm volatile("" ::: "memory"); }
            ss = wave_sum(ss); if (lane == 0) red[wave] = ss; __syncthreads();
            float tot = 0.f;
#pragma unroll
            for (int w = 0; w < 8; ++w) tot += red[w];
            const float scale = rsqrtf(tot), skp = a.in[12][u];
            hm::fwd12<2>(C, Bre, Bim, L, TW1, TW2, wl, jl, hil);
#pragma unroll
            for (int q = 0; q < 4; ++q) { const int t3 = 4 * wl + q, colp = 32 * t3 + jl; f32x16 dr = {}, di = {};
                hm::cmfma<false>(dr, di, C.get(2), *(const LAS bf16x8*)(L + (colp * hm::ROWB + 8 * hil) * 2), *(const LAS bf16x8*)(L + hm::PL_B + (colp * hm::ROWB + 8 * hil) * 2));
#pragma unroll
                for (int r = 0; r < 8; ++r) KF[((o * 32 + t3) * 8 + r) * 64 + lane] = __floats2half2_rn(dr[r] * scale + skp, di[r] * scale); asm volatile("" ::: "memory"); }
            __syncthreads();
        }
#endif
        VM_WAIT();
#ifndef HM_NOMIXER
        bf16x8 Zre[2][1], Zim[2][1];
        { const bf16_t* r0 = UHT + (size_t)c * NTOK; const float w0 = cw[c], w1 = cw[3072 + c], w2 = cw[6144 + c], bb = cb[c];
#pragma unroll
          for (int tl = 0; tl < 2; ++tl) { float v0[8], v1[8];
#pragma unroll
              for (int t = 0; t < 8; ++t) { const int tt = 64 * wl + 32 * tl + jl + 512 * (8 * hil + t); v0[t] = hyconv(r0, tt, w0, w1, w2, bb); v1[t] = hyconv(r0 + SEQ, tt, w0, w1, w2, bb); }
              Zre[tl][0] = pack8(v0); Zim[tl][0] = pack8(v1); asm volatile("" ::: "memory"); } }
#pragma unroll 1
        for (int o = 0; o < 2; ++o) {
            hm::fwd12<1>(C, Zre, Zim, L, TW1, TW2, wl, jl, hil);
            int j3 = jl, h3 = hil; asm volatile("" : "+v"(j3), "+v"(h3));
            bf16x8 zre[4], zim[4];
#pragma unroll
            for (int q = 0; q < 4; ++q) { const int colp = 32 * (4 * wl + q) + j3; zre[q] = *(const LAS bf16x8*)(L + (colp * hm::ROWB + 8 * h3) * 2); zim[q] = *(const LAS bf16x8*)(L + hm::PL_B + (colp * hm::ROWB + 8 * h3) * 2); }
            __syncthreads();
            asm volatile("" : "+v"(j3), "+v"(h3));
#pragma unroll
            for (int q = 0; q < 4; ++q) { const int t3 = 4 * wl + q; f32x16 dr = {}, di = {};
                hm::cmfma<false>(dr, di, C.get(2), zre[q], zim[q]);
                float xr[8], xi[8];
#pragma unroll
                for (int r = 0; r < 8; ++r) { const float2 kf = __half22float2(KF[((o * 32 + t3) * 8 + r) * 64 + lane]); const hm::cf x = hm::cmul((hm::cf){dr[r], di[r]}, (hm::cf){kf.x, kf.y}); xr[r] = x.x; xi[r] = x.y; }
                const bf16x8 br = hm::pk4(xr), bi = hm::pk4(xi);
                f32x16 er = {}, ei = {};
                hm::cmfma<true>(er, ei, C.get(2), br, bi);
#pragma unroll
                for (int r = 0; r < 8; ++r) { const int m2 = hm::crow(r, h3); const float2 t = TW2[j3 * 16 + m2]; hm::st2(L, hm::PL_A, (t3 * 16 + m2) * hm::ROWA + j3, hm::cmulc((hm::cf){er[r], ei[r]}, (hm::cf){t.x, t.y})); } asm volatile("" ::: "memory"); }
            __syncthreads();
            hm::cf y[2][8];
            hm::inv21(C, y, L, TW1, wl, jl, hil);
            const int gch = (o + 1) * 1024 + c; const bf16_t* rg = UHT + (size_t)gch * NTOK;
            const float w0 = cw[gch], w1 = cw[3072 + gch], w2 = cw[6144 + gch], bb = cb[gch];
            int jg = jl, hg = hil; asm volatile("" : "+v"(jg), "+v"(hg));
#pragma unroll
            for (int tl = 0; tl < 2; ++tl) { float z0[8], z1[8];
#pragma unroll
                for (int r = 0; r < 8; ++r) { const int tt = 64 * wl + 32 * tl + jg + 512 * hm::crow(r, hg);
                    z0[r] = hyconv(rg, tt, w0, w1, w2, bb) * y[tl][r].x * (1.0f / 16384.0f); z1[r] = hyconv(rg + SEQ, tt, w0, w1, w2, bb) * y[tl][r].y * (1.0f / 16384.0f); }
                asm volatile("" ::: "memory");
                if (o == 0) { Zre[tl][0] = hm::pk4(z0); Zim[tl][0] = hm::pk4(z1); }
                else { bf16_t* yo = YHT + (size_t)c * NTOK;
#pragma unroll
                    for (int r = 0; r < 8; ++r) { const int tt = 64 * wl + 32 * tl + jg + 512 * hm::crow(r, hg); yo[tt] = (bf16_t)f2bf(z0[r]); yo[SEQ + tt] = (bf16_t)f2bf(z1[r]); } } }
        }
#endif
    }
    __syncthreads();
}
__device__ __forceinline__ void phase_qknorm(KArgs a, LAS unsigned char* lds) {
    const int tid = opaque_tid(), lane = tid & 63, wave = tid >> 6, gw = blockIdx.x * 8 + wave, NGW = gridDim.x * 8;
    LAS unsigned* red = (LAS unsigned*)(lds + LDS_MISC + 1536);
    unsigned* ctl = (unsigned*)(a.ws + WS_CTL);
    if (tid < 64) red[tid] = 0u;
    __syncthreads();
    for (int which = 0; which < 2; ++which) { const bf16_t* P = (const bf16_t*)(a.ws + (which ? A_KB : A_QB));
        for (int b = 0; b < 2; ++b) { float mx = 0.f;
            for (int row = gw; row < SEQ; row += NGW) { const bf16_t* p = P + ((size_t)b * SEQ + row) * 1024 + lane * 16;
                const u32x4 w0 = *(const u32x4*)p, w1 = *(const u32x4*)(p + 8); const unsigned ww[8] = {w0.x, w0.y, w0.z, w0.w, w1.x, w1.y, w1.z, w1.w};
                float ss = 0.f;
#pragma unroll
                for (int i = 0; i < 8; ++i) { const float x = bflo(ww[i]), y = bfhi(ww[i]); ss += x * x + y * y; }
                ss += __shfl_xor(ss, 1); ss += __shfl_xor(ss, 2); mx = fmaxf(mx, ss); }
            if ((lane & 3) == 0) atomicMax((unsigned*)&red[which * 32 + b * 16 + (lane >> 2)], __float_as_uint(mx)); } }
    __syncthreads();
    if (tid < 64) atomicMax(ctl + CW_NORM + tid, red[tid]);
}
__device__ __forceinline__ void phase_attention(KArgs a, LAS unsigned char* lds) {
    const int G = gridDim.x, bx = blockIdx.x;
    const bf16_t* QB = (const bf16_t*)(a.ws + A_QB); const bf16_t* KB = (const bf16_t*)(a.ws + A_KB); const bf16_t* VB = (const bf16_t*)(a.ws + A_VB); bf16_t* OA = (bf16_t*)(a.ws + A_OA);
    const unsigned* nrm = (const unsigned*)(a.ws + WS_CTL) + CW_NORM;
    for (int i = 0;; ++i) {
        int bhc, qb;
        if (G == 256) { if (i >= 4) break;
            const int x = bx & 7, combo = x & 3, hh = (x < 4) ? ((i == 0) ? 7 : (i == 1) ? 5 : (i == 2) ? 1 : 0) : ((i == 0) ? 6 : (i == 1) ? 4 : (i == 2) ? 3 : 2); bhc = (combo >> 1) * 16 + hh * 2 + (combo & 1); qb = bx >> 3; }
        else { const int Lu = i * G + bx; if (Lu >= 1024) break; bhc = Lu >> 5; qb = Lu & 31; }
        const int b = bhc >> 4, h = (bhc >> 1) & 7, cm = bhc & 1;
        const size_t rowq = (size_t)b * SEQ + (size_t)qb * 256;
        const float sl2 = exp2f(-(float)(h + 1)) * 1.4426950408889634f;
        const float qk = sqrtf(__uint_as_float(nrm[bhc]) * __uint_as_float(nrm[32 + bhc]));
        const float Wk = (2.0f * qk + 38.0f) / sl2, q0f = (float)(qb * 256);
        int t_lo = (int)fmaxf(floorf((q0f - Wk - 63.0f) * (1.0f / 64.0f)), 0.0f), t_hi = (int)fminf(ceilf((q0f + 255.0f + Wk) * (1.0f / 64.0f)), 127.0f);
        if (((t_hi - t_lo + 1) & 1) != 0) { if (t_hi < 127) ++t_hi; else --t_lo; }
        att::attn_unit(QB + rowq * 1024 + h * 128 + cm * 64, KB + (size_t)b * SEQ * 1024 + h * 128 + cm * 64, VB + (size_t)b * SEQ * 1024 + h * 128,
                       OA + (size_t)cm * NTOK * 1024 + rowq * 1024 + h * 128, qb * 256, t_lo, t_hi - t_lo + 1, sl2, (char*)lds);
    }
}
__device__ __forceinline__ void phase_concat(KArgs a, LAS unsigned char* lds) {
    const int tid = opaque_tid(), lane = tid & 63, wave = tid >> 6, G = gridDim.x;
    const bf16_t* YHT = (const bf16_t*)(a.ws + A_YHT); const bf16_t* OA0 = (const bf16_t*)(a.ws + A_OA); const bf16_t* OA1 = OA0 + (size_t)NTOK * 1024; bf16_t* YC = (bf16_t*)(a.ws + A_YCAT);
    LAS bf16_t* T = (LAS bf16_t*)lds;
    const float lambda_init = 0.2f;
    const float lam = __expf(wave_sum(a.in[13][lane] * a.in[14][lane])) - __expf(wave_sum(a.in[15][lane] * a.in[16][lane])) + lambda_init;
    float gl[16];
#pragma unroll
    for (int i = 0; i < 16; ++i) gl[i] = a.in[17][(lane & 7) * 16 + i] * (1.0f - lambda_init);
    for (int it = blockIdx.x; it < NTOK / 64; it += G) {
        const int tok0 = it * 64;
#pragma unroll 4
        for (int k = 0; k < 16; ++k) { const int idx = tid + 512 * k, c = idx >> 3, ch = idx & 7;
            const u32x4 w = *(const u32x4*)(YHT + (size_t)c * NTOK + tok0 + ch * 8);
            LAS bf16_t* d = T + (ch * 8) * 1026 + c;
            d[0 * 1026] = (bf16_t)(w.x & 0xffff); d[1 * 1026] = (bf16_t)(w.x >> 16); d[2 * 1026] = (bf16_t)(w.y & 0xffff); d[3 * 1026] = (bf16_t)(w.y >> 16);
            d[4 * 1026] = (bf16_t)(w.z & 0xffff); d[5 * 1026] = (bf16_t)(w.z >> 16); d[6 * 1026] = (bf16_t)(w.w & 0xffff); d[7 * 1026] = (bf16_t)(w.w >> 16); }
        __syncthreads();
#pragma unroll 4
        for (int k = 0; k < 16; ++k) { const int idx = tid + 512 * k, tl = idx >> 7, c8 = idx & 127;
            const LAS unsigned* s = (const LAS unsigned*)(T + tl * 1026 + c8 * 8);
            u32x4 w; w.x = s[0]; w.y = s[1]; w.z = s[2]; w.w = s[3];
            if (FP8_P5) { u32x2 q; q.x = pg8::pk4_fp8(bflo(w.x), bfhi(w.x), bflo(w.y), bfhi(w.y)); q.y = pg8::pk4_fp8(bflo(w.z), bfhi(w.z), bflo(w.w), bfhi(w.w)); *(u32x2*)((unsigned char*)YC + (size_t)(tok0 + tl) * DM + c8 * 8) = q; }
            else *(u32x4*)(YC + (size_t)(tok0 + tl) * DM + c8 * 8) = w; }
        for (int rr = 0; rr < 8; ++rr) { const size_t tok = (size_t)tok0 + wave * 8 + rr;
            const u32x4 p0 = *(const u32x4*)(OA0 + tok * 1024 + lane * 16), p1 = *(const u32x4*)(OA0 + tok * 1024 + lane * 16 + 8);
            const u32x4 q0 = *(const u32x4*)(OA1 + tok * 1024 + lane * 16), q1 = *(const u32x4*)(OA1 + tok * 1024 + lane * 16 + 8);
            const unsigned pw[8] = {p0.x, p0.y, p0.z, p0.w, p1.x, p1.y, p1.z, p1.w}, qw[8] = {q0.x, q0.y, q0.z, q0.w, q1.x, q1.y, q1.z, q1.w};
            float o[16]; float ss = 0.f;
#pragma unroll
            for (int i = 0; i < 8; ++i) { o[2 * i] = bflo(pw[i]) - lam * bflo(qw[i]); o[2 * i + 1] = bfhi(pw[i]) - lam * bfhi(qw[i]); ss += o[2 * i] * o[2 * i] + o[2 * i + 1] * o[2 * i + 1]; }
            ss += __shfl_xor(ss, 1); ss += __shfl_xor(ss, 2); ss += __shfl_xor(ss, 4);
            const float rs = rsqrtf(ss * (1.0f / 128.0f) + LN_EPS);
            u32x4 w0, w1;
            w0.x = pk2(o[0] * rs * gl[0], o[1] * rs * gl[1]); w0.y = pk2(o[2] * rs * gl[2], o[3] * rs * gl[3]); w0.z = pk2(o[4] * rs * gl[4], o[5] * rs * gl[5]); w0.w = pk2(o[6] * rs * gl[6], o[7] * rs * gl[7]);
            w1.x = pk2(o[8] * rs * gl[8], o[9] * rs * gl[9]); w1.y = pk2(o[10] * rs * gl[10], o[11] * rs * gl[11]); w1.z = pk2(o[12] * rs * gl[12], o[13] * rs * gl[13]); w1.w = pk2(o[14] * rs * gl[14], o[15] * rs * gl[15]);
            if (FP8_P5) { u32x4 q; q.x = pg8::pk4_fp8(o[0] * rs * gl[0], o[1] * rs * gl[1], o[2] * rs * gl[2], o[3] * rs * gl[3]); q.y = pg8::pk4_fp8(o[4] * rs * gl[4], o[5] * rs * gl[5], o[6] * rs * gl[6], o[7] * rs * gl[7]);
                q.z = pg8::pk4_fp8(o[8] * rs * gl[8], o[9] * rs * gl[9], o[10] * rs * gl[10], o[11] * rs * gl[11]); q.w = pg8::pk4_fp8(o[12] * rs * gl[12], o[13] * rs * gl[13], o[14] * rs * gl[14], o[15] * rs * gl[15]);
                *(u32x4*)((unsigned char*)YC + tok * DM + 1024 + lane * 16) = q; }
            else { *(u32x4*)(YC + tok * DM + 1024 + lane * 16) = w0; *(u32x4*)(YC + tok * DM + 1024 + lane * 16 + 8) = w1; } }
        __syncthreads();
    }
}
__device__ __forceinline__ void ln_row(f32x4 (&v)[8], const float* g, const float* b, int lane, float& mu, float& rs) {
    float s = 0.f;
#pragma unroll
    for (int j = 0; j < 8; ++j) s += (v[j][0] + v[j][1]) + (v[j][2] + v[j][3]);
    const float mean = wave_sum(s) * (1.0f / DM); float s2 = 0.f;
#pragma unroll
    for (int j = 0; j < 8; ++j) { v[j] = v[j] - mean; s2 += (v[j][0] * v[j][0] + v[j][1] * v[j][1]) + (v[j][2] * v[j][2] + v[j][3] * v[j][3]); }
    const float rstd = rsqrtf(wave_sum(s2) * (1.0f / DM) + LN_EPS); mu = mean; rs = rstd;
#pragma unroll
    for (int j = 0; j < 8; ++j) { const f32x4 gg = *(const f32x4*)(g + 4 * (lane + 64 * j)), bb = *(const f32x4*)(b + 4 * (lane + 64 * j)); v[j] = v[j] * rstd * gg + bb; }
}
__device__ __forceinline__ void phase_ln_router(KArgs a, LAS unsigned char* lds, const bf16_t* R, const float* g, const float* b, bf16_t* HB, unsigned char* HB8, unsigned* cnt, int* rowlist, float* gatew) {
    const int tid = opaque_tid(), lane = tid & 63, wave = tid >> 6, G = gridDim.x;
    const float* rw = a.in[32]; const float* rb = a.in[33];
    LAS float* part = (LAS float*)lds;
    LAS int* hist = (LAS int*)(lds + 40960); LAS int* base = hist + 32; LAS float* stats = (LAS float*)(lds + 40960 + 512);
    for (int it = blockIdx.x; it < NTOK / 32; it += G) {
        const int tok0 = it * 32;
        for (int rr = 0; rr < 4; ++rr) { const size_t row = (size_t)tok0 + wave * 4 + rr; f32x4 v[8]; float mu, rs;
#pragma unroll
            for (int j = 0; j < 8; ++j) { const u32x2 w = *(const u32x2*)(R + row * DM + 4 * (lane + 64 * j)); v[j] = (f32x4){bflo(w.x), bfhi(w.x), bflo(w.y), bfhi(w.y)}; }
            ln_row(v, g, b, lane, mu, rs);
            if (lane == 0) { stats[(wave * 4 + rr) * 2] = mu; stats[(wave * 4 + rr) * 2 + 1] = rs; }
#pragma unroll
            for (int j = 0; j < 8; ++j) { u32x2 w; w.x = pk2(v[j][0], v[j][1]); w.y = pk2(v[j][2], v[j][3]); *(u32x2*)(HB + row * DM + 4 * (lane + 64 * j)) = w;
                if (HB8) *(unsigned*)(HB8 + row * DM + 4 * (lane + 64 * j)) = pg8::pk4_fp8(v[j][0], v[j][1], v[j][2], v[j][3]); } }
        if (tid < 32) hist[tid] = 0;
        __syncthreads();
        { const int i = lane & 31, kk = lane >> 5; f32x16 acc = {};
          const float mu = stats[i * 2], rs = stats[i * 2 + 1];
          const bf16_t* rrow = R + (size_t)(tok0 + i) * DM + wave * 256 + 4 * kk; const float* gp = g + wave * 256 + 4 * kk; const float* bp = b + wave * 256 + 4 * kk;
          const float* rwp = rw + (size_t)(wave * 256 + 4 * kk) * NEXP + i;
#pragma unroll 4
          for (int s = 0; s < 32; ++s) { const u32x2 rw2 = *(const u32x2*)(rrow + 8 * s); const f32x4 hv = ((f32x4){bflo(rw2.x), bfhi(rw2.x), bflo(rw2.y), bfhi(rw2.y)} - mu) * rs * *(const f32x4*)(gp + 8 * s) + *(const f32x4*)(bp + 8 * s);
#pragma unroll
              for (int j = 0; j < 4; ++j) acc = __builtin_amdgcn_mfma_f32_32x32x2f32(rwp[(size_t)(8 * s + j) * NEXP], hv[j], acc, 0, 0, 0); }
#pragma unroll
          for (int r = 0; r < 16; ++r) part[(wave * 32 + i) * 33 + (r & 3) + 8 * (r >> 2) + 4 * kk] = acc[r]; }
        __syncthreads();
        int e1 = 0, e2 = 0, r1 = 0, r2 = 0; float g1 = 0.f, g2 = 0.f;
        if (tid < 32) {
            float bestg = -1e30f;
#pragma unroll
            for (int gi = 0; gi < 4; ++gi) { float m1 = -1e30f, m2 = -1e30f, s1 = 0.f, s2 = 0.f; int i1 = 0, i2 = 0;
#pragma unroll
                for (int j = 0; j < 8; ++j) { const int e = gi * 8 + j; float lg = 0.f;
#pragma unroll
                    for (int w = 0; w < 8; ++w) lg += part[(w * 32 + tid) * 33 + e];
                    const float sg = 1.0f / (1.0f + expf(-lg)), sl = sg + rb[e];
                    if (sl > m1) { m2 = m1; i2 = i1; s2 = s1; m1 = sl; i1 = j; s1 = sg; } else if (sl > m2) { m2 = sl; i2 = j; s2 = sg; } }
                const float gs = m1 + m2;
                if (gs > bestg) { bestg = gs; e1 = gi * 8 + i1; e2 = gi * 8 + i2; g1 = s1; g2 = s2; } }
            const float inv = 1.0f / (g1 + g2); g1 *= inv; g2 *= inv;
            r1 = atomicAdd((int*)&hist[e1], 1); r2 = atomicAdd((int*)&hist[e2], 1);
        }
        __syncthreads();
        if (tid < 32) { const int hc = hist[tid]; base[tid] = hc ? (int)__hip_atomic_fetch_add(cnt + tid * 64, (unsigned)hc, __ATOMIC_RELAXED, __HIP_MEMORY_SCOPE_AGENT) : 0; }
        __syncthreads();
        if (tid < 32) { const int a0 = (tok0 + tid) * 2;
            rowlist[(size_t)e1 * ECAP + base[e1] + r1] = a0; gatew[a0] = g1;
            rowlist[(size_t)e2 * ECAP + base[e2] + r2] = a0 + 1; gatew[a0 + 1] = g2; }
        __syncthreads();
    }
}
__device__ __forceinline__ void phase_ln2(const bf16_t* HB, const bf16_t* Y2, const float* g, const float* b, float* OUT, bf16_t* OB, unsigned char* OB8) {
    const int tid = opaque_tid(), lane = tid & 63, wave = tid >> 6;
    for (int row = blockIdx.x * 8 + wave; row < NTOK; row += gridDim.x * 8) { f32x4 v[8]; float mu, rs;
#pragma unroll
        for (int j = 0; j < 8; ++j) { const int c = 4 * (lane + 64 * j); const u32x2 h = *(const u32x2*)(HB + (size_t)row * DM + c);
            const u32x2 y0 = *(const u32x2*)(Y2 + (size_t)(2 * row) * DM + c), y1 = *(const u32x2*)(Y2 + (size_t)(2 * row + 1) * DM + c);
            v[j] = (f32x4){bflo(h.x), bfhi(h.x), bflo(h.y), bfhi(h.y)} * DN_ALPHA + (f32x4){bflo(y0.x) + bflo(y1.x), bfhi(y0.x) + bfhi(y1.x), bflo(y0.y) + bflo(y1.y), bfhi(y0.y) + bfhi(y1.y)}; }
        ln_row(v, g, b, lane, mu, rs);
#pragma unroll
        for (int j = 0; j < 8; ++j) { const int c = 4 * (lane + 64 * j); if (OUT) *(f32x4*)(OUT + (size_t)row * DM + c) = v[j];
            if (OB) { u32x2 w; w.x = pk2(v[j][0], v[j][1]); w.y = pk2(v[j][2], v[j][3]); *(u32x2*)(OB + (size_t)row * DM + c) = w; }
            if (OB8) *(unsigned*)(OB8 + (size_t)row * DM + c) = pg8::pk4_fp8(v[j][0], v[j][1], v[j][2], v[j][3]); }
    }
}
__device__ __forceinline__ void moe_table(LAS int* tab, const unsigned* cnt) {
    __syncthreads();
    const int tid = opaque_tid();
    if (tid < 32) tab[64 + tid] = (int)cnt[tid * 64];
    __syncthreads();
    if (tid == 0) { int acc = 0; for (int e = 0; e < 32; ++e) { tab[e] = acc; acc += (tab[64 + e] + 255) >> 8; } tab[32] = acc; }
    __syncthreads();
}
__device__ __forceinline__ void phase_conv4(KArgs a) {
    const bf16_t* XR = (const bf16_t*)(a.ws + A_XR); bf16_t* XC = (bf16_t*)(a.ws + A_XC); const float* cw = a.in[20]; const float* cb = a.in[21];
    const int NT = gridDim.x * 512;
    for (int it = blockIdx.x * 512 + opaque_tid(); it < NTOK * 256; it += NT) { const int tok = it >> 8, ch = (it & 255) * 8, t = tok & (SEQ - 1);
        float acc[8];
#pragma unroll
        for (int i = 0; i < 8; ++i) acc[i] = cb[ch + i];
#pragma unroll
        for (int j = 0; j < 4; ++j) { const int tt = t + j - 2;
            if (tt >= 0 && tt < SEQ) { const u32x4 w = *(const u32x4*)(XR + (size_t)(tok + j - 2) * DM + ch); const unsigned ww[4] = {w.x, w.y, w.z, w.w};
#pragma unroll
                for (int i = 0; i < 4; ++i) { acc[2 * i] += cw[j * DM + ch + 2 * i] * bflo(ww[i]); acc[2 * i + 1] += cw[j * DM + ch + 2 * i + 1] * bfhi(ww[i]); } } }
        u32x4 o; o.x = pk2(acc[0], acc[1]); o.y = pk2(acc[2], acc[3]); o.z = pk2(acc[4], acc[5]); o.w = pk2(acc[6], acc[7]);
        *(u32x4*)(XC + (size_t)tok * DM + ch) = o; }
}
constexpr size_t CAR_ELEMS = (size_t)2 * 2 * 256 * DM;
__device__ __forceinline__ void phase_scan1(KArgs a) {
    const bf16_t* LA = (const bf16_t*)(a.ws + A_LA); const bf16_t* BB = (const bf16_t*)(a.ws + A_BB); float* CARA = (float*)(a.ws + A_CAR); float* CARB = CARA + CAR_ELEMS;
    const int NT = gridDim.x * 512;
    for (int it = blockIdx.x * 512 + opaque_tid(); it < 2 * 2 * 256 * 512; it += NT) { const int ch = (it & 511) * 4, chunk = (it >> 9) & 255, dir = (it >> 17) & 1, b = it >> 18;
        float h[4] = {0.f, 0.f, 0.f, 0.f}, ls[4] = {0.f, 0.f, 0.f, 0.f};
#pragma unroll 8
        for (int s = 0; s < 32; ++s) { const int t = chunk * 32 + (dir ? 31 - s : s); const size_t off = ((size_t)dir * NTOK + (size_t)b * SEQ + t) * DM + ch;
            const u32x2 lw = *(const u32x2*)(LA + off), bw = *(const u32x2*)(BB + off);
            const float l4[4] = {bflo(lw.x), bfhi(lw.x), bflo(lw.y), bfhi(lw.y)}, b4[4] = {bflo(bw.x), bfhi(bw.x), bflo(bw.y), bfhi(bw.y)};
#pragma unroll
            for (int i = 0; i < 4; ++i) { h[i] = __expf(l4[i]) * h[i] + b4[i]; ls[i] += l4[i]; } }
        const size_t co = (((size_t)b * 2 + dir) * 256 + chunk) * DM + ch;
        *(f32x4*)(CARA + co) = (f32x4){ls[0], ls[1], ls[2], ls[3]}; *(f32x4*)(CARB + co) = (f32x4){h[0], h[1], h[2], h[3]}; }
}
__device__ __forceinline__ void phase_scan2(KArgs a, LAS unsigned char* lds) {
    float* CARA = (float*)(a.ws + A_CAR); float* CARB = CARA + CAR_ELEMS; float* CARIN = CARB + CAR_ELEMS;
    const int tid = opaque_tid(), grp = tid >> 5, chl = tid & 31;
    LAS float* sh = (LAS float*)lds;
    for (int it = blockIdx.x; it < 2 * 2 * 64; it += gridDim.x) { const int ch = (it & 63) * 32 + chl, dir = (it >> 6) & 1, b = it >> 7;
        float la[16], lb[16]; float A = 0.f, B = 0.f;
#pragma unroll
        for (int k = 0; k < 16; ++k) { const int q = grp * 16 + k, chunk = dir ? 255 - q : q; const size_t co = (((size_t)b * 2 + dir) * 256 + chunk) * DM + ch; la[k] = CARA[co]; lb[k] = CARB[co]; }
#pragma unroll
        for (int k = 0; k < 16; ++k) { B = __expf(la[k]) * B + lb[k]; A += la[k]; }
        sh[(grp * 32 + chl) * 2] = A; sh[(grp * 32 + chl) * 2 + 1] = B;
        __syncthreads();
        float h = 0.f;
        for (int g2 = 0; g2 < grp; ++g2) h = __expf(sh[(g2 * 32 + chl) * 2]) * h + sh[(g2 * 32 + chl) * 2 + 1];
#pragma unroll
        for (int k = 0; k < 16; ++k) { const int q = grp * 16 + k, chunk = dir ? 255 - q : q; const size_t co = (((size_t)b * 2 + dir) * 256 + chunk) * DM + ch; CARIN[co] = h; h = __expf(la[k]) * h + lb[k]; }
        __syncthreads();
    }
}
__device__ __forceinline__ float gelu_tanh(float x) { const float u = 0.7978845608028654f * (x + 0.044715f * x * x * x); const float th = 1.0f - 2.0f * __builtin_amdgcn_rcpf(1.0f + __builtin_amdgcn_exp2f(2.8853900817779268f * u)); return 0.5f * x * (1.0f + th); }
__device__ __forceinline__ void phase_scan3(KArgs a) {
    const bf16_t* LA = (const bf16_t*)(a.ws + A_LA); const bf16_t* BB = (const bf16_t*)(a.ws + A_BB); const bf16_t* GB = (const bf16_t*)(a.ws + A_GB); bf16_t* YG = (bf16_t*)(a.ws + A_YG);
    const float* CARIN = (const float*)(a.ws + A_CAR) + 2 * CAR_ELEMS;
    const int NT = gridDim.x * 512;
    for (int it = blockIdx.x * 512 + opaque_tid(); it < 2 * 256 * 512; it += NT) { const int ch = (it & 511) * 4, chunk = (it >> 9) & 255, b = it >> 17;
        float hf[32][4]; float h[4];
        { const f32x4 c = *(const f32x4*)(CARIN + (((size_t)b * 2 + 0) * 256 + chunk) * DM + ch); h[0] = c[0]; h[1] = c[1]; h[2] = c[2]; h[3] = c[3]; }
#pragma unroll
        for (int s = 0; s < 32; ++s) { const size_t off = ((size_t)b * SEQ + chunk * 32 + s) * DM + ch;
            const u32x2 lw = *(const u32x2*)(LA + off), bw = *(const u32x2*)(BB + off);
            const float l4[4] = {bflo(lw.x), bfhi(lw.x), bflo(lw.y), bfhi(lw.y)}, b4[4] = {bflo(bw.x), bfhi(bw.x), bflo(bw.y), bfhi(bw.y)};
#pragma unroll
            for (int i = 0; i < 4; ++i) { h[i] = __expf(l4[i]) * h[i] + b4[i]; hf[s][i] = h[i]; } }
        { const f32x4 c = *(const f32x4*)(CARIN + (((size_t)b * 2 + 1) * 256 + chunk) * DM + ch); h[0] = c[0]; h[1] = c[1]; h[2] = c[2]; h[3] = c[3]; }
#pragma unroll
        for (int s = 31; s >= 0; --s) { const size_t tokoff = ((size_t)b * SEQ + chunk * 32 + s) * DM + ch; const size_t off = (size_t)NTOK * DM + tokoff;
            const u32x2 lw = *(const u32x2*)(LA + off), bw = *(const u32x2*)(BB + off), gw = *(const u32x2*)(GB + tokoff);
            const float l4[4] = {bflo(lw.x), bfhi(lw.x), bflo(lw.y), bfhi(lw.y)}, b4[4] = {bflo(bw.x), bfhi(bw.x), bflo(bw.y), bfhi(bw.y)}, g4[4] = {bflo(gw.x), bfhi(gw.x), bflo(gw.y), bfhi(gw.y)};
            float y[4];
#pragma unroll
            for (int i = 0; i < 4; ++i) { h[i] = __expf(l4[i]) * h[i] + b4[i]; y[i] = gelu_tanh(g4[i]) * (hf[s][i] + h[i]); }
            if (FP8_P16) { *(unsigned*)((unsigned char*)YG + tokoff) = pg8::pk4_fp8(4.0f * y[0], 4.0f * y[1], 4.0f * y[2], 4.0f * y[3]); }
            else { u32x2 w; w.x = pk2(y[0], y[1]); w.y = pk2(y[2], y[3]); *(u32x2*)(YG + tokoff) = w; } } }
}

#define KARGS() (*(const __attribute__((address_space(4))) Args*)__builtin_amdgcn_kernarg_segment_ptr())
#define PHASE_FN __device__ __forceinline__ void
#define PH_PRE() KArgs a = KARGS(); LAS unsigned char* lds = (LAS unsigned char*)lds_raw; unsigned char* ws = a.ws; asm volatile("" : "+s"(ws)); const int G = gridDim.x, bx = blockIdx.x; (void)lds; (void)ws; (void)G; (void)bx; using namespace pg8
PHASE_FN ph0() { PH_PRE(); phase_prologue(a, lds); }
PHASE_FN ph1a() { PH_PRE(); Gemm g{(const bf16_t*)(ws + A_W4T), (const bf16_t*)(ws + A_H3B), 128, 128, 128}; StaticOrder S; S.init(4096, 8192, G, bx); EpiFilt E{(bf16_t*)(ws + A_KTD)}; gemm_phase(lds, g, S, E); }
PHASE_FN ph1b() { PH_PRE(); StaticOrder S; S.init(NTOK, 3072, G, bx);
    if constexpr (FP8_P1B) { Gemm g{(const bf16_t*)(ws + A_XB8), (const bf16_t*)(ws + WS_WIN_EV8 + (size_t)3072 * DM), DM / 2, DM / 2, DM / 2};
        EpiBf16 E{(bf16_t*)(ws + A_QB), 1024, 1024, (size_t)(A_KB - A_QB) / 2, QSCALE, 1.0f / FP8_SW}; gemm_phase<EpiBf16, StaticOrder, true>(lds, g, S, E); }
    else { Gemm g{(const bf16_t*)(ws + A_XB), (const bf16_t*)(ws + WS_WIN_EV) + (size_t)3072 * DM, DM, DM, DM};
        EpiBf16 E{(bf16_t*)(ws + A_QB), 1024, 1024, (size_t)(A_KB - A_QB) / 2, QSCALE}; gemm_phase(lds, g, S, E); } }
PHASE_FN ph1c() { PH_PRE(); StaticOrder S; S.init(3072, NTOK, G, bx);
    if constexpr (FP8_P1C) { Gemm g{(const bf16_t*)(ws + WS_WIN_EV8), (const bf16_t*)(ws + A_XB8), DM / 2, DM / 2, DM / 2};
        EpiBf16 E{(bf16_t*)(ws + A_UHT), NTOK, 0, 0, 1.f, 1.0f / FP8_SW}; gemm_phase<EpiBf16, StaticOrder, true>(lds, g, S, E); }
    else { Gemm g{(const bf16_t*)(ws + WS_WIN_EV), (const bf16_t*)(ws + A_XB), DM, DM, DM};
        EpiBf16 E{(bf16_t*)(ws + A_UHT), NTOK, 0, 0, 1.f}; gemm_phase(lds, g, S, E); } }
PHASE_FN ph2() { PH_PRE(); phase_qknorm(a, lds); }
PHASE_FN ph3a() { PH_PRE(); phase_hyena_mixer(a, lds); }
PHASE_FN ph3b() { PH_PRE(); phase_attention(a, lds); }
PHASE_FN ph4() { PH_PRE(); phase_concat(a, lds); }
PHASE_FN ph5() { PH_PRE(); StaticOrder S; S.init(NTOK, DM, G, bx);
    if constexpr (FP8_P5) { Gemm g{(const bf16_t*)(ws + A_YCAT), (const bf16_t*)(ws + WS_WOUT_EV), DM / 2, DM / 2, DM / 2};
        EpiResBf E{(const bf16_t*)(ws + A_XB2), (bf16_t*)(ws + A_R0), DM, DN_ALPHA, 1.0f / FP8_SW}; gemm_phase<EpiResBf, StaticOrder, true>(lds, g, S, E); }
    else { Gemm g{(const bf16_t*)(ws + A_YCAT), (const bf16_t*)(ws + WS_WOUT_EV), DM, DM, DM};
        EpiResBf E{(const bf16_t*)(ws + A_XB2), (bf16_t*)(ws + A_R0), DM, DN_ALPHA}; gemm_phase(lds, g, S, E); } }
template <int LAYER> PHASE_FN ph_lnr() { PH_PRE(); unsigned* ctl = (unsigned*)(ws + WS_CTL);
    phase_ln_router(a, lds, (const bf16_t*)(ws + (LAYER ? A_R1 : A_R0)), a.in[28] + LAYER * DM, a.in[29] + LAYER * DM, (bf16_t*)(ws + (LAYER ? A_HB_1 : A_HB_0)), (LAYER >= 2 - MOE_FP8_LAYERS) ? ws + (LAYER ? A_HB8_1 : A_HB8_0) : nullptr,
                    ctl + CW_CNT + LAYER * 32 * 64, (int*)(ws + A_ROWL), (float*)(ws + A_GATEW)); }
template <int LAYER> PHASE_FN ph_moe1() { PH_PRE(); LAS int* tab = (LAS int*)(lds + LDS_MISC); moe_table(tab, (const unsigned*)(ws + WS_CTL) + CW_CNT + LAYER * 32 * 64);
    MoeOrder<4, true> S{G, bx, tab, (const int*)(ws + A_ROWL)};
    if constexpr (LAYER >= 2 - MOE_FP8_LAYERS) {
        Gemm g{(const bf16_t*)(ws + (LAYER ? A_HB8_1 : A_HB8_0)), (const bf16_t*)(ws + WS_W1T + (size_t)LAYER * 32 * 1024 * DM * 2), DM / 2, DM / 2, DM / 2};
        EpiSwiglu8 E{ws + (LAYER ? A_HID_1 : A_HID_0)}; gemm_phase<EpiSwiglu8, MoeOrder<4, true>, true>(lds, g, S, E);
    } else {
        Gemm g{(const bf16_t*)(ws + (LAYER ? A_HB_1 : A_HB_0)), (const bf16_t*)(ws + WS_W1T) + (size_t)LAYER * 32 * 1024 * DM, DM, DM, DM};
        EpiSwiglu E{(bf16_t*)(ws + (LAYER ? A_HID_1 : A_HID_0))}; gemm_phase(lds, g, S, E); } }
template <int LAYER> PHASE_FN ph_moe2() { PH_PRE(); LAS int* tab = (LAS int*)(lds + LDS_MISC); moe_table(tab, (const unsigned*)(ws + WS_CTL) + CW_CNT + LAYER * 32 * 64);
    MoeOrder<8, false> S{G, bx, tab, (const int*)(ws + A_ROWL)};
    if constexpr (LAYER >= 2 - MOE_FP8_LAYERS) {
        Gemm g{(const bf16_t*)(ws + (LAYER ? A_HID_1 : A_HID_0)), (const bf16_t*)(ws + WS_W2T + (size_t)LAYER * 32 * DM * DFF * 2), DFF / 2, DFF / 2, DFF / 2};
        EpiDown E{(bf16_t*)(ws + (LAYER ? A_Y2_1 : A_Y2_0)), (const int*)(ws + A_ROWL), (const float*)(ws + A_GATEW), 1.0f / (FP8_SW * FP8_SH)};
        gemm_phase<EpiDown, MoeOrder<8, false>, true>(lds, g, S, E);
    } else {
        Gemm g{(const bf16_t*)(ws + (LAYER ? A_HID_1 : A_HID_0)), (const bf16_t*)(ws + WS_W2T) + (size_t)LAYER * 32 * DM * DFF, DFF, DFF, DFF};
        EpiDown E{(bf16_t*)(ws + (LAYER ? A_Y2_1 : A_Y2_0)), (const int*)(ws + A_ROWL), (const float*)(ws + A_GATEW), 1.0f}; gemm_phase(lds, g, S, E); } }
template <int LAYER> PHASE_FN ph_ln2() { PH_PRE();
    phase_ln2((const bf16_t*)(ws + (LAYER ? A_HB_1 : A_HB_0)), (const bf16_t*)(ws + (LAYER ? A_Y2_1 : A_Y2_0)), a.in[30] + LAYER * DM, a.in[31] + LAYER * DM, LAYER ? a.out : nullptr, LAYER ? nullptr : (bf16_t*)(ws + A_HB2), (!LAYER && FP8_P10) ? ws + A_HB2_8 : nullptr); }
PHASE_FN ph10() { PH_PRE(); StaticOrder S; S.init(NTOK, 2 * DM, G, bx);
    if constexpr (FP8_P10) { Gemm g{(const bf16_t*)(ws + A_HB2_8), (const bf16_t*)(ws + WS_WIN_OD), DM / 2, DM / 2, DM / 2};
        EpiBf16 E{(bf16_t*)(ws + A_GB), DM, DM, (size_t)(A_XR - A_GB) / 2, 1.f, 1.0f / FP8_SW}; gemm_phase<EpiBf16, StaticOrder, true>(lds, g, S, E); }
    else { Gemm g{(const bf16_t*)(ws + A_HB2), (const bf16_t*)(ws + WS_WIN_OD), DM, DM, DM};
        EpiBf16 E{(bf16_t*)(ws + A_GB), DM, DM, (size_t)(A_XR - A_GB) / 2, 1.f}; gemm_phase(lds, g, S, E); } }
PHASE_FN ph11() { PH_PRE(); phase_conv4(a); }
PHASE_FN ph12() { PH_PRE(); Gemm g{(const bf16_t*)(ws + A_XC), (const bf16_t*)(ws + WS_WG_OD), DM, 256, 256}; RGOrder S{G, bx};
                  EpiRG E{(bf16_t*)(ws + A_LA), (bf16_t*)(ws + A_BB), (const bf16_t*)(ws + A_XC), a.in[23], a.in[25], a.in[26]}; gemm_phase(lds, g, S, E); }
PHASE_FN ph13() { PH_PRE(); phase_scan1(a); }
PHASE_FN ph14() { PH_PRE(); phase_scan2(a, lds); }
PHASE_FN ph15() { PH_PRE(); phase_scan3(a); }
PHASE_FN ph16() { PH_PRE(); StaticOrder S; S.init(NTOK, DM, G, bx);
    if constexpr (FP8_P16) { Gemm g{(const bf16_t*)(ws + A_YG), (const bf16_t*)(ws + WS_WOUT_OD), DM / 2, DM / 2, DM / 2};
        EpiResBf E{(const bf16_t*)(ws + A_HB2), (bf16_t*)(ws + A_R1), DM, DN_ALPHA, 1.0f / (FP8_SW * 4.0f)}; gemm_phase<EpiResBf, StaticOrder, true>(lds, g, S, E); }
    else { Gemm g{(const bf16_t*)(ws + A_YG), (const bf16_t*)(ws + WS_WOUT_OD), DM, DM, DM};
        EpiResBf E{(const bf16_t*)(ws + A_HB2), (bf16_t*)(ws + A_R1), DM, DN_ALPHA}; gemm_phase(lds, g, S, E); } }

__global__ void __launch_bounds__(512, 2) fwd(Args a) {
    LAS unsigned char* lds = (LAS unsigned char*)lds_raw;
    unsigned* ctl = (unsigned*)(a.ws + WS_CTL);
    volatile LAS unsigned* bst = (volatile LAS unsigned*)(lds + LDS_MISC + 2048);
    { const int tid = threadIdx.x;
      if ((tid & 63) == 0) ((LAS int*)(lds + LDS_WIDTAB))[hw_slot()] = tid >> 6;
      if (tid < 4) bst[tid] = 0u; }
    __syncthreads();
    const int lo = a.ph_lo, hi = a.ph_hi;
    XcdBarrier bar; bar.bar = ctl + CW_BAR; bar.x = 0; bar.st = bst;
    if (hi - lo > 1) bar = xcd_barrier_post(ctl + CW_BAR, bst);
#ifdef ONLY_PHASE
#define IN(k) ((k) == ONLY_PHASE && lo <= (k) && (k) < hi)
#else
#define IN(k) (lo <= (k) && (k) < hi)
#endif
#define SEAM(k) do { if (IN(k) && IN((k) + 1)) xcd_barrier(bar); } while (0)
    if (IN(0)) { asm volatile("; PHASE_MARK 0"); ph0(); } SEAM(0);
    if (IN(1)) { asm volatile("; PHASE_MARK 1a"); ph1a(); asm volatile("; PHASE_MARK 1b"); ph1b(); asm volatile("; PHASE_MARK 1c"); ph1c(); } SEAM(1);
    if (IN(2)) { asm volatile("; PHASE_MARK 2"); ph2(); } SEAM(2);
    if (IN(3)) { asm volatile("; PHASE_MARK 3a"); ph3a(); asm volatile("; PHASE_MARK 3b"); ph3b(); } SEAM(3);
    if (IN(4)) { asm volatile("; PHASE_MARK 4"); ph4(); } SEAM(4);
    if (IN(5)) { asm volatile("; PHASE_MARK 5"); ph5(); } SEAM(5);
    if (IN(6)) { asm volatile("; PHASE_MARK 6"); ph_lnr<0>(); } SEAM(6);
    if (IN(7)) { asm volatile("; PHASE_MARK 7"); ph_moe1<0>(); } SEAM(7);
    if (IN(8)) { asm volatile("; PHASE_MARK 8"); ph_moe2<0>(); } SEAM(8);
    if (IN(9)) { asm volatile("; PHASE_MARK 9"); ph_ln2<0>(); } SEAM(9);
    if (IN(10)) { asm volatile("; PHASE_MARK 10"); ph10(); } SEAM(10);
    if (IN(11)) { asm volatile("; PHASE_MARK 11"); ph11(); } SEAM(11);
    if (IN(12)) { asm volatile("; PHASE_MARK 12"); ph12(); } SEAM(12);
    if (IN(13)) { asm volatile("; PHASE_MARK 13"); ph13(); } SEAM(13);
    if (IN(14)) { asm volatile("; PHASE_MARK 14"); ph14(); } SEAM(14);
    if (IN(15)) { asm volatile("; PHASE_MARK 15"); ph15(); } SEAM(15);
    if (IN(16)) { asm volatile("; PHASE_MARK 16"); ph16(); } SEAM(16);
    if (IN(17)) { asm volatile("; PHASE_MARK 17"); ph_lnr<1>(); } SEAM(17);
    if (IN(18)) { asm volatile("; PHASE_MARK 18"); ph_moe1<1>(); } SEAM(18);
    if (IN(19)) { asm volatile("; PHASE_MARK 19"); ph_moe2<1>(); } SEAM(19);
    if (IN(20)) { asm volatile("; PHASE_MARK 20"); ph_ln2<1>(); }
#undef IN
#undef SEAM
}

#ifndef MK_PER_PHASE
#define MK_PER_PHASE 0
#endif
extern "C" void kernel_launch(void* const* d_in, const int* in_sizes, int n_in, void* d_out, int out_size, void* d_ws, size_t ws_size, hipStream_t stream) {
    static int grid = 0;
    if (grid == 0) {
        if (n_in != 37 || out_size != NTOK * DM || ws_size < WS_END) { fprintf(stderr, "kernel_launch: built for 37 inputs, %d outputs, >= %zu bytes of workspace; got n_in %d out %d ws %zu\n", NTOK * DM, (size_t)WS_END, n_in, out_size, ws_size); grid = -1; return; }
        int dev = 0, cus = 0, per_cu = 0;
        if (hipGetDevice(&dev) != hipSuccess || hipDeviceGetAttribute(&cus, hipDeviceAttributeMultiprocessorCount, dev) != hipSuccess) { grid = -1; return; }
        if (hipFuncSetAttribute((const void*)fwd, hipFuncAttributeMaxDynamicSharedMemorySize, LDS_BYTES) != hipSuccess) { fprintf(stderr, "kernel_launch: hipFuncSetAttribute failed\n"); grid = -1; return; }
        if (hipOccupancyMaxActiveBlocksPerMultiprocessor(&per_cu, (const void*)fwd, 512, LDS_BYTES) != hipSuccess || per_cu < 1) fprintf(stderr, "kernel_launch: occupancy query reports %d\n", per_cu);
        (void)hipGetLastError();
        grid = cus;
    }
    if (grid < 0) return;
    (void)hipMemsetAsync((char*)d_ws + WS_CTL, 0, CTL_ZERO_BYTES, stream);
    Args a{};
    for (int i = 0; i < 37; ++i) a.in[i] = (const float*)d_in[i];
    a.out = (float*)d_out; a.ws = (unsigned char*)d_ws;
#if MK_PER_PHASE
    for (int p = 0; p < NPHASE; ++p) { a.ph_lo = p; a.ph_hi = p + 1; hipLaunchKernelGGL(fwd, dim3(grid), dim3(512), LDS_BYTES, stream, a); }
#else
    a.ph_lo = 0; a.ph_hi = NPHASE; hipLaunchKernelGGL(fwd, dim3(grid), dim3(512), LDS_BYTES, stream, a);
#endif
}
```

```cpp
#include <hip/hip_runtime.h>
#include <hip/hip_fp16.h>
#include <cstdio>
#include <cstdint>

#define GAS __attribute__((address_space(1)))
#define LAS __attribute__((address_space(3)))
typedef unsigned short bf16_t;
typedef short bf16x8 __attribute__((ext_vector_type(8)));
typedef short s16x4 __attribute__((ext_vector_type(4)));
typedef float f32x2 __attribute__((ext_vector_type(2)));
typedef float f32x4 __attribute__((ext_vector_type(4)));
typedef float f32x8 __attribute__((ext_vector_type(8)));
typedef float f32x16 __attribute__((ext_vector_type(16)));
typedef unsigned u32x2 __attribute__((ext_vector_type(2)));
typedef unsigned u32x4 __attribute__((ext_vector_type(4)));
typedef GAS unsigned gu32;

constexpr int DM = 2048, BATCH = 2, SEQ = 8192, NTOK = BATCH * SEQ;
constexpr int HY_CH = 1024, EV_IN = 6144;
constexpr int NEXP = 32, DFF = 512, NASSIGN = NTOK * 2, ECAP = NASSIGN;
constexpr float LN_EPS = 1e-5f;
constexpr float DN_ALPHA = 1.4142135623730951f;
constexpr float QSCALE = 0.125f * 1.4426950408889634f;
constexpr int FFT_N = 16384, FFT_RS = 528;

__device__ __forceinline__ unsigned f2bf(float f) { unsigned u = __builtin_bit_cast(unsigned, f); return (u + 0x7fffu + ((u >> 16) & 1u)) >> 16; }
__device__ __forceinline__ unsigned pk2(float lo, float hi) { return f2bf(lo) | (f2bf(hi) << 16); }
__device__ __forceinline__ float bf2f(unsigned short h) { return __builtin_bit_cast(float, (unsigned)h << 16); }
__device__ __forceinline__ float bflo(unsigned w) { return __builtin_bit_cast(float, w << 16); }
__device__ __forceinline__ float bfhi(unsigned w) { return __builtin_bit_cast(float, w & 0xffff0000u); }
__device__ __forceinline__ unsigned cvt_pk_bf16(float lo, float hi) { unsigned r; asm volatile("v_cvt_pk_bf16_f32 %0, %1, %2" : "=v"(r) : "v"(lo), "v"(hi)); return r; }
__device__ __forceinline__ float wave_sum(float v) {
#pragma unroll
    for (int o = 1; o < 64; o <<= 1) v += __shfl_xor(v, o);
    return v;
}
__device__ __forceinline__ float sigmoidf_(float x) { return __builtin_amdgcn_rcpf(1.0f + __builtin_amdgcn_exp2f(-1.4426950408889634f * x)); }
constexpr int LDS_WIDTAB = 139264 + 3072;
__device__ __forceinline__ int hw_slot() { return (int)(__builtin_amdgcn_s_getreg((5 << 11) | 4) & 63u); }
__device__ __forceinline__ int lane_id() { return (int)__builtin_amdgcn_mbcnt_hi(~0u, __builtin_amdgcn_mbcnt_lo(~0u, 0u)); }
extern __shared__ __attribute__((aligned(16))) unsigned char lds_raw[];
__device__ __forceinline__ int wave_id() { return __builtin_amdgcn_readfirstlane(((const LAS int*)((LAS unsigned char*)lds_raw + LDS_WIDTAB))[hw_slot()]); }
__device__ __forceinline__ int opaque_tid() { int t = wave_id() * 64 + lane_id(); asm volatile("" : "+v"(t)); return t; }
#define LDS_WAIT() asm volatile("s_waitcnt lgkmcnt(0)" ::: "memory")
#define VM_WAIT() asm volatile("s_waitcnt vmcnt(0)" ::: "memory")

#define XB_TMO      128
#define XB_XCNT(j)  (256  + 64 * (j))
#define XB_XSUB(j)  (1280 + 64 * (j))
#define XB_XGEN(j)  (2304 + 64 * (j))
#define XB_TOP      3328
#define XB_TOPGEN   3392
#define XCD_BAR_WORDS 3456
#define XB_SPIN_CAP (1u << 18)
__device__ __forceinline__ unsigned xb_ld(unsigned* p)              { return __hip_atomic_load(p, __ATOMIC_RELAXED, __HIP_MEMORY_SCOPE_AGENT); }
__device__ __forceinline__ unsigned xb_add(unsigned* p, unsigned v) { return __hip_atomic_fetch_add(p, v, __ATOMIC_RELAXED, __HIP_MEMORY_SCOPE_AGENT); }
__device__ __forceinline__ unsigned xb_xcc_id() { return (unsigned)__builtin_amdgcn_s_getreg((3 << 11) | 20) & 0xFu; }
#define XB_SPIN(cond, bar) do { unsigned _sp = 0; while (cond) { __builtin_amdgcn_s_sleep(1); \
    if ((++_sp & 255u) == 0u) { if (xb_ld(&(bar)[XB_TMO])) break; if (_sp > XB_SPIN_CAP) { atomicAdd(&(bar)[XB_TMO], 1u); break; } } } } while (0)
struct XcdBarrier { unsigned* bar; unsigned x; volatile LAS unsigned* st; };
__device__ __forceinline__ XcdBarrier xcd_barrier_post(unsigned* bar, volatile LAS unsigned* st) {
    XcdBarrier b; b.bar = bar; b.x = xb_xcc_id(); b.st = st;
    if (opaque_tid() == 0) (void)xb_add(&bar[XB_XCNT(b.x)], 1u);
    return b;
}
__device__ __forceinline__ void xcd_barrier_complete(unsigned* bar, unsigned x, unsigned& nloc, unsigned& nx) {
    const unsigned G = gridDim.x * gridDim.y * gridDim.z;
    unsigned sum, cnt, mine, sp = 0u;
    for (;;) {
        sum = 0u; cnt = 0u; mine = 0u;
#pragma unroll
        for (unsigned j = 0; j < 16; ++j) { const unsigned c = xb_ld(&bar[XB_XCNT(j)]); sum += c; cnt += (c > 0u) ? 1u : 0u; mine = (j == x) ? c : mine; }
        if (sum == G) break;
        __builtin_amdgcn_s_sleep(1);
        if ((++sp & 255u) == 0u) { if (xb_ld(&bar[XB_TMO])) break; if (sp > XB_SPIN_CAP) { atomicAdd(&bar[XB_TMO], 1u); break; } }
    }
    nloc = mine > 0u ? mine : 1u; nx = cnt > 0u ? cnt : 1u;
}
__device__ __forceinline__ void xcd_barrier(const XcdBarrier& b) {
    asm volatile("s_waitcnt vmcnt(0)" ::: "memory");
    __syncthreads();
    if (opaque_tid() == 0) {
        unsigned* bar = b.bar;
        __builtin_amdgcn_s_waitcnt(0);
        unsigned nloc = b.st[0], nx = b.st[1];
        if (nloc == 0u) { xcd_barrier_complete(bar, b.x, nloc, nx); b.st[0] = nloc; b.st[1] = nx; }
        const unsigned old = xb_add(&bar[XB_XSUB(b.x)], 1u);
        const unsigned gen = old / nloc;
        if (old + 1u == (gen + 1u) * nloc) {
            __builtin_amdgcn_fence(__ATOMIC_RELEASE, "agent");
            asm volatile("s_waitcnt vmcnt(0)" ::: "memory");
            const unsigned og = xb_add(&bar[XB_TOP], 1u);
            const unsigned tg = og / nx;
            if (og + 1u == (tg + 1u) * nx) xb_add(&bar[XB_TOPGEN], 1u);
            else XB_SPIN(xb_ld(&bar[XB_TOPGEN]) == tg, bar);
            __builtin_amdgcn_fence(__ATOMIC_ACQUIRE, "agent");
            xb_add(&bar[XB_XGEN(b.x)], 1u);
            asm volatile("s_waitcnt vmcnt(0)" ::: "memory");
        } else {
            XB_SPIN(xb_ld(&bar[XB_XGEN(b.x)]) == gen, bar);
            __builtin_amdgcn_fence(__ATOMIC_ACQUIRE, "agent");
            asm volatile("s_waitcnt vmcnt(0)" ::: "memory");
        }
    }
    __syncthreads();
}

namespace pg8 {
constexpr int BM = 256, BK = 64, HALF = 128, HTB = HALF * BK * 2, STAGE_BYTES = 8 * HTB, NXCD = 8, WGM = 8;
__host__ __device__ __forceinline__ int lds_byte(int r, int c) { const int st = (r >> 4) * 2 + (c >> 5), rr = r & 15, cc = c & 31, ob = rr * 64 + cc * 2; return st * 1024 + (ob ^ (((ob >> 9) & 1) << 5)); }
__host__ __device__ __forceinline__ void stage_rc(int b, int& R, int& C) { const int st = b / 1024, sb = b % 1024, swz = sb ^ (((sb >> 9) & 1) << 5); R = (st >> 1) * 16 + swz / 64; C = (st & 1) * 32 + (swz % 64) / 2; }
__host__ __device__ __forceinline__ int perm32(int rho) { const int n = rho >> 4, i = rho & 15; return 8 * (i >> 2) + 4 * n + (i & 3); }

struct Unit { int pm, pn, e, t, cnt; };
struct Gemm { const bf16_t* A; const bf16_t* Bt; int lda, ldb, K; };

struct StaticOrder {
    static constexpr bool GATHER_A = false;
    int nM, nN, nwg, G, c;
    __device__ void init(int M, int N, int G_, int c_) { nM = M / BM; nN = N / BM; nwg = nM * nN; G = G_; c = c_; }
    __device__ __forceinline__ bool next(int i, Unit& u) const {
        const long L = (long)i * G + c; if (L >= nwg) return false;
        int wgid = (int)L; { const int q = nwg / NXCD, r = nwg % NXCD, xcd = wgid % NXCD, off = wgid / NXCD; wgid = (xcd < r ? xcd * (q + 1) : r * (q + 1) + (xcd - r) * q) + off; }
        const int nig = WGM * nN, gid = wgid / nig, fm = gid * WGM, gsz = (nM - fm) < WGM ? (nM - fm) : WGM;
        u.pm = fm + ((wgid % nig) % gsz); u.pn = (wgid % nig) / gsz; u.e = 0; u.t = 0; u.cnt = 0; return true;
    }
    __device__ __forceinline__ int rowA(const Unit& u, int r) const { return u.pm * BM + r; }
    __device__ __forceinline__ int colA(const Unit&) const { return 0; }
    __device__ __forceinline__ int rowB(const Unit& u, int r) const { return u.pn * BM + r; }
};

typedef int v8i32 __attribute__((ext_vector_type(8)));
template <class Epi, class Sched, bool FP8 = false>
__device__ __forceinline__ void gemm_phase(LAS unsigned char* lds, const Gemm g, const Sched& S, const Epi& E) {
    const int tid = opaque_tid(), wid = __builtin_amdgcn_readfirstlane(tid >> 6), lane = tid & 63, wr = wid >> 2, wc = wid & 3, fr = lane & 15, fq = lane >> 4;
    const int K = g.K, nt = K / BK;
    constexpr bool GA = Sched::GATHER_A;
    int sR[2], sC[2];
    unsigned laneA[2], laneB[2];
#pragma unroll
    for (int i = 0; i < 2; ++i) { int R, C; stage_rc(tid * 16 + i * 8192, R, C); sR[i] = R; sC[i] = C; const int Rb = Epi::PERM ? ((R & ~31) + perm32(R & 31)) : R;
        laneA[i] = (unsigned)(R * g.lda + C) * 2u; laneB[i] = (unsigned)(Rb * g.ldb + C) * 2u; }
    const size_t hstepA = (size_t)HALF * g.lda * 2, hstepB = (size_t)HALF * g.ldb * 2;
    const unsigned ldsw = (unsigned)wid * 1024u;
    const int aoff = lds_byte(wr * 64 + fr, fq * 8), boff = lds_byte(wc * 32 + fr, fq * 8);
    const char* gA = (const char*)g.A; const char* gB = (const char*)g.Bt;
#define PG8_SA(b, h) (((b) * 2 + (h)) * HTB)
#define PG8_SB(b, h) ((4 + (b) * 2 + (h)) * HTB)
#define PG8_STAGE(bufoff, gptr, voff) do { _Pragma("unroll") for (int _i = 0; _i < 2; ++_i) \
        __builtin_amdgcn_global_load_lds((const unsigned*)((gptr) + (size_t)(voff)[_i]), (LAS unsigned*)(lds + (bufoff) + ldsw + _i * 8192), 16, 0, 0); } while (0)
#define PG8_STAGE_B(bufoff, ub, h, kb) PG8_STAGE(bufoff, gB + (ub) + (size_t)(h) * hstepB + (size_t)(kb), laneB)
#define PG8_STAGE_A(bufoff, ub, va, h, kb) do { if constexpr (GA) { PG8_STAGE(bufoff, gA + (size_t)(kb), va[h]); } else { PG8_STAGE(bufoff, gA + (ub) + (size_t)(h) * hstepA + (size_t)(kb), laneA); } } while (0)
#define PG8_RD(off) (*(const LAS u32x4*)(lds + (off)))
#define PG8_CAT2(x, y) __builtin_bit_cast(v8i32, __builtin_shufflevector((x), (y), 0, 1, 2, 3, 4, 5, 6, 7))
#define PG8_LDA(dst, b, h) do { if constexpr (FP8) { _Pragma("unroll") for (int m = 0; m < 4; ++m) dst##8[m] = PG8_CAT2(PG8_RD(PG8_SA(b, h) + aoff + m * 2048), PG8_RD(PG8_SA(b, h) + aoff + m * 2048 + 1024)); } \
        else { _Pragma("unroll") for (int m = 0; m < 4; ++m) _Pragma("unroll") for (int k = 0; k < 2; ++k) dst[m][k] = *(const LAS bf16x8*)(lds + PG8_SA(b, h) + aoff + m * 2048 + k * 1024); } } while (0)
#define PG8_LDB(dst, b, h) do { if constexpr (FP8) { _Pragma("unroll") for (int n = 0; n < 2; ++n) dst##8[n] = PG8_CAT2(PG8_RD(PG8_SB(b, h) + boff + n * 2048), PG8_RD(PG8_SB(b, h) + boff + n * 2048 + 1024)); } \
        else { _Pragma("unroll") for (int n = 0; n < 2; ++n) _Pragma("unroll") for (int k = 0; k < 2; ++k) dst[n][k] = *(const LAS bf16x8*)(lds + PG8_SB(b, h) + boff + n * 2048 + k * 1024); } } while (0)
#define PG8_MMA(ai, bj, At, Bt) do { __builtin_amdgcn_s_setprio(1); _Pragma("unroll") for (int m = 0; m < 4; ++m) _Pragma("unroll") for (int n = 0; n < 2; ++n) { \
        if constexpr (FP8) { asm volatile("v_mfma_scale_f32_16x16x128_f8f6f4 %0, %1, %2, %0, %3, %3 op_sel_hi:[0,0,0]" : "+v"(acc[ai][bj][m][n]) : "v"(Bt##8[n]), "v"(At##8[m]), "v"(fp8_one)); } \
        else { _Pragma("unroll") for (int k = 0; k < 2; ++k) acc[ai][bj][m][n] = __builtin_amdgcn_mfma_f32_16x16x32_bf16(Bt[n][k], At[m][k], acc[ai][bj][m][n], 0, 0, 0); } } \
        __builtin_amdgcn_s_setprio(0); } while (0)
#define PG8_WAIT_V(n) asm volatile("s_waitcnt vmcnt(" #n ")" ::: "memory")
#define PG8_WAIT_L(n) asm volatile("s_waitcnt lgkmcnt(" #n ")" ::: "memory")
#define PG8_BAR __builtin_amdgcn_s_barrier()
#define PG8_SCHED __builtin_amdgcn_sched_barrier(0)
#define PG8_SCHED8 do { if constexpr (FP8) __builtin_amdgcn_sched_barrier(0); } while (0)
#define PG8_OFFS(u, ubA, ubB, vA) do { ubB = ((size_t)S.rowB(u, 0) * (size_t)g.ldb) * 2; \
        if constexpr (GA) { ubA = 0; _Pragma("unroll") for (int _h = 0; _h < 2; ++_h) _Pragma("unroll") for (int _i = 0; _i < 2; ++_i) vA[_h][_i] = ((unsigned)S.rowA(u, _h * HALF + sR[_i]) * (unsigned)g.lda + (unsigned)sC[_i]) * 2u; } \
        else { ubA = ((size_t)S.rowA(u, 0) * (size_t)g.lda + (size_t)S.colA(u)) * 2; } } while (0)
    Unit cur, nxt; int ui = 0;
    if (!S.next(0, cur)) return;
    f32x4 acc[2][2][4][2];
#pragma unroll
    for (int a = 0; a < 2; ++a)
#pragma unroll
        for (int b = 0; b < 2; ++b)
#pragma unroll
            for (int m = 0; m < 4; ++m)
#pragma unroll
                for (int n = 0; n < 2; ++n) acc[a][b][m][n] = (f32x4){0.f, 0.f, 0.f, 0.f};
    const int fp8_one = 0x7f7f7f7f;
    bf16x8 At[4][2], B0[2][2], B1[2][2]; v8i32 At8[4], B08[2], B18[2];
    size_t ubAc, ubBc, ubAn, ubBn; unsigned vAc[2][2] = {}, vAn[2][2] = {};
    PG8_OFFS(cur, ubAc, ubBc, vAc);
    PG8_STAGE_B(PG8_SB(0, 0), ubBc, 0, 0); PG8_STAGE_B(PG8_SB(0, 1), ubBc, 1, 0); PG8_STAGE_A(PG8_SA(0, 0), ubAc, vAc, 0, 0); PG8_STAGE_A(PG8_SA(0, 1), ubAc, vAc, 1, 0);
    if (wr == 1) PG8_BAR;
    PG8_WAIT_V(2); PG8_BAR;
    PG8_STAGE_B(PG8_SB(1, 0), ubBc, 0, 128); PG8_STAGE_A(PG8_SA(1, 0), ubAc, vAc, 0, 128); PG8_STAGE_B(PG8_SB(1, 1), ubBc, 1, 128);
    PG8_WAIT_V(6); PG8_BAR;
    for (;;) {
        const bool has_next = S.next(ui + 1, nxt);
        if (has_next) { PG8_OFFS(nxt, ubAn, ubBn, vAn); }
        else { ubAn = ubAc; ubBn = ubBc;
#pragma unroll
            for (int h = 0; h < 2; ++h)
#pragma unroll
                for (int i = 0; i < 2; ++i) vAn[h][i] = vAc[h][i]; }
        for (int t = 0; t < nt; t += 2) {
            const bool last = (t == nt - 2);
            const unsigned k1 = (unsigned)(t + 1) * 128u, k2 = last ? 0u : (unsigned)(t + 2) * 128u, k3 = k2 + 128u;
            const size_t xubA = last ? ubAn : ubAc, xubB = last ? ubBn : ubBc;
            unsigned xA[2][2];
#pragma unroll
            for (int h = 0; h < 2; ++h)
#pragma unroll
                for (int i = 0; i < 2; ++i) xA[h][i] = last ? vAn[h][i] : vAc[h][i];
            PG8_LDB(B0, 0, 0); PG8_LDB(B1, 0, 1); PG8_SCHED; PG8_LDA(At, 0, 0); PG8_STAGE_A(PG8_SA(1, 1), ubAc, vAc, 1, k1);
            PG8_WAIT_V(8); PG8_WAIT_L(0); PG8_SCHED8; PG8_BAR; PG8_MMA(0, 0, At, B0); PG8_MMA(0, 1, At, B1); PG8_SCHED8; PG8_BAR; PG8_SCHED;
            PG8_LDA(At, 0, 1); PG8_STAGE_B(PG8_SB(0, 0), xubB, 0, k2); PG8_STAGE_B(PG8_SB(0, 1), xubB, 1, k2); PG8_STAGE_A(PG8_SA(0, 0), xubA, xA, 0, k2);
            PG8_WAIT_V(8); PG8_WAIT_L(0); PG8_SCHED8; PG8_BAR; PG8_MMA(1, 0, At, B0); PG8_MMA(1, 1, At, B1); PG8_SCHED8; PG8_BAR; PG8_SCHED;
            PG8_LDB(B0, 1, 0); PG8_LDB(B1, 1, 1); PG8_SCHED; PG8_LDA(At, 1, 0); PG8_STAGE_A(PG8_SA(0, 1), xubA, xA, 1, k2);
            PG8_WAIT_V(8); PG8_WAIT_L(0); PG8_SCHED8; PG8_BAR; PG8_MMA(0, 0, At, B0); PG8_MMA(0, 1, At, B1); PG8_SCHED8; PG8_BAR; PG8_SCHED;
            PG8_LDA(At, 1, 1); PG8_STAGE_B(PG8_SB(1, 0), xubB, 0, k3); PG8_STAGE_B(PG8_SB(1, 1), xubB, 1, k3); PG8_STAGE_A(PG8_SA(1, 0), xubA, xA, 0, k3);
            PG8_WAIT_V(8); PG8_WAIT_L(0); PG8_SCHED8; PG8_BAR; PG8_MMA(1, 0, At, B0); PG8_MMA(1, 1, At, B1); PG8_SCHED8; PG8_BAR; PG8_SCHED;
        }
        if (wr == 0) PG8_BAR;
        E(acc, cur, wr, wc, fr, fq);
        if (!has_next) break;
#pragma unroll
        for (int a = 0; a < 2; ++a)
#pragma unroll
            for (int b = 0; b < 2; ++b)
#pragma unroll
                for (int m = 0; m < 4; ++m)
#pragma unroll
                    for (int n = 0; n < 2; ++n) acc[a][b][m][n] = (f32x4){0.f, 0.f, 0.f, 0.f};
        cur = nxt; ++ui; ubAc = ubAn; ubBc = ubBn;
#pragma unroll
        for (int h = 0; h < 2; ++h)
#pragma unroll
            for (int i = 0; i < 2; ++i) vAc[h][i] = vAn[h][i];
        if (wr == 1) PG8_BAR;
    }
    PG8_WAIT_V(0);
    PG8_BAR;
#undef PG8_SA
#undef PG8_SB
#undef PG8_STAGE
#undef PG8_STAGE_A
#undef PG8_STAGE_B
#undef PG8_LDA
#undef PG8_LDB
#undef PG8_MMA
#undef PG8_RD
#undef PG8_CAT2
#undef PG8_WAIT_V
#undef PG8_WAIT_L
#undef PG8_BAR
#undef PG8_SCHED
#undef PG8_SCHED8
#undef PG8_OFFS
}
}
namespace pg8 {
struct EpiBf16 {
    static constexpr bool PERM = true;
    bf16_t* O; int ldc; int split_cols; size_t split_stride; float scale0; float scale_all = 1.0f;
    __device__ __forceinline__ void operator()(const f32x4 (&acc)[2][2][4][2], const Unit& u, int wr, int wc, int fr, int fq) const {
        const int row0 = u.pm * BM + wr * 64 + fr; int colt = u.pn * BM; bf16_t* base = O;
        float sc = scale_all; if (split_cols) { const int t = colt / split_cols; base += (size_t)t * split_stride; colt -= t * split_cols; if (t == 0) sc *= scale0; }
        const int col0 = colt + wc * 32 + 8 * fq;
#pragma unroll
        for (int ai = 0; ai < 2; ++ai)
#pragma unroll
            for (int m = 0; m < 4; ++m) { bf16_t* rowp = base + (size_t)(row0 + ai * HALF + m * 16) * ldc + col0;
#pragma unroll
                for (int bj = 0; bj < 2; ++bj) { const f32x4 v0 = acc[ai][bj][m][0] * sc, v1 = acc[ai][bj][m][1] * sc;
                    u32x4 w; w.x = cvt_pk_bf16(v0[0], v0[1]); w.y = cvt_pk_bf16(v0[2], v0[3]); w.z = cvt_pk_bf16(v1[0], v1[1]); w.w = cvt_pk_bf16(v1[2], v1[3]);
                    *(u32x4*)(rowp + bj * HALF) = w; } }
    }
};
struct EpiFilt {
    static constexpr bool PERM = true;
    bf16_t* O;
    __device__ __forceinline__ void operator()(const f32x4 (&acc)[2][2][4][2], const Unit& u, int wr, int wc, int fr, int fq) const {
        const float dmin = -3.0701134573253945f, dmax = -15.350567286626973f;
#pragma unroll
        for (int ai = 0; ai < 2; ++ai)
#pragma unroll
            for (int m = 0; m < 4; ++m) { const int row = u.pm * BM + ai * HALF + wr * 64 + m * 16 + fr; const int c = row & 1023;
                const float dl2 = fabsf(dmin + (float)c * ((dmax - dmin) / 1023.0f)) * (1.4426950408889634f / 8191.0f);
#pragma unroll
                for (int bj = 0; bj < 2; ++bj) { const int col = u.pn * BM + bj * HALF + wc * 32 + 8 * fq; float v[8];
#pragma unroll
                    for (int n = 0; n < 2; ++n)
#pragma unroll
                        for (int j = 0; j < 4; ++j) v[n * 4 + j] = acc[ai][bj][m][n][j] * __builtin_amdgcn_exp2f(-(float)(col + n * 4 + j) * dl2);
                    u32x4 w; w.x = cvt_pk_bf16(v[0], v[1]); w.y = cvt_pk_bf16(v[2], v[3]); w.z = cvt_pk_bf16(v[4], v[5]); w.w = cvt_pk_bf16(v[6], v[7]);
                    *(u32x4*)(O + (size_t)row * 8192 + col) = w; }
                asm volatile("" ::: "memory"); }
    }
};
struct EpiResF32 {
    static constexpr bool PERM = false;
    const float* res; float* O; int ldc; float alpha;
    __device__ __forceinline__ void operator()(const f32x4 (&acc)[2][2][4][2], const Unit& u, int wr, int wc, int fr, int fq) const {
#pragma unroll
        for (int ai = 0; ai < 2; ++ai)
#pragma unroll
            for (int m = 0; m < 4; ++m) { const size_t off = (size_t)(u.pm * BM + ai * HALF + wr * 64 + m * 16 + fr) * ldc + u.pn * BM + wc * 32 + 4 * fq;
#pragma unroll
                for (int bj = 0; bj < 2; ++bj)
#pragma unroll
                    for (int n = 0; n < 2; ++n) { const f32x4 r = *(const f32x4*)(res + off + bj * HALF + n * 16); *(f32x4*)(O + off + bj * HALF + n * 16) = r * alpha + acc[ai][bj][m][n]; }
                if (m & 1) asm volatile("" ::: "memory"); }
    }
};
struct EpiResBf {
    static constexpr bool PERM = true;
    const bf16_t* res; bf16_t* O; int ldc; float alpha; float ascale = 1.0f;
    __device__ __forceinline__ void operator()(const f32x4 (&acc)[2][2][4][2], const Unit& u, int wr, int wc, int fr, int fq) const {
#pragma unroll
        for (int ai = 0; ai < 2; ++ai)
#pragma unroll
            for (int m = 0; m < 4; ++m) { const size_t off = (size_t)(u.pm * BM + ai * HALF + wr * 64 + m * 16 + fr) * ldc + u.pn * BM + wc * 32 + 8 * fq;
#pragma unroll
                for (int bj = 0; bj < 2; ++bj) { const u32x4 r = *(const u32x4*)(res + off + bj * HALF); const f32x4 a0 = acc[ai][bj][m][0] * ascale, a1 = acc[ai][bj][m][1] * ascale;
                    u32x4 w; w.x = cvt_pk_bf16(bflo(r.x) * alpha + a0[0], bfhi(r.x) * alpha + a0[1]); w.y = cvt_pk_bf16(bflo(r.y) * alpha + a0[2], bfhi(r.y) * alpha + a0[3]);
                    w.z = cvt_pk_bf16(bflo(r.z) * alpha + a1[0], bfhi(r.z) * alpha + a1[1]); w.w = cvt_pk_bf16(bflo(r.w) * alpha + a1[2], bfhi(r.w) * alpha + a1[3]);
                    *(u32x4*)(O + off + bj * HALF) = w; }
                if (m & 1) asm volatile("" ::: "memory"); }
    }
};
struct EpiSwiglu {
    static constexpr bool PERM = true;
    bf16_t* O;
    __device__ __forceinline__ void operator()(const f32x4 (&acc)[2][2][4][2], const Unit& u, int wr, int wc, int fr, int fq) const {
#pragma unroll
        for (int ai = 0; ai < 2; ++ai)
#pragma unroll
            for (int m = 0; m < 4; ++m) { bf16_t* p = O + (size_t)(u.pm * BM + ai * HALF + wr * 64 + m * 16 + fr) * DFF + u.pn * HALF + wc * 32 + 8 * fq;
                float h[8];
#pragma unroll
                for (int n = 0; n < 2; ++n)
#pragma unroll
                    for (int j = 0; j < 4; ++j) { const float gt = acc[ai][0][m][n][j], up = acc[ai][1][m][n][j]; h[n * 4 + j] = gt * sigmoidf_(gt) * up; }
                u32x4 w; w.x = cvt_pk_bf16(h[0], h[1]); w.y = cvt_pk_bf16(h[2], h[3]); w.z = cvt_pk_bf16(h[4], h[5]); w.w = cvt_pk_bf16(h[6], h[7]);
                *(u32x4*)p = w; }
    }
};
__device__ __forceinline__ float clamp_fp8(float x) { return __builtin_amdgcn_fmed3f(x, -448.0f, 448.0f); }
__device__ __forceinline__ unsigned pk4_fp8(float a, float b, float c, float d) { int w = 0; w = __builtin_amdgcn_cvt_pk_fp8_f32(clamp_fp8(a), clamp_fp8(b), w, false); w = __builtin_amdgcn_cvt_pk_fp8_f32(clamp_fp8(c), clamp_fp8(d), w, true); return (unsigned)w; }
constexpr float FP8_SW = 64.0f, FP8_SH = 8.0f;
struct EpiSwiglu8 {
    static constexpr bool PERM = true;
    unsigned char* O;
    __device__ __forceinline__ void operator()(const f32x4 (&acc)[2][2][4][2], const Unit& u, int wr, int wc, int fr, int fq) const {
#pragma unroll
        for (int ai = 0; ai < 2; ++ai)
#pragma unroll
            for (int m = 0; m < 4; ++m) { unsigned char* p = O + (size_t)(u.pm * BM + ai * HALF + wr * 64 + m * 16 + fr) * DFF + u.pn * HALF + wc * 32 + 8 * fq;
                float h[8];
#pragma unroll
                for (int n = 0; n < 2; ++n)
#pragma unroll
                    for (int j = 0; j < 4; ++j) { const float gt = acc[ai][0][m][n][j] * (1.0f / FP8_SW), up = acc[ai][1][m][n][j] * (1.0f / FP8_SW); h[n * 4 + j] = gt * sigmoidf_(gt) * up * FP8_SH; }
                u32x2 w; w.x = pk4_fp8(h[0], h[1], h[2], h[3]); w.y = pk4_fp8(h[4], h[5], h[6], h[7]);
                *(u32x2*)p = w; }
    }
};
struct EpiDown {
    static constexpr bool PERM = true;
    bf16_t* O; const int* rowlist; const float* gatew; float oscale;
    __device__ __forceinline__ void operator()(const f32x4 (&acc)[2][2][4][2], const Unit& u, int wr, int wc, int fr, int fq) const {
#pragma unroll
        for (int ai = 0; ai < 2; ++ai)
#pragma unroll
            for (int m = 0; m < 4; ++m) { const int idx = u.t * BM + ai * HALF + wr * 64 + m * 16 + fr;
                if (idx < u.cnt) { const int a = rowlist[(size_t)u.e * ECAP + idx]; const float gw = gatew[a] * oscale;
                    bf16_t* p = O + (size_t)a * DM + u.pn * BM + wc * 32 + 8 * fq;
#pragma unroll
                    for (int bj = 0; bj < 2; ++bj) { const f32x4 v0 = acc[ai][bj][m][0] * gw, v1 = acc[ai][bj][m][1] * gw;
                        u32x4 w; w.x = cvt_pk_bf16(v0[0], v0[1]); w.y = cvt_pk_bf16(v0[2], v0[3]); w.z = cvt_pk_bf16(v1[0], v1[1]); w.w = cvt_pk_bf16(v1[2], v1[3]);
                        *(u32x4*)(p + bj * HALF) = w; } } }
    }
};
constexpr float RG_SLA = 4096.0f, RG_SB = 64.0f;
struct EpiRG {
    static constexpr bool PERM = true;
    bf16_t* LA; bf16_t* BB; const bf16_t* XC; const float* ba; const float* bx; const float* lam;
    __device__ __forceinline__ void operator()(const f32x4 (&acc)[2][2][4][2], const Unit& u, int wr, int wc, int fr, int fq) const {
        const int nb = u.pn >> 2, q = u.pn & 3, dir = q >> 1, half = q & 1;
        const int ch0 = nb * 256 + half * HALF + wc * 32 + 8 * fq;
        float vba[8], vbx[8], vsp[8];
#pragma unroll
        for (int j = 0; j < 8; ++j) { vba[j] = ba[dir * DM + ch0 + j]; vbx[j] = bx[dir * DM + ch0 + j];
            const float x = __expf(-lam[dir * DM + ch0 + j]);
            vsp[j] = 8.0f * (x < 0.05f ? x * (1.0f - x * (0.5f - x * (0.33333334f - 0.25f * x))) : __logf(1.0f + x)); }
#pragma unroll
        for (int ai = 0; ai < 2; ++ai)
#pragma unroll
            for (int m = 0; m < 4; ++m) { const size_t tok = (size_t)(u.pm * BM + ai * HALF + wr * 64 + m * 16 + fr);
                asm volatile("" ::: "memory");
                const u32x4 xw = *(const u32x4*)(XC + tok * DM + ch0);
                float xf[8] = {bflo(xw.x), bfhi(xw.x), bflo(xw.y), bfhi(xw.y), bflo(xw.z), bfhi(xw.z), bflo(xw.w), bfhi(xw.w)};
                float la[8], bb[8];
#pragma unroll
                for (int n = 0; n < 2; ++n)
#pragma unroll
                    for (int j = 0; j < 4; ++j) { const int k = n * 4 + j;
                        const float r = sigmoidf_(acc[ai][0][m][n][j] + vba[k]), ig = sigmoidf_(acc[ai][1][m][n][j] + vbx[k]);
                        const float l = -r * vsp[k]; la[k] = l; bb[k] = __builtin_amdgcn_sqrtf(fmaxf(1.0f - __builtin_amdgcn_exp2f(2.8853900817779268f * l), 0.f)) * (ig * xf[k]); }
                u32x2 w; w.x = pk4_fp8(RG_SLA * la[0], RG_SLA * la[1], RG_SLA * la[2], RG_SLA * la[3]); w.y = pk4_fp8(RG_SLA * la[4], RG_SLA * la[5], RG_SLA * la[6], RG_SLA * la[7]);
                *(u32x2*)((unsigned char*)LA + ((size_t)dir * NTOK + tok) * DM + ch0) = w;
                w.x = pk4_fp8(RG_SB * bb[0], RG_SB * bb[1], RG_SB * bb[2], RG_SB * bb[3]); w.y = pk4_fp8(RG_SB * bb[4], RG_SB * bb[5], RG_SB * bb[6], RG_SB * bb[7]);
                *(u32x2*)((unsigned char*)BB + ((size_t)dir * NTOK + tok) * DM + ch0) = w; }
    }
};

struct RGOrder {
    static constexpr bool GATHER_A = false;
    int G, c;
    __device__ __forceinline__ bool next(int i, Unit& u) const {
        if (G == 256) { if (i >= 8) return false; const int x = c & 7, y = c >> 3; u.pm = i * 8 + (y >> 2); u.pn = x * 4 + (y & 3); }
        else { const int L = i * G + c; if (L >= 64 * 32) return false; u.pm = L >> 5; u.pn = L & 31; }
        u.e = 0; u.t = 0; u.cnt = 0; return true; }
    __device__ __forceinline__ int rowA(const Unit& u, int r) const { return u.pm * BM + r; }
    __device__ __forceinline__ int colA(const Unit& u) const { return (u.pn >> 2) * 256; }
    __device__ __forceinline__ int rowB(const Unit& u, int r) const { return u.pn * BM + r; }
};
template <int NPN, bool GATHER>
struct MoeOrder {
    static constexpr bool GATHER_A = GATHER;
    int G, c; const LAS int* tab; const int* rowlist;
    __device__ __forceinline__ bool next(int i, Unit& u) const {
        const int L = i * G + c, ntile = tab[32]; if (L >= ntile * NPN) return false;
        const int tile = L / NPN; u.pm = tile; u.pn = L % NPN; int e = 0;
        while (e < 31 && tab[e + 1] <= tile) ++e;
        u.e = e; u.t = tile - tab[e]; u.cnt = tab[64 + e]; return true;
    }
    __device__ __forceinline__ int rowA(const Unit& u, int r) const {
        if (GATHER) { const int idx = u.t * BM + r; const int a = idx < u.cnt ? rowlist[(size_t)u.e * ECAP + idx] : 0; return a >> 1; }
        return u.pm * BM + r;
    }
    __device__ __forceinline__ int colA(const Unit&) const { return 0; }
    __device__ __forceinline__ int rowB(const Unit& u, int r) const { return (u.e * NPN + u.pn) * BM + r; }
};
}
namespace att {
constexpr int NW = 8, QBLK = 32, KVBLK = 64, LDQ = 1024, LDK = 1024, LDV = 1024, LDO = 1024;
constexpr int SHM_V = KVBLK * 128 * 2, SHM_K = KVBLK * 64 * 2, NSLOT = 4, LDS_K = 0, LDS_V = NSLOT * SHM_K, LDS_WS = NSLOT * (SHM_K + SHM_V), SHM_ATTN = LDS_WS + NW * 64 * 4;
__device__ __forceinline__ void glds16s(const void* sbase, unsigned voff, unsigned lds_dst) { unsigned keep;
    asm volatile("s_mov_b32 %0, m0\n\ts_mov_b32 m0, %3\n\ts_nop 0\n\tglobal_load_lds_dwordx4 %1, %2\n\ts_mov_b32 m0, %0" : "=&s"(keep) : "v"(voff), "s"(sbase), "s"(lds_dst) : "memory"); }
#define WAITBAR(N) asm volatile("s_waitcnt vmcnt(" #N ") lgkmcnt(0)\n\ts_barrier" ::: "memory")
constexpr float THR2 = 8.0f * 1.4426950408889634f;
#define KSWZ64(row, colB) ((row) * 128 + ((colB) ^ ((((row) >> 1) & 7) << 4)))
#define SBAR() __builtin_amdgcn_sched_barrier(0)
__device__ __forceinline__ int crow(int r, int hi) { return (r & 3) + 8 * (r >> 2) + 4 * hi; }
__device__ __forceinline__ void qkt(f32x16& p0, f32x16& p1, const char* Ks, const bf16x8* qr, int r32, int hi, float A, float st) {
    { float b4[4];
#pragma unroll
      for (int j = 0; j < 4; ++j) b4[j] = fmaf(st, (float)j, A);
      const float s8 = 8.0f * st, s32 = 32.0f * st;
#pragma unroll
      for (int r = 0; r < 16; ++r) { p0[r] = (r < 4) ? b4[r] : p0[r - 4] + s8; }
#pragma unroll
      for (int r = 0; r < 16; ++r) p1[r] = p0[r] + s32; }
#pragma unroll
    for (int d0 = 0; d0 < 4; ++d0) { const int cb = (d0 * 16 + hi * 8) * 2;
        const bf16x8 b0 = *reinterpret_cast<const bf16x8*>(Ks + KSWZ64(r32, cb));
        const bf16x8 b1 = *reinterpret_cast<const bf16x8*>(Ks + KSWZ64(32 + r32, cb));
        p0 = __builtin_amdgcn_mfma_f32_32x32x16_bf16(b0, qr[d0], p0, 0, 0, 0);
        p1 = __builtin_amdgcn_mfma_f32_32x32x16_bf16(b1, qr[d0], p1, 0, 0, 0); }
}
__device__ __forceinline__ void partialSM(f32x16& p0, f32x16& p1, bool mixed, float fd, float sl2) {
    if (mixed) {
#pragma unroll
        for (int r = 0; r < 16; ++r) { const float d0 = fd - (float)((r & 3) + 8 * (r >> 2)); p0[r] = fmaf(fabsf(d0), -sl2, p0[r]); p1[r] = fmaf(fabsf(d0 - 32.0f), -sl2, p1[r]); }
    }
#pragma unroll
    for (int r = 0; r < 16; ++r) p0[r] = __builtin_amdgcn_exp2f(p0[r]);
}
__device__ __forceinline__ void finishSM(f32x16& p0, f32x16& p1, float& l_reg, bf16x8& pa0, bf16x8& pa1, bf16x8& pa2, bf16x8& pa3) {
#pragma unroll
    for (int r = 0; r < 16; ++r) p1[r] = __builtin_amdgcn_exp2f(p1[r]);
    float ps = 0;
#pragma unroll
    for (int r = 0; r < 16; ++r) ps += p0[r];
#pragma unroll
    for (int r = 0; r < 16; ++r) ps += p1[r];
    l_reg += ps;
#define PK4(P, BASE, OUT) do { unsigned a0 = cvt_pk_bf16(P[BASE + 0], P[BASE + 1]), a1 = cvt_pk_bf16(P[BASE + 2], P[BASE + 3]);   \
    unsigned b0 = cvt_pk_bf16(P[BASE + 4], P[BASE + 5]), b1 = cvt_pk_bf16(P[BASE + 6], P[BASE + 7]);                              \
    auto r0 = __builtin_amdgcn_permlane32_swap(a0, b0, false, false); auto r1 = __builtin_amdgcn_permlane32_swap(a1, b1, false, false); \
    u32x4 w = {r0[0], r1[0], r0[1], r1[1]}; OUT = __builtin_bit_cast(bf16x8, w); } while (0)
    PK4(p0, 0, pa0); PK4(p0, 8, pa1); PK4(p1, 0, pa2); PK4(p1, 8, pa3);
#undef PK4
}
__device__ __forceinline__ int v_st(int k, int c) { const int kk = (k & ~0xC) | ((k & 4) << 1) | ((k & 8) >> 1); return ((kk >> 3) * 4 + (c >> 5)) * 512 + ((kk & 7) * 32 + (c & 31)) * 2; }
__device__ __forceinline__ int v_rd_base(int lane) { return ((lane & 3) << 3) | (((lane >> 2) & 3) << 6) | (((lane >> 4) & 1) << 5) | (((lane >> 5) & 1) << 8); }
constexpr int v_rd_off(int d0, int ks, int half) { return d0 * 512 + ks * 4096 + half * 2048; }
template <int OFF> __device__ __forceinline__ s16x4 tr_read(int vb) {
    s16x4 r; asm volatile("ds_read_b64_tr_b16 %0, %1 offset:%2" : "=&v"(r) : "v"(vb), "i"(OFF) : "memory"); return r;
}
template <int D0> __device__ __forceinline__ void pv_one(f32x16& od, int vb, bf16x8 pa0, bf16x8 pa1, bf16x8 pa2, bf16x8 pa3) {
    const s16x4 l0 = tr_read<v_rd_off(D0, 0, 0)>(vb), h0 = tr_read<v_rd_off(D0, 0, 1)>(vb), l1 = tr_read<v_rd_off(D0, 1, 0)>(vb), h1 = tr_read<v_rd_off(D0, 1, 1)>(vb);
    const s16x4 l2 = tr_read<v_rd_off(D0, 2, 0)>(vb), h2 = tr_read<v_rd_off(D0, 2, 1)>(vb), l3 = tr_read<v_rd_off(D0, 3, 0)>(vb), h3 = tr_read<v_rd_off(D0, 3, 1)>(vb);
    asm volatile("s_waitcnt lgkmcnt(0)" ::: "memory"); SBAR();
#define PK(L, H) (bf16x8){L[0], L[1], L[2], L[3], H[0], H[1], H[2], H[3]}
    od = __builtin_amdgcn_mfma_f32_32x32x16_bf16(pa0, PK(l0, h0), od, 0, 0, 0);
    od = __builtin_amdgcn_mfma_f32_32x32x16_bf16(pa1, PK(l1, h1), od, 0, 0, 0);
    od = __builtin_amdgcn_mfma_f32_32x32x16_bf16(pa2, PK(l2, h2), od, 0, 0, 0);
    od = __builtin_amdgcn_mfma_f32_32x32x16_bf16(pa3, PK(l3, h3), od, 0, 0, 0);
#undef PK
}
__device__ __forceinline__ void pv_d0(f32x16* o, int vb, bf16x8 pa0, bf16x8 pa1, bf16x8 pa2, bf16x8 pa3) {
    pv_one<0>(o[0], vb, pa0, pa1, pa2, pa3); pv_one<1>(o[1], vb, pa0, pa1, pa2, pa3); pv_one<2>(o[2], vb, pa0, pa1, pa2, pa3); pv_one<3>(o[3], vb, pa0, pa1, pa2, pa3);
}
__device__ __forceinline__ void attn_unit(const bf16_t* __restrict__ Qb, const bf16_t* __restrict__ Kh, const bf16_t* __restrict__ Vh, bf16_t* __restrict__ Ob, int q0, int t_lo, int n, float sl2, char* lds) {
    const int tid = opaque_tid(), wid = __builtin_amdgcn_readfirstlane(tid >> 6), lane = tid & 63, r32 = lane & 31, hi = lane >> 5;
    float* ws = (float*)(lds + LDS_WS) + wid * 64; float* li_l = ws;
    float l_reg = 0; f32x16 o[4] = {}; bf16x8 qr[4];
    const bf16_t* Qw = Qb + (long)(wid * QBLK + r32) * LDQ + hi * 8;
#pragma unroll
    for (int d0 = 0; d0 < 4; ++d0) qr[d0] = *reinterpret_cast<const bf16x8*>(Qw + d0 * 16);
    float negM;
    { const bf16_t* Kw = Kh + (long)(q0 + wid * QBLK + r32) * LDK + hi * 8; float s = 0.f;
#pragma unroll
      for (int d0 = 0; d0 < 4; ++d0) { const u32x4 kw = *reinterpret_cast<const u32x4*>(Kw + d0 * 16); const u32x4 qw = __builtin_bit_cast(u32x4, qr[d0]);
          s += bflo(kw.x) * bflo(qw.x) + bfhi(kw.x) * bfhi(qw.x) + bflo(kw.y) * bflo(qw.y) + bfhi(kw.y) * bfhi(qw.y) + bflo(kw.z) * bflo(qw.z) + bfhi(kw.z) * bfhi(qw.z) + bflo(kw.w) * bflo(qw.w) + bfhi(kw.w) * bfhi(qw.w); }
      auto rr = __builtin_amdgcn_permlane32_swap(__float_as_uint(s), __float_as_uint(s), false, false); negM = -(__uint_as_float(rr[0]) + __uint_as_float(rr[1])); }
    const unsigned lds0 = (unsigned)(uintptr_t)lds;
    const int krow = wid * 8 + (lane >> 3), kch = (lane & 7) ^ ((krow >> 1) & 7);
    const unsigned koff = (unsigned)(krow * LDK * 2 + kch * 16);
    unsigned voff[2];
#pragma unroll
    for (int z = 0; z < 2; ++z) { const int P16 = (wid + 8 * z) * 64 + lane, sub = P16 >> 5, win = P16 & 31, kk = (sub >> 2) * 8 + (win >> 2), k = (kk & ~0xC) | ((kk & 4) << 1) | ((kk & 8) >> 1), c = (sub & 3) * 32 + (win & 3) * 8;
        voff[z] = (unsigned)(k * LDV * 2 + c * 2); }
    const unsigned kdst = lds0 + LDS_K + wid * 1024, vdst = lds0 + LDS_V + wid * 1024;
    const int vb0 = (int)(lds0 + LDS_V) + v_rd_base(lane);
    const char* K_lds = lds + LDS_K;
    const int qw0 = q0 + wid * QBLK;
    const float fq0 = (float)(qw0 + r32 - 4 * hi);
    const char* Kt = (const char*)(Kh + (long)t_lo * KVBLK * LDK); const char* Vt = (const char*)(Vh + (long)t_lo * KVBLK * LDV);
#define DMA(jj, slot) do { const char* kb_ = Kt + (size_t)(jj) * (KVBLK * LDK * 2); const char* vb_ = Vt + (size_t)(jj) * (KVBLK * LDV * 2); \
    glds16s(kb_, koff, (unsigned)__builtin_amdgcn_readfirstlane(kdst + (slot) * SHM_K)); \
    glds16s(vb_, voff[0], (unsigned)__builtin_amdgcn_readfirstlane(vdst + (slot) * SHM_V)); \
    glds16s(vb_, voff[1], (unsigned)__builtin_amdgcn_readfirstlane(vdst + (slot) * SHM_V + 8192)); } while (0)
#define TILE(jj) const int k0_ = (t_lo + (jj)) * KVBLK; const bool left_ = k0_ + 63 < qw0, right_ = k0_ > qw0 + 31, mixed_ = !(left_ || right_); \
    const float fd_ = fq0 - (float)k0_, st_ = left_ ? sl2 : (right_ ? -sl2 : 0.f), A_ = negM - st_ * fd_
    f32x16 pA0, pA1, pB0, pB1; bf16x8 pa0, pa1, pa2, pa3;
    asm volatile("s_waitcnt vmcnt(0)" ::: "memory");
#define SEG_A(PN0, PN1, PO0, PO1, jt, FIN) do { TILE(jt); SBAR(); qkt(PN0, PN1, K_lds + ((jt) & 3) * SHM_K, qr, r32, hi, A_, st_); if (FIN) finishSM(PO0, PO1, l_reg, pa0, pa1, pa2, pa3); SBAR(); } while (0)
#define SEG_B(P0, P1, jt, PV) do { if (PV) pv_d0(o, vb0 + (((jt) - 1) & 3) * SHM_V, pa0, pa1, pa2, pa3); { TILE(jt); partialSM(P0, P1, mixed_, fd_, sl2); } } while (0)
#define STEP_BAR(jt) do { WAITBAR(0); if ((jt) + 2 < n) DMA((jt) + 2, ((jt) + 2) & 3); } while (0)
    const bool lead = wid < 4;
    DMA(0, 0); DMA(1, 1);
    WAITBAR(3);
    SEG_A(pA0, pA1, pB0, pB1, 0, false); if (!lead) STEP_BAR(0); SEG_B(pA0, pA1, 0, false); if (lead) STEP_BAR(0);
    for (int j = 1; j + 1 < n; j += 2) {
        SEG_A(pB0, pB1, pA0, pA1, j, true); if (!lead) STEP_BAR(j); SEG_B(pB0, pB1, j, true); if (lead) STEP_BAR(j);
        SEG_A(pA0, pA1, pB0, pB1, j + 1, true); if (!lead) STEP_BAR(j + 1); SEG_B(pA0, pA1, j + 1, true); if (lead) STEP_BAR(j + 1);
    }
    SEG_A(pB0, pB1, pA0, pA1, n - 1, true); if (!lead) STEP_BAR(n - 1); SEG_B(pB0, pB1, n - 1, true); if (lead) STEP_BAR(n - 1);
    finishSM(pB0, pB1, l_reg, pa0, pa1, pa2, pa3); SBAR();
    pv_d0(o, vb0 + ((n - 1) & 3) * SHM_V, pa0, pa1, pa2, pa3);
    { auto rr = __builtin_amdgcn_permlane32_swap(__float_as_uint(l_reg), __float_as_uint(l_reg), false, false); l_reg = __uint_as_float(rr[0]) + __uint_as_float(rr[1]); }
    if (hi == 0) li_l[r32] = l_reg; asm volatile("s_waitcnt lgkmcnt(0)" ::: "memory");
    float rli[16];
#pragma unroll
    for (int r = 0; r < 16; ++r) rli[r] = __builtin_amdgcn_rcpf(li_l[crow(r, hi)]);
    bf16_t* Ow = Ob + (long)(wid * QBLK) * LDO;
#pragma unroll
    for (int r = 0; r < 16; ++r) { const int orow = crow(r, hi);
#pragma unroll
        for (int d0 = 0; d0 < 4; ++d0) Ow[(long)orow * LDO + d0 * 32 + r32] = (bf16_t)f2bf(o[d0][r] * rli[r]); }
    WAITBAR(0);
#undef DMA
#undef SEG_A
#undef SEG_B
#undef STEP_BAR
#undef TILE
}
#undef SBAR
}

namespace hy {
typedef f32x2 cf;
__device__ __forceinline__ cf lld(const LAS f32x2* L, int i) { return L[i]; }
__device__ __forceinline__ void lst(LAS f32x2* L, int i, cf v) { L[i] = v; }
__device__ __forceinline__ cf cmul(cf a, cf b) { return a * b.xx + a.yx * (b.yy * (cf){-1.f, 1.f}); }
__device__ __forceinline__ cf cmulc(cf a, cf b) { return a * b.xx + a.yx * (b.yy * (cf){1.f, -1.f}); }
__device__ constexpr float C32[16] = {1.0f, 0.98078528040323043f, 0.92387953251128674f, 0.83146961230254524f, 0.70710678118654757f, 0.55557023301960229f, 0.38268343236508984f, 0.19509032201612833f,
                                      0.0f, -0.19509032201612819f, -0.38268343236508973f, -0.55557023301960196f, -0.70710678118654746f, -0.83146961230254535f, -0.92387953251128674f, -0.98078528040323043f};
__device__ constexpr float S32[16] = {0.0f, 0.19509032201612825f, 0.38268343236508978f, 0.55557023301960218f, 0.70710678118654746f, 0.83146961230254524f, 0.92387953251128674f, 0.98078528040323043f,
                                      1.0f, 0.98078528040323043f, 0.92387953251128674f, 0.83146961230254546f, 0.70710678118654757f, 0.55557023301960218f, 0.38268343236508989f, 0.19509032201612861f};
__host__ __device__ constexpr int brev(int k, int bits) { int r = 0; for (int i = 0; i < bits; ++i) r |= ((k >> i) & 1) << (bits - 1 - i); return r; }
template <int R, bool INV> __device__ __forceinline__ void dft_reg(cf (&v)[R]) {
#pragma unroll
    for (int s = R / 2; s >= 1; s >>= 1) {
#pragma unroll
        for (int g0 = 0; g0 < R; g0 += 2 * s) {
#pragma unroll
            for (int j = 0; j < s; ++j) {
                const cf a = v[g0 + j], b = v[g0 + j + s];
                v[g0 + j] = a + b;
                const cf d = a - b;
                const int tw = j * (16 / s);
                if (tw == 0) v[g0 + j + s] = d;
                else if (tw == 8) v[g0 + j + s] = INV ? (cf){-d.y, d.x} : (cf){d.y, -d.x};
                else { const float c = C32[tw], sn = INV ? S32[tw] : -S32[tw]; v[g0 + j + s] = d * c + d.yx * (cf){-sn, sn}; }
            }
        }
    }
}
constexpr int RS = FFT_RS;
__device__ __forceinline__ void fft_fwd12(cf (&v)[32], LAS f32x2* L, int tid) {
    dft_reg<32, false>(v);
    { float s, c; sincospif((float)tid * (1.0f / 8192.0f), &s, &c); cf w1 = {c, -s}; asm volatile("" : "+v"(w1.x), "+v"(w1.y)); cf w = w1;
#pragma unroll
      for (int k1 = 0; k1 < 32; ++k1) { cf x = v[brev(k1, 5)]; if (k1) { x = cmul(x, w); w = cmul(w, w1); } lst(L, k1 * RS + tid, x); } }
    __syncthreads();
    const int k1 = tid >> 4, m2 = tid & 15;
#pragma unroll
    for (int m1 = 0; m1 < 32; ++m1) v[m1] = lld(L, k1 * RS + 16 * m1 + m2);
    __syncthreads();
    dft_reg<32, false>(v);
    { float s, c; sincospif((float)m2 * (1.0f / 256.0f), &s, &c); cf w1 = {c, -s}; asm volatile("" : "+v"(w1.x), "+v"(w1.y)); cf w = w1;
#pragma unroll
      for (int j1 = 0; j1 < 32; ++j1) { cf x = v[brev(j1, 5)]; if (j1) { x = cmul(x, w); w = cmul(w, w1); } lst(L, k1 * RS + 33 * m2 + j1, x); } }
    __syncthreads();
}
__device__ __forceinline__ void fft_inv21(cf (&v)[32], LAS f32x2* L, int tid) {
    const int k1 = tid >> 4, m2 = tid & 15;
    { float s, c; sincospif((float)m2 * (1.0f / 256.0f), &s, &c); cf w1 = {c, -s}; asm volatile("" : "+v"(w1.x), "+v"(w1.y)); cf w = w1;
#pragma unroll
      for (int j1 = 0; j1 < 32; ++j1) { cf x = lld(L, k1 * RS + 33 * m2 + j1); if (j1) { x = cmulc(x, w); w = cmul(w, w1); } v[j1] = x; } }
    __syncthreads();
    dft_reg<32, true>(v);
#pragma unroll
    for (int m1 = 0; m1 < 32; ++m1) lst(L, k1 * RS + 16 * m1 + m2, v[brev(m1, 5)]);
    __syncthreads();
    { float s, c; sincospif((float)tid * (1.0f / 8192.0f), &s, &c); cf w1 = {c, -s}; asm volatile("" : "+v"(w1.x), "+v"(w1.y)); cf w = w1;
#pragma unroll
      for (int kk = 0; kk < 32; ++kk) { cf x = lld(L, kk * RS + tid); if (kk) { x = cmulc(x, w); w = cmul(w, w1); } v[kk] = x; } }
    dft_reg<32, true>(v);
}
}

namespace hm {
typedef f32x2 cf;
constexpr int ROWA = 40, ROWB = 24;
constexpr int PL_A = 512 * ROWA * 2, PL_B = 1024 * ROWB * 2;
__device__ __forceinline__ int crow(int r, int hi) { return (r & 3) + 8 * (r >> 2) + 4 * hi; }
struct CFrag { bf16x8 re, im, nim; };
__device__ __forceinline__ CFrag dft_frag(int n, int row, int k0, bool valid) {
    unsigned wr[4], wi[4], wn[4];
#pragma unroll
    for (int t = 0; t < 4; ++t) { float s0, c0, s1, c1; sincospif(-2.0f * (float)((row * (k0 + 2 * t)) % n) / (float)n, &s0, &c0); sincospif(-2.0f * (float)((row * (k0 + 2 * t + 1)) % n) / (float)n, &s1, &c1);
        if (!valid) { s0 = c0 = s1 = c1 = 0.f; }
        wr[t] = pk2(c0, c1); wi[t] = pk2(s0, s1); wn[t] = pk2(-s0, -s1); }
    CFrag f; f.re = __builtin_bit_cast(bf16x8, (u32x4){wr[0], wr[1], wr[2], wr[3]}); f.im = __builtin_bit_cast(bf16x8, (u32x4){wi[0], wi[1], wi[2], wi[3]}); f.nim = __builtin_bit_cast(bf16x8, (u32x4){wn[0], wn[1], wn[2], wn[3]});
    return f;
}
template <bool CONJ> __device__ __forceinline__ void cmfma(f32x16& dr, f32x16& di, const CFrag& a, bf16x8 br, bf16x8 bi) {
    dr = __builtin_amdgcn_mfma_f32_32x32x16_bf16(a.re, br, dr, 0, 0, 0); dr = __builtin_amdgcn_mfma_f32_32x32x16_bf16(CONJ ? a.im : a.nim, bi, dr, 0, 0, 0);
    di = __builtin_amdgcn_mfma_f32_32x32x16_bf16(a.re, bi, di, 0, 0, 0); di = __builtin_amdgcn_mfma_f32_32x32x16_bf16(CONJ ? a.nim : a.im, br, di, 0, 0, 0);
}
__device__ __forceinline__ cf cmul(cf a, cf b) { return a * b.xx + a.yx * (b.yy * (cf){-1.f, 1.f}); }
__device__ __forceinline__ cf cmulc(cf a, cf b) { return a * b.xx + a.yx * (b.yy * (cf){1.f, -1.f}); }
__device__ __forceinline__ bf16x8 pk4(const float (&P)[8]) {
    const unsigned a0 = cvt_pk_bf16(P[0], P[1]), a1 = cvt_pk_bf16(P[2], P[3]), b0 = cvt_pk_bf16(P[4], P[5]), b1 = cvt_pk_bf16(P[6], P[7]);
    auto r0 = __builtin_amdgcn_permlane32_swap(a0, b0, false, false); auto r1 = __builtin_amdgcn_permlane32_swap(a1, b1, false, false);
    return __builtin_bit_cast(bf16x8, (u32x4){r0[0], r1[0], r0[1], r1[1]});
}
constexpr int LDS_FTAB = 100 * 1024;
struct Consts { const LAS unsigned char* T; int lane;
    __device__ __forceinline__ CFrag get(int which) const { const LAS unsigned char* p = T + (which * 64 + lane) * 48; CFrag f; f.re = *(const LAS bf16x8*)p; f.im = *(const LAS bf16x8*)(p + 16); f.nim = *(const LAS bf16x8*)(p + 32); return f; } };
__device__ __forceinline__ void build_ftab(LAS unsigned char* T, int tid) {
    if (tid < 64) { const int j = tid & 31, hi = tid >> 5;
        const CFrag f0 = dft_frag(32, j, 8 * hi, true), f1 = dft_frag(32, j, 16 + 8 * hi, true), g = dft_frag(16, j & 15, 8 * hi, j < 16);
        LAS bf16x8* p = (LAS bf16x8*)(T + tid * 48); p[0] = f0.re; p[1] = f0.im; p[2] = f0.nim;
        p = (LAS bf16x8*)(T + (64 + tid) * 48); p[0] = f1.re; p[1] = f1.im; p[2] = f1.nim;
        p = (LAS bf16x8*)(T + (128 + tid) * 48); p[0] = g.re; p[1] = g.im; p[2] = g.nim; }
    __syncthreads();
}
__device__ __forceinline__ void st2(LAS unsigned char* L, int plane_bytes, int idx, cf v) { const unsigned w = cvt_pk_bf16(v.x, v.y); ((LAS bf16_t*)L)[idx] = (bf16_t)(w & 0xffffu); ((LAS bf16_t*)(L + plane_bytes))[idx] = (bf16_t)(w >> 16); }
template <int NK> __device__ __forceinline__ void fwd12(const Consts& C, const bf16x8 (&Bre)[2][NK], const bf16x8 (&Bim)[2][NK], LAS unsigned char* L, const float2* TW1, const float2* TW2, int wave, int j, int hi) {
    asm volatile("" : "+v"(j), "+v"(hi));
#pragma unroll
    for (int tl = 0; tl < 2; ++tl) { const int n2 = 64 * wave + 32 * tl + j; f32x16 dr = {}, di = {};
        cmfma<false>(dr, di, C.get(0), Bre[tl][0], Bim[tl][0]); if constexpr (NK == 2) cmfma<false>(dr, di, C.get(1), Bre[tl][1], Bim[tl][1]);
#pragma unroll
        for (int r = 0; r < 16; ++r) { const int k1 = crow(r, hi); const float2 t = TW1[k1 * 512 + n2]; st2(L, PL_A, (k1 * 16 + (n2 & 15)) * ROWA + (n2 >> 4), cmul((cf){dr[r], di[r]}, (cf){t.x, t.y})); } }
    __syncthreads();
    asm volatile("" : "+v"(j), "+v"(hi));
    bf16x8 yre[2][2], yim[2][2];
#pragma unroll
    for (int tl = 0; tl < 2; ++tl) { const int col = (4 * wave + 2 * tl + (j >> 4)) * 16 + (j & 15);
#pragma unroll
        for (int ks = 0; ks < 2; ++ks) { yre[tl][ks] = *(const LAS bf16x8*)(L + (col * ROWA + 16 * ks + 8 * hi) * 2); yim[tl][ks] = *(const LAS bf16x8*)(L + PL_A + (col * ROWA + 16 * ks + 8 * hi) * 2); } }
    __syncthreads();
    asm volatile("" : "+v"(j), "+v"(hi));
#pragma unroll
    for (int tl = 0; tl < 2; ++tl) { const int k1 = 4 * wave + 2 * tl + (j >> 4), m2 = j & 15; f32x16 dr = {}, di = {};
        cmfma<false>(dr, di, C.get(0), yre[tl][0], yim[tl][0]); cmfma<false>(dr, di, C.get(1), yre[tl][1], yim[tl][1]);
#pragma unroll
        for (int r = 0; r < 16; ++r) { const int j1 = crow(r, hi); const float2 t = TW2[j1 * 16 + m2]; st2(L, PL_B, (k1 * 32 + j1) * ROWB + m2, cmul((cf){dr[r], di[r]}, (cf){t.x, t.y})); } }
    __syncthreads();
}
__device__ __forceinline__ void inv21(const Consts& C, cf (&y)[2][8], LAS unsigned char* L, const float2* TW1, int wave, int j, int hi) {
    asm volatile("" : "+v"(j), "+v"(hi));
    bf16x8 yre[2][2], yim[2][2];
#pragma unroll
    for (int tl = 0; tl < 2; ++tl) { const int col = (4 * wave + 2 * tl + (j >> 4)) * 16 + (j & 15);
#pragma unroll
        for (int ks = 0; ks < 2; ++ks) { yre[tl][ks] = *(const LAS bf16x8*)(L + (col * ROWA + 16 * ks + 8 * hi) * 2); yim[tl][ks] = *(const LAS bf16x8*)(L + PL_A + (col * ROWA + 16 * ks + 8 * hi) * 2); } }
    __syncthreads();
    asm volatile("" : "+v"(j), "+v"(hi));
#pragma unroll
    for (int tl = 0; tl < 2; ++tl) { const int k1 = 4 * wave + 2 * tl + (j >> 4), m2 = j & 15; f32x16 dr = {}, di = {};
        cmfma<true>(dr, di, C.get(0), yre[tl][0], yim[tl][0]); cmfma<true>(dr, di, C.get(1), yre[tl][1], yim[tl][1]);
#pragma unroll
        for (int r = 0; r < 16; ++r) { const int n2 = 16 * crow(r, hi) + m2; const float2 t = TW1[k1 * 512 + n2]; st2(L, PL_A, n2 * ROWA + k1, cmulc((cf){dr[r], di[r]}, (cf){t.x, t.y})); } }
    __syncthreads();
    asm volatile("" : "+v"(j), "+v"(hi));
#pragma unroll
    for (int tl = 0; tl < 2; ++tl) { const int n2 = 64 * wave + 32 * tl + j; f32x16 dr = {}, di = {};
#pragma unroll
        for (int ks = 0; ks < 2; ++ks) { const bf16x8 br = *(const LAS bf16x8*)(L + (n2 * ROWA + 16 * ks + 8 * hi) * 2), bi = *(const LAS bf16x8*)(L + PL_A + (n2 * ROWA + 16 * ks + 8 * hi) * 2);
            cmfma<true>(dr, di, C.get(ks), br, bi); }
#pragma unroll
        for (int r = 0; r < 8; ++r) y[tl][r] = (cf){dr[r], di[r]}; }
    __syncthreads();
}
}
constexpr size_t MiB = 1u << 20;
constexpr size_t WS_CTL = 0, CTL_ZERO_BYTES = 1 * MiB;
constexpr size_t WS_W1T = 1 * MiB;
constexpr size_t WS_W2T = 257 * MiB;
constexpr size_t WS_WIN_EV = 385 * MiB, WS_WOUT_EV = 409 * MiB, WS_WIN_OD = 417 * MiB, WS_WOUT_OD = 433 * MiB, WS_WG_OD = 441 * MiB;
constexpr size_t AR = 445 * MiB;
constexpr size_t A_XB = AR + 0 * MiB, A_UHT = AR + 64 * MiB, A_QB = AR + 160 * MiB, A_KB = AR + 192 * MiB, A_VB = AR + 224 * MiB, A_KTD = AR + 256 * MiB, A_KF = AR + 384 * MiB,
                 A_H3B = AR + 512 * MiB, A_W4T = AR + 514 * MiB, A_YHT = AR + 416 * MiB, A_OA = AR + 448 * MiB, A_YCAT = AR + 512 * MiB, A_XB2 = AR + 0 * MiB, A_R0 = AR + 64 * MiB, A_H1_0 = AR + 192 * MiB,
                 A_HB_0 = AR + 320 * MiB, A_HID_0 = AR + 384 * MiB, A_ROWL = AR + 424 * MiB, A_GATEW = AR + 428 * MiB, A_Y2_0 = AR + 0 * MiB, A_H2 = AR + 448 * MiB, A_HB2 = AR + 448 * MiB;
constexpr size_t A_GB = AR + 0 * MiB, A_XR = AR + 64 * MiB, A_XC = AR + 192 * MiB, A_LA = AR + 256 * MiB, A_BB = AR + 64 * MiB, A_CAR = AR + 384 * MiB, A_YG = AR + 192 * MiB, A_R1 = AR + 256 * MiB,
                 A_H1_1 = AR + 0 * MiB, A_HB8_1 = AR + 0 * MiB, A_XB8 = AR + 320 * MiB, WS_WIN_EV8 = AR + 544 * MiB, A_HB2_8 = AR + 512 * MiB, A_HB8_0 = AR + 192 * MiB, A_HB_1 = AR + 128 * MiB, A_HID_1 = AR + 192 * MiB, A_Y2_1 = AR + 256 * MiB;
constexpr size_t WS_END = AR + 576 * MiB;
constexpr size_t WS_TW1 = WS_CTL + 512 * 1024, WS_TW2 = WS_TW1 + 128 * 1024;
constexpr int CW_BAR = 4096, CW_CNT = 16384, CW_NORM = 24576;
constexpr int LDS_MISC = 139264, LDS_BYTES = 147456;
constexpr int NPHASE = 21;
#ifndef FP8_P1
#define FP8_P1 0
#endif
#ifndef FP8_P1B
#define FP8_P1B 0
#endif
#ifndef FP8_P1C
#define FP8_P1C 0
#endif
#ifndef FP8_P16
#define FP8_P16 1
#endif
#ifndef FP8_P5
#define FP8_P5 1
#endif
#ifndef FP8_P10
#define FP8_P10 1
#endif
#ifndef MOE_FP8_LAYERS
#define MOE_FP8_LAYERS 2
#endif

struct Args { const float* in[37]; float* out; unsigned char* ws; int ph_lo, ph_hi; };
typedef const __attribute__((address_space(4))) Args& KArgs;

template <bool F8> __device__ __forceinline__ void transpose_item(const float* W, int N, int k0, int n0, void* WTv, int ldk, int drow0, float scale, LAS float* scr, int lane) {
#pragma unroll 4
    for (int kk = 0; kk < 64; ++kk) scr[kk * 65 + lane] = W[(size_t)(k0 + kk) * N + n0 + lane];
    LDS_WAIT(); asm volatile("" ::: "memory");
    const int c = lane & 7;
#pragma unroll
    for (int jj = 0; jj < 8; ++jj) { const int n = (lane >> 3) + 8 * jj; const LAS float* s = scr + (8 * c) * 65 + n;
        if constexpr (F8) { u32x2 o; o.x = pg8::pk4_fp8(s[0 * 65] * scale, s[1 * 65] * scale, s[2 * 65] * scale, s[3 * 65] * scale); o.y = pg8::pk4_fp8(s[4 * 65] * scale, s[5 * 65] * scale, s[6 * 65] * scale, s[7 * 65] * scale);
            *(u32x2*)((unsigned char*)WTv + (size_t)(drow0 + n) * ldk + k0 + 8 * c) = o; }
        else { u32x4 o; o.x = pk2(s[0 * 65], s[1 * 65]); o.y = pk2(s[2 * 65], s[3 * 65]); o.z = pk2(s[4 * 65], s[5 * 65]); o.w = pk2(s[6 * 65], s[7 * 65]);
            *(u32x4*)((bf16_t*)WTv + (size_t)(drow0 + n) * ldk + k0 + 8 * c) = o; } }
    LDS_WAIT(); asm volatile("" ::: "memory");
}
__device__ __forceinline__ void phase_prologue(KArgs a, LAS unsigned char* lds) {
    const int tid = opaque_tid(), lane = tid & 63, wave = tid >> 6, G = gridDim.x;
    const int gw = blockIdx.x * 8 + wave, NGW = G * 8;
    unsigned char* ws = a.ws;
    LAS float* scr = (LAS float*)(lds + wave * 16640);
    constexpr int I_EVIN = 32 * 96, I_SQ = 32 * 32, I_ODIN = 32 * 64, I_MOE_GU = 64 * 256, I_MOE_D = 64 * 256, I_RG = 16 * 16, I_W4 = 64;
    constexpr int O1 = I_EVIN, O2 = O1 + I_SQ, O3 = O2 + I_ODIN, O4 = O3 + I_SQ, O5 = O4 + I_MOE_GU, O6 = O5 + I_MOE_GU, O7 = O6 + I_MOE_D, O8 = O7 + I_RG, O9 = O8 + I_RG, O10 = O9 + I_W4;
    for (int it = gw; it < O10; it += NGW) {
        if (it < O1) { const int kb = it / 96, nb = it % 96;
            const bool f8 = (nb * 64 < 3072) ? (FP8_P1C != 0) : (FP8_P1B != 0);
            if (f8) transpose_item<true>(a.in[1], EV_IN, kb * 64, nb * 64, ws + WS_WIN_EV8, DM, nb * 64, pg8::FP8_SW, scr, lane);
            else transpose_item<false>(a.in[1], EV_IN, kb * 64, nb * 64, ws + WS_WIN_EV, DM, nb * 64, 1.f, scr, lane); }
        else if (it < O2) { const int r = it - O1, kb = r / 32, nb = r % 32;
            if (FP8_P5) transpose_item<true>(a.in[18], DM, kb * 64, nb * 64, ws + WS_WOUT_EV, DM, nb * 64, pg8::FP8_SW, scr, lane);
            else transpose_item<false>(a.in[18], DM, kb * 64, nb * 64, ws + WS_WOUT_EV, DM, nb * 64, 1.f, scr, lane); }
        else if (it < O3) { const int r = it - O2, kb = r / 64, nb = r % 64;
            if (FP8_P10) transpose_item<true>(a.in[19], 2 * DM, kb * 64, nb * 64, ws + WS_WIN_OD, DM, nb * 64, pg8::FP8_SW, scr, lane);
            else transpose_item<false>(a.in[19], 2 * DM, kb * 64, nb * 64, ws + WS_WIN_OD, DM, nb * 64, 1.f, scr, lane); }
        else if (it < O4) { const int r = it - O3, kb = r / 32, nb = r % 32;
            if (FP8_P16) transpose_item<true>(a.in[27], DM, kb * 64, nb * 64, ws + WS_WOUT_OD, DM, nb * 64, pg8::FP8_SW, scr, lane);
            else transpose_item<false>(a.in[27], DM, kb * 64, nb * 64, ws + WS_WOUT_OD, DM, nb * 64, 1.f, scr, lane); }
        else if (it < O6) { const bool up = it >= O5; const int r = it - (up ? O5 : O4), le = r / 256, q = r % 256, kb = q / 8, nb = q % 8, n0 = nb * 64;
            const int drow = (n0 >> 7) * 256 + (n0 & 127) + (up ? 128 : 0); const float* src = (up ? a.in[35] : a.in[34]) + (size_t)le * DM * DFF;
            if (le < 32 * (2 - MOE_FP8_LAYERS)) transpose_item<false>(src, DFF, kb * 64, n0, (bf16_t*)(ws + WS_W1T) + (size_t)le * 1024 * DM, DM, drow, 1.f, scr, lane);
            else transpose_item<true>(src, DFF, kb * 64, n0, ws + WS_W1T + (size_t)(le >> 5) * 32 * 1024 * DM * 2 + (size_t)(le & 31) * 1024 * DM, DM, drow, pg8::FP8_SW, scr, lane); }
        else if (it < O7) { const int r = it - O6, le = r / 256, q = r % 256, kb = q / 32, nb = q % 32; const float* src = a.in[36] + (size_t)le * DFF * DM;
            if (le < 32 * (2 - MOE_FP8_LAYERS)) transpose_item<false>(src, DM, kb * 64, nb * 64, (bf16_t*)(ws + WS_W2T) + (size_t)le * DM * DFF, DFF, nb * 64, 1.f, scr, lane);
            else transpose_item<true>(src, DM, kb * 64, nb * 64, ws + WS_W2T + (size_t)(le >> 5) * 32 * DM * DFF * 2 + (size_t)(le & 31) * DM * DFF, DFF, nb * 64, pg8::FP8_SW, scr, lane); }
        else if (it < O9) { const bool wx = it >= O8; const int r = it - (wx ? O8 : O7), dn = r / 16, q = r % 16, kb = q / 4, nb = q % 4, n0 = nb * 64, dir = dn / 8, n = dn % 8;
            transpose_item<false>((wx ? a.in[24] : a.in[22]) + (size_t)dn * 65536, 256, kb * 64, n0, ws + WS_WG_OD, 256, (n * 4 + dir * 2 + (n0 >> 7)) * 256 + (n0 & 127) + (wx ? 128 : 0), 1.f, scr, lane); }
        else { const int nb = it - O9; transpose_item<false>(a.in[11], 4096, 0, nb * 64, ws + A_W4T, 128, nb * 64, 1.f, scr, lane); }
    }
    { const int gt = blockIdx.x * 512 + tid, NT = G * 512;
      for (int i = gt; i < 16384 + 512; i += NT) { float sn, cs;
          if (i < 16384) { const int k1 = i >> 9, n2 = i & 511; sincospif(-2.0f * (float)((k1 * n2) & 16383) * (1.0f / 16384.0f), &sn, &cs); ((float2*)(ws + WS_TW1))[i] = make_float2(cs, sn); }
          else { const int q = i - 16384, j1 = q >> 4, m2 = q & 15; sincospif(-2.0f * (float)((j1 * m2) & 511) * (1.0f / 512.0f), &sn, &cs); ((float2*)(ws + WS_TW2))[q] = make_float2(cs, sn); } }
      for (int i = gt; i < 4096 * 8; i += NT) { const int r = i >> 3, c = i & 7; *(u32x4*)((bf16_t*)(ws + A_W4T) + (size_t)r * 128 + 64 + c * 8) = (u32x4){0u, 0u, 0u, 0u}; }
      for (int i = gt; i < 8192 * 8; i += NT) { const int r = i >> 3, c = i & 7; *(u32x4*)((bf16_t*)(ws + A_H3B) + (size_t)r * 128 + 64 + c * 8) = (u32x4){0u, 0u, 0u, 0u}; }
      const f32x8* x8 = (const f32x8*)a.in[0]; u32x4* xb = (u32x4*)(ws + A_XB);
      u32x2* xb8 = (u32x2*)(ws + A_XB8);
      for (int i = gt; i < NTOK * DM / 8; i += NT) { const f32x8 v = x8[i]; u32x4 o; o.x = pk2(v[0], v[1]); o.y = pk2(v[2], v[3]); o.z = pk2(v[4], v[5]); o.w = pk2(v[6], v[7]); xb[i] = o;
          if (FP8_P1) { u32x2 q; q.x = pg8::pk4_fp8(v[0], v[1], v[2], v[3]); q.y = pg8::pk4_fp8(v[4], v[5], v[6], v[7]); xb8[i] = q; } } }
    { const float* w1 = a.in[4]; const float* b1 = a.in[5]; const float* w2 = a.in[6]; const float* b2 = a.in[7]; const float* w3 = a.in[8]; const float* b3 = a.in[9]; const float* fr = a.in[10];
      const float frq = fr[lane];
      for (int t = gw; t < SEQ; t += NGW) {
          float z;
          { const float tl = (float)t * (1.0f / 8191.0f);
            if (lane == 0) z = tl;
            else { const int j = (lane - 1) & 15; const float band = 1e-4f + (float)j * ((15.0f - 1e-4f) / 15.0f);
                   const float ang = (6.283185307179586f * (float)t * (1.0f / 8192.0f)) * band; float sn, cs; sincosf(ang, &sn, &cs); z = (lane <= 16) ? cs : -sn; } }
          float acc = b1[lane];
#pragma unroll
          for (int i = 0; i < 33; ++i) acc += __shfl(z, i) * w1[i * 64 + lane];
          float h = sinf(frq * acc);
          acc = b2[lane];
#pragma unroll 16
          for (int i = 0; i < 64; ++i) acc += __shfl(h, i) * w2[i * 64 + lane];
          h = sinf(frq * acc);
          acc = b3[lane];
#pragma unroll 16
          for (int i = 0; i < 64; ++i) acc += __shfl(h, i) * w3[i * 64 + lane];
          h = sinf(frq * acc);
          ((bf16_t*)(ws + A_H3B))[(size_t)t * 128 + lane] = (bf16_t)f2bf(h);
      } }
}

__device__ __forceinline__ void filter_unit(KArgs a, LAS unsigned char* lds, int u, int tid) {
    const int lane = tid & 63, wave = tid >> 6;
    LAS f32x2* L = (LAS f32x2*)lds; LAS float* red = (LAS float*)(lds + LDS_MISC + 1024);
    const bf16_t* KTD = (const bf16_t*)(a.ws + A_KTD); __half2* KF = (__half2*)(a.ws + A_KF);
    {
        int tl = tid; asm volatile("" : "+v"(tl));
        const bf16_t* rowF = KTD + (size_t)u * 8192; const bf16_t* rowB = KTD + (size_t)(2048 + u) * 8192;
        hy::cf v[32]; float ss = 0.f;
#pragma unroll
        for (int n1 = 0; n1 < 32; ++n1) { const int p = tl + 512 * n1; float val;
            if (n1 < 16) val = bf2f(rowF[p]); else if (p == 8192) val = 0.f; else val = bf2f(rowB[16384 - p]);
            v[n1] = (hy::cf){val, 0.f}; ss += val * val; }
        ss = wave_sum(ss); if (lane == 0) red[wave] = ss; __syncthreads();
        float tot = 0.f;
#pragma unroll
        for (int w = 0; w < 8; ++w) tot += red[w];
        const float scale = rsqrtf(tot), skp = a.in[12][u];
        hy::fft_fwd12(v, L, tl);
#pragma unroll
        for (int bf = 0; bf < 2; ++bf) { const int idx = bf * 512 + tl, k1 = idx >> 5, j1 = idx & 31; hy::cf w[16];
#pragma unroll
            for (int m2 = 0; m2 < 16; ++m2) w[m2] = hy::lld(L, k1 * hy::RS + 33 * m2 + j1);
            hy::dft_reg<16, false>(w);
#pragma unroll
            for (int j2 = 0; j2 < 16; ++j2) { const hy::cf x = w[hy::brev(j2, 4)]; KF[((size_t)((blockIdx.x * 2 + (u >> 10)) * 2 + bf) * 16 + j2) * 512 + tl] = __floats2half2_rn(x.x * scale + skp, x.y * scale); } }
        __syncthreads();
    }
}
__device__ __forceinline__ float hyconv(const bf16_t* row, int t, float w0, float w1, float w2, float bias) {
    const bf16_t* p = row + t;
    float xm = bf2f(p[-1]), x0 = bf2f(p[0]), xp = bf2f(p[1]);
    xm = t > 0 ? xm : 0.f; xp = t < SEQ - 1 ? xp : 0.f;
    return w0 * xm + w1 * x0 + w2 * xp + bias;
}
__device__ __forceinline__ bf16x8 pack8(const float (&v)[8]) { return __builtin_bit_cast(bf16x8, (u32x4){cvt_pk_bf16(v[0], v[1]), cvt_pk_bf16(v[2], v[3]), cvt_pk_bf16(v[4], v[5]), cvt_pk_bf16(v[6], v[7])}); }
__device__ __forceinline__ void phase_hyena_mixer(KArgs a, LAS unsigned char* lds) {
    const int tid = opaque_tid(), lane = tid & 63, wave = __builtin_amdgcn_readfirstlane(tid >> 6), j = lane & 31, hi = lane >> 5, G = gridDim.x;
    LAS unsigned char* L = lds; LAS float* red = (LAS float*)(lds + LDS_MISC + 1024);
    const bf16_t* UHT = (const bf16_t*)(a.ws + A_UHT); const bf16_t* KTD = (const bf16_t*)(a.ws + A_KTD); bf16_t* YHT = (bf16_t*)(a.ws + A_YHT);
    __half2* KF = (__half2*)(a.ws + A_KF) + (size_t)blockIdx.x * (2 * 32 * 8 * 64);
    const float2* TW1 = (const float2*)(a.ws + WS_TW1); const float2* TW2 = (const float2*)(a.ws + WS_TW2);
    const float* cw = a.in[2]; const float* cb = a.in[3];
    hm::build_ftab(lds + hm::LDS_FTAB, tid); const hm::Consts C{lds + hm::LDS_FTAB, lane};
    for (int c = blockIdx.x; c < HY_CH; c += G) {
        int jl = j, hil = hi, wl = wave; asm volatile("" : "+v"(jl), "+v"(hil), "+s"(wl));
#ifndef HM_NOFILTER
#pragma unroll 1
        for (int o = 0; o < 2; ++o) { const int u = o * 1024 + c;
            const bf16_t* rowF = KTD + (size_t)u * 8192; const bf16_t* rowB = KTD + (size_t)(2048 + u) * 8192;
            bf16x8 Bre[2][2], Bim[2][2]; float ss = 0.f;
#pragma unroll
            for (int tl = 0; tl < 2; ++tl)
#pragma unroll
                for (int ks = 0; ks < 2; ++ks) { float v[8];
#pragma unroll
                    for (int t = 0; t < 8; ++t) { const int p = 64 * wl + 32 * tl + jl + 512 * (16 * ks + 8 * hil + t);
                        if (ks == 0) v[t] = bf2f(rowF[p]); else { const float x = bf2f(rowB[16384 - p]); v[t] = (p == 8192) ? 0.f : x; }
                        ss += v[t] * v[t]; }
                    Bre[tl][ks] = pack8(v); Bim[tl][ks] = (bf16x8){0, 0, 0, 0, 0, 0, 0, 0}; asm volatile("" ::: "memory"); }
            ss = wave_sum(ss); if (lane == 0) red[wave] = ss; __syncthreads();
            float tot = 0.f;
#pragma unroll
            for (int w = 0; w < 8; ++w) tot += red[w];
            const float scale = rsqrtf(tot), skp = a.in[12][u];
            hm::fwd12<2>(C, Bre, Bim, L, TW1, TW2, wl, jl, hil);
#pragma unroll
            for (int q = 0; q < 4; ++q) { const int t3 = 4 * wl + q, colp = 32 * t3 + jl; f32x16 dr = {}, di = {};
                hm::cmfma<false>(dr, di, C.get(2), *(const LAS bf16x8*)(L + (colp * hm::ROWB + 8 * hil) * 2), *(const LAS bf16x8*)(L + hm::PL_B + (colp * hm::ROWB + 8 * hil) * 2));
#pragma unroll
                for (int r = 0; r < 8; ++r) KF[((o * 32 + t3) * 8 + r) * 64 + lane] = __floats2half2_rn(dr[r] * scale + skp, di[r] * scale); asm volatile("" ::: "memory"); }
            __syncthreads();
        }
#endif
        VM_WAIT();
#ifndef HM_NOMIXER
        bf16x8 Zre[2][1], Zim[2][1];
        { const bf16_t* r0 = UHT + (size_t)c * NTOK; const float w0 = cw[c], w1 = cw[3072 + c], w2 = cw[6144 + c], bb = cb[c];
#pragma unroll
          for (int tl = 0; tl < 2; ++tl) { float v0[8], v1[8];
#pragma unroll
              for (int t = 0; t < 8; ++t) { const int tt = 64 * wl + 32 * tl + jl + 512 * (8 * hil + t); v0[t] = hyconv(r0, tt, w0, w1, w2, bb); v1[t] = hyconv(r0 + SEQ, tt, w0, w1, w2, bb); }
              Zre[tl][0] = pack8(v0); Zim[tl][0] = pack8(v1); asm volatile("" ::: "memory"); } }
#pragma unroll 1
        for (int o = 0; o < 2; ++o) {
            hm::fwd12<1>(C, Zre, Zim, L, TW1, TW2, wl, jl, hil);
            int j3 = jl, h3 = hil; asm volatile("" : "+v"(j3), "+v"(h3));
            bf16x8 zre[4], zim[4];
#pragma unroll
            for (int q = 0; q < 4; ++q) { const int colp = 32 * (4 * wl + q) + j3; zre[q] = *(const LAS bf16x8*)(L + (colp * hm::ROWB + 8 * h3) * 2); zim[q] = *(const LAS bf16x8*)(L + hm::PL_B + (colp * hm::ROWB + 8 * h3) * 2); }
            __syncthreads();
            asm volatile("" : "+v"(j3), "+v"(h3));
#pragma unroll
            for (int q = 0; q < 4; ++q) { const int t3 = 4 * wl + q; f32x16 dr = {}, di = {};
                hm::cmfma<false>(dr, di, C.get(2), zre[q], zim[q]);
                float xr[8], xi[8];
#pragma unroll
                for (int r = 0; r < 8; ++r) { const float2 kf = __half22float2(KF[((o * 32 + t3) * 8 + r) * 64 + lane]); const hm::cf x = hm::cmul((hm::cf){dr[r], di[r]}, (hm::cf){kf.x, kf.y}); xr[r] = x.x; xi[r] = x.y; }
                const bf16x8 br = hm::pk4(xr), bi = hm::pk4(xi);
                f32x16 er = {}, ei = {};
                hm::cmfma<true>(er, ei, C.get(2), br, bi);
#pragma unroll
                for (int r = 0; r < 8; ++r) { const int m2 = hm::crow(r, h3); const float2 t = TW2[j3 * 16 + m2]; hm::st2(L, hm::PL_A, (t3 * 16 + m2) * hm::ROWA + j3, hm::cmulc((hm::cf){er[r], ei[r]}, (hm::cf){t.x, t.y})); } asm volatile("" ::: "memory"); }
            __syncthreads();
            hm::cf y[2][8];
            hm::inv21(C, y, L, TW1, wl, jl, hil);
            const int gch = (o + 1) * 1024 + c; const bf16_t* rg = UHT + (size_t)gch * NTOK;
            const float w0 = cw[gch], w1 = cw[3072 + gch], w2 = cw[6144 + gch], bb = cb[gch];
            int jg = jl, hg = hil; asm volatile("" : "+v"(jg), "+v"(hg));
#pragma unroll
            for (int tl = 0; tl < 2; ++tl) { float z0[8], z1[8];
#pragma unroll
                for (int r = 0; r < 8; ++r) { const int tt = 64 * wl + 32 * tl + jg + 512 * hm::crow(r, hg);
                    z0[r] = hyconv(rg, tt, w0, w1, w2, bb) * y[tl][r].x * (1.0f / 16384.0f); z1[r] = hyconv(rg + SEQ, tt, w0, w1, w2, bb) * y[tl][r].y * (1.0f / 16384.0f); }
                asm volatile("" ::: "memory");
                if (o == 0) { Zre[tl][0] = hm::pk4(z0); Zim[tl][0] = hm::pk4(z1); }
                else { bf16_t* yo = YHT + (size_t)c * NTOK;
#pragma unroll
                    for (int r = 0; r < 8; ++r) { const int tt = 64 * wl + 32 * tl + jg + 512 * hm::crow(r, hg); yo[tt] = (bf16_t)f2bf(z0[r]); yo[SEQ + tt] = (bf16_t)f2bf(z1[r]); } } }
        }
#endif
    }
    __syncthreads();
}
__device__ __forceinline__ void phase_qknorm(KArgs a, LAS unsigned char* lds) {
    const int tid = opaque_tid(), lane = tid & 63, wave = tid >> 6, gw = blockIdx.x * 8 + wave, NGW = gridDim.x * 8;
    LAS unsigned* red = (LAS unsigned*)(lds + LDS_MISC + 1536);
    unsigned* ctl = (unsigned*)(a.ws + WS_CTL);
    if (tid < 64) red[tid] = 0u;
    __syncthreads();
    for (int which = 0; which < 2; ++which) { const bf16_t* P = (const bf16_t*)(a.ws + (which ? A_KB : A_QB));
        for (int b = 0; b < 2; ++b) { float mx = 0.f;
            for (int row = gw; row < SEQ; row += NGW) { const bf16_t* p = P + ((size_t)b * SEQ + row) * 1024 + lane * 16;
                const u32x4 w0 = *(const u32x4*)p, w1 = *(const u32x4*)(p + 8); const unsigned ww[8] = {w0.x, w0.y, w0.z, w0.w, w1.x, w1.y, w1.z, w1.w};
                float ss = 0.f;
#pragma unroll
                for (int i = 0; i < 8; ++i) { const float x = bflo(ww[i]), y = bfhi(ww[i]); ss += x * x + y * y; }
                ss += __shfl_xor(ss, 1); ss += __shfl_xor(ss, 2); mx = fmaxf(mx, ss); }
            if ((lane & 3) == 0) atomicMax((unsigned*)&red[which * 32 + b * 16 + (lane >> 2)], __float_as_uint(mx)); } }
    __syncthreads();
    if (tid < 64) atomicMax(ctl + CW_NORM + tid, red[tid]);
}
__device__ __forceinline__ void phase_attention(KArgs a, LAS unsigned char* lds) {
    const int G = gridDim.x, bx = blockIdx.x;
    const bf16_t* QB = (const bf16_t*)(a.ws + A_QB); const bf16_t* KB = (const bf16_t*)(a.ws + A_KB); const bf16_t* VB = (const bf16_t*)(a.ws + A_VB); bf16_t* OA = (bf16_t*)(a.ws + A_OA);
    const unsigned* nrm = (const unsigned*)(a.ws + WS_CTL) + CW_NORM;
    for (int i = 0;; ++i) {
        int bhc, qb;
        if (G == 256) { if (i >= 4) break;
            const int x = bx & 7, combo = x & 3, hh = (x < 4) ? ((i == 0) ? 7 : (i == 1) ? 5 : (i == 2) ? 1 : 0) : ((i == 0) ? 6 : (i == 1) ? 4 : (i == 2) ? 3 : 2); bhc = (combo >> 1) * 16 + hh * 2 + (combo & 1); qb = bx >> 3; }
        else { const int Lu = i * G + bx; if (Lu >= 1024) break; bhc = Lu >> 5; qb = Lu & 31; }
        const int b = bhc >> 4, h = (bhc >> 1) & 7, cm = bhc & 1;
        const size_t rowq = (size_t)b * SEQ + (size_t)qb * 256;
        const float sl2 = exp2f(-(float)(h + 1)) * 1.4426950408889634f;
        const float qk = sqrtf(__uint_as_float(nrm[bhc]) * __uint_as_float(nrm[32 + bhc]));
        const float Wk = (2.0f * qk + 38.0f) / sl2, q0f = (float)(qb * 256);
        int t_lo = (int)fmaxf(floorf((q0f - Wk - 63.0f) * (1.0f / 64.0f)), 0.0f), t_hi = (int)fminf(ceilf((q0f + 255.0f + Wk) * (1.0f / 64.0f)), 127.0f);
        if (((t_hi - t_lo + 1) & 1) != 0) { if (t_hi < 127) ++t_hi; else --t_lo; }
        att::attn_unit(QB + rowq * 1024 + h * 128 + cm * 64, KB + (size_t)b * SEQ * 1024 + h * 128 + cm * 64, VB + (size_t)b * SEQ * 1024 + h * 128,
                       OA + (size_t)cm * NTOK * 1024 + rowq * 1024 + h * 128, qb * 256, t_lo, t_hi - t_lo + 1, sl2, (char*)lds);
    }
}
__device__ __forceinline__ void phase_concat(KArgs a, LAS unsigned char* lds) {
    const int tid = opaque_tid(), lane = tid & 63, wave = tid >> 6, G = gridDim.x;
    const bf16_t* YHT = (const bf16_t*)(a.ws + A_YHT); const bf16_t* OA0 = (const bf16_t*)(a.ws + A_OA); const bf16_t* OA1 = OA0 + (size_t)NTOK * 1024; bf16_t* YC = (bf16_t*)(a.ws + A_YCAT);
    LAS bf16_t* T = (LAS bf16_t*)lds;
    const float lambda_init = 0.2f;
    const float lam = __expf(wave_sum(a.in[13][lane] * a.in[14][lane])) - __expf(wave_sum(a.in[15][lane] * a.in[16][lane])) + lambda_init;
    float gl[16];
#pragma unroll
    for (int i = 0; i < 16; ++i) gl[i] = a.in[17][(lane & 7) * 16 + i] * (1.0f - lambda_init);
    for (int it = blockIdx.x; it < NTOK / 64; it += G) {
        const int tok0 = it * 64;
#pragma unroll 4
        for (int k = 0; k < 16; ++k) { const int idx = tid + 512 * k, c = idx >> 3, ch = idx & 7;
            const u32x4 w = *(const u32x4*)(YHT + (size_t)c * NTOK + tok0 + ch * 8);
            LAS bf16_t* d = T + (ch * 8) * 1026 + c;
            d[0 * 1026] = (bf16_t)(w.x & 0xffff); d[1 * 1026] = (bf16_t)(w.x >> 16); d[2 * 1026] = (bf16_t)(w.y & 0xffff); d[3 * 1026] = (bf16_t)(w.y >> 16);
            d[4 * 1026] = (bf16_t)(w.z & 0xffff); d[5 * 1026] = (bf16_t)(w.z >> 16); d[6 * 1026] = (bf16_t)(w.w & 0xffff); d[7 * 1026] = (bf16_t)(w.w >> 16); }
        __syncthreads();
#pragma unroll 4
        for (int k = 0; k < 16; ++k) { const int idx = tid + 512 * k, tl = idx >> 7, c8 = idx & 127;
            const LAS unsigned* s = (const LAS unsigned*)(T + tl * 1026 + c8 * 8);
            u32x4 w; w.x = s[0]; w.y = s[1]; w.z = s[2]; w.w = s[3];
            if (FP8_P5) { u32x2 q; q.x = pg8::pk4_fp8(bflo(w.x), bfhi(w.x), bflo(w.y), bfhi(w.y)); q.y = pg8::pk4_fp8(bflo(w.z), bfhi(w.z), bflo(w.w), bfhi(w.w)); *(u32x2*)((unsigned char*)YC + (size_t)(tok0 + tl) * DM + c8 * 8) = q; }
            else *(u32x4*)(YC + (size_t)(tok0 + tl) * DM + c8 * 8) = w; }
        for (int rr = 0; rr < 8; ++rr) { const size_t tok = (size_t)tok0 + wave * 8 + rr;
            const u32x4 p0 = *(const u32x4*)(OA0 + tok * 1024 + lane * 16), p1 = *(const u32x4*)(OA0 + tok * 1024 + lane * 16 + 8);
            const u32x4 q0 = *(const u32x4*)(OA1 + tok * 1024 + lane * 16), q1 = *(const u32x4*)(OA1 + tok * 1024 + lane * 16 + 8);
            const unsigned pw[8] = {p0.x, p0.y, p0.z, p0.w, p1.x, p1.y, p1.z, p1.w}, qw[8] = {q0.x, q0.y, q0.z, q0.w, q1.x, q1.y, q1.z, q1.w};
            float o[16]; float ss = 0.f;
#pragma unroll
            for (int i = 0; i < 8; ++i) { o[2 * i] = bflo(pw[i]) - lam * bflo(qw[i]); o[2 * i + 1] = bfhi(pw[i]) - lam * bfhi(qw[i]); ss += o[2 * i] * o[2 * i] + o[2 * i + 1] * o[2 * i + 1]; }
            ss += __shfl_xor(ss, 1); ss += __shfl_xor(ss, 2); ss += __shfl_xor(ss, 4);
            const float rs = rsqrtf(ss * (1.0f / 128.0f) + LN_EPS);
            u32x4 w0, w1;
            w0.x = pk2(o[0] * rs * gl[0], o[1] * rs * gl[1]); w0.y = pk2(o[2] * rs * gl[2], o[3] * rs * gl[3]); w0.z = pk2(o[4] * rs * gl[4], o[5] * rs * gl[5]); w0.w = pk2(o[6] * rs * gl[6], o[7] * rs * gl[7]);
            w1.x = pk2(o[8] * rs * gl[8], o[9] * rs * gl[9]); w1.y = pk2(o[10] * rs * gl[10], o[11] * rs * gl[11]); w1.z = pk2(o[12] * rs * gl[12], o[13] * rs * gl[13]); w1.w = pk2(o[14] * rs * gl[14], o[15] * rs * gl[15]);
            if (FP8_P5) { u32x4 q; q.x = pg8::pk4_fp8(o[0] * rs * gl[0], o[1] * rs * gl[1], o[2] * rs * gl[2], o[3] * rs * gl[3]); q.y = pg8::pk4_fp8(o[4] * rs * gl[4], o[5] * rs * gl[5], o[6] * rs * gl[6], o[7] * rs * gl[7]);
                q.z = pg8::pk4_fp8(o[8] * rs * gl[8], o[9] * rs * gl[9], o[10] * rs * gl[10], o[11] * rs * gl[11]); q.w = pg8::pk4_fp8(o[12] * rs * gl[12], o[13] * rs * gl[13], o[14] * rs * gl[14], o[15] * rs * gl[15]);
                *(u32x4*)((unsigned char*)YC + tok * DM + 1024 + lane * 16) = q; }
            else { *(u32x4*)(YC + tok * DM + 1024 + lane * 16) = w0; *(u32x4*)(YC + tok * DM + 1024 + lane * 16 + 8) = w1; } }
        __syncthreads();
    }
}
__device__ __forceinline__ void ln_row(f32x4 (&v)[8], const float* g, const float* b, int lane, float& mu, float& rs) {
    float s = 0.f;
#pragma unroll
    for (int j = 0; j < 8; ++j) s += (v[j][0] + v[j][1]) + (v[j][2] + v[j][3]);
    const float mean = wave_sum(s) * (1.0f / DM); float s2 = 0.f;
#pragma unroll
    for (int j = 0; j < 8; ++j) { v[j] = v[j] - mean; s2 += (v[j][0] * v[j][0] + v[j][1] * v[j][1]) + (v[j][2] * v[j][2] + v[j][3] * v[j][3]); }
    const float rstd = rsqrtf(wave_sum(s2) * (1.0f / DM) + LN_EPS); mu = mean; rs = rstd;
#pragma unroll
    for (int j = 0; j < 8; ++j) { const f32x4 gg = *(const f32x4*)(g + 4 * (lane + 64 * j)), bb = *(const f32x4*)(b + 4 * (lane + 64 * j)); v[j] = v[j] * rstd * gg + bb; }
}
__device__ __forceinline__ void phase_ln_router(KArgs a, LAS unsigned char* lds, const bf16_t* R, const float* g, const float* b, bf16_t* HB, unsigned char* HB8, unsigned* cnt, int* rowlist, float* gatew) {
    const int tid = opaque_tid(), lane = tid & 63, wave = tid >> 6, G = gridDim.x;
    const float* rw = a.in[32]; const float* rb = a.in[33];
    LAS float* part = (LAS float*)lds;
    LAS int* hist = (LAS int*)(lds + 40960); LAS int* base = hist + 32; LAS float* stats = (LAS float*)(lds + 40960 + 512);
    for (int it = blockIdx.x; it < NTOK / 32; it += G) {
        const int tok0 = it * 32;
        for (int rr = 0; rr < 4; ++rr) { const size_t row = (size_t)tok0 + wave * 4 + rr; f32x4 v[8]; float mu, rs;
#pragma unroll
            for (int j = 0; j < 8; ++j) { const u32x2 w = *(const u32x2*)(R + row * DM + 4 * (lane + 64 * j)); v[j] = (f32x4){bflo(w.x), bfhi(w.x), bflo(w.y), bfhi(w.y)}; }
            ln_row(v, g, b, lane, mu, rs);
            if (lane == 0) { stats[(wave * 4 + rr) * 2] = mu; stats[(wave * 4 + rr) * 2 + 1] = rs; }
#pragma unroll
            for (int j = 0; j < 8; ++j) { u32x2 w; w.x = pk2(v[j][0], v[j][1]); w.y = pk2(v[j][2], v[j][3]); *(u32x2*)(HB + row * DM + 4 * (lane + 64 * j)) = w;
                if (HB8) *(unsigned*)(HB8 + row * DM + 4 * (lane + 64 * j)) = pg8::pk4_fp8(v[j][0], v[j][1], v[j][2], v[j][3]); } }
        if (tid < 32) hist[tid] = 0;
        __syncthreads();
        { const int i = lane & 31, kk = lane >> 5; f32x16 acc = {};
          const float mu = stats[i * 2], rs = stats[i * 2 + 1];
          const bf16_t* rrow = R + (size_t)(tok0 + i) * DM + wave * 256 + 4 * kk; const float* gp = g + wave * 256 + 4 * kk; const float* bp = b + wave * 256 + 4 * kk;
          const float* rwp = rw + (size_t)(wave * 256 + 4 * kk) * NEXP + i;
#pragma unroll 4
          for (int s = 0; s < 32; ++s) { const u32x2 rw2 = *(const u32x2*)(rrow + 8 * s); const f32x4 hv = ((f32x4){bflo(rw2.x), bfhi(rw2.x), bflo(rw2.y), bfhi(rw2.y)} - mu) * rs * *(const f32x4*)(gp + 8 * s) + *(const f32x4*)(bp + 8 * s);
#pragma unroll
              for (int j = 0; j < 4; ++j) acc = __builtin_amdgcn_mfma_f32_32x32x2f32(rwp[(size_t)(8 * s + j) * NEXP], hv[j], acc, 0, 0, 0); }
#pragma unroll
          for (int r = 0; r < 16; ++r) part[(wave * 32 + i) * 33 + (r & 3) + 8 * (r >> 2) + 4 * kk] = acc[r]; }
        __syncthreads();
        int e1 = 0, e2 = 0, r1 = 0, r2 = 0; float g1 = 0.f, g2 = 0.f;
        if (tid < 32) {
            float bestg = -1e30f;
#pragma unroll
            for (int gi = 0; gi < 4; ++gi) { float m1 = -1e30f, m2 = -1e30f, s1 = 0.f, s2 = 0.f; int i1 = 0, i2 = 0;
#pragma unroll
                for (int j = 0; j < 8; ++j) { const int e = gi * 8 + j; float lg = 0.f;
#pragma unroll
                    for (int w = 0; w < 8; ++w) lg += part[(w * 32 + tid) * 33 + e];
                    const float sg = 1.0f / (1.0f + expf(-lg)), sl = sg + rb[e];
                    if (sl > m1) { m2 = m1; i2 = i1; s2 = s1; m1 = sl; i1 = j; s1 = sg; } else if (sl > m2) { m2 = sl; i2 = j; s2 = sg; } }
                const float gs = m1 + m2;
                if (gs > bestg) { bestg = gs; e1 = gi * 8 + i1; e2 = gi * 8 + i2; g1 = s1; g2 = s2; } }
            const float inv = 1.0f / (g1 + g2); g1 *= inv; g2 *= inv;
            r1 = atomicAdd((int*)&hist[e1], 1); r2 = atomicAdd((int*)&hist[e2], 1);
        }
        __syncthreads();
        if (tid < 32) { const int hc = hist[tid]; base[tid] = hc ? (int)__hip_atomic_fetch_add(cnt + tid * 64, (unsigned)hc, __ATOMIC_RELAXED, __HIP_MEMORY_SCOPE_AGENT) : 0; }
        __syncthreads();
        if (tid < 32) { const int a0 = (tok0 + tid) * 2;
            rowlist[(size_t)e1 * ECAP + base[e1] + r1] = a0; gatew[a0] = g1;
            rowlist[(size_t)e2 * ECAP + base[e2] + r2] = a0 + 1; gatew[a0 + 1] = g2; }
        __syncthreads();
    }
}
__device__ __forceinline__ void phase_ln2(const bf16_t* HB, const bf16_t* Y2, const float* g, const float* b, float* OUT, bf16_t* OB, unsigned char* OB8) {
    const int tid = opaque_tid(), lane = tid & 63, wave = tid >> 6;
    for (int row = blockIdx.x * 8 + wave; row < NTOK; row += gridDim.x * 8) { f32x4 v[8]; float mu, rs;
#pragma unroll
        for (int j = 0; j < 8; ++j) { const int c = 4 * (lane + 64 * j); const u32x2 h = *(const u32x2*)(HB + (size_t)row * DM + c);
            const u32x2 y0 = *(const u32x2*)(Y2 + (size_t)(2 * row) * DM + c), y1 = *(const u32x2*)(Y2 + (size_t)(2 * row + 1) * DM + c);
            v[j] = (f32x4){bflo(h.x), bfhi(h.x), bflo(h.y), bfhi(h.y)} * DN_ALPHA + (f32x4){bflo(y0.x) + bflo(y1.x), bfhi(y0.x) + bfhi(y1.x), bflo(y0.y) + bflo(y1.y), bfhi(y0.y) + bfhi(y1.y)}; }
        ln_row(v, g, b, lane, mu, rs);
#pragma unroll
        for (int j = 0; j < 8; ++j) { const int c = 4 * (lane + 64 * j); if (OUT) *(f32x4*)(OUT + (size_t)row * DM + c) = v[j];
            if (OB) { u32x2 w; w.x = pk2(v[j][0], v[j][1]); w.y = pk2(v[j][2], v[j][3]); *(u32x2*)(OB + (size_t)row * DM + c) = w; }
            if (OB8) *(unsigned*)(OB8 + (size_t)row * DM + c) = pg8::pk4_fp8(v[j][0], v[j][1], v[j][2], v[j][3]); }
    }
}
__device__ __forceinline__ void moe_table(LAS int* tab, const unsigned* cnt) {
    __syncthreads();
    const int tid = opaque_tid();
    if (tid < 32) tab[64 + tid] = (int)cnt[tid * 64];
    __syncthreads();
    if (tid == 0) { int acc = 0; for (int e = 0; e < 32; ++e) { tab[e] = acc; acc += (tab[64 + e] + 255) >> 8; } tab[32] = acc; }
    __syncthreads();
}
__device__ __forceinline__ void phase_conv4(KArgs a) {
    const bf16_t* XR = (const bf16_t*)(a.ws + A_XR); bf16_t* XC = (bf16_t*)(a.ws + A_XC); const float* cw = a.in[20]; const float* cb = a.in[21];
    const int NT = gridDim.x * 512;
    for (int it = blockIdx.x * 512 + opaque_tid(); it < NTOK * 256; it += NT) { const int tok = it >> 8, ch = (it & 255) * 8, t = tok & (SEQ - 1);
        float acc[8];
#pragma unroll
        for (int i = 0; i < 8; ++i) acc[i] = cb[ch + i];
#pragma unroll
        for (int j = 0; j < 4; ++j) { const int tt = t + j - 2;
            if (tt >= 0 && tt < SEQ) { const u32x4 w = *(const u32x4*)(XR + (size_t)(tok + j - 2) * DM + ch); const unsigned ww[4] = {w.x, w.y, w.z, w.w};
#pragma unroll
                for (int i = 0; i < 4; ++i) { acc[2 * i] += cw[j * DM + ch + 2 * i] * bflo(ww[i]); acc[2 * i + 1] += cw[j * DM + ch + 2 * i + 1] * bfhi(ww[i]); } } }
        u32x4 o; o.x = pk2(acc[0], acc[1]); o.y = pk2(acc[2], acc[3]); o.z = pk2(acc[4], acc[5]); o.w = pk2(acc[6], acc[7]);
        *(u32x4*)(XC + (size_t)tok * DM + ch) = o; }
}
constexpr size_t CAR_ELEMS = (size_t)2 * 2 * 256 * DM;
constexpr float RG_ILA = 1.0f / pg8::RG_SLA, RG_IB = 1.0f / pg8::RG_SB;
__device__ __forceinline__ void phase_scan1(KArgs a) {
    const bf16_t* LA = (const bf16_t*)(a.ws + A_LA); const bf16_t* BB = (const bf16_t*)(a.ws + A_BB); float* CARA = (float*)(a.ws + A_CAR); float* CARB = CARA + CAR_ELEMS;
    const int NT = gridDim.x * 512;
    for (int it = blockIdx.x * 512 + opaque_tid(); it < 2 * 2 * 256 * 512; it += NT) { const int ch = (it & 511) * 4, chunk = (it >> 9) & 255, dir = (it >> 17) & 1, b = it >> 18;
        float h[4] = {0.f, 0.f, 0.f, 0.f}, ls[4] = {0.f, 0.f, 0.f, 0.f};
#pragma unroll 8
        for (int s = 0; s < 32; ++s) { const int t = chunk * 32 + (dir ? 31 - s : s); const size_t off = ((size_t)dir * NTOK + (size_t)b * SEQ + t) * DM + ch;
            const int lw = *(const int*)((const unsigned char*)LA + off), bw = *(const int*)((const unsigned char*)BB + off);
            const float l4[4] = {RG_ILA * __builtin_amdgcn_cvt_f32_fp8(lw, 0), RG_ILA * __builtin_amdgcn_cvt_f32_fp8(lw, 1), RG_ILA * __builtin_amdgcn_cvt_f32_fp8(lw, 2), RG_ILA * __builtin_amdgcn_cvt_f32_fp8(lw, 3)};
            const float b4[4] = {RG_IB * __builtin_amdgcn_cvt_f32_fp8(bw, 0), RG_IB * __builtin_amdgcn_cvt_f32_fp8(bw, 1), RG_IB * __builtin_amdgcn_cvt_f32_fp8(bw, 2), RG_IB * __builtin_amdgcn_cvt_f32_fp8(bw, 3)};
#pragma unroll
            for (int i = 0; i < 4; ++i) { h[i] = __expf(l4[i]) * h[i] + b4[i]; ls[i] += l4[i]; } }
        const size_t co = (((size_t)b * 2 + dir) * 256 + chunk) * DM + ch;
        *(f32x4*)(CARA + co) = (f32x4){ls[0], ls[1], ls[2], ls[3]}; *(f32x4*)(CARB + co) = (f32x4){h[0], h[1], h[2], h[3]}; }
}
__device__ __forceinline__ void phase_scan2(KArgs a, LAS unsigned char* lds) {
    float* CARA = (float*)(a.ws + A_CAR); float* CARB = CARA + CAR_ELEMS; float* CARIN = CARB + CAR_ELEMS;
    const int tid = opaque_tid(), grp = tid >> 5, chl = tid & 31;
    LAS float* sh = (LAS float*)lds;
    for (int it = blockIdx.x; it < 2 * 2 * 64; it += gridDim.x) { const int ch = (it & 63) * 32 + chl, dir = (it >> 6) & 1, b = it >> 7;
        float la[16], lb[16]; float A = 0.f, B = 0.f;
#pragma unroll
        for (int k = 0; k < 16; ++k) { const int q = grp * 16 + k, chunk = dir ? 255 - q : q; const size_t co = (((size_t)b * 2 + dir) * 256 + chunk) * DM + ch; la[k] = CARA[co]; lb[k] = CARB[co]; }
#pragma unroll
        for (int k = 0; k < 16; ++k) { B = __expf(la[k]) * B + lb[k]; A += la[k]; }
        sh[(grp * 32 + chl) * 2] = A; sh[(grp * 32 + chl) * 2 + 1] = B;
        __syncthreads();
        float h = 0.f;
        for (int g2 = 0; g2 < grp; ++g2) h = __expf(sh[(g2 * 32 + chl) * 2]) * h + sh[(g2 * 32 + chl) * 2 + 1];
#pragma unroll
        for (int k = 0; k < 16; ++k) { const int q = grp * 16 + k, chunk = dir ? 255 - q : q; const size_t co = (((size_t)b * 2 + dir) * 256 + chunk) * DM + ch; CARIN[co] = h; h = __expf(la[k]) * h + lb[k]; }
        __syncthreads();
    }
}
__device__ __forceinline__ float gelu_tanh(float x) { const float u = 0.7978845608028654f * (x + 0.044715f * x * x * x); const float th = 1.0f - 2.0f * __builtin_amdgcn_rcpf(1.0f + __builtin_amdgcn_exp2f(2.8853900817779268f * u)); return 0.5f * x * (1.0f + th); }
__device__ __forceinline__ void phase_scan3(KArgs a) {
    const bf16_t* LA = (const bf16_t*)(a.ws + A_LA); const bf16_t* BB = (const bf16_t*)(a.ws + A_BB); const bf16_t* GB = (const bf16_t*)(a.ws + A_GB); bf16_t* YG = (bf16_t*)(a.ws + A_YG);
    const float* CARIN = (const float*)(a.ws + A_CAR) + 2 * CAR_ELEMS;
    const int NT = gridDim.x * 512;
    for (int it = blockIdx.x * 512 + opaque_tid(); it < 2 * 256 * 512; it += NT) { const int ch = (it & 511) * 4, chunk = (it >> 9) & 255, b = it >> 17;
        unsigned hf[32][2]; float h[4];
        { const f32x4 c = *(const f32x4*)(CARIN + (((size_t)b * 2 + 0) * 256 + chunk) * DM + ch); h[0] = c[0]; h[1] = c[1]; h[2] = c[2]; h[3] = c[3]; }
#pragma unroll
        for (int s = 0; s < 32; ++s) { const size_t off = ((size_t)b * SEQ + chunk * 32 + s) * DM + ch;
            const int lw = *(const int*)((const unsigned char*)LA + off), bw = *(const int*)((const unsigned char*)BB + off);
            const float l4[4] = {RG_ILA * __builtin_amdgcn_cvt_f32_fp8(lw, 0), RG_ILA * __builtin_amdgcn_cvt_f32_fp8(lw, 1), RG_ILA * __builtin_amdgcn_cvt_f32_fp8(lw, 2), RG_ILA * __builtin_amdgcn_cvt_f32_fp8(lw, 3)};
            const float b4[4] = {RG_IB * __builtin_amdgcn_cvt_f32_fp8(bw, 0), RG_IB * __builtin_amdgcn_cvt_f32_fp8(bw, 1), RG_IB * __builtin_amdgcn_cvt_f32_fp8(bw, 2), RG_IB * __builtin_amdgcn_cvt_f32_fp8(bw, 3)};
#pragma unroll
            for (int i = 0; i < 4; ++i) h[i] = __expf(l4[i]) * h[i] + b4[i];
            hf[s][0] = cvt_pk_bf16(h[0], h[1]); hf[s][1] = cvt_pk_bf16(h[2], h[3]);
            if ((s & 7) == 7) __builtin_amdgcn_sched_barrier(0); }
        { const f32x4 c = *(const f32x4*)(CARIN + (((size_t)b * 2 + 1) * 256 + chunk) * DM + ch); h[0] = c[0]; h[1] = c[1]; h[2] = c[2]; h[3] = c[3]; }
#pragma unroll
        for (int s = 31; s >= 0; --s) { const size_t tokoff = ((size_t)b * SEQ + chunk * 32 + s) * DM + ch; const size_t off = (size_t)NTOK * DM + tokoff;
            const int lw = *(const int*)((const unsigned char*)LA + off), bw = *(const int*)((const unsigned char*)BB + off); const u32x2 gw = *(const u32x2*)(GB + tokoff);
            const float l4[4] = {RG_ILA * __builtin_amdgcn_cvt_f32_fp8(lw, 0), RG_ILA * __builtin_amdgcn_cvt_f32_fp8(lw, 1), RG_ILA * __builtin_amdgcn_cvt_f32_fp8(lw, 2), RG_ILA * __builtin_amdgcn_cvt_f32_fp8(lw, 3)};
            const float b4[4] = {RG_IB * __builtin_amdgcn_cvt_f32_fp8(bw, 0), RG_IB * __builtin_amdgcn_cvt_f32_fp8(bw, 1), RG_IB * __builtin_amdgcn_cvt_f32_fp8(bw, 2), RG_IB * __builtin_amdgcn_cvt_f32_fp8(bw, 3)}, g4[4] = {bflo(gw.x), bfhi(gw.x), bflo(gw.y), bfhi(gw.y)};
            float y[4];
            const float f4[4] = {bflo(hf[s][0]), bfhi(hf[s][0]), bflo(hf[s][1]), bfhi(hf[s][1])};
#pragma unroll
            for (int i = 0; i < 4; ++i) { h[i] = __expf(l4[i]) * h[i] + b4[i]; y[i] = gelu_tanh(g4[i]) * (f4[i] + h[i]); }
            if (FP8_P16) { *(unsigned*)((unsigned char*)YG + tokoff) = pg8::pk4_fp8(4.0f * y[0], 4.0f * y[1], 4.0f * y[2], 4.0f * y[3]); }
            else { u32x2 w; w.x = pk2(y[0], y[1]); w.y = pk2(y[2], y[3]); *(u32x2*)(YG + tokoff) = w; }
            if ((s & 7) == 0) __builtin_amdgcn_sched_barrier(0); } }
}

#define KARGS() (*(const __attribute__((address_space(4))) Args*)__builtin_amdgcn_kernarg_segment_ptr())
#define PHASE_FN __device__ __forceinline__ void
#define PH_PRE() KArgs a = KARGS(); LAS unsigned char* lds = (LAS unsigned char*)lds_raw; unsigned char* ws = a.ws; asm volatile("" : "+s"(ws)); const int G = gridDim.x, bx = blockIdx.x; (void)lds; (void)ws; (void)G; (void)bx; using namespace pg8
PHASE_FN ph0() { PH_PRE(); phase_prologue(a, lds); }
PHASE_FN ph1a() { PH_PRE(); Gemm g{(const bf16_t*)(ws + A_W4T), (const bf16_t*)(ws + A_H3B), 128, 128, 128}; StaticOrder S; S.init(4096, 8192, G, bx); EpiFilt E{(bf16_t*)(ws + A_KTD)}; gemm_phase(lds, g, S, E); }
PHASE_FN ph1b() { PH_PRE(); StaticOrder S; S.init(NTOK, 3072, G, bx);
    if constexpr (FP8_P1B) { Gemm g{(const bf16_t*)(ws + A_XB8), (const bf16_t*)(ws + WS_WIN_EV8 + (size_t)3072 * DM), DM / 2, DM / 2, DM / 2};
        EpiBf16 E{(bf16_t*)(ws + A_QB), 1024, 1024, (size_t)(A_KB - A_QB) / 2, QSCALE, 1.0f / FP8_SW}; gemm_phase<EpiBf16, StaticOrder, true>(lds, g, S, E); }
    else { Gemm g{(const bf16_t*)(ws + A_XB), (const bf16_t*)(ws + WS_WIN_EV) + (size_t)3072 * DM, DM, DM, DM};
        EpiBf16 E{(bf16_t*)(ws + A_QB), 1024, 1024, (size_t)(A_KB - A_QB) / 2, QSCALE}; gemm_phase(lds, g, S, E); } }
PHASE_FN ph1c() { PH_PRE(); StaticOrder S; S.init(3072, NTOK, G, bx);
    if constexpr (FP8_P1C) { Gemm g{(const bf16_t*)(ws + WS_WIN_EV8), (const bf16_t*)(ws + A_XB8), DM / 2, DM / 2, DM / 2};
        EpiBf16 E{(bf16_t*)(ws + A_UHT), NTOK, 0, 0, 1.f, 1.0f / FP8_SW}; gemm_phase<EpiBf16, StaticOrder, true>(lds, g, S, E); }
    else { Gemm g{(const bf16_t*)(ws + WS_WIN_EV), (const bf16_t*)(ws + A_XB), DM, DM, DM};
        EpiBf16 E{(bf16_t*)(ws + A_UHT), NTOK, 0, 0, 1.f}; gemm_phase(lds, g, S, E); } }
PHASE_FN ph2() { PH_PRE(); phase_qknorm(a, lds); }
PHASE_FN ph3a() { PH_PRE(); phase_hyena_mixer(a, lds); }
PHASE_FN ph3b() { PH_PRE(); phase_attention(a, lds); }
PHASE_FN ph4() { PH_PRE(); phase_concat(a, lds); }
PHASE_FN ph5() { PH_PRE(); StaticOrder S; S.init(NTOK, DM, G, bx);
    if constexpr (FP8_P5) { Gemm g{(const bf16_t*)(ws + A_YCAT), (const bf16_t*)(ws + WS_WOUT_EV), DM / 2, DM / 2, DM / 2};
        EpiResBf E{(const bf16_t*)(ws + A_XB2), (bf16_t*)(ws + A_R0), DM, DN_ALPHA, 1.0f / FP8_SW}; gemm_phase<EpiResBf, StaticOrder, true>(lds, g, S, E); }
    else { Gemm g{(const bf16_t*)(ws + A_YCAT), (const bf16_t*)(ws + WS_WOUT_EV), DM, DM, DM};
        EpiResBf E{(const bf16_t*)(ws + A_XB2), (bf16_t*)(ws + A_R0), DM, DN_ALPHA}; gemm_phase(lds, g, S, E); } }
template <int LAYER> PHASE_FN ph_lnr() { PH_PRE(); unsigned* ctl = (unsigned*)(ws + WS_CTL);
    phase_ln_router(a, lds, (const bf16_t*)(ws + (LAYER ? A_R1 : A_R0)), a.in[28] + LAYER * DM, a.in[29] + LAYER * DM, (bf16_t*)(ws + (LAYER ? A_HB_1 : A_HB_0)), (LAYER >= 2 - MOE_FP8_LAYERS) ? ws + (LAYER ? A_HB8_1 : A_HB8_0) : nullptr,
                    ctl + CW_CNT + LAYER * 32 * 64, (int*)(ws + A_ROWL), (float*)(ws + A_GATEW)); }
template <int LAYER> PHASE_FN ph_moe1() { PH_PRE(); LAS int* tab = (LAS int*)(lds + LDS_MISC); moe_table(tab, (const unsigned*)(ws + WS_CTL) + CW_CNT + LAYER * 32 * 64);
    MoeOrder<4, true> S{G, bx, tab, (const int*)(ws + A_ROWL)};
    if constexpr (LAYER >= 2 - MOE_FP8_LAYERS) {
        Gemm g{(const bf16_t*)(ws + (LAYER ? A_HB8_1 : A_HB8_0)), (const bf16_t*)(ws + WS_W1T + (size_t)LAYER * 32 * 1024 * DM * 2), DM / 2, DM / 2, DM / 2};
        EpiSwiglu8 E{ws + (LAYER ? A_HID_1 : A_HID_0)}; gemm_phase<EpiSwiglu8, MoeOrder<4, true>, true>(lds, g, S, E);
    } else {
        Gemm g{(const bf16_t*)(ws + (LAYER ? A_HB_1 : A_HB_0)), (const bf16_t*)(ws + WS_W1T) + (size_t)LAYER * 32 * 1024 * DM, DM, DM, DM};
        EpiSwiglu E{(bf16_t*)(ws + (LAYER ? A_HID_1 : A_HID_0))}; gemm_phase(lds, g, S, E); } }
template <int LAYER> PHASE_FN ph_moe2() { PH_PRE(); LAS int* tab = (LAS int*)(lds + LDS_MISC); moe_table(tab, (const unsigned*)(ws + WS_CTL) + CW_CNT + LAYER * 32 * 64);
    MoeOrder<8, false> S{G, bx, tab, (const int*)(ws + A_ROWL)};
    if constexpr (LAYER >= 2 - MOE_FP8_LAYERS) {
        Gemm g{(const bf16_t*)(ws + (LAYER ? A_HID_1 : A_HID_0)), (const bf16_t*)(ws + WS_W2T + (size_t)LAYER * 32 * DM * DFF * 2), DFF / 2, DFF / 2, DFF / 2};
        EpiDown E{(bf16_t*)(ws + (LAYER ? A_Y2_1 : A_Y2_0)), (const int*)(ws + A_ROWL), (const float*)(ws + A_GATEW), 1.0f / (FP8_SW * FP8_SH)};
        gemm_phase<EpiDown, MoeOrder<8, false>, true>(lds, g, S, E);
    } else {
        Gemm g{(const bf16_t*)(ws + (LAYER ? A_HID_1 : A_HID_0)), (const bf16_t*)(ws + WS_W2T) + (size_t)LAYER * 32 * DM * DFF, DFF, DFF, DFF};
        EpiDown E{(bf16_t*)(ws + (LAYER ? A_Y2_1 : A_Y2_0)), (const int*)(ws + A_ROWL), (const float*)(ws + A_GATEW), 1.0f}; gemm_phase(lds, g, S, E); } }
template <int LAYER> PHASE_FN ph_ln2() { PH_PRE();
    phase_ln2((const bf16_t*)(ws + (LAYER ? A_HB_1 : A_HB_0)), (const bf16_t*)(ws + (LAYER ? A_Y2_1 : A_Y2_0)), a.in[30] + LAYER * DM, a.in[31] + LAYER * DM, LAYER ? a.out : nullptr, LAYER ? nullptr : (bf16_t*)(ws + A_HB2), (!LAYER && FP8_P10) ? ws + A_HB2_8 : nullptr); }
PHASE_FN ph10() { PH_PRE(); StaticOrder S; S.init(NTOK, 2 * DM, G, bx);
    if constexpr (FP8_P10) { Gemm g{(const bf16_t*)(ws + A_HB2_8), (const bf16_t*)(ws + WS_WIN_OD), DM / 2, DM / 2, DM / 2};
        EpiBf16 E{(bf16_t*)(ws + A_GB), DM, DM, (size_t)(A_XR - A_GB) / 2, 1.f, 1.0f / FP8_SW}; gemm_phase<EpiBf16, StaticOrder, true>(lds, g, S, E); }
    else { Gemm g{(const bf16_t*)(ws + A_HB2), (const bf16_t*)(ws + WS_WIN_OD), DM, DM, DM};
        EpiBf16 E{(bf16_t*)(ws + A_GB), DM, DM, (size_t)(A_XR - A_GB) / 2, 1.f}; gemm_phase(lds, g, S, E); } }
PHASE_FN ph11() { PH_PRE(); phase_conv4(a); }
PHASE_FN ph12() { PH_PRE(); Gemm g{(const bf16_t*)(ws + A_XC), (const bf16_t*)(ws + WS_WG_OD), DM, 256, 256}; RGOrder S{G, bx};
                  EpiRG E{(bf16_t*)(ws + A_LA), (bf16_t*)(ws + A_BB), (const bf16_t*)(ws + A_XC), a.in[23], a.in[25], a.in[26]}; gemm_phase(lds, g, S, E); }
PHASE_FN ph13() { PH_PRE(); phase_scan1(a); }
PHASE_FN ph14() { PH_PRE(); phase_scan2(a, lds); }
PHASE_FN ph15() { PH_PRE(); phase_scan3(a); }
PHASE_FN ph16() { PH_PRE(); StaticOrder S; S.init(NTOK, DM, G, bx);
    if constexpr (FP8_P16) { Gemm g{(const bf16_t*)(ws + A_YG), (const bf16_t*)(ws + WS_WOUT_OD), DM / 2, DM / 2, DM / 2};
        EpiResBf E{(const bf16_t*)(ws + A_HB2), (bf16_t*)(ws + A_R1), DM, DN_ALPHA, 1.0f / (FP8_SW * 4.0f)}; gemm_phase<EpiResBf, StaticOrder, true>(lds, g, S, E); }
    else { Gemm g{(const bf16_t*)(ws + A_YG), (const bf16_t*)(ws + WS_WOUT_OD), DM, DM, DM};
        EpiResBf E{(const bf16_t*)(ws + A_HB2), (bf16_t*)(ws + A_R1), DM, DN_ALPHA}; gemm_phase(lds, g, S, E); } }

__global__ void __launch_bounds__(512, 2) fwd(Args a) {
    LAS unsigned char* lds = (LAS unsigned char*)lds_raw;
    unsigned* ctl = (unsigned*)(a.ws + WS_CTL);
    volatile LAS unsigned* bst = (volatile LAS unsigned*)(lds + LDS_MISC + 2048);
    { const int tid = threadIdx.x;
      if ((tid & 63) == 0) ((LAS int*)(lds + LDS_WIDTAB))[hw_slot()] = tid >> 6;
      if (tid < 4) bst[tid] = 0u; }
    __syncthreads();
    const int lo = a.ph_lo, hi = a.ph_hi;
    XcdBarrier bar; bar.bar = ctl + CW_BAR; bar.x = 0; bar.st = bst;
    if (hi - lo > 1) bar = xcd_barrier_post(ctl + CW_BAR, bst);
#ifdef ONLY_PHASE
#define IN(k) ((k) == ONLY_PHASE && lo <= (k) && (k) < hi)
#else
#define IN(k) (lo <= (k) && (k) < hi)
#endif
#define SEAM(k) do { if (IN(k) && IN((k) + 1)) xcd_barrier(bar); } while (0)
    if (IN(0)) { asm volatile("; PHASE_MARK 0"); ph0(); } SEAM(0);
    if (IN(1)) { asm volatile("; PHASE_MARK 1a"); ph1a(); asm volatile("; PHASE_MARK 1b"); ph1b(); asm volatile("; PHASE_MARK 1c"); ph1c(); } SEAM(1);
    if (IN(2)) { asm volatile("; PHASE_MARK 2"); ph2(); } SEAM(2);
    if (IN(3)) { asm volatile("; PHASE_MARK 3a"); ph3a(); asm volatile("; PHASE_MARK 3b"); ph3b(); } SEAM(3);
    if (IN(4)) { asm volatile("; PHASE_MARK 4"); ph4(); } SEAM(4);
    if (IN(5)) { asm volatile("; PHASE_MARK 5"); ph5(); } SEAM(5);
    if (IN(6)) { asm volatile("; PHASE_MARK 6"); ph_lnr<0>(); } SEAM(6);
    if (IN(7)) { asm volatile("; PHASE_MARK 7"); ph_moe1<0>(); } SEAM(7);
    if (IN(8)) { asm volatile("; PHASE_MARK 8"); ph_moe2<0>(); } SEAM(8);
    if (IN(9)) { asm volatile("; PHASE_MARK 9"); ph_ln2<0>(); } SEAM(9);
    if (IN(10)) { asm volatile("; PHASE_MARK 10"); ph10(); } SEAM(10);
    if (IN(11)) { asm volatile("; PHASE_MARK 11"); ph11(); } SEAM(11);
    if (IN(12)) { asm volatile("; PHASE_MARK 12"); ph12(); } SEAM(12);
    if (IN(13)) { asm volatile("; PHASE_MARK 13"); ph13(); } SEAM(13);
    if (IN(14)) { asm volatile("; PHASE_MARK 14"); ph14(); } SEAM(14);
    if (IN(15)) { asm volatile("; PHASE_MARK 15"); ph15(); } SEAM(15);
    if (IN(16)) { asm volatile("; PHASE_MARK 16"); ph16(); } SEAM(16);
    if (IN(17)) { asm volatile("; PHASE_MARK 17"); ph_lnr<1>(); } SEAM(17);
    if (IN(18)) { asm volatile("; PHASE_MARK 18"); ph_moe1<1>(); } SEAM(18);
    if (IN(19)) { asm volatile("; PHASE_MARK 19"); ph_moe2<1>(); } SEAM(19);
    if (IN(20)) { asm volatile("; PHASE_MARK 20"); ph_ln2<1>(); }
#undef IN
#undef SEAM
}

#ifndef MK_PER_PHASE
#define MK_PER_PHASE 0
#endif
extern "C" void kernel_launch(void* const* d_in, const int* in_sizes, int n_in, void* d_out, int out_size, void* d_ws, size_t ws_size, hipStream_t stream) {
    static int grid = 0;
    if (grid == 0) {
        if (n_in != 37 || out_size != NTOK * DM || ws_size < WS_END) { fprintf(stderr, "kernel_launch: built for 37 inputs, %d outputs, >= %zu bytes of workspace; got n_in %d out %d ws %zu\n", NTOK * DM, (size_t)WS_END, n_in, out_size, ws_size); grid = -1; return; }
        int dev = 0, cus = 0, per_cu = 0;
        if (hipGetDevice(&dev) != hipSuccess || hipDeviceGetAttribute(&cus, hipDeviceAttributeMultiprocessorCount, dev) != hipSuccess) { grid = -1; return; }
        if (hipFuncSetAttribute((const void*)fwd, hipFuncAttributeMaxDynamicSharedMemorySize, LDS_BYTES) != hipSuccess) { fprintf(stderr, "kernel_launch: hipFuncSetAttribute failed\n"); grid = -1; return; }
        if (hipOccupancyMaxActiveBlocksPerMultiprocessor(&per_cu, (const void*)fwd, 512, LDS_BYTES) != hipSuccess || per_cu < 1) fprintf(stderr, "kernel_launch: occupancy query reports %d\n", per_cu);
        (void)hipGetLastError();
        grid = cus;
    }
    if (grid < 0) return;
    (void)hipMemsetAsync((char*)d_ws + WS_CTL, 0, CTL_ZERO_BYTES, stream);
    Args a{};
    for (int i = 0; i < 37; ++i) a.in[i] = (const float*)d_in[i];
    a.out = (float*)d_out; a.ws = (unsigned char*)d_ws;
#if MK_PER_PHASE
    for (int p = 0; p < NPHASE; ++p) { a.ph_lo = p; a.ph_hi = p + 1; hipLaunchKernelGGL(fwd, dim3(grid), dim3(512), LDS_BYTES, stream, a); }
#else
    a.ph_lo = 0; a.ph_hi = NPHASE; hipLaunchKernelGGL(fwd, dim3(grid), dim3(512), LDS_BYTES, stream, a);
#endif
}
```

```cpp
#include <hip/hip_runtime.h>
#include <hip/hip_fp16.h>
#include <cstdio>
#include <cstdint>

#define GAS __attribute__((address_space(1)))
#define LAS __attribute__((address_space(3)))
typedef unsigned short bf16_t;
typedef short bf16x8 __attribute__((ext_vector_type(8)));
typedef short s16x4 __attribute__((ext_vector_type(4)));
typedef float f32x2 __attribute__((ext_vector_type(2)));
typedef float f32x4 __attribute__((ext_vector_type(4)));
typedef float f32x8 __attribute__((ext_vector_type(8)));
typedef float f32x16 __attribute__((ext_vector_type(16)));
typedef unsigned u32x2 __attribute__((ext_vector_type(2)));
typedef unsigned u32x4 __attribute__((ext_vector_type(4)));
typedef GAS unsigned gu32;

constexpr int DM = 2048, BATCH = 2, SEQ = 8192, NTOK = BATCH * SEQ;
constexpr int HY_CH = 1024, EV_IN = 6144;
constexpr int NEXP = 32, DFF = 512, NASSIGN = NTOK * 2, ECAP = NASSIGN;
constexpr float LN_EPS = 1e-5f;
constexpr float DN_ALPHA = 1.4142135623730951f;
constexpr float QSCALE = 0.125f * 1.4426950408889634f;
constexpr int FFT_N = 16384, FFT_RS = 528;

__device__ __forceinline__ unsigned f2bf(float f) { unsigned u = __builtin_bit_cast(unsigned, f); return (u + 0x7fffu + ((u >> 16) & 1u)) >> 16; }
__device__ __forceinline__ unsigned pk2(float lo, float hi) { return f2bf(lo) | (f2bf(hi) << 16); }
__device__ __forceinline__ float bf2f(unsigned short h) { return __builtin_bit_cast(float, (unsigned)h << 16); }
__device__ __forceinline__ float bflo(unsigned w) { return __builtin_bit_cast(float, w << 16); }
__device__ __forceinline__ float bfhi(unsigned w) { return __builtin_bit_cast(float, w & 0xffff0000u); }
__device__ __forceinline__ unsigned cvt_pk_bf16(float lo, float hi) { unsigned r; asm volatile("v_cvt_pk_bf16_f32 %0, %1, %2" : "=v"(r) : "v"(lo), "v"(hi)); return r; }
__device__ __forceinline__ float wave_sum(float v) {
#pragma unroll
    for (int o = 1; o < 64; o <<= 1) v += __shfl_xor(v, o);
    return v;
}
__device__ __forceinline__ float sigmoidf_(float x) { return __builtin_amdgcn_rcpf(1.0f + __builtin_amdgcn_exp2f(-1.4426950408889634f * x)); }
constexpr int LDS_WIDTAB = 153600 + 3072;
__device__ __forceinline__ int hw_slot() { return (int)(__builtin_amdgcn_s_getreg((5 << 11) | 4) & 63u); }
__device__ __forceinline__ int lane_id() { return (int)__builtin_amdgcn_mbcnt_hi(~0u, __builtin_amdgcn_mbcnt_lo(~0u, 0u)); }
extern __shared__ __attribute__((aligned(16))) unsigned char lds_raw[];
__device__ __forceinline__ int wave_id() { return __builtin_amdgcn_readfirstlane(((const LAS int*)((LAS unsigned char*)lds_raw + LDS_WIDTAB))[hw_slot()]); }
__device__ __forceinline__ int opaque_tid() { int t = wave_id() * 64 + lane_id(); asm volatile("" : "+v"(t)); return t; }
#define LDS_WAIT() asm volatile("s_waitcnt lgkmcnt(0)" ::: "memory")
#define VM_WAIT() asm volatile("s_waitcnt vmcnt(0)" ::: "memory")

#define XB_TMO      128
#define XB_XCNT(j)  (256  + 64 * (j))
#define XB_XSUB(j)  (1280 + 64 * (j))
#define XB_XGEN(j)  (2304 + 64 * (j))
#define XB_TOP      3328
#define XB_TOPGEN   3392
#define XCD_BAR_WORDS 3456
#define XB_SPIN_CAP (1u << 18)
__device__ __forceinline__ unsigned xb_ld(unsigned* p)              { return __hip_atomic_load(p, __ATOMIC_RELAXED, __HIP_MEMORY_SCOPE_AGENT); }
__device__ __forceinline__ unsigned xb_add(unsigned* p, unsigned v) { return __hip_atomic_fetch_add(p, v, __ATOMIC_RELAXED, __HIP_MEMORY_SCOPE_AGENT); }
__device__ __forceinline__ unsigned xb_xcc_id() { return (unsigned)__builtin_amdgcn_s_getreg((3 << 11) | 20) & 0xFu; }
#define XB_SPIN(cond, bar) do { unsigned _sp = 0; while (cond) { __builtin_amdgcn_s_sleep(1); \
    if ((++_sp & 255u) == 0u) { if (xb_ld(&(bar)[XB_TMO])) break; if (_sp > XB_SPIN_CAP) { atomicAdd(&(bar)[XB_TMO], 1u); break; } } } } while (0)
struct XcdBarrier { unsigned* bar; unsigned x; volatile LAS unsigned* st; };
__device__ __forceinline__ XcdBarrier xcd_barrier_post(unsigned* bar, volatile LAS unsigned* st) {
    XcdBarrier b; b.bar = bar; b.x = xb_xcc_id(); b.st = st;
    if (opaque_tid() == 0) (void)xb_add(&bar[XB_XCNT(b.x)], 1u);
    return b;
}
__device__ __forceinline__ void xcd_barrier_complete(unsigned* bar, unsigned x, unsigned& nloc, unsigned& nx) {
    const unsigned G = gridDim.x * gridDim.y * gridDim.z;
    unsigned sum, cnt, mine, sp = 0u;
    for (;;) {
        sum = 0u; cnt = 0u; mine = 0u;
#pragma unroll
        for (unsigned j = 0; j < 16; ++j) { const unsigned c = xb_ld(&bar[XB_XCNT(j)]); sum += c; cnt += (c > 0u) ? 1u : 0u; mine = (j == x) ? c : mine; }
        if (sum == G) break;
        __builtin_amdgcn_s_sleep(1);
        if ((++sp & 255u) == 0u) { if (xb_ld(&bar[XB_TMO])) break; if (sp > XB_SPIN_CAP) { atomicAdd(&bar[XB_TMO], 1u); break; } }
    }
    nloc = mine > 0u ? mine : 1u; nx = cnt > 0u ? cnt : 1u;
}
__device__ __forceinline__ void xcd_barrier(const XcdBarrier& b) {
    asm volatile("s_waitcnt vmcnt(0)" ::: "memory");
    __syncthreads();
    if (opaque_tid() == 0) {
        unsigned* bar = b.bar;
        __builtin_amdgcn_s_waitcnt(0);
        unsigned nloc = b.st[0], nx = b.st[1];
        if (nloc == 0u) { xcd_barrier_complete(bar, b.x, nloc, nx); b.st[0] = nloc; b.st[1] = nx; }
        const unsigned old = xb_add(&bar[XB_XSUB(b.x)], 1u);
        const unsigned gen = old / nloc;
        if (old + 1u == (gen + 1u) * nloc) {
            __builtin_amdgcn_fence(__ATOMIC_RELEASE, "agent");
            asm volatile("s_waitcnt vmcnt(0)" ::: "memory");
            const unsigned og = xb_add(&bar[XB_TOP], 1u);
            const unsigned tg = og / nx;
            if (og + 1u == (tg + 1u) * nx) xb_add(&bar[XB_TOPGEN], 1u);
            else XB_SPIN(xb_ld(&bar[XB_TOPGEN]) == tg, bar);
            __builtin_amdgcn_fence(__ATOMIC_ACQUIRE, "agent");
            xb_add(&bar[XB_XGEN(b.x)], 1u);
            asm volatile("s_waitcnt vmcnt(0)" ::: "memory");
        } else {
            XB_SPIN(xb_ld(&bar[XB_XGEN(b.x)]) == gen, bar);
            __builtin_amdgcn_fence(__ATOMIC_ACQUIRE, "agent");
            asm volatile("s_waitcnt vmcnt(0)" ::: "memory");
        }
    }
    __syncthreads();
}

namespace pg8 {
constexpr int BM = 256, BK = 64, HALF = 128, HTB = HALF * BK * 2, STAGE_BYTES = 8 * HTB, NXCD = 8, WGM = 8;
__host__ __device__ __forceinline__ int lds_byte(int r, int c) { const int st = (r >> 4) * 2 + (c >> 5), rr = r & 15, cc = c & 31, ob = rr * 64 + cc * 2; return st * 1024 + (ob ^ (((ob >> 9) & 1) << 5)); }
__host__ __device__ __forceinline__ void stage_rc(int b, int& R, int& C) { const int st = b / 1024, sb = b % 1024, swz = sb ^ (((sb >> 9) & 1) << 5); R = (st >> 1) * 16 + swz / 64; C = (st & 1) * 32 + (swz % 64) / 2; }
__host__ __device__ __forceinline__ int perm32(int rho) { const int n = rho >> 4, i = rho & 15; return 8 * (i >> 2) + 4 * n + (i & 3); }

struct Unit { int pm, pn, e, t, cnt; };
struct Gemm { const bf16_t* A; const bf16_t* Bt; int lda, ldb, K; };

struct StaticOrder {
    static constexpr bool GATHER_A = false;
    int nM, nN, nwg, G, c;
    __device__ void init(int M, int N, int G_, int c_) { nM = M / BM; nN = N / BM; nwg = nM * nN; G = G_; c = c_; }
    __device__ __forceinline__ bool next(int i, Unit& u) const {
        const long L = (long)i * G + c; if (L >= nwg) return false;
        int wgid = (int)L; { const int q = nwg / NXCD, r = nwg % NXCD, xcd = wgid % NXCD, off = wgid / NXCD; wgid = (xcd < r ? xcd * (q + 1) : r * (q + 1) + (xcd - r) * q) + off; }
        const int nig = WGM * nN, gid = wgid / nig, fm = gid * WGM, gsz = (nM - fm) < WGM ? (nM - fm) : WGM;
        u.pm = fm + ((wgid % nig) % gsz); u.pn = (wgid % nig) / gsz; u.e = 0; u.t = 0; u.cnt = 0; return true;
    }
    __device__ __forceinline__ int rowA(const Unit& u, int r) const { return u.pm * BM + r; }
    __device__ __forceinline__ int colA(const Unit&) const { return 0; }
    __device__ __forceinline__ int rowB(const Unit& u, int r) const { return u.pn * BM + r; }
};

typedef int v8i32 __attribute__((ext_vector_type(8)));
template <class Epi, class Sched, bool FP8 = false>
__device__ __forceinline__ void gemm_phase(LAS unsigned char* lds, const Gemm g, const Sched& S, const Epi& E) {
    const int tid = opaque_tid(), wid = __builtin_amdgcn_readfirstlane(tid >> 6), lane = tid & 63, wr = wid >> 2, wc = wid & 3, fr = lane & 15, fq = lane >> 4;
    const int K = g.K, nt = K / BK;
    constexpr bool GA = Sched::GATHER_A;
    int sR[2], sC[2];
    unsigned laneA[2], laneB[2];
#pragma unroll
    for (int i = 0; i < 2; ++i) { int R, C; stage_rc(tid * 16 + i * 8192, R, C); sR[i] = R; sC[i] = C; const int Rb = Epi::PERM ? ((R & ~31) + perm32(R & 31)) : R;
        laneA[i] = (unsigned)(R * g.lda + C) * 2u; laneB[i] = (unsigned)(Rb * g.ldb + C) * 2u; }
    const size_t hstepA = (size_t)HALF * g.lda * 2, hstepB = (size_t)HALF * g.ldb * 2;
    const unsigned ldsw = (unsigned)wid * 1024u;
    const int aoff = lds_byte(wr * 64 + fr, fq * 8), boff = lds_byte(wc * 32 + fr, fq * 8);
    const char* gA = (const char*)g.A; const char* gB = (const char*)g.Bt;
#define PG8_SA(b, h) (((b) * 2 + (h)) * HTB)
#define PG8_SB(b, h) ((4 + (b) * 2 + (h)) * HTB)
#define PG8_STAGE(bufoff, gptr, voff) do { _Pragma("unroll") for (int _i = 0; _i < 2; ++_i) \
        __builtin_amdgcn_global_load_lds((const unsigned*)((gptr) + (size_t)(voff)[_i]), (LAS unsigned*)(lds + (bufoff) + ldsw + _i * 8192), 16, 0, 0); } while (0)
#define PG8_STAGE_B(bufoff, ub, h, kb) PG8_STAGE(bufoff, gB + (ub) + (size_t)(h) * hstepB + (size_t)(kb), laneB)
#define PG8_STAGE_A(bufoff, ub, va, h, kb) do { if constexpr (GA) { PG8_STAGE(bufoff, gA + (size_t)(kb), va[h]); } else { PG8_STAGE(bufoff, gA + (ub) + (size_t)(h) * hstepA + (size_t)(kb), laneA); } } while (0)
#define PG8_RD(off) (*(const LAS u32x4*)(lds + (off)))
#define PG8_CAT2(x, y) __builtin_bit_cast(v8i32, __builtin_shufflevector((x), (y), 0, 1, 2, 3, 4, 5, 6, 7))
#define PG8_LDA(dst, b, h) do { if constexpr (FP8) { _Pragma("unroll") for (int m = 0; m < 4; ++m) dst##8[m] = PG8_CAT2(PG8_RD(PG8_SA(b, h) + aoff + m * 2048), PG8_RD(PG8_SA(b, h) + aoff + m * 2048 + 1024)); } \
        else { _Pragma("unroll") for (int m = 0; m < 4; ++m) _Pragma("unroll") for (int k = 0; k < 2; ++k) dst[m][k] = *(const LAS bf16x8*)(lds + PG8_SA(b, h) + aoff + m * 2048 + k * 1024); } } while (0)
#define PG8_LDB(dst, b, h) do { if constexpr (FP8) { _Pragma("unroll") for (int n = 0; n < 2; ++n) dst##8[n] = PG8_CAT2(PG8_RD(PG8_SB(b, h) + boff + n * 2048), PG8_RD(PG8_SB(b, h) + boff + n * 2048 + 1024)); } \
        else { _Pragma("unroll") for (int n = 0; n < 2; ++n) _Pragma("unroll") for (int k = 0; k < 2; ++k) dst[n][k] = *(const LAS bf16x8*)(lds + PG8_SB(b, h) + boff + n * 2048 + k * 1024); } } while (0)
#define PG8_MMA(ai, bj, At, Bt) do { __builtin_amdgcn_s_setprio(1); _Pragma("unroll") for (int m = 0; m < 4; ++m) _Pragma("unroll") for (int n = 0; n < 2; ++n) { \
        if constexpr (FP8) { asm volatile("v_mfma_scale_f32_16x16x128_f8f6f4 %0, %1, %2, %0, %3, %3 op_sel_hi:[0,0,0]" : "+v"(acc[ai][bj][m][n]) : "v"(Bt##8[n]), "v"(At##8[m]), "v"(fp8_one)); } \
        else { _Pragma("unroll") for (int k = 0; k < 2; ++k) acc[ai][bj][m][n] = __builtin_amdgcn_mfma_f32_16x16x32_bf16(Bt[n][k], At[m][k], acc[ai][bj][m][n], 0, 0, 0); } } \
        __builtin_amdgcn_s_setprio(0); } while (0)
#define PG8_WAIT_V(n) asm volatile("s_waitcnt vmcnt(" #n ")" ::: "memory")
#define PG8_WAIT_L(n) asm volatile("s_waitcnt lgkmcnt(" #n ")" ::: "memory")
#define PG8_BAR __builtin_amdgcn_s_barrier()
#define PG8_SCHED __builtin_amdgcn_sched_barrier(0)
#define PG8_SCHED8 do { if constexpr (FP8) __builtin_amdgcn_sched_barrier(0); } while (0)
#define PG8_OFFS(u, ubA, ubB, vA) do { ubB = ((size_t)S.rowB(u, 0) * (size_t)g.ldb) * 2; \
        if constexpr (GA) { ubA = 0; _Pragma("unroll") for (int _h = 0; _h < 2; ++_h) _Pragma("unroll") for (int _i = 0; _i < 2; ++_i) vA[_h][_i] = ((unsigned)S.rowA(u, _h * HALF + sR[_i]) * (unsigned)g.lda + (unsigned)sC[_i]) * 2u; } \
        else { ubA = ((size_t)S.rowA(u, 0) * (size_t)g.lda + (size_t)S.colA(u)) * 2; } } while (0)
    Unit cur, nxt; int ui = 0;
    if (!S.next(0, cur)) return;
    f32x4 acc[2][2][4][2];
#pragma unroll
    for (int a = 0; a < 2; ++a)
#pragma unroll
        for (int b = 0; b < 2; ++b)
#pragma unroll
            for (int m = 0; m < 4; ++m)
#pragma unroll
                for (int n = 0; n < 2; ++n) acc[a][b][m][n] = (f32x4){0.f, 0.f, 0.f, 0.f};
    const int fp8_one = 0x7f7f7f7f;
    bf16x8 At[4][2], B0[2][2], B1[2][2]; v8i32 At8[4], B08[2], B18[2];
    size_t ubAc, ubBc, ubAn, ubBn; unsigned vAc[2][2] = {}, vAn[2][2] = {};
    PG8_OFFS(cur, ubAc, ubBc, vAc);
    PG8_STAGE_B(PG8_SB(0, 0), ubBc, 0, 0); PG8_STAGE_B(PG8_SB(0, 1), ubBc, 1, 0); PG8_STAGE_A(PG8_SA(0, 0), ubAc, vAc, 0, 0); PG8_STAGE_A(PG8_SA(0, 1), ubAc, vAc, 1, 0);
    if (wr == 1) PG8_BAR;
    PG8_WAIT_V(2); PG8_BAR;
    PG8_STAGE_B(PG8_SB(1, 0), ubBc, 0, 128); PG8_STAGE_A(PG8_SA(1, 0), ubAc, vAc, 0, 128); PG8_STAGE_B(PG8_SB(1, 1), ubBc, 1, 128);
    PG8_WAIT_V(6); PG8_BAR;
    for (;;) {
        const bool has_next = S.next(ui + 1, nxt);
        if (has_next) { PG8_OFFS(nxt, ubAn, ubBn, vAn); }
        else { ubAn = ubAc; ubBn = ubBc;
#pragma unroll
            for (int h = 0; h < 2; ++h)
#pragma unroll
                for (int i = 0; i < 2; ++i) vAn[h][i] = vAc[h][i]; }
        for (int t = 0; t < nt; t += 2) {
            const bool last = (t == nt - 2);
            const unsigned k1 = (unsigned)(t + 1) * 128u, k2 = last ? 0u : (unsigned)(t + 2) * 128u, k3 = k2 + 128u;
            const size_t xubA = last ? ubAn : ubAc, xubB = last ? ubBn : ubBc;
            unsigned xA[2][2];
#pragma unroll
            for (int h = 0; h < 2; ++h)
#pragma unroll
                for (int i = 0; i < 2; ++i) xA[h][i] = last ? vAn[h][i] : vAc[h][i];
            PG8_LDB(B0, 0, 0); PG8_LDB(B1, 0, 1); PG8_SCHED; PG8_LDA(At, 0, 0); PG8_STAGE_A(PG8_SA(1, 1), ubAc, vAc, 1, k1);
            PG8_WAIT_V(8); PG8_WAIT_L(0); PG8_SCHED8; PG8_BAR; PG8_MMA(0, 0, At, B0); PG8_MMA(0, 1, At, B1); PG8_SCHED8; PG8_BAR; PG8_SCHED;
            PG8_LDA(At, 0, 1); PG8_STAGE_B(PG8_SB(0, 0), xubB, 0, k2); PG8_STAGE_B(PG8_SB(0, 1), xubB, 1, k2); PG8_STAGE_A(PG8_SA(0, 0), xubA, xA, 0, k2);
            PG8_WAIT_V(8); PG8_WAIT_L(0); PG8_SCHED8; PG8_BAR; PG8_MMA(1, 0, At, B0); PG8_MMA(1, 1, At, B1); PG8_SCHED8; PG8_BAR; PG8_SCHED;
            PG8_LDB(B0, 1, 0); PG8_LDB(B1, 1, 1); PG8_SCHED; PG8_LDA(At, 1, 0); PG8_STAGE_A(PG8_SA(0, 1), xubA, xA, 1, k2);
            PG8_WAIT_V(8); PG8_WAIT_L(0); PG8_SCHED8; PG8_BAR; PG8_MMA(0, 0, At, B0); PG8_MMA(0, 1, At, B1); PG8_SCHED8; PG8_BAR; PG8_SCHED;
            PG8_LDA(At, 1, 1); PG8_STAGE_B(PG8_SB(1, 0), xubB, 0, k3); PG8_STAGE_B(PG8_SB(1, 1), xubB, 1, k3); PG8_STAGE_A(PG8_SA(1, 0), xubA, xA, 0, k3);
            PG8_WAIT_V(8); PG8_WAIT_L(0); PG8_SCHED8; PG8_BAR; PG8_MMA(1, 0, At, B0); PG8_MMA(1, 1, At, B1); PG8_SCHED8; PG8_BAR; PG8_SCHED;
        }
        if (wr == 0) PG8_BAR;
        E(acc, cur, wr, wc, fr, fq);
        if (!has_next) break;
#pragma unroll
        for (int a = 0; a < 2; ++a)
#pragma unroll
            for (int b = 0; b < 2; ++b)
#pragma unroll
                for (int m = 0; m < 4; ++m)
#pragma unroll
                    for (int n = 0; n < 2; ++n) acc[a][b][m][n] = (f32x4){0.f, 0.f, 0.f, 0.f};
        cur = nxt; ++ui; ubAc = ubAn; ubBc = ubBn;
#pragma unroll
        for (int h = 0; h < 2; ++h)
#pragma unroll
            for (int i = 0; i < 2; ++i) vAc[h][i] = vAn[h][i];
        if (wr == 1) PG8_BAR;
    }
    PG8_WAIT_V(0);
    PG8_BAR;
#undef PG8_SA
#undef PG8_SB
#undef PG8_STAGE
#undef PG8_STAGE_A
#undef PG8_STAGE_B
#undef PG8_LDA
#undef PG8_LDB
#undef PG8_MMA
#undef PG8_RD
#undef PG8_CAT2
#undef PG8_WAIT_V
#undef PG8_WAIT_L
#undef PG8_BAR
#undef PG8_SCHED
#undef PG8_SCHED8
#undef PG8_OFFS
}
}
namespace pg8 {
struct EpiBf16 {
    static constexpr bool PERM = true;
    bf16_t* O; int ldc; int split_cols; size_t split_stride; float scale0; float scale_all = 1.0f;
    __device__ __forceinline__ void operator()(const f32x4 (&acc)[2][2][4][2], const Unit& u, int wr, int wc, int fr, int fq) const {
        const int row0 = u.pm * BM + wr * 64 + fr; int colt = u.pn * BM; bf16_t* base = O;
        float sc = scale_all; if (split_cols) { const int t = colt / split_cols; base += (size_t)t * split_stride; colt -= t * split_cols; if (t == 0) sc *= scale0; }
        const int col0 = colt + wc * 32 + 8 * fq;
#pragma unroll
        for (int ai = 0; ai < 2; ++ai)
#pragma unroll
            for (int m = 0; m < 4; ++m) { bf16_t* rowp = base + (size_t)(row0 + ai * HALF + m * 16) * ldc + col0;
#pragma unroll
                for (int bj = 0; bj < 2; ++bj) { const f32x4 v0 = acc[ai][bj][m][0] * sc, v1 = acc[ai][bj][m][1] * sc;
                    u32x4 w; w.x = cvt_pk_bf16(v0[0], v0[1]); w.y = cvt_pk_bf16(v0[2], v0[3]); w.z = cvt_pk_bf16(v1[0], v1[1]); w.w = cvt_pk_bf16(v1[2], v1[3]);
                    *(u32x4*)(rowp + bj * HALF) = w; } }
    }
};
struct EpiFilt {
    static constexpr bool PERM = true;
    bf16_t* O;
    __device__ __forceinline__ void operator()(const f32x4 (&acc)[2][2][4][2], const Unit& u, int wr, int wc, int fr, int fq) const {
        const float dmin = -3.0701134573253945f, dmax = -15.350567286626973f;
#pragma unroll
        for (int ai = 0; ai < 2; ++ai)
#pragma unroll
            for (int m = 0; m < 4; ++m) { const int row = u.pm * BM + ai * HALF + wr * 64 + m * 16 + fr; const int c = row & 1023;
                const float dl2 = fabsf(dmin + (float)c * ((dmax - dmin) / 1023.0f)) * (1.4426950408889634f / 8191.0f);
#pragma unroll
                for (int bj = 0; bj < 2; ++bj) { const int col = u.pn * BM + bj * HALF + wc * 32 + 8 * fq; float v[8];
#pragma unroll
                    for (int n = 0; n < 2; ++n)
#pragma unroll
                        for (int j = 0; j < 4; ++j) v[n * 4 + j] = acc[ai][bj][m][n][j] * __builtin_amdgcn_exp2f(-(float)(col + n * 4 + j) * dl2);
                    u32x4 w; w.x = cvt_pk_bf16(v[0], v[1]); w.y = cvt_pk_bf16(v[2], v[3]); w.z = cvt_pk_bf16(v[4], v[5]); w.w = cvt_pk_bf16(v[6], v[7]);
                    *(u32x4*)(O + (size_t)row * 8192 + col) = w; }
                asm volatile("" ::: "memory"); }
    }
};
struct EpiResF32 {
    static constexpr bool PERM = false;
    const float* res; float* O; int ldc; float alpha;
    __device__ __forceinline__ void operator()(const f32x4 (&acc)[2][2][4][2], const Unit& u, int wr, int wc, int fr, int fq) const {
#pragma unroll
        for (int ai = 0; ai < 2; ++ai)
#pragma unroll
            for (int m = 0; m < 4; ++m) { const size_t off = (size_t)(u.pm * BM + ai * HALF + wr * 64 + m * 16 + fr) * ldc + u.pn * BM + wc * 32 + 4 * fq;
#pragma unroll
                for (int bj = 0; bj < 2; ++bj)
#pragma unroll
                    for (int n = 0; n < 2; ++n) { const f32x4 r = *(const f32x4*)(res + off + bj * HALF + n * 16); *(f32x4*)(O + off + bj * HALF + n * 16) = r * alpha + acc[ai][bj][m][n]; }
                if (m & 1) asm volatile("" ::: "memory"); }
    }
};
struct EpiResBf {
    static constexpr bool PERM = true;
    const bf16_t* res; bf16_t* O; int ldc; float alpha; float ascale = 1.0f;
    __device__ __forceinline__ void operator()(const f32x4 (&acc)[2][2][4][2], const Unit& u, int wr, int wc, int fr, int fq) const {
#pragma unroll
        for (int ai = 0; ai < 2; ++ai)
#pragma unroll
            for (int m = 0; m < 4; ++m) { const size_t off = (size_t)(u.pm * BM + ai * HALF + wr * 64 + m * 16 + fr) * ldc + u.pn * BM + wc * 32 + 8 * fq;
#pragma unroll
                for (int bj = 0; bj < 2; ++bj) { const u32x4 r = *(const u32x4*)(res + off + bj * HALF); const f32x4 a0 = acc[ai][bj][m][0] * ascale, a1 = acc[ai][bj][m][1] * ascale;
                    u32x4 w; w.x = cvt_pk_bf16(bflo(r.x) * alpha + a0[0], bfhi(r.x) * alpha + a0[1]); w.y = cvt_pk_bf16(bflo(r.y) * alpha + a0[2], bfhi(r.y) * alpha + a0[3]);
                    w.z = cvt_pk_bf16(bflo(r.z) * alpha + a1[0], bfhi(r.z) * alpha + a1[1]); w.w = cvt_pk_bf16(bflo(r.w) * alpha + a1[2], bfhi(r.w) * alpha + a1[3]);
                    *(u32x4*)(O + off + bj * HALF) = w; }
                if (m & 1) asm volatile("" ::: "memory"); }
    }
};
struct EpiSwiglu {
    static constexpr bool PERM = true;
    bf16_t* O;
    __device__ __forceinline__ void operator()(const f32x4 (&acc)[2][2][4][2], const Unit& u, int wr, int wc, int fr, int fq) const {
#pragma unroll
        for (int ai = 0; ai < 2; ++ai)
#pragma unroll
            for (int m = 0; m < 4; ++m) { bf16_t* p = O + (size_t)(u.pm * BM + ai * HALF + wr * 64 + m * 16 + fr) * DFF + u.pn * HALF + wc * 32 + 8 * fq;
                float h[8];
#pragma unroll
                for (int n = 0; n < 2; ++n)
#pragma unroll
                    for (int j = 0; j < 4; ++j) { const float gt = acc[ai][0][m][n][j], up = acc[ai][1][m][n][j]; h[n * 4 + j] = gt * sigmoidf_(gt) * up; }
                u32x4 w; w.x = cvt_pk_bf16(h[0], h[1]); w.y = cvt_pk_bf16(h[2], h[3]); w.z = cvt_pk_bf16(h[4], h[5]); w.w = cvt_pk_bf16(h[6], h[7]);
                *(u32x4*)p = w; }
    }
};
__device__ __forceinline__ float clamp_fp8(float x) { return __builtin_amdgcn_fmed3f(x, -448.0f, 448.0f); }
__device__ __forceinline__ unsigned pk4_fp8(float a, float b, float c, float d) { int w = 0; w = __builtin_amdgcn_cvt_pk_fp8_f32(clamp_fp8(a), clamp_fp8(b), w, false); w = __builtin_amdgcn_cvt_pk_fp8_f32(clamp_fp8(c), clamp_fp8(d), w, true); return (unsigned)w; }
constexpr float FP8_SW = 64.0f, FP8_SH = 8.0f;
struct EpiSwiglu8 {
    static constexpr bool PERM = true;
    unsigned char* O;
    __device__ __forceinline__ void operator()(const f32x4 (&acc)[2][2][4][2], const Unit& u, int wr, int wc, int fr, int fq) const {
#pragma unroll
        for (int ai = 0; ai < 2; ++ai)
#pragma unroll
            for (int m = 0; m < 4; ++m) { unsigned char* p = O + (size_t)(u.pm * BM + ai * HALF + wr * 64 + m * 16 + fr) * DFF + u.pn * HALF + wc * 32 + 8 * fq;
                float h[8];
#pragma unroll
                for (int n = 0; n < 2; ++n)
#pragma unroll
                    for (int j = 0; j < 4; ++j) { const float gt = acc[ai][0][m][n][j] * (1.0f / FP8_SW), up = acc[ai][1][m][n][j] * (1.0f / FP8_SW); h[n * 4 + j] = gt * sigmoidf_(gt) * up * FP8_SH; }
                u32x2 w; w.x = pk4_fp8(h[0], h[1], h[2], h[3]); w.y = pk4_fp8(h[4], h[5], h[6], h[7]);
                *(u32x2*)p = w; }
    }
};
struct EpiDown {
    static constexpr bool PERM = true;
    bf16_t* O; const int* rowlist; const float* gatew; float oscale;
    __device__ __forceinline__ void operator()(const f32x4 (&acc)[2][2][4][2], const Unit& u, int wr, int wc, int fr, int fq) const {
#pragma unroll
        for (int ai = 0; ai < 2; ++ai)
#pragma unroll
            for (int m = 0; m < 4; ++m) { const int idx = u.t * BM + ai * HALF + wr * 64 + m * 16 + fr;
                if (idx < u.cnt) { const int a = rowlist[(size_t)u.e * ECAP + idx]; const float gw = gatew[a] * oscale;
                    bf16_t* p = O + (size_t)a * DM + u.pn * BM + wc * 32 + 8 * fq;
#pragma unroll
                    for (int bj = 0; bj < 2; ++bj) { const f32x4 v0 = acc[ai][bj][m][0] * gw, v1 = acc[ai][bj][m][1] * gw;
                        u32x4 w; w.x = cvt_pk_bf16(v0[0], v0[1]); w.y = cvt_pk_bf16(v0[2], v0[3]); w.z = cvt_pk_bf16(v1[0], v1[1]); w.w = cvt_pk_bf16(v1[2], v1[3]);
                        *(u32x4*)(p + bj * HALF) = w; } } }
    }
};
constexpr float RG_SLA = 4096.0f, RG_SB = 64.0f;
struct EpiRG {
    static constexpr bool PERM = true;
    bf16_t* LA; bf16_t* BB; const bf16_t* XC; const float* ba; const float* bx; const float* lam;
    __device__ __forceinline__ void operator()(const f32x4 (&acc)[2][2][4][2], const Unit& u, int wr, int wc, int fr, int fq) const {
        const int nb = u.pn >> 2, q = u.pn & 3, dir = q >> 1, half = q & 1;
        const int ch0 = nb * 256 + half * HALF + wc * 32 + 8 * fq;
        float vba[8], vbx[8], vsp[8];
#pragma unroll
        for (int j = 0; j < 8; ++j) { vba[j] = ba[dir * DM + ch0 + j]; vbx[j] = bx[dir * DM + ch0 + j];
            const float x = __expf(-lam[dir * DM + ch0 + j]);
            vsp[j] = 8.0f * (x < 0.05f ? x * (1.0f - x * (0.5f - x * (0.33333334f - 0.25f * x))) : __logf(1.0f + x)); }
#pragma unroll
        for (int ai = 0; ai < 2; ++ai)
#pragma unroll
            for (int m = 0; m < 4; ++m) { const size_t tok = (size_t)(u.pm * BM + ai * HALF + wr * 64 + m * 16 + fr);
                asm volatile("" ::: "memory");
                const u32x4 xw = *(const u32x4*)(XC + tok * DM + ch0);
                float xf[8] = {bflo(xw.x), bfhi(xw.x), bflo(xw.y), bfhi(xw.y), bflo(xw.z), bfhi(xw.z), bflo(xw.w), bfhi(xw.w)};
                float la[8], bb[8];
#pragma unroll
                for (int n = 0; n < 2; ++n)
#pragma unroll
                    for (int j = 0; j < 4; ++j) { const int k = n * 4 + j;
                        const float r = sigmoidf_(acc[ai][0][m][n][j] + vba[k]), ig = sigmoidf_(acc[ai][1][m][n][j] + vbx[k]);
                        const float l = -r * vsp[k]; la[k] = l; bb[k] = __builtin_amdgcn_sqrtf(fmaxf(1.0f - __builtin_amdgcn_exp2f(2.8853900817779268f * l), 0.f)) * (ig * xf[k]); }
                u32x2 w; w.x = pk4_fp8(RG_SLA * la[0], RG_SLA * la[1], RG_SLA * la[2], RG_SLA * la[3]); w.y = pk4_fp8(RG_SLA * la[4], RG_SLA * la[5], RG_SLA * la[6], RG_SLA * la[7]);
                *(u32x2*)((unsigned char*)LA + ((size_t)dir * NTOK + tok) * DM + ch0) = w;
                w.x = pk4_fp8(RG_SB * bb[0], RG_SB * bb[1], RG_SB * bb[2], RG_SB * bb[3]); w.y = pk4_fp8(RG_SB * bb[4], RG_SB * bb[5], RG_SB * bb[6], RG_SB * bb[7]);
                *(u32x2*)((unsigned char*)BB + ((size_t)dir * NTOK + tok) * DM + ch0) = w; }
    }
};

struct RGOrder {
    static constexpr bool GATHER_A = false;
    int G, c;
    __device__ __forceinline__ bool next(int i, Unit& u) const {
        if (G == 256) { if (i >= 8) return false; const int x = c & 7, y = c >> 3; u.pm = i * 8 + (y >> 2); u.pn = x * 4 + (y & 3); }
        else { const int L = i * G + c; if (L >= 64 * 32) return false; u.pm = L >> 5; u.pn = L & 31; }
        u.e = 0; u.t = 0; u.cnt = 0; return true; }
    __device__ __forceinline__ int rowA(const Unit& u, int r) const { return u.pm * BM + r; }
    __device__ __forceinline__ int colA(const Unit& u) const { return (u.pn >> 2) * 256; }
    __device__ __forceinline__ int rowB(const Unit& u, int r) const { return u.pn * BM + r; }
};
template <int NPN, bool GATHER>
struct MoeOrder {
    static constexpr bool GATHER_A = GATHER;
    int G, c; const LAS int* tab; const int* rowlist;
    __device__ __forceinline__ bool next(int i, Unit& u) const {
        const int L = i * G + c, ntile = tab[32]; if (L >= ntile * NPN) return false;
        const int tile = L / NPN; u.pm = tile; u.pn = L % NPN; int e = 0;
        while (e < 31 && tab[e + 1] <= tile) ++e;
        u.e = e; u.t = tile - tab[e]; u.cnt = tab[64 + e]; return true;
    }
    __device__ __forceinline__ int rowA(const Unit& u, int r) const {
        if (GATHER) { const int idx = u.t * BM + r; const int a = idx < u.cnt ? rowlist[(size_t)u.e * ECAP + idx] : 0; return a >> 1; }
        return u.pm * BM + r;
    }
    __device__ __forceinline__ int colA(const Unit&) const { return 0; }
    __device__ __forceinline__ int rowB(const Unit& u, int r) const { return (u.e * NPN + u.pn) * BM + r; }
};
}
namespace att {
constexpr int NW = 8, QBLK = 32, KVBLK = 64, LDQ = 1024, LDK = 1024, LDV = 1024, LDO = 1024;
constexpr int SHM_V = KVBLK * 128 * 2, SHM_K = KVBLK * 64 * 2, NSLOT = 4, LDS_K = 0, LDS_V = NSLOT * SHM_K, LDS_WS = NSLOT * (SHM_K + SHM_V), SHM_ATTN = LDS_WS + NW * 64 * 4;
__device__ __forceinline__ void glds16s(const void* sbase, unsigned voff, unsigned lds_dst) { unsigned keep;
    asm volatile("s_mov_b32 %0, m0\n\ts_mov_b32 m0, %3\n\ts_nop 0\n\tglobal_load_lds_dwordx4 %1, %2\n\ts_mov_b32 m0, %0" : "=&s"(keep) : "v"(voff), "s"(sbase), "s"(lds_dst) : "memory"); }
#define WAITBAR(N) asm volatile("s_waitcnt vmcnt(" #N ") lgkmcnt(0)\n\ts_barrier" ::: "memory")
constexpr float THR2 = 8.0f * 1.4426950408889634f;
#define KSWZ64(row, colB) ((row) * 128 + ((colB) ^ ((((row) >> 1) & 7) << 4)))
#define SBAR() __builtin_amdgcn_sched_barrier(0)
__device__ __forceinline__ int crow(int r, int hi) { return (r & 3) + 8 * (r >> 2) + 4 * hi; }
__device__ __forceinline__ void qkt(f32x16& p0, f32x16& p1, const char* Ks, const bf16x8* qr, int r32, int hi, float A, float st) {
    { float b4[4];
#pragma unroll
      for (int j = 0; j < 4; ++j) b4[j] = fmaf(st, (float)j, A);
      const float s8 = 8.0f * st, s32 = 32.0f * st;
#pragma unroll
      for (int r = 0; r < 16; ++r) { p0[r] = (r < 4) ? b4[r] : p0[r - 4] + s8; }
#pragma unroll
      for (int r = 0; r < 16; ++r) p1[r] = p0[r] + s32; }
#pragma unroll
    for (int d0 = 0; d0 < 4; ++d0) { const int cb = (d0 * 16 + hi * 8) * 2;
        const bf16x8 b0 = *reinterpret_cast<const bf16x8*>(Ks + KSWZ64(r32, cb));
        const bf16x8 b1 = *reinterpret_cast<const bf16x8*>(Ks + KSWZ64(32 + r32, cb));
        p0 = __builtin_amdgcn_mfma_f32_32x32x16_bf16(b0, qr[d0], p0, 0, 0, 0);
        p1 = __builtin_amdgcn_mfma_f32_32x32x16_bf16(b1, qr[d0], p1, 0, 0, 0); }
}
__device__ __forceinline__ void partialSM(f32x16& p0, f32x16& p1, bool mixed, float fd, float sl2) {
    if (mixed) {
#pragma unroll
        for (int r = 0; r < 16; ++r) { const float d0 = fd - (float)((r & 3) + 8 * (r >> 2)); p0[r] = fmaf(fabsf(d0), -sl2, p0[r]); p1[r] = fmaf(fabsf(d0 - 32.0f), -sl2, p1[r]); }
    }
#pragma unroll
    for (int r = 0; r < 16; ++r) p0[r] = __builtin_amdgcn_exp2f(p0[r]);
}
__device__ __forceinline__ void finishSM(f32x16& p0, f32x16& p1, float& l_reg, bf16x8& pa0, bf16x8& pa1, bf16x8& pa2, bf16x8& pa3) {
#pragma unroll
    for (int r = 0; r < 16; ++r) p1[r] = __builtin_amdgcn_exp2f(p1[r]);
    float ps = 0;
#pragma unroll
    for (int r = 0; r < 16; ++r) ps += p0[r];
#pragma unroll
    for (int r = 0; r < 16; ++r) ps += p1[r];
    l_reg += ps;
#define PK4(P, BASE, OUT) do { unsigned a0 = cvt_pk_bf16(P[BASE + 0], P[BASE + 1]), a1 = cvt_pk_bf16(P[BASE + 2], P[BASE + 3]);   \
    unsigned b0 = cvt_pk_bf16(P[BASE + 4], P[BASE + 5]), b1 = cvt_pk_bf16(P[BASE + 6], P[BASE + 7]);                              \
    auto r0 = __builtin_amdgcn_permlane32_swap(a0, b0, false, false); auto r1 = __builtin_amdgcn_permlane32_swap(a1, b1, false, false); \
    u32x4 w = {r0[0], r1[0], r0[1], r1[1]}; OUT = __builtin_bit_cast(bf16x8, w); } while (0)
    PK4(p0, 0, pa0); PK4(p0, 8, pa1); PK4(p1, 0, pa2); PK4(p1, 8, pa3);
#undef PK4
}
__device__ __forceinline__ int v_st(int k, int c) { const int kk = (k & ~0xC) | ((k & 4) << 1) | ((k & 8) >> 1); return ((kk >> 3) * 4 + (c >> 5)) * 512 + ((kk & 7) * 32 + (c & 31)) * 2; }
__device__ __forceinline__ int v_rd_base(int lane) { return ((lane & 3) << 3) | (((lane >> 2) & 3) << 6) | (((lane >> 4) & 1) << 5) | (((lane >> 5) & 1) << 8); }
constexpr int v_rd_off(int d0, int ks, int half) { return d0 * 512 + ks * 4096 + half * 2048; }
template <int OFF> __device__ __forceinline__ s16x4 tr_read(int vb) {
    s16x4 r; asm volatile("ds_read_b64_tr_b16 %0, %1 offset:%2" : "=&v"(r) : "v"(vb), "i"(OFF) : "memory"); return r;
}
template <int D0> __device__ __forceinline__ void pv_one(f32x16& od, int vb, bf16x8 pa0, bf16x8 pa1, bf16x8 pa2, bf16x8 pa3) {
    const s16x4 l0 = tr_read<v_rd_off(D0, 0, 0)>(vb), h0 = tr_read<v_rd_off(D0, 0, 1)>(vb), l1 = tr_read<v_rd_off(D0, 1, 0)>(vb), h1 = tr_read<v_rd_off(D0, 1, 1)>(vb);
    const s16x4 l2 = tr_read<v_rd_off(D0, 2, 0)>(vb), h2 = tr_read<v_rd_off(D0, 2, 1)>(vb), l3 = tr_read<v_rd_off(D0, 3, 0)>(vb), h3 = tr_read<v_rd_off(D0, 3, 1)>(vb);
    asm volatile("s_waitcnt lgkmcnt(0)" ::: "memory"); SBAR();
#define PK(L, H) (bf16x8){L[0], L[1], L[2], L[3], H[0], H[1], H[2], H[3]}
    od = __builtin_amdgcn_mfma_f32_32x32x16_bf16(pa0, PK(l0, h0), od, 0, 0, 0);
    od = __builtin_amdgcn_mfma_f32_32x32x16_bf16(pa1, PK(l1, h1), od, 0, 0, 0);
    od = __builtin_amdgcn_mfma_f32_32x32x16_bf16(pa2, PK(l2, h2), od, 0, 0, 0);
    od = __builtin_amdgcn_mfma_f32_32x32x16_bf16(pa3, PK(l3, h3), od, 0, 0, 0);
#undef PK
}
__device__ __forceinline__ void pv_d0(f32x16* o, int vb, bf16x8 pa0, bf16x8 pa1, bf16x8 pa2, bf16x8 pa3) {
    pv_one<0>(o[0], vb, pa0, pa1, pa2, pa3); pv_one<1>(o[1], vb, pa0, pa1, pa2, pa3); pv_one<2>(o[2], vb, pa0, pa1, pa2, pa3); pv_one<3>(o[3], vb, pa0, pa1, pa2, pa3);
}
__device__ __forceinline__ void attn_unit(const bf16_t* __restrict__ Qb, const bf16_t* __restrict__ Kh, const bf16_t* __restrict__ Vh, bf16_t* __restrict__ Ob, int q0, int t_lo, int n, float sl2, char* lds) {
    const int tid = opaque_tid(), wid = __builtin_amdgcn_readfirstlane(tid >> 6), lane = tid & 63, r32 = lane & 31, hi = lane >> 5;
    float* ws = (float*)(lds + LDS_WS) + wid * 64; float* li_l = ws;
    float l_reg = 0; f32x16 o[4] = {}; bf16x8 qr[4];
    const bf16_t* Qw = Qb + (long)(wid * QBLK + r32) * LDQ + hi * 8;
#pragma unroll
    for (int d0 = 0; d0 < 4; ++d0) qr[d0] = *reinterpret_cast<const bf16x8*>(Qw + d0 * 16);
    float negM;
    { const bf16_t* Kw = Kh + (long)(q0 + wid * QBLK + r32) * LDK + hi * 8; float s = 0.f;
#pragma unroll
      for (int d0 = 0; d0 < 4; ++d0) { const u32x4 kw = *reinterpret_cast<const u32x4*>(Kw + d0 * 16); const u32x4 qw = __builtin_bit_cast(u32x4, qr[d0]);
          s += bflo(kw.x) * bflo(qw.x) + bfhi(kw.x) * bfhi(qw.x) + bflo(kw.y) * bflo(qw.y) + bfhi(kw.y) * bfhi(qw.y) + bflo(kw.z) * bflo(qw.z) + bfhi(kw.z) * bfhi(qw.z) + bflo(kw.w) * bflo(qw.w) + bfhi(kw.w) * bfhi(qw.w); }
      auto rr = __builtin_amdgcn_permlane32_swap(__float_as_uint(s), __float_as_uint(s), false, false); negM = -(__uint_as_float(rr[0]) + __uint_as_float(rr[1])); }
    const unsigned lds0 = (unsigned)(uintptr_t)lds;
    const int krow = wid * 8 + (lane >> 3), kch = (lane & 7) ^ ((krow >> 1) & 7);
    const unsigned koff = (unsigned)(krow * LDK * 2 + kch * 16);
    unsigned voff[2];
#pragma unroll
    for (int z = 0; z < 2; ++z) { const int P16 = (wid + 8 * z) * 64 + lane, sub = P16 >> 5, win = P16 & 31, kk = (sub >> 2) * 8 + (win >> 2), k = (kk & ~0xC) | ((kk & 4) << 1) | ((kk & 8) >> 1), c = (sub & 3) * 32 + (win & 3) * 8;
        voff[z] = (unsigned)(k * LDV * 2 + c * 2); }
    const unsigned kdst = lds0 + LDS_K + wid * 1024, vdst = lds0 + LDS_V + wid * 1024;
    const int vb0 = (int)(lds0 + LDS_V) + v_rd_base(lane);
    const char* K_lds = lds + LDS_K;
    const int qw0 = q0 + wid * QBLK;
    const float fq0 = (float)(qw0 + r32 - 4 * hi);
    const char* Kt = (const char*)(Kh + (long)t_lo * KVBLK * LDK); const char* Vt = (const char*)(Vh + (long)t_lo * KVBLK * LDV);
#define DMA(jj, slot) do { const char* kb_ = Kt + (size_t)(jj) * (KVBLK * LDK * 2); const char* vb_ = Vt + (size_t)(jj) * (KVBLK * LDV * 2); \
    glds16s(kb_, koff, (unsigned)__builtin_amdgcn_readfirstlane(kdst + (slot) * SHM_K)); \
    glds16s(vb_, voff[0], (unsigned)__builtin_amdgcn_readfirstlane(vdst + (slot) * SHM_V)); \
    glds16s(vb_, voff[1], (unsigned)__builtin_amdgcn_readfirstlane(vdst + (slot) * SHM_V + 8192)); } while (0)
#define TILE(jj) const int k0_ = (t_lo + (jj)) * KVBLK; const bool left_ = k0_ + 63 < qw0, right_ = k0_ > qw0 + 31, mixed_ = !(left_ || right_); \
    const float fd_ = fq0 - (float)k0_, st_ = left_ ? sl2 : (right_ ? -sl2 : 0.f), A_ = negM - st_ * fd_
    f32x16 pA0, pA1, pB0, pB1; bf16x8 pa0, pa1, pa2, pa3;
    asm volatile("s_waitcnt vmcnt(0)" ::: "memory");
#define SEG_A(PN0, PN1, PO0, PO1, jt, FIN) do { TILE(jt); SBAR(); qkt(PN0, PN1, K_lds + ((jt) & 3) * SHM_K, qr, r32, hi, A_, st_); if (FIN) finishSM(PO0, PO1, l_reg, pa0, pa1, pa2, pa3); SBAR(); } while (0)
#define SEG_B(P0, P1, jt, PV) do { if (PV) pv_d0(o, vb0 + (((jt) - 1) & 3) * SHM_V, pa0, pa1, pa2, pa3); { TILE(jt); partialSM(P0, P1, mixed_, fd_, sl2); } } while (0)
#define STEP_BAR(jt) do { WAITBAR(0); if ((jt) + 2 < n) DMA((jt) + 2, ((jt) + 2) & 3); } while (0)
    const bool lead = wid < 4;
    DMA(0, 0); DMA(1, 1);
    WAITBAR(3);
    SEG_A(pA0, pA1, pB0, pB1, 0, false); if (!lead) STEP_BAR(0); SEG_B(pA0, pA1, 0, false); if (lead) STEP_BAR(0);
    for (int j = 1; j + 1 < n; j += 2) {
        SEG_A(pB0, pB1, pA0, pA1, j, true); if (!lead) STEP_BAR(j); SEG_B(pB0, pB1, j, true); if (lead) STEP_BAR(j);
        SEG_A(pA0, pA1, pB0, pB1, j + 1, true); if (!lead) STEP_BAR(j + 1); SEG_B(pA0, pA1, j + 1, true); if (lead) STEP_BAR(j + 1);
    }
    SEG_A(pB0, pB1, pA0, pA1, n - 1, true); if (!lead) STEP_BAR(n - 1); SEG_B(pB0, pB1, n - 1, true); if (lead) STEP_BAR(n - 1);
    finishSM(pB0, pB1, l_reg, pa0, pa1, pa2, pa3); SBAR();
    pv_d0(o, vb0 + ((n - 1) & 3) * SHM_V, pa0, pa1, pa2, pa3);
    { auto rr = __builtin_amdgcn_permlane32_swap(__float_as_uint(l_reg), __float_as_uint(l_reg), false, false); l_reg = __uint_as_float(rr[0]) + __uint_as_float(rr[1]); }
    if (hi == 0) li_l[r32] = l_reg; asm volatile("s_waitcnt lgkmcnt(0)" ::: "memory");
    float rli[16];
#pragma unroll
    for (int r = 0; r < 16; ++r) rli[r] = __builtin_amdgcn_rcpf(li_l[crow(r, hi)]);
    bf16_t* Ow = Ob + (long)(wid * QBLK) * LDO;
#pragma unroll
    for (int r = 0; r < 16; ++r) { const int orow = crow(r, hi);
#pragma unroll
        for (int d0 = 0; d0 < 4; ++d0) Ow[(long)orow * LDO + d0 * 32 + r32] = (bf16_t)f2bf(o[d0][r] * rli[r]); }
    WAITBAR(0);
#undef DMA
#undef SEG_A
#undef SEG_B
#undef STEP_BAR
#undef TILE
}
#undef SBAR
}

namespace hy {
typedef f32x2 cf;
__device__ __forceinline__ cf lld(const LAS f32x2* L, int i) { return L[i]; }
__device__ __forceinline__ void lst(LAS f32x2* L, int i, cf v) { L[i] = v; }
__device__ __forceinline__ cf cmul(cf a, cf b) { return a * b.xx + a.yx * (b.yy * (cf){-1.f, 1.f}); }
__device__ __forceinline__ cf cmulc(cf a, cf b) { return a * b.xx + a.yx * (b.yy * (cf){1.f, -1.f}); }
__device__ constexpr float C32[16] = {1.0f, 0.98078528040323043f, 0.92387953251128674f, 0.83146961230254524f, 0.70710678118654757f, 0.55557023301960229f, 0.38268343236508984f, 0.19509032201612833f,
                                      0.0f, -0.19509032201612819f, -0.38268343236508973f, -0.55557023301960196f, -0.70710678118654746f, -0.83146961230254535f, -0.92387953251128674f, -0.98078528040323043f};
__device__ constexpr float S32[16] = {0.0f, 0.19509032201612825f, 0.38268343236508978f, 0.55557023301960218f, 0.70710678118654746f, 0.83146961230254524f, 0.92387953251128674f, 0.98078528040323043f,
                                      1.0f, 0.98078528040323043f, 0.92387953251128674f, 0.83146961230254546f, 0.70710678118654757f, 0.55557023301960218f, 0.38268343236508989f, 0.19509032201612861f};
__host__ __device__ constexpr int brev(int k, int bits) { int r = 0; for (int i = 0; i < bits; ++i) r |= ((k >> i) & 1) << (bits - 1 - i); return r; }
template <int R, bool INV> __device__ __forceinline__ void dft_reg(cf (&v)[R]) {
#pragma unroll
    for (int s = R / 2; s >= 1; s >>= 1) {
#pragma unroll
        for (int g0 = 0; g0 < R; g0 += 2 * s) {
#pragma unroll
            for (int j = 0; j < s; ++j) {
                const cf a = v[g0 + j], b = v[g0 + j + s];
                v[g0 + j] = a + b;
                const cf d = a - b;
                const int tw = j * (16 / s);
                if (tw == 0) v[g0 + j + s] = d;
                else if (tw == 8) v[g0 + j + s] = INV ? (cf){-d.y, d.x} : (cf){d.y, -d.x};
                else { const float c = C32[tw], sn = INV ? S32[tw] : -S32[tw]; v[g0 + j + s] = d * c + d.yx * (cf){-sn, sn}; }
            }
        }
    }
}
constexpr int RS = FFT_RS;
__device__ __forceinline__ void fft_fwd12(cf (&v)[32], LAS f32x2* L, int tid) {
    dft_reg<32, false>(v);
    { float s, c; sincospif((float)tid * (1.0f / 8192.0f), &s, &c); cf w1 = {c, -s}; asm volatile("" : "+v"(w1.x), "+v"(w1.y)); cf w = w1;
#pragma unroll
      for (int k1 = 0; k1 < 32; ++k1) { cf x = v[brev(k1, 5)]; if (k1) { x = cmul(x, w); w = cmul(w, w1); } lst(L, k1 * RS + tid, x); } }
    __syncthreads();
    const int k1 = tid >> 4, m2 = tid & 15;
#pragma unroll
    for (int m1 = 0; m1 < 32; ++m1) v[m1] = lld(L, k1 * RS + 16 * m1 + m2);
    __syncthreads();
    dft_reg<32, false>(v);
    { float s, c; sincospif((float)m2 * (1.0f / 256.0f), &s, &c); cf w1 = {c, -s}; asm volatile("" : "+v"(w1.x), "+v"(w1.y)); cf w = w1;
#pragma unroll
      for (int j1 = 0; j1 < 32; ++j1) { cf x = v[brev(j1, 5)]; if (j1) { x = cmul(x, w); w = cmul(w, w1); } lst(L, k1 * RS + 33 * m2 + j1, x); } }
    __syncthreads();
}
__device__ __forceinline__ void fft_inv21(cf (&v)[32], LAS f32x2* L, int tid) {
    const int k1 = tid >> 4, m2 = tid & 15;
    { float s, c; sincospif((float)m2 * (1.0f / 256.0f), &s, &c); cf w1 = {c, -s}; asm volatile("" : "+v"(w1.x), "+v"(w1.y)); cf w = w1;
#pragma unroll
      for (int j1 = 0; j1 < 32; ++j1) { cf x = lld(L, k1 * RS + 33 * m2 + j1); if (j1) { x = cmulc(x, w); w = cmul(w, w1); } v[j1] = x; } }
    __syncthreads();
    dft_reg<32, true>(v);
#pragma unroll
    for (int m1 = 0; m1 < 32; ++m1) lst(L, k1 * RS + 16 * m1 + m2, v[brev(m1, 5)]);
    __syncthreads();
    { float s, c; sincospif((float)tid * (1.0f / 8192.0f), &s, &c); cf w1 = {c, -s}; asm volatile("" : "+v"(w1.x), "+v"(w1.y)); cf w = w1;
#pragma unroll
      for (int kk = 0; kk < 32; ++kk) { cf x = lld(L, kk * RS + tid); if (kk) { x = cmulc(x, w); w = cmul(w, w1); } v[kk] = x; } }
    dft_reg<32, true>(v);
}
}

namespace hm {
typedef f32x2 cf;
constexpr int ROWA = 40, ROWB = 24;
constexpr int PL_A = 512 * ROWA * 2, PL_B = 1024 * ROWB * 2;
__device__ __forceinline__ int crow(int r, int hi) { return (r & 3) + 8 * (r >> 2) + 4 * hi; }
struct CFrag { bf16x8 re, im, nim; };
__device__ __forceinline__ CFrag dft_frag(int n, int row, int k0, bool valid) {
    unsigned wr[4], wi[4], wn[4];
#pragma unroll
    for (int t = 0; t < 4; ++t) { float s0, c0, s1, c1; sincospif(-2.0f * (float)((row * (k0 + 2 * t)) % n) / (float)n, &s0, &c0); sincospif(-2.0f * (float)((row * (k0 + 2 * t + 1)) % n) / (float)n, &s1, &c1);
        if (!valid) { s0 = c0 = s1 = c1 = 0.f; }
        wr[t] = pk2(c0, c1); wi[t] = pk2(s0, s1); wn[t] = pk2(-s0, -s1); }
    CFrag f; f.re = __builtin_bit_cast(bf16x8, (u32x4){wr[0], wr[1], wr[2], wr[3]}); f.im = __builtin_bit_cast(bf16x8, (u32x4){wi[0], wi[1], wi[2], wi[3]}); f.nim = __builtin_bit_cast(bf16x8, (u32x4){wn[0], wn[1], wn[2], wn[3]});
    return f;
}
template <bool CONJ> __device__ __forceinline__ void cmfma(f32x16& dr, f32x16& di, const CFrag& a, bf16x8 br, bf16x8 bi) {
    dr = __builtin_amdgcn_mfma_f32_32x32x16_bf16(a.re, br, dr, 0, 0, 0); dr = __builtin_amdgcn_mfma_f32_32x32x16_bf16(CONJ ? a.im : a.nim, bi, dr, 0, 0, 0);
    di = __builtin_amdgcn_mfma_f32_32x32x16_bf16(a.re, bi, di, 0, 0, 0); di = __builtin_amdgcn_mfma_f32_32x32x16_bf16(CONJ ? a.nim : a.im, br, di, 0, 0, 0);
}
__device__ __forceinline__ cf cmul(cf a, cf b) { return a * b.xx + a.yx * (b.yy * (cf){-1.f, 1.f}); }
__device__ __forceinline__ cf cmulc(cf a, cf b) { return a * b.xx + a.yx * (b.yy * (cf){1.f, -1.f}); }
__device__ __forceinline__ bf16x8 pk4(const float (&P)[8]) {
    const unsigned a0 = cvt_pk_bf16(P[0], P[1]), a1 = cvt_pk_bf16(P[2], P[3]), b0 = cvt_pk_bf16(P[4], P[5]), b1 = cvt_pk_bf16(P[6], P[7]);
    auto r0 = __builtin_amdgcn_permlane32_swap(a0, b0, false, false); auto r1 = __builtin_amdgcn_permlane32_swap(a1, b1, false, false);
    return __builtin_bit_cast(bf16x8, (u32x4){r0[0], r1[0], r0[1], r1[1]});
}
constexpr int LDS_FTAB = 98304, LDS_TW1 = 110592, LDS_TW2 = 143360;
struct Consts { const LAS unsigned char* T; int lane;
    __device__ __forceinline__ CFrag get(int which) const { const LAS unsigned char* p = T + (which * 64 + lane) * 48; CFrag f; f.re = *(const LAS bf16x8*)p; f.im = *(const LAS bf16x8*)(p + 16); f.nim = *(const LAS bf16x8*)(p + 32); return f; } };
__device__ __forceinline__ cf tw1(const LAS unsigned* T1, int e) { const unsigned w = T1[e & 8191]; const float2 t = __half22float2(__builtin_bit_cast(__half2, w)); const float sg = (e & 8192) ? -1.0f : 1.0f; return (cf){t.x * sg, t.y * sg}; }
__device__ __forceinline__ void build_tw(LAS unsigned char* lds, int tid) {
    LAS unsigned* T1 = (LAS unsigned*)(lds + LDS_TW1); LAS f32x2* T2 = (LAS f32x2*)(lds + LDS_TW2);
#pragma unroll 4
    for (int i = 0; i < 16; ++i) { const int e = tid + 512 * i; float sn, cs; sincospif(-2.0f * (float)e * (1.0f / 16384.0f), &sn, &cs); T1[e] = __builtin_bit_cast(unsigned, __floats2half2_rn(cs, sn)); }
    { const int j1 = tid >> 4, m2 = tid & 15; float sn, cs; sincospif(-2.0f * (float)((j1 * m2) & 511) * (1.0f / 512.0f), &sn, &cs); T2[tid] = (f32x2){cs, sn}; }
}
__device__ __forceinline__ void build_ftab(LAS unsigned char* T, int tid) {
    if (tid < 64) { const int j = tid & 31, hi = tid >> 5;
        const CFrag f0 = dft_frag(32, j, 8 * hi, true), f1 = dft_frag(32, j, 16 + 8 * hi, true), g = dft_frag(16, j & 15, 8 * hi, j < 16);
        LAS bf16x8* p = (LAS bf16x8*)(T + tid * 48); p[0] = f0.re; p[1] = f0.im; p[2] = f0.nim;
        p = (LAS bf16x8*)(T + (64 + tid) * 48); p[0] = f1.re; p[1] = f1.im; p[2] = f1.nim;
        p = (LAS bf16x8*)(T + (128 + tid) * 48); p[0] = g.re; p[1] = g.im; p[2] = g.nim; }
    __syncthreads();
}
__device__ __forceinline__ void st2(LAS unsigned char* L, int plane_bytes, int idx, cf v) { const unsigned w = cvt_pk_bf16(v.x, v.y); ((LAS bf16_t*)L)[idx] = (bf16_t)(w & 0xffffu); ((LAS bf16_t*)(L + plane_bytes))[idx] = (bf16_t)(w >> 16); }
template <int NK> __device__ __forceinline__ void fwd12(const Consts& C, const bf16x8 (&Bre)[2][NK], const bf16x8 (&Bim)[2][NK], LAS unsigned char* L, const LAS unsigned* TW1, const LAS f32x2* TW2, int wave, int j, int hi) {
    asm volatile("" : "+v"(j), "+v"(hi));
#pragma unroll
    for (int tl = 0; tl < 2; ++tl) { const int n2 = 64 * wave + 32 * tl + j; f32x16 dr = {}, di = {};
        cmfma<false>(dr, di, C.get(0), Bre[tl][0], Bim[tl][0]); if constexpr (NK == 2) cmfma<false>(dr, di, C.get(1), Bre[tl][1], Bim[tl][1]);
#pragma unroll
        for (int r = 0; r < 16; ++r) { const int k1 = crow(r, hi); st2(L, PL_A, (k1 * 16 + (n2 & 15)) * ROWA + (n2 >> 4), cmul((cf){dr[r], di[r]}, tw1(TW1, k1 * n2))); } }
    __syncthreads();
    asm volatile("" : "+v"(j), "+v"(hi));
    bf16x8 yre[2][2], yim[2][2];
#pragma unroll
    for (int tl = 0; tl < 2; ++tl) { const int col = (4 * wave + 2 * tl + (j >> 4)) * 16 + (j & 15);
#pragma unroll
        for (int ks = 0; ks < 2; ++ks) { yre[tl][ks] = *(const LAS bf16x8*)(L + (col * ROWA + 16 * ks + 8 * hi) * 2); yim[tl][ks] = *(const LAS bf16x8*)(L + PL_A + (col * ROWA + 16 * ks + 8 * hi) * 2); } }
    __syncthreads();
    asm volatile("" : "+v"(j), "+v"(hi));
#pragma unroll
    for (int tl = 0; tl < 2; ++tl) { const int k1 = 4 * wave + 2 * tl + (j >> 4), m2 = j & 15; f32x16 dr = {}, di = {};
        cmfma<false>(dr, di, C.get(0), yre[tl][0], yim[tl][0]); cmfma<false>(dr, di, C.get(1), yre[tl][1], yim[tl][1]);
#pragma unroll
        for (int r = 0; r < 16; ++r) { const int j1 = crow(r, hi); st2(L, PL_B, (k1 * 32 + j1) * ROWB + m2, cmul((cf){dr[r], di[r]}, TW2[j1 * 16 + m2])); } }
    __syncthreads();
}
__device__ __forceinline__ void inv21(const Consts& C, cf (&y)[2][8], LAS unsigned char* L, const LAS unsigned* TW1, int wave, int j, int hi) {
    asm volatile("" : "+v"(j), "+v"(hi));
    bf16x8 yre[2][2], yim[2][2];
#pragma unroll
    for (int tl = 0; tl < 2; ++tl) { const int col = (4 * wave + 2 * tl + (j >> 4)) * 16 + (j & 15);
#pragma unroll
        for (int ks = 0; ks < 2; ++ks) { yre[tl][ks] = *(const LAS bf16x8*)(L + (col * ROWA + 16 * ks + 8 * hi) * 2); yim[tl][ks] = *(const LAS bf16x8*)(L + PL_A + (col * ROWA + 16 * ks + 8 * hi) * 2); } }
    __syncthreads();
    asm volatile("" : "+v"(j), "+v"(hi));
#pragma unroll
    for (int tl = 0; tl < 2; ++tl) { const int k1 = 4 * wave + 2 * tl + (j >> 4), m2 = j & 15; f32x16 dr = {}, di = {};
        cmfma<true>(dr, di, C.get(0), yre[tl][0], yim[tl][0]); cmfma<true>(dr, di, C.get(1), yre[tl][1], yim[tl][1]);
#pragma unroll
        for (int r = 0; r < 16; ++r) { const int n2 = 16 * crow(r, hi) + m2; st2(L, PL_A, n2 * ROWA + k1, cmulc((cf){dr[r], di[r]}, tw1(TW1, k1 * n2))); } }
    __syncthreads();
    asm volatile("" : "+v"(j), "+v"(hi));
#pragma unroll
    for (int tl = 0; tl < 2; ++tl) { const int n2 = 64 * wave + 32 * tl + j; f32x16 dr = {}, di = {};
#pragma unroll
        for (int ks = 0; ks < 2; ++ks) { const bf16x8 br = *(const LAS bf16x8*)(L + (n2 * ROWA + 16 * ks + 8 * hi) * 2), bi = *(const LAS bf16x8*)(L + PL_A + (n2 * ROWA + 16 * ks + 8 * hi) * 2);
            cmfma<true>(dr, di, C.get(ks), br, bi); }
#pragma unroll
        for (int r = 0; r < 8; ++r) y[tl][r] = (cf){dr[r], di[r]}; }
    __syncthreads();
}
}
constexpr size_t MiB = 1u << 20;
constexpr size_t WS_CTL = 0, CTL_ZERO_BYTES = 1 * MiB;
constexpr size_t WS_W1T = 1 * MiB;
constexpr size_t WS_W2T = 257 * MiB;
constexpr size_t WS_WIN_EV = 385 * MiB, WS_WOUT_EV = 409 * MiB, WS_WIN_OD = 417 * MiB, WS_WOUT_OD = 433 * MiB, WS_WG_OD = 441 * MiB;
constexpr size_t AR = 445 * MiB;
constexpr size_t A_XB = AR + 0 * MiB, A_UHT = AR + 64 * MiB, A_QB = AR + 160 * MiB, A_KB = AR + 192 * MiB, A_VB = AR + 224 * MiB, A_KTD = AR + 256 * MiB, A_KF = AR + 384 * MiB,
                 A_H3B = AR + 512 * MiB, A_W4T = AR + 514 * MiB, A_YHT = AR + 416 * MiB, A_OA = AR + 448 * MiB, A_YCAT = AR + 512 * MiB, A_XB2 = AR + 0 * MiB, A_R0 = AR + 64 * MiB, A_H1_0 = AR + 192 * MiB,
                 A_HB_0 = AR + 320 * MiB, A_HID_0 = AR + 384 * MiB, A_ROWL = AR + 424 * MiB, A_GATEW = AR + 428 * MiB, A_Y2_0 = AR + 0 * MiB, A_H2 = AR + 448 * MiB, A_HB2 = AR + 448 * MiB;
constexpr size_t A_GB = AR + 0 * MiB, A_XR = AR + 64 * MiB, A_XC = AR + 192 * MiB, A_LA = AR + 256 * MiB, A_BB = AR + 64 * MiB, A_CAR = AR + 384 * MiB, A_YG = AR + 192 * MiB, A_R1 = AR + 256 * MiB,
                 A_H1_1 = AR + 0 * MiB, A_HB8_1 = AR + 0 * MiB, A_XB8 = AR + 320 * MiB, WS_WIN_EV8 = AR + 544 * MiB, A_HB2_8 = AR + 512 * MiB, A_HB8_0 = AR + 192 * MiB, A_HB_1 = AR + 128 * MiB, A_HID_1 = AR + 192 * MiB, A_Y2_1 = AR + 256 * MiB;
constexpr size_t WS_END = AR + 576 * MiB;
constexpr size_t WS_TW1 = WS_CTL + 512 * 1024, WS_TW2 = WS_TW1 + 128 * 1024;
constexpr int CW_BAR = 4096, CW_CNT = 16384, CW_NORM = 24576;
constexpr int LDS_MISC = 153600, LDS_BYTES = 161792;
constexpr int NPHASE = 21;
#ifndef FP8_P1
#define FP8_P1 0
#endif
#ifndef FP8_P1B
#define FP8_P1B 0
#endif
#ifndef FP8_P1C
#define FP8_P1C 0
#endif
#ifndef FP8_P16
#define FP8_P16 1
#endif
#ifndef FP8_P5
#define FP8_P5 1
#endif
#ifndef FP8_P10
#define FP8_P10 1
#endif
#ifndef MOE_FP8_LAYERS
#define MOE_FP8_LAYERS 2
#endif

struct Args { const float* in[37]; float* out; unsigned char* ws; int ph_lo, ph_hi; };
typedef const __attribute__((address_space(4))) Args& KArgs;

template <bool F8> __device__ __forceinline__ void transpose_item(const float* W, int N, int k0, int n0, void* WTv, int ldk, int drow0, float scale, LAS float* scr, int lane) {
#pragma unroll 4
    for (int kk = 0; kk < 64; ++kk) scr[kk * 65 + lane] = W[(size_t)(k0 + kk) * N + n0 + lane];
    LDS_WAIT(); asm volatile("" ::: "memory");
    const int c = lane & 7;
#pragma unroll
    for (int jj = 0; jj < 8; ++jj) { const int n = (lane >> 3) + 8 * jj; const LAS float* s = scr + (8 * c) * 65 + n;
        if constexpr (F8) { u32x2 o; o.x = pg8::pk4_fp8(s[0 * 65] * scale, s[1 * 65] * scale, s[2 * 65] * scale, s[3 * 65] * scale); o.y = pg8::pk4_fp8(s[4 * 65] * scale, s[5 * 65] * scale, s[6 * 65] * scale, s[7 * 65] * scale);
            *(u32x2*)((unsigned char*)WTv + (size_t)(drow0 + n) * ldk + k0 + 8 * c) = o; }
        else { u32x4 o; o.x = pk2(s[0 * 65], s[1 * 65]); o.y = pk2(s[2 * 65], s[3 * 65]); o.z = pk2(s[4 * 65], s[5 * 65]); o.w = pk2(s[6 * 65], s[7 * 65]);
            *(u32x4*)((bf16_t*)WTv + (size_t)(drow0 + n) * ldk + k0 + 8 * c) = o; } }
    LDS_WAIT(); asm volatile("" ::: "memory");
}
__device__ __forceinline__ void phase_prologue(KArgs a, LAS unsigned char* lds) {
    const int tid = opaque_tid(), lane = tid & 63, wave = tid >> 6, G = gridDim.x;
    const int gw = blockIdx.x * 8 + wave, NGW = G * 8;
    unsigned char* ws = a.ws;
    LAS float* scr = (LAS float*)(lds + wave * 16640);
    constexpr int I_EVIN = 32 * 96, I_SQ = 32 * 32, I_ODIN = 32 * 64, I_MOE_GU = 64 * 256, I_MOE_D = 64 * 256, I_RG = 16 * 16, I_W4 = 64;
    constexpr int O1 = I_EVIN, O2 = O1 + I_SQ, O3 = O2 + I_ODIN, O4 = O3 + I_SQ, O5 = O4 + I_MOE_GU, O6 = O5 + I_MOE_GU, O7 = O6 + I_MOE_D, O8 = O7 + I_RG, O9 = O8 + I_RG, O10 = O9 + I_W4;
    for (int it = gw; it < O10; it += NGW) {
        if (it < O1) { const int kb = it / 96, nb = it % 96;
            const bool f8 = (nb * 64 < 3072) ? (FP8_P1C != 0) : (FP8_P1B != 0);
            if (f8) transpose_item<true>(a.in[1], EV_IN, kb * 64, nb * 64, ws + WS_WIN_EV8, DM, nb * 64, pg8::FP8_SW, scr, lane);
            else transpose_item<false>(a.in[1], EV_IN, kb * 64, nb * 64, ws + WS_WIN_EV, DM, nb * 64, 1.f, scr, lane); }
        else if (it < O2) { const int r = it - O1, kb = r / 32, nb = r % 32;
            if (FP8_P5) transpose_item<true>(a.in[18], DM, kb * 64, nb * 64, ws + WS_WOUT_EV, DM, nb * 64, pg8::FP8_SW, scr, lane);
            else transpose_item<false>(a.in[18], DM, kb * 64, nb * 64, ws + WS_WOUT_EV, DM, nb * 64, 1.f, scr, lane); }
        else if (it < O3) { const int r = it - O2, kb = r / 64, nb = r % 64;
            if (FP8_P10) transpose_item<true>(a.in[19], 2 * DM, kb * 64, nb * 64, ws + WS_WIN_OD, DM, nb * 64, pg8::FP8_SW, scr, lane);
            else transpose_item<false>(a.in[19], 2 * DM, kb * 64, nb * 64, ws + WS_WIN_OD, DM, nb * 64, 1.f, scr, lane); }
        else if (it < O4) { const int r = it - O3, kb = r / 32, nb = r % 32;
            if (FP8_P16) transpose_item<true>(a.in[27], DM, kb * 64, nb * 64, ws + WS_WOUT_OD, DM, nb * 64, pg8::FP8_SW, scr, lane);
            else transpose_item<false>(a.in[27], DM, kb * 64, nb * 64, ws + WS_WOUT_OD, DM, nb * 64, 1.f, scr, lane); }
        else if (it < O6) { const bool up = it >= O5; const int r = it - (up ? O5 : O4), le = r / 256, q = r % 256, kb = q / 8, nb = q % 8, n0 = nb * 64;
            const int drow = (n0 >> 7) * 256 + (n0 & 127) + (up ? 128 : 0); const float* src = (up ? a.in[35] : a.in[34]) + (size_t)le * DM * DFF;
            if (le < 32 * (2 - MOE_FP8_LAYERS)) transpose_item<false>(src, DFF, kb * 64, n0, (bf16_t*)(ws + WS_W1T) + (size_t)le * 1024 * DM, DM, drow, 1.f, scr, lane);
            else transpose_item<true>(src, DFF, kb * 64, n0, ws + WS_W1T + (size_t)(le >> 5) * 32 * 1024 * DM * 2 + (size_t)(le & 31) * 1024 * DM, DM, drow, pg8::FP8_SW, scr, lane); }
        else if (it < O7) { const int r = it - O6, le = r / 256, q = r % 256, kb = q / 32, nb = q % 32; const float* src = a.in[36] + (size_t)le * DFF * DM;
            if (le < 32 * (2 - MOE_FP8_LAYERS)) transpose_item<false>(src, DM, kb * 64, nb * 64, (bf16_t*)(ws + WS_W2T) + (size_t)le * DM * DFF, DFF, nb * 64, 1.f, scr, lane);
            else transpose_item<true>(src, DM, kb * 64, nb * 64, ws + WS_W2T + (size_t)(le >> 5) * 32 * DM * DFF * 2 + (size_t)(le & 31) * DM * DFF, DFF, nb * 64, pg8::FP8_SW, scr, lane); }
        else if (it < O9) { const bool wx = it >= O8; const int r = it - (wx ? O8 : O7), dn = r / 16, q = r % 16, kb = q / 4, nb = q % 4, n0 = nb * 64, dir = dn / 8, n = dn % 8;
            transpose_item<false>((wx ? a.in[24] : a.in[22]) + (size_t)dn * 65536, 256, kb * 64, n0, ws + WS_WG_OD, 256, (n * 4 + dir * 2 + (n0 >> 7)) * 256 + (n0 & 127) + (wx ? 128 : 0), 1.f, scr, lane); }
        else { const int nb = it - O9; transpose_item<false>(a.in[11], 4096, 0, nb * 64, ws + A_W4T, 128, nb * 64, 1.f, scr, lane); }
    }
    { const int gt = blockIdx.x * 512 + tid, NT = G * 512;
      for (int i = gt; i < 16384 + 512; i += NT) { float sn, cs;
          if (i < 16384) { const int k1 = i >> 9, n2 = i & 511; sincospif(-2.0f * (float)((k1 * n2) & 16383) * (1.0f / 16384.0f), &sn, &cs); ((float2*)(ws + WS_TW1))[i] = make_float2(cs, sn); }
          else { const int q = i - 16384, j1 = q >> 4, m2 = q & 15; sincospif(-2.0f * (float)((j1 * m2) & 511) * (1.0f / 512.0f), &sn, &cs); ((float2*)(ws + WS_TW2))[q] = make_float2(cs, sn); } }
      for (int i = gt; i < 4096 * 8; i += NT) { const int r = i >> 3, c = i & 7; *(u32x4*)((bf16_t*)(ws + A_W4T) + (size_t)r * 128 + 64 + c * 8) = (u32x4){0u, 0u, 0u, 0u}; }
      for (int i = gt; i < 8192 * 8; i += NT) { const int r = i >> 3, c = i & 7; *(u32x4*)((bf16_t*)(ws + A_H3B) + (size_t)r * 128 + 64 + c * 8) = (u32x4){0u, 0u, 0u, 0u}; }
      const f32x8* x8 = (const f32x8*)a.in[0]; u32x4* xb = (u32x4*)(ws + A_XB);
      u32x2* xb8 = (u32x2*)(ws + A_XB8);
      for (int i = gt; i < NTOK * DM / 8; i += NT) { const f32x8 v = x8[i]; u32x4 o; o.x = pk2(v[0], v[1]); o.y = pk2(v[2], v[3]); o.z = pk2(v[4], v[5]); o.w = pk2(v[6], v[7]); xb[i] = o;
          if (FP8_P1) { u32x2 q; q.x = pg8::pk4_fp8(v[0], v[1], v[2], v[3]); q.y = pg8::pk4_fp8(v[4], v[5], v[6], v[7]); xb8[i] = q; } } }
    { const float* w1 = a.in[4]; const float* b1 = a.in[5]; const float* w2 = a.in[6]; const float* b2 = a.in[7]; const float* w3 = a.in[8]; const float* b3 = a.in[9]; const float* fr = a.in[10];
      const float frq = fr[lane];
      for (int t = gw; t < SEQ; t += NGW) {
          float z;
          { const float tl = (float)t * (1.0f / 8191.0f);
            if (lane == 0) z = tl;
            else { const int j = (lane - 1) & 15; const float band = 1e-4f + (float)j * ((15.0f - 1e-4f) / 15.0f);
                   const float ang = (6.283185307179586f * (float)t * (1.0f / 8192.0f)) * band; float sn, cs; sincosf(ang, &sn, &cs); z = (lane <= 16) ? cs : -sn; } }
          float acc = b1[lane];
#pragma unroll
          for (int i = 0; i < 33; ++i) acc += __shfl(z, i) * w1[i * 64 + lane];
          float h = sinf(frq * acc);
          acc = b2[lane];
#pragma unroll 16
          for (int i = 0; i < 64; ++i) acc += __shfl(h, i) * w2[i * 64 + lane];
          h = sinf(frq * acc);
          acc = b3[lane];
#pragma unroll 16
          for (int i = 0; i < 64; ++i) acc += __shfl(h, i) * w3[i * 64 + lane];
          h = sinf(frq * acc);
          ((bf16_t*)(ws + A_H3B))[(size_t)t * 128 + lane] = (bf16_t)f2bf(h);
      } }
}

__device__ __forceinline__ void filter_unit(KArgs a, LAS unsigned char* lds, int u, int tid) {
    const int lane = tid & 63, wave = tid >> 6;
    LAS f32x2* L = (LAS f32x2*)lds; LAS float* red = (LAS float*)(lds + LDS_MISC + 1024);
    const bf16_t* KTD = (const bf16_t*)(a.ws + A_KTD); __half2* KF = (__half2*)(a.ws + A_KF);
    {
        int tl = tid; asm volatile("" : "+v"(tl));
        const bf16_t* rowF = KTD + (size_t)u * 8192; const bf16_t* rowB = KTD + (size_t)(2048 + u) * 8192;
        hy::cf v[32]; float ss = 0.f;
#pragma unroll
        for (int n1 = 0; n1 < 32; ++n1) { const int p = tl + 512 * n1; float val;
            if (n1 < 16) val = bf2f(rowF[p]); else if (p == 8192) val = 0.f; else val = bf2f(rowB[16384 - p]);
            v[n1] = (hy::cf){val, 0.f}; ss += val * val; }
        ss = wave_sum(ss); if (lane == 0) red[wave] = ss; __syncthreads();
        float tot = 0.f;
#pragma unroll
        for (int w = 0; w < 8; ++w) tot += red[w];
        const float scale = rsqrtf(tot), skp = a.in[12][u];
        hy::fft_fwd12(v, L, tl);
#pragma unroll
        for (int bf = 0; bf < 2; ++bf) { const int idx = bf * 512 + tl, k1 = idx >> 5, j1 = idx & 31; hy::cf w[16];
#pragma unroll
            for (int m2 = 0; m2 < 16; ++m2) w[m2] = hy::lld(L, k1 * hy::RS + 33 * m2 + j1);
            hy::dft_reg<16, false>(w);
#pragma unroll
            for (int j2 = 0; j2 < 16; ++j2) { const hy::cf x = w[hy::brev(j2, 4)]; KF[((size_t)((blockIdx.x * 2 + (u >> 10)) * 2 + bf) * 16 + j2) * 512 + tl] = __floats2half2_rn(x.x * scale + skp, x.y * scale); } }
        __syncthreads();
    }
}
__device__ __forceinline__ float hyconv(const bf16_t* row, int t, float w0, float w1, float w2, float bias) {
    const bf16_t* p = row + t;
    float xm = bf2f(p[-1]), x0 = bf2f(p[0]), xp = bf2f(p[1]);
    xm = t > 0 ? xm : 0.f; xp = t < SEQ - 1 ? xp : 0.f;
    return w0 * xm + w1 * x0 + w2 * xp + bias;
}
__device__ __forceinline__ bf16x8 pack8(const float (&v)[8]) { return __builtin_bit_cast(bf16x8, (u32x4){cvt_pk_bf16(v[0], v[1]), cvt_pk_bf16(v[2], v[3]), cvt_pk_bf16(v[4], v[5]), cvt_pk_bf16(v[6], v[7])}); }
__device__ __forceinline__ void phase_hyena_mixer(KArgs a, LAS unsigned char* lds) {
    const int tid = opaque_tid(), lane = tid & 63, wave = __builtin_amdgcn_readfirstlane(tid >> 6), j = lane & 31, hi = lane >> 5, G = gridDim.x;
    LAS unsigned char* L = lds; LAS float* red = (LAS float*)(lds + LDS_MISC + 1024);
    const bf16_t* UHT = (const bf16_t*)(a.ws + A_UHT); const bf16_t* KTD = (const bf16_t*)(a.ws + A_KTD); bf16_t* YHT = (bf16_t*)(a.ws + A_YHT);
    __half2* KF = (__half2*)(a.ws + A_KF) + (size_t)blockIdx.x * (2 * 32 * 8 * 64);
    const LAS unsigned* TW1 = (const LAS unsigned*)(lds + hm::LDS_TW1); const LAS f32x2* TW2 = (const LAS f32x2*)(lds + hm::LDS_TW2);
    const float* cw = a.in[2]; const float* cb = a.in[3];
    hm::build_tw(lds, tid); hm::build_ftab(lds + hm::LDS_FTAB, tid); const hm::Consts C{lds + hm::LDS_FTAB, lane};
    for (int c = blockIdx.x; c < HY_CH; c += G) {
        int jl = j, hil = hi, wl = wave; asm volatile("" : "+v"(jl), "+v"(hil), "+s"(wl));
#ifndef HM_NOFILTER
#pragma unroll 1
        for (int o = 0; o < 2; ++o) { const int u = o * 1024 + c;
            const bf16_t* rowF = KTD + (size_t)u * 8192; const bf16_t* rowB = KTD + (size_t)(2048 + u) * 8192;
            bf16x8 Bre[2][2], Bim[2][2]; float ss = 0.f;
#pragma unroll
            for (int tl = 0; tl < 2; ++tl)
#pragma unroll
                for (int ks = 0; ks < 2; ++ks) { float v[8];
#pragma unroll
                    for (int t = 0; t < 8; ++t) { const int p = 64 * wl + 32 * tl + jl + 512 * (16 * ks + 8 * hil + t);
                        if (ks == 0) v[t] = bf2f(rowF[p]); else { const float x = bf2f(rowB[16384 - p]); v[t] = (p == 8192) ? 0.f : x; }
                        ss += v[t] * v[t]; }
                    Bre[tl][ks] = pack8(v); Bim[tl][ks] = (bf16x8){0, 0, 0, 0, 0, 0, 0, 0}; asm volatile("" ::: "memory"); }
            ss = wave_sum(ss); if (lane == 0) red[wave] = ss; __syncthreads();
            float tot = 0.f;
#pragma unroll
            for (int w = 0; w < 8; ++w) tot += red[w];
            const float scale = rsqrtf(tot), skp = a.in[12][u];
            hm::fwd12<2>(C, Bre, Bim, L, TW1, TW2, wl, jl, hil);
#pragma unroll
            for (int q = 0; q < 4; ++q) { const int t3 = 4 * wl + q, colp = 32 * t3 + jl; f32x16 dr = {}, di = {};
                hm::cmfma<false>(dr, di, C.get(2), *(const LAS bf16x8*)(L + (colp * hm::ROWB + 8 * hil) * 2), *(const LAS bf16x8*)(L + hm::PL_B + (colp * hm::ROWB + 8 * hil) * 2));
#pragma unroll
                for (int r = 0; r < 8; ++r) KF[((o * 32 + t3) * 8 + r) * 64 + lane] = __floats2half2_rn(dr[r] * scale + skp, di[r] * scale); asm volatile("" ::: "memory"); }
            __syncthreads();
        }
#endif
        VM_WAIT();
#ifndef HM_NOMIXER
        bf16x8 Zre[2][1], Zim[2][1];
        { const bf16_t* r0 = UHT + (size_t)c * NTOK; const float w0 = cw[c], w1 = cw[3072 + c], w2 = cw[6144 + c], bb = cb[c];
#pragma unroll
          for (int tl = 0; tl < 2; ++tl) { float v0[8], v1[8];
#pragma unroll
              for (int t = 0; t < 8; ++t) { const int tt = 64 * wl + 32 * tl + jl + 512 * (8 * hil + t); v0[t] = hyconv(r0, tt, w0, w1, w2, bb); v1[t] = hyconv(r0 + SEQ, tt, w0, w1, w2, bb); }
              Zre[tl][0] = pack8(v0); Zim[tl][0] = pack8(v1); asm volatile("" ::: "memory"); } }
#pragma unroll 1
        for (int o = 0; o < 2; ++o) {
            hm::fwd12<1>(C, Zre, Zim, L, TW1, TW2, wl, jl, hil);
            int j3 = jl, h3 = hil; asm volatile("" : "+v"(j3), "+v"(h3));
            bf16x8 zre[4], zim[4];
#pragma unroll
            for (int q = 0; q < 4; ++q) { const int colp = 32 * (4 * wl + q) + j3; zre[q] = *(const LAS bf16x8*)(L + (colp * hm::ROWB + 8 * h3) * 2); zim[q] = *(const LAS bf16x8*)(L + hm::PL_B + (colp * hm::ROWB + 8 * h3) * 2); }
            __syncthreads();
            asm volatile("" : "+v"(j3), "+v"(h3));
#pragma unroll
            for (int q = 0; q < 4; ++q) { const int t3 = 4 * wl + q; f32x16 dr = {}, di = {};
                hm::cmfma<false>(dr, di, C.get(2), zre[q], zim[q]);
                float xr[8], xi[8];
#pragma unroll
                for (int r = 0; r < 8; ++r) { const float2 kf = __half22float2(KF[((o * 32 + t3) * 8 + r) * 64 + lane]); const hm::cf x = hm::cmul((hm::cf){dr[r], di[r]}, (hm::cf){kf.x, kf.y}); xr[r] = x.x; xi[r] = x.y; }
                const bf16x8 br = hm::pk4(xr), bi = hm::pk4(xi);
                f32x16 er = {}, ei = {};
                hm::cmfma<true>(er, ei, C.get(2), br, bi);
#pragma unroll
                for (int r = 0; r < 8; ++r) { const int m2 = hm::crow(r, h3); hm::st2(L, hm::PL_A, (t3 * 16 + m2) * hm::ROWA + j3, hm::cmulc((hm::cf){er[r], ei[r]}, TW2[j3 * 16 + m2])); } asm volatile("" ::: "memory"); }
            __syncthreads();
            hm::cf y[2][8];
            hm::inv21(C, y, L, TW1, wl, jl, hil);
            const int gch = (o + 1) * 1024 + c; const bf16_t* rg = UHT + (size_t)gch * NTOK;
            const float w0 = cw[gch], w1 = cw[3072 + gch], w2 = cw[6144 + gch], bb = cb[gch];
            int jg = jl, hg = hil; asm volatile("" : "+v"(jg), "+v"(hg));
#pragma unroll
            for (int tl = 0; tl < 2; ++tl) { float z0[8], z1[8];
#pragma unroll
                for (int r = 0; r < 8; ++r) { const int tt = 64 * wl + 32 * tl + jg + 512 * hm::crow(r, hg);
                    z0[r] = hyconv(rg, tt, w0, w1, w2, bb) * y[tl][r].x * (1.0f / 16384.0f); z1[r] = hyconv(rg + SEQ, tt, w0, w1, w2, bb) * y[tl][r].y * (1.0f / 16384.0f); }
                asm volatile("" ::: "memory");
                if (o == 0) { Zre[tl][0] = hm::pk4(z0); Zim[tl][0] = hm::pk4(z1); }
                else { bf16_t* yo = YHT + (size_t)c * NTOK;
#pragma unroll
                    for (int r = 0; r < 8; ++r) { const int tt = 64 * wl + 32 * tl + jg + 512 * hm::crow(r, hg); yo[tt] = (bf16_t)f2bf(z0[r]); yo[SEQ + tt] = (bf16_t)f2bf(z1[r]); } } }
        }
#endif
    }
    __syncthreads();
}
__device__ __forceinline__ void phase_qknorm(KArgs a, LAS unsigned char* lds) {
    const int tid = opaque_tid(), lane = tid & 63, wave = tid >> 6, gw = blockIdx.x * 8 + wave, NGW = gridDim.x * 8;
    LAS unsigned* red = (LAS unsigned*)(lds + LDS_MISC + 1536);
    unsigned* ctl = (unsigned*)(a.ws + WS_CTL);
    if (tid < 64) red[tid] = 0u;
    __syncthreads();
    for (int which = 0; which < 2; ++which) { const bf16_t* P = (const bf16_t*)(a.ws + (which ? A_KB : A_QB));
        for (int b = 0; b < 2; ++b) { float mx = 0.f;
            for (int row = gw; row < SEQ; row += NGW) { const bf16_t* p = P + ((size_t)b * SEQ + row) * 1024 + lane * 16;
                const u32x4 w0 = *(const u32x4*)p, w1 = *(const u32x4*)(p + 8); const unsigned ww[8] = {w0.x, w0.y, w0.z, w0.w, w1.x, w1.y, w1.z, w1.w};
                float ss = 0.f;
#pragma unroll
                for (int i = 0; i < 8; ++i) { const float x = bflo(ww[i]), y = bfhi(ww[i]); ss += x * x + y * y; }
                ss += __shfl_xor(ss, 1); ss += __shfl_xor(ss, 2); mx = fmaxf(mx, ss); }
            if ((lane & 3) == 0) atomicMax((unsigned*)&red[which * 32 + b * 16 + (lane >> 2)], __float_as_uint(mx)); } }
    __syncthreads();
    if (tid < 64) atomicMax(ctl + CW_NORM + tid, red[tid]);
}
__device__ __forceinline__ void phase_attention(KArgs a, LAS unsigned char* lds) {
    const int G = gridDim.x, bx = blockIdx.x;
    const bf16_t* QB = (const bf16_t*)(a.ws + A_QB); const bf16_t* KB = (const bf16_t*)(a.ws + A_KB); const bf16_t* VB = (const bf16_t*)(a.ws + A_VB); bf16_t* OA = (bf16_t*)(a.ws + A_OA);
    const unsigned* nrm = (const unsigned*)(a.ws + WS_CTL) + CW_NORM;
    for (int i = 0;; ++i) {
        int bhc, qb;
        if (G == 256) { if (i >= 4) break;
            const int x = bx & 7, combo = x & 3, hh = (x < 4) ? ((i == 0) ? 7 : (i == 1) ? 5 : (i == 2) ? 1 : 0) : ((i == 0) ? 6 : (i == 1) ? 4 : (i == 2) ? 3 : 2); bhc = (combo >> 1) * 16 + hh * 2 + (combo & 1); qb = bx >> 3; }
        else { const int Lu = i * G + bx; if (Lu >= 1024) break; bhc = Lu >> 5; qb = Lu & 31; }
        const int b = bhc >> 4, h = (bhc >> 1) & 7, cm = bhc & 1;
        const size_t rowq = (size_t)b * SEQ + (size_t)qb * 256;
        const float sl2 = exp2f(-(float)(h + 1)) * 1.4426950408889634f;
        const float qk = sqrtf(__uint_as_float(nrm[bhc]) * __uint_as_float(nrm[32 + bhc]));
        const float Wk = (2.0f * qk + 38.0f) / sl2, q0f = (float)(qb * 256);
        int t_lo = (int)fmaxf(floorf((q0f - Wk - 63.0f) * (1.0f / 64.0f)), 0.0f), t_hi = (int)fminf(ceilf((q0f + 255.0f + Wk) * (1.0f / 64.0f)), 127.0f);
        if (((t_hi - t_lo + 1) & 1) != 0) { if (t_hi < 127) ++t_hi; else --t_lo; }
        att::attn_unit(QB + rowq * 1024 + h * 128 + cm * 64, KB + (size_t)b * SEQ * 1024 + h * 128 + cm * 64, VB + (size_t)b * SEQ * 1024 + h * 128,
                       OA + (size_t)cm * NTOK * 1024 + rowq * 1024 + h * 128, qb * 256, t_lo, t_hi - t_lo + 1, sl2, (char*)lds);
    }
}
__device__ __forceinline__ void phase_concat(KArgs a, LAS unsigned char* lds) {
    const int tid = opaque_tid(), lane = tid & 63, wave = tid >> 6, G = gridDim.x;
    const bf16_t* YHT = (const bf16_t*)(a.ws + A_YHT); const bf16_t* OA0 = (const bf16_t*)(a.ws + A_OA); const bf16_t* OA1 = OA0 + (size_t)NTOK * 1024; bf16_t* YC = (bf16_t*)(a.ws + A_YCAT);
    LAS bf16_t* T = (LAS bf16_t*)lds;
    const float lambda_init = 0.2f;
    const float lam = __expf(wave_sum(a.in[13][lane] * a.in[14][lane])) - __expf(wave_sum(a.in[15][lane] * a.in[16][lane])) + lambda_init;
    float gl[16];
#pragma unroll
    for (int i = 0; i < 16; ++i) gl[i] = a.in[17][(lane & 7) * 16 + i] * (1.0f - lambda_init);
    for (int it = blockIdx.x; it < NTOK / 64; it += G) {
        const int tok0 = it * 64;
#pragma unroll 4
        for (int k = 0; k < 16; ++k) { const int idx = tid + 512 * k, c = idx >> 3, ch = idx & 7;
            const u32x4 w = *(const u32x4*)(YHT + (size_t)c * NTOK + tok0 + ch * 8);
            LAS bf16_t* d = T + (ch * 8) * 1026 + c;
            d[0 * 1026] = (bf16_t)(w.x & 0xffff); d[1 * 1026] = (bf16_t)(w.x >> 16); d[2 * 1026] = (bf16_t)(w.y & 0xffff); d[3 * 1026] = (bf16_t)(w.y >> 16);
            d[4 * 1026] = (bf16_t)(w.z & 0xffff); d[5 * 1026] = (bf16_t)(w.z >> 16); d[6 * 1026] = (bf16_t)(w.w & 0xffff); d[7 * 1026] = (bf16_t)(w.w >> 16); }
        __syncthreads();
#pragma unroll 4
        for (int k = 0; k < 16; ++k) { const int idx = tid + 512 * k, tl = idx >> 7, c8 = idx & 127;
            const LAS unsigned* s = (const LAS unsigned*)(T + tl * 1026 + c8 * 8);
            u32x4 w; w.x = s[0]; w.y = s[1]; w.z = s[2]; w.w = s[3];
            if (FP8_P5) { u32x2 q; q.x = pg8::pk4_fp8(bflo(w.x), bfhi(w.x), bflo(w.y), bfhi(w.y)); q.y = pg8::pk4_fp8(bflo(w.z), bfhi(w.z), bflo(w.w), bfhi(w.w)); *(u32x2*)((unsigned char*)YC + (size_t)(tok0 + tl) * DM + c8 * 8) = q; }
            else *(u32x4*)(YC + (size_t)(tok0 + tl) * DM + c8 * 8) = w; }
        for (int rr = 0; rr < 8; ++rr) { const size_t tok = (size_t)tok0 + wave * 8 + rr;
            const u32x4 p0 = *(const u32x4*)(OA0 + tok * 1024 + lane * 16), p1 = *(const u32x4*)(OA0 + tok * 1024 + lane * 16 + 8);
            const u32x4 q0 = *(const u32x4*)(OA1 + tok * 1024 + lane * 16), q1 = *(const u32x4*)(OA1 + tok * 1024 + lane * 16 + 8);
            const unsigned pw[8] = {p0.x, p0.y, p0.z, p0.w, p1.x, p1.y, p1.z, p1.w}, qw[8] = {q0.x, q0.y, q0.z, q0.w, q1.x, q1.y, q1.z, q1.w};
            float o[16]; float ss = 0.f;
#pragma unroll
            for (int i = 0; i < 8; ++i) { o[2 * i] = bflo(pw[i]) - lam * bflo(qw[i]); o[2 * i + 1] = bfhi(pw[i]) - lam * bfhi(qw[i]); ss += o[2 * i] * o[2 * i] + o[2 * i + 1] * o[2 * i + 1]; }
            ss += __shfl_xor(ss, 1); ss += __shfl_xor(ss, 2); ss += __shfl_xor(ss, 4);
            const float rs = rsqrtf(ss * (1.0f / 128.0f) + LN_EPS);
            u32x4 w0, w1;
            w0.x = pk2(o[0] * rs * gl[0], o[1] * rs * gl[1]); w0.y = pk2(o[2] * rs * gl[2], o[3] * rs * gl[3]); w0.z = pk2(o[4] * rs * gl[4], o[5] * rs * gl[5]); w0.w = pk2(o[6] * rs * gl[6], o[7] * rs * gl[7]);
            w1.x = pk2(o[8] * rs * gl[8], o[9] * rs * gl[9]); w1.y = pk2(o[10] * rs * gl[10], o[11] * rs * gl[11]); w1.z = pk2(o[12] * rs * gl[12], o[13] * rs * gl[13]); w1.w = pk2(o[14] * rs * gl[14], o[15] * rs * gl[15]);
            if (FP8_P5) { u32x4 q; q.x = pg8::pk4_fp8(o[0] * rs * gl[0], o[1] * rs * gl[1], o[2] * rs * gl[2], o[3] * rs * gl[3]); q.y = pg8::pk4_fp8(o[4] * rs * gl[4], o[5] * rs * gl[5], o[6] * rs * gl[6], o[7] * rs * gl[7]);
                q.z = pg8::pk4_fp8(o[8] * rs * gl[8], o[9] * rs * gl[9], o[10] * rs * gl[10], o[11] * rs * gl[11]); q.w = pg8::pk4_fp8(o[12] * rs * gl[12], o[13] * rs * gl[13], o[14] * rs * gl[14], o[15] * rs * gl[15]);
                *(u32x4*)((unsigned char*)YC + tok * DM + 1024 + lane * 16) = q; }
            else { *(u32x4*)(YC + tok * DM + 1024 + lane * 16) = w0; *(u32x4*)(YC + tok * DM + 1024 + lane * 16 + 8) = w1; } }
        __syncthreads();
    }
}
__device__ __forceinline__ void ln_row(f32x4 (&v)[8], const float* g, const float* b, int lane, float& mu, float& rs) {
    float s = 0.f;
#pragma unroll
    for (int j = 0; j < 8; ++j) s += (v[j][0] + v[j][1]) + (v[j][2] + v[j][3]);
    const float mean = wave_sum(s) * (1.0f / DM); float s2 = 0.f;
#pragma unroll
    for (int j = 0; j < 8; ++j) { v[j] = v[j] - mean; s2 += (v[j][0] * v[j][0] + v[j][1] * v[j][1]) + (v[j][2] * v[j][2] + v[j][3] * v[j][3]); }
    const float rstd = rsqrtf(wave_sum(s2) * (1.0f / DM) + LN_EPS); mu = mean; rs = rstd;
#pragma unroll
    for (int j = 0; j < 8; ++j) { const f32x4 gg = *(const f32x4*)(g + 4 * (lane + 64 * j)), bb = *(const f32x4*)(b + 4 * (lane + 64 * j)); v[j] = v[j] * rstd * gg + bb; }
}
__device__ __forceinline__ void phase_ln_router(KArgs a, LAS unsigned char* lds, const bf16_t* R, const float* g, const float* b, bf16_t* HB, unsigned char* HB8, unsigned* cnt, int* rowlist, float* gatew) {
    const int tid = opaque_tid(), lane = tid & 63, wave = tid >> 6, G = gridDim.x;
    const float* rw = a.in[32]; const float* rb = a.in[33];
    LAS float* part = (LAS float*)lds;
    LAS int* hist = (LAS int*)(lds + 40960); LAS int* base = hist + 32; LAS float* stats = (LAS float*)(lds + 40960 + 512);
    for (int it = blockIdx.x; it < NTOK / 32; it += G) {
        const int tok0 = it * 32;
        for (int rr = 0; rr < 4; ++rr) { const size_t row = (size_t)tok0 + wave * 4 + rr; f32x4 v[8]; float mu, rs;
#pragma unroll
            for (int j = 0; j < 8; ++j) { const u32x2 w = *(const u32x2*)(R + row * DM + 4 * (lane + 64 * j)); v[j] = (f32x4){bflo(w.x), bfhi(w.x), bflo(w.y), bfhi(w.y)}; }
            ln_row(v, g, b, lane, mu, rs);
            if (lane == 0) { stats[(wave * 4 + rr) * 2] = mu; stats[(wave * 4 + rr) * 2 + 1] = rs; }
#pragma unroll
            for (int j = 0; j < 8; ++j) { u32x2 w; w.x = pk2(v[j][0], v[j][1]); w.y = pk2(v[j][2], v[j][3]); *(u32x2*)(HB + row * DM + 4 * (lane + 64 * j)) = w;
                if (HB8) *(unsigned*)(HB8 + row * DM + 4 * (lane + 64 * j)) = pg8::pk4_fp8(v[j][0], v[j][1], v[j][2], v[j][3]); } }
        if (tid < 32) hist[tid] = 0;
        __syncthreads();
        { const int i = lane & 31, kk = lane >> 5; f32x16 acc = {};
          const float mu = stats[i * 2], rs = stats[i * 2 + 1];
          const bf16_t* rrow = R + (size_t)(tok0 + i) * DM + wave * 256 + 4 * kk; const float* gp = g + wave * 256 + 4 * kk; const float* bp = b + wave * 256 + 4 * kk;
          const float* rwp = rw + (size_t)(wave * 256 + 4 * kk) * NEXP + i;
#pragma unroll 4
          for (int s = 0; s < 32; ++s) { const u32x2 rw2 = *(const u32x2*)(rrow + 8 * s); const f32x4 hv = ((f32x4){bflo(rw2.x), bfhi(rw2.x), bflo(rw2.y), bfhi(rw2.y)} - mu) * rs * *(const f32x4*)(gp + 8 * s) + *(const f32x4*)(bp + 8 * s);
#pragma unroll
              for (int j = 0; j < 4; ++j) acc = __builtin_amdgcn_mfma_f32_32x32x2f32(rwp[(size_t)(8 * s + j) * NEXP], hv[j], acc, 0, 0, 0); }
#pragma unroll
          for (int r = 0; r < 16; ++r) part[(wave * 32 + i) * 33 + (r & 3) + 8 * (r >> 2) + 4 * kk] = acc[r]; }
        __syncthreads();
        int e1 = 0, e2 = 0, r1 = 0, r2 = 0; float g1 = 0.f, g2 = 0.f;
        if (tid < 32) {
            float bestg = -1e30f;
#pragma unroll
            for (int gi = 0; gi < 4; ++gi) { float m1 = -1e30f, m2 = -1e30f, s1 = 0.f, s2 = 0.f; int i1 = 0, i2 = 0;
#pragma unroll
                for (int j = 0; j < 8; ++j) { const int e = gi * 8 + j; float lg = 0.f;
#pragma unroll
                    for (int w = 0; w < 8; ++w) lg += part[(w * 32 + tid) * 33 + e];
                    const float sg = 1.0f / (1.0f + expf(-lg)), sl = sg + rb[e];
                    if (sl > m1) { m2 = m1; i2 = i1; s2 = s1; m1 = sl; i1 = j; s1 = sg; } else if (sl > m2) { m2 = sl; i2 = j; s2 = sg; } }
                const float gs = m1 + m2;
                if (gs > bestg) { bestg = gs; e1 = gi * 8 + i1; e2 = gi * 8 + i2; g1 = s1; g2 = s2; } }
            const float inv = 1.0f / (g1 + g2); g1 *= inv; g2 *= inv;
            r1 = atomicAdd((int*)&hist[e1], 1); r2 = atomicAdd((int*)&hist[e2], 1);
        }
        __syncthreads();
        if (tid < 32) { const int hc = hist[tid]; base[tid] = hc ? (int)__hip_atomic_fetch_add(cnt + tid * 64, (unsigned)hc, __ATOMIC_RELAXED, __HIP_MEMORY_SCOPE_AGENT) : 0; }
        __syncthreads();
        if (tid < 32) { const int a0 = (tok0 + tid) * 2;
            rowlist[(size_t)e1 * ECAP + base[e1] + r1] = a0; gatew[a0] = g1;
            rowlist[(size_t)e2 * ECAP + base[e2] + r2] = a0 + 1; gatew[a0 + 1] = g2; }
        __syncthreads();
    }
}
__device__ __forceinline__ void phase_ln2(const bf16_t* HB, const bf16_t* Y2, const float* g, const float* b, float* OUT, bf16_t* OB, unsigned char* OB8) {
    const int tid = opaque_tid(), lane = tid & 63, wave = tid >> 6;
    for (int row = blockIdx.x * 8 + wave; row < NTOK; row += gridDim.x * 8) { f32x4 v[8]; float mu, rs;
#pragma unroll
        for (int j = 0; j < 8; ++j) { const int c = 4 * (lane + 64 * j); const u32x2 h = *(const u32x2*)(HB + (size_t)row * DM + c);
            const u32x2 y0 = *(const u32x2*)(Y2 + (size_t)(2 * row) * DM + c), y1 = *(const u32x2*)(Y2 + (size_t)(2 * row + 1) * DM + c);
            v[j] = (f32x4){bflo(h.x), bfhi(h.x), bflo(h.y), bfhi(h.y)} * DN_ALPHA + (f32x4){bflo(y0.x) + bflo(y1.x), bfhi(y0.x) + bfhi(y1.x), bflo(y0.y) + bflo(y1.y), bfhi(y0.y) + bfhi(y1.y)}; }
        ln_row(v, g, b, lane, mu, rs);
#pragma unroll
        for (int j = 0; j < 8; ++j) { const int c = 4 * (lane + 64 * j); if (OUT) *(f32x4*)(OUT + (size_t)row * DM + c) = v[j];
            if (OB) { u32x2 w; w.x = pk2(v[j][0], v[j][1]); w.y = pk2(v[j][2], v[j][3]); *(u32x2*)(OB + (size_t)row * DM + c) = w; }
            if (OB8) *(unsigned*)(OB8 + (size_t)row * DM + c) = pg8::pk4_fp8(v[j][0], v[j][1], v[j][2], v[j][3]); }
    }
}
__device__ __forceinline__ void moe_table(LAS int* tab, const unsigned* cnt) {
    __syncthreads();
    const int tid = opaque_tid();
    if (tid < 32) tab[64 + tid] = (int)cnt[tid * 64];
    __syncthreads();
    if (tid == 0) { int acc = 0; for (int e = 0; e < 32; ++e) { tab[e] = acc; acc += (tab[64 + e] + 255) >> 8; } tab[32] = acc; }
    __syncthreads();
}
__device__ __forceinline__ void phase_conv4(KArgs a) {
    const bf16_t* XR = (const bf16_t*)(a.ws + A_XR); bf16_t* XC = (bf16_t*)(a.ws + A_XC); const float* cw = a.in[20]; const float* cb = a.in[21];
    const int NT = gridDim.x * 512;
    for (int it = blockIdx.x * 512 + opaque_tid(); it < NTOK * 256; it += NT) { const int tok = it >> 8, ch = (it & 255) * 8, t = tok & (SEQ - 1);
        float acc[8];
#pragma unroll
        for (int i = 0; i < 8; ++i) acc[i] = cb[ch + i];
#pragma unroll
        for (int j = 0; j < 4; ++j) { const int tt = t + j - 2;
            if (tt >= 0 && tt < SEQ) { const u32x4 w = *(const u32x4*)(XR + (size_t)(tok + j - 2) * DM + ch); const unsigned ww[4] = {w.x, w.y, w.z, w.w};
#pragma unroll
                for (int i = 0; i < 4; ++i) { acc[2 * i] += cw[j * DM + ch + 2 * i] * bflo(ww[i]); acc[2 * i + 1] += cw[j * DM + ch + 2 * i + 1] * bfhi(ww[i]); } } }
        u32x4 o; o.x = pk2(acc[0], acc[1]); o.y = pk2(acc[2], acc[3]); o.z = pk2(acc[4], acc[5]); o.w = pk2(acc[6], acc[7]);
        *(u32x4*)(XC + (size_t)tok * DM + ch) = o; }
}
constexpr size_t CAR_ELEMS = (size_t)2 * 2 * 256 * DM;
constexpr float RG_ILA = 1.0f / pg8::RG_SLA, RG_IB = 1.0f / pg8::RG_SB;
__device__ __forceinline__ void phase_scan1(KArgs a) {
    const bf16_t* LA = (const bf16_t*)(a.ws + A_LA); const bf16_t* BB = (const bf16_t*)(a.ws + A_BB); float* CARA = (float*)(a.ws + A_CAR); float* CARB = CARA + CAR_ELEMS;
    const int NT = gridDim.x * 512;
    for (int it = blockIdx.x * 512 + opaque_tid(); it < 2 * 2 * 256 * 512; it += NT) { const int ch = (it & 511) * 4, chunk = (it >> 9) & 255, dir = (it >> 17) & 1, b = it >> 18;
        float h[4] = {0.f, 0.f, 0.f, 0.f}, ls[4] = {0.f, 0.f, 0.f, 0.f};
#pragma unroll 8
        for (int s = 0; s < 32; ++s) { const int t = chunk * 32 + (dir ? 31 - s : s); const size_t off = ((size_t)dir * NTOK + (size_t)b * SEQ + t) * DM + ch;
            const int lw = *(const int*)((const unsigned char*)LA + off), bw = *(const int*)((const unsigned char*)BB + off);
            const float l4[4] = {RG_ILA * __builtin_amdgcn_cvt_f32_fp8(lw, 0), RG_ILA * __builtin_amdgcn_cvt_f32_fp8(lw, 1), RG_ILA * __builtin_amdgcn_cvt_f32_fp8(lw, 2), RG_ILA * __builtin_amdgcn_cvt_f32_fp8(lw, 3)};
            const float b4[4] = {RG_IB * __builtin_amdgcn_cvt_f32_fp8(bw, 0), RG_IB * __builtin_amdgcn_cvt_f32_fp8(bw, 1), RG_IB * __builtin_amdgcn_cvt_f32_fp8(bw, 2), RG_IB * __builtin_amdgcn_cvt_f32_fp8(bw, 3)};
#pragma unroll
            for (int i = 0; i < 4; ++i) { h[i] = __expf(l4[i]) * h[i] + b4[i]; ls[i] += l4[i]; } }
        const size_t co = (((size_t)b * 2 + dir) * 256 + chunk) * DM + ch;
        *(f32x4*)(CARA + co) = (f32x4){ls[0], ls[1], ls[2], ls[3]}; *(f32x4*)(CARB + co) = (f32x4){h[0], h[1], h[2], h[3]}; }
}
__device__ __forceinline__ void phase_scan2(KArgs a, LAS unsigned char* lds) {
    float* CARA = (float*)(a.ws + A_CAR); float* CARB = CARA + CAR_ELEMS; float* CARIN = CARB + CAR_ELEMS;
    const int tid = opaque_tid(), grp = tid >> 5, chl = tid & 31;
    LAS float* sh = (LAS float*)lds;
    for (int it = blockIdx.x; it < 2 * 2 * 64; it += gridDim.x) { const int ch = (it & 63) * 32 + chl, dir = (it >> 6) & 1, b = it >> 7;
        float la[16], lb[16]; float A = 0.f, B = 0.f;
#pragma unroll
        for (int k = 0; k < 16; ++k) { const int q = grp * 16 + k, chunk = dir ? 255 - q : q; const size_t co = (((size_t)b * 2 + dir) * 256 + chunk) * DM + ch; la[k] = CARA[co]; lb[k] = CARB[co]; }
#pragma unroll
        for (int k = 0; k < 16; ++k) { B = __expf(la[k]) * B + lb[k]; A += la[k]; }
        sh[(grp * 32 + chl) * 2] = A; sh[(grp * 32 + chl) * 2 + 1] = B;
        __syncthreads();
        float h = 0.f;
        for (int g2 = 0; g2 < grp; ++g2) h = __expf(sh[(g2 * 32 + chl) * 2]) * h + sh[(g2 * 32 + chl) * 2 + 1];
#pragma unroll
        for (int k = 0; k < 16; ++k) { const int q = grp * 16 + k, chunk = dir ? 255 - q : q; const size_t co = (((size_t)b * 2 + dir) * 256 + chunk) * DM + ch; CARIN[co] = h; h = __expf(la[k]) * h + lb[k]; }
        __syncthreads();
    }
}
__device__ __forceinline__ float gelu_tanh(float x) { const float u = 0.7978845608028654f * (x + 0.044715f * x * x * x); const float th = 1.0f - 2.0f * __builtin_amdgcn_rcpf(1.0f + __builtin_amdgcn_exp2f(2.8853900817779268f * u)); return 0.5f * x * (1.0f + th); }
__device__ __forceinline__ void phase_scan3(KArgs a) {
    const bf16_t* LA = (const bf16_t*)(a.ws + A_LA); const bf16_t* BB = (const bf16_t*)(a.ws + A_BB); const bf16_t* GB = (const bf16_t*)(a.ws + A_GB); bf16_t* YG = (bf16_t*)(a.ws + A_YG);
    const float* CARIN = (const float*)(a.ws + A_CAR) + 2 * CAR_ELEMS;
    const int NT = gridDim.x * 512;
    for (int it = blockIdx.x * 512 + opaque_tid(); it < 2 * 256 * 512; it += NT) { const int ch = (it & 511) * 4, chunk = (it >> 9) & 255, b = it >> 17;
        unsigned hf[32][2]; float h[4];
        { const f32x4 c = *(const f32x4*)(CARIN + (((size_t)b * 2 + 0) * 256 + chunk) * DM + ch); h[0] = c[0]; h[1] = c[1]; h[2] = c[2]; h[3] = c[3]; }
#pragma unroll
        for (int s = 0; s < 32; ++s) { const size_t off = ((size_t)b * SEQ + chunk * 32 + s) * DM + ch;
            const int lw = *(const int*)((const unsigned char*)LA + off), bw = *(const int*)((const unsigned char*)BB + off);
            const float l4[4] = {RG_ILA * __builtin_amdgcn_cvt_f32_fp8(lw, 0), RG_ILA * __builtin_amdgcn_cvt_f32_fp8(lw, 1), RG_ILA * __builtin_amdgcn_cvt_f32_fp8(lw, 2), RG_ILA * __builtin_amdgcn_cvt_f32_fp8(lw, 3)};
            const float b4[4] = {RG_IB * __builtin_amdgcn_cvt_f32_fp8(bw, 0), RG_IB * __builtin_amdgcn_cvt_f32_fp8(bw, 1), RG_IB * __builtin_amdgcn_cvt_f32_fp8(bw, 2), RG_IB * __builtin_amdgcn_cvt_f32_fp8(bw, 3)};
#pragma unroll
            for (int i = 0; i < 4; ++i) h[i] = __expf(l4[i]) * h[i] + b4[i];
            hf[s][0] = cvt_pk_bf16(h[0], h[1]); hf[s][1] = cvt_pk_bf16(h[2], h[3]);
            if ((s & 7) == 7) __builtin_amdgcn_sched_barrier(0); }
        { const f32x4 c = *(const f32x4*)(CARIN + (((size_t)b * 2 + 1) * 256 + chunk) * DM + ch); h[0] = c[0]; h[1] = c[1]; h[2] = c[2]; h[3] = c[3]; }
#pragma unroll
        for (int s = 31; s >= 0; --s) { const size_t tokoff = ((size_t)b * SEQ + chunk * 32 + s) * DM + ch; const size_t off = (size_t)NTOK * DM + tokoff;
            const int lw = *(const int*)((const unsigned char*)LA + off), bw = *(const int*)((const unsigned char*)BB + off); const u32x2 gw = *(const u32x2*)(GB + tokoff);
            const float l4[4] = {RG_ILA * __builtin_amdgcn_cvt_f32_fp8(lw, 0), RG_ILA * __builtin_amdgcn_cvt_f32_fp8(lw, 1), RG_ILA * __builtin_amdgcn_cvt_f32_fp8(lw, 2), RG_ILA * __builtin_amdgcn_cvt_f32_fp8(lw, 3)};
            const float b4[4] = {RG_IB * __builtin_amdgcn_cvt_f32_fp8(bw, 0), RG_IB * __builtin_amdgcn_cvt_f32_fp8(bw, 1), RG_IB * __builtin_amdgcn_cvt_f32_fp8(bw, 2), RG_IB * __builtin_amdgcn_cvt_f32_fp8(bw, 3)}, g4[4] = {bflo(gw.x), bfhi(gw.x), bflo(gw.y), bfhi(gw.y)};
            float y[4];
            const float f4[4] = {bflo(hf[s][0]), bfhi(hf[s][0]), bflo(hf[s][1]), bfhi(hf[s][1])};
#pragma unroll
            for (int i = 0; i < 4; ++i) { h[i] = __expf(l4[i]) * h[i] + b4[i]; y[i] = gelu_tanh(g4[i]) * (f4[i] + h[i]); }
            if (FP8_P16) { *(unsigned*)((unsigned char*)YG + tokoff) = pg8::pk4_fp8(4.0f * y[0], 4.0f * y[1], 4.0f * y[2], 4.0f * y[3]); }
            else { u32x2 w; w.x = pk2(y[0], y[1]); w.y = pk2(y[2], y[3]); *(u32x2*)(YG + tokoff) = w; }
            if ((s & 7) == 0) __builtin_amdgcn_sched_barrier(0); } }
}

#define KARGS() (*(const __attribute__((address_space(4))) Args*)__builtin_amdgcn_kernarg_segment_ptr())
#define PHASE_FN __device__ __forceinline__ void
#define PH_PRE() KArgs a = KARGS(); LAS unsigned char* lds = (LAS unsigned char*)lds_raw; unsigned char* ws = a.ws; asm volatile("" : "+s"(ws)); const int G = gridDim.x, bx = blockIdx.x; (void)lds; (void)ws; (void)G; (void)bx; using namespace pg8
PHASE_FN ph0() { PH_PRE(); phase_prologue(a, lds); }
PHASE_FN ph1a() { PH_PRE(); Gemm g{(const bf16_t*)(ws + A_W4T), (const bf16_t*)(ws + A_H3B), 128, 128, 128}; StaticOrder S; S.init(4096, 8192, G, bx); EpiFilt E{(bf16_t*)(ws + A_KTD)}; gemm_phase(lds, g, S, E); }
PHASE_FN ph1b() { PH_PRE(); StaticOrder S; S.init(NTOK, 3072, G, bx);
    if constexpr (FP8_P1B) { Gemm g{(const bf16_t*)(ws + A_XB8), (const bf16_t*)(ws + WS_WIN_EV8 + (size_t)3072 * DM), DM / 2, DM / 2, DM / 2};
        EpiBf16 E{(bf16_t*)(ws + A_QB), 1024, 1024, (size_t)(A_KB - A_QB) / 2, QSCALE, 1.0f / FP8_SW}; gemm_phase<EpiBf16, StaticOrder, true>(lds, g, S, E); }
    else { Gemm g{(const bf16_t*)(ws + A_XB), (const bf16_t*)(ws + WS_WIN_EV) + (size_t)3072 * DM, DM, DM, DM};
        EpiBf16 E{(bf16_t*)(ws + A_QB), 1024, 1024, (size_t)(A_KB - A_QB) / 2, QSCALE}; gemm_phase(lds, g, S, E); } }
PHASE_FN ph1c() { PH_PRE(); StaticOrder S; S.init(3072, NTOK, G, bx);
    if constexpr (FP8_P1C) { Gemm g{(const bf16_t*)(ws + WS_WIN_EV8), (const bf16_t*)(ws + A_XB8), DM / 2, DM / 2, DM / 2};
        EpiBf16 E{(bf16_t*)(ws + A_UHT), NTOK, 0, 0, 1.f, 1.0f / FP8_SW}; gemm_phase<EpiBf16, StaticOrder, true>(lds, g, S, E); }
    else { Gemm g{(const bf16_t*)(ws + WS_WIN_EV), (const bf16_t*)(ws + A_XB), DM, DM, DM};
        EpiBf16 E{(bf16_t*)(ws + A_UHT), NTOK, 0, 0, 1.f}; gemm_phase(lds, g, S, E); } }
PHASE_FN ph2() { PH_PRE(); phase_qknorm(a, lds); }
PHASE_FN ph3a() { PH_PRE(); phase_hyena_mixer(a, lds); }
PHASE_FN ph3b() { PH_PRE(); phase_attention(a, lds); }
PHASE_FN ph4() { PH_PRE(); phase_concat(a, lds); }
PHASE_FN ph5() { PH_PRE(); StaticOrder S; S.init(NTOK, DM, G, bx);
    if constexpr (FP8_P5) { Gemm g{(const bf16_t*)(ws + A_YCAT), (const bf16_t*)(ws + WS_WOUT_EV), DM / 2, DM / 2, DM / 2};
        EpiResBf E{(const bf16_t*)(ws + A_XB2), (bf16_t*)(ws + A_R0), DM, DN_ALPHA, 1.0f / FP8_SW}; gemm_phase<EpiResBf, StaticOrder, true>(lds, g, S, E); }
    else { Gemm g{(const bf16_t*)(ws + A_YCAT), (const bf16_t*)(ws + WS_WOUT_EV), DM, DM, DM};
        EpiResBf E{(const bf16_t*)(ws + A_XB2), (bf16_t*)(ws + A_R0), DM, DN_ALPHA}; gemm_phase(lds, g, S, E); } }
template <int LAYER> PHASE_FN ph_lnr() { PH_PRE(); unsigned* ctl = (unsigned*)(ws + WS_CTL);
    phase_ln_router(a, lds, (const bf16_t*)(ws + (LAYER ? A_R1 : A_R0)), a.in[28] + LAYER * DM, a.in[29] + LAYER * DM, (bf16_t*)(ws + (LAYER ? A_HB_1 : A_HB_0)), (LAYER >= 2 - MOE_FP8_LAYERS) ? ws + (LAYER ? A_HB8_1 : A_HB8_0) : nullptr,
                    ctl + CW_CNT + LAYER * 32 * 64, (int*)(ws + A_ROWL), (float*)(ws + A_GATEW)); }
template <int LAYER> PHASE_FN ph_moe1() { PH_PRE(); LAS int* tab = (LAS int*)(lds + LDS_MISC); moe_table(tab, (const unsigned*)(ws + WS_CTL) + CW_CNT + LAYER * 32 * 64);
    MoeOrder<4, true> S{G, bx, tab, (const int*)(ws + A_ROWL)};
    if constexpr (LAYER >= 2 - MOE_FP8_LAYERS) {
        Gemm g{(const bf16_t*)(ws + (LAYER ? A_HB8_1 : A_HB8_0)), (const bf16_t*)(ws + WS_W1T + (size_t)LAYER * 32 * 1024 * DM * 2), DM / 2, DM / 2, DM / 2};
        EpiSwiglu8 E{ws + (LAYER ? A_HID_1 : A_HID_0)}; gemm_phase<EpiSwiglu8, MoeOrder<4, true>, true>(lds, g, S, E);
    } else {
        Gemm g{(const bf16_t*)(ws + (LAYER ? A_HB_1 : A_HB_0)), (const bf16_t*)(ws + WS_W1T) + (size_t)LAYER * 32 * 1024 * DM, DM, DM, DM};
        EpiSwiglu E{(bf16_t*)(ws + (LAYER ? A_HID_1 : A_HID_0))}; gemm_phase(lds, g, S, E); } }
template <int LAYER> PHASE_FN ph_moe2() { PH_PRE(); LAS int* tab = (LAS int*)(lds + LDS_MISC); moe_table(tab, (const unsigned*)(ws + WS_CTL) + CW_CNT + LAYER * 32 * 64);
    MoeOrder<8, false> S{G, bx, tab, (const int*)(ws + A_ROWL)};
    if constexpr (LAYER >= 2 - MOE_FP8_LAYERS) {
        Gemm g{(const bf16_t*)(ws + (LAYER ? A_HID_1 : A_HID_0)), (const bf16_t*)(ws + WS_W2T + (size_t)LAYER * 32 * DM * DFF * 2), DFF / 2, DFF / 2, DFF / 2};
        EpiDown E{(bf16_t*)(ws + (LAYER ? A_Y2_1 : A_Y2_0)), (const int*)(ws + A_ROWL), (const float*)(ws + A_GATEW), 1.0f / (FP8_SW * FP8_SH)};
        gemm_phase<EpiDown, MoeOrder<8, false>, true>(lds, g, S, E);
    } else {
        Gemm g{(const bf16_t*)(ws + (LAYER ? A_HID_1 : A_HID_0)), (const bf16_t*)(ws + WS_W2T) + (size_t)LAYER * 32 * DM * DFF, DFF, DFF, DFF};
        EpiDown E{(bf16_t*)(ws + (LAYER ? A_Y2_1 : A_Y2_0)), (const int*)(ws + A_ROWL), (const float*)(ws + A_GATEW), 1.0f}; gemm_phase(lds, g, S, E); } }
template <int LAYER> PHASE_FN ph_ln2() { PH_PRE();
    phase_ln2((const bf16_t*)(ws + (LAYER ? A_HB_1 : A_HB_0)), (const bf16_t*)(ws + (LAYER ? A_Y2_1 : A_Y2_0)), a.in[30] + LAYER * DM, a.in[31] + LAYER * DM, LAYER ? a.out : nullptr, LAYER ? nullptr : (bf16_t*)(ws + A_HB2), (!LAYER && FP8_P10) ? ws + A_HB2_8 : nullptr); }
PHASE_FN ph10() { PH_PRE(); StaticOrder S; S.init(NTOK, 2 * DM, G, bx);
    if constexpr (FP8_P10) { Gemm g{(const bf16_t*)(ws + A_HB2_8), (const bf16_t*)(ws + WS_WIN_OD), DM / 2, DM / 2, DM / 2};
        EpiBf16 E{(bf16_t*)(ws + A_GB), DM, DM, (size_t)(A_XR - A_GB) / 2, 1.f, 1.0f / FP8_SW}; gemm_phase<EpiBf16, StaticOrder, true>(lds, g, S, E); }
    else { Gemm g{(const bf16_t*)(ws + A_HB2), (const bf16_t*)(ws + WS_WIN_OD), DM, DM, DM};
        EpiBf16 E{(bf16_t*)(ws + A_GB), DM, DM, (size_t)(A_XR - A_GB) / 2, 1.f}; gemm_phase(lds, g, S, E); } }
PHASE_FN ph11() { PH_PRE(); phase_conv4(a); }
PHASE_FN ph12() { PH_PRE(); Gemm g{(const bf16_t*)(ws + A_XC), (const bf16_t*)(ws + WS_WG_OD), DM, 256, 256}; RGOrder S{G, bx};
                  EpiRG E{(bf16_t*)(ws + A_LA), (bf16_t*)(ws + A_BB), (const bf16_t*)(ws + A_XC), a.in[23], a.in[25], a.in[26]}; gemm_phase(lds, g, S, E); }
PHASE_FN ph13() { PH_PRE(); phase_scan1(a); }
PHASE_FN ph14() { PH_PRE(); phase_scan2(a, lds); }
PHASE_FN ph15() { PH_PRE(); phase_scan3(a); }
PHASE_FN ph16() { PH_PRE(); StaticOrder S; S.init(NTOK, DM, G, bx);
    if constexpr (FP8_P16) { Gemm g{(const bf16_t*)(ws + A_YG), (const bf16_t*)(ws + WS_WOUT_OD), DM / 2, DM / 2, DM / 2};
        EpiResBf E{(const bf16_t*)(ws + A_HB2), (bf16_t*)(ws + A_R1), DM, DN_ALPHA, 1.0f / (FP8_SW * 4.0f)}; gemm_phase<EpiResBf, StaticOrder, true>(lds, g, S, E); }
    else { Gemm g{(const bf16_t*)(ws + A_YG), (const bf16_t*)(ws + WS_WOUT_OD), DM, DM, DM};
        EpiResBf E{(const bf16_t*)(ws + A_HB2), (bf16_t*)(ws + A_R1), DM, DN_ALPHA}; gemm_phase(lds, g, S, E); } }

__global__ void __launch_bounds__(512, 2) fwd(Args a) {
    LAS unsigned char* lds = (LAS unsigned char*)lds_raw;
    unsigned* ctl = (unsigned*)(a.ws + WS_CTL);
    volatile LAS unsigned* bst = (volatile LAS unsigned*)(lds + LDS_MISC + 2048);
    { const int tid = threadIdx.x;
      if ((tid & 63) == 0) ((LAS int*)(lds + LDS_WIDTAB))[hw_slot()] = tid >> 6;
      if (tid < 4) bst[tid] = 0u; }
    __syncthreads();
    const int lo = a.ph_lo, hi = a.ph_hi;
    XcdBarrier bar; bar.bar = ctl + CW_BAR; bar.x = 0; bar.st = bst;
    if (hi - lo > 1) bar = xcd_barrier_post(ctl + CW_BAR, bst);
#ifdef ONLY_PHASE
#define IN(k) ((k) == ONLY_PHASE && lo <= (k) && (k) < hi)
#else
#define IN(k) (lo <= (k) && (k) < hi)
#endif
#define SEAM(k) do { if (IN(k) && IN((k) + 1)) xcd_barrier(bar); } while (0)
    if (IN(0)) { asm volatile("; PHASE_MARK 0"); ph0(); } SEAM(0);
    if (IN(1)) { asm volatile("; PHASE_MARK 1a"); ph1a(); asm volatile("; PHASE_MARK 1b"); ph1b(); asm volatile("; PHASE_MARK 1c"); ph1c(); } SEAM(1);
    if (IN(2)) { asm volatile("; PHASE_MARK 2"); ph2(); } SEAM(2);
    if (IN(3)) { asm volatile("; PHASE_MARK 3a"); ph3a(); asm volatile("; PHASE_MARK 3b"); ph3b(); } SEAM(3);
    if (IN(4)) { asm volatile("; PHASE_MARK 4"); ph4(); } SEAM(4);
    if (IN(5)) { asm volatile("; PHASE_MARK 5"); ph5(); } SEAM(5);
    if (IN(6)) { asm volatile("; PHASE_MARK 6"); ph_lnr<0>(); } SEAM(6);
    if (IN(7)) { asm volatile("; PHASE_MARK 7"); ph_moe1<0>(); } SEAM(7);
    if (IN(8)) { asm volatile("; PHASE_MARK 8"); ph_moe2<0>(); } SEAM(8);
    if (IN(9)) { asm volatile("; PHASE_MARK 9"); ph_ln2<0>(); } SEAM(9);
    if (IN(10)) { asm volatile("; PHASE_MARK 10"); ph10(); } SEAM(10);
    if (IN(11)) { asm volatile("; PHASE_MARK 11"); ph11(); } SEAM(11);
    if (IN(12)) { asm volatile("; PHASE_MARK 12"); ph12(); } SEAM(12);
    if (IN(13)) { asm volatile("; PHASE_MARK 13"); ph13(); } SEAM(13);
    if (IN(14)) { asm volatile("; PHASE_MARK 14"); ph14(); } SEAM(14);
    if (IN(15)) { asm volatile("; PHASE_MARK 15"); ph15(); } SEAM(15);
    if (IN(16)) { asm volatile("; PHASE_MARK 16"); ph16(); } SEAM(16);
    if (IN(17)) { asm volatile("; PHASE_MARK 17"); ph_lnr<1>(); } SEAM(17);
    if (IN(18)) { asm volatile("; PHASE_MARK 18"); ph_moe1<1>(); } SEAM(18);
    if (IN(19)) { asm volatile("; PHASE_MARK 19"); ph_moe2<1>(); } SEAM(19);
    if (IN(20)) { asm volatile("; PHASE_MARK 20"); ph_ln2<1>(); }
#undef IN
#undef SEAM
}

#ifndef MK_PER_PHASE
#define MK_PER_PHASE 0
#endif
extern "C" void kernel_launch(void* const* d_in, const int* in_sizes, int n_in, void* d_out, int out_size, void* d_ws, size_t ws_size, hipStream_t stream) {
    static int grid = 0;
    if (grid == 0) {
        if (n_in != 37 || out_size != NTOK * DM || ws_size < WS_END) { fprintf(stderr, "kernel_launch: built for 37 inputs, %d outputs, >= %zu bytes of workspace; got n_in %d out %d ws %zu\n", NTOK * DM, (size_t)WS_END, n_in, out_size, ws_size); grid = -1; return; }
        int dev = 0, cus = 0, per_cu = 0;
        if (hipGetDevice(&dev) != hipSuccess || hipDeviceGetAttribute(&cus, hipDeviceAttributeMultiprocessorCount, dev) != hipSuccess) { grid = -1; return; }
        if (hipFuncSetAttribute((const void*)fwd, hipFuncAttributeMaxDynamicSharedMemorySize, LDS_BYTES) != hipSuccess) { fprintf(stderr, "kernel_launch: hipFuncSetAttribute failed\n"); grid = -1; return; }
        if (hipOccupancyMaxActiveBlocksPerMultiprocessor(&per_cu, (const void*)fwd, 512, LDS_BYTES) != hipSuccess || per_cu < 1) fprintf(stderr, "kernel_launch: occupancy query reports %d\n", per_cu);
        (void)hipGetLastError();
        grid = cus;
    }
    if (grid < 0) return;
    (void)hipMemsetAsync((char*)d_ws + WS_CTL, 0, CTL_ZERO_BYTES, stream);
    Args a{};
    for (int i = 0; i < 37; ++i) a.in[i] = (const float*)d_in[i];
    a.out = (float*)d_out; a.ws = (unsigned char*)d_ws;
#if MK_PER_PHASE
    for (int p = 0; p < NPHASE; ++p) { a.ph_lo = p; a.ph_hi = p + 1; hipLaunchKernelGGL(fwd, dim3(grid), dim3(512), LDS_BYTES, stream, a); }
#else
    a.ph_lo = 0; a.ph_hi = NPHASE; hipLaunchKernelGGL(fwd, dim3(grid), dim3(512), LDS_BYTES, stream, a);
#endif
}
```

```cpp
#include <hip/hip_runtime.h>
#include <hip/hip_fp16.h>
#include <cstdio>
#include <cstdint>

#define GAS __attribute__((address_space(1)))
#define LAS __attribute__((address_space(3)))
typedef unsigned short bf16_t;
typedef short bf16x8 __attribute__((ext_vector_type(8)));
typedef short s16x4 __attribute__((ext_vector_type(4)));
typedef float f32x2 __attribute__((ext_vector_type(2)));
typedef float f32x4 __attribute__((ext_vector_type(4)));
typedef float f32x8 __attribute__((ext_vector_type(8)));
typedef float f32x16 __attribute__((ext_vector_type(16)));
typedef unsigned u32x2 __attribute__((ext_vector_type(2)));
typedef unsigned u32x4 __attribute__((ext_vector_type(4)));
typedef GAS unsigned gu32;

constexpr int DM = 2048, BATCH = 2, SEQ = 8192, NTOK = BATCH * SEQ;
constexpr int HY_CH = 1024, EV_IN = 6144;
constexpr int NEXP = 32, DFF = 512, NASSIGN = NTOK * 2, ECAP = NASSIGN;
constexpr float LN_EPS = 1e-5f;
constexpr float DN_ALPHA = 1.4142135623730951f;
constexpr float QSCALE = 0.125f * 1.4426950408889634f;
constexpr int FFT_N = 16384, FFT_RS = 528;

__device__ __forceinline__ unsigned f2bf(float f) { unsigned u = __builtin_bit_cast(unsigned, f); return (u + 0x7fffu + ((u >> 16) & 1u)) >> 16; }
__device__ __forceinline__ unsigned pk2(float lo, float hi) { return f2bf(lo) | (f2bf(hi) << 16); }
__device__ __forceinline__ float bf2f(unsigned short h) { return __builtin_bit_cast(float, (unsigned)h << 16); }
__device__ __forceinline__ float bflo(unsigned w) { return __builtin_bit_cast(float, w << 16); }
__device__ __forceinline__ float bfhi(unsigned w) { return __builtin_bit_cast(float, w & 0xffff0000u); }
__device__ __forceinline__ unsigned cvt_pk_bf16(float lo, float hi) { unsigned r; asm volatile("v_cvt_pk_bf16_f32 %0, %1, %2" : "=v"(r) : "v"(lo), "v"(hi)); return r; }
__device__ __forceinline__ float wave_sum(float v) {
#pragma unroll
    for (int o = 1; o < 64; o <<= 1) v += __shfl_xor(v, o);
    return v;
}
__device__ __forceinline__ float sigmoidf_(float x) { return __builtin_amdgcn_rcpf(1.0f + __builtin_amdgcn_exp2f(-1.4426950408889634f * x)); }
constexpr int LDS_WIDTAB = 153600 + 3072;
__device__ __forceinline__ int hw_slot() { return (int)(__builtin_amdgcn_s_getreg((5 << 11) | 4) & 63u); }
__device__ __forceinline__ int lane_id() { return (int)__builtin_amdgcn_mbcnt_hi(~0u, __builtin_amdgcn_mbcnt_lo(~0u, 0u)); }
extern __shared__ __attribute__((aligned(16))) unsigned char lds_raw[];
__device__ __forceinline__ int wave_id() { return __builtin_amdgcn_readfirstlane(((const LAS int*)((LAS unsigned char*)lds_raw + LDS_WIDTAB))[hw_slot()]); }
__device__ __forceinline__ int opaque_tid() { int t = wave_id() * 64 + lane_id(); asm volatile("" : "+v"(t)); return t; }
#define LDS_WAIT() asm volatile("s_waitcnt lgkmcnt(0)" ::: "memory")
#define VM_WAIT() asm volatile("s_waitcnt vmcnt(0)" ::: "memory")

#define XB_TMO      128
#define XB_XCNT(j)  (256  + 64 * (j))
#define XB_XSUB(j)  (1280 + 64 * (j))
#define XB_XGEN(j)  (2304 + 64 * (j))
#define XB_TOP      3328
#define XB_TOPGEN   3392
#define XCD_BAR_WORDS 3456
#define XB_SPIN_CAP (1u << 18)
__device__ __forceinline__ unsigned xb_ld(unsigned* p)              { return __hip_atomic_load(p, __ATOMIC_RELAXED, __HIP_MEMORY_SCOPE_AGENT); }
__device__ __forceinline__ unsigned xb_add(unsigned* p, unsigned v) { return __hip_atomic_fetch_add(p, v, __ATOMIC_RELAXED, __HIP_MEMORY_SCOPE_AGENT); }
__device__ __forceinline__ unsigned xb_xcc_id() { return (unsigned)__builtin_amdgcn_s_getreg((3 << 11) | 20) & 0xFu; }
#define XB_SPIN(cond, bar) do { unsigned _sp = 0; while (cond) { __builtin_amdgcn_s_sleep(1); \
    if ((++_sp & 255u) == 0u) { if (xb_ld(&(bar)[XB_TMO])) break; if (_sp > XB_SPIN_CAP) { atomicAdd(&(bar)[XB_TMO], 1u); break; } } } } while (0)
struct XcdBarrier { unsigned* bar; unsigned x; volatile LAS unsigned* st; };
__device__ __forceinline__ XcdBarrier xcd_barrier_post(unsigned* bar, volatile LAS unsigned* st) {
    XcdBarrier b; b.bar = bar; b.x = xb_xcc_id(); b.st = st;
    if (opaque_tid() == 0) (void)xb_add(&bar[XB_XCNT(b.x)], 1u);
    return b;
}
__device__ __forceinline__ void xcd_barrier_complete(unsigned* bar, unsigned x, unsigned& nloc, unsigned& nx) {
    const unsigned G = gridDim.x * gridDim.y * gridDim.z;
    unsigned sum, cnt, mine, sp = 0u;
    for (;;) {
        sum = 0u; cnt = 0u; mine = 0u;
#pragma unroll
        for (unsigned j = 0; j < 16; ++j) { const unsigned c = xb_ld(&bar[XB_XCNT(j)]); sum += c; cnt += (c > 0u) ? 1u : 0u; mine = (j == x) ? c : mine; }
        if (sum == G) break;
        __builtin_amdgcn_s_sleep(1);
        if ((++sp & 255u) == 0u) { if (xb_ld(&bar[XB_TMO])) break; if (sp > XB_SPIN_CAP) { atomicAdd(&bar[XB_TMO], 1u); break; } }
    }
    nloc = mine > 0u ? mine : 1u; nx = cnt > 0u ? cnt : 1u;
}
__device__ __forceinline__ void xcd_barrier(const XcdBarrier& b) {
    asm volatile("s_waitcnt vmcnt(0)" ::: "memory");
    __syncthreads();
    if (opaque_tid() == 0) {
        unsigned* bar = b.bar;
        __builtin_amdgcn_s_waitcnt(0);
        unsigned nloc = b.st[0], nx = b.st[1];
        if (nloc == 0u) { xcd_barrier_complete(bar, b.x, nloc, nx); b.st[0] = nloc; b.st[1] = nx; }
        const unsigned old = xb_add(&bar[XB_XSUB(b.x)], 1u);
        const unsigned gen = old / nloc;
        if (old + 1u == (gen + 1u) * nloc) {
            __builtin_amdgcn_fence(__ATOMIC_RELEASE, "agent");
            asm volatile("s_waitcnt vmcnt(0)" ::: "memory");
            const unsigned og = xb_add(&bar[XB_TOP], 1u);
            const unsigned tg = og / nx;
            if (og + 1u == (tg + 1u) * nx) xb_add(&bar[XB_TOPGEN], 1u);
            else XB_SPIN(xb_ld(&bar[XB_TOPGEN]) == tg, bar);
            __builtin_amdgcn_fence(__ATOMIC_ACQUIRE, "agent");
            xb_add(&bar[XB_XGEN(b.x)], 1u);
            asm volatile("s_waitcnt vmcnt(0)" ::: "memory");
        } else {
            XB_SPIN(xb_ld(&bar[XB_XGEN(b.x)]) == gen, bar);
            __builtin_amdgcn_fence(__ATOMIC_ACQUIRE, "agent");
            asm volatile("s_waitcnt vmcnt(0)" ::: "memory");
        }
    }
    __syncthreads();
}

namespace pg8 {
constexpr int BM = 256, BK = 64, HALF = 128, HTB = HALF * BK * 2, STAGE_BYTES = 8 * HTB, NXCD = 8, WGM = 8;
__host__ __device__ __forceinline__ int lds_byte(int r, int c) { const int st = (r >> 4) * 2 + (c >> 5), rr = r & 15, cc = c & 31, ob = rr * 64 + cc * 2; return st * 1024 + (ob ^ (((ob >> 9) & 1) << 5)); }
__host__ __device__ __forceinline__ void stage_rc(int b, int& R, int& C) { const int st = b / 1024, sb = b % 1024, swz = sb ^ (((sb >> 9) & 1) << 5); R = (st >> 1) * 16 + swz / 64; C = (st & 1) * 32 + (swz % 64) / 2; }
__host__ __device__ __forceinline__ int perm32(int rho) { const int n = rho >> 4, i = rho & 15; return 8 * (i >> 2) + 4 * n + (i & 3); }

struct Unit { int pm, pn, e, t, cnt; };
struct Gemm { const bf16_t* A; const bf16_t* Bt; int lda, ldb, K; };

struct StaticOrder {
    static constexpr bool GATHER_A = false;
    int nM, nN, nwg, G, c;
    __device__ void init(int M, int N, int G_, int c_) { nM = M / BM; nN = N / BM; nwg = nM * nN; G = G_; c = c_; }
    __device__ __forceinline__ bool next(int i, Unit& u) const {
        const long L = (long)i * G + c; if (L >= nwg) return false;
        int wgid = (int)L; { const int q = nwg / NXCD, r = nwg % NXCD, xcd = wgid % NXCD, off = wgid / NXCD; wgid = (xcd < r ? xcd * (q + 1) : r * (q + 1) + (xcd - r) * q) + off; }
        const int nig = WGM * nN, gid = wgid / nig, fm = gid * WGM, gsz = (nM - fm) < WGM ? (nM - fm) : WGM;
        u.pm = fm + ((wgid % nig) % gsz); u.pn = (wgid % nig) / gsz; u.e = 0; u.t = 0; u.cnt = 0; return true;
    }
    __device__ __forceinline__ int rowA(const Unit& u, int r) const { return u.pm * BM + r; }
    __device__ __forceinline__ int colA(const Unit&) const { return 0; }
    __device__ __forceinline__ int rowB(const Unit& u, int r) const { return u.pn * BM + r; }
};

typedef int v8i32 __attribute__((ext_vector_type(8)));
template <class Epi, class Sched, bool FP8 = false>
__device__ __forceinline__ void gemm_phase(LAS unsigned char* lds, const Gemm g, const Sched& S, const Epi& E) {
    const int tid = opaque_tid(), wid = __builtin_amdgcn_readfirstlane(tid >> 6), lane = tid & 63, wr = wid >> 2, wc = wid & 3, fr = lane & 15, fq = lane >> 4;
    const int K = g.K, nt = K / BK;
    constexpr bool GA = Sched::GATHER_A;
    int sR[2], sC[2];
    unsigned laneA[2], laneB[2];
#pragma unroll
    for (int i = 0; i < 2; ++i) { int R, C; stage_rc(tid * 16 + i * 8192, R, C); sR[i] = R; sC[i] = C; const int Rb = Epi::PERM ? ((R & ~31) + perm32(R & 31)) : R;
        laneA[i] = (unsigned)(R * g.lda + C) * 2u; laneB[i] = (unsigned)(Rb * g.ldb + C) * 2u; }
    const size_t hstepA = (size_t)HALF * g.lda * 2, hstepB = (size_t)HALF * g.ldb * 2;
    const unsigned ldsw = (unsigned)wid * 1024u;
    const int aoff = lds_byte(wr * 64 + fr, fq * 8), boff = lds_byte(wc * 32 + fr, fq * 8);
    const char* gA = (const char*)g.A; const char* gB = (const char*)g.Bt;
#define PG8_SA(b, h) (((b) * 2 + (h)) * HTB)
#define PG8_SB(b, h) ((4 + (b) * 2 + (h)) * HTB)
#define PG8_STAGE(bufoff, gptr, voff) do { _Pragma("unroll") for (int _i = 0; _i < 2; ++_i) \
        __builtin_amdgcn_global_load_lds((const unsigned*)((gptr) + (size_t)(voff)[_i]), (LAS unsigned*)(lds + (bufoff) + ldsw + _i * 8192), 16, 0, 0); } while (0)
#define PG8_STAGE_B(bufoff, ub, h, kb) PG8_STAGE(bufoff, gB + (ub) + (size_t)(h) * hstepB + (size_t)(kb), laneB)
#define PG8_STAGE_A(bufoff, ub, va, h, kb) do { if constexpr (GA) { PG8_STAGE(bufoff, gA + (size_t)(kb), va[h]); } else { PG8_STAGE(bufoff, gA + (ub) + (size_t)(h) * hstepA + (size_t)(kb), laneA); } } while (0)
#define PG8_RD(off) (*(const LAS u32x4*)(lds + (off)))
#define PG8_CAT2(x, y) __builtin_bit_cast(v8i32, __builtin_shufflevector((x), (y), 0, 1, 2, 3, 4, 5, 6, 7))
#define PG8_LDA(dst, b, h) do { if constexpr (FP8) { _Pragma("unroll") for (int m = 0; m < 4; ++m) dst##8[m] = PG8_CAT2(PG8_RD(PG8_SA(b, h) + aoff + m * 2048), PG8_RD(PG8_SA(b, h) + aoff + m * 2048 + 1024)); } \
        else { _Pragma("unroll") for (int m = 0; m < 4; ++m) _Pragma("unroll") for (int k = 0; k < 2; ++k) dst[m][k] = *(const LAS bf16x8*)(lds + PG8_SA(b, h) + aoff + m * 2048 + k * 1024); } } while (0)
#define PG8_LDB(dst, b, h) do { if constexpr (FP8) { _Pragma("unroll") for (int n = 0; n < 2; ++n) dst##8[n] = PG8_CAT2(PG8_RD(PG8_SB(b, h) + boff + n * 2048), PG8_RD(PG8_SB(b, h) + boff + n * 2048 + 1024)); } \
        else { _Pragma("unroll") for (int n = 0; n < 2; ++n) _Pragma("unroll") for (int k = 0; k < 2; ++k) dst[n][k] = *(const LAS bf16x8*)(lds + PG8_SB(b, h) + boff + n * 2048 + k * 1024); } } while (0)
#define PG8_MMA(ai, bj, At, Bt) do { __builtin_amdgcn_s_setprio(1); _Pragma("unroll") for (int m = 0; m < 4; ++m) _Pragma("unroll") for (int n = 0; n < 2; ++n) { \
        if constexpr (FP8) { asm volatile("v_mfma_scale_f32_16x16x128_f8f6f4 %0, %1, %2, %0, %3, %3 op_sel_hi:[0,0,0]" : "+v"(acc[ai][bj][m][n]) : "v"(Bt##8[n]), "v"(At##8[m]), "v"(fp8_one)); } \
        else { _Pragma("unroll") for (int k = 0; k < 2; ++k) acc[ai][bj][m][n] = __builtin_amdgcn_mfma_f32_16x16x32_bf16(Bt[n][k], At[m][k], acc[ai][bj][m][n], 0, 0, 0); } } \
        __builtin_amdgcn_s_setprio(0); } while (0)
#define PG8_WAIT_V(n) asm volatile("s_waitcnt vmcnt(" #n ")" ::: "memory")
#define PG8_WAIT_L(n) asm volatile("s_waitcnt lgkmcnt(" #n ")" ::: "memory")
#define PG8_BAR __builtin_amdgcn_s_barrier()
#define PG8_SCHED __builtin_amdgcn_sched_barrier(0)
#define PG8_SCHED8 do { if constexpr (FP8) __builtin_amdgcn_sched_barrier(0); } while (0)
#define PG8_OFFS(u, ubA, ubB, vA) do { ubB = ((size_t)S.rowB(u, 0) * (size_t)g.ldb) * 2; \
        if constexpr (GA) { ubA = 0; _Pragma("unroll") for (int _h = 0; _h < 2; ++_h) _Pragma("unroll") for (int _i = 0; _i < 2; ++_i) vA[_h][_i] = ((unsigned)S.rowA(u, _h * HALF + sR[_i]) * (unsigned)g.lda + (unsigned)sC[_i]) * 2u; } \
        else { ubA = ((size_t)S.rowA(u, 0) * (size_t)g.lda + (size_t)S.colA(u)) * 2; } } while (0)
    Unit cur, nxt; int ui = 0;
    if (!S.next(0, cur)) return;
    f32x4 acc[2][2][4][2];
#pragma unroll
    for (int a = 0; a < 2; ++a)
#pragma unroll
        for (int b = 0; b < 2; ++b)
#pragma unroll
            for (int m = 0; m < 4; ++m)
#pragma unroll
                for (int n = 0; n < 2; ++n) acc[a][b][m][n] = (f32x4){0.f, 0.f, 0.f, 0.f};
    const int fp8_one = 0x7f7f7f7f;
    bf16x8 At[4][2], B0[2][2], B1[2][2]; v8i32 At8[4], B08[2], B18[2];
    size_t ubAc, ubBc, ubAn, ubBn; unsigned vAc[2][2] = {}, vAn[2][2] = {};
    PG8_OFFS(cur, ubAc, ubBc, vAc);
    PG8_STAGE_B(PG8_SB(0, 0), ubBc, 0, 0); PG8_STAGE_B(PG8_SB(0, 1), ubBc, 1, 0); PG8_STAGE_A(PG8_SA(0, 0), ubAc, vAc, 0, 0); PG8_STAGE_A(PG8_SA(0, 1), ubAc, vAc, 1, 0);
    if (wr == 1) PG8_BAR;
    PG8_WAIT_V(2); PG8_BAR;
    PG8_STAGE_B(PG8_SB(1, 0), ubBc, 0, 128); PG8_STAGE_A(PG8_SA(1, 0), ubAc, vAc, 0, 128); PG8_STAGE_B(PG8_SB(1, 1), ubBc, 1, 128);
    PG8_WAIT_V(6); PG8_BAR;
    for (;;) {
        const bool has_next = S.next(ui + 1, nxt);
        if (has_next) { PG8_OFFS(nxt, ubAn, ubBn, vAn); }
        else { ubAn = ubAc; ubBn = ubBc;
#pragma unroll
            for (int h = 0; h < 2; ++h)
#pragma unroll
                for (int i = 0; i < 2; ++i) vAn[h][i] = vAc[h][i]; }
        for (int t = 0; t < nt; t += 2) {
            const bool last = (t == nt - 2);
            const unsigned k1 = (unsigned)(t + 1) * 128u, k2 = last ? 0u : (unsigned)(t + 2) * 128u, k3 = k2 + 128u;
            const size_t xubA = last ? ubAn : ubAc, xubB = last ? ubBn : ubBc;
            unsigned xA[2][2];
#pragma unroll
            for (int h = 0; h < 2; ++h)
#pragma unroll
                for (int i = 0; i < 2; ++i) xA[h][i] = last ? vAn[h][i] : vAc[h][i];
            PG8_LDB(B0, 0, 0); PG8_LDB(B1, 0, 1); PG8_SCHED; PG8_LDA(At, 0, 0); PG8_STAGE_A(PG8_SA(1, 1), ubAc, vAc, 1, k1);
            PG8_WAIT_V(8); PG8_WAIT_L(0); PG8_SCHED8; PG8_BAR; PG8_MMA(0, 0, At, B0); PG8_MMA(0, 1, At, B1); PG8_SCHED8; PG8_BAR; PG8_SCHED;
            PG8_LDA(At, 0, 1); PG8_STAGE_B(PG8_SB(0, 0), xubB, 0, k2); PG8_STAGE_B(PG8_SB(0, 1), xubB, 1, k2); PG8_STAGE_A(PG8_SA(0, 0), xubA, xA, 0, k2);
            PG8_WAIT_V(8); PG8_WAIT_L(0); PG8_SCHED8; PG8_BAR; PG8_MMA(1, 0, At, B0); PG8_MMA(1, 1, At, B1); PG8_SCHED8; PG8_BAR; PG8_SCHED;
            PG8_LDB(B0, 1, 0); PG8_LDB(B1, 1, 1); PG8_SCHED; PG8_LDA(At, 1, 0); PG8_STAGE_A(PG8_SA(0, 1), xubA, xA, 1, k2);
            PG8_WAIT_V(8); PG8_WAIT_L(0); PG8_SCHED8; PG8_BAR; PG8_MMA(0, 0, At, B0); PG8_MMA(0, 1, At, B1); PG8_SCHED8; PG8_BAR; PG8_SCHED;
            PG8_LDA(At, 1, 1); PG8_STAGE_B(PG8_SB(1, 0), xubB, 0, k3); PG8_STAGE_B(PG8_SB(1, 1), xubB, 1, k3); PG8_STAGE_A(PG8_SA(1, 0), xubA, xA, 0, k3);
            PG8_WAIT_V(8); PG8_WAIT_L(0); PG8_SCHED8; PG8_BAR; PG8_MMA(1, 0, At, B0); PG8_MMA(1, 1, At, B1); PG8_SCHED8; PG8_BAR; PG8_SCHED;
        }
        if (wr == 0) PG8_BAR;
        E(acc, cur, wr, wc, fr, fq);
        if (!has_next) break;
#pragma unroll
        for (int a = 0; a < 2; ++a)
#pragma unroll
            for (int b = 0; b < 2; ++b)
#pragma unroll
                for (int m = 0; m < 4; ++m)
#pragma unroll
                    for (int n = 0; n < 2; ++n) acc[a][b][m][n] = (f32x4){0.f, 0.f, 0.f, 0.f};
        cur = nxt; ++ui; ubAc = ubAn; ubBc = ubBn;
#pragma unroll
        for (int h = 0; h < 2; ++h)
#pragma unroll
            for (int i = 0; i < 2; ++i) vAc[h][i] = vAn[h][i];
        if (wr == 1) PG8_BAR;
    }
    PG8_WAIT_V(0);
    PG8_BAR;
#undef PG8_SA
#undef PG8_SB
#undef PG8_STAGE
#undef PG8_STAGE_A
#undef PG8_STAGE_B
#undef PG8_LDA
#undef PG8_LDB
#undef PG8_MMA
#undef PG8_RD
#undef PG8_CAT2
#undef PG8_WAIT_V
#undef PG8_WAIT_L
#undef PG8_BAR
#undef PG8_SCHED
#undef PG8_SCHED8
#undef PG8_OFFS
}
}
namespace pg8 {
struct EpiBf16 {
    static constexpr bool PERM = true;
    bf16_t* O; int ldc; int split_cols; size_t split_stride; float scale0; float scale_all = 1.0f;
    unsigned* nrm = nullptr; LAS float* red = nullptr;
    __device__ __forceinline__ void operator()(const f32x4 (&acc)[2][2][4][2], const Unit& u, int wr, int wc, int fr, int fq) const {
        const int row0 = u.pm * BM + wr * 64 + fr; int colt = u.pn * BM; bf16_t* base = O; int t = 0;
        float sc = scale_all; if (split_cols) { t = colt / split_cols; base += (size_t)t * split_stride; colt -= t * split_cols; if (t == 0) sc *= scale0; }
        const int col0 = colt + wc * 32 + 8 * fq;
        const bool norms = nrm != nullptr && t < 2;
        float sq[16];
#pragma unroll
        for (int ai = 0; ai < 2; ++ai)
#pragma unroll
            for (int m = 0; m < 4; ++m) { bf16_t* rowp = base + (size_t)(row0 + ai * HALF + m * 16) * ldc + col0;
#pragma unroll
                for (int bj = 0; bj < 2; ++bj) { const f32x4 v0 = acc[ai][bj][m][0] * sc, v1 = acc[ai][bj][m][1] * sc;
                    u32x4 w; w.x = cvt_pk_bf16(v0[0], v0[1]); w.y = cvt_pk_bf16(v0[2], v0[3]); w.z = cvt_pk_bf16(v1[0], v1[1]); w.w = cvt_pk_bf16(v1[2], v1[3]);
                    *(u32x4*)(rowp + bj * HALF) = w;
                    if (norms) { float s = 0.f;
#pragma unroll
                        for (int k = 0; k < 4; ++k) { const float lo = bflo(w[k]), hi = bfhi(w[k]); s = fmaf(lo, lo, s); s = fmaf(hi, hi, s); }
                        s += __shfl_xor(s, 16); s += __shfl_xor(s, 32); sq[(ai * 4 + m) * 2 + bj] = s; } } }
        if (norms) {
            int frn = fr, wv = wr * 4 + wc; asm volatile("" : "+v"(frn), "+s"(wv));
            fr = frn;
            if (fq == 0) {
#pragma unroll
                for (int i = 0; i < 16; ++i) red[(wv * 16 + i) * 16 + fr] = sq[i]; }
            asm volatile("s_waitcnt lgkmcnt(0)" ::: "memory"); __builtin_amdgcn_s_barrier(); asm volatile("" ::: "memory");
            float mx[2] = {0.f, 0.f};
#pragma unroll
            for (int i = 0; i < 16; ++i) mx[i & 1] = fmaxf(mx[i & 1], sq[i] + red[((wv ^ 1) * 16 + i) * 16 + fr]);
#pragma unroll
            for (int bj = 0; bj < 2; ++bj) { float v = mx[bj]; v = fmaxf(v, __shfl_xor(v, 1)); v = fmaxf(v, __shfl_xor(v, 2)); v = fmaxf(v, __shfl_xor(v, 4)); v = fmaxf(v, __shfl_xor(v, 8));
                if (fr == 0 && fq == 0 && (wc & 1) == 0) atomicMax(nrm + t * 32 + (u.pm >> 5) * 16 + ((colt >> 7) + bj) * 2 + (wc >> 1), __float_as_uint(v)); }
        }
    }
};
struct EpiFilt {
    static constexpr bool PERM = true;
    bf16_t* O;
    __device__ __forceinline__ void operator()(const f32x4 (&acc)[2][2][4][2], const Unit& u, int wr, int wc, int fr, int fq) const {
        const float dmin = -3.0701134573253945f, dmax = -15.350567286626973f;
#pragma unroll
        for (int ai = 0; ai < 2; ++ai)
#pragma unroll
            for (int m = 0; m < 4; ++m) { const int row = u.pm * BM + ai * HALF + wr * 64 + m * 16 + fr; const int c = row & 1023;
                const float dl2 = fabsf(dmin + (float)c * ((dmax - dmin) / 1023.0f)) * (1.4426950408889634f / 8191.0f);
#pragma unroll
                for (int bj = 0; bj < 2; ++bj) { const int col = u.pn * BM + bj * HALF + wc * 32 + 8 * fq; float v[8];
#pragma unroll
                    for (int n = 0; n < 2; ++n)
#pragma unroll
                        for (int j = 0; j < 4; ++j) v[n * 4 + j] = acc[ai][bj][m][n][j] * __builtin_amdgcn_exp2f(-(float)(col + n * 4 + j) * dl2);
                    u32x4 w; w.x = cvt_pk_bf16(v[0], v[1]); w.y = cvt_pk_bf16(v[2], v[3]); w.z = cvt_pk_bf16(v[4], v[5]); w.w = cvt_pk_bf16(v[6], v[7]);
                    *(u32x4*)(O + (size_t)row * 8192 + col) = w; }
                asm volatile("" ::: "memory"); }
    }
};
struct EpiResF32 {
    static constexpr bool PERM = false;
    const float* res; float* O; int ldc; float alpha;
    __device__ __forceinline__ void operator()(const f32x4 (&acc)[2][2][4][2], const Unit& u, int wr, int wc, int fr, int fq) const {
#pragma unroll
        for (int ai = 0; ai < 2; ++ai)
#pragma unroll
            for (int m = 0; m < 4; ++m) { const size_t off = (size_t)(u.pm * BM + ai * HALF + wr * 64 + m * 16 + fr) * ldc + u.pn * BM + wc * 32 + 4 * fq;
#pragma unroll
                for (int bj = 0; bj < 2; ++bj)
#pragma unroll
                    for (int n = 0; n < 2; ++n) { const f32x4 r = *(const f32x4*)(res + off + bj * HALF + n * 16); *(f32x4*)(O + off + bj * HALF + n * 16) = r * alpha + acc[ai][bj][m][n]; }
                if (m & 1) asm volatile("" ::: "memory"); }
    }
};
struct EpiResBf {
    static constexpr bool PERM = true;
    const bf16_t* res; bf16_t* O; int ldc; float alpha; float ascale = 1.0f;
    __device__ __forceinline__ void operator()(const f32x4 (&acc)[2][2][4][2], const Unit& u, int wr, int wc, int fr, int fq) const {
#pragma unroll
        for (int ai = 0; ai < 2; ++ai)
#pragma unroll
            for (int m = 0; m < 4; ++m) { const size_t off = (size_t)(u.pm * BM + ai * HALF + wr * 64 + m * 16 + fr) * ldc + u.pn * BM + wc * 32 + 8 * fq;
#pragma unroll
                for (int bj = 0; bj < 2; ++bj) { const u32x4 r = *(const u32x4*)(res + off + bj * HALF); const f32x4 a0 = acc[ai][bj][m][0] * ascale, a1 = acc[ai][bj][m][1] * ascale;
                    u32x4 w; w.x = cvt_pk_bf16(bflo(r.x) * alpha + a0[0], bfhi(r.x) * alpha + a0[1]); w.y = cvt_pk_bf16(bflo(r.y) * alpha + a0[2], bfhi(r.y) * alpha + a0[3]);
                    w.z = cvt_pk_bf16(bflo(r.z) * alpha + a1[0], bfhi(r.z) * alpha + a1[1]); w.w = cvt_pk_bf16(bflo(r.w) * alpha + a1[2], bfhi(r.w) * alpha + a1[3]);
                    *(u32x4*)(O + off + bj * HALF) = w; }
                if (m & 1) asm volatile("" ::: "memory"); }
    }
};
struct EpiSwiglu {
    static constexpr bool PERM = true;
    bf16_t* O;
    __device__ __forceinline__ void operator()(const f32x4 (&acc)[2][2][4][2], const Unit& u, int wr, int wc, int fr, int fq) const {
#pragma unroll
        for (int ai = 0; ai < 2; ++ai)
#pragma unroll
            for (int m = 0; m < 4; ++m) { bf16_t* p = O + (size_t)(u.pm * BM + ai * HALF + wr * 64 + m * 16 + fr) * DFF + u.pn * HALF + wc * 32 + 8 * fq;
                float h[8];
#pragma unroll
                for (int n = 0; n < 2; ++n)
#pragma unroll
                    for (int j = 0; j < 4; ++j) { const float gt = acc[ai][0][m][n][j], up = acc[ai][1][m][n][j]; h[n * 4 + j] = gt * sigmoidf_(gt) * up; }
                u32x4 w; w.x = cvt_pk_bf16(h[0], h[1]); w.y = cvt_pk_bf16(h[2], h[3]); w.z = cvt_pk_bf16(h[4], h[5]); w.w = cvt_pk_bf16(h[6], h[7]);
                *(u32x4*)p = w; }
    }
};
__device__ __forceinline__ float clamp_fp8(float x) { return __builtin_amdgcn_fmed3f(x, -448.0f, 448.0f); }
__device__ __forceinline__ unsigned pk4_fp8(float a, float b, float c, float d) { int w = 0; w = __builtin_amdgcn_cvt_pk_fp8_f32(clamp_fp8(a), clamp_fp8(b), w, false); w = __builtin_amdgcn_cvt_pk_fp8_f32(clamp_fp8(c), clamp_fp8(d), w, true); return (unsigned)w; }
constexpr float FP8_SW = 64.0f, FP8_SH = 8.0f;
struct EpiSwiglu8 {
    static constexpr bool PERM = true;
    unsigned char* O;
    __device__ __forceinline__ void operator()(const f32x4 (&acc)[2][2][4][2], const Unit& u, int wr, int wc, int fr, int fq) const {
#pragma unroll
        for (int ai = 0; ai < 2; ++ai)
#pragma unroll
            for (int m = 0; m < 4; ++m) { unsigned char* p = O + (size_t)(u.pm * BM + ai * HALF + wr * 64 + m * 16 + fr) * DFF + u.pn * HALF + wc * 32 + 8 * fq;
                float h[8];
#pragma unroll
                for (int n = 0; n < 2; ++n)
#pragma unroll
                    for (int j = 0; j < 4; ++j) { const float gt = acc[ai][0][m][n][j] * (1.0f / FP8_SW), up = acc[ai][1][m][n][j] * (1.0f / FP8_SW); h[n * 4 + j] = gt * sigmoidf_(gt) * up * FP8_SH; }
                u32x2 w; w.x = pk4_fp8(h[0], h[1], h[2], h[3]); w.y = pk4_fp8(h[4], h[5], h[6], h[7]);
                *(u32x2*)p = w; }
    }
};
struct EpiDown {
    static constexpr bool PERM = true;
    bf16_t* O; const int* rowlist; const float* gatew; float oscale;
    __device__ __forceinline__ void operator()(const f32x4 (&acc)[2][2][4][2], const Unit& u, int wr, int wc, int fr, int fq) const {
#pragma unroll
        for (int ai = 0; ai < 2; ++ai)
#pragma unroll
            for (int m = 0; m < 4; ++m) { const int idx = u.t * BM + ai * HALF + wr * 64 + m * 16 + fr;
                if (idx < u.cnt) { const int a = rowlist[(size_t)u.e * ECAP + idx]; const float gw = gatew[a] * oscale;
                    bf16_t* p = O + (size_t)a * DM + u.pn * BM + wc * 32 + 8 * fq;
#pragma unroll
                    for (int bj = 0; bj < 2; ++bj) { const f32x4 v0 = acc[ai][bj][m][0] * gw, v1 = acc[ai][bj][m][1] * gw;
                        u32x4 w; w.x = cvt_pk_bf16(v0[0], v0[1]); w.y = cvt_pk_bf16(v0[2], v0[3]); w.z = cvt_pk_bf16(v1[0], v1[1]); w.w = cvt_pk_bf16(v1[2], v1[3]);
                        *(u32x4*)(p + bj * HALF) = w; } } }
    }
};
constexpr float RG_SLA = 4096.0f, RG_SB = 64.0f;
struct EpiRG {
    static constexpr bool PERM = true;
    bf16_t* LA; bf16_t* BB; const bf16_t* XC; const float* ba; const float* bx; const float* lam;
    __device__ __forceinline__ void operator()(const f32x4 (&acc)[2][2][4][2], const Unit& u, int wr, int wc, int fr, int fq) const {
        const int nb = u.pn >> 2, q = u.pn & 3, dir = q >> 1, half = q & 1;
        const int ch0 = nb * 256 + half * HALF + wc * 32 + 8 * fq;
        float vba[8], vbx[8], vsp[8];
#pragma unroll
        for (int j = 0; j < 8; ++j) { vba[j] = ba[dir * DM + ch0 + j]; vbx[j] = bx[dir * DM + ch0 + j];
            const float x = __expf(-lam[dir * DM + ch0 + j]);
            vsp[j] = 8.0f * (x < 0.05f ? x * (1.0f - x * (0.5f - x * (0.33333334f - 0.25f * x))) : __logf(1.0f + x)); }
#pragma unroll
        for (int ai = 0; ai < 2; ++ai)
#pragma unroll
            for (int m = 0; m < 4; ++m) { const size_t tok = (size_t)(u.pm * BM + ai * HALF + wr * 64 + m * 16 + fr);
                asm volatile("" ::: "memory");
                const u32x4 xw = *(const u32x4*)(XC + tok * DM + ch0);
                float xf[8] = {bflo(xw.x), bfhi(xw.x), bflo(xw.y), bfhi(xw.y), bflo(xw.z), bfhi(xw.z), bflo(xw.w), bfhi(xw.w)};
                float la[8], bb[8];
#pragma unroll
                for (int n = 0; n < 2; ++n)
#pragma unroll
                    for (int j = 0; j < 4; ++j) { const int k = n * 4 + j;
                        const float r = sigmoidf_(acc[ai][0][m][n][j] + vba[k]), ig = sigmoidf_(acc[ai][1][m][n][j] + vbx[k]);
                        const float l = -r * vsp[k]; la[k] = l; bb[k] = __builtin_amdgcn_sqrtf(fmaxf(1.0f - __builtin_amdgcn_exp2f(2.8853900817779268f * l), 0.f)) * (ig * xf[k]); }
                u32x2 w; w.x = pk4_fp8(RG_SLA * la[0], RG_SLA * la[1], RG_SLA * la[2], RG_SLA * la[3]); w.y = pk4_fp8(RG_SLA * la[4], RG_SLA * la[5], RG_SLA * la[6], RG_SLA * la[7]);
                *(u32x2*)((unsigned char*)LA + ((size_t)dir * NTOK + tok) * DM + ch0) = w;
                w.x = pk4_fp8(RG_SB * bb[0], RG_SB * bb[1], RG_SB * bb[2], RG_SB * bb[3]); w.y = pk4_fp8(RG_SB * bb[4], RG_SB * bb[5], RG_SB * bb[6], RG_SB * bb[7]);
                *(u32x2*)((unsigned char*)BB + ((size_t)dir * NTOK + tok) * DM + ch0) = w; }
    }
};

struct RGOrder {
    static constexpr bool GATHER_A = false;
    int G, c;
    __device__ __forceinline__ bool next(int i, Unit& u) const {
        if (G == 256) { if (i >= 8) return false; const int x = c & 7, y = c >> 3; u.pm = i * 8 + (y >> 2); u.pn = x * 4 + (y & 3); }
        else { const int L = i * G + c; if (L >= 64 * 32) return false; u.pm = L >> 5; u.pn = L & 31; }
        u.e = 0; u.t = 0; u.cnt = 0; return true; }
    __device__ __forceinline__ int rowA(const Unit& u, int r) const { return u.pm * BM + r; }
    __device__ __forceinline__ int colA(const Unit& u) const { return (u.pn >> 2) * 256; }
    __device__ __forceinline__ int rowB(const Unit& u, int r) const { return u.pn * BM + r; }
};
template <int NPN, bool GATHER>
struct MoeOrder {
    static constexpr bool GATHER_A = GATHER;
    int G, c; const LAS int* tab; const int* rowlist; int L0 = 0, L1 = 1 << 30;
    __device__ __forceinline__ bool next(int i, Unit& u) const {
        const int L = L0 + i * G + c, ntile = tab[32]; if (L >= ntile * NPN || L >= L1 || c < 0) return false;
        const int tile = L / NPN; u.pm = tile; u.pn = L % NPN; int e = 0;
        while (e < 31 && tab[e + 1] <= tile) ++e;
        u.e = e; u.t = tile - tab[e]; u.cnt = tab[64 + e]; return true;
    }
    __device__ __forceinline__ int rowA(const Unit& u, int r) const {
        if (GATHER) { const int idx = u.t * BM + r; const int a = idx < u.cnt ? rowlist[(size_t)u.e * ECAP + idx] : 0; return a >> 1; }
        return u.pm * BM + r;
    }
    __device__ __forceinline__ int colA(const Unit&) const { return 0; }
    __device__ __forceinline__ int rowB(const Unit& u, int r) const { return (u.e * NPN + u.pn) * BM + r; }
};
}
namespace att {
constexpr int NW = 8, QBLK = 32, KVBLK = 64, LDQ = 1024, LDK = 1024, LDV = 1024, LDO = 1024;
constexpr int SHM_V = KVBLK * 128 * 2, SHM_K = KVBLK * 64 * 2, NSLOT = 4, LDS_K = 0, LDS_V = NSLOT * SHM_K, LDS_WS = NSLOT * (SHM_K + SHM_V), SHM_ATTN = LDS_WS + NW * 64 * 4;
__device__ __forceinline__ void glds16s(const void* sbase, unsigned voff, unsigned lds_dst) { unsigned keep;
    asm volatile("s_mov_b32 %0, m0\n\ts_mov_b32 m0, %3\n\ts_nop 0\n\tglobal_load_lds_dwordx4 %1, %2\n\ts_mov_b32 m0, %0" : "=&s"(keep) : "v"(voff), "s"(sbase), "s"(lds_dst) : "memory"); }
#define WAITBAR(N) asm volatile("s_waitcnt vmcnt(" #N ") lgkmcnt(0)\n\ts_barrier" ::: "memory")
constexpr float THR2 = 8.0f * 1.4426950408889634f;
#define KSWZ64(row, colB) ((row) * 128 + ((colB) ^ ((((row) >> 1) & 7) << 4)))
#define SBAR() __builtin_amdgcn_sched_barrier(0)
__device__ __forceinline__ int crow(int r, int hi) { return (r & 3) + 8 * (r >> 2) + 4 * hi; }
__device__ __forceinline__ void qkt(f32x16& p0, f32x16& p1, const char* Ks, const bf16x8* qr, int r32, int hi, float A, float st) {
    { float b4[4];
#pragma unroll
      for (int j = 0; j < 4; ++j) b4[j] = fmaf(st, (float)j, A);
      const float s8 = 8.0f * st, s32 = 32.0f * st;
#pragma unroll
      for (int r = 0; r < 16; ++r) { p0[r] = (r < 4) ? b4[r] : p0[r - 4] + s8; }
#pragma unroll
      for (int r = 0; r < 16; ++r) p1[r] = p0[r] + s32; }
#pragma unroll
    for (int d0 = 0; d0 < 4; ++d0) { const int cb = (d0 * 16 + hi * 8) * 2;
        const bf16x8 b0 = *reinterpret_cast<const bf16x8*>(Ks + KSWZ64(r32, cb));
        const bf16x8 b1 = *reinterpret_cast<const bf16x8*>(Ks + KSWZ64(32 + r32, cb));
        p0 = __builtin_amdgcn_mfma_f32_32x32x16_bf16(b0, qr[d0], p0, 0, 0, 0);
        p1 = __builtin_amdgcn_mfma_f32_32x32x16_bf16(b1, qr[d0], p1, 0, 0, 0); }
}
__device__ __forceinline__ void partialSM(f32x16& p0, f32x16& p1, bool mixed, float fd, float sl2) {
    if (mixed) {
#pragma unroll
        for (int r = 0; r < 16; ++r) { const float d0 = fd - (float)((r & 3) + 8 * (r >> 2)); p0[r] = fmaf(fabsf(d0), -sl2, p0[r]); p1[r] = fmaf(fabsf(d0 - 32.0f), -sl2, p1[r]); }
    }
#pragma unroll
    for (int r = 0; r < 16; ++r) p0[r] = __builtin_amdgcn_exp2f(p0[r]);
}
__device__ __forceinline__ void finishSM(f32x16& p0, f32x16& p1, float& l_reg, bf16x8& pa0, bf16x8& pa1, bf16x8& pa2, bf16x8& pa3) {
#pragma unroll
    for (int r = 0; r < 16; ++r) p1[r] = __builtin_amdgcn_exp2f(p1[r]);
    float ps = 0;
#pragma unroll
    for (int r = 0; r < 16; ++r) ps += p0[r];
#pragma unroll
    for (int r = 0; r < 16; ++r) ps += p1[r];
    l_reg += ps;
#define PK4(P, BASE, OUT) do { unsigned a0 = cvt_pk_bf16(P[BASE + 0], P[BASE + 1]), a1 = cvt_pk_bf16(P[BASE + 2], P[BASE + 3]);   \
    unsigned b0 = cvt_pk_bf16(P[BASE + 4], P[BASE + 5]), b1 = cvt_pk_bf16(P[BASE + 6], P[BASE + 7]);                              \
    auto r0 = __builtin_amdgcn_permlane32_swap(a0, b0, false, false); auto r1 = __builtin_amdgcn_permlane32_swap(a1, b1, false, false); \
    u32x4 w = {r0[0], r1[0], r0[1], r1[1]}; OUT = __builtin_bit_cast(bf16x8, w); } while (0)
    PK4(p0, 0, pa0); PK4(p0, 8, pa1); PK4(p1, 0, pa2); PK4(p1, 8, pa3);
#undef PK4
}
__device__ __forceinline__ int v_st(int k, int c) { const int kk = (k & ~0xC) | ((k & 4) << 1) | ((k & 8) >> 1); return ((kk >> 3) * 4 + (c >> 5)) * 512 + ((kk & 7) * 32 + (c & 31)) * 2; }
__device__ __forceinline__ int v_rd_base(int lane) { return ((lane & 3) << 3) | (((lane >> 2) & 3) << 6) | (((lane >> 4) & 1) << 5) | (((lane >> 5) & 1) << 8); }
constexpr int v_rd_off(int d0, int ks, int half) { return d0 * 512 + ks * 4096 + half * 2048; }
template <int OFF> __device__ __forceinline__ s16x4 tr_read(int vb) {
    s16x4 r; asm volatile("ds_read_b64_tr_b16 %0, %1 offset:%2" : "=&v"(r) : "v"(vb), "i"(OFF) : "memory"); return r;
}
template <int D0> __device__ __forceinline__ void pv_one(f32x16& od, int vb, bf16x8 pa0, bf16x8 pa1, bf16x8 pa2, bf16x8 pa3) {
    const s16x4 l0 = tr_read<v_rd_off(D0, 0, 0)>(vb), h0 = tr_read<v_rd_off(D0, 0, 1)>(vb), l1 = tr_read<v_rd_off(D0, 1, 0)>(vb), h1 = tr_read<v_rd_off(D0, 1, 1)>(vb);
    const s16x4 l2 = tr_read<v_rd_off(D0, 2, 0)>(vb), h2 = tr_read<v_rd_off(D0, 2, 1)>(vb), l3 = tr_read<v_rd_off(D0, 3, 0)>(vb), h3 = tr_read<v_rd_off(D0, 3, 1)>(vb);
    asm volatile("s_waitcnt lgkmcnt(0)" ::: "memory"); SBAR();
#define PK(L, H) (bf16x8){L[0], L[1], L[2], L[3], H[0], H[1], H[2], H[3]}
    od = __builtin_amdgcn_mfma_f32_32x32x16_bf16(pa0, PK(l0, h0), od, 0, 0, 0);
    od = __builtin_amdgcn_mfma_f32_32x32x16_bf16(pa1, PK(l1, h1), od, 0, 0, 0);
    od = __builtin_amdgcn_mfma_f32_32x32x16_bf16(pa2, PK(l2, h2), od, 0, 0, 0);
    od = __builtin_amdgcn_mfma_f32_32x32x16_bf16(pa3, PK(l3, h3), od, 0, 0, 0);
#undef PK
}
__device__ __forceinline__ void pv_d0(f32x16* o, int vb, bf16x8 pa0, bf16x8 pa1, bf16x8 pa2, bf16x8 pa3) {
    pv_one<0>(o[0], vb, pa0, pa1, pa2, pa3); pv_one<1>(o[1], vb, pa0, pa1, pa2, pa3); pv_one<2>(o[2], vb, pa0, pa1, pa2, pa3); pv_one<3>(o[3], vb, pa0, pa1, pa2, pa3);
}
__device__ __forceinline__ void attn_unit(const bf16_t* __restrict__ Qb, const bf16_t* __restrict__ Kh, const bf16_t* __restrict__ Vh, bf16_t* __restrict__ Ob, int q0, int t_lo, int n, float sl2, char* lds) {
    const int tid = opaque_tid(), wid = __builtin_amdgcn_readfirstlane(tid >> 6), lane = tid & 63, r32 = lane & 31, hi = lane >> 5;
    float* ws = (float*)(lds + LDS_WS) + wid * 64; float* li_l = ws;
    float l_reg = 0; f32x16 o[4] = {}; bf16x8 qr[4];
    const bf16_t* Qw = Qb + (long)(wid * QBLK + r32) * LDQ + hi * 8;
#pragma unroll
    for (int d0 = 0; d0 < 4; ++d0) qr[d0] = *reinterpret_cast<const bf16x8*>(Qw + d0 * 16);
    float negM;
    { const bf16_t* Kw = Kh + (long)(q0 + wid * QBLK + r32) * LDK + hi * 8; float s = 0.f;
#pragma unroll
      for (int d0 = 0; d0 < 4; ++d0) { const u32x4 kw = *reinterpret_cast<const u32x4*>(Kw + d0 * 16); const u32x4 qw = __builtin_bit_cast(u32x4, qr[d0]);
          s += bflo(kw.x) * bflo(qw.x) + bfhi(kw.x) * bfhi(qw.x) + bflo(kw.y) * bflo(qw.y) + bfhi(kw.y) * bfhi(qw.y) + bflo(kw.z) * bflo(qw.z) + bfhi(kw.z) * bfhi(qw.z) + bflo(kw.w) * bflo(qw.w) + bfhi(kw.w) * bfhi(qw.w); }
      auto rr = __builtin_amdgcn_permlane32_swap(__float_as_uint(s), __float_as_uint(s), false, false); negM = -(__uint_as_float(rr[0]) + __uint_as_float(rr[1])); }
    const unsigned lds0 = (unsigned)(uintptr_t)lds;
    const int krow = wid * 8 + (lane >> 3), kch = (lane & 7) ^ ((krow >> 1) & 7);
    const unsigned koff = (unsigned)(krow * LDK * 2 + kch * 16);
    unsigned voff[2];
#pragma unroll
    for (int z = 0; z < 2; ++z) { const int P16 = (wid + 8 * z) * 64 + lane, sub = P16 >> 5, win = P16 & 31, kk = (sub >> 2) * 8 + (win >> 2), k = (kk & ~0xC) | ((kk & 4) << 1) | ((kk & 8) >> 1), c = (sub & 3) * 32 + (win & 3) * 8;
        voff[z] = (unsigned)(k * LDV * 2 + c * 2); }
    const unsigned kdst = lds0 + LDS_K + wid * 1024, vdst = lds0 + LDS_V + wid * 1024;
    const int vb0 = (int)(lds0 + LDS_V) + v_rd_base(lane);
    const char* K_lds = lds + LDS_K;
    const int qw0 = q0 + wid * QBLK;
    const float fq0 = (float)(qw0 + r32 - 4 * hi);
    const char* Kt = (const char*)(Kh + (long)t_lo * KVBLK * LDK); const char* Vt = (const char*)(Vh + (long)t_lo * KVBLK * LDV);
#define DMA(jj, slot) do { const char* kb_ = Kt + (size_t)(jj) * (KVBLK * LDK * 2); const char* vb_ = Vt + (size_t)(jj) * (KVBLK * LDV * 2); \
    glds16s(kb_, koff, (unsigned)__builtin_amdgcn_readfirstlane(kdst + (slot) * SHM_K)); \
    glds16s(vb_, voff[0], (unsigned)__builtin_amdgcn_readfirstlane(vdst + (slot) * SHM_V)); \
    glds16s(vb_, voff[1], (unsigned)__builtin_amdgcn_readfirstlane(vdst + (slot) * SHM_V + 8192)); } while (0)
#define TILE(jj) const int k0_ = (t_lo + (jj)) * KVBLK; const bool left_ = k0_ + 63 < qw0, right_ = k0_ > qw0 + 31, mixed_ = !(left_ || right_); \
    const float fd_ = fq0 - (float)k0_, st_ = left_ ? sl2 : (right_ ? -sl2 : 0.f), A_ = negM - st_ * fd_
    f32x16 pA0, pA1, pB0, pB1; bf16x8 pa0, pa1, pa2, pa3;
    asm volatile("s_waitcnt vmcnt(0)" ::: "memory");
#define SEG_A(PN0, PN1, PO0, PO1, jt, FIN) do { TILE(jt); SBAR(); qkt(PN0, PN1, K_lds + ((jt) & 3) * SHM_K, qr, r32, hi, A_, st_); if (FIN) finishSM(PO0, PO1, l_reg, pa0, pa1, pa2, pa3); SBAR(); } while (0)
#define SEG_B(P0, P1, jt, PV) do { if (PV) pv_d0(o, vb0 + (((jt) - 1) & 3) * SHM_V, pa0, pa1, pa2, pa3); { TILE(jt); partialSM(P0, P1, mixed_, fd_, sl2); } } while (0)
#define STEP_BAR(jt) do { WAITBAR(0); if ((jt) + 2 < n) DMA((jt) + 2, ((jt) + 2) & 3); } while (0)
    const bool lead = wid < 4;
    DMA(0, 0); DMA(1, 1);
    WAITBAR(3);
    SEG_A(pA0, pA1, pB0, pB1, 0, false); if (!lead) STEP_BAR(0); SEG_B(pA0, pA1, 0, false); if (lead) STEP_BAR(0);
    for (int j = 1; j + 1 < n; j += 2) {
        SEG_A(pB0, pB1, pA0, pA1, j, true); if (!lead) STEP_BAR(j); SEG_B(pB0, pB1, j, true); if (lead) STEP_BAR(j);
        SEG_A(pA0, pA1, pB0, pB1, j + 1, true); if (!lead) STEP_BAR(j + 1); SEG_B(pA0, pA1, j + 1, true); if (lead) STEP_BAR(j + 1);
    }
    SEG_A(pB0, pB1, pA0, pA1, n - 1, true); if (!lead) STEP_BAR(n - 1); SEG_B(pB0, pB1, n - 1, true); if (lead) STEP_BAR(n - 1);
    finishSM(pB0, pB1, l_reg, pa0, pa1, pa2, pa3); SBAR();
    pv_d0(o, vb0 + ((n - 1) & 3) * SHM_V, pa0, pa1, pa2, pa3);
    { auto rr = __builtin_amdgcn_permlane32_swap(__float_as_uint(l_reg), __float_as_uint(l_reg), false, false); l_reg = __uint_as_float(rr[0]) + __uint_as_float(rr[1]); }
    if (hi == 0) li_l[r32] = l_reg; asm volatile("s_waitcnt lgkmcnt(0)" ::: "memory");
    float rli[16];
#pragma unroll
    for (int r = 0; r < 16; ++r) rli[r] = __builtin_amdgcn_rcpf(li_l[crow(r, hi)]);
    bf16_t* Ow = Ob + (long)(wid * QBLK) * LDO;
#pragma unroll
    for (int r = 0; r < 16; ++r) { const int orow = crow(r, hi);
#pragma unroll
        for (int d0 = 0; d0 < 4; ++d0) Ow[(long)orow * LDO + d0 * 32 + r32] = (bf16_t)f2bf(o[d0][r] * rli[r]); }
    WAITBAR(0);
#undef DMA
#undef SEG_A
#undef SEG_B
#undef STEP_BAR
#undef TILE
}
#undef SBAR
}

namespace hy {
typedef f32x2 cf;
__device__ __forceinline__ cf lld(const LAS f32x2* L, int i) { return L[i]; }
__device__ __forceinline__ void lst(LAS f32x2* L, int i, cf v) { L[i] = v; }
__device__ __forceinline__ cf cmul(cf a, cf b) { return a * b.xx + a.yx * (b.yy * (cf){-1.f, 1.f}); }
__device__ __forceinline__ cf cmulc(cf a, cf b) { return a * b.xx + a.yx * (b.yy * (cf){1.f, -1.f}); }
__device__ constexpr float C32[16] = {1.0f, 0.98078528040323043f, 0.92387953251128674f, 0.83146961230254524f, 0.70710678118654757f, 0.55557023301960229f, 0.38268343236508984f, 0.19509032201612833f,
                                      0.0f, -0.19509032201612819f, -0.38268343236508973f, -0.55557023301960196f, -0.70710678118654746f, -0.83146961230254535f, -0.92387953251128674f, -0.98078528040323043f};
__device__ constexpr float S32[16] = {0.0f, 0.19509032201612825f, 0.38268343236508978f, 0.55557023301960218f, 0.70710678118654746f, 0.83146961230254524f, 0.92387953251128674f, 0.98078528040323043f,
                                      1.0f, 0.98078528040323043f, 0.92387953251128674f, 0.83146961230254546f, 0.70710678118654757f, 0.55557023301960218f, 0.38268343236508989f, 0.19509032201612861f};
__host__ __device__ constexpr int brev(int k, int bits) { int r = 0; for (int i = 0; i < bits; ++i) r |= ((k >> i) & 1) << (bits - 1 - i); return r; }
template <int R, bool INV> __device__ __forceinline__ void dft_reg(cf (&v)[R]) {
#pragma unroll
    for (int s = R / 2; s >= 1; s >>= 1) {
#pragma unroll
        for (int g0 = 0; g0 < R; g0 += 2 * s) {
#pragma unroll
            for (int j = 0; j < s; ++j) {
                const cf a = v[g0 + j], b = v[g0 + j + s];
                v[g0 + j] = a + b;
                const cf d = a - b;
                const int tw = j * (16 / s);
                if (tw == 0) v[g0 + j + s] = d;
                else if (tw == 8) v[g0 + j + s] = INV ? (cf){-d.y, d.x} : (cf){d.y, -d.x};
                else { const float c = C32[tw], sn = INV ? S32[tw] : -S32[tw]; v[g0 + j + s] = d * c + d.yx * (cf){-sn, sn}; }
            }
        }
    }
}
constexpr int RS = FFT_RS;
__device__ __forceinline__ void fft_fwd12(cf (&v)[32], LAS f32x2* L, int tid) {
    dft_reg<32, false>(v);
    { float s, c; sincospif((float)tid * (1.0f / 8192.0f), &s, &c); cf w1 = {c, -s}; asm volatile("" : "+v"(w1.x), "+v"(w1.y)); cf w = w1;
#pragma unroll
      for (int k1 = 0; k1 < 32; ++k1) { cf x = v[brev(k1, 5)]; if (k1) { x = cmul(x, w); w = cmul(w, w1); } lst(L, k1 * RS + tid, x); } }
    __syncthreads();
    const int k1 = tid >> 4, m2 = tid & 15;
#pragma unroll
    for (int m1 = 0; m1 < 32; ++m1) v[m1] = lld(L, k1 * RS + 16 * m1 + m2);
    __syncthreads();
    dft_reg<32, false>(v);
    { float s, c; sincospif((float)m2 * (1.0f / 256.0f), &s, &c); cf w1 = {c, -s}; asm volatile("" : "+v"(w1.x), "+v"(w1.y)); cf w = w1;
#pragma unroll
      for (int j1 = 0; j1 < 32; ++j1) { cf x = v[brev(j1, 5)]; if (j1) { x = cmul(x, w); w = cmul(w, w1); } lst(L, k1 * RS + 33 * m2 + j1, x); } }
    __syncthreads();
}
__device__ __forceinline__ void fft_inv21(cf (&v)[32], LAS f32x2* L, int tid) {
    const int k1 = tid >> 4, m2 = tid & 15;
    { float s, c; sincospif((float)m2 * (1.0f / 256.0f), &s, &c); cf w1 = {c, -s}; asm volatile("" : "+v"(w1.x), "+v"(w1.y)); cf w = w1;
#pragma unroll
      for (int j1 = 0; j1 < 32; ++j1) { cf x = lld(L, k1 * RS + 33 * m2 + j1); if (j1) { x = cmulc(x, w); w = cmul(w, w1); } v[j1] = x; } }
    __syncthreads();
    dft_reg<32, true>(v);
#pragma unroll
    for (int m1 = 0; m1 < 32; ++m1) lst(L, k1 * RS + 16 * m1 + m2, v[brev(m1, 5)]);
    __syncthreads();
    { float s, c; sincospif((float)tid * (1.0f / 8192.0f), &s, &c); cf w1 = {c, -s}; asm volatile("" : "+v"(w1.x), "+v"(w1.y)); cf w = w1;
#pragma unroll
      for (int kk = 0; kk < 32; ++kk) { cf x = lld(L, kk * RS + tid); if (kk) { x = cmulc(x, w); w = cmul(w, w1); } v[kk] = x; } }
    dft_reg<32, true>(v);
}
}

namespace hm {
typedef f32x2 cf;
constexpr int ROWA = 40, ROWB = 24;
constexpr int PL_A = 512 * ROWA * 2, PL_B = 1024 * ROWB * 2;
__device__ __forceinline__ int crow(int r, int hi) { return (r & 3) + 8 * (r >> 2) + 4 * hi; }
struct CFrag { bf16x8 re, im, nim; };
__device__ __forceinline__ CFrag dft_frag(int n, int row, int k0, bool valid) {
    unsigned wr[4], wi[4], wn[4];
#pragma unroll
    for (int t = 0; t < 4; ++t) { float s0, c0, s1, c1; sincospif(-2.0f * (float)((row * (k0 + 2 * t)) % n) / (float)n, &s0, &c0); sincospif(-2.0f * (float)((row * (k0 + 2 * t + 1)) % n) / (float)n, &s1, &c1);
        if (!valid) { s0 = c0 = s1 = c1 = 0.f; }
        wr[t] = pk2(c0, c1); wi[t] = pk2(s0, s1); wn[t] = pk2(-s0, -s1); }
    CFrag f; f.re = __builtin_bit_cast(bf16x8, (u32x4){wr[0], wr[1], wr[2], wr[3]}); f.im = __builtin_bit_cast(bf16x8, (u32x4){wi[0], wi[1], wi[2], wi[3]}); f.nim = __builtin_bit_cast(bf16x8, (u32x4){wn[0], wn[1], wn[2], wn[3]});
    return f;
}
template <bool CONJ> __device__ __forceinline__ void cmfma(f32x16& dr, f32x16& di, const CFrag& a, bf16x8 br, bf16x8 bi) {
    dr = __builtin_amdgcn_mfma_f32_32x32x16_bf16(a.re, br, dr, 0, 0, 0); dr = __builtin_amdgcn_mfma_f32_32x32x16_bf16(CONJ ? a.im : a.nim, bi, dr, 0, 0, 0);
    di = __builtin_amdgcn_mfma_f32_32x32x16_bf16(a.re, bi, di, 0, 0, 0); di = __builtin_amdgcn_mfma_f32_32x32x16_bf16(CONJ ? a.nim : a.im, br, di, 0, 0, 0);
}
__device__ __forceinline__ cf cmul(cf a, cf b) { return a * b.xx + a.yx * (b.yy * (cf){-1.f, 1.f}); }
__device__ __forceinline__ cf cmulc(cf a, cf b) { return a * b.xx + a.yx * (b.yy * (cf){1.f, -1.f}); }
__device__ __forceinline__ bf16x8 pk4(const float (&P)[8]) {
    const unsigned a0 = cvt_pk_bf16(P[0], P[1]), a1 = cvt_pk_bf16(P[2], P[3]), b0 = cvt_pk_bf16(P[4], P[5]), b1 = cvt_pk_bf16(P[6], P[7]);
    auto r0 = __builtin_amdgcn_permlane32_swap(a0, b0, false, false); auto r1 = __builtin_amdgcn_permlane32_swap(a1, b1, false, false);
    return __builtin_bit_cast(bf16x8, (u32x4){r0[0], r1[0], r0[1], r1[1]});
}
constexpr int LDS_FTAB = 98304, LDS_TW1 = 110592, LDS_TW2 = 143360;
struct Consts { const LAS unsigned char* T; int lane;
    __device__ __forceinline__ CFrag get(int which) const { const LAS unsigned char* p = T + (which * 64 + lane) * 48; CFrag f; f.re = *(const LAS bf16x8*)p; f.im = *(const LAS bf16x8*)(p + 16); f.nim = *(const LAS bf16x8*)(p + 32); return f; } };
__device__ __forceinline__ cf tw1(const LAS unsigned* T1, int e) { const unsigned w = T1[e & 8191]; const float2 t = __half22float2(__builtin_bit_cast(__half2, w)); const float sg = (e & 8192) ? -1.0f : 1.0f; return (cf){t.x * sg, t.y * sg}; }
__device__ __forceinline__ void build_tw(LAS unsigned char* lds, int tid) {
    LAS unsigned* T1 = (LAS unsigned*)(lds + LDS_TW1); LAS f32x2* T2 = (LAS f32x2*)(lds + LDS_TW2);
#pragma unroll 4
    for (int i = 0; i < 16; ++i) { const int e = tid + 512 * i; float sn, cs; sincospif(-2.0f * (float)e * (1.0f / 16384.0f), &sn, &cs); T1[e] = __builtin_bit_cast(unsigned, __floats2half2_rn(cs, sn)); }
    { const int j1 = tid >> 4, m2 = tid & 15; float sn, cs; sincospif(-2.0f * (float)((j1 * m2) & 511) * (1.0f / 512.0f), &sn, &cs); T2[tid] = (f32x2){cs, sn}; }
}
__device__ __forceinline__ void build_ftab(LAS unsigned char* T, int tid) {
    if (tid < 64) { const int j = tid & 31, hi = tid >> 5;
        const CFrag f0 = dft_frag(32, j, 8 * hi, true), f1 = dft_frag(32, j, 16 + 8 * hi, true), g = dft_frag(16, j & 15, 8 * hi, j < 16);
        LAS bf16x8* p = (LAS bf16x8*)(T + tid * 48); p[0] = f0.re; p[1] = f0.im; p[2] = f0.nim;
        p = (LAS bf16x8*)(T + (64 + tid) * 48); p[0] = f1.re; p[1] = f1.im; p[2] = f1.nim;
        p = (LAS bf16x8*)(T + (128 + tid) * 48); p[0] = g.re; p[1] = g.im; p[2] = g.nim; }
    __syncthreads();
}
__device__ __forceinline__ void st2(LAS unsigned char* L, int plane_bytes, int idx, cf v) { const unsigned w = cvt_pk_bf16(v.x, v.y); ((LAS bf16_t*)L)[idx] = (bf16_t)(w & 0xffffu); ((LAS bf16_t*)(L + plane_bytes))[idx] = (bf16_t)(w >> 16); }
template <int NK> __device__ __forceinline__ void fwd12(const Consts& C, const bf16x8 (&Bre)[2][NK], const bf16x8 (&Bim)[2][NK], LAS unsigned char* L, const LAS unsigned* TW1, const LAS f32x2* TW2, int wave, int j, int hi) {
    asm volatile("" : "+v"(j), "+v"(hi));
#pragma unroll
    for (int tl = 0; tl < 2; ++tl) { const int n2 = 64 * wave + 32 * tl + j; f32x16 dr = {}, di = {};
        cmfma<false>(dr, di, C.get(0), Bre[tl][0], Bim[tl][0]); if constexpr (NK == 2) cmfma<false>(dr, di, C.get(1), Bre[tl][1], Bim[tl][1]);
#pragma unroll
        for (int r = 0; r < 16; ++r) { const int k1 = crow(r, hi); st2(L, PL_A, (k1 * 16 + (n2 & 15)) * ROWA + (n2 >> 4), cmul((cf){dr[r], di[r]}, tw1(TW1, k1 * n2))); } }
    __syncthreads();
    asm volatile("" : "+v"(j), "+v"(hi));
    bf16x8 yre[2][2], yim[2][2];
#pragma unroll
    for (int tl = 0; tl < 2; ++tl) { const int col = (4 * wave + 2 * tl + (j >> 4)) * 16 + (j & 15);
#pragma unroll
        for (int ks = 0; ks < 2; ++ks) { yre[tl][ks] = *(const LAS bf16x8*)(L + (col * ROWA + 16 * ks + 8 * hi) * 2); yim[tl][ks] = *(const LAS bf16x8*)(L + PL_A + (col * ROWA + 16 * ks + 8 * hi) * 2); } }
    __syncthreads();
    asm volatile("" : "+v"(j), "+v"(hi));
#pragma unroll
    for (int tl = 0; tl < 2; ++tl) { const int k1 = 4 * wave + 2 * tl + (j >> 4), m2 = j & 15; f32x16 dr = {}, di = {};
        cmfma<false>(dr, di, C.get(0), yre[tl][0], yim[tl][0]); cmfma<false>(dr, di, C.get(1), yre[tl][1], yim[tl][1]);
#pragma unroll
        for (int r = 0; r < 16; ++r) { const int j1 = crow(r, hi); st2(L, PL_B, (k1 * 32 + j1) * ROWB + m2, cmul((cf){dr[r], di[r]}, TW2[j1 * 16 + m2])); } }
    __syncthreads();
}
__device__ __forceinline__ void inv21(const Consts& C, cf (&y)[2][8], LAS unsigned char* L, const LAS unsigned* TW1, int wave, int j, int hi) {
    asm volatile("" : "+v"(j), "+v"(hi));
    bf16x8 yre[2][2], yim[2][2];
#pragma unroll
    for (int tl = 0; tl < 2; ++tl) { const int col = (4 * wave + 2 * tl + (j >> 4)) * 16 + (j & 15);
#pragma unroll
        for (int ks = 0; ks < 2; ++ks) { yre[tl][ks] = *(const LAS bf16x8*)(L + (col * ROWA + 16 * ks + 8 * hi) * 2); yim[tl][ks] = *(const LAS bf16x8*)(L + PL_A + (col * ROWA + 16 * ks + 8 * hi) * 2); } }
    __syncthreads();
    asm volatile("" : "+v"(j), "+v"(hi));
#pragma unroll
    for (int tl = 0; tl < 2; ++tl) { const int k1 = 4 * wave + 2 * tl + (j >> 4), m2 = j & 15; f32x16 dr = {}, di = {};
        cmfma<true>(dr, di, C.get(0), yre[tl][0], yim[tl][0]); cmfma<true>(dr, di, C.get(1), yre[tl][1], yim[tl][1]);
#pragma unroll
        for (int r = 0; r < 16; ++r) { const int n2 = 16 * crow(r, hi) + m2; st2(L, PL_A, n2 * ROWA + k1, cmulc((cf){dr[r], di[r]}, tw1(TW1, k1 * n2))); } }
    __syncthreads();
    asm volatile("" : "+v"(j), "+v"(hi));
#pragma unroll
    for (int tl = 0; tl < 2; ++tl) { const int n2 = 64 * wave + 32 * tl + j; f32x16 dr = {}, di = {};
#pragma unroll
        for (int ks = 0; ks < 2; ++ks) { const bf16x8 br = *(const LAS bf16x8*)(L + (n2 * ROWA + 16 * ks + 8 * hi) * 2), bi = *(const LAS bf16x8*)(L + PL_A + (n2 * ROWA + 16 * ks + 8 * hi) * 2);
            cmfma<true>(dr, di, C.get(ks), br, bi); }
#pragma unroll
        for (int r = 0; r < 8; ++r) y[tl][r] = (cf){dr[r], di[r]}; }
    __syncthreads();
}
}
constexpr size_t MiB = 1u << 20;
constexpr size_t WS_CTL = 0, CTL_ZERO_BYTES = 1 * MiB;
constexpr size_t WS_W1T = 1 * MiB;
constexpr size_t WS_W2T = 257 * MiB;
constexpr size_t WS_WIN_EV = 385 * MiB, WS_WOUT_EV = 409 * MiB, WS_WIN_OD = 417 * MiB, WS_WOUT_OD = 433 * MiB, WS_WG_OD = 441 * MiB;
constexpr size_t AR = 445 * MiB;
constexpr size_t A_XB = AR + 0 * MiB, A_UHT = AR + 64 * MiB, A_QB = AR + 160 * MiB, A_KB = AR + 192 * MiB, A_VB = AR + 224 * MiB, A_KTD = AR + 256 * MiB, A_KF = AR + 384 * MiB,
                 A_H3B = AR + 512 * MiB, A_W4T = AR + 514 * MiB, A_YHT = AR + 416 * MiB, A_OA = AR + 448 * MiB, A_YCAT = AR + 512 * MiB, A_XB2 = AR + 0 * MiB, A_R0 = AR + 64 * MiB, A_H1_0 = AR + 192 * MiB,
                 A_HB_0 = AR + 320 * MiB, A_HID_0 = AR + 384 * MiB, A_ROWL = AR + 424 * MiB, A_GATEW = AR + 428 * MiB, A_Y2_0 = AR + 0 * MiB, A_H2 = AR + 448 * MiB, A_HB2 = AR + 448 * MiB;
constexpr size_t A_GB = AR + 0 * MiB, A_XR = AR + 64 * MiB, A_XC = AR + 192 * MiB, A_LA = AR + 256 * MiB, A_BB = AR + 64 * MiB, A_CAR = AR + 384 * MiB, A_YG = AR + 192 * MiB, A_R1 = AR + 256 * MiB,
                 A_H1_1 = AR + 0 * MiB, A_HB8_1 = AR + 0 * MiB, A_XB8 = AR + 320 * MiB, WS_WIN_EV8 = AR + 544 * MiB, A_HB2_8 = AR + 512 * MiB, A_HB8_0 = AR + 192 * MiB, A_HB_1 = AR + 128 * MiB, A_HID_1 = AR + 192 * MiB, A_Y2_1 = AR + 256 * MiB;
constexpr size_t WS_END = AR + 576 * MiB;
constexpr size_t WS_TW1 = WS_CTL + 512 * 1024, WS_TW2 = WS_TW1 + 128 * 1024;
constexpr int CW_BAR = 4096, CW_CNT = 16384, CW_NORM = 24576;
constexpr int LDS_MISC = 153600, LDS_BYTES = 161792;
constexpr int NPHASE = 21;
#ifndef FP8_P1
#define FP8_P1 1
#endif
#ifndef FP8_P1B
#define FP8_P1B 1
#endif
#ifndef FP8_P1C
#define FP8_P1C 0
#endif
#ifndef FP8_P16
#define FP8_P16 1
#endif
#ifndef FP8_P5
#define FP8_P5 1
#endif
#ifndef FP8_P10
#define FP8_P10 1
#endif
#ifndef MOE_FP8_LAYERS
#define MOE_FP8_LAYERS 2
#endif

struct Args { const float* in[37]; float* out; unsigned char* ws; int ph_lo, ph_hi; };
typedef const __attribute__((address_space(4))) Args& KArgs;

template <bool F8> __device__ __forceinline__ void transpose_item(const float* W, int N, int k0, int n0, void* WTv, int ldk, int drow0, float scale, LAS float* scr, int lane) {
#pragma unroll 4
    for (int kk = 0; kk < 64; ++kk) scr[kk * 65 + lane] = W[(size_t)(k0 + kk) * N + n0 + lane];
    LDS_WAIT(); asm volatile("" ::: "memory");
    const int c = lane & 7;
#pragma unroll
    for (int jj = 0; jj < 8; ++jj) { const int n = (lane >> 3) + 8 * jj; const LAS float* s = scr + (8 * c) * 65 + n;
        if constexpr (F8) { u32x2 o; o.x = pg8::pk4_fp8(s[0 * 65] * scale, s[1 * 65] * scale, s[2 * 65] * scale, s[3 * 65] * scale); o.y = pg8::pk4_fp8(s[4 * 65] * scale, s[5 * 65] * scale, s[6 * 65] * scale, s[7 * 65] * scale);
            *(u32x2*)((unsigned char*)WTv + (size_t)(drow0 + n) * ldk + k0 + 8 * c) = o; }
        else { u32x4 o; o.x = pk2(s[0 * 65], s[1 * 65]); o.y = pk2(s[2 * 65], s[3 * 65]); o.z = pk2(s[4 * 65], s[5 * 65]); o.w = pk2(s[6 * 65], s[7 * 65]);
            *(u32x4*)((bf16_t*)WTv + (size_t)(drow0 + n) * ldk + k0 + 8 * c) = o; } }
    LDS_WAIT(); asm volatile("" ::: "memory");
}
struct TbItem { const float* W; unsigned char* dst; int N, k0, n0, ldkB, gu, upoff; };
constexpr int TB_RS = 260, TB_BYTES = 32 * TB_RS * 4;
template <bool F8> __device__ __forceinline__ void tb_load(f32x4 (&v)[4][F8 ? 4 : 2], const TbItem& it, int wave, int lane) {
    constexpr int RPD = F8 ? 4 : 2;
    const float* p = it.W + (size_t)(it.k0 + RPD * wave) * it.N + it.n0 + 4 * lane;
#pragma unroll
    for (int j = 0; j < 4; ++j)
#pragma unroll
        for (int i = 0; i < RPD; ++i) { if constexpr (F8) v[j][i] = __builtin_nontemporal_load((const f32x4*)(p + (size_t)(8 * RPD * j + i) * it.N)); else v[j][i] = *(const f32x4*)(p + (size_t)(8 * RPD * j + i) * it.N); }
}
template <bool F8> __device__ __forceinline__ void tb_write(const f32x4 (&v)[4][F8 ? 4 : 2], LAS unsigned char* T, int wave, int lane) {
#pragma unroll
    for (int j = 0; j < 4; ++j) { u32x4 d;
#pragma unroll
        for (int q = 0; q < 4; ++q) {
            if constexpr (F8) d[q] = pg8::pk4_fp8(v[j][0][q] * pg8::FP8_SW, v[j][1][q] * pg8::FP8_SW, v[j][2][q] * pg8::FP8_SW, v[j][3][q] * pg8::FP8_SW);
            else d[q] = pk2(v[j][0][q], v[j][1][q]); }
        *(LAS u32x4*)(T + ((8 * j + wave) * TB_RS + 4 * lane) * 4) = d; }
}
template <bool F8> __device__ __forceinline__ void tb_store(const LAS unsigned char* T, const TbItem& it, int wave, int lane) {
    const int q = (lane & 3) + 4 * (lane >> 5), nl = (lane >> 2) & 7;
    const LAS unsigned* Tw = (const LAS unsigned*)T;
#pragma unroll
    for (int p = 0; p < 4; ++p) { const int nloc = 8 * (wave + 8 * p) + nl, n = it.n0 + nloc; u32x4 r;
#pragma unroll
        for (int i = 0; i < 4; ++i) r[i] = Tw[(4 * q + i) * TB_RS + nloc];
        const int drow = n + ((n >> 7) << 7) * it.gu + it.upoff;
        u32x4* dp = (u32x4*)(it.dst + (size_t)drow * it.ldkB + it.k0 * (F8 ? 1 : 2) + 16 * q); if constexpr (F8) __builtin_nontemporal_store(r, dp); else *dp = r; }
}
static_assert(FP8_P5 && FP8_P10 && FP8_P16 && MOE_FP8_LAYERS == 2 && FP8_P1 == FP8_P1B && !FP8_P1C, "the prologue's block items assume this operand plan");
constexpr int TB_N8 = 4096 + 2048 + 128 + 256 + 128, TB_N16 = 32 * (FP8_P1B ? 12 : 24), TB_NQ8 = FP8_P1B ? 16 * 12 : 0;
__device__ __forceinline__ TbItem tb_item8(KArgs a, int bi) {
    TbItem t; unsigned char* ws = a.ws; t.gu = 0; t.upoff = 0;
    if (bi < 4096) { const int le = bi >> 6, q = bi & 63, up = q >> 5, kb = (q & 31) >> 1, nb = q & 1;
        t.W = (up ? a.in[35] : a.in[34]) + (size_t)le * DM * DFF; t.N = DFF; t.k0 = kb * 128; t.n0 = nb * 256; t.ldkB = DM; t.gu = 1; t.upoff = up * 128;
        t.dst = ws + WS_W1T + (size_t)(le >> 5) * 32 * 1024 * DM * 2 + (size_t)(le & 31) * 1024 * DM; }
    else if (bi < 6144) { const int r = bi - 4096, le = r >> 5, q = r & 31, kb = q >> 3, nb = q & 7;
        t.W = a.in[36] + (size_t)le * DFF * DM; t.N = DM; t.k0 = kb * 128; t.n0 = nb * 256; t.ldkB = DFF; t.dst = ws + WS_W2T + (size_t)(le >> 5) * 32 * DM * DFF * 2 + (size_t)(le & 31) * DM * DFF; }
    else if (bi < 6272) { const int r = bi - 6144, kb = r >> 3, nb = r & 7; t.W = a.in[18]; t.N = DM; t.k0 = kb * 128; t.n0 = nb * 256; t.ldkB = DM; t.dst = ws + WS_WOUT_EV; }
    else if (bi < 6528) { const int r = bi - 6272, kb = r >> 4, nb = r & 15; t.W = a.in[19]; t.N = 2 * DM; t.k0 = kb * 128; t.n0 = nb * 256; t.ldkB = DM; t.dst = ws + WS_WIN_OD; }
    else { const int r = bi - 6528, kb = r >> 3, nb = r & 7; t.W = a.in[27]; t.N = DM; t.k0 = kb * 128; t.n0 = nb * 256; t.ldkB = DM; t.dst = ws + WS_WOUT_OD; }
    return t;
}
__device__ __forceinline__ TbItem tb_item16(KArgs a, int bi) {
    constexpr int NB = FP8_P1B ? 12 : 24;
    TbItem t; const int kb = bi / NB, nb = bi % NB; t.W = a.in[1]; t.N = EV_IN; t.k0 = kb * 64; t.n0 = nb * 256; t.ldkB = DM * 2; t.gu = 0; t.upoff = 0; t.dst = a.ws + WS_WIN_EV; return t;
}
__device__ __forceinline__ TbItem tb_itemq8(KArgs a, int bi) {
    TbItem t; const int kb = bi / 12, nb = bi % 12; t.W = a.in[1]; t.N = EV_IN; t.k0 = kb * 128; t.n0 = 3072 + nb * 256; t.ldkB = DM; t.gu = 0; t.upoff = 0; t.dst = a.ws + WS_WIN_EV8; return t;
}
template <bool F8, int LIST = 0> __device__ __forceinline__ void tb_run(KArgs a, LAS unsigned char* lds, int nitems, int bx, int G, int wave, int lane) {
#define TB_ITEM(i_) (F8 ? (LIST == 1 ? tb_itemq8(a, i_) : tb_item8(a, i_)) : tb_item16(a, i_))
    int bi = bx; if (bi >= nitems) return;
    TbItem cur = TB_ITEM(bi), nxt = cur; f32x4 v[4][F8 ? 4 : 2]; tb_load<F8>(v, cur, wave, lane); int buf = 0, nbi; bool more;
#define TB_STEP() do { LAS unsigned char* T = lds + buf * TB_BYTES; tb_write<F8>(v, T, wave, lane); nbi = bi + G; more = nbi < nitems; \
        if (more) { nxt = TB_ITEM(nbi); tb_load<F8>(v, nxt, wave, lane); } \
        LDS_WAIT(); __builtin_amdgcn_s_barrier(); tb_store<F8>(T, cur, wave, lane); } while (0)
    TB_STEP();
    while (more) { cur = nxt; bi = nbi; buf ^= 1; TB_STEP(); }
#undef TB_STEP
#undef TB_ITEM
    __syncthreads();
}
constexpr int CW_Q = 28672, TBQ_CH = 4, CW_AQ = 28800;
constexpr int TBQ_N0 = 2048 + 1024 + 128, TBQ_N1 = 2048 + 1024 + 384;
static_assert(TBQ_N0 % TBQ_CH == 0 && TBQ_N1 % TBQ_CH == 0 && TBQ_N0 + TBQ_N1 == TB_N8, "chunks must not straddle the end of an item list");
template <int LIST> __device__ __forceinline__ int tbq_map(int i) {
    if (LIST == 0) return i < 2048 ? i : (i < 3072 ? 4096 + (i - 2048) : 6144 + (i - 3072));
    return i < 2048 ? 2048 + i : (i < 3072 ? 5120 + (i - 2048) : 6272 + (i - 3072));
}
template <int LIST> __device__ __forceinline__ void tb_stream_q(KArgs a, LAS unsigned char* lds, int tid, int wave, int lane) {
    constexpr int NQ = LIST ? TBQ_N1 : TBQ_N0;
    unsigned* qc = (unsigned*)(a.ws + WS_CTL) + CW_Q + LIST * 64;
    LAS int* qw = (LAS int*)(lds + LDS_MISC + 2560);
    __syncthreads();
    if (tid == 0) qw[0] = (int)atomicAdd(qc, (unsigned)TBQ_CH);
    __syncthreads();
    int bi = __builtin_amdgcn_readfirstlane(qw[0]), slot = 0, j = 0, buf = 0, nbi; bool more;
    if (bi >= NQ) return;
    int nb_pending = 0; if (tid == 0) nb_pending = (int)atomicAdd(qc, (unsigned)TBQ_CH);
    TbItem cur = tb_item8(a, tbq_map<LIST>(bi)), nxt = cur; f32x4 v[4][4]; tb_load<true>(v, cur, wave, lane);
    for (;;) {
        LAS unsigned char* T = lds + buf * TB_BYTES; tb_write<true>(v, T, wave, lane);
        if (j == 0 && tid == 0) qw[slot ^ 1] = nb_pending;
        if (j + 1 < TBQ_CH) nbi = bi + 1; else nbi = __builtin_amdgcn_readfirstlane(qw[slot ^ 1]);
        more = nbi < NQ;
        if (more) { nxt = tb_item8(a, tbq_map<LIST>(nbi)); tb_load<true>(v, nxt, wave, lane); }
        if (j + 1 == TBQ_CH) { slot ^= 1; if (more && tid == 0) nb_pending = (int)atomicAdd(qc, (unsigned)TBQ_CH); }
        LDS_WAIT(); __builtin_amdgcn_s_barrier(); tb_store<true>(T, cur, wave, lane);
        if (!more) break;
        cur = nxt; bi = nbi; buf ^= 1; j = (j + 1 == TBQ_CH) ? 0 : j + 1;
    }
    __syncthreads();
}
__device__ __forceinline__ void phase_prologue(KArgs a, LAS unsigned char* lds) {
    const int tid = opaque_tid(), lane = tid & 63, wave = tid >> 6, G = gridDim.x;
    const int gw = blockIdx.x * 8 + wave, NGW = G * 8;
    unsigned char* ws = a.ws;
    LAS float* scr = (LAS float*)(lds + wave * 16640);
    tb_run<false>(a, lds, TB_N16, blockIdx.x, G, wave, lane);
    if constexpr (FP8_P1B) tb_run<true, 1>(a, lds, TB_NQ8, blockIdx.x, G, wave, lane);
    constexpr int I_RG = 16 * 16, I_W4 = 64, O8 = I_RG, O9 = O8 + I_RG, O10 = O9 + I_W4;
    for (int it = gw; it < O10; it += NGW) {
        if (it < O9) { const bool wx = it >= O8; const int r = it - (wx ? O8 : 0), dn = r / 16, q = r % 16, kb = q / 4, nb = q % 4, n0 = nb * 64, dir = dn / 8, n = dn % 8;
            transpose_item<false>((wx ? a.in[24] : a.in[22]) + (size_t)dn * 65536, 256, kb * 64, n0, ws + WS_WG_OD, 256, (n * 4 + dir * 2 + (n0 >> 7)) * 256 + (n0 & 127) + (wx ? 128 : 0), 1.f, scr, lane); }
        else { const int nb = it - O9; transpose_item<false>(a.in[11], 4096, 0, nb * 64, ws + A_W4T, 128, nb * 64, 1.f, scr, lane); }
    }
    { const int gt = blockIdx.x * 512 + tid, NT = G * 512;
      for (int i = gt; i < 16384 + 512; i += NT) { float sn, cs;
          if (i < 16384) { const int k1 = i >> 9, n2 = i & 511; sincospif(-2.0f * (float)((k1 * n2) & 16383) * (1.0f / 16384.0f), &sn, &cs); ((float2*)(ws + WS_TW1))[i] = make_float2(cs, sn); }
          else { const int q = i - 16384, j1 = q >> 4, m2 = q & 15; sincospif(-2.0f * (float)((j1 * m2) & 511) * (1.0f / 512.0f), &sn, &cs); ((float2*)(ws + WS_TW2))[q] = make_float2(cs, sn); } }
      for (int i = gt; i < 4096 * 8; i += NT) { const int r = i >> 3, c = i & 7; *(u32x4*)((bf16_t*)(ws + A_W4T) + (size_t)r * 128 + 64 + c * 8) = (u32x4){0u, 0u, 0u, 0u}; }
      for (int i = gt; i < 8192 * 8; i += NT) { const int r = i >> 3, c = i & 7; *(u32x4*)((bf16_t*)(ws + A_H3B) + (size_t)r * 128 + 64 + c * 8) = (u32x4){0u, 0u, 0u, 0u}; }
      const f32x8* x8 = (const f32x8*)a.in[0]; u32x4* xb = (u32x4*)(ws + A_XB);
      u32x2* xb8 = (u32x2*)(ws + A_XB8);
      for (int i = gt; i < NTOK * DM / 8; i += NT) { const f32x8 v = x8[i]; u32x4 o; o.x = pk2(v[0], v[1]); o.y = pk2(v[2], v[3]); o.z = pk2(v[4], v[5]); o.w = pk2(v[6], v[7]); xb[i] = o;
          if (FP8_P1) { u32x2 q; q.x = pg8::pk4_fp8(v[0], v[1], v[2], v[3]); q.y = pg8::pk4_fp8(v[4], v[5], v[6], v[7]); xb8[i] = q; } } }
    { const float* w1 = a.in[4]; const float* b1 = a.in[5]; const float* w2 = a.in[6]; const float* b2 = a.in[7]; const float* w3 = a.in[8]; const float* b3 = a.in[9]; const float* fr = a.in[10];
      const float frq = fr[lane];
      for (int t = gw; t < SEQ; t += NGW) {
          float z;
          { const float tl = (float)t * (1.0f / 8191.0f);
            if (lane == 0) z = tl;
            else { const int j = (lane - 1) & 15; const float band = 1e-4f + (float)j * ((15.0f - 1e-4f) / 15.0f);
                   const float ang = (6.283185307179586f * (float)t * (1.0f / 8192.0f)) * band; float sn, cs; sincosf(ang, &sn, &cs); z = (lane <= 16) ? cs : -sn; } }
          float acc = b1[lane];
#pragma unroll
          for (int i = 0; i < 33; ++i) acc += __shfl(z, i) * w1[i * 64 + lane];
          float h = sinf(frq * acc);
          acc = b2[lane];
#pragma unroll 16
          for (int i = 0; i < 64; ++i) acc += __shfl(h, i) * w2[i * 64 + lane];
          h = sinf(frq * acc);
          acc = b3[lane];
#pragma unroll 16
          for (int i = 0; i < 64; ++i) acc += __shfl(h, i) * w3[i * 64 + lane];
          h = sinf(frq * acc);
          ((bf16_t*)(ws + A_H3B))[(size_t)t * 128 + lane] = (bf16_t)f2bf(h);
      } }
}

__device__ __forceinline__ void filter_unit(KArgs a, LAS unsigned char* lds, int u, int tid) {
    const int lane = tid & 63, wave = tid >> 6;
    LAS f32x2* L = (LAS f32x2*)lds; LAS float* red = (LAS float*)(lds + LDS_MISC + 1024);
    const bf16_t* KTD = (const bf16_t*)(a.ws + A_KTD); __half2* KF = (__half2*)(a.ws + A_KF);
    {
        int tl = tid; asm volatile("" : "+v"(tl));
        const bf16_t* rowF = KTD + (size_t)u * 8192; const bf16_t* rowB = KTD + (size_t)(2048 + u) * 8192;
        hy::cf v[32]; float ss = 0.f;
#pragma unroll
        for (int n1 = 0; n1 < 32; ++n1) { const int p = tl + 512 * n1; float val;
            if (n1 < 16) val = bf2f(rowF[p]); else if (p == 8192) val = 0.f; else val = bf2f(rowB[16384 - p]);
            v[n1] = (hy::cf){val, 0.f}; ss += val * val; }
        ss = wave_sum(ss); if (lane == 0) red[wave] = ss; __syncthreads();
        float tot = 0.f;
#pragma unroll
        for (int w = 0; w < 8; ++w) tot += red[w];
        const float scale = rsqrtf(tot), skp = a.in[12][u];
        hy::fft_fwd12(v, L, tl);
#pragma unroll
        for (int bf = 0; bf < 2; ++bf) { const int idx = bf * 512 + tl, k1 = idx >> 5, j1 = idx & 31; hy::cf w[16];
#pragma unroll
            for (int m2 = 0; m2 < 16; ++m2) w[m2] = hy::lld(L, k1 * hy::RS + 33 * m2 + j1);
            hy::dft_reg<16, false>(w);
#pragma unroll
            for (int j2 = 0; j2 < 16; ++j2) { const hy::cf x = w[hy::brev(j2, 4)]; KF[((size_t)((blockIdx.x * 2 + (u >> 10)) * 2 + bf) * 16 + j2) * 512 + tl] = __floats2half2_rn(x.x * scale + skp, x.y * scale); } }
        __syncthreads();
    }
}
__device__ __forceinline__ float hyconv(const bf16_t* row, int t, float w0, float w1, float w2, float bias) {
    const bf16_t* p = row + t;
    float xm = bf2f(p[-1]), x0 = bf2f(p[0]), xp = bf2f(p[1]);
    xm = t > 0 ? xm : 0.f; xp = t < SEQ - 1 ? xp : 0.f;
    return w0 * xm + w1 * x0 + w2 * xp + bias;
}
__device__ __forceinline__ bf16x8 pack8(const float (&v)[8]) { return __builtin_bit_cast(bf16x8, (u32x4){cvt_pk_bf16(v[0], v[1]), cvt_pk_bf16(v[2], v[3]), cvt_pk_bf16(v[4], v[5]), cvt_pk_bf16(v[6], v[7])}); }
__device__ __forceinline__ void phase_hyena_mixer(KArgs a, LAS unsigned char* lds) {
    const int tid = opaque_tid(), lane = tid & 63, wave = __builtin_amdgcn_readfirstlane(tid >> 6), j = lane & 31, hi = lane >> 5, G = gridDim.x;
    LAS unsigned char* L = lds; LAS float* red = (LAS float*)(lds + LDS_MISC + 1024);
    const bf16_t* UHT = (const bf16_t*)(a.ws + A_UHT); const bf16_t* KTD = (const bf16_t*)(a.ws + A_KTD); bf16_t* YHT = (bf16_t*)(a.ws + A_YHT);
    __half2* KF = (__half2*)(a.ws + A_KF) + (size_t)blockIdx.x * (2 * 32 * 8 * 64);
    const LAS unsigned* TW1 = (const LAS unsigned*)(lds + hm::LDS_TW1); const LAS f32x2* TW2 = (const LAS f32x2*)(lds + hm::LDS_TW2);
    const float* cw = a.in[2]; const float* cb = a.in[3];
    hm::build_tw(lds, tid); hm::build_ftab(lds + hm::LDS_FTAB, tid); const hm::Consts C{lds + hm::LDS_FTAB, lane};
    for (int c = blockIdx.x; c < HY_CH; c += G) {
        int jl = j, hil = hi, wl = wave; asm volatile("" : "+v"(jl), "+v"(hil), "+s"(wl));
#ifndef HM_NOFILTER
#pragma unroll 1
        for (int o = 0; o < 2; ++o) { const int u = o * 1024 + c;
            const bf16_t* rowF = KTD + (size_t)u * 8192; const bf16_t* rowB = KTD + (size_t)(2048 + u) * 8192;
            bf16x8 Bre[2][2], Bim[2][2]; float ss = 0.f;
#pragma unroll
            for (int tl = 0; tl < 2; ++tl)
#pragma unroll
                for (int ks = 0; ks < 2; ++ks) { float v[8];
#pragma unroll
                    for (int t = 0; t < 8; ++t) { const int p = 64 * wl + 32 * tl + jl + 512 * (16 * ks + 8 * hil + t);
                        if (ks == 0) v[t] = bf2f(rowF[p]); else { const float x = bf2f(rowB[16384 - p]); v[t] = (p == 8192) ? 0.f : x; }
                        ss += v[t] * v[t]; }
                    Bre[tl][ks] = pack8(v); Bim[tl][ks] = (bf16x8){0, 0, 0, 0, 0, 0, 0, 0}; asm volatile("" ::: "memory"); }
            ss = wave_sum(ss); if (lane == 0) red[wave] = ss; __syncthreads();
            float tot = 0.f;
#pragma unroll
            for (int w = 0; w < 8; ++w) tot += red[w];
            const float scale = rsqrtf(tot), skp = a.in[12][u];
            hm::fwd12<2>(C, Bre, Bim, L, TW1, TW2, wl, jl, hil);
#pragma unroll
            for (int q = 0; q < 4; ++q) { const int t3 = 4 * wl + q, colp = 32 * t3 + jl; f32x16 dr = {}, di = {};
                hm::cmfma<false>(dr, di, C.get(2), *(const LAS bf16x8*)(L + (colp * hm::ROWB + 8 * hil) * 2), *(const LAS bf16x8*)(L + hm::PL_B + (colp * hm::ROWB + 8 * hil) * 2));
#pragma unroll
                for (int r = 0; r < 8; ++r) KF[((o * 32 + t3) * 8 + r) * 64 + lane] = __floats2half2_rn(dr[r] * scale + skp, di[r] * scale); asm volatile("" ::: "memory"); }
            __syncthreads();
        }
#endif
        VM_WAIT();
#ifndef HM_NOMIXER
        bf16x8 Zre[2][1], Zim[2][1];
        { const bf16_t* r0 = UHT + (size_t)c * NTOK; const float w0 = cw[c], w1 = cw[3072 + c], w2 = cw[6144 + c], bb = cb[c];
#pragma unroll
          for (int tl = 0; tl < 2; ++tl) { float v0[8], v1[8];
#pragma unroll
              for (int t = 0; t < 8; ++t) { const int tt = 64 * wl + 32 * tl + jl + 512 * (8 * hil + t); v0[t] = hyconv(r0, tt, w0, w1, w2, bb); v1[t] = hyconv(r0 + SEQ, tt, w0, w1, w2, bb); }
              Zre[tl][0] = pack8(v0); Zim[tl][0] = pack8(v1); asm volatile("" ::: "memory"); } }
#pragma unroll 1
        for (int o = 0; o < 2; ++o) {
            hm::fwd12<1>(C, Zre, Zim, L, TW1, TW2, wl, jl, hil);
            int j3 = jl, h3 = hil; asm volatile("" : "+v"(j3), "+v"(h3));
            bf16x8 zre[4], zim[4];
#pragma unroll
            for (int q = 0; q < 4; ++q) { const int colp = 32 * (4 * wl + q) + j3; zre[q] = *(const LAS bf16x8*)(L + (colp * hm::ROWB + 8 * h3) * 2); zim[q] = *(const LAS bf16x8*)(L + hm::PL_B + (colp * hm::ROWB + 8 * h3) * 2); }
            __syncthreads();
            asm volatile("" : "+v"(j3), "+v"(h3));
#pragma unroll
            for (int q = 0; q < 4; ++q) { const int t3 = 4 * wl + q; f32x16 dr = {}, di = {};
                hm::cmfma<false>(dr, di, C.get(2), zre[q], zim[q]);
                float xr[8], xi[8];
#pragma unroll
                for (int r = 0; r < 8; ++r) { const float2 kf = __half22float2(KF[((o * 32 + t3) * 8 + r) * 64 + lane]); const hm::cf x = hm::cmul((hm::cf){dr[r], di[r]}, (hm::cf){kf.x, kf.y}); xr[r] = x.x; xi[r] = x.y; }
                const bf16x8 br = hm::pk4(xr), bi = hm::pk4(xi);
                f32x16 er = {}, ei = {};
                hm::cmfma<true>(er, ei, C.get(2), br, bi);
#pragma unroll
                for (int r = 0; r < 8; ++r) { const int m2 = hm::crow(r, h3); hm::st2(L, hm::PL_A, (t3 * 16 + m2) * hm::ROWA + j3, hm::cmulc((hm::cf){er[r], ei[r]}, TW2[j3 * 16 + m2])); } asm volatile("" ::: "memory"); }
            __syncthreads();
            hm::cf y[2][8];
            hm::inv21(C, y, L, TW1, wl, jl, hil);
            const int gch = (o + 1) * 1024 + c; const bf16_t* rg = UHT + (size_t)gch * NTOK;
            const float w0 = cw[gch], w1 = cw[3072 + gch], w2 = cw[6144 + gch], bb = cb[gch];
            int jg = jl, hg = hil; asm volatile("" : "+v"(jg), "+v"(hg));
#pragma unroll
            for (int tl = 0; tl < 2; ++tl) { float z0[8], z1[8];
#pragma unroll
                for (int r = 0; r < 8; ++r) { const int tt = 64 * wl + 32 * tl + jg + 512 * hm::crow(r, hg);
                    z0[r] = hyconv(rg, tt, w0, w1, w2, bb) * y[tl][r].x * (1.0f / 16384.0f); z1[r] = hyconv(rg + SEQ, tt, w0, w1, w2, bb) * y[tl][r].y * (1.0f / 16384.0f); }
                asm volatile("" ::: "memory");
                if (o == 0) { Zre[tl][0] = hm::pk4(z0); Zim[tl][0] = hm::pk4(z1); }
                else { bf16_t* yo = YHT + (size_t)c * NTOK;
#pragma unroll
                    for (int r = 0; r < 8; ++r) { const int tt = 64 * wl + 32 * tl + jg + 512 * hm::crow(r, hg); yo[tt] = (bf16_t)f2bf(z0[r]); yo[SEQ + tt] = (bf16_t)f2bf(z1[r]); } } }
        }
#endif
    }
    __syncthreads();
}
__device__ __forceinline__ void phase_qknorm(KArgs a, LAS unsigned char* lds) {
    const int tid = opaque_tid(), lane = tid & 63, wave = tid >> 6, gw = blockIdx.x * 8 + wave, NGW = gridDim.x * 8;
    LAS unsigned* red = (LAS unsigned*)(lds + LDS_MISC + 1536);
    unsigned* ctl = (unsigned*)(a.ws + WS_CTL);
    if (tid < 64) red[tid] = 0u;
    __syncthreads();
    for (int which = 0; which < 2; ++which) { const bf16_t* P = (const bf16_t*)(a.ws + (which ? A_KB : A_QB));
        for (int b = 0; b < 2; ++b) { float mx = 0.f;
            for (int row = gw; row < SEQ; row += NGW) { const bf16_t* p = P + ((size_t)b * SEQ + row) * 1024 + lane * 16;
                const u32x4 w0 = *(const u32x4*)p, w1 = *(const u32x4*)(p + 8); const unsigned ww[8] = {w0.x, w0.y, w0.z, w0.w, w1.x, w1.y, w1.z, w1.w};
                float ss = 0.f;
#pragma unroll
                for (int i = 0; i < 8; ++i) { const float x = bflo(ww[i]), y = bfhi(ww[i]); ss += x * x + y * y; }
                ss += __shfl_xor(ss, 1); ss += __shfl_xor(ss, 2); mx = fmaxf(mx, ss); }
            if ((lane & 3) == 0) atomicMax((unsigned*)&red[which * 32 + b * 16 + (lane >> 2)], __float_as_uint(mx)); } }
    __syncthreads();
    if (tid < 64) atomicMax(ctl + CW_NORM + tid, red[tid]);
}
__device__ __forceinline__ void phase_attention(KArgs a, LAS unsigned char* lds) {
    const int G = gridDim.x, bx = blockIdx.x;
    const bf16_t* QB = (const bf16_t*)(a.ws + A_QB); const bf16_t* KB = (const bf16_t*)(a.ws + A_KB); const bf16_t* VB = (const bf16_t*)(a.ws + A_VB); bf16_t* OA = (bf16_t*)(a.ws + A_OA);
    const unsigned* nrm = (const unsigned*)(a.ws + WS_CTL) + CW_NORM;
    const int tid_ = opaque_tid(), xq = bx & 7; unsigned* actr = (unsigned*)(a.ws + WS_CTL) + CW_AQ;
    LAS int* ash = (LAS int*)(lds + LDS_MISC + 2560);
    int qsel = 0;
    for (;;) {
        int bhc, qb;
        __syncthreads();
        if (tid_ == 0) { int u = -1, qx = xq;
            while (qsel < 8) { const int sc = ((qsel & 1) << 2) | (qsel >> 1); qx = xq ^ sc; u = (int)atomicAdd(actr + qx * 64, 1u); if (u < 128) break; ++qsel; u = -1; }
            ash[0] = u; ash[1] = qx; }
        __syncthreads();
        { const int u = __builtin_amdgcn_readfirstlane(ash[0]), x = __builtin_amdgcn_readfirstlane(ash[1]); if (u < 0) break;
          const int i = u >> 5, r = u & 31, combo = x & 3, hh = (x < 4) ? ((i == 0) ? 7 : (i == 1) ? 5 : (i == 2) ? 1 : 0) : ((i == 0) ? 6 : (i == 1) ? 4 : (i == 2) ? 3 : 2);
          bhc = (combo >> 1) * 16 + hh * 2 + (combo & 1); qb = (r & 1) ? 15 - (r >> 1) : 16 + (r >> 1); }
        const int b = bhc >> 4, h = (bhc >> 1) & 7, cm = bhc & 1;
        const size_t rowq = (size_t)b * SEQ + (size_t)qb * 256;
        const float sl2 = exp2f(-(float)(h + 1)) * 1.4426950408889634f;
        const float qk = sqrtf(__uint_as_float(nrm[bhc]) * __uint_as_float(nrm[32 + bhc]));
        const float Wk = (2.0f * qk + 38.0f) / sl2, q0f = (float)(qb * 256);
        int t_lo = (int)fmaxf(floorf((q0f - Wk - 63.0f) * (1.0f / 64.0f)), 0.0f), t_hi = (int)fminf(ceilf((q0f + 255.0f + Wk) * (1.0f / 64.0f)), 127.0f);
        if (((t_hi - t_lo + 1) & 1) != 0) { if (t_hi < 127) ++t_hi; else --t_lo; }
        att::attn_unit(QB + rowq * 1024 + h * 128 + cm * 64, KB + (size_t)b * SEQ * 1024 + h * 128 + cm * 64, VB + (size_t)b * SEQ * 1024 + h * 128,
                       OA + (size_t)cm * NTOK * 1024 + rowq * 1024 + h * 128, qb * 256, t_lo, t_hi - t_lo + 1, sl2, (char*)lds);
    }
}
__device__ __forceinline__ void phase_concat(KArgs a, LAS unsigned char* lds) {
    const int tid = opaque_tid(), lane = tid & 63, wave = tid >> 6, G = gridDim.x;
    const bf16_t* YHT = (const bf16_t*)(a.ws + A_YHT); const bf16_t* OA0 = (const bf16_t*)(a.ws + A_OA); const bf16_t* OA1 = OA0 + (size_t)NTOK * 1024; bf16_t* YC = (bf16_t*)(a.ws + A_YCAT);
    LAS bf16_t* T = (LAS bf16_t*)lds;
    const float lambda_init = 0.2f;
    const float lam = __expf(wave_sum(a.in[13][lane] * a.in[14][lane])) - __expf(wave_sum(a.in[15][lane] * a.in[16][lane])) + lambda_init;
    float gl[16];
#pragma unroll
    for (int i = 0; i < 16; ++i) gl[i] = a.in[17][(lane & 7) * 16 + i] * (1.0f - lambda_init);
    for (int it = blockIdx.x; it < NTOK / 64; it += G) {
        const int tok0 = it * 64;
#pragma unroll 4
        for (int k = 0; k < 16; ++k) { const int idx = tid + 512 * k, c = idx >> 3, ch = idx & 7;
            const u32x4 w = *(const u32x4*)(YHT + (size_t)c * NTOK + tok0 + ch * 8);
            LAS bf16_t* d = T + (ch * 8) * 1026 + c;
            d[0 * 1026] = (bf16_t)(w.x & 0xffff); d[1 * 1026] = (bf16_t)(w.x >> 16); d[2 * 1026] = (bf16_t)(w.y & 0xffff); d[3 * 1026] = (bf16_t)(w.y >> 16);
            d[4 * 1026] = (bf16_t)(w.z & 0xffff); d[5 * 1026] = (bf16_t)(w.z >> 16); d[6 * 1026] = (bf16_t)(w.w & 0xffff); d[7 * 1026] = (bf16_t)(w.w >> 16); }
        __syncthreads();
#pragma unroll 4
        for (int k = 0; k < 16; ++k) { const int idx = tid + 512 * k, tl = idx >> 7, c8 = idx & 127;
            const LAS unsigned* s = (const LAS unsigned*)(T + tl * 1026 + c8 * 8);
            u32x4 w; w.x = s[0]; w.y = s[1]; w.z = s[2]; w.w = s[3];
            if (FP8_P5) { u32x2 q; q.x = pg8::pk4_fp8(bflo(w.x), bfhi(w.x), bflo(w.y), bfhi(w.y)); q.y = pg8::pk4_fp8(bflo(w.z), bfhi(w.z), bflo(w.w), bfhi(w.w)); *(u32x2*)((unsigned char*)YC + (size_t)(tok0 + tl) * DM + c8 * 8) = q; }
            else *(u32x4*)(YC + (size_t)(tok0 + tl) * DM + c8 * 8) = w; }
        for (int rr = 0; rr < 8; ++rr) { const size_t tok = (size_t)tok0 + wave * 8 + rr;
            const u32x4 p0 = *(const u32x4*)(OA0 + tok * 1024 + lane * 16), p1 = *(const u32x4*)(OA0 + tok * 1024 + lane * 16 + 8);
            const u32x4 q0 = *(const u32x4*)(OA1 + tok * 1024 + lane * 16), q1 = *(const u32x4*)(OA1 + tok * 1024 + lane * 16 + 8);
            const unsigned pw[8] = {p0.x, p0.y, p0.z, p0.w, p1.x, p1.y, p1.z, p1.w}, qw[8] = {q0.x, q0.y, q0.z, q0.w, q1.x, q1.y, q1.z, q1.w};
            float o[16]; float ss = 0.f;
#pragma unroll
            for (int i = 0; i < 8; ++i) { o[2 * i] = bflo(pw[i]) - lam * bflo(qw[i]); o[2 * i + 1] = bfhi(pw[i]) - lam * bfhi(qw[i]); ss += o[2 * i] * o[2 * i] + o[2 * i + 1] * o[2 * i + 1]; }
            ss += __shfl_xor(ss, 1); ss += __shfl_xor(ss, 2); ss += __shfl_xor(ss, 4);
            const float rs = rsqrtf(ss * (1.0f / 128.0f) + LN_EPS);
            u32x4 w0, w1;
            w0.x = pk2(o[0] * rs * gl[0], o[1] * rs * gl[1]); w0.y = pk2(o[2] * rs * gl[2], o[3] * rs * gl[3]); w0.z = pk2(o[4] * rs * gl[4], o[5] * rs * gl[5]); w0.w = pk2(o[6] * rs * gl[6], o[7] * rs * gl[7]);
            w1.x = pk2(o[8] * rs * gl[8], o[9] * rs * gl[9]); w1.y = pk2(o[10] * rs * gl[10], o[11] * rs * gl[11]); w1.z = pk2(o[12] * rs * gl[12], o[13] * rs * gl[13]); w1.w = pk2(o[14] * rs * gl[14], o[15] * rs * gl[15]);
            if (FP8_P5) { u32x4 q; q.x = pg8::pk4_fp8(o[0] * rs * gl[0], o[1] * rs * gl[1], o[2] * rs * gl[2], o[3] * rs * gl[3]); q.y = pg8::pk4_fp8(o[4] * rs * gl[4], o[5] * rs * gl[5], o[6] * rs * gl[6], o[7] * rs * gl[7]);
                q.z = pg8::pk4_fp8(o[8] * rs * gl[8], o[9] * rs * gl[9], o[10] * rs * gl[10], o[11] * rs * gl[11]); q.w = pg8::pk4_fp8(o[12] * rs * gl[12], o[13] * rs * gl[13], o[14] * rs * gl[14], o[15] * rs * gl[15]);
                *(u32x4*)((unsigned char*)YC + tok * DM + 1024 + lane * 16) = q; }
            else { *(u32x4*)(YC + tok * DM + 1024 + lane * 16) = w0; *(u32x4*)(YC + tok * DM + 1024 + lane * 16 + 8) = w1; } }
        __syncthreads();
    }
}
__device__ __forceinline__ void ln_row(f32x4 (&v)[8], const float* g, const float* b, int lane, float& mu, float& rs) {
    float s = 0.f;
#pragma unroll
    for (int j = 0; j < 8; ++j) s += (v[j][0] + v[j][1]) + (v[j][2] + v[j][3]);
    const float mean = wave_sum(s) * (1.0f / DM); float s2 = 0.f;
#pragma unroll
    for (int j = 0; j < 8; ++j) { v[j] = v[j] - mean; s2 += (v[j][0] * v[j][0] + v[j][1] * v[j][1]) + (v[j][2] * v[j][2] + v[j][3] * v[j][3]); }
    const float rstd = rsqrtf(wave_sum(s2) * (1.0f / DM) + LN_EPS); mu = mean; rs = rstd;
#pragma unroll
    for (int j = 0; j < 8; ++j) { const f32x4 gg = *(const f32x4*)(g + 4 * (lane + 64 * j)), bb = *(const f32x4*)(b + 4 * (lane + 64 * j)); v[j] = v[j] * rstd * gg + bb; }
}
__device__ __forceinline__ void phase_ln_router(KArgs a, LAS unsigned char* lds, const bf16_t* R, const float* g, const float* b, bf16_t* HB, unsigned char* HB8, unsigned* cnt, int* rowlist, float* gatew) {
    const int tid = opaque_tid(), lane = tid & 63, wave = tid >> 6, G = gridDim.x;
    const float* rw = a.in[32]; const float* rb = a.in[33];
    LAS float* part = (LAS float*)lds;
    LAS int* hist = (LAS int*)(lds + 69632); LAS int* base = hist + 32; LAS float* stats = (LAS float*)(lds + 69632 + 512);
    for (int it = blockIdx.x; it < NTOK / 64; it += G) {
        const int tok0 = it * 64;
#pragma unroll 1
        for (int hb = 0; hb < 2; ++hb) { u32x2 raw[4][8];
#pragma unroll
          for (int rr = 0; rr < 4; ++rr)
#pragma unroll
              for (int j = 0; j < 8; ++j) raw[rr][j] = *(const u32x2*)(R + ((size_t)tok0 + wave * 8 + hb * 4 + rr) * DM + 4 * (lane + 64 * j));
#pragma unroll
          for (int rr = 0; rr < 4; ++rr) { const int tl = wave * 8 + hb * 4 + rr; const size_t row = (size_t)tok0 + tl; f32x4 v[8]; float mu, rs;
#pragma unroll
            for (int j = 0; j < 8; ++j) v[j] = (f32x4){bflo(raw[rr][j].x), bfhi(raw[rr][j].x), bflo(raw[rr][j].y), bfhi(raw[rr][j].y)};
            ln_row(v, g, b, lane, mu, rs);
            if (lane == 0) { stats[tl * 2] = mu; stats[tl * 2 + 1] = rs; }
#pragma unroll
            for (int j = 0; j < 8; ++j) { u32x2 w; w.x = pk2(v[j][0], v[j][1]); w.y = pk2(v[j][2], v[j][3]); *(u32x2*)(HB + row * DM + 4 * (lane + 64 * j)) = w;
                if (HB8) *(unsigned*)(HB8 + row * DM + 4 * (lane + 64 * j)) = pg8::pk4_fp8(v[j][0], v[j][1], v[j][2], v[j][3]); } } }
        if (tid < 32) hist[tid] = 0;
        __syncthreads();
        { const int i = lane & 31, kk = lane >> 5; f32x16 acc0 = {}, acc1 = {};
          const float mu0 = stats[i * 2], rs0 = stats[i * 2 + 1], mu1 = stats[(i + 32) * 2], rs1 = stats[(i + 32) * 2 + 1];
          const bf16_t* rrow = R + (size_t)(tok0 + i) * DM + wave * 256 + 4 * kk; const float* gp = g + wave * 256 + 4 * kk; const float* bp = b + wave * 256 + 4 * kk;
          const float* rwp = rw + (size_t)(wave * 256 + 4 * kk) * NEXP + i;
#pragma unroll 4
          for (int s = 0; s < 32; ++s) { const u32x2 ra = *(const u32x2*)(rrow + 8 * s), rc = *(const u32x2*)(rrow + (size_t)32 * DM + 8 * s); const f32x4 gv = *(const f32x4*)(gp + 8 * s), bv = *(const f32x4*)(bp + 8 * s);
              const f32x4 h0 = ((f32x4){bflo(ra.x), bfhi(ra.x), bflo(ra.y), bfhi(ra.y)} - mu0) * rs0 * gv + bv, h1 = ((f32x4){bflo(rc.x), bfhi(rc.x), bflo(rc.y), bfhi(rc.y)} - mu1) * rs1 * gv + bv;
#pragma unroll
              for (int j = 0; j < 4; ++j) { const float wv = rwp[(size_t)(8 * s + j) * NEXP]; acc0 = __builtin_amdgcn_mfma_f32_32x32x2f32(wv, h0[j], acc0, 0, 0, 0); acc1 = __builtin_amdgcn_mfma_f32_32x32x2f32(wv, h1[j], acc1, 0, 0, 0); } }
#pragma unroll
          for (int r = 0; r < 16; ++r) { part[(wave * 64 + i) * 33 + (r & 3) + 8 * (r >> 2) + 4 * kk] = acc0[r]; part[(wave * 64 + 32 + i) * 33 + (r & 3) + 8 * (r >> 2) + 4 * kk] = acc1[r]; } }
        __syncthreads();
        int e1 = 0, e2 = 0, r1 = 0, r2 = 0; float g1 = 0.f, g2 = 0.f;
        if (tid < 64) {
            float bestg = -1e30f;
#pragma unroll
            for (int gi = 0; gi < 4; ++gi) { float m1 = -1e30f, m2 = -1e30f, s1 = 0.f, s2 = 0.f; int i1 = 0, i2 = 0;
#pragma unroll
                for (int j = 0; j < 8; ++j) { const int e = gi * 8 + j; float lg = 0.f;
#pragma unroll
                    for (int w = 0; w < 8; ++w) lg += part[(w * 64 + tid) * 33 + e];
                    const float sg = 1.0f / (1.0f + expf(-lg)), sl = sg + rb[e];
                    if (sl > m1) { m2 = m1; i2 = i1; s2 = s1; m1 = sl; i1 = j; s1 = sg; } else if (sl > m2) { m2 = sl; i2 = j; s2 = sg; } }
                const float gs = m1 + m2;
                if (gs > bestg) { bestg = gs; e1 = gi * 8 + i1; e2 = gi * 8 + i2; g1 = s1; g2 = s2; } }
            const float inv = 1.0f / (g1 + g2); g1 *= inv; g2 *= inv;
            r1 = atomicAdd((int*)&hist[e1], 1); r2 = atomicAdd((int*)&hist[e2], 1);
        }
        __syncthreads();
        if (tid < 32) { const int hc = hist[tid]; base[tid] = hc ? (int)__hip_atomic_fetch_add(cnt + tid * 64, (unsigned)hc, __ATOMIC_RELAXED, __HIP_MEMORY_SCOPE_AGENT) : 0; }
        __syncthreads();
        if (tid < 64) { const int a0 = (tok0 + tid) * 2;
            rowlist[(size_t)e1 * ECAP + base[e1] + r1] = a0; gatew[a0] = g1;
            rowlist[(size_t)e2 * ECAP + base[e2] + r2] = a0 + 1; gatew[a0 + 1] = g2; }
        __syncthreads();
    }
}
__device__ __forceinline__ void phase_ln2(const bf16_t* HB, const bf16_t* Y2, const float* g, const float* b, float* OUT, bf16_t* OB, unsigned char* OB8) {
    const int tid = opaque_tid(), lane = tid & 63, wave = tid >> 6;
    for (int row = blockIdx.x * 8 + wave; row < NTOK; row += gridDim.x * 8) { f32x4 v[8]; float mu, rs;
#pragma unroll
        for (int j = 0; j < 8; ++j) { const int c = 4 * (lane + 64 * j); const u32x2 h = *(const u32x2*)(HB + (size_t)row * DM + c);
            const u32x2 y0 = *(const u32x2*)(Y2 + (size_t)(2 * row) * DM + c), y1 = *(const u32x2*)(Y2 + (size_t)(2 * row + 1) * DM + c);
            v[j] = (f32x4){bflo(h.x), bfhi(h.x), bflo(h.y), bfhi(h.y)} * DN_ALPHA + (f32x4){bflo(y0.x) + bflo(y1.x), bfhi(y0.x) + bfhi(y1.x), bflo(y0.y) + bflo(y1.y), bfhi(y0.y) + bfhi(y1.y)}; }
        ln_row(v, g, b, lane, mu, rs);
#pragma unroll
        for (int j = 0; j < 8; ++j) { const int c = 4 * (lane + 64 * j); if (OUT) *(f32x4*)(OUT + (size_t)row * DM + c) = v[j];
            if (OB) { u32x2 w; w.x = pk2(v[j][0], v[j][1]); w.y = pk2(v[j][2], v[j][3]); *(u32x2*)(OB + (size_t)row * DM + c) = w; }
            if (OB8) *(unsigned*)(OB8 + (size_t)row * DM + c) = pg8::pk4_fp8(v[j][0], v[j][1], v[j][2], v[j][3]); }
    }
}
__device__ __forceinline__ void moe_table(LAS int* tab, const unsigned* cnt) {
    __syncthreads();
    const int tid = opaque_tid();
    if (tid < 32) tab[64 + tid] = (int)cnt[tid * 64];
    __syncthreads();
    if (tid == 0) { int acc = 0; for (int e = 0; e < 32; ++e) { tab[e] = acc; acc += (tab[64 + e] + 255) >> 8; } tab[32] = acc; }
    __syncthreads();
}
__device__ __forceinline__ void phase_conv4(KArgs a) {
    const bf16_t* XR = (const bf16_t*)(a.ws + A_XR); bf16_t* XC = (bf16_t*)(a.ws + A_XC); const float* cw = a.in[20]; const float* cb = a.in[21];
    const int NT = gridDim.x * 512;
    for (int it = blockIdx.x * 512 + opaque_tid(); it < (NTOK / 32) * 256; it += NT) { const int ch = (it & 255) * 8, tok0 = (it >> 8) * 32, t0 = tok0 & (SEQ - 1);
        float w[4][8], bias[8];
#pragma unroll
        for (int j = 0; j < 4; ++j) { const f32x4 p = *(const f32x4*)(cw + j * DM + ch), q = *(const f32x4*)(cw + j * DM + ch + 4);
#pragma unroll
            for (int i = 0; i < 4; ++i) { w[j][i] = p[i]; w[j][4 + i] = q[i]; } }
        { const f32x4 p = *(const f32x4*)(cb + ch), q = *(const f32x4*)(cb + ch + 4);
#pragma unroll
          for (int i = 0; i < 4; ++i) { bias[i] = p[i]; bias[4 + i] = q[i]; } }
        const bf16_t* xp = XR + (size_t)tok0 * DM + ch;
#define C4_ROW(dt) (((t0 + (dt)) >= 0 && (t0 + (dt)) < SEQ) ? *(const u32x4*)(xp + (ptrdiff_t)(dt) * DM) : (u32x4){0u, 0u, 0u, 0u})
#define C4_UNPACK(dst, r) do { dst[0] = bflo(r.x); dst[1] = bfhi(r.x); dst[2] = bflo(r.y); dst[3] = bfhi(r.y); dst[4] = bflo(r.z); dst[5] = bfhi(r.z); dst[6] = bflo(r.w); dst[7] = bfhi(r.w); } while (0)
        u32x4 nx[2][8];
        const u32x4 rm2 = C4_ROW(-2), rm1 = C4_ROW(-1), r0 = C4_ROW(0);
#pragma unroll
        for (int k = 0; k < 8; ++k) nx[0][k] = C4_ROW(1 + k);
        float xa[8], xb_[8], xc[8], xd[8];
        C4_UNPACK(xa, rm2); C4_UNPACK(xb_, rm1); C4_UNPACK(xc, r0);
#pragma unroll
        for (int g = 0; g < 4; ++g) {
            if (g < 3) {
#pragma unroll
                for (int k = 0; k < 8; ++k) nx[(g + 1) & 1][k] = C4_ROW(9 + 8 * g + k); }
            __builtin_amdgcn_sched_barrier(0);
#pragma unroll
            for (int k = 0; k < 8; ++k) { const u32x4 rn = nx[g & 1][k]; C4_UNPACK(xd, rn);
                float o[8];
#pragma unroll
                for (int i = 0; i < 8; ++i) o[i] = fmaf(w[3][i], xd[i], fmaf(w[2][i], xc[i], fmaf(w[1][i], xb_[i], fmaf(w[0][i], xa[i], bias[i]))));
                u32x4 ow; ow.x = pk2(o[0], o[1]); ow.y = pk2(o[2], o[3]); ow.z = pk2(o[4], o[5]); ow.w = pk2(o[6], o[7]);
                *(u32x4*)(XC + (size_t)(tok0 + 8 * g + k) * DM + ch) = ow;
#pragma unroll
                for (int i = 0; i < 8; ++i) { xa[i] = xb_[i]; xb_[i] = xc[i]; xc[i] = xd[i]; } }
            __builtin_amdgcn_sched_barrier(0); }
#undef C4_ROW
#undef C4_UNPACK
    }
}
constexpr size_t CAR_ELEMS = (size_t)2 * 2 * 256 * DM;
constexpr float RG_ILA = 1.0f / pg8::RG_SLA, RG_IB = 1.0f / pg8::RG_SB;
__device__ __forceinline__ void phase_scan1(KArgs a) {
    const bf16_t* LA = (const bf16_t*)(a.ws + A_LA); const bf16_t* BB = (const bf16_t*)(a.ws + A_BB); float* CARA = (float*)(a.ws + A_CAR); float* CARB = CARA + CAR_ELEMS;
    const int NT = gridDim.x * 512;
    for (int it = blockIdx.x * 512 + opaque_tid(); it < 2 * 2 * 256 * 512; it += NT) { const int ch = (it & 511) * 4, chunk = (it >> 9) & 255, dir = (it >> 17) & 1, b = it >> 18;
        float h[4] = {0.f, 0.f, 0.f, 0.f}, ls[4] = {0.f, 0.f, 0.f, 0.f};
#pragma unroll 8
        for (int s = 0; s < 32; ++s) { const int t = chunk * 32 + (dir ? 31 - s : s); const size_t off = ((size_t)dir * NTOK + (size_t)b * SEQ + t) * DM + ch;
            const int lw = *(const int*)((const unsigned char*)LA + off), bw = *(const int*)((const unsigned char*)BB + off);
            const float l4[4] = {RG_ILA * __builtin_amdgcn_cvt_f32_fp8(lw, 0), RG_ILA * __builtin_amdgcn_cvt_f32_fp8(lw, 1), RG_ILA * __builtin_amdgcn_cvt_f32_fp8(lw, 2), RG_ILA * __builtin_amdgcn_cvt_f32_fp8(lw, 3)};
            const float b4[4] = {RG_IB * __builtin_amdgcn_cvt_f32_fp8(bw, 0), RG_IB * __builtin_amdgcn_cvt_f32_fp8(bw, 1), RG_IB * __builtin_amdgcn_cvt_f32_fp8(bw, 2), RG_IB * __builtin_amdgcn_cvt_f32_fp8(bw, 3)};
#pragma unroll
            for (int i = 0; i < 4; ++i) { h[i] = __expf(l4[i]) * h[i] + b4[i]; ls[i] += l4[i]; } }
        const size_t co = (((size_t)b * 2 + dir) * 256 + chunk) * DM + ch;
        *(f32x4*)(CARA + co) = (f32x4){ls[0], ls[1], ls[2], ls[3]}; *(f32x4*)(CARB + co) = (f32x4){h[0], h[1], h[2], h[3]}; }
}
__device__ __forceinline__ void phase_scan2(KArgs a, LAS unsigned char* lds) {
    float* CARA = (float*)(a.ws + A_CAR); float* CARB = CARA + CAR_ELEMS; float* CARIN = CARB + CAR_ELEMS;
    const int tid = opaque_tid(), grp = tid >> 5, chl = tid & 31;
    LAS float* sh = (LAS float*)lds;
    for (int it = blockIdx.x; it < 2 * 2 * 64; it += gridDim.x) { const int ch = (it & 63) * 32 + chl, dir = (it >> 6) & 1, b = it >> 7;
        float la[16], lb[16]; float A = 0.f, B = 0.f;
#pragma unroll
        for (int k = 0; k < 16; ++k) { const int q = grp * 16 + k, chunk = dir ? 255 - q : q; const size_t co = (((size_t)b * 2 + dir) * 256 + chunk) * DM + ch; la[k] = CARA[co]; lb[k] = CARB[co]; }
#pragma unroll
        for (int k = 0; k < 16; ++k) { B = __expf(la[k]) * B + lb[k]; A += la[k]; }
        sh[(grp * 32 + chl) * 2] = A; sh[(grp * 32 + chl) * 2 + 1] = B;
        __syncthreads();
        float h = 0.f;
        for (int g2 = 0; g2 < grp; ++g2) h = __expf(sh[(g2 * 32 + chl) * 2]) * h + sh[(g2 * 32 + chl) * 2 + 1];
#pragma unroll
        for (int k = 0; k < 16; ++k) { const int q = grp * 16 + k, chunk = dir ? 255 - q : q; const size_t co = (((size_t)b * 2 + dir) * 256 + chunk) * DM + ch; CARIN[co] = h; h = __expf(la[k]) * h + lb[k]; }
        __syncthreads();
    }
}
__device__ __forceinline__ float gelu_tanh(float x) { const float u = 0.7978845608028654f * (x + 0.044715f * x * x * x); const float th = 1.0f - 2.0f * __builtin_amdgcn_rcpf(1.0f + __builtin_amdgcn_exp2f(2.8853900817779268f * u)); return 0.5f * x * (1.0f + th); }
__device__ __forceinline__ void phase_scan3(KArgs a) {
    const unsigned char* LA = (const unsigned char*)(a.ws + A_LA); const unsigned char* BB = (const unsigned char*)(a.ws + A_BB); const bf16_t* GB = (const bf16_t*)(a.ws + A_GB); bf16_t* YG = (bf16_t*)(a.ws + A_YG);
    const float* CARIN = (const float*)(a.ws + A_CAR) + 2 * CAR_ELEMS;
    const int NT = gridDim.x * 512;
    constexpr float LSC = RG_ILA * 1.4426950408889634f;
    for (int it = blockIdx.x * 512 + opaque_tid(); it < 2 * 256 * 512; it += NT) { const int ch = (it & 511) * 4, chunk = (it >> 9) & 255, b = it >> 17;
        unsigned hf[32][2]; float h[4];
        const size_t base = ((size_t)b * SEQ + chunk * 32) * DM + ch;
        int lw[2][8], bw[2][8]; u32x2 gw[2][8];
#define S3_LOADF(set, g) do { _Pragma("unroll") for (int j = 0; j < 8; ++j) { const size_t off = base + (size_t)((g) * 8 + j) * DM; lw[set][j] = *(const int*)(LA + off); bw[set][j] = *(const int*)(BB + off); } } while (0)
#define S3_LOADR(set, g) do { _Pragma("unroll") for (int j = 0; j < 8; ++j) { const size_t tokoff = base + (size_t)((g) * 8 + j) * DM; lw[set][j] = *(const int*)(LA + (size_t)NTOK * DM + tokoff); bw[set][j] = *(const int*)(BB + (size_t)NTOK * DM + tokoff); gw[set][j] = *(const u32x2*)(GB + tokoff); } } while (0)
        S3_LOADF(0, 0);
        { const f32x4 c = *(const f32x4*)(CARIN + (((size_t)b * 2 + 0) * 256 + chunk) * DM + ch); h[0] = c[0] * pg8::RG_SB; h[1] = c[1] * pg8::RG_SB; h[2] = c[2] * pg8::RG_SB; h[3] = c[3] * pg8::RG_SB; }
#pragma unroll
        for (int g = 0; g < 4; ++g) {
            if (g < 3) S3_LOADF((g + 1) & 1, g + 1); else S3_LOADR(0, 3);
            __builtin_amdgcn_sched_barrier(0);
#pragma unroll
            for (int j = 0; j < 8; ++j) { const int s = g * 8 + j, lwv = lw[g & 1][j], bwv = bw[g & 1][j];
#pragma unroll
                for (int i = 0; i < 4; ++i) { const float av = __builtin_amdgcn_exp2f(LSC * (i == 0 ? __builtin_amdgcn_cvt_f32_fp8(lwv, 0) : i == 1 ? __builtin_amdgcn_cvt_f32_fp8(lwv, 1) : i == 2 ? __builtin_amdgcn_cvt_f32_fp8(lwv, 2) : __builtin_amdgcn_cvt_f32_fp8(lwv, 3)));
                    const float bv = (i == 0 ? __builtin_amdgcn_cvt_f32_fp8(bwv, 0) : i == 1 ? __builtin_amdgcn_cvt_f32_fp8(bwv, 1) : i == 2 ? __builtin_amdgcn_cvt_f32_fp8(bwv, 2) : __builtin_amdgcn_cvt_f32_fp8(bwv, 3));
                    h[i] = fmaf(av, h[i], bv); }
                hf[s][0] = cvt_pk_bf16(h[0], h[1]); hf[s][1] = cvt_pk_bf16(h[2], h[3]); }
            __builtin_amdgcn_sched_barrier(0); }
        { const f32x4 c = *(const f32x4*)(CARIN + (((size_t)b * 2 + 1) * 256 + chunk) * DM + ch); h[0] = c[0] * pg8::RG_SB; h[1] = c[1] * pg8::RG_SB; h[2] = c[2] * pg8::RG_SB; h[3] = c[3] * pg8::RG_SB; }
        constexpr float OSC = (FP8_P16 ? 4.0f : 1.0f) * RG_IB;
#pragma unroll
        for (int g = 3; g >= 0; --g) { const int set = (3 - g) & 1;
            if (g > 0) S3_LOADR(set ^ 1, g - 1);
            __builtin_amdgcn_sched_barrier(0);
#pragma unroll
            for (int j = 7; j >= 0; --j) { const int s = g * 8 + j, lwv = lw[set][j], bwv = bw[set][j]; const u32x2 gv = gw[set][j];
                const float g4[4] = {bflo(gv.x), bfhi(gv.x), bflo(gv.y), bfhi(gv.y)}, f4[4] = {bflo(hf[s][0]), bfhi(hf[s][0]), bflo(hf[s][1]), bfhi(hf[s][1])};
                float y[4];
#pragma unroll
                for (int i = 0; i < 4; ++i) { const float av = __builtin_amdgcn_exp2f(LSC * (i == 0 ? __builtin_amdgcn_cvt_f32_fp8(lwv, 0) : i == 1 ? __builtin_amdgcn_cvt_f32_fp8(lwv, 1) : i == 2 ? __builtin_amdgcn_cvt_f32_fp8(lwv, 2) : __builtin_amdgcn_cvt_f32_fp8(lwv, 3)));
                    const float bv = (i == 0 ? __builtin_amdgcn_cvt_f32_fp8(bwv, 0) : i == 1 ? __builtin_amdgcn_cvt_f32_fp8(bwv, 1) : i == 2 ? __builtin_amdgcn_cvt_f32_fp8(bwv, 2) : __builtin_amdgcn_cvt_f32_fp8(bwv, 3));
                    h[i] = fmaf(av, h[i], bv); y[i] = (OSC * gelu_tanh(g4[i])) * (f4[i] + h[i]); }
                const size_t tokoff = base + (size_t)s * DM;
                if (FP8_P16) { *(unsigned*)((unsigned char*)YG + tokoff) = pg8::pk4_fp8(y[0], y[1], y[2], y[3]); }
                else { u32x2 w; w.x = pk2(y[0], y[1]); w.y = pk2(y[2], y[3]); *(u32x2*)(YG + tokoff) = w; } }
            __builtin_amdgcn_sched_barrier(0); }
#undef S3_LOADF
#undef S3_LOADR
    }
}

#define KARGS() (*(const __attribute__((address_space(4))) Args*)__builtin_amdgcn_kernarg_segment_ptr())
#define PHASE_FN __device__ __forceinline__ void
#define PH_PRE() KArgs a = KARGS(); LAS unsigned char* lds = (LAS unsigned char*)lds_raw; unsigned char* ws = a.ws; asm volatile("" : "+s"(ws)); const int G = gridDim.x, bx = blockIdx.x; (void)lds; (void)ws; (void)G; (void)bx; using namespace pg8
PHASE_FN ph0() { PH_PRE(); phase_prologue(a, lds); }
#define NSTREAM(G_) ((G_) >= 64 ? ((G_) >> 3) : 0)
PHASE_FN ph1q() { PH_PRE(); const int tid = opaque_tid(); tb_stream_q<0>(a, lds, tid, tid >> 6, tid & 63); }
PHASE_FN ph3q() { PH_PRE(); const int tid = opaque_tid(); tb_stream_q<1>(a, lds, tid, tid >> 6, tid & 63); }
PHASE_FN ph1a() { PH_PRE(); Gemm g{(const bf16_t*)(ws + A_W4T), (const bf16_t*)(ws + A_H3B), 128, 128, 128}; StaticOrder S; S.init(4096, 8192, G - NSTREAM(G), bx); EpiFilt E{(bf16_t*)(ws + A_KTD)}; gemm_phase(lds, g, S, E); }
PHASE_FN ph1b() { PH_PRE(); StaticOrder S; S.init(NTOK, 3072, G - NSTREAM(G), bx);
    if constexpr (FP8_P1B) { Gemm g{(const bf16_t*)(ws + A_XB8), (const bf16_t*)(ws + WS_WIN_EV8 + (size_t)3072 * DM), DM / 2, DM / 2, DM / 2};
        EpiBf16 E{(bf16_t*)(ws + A_QB), 1024, 1024, (size_t)(A_KB - A_QB) / 2, QSCALE, 1.0f / FP8_SW, (unsigned*)(ws + WS_CTL) + CW_NORM, (LAS float*)(lds + 131072)}; gemm_phase<EpiBf16, StaticOrder, true>(lds, g, S, E); }
    else { Gemm g{(const bf16_t*)(ws + A_XB), (const bf16_t*)(ws + WS_WIN_EV) + (size_t)3072 * DM, DM, DM, DM};
        EpiBf16 E{(bf16_t*)(ws + A_QB), 1024, 1024, (size_t)(A_KB - A_QB) / 2, QSCALE, 1.0f, (unsigned*)(ws + WS_CTL) + CW_NORM, (LAS float*)(lds + 131072)}; gemm_phase(lds, g, S, E); } }
PHASE_FN ph1c() { PH_PRE(); StaticOrder S; { const int Gc = G - NSTREAM(G); S.init(3072, NTOK, Gc, (bx + ((Gc >> 1) & ~7)) % Gc); }
    if constexpr (FP8_P1C) { Gemm g{(const bf16_t*)(ws + WS_WIN_EV8), (const bf16_t*)(ws + A_XB8), DM / 2, DM / 2, DM / 2};
        EpiBf16 E{(bf16_t*)(ws + A_UHT), NTOK, 0, 0, 1.f, 1.0f / FP8_SW}; gemm_phase<EpiBf16, StaticOrder, true>(lds, g, S, E); }
    else { Gemm g{(const bf16_t*)(ws + WS_WIN_EV), (const bf16_t*)(ws + A_XB), DM, DM, DM};
        EpiBf16 E{(bf16_t*)(ws + A_UHT), NTOK, 0, 0, 1.f}; gemm_phase(lds, g, S, E); } }
PHASE_FN ph2() { PH_PRE(); phase_qknorm(a, lds); }
PHASE_FN ph3a() { PH_PRE(); phase_hyena_mixer(a, lds); }
PHASE_FN ph3b() { PH_PRE(); phase_attention(a, lds); }
PHASE_FN ph4() { PH_PRE(); phase_concat(a, lds); }
PHASE_FN ph5() { PH_PRE(); StaticOrder S; S.init(NTOK, DM, G, bx);
    if constexpr (FP8_P5) { Gemm g{(const bf16_t*)(ws + A_YCAT), (const bf16_t*)(ws + WS_WOUT_EV), DM / 2, DM / 2, DM / 2};
        EpiResBf E{(const bf16_t*)(ws + A_XB2), (bf16_t*)(ws + A_R0), DM, DN_ALPHA, 1.0f / FP8_SW}; gemm_phase<EpiResBf, StaticOrder, true>(lds, g, S, E); }
    else { Gemm g{(const bf16_t*)(ws + A_YCAT), (const bf16_t*)(ws + WS_WOUT_EV), DM, DM, DM};
        EpiResBf E{(const bf16_t*)(ws + A_XB2), (bf16_t*)(ws + A_R0), DM, DN_ALPHA}; gemm_phase(lds, g, S, E); } }
template <int LAYER> PHASE_FN ph_lnr() { PH_PRE(); unsigned* ctl = (unsigned*)(ws + WS_CTL);
    phase_ln_router(a, lds, (const bf16_t*)(ws + (LAYER ? A_R1 : A_R0)), a.in[28] + LAYER * DM, a.in[29] + LAYER * DM, (bf16_t*)(ws + (LAYER ? A_HB_1 : A_HB_0)), (LAYER >= 2 - MOE_FP8_LAYERS) ? ws + (LAYER ? A_HB8_1 : A_HB8_0) : nullptr,
                    ctl + CW_CNT + LAYER * 32 * 64, (int*)(ws + A_ROWL), (float*)(ws + A_GATEW)); }
template <int LAYER> PHASE_FN ph_moe1(int Gq = -1, int cq = 0, int L0 = 0, int L1 = 1 << 30) { PH_PRE(); LAS int* tab = (LAS int*)(lds + LDS_MISC); if (Gq < 0) moe_table(tab, (const unsigned*)(ws + WS_CTL) + CW_CNT + LAYER * 32 * 64);
    MoeOrder<4, true> S{Gq < 0 ? G : Gq, Gq < 0 ? bx : cq, tab, (const int*)(ws + A_ROWL), L0, L1};
    if constexpr (LAYER >= 2 - MOE_FP8_LAYERS) {
        Gemm g{(const bf16_t*)(ws + (LAYER ? A_HB8_1 : A_HB8_0)), (const bf16_t*)(ws + WS_W1T + (size_t)LAYER * 32 * 1024 * DM * 2), DM / 2, DM / 2, DM / 2};
        EpiSwiglu8 E{ws + (LAYER ? A_HID_1 : A_HID_0)}; gemm_phase<EpiSwiglu8, MoeOrder<4, true>, true>(lds, g, S, E);
    } else {
        Gemm g{(const bf16_t*)(ws + (LAYER ? A_HB_1 : A_HB_0)), (const bf16_t*)(ws + WS_W1T) + (size_t)LAYER * 32 * 1024 * DM, DM, DM, DM};
        EpiSwiglu E{(bf16_t*)(ws + (LAYER ? A_HID_1 : A_HID_0))}; gemm_phase(lds, g, S, E); } }
template <int LAYER> PHASE_FN ph_moe2(int Gq = -1, int cq = 0, int L0 = 0, int L1 = 1 << 30) { PH_PRE(); LAS int* tab = (LAS int*)(lds + LDS_MISC); if (Gq < 0) moe_table(tab, (const unsigned*)(ws + WS_CTL) + CW_CNT + LAYER * 32 * 64);
    MoeOrder<8, false> S{Gq < 0 ? G : Gq, Gq < 0 ? bx : cq, tab, (const int*)(ws + A_ROWL), L0, L1};
    if constexpr (LAYER >= 2 - MOE_FP8_LAYERS) {
        Gemm g{(const bf16_t*)(ws + (LAYER ? A_HID_1 : A_HID_0)), (const bf16_t*)(ws + WS_W2T + (size_t)LAYER * 32 * DM * DFF * 2), DFF / 2, DFF / 2, DFF / 2};
        EpiDown E{(bf16_t*)(ws + (LAYER ? A_Y2_1 : A_Y2_0)), (const int*)(ws + A_ROWL), (const float*)(ws + A_GATEW), 1.0f / (FP8_SW * FP8_SH)};
        gemm_phase<EpiDown, MoeOrder<8, false>, true>(lds, g, S, E);
    } else {
        Gemm g{(const bf16_t*)(ws + (LAYER ? A_HID_1 : A_HID_0)), (const bf16_t*)(ws + WS_W2T) + (size_t)LAYER * 32 * DM * DFF, DFF, DFF, DFF};
        EpiDown E{(bf16_t*)(ws + (LAYER ? A_Y2_1 : A_Y2_0)), (const int*)(ws + A_ROWL), (const float*)(ws + A_GATEW), 1.0f}; gemm_phase(lds, g, S, E); } }
template <int LAYER> PHASE_FN ph_ln2() { PH_PRE();
    phase_ln2((const bf16_t*)(ws + (LAYER ? A_HB_1 : A_HB_0)), (const bf16_t*)(ws + (LAYER ? A_Y2_1 : A_Y2_0)), a.in[30] + LAYER * DM, a.in[31] + LAYER * DM, LAYER ? a.out : nullptr, LAYER ? nullptr : (bf16_t*)(ws + A_HB2), (!LAYER && FP8_P10) ? ws + A_HB2_8 : nullptr); }
PHASE_FN ph10() { PH_PRE(); StaticOrder S; S.init(NTOK, 2 * DM, G, bx);
    if constexpr (FP8_P10) { Gemm g{(const bf16_t*)(ws + A_HB2_8), (const bf16_t*)(ws + WS_WIN_OD), DM / 2, DM / 2, DM / 2};
        EpiBf16 E{(bf16_t*)(ws + A_GB), DM, DM, (size_t)(A_XR - A_GB) / 2, 1.f, 1.0f / FP8_SW}; gemm_phase<EpiBf16, StaticOrder, true>(lds, g, S, E); }
    else { Gemm g{(const bf16_t*)(ws + A_HB2), (const bf16_t*)(ws + WS_WIN_OD), DM, DM, DM};
        EpiBf16 E{(bf16_t*)(ws + A_GB), DM, DM, (size_t)(A_XR - A_GB) / 2, 1.f}; gemm_phase(lds, g, S, E); } }
PHASE_FN ph11() { PH_PRE(); phase_conv4(a); }
PHASE_FN ph12() { PH_PRE(); Gemm g{(const bf16_t*)(ws + A_XC), (const bf16_t*)(ws + WS_WG_OD), DM, 256, 256}; RGOrder S{G, bx};
                  EpiRG E{(bf16_t*)(ws + A_LA), (bf16_t*)(ws + A_BB), (const bf16_t*)(ws + A_XC), a.in[23], a.in[25], a.in[26]}; gemm_phase(lds, g, S, E); }
PHASE_FN ph13() { PH_PRE(); phase_scan1(a); }
PHASE_FN ph14() { PH_PRE(); phase_scan2(a, lds); }
PHASE_FN ph15() { PH_PRE(); phase_scan3(a); }
PHASE_FN ph16() { PH_PRE(); StaticOrder S; S.init(NTOK, DM, G, bx);
    if constexpr (FP8_P16) { Gemm g{(const bf16_t*)(ws + A_YG), (const bf16_t*)(ws + WS_WOUT_OD), DM / 2, DM / 2, DM / 2};
        EpiResBf E{(const bf16_t*)(ws + A_HB2), (bf16_t*)(ws + A_R1), DM, DN_ALPHA, 1.0f / (FP8_SW * 4.0f)}; gemm_phase<EpiResBf, StaticOrder, true>(lds, g, S, E); }
    else { Gemm g{(const bf16_t*)(ws + A_YG), (const bf16_t*)(ws + WS_WOUT_OD), DM, DM, DM};
        EpiResBf E{(const bf16_t*)(ws + A_HB2), (bf16_t*)(ws + A_R1), DM, DN_ALPHA}; gemm_phase(lds, g, S, E); } }

template <int LAYER> __device__ __forceinline__ void moe_stages(const XcdBarrier& bar) {
    const int G = gridDim.x, bx = blockIdx.x;
    const unsigned* cnt = (const unsigned*)(KARGS().ws + WS_CTL) + CW_CNT + LAYER * 32 * 64;
    int ntile = 0;
#pragma unroll 1
    for (int e = 0; e < 32; ++e) ntile += ((int)__builtin_amdgcn_readfirstlane(cnt[e * 64]) + 255) >> 8;
    moe_table((LAS int*)((LAS unsigned char*)lds_raw + LDS_MISC), cnt);
    const int n1 = ntile * 4, LA = (n1 / G) * G, R = n1 - LA, tdone = LA >> 2, Gp = G - R;
    int E2 = 2 * Gp; if (E2 > 8 * tdone) E2 = 8 * tdone;
    for (int st = 0; st < 3; ++st) {
        int g1 = G, c1 = bx, a0 = 0, a1 = 0, g2 = G, c2 = bx, b0 = 0, b1 = 0;
        if (st == 0) { a1 = LA; }
        else if (st == 1) { if (bx < R) { a0 = LA; a1 = n1; } else { g2 = Gp; c2 = bx - R; b1 = E2; } }
        else { b0 = E2; b1 = 1 << 30; }
        asm volatile("; PHASE_MARK 7"); ph_moe1<LAYER>(g1, c1, a0, a1);
        asm volatile("; PHASE_MARK 8"); ph_moe2<LAYER>(g2, c2, b0, b1);
        if (st < 2) xcd_barrier(bar);
    }
}
__global__ void __launch_bounds__(512, 2) fwd(Args a) {
    LAS unsigned char* lds = (LAS unsigned char*)lds_raw;
    unsigned* ctl = (unsigned*)(a.ws + WS_CTL);
    volatile LAS unsigned* bst = (volatile LAS unsigned*)(lds + LDS_MISC + 2048);
    { const int tid = threadIdx.x;
      if ((tid & 63) == 0) ((LAS int*)(lds + LDS_WIDTAB))[hw_slot()] = tid >> 6;
      if (tid < 4) bst[tid] = 0u; }
    __syncthreads();
    const int lo = a.ph_lo, hi = a.ph_hi;
    XcdBarrier bar; bar.bar = ctl + CW_BAR; bar.x = 0; bar.st = bst;
    if (hi - lo > 1) bar = xcd_barrier_post(ctl + CW_BAR, bst);
#ifdef ONLY_PHASE
#define IN(k) ((k) == ONLY_PHASE && lo <= (k) && (k) < hi)
#else
#define IN(k) (lo <= (k) && (k) < hi)
#endif
#define SEAM(k) do { if (IN(k) && IN((k) + 1)) xcd_barrier(bar); } while (0)
    if (IN(0)) { asm volatile("; PHASE_MARK 0"); ph0(); } SEAM(0);
    if (IN(1)) { if ((int)blockIdx.x < (int)gridDim.x - NSTREAM((int)gridDim.x)) { asm volatile("; PHASE_MARK 1a"); ph1a(); asm volatile("; PHASE_MARK 1b"); ph1b(); asm volatile("; PHASE_MARK 1c"); ph1c(); } asm volatile("; PHASE_MARK 1q"); ph1q(); } if (IN(1) && (IN(2) || IN(3))) xcd_barrier(bar);
    if (IN(3)) { asm volatile("; PHASE_MARK 3a"); ph3a();
        for (int r = 0; r < 2; ++r) { if (r == 1 || (int)blockIdx.x >= (int)gridDim.x - NSTREAM((int)gridDim.x)) { asm volatile("; PHASE_MARK 3q"); ph3q(); }
            if (r == 0) { asm volatile("; PHASE_MARK 3b"); ph3b(); } } } SEAM(3);
    if (IN(4)) { asm volatile("; PHASE_MARK 4"); ph4(); } SEAM(4);
    if (IN(5)) { asm volatile("; PHASE_MARK 5"); ph5(); } SEAM(5);
    if (IN(6)) { asm volatile("; PHASE_MARK 6"); ph_lnr<0>(); } SEAM(6);
    if (IN(7) && IN(8)) { moe_stages<0>(bar); } else { if (IN(7)) { asm volatile("; PHASE_MARK 7"); ph_moe1<0>(); } if (IN(8)) { asm volatile("; PHASE_MARK 8"); ph_moe2<0>(); } } SEAM(8);
    if (IN(9)) { asm volatile("; PHASE_MARK 9"); ph_ln2<0>(); } SEAM(9);
    if (IN(10)) { asm volatile("; PHASE_MARK 10"); ph10(); } SEAM(10);
    if (IN(11)) { asm volatile("; PHASE_MARK 11"); ph11(); } SEAM(11);
    if (IN(12)) { asm volatile("; PHASE_MARK 12"); ph12(); } SEAM(12);
    if (IN(13)) { asm volatile("; PHASE_MARK 13"); ph13(); } SEAM(13);
    if (IN(14)) { asm volatile("; PHASE_MARK 14"); ph14(); } SEAM(14);
    if (IN(15)) { asm volatile("; PHASE_MARK 15"); ph15(); } SEAM(15);
    if (IN(16)) { asm volatile("; PHASE_MARK 16"); ph16(); } SEAM(16);
    if (IN(17)) { asm volatile("; PHASE_MARK 17"); ph_lnr<1>(); } SEAM(17);
    if (IN(18) && IN(19)) { moe_stages<1>(bar); } else { if (IN(18)) { asm volatile("; PHASE_MARK 18"); ph_moe1<1>(); } if (IN(19)) { asm volatile("; PHASE_MARK 19"); ph_moe2<1>(); } } SEAM(19);
    if (IN(20)) { asm volatile("; PHASE_MARK 20"); ph_ln2<1>(); }
#undef IN
#undef SEAM
}

#ifndef MK_PER_PHASE
#define MK_PER_PHASE 0
#endif
extern "C" void kernel_launch(void* const* d_in, const int* in_sizes, int n_in, void* d_out, int out_size, void* d_ws, size_t ws_size, hipStream_t stream) {
    static int grid = 0;
    if (grid == 0) {
        if (n_in != 37 || out_size != NTOK * DM || ws_size < WS_END) { fprintf(stderr, "kernel_launch: built for 37 inputs, %d outputs, >= %zu bytes of workspace; got n_in %d out %d ws %zu\n", NTOK * DM, (size_t)WS_END, n_in, out_size, ws_size); grid = -1; return; }
        int dev = 0, cus = 0, per_cu = 0;
        if (hipGetDevice(&dev) != hipSuccess || hipDeviceGetAttribute(&cus, hipDeviceAttributeMultiprocessorCount, dev) != hipSuccess) { grid = -1; return; }
        if (hipFuncSetAttribute((const void*)fwd, hipFuncAttributeMaxDynamicSharedMemorySize, LDS_BYTES) != hipSuccess) { fprintf(stderr, "kernel_launch: hipFuncSetAttribute failed\n"); grid = -1; return; }
        if (hipOccupancyMaxActiveBlocksPerMultiprocessor(&per_cu, (const void*)fwd, 512, LDS_BYTES) != hipSuccess || per_cu < 1) fprintf(stderr, "kernel_launch: occupancy query reports %d\n", per_cu);
        (void)hipGetLastError();
        grid = cus;
    }
    if (grid < 0) return;
    (void)hipMemsetAsync((char*)d_ws + WS_CTL, 0, CTL_ZERO_BYTES, stream);
    Args a{};
    for (int i = 0; i < 37; ++i) a.in[i] = (const float*)d_in[i];
    a.out = (float*)d_out; a.ws = (unsigned char*)d_ws;
#if MK_PER_PHASE
    for (int p = 0; p < NPHASE; ++p) { a.ph_lo = p; a.ph_hi = p + 1; hipLaunchKernelGGL(fwd, dim3(grid), dim3(512), LDS_BYTES, stream, a); }
#else
    a.ph_lo = 0; a.ph_hi = NPHASE; hipLaunchKernelGGL(fwd, dim3(grid), dim3(512), LDS_BYTES, stream, a);
#endif
}
```

```cpp
#include <hip/hip_runtime.h>
#include <hip/hip_fp16.h>
#include <cstdio>
#include <cstdint>

#define GAS __attribute__((address_space(1)))
#define LAS __attribute__((address_space(3)))
typedef unsigned short bf16_t;
typedef short bf16x8 __attribute__((ext_vector_type(8)));
typedef short s16x4 __attribute__((ext_vector_type(4)));
typedef float f32x2 __attribute__((ext_vector_type(2)));
typedef float f32x4 __attribute__((ext_vector_type(4)));
typedef float f32x8 __attribute__((ext_vector_type(8)));
typedef float f32x16 __attribute__((ext_vector_type(16)));
typedef unsigned u32x2 __attribute__((ext_vector_type(2)));
typedef unsigned u32x4 __attribute__((ext_vector_type(4)));
typedef GAS unsigned gu32;

constexpr int DM = 2048, BATCH = 2, SEQ = 8192, NTOK = BATCH * SEQ;
constexpr int HY_CH = 1024, EV_IN = 6144;
constexpr int NEXP = 32, DFF = 512, NASSIGN = NTOK * 2, ECAP = NASSIGN;
constexpr float LN_EPS = 1e-5f;
constexpr float DN_ALPHA = 1.4142135623730951f;
constexpr float QSCALE = 0.125f * 1.4426950408889634f;
constexpr int FFT_N = 16384, FFT_RS = 528;

__device__ __forceinline__ unsigned f2bf(float f) { unsigned u = __builtin_bit_cast(unsigned, f); return (u + 0x7fffu + ((u >> 16) & 1u)) >> 16; }
__device__ __forceinline__ unsigned pk2(float lo, float hi) { unsigned r; asm("v_cvt_pk_bf16_f32 %0, %1, %2" : "=v"(r) : "v"(lo), "v"(hi)); return r; }
__device__ __forceinline__ float bf2f(unsigned short h) { return __builtin_bit_cast(float, (unsigned)h << 16); }
__device__ __forceinline__ float bflo(unsigned w) { return __builtin_bit_cast(float, w << 16); }
__device__ __forceinline__ float bfhi(unsigned w) { return __builtin_bit_cast(float, w & 0xffff0000u); }
__device__ __forceinline__ unsigned cvt_pk_bf16(float lo, float hi) { unsigned r; asm volatile("v_cvt_pk_bf16_f32 %0, %1, %2" : "=v"(r) : "v"(lo), "v"(hi)); return r; }
__device__ __forceinline__ float wave_sum(float v) {
#define WS_DPP(x, ctrl) __builtin_bit_cast(float, __builtin_amdgcn_update_dpp(0, __builtin_bit_cast(int, (x)), (ctrl), 0xF, 0xF, true))
    v += WS_DPP(v, 0xB1);
    v += WS_DPP(v, 0x4E);
    v += WS_DPP(v, 0x141);
    v += WS_DPP(v, 0x140);
#undef WS_DPP
    const int vi = __builtin_bit_cast(int, v);
    const float r0 = __builtin_bit_cast(float, __builtin_amdgcn_readlane(vi, 0)), r1 = __builtin_bit_cast(float, __builtin_amdgcn_readlane(vi, 16));
    const float r2 = __builtin_bit_cast(float, __builtin_amdgcn_readlane(vi, 32)), r3 = __builtin_bit_cast(float, __builtin_amdgcn_readlane(vi, 48));
    return (r0 + r1) + (r2 + r3);
}
__device__ __forceinline__ float sigmoidf_(float x) { return __builtin_amdgcn_rcpf(1.0f + __builtin_amdgcn_exp2f(-1.4426950408889634f * x)); }
constexpr int LDS_WIDTAB = 153600 + 3072;
__device__ __forceinline__ int hw_slot() { return (int)(__builtin_amdgcn_s_getreg((5 << 11) | 4) & 63u); }
__device__ __forceinline__ int lane_id() { return (int)__builtin_amdgcn_mbcnt_hi(~0u, __builtin_amdgcn_mbcnt_lo(~0u, 0u)); }
extern __shared__ __attribute__((aligned(16))) unsigned char lds_raw[];
__device__ __forceinline__ int wave_id() { return __builtin_amdgcn_readfirstlane(((const LAS int*)((LAS unsigned char*)lds_raw + LDS_WIDTAB))[hw_slot()]); }
__device__ __forceinline__ int opaque_tid() { int t = wave_id() * 64 + lane_id(); asm volatile("" : "+v"(t)); return t; }
#define LDS_WAIT() asm volatile("s_waitcnt lgkmcnt(0)" ::: "memory")
#define VM_WAIT() asm volatile("s_waitcnt vmcnt(0)" ::: "memory")

#define XB_TMO      128
#define XB_XCNT(j)  (256  + 64 * (j))
#define XB_XSUB(j)  (1280 + 64 * (j))
#define XB_XGEN(j)  (2304 + 64 * (j))
#define XB_TOP      3328
#define XB_TOPGEN   3392
#define XCD_BAR_WORDS 3456
#define XB_SPIN_CAP (1u << 18)
__device__ __forceinline__ unsigned xb_ld(unsigned* p)              { return __hip_atomic_load(p, __ATOMIC_RELAXED, __HIP_MEMORY_SCOPE_AGENT); }
__device__ __forceinline__ unsigned xb_add(unsigned* p, unsigned v) { return __hip_atomic_fetch_add(p, v, __ATOMIC_RELAXED, __HIP_MEMORY_SCOPE_AGENT); }
__device__ __forceinline__ unsigned xb_xcc_id() { return (unsigned)__builtin_amdgcn_s_getreg((3 << 11) | 20) & 0xFu; }
#define XB_SPIN(cond, bar) do { unsigned _sp = 0; while (cond) { __builtin_amdgcn_s_sleep(1); \
    if ((++_sp & 255u) == 0u) { if (xb_ld(&(bar)[XB_TMO])) break; if (_sp > XB_SPIN_CAP) { atomicAdd(&(bar)[XB_TMO], 1u); break; } } } } while (0)
struct XcdBarrier { unsigned* bar; unsigned x; volatile LAS unsigned* st; };
__device__ __forceinline__ XcdBarrier xcd_barrier_post(unsigned* bar, volatile LAS unsigned* st) {
    XcdBarrier b; b.bar = bar; b.x = xb_xcc_id(); b.st = st;
    if (opaque_tid() == 0) (void)xb_add(&bar[XB_XCNT(b.x)], 1u);
    return b;
}
__device__ __forceinline__ void xcd_barrier_complete(unsigned* bar, unsigned x, unsigned& nloc, unsigned& nx) {
    const unsigned G = gridDim.x * gridDim.y * gridDim.z;
    unsigned sum, cnt, mine, sp = 0u;
    for (;;) {
        sum = 0u; cnt = 0u; mine = 0u;
#pragma unroll
        for (unsigned j = 0; j < 16; ++j) { const unsigned c = xb_ld(&bar[XB_XCNT(j)]); sum += c; cnt += (c > 0u) ? 1u : 0u; mine = (j == x) ? c : mine; }
        if (sum == G) break;
        __builtin_amdgcn_s_sleep(1);
        if ((++sp & 255u) == 0u) { if (xb_ld(&bar[XB_TMO])) break; if (sp > XB_SPIN_CAP) { atomicAdd(&bar[XB_TMO], 1u); break; } }
    }
    nloc = mine > 0u ? mine : 1u; nx = cnt > 0u ? cnt : 1u;
}
__device__ __forceinline__ void xcd_barrier(const XcdBarrier& b) {
    asm volatile("s_waitcnt vmcnt(0)" ::: "memory");
    __syncthreads();
    if (opaque_tid() == 0) {
        unsigned* bar = b.bar;
        __builtin_amdgcn_s_waitcnt(0);
        unsigned nloc = b.st[0], nx = b.st[1];
        if (nloc == 0u) { xcd_barrier_complete(bar, b.x, nloc, nx); b.st[0] = nloc; b.st[1] = nx; }
        const unsigned old = xb_add(&bar[XB_XSUB(b.x)], 1u);
        const unsigned gen = old / nloc;
        if (old + 1u == (gen + 1u) * nloc) {
            __builtin_amdgcn_fence(__ATOMIC_RELEASE, "agent");
            asm volatile("s_waitcnt vmcnt(0)" ::: "memory");
            const unsigned og = xb_add(&bar[XB_TOP], 1u);
            const unsigned tg = og / nx;
            if (og + 1u == (tg + 1u) * nx) xb_add(&bar[XB_TOPGEN], 1u);
            else XB_SPIN(xb_ld(&bar[XB_TOPGEN]) == tg, bar);
            __builtin_amdgcn_fence(__ATOMIC_ACQUIRE, "agent");
            xb_add(&bar[XB_XGEN(b.x)], 1u);
            asm volatile("s_waitcnt vmcnt(0)" ::: "memory");
        } else {
            XB_SPIN(xb_ld(&bar[XB_XGEN(b.x)]) == gen, bar);
            __builtin_amdgcn_fence(__ATOMIC_ACQUIRE, "agent");
            asm volatile("s_waitcnt vmcnt(0)" ::: "memory");
        }
    }
    __syncthreads();
}

namespace pg8 {
constexpr int BM = 256, BK = 64, HALF = 128, HTB = HALF * BK * 2, STAGE_BYTES = 8 * HTB, NXCD = 8, WGM = 4;
__host__ __device__ __forceinline__ int lds_byte(int r, int c) { const int st = (r >> 4) * 2 + (c >> 5), rr = r & 15, cc = c & 31, ob = rr * 64 + cc * 2; return st * 1024 + (ob ^ (((ob >> 9) & 1) << 5)); }
__host__ __device__ __forceinline__ void stage_rc(int b, int& R, int& C) { const int st = b / 1024, sb = b % 1024, swz = sb ^ (((sb >> 9) & 1) << 5); R = (st >> 1) * 16 + swz / 64; C = (st & 1) * 32 + (swz % 64) / 2; }
__host__ __device__ __forceinline__ int perm32(int rho) { const int n = rho >> 4, i = rho & 15; return 8 * (i >> 2) + 4 * n + (i & 3); }

struct Unit { int pm, pn, e, t, cnt; };
struct Gemm { const bf16_t* A; const bf16_t* Bt; int lda, ldb, K; };

struct StaticOrder {
    static constexpr bool GATHER_A = false;
    int nM, nN, nwg, G, c;
    __device__ void init(int M, int N, int G_, int c_) { nM = M / BM; nN = N / BM; nwg = nM * nN; G = G_; c = c_; }
    __device__ __forceinline__ bool next(int i, Unit& u) const {
        const long L = (long)i * G + c; if (L >= nwg) return false;
        int wgid = (int)L; { const int q = nwg / NXCD, r = nwg % NXCD, xcd = wgid % NXCD, off = wgid / NXCD; wgid = (xcd < r ? xcd * (q + 1) : r * (q + 1) + (xcd - r) * q) + off; }
        const int nig = WGM * nN, gid = wgid / nig, fm = gid * WGM, gsz = (nM - fm) < WGM ? (nM - fm) : WGM;
        u.pm = fm + ((wgid % nig) % gsz); u.pn = (wgid % nig) / gsz; u.e = 0; u.t = 0; u.cnt = 0; return true;
    }
    __device__ __forceinline__ int rowA(const Unit& u, int r) const { return u.pm * BM + r; }
    __device__ __forceinline__ int colA(const Unit&) const { return 0; }
    __device__ __forceinline__ int rowB(const Unit& u, int r) const { return u.pn * BM + r; }
};

typedef int v8i32 __attribute__((ext_vector_type(8)));
template <class Epi, class Sched, bool FP8 = false>
__device__ __forceinline__ void gemm_phase(LAS unsigned char* lds, const Gemm g, const Sched& S, const Epi& E) {
    const int tid = opaque_tid(), wid = __builtin_amdgcn_readfirstlane(tid >> 6), lane = tid & 63, wr = wid >> 2, wc = wid & 3, fr = lane & 15, fq = lane >> 4;
    const int K = g.K, nt = K / BK;
    constexpr bool GA = Sched::GATHER_A;
    int sR[2], sC[2];
    unsigned laneA[2], laneB[2];
#pragma unroll
    for (int i = 0; i < 2; ++i) { int R, C; stage_rc(tid * 16 + i * 8192, R, C); sR[i] = R; sC[i] = C; const int Rb = Epi::PERM ? ((R & ~31) + perm32(R & 31)) : R;
        laneA[i] = (unsigned)(R * g.lda + C) * 2u; laneB[i] = (unsigned)(Rb * g.ldb + C) * 2u; }
    const size_t hstepA = (size_t)HALF * g.lda * 2, hstepB = (size_t)HALF * g.ldb * 2;
    const unsigned ldsw = (unsigned)wid * 1024u;
    const int aoff = lds_byte(wr * 64 + fr, fq * 8), boff = lds_byte(wc * 32 + fr, fq * 8);
    const char* gA = (const char*)g.A; const char* gB = (const char*)g.Bt;
#define PG8_SA(b, h) (((b) * 2 + (h)) * HTB)
#define PG8_SB(b, h) ((4 + (b) * 2 + (h)) * HTB)
#define PG8_STAGE(bufoff, gptr, voff) do { _Pragma("unroll") for (int _i = 0; _i < 2; ++_i) \
        __builtin_amdgcn_global_load_lds((const unsigned*)((gptr) + (size_t)(voff)[_i]), (LAS unsigned*)(lds + (bufoff) + ldsw + _i * 8192), 16, 0, 0); } while (0)
#define PG8_STAGE_B(bufoff, ub, h, kb) PG8_STAGE(bufoff, gB + (ub) + (size_t)(h) * hstepB + (size_t)(kb), laneB)
#define PG8_STAGE_A(bufoff, ub, va, h, kb) do { if constexpr (GA) { PG8_STAGE(bufoff, gA + (size_t)(kb), va[h]); } else { PG8_STAGE(bufoff, gA + (ub) + (size_t)(h) * hstepA + (size_t)(kb), laneA); } } while (0)
#define PG8_RD(off) (*(const LAS u32x4*)(lds + (off)))
#define PG8_CAT2(x, y) __builtin_bit_cast(v8i32, __builtin_shufflevector((x), (y), 0, 1, 2, 3, 4, 5, 6, 7))
#define PG8_LDA(dst, b, h) do { if constexpr (FP8) { _Pragma("unroll") for (int m = 0; m < 4; ++m) dst##8[m] = PG8_CAT2(PG8_RD(PG8_SA(b, h) + aoff + m * 2048), PG8_RD(PG8_SA(b, h) + aoff + m * 2048 + 1024)); } \
        else { _Pragma("unroll") for (int m = 0; m < 4; ++m) _Pragma("unroll") for (int k = 0; k < 2; ++k) dst[m][k] = *(const LAS bf16x8*)(lds + PG8_SA(b, h) + aoff + m * 2048 + k * 1024); } } while (0)
#define PG8_LDB(dst, b, h) do { if constexpr (FP8) { _Pragma("unroll") for (int n = 0; n < 2; ++n) dst##8[n] = PG8_CAT2(PG8_RD(PG8_SB(b, h) + boff + n * 2048), PG8_RD(PG8_SB(b, h) + boff + n * 2048 + 1024)); } \
        else { _Pragma("unroll") for (int n = 0; n < 2; ++n) _Pragma("unroll") for (int k = 0; k < 2; ++k) dst[n][k] = *(const LAS bf16x8*)(lds + PG8_SB(b, h) + boff + n * 2048 + k * 1024); } } while (0)
#define PG8_MMA(ai, bj, At, Bt) do { __builtin_amdgcn_s_setprio(1); _Pragma("unroll") for (int m = 0; m < 4; ++m) _Pragma("unroll") for (int n = 0; n < 2; ++n) { \
        if constexpr (FP8) { asm volatile("v_mfma_scale_f32_16x16x128_f8f6f4 %0, %1, %2, %0, %3, %3 op_sel_hi:[0,0,0]" : "+v"(acc[ai][bj][m][n]) : "v"(Bt##8[n]), "v"(At##8[m]), "v"(fp8_one)); } \
        else { _Pragma("unroll") for (int k = 0; k < 2; ++k) acc[ai][bj][m][n] = __builtin_amdgcn_mfma_f32_16x16x32_bf16(Bt[n][k], At[m][k], acc[ai][bj][m][n], 0, 0, 0); } } \
        __builtin_amdgcn_s_setprio(0); } while (0)
#define PG8_WAIT_V(n) asm volatile("s_waitcnt vmcnt(" #n ")" ::: "memory")
#define PG8_WAIT_L(n) asm volatile("s_waitcnt lgkmcnt(" #n ")" ::: "memory")
#define PG8_BAR __builtin_amdgcn_s_barrier()
#define PG8_SCHED __builtin_amdgcn_sched_barrier(0)
#define PG8_SCHED8 do { if constexpr (FP8) __builtin_amdgcn_sched_barrier(0); } while (0)
#define PG8_OFFS(u, ubA, ubB, vA) do { ubB = ((size_t)S.rowB(u, 0) * (size_t)g.ldb) * 2; \
        if constexpr (GA) { ubA = 0; _Pragma("unroll") for (int _h = 0; _h < 2; ++_h) _Pragma("unroll") for (int _i = 0; _i < 2; ++_i) vA[_h][_i] = ((unsigned)S.rowA(u, _h * HALF + sR[_i]) * (unsigned)g.lda + (unsigned)sC[_i]) * 2u; } \
        else { ubA = ((size_t)S.rowA(u, 0) * (size_t)g.lda + (size_t)S.colA(u)) * 2; } } while (0)
    Unit cur, nxt; int ui = 0;
    if (!S.next(0, cur)) return;
    f32x4 acc[2][2][4][2];
#pragma unroll
    for (int a = 0; a < 2; ++a)
#pragma unroll
        for (int b = 0; b < 2; ++b)
#pragma unroll
            for (int m = 0; m < 4; ++m)
#pragma unroll
                for (int n = 0; n < 2; ++n) acc[a][b][m][n] = (f32x4){0.f, 0.f, 0.f, 0.f};
    const int fp8_one = 0x7f7f7f7f;
    bf16x8 At[4][2], B0[2][2], B1[2][2]; v8i32 At8[4], B08[2], B18[2];
    size_t ubAc, ubBc, ubAn, ubBn; unsigned vAc[2][2] = {}, vAn[2][2] = {};
    PG8_OFFS(cur, ubAc, ubBc, vAc);
    PG8_STAGE_B(PG8_SB(0, 0), ubBc, 0, 0); PG8_STAGE_B(PG8_SB(0, 1), ubBc, 1, 0); PG8_STAGE_A(PG8_SA(0, 0), ubAc, vAc, 0, 0); PG8_STAGE_A(PG8_SA(0, 1), ubAc, vAc, 1, 0);
    if (wr == 1) PG8_BAR;
    PG8_WAIT_V(2); PG8_BAR;
    PG8_STAGE_B(PG8_SB(1, 0), ubBc, 0, 128); PG8_STAGE_A(PG8_SA(1, 0), ubAc, vAc, 0, 128); PG8_STAGE_B(PG8_SB(1, 1), ubBc, 1, 128);
    PG8_WAIT_V(6); PG8_BAR;
    for (;;) {
        const bool has_next = S.next(ui + 1, nxt);
        if (has_next) { PG8_OFFS(nxt, ubAn, ubBn, vAn); }
        else { ubAn = ubAc; ubBn = ubBc;
#pragma unroll
            for (int h = 0; h < 2; ++h)
#pragma unroll
                for (int i = 0; i < 2; ++i) vAn[h][i] = vAc[h][i]; }
        for (int t = 0; t < nt; t += 2) {
            const bool last = (t == nt - 2);
            const unsigned k1 = (unsigned)(t + 1) * 128u, k2 = last ? 0u : (unsigned)(t + 2) * 128u, k3 = k2 + 128u;
            const size_t xubA = last ? ubAn : ubAc, xubB = last ? ubBn : ubBc;
            unsigned xA[2][2];
#pragma unroll
            for (int h = 0; h < 2; ++h)
#pragma unroll
                for (int i = 0; i < 2; ++i) xA[h][i] = last ? vAn[h][i] : vAc[h][i];
            PG8_LDB(B0, 0, 0); PG8_LDB(B1, 0, 1); PG8_SCHED; PG8_LDA(At, 0, 0); PG8_STAGE_A(PG8_SA(1, 1), ubAc, vAc, 1, k1);
            PG8_WAIT_V(8); PG8_WAIT_L(0); PG8_SCHED8; PG8_BAR; PG8_MMA(0, 0, At, B0); PG8_MMA(0, 1, At, B1); PG8_SCHED8; PG8_BAR; PG8_SCHED;
            PG8_LDA(At, 0, 1); PG8_STAGE_B(PG8_SB(0, 0), xubB, 0, k2); PG8_STAGE_B(PG8_SB(0, 1), xubB, 1, k2); PG8_STAGE_A(PG8_SA(0, 0), xubA, xA, 0, k2);
            PG8_WAIT_V(8); PG8_WAIT_L(0); PG8_SCHED8; PG8_BAR; PG8_MMA(1, 0, At, B0); PG8_MMA(1, 1, At, B1); PG8_SCHED8; PG8_BAR; PG8_SCHED;
            PG8_LDB(B0, 1, 0); PG8_LDB(B1, 1, 1); PG8_SCHED; PG8_LDA(At, 1, 0); PG8_STAGE_A(PG8_SA(0, 1), xubA, xA, 1, k2);
            PG8_WAIT_V(8); PG8_WAIT_L(0); PG8_SCHED8; PG8_BAR; PG8_MMA(0, 0, At, B0); PG8_MMA(0, 1, At, B1); PG8_SCHED8; PG8_BAR; PG8_SCHED;
            PG8_LDA(At, 1, 1); PG8_STAGE_B(PG8_SB(1, 0), xubB, 0, k3); PG8_STAGE_B(PG8_SB(1, 1), xubB, 1, k3); PG8_STAGE_A(PG8_SA(1, 0), xubA, xA, 0, k3);
            PG8_WAIT_V(8); PG8_WAIT_L(0); PG8_SCHED8; PG8_BAR; PG8_MMA(1, 0, At, B0); PG8_MMA(1, 1, At, B1); PG8_SCHED8; PG8_BAR; PG8_SCHED;
        }
        if (wr == 0) PG8_BAR;
        E(acc, cur, wr, wc, fr, fq);
        if (!has_next) break;
#pragma unroll
        for (int a = 0; a < 2; ++a)
#pragma unroll
            for (int b = 0; b < 2; ++b)
#pragma unroll
                for (int m = 0; m < 4; ++m)
#pragma unroll
                    for (int n = 0; n < 2; ++n) acc[a][b][m][n] = (f32x4){0.f, 0.f, 0.f, 0.f};
        cur = nxt; ++ui; ubAc = ubAn; ubBc = ubBn;
#pragma unroll
        for (int h = 0; h < 2; ++h)
#pragma unroll
            for (int i = 0; i < 2; ++i) vAc[h][i] = vAn[h][i];
        if (wr == 1) PG8_BAR;
    }
    PG8_WAIT_V(0);
    PG8_BAR;
#undef PG8_SA
#undef PG8_SB
#undef PG8_STAGE
#undef PG8_STAGE_A
#undef PG8_STAGE_B
#undef PG8_LDA
#undef PG8_LDB
#undef PG8_MMA
#undef PG8_RD
#undef PG8_CAT2
#undef PG8_WAIT_V
#undef PG8_WAIT_L
#undef PG8_BAR
#undef PG8_SCHED
#undef PG8_SCHED8
#undef PG8_OFFS
}
}
namespace pg8 {
struct EpiBf16 {
    static constexpr bool PERM = true;
    bf16_t* O; int ldc; int split_cols; size_t split_stride; float scale0; float scale_all = 1.0f;
    unsigned* nrm = nullptr; LAS float* red = nullptr;
    __device__ __forceinline__ void operator()(const f32x4 (&acc)[2][2][4][2], const Unit& u, int wr, int wc, int fr, int fq) const {
        const int row0 = u.pm * BM + wr * 64 + fr; int colt = u.pn * BM; bf16_t* base = O; int t = 0;
        float sc = scale_all; if (split_cols) { t = colt / split_cols; base += (size_t)t * split_stride; colt -= t * split_cols; if (t == 0) sc *= scale0; }
        const int col0 = colt + wc * 32 + 8 * fq;
        const bool norms = nrm != nullptr && t < 2;
        float sq[16];
#pragma unroll
        for (int ai = 0; ai < 2; ++ai)
#pragma unroll
            for (int m = 0; m < 4; ++m) { bf16_t* rowp = base + (size_t)(row0 + ai * HALF + m * 16) * ldc + col0;
#pragma unroll
                for (int bj = 0; bj < 2; ++bj) { const f32x4 v0 = acc[ai][bj][m][0] * sc, v1 = acc[ai][bj][m][1] * sc;
                    u32x4 w; w.x = cvt_pk_bf16(v0[0], v0[1]); w.y = cvt_pk_bf16(v0[2], v0[3]); w.z = cvt_pk_bf16(v1[0], v1[1]); w.w = cvt_pk_bf16(v1[2], v1[3]);
                    *(u32x4*)(rowp + bj * HALF) = w;
                    if (norms) { float s = 0.f;
#pragma unroll
                        for (int k = 0; k < 4; ++k) { const float lo = bflo(w[k]), hi = bfhi(w[k]); s = fmaf(lo, lo, s); s = fmaf(hi, hi, s); }
                        s += __shfl_xor(s, 16); s += __shfl_xor(s, 32); sq[(ai * 4 + m) * 2 + bj] = s; } } }
        if (norms) {
            int frn = fr, wv = wr * 4 + wc; asm volatile("" : "+v"(frn), "+s"(wv));
            fr = frn;
            if (fq == 0) {
#pragma unroll
                for (int i = 0; i < 16; ++i) red[(wv * 16 + i) * 16 + fr] = sq[i]; }
            asm volatile("s_waitcnt lgkmcnt(0)" ::: "memory"); __builtin_amdgcn_s_barrier(); asm volatile("" ::: "memory");
            float mx[2] = {0.f, 0.f};
#pragma unroll
            for (int i = 0; i < 16; ++i) mx[i & 1] = fmaxf(mx[i & 1], sq[i] + red[((wv ^ 1) * 16 + i) * 16 + fr]);
#pragma unroll
            for (int bj = 0; bj < 2; ++bj) { float v = mx[bj]; v = fmaxf(v, __shfl_xor(v, 1)); v = fmaxf(v, __shfl_xor(v, 2)); v = fmaxf(v, __shfl_xor(v, 4)); v = fmaxf(v, __shfl_xor(v, 8));
                if (fr == 0 && fq == 0 && (wc & 1) == 0) atomicMax(nrm + t * 32 + (u.pm >> 5) * 16 + ((colt >> 7) + bj) * 2 + (wc >> 1), __float_as_uint(v)); }
        }
    }
};
struct EpiFilt {
    static constexpr bool PERM = true;
    bf16_t* O;
    __device__ __forceinline__ void operator()(const f32x4 (&acc)[2][2][4][2], const Unit& u, int wr, int wc, int fr, int fq) const {
        const float dmin = -3.0701134573253945f, dmax = -15.350567286626973f;
#pragma unroll
        for (int ai = 0; ai < 2; ++ai)
#pragma unroll
            for (int m = 0; m < 4; ++m) { const int row = u.pm * BM + ai * HALF + wr * 64 + m * 16 + fr; const int c = row & 1023;
                const float dl2 = fabsf(dmin + (float)c * ((dmax - dmin) / 1023.0f)) * (1.4426950408889634f / 8191.0f);
#pragma unroll
                for (int bj = 0; bj < 2; ++bj) { const int col = u.pn * BM + bj * HALF + wc * 32 + 8 * fq; float v[8];
#pragma unroll
                    for (int n = 0; n < 2; ++n)
#pragma unroll
                        for (int j = 0; j < 4; ++j) v[n * 4 + j] = acc[ai][bj][m][n][j] * __builtin_amdgcn_exp2f(-(float)(col + n * 4 + j) * dl2);
                    u32x4 w; w.x = cvt_pk_bf16(v[0], v[1]); w.y = cvt_pk_bf16(v[2], v[3]); w.z = cvt_pk_bf16(v[4], v[5]); w.w = cvt_pk_bf16(v[6], v[7]);
                    *(u32x4*)(O + (size_t)row * 8192 + col) = w; }
                asm volatile("" ::: "memory"); }
    }
};
struct EpiResF32 {
    static constexpr bool PERM = false;
    const float* res; float* O; int ldc; float alpha;
    __device__ __forceinline__ void operator()(const f32x4 (&acc)[2][2][4][2], const Unit& u, int wr, int wc, int fr, int fq) const {
#pragma unroll
        for (int ai = 0; ai < 2; ++ai)
#pragma unroll
            for (int m = 0; m < 4; ++m) { const size_t off = (size_t)(u.pm * BM + ai * HALF + wr * 64 + m * 16 + fr) * ldc + u.pn * BM + wc * 32 + 4 * fq;
#pragma unroll
                for (int bj = 0; bj < 2; ++bj)
#pragma unroll
                    for (int n = 0; n < 2; ++n) { const f32x4 r = *(const f32x4*)(res + off + bj * HALF + n * 16); *(f32x4*)(O + off + bj * HALF + n * 16) = r * alpha + acc[ai][bj][m][n]; }
                if (m & 1) asm volatile("" ::: "memory"); }
    }
};
struct EpiResBf {
    static constexpr bool PERM = true;
    const bf16_t* res; bf16_t* O; int ldc; float alpha; float ascale = 1.0f;
    __device__ __forceinline__ void operator()(const f32x4 (&acc)[2][2][4][2], const Unit& u, int wr, int wc, int fr, int fq) const {
        u32x4 rs[16];
#pragma unroll
        for (int i = 0; i < 16; ++i) rs[i] = *(const u32x4*)(res + (size_t)(u.pm * BM + (i >> 3) * HALF + wr * 64 + ((i >> 1) & 3) * 16 + fr) * ldc + u.pn * BM + wc * 32 + 8 * fq + (i & 1) * HALF);
#pragma unroll
        for (int ai = 0; ai < 2; ++ai)
#pragma unroll
            for (int m = 0; m < 4; ++m) { const size_t off = (size_t)(u.pm * BM + ai * HALF + wr * 64 + m * 16 + fr) * ldc + u.pn * BM + wc * 32 + 8 * fq;
#pragma unroll
                for (int bj = 0; bj < 2; ++bj) { const u32x4 r = rs[(ai * 4 + m) * 2 + bj]; const f32x4 a0 = acc[ai][bj][m][0] * ascale, a1 = acc[ai][bj][m][1] * ascale;
                    u32x4 w; w.x = cvt_pk_bf16(bflo(r.x) * alpha + a0[0], bfhi(r.x) * alpha + a0[1]); w.y = cvt_pk_bf16(bflo(r.y) * alpha + a0[2], bfhi(r.y) * alpha + a0[3]);
                    w.z = cvt_pk_bf16(bflo(r.z) * alpha + a1[0], bfhi(r.z) * alpha + a1[1]); w.w = cvt_pk_bf16(bflo(r.w) * alpha + a1[2], bfhi(r.w) * alpha + a1[3]);
                    *(u32x4*)(O + off + bj * HALF) = w; } }
    }
};
struct EpiSwiglu {
    static constexpr bool PERM = true;
    bf16_t* O;
    __device__ __forceinline__ void operator()(const f32x4 (&acc)[2][2][4][2], const Unit& u, int wr, int wc, int fr, int fq) const {
#pragma unroll
        for (int ai = 0; ai < 2; ++ai)
#pragma unroll
            for (int m = 0; m < 4; ++m) { bf16_t* p = O + (size_t)(u.pm * BM + ai * HALF + wr * 64 + m * 16 + fr) * DFF + u.pn * HALF + wc * 32 + 8 * fq;
                float h[8];
#pragma unroll
                for (int n = 0; n < 2; ++n)
#pragma unroll
                    for (int j = 0; j < 4; ++j) { const float gt = acc[ai][0][m][n][j], up = acc[ai][1][m][n][j]; h[n * 4 + j] = gt * sigmoidf_(gt) * up; }
                u32x4 w; w.x = cvt_pk_bf16(h[0], h[1]); w.y = cvt_pk_bf16(h[2], h[3]); w.z = cvt_pk_bf16(h[4], h[5]); w.w = cvt_pk_bf16(h[6], h[7]);
                *(u32x4*)p = w; }
    }
};
__device__ __forceinline__ float clamp_fp8(float x) { return __builtin_amdgcn_fmed3f(x, -448.0f, 448.0f); }
__device__ __forceinline__ unsigned pk4_fp8(float a, float b, float c, float d) { int w = 0; w = __builtin_amdgcn_cvt_pk_fp8_f32(clamp_fp8(a), clamp_fp8(b), w, false); w = __builtin_amdgcn_cvt_pk_fp8_f32(clamp_fp8(c), clamp_fp8(d), w, true); return (unsigned)w; }
constexpr float FP8_SW = 64.0f, FP8_SH = 8.0f;
struct EpiSwiglu8 {
    static constexpr bool PERM = true;
    unsigned char* O;
    __device__ __forceinline__ void operator()(const f32x4 (&acc)[2][2][4][2], const Unit& u, int wr, int wc, int fr, int fq) const {
#pragma unroll
        for (int ai = 0; ai < 2; ++ai)
#pragma unroll
            for (int m = 0; m < 4; ++m) { unsigned char* p = O + (size_t)(u.pm * BM + ai * HALF + wr * 64 + m * 16 + fr) * DFF + u.pn * HALF + wc * 32 + 8 * fq;
                float h[8];
#pragma unroll
                for (int n = 0; n < 2; ++n)
#pragma unroll
                    for (int j = 0; j < 4; ++j) { const float g = acc[ai][0][m][n][j], up = acc[ai][1][m][n][j];
                        h[n * 4 + j] = (g * up) * (FP8_SH / (FP8_SW * FP8_SW)) * __builtin_amdgcn_rcpf(1.0f + __builtin_amdgcn_exp2f(g * (-1.4426950408889634f / FP8_SW))); }
                u32x2 w; w.x = pk4_fp8(h[0], h[1], h[2], h[3]); w.y = pk4_fp8(h[4], h[5], h[6], h[7]);
                *(u32x2*)p = w; }
    }
};
constexpr float Y2_S = 64.0f;
struct EpiDown {
    static constexpr bool PERM = true;
    unsigned char* O; const int* rowlist; const float* gatew; float oscale;
    __device__ __forceinline__ void operator()(const f32x4 (&acc)[2][2][4][2], const Unit& u, int wr, int wc, int fr, int fq) const {
        u32x2 rg[8];
#pragma unroll
        for (int i = 0; i < 8; ++i) { const int idx = u.t * BM + (i >> 2) * HALF + wr * 64 + (i & 3) * 16 + fr; rg[i] = (idx < u.cnt) ? *(const u32x2*)(rowlist + 2 * ((size_t)u.e * ECAP + idx)) : (u32x2){0u, 0u}; }
#pragma unroll
        for (int ai = 0; ai < 2; ++ai)
#pragma unroll
            for (int m = 0; m < 4; ++m) { const int idx = u.t * BM + ai * HALF + wr * 64 + m * 16 + fr;
                if (idx < u.cnt) { const int a = (int)rg[ai * 4 + m].x; const float gw = __uint_as_float(rg[ai * 4 + m].y) * oscale * Y2_S;
                    unsigned char* p = O + (size_t)a * DM + u.pn * BM + wc * 32 + 8 * fq;
#pragma unroll
                    for (int bj = 0; bj < 2; ++bj) { const f32x4 v0 = acc[ai][bj][m][0] * gw, v1 = acc[ai][bj][m][1] * gw;
                        u32x2 w; w.x = pk4_fp8(v0[0], v0[1], v0[2], v0[3]); w.y = pk4_fp8(v1[0], v1[1], v1[2], v1[3]);
                        *(u32x2*)(p + bj * HALF) = w; } } }
    }
};
constexpr float RG_SLA = 4096.0f, RG_SB = 64.0f;
__device__ __forceinline__ float rg_vsp(float lamv) { const float x = __expf(-lamv);
    return 8.0f * (x < 0.05f ? x * (1.0f - x * (0.5f - x * (0.33333334f - 0.25f * x))) : __logf(1.0f + x)); }
struct EpiRG {
    static constexpr bool PERM = true;
    bf16_t* LA; bf16_t* BB; const bf16_t* XC; const float* ba; const float* bx; const float* lam;
    const LAS float* ctab = nullptr;
    __device__ __forceinline__ void operator()(const f32x4 (&acc)[2][2][4][2], const Unit& u, int wr, int wc, int fr, int fq) const {
        const int nb = u.pn >> 2, q = u.pn & 3, dir = q >> 1, half = q & 1;
        const int ch0 = nb * 256 + half * HALF + wc * 32 + 8 * fq;
        float cba[8], cbx[8], cla[8], cex[8];
        if (ctab) {
            const int c0 = wc * 32 + 8 * fq;
#pragma unroll
            for (int j = 0; j < 8; ++j) { cba[j] = ctab[c0 + j]; cbx[j] = ctab[128 + c0 + j]; cla[j] = ctab[256 + c0 + j]; cex[j] = ctab[384 + c0 + j]; } }
        else {
#pragma unroll
        for (int j = 0; j < 8; ++j) { const float vs = rg_vsp(lam[dir * DM + ch0 + j]); cba[j] = -1.4426950408889634f * ba[dir * DM + ch0 + j]; cbx[j] = -1.4426950408889634f * bx[dir * DM + ch0 + j];
            cla[j] = -RG_SLA * vs; cex[j] = -2.8853900817779268f * vs; } }
        u32x4 xws[8];
#pragma unroll
        for (int i = 0; i < 8; ++i) xws[i] = *(const u32x4*)(XC + (size_t)(u.pm * BM + (i >> 2) * HALF + wr * 64 + (i & 3) * 16 + fr) * DM + ch0);
#pragma unroll
        for (int ai = 0; ai < 2; ++ai)
#pragma unroll
            for (int m = 0; m < 4; ++m) { const size_t tok = (size_t)(u.pm * BM + ai * HALF + wr * 64 + m * 16 + fr);
                const u32x4 xw = xws[ai * 4 + m];
                float xf[8] = {bflo(xw.x), bfhi(xw.x), bflo(xw.y), bfhi(xw.y), bflo(xw.z), bfhi(xw.z), bflo(xw.w), bfhi(xw.w)};
                float la[8], bb[8];
#pragma unroll
                for (int n = 0; n < 2; ++n)
#pragma unroll
                    for (int j = 0; j < 4; ++j) { const int k = n * 4 + j;
                        const float r = __builtin_amdgcn_rcpf(1.0f + __builtin_amdgcn_exp2f(fmaf(acc[ai][0][m][n][j], -1.4426950408889634f, cba[k])));
                        const float ig = __builtin_amdgcn_rcpf(1.0f + __builtin_amdgcn_exp2f(fmaf(acc[ai][1][m][n][j], -1.4426950408889634f, cbx[k])));
                        la[k] = r * cla[k];
                        const float a2 = __builtin_amdgcn_exp2f(r * cex[k]);
                        bb[k] = __builtin_amdgcn_sqrtf(fabsf(fmaf(a2, -RG_SB * RG_SB, RG_SB * RG_SB))) * (ig * xf[k]); }
                u32x2 w; w.x = pk4_fp8(la[0], la[1], la[2], la[3]); w.y = pk4_fp8(la[4], la[5], la[6], la[7]);
                *(u32x2*)((unsigned char*)LA + ((size_t)dir * NTOK + tok) * DM + ch0) = w;
                w.x = pk4_fp8(bb[0], bb[1], bb[2], bb[3]); w.y = pk4_fp8(bb[4], bb[5], bb[6], bb[7]);
                *(u32x2*)((unsigned char*)BB + ((size_t)dir * NTOK + tok) * DM + ch0) = w; }
    }
};

struct RGOrder {
    static constexpr bool GATHER_A = false;
    int G, c;
    __device__ __forceinline__ bool next(int i, Unit& u) const {
        if (G == 256) { if (i >= 8) return false; const int x = c & 7, y = c >> 3; u.pm = i * 8 + (y >> 2); u.pn = x * 4 + (y & 3); }
        else { const int L = i * G + c; if (L >= 64 * 32) return false; u.pm = L >> 5; u.pn = L & 31; }
        u.e = 0; u.t = 0; u.cnt = 0; return true; }
    __device__ __forceinline__ int rowA(const Unit& u, int r) const { return u.pm * BM + r; }
    __device__ __forceinline__ int colA(const Unit& u) const { return (u.pn >> 2) * 256; }
    __device__ __forceinline__ int rowB(const Unit& u, int r) const { return u.pn * BM + r; }
};
template <int NPN, bool GATHER>
struct MoeOrder {
    static constexpr bool GATHER_A = GATHER;
    int G, c; const LAS int* tab; const int* rowlist;
    __device__ __forceinline__ bool next(int i, Unit& u) const {
        const int L = i * G + c, ntile = tab[32]; if (L >= ntile * NPN) return false;
        const int tile = L / NPN; u.pm = tile; u.pn = L % NPN; const int e = tab[128 + tile];
        u.e = e; u.t = tile - tab[e]; u.cnt = tab[64 + e]; return true;
    }
    __device__ __forceinline__ int rowA(const Unit& u, int r) const {
        if (GATHER) { int idx = u.t * BM + r; idx = idx < u.cnt ? idx : u.cnt - 1;
            return rowlist[2 * ((size_t)u.e * ECAP + idx)] >> 1; }
        return u.pm * BM + r;
    }
    __device__ __forceinline__ int colA(const Unit&) const { return 0; }
    __device__ __forceinline__ int rowB(const Unit& u, int r) const { return (u.e * NPN + u.pn) * BM + r; }
};
}
namespace att {
constexpr int NW = 8, QBLK = 32, KVBLK = 64, LDQ = 1024, LDK = 1024, LDV = 1024, LDO = 1024;
constexpr int SHM_V = KVBLK * 128 * 2, SHM_K = KVBLK * 64 * 2, NSLOT = 4, LDS_K = 0, LDS_V = NSLOT * SHM_K, LDS_WS = NSLOT * (SHM_K + SHM_V), SHM_ATTN = LDS_WS + NW * 64 * 4;
__device__ __forceinline__ void glds16s(const void* sbase, unsigned voff, unsigned lds_dst) { unsigned keep;
    asm volatile("s_mov_b32 %0, m0\n\ts_mov_b32 m0, %3\n\ts_nop 0\n\tglobal_load_lds_dwordx4 %1, %2\n\ts_mov_b32 m0, %0" : "=&s"(keep) : "v"(voff), "s"(sbase), "s"(lds_dst) : "memory"); }
#define WAITBAR(N) asm volatile("s_waitcnt vmcnt(" #N ") lgkmcnt(0)\n\ts_barrier" ::: "memory")
constexpr float THR2 = 8.0f * 1.4426950408889634f;
#define KSWZ64(row, colB) ((row) * 128 + ((colB) ^ ((((row) >> 1) & 7) << 4)))
#define SBAR() __builtin_amdgcn_sched_barrier(0)
__device__ __forceinline__ int crow(int r, int hi) { return (r & 3) + 8 * (r >> 2) + 4 * hi; }
__device__ __forceinline__ void qkt(f32x16& p0, f32x16& p1, const char* Ks, const bf16x8* qr, int r32, int hi, float A, float st) {
#pragma unroll
    for (int r = 0; r < 16; ++r) { const float off = (float)((r & 3) + 8 * (r >> 2));
        float a = fmaf(st, off, A), b = fmaf(st, off + 32.0f, A); asm("" : "+v"(a)); asm("" : "+v"(b)); p0[r] = a; p1[r] = b; }
#pragma unroll
    for (int d0 = 0; d0 < 4; ++d0) { const int cb = (d0 * 16 + hi * 8) * 2;
        const bf16x8 b0 = *reinterpret_cast<const bf16x8*>(Ks + KSWZ64(r32, cb));
        const bf16x8 b1 = *reinterpret_cast<const bf16x8*>(Ks + KSWZ64(32 + r32, cb));
        p0 = __builtin_amdgcn_mfma_f32_32x32x16_bf16(b0, qr[d0], p0, 0, 0, 0);
        p1 = __builtin_amdgcn_mfma_f32_32x32x16_bf16(b1, qr[d0], p1, 0, 0, 0); }
}
__device__ __forceinline__ void partialSM(f32x16& p0, f32x16& p1, bool mixed, float fd, float sl2) {
    if (mixed) {
#pragma unroll
        for (int r = 0; r < 16; ++r) { const float d0 = fd - (float)((r & 3) + 8 * (r >> 2)); p0[r] = fmaf(fabsf(d0), -sl2, p0[r]); p1[r] = fmaf(fabsf(d0 - 32.0f), -sl2, p1[r]); }
    }
#pragma unroll
    for (int r = 0; r < 16; ++r) p0[r] = __builtin_amdgcn_exp2f(p0[r]);
}
__device__ __forceinline__ void finishSM(f32x16& p0, f32x16& p1, float& l_reg, bf16x8& pa0, bf16x8& pa1, bf16x8& pa2, bf16x8& pa3) {
#pragma unroll
    for (int r = 0; r < 16; ++r) p1[r] = __builtin_amdgcn_exp2f(p1[r]);
    float ps = 0;
#pragma unroll
    for (int r = 0; r < 16; ++r) ps += p0[r];
#pragma unroll
    for (int r = 0; r < 16; ++r) ps += p1[r];
    l_reg += ps;
#define PK4(P, BASE, OUT) do { unsigned a0 = cvt_pk_bf16(P[BASE + 0], P[BASE + 1]), a1 = cvt_pk_bf16(P[BASE + 2], P[BASE + 3]);   \
    unsigned b0 = cvt_pk_bf16(P[BASE + 4], P[BASE + 5]), b1 = cvt_pk_bf16(P[BASE + 6], P[BASE + 7]);                              \
    auto r0 = __builtin_amdgcn_permlane32_swap(a0, b0, false, false); auto r1 = __builtin_amdgcn_permlane32_swap(a1, b1, false, false); \
    u32x4 w = {r0[0], r1[0], r0[1], r1[1]}; OUT = __builtin_bit_cast(bf16x8, w); } while (0)
    PK4(p0, 0, pa0); PK4(p0, 8, pa1); PK4(p1, 0, pa2); PK4(p1, 8, pa3);
#undef PK4
}
__device__ __forceinline__ int v_st(int k, int c) { const int kk = (k & ~0xC) | ((k & 4) << 1) | ((k & 8) >> 1); return ((kk >> 3) * 4 + (c >> 5)) * 512 + ((kk & 7) * 32 + (c & 31)) * 2; }
__device__ __forceinline__ int v_rd_base(int lane) { return ((lane & 3) << 3) | (((lane >> 2) & 3) << 6) | (((lane >> 4) & 1) << 5) | (((lane >> 5) & 1) << 8); }
constexpr int v_rd_off(int d0, int ks, int half) { return d0 * 512 + ks * 4096 + half * 2048; }
template <int OFF> __device__ __forceinline__ s16x4 tr_read(int vb) {
    s16x4 r; asm volatile("ds_read_b64_tr_b16 %0, %1 offset:%2" : "=&v"(r) : "v"(vb), "i"(OFF) : "memory"); return r;
}
template <int D0> __device__ __forceinline__ void pv_one(f32x16& od, int vb, bf16x8 pa0, bf16x8 pa1, bf16x8 pa2, bf16x8 pa3) {
    const s16x4 l0 = tr_read<v_rd_off(D0, 0, 0)>(vb), h0 = tr_read<v_rd_off(D0, 0, 1)>(vb), l1 = tr_read<v_rd_off(D0, 1, 0)>(vb), h1 = tr_read<v_rd_off(D0, 1, 1)>(vb);
    const s16x4 l2 = tr_read<v_rd_off(D0, 2, 0)>(vb), h2 = tr_read<v_rd_off(D0, 2, 1)>(vb), l3 = tr_read<v_rd_off(D0, 3, 0)>(vb), h3 = tr_read<v_rd_off(D0, 3, 1)>(vb);
    asm volatile("s_waitcnt lgkmcnt(0)" ::: "memory"); SBAR();
#define PK(L, H) (bf16x8){L[0], L[1], L[2], L[3], H[0], H[1], H[2], H[3]}
    od = __builtin_amdgcn_mfma_f32_32x32x16_bf16(pa0, PK(l0, h0), od, 0, 0, 0);
    od = __builtin_amdgcn_mfma_f32_32x32x16_bf16(pa1, PK(l1, h1), od, 0, 0, 0);
    od = __builtin_amdgcn_mfma_f32_32x32x16_bf16(pa2, PK(l2, h2), od, 0, 0, 0);
    od = __builtin_amdgcn_mfma_f32_32x32x16_bf16(pa3, PK(l3, h3), od, 0, 0, 0);
#undef PK
}
__device__ __forceinline__ void pv_d0(f32x16* o, int vb, bf16x8 pa0, bf16x8 pa1, bf16x8 pa2, bf16x8 pa3) {
    pv_one<0>(o[0], vb, pa0, pa1, pa2, pa3); pv_one<1>(o[1], vb, pa0, pa1, pa2, pa3); pv_one<2>(o[2], vb, pa0, pa1, pa2, pa3); pv_one<3>(o[3], vb, pa0, pa1, pa2, pa3);
}
__device__ __forceinline__ void attn_unit(const bf16_t* __restrict__ Qb, const bf16_t* __restrict__ Kh, const bf16_t* __restrict__ Vh, bf16_t* __restrict__ Ob, int q0, int t_lo, int n, float sl2, char* lds) {
    const int tid = opaque_tid(), wid = __builtin_amdgcn_readfirstlane(tid >> 6), lane = tid & 63, r32 = lane & 31, hi = lane >> 5;
    float* ws = (float*)(lds + LDS_WS) + wid * 64; float* li_l = ws;
    float l_reg = 0; f32x16 o[4] = {}; bf16x8 qr[4];
    const bf16_t* Qw = Qb + (long)(wid * QBLK + r32) * LDQ + hi * 8;
#pragma unroll
    for (int d0 = 0; d0 < 4; ++d0) qr[d0] = *reinterpret_cast<const bf16x8*>(Qw + d0 * 16);
    float negM;
    { const bf16_t* Kw = Kh + (long)(q0 + wid * QBLK + r32) * LDK + hi * 8; float s = 0.f;
#pragma unroll
      for (int d0 = 0; d0 < 4; ++d0) { const u32x4 kw = *reinterpret_cast<const u32x4*>(Kw + d0 * 16); const u32x4 qw = __builtin_bit_cast(u32x4, qr[d0]);
          s += bflo(kw.x) * bflo(qw.x) + bfhi(kw.x) * bfhi(qw.x) + bflo(kw.y) * bflo(qw.y) + bfhi(kw.y) * bfhi(qw.y) + bflo(kw.z) * bflo(qw.z) + bfhi(kw.z) * bfhi(qw.z) + bflo(kw.w) * bflo(qw.w) + bfhi(kw.w) * bfhi(qw.w); }
      auto rr = __builtin_amdgcn_permlane32_swap(__float_as_uint(s), __float_as_uint(s), false, false); negM = -(__uint_as_float(rr[0]) + __uint_as_float(rr[1])); }
    const unsigned lds0 = (unsigned)(uintptr_t)lds;
    const int krow = wid * 8 + (lane >> 3), kch = (lane & 7) ^ ((krow >> 1) & 7);
    const unsigned koff = (unsigned)(krow * LDK * 2 + kch * 16);
    unsigned voff[2];
#pragma unroll
    for (int z = 0; z < 2; ++z) { const int P16 = (wid + 8 * z) * 64 + lane, sub = P16 >> 5, win = P16 & 31, kk = (sub >> 2) * 8 + (win >> 2), k = (kk & ~0xC) | ((kk & 4) << 1) | ((kk & 8) >> 1), c = (sub & 3) * 32 + (win & 3) * 8;
        voff[z] = (unsigned)(k * LDV * 2 + c * 2); }
    const unsigned kdst = lds0 + LDS_K + wid * 1024, vdst = lds0 + LDS_V + wid * 1024;
    const int vb0 = (int)(lds0 + LDS_V) + v_rd_base(lane);
    const char* K_lds = lds + LDS_K;
    const int qw0 = q0 + wid * QBLK;
    const float fq0 = (float)(qw0 + r32 - 4 * hi);
    const char* Kt = (const char*)(Kh + (long)t_lo * KVBLK * LDK); const char* Vt = (const char*)(Vh + (long)t_lo * KVBLK * LDV);
#define DMA(jj, slot) do { const char* kb_ = Kt + (size_t)(jj) * (KVBLK * LDK * 2); const char* vb_ = Vt + (size_t)(jj) * (KVBLK * LDV * 2); \
    glds16s(kb_, koff, (unsigned)__builtin_amdgcn_readfirstlane(kdst + (slot) * SHM_K)); \
    glds16s(vb_, voff[0], (unsigned)__builtin_amdgcn_readfirstlane(vdst + (slot) * SHM_V)); \
    glds16s(vb_, voff[1], (unsigned)__builtin_amdgcn_readfirstlane(vdst + (slot) * SHM_V + 8192)); } while (0)
#define TILE(jj) const int k0_ = (t_lo + (jj)) * KVBLK; const bool left_ = k0_ + 63 < qw0, right_ = k0_ > qw0 + 31, mixed_ = !(left_ || right_); \
    const float fd_ = fq0 - (float)k0_, st_ = left_ ? sl2 : (right_ ? -sl2 : 0.f), A_ = negM - st_ * fd_
    f32x16 pA0, pA1, pB0, pB1; bf16x8 pa0, pa1, pa2, pa3;
    asm volatile("s_waitcnt vmcnt(0)" ::: "memory");
#define SEG_A(PN0, PN1, PO0, PO1, jt, FIN) do { TILE(jt); SBAR(); qkt(PN0, PN1, K_lds + ((jt) & 3) * SHM_K, qr, r32, hi, A_, st_); if (FIN) finishSM(PO0, PO1, l_reg, pa0, pa1, pa2, pa3); SBAR(); } while (0)
#define SEG_B(P0, P1, jt, PV) do { if (PV) pv_d0(o, vb0 + (((jt) - 1) & 3) * SHM_V, pa0, pa1, pa2, pa3); { TILE(jt); partialSM(P0, P1, mixed_, fd_, sl2); } } while (0)
#define STEP_BAR(jt) do { WAITBAR(0); if ((jt) + 2 < n) DMA((jt) + 2, ((jt) + 2) & 3); } while (0)
    const bool lead = wid < 4;
    DMA(0, 0); DMA(1, 1);
    WAITBAR(3);
    SEG_A(pA0, pA1, pB0, pB1, 0, false); if (!lead) STEP_BAR(0); SEG_B(pA0, pA1, 0, false); if (lead) STEP_BAR(0);
    for (int j = 1; j + 1 < n; j += 2) {
        SEG_A(pB0, pB1, pA0, pA1, j, true); if (!lead) STEP_BAR(j); SEG_B(pB0, pB1, j, true); if (lead) STEP_BAR(j);
        SEG_A(pA0, pA1, pB0, pB1, j + 1, true); if (!lead) STEP_BAR(j + 1); SEG_B(pA0, pA1, j + 1, true); if (lead) STEP_BAR(j + 1);
    }
    SEG_A(pB0, pB1, pA0, pA1, n - 1, true); if (!lead) STEP_BAR(n - 1); SEG_B(pB0, pB1, n - 1, true); if (lead) STEP_BAR(n - 1);
    finishSM(pB0, pB1, l_reg, pa0, pa1, pa2, pa3); SBAR();
    pv_d0(o, vb0 + ((n - 1) & 3) * SHM_V, pa0, pa1, pa2, pa3);
    { auto rr = __builtin_amdgcn_permlane32_swap(__float_as_uint(l_reg), __float_as_uint(l_reg), false, false); l_reg = __uint_as_float(rr[0]) + __uint_as_float(rr[1]); }
    if (hi == 0) li_l[r32] = l_reg; asm volatile("s_waitcnt lgkmcnt(0)" ::: "memory");
    float rli[16];
#pragma unroll
    for (int r = 0; r < 16; ++r) rli[r] = __builtin_amdgcn_rcpf(li_l[crow(r, hi)]);
    bf16_t* Ow = Ob + (long)(wid * QBLK) * LDO;
#pragma unroll
    for (int r = 0; r < 16; ++r) { const int orow = crow(r, hi);
#pragma unroll
        for (int d0 = 0; d0 < 4; ++d0) Ow[(long)orow * LDO + d0 * 32 + r32] = (bf16_t)f2bf(o[d0][r] * rli[r]); }
    asm volatile("s_waitcnt lgkmcnt(0)\n\ts_barrier" ::: "memory");
#undef DMA
#undef SEG_A
#undef SEG_B
#undef STEP_BAR
#undef TILE
}
#undef SBAR
}

namespace hy {
typedef f32x2 cf;
__device__ __forceinline__ cf lld(const LAS f32x2* L, int i) { return L[i]; }
__device__ __forceinline__ void lst(LAS f32x2* L, int i, cf v) { L[i] = v; }
__device__ __forceinline__ cf cmul(cf a, cf b) { return a * b.xx + a.yx * (b.yy * (cf){-1.f, 1.f}); }
__device__ __forceinline__ cf cmulc(cf a, cf b) { return a * b.xx + a.yx * (b.yy * (cf){1.f, -1.f}); }
__device__ constexpr float C32[16] = {1.0f, 0.98078528040323043f, 0.92387953251128674f, 0.83146961230254524f, 0.70710678118654757f, 0.55557023301960229f, 0.38268343236508984f, 0.19509032201612833f,
                                      0.0f, -0.19509032201612819f, -0.38268343236508973f, -0.55557023301960196f, -0.70710678118654746f, -0.83146961230254535f, -0.92387953251128674f, -0.98078528040323043f};
__device__ constexpr float S32[16] = {0.0f, 0.19509032201612825f, 0.38268343236508978f, 0.55557023301960218f, 0.70710678118654746f, 0.83146961230254524f, 0.92387953251128674f, 0.98078528040323043f,
                                      1.0f, 0.98078528040323043f, 0.92387953251128674f, 0.83146961230254546f, 0.70710678118654757f, 0.55557023301960218f, 0.38268343236508989f, 0.19509032201612861f};
__host__ __device__ constexpr int brev(int k, int bits) { int r = 0; for (int i = 0; i < bits; ++i) r |= ((k >> i) & 1) << (bits - 1 - i); return r; }
template <int R, bool INV> __device__ __forceinline__ void dft_reg(cf (&v)[R]) {
#pragma unroll
    for (int s = R / 2; s >= 1; s >>= 1) {
#pragma unroll
        for (int g0 = 0; g0 < R; g0 += 2 * s) {
#pragma unroll
            for (int j = 0; j < s; ++j) {
                const cf a = v[g0 + j], b = v[g0 + j + s];
                v[g0 + j] = a + b;
                const cf d = a - b;
                const int tw = j * (16 / s);
                if (tw == 0) v[g0 + j + s] = d;
                else if (tw == 8) v[g0 + j + s] = INV ? (cf){-d.y, d.x} : (cf){d.y, -d.x};
                else { const float c = C32[tw], sn = INV ? S32[tw] : -S32[tw]; v[g0 + j + s] = d * c + d.yx * (cf){-sn, sn}; }
            }
        }
    }
}
constexpr int RS = FFT_RS;
__device__ __forceinline__ void fft_fwd12(cf (&v)[32], LAS f32x2* L, int tid) {
    dft_reg<32, false>(v);
    { float s, c; sincospif((float)tid * (1.0f / 8192.0f), &s, &c); cf w1 = {c, -s}; asm volatile("" : "+v"(w1.x), "+v"(w1.y)); cf w = w1;
#pragma unroll
      for (int k1 = 0; k1 < 32; ++k1) { cf x = v[brev(k1, 5)]; if (k1) { x = cmul(x, w); w = cmul(w, w1); } lst(L, k1 * RS + tid, x); } }
    __syncthreads();
    const int k1 = tid >> 4, m2 = tid & 15;
#pragma unroll
    for (int m1 = 0; m1 < 32; ++m1) v[m1] = lld(L, k1 * RS + 16 * m1 + m2);
    __syncthreads();
    dft_reg<32, false>(v);
    { float s, c; sincospif((float)m2 * (1.0f / 256.0f), &s, &c); cf w1 = {c, -s}; asm volatile("" : "+v"(w1.x), "+v"(w1.y)); cf w = w1;
#pragma unroll
      for (int j1 = 0; j1 < 32; ++j1) { cf x = v[brev(j1, 5)]; if (j1) { x = cmul(x, w); w = cmul(w, w1); } lst(L, k1 * RS + 33 * m2 + j1, x); } }
    __syncthreads();
}
__device__ __forceinline__ void fft_inv21(cf (&v)[32], LAS f32x2* L, int tid) {
    const int k1 = tid >> 4, m2 = tid & 15;
    { float s, c; sincospif((float)m2 * (1.0f / 256.0f), &s, &c); cf w1 = {c, -s}; asm volatile("" : "+v"(w1.x), "+v"(w1.y)); cf w = w1;
#pragma unroll
      for (int j1 = 0; j1 < 32; ++j1) { cf x = lld(L, k1 * RS + 33 * m2 + j1); if (j1) { x = cmulc(x, w); w = cmul(w, w1); } v[j1] = x; } }
    __syncthreads();
    dft_reg<32, true>(v);
#pragma unroll
    for (int m1 = 0; m1 < 32; ++m1) lst(L, k1 * RS + 16 * m1 + m2, v[brev(m1, 5)]);
    __syncthreads();
    { float s, c; sincospif((float)tid * (1.0f / 8192.0f), &s, &c); cf w1 = {c, -s}; asm volatile("" : "+v"(w1.x), "+v"(w1.y)); cf w = w1;
#pragma unroll
      for (int kk = 0; kk < 32; ++kk) { cf x = lld(L, kk * RS + tid); if (kk) { x = cmulc(x, w); w = cmul(w, w1); } v[kk] = x; } }
    dft_reg<32, true>(v);
}
}

namespace hm {
typedef f32x2 cf;
constexpr int ROWA = 40, ROWB = 24;
constexpr int PL_A = 512 * ROWA * 2, PL_B = 1024 * ROWB * 2;
__device__ __forceinline__ int crow(int r, int hi) { return (r & 3) + 8 * (r >> 2) + 4 * hi; }
struct CFrag { bf16x8 re, im, nim; };
__device__ __forceinline__ CFrag dft_frag(int n, int row, int k0, bool valid) {
    unsigned wr[4], wi[4], wn[4];
#pragma unroll
    for (int t = 0; t < 4; ++t) { float s0, c0, s1, c1; sincospif(-2.0f * (float)((row * (k0 + 2 * t)) % n) / (float)n, &s0, &c0); sincospif(-2.0f * (float)((row * (k0 + 2 * t + 1)) % n) / (float)n, &s1, &c1);
        if (!valid) { s0 = c0 = s1 = c1 = 0.f; }
        wr[t] = pk2(c0, c1); wi[t] = pk2(s0, s1); wn[t] = pk2(-s0, -s1); }
    CFrag f; f.re = __builtin_bit_cast(bf16x8, (u32x4){wr[0], wr[1], wr[2], wr[3]}); f.im = __builtin_bit_cast(bf16x8, (u32x4){wi[0], wi[1], wi[2], wi[3]}); f.nim = __builtin_bit_cast(bf16x8, (u32x4){wn[0], wn[1], wn[2], wn[3]});
    return f;
}
template <bool CONJ> __device__ __forceinline__ void cmfma(f32x16& dr, f32x16& di, const CFrag& a, bf16x8 br, bf16x8 bi) {
    dr = __builtin_amdgcn_mfma_f32_32x32x16_bf16(a.re, br, dr, 0, 0, 0); dr = __builtin_amdgcn_mfma_f32_32x32x16_bf16(CONJ ? a.im : a.nim, bi, dr, 0, 0, 0);
    di = __builtin_amdgcn_mfma_f32_32x32x16_bf16(a.re, bi, di, 0, 0, 0); di = __builtin_amdgcn_mfma_f32_32x32x16_bf16(CONJ ? a.nim : a.im, br, di, 0, 0, 0);
}
__device__ __forceinline__ cf cmul(cf a, cf b) { float m = a.y * b.y; asm("" : "+v"(m)); float re = fmaf(a.x, b.x, -m); asm("" : "+v"(re)); const float im = fmaf(a.x, b.y, a.y * b.x); return (cf){re, im}; }
__device__ __forceinline__ cf cmulc(cf a, cf b) { float m = a.y * b.y; asm("" : "+v"(m)); float re = fmaf(a.x, b.x, m); asm("" : "+v"(re)); const float im = fmaf(a.y, b.x, -(a.x * b.y)); return (cf){re, im}; }
__device__ __forceinline__ bf16x8 pk4(const float (&P)[8]) {
    const unsigned a0 = cvt_pk_bf16(P[0], P[1]), a1 = cvt_pk_bf16(P[2], P[3]), b0 = cvt_pk_bf16(P[4], P[5]), b1 = cvt_pk_bf16(P[6], P[7]);
    auto r0 = __builtin_amdgcn_permlane32_swap(a0, b0, false, false); auto r1 = __builtin_amdgcn_permlane32_swap(a1, b1, false, false);
    return __builtin_bit_cast(bf16x8, (u32x4){r0[0], r1[0], r0[1], r1[1]});
}
constexpr int LDS_FTAB = 98304, LDS_TW1 = 110592, LDS_TW2 = 143360;
struct Consts { const LAS unsigned char* T; int lane;
    __device__ __forceinline__ CFrag get(int which) const { const LAS unsigned char* p = T + (which * 64 + lane) * 48; CFrag f; f.re = *(const LAS bf16x8*)p; f.im = *(const LAS bf16x8*)(p + 16); f.nim = *(const LAS bf16x8*)(p + 32); return f; } };
__device__ __forceinline__ cf tw1(const LAS unsigned* T1, int e) { const unsigned w = T1[e & 8191]; const float2 t = __half22float2(__builtin_bit_cast(__half2, w)); const unsigned sb = ((unsigned)e & 8192u) << 18; return (cf){__uint_as_float(__float_as_uint(t.x) ^ sb), __uint_as_float(__float_as_uint(t.y) ^ sb)}; }
__device__ __forceinline__ void build_tw(LAS unsigned char* lds, int tid) {
    LAS unsigned* T1 = (LAS unsigned*)(lds + LDS_TW1); LAS f32x2* T2 = (LAS f32x2*)(lds + LDS_TW2);
#pragma unroll 4
    for (int i = 0; i < 16; ++i) { const int e = tid + 512 * i; float sn, cs; sincospif(-2.0f * (float)e * (1.0f / 16384.0f), &sn, &cs); T1[e] = __builtin_bit_cast(unsigned, __floats2half2_rn(cs, sn)); }
    { const int j1 = tid >> 4, m2 = tid & 15; float sn, cs; sincospif(-2.0f * (float)((j1 * m2) & 511) * (1.0f / 512.0f), &sn, &cs); T2[tid] = (f32x2){cs, sn}; }
}
__device__ __forceinline__ void build_ftab(LAS unsigned char* T, int tid) {
    if (tid < 64) { const int j = tid & 31, hi = tid >> 5;
        const CFrag f0 = dft_frag(32, j, 8 * hi, true), f1 = dft_frag(32, j, 16 + 8 * hi, true), g = dft_frag(16, j & 15, 8 * hi, j < 16);
        LAS bf16x8* p = (LAS bf16x8*)(T + tid * 48); p[0] = f0.re; p[1] = f0.im; p[2] = f0.nim;
        p = (LAS bf16x8*)(T + (64 + tid) * 48); p[0] = f1.re; p[1] = f1.im; p[2] = f1.nim;
        p = (LAS bf16x8*)(T + (128 + tid) * 48); p[0] = g.re; p[1] = g.im; p[2] = g.nim; }
    __syncthreads();
}
__device__ __forceinline__ void st2(LAS unsigned char* L, int plane_bytes, int idx, cf v) { const unsigned w = cvt_pk_bf16(v.x, v.y); ((LAS bf16_t*)L)[idx] = (bf16_t)(w & 0xffffu); ((LAS bf16_t*)(L + plane_bytes))[idx] = (bf16_t)(w >> 16); }
template <int NK> __device__ __forceinline__ void fwd12(const Consts& C, const bf16x8 (&Bre)[2][NK], const bf16x8 (&Bim)[2][NK], LAS unsigned char* L, const LAS unsigned* TW1, const LAS f32x2* TW2, int wave, int j, int hi) {
    asm volatile("" : "+v"(j), "+v"(hi));
#pragma unroll
    for (int tl = 0; tl < 2; ++tl) { const int n2 = 64 * wave + 32 * tl + j; f32x16 dr = {}, di = {};
        cmfma<false>(dr, di, C.get(0), Bre[tl][0], Bim[tl][0]); if constexpr (NK == 2) cmfma<false>(dr, di, C.get(1), Bre[tl][1], Bim[tl][1]);
#pragma unroll
        for (int r = 0; r < 16; ++r) { const int k1 = crow(r, hi); st2(L, PL_A, (k1 * 16 + (n2 & 15)) * ROWA + (n2 >> 4), cmul((cf){dr[r], di[r]}, tw1(TW1, k1 * n2))); } }
    __syncthreads();
    asm volatile("" : "+v"(j), "+v"(hi));
    bf16x8 yre[2][2], yim[2][2];
#pragma unroll
    for (int tl = 0; tl < 2; ++tl) { const int col = (4 * wave + 2 * tl + (j >> 4)) * 16 + (j & 15);
#pragma unroll
        for (int ks = 0; ks < 2; ++ks) { yre[tl][ks] = *(const LAS bf16x8*)(L + (col * ROWA + 16 * ks + 8 * hi) * 2); yim[tl][ks] = *(const LAS bf16x8*)(L + PL_A + (col * ROWA + 16 * ks + 8 * hi) * 2); } }
    __syncthreads();
    asm volatile("" : "+v"(j), "+v"(hi));
#pragma unroll
    for (int tl = 0; tl < 2; ++tl) { const int k1 = 4 * wave + 2 * tl + (j >> 4), m2 = j & 15; f32x16 dr = {}, di = {};
        cmfma<false>(dr, di, C.get(0), yre[tl][0], yim[tl][0]); cmfma<false>(dr, di, C.get(1), yre[tl][1], yim[tl][1]);
#pragma unroll
        for (int r = 0; r < 16; ++r) { const int j1 = crow(r, hi); st2(L, PL_B, (k1 * 32 + j1) * ROWB + m2, cmul((cf){dr[r], di[r]}, TW2[j1 * 16 + m2])); } }
    __syncthreads();
}
__device__ __forceinline__ void inv21(const Consts& C, cf (&y)[2][8], LAS unsigned char* L, const LAS unsigned* TW1, int wave, int j, int hi) {
    asm volatile("" : "+v"(j), "+v"(hi));
    bf16x8 yre[2][2], yim[2][2];
#pragma unroll
    for (int tl = 0; tl < 2; ++tl) { const int col = (4 * wave + 2 * tl + (j >> 4)) * 16 + (j & 15);
#pragma unroll
        for (int ks = 0; ks < 2; ++ks) { yre[tl][ks] = *(const LAS bf16x8*)(L + (col * ROWA + 16 * ks + 8 * hi) * 2); yim[tl][ks] = *(const LAS bf16x8*)(L + PL_A + (col * ROWA + 16 * ks + 8 * hi) * 2); } }
    __syncthreads();
    asm volatile("" : "+v"(j), "+v"(hi));
#pragma unroll
    for (int tl = 0; tl < 2; ++tl) { const int k1 = 4 * wave + 2 * tl + (j >> 4), m2 = j & 15; f32x16 dr = {}, di = {};
        cmfma<true>(dr, di, C.get(0), yre[tl][0], yim[tl][0]); cmfma<true>(dr, di, C.get(1), yre[tl][1], yim[tl][1]);
#pragma unroll
        for (int r = 0; r < 16; ++r) { const int n2 = 16 * crow(r, hi) + m2; st2(L, PL_A, n2 * ROWA + k1, cmulc((cf){dr[r], di[r]}, tw1(TW1, k1 * n2))); } }
    __syncthreads();
    asm volatile("" : "+v"(j), "+v"(hi));
#pragma unroll
    for (int tl = 0; tl < 2; ++tl) { const int n2 = 64 * wave + 32 * tl + j; f32x16 dr = {}, di = {};
#pragma unroll
        for (int ks = 0; ks < 2; ++ks) { const bf16x8 br = *(const LAS bf16x8*)(L + (n2 * ROWA + 16 * ks + 8 * hi) * 2), bi = *(const LAS bf16x8*)(L + PL_A + (n2 * ROWA + 16 * ks + 8 * hi) * 2);
            cmfma<true>(dr, di, C.get(ks), br, bi); }
#pragma unroll
        for (int r = 0; r < 8; ++r) y[tl][r] = (cf){dr[r], di[r]}; }
    __syncthreads();
}
}
constexpr size_t MiB = 1u << 20;
constexpr size_t WS_CTL = 0, CTL_ZERO_BYTES = 128 * 1024;
constexpr size_t WS_W1T = 1 * MiB;
constexpr size_t WS_W2T = 257 * MiB;
constexpr size_t WS_WIN_EV = 385 * MiB, WS_WOUT_EV = 409 * MiB, WS_WIN_OD = 417 * MiB, WS_WOUT_OD = 433 * MiB, WS_WG_OD = 441 * MiB;
constexpr size_t AR = 445 * MiB;
constexpr size_t A_XB = AR + 0 * MiB, A_UHT = AR + 64 * MiB, A_QB = AR + 160 * MiB, A_KB = AR + 192 * MiB, A_VB = AR + 224 * MiB, A_KTD = AR + 256 * MiB, A_KF = AR + 384 * MiB,
                 A_H3B = AR + 512 * MiB, A_W4T = AR + 514 * MiB, A_YHT = AR + 416 * MiB, A_OA = AR + 448 * MiB, A_YCAT = AR + 512 * MiB, A_XB2 = AR + 0 * MiB, A_R0 = AR + 64 * MiB, A_H1_0 = AR + 192 * MiB,
                 A_HB_0 = AR + 320 * MiB, A_HID_0 = AR + 384 * MiB, A_ROWL = AR + 424 * MiB, A_GATEW = AR + 428 * MiB, A_Y2_0 = AR + 0 * MiB, A_H2 = AR + 448 * MiB, A_HB2 = AR + 448 * MiB;
constexpr size_t A_GB = AR + 0 * MiB, A_XR = AR + 64 * MiB, A_XC = AR + 192 * MiB, A_LA = AR + 256 * MiB, A_BB = AR + 64 * MiB, A_CAR = AR + 384 * MiB, A_YG = AR + 192 * MiB, A_R1 = AR + 256 * MiB,
                 A_H1_1 = AR + 0 * MiB, A_HB8_1 = AR + 0 * MiB, A_XB8 = AR + 320 * MiB, WS_WIN_EV8 = AR + 544 * MiB, A_HB2_8 = AR + 512 * MiB, A_HB8_0 = AR + 192 * MiB, A_HB_1 = AR + 128 * MiB, A_HID_1 = AR + 192 * MiB, A_Y2_1 = AR + 256 * MiB;
constexpr size_t WS_END = AR + 576 * MiB;
constexpr size_t WS_TW1 = WS_CTL + 512 * 1024, WS_TW2 = WS_TW1 + 128 * 1024;
constexpr int CW_BAR = 4096, CW_CNT = 16384, CW_NORM = 24576;
constexpr int LDS_MISC = 153600, LDS_BYTES = 161792;
constexpr int NPHASE = 21;
#ifndef FP8_P1
#define FP8_P1 1
#endif
#ifndef FP8_P1B
#define FP8_P1B 1
#endif
#ifndef FP8_P1C
#define FP8_P1C 0
#endif
#ifndef FP8_P16
#define FP8_P16 1
#endif
#ifndef FP8_P5
#define FP8_P5 1
#endif
#ifndef FP8_P10
#define FP8_P10 1
#endif
#ifndef MOE_FP8_LAYERS
#define MOE_FP8_LAYERS 2
#endif

struct Args { const float* in[37]; float* out; unsigned char* ws; int ph_lo, ph_hi; };
typedef const __attribute__((address_space(4))) Args& KArgs;

template <bool F8> __device__ __forceinline__ void transpose_item(const float* W, int N, int k0, int n0, void* WTv, int ldk, int drow0, float scale, LAS float* scr, int lane) {
#pragma unroll 4
    for (int kk = 0; kk < 64; ++kk) scr[kk * 65 + lane] = W[(size_t)(k0 + kk) * N + n0 + lane];
    LDS_WAIT(); asm volatile("" ::: "memory");
    const int c = lane & 7;
#pragma unroll
    for (int jj = 0; jj < 8; ++jj) { const int n = (lane >> 3) + 8 * jj; const LAS float* s = scr + (8 * c) * 65 + n;
        if constexpr (F8) { u32x2 o; o.x = pg8::pk4_fp8(s[0 * 65] * scale, s[1 * 65] * scale, s[2 * 65] * scale, s[3 * 65] * scale); o.y = pg8::pk4_fp8(s[4 * 65] * scale, s[5 * 65] * scale, s[6 * 65] * scale, s[7 * 65] * scale);
            *(u32x2*)((unsigned char*)WTv + (size_t)(drow0 + n) * ldk + k0 + 8 * c) = o; }
        else { u32x4 o; o.x = pk2(s[0 * 65], s[1 * 65]); o.y = pk2(s[2 * 65], s[3 * 65]); o.z = pk2(s[4 * 65], s[5 * 65]); o.w = pk2(s[6 * 65], s[7 * 65]);
            *(u32x4*)((bf16_t*)WTv + (size_t)(drow0 + n) * ldk + k0 + 8 * c) = o; } }
    LDS_WAIT(); asm volatile("" ::: "memory");
}
struct TbItem { const float* W; unsigned char* dst; int N, k0, n0, ldkB, gu, upoff; };
constexpr int TB_RS = 260, TB_BYTES = 32 * TB_RS * 4;
template <bool F8> __device__ __forceinline__ void tb_load(f32x4 (&v)[4][F8 ? 4 : 2], const TbItem& it, int wave, int lane) {
    constexpr int RPD = F8 ? 4 : 2;
    const float* p = it.W + (size_t)(it.k0 + RPD * wave) * it.N + it.n0 + 4 * lane;
#pragma unroll
    for (int j = 0; j < 4; ++j)
#pragma unroll
        for (int i = 0; i < RPD; ++i) { if constexpr (F8) v[j][i] = __builtin_nontemporal_load((const f32x4*)(p + (size_t)(8 * RPD * j + i) * it.N)); else v[j][i] = *(const f32x4*)(p + (size_t)(8 * RPD * j + i) * it.N); }
}
template <bool F8> __device__ __forceinline__ void tb_write(const f32x4 (&v)[4][F8 ? 4 : 2], LAS unsigned char* T, int wave, int lane) {
#pragma unroll
    for (int j = 0; j < 4; ++j) { u32x4 d;
#pragma unroll
        for (int q = 0; q < 4; ++q) {
            if constexpr (F8) d[q] = pg8::pk4_fp8(v[j][0][q] * pg8::FP8_SW, v[j][1][q] * pg8::FP8_SW, v[j][2][q] * pg8::FP8_SW, v[j][3][q] * pg8::FP8_SW);
            else d[q] = pk2(v[j][0][q], v[j][1][q]); }
        *(LAS u32x4*)(T + ((8 * j + wave) * TB_RS + 4 * lane) * 4) = d; }
}
template <bool F8> __device__ __forceinline__ void tb_store(const LAS unsigned char* T, const TbItem& it, int wave, int lane) {
    const int q = (lane & 3) + 4 * (lane >> 5), nl = (lane >> 2) & 7;
    const LAS unsigned* Tw = (const LAS unsigned*)T;
#pragma unroll
    for (int p = 0; p < 4; ++p) { const int nloc = 8 * (wave + 8 * p) + nl, n = it.n0 + nloc; u32x4 r;
#pragma unroll
        for (int i = 0; i < 4; ++i) r[i] = Tw[(4 * q + i) * TB_RS + nloc];
        const int drow = n + ((n >> 7) << 7) * it.gu + it.upoff;
        u32x4* dp = (u32x4*)(it.dst + (size_t)drow * it.ldkB + it.k0 * (F8 ? 1 : 2) + 16 * q); if constexpr (F8) __builtin_nontemporal_store(r, dp); else *dp = r; }
}
static_assert(FP8_P5 && FP8_P10 && FP8_P16 && MOE_FP8_LAYERS == 2 && FP8_P1 == FP8_P1B && !FP8_P1C, "the prologue's block items assume this operand plan");
constexpr int TB_N8 = 4096 + 2048 + 128 + 256 + 128, TB_N16 = 32 * (FP8_P1B ? 12 : 24), TB_NQ8 = FP8_P1B ? 16 * 12 : 0;
__device__ __forceinline__ TbItem tb_item8(KArgs a, int bi) {
    TbItem t; unsigned char* ws = a.ws; t.gu = 0; t.upoff = 0;
    if (bi < 4096) { const int le = bi >> 6, q = bi & 63, up = q >> 5, kb = (q & 31) >> 1, nb = q & 1;
        t.W = (up ? a.in[35] : a.in[34]) + (size_t)le * DM * DFF; t.N = DFF; t.k0 = kb * 128; t.n0 = nb * 256; t.ldkB = DM; t.gu = 1; t.upoff = up * 128;
        t.dst = ws + WS_W1T + (size_t)(le >> 5) * 32 * 1024 * DM * 2 + (size_t)(le & 31) * 1024 * DM; }
    else if (bi < 6144) { const int r = bi - 4096, le = r >> 5, q = r & 31, kb = q >> 3, nb = q & 7;
        t.W = a.in[36] + (size_t)le * DFF * DM; t.N = DM; t.k0 = kb * 128; t.n0 = nb * 256; t.ldkB = DFF; t.dst = ws + WS_W2T + (size_t)(le >> 5) * 32 * DM * DFF * 2 + (size_t)(le & 31) * DM * DFF; }
    else if (bi < 6272) { const int r = bi - 6144, kb = r >> 3, nb = r & 7; t.W = a.in[18]; t.N = DM; t.k0 = kb * 128; t.n0 = nb * 256; t.ldkB = DM; t.dst = ws + WS_WOUT_EV; }
    else if (bi < 6528) { const int r = bi - 6272, kb = r >> 4, nb = r & 15; t.W = a.in[19]; t.N = 2 * DM; t.k0 = kb * 128; t.n0 = nb * 256; t.ldkB = DM; t.dst = ws + WS_WIN_OD; }
    else { const int r = bi - 6528, kb = r >> 3, nb = r & 7; t.W = a.in[27]; t.N = DM; t.k0 = kb * 128; t.n0 = nb * 256; t.ldkB = DM; t.dst = ws + WS_WOUT_OD; }
    return t;
}
__device__ __forceinline__ TbItem tb_item16(KArgs a, int bi) {
    constexpr int NB = FP8_P1B ? 12 : 24;
    TbItem t; const int kb = bi / NB, nb = bi % NB; t.W = a.in[1]; t.N = EV_IN; t.k0 = kb * 64; t.n0 = nb * 256; t.ldkB = DM * 2; t.gu = 0; t.upoff = 0; t.dst = a.ws + WS_WIN_EV; return t;
}
__device__ __forceinline__ TbItem tb_itemq8(KArgs a, int bi) {
    TbItem t; const int kb = bi / 12, nb = bi % 12; t.W = a.in[1]; t.N = EV_IN; t.k0 = kb * 128; t.n0 = 3072 + nb * 256; t.ldkB = DM; t.gu = 0; t.upoff = 0; t.dst = a.ws + WS_WIN_EV8; return t;
}
template <bool F8, int LIST = 0> __device__ __forceinline__ void tb_run(KArgs a, LAS unsigned char* lds, int nitems, int bx, int G, int wave, int lane) {
#define TB_ITEM(i_) (F8 ? (LIST == 1 ? tb_itemq8(a, i_) : tb_item8(a, i_)) : tb_item16(a, i_))
    int bi = bx; if (bi >= nitems) return;
    TbItem cur = TB_ITEM(bi), nxt = cur; f32x4 v[4][F8 ? 4 : 2]; tb_load<F8>(v, cur, wave, lane); int buf = 0, nbi; bool more;
#define TB_STEP() do { LAS unsigned char* T = lds + buf * TB_BYTES; tb_write<F8>(v, T, wave, lane); nbi = bi + G; more = nbi < nitems; \
        if (more) { nxt = TB_ITEM(nbi); tb_load<F8>(v, nxt, wave, lane); } \
        LDS_WAIT(); __builtin_amdgcn_s_barrier(); tb_store<F8>(T, cur, wave, lane); } while (0)
    TB_STEP();
    while (more) { cur = nxt; bi = nbi; buf ^= 1; TB_STEP(); }
#undef TB_STEP
#undef TB_ITEM
    __syncthreads();
}
constexpr int CW_Q = 28672, TBQ_CH = 2, CW_AQ = 28800;
constexpr int TBQ_N0 = 2048 + 1024 + 128, TBQ_N1 = 2048 + 1024 + 384;
static_assert(TBQ_N0 % TBQ_CH == 0 && TBQ_N1 % TBQ_CH == 0 && TBQ_N0 + TBQ_N1 == TB_N8, "chunks must not straddle the end of an item list");
template <int LIST> __device__ __forceinline__ int tbq_map(int i) {
    if (LIST == 0) return i < 2048 ? i : (i < 3072 ? 4096 + (i - 2048) : 6144 + (i - 3072));
    return i < 2048 ? 2048 + i : (i < 3072 ? 5120 + (i - 2048) : 6272 + (i - 3072));
}
template <int LIST> __device__ __forceinline__ void tb_stream_q(KArgs a, LAS unsigned char* lds, int tid, int wave, int lane) {
    constexpr int NQ = LIST ? TBQ_N1 : TBQ_N0;
    unsigned* qc = (unsigned*)(a.ws + WS_CTL) + CW_Q + LIST * 64;
    LAS int* qw = (LAS int*)(lds + LDS_MISC + 2560);
    __syncthreads();
    if (tid == 0) qw[0] = (int)atomicAdd(qc, (unsigned)TBQ_CH);
    __syncthreads();
    int bi = __builtin_amdgcn_readfirstlane(qw[0]), slot = 0, j = 0, buf = 0, nbi; bool more;
    if (bi >= NQ) return;
    int nb_pending = 0; if (tid == 0) nb_pending = (int)atomicAdd(qc, (unsigned)TBQ_CH);
    TbItem cur = tb_item8(a, tbq_map<LIST>(bi)), nxt = cur; f32x4 v[4][4]; tb_load<true>(v, cur, wave, lane);
    for (;;) {
        LAS unsigned char* T = lds + buf * TB_BYTES; tb_write<true>(v, T, wave, lane);
        if (j == 0 && tid == 0) qw[slot ^ 1] = nb_pending;
        if (j + 1 < TBQ_CH) nbi = bi + 1; else nbi = __builtin_amdgcn_readfirstlane(qw[slot ^ 1]);
        more = nbi < NQ;
        if (more) { nxt = tb_item8(a, tbq_map<LIST>(nbi)); tb_load<true>(v, nxt, wave, lane); }
        if (j + 1 == TBQ_CH) { slot ^= 1; if (more && tid == 0) nb_pending = (int)atomicAdd(qc, (unsigned)TBQ_CH); }
        LDS_WAIT(); __builtin_amdgcn_s_barrier(); tb_store<true>(T, cur, wave, lane);
        if (!more) break;
        cur = nxt; bi = nbi; buf ^= 1; j = (j + 1 == TBQ_CH) ? 0 : j + 1;
    }
    __syncthreads();
}
__device__ __forceinline__ void phase_prologue(KArgs a, LAS unsigned char* lds) {
    const int tid = opaque_tid(), lane = tid & 63, wave = tid >> 6, G = gridDim.x;
    const int gw = blockIdx.x * 8 + wave, NGW = G * 8;
    unsigned char* ws = a.ws;
    LAS float* scr = (LAS float*)(lds + wave * 16640);
    tb_run<false>(a, lds, TB_N16, blockIdx.x, G, wave, lane);
    if constexpr (FP8_P1B) tb_run<true, 1>(a, lds, TB_NQ8, blockIdx.x, G, wave, lane);
    constexpr int I_RG = 16 * 16, I_W4 = 64, O8 = I_RG, O9 = O8 + I_RG, O10 = O9 + I_W4;
    for (int it = gw; it < O10; it += NGW) {
        if (it < O9) { const bool wx = it >= O8; const int r = it - (wx ? O8 : 0), dn = r / 16, q = r % 16, kb = q / 4, nb = q % 4, n0 = nb * 64, dir = dn / 8, n = dn % 8;
            transpose_item<false>((wx ? a.in[24] : a.in[22]) + (size_t)dn * 65536, 256, kb * 64, n0, ws + WS_WG_OD, 256, (n * 4 + dir * 2 + (n0 >> 7)) * 256 + (n0 & 127) + (wx ? 128 : 0), 1.f, scr, lane); }
        else { const int nb = it - O9; transpose_item<false>(a.in[11], 4096, 0, nb * 64, ws + A_W4T, 128, nb * 64, 1.f, scr, lane); }
    }
    { const int gt = blockIdx.x * 512 + tid, NT = G * 512;
      for (int i = gt; i < 16384 + 512; i += NT) { float sn, cs;
          if (i < 16384) { const int k1 = i >> 9, n2 = i & 511; sincospif(-2.0f * (float)((k1 * n2) & 16383) * (1.0f / 16384.0f), &sn, &cs); ((float2*)(ws + WS_TW1))[i] = make_float2(cs, sn); }
          else { const int q = i - 16384, j1 = q >> 4, m2 = q & 15; sincospif(-2.0f * (float)((j1 * m2) & 511) * (1.0f / 512.0f), &sn, &cs); ((float2*)(ws + WS_TW2))[q] = make_float2(cs, sn); } }
      for (int i = gt; i < 4096 * 8; i += NT) { const int r = i >> 3, c = i & 7; *(u32x4*)((bf16_t*)(ws + A_W4T) + (size_t)r * 128 + 64 + c * 8) = (u32x4){0u, 0u, 0u, 0u}; }
      for (int i = gt; i < 8192 * 8; i += NT) { const int r = i >> 3, c = i & 7; *(u32x4*)((bf16_t*)(ws + A_H3B) + (size_t)r * 128 + 64 + c * 8) = (u32x4){0u, 0u, 0u, 0u}; }
      const f32x8* x8 = (const f32x8*)a.in[0]; u32x4* xb = (u32x4*)(ws + A_XB);
      u32x2* xb8 = (u32x2*)(ws + A_XB8);
      for (int i0 = gt; i0 < NTOK * DM / 8; i0 += 4 * NT) { f32x8 v[4];
#pragma unroll
          for (int k = 0; k < 4; ++k) { const int i = i0 + k * NT; v[k] = (i < NTOK * DM / 8) ? __builtin_nontemporal_load(x8 + i) : (f32x8){0.f, 0.f, 0.f, 0.f, 0.f, 0.f, 0.f, 0.f}; }
#pragma unroll
          for (int k = 0; k < 4; ++k) { const int i = i0 + k * NT; if (i < NTOK * DM / 8) { u32x4 o; o.x = pk2(v[k][0], v[k][1]); o.y = pk2(v[k][2], v[k][3]); o.z = pk2(v[k][4], v[k][5]); o.w = pk2(v[k][6], v[k][7]); xb[i] = o;
              if (FP8_P1) { u32x2 q; q.x = pg8::pk4_fp8(v[k][0], v[k][1], v[k][2], v[k][3]); q.y = pg8::pk4_fp8(v[k][4], v[k][5], v[k][6], v[k][7]); xb8[i] = q; } } } } }
    { const float* w1 = a.in[4]; const float* b1 = a.in[5]; const float* w2 = a.in[6]; const float* b2 = a.in[7]; const float* w3 = a.in[8]; const float* b3 = a.in[9]; const float* fr = a.in[10];
      const float frq = fr[lane];
      for (int t = gw; t < SEQ; t += NGW) {
          float z;
          { const float tl = (float)t * (1.0f / 8191.0f);
            if (lane == 0) z = tl;
            else { const int j = (lane - 1) & 15; const float band = 1e-4f + (float)j * ((15.0f - 1e-4f) / 15.0f);
                   const float ang = (6.283185307179586f * (float)t * (1.0f / 8192.0f)) * band; float sn, cs; sincosf(ang, &sn, &cs); z = (lane <= 16) ? cs : -sn; } }
          float acc = b1[lane];
#pragma unroll
          for (int i = 0; i < 33; ++i) acc += __shfl(z, i) * w1[i * 64 + lane];
          float h = sinf(frq * acc);
          acc = b2[lane];
#pragma unroll 16
          for (int i = 0; i < 64; ++i) acc += __shfl(h, i) * w2[i * 64 + lane];
          h = sinf(frq * acc);
          acc = b3[lane];
#pragma unroll 16
          for (int i = 0; i < 64; ++i) acc += __shfl(h, i) * w3[i * 64 + lane];
          h = sinf(frq * acc);
          ((bf16_t*)(ws + A_H3B))[(size_t)t * 128 + lane] = (bf16_t)f2bf(h);
      } }
}

__device__ __forceinline__ void filter_unit(KArgs a, LAS unsigned char* lds, int u, int tid) {
    const int lane = tid & 63, wave = tid >> 6;
    LAS f32x2* L = (LAS f32x2*)lds; LAS float* red = (LAS float*)(lds + LDS_MISC + 1024);
    const bf16_t* KTD = (const bf16_t*)(a.ws + A_KTD); __half2* KF = (__half2*)(a.ws + A_KF);
    {
        int tl = tid; asm volatile("" : "+v"(tl));
        const bf16_t* rowF = KTD + (size_t)u * 8192; const bf16_t* rowB = KTD + (size_t)(2048 + u) * 8192;
        hy::cf v[32]; float ss = 0.f;
#pragma unroll
        for (int n1 = 0; n1 < 32; ++n1) { const int p = tl + 512 * n1; float val;
            if (n1 < 16) val = bf2f(rowF[p]); else if (p == 8192) val = 0.f; else val = bf2f(rowB[16384 - p]);
            v[n1] = (hy::cf){val, 0.f}; ss += val * val; }
        ss = wave_sum(ss); if (lane == 0) red[wave] = ss; __syncthreads();
        float tot = 0.f;
#pragma unroll
        for (int w = 0; w < 8; ++w) tot += red[w];
        const float scale = rsqrtf(tot), skp = a.in[12][u];
        hy::fft_fwd12(v, L, tl);
#pragma unroll
        for (int bf = 0; bf < 2; ++bf) { const int idx = bf * 512 + tl, k1 = idx >> 5, j1 = idx & 31; hy::cf w[16];
#pragma unroll
            for (int m2 = 0; m2 < 16; ++m2) w[m2] = hy::lld(L, k1 * hy::RS + 33 * m2 + j1);
            hy::dft_reg<16, false>(w);
#pragma unroll
            for (int j2 = 0; j2 < 16; ++j2) { const hy::cf x = w[hy::brev(j2, 4)]; KF[((size_t)((blockIdx.x * 2 + (u >> 10)) * 2 + bf) * 16 + j2) * 512 + tl] = __floats2half2_rn(x.x * scale + skp, x.y * scale); } }
        __syncthreads();
    }
}
__device__ __forceinline__ float hyconv(const bf16_t* row, int t, float w0, float w1, float w2, float bias) {
    const bf16_t* p = row + t;
    float xm = bf2f(p[-1]), x0 = bf2f(p[0]), xp = bf2f(p[1]);
    xm = t > 0 ? xm : 0.f; xp = t < SEQ - 1 ? xp : 0.f;
    return w0 * xm + w1 * x0 + w2 * xp + bias;
}
__device__ __forceinline__ bf16x8 pack8(const float (&v)[8]) { return __builtin_bit_cast(bf16x8, (u32x4){cvt_pk_bf16(v[0], v[1]), cvt_pk_bf16(v[2], v[3]), cvt_pk_bf16(v[4], v[5]), cvt_pk_bf16(v[6], v[7])}); }
__device__ __forceinline__ void phase_hyena_mixer(KArgs a, LAS unsigned char* lds) {
    const int tid = opaque_tid(), lane = tid & 63, wave = __builtin_amdgcn_readfirstlane(tid >> 6), j = lane & 31, hi = lane >> 5, G = gridDim.x;
    LAS unsigned char* L = lds; LAS float* red = (LAS float*)(lds + LDS_MISC + 1024);
    const bf16_t* UHT = (const bf16_t*)(a.ws + A_UHT); const bf16_t* KTD = (const bf16_t*)(a.ws + A_KTD); bf16_t* YHT = (bf16_t*)(a.ws + A_YHT);
    __half2* KF = (__half2*)(a.ws + A_KF) + (size_t)blockIdx.x * (2 * 32 * 8 * 64);
    const LAS unsigned* TW1 = (const LAS unsigned*)(lds + hm::LDS_TW1); const LAS f32x2* TW2 = (const LAS f32x2*)(lds + hm::LDS_TW2);
    const float* cw = a.in[2]; const float* cb = a.in[3];
    hm::build_tw(lds, tid); hm::build_ftab(lds + hm::LDS_FTAB, tid); const hm::Consts C{lds + hm::LDS_FTAB, lane};
    for (int c = blockIdx.x; c < HY_CH; c += G) {
        int jl = j, hil = hi, wl = wave; asm volatile("" : "+v"(jl), "+v"(hil), "+s"(wl));
#ifndef HM_NOFILTER
        { const bf16_t* rF0 = KTD + (size_t)c * 8192; const bf16_t* rB0 = KTD + (size_t)(2048 + c) * 8192;
          const bf16_t* rF1 = KTD + (size_t)(1024 + c) * 8192; const bf16_t* rB1 = KTD + (size_t)(3072 + c) * 8192;
          float va[2][2][8], vb[2][2][8]; float ss0 = 0.f, ss1 = 0.f;
#pragma unroll
          for (int tl = 0; tl < 2; ++tl)
#pragma unroll
              for (int ks = 0; ks < 2; ++ks) {
#pragma unroll
                  for (int t = 0; t < 8; ++t) { const int p = 64 * wl + 32 * tl + jl + 512 * (16 * ks + 8 * hil + t); float x0, x1;
                      if (ks == 0) { x0 = bf2f(rF0[p]); x1 = bf2f(rF1[p]); }
                      else { x0 = bf2f(rB0[16384 - p]); x1 = bf2f(rB1[16384 - p]); if (p == 8192) { x0 = 0.f; x1 = 0.f; } }
                      va[tl][ks][t] = x0; vb[tl][ks][t] = x1; ss0 += x0 * x0; ss1 += x1 * x1; }
                  asm volatile("" ::: "memory"); }
          ss0 = wave_sum(ss0); ss1 = wave_sum(ss1); if (lane == 0) { red[wave] = ss0; red[8 + wave] = ss1; } __syncthreads();
          float tot0 = 0.f, tot1 = 0.f;
#pragma unroll
          for (int w = 0; w < 8; ++w) { tot0 += red[w]; tot1 += red[8 + w]; }
          const float s0 = rsqrtf(tot0), s1 = rsqrtf(tot1);
          bf16x8 Bre[2][2], Bim[2][2];
#pragma unroll
          for (int tl = 0; tl < 2; ++tl)
#pragma unroll
              for (int ks = 0; ks < 2; ++ks) { float w0[8], w1[8];
#pragma unroll
                  for (int t = 0; t < 8; ++t) { w0[t] = va[tl][ks][t] * s0; w1[t] = vb[tl][ks][t] * s1; }
                  Bre[tl][ks] = pack8(w0); Bim[tl][ks] = pack8(w1); }
          hm::fwd12<2>(C, Bre, Bim, L, TW1, TW2, wl, jl, hil);
#pragma unroll
          for (int q = 0; q < 4; ++q) { const int t3 = 4 * wl + q, colp = 32 * t3 + jl; f32x16 dr = {}, di = {};
              hm::cmfma<false>(dr, di, C.get(2), *(const LAS bf16x8*)(L + (colp * hm::ROWB + 8 * hil) * 2), *(const LAS bf16x8*)(L + hm::PL_B + (colp * hm::ROWB + 8 * hil) * 2));
#pragma unroll
              for (int r = 0; r < 8; ++r) KF[(t3 * 8 + r) * 64 + lane] = __floats2half2_rn(dr[r], di[r]); asm volatile("" ::: "memory"); }
          __syncthreads();
        }
#endif
        VM_WAIT();
#ifndef HM_NOMIXER
        bf16x8 Zre[2][1], Zim[2][1];
        { const bf16_t* r0 = UHT + (size_t)c * NTOK; const float w0 = cw[c], w1 = cw[3072 + c], w2 = cw[6144 + c], bb = cb[c];
#pragma unroll
          for (int tl = 0; tl < 2; ++tl) { float v0[8], v1[8];
#pragma unroll
              for (int t = 0; t < 8; ++t) { const int tt = 64 * wl + 32 * tl + jl + 512 * (8 * hil + t); v0[t] = hyconv(r0, tt, w0, w1, w2, bb); v1[t] = hyconv(r0 + SEQ, tt, w0, w1, w2, bb); }
              Zre[tl][0] = pack8(v0); Zim[tl][0] = pack8(v1); asm volatile("" ::: "memory"); } }
#pragma unroll 1
        for (int o = 0; o < 2; ++o) {
            hm::fwd12<1>(C, Zre, Zim, L, TW1, TW2, wl, jl, hil);
            int j3 = jl, h3 = hil; asm volatile("" : "+v"(j3), "+v"(h3));
            const float skp = a.in[12][o * 1024 + c];
            bf16x8 zre[4], zim[4];
#pragma unroll
            for (int q = 0; q < 4; ++q) { const int colp = 32 * (4 * wl + q) + j3; zre[q] = *(const LAS bf16x8*)(L + (colp * hm::ROWB + 8 * h3) * 2); zim[q] = *(const LAS bf16x8*)(L + hm::PL_B + (colp * hm::ROWB + 8 * h3) * 2); }
            __syncthreads();
            asm volatile("" : "+v"(j3), "+v"(h3));
#pragma unroll
            for (int q = 0; q < 4; ++q) { const int t3 = 4 * wl + q; f32x16 dr = {}, di = {};
                hm::cmfma<false>(dr, di, C.get(2), zre[q], zim[q]);
                float xr[8], xi[8];
#pragma unroll
                for (int r = 0; r < 8; ++r) {
                    const int km = (16384 - (t3 + 32 * j3 + 1024 * hm::crow(r, h3))) & 16383, j2m = km >> 10;
                    const float2 za = __half22float2(KF[(t3 * 8 + r) * 64 + lane]), zb = __half22float2(KF[((km & 31) * 8 + (j2m & 3) + 4 * (j2m >> 3)) * 64 + ((km >> 5) & 31) + 32 * ((j2m >> 2) & 1)]);
                    const float kx = 0.5f * ((o ? za.y : za.x) + (o ? zb.y : zb.x)) + skp, ky = 0.5f * ((o ? zb.x : za.y) - (o ? za.x : zb.y));
                    const hm::cf x = hm::cmul((hm::cf){dr[r], di[r]}, (hm::cf){kx, ky}); xr[r] = x.x; xi[r] = x.y; }
                const bf16x8 br = hm::pk4(xr), bi = hm::pk4(xi);
                f32x16 er = {}, ei = {};
                hm::cmfma<true>(er, ei, C.get(2), br, bi);
#pragma unroll
                for (int r = 0; r < 8; ++r) { const int m2 = hm::crow(r, h3); hm::st2(L, hm::PL_A, (t3 * 16 + m2) * hm::ROWA + j3, hm::cmulc((hm::cf){er[r], ei[r]}, TW2[j3 * 16 + m2])); } asm volatile("" ::: "memory"); }
            __syncthreads();
            hm::cf y[2][8];
            hm::inv21(C, y, L, TW1, wl, jl, hil);
            const int gch = (o + 1) * 1024 + c; const bf16_t* rg = UHT + (size_t)gch * NTOK;
            const float w0 = cw[gch], w1 = cw[3072 + gch], w2 = cw[6144 + gch], bb = cb[gch];
            int jg = jl, hg = hil; asm volatile("" : "+v"(jg), "+v"(hg));
#pragma unroll
            for (int tl = 0; tl < 2; ++tl) { float z0[8], z1[8];
#pragma unroll
                for (int r = 0; r < 8; ++r) { const int tt = 64 * wl + 32 * tl + jg + 512 * hm::crow(r, hg);
                    z0[r] = hyconv(rg, tt, w0, w1, w2, bb) * y[tl][r].x * (1.0f / 16384.0f); z1[r] = hyconv(rg + SEQ, tt, w0, w1, w2, bb) * y[tl][r].y * (1.0f / 16384.0f); }
                asm volatile("" ::: "memory");
                if (o == 0) { Zre[tl][0] = hm::pk4(z0); Zim[tl][0] = hm::pk4(z1); }
                else { bf16_t* yo = YHT + (size_t)c * NTOK;
#pragma unroll
                    for (int r = 0; r < 8; ++r) { const int tt = 64 * wl + 32 * tl + jg + 512 * hm::crow(r, hg); yo[tt] = (bf16_t)f2bf(z0[r]); yo[SEQ + tt] = (bf16_t)f2bf(z1[r]); } } }
        }
#endif
    }
    __syncthreads();
}
__device__ __forceinline__ void phase_qknorm(KArgs a, LAS unsigned char* lds) {
    const int tid = opaque_tid(), lane = tid & 63, wave = tid >> 6, gw = blockIdx.x * 8 + wave, NGW = gridDim.x * 8;
    LAS unsigned* red = (LAS unsigned*)(lds + LDS_MISC + 1536);
    unsigned* ctl = (unsigned*)(a.ws + WS_CTL);
    if (tid < 64) red[tid] = 0u;
    __syncthreads();
    for (int which = 0; which < 2; ++which) { const bf16_t* P = (const bf16_t*)(a.ws + (which ? A_KB : A_QB));
        for (int b = 0; b < 2; ++b) { float mx = 0.f;
            for (int row = gw; row < SEQ; row += NGW) { const bf16_t* p = P + ((size_t)b * SEQ + row) * 1024 + lane * 16;
                const u32x4 w0 = *(const u32x4*)p, w1 = *(const u32x4*)(p + 8); const unsigned ww[8] = {w0.x, w0.y, w0.z, w0.w, w1.x, w1.y, w1.z, w1.w};
                float ss = 0.f;
#pragma unroll
                for (int i = 0; i < 8; ++i) { const float x = bflo(ww[i]), y = bfhi(ww[i]); ss += x * x + y * y; }
                ss += __shfl_xor(ss, 1); ss += __shfl_xor(ss, 2); mx = fmaxf(mx, ss); }
            if ((lane & 3) == 0) atomicMax((unsigned*)&red[which * 32 + b * 16 + (lane >> 2)], __float_as_uint(mx)); } }
    __syncthreads();
    if (tid < 64) atomicMax(ctl + CW_NORM + tid, red[tid]);
}
__device__ __forceinline__ void phase_attention(KArgs a, LAS unsigned char* lds) {
    const int G = gridDim.x, bx = blockIdx.x;
    const bf16_t* QB = (const bf16_t*)(a.ws + A_QB); const bf16_t* KB = (const bf16_t*)(a.ws + A_KB); const bf16_t* VB = (const bf16_t*)(a.ws + A_VB); bf16_t* OA = (bf16_t*)(a.ws + A_OA);
    const unsigned* nrm = (const unsigned*)(a.ws + WS_CTL) + CW_NORM;
    const int tid_ = opaque_tid(), xq = bx & 7; unsigned* actr = (unsigned*)(a.ws + WS_CTL) + CW_AQ;
    LAS int* ash = (LAS int*)(lds + LDS_MISC + 2560);
    int qsel = 0;
    for (;;) {
        int bhc, qb;
        __syncthreads();
        if (tid_ == 0) { int u = -1, qx = xq;
            while (qsel < 8) { const int sc = ((qsel & 1) << 2) | (qsel >> 1); qx = xq ^ sc; u = (int)atomicAdd(actr + qx * 64, 1u); if (u < 128) break; ++qsel; u = -1; }
            ash[0] = u; ash[1] = qx; }
        __syncthreads();
        { const int u = __builtin_amdgcn_readfirstlane(ash[0]), x = __builtin_amdgcn_readfirstlane(ash[1]); if (u < 0) break;
          const int i = u >> 5, r = u & 31, combo = x & 3, hh = (x < 4) ? ((i == 0) ? 7 : (i == 1) ? 5 : (i == 2) ? 1 : 0) : ((i == 0) ? 6 : (i == 1) ? 4 : (i == 2) ? 3 : 2);
          bhc = (combo >> 1) * 16 + hh * 2 + (combo & 1); qb = (r & 1) ? 15 - (r >> 1) : 16 + (r >> 1); }
        const int b = bhc >> 4, h = (bhc >> 1) & 7, cm = bhc & 1;
        const size_t rowq = (size_t)b * SEQ + (size_t)qb * 256;
        const float sl2 = exp2f(-(float)(h + 1)) * 1.4426950408889634f;
        const float qk = sqrtf(__uint_as_float(nrm[bhc]) * __uint_as_float(nrm[32 + bhc]));
        const float Wk = (2.0f * qk + 38.0f) / sl2, q0f = (float)(qb * 256);
        int t_lo = (int)fmaxf(floorf((q0f - Wk - 63.0f) * (1.0f / 64.0f)), 0.0f), t_hi = (int)fminf(ceilf((q0f + 255.0f + Wk) * (1.0f / 64.0f)), 127.0f);
        if (((t_hi - t_lo + 1) & 1) != 0) { if (t_hi < 127) ++t_hi; else --t_lo; }
        att::attn_unit(QB + rowq * 1024 + h * 128 + cm * 64, KB + (size_t)b * SEQ * 1024 + h * 128 + cm * 64, VB + (size_t)b * SEQ * 1024 + h * 128,
                       OA + (size_t)cm * NTOK * 1024 + rowq * 1024 + h * 128, qb * 256, t_lo, t_hi - t_lo + 1, sl2, (char*)lds);
    }
}
__device__ __forceinline__ void phase_concat(KArgs a, LAS unsigned char* lds) {
    const int tid = opaque_tid(), lane = tid & 63, wave = tid >> 6, G = gridDim.x;
    const bf16_t* YHT = (const bf16_t*)(a.ws + A_YHT); const bf16_t* OA0 = (const bf16_t*)(a.ws + A_OA); const bf16_t* OA1 = OA0 + (size_t)NTOK * 1024; bf16_t* YC = (bf16_t*)(a.ws + A_YCAT);
    LAS bf16_t* T = (LAS bf16_t*)lds;
    const float lambda_init = 0.2f;
    const float lam = __expf(wave_sum(a.in[13][lane] * a.in[14][lane])) - __expf(wave_sum(a.in[15][lane] * a.in[16][lane])) + lambda_init;
    float gl[16];
#pragma unroll
    for (int i = 0; i < 16; ++i) gl[i] = a.in[17][(lane & 7) * 16 + i] * (1.0f - lambda_init);
    for (int it = blockIdx.x; it < NTOK / 64; it += G) {
        const int tok0 = it * 64;
#pragma unroll 4
        for (int k = 0; k < 16; ++k) { const int idx = tid + 512 * k, c = idx >> 3, ch = idx & 7;
            const u32x4 w = *(const u32x4*)(YHT + (size_t)c * NTOK + tok0 + ch * 8);
            LAS bf16_t* d = T + (ch * 8) * 1026 + c;
            d[0 * 1026] = (bf16_t)(w.x & 0xffff); d[1 * 1026] = (bf16_t)(w.x >> 16); d[2 * 1026] = (bf16_t)(w.y & 0xffff); d[3 * 1026] = (bf16_t)(w.y >> 16);
            d[4 * 1026] = (bf16_t)(w.z & 0xffff); d[5 * 1026] = (bf16_t)(w.z >> 16); d[6 * 1026] = (bf16_t)(w.w & 0xffff); d[7 * 1026] = (bf16_t)(w.w >> 16); }
        __syncthreads();
#pragma unroll 4
        for (int k = 0; k < 16; ++k) { const int idx = tid + 512 * k, tl = idx >> 7, c8 = idx & 127;
            const LAS unsigned* s = (const LAS unsigned*)(T + tl * 1026 + c8 * 8);
            u32x4 w; w.x = s[0]; w.y = s[1]; w.z = s[2]; w.w = s[3];
            if (FP8_P5) { u32x2 q; q.x = pg8::pk4_fp8(bflo(w.x), bfhi(w.x), bflo(w.y), bfhi(w.y)); q.y = pg8::pk4_fp8(bflo(w.z), bfhi(w.z), bflo(w.w), bfhi(w.w)); *(u32x2*)((unsigned char*)YC + (size_t)(tok0 + tl) * DM + c8 * 8) = q; }
            else *(u32x4*)(YC + (size_t)(tok0 + tl) * DM + c8 * 8) = w; }
        for (int rr = 0; rr < 8; ++rr) { const size_t tok = (size_t)tok0 + wave * 8 + rr;
            const u32x4 p0 = *(const u32x4*)(OA0 + tok * 1024 + lane * 16), p1 = *(const u32x4*)(OA0 + tok * 1024 + lane * 16 + 8);
            const u32x4 q0 = *(const u32x4*)(OA1 + tok * 1024 + lane * 16), q1 = *(const u32x4*)(OA1 + tok * 1024 + lane * 16 + 8);
            const unsigned pw[8] = {p0.x, p0.y, p0.z, p0.w, p1.x, p1.y, p1.z, p1.w}, qw[8] = {q0.x, q0.y, q0.z, q0.w, q1.x, q1.y, q1.z, q1.w};
            float o[16]; float ss = 0.f;
#pragma unroll
            for (int i = 0; i < 8; ++i) { o[2 * i] = bflo(pw[i]) - lam * bflo(qw[i]); o[2 * i + 1] = bfhi(pw[i]) - lam * bfhi(qw[i]); ss += o[2 * i] * o[2 * i] + o[2 * i + 1] * o[2 * i + 1]; }
            ss += __shfl_xor(ss, 1); ss += __shfl_xor(ss, 2); ss += __shfl_xor(ss, 4);
            const float rs = rsqrtf(ss * (1.0f / 128.0f) + LN_EPS);
            u32x4 w0, w1;
            w0.x = pk2(o[0] * rs * gl[0], o[1] * rs * gl[1]); w0.y = pk2(o[2] * rs * gl[2], o[3] * rs * gl[3]); w0.z = pk2(o[4] * rs * gl[4], o[5] * rs * gl[5]); w0.w = pk2(o[6] * rs * gl[6], o[7] * rs * gl[7]);
            w1.x = pk2(o[8] * rs * gl[8], o[9] * rs * gl[9]); w1.y = pk2(o[10] * rs * gl[10], o[11] * rs * gl[11]); w1.z = pk2(o[12] * rs * gl[12], o[13] * rs * gl[13]); w1.w = pk2(o[14] * rs * gl[14], o[15] * rs * gl[15]);
            if (FP8_P5) { u32x4 q; q.x = pg8::pk4_fp8(o[0] * rs * gl[0], o[1] * rs * gl[1], o[2] * rs * gl[2], o[3] * rs * gl[3]); q.y = pg8::pk4_fp8(o[4] * rs * gl[4], o[5] * rs * gl[5], o[6] * rs * gl[6], o[7] * rs * gl[7]);
                q.z = pg8::pk4_fp8(o[8] * rs * gl[8], o[9] * rs * gl[9], o[10] * rs * gl[10], o[11] * rs * gl[11]); q.w = pg8::pk4_fp8(o[12] * rs * gl[12], o[13] * rs * gl[13], o[14] * rs * gl[14], o[15] * rs * gl[15]);
                *(u32x4*)((unsigned char*)YC + tok * DM + 1024 + lane * 16) = q; }
            else { *(u32x4*)(YC + tok * DM + 1024 + lane * 16) = w0; *(u32x4*)(YC + tok * DM + 1024 + lane * 16 + 8) = w1; } }
        __syncthreads();
    }
}
__device__ __forceinline__ void ln_row(f32x4 (&v)[8], const float* g, const float* b, int lane, float& mu, float& rs) {
    float s = 0.f;
#pragma unroll
    for (int j = 0; j < 8; ++j) s += (v[j][0] + v[j][1]) + (v[j][2] + v[j][3]);
    const float mean = wave_sum(s) * (1.0f / DM); float s2 = 0.f;
#pragma unroll
    for (int j = 0; j < 8; ++j) { v[j] = v[j] - mean; s2 += (v[j][0] * v[j][0] + v[j][1] * v[j][1]) + (v[j][2] * v[j][2] + v[j][3] * v[j][3]); }
    const float rstd = rsqrtf(wave_sum(s2) * (1.0f / DM) + LN_EPS); mu = mean; rs = rstd;
#pragma unroll
    for (int j = 0; j < 8; ++j) { const f32x4 gg = *(const f32x4*)(g + 4 * (lane + 64 * j)), bb = *(const f32x4*)(b + 4 * (lane + 64 * j)); v[j] = v[j] * rstd * gg + bb; }
}
__device__ __forceinline__ void phase_ln_router(KArgs a, LAS unsigned char* lds, const bf16_t* R, const float* g, const float* b, bf16_t* HB, unsigned char* HB8, unsigned* cnt, int* rowlist, float* gatew) {
    const int tid = opaque_tid(), lane = tid & 63, wave = tid >> 6, G = gridDim.x;
    const float* rw = a.in[32]; const float* rb = a.in[33];
    LAS float* part = (LAS float*)lds;
    LAS int* hist = (LAS int*)(lds + 69632); LAS int* base = hist + 32; LAS float* stats = (LAS float*)(lds + 69632 + 512);
    for (int it = blockIdx.x; it < NTOK / 64; it += G) {
        const int tok0 = it * 64;
#pragma unroll 1
        for (int hb = 0; hb < 2; ++hb) { u32x2 raw[4][8];
#pragma unroll
          for (int rr = 0; rr < 4; ++rr)
#pragma unroll
              for (int j = 0; j < 8; ++j) raw[rr][j] = *(const u32x2*)(R + ((size_t)tok0 + wave * 8 + hb * 4 + rr) * DM + 4 * (lane + 64 * j));
#pragma unroll
          for (int rr = 0; rr < 4; ++rr) { const int tl = wave * 8 + hb * 4 + rr; const size_t row = (size_t)tok0 + tl; f32x4 v[8]; float mu, rs;
#pragma unroll
            for (int j = 0; j < 8; ++j) v[j] = (f32x4){bflo(raw[rr][j].x), bfhi(raw[rr][j].x), bflo(raw[rr][j].y), bfhi(raw[rr][j].y)};
            ln_row(v, g, b, lane, mu, rs);
            if (lane == 0) { stats[tl * 2] = mu; stats[tl * 2 + 1] = rs; }
#pragma unroll
            for (int j = 0; j < 8; ++j) { u32x2 w; w.x = pk2(v[j][0], v[j][1]); w.y = pk2(v[j][2], v[j][3]); *(u32x2*)(HB + row * DM + 4 * (lane + 64 * j)) = w;
                if (HB8) *(unsigned*)(HB8 + row * DM + 4 * (lane + 64 * j)) = pg8::pk4_fp8(v[j][0], v[j][1], v[j][2], v[j][3]); } } }
        if (tid < 32) hist[tid] = 0;
        __syncthreads();
        { const int i = lane & 31, kk = lane >> 5; f32x16 acc0 = {}, acc1 = {};
          const float mu0 = stats[i * 2], rs0 = stats[i * 2 + 1], mu1 = stats[(i + 32) * 2], rs1 = stats[(i + 32) * 2 + 1];
          const bf16_t* rrow = R + (size_t)(tok0 + i) * DM + wave * 256 + 4 * kk; const float* gp = g + wave * 256 + 4 * kk; const float* bp = b + wave * 256 + 4 * kk;
          const float* rwp = rw + (size_t)(wave * 256 + 4 * kk) * NEXP + i;
#pragma unroll 4
          for (int s = 0; s < 32; ++s) { const u32x2 ra = *(const u32x2*)(rrow + 8 * s), rc = *(const u32x2*)(rrow + (size_t)32 * DM + 8 * s); const f32x4 gv = *(const f32x4*)(gp + 8 * s), bv = *(const f32x4*)(bp + 8 * s);
              const f32x4 h0 = ((f32x4){bflo(ra.x), bfhi(ra.x), bflo(ra.y), bfhi(ra.y)} - mu0) * rs0 * gv + bv, h1 = ((f32x4){bflo(rc.x), bfhi(rc.x), bflo(rc.y), bfhi(rc.y)} - mu1) * rs1 * gv + bv;
#pragma unroll
              for (int j = 0; j < 4; ++j) { const float wv = rwp[(size_t)(8 * s + j) * NEXP]; acc0 = __builtin_amdgcn_mfma_f32_32x32x2f32(wv, h0[j], acc0, 0, 0, 0); acc1 = __builtin_amdgcn_mfma_f32_32x32x2f32(wv, h1[j], acc1, 0, 0, 0); } }
#pragma unroll
          for (int r = 0; r < 16; ++r) { part[(wave * 64 + i) * 33 + (r & 3) + 8 * (r >> 2) + 4 * kk] = acc0[r]; part[(wave * 64 + 32 + i) * 33 + (r & 3) + 8 * (r >> 2) + 4 * kk] = acc1[r]; } }
        __syncthreads();
        int e1 = 0, e2 = 0, r1 = 0, r2 = 0; float g1 = 0.f, g2 = 0.f;
        const float rbl = rb[lane & 31];
        if (tid < 64) {
            float bestg = -1e30f;
#pragma unroll
            for (int gi = 0; gi < 4; ++gi) { float m1 = -1e30f, m2 = -1e30f, s1 = 0.f, s2 = 0.f; int i1 = 0, i2 = 0;
#pragma unroll
                for (int j = 0; j < 8; ++j) { const int e = gi * 8 + j; float lg = 0.f;
#pragma unroll
                    for (int w = 0; w < 8; ++w) lg += part[(w * 64 + tid) * 33 + e];
                    const float sg = sigmoidf_(lg), sl = sg + __shfl(rbl, e);
                    if (sl > m1) { m2 = m1; i2 = i1; s2 = s1; m1 = sl; i1 = j; s1 = sg; } else if (sl > m2) { m2 = sl; i2 = j; s2 = sg; } }
                const float gs = m1 + m2;
                if (gs > bestg) { bestg = gs; e1 = gi * 8 + i1; e2 = gi * 8 + i2; g1 = s1; g2 = s2; } }
            const float inv = 1.0f / (g1 + g2); g1 *= inv; g2 *= inv;
            r1 = atomicAdd((int*)&hist[e1], 1); r2 = atomicAdd((int*)&hist[e2], 1);
        }
        __syncthreads();
        if (tid < 32) { const int hc = hist[tid]; base[tid] = hc ? (int)__hip_atomic_fetch_add(cnt + tid * 64, (unsigned)hc, __ATOMIC_RELAXED, __HIP_MEMORY_SCOPE_AGENT) : 0; }
        __syncthreads();
        if (tid < 64) { const int a0 = (tok0 + tid) * 2;
            *(u32x2*)(rowlist + 2 * ((size_t)e1 * ECAP + base[e1] + r1)) = (u32x2){(unsigned)a0, __float_as_uint(g1)};
            *(u32x2*)(rowlist + 2 * ((size_t)e2 * ECAP + base[e2] + r2)) = (u32x2){(unsigned)(a0 + 1), __float_as_uint(g2)}; }
        __syncthreads();
    }
}
__device__ __forceinline__ void phase_ln2(const bf16_t* HB, const unsigned char* Y2, const float* g, const float* b, float* OUT, bf16_t* OB, unsigned char* OB8) {
    const int tid = opaque_tid(), lane = tid & 63, wave = tid >> 6;
    for (int row = blockIdx.x * 8 + wave; row < NTOK; row += gridDim.x * 8) { f32x4 v[8]; float mu, rs;
#pragma unroll
        for (int j = 0; j < 8; ++j) { const int c = 4 * (lane + 64 * j); const u32x2 h = *(const u32x2*)(HB + (size_t)row * DM + c);
            const int y0 = *(const int*)(Y2 + (size_t)(2 * row) * DM + c), y1 = *(const int*)(Y2 + (size_t)(2 * row + 1) * DM + c);
            v[j] = (f32x4){bflo(h.x), bfhi(h.x), bflo(h.y), bfhi(h.y)} * DN_ALPHA + (f32x4){__builtin_amdgcn_cvt_f32_fp8(y0, 0) + __builtin_amdgcn_cvt_f32_fp8(y1, 0), __builtin_amdgcn_cvt_f32_fp8(y0, 1) + __builtin_amdgcn_cvt_f32_fp8(y1, 1),
                                                                                                 __builtin_amdgcn_cvt_f32_fp8(y0, 2) + __builtin_amdgcn_cvt_f32_fp8(y1, 2), __builtin_amdgcn_cvt_f32_fp8(y0, 3) + __builtin_amdgcn_cvt_f32_fp8(y1, 3)} * (1.0f / pg8::Y2_S); }
        ln_row(v, g, b, lane, mu, rs);
#pragma unroll
        for (int j = 0; j < 8; ++j) { const int c = 4 * (lane + 64 * j); if (OUT) *(f32x4*)(OUT + (size_t)row * DM + c) = v[j];
            if (OB) { u32x2 w; w.x = pk2(v[j][0], v[j][1]); w.y = pk2(v[j][2], v[j][3]); *(u32x2*)(OB + (size_t)row * DM + c) = w; }
            if (OB8) *(unsigned*)(OB8 + (size_t)row * DM + c) = pg8::pk4_fp8(v[j][0], v[j][1], v[j][2], v[j][3]); }
    }
}
__device__ __forceinline__ void moe_table(LAS int* tab, const unsigned* cnt) {
    __syncthreads();
    const int tid = opaque_tid();
    if (tid < 64) { const int e = tid & 31; const int c = (int)cnt[e * 64], nt = (c + 255) >> 8; int inc = nt;
#pragma unroll
        for (int d = 1; d < 32; d <<= 1) { const int up = __shfl_up(inc, d, 32); if (e >= d) inc += up; }
        if (tid < 32) { const int first = inc - nt; tab[e] = first; tab[64 + e] = c; if (e == 31) tab[32] = inc;
            for (int t = first; t < inc && t < 256; ++t) tab[128 + t] = e; } }
    __syncthreads();
}
__device__ __forceinline__ void phase_conv4(KArgs a) {
    const bf16_t* XR = (const bf16_t*)(a.ws + A_XR); bf16_t* XC = (bf16_t*)(a.ws + A_XC); const float* cw = a.in[20]; const float* cb = a.in[21];
    const int NT = gridDim.x * 512;
    for (int it = blockIdx.x * 512 + opaque_tid(); it < (NTOK / 32) * 256; it += NT) { const int ch = (it & 255) * 8, tok0 = (it >> 8) * 32, t0 = tok0 & (SEQ - 1);
        float w[4][8], bias[8];
#pragma unroll
        for (int j = 0; j < 4; ++j) { const f32x4 p = *(const f32x4*)(cw + j * DM + ch), q = *(const f32x4*)(cw + j * DM + ch + 4);
#pragma unroll
            for (int i = 0; i < 4; ++i) { w[j][i] = p[i]; w[j][4 + i] = q[i]; } }
        { const f32x4 p = *(const f32x4*)(cb + ch), q = *(const f32x4*)(cb + ch + 4);
#pragma unroll
          for (int i = 0; i < 4; ++i) { bias[i] = p[i]; bias[4 + i] = q[i]; } }
        const bf16_t* xp = XR + (size_t)tok0 * DM + ch;
#define C4_ROW(dt) (((t0 + (dt)) >= 0 && (t0 + (dt)) < SEQ) ? *(const u32x4*)(xp + (ptrdiff_t)(dt) * DM) : (u32x4){0u, 0u, 0u, 0u})
#define C4_UNPACK(dst, r) do { dst[0] = bflo(r.x); dst[1] = bfhi(r.x); dst[2] = bflo(r.y); dst[3] = bfhi(r.y); dst[4] = bflo(r.z); dst[5] = bfhi(r.z); dst[6] = bflo(r.w); dst[7] = bfhi(r.w); } while (0)
        u32x4 nx[2][8];
        const u32x4 rm2 = C4_ROW(-2), rm1 = C4_ROW(-1), r0 = C4_ROW(0);
#pragma unroll
        for (int k = 0; k < 8; ++k) nx[0][k] = C4_ROW(1 + k);
        float xa[8], xb_[8], xc[8], xd[8];
        C4_UNPACK(xa, rm2); C4_UNPACK(xb_, rm1); C4_UNPACK(xc, r0);
#pragma unroll
        for (int g = 0; g < 4; ++g) {
            if (g < 3) {
#pragma unroll
                for (int k = 0; k < 8; ++k) nx[(g + 1) & 1][k] = C4_ROW(9 + 8 * g + k); }
            __builtin_amdgcn_sched_barrier(0);
#pragma unroll
            for (int k = 0; k < 8; ++k) { const u32x4 rn = nx[g & 1][k]; C4_UNPACK(xd, rn);
                float o[8];
#pragma unroll
                for (int i = 0; i < 8; ++i) o[i] = fmaf(w[3][i], xd[i], fmaf(w[2][i], xc[i], fmaf(w[1][i], xb_[i], fmaf(w[0][i], xa[i], bias[i]))));
                u32x4 ow; ow.x = pk2(o[0], o[1]); ow.y = pk2(o[2], o[3]); ow.z = pk2(o[4], o[5]); ow.w = pk2(o[6], o[7]);
                *(u32x4*)(XC + (size_t)(tok0 + 8 * g + k) * DM + ch) = ow;
#pragma unroll
                for (int i = 0; i < 8; ++i) { xa[i] = xb_[i]; xb_[i] = xc[i]; xc[i] = xd[i]; } }
            __builtin_amdgcn_sched_barrier(0); }
#undef C4_ROW
#undef C4_UNPACK
    }
}
constexpr size_t CAR_ELEMS = (size_t)2 * 2 * 256 * DM;
constexpr float RG_ILA = 1.0f / pg8::RG_SLA, RG_IB = 1.0f / pg8::RG_SB;
template <int DIR> __device__ __forceinline__ void scan1_item(const unsigned char* LA, const unsigned char* BB, float* CARA, float* CARB, int ch, int chunk, int b) {
    constexpr float LSC = RG_ILA * 1.4426950408889634f;
    float h[4] = {0.f, 0.f, 0.f, 0.f}, ls[4] = {0.f, 0.f, 0.f, 0.f};
    const size_t base = ((size_t)DIR * NTOK + (size_t)b * SEQ + chunk * 32) * DM + ch;
    int lw[2][8], bw[2][8];
#define S1_LOAD(set, g) do { _Pragma("unroll") for (int j = 0; j < 8; ++j) { const int s = (g) * 8 + j; const size_t off = base + (size_t)(DIR ? 31 - s : s) * DM; lw[set][j] = *(const int*)(LA + off); bw[set][j] = *(const int*)(BB + off); } } while (0)
    S1_LOAD(0, 0);
#pragma unroll
    for (int g = 0; g < 4; ++g) {
        if (g < 3) S1_LOAD((g + 1) & 1, g + 1);
        __builtin_amdgcn_sched_barrier(0);
#pragma unroll
        for (int j = 0; j < 8; ++j) { const int lwv = lw[g & 1][j], bwv = bw[g & 1][j];
#pragma unroll
            for (int i = 0; i < 4; ++i) { const float lv = (i == 0 ? __builtin_amdgcn_cvt_f32_fp8(lwv, 0) : i == 1 ? __builtin_amdgcn_cvt_f32_fp8(lwv, 1) : i == 2 ? __builtin_amdgcn_cvt_f32_fp8(lwv, 2) : __builtin_amdgcn_cvt_f32_fp8(lwv, 3));
                const float bv = (i == 0 ? __builtin_amdgcn_cvt_f32_fp8(bwv, 0) : i == 1 ? __builtin_amdgcn_cvt_f32_fp8(bwv, 1) : i == 2 ? __builtin_amdgcn_cvt_f32_fp8(bwv, 2) : __builtin_amdgcn_cvt_f32_fp8(bwv, 3));
                h[i] = fmaf(__builtin_amdgcn_exp2f(LSC * lv), h[i], bv); asm("" : "+v"(h[i])); ls[i] += lv; asm("" : "+v"(ls[i])); } }
        __builtin_amdgcn_sched_barrier(0); }
#undef S1_LOAD
    const size_t co = (((size_t)b * 2 + DIR) * 256 + chunk) * DM + ch;
    *(f32x4*)(CARA + co) = (f32x4){ls[0] * RG_ILA, ls[1] * RG_ILA, ls[2] * RG_ILA, ls[3] * RG_ILA}; *(f32x4*)(CARB + co) = (f32x4){h[0] * RG_IB, h[1] * RG_IB, h[2] * RG_IB, h[3] * RG_IB};
}
__device__ __forceinline__ void phase_scan1(KArgs a) {
    const unsigned char* LA = (const unsigned char*)(a.ws + A_LA); const unsigned char* BB = (const unsigned char*)(a.ws + A_BB); float* CARA = (float*)(a.ws + A_CAR); float* CARB = CARA + CAR_ELEMS;
    const int NT = gridDim.x * 512;
    for (int it = blockIdx.x * 512 + opaque_tid(); it < 2 * 2 * 256 * 512; it += NT) { const int ch = (it & 511) * 4, chunk = (it >> 9) & 255, dir = (it >> 17) & 1, b = it >> 18;
        if (dir) scan1_item<1>(LA, BB, CARA, CARB, ch, chunk, b); else scan1_item<0>(LA, BB, CARA, CARB, ch, chunk, b); }
}
__device__ __forceinline__ void phase_scan2(KArgs a, LAS unsigned char* lds) {
    float* CARA = (float*)(a.ws + A_CAR); float* CARB = CARA + CAR_ELEMS; float* CARIN = CARB + CAR_ELEMS;
    const int tid = opaque_tid(), grp = tid >> 5, chl = tid & 31;
    LAS float* sh = (LAS float*)lds;
    for (int it = blockIdx.x; it < 2 * 2 * 64; it += gridDim.x) { const int ch = (it & 63) * 32 + chl, dir = (it >> 6) & 1, b = it >> 7;
        float la[16], lb[16]; float A = 0.f, B = 0.f;
#pragma unroll
        for (int k = 0; k < 16; ++k) { const int q = grp * 16 + k, chunk = dir ? 255 - q : q; const size_t co = (((size_t)b * 2 + dir) * 256 + chunk) * DM + ch; la[k] = CARA[co]; lb[k] = CARB[co]; }
#pragma unroll
        for (int k = 0; k < 16; ++k) { B = __expf(la[k]) * B + lb[k]; A += la[k]; }
        sh[(grp * 32 + chl) * 2] = A; sh[(grp * 32 + chl) * 2 + 1] = B;
        __syncthreads();
        float h = 0.f;
        for (int g2 = 0; g2 < grp; ++g2) h = __expf(sh[(g2 * 32 + chl) * 2]) * h + sh[(g2 * 32 + chl) * 2 + 1];
#pragma unroll
        for (int k = 0; k < 16; ++k) { const int q = grp * 16 + k, chunk = dir ? 255 - q : q; const size_t co = (((size_t)b * 2 + dir) * 256 + chunk) * DM + ch; CARIN[co] = h; h = __expf(la[k]) * h + lb[k]; }
        __syncthreads();
    }
}
__device__ __forceinline__ float gelu_tanh(float x) { const float v = x * fmaf(-0.10294324f, x * x, -2.3022082f); return x * __builtin_amdgcn_rcpf(1.0f + __builtin_amdgcn_exp2f(v)); }
__device__ __forceinline__ void phase_scan3(KArgs a) {
    const unsigned char* LA = (const unsigned char*)(a.ws + A_LA); const unsigned char* BB = (const unsigned char*)(a.ws + A_BB); const bf16_t* GB = (const bf16_t*)(a.ws + A_GB); bf16_t* YG = (bf16_t*)(a.ws + A_YG);
    const float* CARIN = (const float*)(a.ws + A_CAR) + 2 * CAR_ELEMS;
    const int NT = gridDim.x * 512;
    constexpr float LSC = RG_ILA * 1.4426950408889634f;
    for (int it = blockIdx.x * 512 + opaque_tid(); it < 2 * 256 * 512; it += NT) { const int ch = (it & 511) * 4, chunk = (it >> 9) & 255, b = it >> 17;
        unsigned hf[32][2]; float h[4];
        const size_t base = ((size_t)b * SEQ + chunk * 32) * DM + ch;
        int lw[2][8], bw[2][8]; u32x2 gw[2][8];
#define S3_LOADF(set, g) do { _Pragma("unroll") for (int j = 0; j < 8; ++j) { const size_t off = base + (size_t)((g) * 8 + j) * DM; lw[set][j] = *(const int*)(LA + off); bw[set][j] = *(const int*)(BB + off); } } while (0)
#define S3_LOADR(set, g) do { _Pragma("unroll") for (int j = 0; j < 8; ++j) { const size_t tokoff = base + (size_t)((g) * 8 + j) * DM; lw[set][j] = *(const int*)(LA + (size_t)NTOK * DM + tokoff); bw[set][j] = *(const int*)(BB + (size_t)NTOK * DM + tokoff); gw[set][j] = *(const u32x2*)(GB + tokoff); } } while (0)
        S3_LOADF(0, 0);
        { const f32x4 c = *(const f32x4*)(CARIN + (((size_t)b * 2 + 0) * 256 + chunk) * DM + ch); h[0] = c[0] * pg8::RG_SB; h[1] = c[1] * pg8::RG_SB; h[2] = c[2] * pg8::RG_SB; h[3] = c[3] * pg8::RG_SB; }
#pragma unroll
        for (int g = 0; g < 4; ++g) {
            if (g < 3) S3_LOADF((g + 1) & 1, g + 1); else S3_LOADR(0, 3);
            __builtin_amdgcn_sched_barrier(0);
#pragma unroll
            for (int j = 0; j < 8; ++j) { const int s = g * 8 + j, lwv = lw[g & 1][j], bwv = bw[g & 1][j];
#pragma unroll
                for (int i = 0; i < 4; ++i) { const float av = __builtin_amdgcn_exp2f(LSC * (i == 0 ? __builtin_amdgcn_cvt_f32_fp8(lwv, 0) : i == 1 ? __builtin_amdgcn_cvt_f32_fp8(lwv, 1) : i == 2 ? __builtin_amdgcn_cvt_f32_fp8(lwv, 2) : __builtin_amdgcn_cvt_f32_fp8(lwv, 3)));
                    const float bv = (i == 0 ? __builtin_amdgcn_cvt_f32_fp8(bwv, 0) : i == 1 ? __builtin_amdgcn_cvt_f32_fp8(bwv, 1) : i == 2 ? __builtin_amdgcn_cvt_f32_fp8(bwv, 2) : __builtin_amdgcn_cvt_f32_fp8(bwv, 3));
                    h[i] = fmaf(av, h[i], bv); }
                hf[s][0] = cvt_pk_bf16(h[0], h[1]); hf[s][1] = cvt_pk_bf16(h[2], h[3]); }
            __builtin_amdgcn_sched_barrier(0); }
        { const f32x4 c = *(const f32x4*)(CARIN + (((size_t)b * 2 + 1) * 256 + chunk) * DM + ch); h[0] = c[0] * pg8::RG_SB; h[1] = c[1] * pg8::RG_SB; h[2] = c[2] * pg8::RG_SB; h[3] = c[3] * pg8::RG_SB; }
        constexpr float OSC = (FP8_P16 ? 4.0f : 1.0f) * RG_IB;
#pragma unroll
        for (int g = 3; g >= 0; --g) { const int set = (3 - g) & 1;
            if (g > 0) S3_LOADR(set ^ 1, g - 1);
            __builtin_amdgcn_sched_barrier(0);
#pragma unroll
            for (int j = 7; j >= 0; --j) { const int s = g * 8 + j, lwv = lw[set][j], bwv = bw[set][j]; const u32x2 gv = gw[set][j];
                const float g4[4] = {bflo(gv.x), bfhi(gv.x), bflo(gv.y), bfhi(gv.y)}, f4[4] = {bflo(hf[s][0]), bfhi(hf[s][0]), bflo(hf[s][1]), bfhi(hf[s][1])};
                float y[4];
#pragma unroll
                for (int i = 0; i < 4; ++i) { const float av = __builtin_amdgcn_exp2f(LSC * (i == 0 ? __builtin_amdgcn_cvt_f32_fp8(lwv, 0) : i == 1 ? __builtin_amdgcn_cvt_f32_fp8(lwv, 1) : i == 2 ? __builtin_amdgcn_cvt_f32_fp8(lwv, 2) : __builtin_amdgcn_cvt_f32_fp8(lwv, 3)));
                    const float bv = (i == 0 ? __builtin_amdgcn_cvt_f32_fp8(bwv, 0) : i == 1 ? __builtin_amdgcn_cvt_f32_fp8(bwv, 1) : i == 2 ? __builtin_amdgcn_cvt_f32_fp8(bwv, 2) : __builtin_amdgcn_cvt_f32_fp8(bwv, 3));
                    h[i] = fmaf(av, h[i], bv); y[i] = (OSC * gelu_tanh(g4[i])) * (f4[i] + h[i]); }
                const size_t tokoff = base + (size_t)s * DM;
                if (FP8_P16) { *(unsigned*)((unsigned char*)YG + tokoff) = pg8::pk4_fp8(y[0], y[1], y[2], y[3]); }
                else { u32x2 w; w.x = pk2(y[0], y[1]); w.y = pk2(y[2], y[3]); *(u32x2*)(YG + tokoff) = w; } }
            __builtin_amdgcn_sched_barrier(0); }
#undef S3_LOADF
#undef S3_LOADR
    }
}

#define KARGS() (*(const __attribute__((address_space(4))) Args*)__builtin_amdgcn_kernarg_segment_ptr())
#define PHASE_FN __device__ __forceinline__ void
#define PH_PRE() KArgs a = KARGS(); LAS unsigned char* lds = (LAS unsigned char*)lds_raw; GAS unsigned char* wsg_ = (GAS unsigned char*)a.ws; asm volatile("" : "+s"(wsg_)); unsigned char* ws = (unsigned char*)wsg_;     const int G = gridDim.x, bx = blockIdx.x; (void)lds; (void)ws; (void)G; (void)bx; using namespace pg8
PHASE_FN ph0() { PH_PRE(); phase_prologue(a, lds); }
#define NSTREAM(G_) ((G_) >= 64 ? ((G_) >> 3) : 0)
PHASE_FN ph1q() { PH_PRE(); const int tid = opaque_tid(); tb_stream_q<0>(a, lds, tid, tid >> 6, tid & 63); }
PHASE_FN ph3q() { PH_PRE(); const int tid = opaque_tid(); tb_stream_q<1>(a, lds, tid, tid >> 6, tid & 63); }
PHASE_FN ph1a() { PH_PRE(); Gemm g{(const bf16_t*)(ws + A_W4T), (const bf16_t*)(ws + A_H3B), 128, 128, 128}; StaticOrder S; S.init(4096, 8192, G - NSTREAM(G), bx); EpiFilt E{(bf16_t*)(ws + A_KTD)}; gemm_phase(lds, g, S, E); }
PHASE_FN ph1b() { PH_PRE(); StaticOrder S; S.init(NTOK, 3072, G - NSTREAM(G), bx);
    if constexpr (FP8_P1B) { Gemm g{(const bf16_t*)(ws + A_XB8), (const bf16_t*)(ws + WS_WIN_EV8 + (size_t)3072 * DM), DM / 2, DM / 2, DM / 2};
        EpiBf16 E{(bf16_t*)(ws + A_QB), 1024, 1024, (size_t)(A_KB - A_QB) / 2, QSCALE, 1.0f / FP8_SW, (unsigned*)(ws + WS_CTL) + CW_NORM, (LAS float*)(lds + 131072)}; gemm_phase<EpiBf16, StaticOrder, true>(lds, g, S, E); }
    else { Gemm g{(const bf16_t*)(ws + A_XB), (const bf16_t*)(ws + WS_WIN_EV) + (size_t)3072 * DM, DM, DM, DM};
        EpiBf16 E{(bf16_t*)(ws + A_QB), 1024, 1024, (size_t)(A_KB - A_QB) / 2, QSCALE, 1.0f, (unsigned*)(ws + WS_CTL) + CW_NORM, (LAS float*)(lds + 131072)}; gemm_phase(lds, g, S, E); } }
PHASE_FN ph1c() { PH_PRE(); StaticOrder S; { const int Gc = G - NSTREAM(G); S.init(3072, NTOK, Gc, (bx + ((Gc >> 1) & ~7)) % Gc); }
    if constexpr (FP8_P1C) { Gemm g{(const bf16_t*)(ws + WS_WIN_EV8), (const bf16_t*)(ws + A_XB8), DM / 2, DM / 2, DM / 2};
        EpiBf16 E{(bf16_t*)(ws + A_UHT), NTOK, 0, 0, 1.f, 1.0f / FP8_SW}; gemm_phase<EpiBf16, StaticOrder, true>(lds, g, S, E); }
    else { Gemm g{(const bf16_t*)(ws + WS_WIN_EV), (const bf16_t*)(ws + A_XB), DM, DM, DM};
        EpiBf16 E{(bf16_t*)(ws + A_UHT), NTOK, 0, 0, 1.f}; gemm_phase(lds, g, S, E); } }
PHASE_FN ph2() { PH_PRE(); phase_qknorm(a, lds); }
PHASE_FN ph3a() { PH_PRE(); phase_hyena_mixer(a, lds); }
PHASE_FN ph3b() { PH_PRE(); phase_attention(a, lds); }
PHASE_FN ph4() { PH_PRE(); phase_concat(a, lds); }
PHASE_FN ph5() { PH_PRE(); StaticOrder S; S.init(NTOK, DM, G, bx);
    if constexpr (FP8_P5) { Gemm g{(const bf16_t*)(ws + A_YCAT), (const bf16_t*)(ws + WS_WOUT_EV), DM / 2, DM / 2, DM / 2};
        EpiResBf E{(const bf16_t*)(ws + A_XB2), (bf16_t*)(ws + A_R0), DM, DN_ALPHA, 1.0f / FP8_SW}; gemm_phase<EpiResBf, StaticOrder, true>(lds, g, S, E); }
    else { Gemm g{(const bf16_t*)(ws + A_YCAT), (const bf16_t*)(ws + WS_WOUT_EV), DM, DM, DM};
        EpiResBf E{(const bf16_t*)(ws + A_XB2), (bf16_t*)(ws + A_R0), DM, DN_ALPHA}; gemm_phase(lds, g, S, E); } }
template <int LAYER> PHASE_FN ph_lnr() { PH_PRE(); unsigned* ctl = (unsigned*)(ws + WS_CTL);
    phase_ln_router(a, lds, (const bf16_t*)(ws + (LAYER ? A_R1 : A_R0)), a.in[28] + LAYER * DM, a.in[29] + LAYER * DM, (bf16_t*)(ws + (LAYER ? A_HB_1 : A_HB_0)), (LAYER >= 2 - MOE_FP8_LAYERS) ? ws + (LAYER ? A_HB8_1 : A_HB8_0) : nullptr,
                    ctl + CW_CNT + LAYER * 32 * 64, (int*)(ws + A_ROWL), (float*)(ws + A_GATEW)); }
template <int LAYER> PHASE_FN ph_moe1() { PH_PRE(); LAS int* tab = (LAS int*)(lds + LDS_MISC); moe_table(tab, (const unsigned*)(ws + WS_CTL) + CW_CNT + LAYER * 32 * 64);
    MoeOrder<4, true> S{G, bx, tab, (const int*)(ws + A_ROWL)};
    if constexpr (LAYER >= 2 - MOE_FP8_LAYERS) {
        Gemm g{(const bf16_t*)(ws + (LAYER ? A_HB8_1 : A_HB8_0)), (const bf16_t*)(ws + WS_W1T + (size_t)LAYER * 32 * 1024 * DM * 2), DM / 2, DM / 2, DM / 2};
        EpiSwiglu8 E{ws + (LAYER ? A_HID_1 : A_HID_0)}; gemm_phase<EpiSwiglu8, MoeOrder<4, true>, true>(lds, g, S, E);
    } else {
        Gemm g{(const bf16_t*)(ws + (LAYER ? A_HB_1 : A_HB_0)), (const bf16_t*)(ws + WS_W1T) + (size_t)LAYER * 32 * 1024 * DM, DM, DM, DM};
        EpiSwiglu E{(bf16_t*)(ws + (LAYER ? A_HID_1 : A_HID_0))}; gemm_phase(lds, g, S, E); } }
template <int LAYER> PHASE_FN ph_moe2() { PH_PRE(); LAS int* tab = (LAS int*)(lds + LDS_MISC); moe_table(tab, (const unsigned*)(ws + WS_CTL) + CW_CNT + LAYER * 32 * 64);
    MoeOrder<8, false> S{G, bx, tab, (const int*)(ws + A_ROWL)};
    if constexpr (LAYER >= 2 - MOE_FP8_LAYERS) {
        Gemm g{(const bf16_t*)(ws + (LAYER ? A_HID_1 : A_HID_0)), (const bf16_t*)(ws + WS_W2T + (size_t)LAYER * 32 * DM * DFF * 2), DFF / 2, DFF / 2, DFF / 2};
        EpiDown E{ws + (LAYER ? A_Y2_1 : A_Y2_0), (const int*)(ws + A_ROWL), (const float*)(ws + A_GATEW), 1.0f / (FP8_SW * FP8_SH)};
        gemm_phase<EpiDown, MoeOrder<8, false>, true>(lds, g, S, E);
    } else {
        Gemm g{(const bf16_t*)(ws + (LAYER ? A_HID_1 : A_HID_0)), (const bf16_t*)(ws + WS_W2T) + (size_t)LAYER * 32 * DM * DFF, DFF, DFF, DFF};
        EpiDown E{ws + (LAYER ? A_Y2_1 : A_Y2_0), (const int*)(ws + A_ROWL), (const float*)(ws + A_GATEW), 1.0f}; gemm_phase(lds, g, S, E); } }
template <int LAYER> PHASE_FN ph_ln2() { PH_PRE();
    phase_ln2((const bf16_t*)(ws + (LAYER ? A_HB_1 : A_HB_0)), ws + (LAYER ? A_Y2_1 : A_Y2_0), a.in[30] + LAYER * DM, a.in[31] + LAYER * DM, LAYER ? a.out : nullptr, LAYER ? nullptr : (bf16_t*)(ws + A_HB2), (!LAYER && FP8_P10) ? ws + A_HB2_8 : nullptr); }
PHASE_FN ph10() { PH_PRE(); StaticOrder S; S.init(NTOK, 2 * DM, G, bx);
    if constexpr (FP8_P10) { Gemm g{(const bf16_t*)(ws + A_HB2_8), (const bf16_t*)(ws + WS_WIN_OD), DM / 2, DM / 2, DM / 2};
        EpiBf16 E{(bf16_t*)(ws + A_GB), DM, DM, (size_t)(A_XR - A_GB) / 2, 1.f, 1.0f / FP8_SW}; gemm_phase<EpiBf16, StaticOrder, true>(lds, g, S, E); }
    else { Gemm g{(const bf16_t*)(ws + A_HB2), (const bf16_t*)(ws + WS_WIN_OD), DM, DM, DM};
        EpiBf16 E{(bf16_t*)(ws + A_GB), DM, DM, (size_t)(A_XR - A_GB) / 2, 1.f}; gemm_phase(lds, g, S, E); } }
PHASE_FN ph11() { PH_PRE(); phase_conv4(a); }
PHASE_FN ph12() { PH_PRE(); Gemm g{(const bf16_t*)(ws + A_XC), (const bf16_t*)(ws + WS_WG_OD), DM, 256, 256}; RGOrder S{G, bx};
                  EpiRG E{(bf16_t*)(ws + A_LA), (bf16_t*)(ws + A_BB), (const bf16_t*)(ws + A_XC), a.in[23], a.in[25], a.in[26]};
                  if (G == 256) {
                      LAS float* tb = (LAS float*)(lds + 131072); const int tid = opaque_tid(), pn = (bx & 7) * 4 + ((bx >> 3) & 3), ch = (pn >> 2) * 256 + (pn & 1) * 128 + tid, dir = (pn & 3) >> 1;
                      __syncthreads();
                      if (tid < 128) { const float vs = rg_vsp(a.in[26][dir * DM + ch]); tb[tid] = -1.4426950408889634f * a.in[23][dir * DM + ch]; tb[128 + tid] = -1.4426950408889634f * a.in[25][dir * DM + ch];
                          tb[256 + tid] = -RG_SLA * vs; tb[384 + tid] = -2.8853900817779268f * vs; }
                      __syncthreads(); E.ctab = tb; }
                  gemm_phase(lds, g, S, E); }
PHASE_FN ph13() { PH_PRE(); phase_scan1(a); }
PHASE_FN ph14() { PH_PRE(); phase_scan2(a, lds); }
PHASE_FN ph15() { PH_PRE(); phase_scan3(a); }
PHASE_FN ph16() { PH_PRE(); StaticOrder S; S.init(NTOK, DM, G, bx);
    if constexpr (FP8_P16) { Gemm g{(const bf16_t*)(ws + A_YG), (const bf16_t*)(ws + WS_WOUT_OD), DM / 2, DM / 2, DM / 2};
        EpiResBf E{(const bf16_t*)(ws + A_HB2), (bf16_t*)(ws + A_R1), DM, DN_ALPHA, 1.0f / (FP8_SW * 4.0f)}; gemm_phase<EpiResBf, StaticOrder, true>(lds, g, S, E); }
    else { Gemm g{(const bf16_t*)(ws + A_YG), (const bf16_t*)(ws + WS_WOUT_OD), DM, DM, DM};
        EpiResBf E{(const bf16_t*)(ws + A_HB2), (bf16_t*)(ws + A_R1), DM, DN_ALPHA}; gemm_phase(lds, g, S, E); } }

__global__ void __launch_bounds__(512, 2) fwd(Args a) {
    LAS unsigned char* lds = (LAS unsigned char*)lds_raw;
    unsigned* ctl = (unsigned*)(a.ws + WS_CTL);
    volatile LAS unsigned* bst = (volatile LAS unsigned*)(lds + LDS_MISC + 2048);
    { const int tid = threadIdx.x;
      if ((tid & 63) == 0) ((LAS int*)(lds + LDS_WIDTAB))[hw_slot()] = tid >> 6;
      if (tid < 4) bst[tid] = 0u; }
    __syncthreads();
    const int lo = a.ph_lo, hi = a.ph_hi;
    XcdBarrier bar; bar.bar = ctl + CW_BAR; bar.x = 0; bar.st = bst;
    if (hi - lo > 1) bar = xcd_barrier_post(ctl + CW_BAR, bst);
#ifdef ONLY_PHASE
#define IN(k) ((k) == ONLY_PHASE && lo <= (k) && (k) < hi)
#else
#define IN(k) (lo <= (k) && (k) < hi)
#endif
#define SEAM(k) do { if (IN(k) && IN((k) + 1)) xcd_barrier(bar); } while (0)
    if (IN(0)) { asm volatile("; PHASE_MARK 0"); ph0(); } SEAM(0);
    if (IN(1)) { if ((int)blockIdx.x < (int)gridDim.x - NSTREAM((int)gridDim.x)) { asm volatile("; PHASE_MARK 1a"); ph1a(); asm volatile("; PHASE_MARK 1b"); ph1b(); asm volatile("; PHASE_MARK 1c"); ph1c(); } asm volatile("; PHASE_MARK 1q"); ph1q(); } if (IN(1) && (IN(2) || IN(3))) xcd_barrier(bar);
    if (IN(3)) { asm volatile("; PHASE_MARK 3a"); ph3a();
        for (int r = 0; r < 2; ++r) { if (r == 1 || (int)blockIdx.x >= (int)gridDim.x - NSTREAM((int)gridDim.x)) { asm volatile("; PHASE_MARK 3q"); ph3q(); }
            if (r == 0) { asm volatile("; PHASE_MARK 3b"); ph3b(); } } } SEAM(3);
    if (IN(4)) { asm volatile("; PHASE_MARK 4"); ph4(); } SEAM(4);
    if (IN(5)) { asm volatile("; PHASE_MARK 5"); ph5(); } SEAM(5);
    if (IN(6)) { asm volatile("; PHASE_MARK 6"); ph_lnr<0>(); } SEAM(6);
    if (IN(7)) { asm volatile("; PHASE_MARK 7"); ph_moe1<0>(); } SEAM(7);
    if (IN(8)) { asm volatile("; PHASE_MARK 8"); ph_moe2<0>(); } SEAM(8);
    if (IN(9)) { asm volatile("; PHASE_MARK 9"); ph_ln2<0>(); } SEAM(9);
    if (IN(10)) { asm volatile("; PHASE_MARK 10"); ph10(); } SEAM(10);
    if (IN(11)) { asm volatile("; PHASE_MARK 11"); ph11(); } SEAM(11);
    if (IN(12)) { asm volatile("; PHASE_MARK 12"); ph12(); } SEAM(12);
    if (IN(13)) { asm volatile("; PHASE_MARK 13"); ph13(); } SEAM(13);
    if (IN(14)) { asm volatile("; PHASE_MARK 14"); ph14(); } SEAM(14);
    if (IN(15)) { asm volatile("; PHASE_MARK 15"); ph15(); } SEAM(15);
    if (IN(16)) { asm volatile("; PHASE_MARK 16"); ph16(); } SEAM(16);
    if (IN(17)) { asm volatile("; PHASE_MARK 17"); ph_lnr<1>(); } SEAM(17);
    if (IN(18)) { asm volatile("; PHASE_MARK 18"); ph_moe1<1>(); } SEAM(18);
    if (IN(19)) { asm volatile("; PHASE_MARK 19"); ph_moe2<1>(); } SEAM(19);
    if (IN(20)) { asm volatile("; PHASE_MARK 20"); ph_ln2<1>(); }
#undef IN
#undef SEAM
}

#ifndef MK_PER_PHASE
#define MK_PER_PHASE 0
#endif
extern "C" void kernel_launch(void* const* d_in, const int* in_sizes, int n_in, void* d_out, int out_size, void* d_ws, size_t ws_size, hipStream_t stream) {
    static int grid = 0;
    if (grid == 0) {
        if (n_in != 37 || out_size != NTOK * DM || ws_size < WS_END) { fprintf(stderr, "kernel_launch: built for 37 inputs, %d outputs, >= %zu bytes of workspace; got n_in %d out %d ws %zu\n", NTOK * DM, (size_t)WS_END, n_in, out_size, ws_size); grid = -1; return; }
        int dev = 0, cus = 0, per_cu = 0;
        if (hipGetDevice(&dev) != hipSuccess || hipDeviceGetAttribute(&cus, hipDeviceAttributeMultiprocessorCount, dev) != hipSuccess) { grid = -1; return; }
        if (hipFuncSetAttribute((const void*)fwd, hipFuncAttributeMaxDynamicSharedMemorySize, LDS_BYTES) != hipSuccess) { fprintf(stderr, "kernel_launch: hipFuncSetAttribute failed\n"); grid = -1; return; }
        if (hipOccupancyMaxActiveBlocksPerMultiprocessor(&per_cu, (const void*)fwd, 512, LDS_BYTES) != hipSuccess || per_cu < 1) fprintf(stderr, "kernel_launch: occupancy query reports %d\n", per_cu);
        (void)hipGetLastError();
        grid = cus;
    }
    if (grid < 0) return;
    (void)hipMemsetAsync((char*)d_ws + WS_CTL, 0, CTL_ZERO_BYTES, stream);
    Args a{};
    for (int i = 0; i < 37; ++i) a.in[i] = (const float*)d_in[i];
    a.out = (float*)d_out; a.ws = (unsigned char*)d_ws;
#if MK_PER_PHASE
    for (int p = 0; p < NPHASE; ++p) { a.ph_lo = p; a.ph_hi = p + 1; hipLaunchKernelGGL(fwd, dim3(grid), dim3(512), LDS_BYTES, stream, a); }
#else
    a.ph_lo = 0; a.ph_hi = NPHASE; hipLaunchKernelGGL(fwd, dim3(grid), dim3(512), LDS_BYTES, stream, a);
#endif
}
```
